# Optimizing an MI355X kernel written in HIP

```python
import math
import jax, jax.numpy as jnp
from jax import lax
import numpy as np

D_MODEL = 2048
BATCH = 2
SEQ = 16384
DEPTH = 1

HEAD_DIM = 128
A_HEADS = 8
A_KV_HEADS = 2
A_GROUP = A_HEADS // A_KV_HEADS
A_WIDTH = A_HEADS * HEAD_DIM
A_KV_WIDTH = A_KV_HEADS * HEAD_DIM
WINDOW = 128
A_BLOCK = 128
NUM_BUCKETS = 32
MAX_DISTANCE = 128
B_HEADS = 8
B_WIDTH = B_HEADS * HEAD_DIM
GRID_W = 64
NB_ROWS = 8
NB_COLS = 16
IN_COLS = A_WIDTH + 2 * A_KV_WIDTH + 3 * B_WIDTH + 2 * D_MODEL
N_GROUPS = 4
EXPERTS_PER_GROUP = 8
N_EXPERTS = N_GROUPS * EXPERTS_PER_GROUP
TOP_K = 2
D_EXPERT = 512
MOE_BLOCK = 128
EPS = 1e-6
NEG_INF = -1e30

kernel_name = "hybrid_window_gqa_natten_hier_moe"


def rms_norm(x, g):
    xf = x.astype(jnp.float32)
    y = xf * lax.rsqrt(jnp.mean(xf * xf, axis=-1, keepdims=True) + EPS)
    return (y * g.astype(jnp.float32)).astype(x.dtype)


def t5_bucket(rel):
    nb = NUM_BUCKETS // 2
    ret = jnp.where(rel > 0, nb, 0)
    n = jnp.abs(rel)
    max_exact = nb // 2
    nf = jnp.maximum(n, 1).astype(jnp.float32)
    large = max_exact + (jnp.log(nf / max_exact) / math.log(MAX_DISTANCE / max_exact)
                         * (nb - max_exact)).astype(jnp.int32)
    large = jnp.minimum(large, nb - 1)
    return ret + jnp.where(n < max_exact, n, large)


def window_gqa(q, k, v, g_q, g_k, rel_table, sink):
    B, S = q.shape[0], q.shape[1]
    nb = S // A_BLOCK
    q = rms_norm(q.reshape(B, S, A_HEADS, HEAD_DIM), g_q)
    k = rms_norm(k.reshape(B, S, A_KV_HEADS, HEAD_DIM), g_k)
    v = v.reshape(B, S, A_KV_HEADS, HEAD_DIM)
    qb = q.reshape(B, nb, A_BLOCK, A_KV_HEADS, A_GROUP, HEAD_DIM)

    def band(t):
        tp = jnp.pad(t, ((0, 0), (WINDOW, WINDOW), (0, 0), (0, 0)))
        tp = tp.reshape(B, nb + 2, A_BLOCK, A_KV_HEADS, HEAD_DIM)
        return jnp.concatenate([tp[:, :-2], tp[:, 1:-1], tp[:, 2:]], axis=2)

    kw, vw = band(k), band(v)
    s = jnp.einsum('bnqhgd,bnkhd->bnhgqk', qb, kw).astype(jnp.float32) * (HEAD_DIM ** -0.5)
    q_loc = jnp.arange(A_BLOCK)
    k_loc = jnp.arange(3 * A_BLOCK) - WINDOW
    rel = k_loc[None, :] - q_loc[:, None]
    bias = rel_table[t5_bucket(rel)].astype(jnp.float32)
    bias = jnp.transpose(bias, (2, 0, 1)).reshape(A_KV_HEADS, A_GROUP, A_BLOCK, 3 * A_BLOCK)
    k_pos = jnp.arange(nb)[:, None] * A_BLOCK + k_loc[None, :]
    valid = (jnp.abs(rel) <= WINDOW)[None] & ((k_pos >= 0) & (k_pos < S))[:, None, :]
    s = jnp.where(valid[None, :, None, None], s + bias, NEG_INF)
    sink_col = jnp.broadcast_to(sink.astype(jnp.float32).reshape(A_KV_HEADS, A_GROUP, 1, 1),
                                s.shape[:-1] + (1,))
    p = jax.nn.softmax(jnp.concatenate([s, sink_col], axis=-1), axis=-1)[..., :-1]
    o = jnp.einsum('bnhgqk,bnkhd->bnqhgd', p.astype(v.dtype), vw)
    return o.reshape(B, S, A_WIDTH)


def neighbourhood_attention(q, k, v, g_q, g_k, rpb):
    B, S = q.shape[0], q.shape[1]
    R = S // GRID_W
    kh = min(NB_ROWS, R)
    q = rms_norm(q.reshape(B, R, GRID_W, B_HEADS, HEAD_DIM), g_q)
    k = rms_norm(k.reshape(B, R, GRID_W, B_HEADS, HEAD_DIM), g_k)
    v = v.reshape(B, R, GRID_W, B_HEADS, HEAD_DIM)
    cols = jnp.arange(GRID_W)
    col_idx = jnp.clip(cols - NB_COLS // 2, 0, GRID_W - NB_COLS)[:, None] + jnp.arange(NB_COLS)[None, :]
    dc = col_idx - cols[:, None] + (NB_COLS - 1)
    scale = HEAD_DIM ** -0.5

    def row(r):
        rs = jnp.clip(r - kh // 2, 0, R - kh)
        q_r = lax.dynamic_index_in_dim(q, r, axis=1, keepdims=False)
        k_nb = lax.dynamic_slice_in_dim(k, rs, kh, axis=1)[:, :, col_idx]
        v_nb = lax.dynamic_slice_in_dim(v, rs, kh, axis=1)[:, :, col_idx]
        s = jnp.einsum('bqhd,brqjhd->bhqrj', q_r, k_nb).astype(jnp.float32) * scale
        dr = rs + jnp.arange(kh) - r + (NB_ROWS - 1)
        bias = rpb[:, dr[None, :, None], dc[:, None, :]].astype(jnp.float32)
        s = s + bias[None]
        p = jax.nn.softmax(s.reshape(B, B_HEADS, GRID_W, kh * NB_COLS), axis=-1).reshape(s.shape)
        return jnp.einsum('bhqrj,brqjhd->bqhd', p.astype(v.dtype), v_nb)

    o = lax.map(row, jnp.arange(R))
    return jnp.moveaxis(o, 0, 1).reshape(B, S, B_WIDTH)


def mixer_sublayer(x, norm_g, w_in, q_norm_a, k_norm_a, sink_a, q_norm_b, k_norm_b, rpb_b,
                   w_up_a, w_up_b, w_out, rel_table):
    xn = rms_norm(x, norm_g)
    proj = xn @ w_in
    cuts = np.cumsum([A_WIDTH, A_KV_WIDTH, A_KV_WIDTH, B_WIDTH, B_WIDTH, B_WIDTH, D_MODEL])
    qa, ka, va, qb, kb, vb, ga, gb = jnp.split(proj, [int(c) for c in cuts], axis=-1)
    oa = window_gqa(qa, ka, va, q_norm_a, k_norm_a, rel_table, sink_a)
    ob = neighbourhood_attention(qb, kb, vb, q_norm_b, k_norm_b, rpb_b)
    merged = jax.nn.sigmoid(ga) * (oa @ w_up_a) + jax.nn.sigmoid(gb) * (ob @ w_up_b)
    return x + merged @ w_out


def hier_moe(xn, w_rg, b_rg, w_re, b_re, w_gate, w_up, w_down):
    T, D = xn.shape
    g_logits = (xn @ w_rg).astype(jnp.float32) + b_rg.astype(jnp.float32)
    g_idx = jnp.argmax(g_logits, axis=-1)
    p_g = jnp.take_along_axis(jax.nn.softmax(g_logits, axis=-1), g_idx[:, None], axis=-1)
    e_all = ((xn @ w_re).astype(jnp.float32) + b_re.astype(jnp.float32)).reshape(T, N_GROUPS, EXPERTS_PER_GROUP)
    e_logits = jnp.take_along_axis(e_all, g_idx[:, None, None], axis=1)[:, 0]
    top_v, top_e = lax.top_k(e_logits, TOP_K)
    weight = p_g * jax.nn.softmax(top_v, axis=-1)
    expert_id = g_idx[:, None] * EXPERTS_PER_GROUP + top_e

    A = T * TOP_K
    flat_e = expert_id.reshape(A).astype(jnp.int32)
    flat_tok = jnp.repeat(jnp.arange(T, dtype=jnp.int32), TOP_K)
    flat_w = weight.reshape(A)
    order = jnp.argsort(flat_e)
    se, st, sw = flat_e[order], flat_tok[order], flat_w[order]
    counts = jnp.bincount(flat_e, length=N_EXPERTS).astype(jnp.int32)
    padded = ((counts + MOE_BLOCK - 1) // MOE_BLOCK) * MOE_BLOCK
    end_pad = jnp.cumsum(padded)
    start_pad = end_pad - padded
    start_orig = jnp.cumsum(counts) - counts
    dest = start_pad[se] + (jnp.arange(A, dtype=jnp.int32) - start_orig[se])
    P = A + N_EXPERTS * MOE_BLOCK
    NB = P // MOE_BLOCK
    buf_tok = jnp.full((P,), T, jnp.int32).at[dest].set(st)
    buf_w = jnp.zeros((P,), jnp.float32).at[dest].set(sw)
    blk_e = jnp.minimum(jnp.searchsorted(end_pad, jnp.arange(NB, dtype=jnp.int32) * MOE_BLOCK, side='right'),
                        N_EXPERTS - 1)
    x_pad = jnp.concatenate([xn, jnp.zeros((1, D), xn.dtype)], axis=0)

    def expert_block(args):
        e, tok, w = args
        rows = x_pad[tok]
        h = jax.nn.silu(rows @ w_gate[e]) * (rows @ w_up[e])
        return (h @ w_down[e]) * w[:, None].astype(rows.dtype)

    yb = lax.map(expert_block, (blk_e, buf_tok.reshape(NB, MOE_BLOCK), buf_w.reshape(NB, MOE_BLOCK)))
    y = jnp.zeros((T + 1, D), xn.dtype).at[buf_tok].add(yb.reshape(P, D))
    return y[:T]


def setup_inputs(seed: int = 0) -> dict:
    key = jax.random.key(seed)
    ks = jax.random.split(key, 21)
    f32 = jnp.float32
    L = DEPTH

    def nrm(k, shape, scale):
        return jax.random.normal(k, shape, f32) * scale

    return {
        "x": nrm(ks[0], (BATCH, SEQ, D_MODEL), 1.0),
        "norm1_g": 1.0 + nrm(ks[1], (L, D_MODEL), 0.02),
        "w_in": nrm(ks[2], (L, D_MODEL, IN_COLS), D_MODEL ** -0.5),
        "q_norm_a": 1.0 + nrm(ks[3], (L, HEAD_DIM), 0.02),
        "k_norm_a": 1.0 + nrm(ks[4], (L, HEAD_DIM), 0.02),
        "sink_a": nrm(ks[5], (L, A_HEADS), 0.5),
        "q_norm_b": 1.0 + nrm(ks[6], (L, HEAD_DIM), 0.02),
        "k_norm_b": 1.0 + nrm(ks[7], (L, HEAD_DIM), 0.02),
        "rpb_b": nrm(ks[8], (L, B_HEADS, 2 * NB_ROWS - 1, 2 * NB_COLS - 1), 0.1),
        "w_up_a": nrm(ks[9], (L, A_WIDTH, D_MODEL), A_WIDTH ** -0.5),
        "w_up_b": nrm(ks[10], (L, B_WIDTH, D_MODEL), B_WIDTH ** -0.5),
        "w_out": nrm(ks[11], (L, D_MODEL, D_MODEL), D_MODEL ** -0.5),
        "rel_bias_table": nrm(ks[12], (NUM_BUCKETS, A_HEADS), 0.1),
        "norm2_g": 1.0 + nrm(ks[13], (L, D_MODEL), 0.02),
        "w_router_group": nrm(ks[14], (L, D_MODEL, N_GROUPS), D_MODEL ** -0.5),
        "b_router_group": nrm(ks[15], (L, N_GROUPS), 0.01),
        "w_router_expert": nrm(ks[16], (L, D_MODEL, N_EXPERTS), D_MODEL ** -0.5),
        "b_router_expert": nrm(ks[17], (L, N_EXPERTS), 0.01),
        "w_gate": nrm(ks[18], (L, N_EXPERTS, D_MODEL, D_EXPERT), D_MODEL ** -0.5),
        "w_up": nrm(ks[19], (L, N_EXPERTS, D_MODEL, D_EXPERT), D_MODEL ** -0.5),
        "w_down": nrm(ks[20], (L, N_EXPERTS, D_EXPERT, D_MODEL), D_EXPERT ** -0.5),
    }


def reference(x, norm1_g, w_in, q_norm_a, k_norm_a, sink_a, q_norm_b, k_norm_b, rpb_b,
              w_up_a, w_up_b, w_out, rel_bias_table, norm2_g, w_router_group, b_router_group,
              w_router_expert, b_router_expert, w_gate, w_up, w_down):
    B, S, D = x.shape
    h = x
    for l in range(DEPTH):
        h = mixer_sublayer(h, norm1_g[l], w_in[l], q_norm_a[l], k_norm_a[l], sink_a[l],
                           q_norm_b[l], k_norm_b[l], rpb_b[l], w_up_a[l], w_up_b[l], w_out[l],
                           rel_bias_table)
        hn = rms_norm(h, norm2_g[l]).reshape(B * S, D)
        h = h + hier_moe(hn, w_router_group[l], b_router_group[l], w_router_expert[l],
                         b_router_expert[l], w_gate[l], w_up[l], w_down[l]).reshape(B, S, D)
    return h
```

```cpp
#include <hip/hip_runtime.h>
#include <cstdio>
#include <cstdint>

#define LAS __attribute__((address_space(3)))
typedef unsigned short bf16_t;
typedef short bf16x8 __attribute__((ext_vector_type(8)));
typedef short s16x4 __attribute__((ext_vector_type(4)));
typedef float f32x4 __attribute__((ext_vector_type(4)));
typedef unsigned u32x4 __attribute__((ext_vector_type(4)));
typedef unsigned u32x2 __attribute__((ext_vector_type(2)));
typedef short v4i16_t __attribute__((ext_vector_type(4)));

namespace cfg {
constexpr int T = 32768, D = 2048, SEQ = 16384;
constexpr int NQKV = 4608, NGATE = 4096, NIN = 8704;
constexpr size_t MiB = 1ull << 20;
constexpr size_t WS_XB = 0, WS_QKV = 128 * MiB, WS_GATES = 416 * MiB, WS_O = 672 * MiB, WS_WIN = 800 * MiB, WS_WUP = 834 * MiB, WS_WOUT = 842 * MiB, WS_MISC = 850 * MiB;
constexpr size_t WS_WGU = WS_QKV, WS_WD = WS_QKV + 128 * MiB, WS_HE = WS_QKV + 192 * MiB;
constexpr size_t WS_R1 = WS_MISC, WS_R2 = WS_R1 + (size_t)T * 4, WS_WRT = WS_R2 + (size_t)T * 4, WS_CNT = WS_WRT + 512 * 1024, WS_TOK = WS_CNT + 4096,
                 WS_WL = WS_TOK + 64ull * T * 4, WS_END = WS_WL + 64ull * T * 4;
constexpr int LDS_BYTES = 140 * 1024;
constexpr int TAB_OFF = 132 * 1024;
constexpr float EPS = 1e-6f;
}
using namespace cfg;

struct Params { const float* in[21]; float* out; unsigned char* ws; };

__device__ __forceinline__ float bf2f(short s) { return __uint_as_float(((unsigned)(unsigned short)s) << 16); }
typedef float f32x2 __attribute__((ext_vector_type(2)));
typedef __bf16 bf16x2_t __attribute__((ext_vector_type(2)));
__device__ __forceinline__ unsigned pk2(float lo, float hi) { const f32x2 v = {lo, hi}; return __builtin_bit_cast(unsigned, __builtin_convertvector(v, bf16x2_t)); }
__device__ __forceinline__ float wave_sum(float v) {
#pragma unroll
    for (int o = 1; o < 64; o <<= 1) v += __shfl_xor(v, o);
    return v;
}
__device__ __forceinline__ float sigmoidf_(float v) { return 1.0f / (1.0f + __expf(-v)); }
__device__ __forceinline__ unsigned off_b(unsigned row, unsigned ch) { return 256u * row + 16u * (ch ^ (((row & 3) << 2) | ((row >> 2) & 3))); }
__device__ __forceinline__ s16x4 tr_read(LAS unsigned char* p) { return __builtin_bit_cast(s16x4, __builtin_amdgcn_ds_read_tr16_b64_v4i16((LAS v4i16_t*)p)); }
__host__ __device__ __forceinline__ int perm32(int rho) { const int n = rho >> 4, i = rho & 15; return 8 * (i >> 2) + 4 * n + (i & 3); }
__device__ __forceinline__ int t5_bucket(int rel) {
    const int n = rel < 0 ? -rel : rel; const int ret = rel > 0 ? 16 : 0; int b;
    if (n < 8) b = n; else if (n < 12) b = 8; else if (n < 16) b = 9; else if (n < 23) b = 10; else if (n < 32) b = 11; else if (n < 46) b = 12; else if (n < 64) b = 13; else if (n < 91) b = 14; else b = 15;
    return ret + b;
}

__device__ __forceinline__ void transpose_item(const float* __restrict__ W, int ldw, int k0, int n0, bf16_t* __restrict__ WT, int ldt, int drow0, int dk0, const float* __restrict__ scale, LAS float* scr, int lane) {
#pragma unroll 8
    for (int i = 0; i < 32; ++i) { const int kk = 2 * i + (lane >> 5); float v = W[(size_t)(k0 + kk) * ldw + n0 + (lane & 31)]; if (scale) v *= scale[k0 + kk]; scr[kk * 33 + (lane & 31)] = v; }
    asm volatile("s_waitcnt lgkmcnt(0)" ::: "memory");
    const int c = lane & 7;
#pragma unroll
    for (int j = 0; j < 4; ++j) { const int n = (lane >> 3) + 8 * j; const LAS float* s = scr + (8 * c) * 33 + n;
        u32x4 o; o.x = pk2(s[0 * 33], s[1 * 33]); o.y = pk2(s[2 * 33], s[3 * 33]); o.z = pk2(s[4 * 33], s[5 * 33]); o.w = pk2(s[6 * 33], s[7 * 33]);
        *(u32x4*)(WT + (size_t)(drow0 + n) * ldt + dk0 + k0 + 8 * c) = o; }
    asm volatile("s_waitcnt lgkmcnt(0)" ::: "memory");
}

__device__ __forceinline__ void p0_prep(const Params& p, LAS unsigned char* lds) {
    const int tid = threadIdx.x, lane = tid & 63, wave = tid >> 6;
    const int gw = blockIdx.x * 8 + wave, NGW = gridDim.x * 8;
    LAS float* scr = (LAS float*)(lds + wave * 8448);
    const float* x = p.in[0]; const float* g1 = p.in[1]; const float* w_in = p.in[2];
    bf16_t* xb = (bf16_t*)(p.ws + WS_XB); float* r1 = (float*)(p.ws + WS_R1);
    bf16_t* WinT = (bf16_t*)(p.ws + WS_WIN); bf16_t* WupT = (bf16_t*)(p.ws + WS_WUP); bf16_t* WoutT = (bf16_t*)(p.ws + WS_WOUT);
    constexpr int I_WIN = 32 * 272, I_UP = 16 * 64, I_OUT = 32 * 64, NITEMS = I_WIN + 2 * I_UP + I_OUT;
    for (int it = gw; it < NITEMS; it += NGW) {
        int r = it;
        if (r < I_WIN) { const int kb = r / 272, nb = r % 272; transpose_item(w_in, NIN, kb * 64, nb * 32, WinT, 2048, nb * 32, 0, g1, scr, lane); continue; } r -= I_WIN;
        if (r < I_UP) { const int kb = r / 64, nb = r % 64; transpose_item(p.in[9], 2048, kb * 64, nb * 32, WupT, 2048, nb * 32, 0, nullptr, scr, lane); continue; } r -= I_UP;
        if (r < I_UP) { const int kb = r / 64, nb = r % 64; transpose_item(p.in[10], 2048, kb * 64, nb * 32, WupT, 2048, nb * 32, 1024, nullptr, scr, lane); continue; } r -= I_UP;
        { const int kb = r / 64, nb = r % 64; transpose_item(p.in[11], 2048, kb * 64, nb * 32, WoutT, 2048, nb * 32, 0, nullptr, scr, lane); }
    }
    { float* wrt = (float*)(p.ws + WS_WRT); const float* g2 = p.in[13]; const float* wrg = p.in[14]; const float* wre = p.in[16];
      for (int i = blockIdx.x * 512 + tid; i < 36 * 2048; i += gridDim.x * 512) { const int j = i >> 11, k = i & 2047; wrt[i] = g2[k] * (j < 4 ? wrg[k * 4 + j] : wre[k * 32 + (j - 4)]); } }
    if (blockIdx.x == 0 && tid < 64) ((int*)(p.ws + WS_CNT))[tid] = 0;
    for (int row = gw; row < T; row += NGW) {
        const f32x4* xr = (const f32x4*)(x + (size_t)row * D) + lane; f32x4 v[8]; float ss = 0.f;
#pragma unroll
        for (int j = 0; j < 8; ++j) { v[j] = xr[64 * j]; ss += (v[j].x * v[j].x + v[j].y * v[j].y) + (v[j].z * v[j].z + v[j].w * v[j].w); }
        ss = wave_sum(ss);
        if (lane == 0) r1[row] = rsqrtf(ss * (1.0f / D) + EPS);
        u32x2* o = (u32x2*)(xb + (size_t)row * D) + lane;
#pragma unroll
        for (int j = 0; j < 8; ++j) { u32x2 w; w.x = pk2(v[j].x, v[j].y); w.y = pk2(v[j].z, v[j].w); o[64 * j] = w; }
    }
}

__device__ __forceinline__ void p_moe_prep(const Params& p, LAS unsigned char* lds) {
    const int tid = threadIdx.x, lane = tid & 63, wave = tid >> 6;
    const int gw = blockIdx.x * 8 + wave, NGW = gridDim.x * 8;
    LAS float* scr = (LAS float*)(lds + wave * 8448);
    const float* g2 = p.in[13];
    bf16_t* WguT = (bf16_t*)(p.ws + WS_WGU); bf16_t* WdT = (bf16_t*)(p.ws + WS_WD);
    constexpr int I_G = 32 * 32 * 16;
    constexpr int I_D = 32 * 8 * 64;
    for (int it = gw; it < 2 * I_G + I_D; it += NGW) {
        int r = it;
        if (r < 2 * I_G) { const int which = r >= I_G; if (which) r -= I_G; const int e = r / 512, rr = r % 512, kb = rr / 16, nb = rr % 16;
            const float* W = p.in[which ? 19 : 18] + (size_t)e * 2048 * 512; const int n0 = nb * 32;
            transpose_item(W, 512, kb * 64, n0, WguT, 2048, e * 1024 + (n0 >> 7) * 256 + which * 128 + (n0 & 127), 0, g2, scr, lane); continue; }
        r -= 2 * I_G;
        { const int e = r / 512, rr = r % 512, kb = rr / 64, nb = rr % 64; const float* W = p.in[20] + (size_t)e * 512 * 2048;
          transpose_item(W, 2048, kb * 64, nb * 32, WdT, 512, e * 2048 + nb * 32, 0, nullptr, scr, lane); }
    }
}

struct Unit { int pm, pn, aux; };
template <bool PERM, bool ZERO, class ARow, class BRow>
__device__ __forceinline__ void sgemm_unit(LAS unsigned char* lds, const ARow& arow, const BRow& brow, int kbeg, int kend, f32x4 (&acc)[2][2][4][2], int wr, int wc, int fr, int fq, int tid) {
    if (ZERO) {
#pragma unroll
    for (int a = 0; a < 2; ++a)
#pragma unroll
        for (int b = 0; b < 2; ++b)
#pragma unroll
            for (int m = 0; m < 4; ++m)
#pragma unroll
                for (int n = 0; n < 2; ++n) acc[a][b][m][n] = (f32x4){0.f, 0.f, 0.f, 0.f};
    }
    unsigned ao[4], bo[4]; const bf16_t* const abase = arow.base; const bf16_t* const bbase = brow.base;
#pragma unroll
    for (int i = 0; i < 4; ++i) { const int pz = tid + 512 * i, row = pz >> 3, c8 = pz & 7; ao[i] = arow(row) + c8 * 8; const int Rb = PERM ? ((row & ~31) + perm32(row & 31)) : row; bo[i] = brow(Rb) + c8 * 8; }
    for (int k0 = kbeg; k0 < kend; k0 += 64) {
        bf16x8 ra[4], rb[4];
#pragma unroll
        for (int i = 0; i < 4; ++i) { ra[i] = *(const bf16x8*)(abase + ao[i] + k0); rb[i] = *(const bf16x8*)(bbase + bo[i] + k0); }
        __syncthreads();
#pragma unroll
        for (int i = 0; i < 4; ++i) { const int pz = tid + 512 * i, row = pz >> 3, c8 = pz & 7; *(LAS bf16x8*)(lds + row * 144 + c8 * 16) = ra[i]; *(LAS bf16x8*)(lds + 36864 + row * 144 + c8 * 16) = rb[i]; }
        __syncthreads();
#pragma unroll
        for (int ai = 0; ai < 2; ++ai) {
            bf16x8 At[4][2];
#pragma unroll
            for (int m = 0; m < 4; ++m)
#pragma unroll
                for (int k = 0; k < 2; ++k) At[m][k] = *(const LAS bf16x8*)(lds + (ai * 128 + wr * 64 + m * 16 + fr) * 144 + (k * 32 + fq * 8) * 2);
#pragma unroll
            for (int bj = 0; bj < 2; ++bj) {
                bf16x8 Bf[2][2];
#pragma unroll
                for (int n = 0; n < 2; ++n)
#pragma unroll
                    for (int k = 0; k < 2; ++k) Bf[n][k] = *(const LAS bf16x8*)(lds + 36864 + (bj * 128 + wc * 32 + n * 16 + fr) * 144 + (k * 32 + fq * 8) * 2);
#pragma unroll
                for (int m = 0; m < 4; ++m)
#pragma unroll
                    for (int n = 0; n < 2; ++n)
#pragma unroll
                        for (int k = 0; k < 2; ++k) acc[ai][bj][m][n] = __builtin_amdgcn_mfma_f32_16x16x32_bf16(Bf[n][k], At[m][k], acc[ai][bj][m][n], 0, 0, 0);
            }
        }
    }
}
struct DenseRow { const bf16_t* base; int ld; __device__ __forceinline__ unsigned operator()(int r) const { return (unsigned)(r * ld); } };

__device__ __forceinline__ void p1_inproj(const Params& p, LAS unsigned char* lds) {
    const int tid = threadIdx.x, lane = tid & 63, wid = tid >> 6, wr = wid >> 2, wc = wid & 3, fr = lane & 15, fq = lane >> 4;
    const bf16_t* xb = (const bf16_t*)(p.ws + WS_XB); const bf16_t* WinT = (const bf16_t*)(p.ws + WS_WIN);
    bf16_t* qkv = (bf16_t*)(p.ws + WS_QKV); bf16_t* gates = (bf16_t*)(p.ws + WS_GATES); const float* r1 = (const float*)(p.ws + WS_R1);
    constexpr int NU = 128 * 34;
    for (int ui = blockIdx.x; ui < NU; ui += gridDim.x) {
        Unit u; u.pn = ui / 128; u.pm = ui % 128; u.aux = 0;
        f32x4 acc[2][2][4][2];
        DenseRow ar{xb + (size_t)u.pm * 256 * D, D}, br{WinT + (size_t)u.pn * 256 * D, D};
        sgemm_unit<true, true>(lds, ar, br, 0, D, acc, wr, wc, fr, fq, tid);
        const bool isg = u.pn >= 18; bf16_t* base = isg ? gates : qkv; const int ldc = isg ? NGATE : NQKV; const int colt = (isg ? u.pn - 18 : u.pn) * 256 + wc * 32 + 8 * fq;
#pragma unroll
        for (int ai = 0; ai < 2; ++ai)
#pragma unroll
            for (int m = 0; m < 4; ++m) { const int row = u.pm * 256 + ai * 128 + wr * 64 + m * 16 + fr; const float rs = r1[row]; bf16_t* rowp = base + (size_t)row * ldc + colt;
#pragma unroll
                for (int bj = 0; bj < 2; ++bj) { f32x4 v0 = acc[ai][bj][m][0] * rs, v1 = acc[ai][bj][m][1] * rs;
                    if (isg) {
#pragma unroll
                        for (int j = 0; j < 4; ++j) { v0[j] = sigmoidf_(v0[j]); v1[j] = sigmoidf_(v1[j]); } }
                    u32x4 w; w.x = pk2(v0[0], v0[1]); w.y = pk2(v0[2], v0[3]); w.z = pk2(v1[0], v1[1]); w.w = pk2(v1[2], v1[3]);
                    *(u32x4*)(rowp + bj * 128) = w; } }
    }
}

template <bool NORM, class SrcRow>
__device__ __forceinline__ void stage_chunk(LAS unsigned char* lds, const SrcRow& src, const float* __restrict__ gain, int tid) {
#pragma unroll
    for (int i = 0; i < 4; ++i) { const int pz = tid + 512 * i, row = pz >> 4, ch = pz & 15;
        bf16x8 v = *(const bf16x8*)(src(row) + ch * 8);
        if (NORM) { float f[8]; float ss = 0.f;
#pragma unroll
            for (int j = 0; j < 8; ++j) { f[j] = bf2f(v[j]); ss += f[j] * f[j]; }
            ss += __shfl_xor(ss, 1); ss += __shfl_xor(ss, 2); ss += __shfl_xor(ss, 4); ss += __shfl_xor(ss, 8);
            const float rk = rsqrtf(ss * (1.0f / 128.0f) + EPS); const f32x4 g0 = *(const f32x4*)(gain + ch * 8), g1 = *(const f32x4*)(gain + ch * 8 + 4);
            u32x4 w; w.x = pk2(f[0] * rk * g0.x, f[1] * rk * g0.y); w.y = pk2(f[2] * rk * g0.z, f[3] * rk * g0.w); w.z = pk2(f[4] * rk * g1.x, f[5] * rk * g1.y); w.w = pk2(f[6] * rk * g1.z, f[7] * rk * g1.w);
            v = __builtin_bit_cast(bf16x8, w); }
        *(LAS bf16x8*)(lds + off_b(row, ch)) = v; }
}
__device__ __forceinline__ void load_q(const bf16_t* qp, const float* __restrict__ gain, int g, bf16x8 (&qf)[4]) {
    float f[4][8]; float ss = 0.f;
#pragma unroll
    for (int ks = 0; ks < 4; ++ks) { const bf16x8 v = *(const bf16x8*)(qp + 32 * ks + 8 * g);
#pragma unroll
        for (int j = 0; j < 8; ++j) { f[ks][j] = bf2f(v[j]); ss += f[ks][j] * f[ks][j]; } }
    ss += __shfl_xor(ss, 16); ss += __shfl_xor(ss, 32);
    const float rq = rsqrtf(ss * (1.0f / 128.0f) + EPS) * 0.08838834764831845f;
#pragma unroll
    for (int ks = 0; ks < 4; ++ks) { const f32x4 g0 = *(const f32x4*)(gain + 32 * ks + 8 * g), g1 = *(const f32x4*)(gain + 32 * ks + 8 * g + 4);
        u32x4 w; w.x = pk2(f[ks][0] * rq * g0.x, f[ks][1] * rq * g0.y); w.y = pk2(f[ks][2] * rq * g0.z, f[ks][3] * rq * g0.w); w.z = pk2(f[ks][4] * rq * g1.x, f[ks][5] * rq * g1.y); w.w = pk2(f[ks][6] * rq * g1.z, f[ks][7] * rq * g1.w);
        qf[ks] = __builtin_bit_cast(bf16x8, w); }
}
struct TokRow { const bf16_t* base; __device__ __forceinline__ const bf16_t* operator()(int r) const { return base + (size_t)r * NQKV; } };
struct NatRow { const bf16_t* base;   __device__ __forceinline__ const bf16_t* operator()(int r) const { return base + (size_t)(r & 63) * NQKV + (r >> 6) * 128; } };

__device__ __forceinline__ void attn_window_item(const Params& p, LAS unsigned char* lds, int item) {
    const int tid = threadIdx.x, lane = tid & 63, w = __builtin_amdgcn_readfirstlane(tid >> 6), g = lane >> 4, ql = lane & 15;
    const int b = item >> 10, nb = (item >> 3) & 127, hq = item & 7, kv = hq >> 2;
    const bf16_t* qkv = (const bf16_t*)(p.ws + WS_QKV); bf16_t* o = (bf16_t*)(p.ws + WS_O);
    LAS float* bias = (LAS float*)(lds + 32768);
    __syncthreads();
    if (tid < 257) bias[tid] = p.in[12][t5_bucket(tid - 128) * 8 + hq];
    const int tq = b * SEQ + nb * 128 + 16 * w + ql;
    bf16x8 qf[4]; load_q(qkv + (size_t)tq * NQKV + hq * 128, p.in[3], g, qf);
    f32x4 S1[8], SC[9];
#pragma unroll
    for (int kt = 0; kt < 8; ++kt) S1[kt] = (f32x4){0.f, 0.f, 0.f, 0.f};
#pragma unroll
    for (int s = 0; s < 9; ++s) SC[s] = (f32x4){0.f, 0.f, 0.f, 0.f};
    const bool in0 = nb > 0, in2 = nb < 127;
#pragma unroll
    for (int c = 0; c < 3; ++c) { const int kb = nb - 1 + c; if (kb < 0 || kb > 127) continue;
        __syncthreads();
        stage_chunk<true>(lds, TokRow{qkv + (size_t)(b * SEQ + kb * 128) * NQKV + 1024 + kv * 128}, p.in[4], tid);
        __syncthreads();
#pragma unroll
        for (int kt = 0; kt < 8; ++kt) {
            if (c == 1) {
#pragma unroll
                for (int ks = 0; ks < 4; ++ks) { const bf16x8 kf = *(const LAS bf16x8*)(lds + off_b(16 * kt + ql, 4 * ks + g)); S1[kt] = __builtin_amdgcn_mfma_f32_16x16x32_bf16(kf, qf[ks], S1[kt], 0, 0, 0); }
            } else if (c == 0) { if (kt >= w) {
#pragma unroll
                for (int ks = 0; ks < 4; ++ks) { const bf16x8 kf = *(const LAS bf16x8*)(lds + off_b(16 * kt + ql, 4 * ks + g)); SC[7 - kt] = __builtin_amdgcn_mfma_f32_16x16x32_bf16(kf, qf[ks], SC[7 - kt], 0, 0, 0); } }
            } else { if (kt <= w) {
#pragma unroll
                for (int ks = 0; ks < 4; ++ks) { const bf16x8 kf = *(const LAS bf16x8*)(lds + off_b(16 * kt + ql, 4 * ks + g)); SC[8 - kt] = __builtin_amdgcn_mfma_f32_16x16x32_bf16(kf, qf[ks], SC[8 - kt], 0, 0, 0); } }
            }
        }
    }
    const float sink = p.in[5][hq]; float mx = sink; const int qi = 16 * w + ql;
#pragma unroll
    for (int kt = 0; kt < 8; ++kt)
#pragma unroll
        for (int r = 0; r < 4; ++r) { const int rel = 16 * kt + 4 * g + r - qi; const float sv = S1[kt][r] + bias[rel + 128]; S1[kt][r] = sv; mx = fmaxf(mx, sv); }
#pragma unroll
    for (int s = 0; s < 9; ++s) { const bool c0 = s <= 7 - w; const int kt = c0 ? 7 - s : 8 - s; const int cofs = c0 ? -128 : 128; const bool inr = c0 ? in0 : in2;
#pragma unroll
        for (int r = 0; r < 4; ++r) { const int rel = cofs + 16 * kt + 4 * g + r - qi; const bool valid = inr && rel >= -128 && rel <= 128;
            const float sv = valid ? SC[s][r] + bias[valid ? rel + 128 : 0] : -1e30f; SC[s][r] = sv; mx = fmaxf(mx, sv); } }
    mx = fmaxf(mx, __shfl_xor(mx, 16)); mx = fmaxf(mx, __shfl_xor(mx, 32));
    float l = 0.f;
#pragma unroll
    for (int kt = 0; kt < 8; ++kt)
#pragma unroll
        for (int r = 0; r < 4; ++r) { const float pe = __expf(S1[kt][r] - mx); S1[kt][r] = pe; l += pe; }
#pragma unroll
    for (int s = 0; s < 9; ++s)
#pragma unroll
        for (int r = 0; r < 4; ++r) { const float pe = __expf(SC[s][r] - mx); SC[s][r] = pe; l += pe; }
    l += __shfl_xor(l, 16); l += __shfl_xor(l, 32); l += __expf(sink - mx);
    const float inv = 1.0f / l;
    f32x4 O[8];
#pragma unroll
    for (int dt = 0; dt < 8; ++dt) O[dt] = (f32x4){0.f, 0.f, 0.f, 0.f};
    const int q4 = ql >> 2, pp = ql & 3;
    const f32x4 zero4 = (f32x4){0.f, 0.f, 0.f, 0.f};
#pragma unroll
    for (int c = 0; c < 3; ++c) { const int kb = nb - 1 + c; if (kb < 0 || kb > 127) continue;
        __syncthreads();
        stage_chunk<false>(lds, TokRow{qkv + (size_t)(b * SEQ + kb * 128) * NQKV + 1280 + kv * 128}, nullptr, tid);
        __syncthreads();
#pragma unroll
        for (int kk = 0; kk < 4; ++kk) {
            bool a0, a1; f32x4 p0, p1;
            if (c == 1) { a0 = true; a1 = true; p0 = S1[2 * kk]; p1 = S1[2 * kk + 1]; }
            else if (c == 0) { a0 = 2 * kk >= w; a1 = 2 * kk + 1 >= w; p0 = a0 ? SC[7 - 2 * kk] : zero4; p1 = a1 ? SC[6 - 2 * kk] : zero4; }
            else { a0 = 2 * kk <= w; a1 = 2 * kk + 1 <= w; p0 = a0 ? SC[8 - 2 * kk] : zero4; p1 = a1 ? SC[7 - 2 * kk] : zero4; }
            if (a0 || a1) { u32x4 pw; pw.x = pk2(p0[0], p0[1]); pw.y = pk2(p0[2], p0[3]); pw.z = pk2(p1[0], p1[1]); pw.w = pk2(p1[2], p1[3]);
                const bf16x8 pf = __builtin_bit_cast(bf16x8, pw);
#pragma unroll
                for (int dt = 0; dt < 8; ++dt) { const s16x4 lo = tr_read(lds + off_b(32 * kk + 4 * g + q4, 2 * dt + (pp >> 1)) + 8 * (pp & 1)), hi = tr_read(lds + off_b(32 * kk + 16 + 4 * g + q4, 2 * dt + (pp >> 1)) + 8 * (pp & 1));
                    bf16x8 vf; vf[0] = lo[0]; vf[1] = lo[1]; vf[2] = lo[2]; vf[3] = lo[3]; vf[4] = hi[0]; vf[5] = hi[1]; vf[6] = hi[2]; vf[7] = hi[3];
                    O[dt] = __builtin_amdgcn_mfma_f32_16x16x32_bf16(vf, pf, O[dt], 0, 0, 0); } } }
    }
    bf16_t* op = o + (size_t)tq * D + hq * 128 + 4 * g;
#pragma unroll
    for (int dt = 0; dt < 8; ++dt) { u32x2 w2; w2.x = pk2(O[dt][0] * inv, O[dt][1] * inv); w2.y = pk2(O[dt][2] * inv, O[dt][3] * inv); *(u32x2*)(op + 16 * dt) = w2; }
}

__device__ __forceinline__ void attn_nat_item(const Params& p, LAS unsigned char* lds, int item) {
    const int tid = threadIdx.x, lane = tid & 63, w = tid >> 6, g = lane >> 4, ql = lane & 15;
    const int b = item >> 10, r = (item >> 2) & 255, hp = item & 3, hh = w >> 2, h = 2 * hp + hh, jq = w & 3;
    const int rs = min(max(r - 4, 0), 248); const int w0 = jq == 0 ? 0 : (jq == 1 ? 8 : (jq == 2 ? 24 : 32));
    const bf16_t* qkv = (const bf16_t*)(p.ws + WS_QKV); bf16_t* o = (bf16_t*)(p.ws + WS_O);
    LAS float* rpb = (LAS float*)(lds + 32768);
    __syncthreads();
    for (int i = tid; i < 930; i += 512) rpb[i] = p.in[8][(2 * hp) * 465 + i];
    const int qcol = 16 * jq + ql; const int tq = b * SEQ + r * 64 + qcol;
    bf16x8 qf[4]; load_q(qkv + (size_t)tq * NQKV + 1536 + h * 128, p.in[6], g, qf);
    f32x4 S[8][2];
#pragma unroll
    for (int i = 0; i < 8; ++i) { S[i][0] = (f32x4){0.f, 0.f, 0.f, 0.f}; S[i][1] = (f32x4){0.f, 0.f, 0.f, 0.f}; }
#pragma unroll
    for (int i = 0; i < 8; ++i) {
        __syncthreads();
        stage_chunk<true>(lds, NatRow{qkv + (size_t)(b * SEQ + (rs + i) * 64) * NQKV + 2560 + 2 * hp * 128}, p.in[7], tid);
        __syncthreads();
#pragma unroll
        for (int t = 0; t < 2; ++t)
#pragma unroll
            for (int ks = 0; ks < 4; ++ks) { const bf16x8 kf = *(const LAS bf16x8*)(lds + off_b(hh * 64 + w0 + 16 * t + ql, 4 * ks + g)); S[i][t] = __builtin_amdgcn_mfma_f32_16x16x32_bf16(kf, qf[ks], S[i][t], 0, 0, 0); }
    }
    const int cs = min(max(qcol - 8, 0), 48); float mx = -1e30f;
#pragma unroll
    for (int i = 0; i < 8; ++i) { const int dr = rs + i - r + 7;
#pragma unroll
        for (int t = 0; t < 2; ++t)
#pragma unroll
            for (int rr = 0; rr < 4; ++rr) { const int kc = w0 + 16 * t + 4 * g + rr; const bool valid = kc >= cs && kc < cs + 16; const int dc = kc - qcol + 15;
                const float s = valid ? S[i][t][rr] + rpb[hh * 465 + dr * 31 + (valid ? dc : 0)] : -1e30f; S[i][t][rr] = s; mx = fmaxf(mx, s); } }
    mx = fmaxf(mx, __shfl_xor(mx, 16)); mx = fmaxf(mx, __shfl_xor(mx, 32));
    float l = 0.f;
#pragma unroll
    for (int i = 0; i < 8; ++i)
#pragma unroll
        for (int t = 0; t < 2; ++t)
#pragma unroll
            for (int rr = 0; rr < 4; ++rr) { const float pe = __expf(S[i][t][rr] - mx); S[i][t][rr] = pe; l += pe; }
    l += __shfl_xor(l, 16); l += __shfl_xor(l, 32);
    const float inv = 1.0f / l;
    f32x4 O[8];
#pragma unroll
    for (int dt = 0; dt < 8; ++dt) O[dt] = (f32x4){0.f, 0.f, 0.f, 0.f};
    const int q4 = ql >> 2, pp = ql & 3;
#pragma unroll
    for (int i = 0; i < 8; ++i) {
        __syncthreads();
        stage_chunk<false>(lds, NatRow{qkv + (size_t)(b * SEQ + (rs + i) * 64) * NQKV + 3584 + 2 * hp * 128}, nullptr, tid);
        __syncthreads();
        u32x4 pw; pw.x = pk2(S[i][0][0], S[i][0][1]); pw.y = pk2(S[i][0][2], S[i][0][3]); pw.z = pk2(S[i][1][0], S[i][1][1]); pw.w = pk2(S[i][1][2], S[i][1][3]);
        const bf16x8 pf = __builtin_bit_cast(bf16x8, pw); const int rb = hh * 64 + w0;
#pragma unroll
        for (int dt = 0; dt < 8; ++dt) { const s16x4 lo = tr_read(lds + off_b(rb + 4 * g + q4, 2 * dt + (pp >> 1)) + 8 * (pp & 1)), hi = tr_read(lds + off_b(rb + 16 + 4 * g + q4, 2 * dt + (pp >> 1)) + 8 * (pp & 1));
            bf16x8 vf; vf[0] = lo[0]; vf[1] = lo[1]; vf[2] = lo[2]; vf[3] = lo[3]; vf[4] = hi[0]; vf[5] = hi[1]; vf[6] = hi[2]; vf[7] = hi[3];
            O[dt] = __builtin_amdgcn_mfma_f32_16x16x32_bf16(vf, pf, O[dt], 0, 0, 0); }
    }
    bf16_t* op = o + (size_t)tq * D + 1024 + h * 128 + 4 * g;
#pragma unroll
    for (int dt = 0; dt < 8; ++dt) { u32x2 w2; w2.x = pk2(O[dt][0] * inv, O[dt][1] * inv); w2.y = pk2(O[dt][2] * inv, O[dt][3] * inv); *(u32x2*)(op + 16 * dt) = w2; }
}
__device__ __forceinline__ void p2_attn(const Params& p, LAS unsigned char* lds) {
    for (int it = blockIdx.x; it < 4096; it += gridDim.x) { if (it < 2048) attn_window_item(p, lds, it); else attn_nat_item(p, lds, it - 2048); }
}
__device__ __forceinline__ void p2_attn_w(const Params& p, LAS unsigned char* lds) { for (int it = blockIdx.x; it < 2048; it += gridDim.x) attn_window_item(p, lds, it); }
__device__ __forceinline__ void p2_attn_n(const Params& p, LAS unsigned char* lds) { for (int it = blockIdx.x; it < 2048; it += gridDim.x) attn_nat_item(p, lds, it); }

struct UpHook { const bf16_t* gates;
    __device__ __forceinline__ void operator()(f32x4 (&acc)[2][2][4][2], const Unit& u, int wr, int wc, int fr, int fq) const {
        unsigned goff = (unsigned)(u.pm * 256 + wr * 64 + fr) * NGATE + u.pn * 256 + wc * 32 + 8 * fq;
#pragma unroll
        for (int ai = 0; ai < 2; ++ai) {
#pragma unroll
            for (int m = 0; m < 4; ++m) { asm volatile("" : "+v"(goff));
#pragma unroll
                for (int bj = 0; bj < 2; ++bj) { const bf16x8 sa = *(const bf16x8*)(gates + goff + bj * 128), sb = *(const bf16x8*)(gates + goff + 2048 + bj * 128);
#pragma unroll
                    for (int n = 0; n < 2; ++n)
#pragma unroll
                        for (int j = 0; j < 4; ++j) acc[ai][bj][m][n][j] *= bf2f(sa[4 * n + j]) * __builtin_amdgcn_rcpf(fmaxf(bf2f(sb[4 * n + j]), 1e-30f)); }
                goff += 16 * NGATE; }
            goff += 64 * NGATE; }
    } };
__device__ __forceinline__ void p3_up(const Params& p, LAS unsigned char* lds) {
    const int tid = threadIdx.x, lane = tid & 63, wid = tid >> 6, wr = wid >> 2, wc = wid & 3, fr = lane & 15, fq = lane >> 4;
    const bf16_t* o = (const bf16_t*)(p.ws + WS_O); const bf16_t* WupT = (const bf16_t*)(p.ws + WS_WUP); const bf16_t* gates = (const bf16_t*)(p.ws + WS_GATES); bf16_t* merged = (bf16_t*)(p.ws + WS_XB);
    for (int ui = blockIdx.x; ui < 128 * 8; ui += gridDim.x) {
        Unit u; u.pn = ui / 128; u.pm = ui % 128; u.aux = 0;
        f32x4 acc[2][2][4][2];
        DenseRow ar{o + (size_t)u.pm * 256 * D, D}, br{WupT + (size_t)u.pn * 256 * D, D};
        sgemm_unit<true, true>(lds, ar, br, 0, 1024, acc, wr, wc, fr, fq, tid);
        UpHook{gates}(acc, u, wr, wc, fr, fq);
        sgemm_unit<true, false>(lds, ar, br, 1024, D, acc, wr, wc, fr, fq, tid);
        unsigned goff = (unsigned)(u.pm * 256 + wr * 64 + fr) * NGATE + u.pn * 256 + wc * 32 + 8 * fq;
        unsigned moff = (unsigned)(u.pm * 256 + wr * 64 + fr) * D + u.pn * 256 + wc * 32 + 8 * fq;
#pragma unroll
        for (int ai = 0; ai < 2; ++ai) {
#pragma unroll
            for (int m = 0; m < 4; ++m) { asm volatile("" : "+v"(goff), "+v"(moff));
#pragma unroll
                for (int bj = 0; bj < 2; ++bj) { const bf16x8 sb = *(const bf16x8*)(gates + goff + 2048 + bj * 128);
                    f32x4 v0 = acc[ai][bj][m][0], v1 = acc[ai][bj][m][1];
#pragma unroll
                    for (int j = 0; j < 4; ++j) { v0[j] *= fmaxf(bf2f(sb[j]), 1e-30f); v1[j] *= fmaxf(bf2f(sb[4 + j]), 1e-30f); }
                    u32x4 w; w.x = pk2(v0[0], v0[1]); w.y = pk2(v0[2], v0[3]); w.z = pk2(v1[0], v1[1]); w.w = pk2(v1[2], v1[3]);
                    *(u32x4*)(merged + moff + bj * 128) = w; }
                goff += 16 * NGATE; moff += 16 * D; }
            goff += 64 * NGATE; moff += 64 * D; }
    }
}

__device__ __forceinline__ void p4_out(const Params& p, LAS unsigned char* lds) {
    const int tid = threadIdx.x, lane = tid & 63, wid = tid >> 6, wr = wid >> 2, wc = wid & 3, fr = lane & 15, fq = lane >> 4;
    const bf16_t* merged = (const bf16_t*)(p.ws + WS_XB); const bf16_t* WoutT = (const bf16_t*)(p.ws + WS_WOUT); bf16_t* hb = (bf16_t*)(p.ws + WS_O); const float* x = p.in[0];
    for (int ui = blockIdx.x; ui < 128 * 8; ui += gridDim.x) {
        Unit u; u.pn = ui / 128; u.pm = ui % 128; u.aux = 0;
        f32x4 acc[2][2][4][2];
        DenseRow ar{merged + (size_t)u.pm * 256 * D, D}, br{WoutT + (size_t)u.pn * 256 * D, D};
        sgemm_unit<false, true>(lds, ar, br, 0, D, acc, wr, wc, fr, fq, tid);
#pragma unroll
        for (int ai = 0; ai < 2; ++ai)
#pragma unroll
            for (int m = 0; m < 4; ++m) { const int row = u.pm * 256 + ai * 128 + wr * 64 + m * 16 + fr;
#pragma unroll
                for (int bj = 0; bj < 2; ++bj)
#pragma unroll
                    for (int n = 0; n < 2; ++n) { const size_t off = (size_t)row * D + u.pn * 256 + bj * 128 + wc * 32 + 16 * n + 4 * fq;
                        const f32x4 hv = *(const f32x4*)(x + off) + acc[ai][bj][m][n]; *(f32x4*)(p.out + off) = hv;
                        u32x2 w2; w2.x = pk2(hv[0], hv[1]); w2.y = pk2(hv[2], hv[3]); *(u32x2*)(hb + off) = w2; } }
    }
}

__device__ __forceinline__ void p5_router(const Params& p) {
    const int tid = threadIdx.x, lane = tid & 63, wave = tid >> 6; const int gw = blockIdx.x * 8 + wave, NGW = gridDim.x * 8;
    const float* wrt = (const float*)(p.ws + WS_WRT); float* r2 = (float*)(p.ws + WS_R2); int* cnt = (int*)(p.ws + WS_CNT); int* tokl = (int*)(p.ws + WS_TOK); float* wl = (float*)(p.ws + WS_WL);
    const float* brg = p.in[15]; const float* bre = p.in[17];
    for (int tok = gw; tok < T; tok += NGW) {
        const f32x4* hr = (const f32x4*)(p.out + (size_t)tok * D) + lane; f32x4 v[8]; float ss = 0.f;
#pragma unroll
        for (int j = 0; j < 8; ++j) { v[j] = hr[64 * j]; ss += (v[j].x * v[j].x + v[j].y * v[j].y) + (v[j].z * v[j].z + v[j].w * v[j].w); }
        ss = wave_sum(ss); const float rr = rsqrtf(ss * (1.0f / D) + EPS);
        float mylg = 0.f;
#pragma unroll 2
        for (int jj = 0; jj < 36; ++jj) { const f32x4* wr_ = (const f32x4*)(wrt + jj * 2048) + lane; float a = 0.f;
#pragma unroll
            for (int j = 0; j < 8; ++j) { const f32x4 wv = wr_[64 * j]; a += (v[j].x * wv.x + v[j].y * wv.y) + (v[j].z * wv.z + v[j].w * wv.w); }
            a = wave_sum(a) * rr; if (lane == jj) mylg = a; }
        float gl[4];
#pragma unroll
        for (int i = 0; i < 4; ++i) gl[i] = __shfl(mylg, i) + brg[i];
        int gi = 0; float gm = gl[0];
#pragma unroll
        for (int i = 1; i < 4; ++i) if (gl[i] > gm) { gm = gl[i]; gi = i; }
        float den = 0.f;
#pragma unroll
        for (int i = 0; i < 4; ++i) den += __expf(gl[i] - gm);
        const float pg = 1.0f / den;
        float el[8];
#pragma unroll
        for (int i = 0; i < 8; ++i) el[i] = __shfl(mylg, 4 + gi * 8 + i) + bre[gi * 8 + i];
        int e0 = 0; float v0 = el[0];
#pragma unroll
        for (int i = 1; i < 8; ++i) if (el[i] > v0) { v0 = el[i]; e0 = i; }
        int e1 = -1; float v1 = -3.0e38f;
#pragma unroll
        for (int i = 0; i < 8; ++i) if (i != e0 && el[i] > v1) { v1 = el[i]; e1 = i; }
        const float ex = __expf(v1 - v0); const float s0 = 1.0f / (1.0f + ex), s1 = ex * s0;
        if (lane == 0) { r2[tok] = rr;
            const int L0 = gi * 8 + e0, L1 = 32 + gi * 8 + e1;
            const int p0 = atomicAdd(&cnt[L0], 1); tokl[(size_t)L0 * T + p0] = tok; wl[(size_t)L0 * T + p0] = pg * s0;
            const int p1 = atomicAdd(&cnt[L1], 1); tokl[(size_t)L1 * T + p1] = tok; wl[(size_t)L1 * T + p1] = pg * s1; }
    }
}

__device__ __forceinline__ void build_tiles(const Params& p, LAS int* tab) {
    __syncthreads();
    if (threadIdx.x == 0) { const int* cnt = (const int*)(p.ws + WS_CNT); int nt = 0, slot = 0, k1 = 0;
        for (int L = 0; L < 64; ++L) { if (L == 32) k1 = nt; const int c = cnt[L]; for (int r0 = 0; r0 < c; r0 += 256) { tab[4 + nt * 4 + 0] = L; tab[4 + nt * 4 + 1] = r0; tab[4 + nt * 4 + 2] = slot; tab[4 + nt * 4 + 3] = min(256, c - r0); slot += 256; ++nt; } }
        tab[0] = nt; tab[1] = k1; }
    __syncthreads();
}
struct GatherRow { const bf16_t* base; const int* list; int nrows; __device__ __forceinline__ unsigned operator()(int r) const { const int t = r < nrows ? list[r] : 0; return (unsigned)t * (unsigned)D; } };

__device__ __forceinline__ void p6_gateup(const Params& p, LAS unsigned char* lds) {
    const int tid = threadIdx.x, lane = tid & 63, wid = tid >> 6, wr = wid >> 2, wc = wid & 3, fr = lane & 15, fq = lane >> 4;
    LAS int* tab = (LAS int*)(lds + TAB_OFF); build_tiles(p, tab);
    const int nt = tab[0];
    const bf16_t* hb = (const bf16_t*)(p.ws + WS_O); const bf16_t* WguT = (const bf16_t*)(p.ws + WS_WGU); bf16_t* he = (bf16_t*)(p.ws + WS_HE);
    const int* tokl = (const int*)(p.ws + WS_TOK); const float* r2 = (const float*)(p.ws + WS_R2);
    for (int ui = blockIdx.x; ui < nt * 4; ui += gridDim.x) {
        const int ti = ui >> 2; Unit u; u.pn = ui & 3; u.pm = ti; u.aux = 0;
        const int L = tab[4 + ti * 4], row0 = tab[4 + ti * 4 + 1], slot = tab[4 + ti * 4 + 2], nrows = tab[4 + ti * 4 + 3], e = L & 31;
        f32x4 acc[2][2][4][2];
        GatherRow ar{hb, tokl + (size_t)L * T + row0, nrows}; DenseRow br{WguT + (size_t)(e * 1024 + u.pn * 256) * D, D};
        sgemm_unit<true, true>(lds, ar, br, 0, D, acc, wr, wc, fr, fq, tid);
#pragma unroll
        for (int ai = 0; ai < 2; ++ai)
#pragma unroll
            for (int m = 0; m < 4; ++m) { const int rr = ai * 128 + wr * 64 + m * 16 + fr; const int tk = rr < nrows ? tokl[(size_t)L * T + row0 + rr] : 0; const float rs = r2[tk];
                u32x4 w; unsigned ww[4];
#pragma unroll
                for (int n = 0; n < 2; ++n) { float hv[4];
#pragma unroll
                    for (int j = 0; j < 4; ++j) { const float gt = acc[ai][0][m][n][j] * rs, up = acc[ai][1][m][n][j] * rs; hv[j] = gt * sigmoidf_(gt) * up; }
                    ww[2 * n] = pk2(hv[0], hv[1]); ww[2 * n + 1] = pk2(hv[2], hv[3]); }
                w.x = ww[0]; w.y = ww[1]; w.z = ww[2]; w.w = ww[3];
                *(u32x4*)(he + (size_t)(slot + rr) * 512 + u.pn * 128 + wc * 32 + 8 * fq) = w; }
    }
}
__device__ __forceinline__ void p7_down(const Params& p, LAS unsigned char* lds, int k) {
    const int tid = threadIdx.x, lane = tid & 63, wid = tid >> 6, wr = wid >> 2, wc = wid & 3, fr = lane & 15, fq = lane >> 4;
    LAS int* tab = (LAS int*)(lds + TAB_OFF); build_tiles(p, tab);
    const int t_lo = k ? tab[1] : 0, t_hi = k ? tab[0] : tab[1];
    const bf16_t* he = (const bf16_t*)(p.ws + WS_HE); const bf16_t* WdT = (const bf16_t*)(p.ws + WS_WD);
    const int* tokl = (const int*)(p.ws + WS_TOK); const float* wl = (const float*)(p.ws + WS_WL);
    for (int ui = blockIdx.x; ui < (t_hi - t_lo) * 8; ui += gridDim.x) {
        const int ti = t_lo + (ui >> 3); Unit u; u.pn = ui & 7; u.pm = ti; u.aux = 0;
        const int L = tab[4 + ti * 4], row0 = tab[4 + ti * 4 + 1], slot = tab[4 + ti * 4 + 2], nrows = tab[4 + ti * 4 + 3], e = L & 31;
        f32x4 acc[2][2][4][2];
        DenseRow ar{he + (size_t)slot * 512, 512}, br{WdT + (size_t)(e * 2048 + u.pn * 256) * 512, 512};
        sgemm_unit<false, true>(lds, ar, br, 0, 512, acc, wr, wc, fr, fq, tid);
#pragma unroll
        for (int ai = 0; ai < 2; ++ai)
#pragma unroll
            for (int m = 0; m < 4; ++m) { const int rr = ai * 128 + wr * 64 + m * 16 + fr;
                if (rr < nrows) { const int tk = tokl[(size_t)L * T + row0 + rr]; const float wg = wl[(size_t)L * T + row0 + rr];
#pragma unroll
                    for (int bj = 0; bj < 2; ++bj)
#pragma unroll
                        for (int n = 0; n < 2; ++n) { float* op = p.out + (size_t)tk * D + u.pn * 256 + bj * 128 + wc * 32 + 16 * n + 4 * fq; *(f32x4*)op = *(const f32x4*)op + acc[ai][bj][m][n] * wg; } } }
    }
}

#define KERNEL(name, body) __global__ void __launch_bounds__(512, 2) name(Params p) { extern __shared__ __attribute__((aligned(16))) unsigned char lds_raw[]; LAS unsigned char* lds = (LAS unsigned char*)lds_raw; body; }
KERNEL(k_prep, p0_prep(p, lds))
KERNEL(k_inproj, p1_inproj(p, lds))
KERNEL(k_attn, p2_attn(p, lds))
KERNEL(k_attn_w, p2_attn_w(p, lds))
KERNEL(k_attn_n, p2_attn_n(p, lds))
KERNEL(k_moeprep, p_moe_prep(p, lds))
KERNEL(k_up, p3_up(p, lds))
KERNEL(k_out, p4_out(p, lds))
KERNEL(k_router, p5_router(p))
KERNEL(k_gateup, p6_gateup(p, lds))
KERNEL(k_down0, p7_down(p, lds, 0))
KERNEL(k_down1, p7_down(p, lds, 1))

__global__ void __launch_bounds__(512) k_dump(Params p, size_t ws_off, int ld, int coff, int clo = 0, int chi = 2048) {
    const bf16_t* src = (const bf16_t*)(p.ws + ws_off);
    for (size_t i = (size_t)blockIdx.x * 512 + threadIdx.x; i < (size_t)T * D; i += (size_t)gridDim.x * 512) { const size_t t = i >> 11, c = i & 2047; p.out[i] = ((int)c >= clo && (int)c < chi) ? bf2f((short)src[t * ld + coff + c]) : 0.f; }
}
extern "C" void kernel_launch(void* const* d_in, const int* in_sizes, int n_in, void* d_out, int out_size, void* d_ws, size_t ws_size, hipStream_t stream) {
    static int inited = 0;
    if (!inited) {
        if (n_in != 21 || out_size != T * D || ws_size < WS_END) { fprintf(stderr, "kernel_launch: unexpected problem (n_in %d out %d ws %zu)\n", n_in, out_size, ws_size); inited = -1; return; }
        const void* ks[] = {(const void*)k_prep, (const void*)k_inproj, (const void*)k_attn, (const void*)k_attn_w, (const void*)k_attn_n, (const void*)k_moeprep, (const void*)k_up, (const void*)k_out, (const void*)k_router, (const void*)k_gateup, (const void*)k_down0, (const void*)k_down1};
        for (const void* k : ks) if (hipFuncSetAttribute(k, hipFuncAttributeMaxDynamicSharedMemorySize, LDS_BYTES) != hipSuccess) { fprintf(stderr, "kernel_launch: hipFuncSetAttribute failed\n"); inited = -1; return; }
        inited = 1;
    }
    if (inited < 0) return;
    Params p{};
    for (int i = 0; i < 21; ++i) p.in[i] = (const float*)d_in[i];
    p.out = (float*)d_out; p.ws = (unsigned char*)d_ws;
    const dim3 grid(256), blk(512);
    hipLaunchKernelGGL(k_prep, grid, blk, LDS_BYTES, stream, p);
    hipLaunchKernelGGL(k_inproj, grid, blk, LDS_BYTES, stream, p);
#if STOP4 == 1
    hipLaunchKernelGGL(k_dump, dim3(2048), blk, 0, stream, p, (size_t)WS_QKV, (int)NQKV, 2560, 0, 2048); return;
#endif
    hipLaunchKernelGGL(k_attn, grid, blk, LDS_BYTES, stream, p);
#if STOP4 == 2
    hipLaunchKernelGGL(k_dump, dim3(2048), blk, 0, stream, p, (size_t)WS_O, (int)D, 0, 1024, 2048); return;
#endif
    hipLaunchKernelGGL(k_moeprep, grid, blk, LDS_BYTES, stream, p);
    hipLaunchKernelGGL(k_up, grid, blk, LDS_BYTES, stream, p);
    hipLaunchKernelGGL(k_out, grid, blk, LDS_BYTES, stream, p);
#ifndef STOP4
    hipLaunchKernelGGL(k_router, grid, blk, LDS_BYTES, stream, p);
    hipLaunchKernelGGL(k_gateup, grid, blk, LDS_BYTES, stream, p);
    hipLaunchKernelGGL(k_down0, grid, blk, LDS_BYTES, stream, p);
    hipLaunchKernelGGL(k_down1, grid, blk, LDS_BYTES, stream, p);
#endif
}
```

```cpp
#include <hip/hip_runtime.h>
#include <hip/hip_cooperative_groups.h>
#include <cstdio>
#include <cstdint>

#define LAS __attribute__((address_space(3)))
typedef unsigned short bf16_t;
typedef short bf16x8 __attribute__((ext_vector_type(8)));
typedef short s16x4 __attribute__((ext_vector_type(4)));
typedef float f32x4 __attribute__((ext_vector_type(4)));
typedef unsigned u32x4 __attribute__((ext_vector_type(4)));
typedef unsigned u32x2 __attribute__((ext_vector_type(2)));
typedef short v4i16_t __attribute__((ext_vector_type(4)));

namespace cfg {
constexpr int T = 32768, D = 2048, SEQ = 16384;
constexpr int NQKV = 4608, NGATE = 4096, NIN = 8704;
constexpr size_t MiB = 1ull << 20;
constexpr size_t WS_XB = 0, WS_QKV = 128 * MiB, WS_GATES = 416 * MiB, WS_O = 672 * MiB, WS_WIN = 800 * MiB, WS_WUP = 834 * MiB, WS_WOUT = 842 * MiB, WS_MISC = 850 * MiB;
constexpr size_t WS_WGU = WS_QKV, WS_WD = WS_QKV + 128 * MiB, WS_HE = WS_QKV + 192 * MiB;
constexpr size_t WS_R1 = WS_MISC, WS_R2 = WS_R1 + (size_t)T * 4, WS_WRT = WS_R2 + (size_t)T * 4, WS_CNT = WS_WRT + 512 * 1024, WS_TOK = WS_CNT + 4096,
                 WS_WL = WS_TOK + 64ull * T * 4, WS_END = WS_WL + 64ull * T * 4;
constexpr int LDS_BYTES = 140 * 1024;
constexpr int TAB_OFF = 132 * 1024;
constexpr float EPS = 1e-6f;
}
using namespace cfg;

struct Params { const float* in[21]; float* out; unsigned char* ws; };

__device__ __forceinline__ float bf2f(short s) { return __uint_as_float(((unsigned)(unsigned short)s) << 16); }
typedef float f32x2 __attribute__((ext_vector_type(2)));
typedef __bf16 bf16x2_t __attribute__((ext_vector_type(2)));
__device__ __forceinline__ unsigned pk2(float lo, float hi) { const f32x2 v = {lo, hi}; return __builtin_bit_cast(unsigned, __builtin_convertvector(v, bf16x2_t)); }
__device__ __forceinline__ float wave_sum(float v) {
#pragma unroll
    for (int o = 1; o < 64; o <<= 1) v += __shfl_xor(v, o);
    return v;
}
__device__ __forceinline__ float sigmoidf_(float v) { return 1.0f / (1.0f + __expf(-v)); }
__device__ __forceinline__ unsigned off_b(unsigned row, unsigned ch) { return 256u * row + 16u * (ch ^ (((row & 3) << 2) | ((row >> 2) & 3))); }
__device__ __forceinline__ s16x4 tr_read(LAS unsigned char* p) { return __builtin_bit_cast(s16x4, __builtin_amdgcn_ds_read_tr16_b64_v4i16((LAS v4i16_t*)p)); }
__host__ __device__ __forceinline__ int perm32(int rho) { const int n = rho >> 4, i = rho & 15; return 8 * (i >> 2) + 4 * n + (i & 3); }
__device__ __forceinline__ int t5_bucket(int rel) {
    const int n = rel < 0 ? -rel : rel; const int ret = rel > 0 ? 16 : 0; int b;
    if (n < 8) b = n; else if (n < 12) b = 8; else if (n < 16) b = 9; else if (n < 23) b = 10; else if (n < 32) b = 11; else if (n < 46) b = 12; else if (n < 64) b = 13; else if (n < 91) b = 14; else b = 15;
    return ret + b;
}

__device__ __forceinline__ void transpose_item(const float* __restrict__ W, int ldw, int k0, int n0, bf16_t* __restrict__ WT, int ldt, int drow0, int dk0, const float* __restrict__ scale, LAS float* scr, int lane) {
#pragma unroll 8
    for (int i = 0; i < 32; ++i) { const int kk = 2 * i + (lane >> 5); float v = W[(size_t)(k0 + kk) * ldw + n0 + (lane & 31)]; if (scale) v *= scale[k0 + kk]; scr[kk * 33 + (lane & 31)] = v; }
    asm volatile("s_waitcnt lgkmcnt(0)" ::: "memory");
    const int c = lane & 7;
#pragma unroll
    for (int j = 0; j < 4; ++j) { const int n = (lane >> 3) + 8 * j; const LAS float* s = scr + (8 * c) * 33 + n;
        u32x4 o; o.x = pk2(s[0 * 33], s[1 * 33]); o.y = pk2(s[2 * 33], s[3 * 33]); o.z = pk2(s[4 * 33], s[5 * 33]); o.w = pk2(s[6 * 33], s[7 * 33]);
        *(u32x4*)(WT + (size_t)(drow0 + n) * ldt + dk0 + k0 + 8 * c) = o; }
    asm volatile("s_waitcnt lgkmcnt(0)" ::: "memory");
}

__device__ __forceinline__ void p0_prep(const Params& p, LAS unsigned char* lds) {
    const int tid = threadIdx.x, lane = tid & 63, wave = tid >> 6;
    const int gw = blockIdx.x * 8 + wave, NGW = gridDim.x * 8;
    LAS float* scr = (LAS float*)(lds + wave * 8448);
    const float* x = p.in[0]; const float* g1 = p.in[1]; const float* w_in = p.in[2];
    bf16_t* xb = (bf16_t*)(p.ws + WS_XB); float* r1 = (float*)(p.ws + WS_R1);
    bf16_t* WinT = (bf16_t*)(p.ws + WS_WIN); bf16_t* WupT = (bf16_t*)(p.ws + WS_WUP); bf16_t* WoutT = (bf16_t*)(p.ws + WS_WOUT);
    constexpr int I_WIN = 32 * 272, I_UP = 16 * 64, I_OUT = 32 * 64, NITEMS = I_WIN + 2 * I_UP + I_OUT;
    for (int it = gw; it < NITEMS; it += NGW) {
        int r = it;
        if (r < I_WIN) { const int kb = r / 272, nb = r % 272; transpose_item(w_in, NIN, kb * 64, nb * 32, WinT, 2048, nb * 32, 0, g1, scr, lane); continue; } r -= I_WIN;
        if (r < I_UP) { const int kb = r / 64, nb = r % 64; transpose_item(p.in[9], 2048, kb * 64, nb * 32, WupT, 2048, nb * 32, 0, nullptr, scr, lane); continue; } r -= I_UP;
        if (r < I_UP) { const int kb = r / 64, nb = r % 64; transpose_item(p.in[10], 2048, kb * 64, nb * 32, WupT, 2048, nb * 32, 1024, nullptr, scr, lane); continue; } r -= I_UP;
        { const int kb = r / 64, nb = r % 64; transpose_item(p.in[11], 2048, kb * 64, nb * 32, WoutT, 2048, nb * 32, 0, nullptr, scr, lane); }
    }
    { float* wrt = (float*)(p.ws + WS_WRT); const float* g2 = p.in[13]; const float* wrg = p.in[14]; const float* wre = p.in[16];
      for (int i = blockIdx.x * 512 + tid; i < 36 * 2048; i += gridDim.x * 512) { const int j = i >> 11, k = i & 2047; wrt[i] = g2[k] * (j < 4 ? wrg[k * 4 + j] : wre[k * 32 + (j - 4)]); } }
    if (blockIdx.x == 0 && tid < 64) ((int*)(p.ws + WS_CNT))[tid] = 0;
    for (int row = gw; row < T; row += NGW) {
        const f32x4* xr = (const f32x4*)(x + (size_t)row * D) + lane; f32x4 v[8]; float ss = 0.f;
#pragma unroll
        for (int j = 0; j < 8; ++j) { v[j] = xr[64 * j]; ss += (v[j].x * v[j].x + v[j].y * v[j].y) + (v[j].z * v[j].z + v[j].w * v[j].w); }
        ss = wave_sum(ss);
        if (lane == 0) r1[row] = rsqrtf(ss * (1.0f / D) + EPS);
        u32x2* o = (u32x2*)(xb + (size_t)row * D) + lane;
#pragma unroll
        for (int j = 0; j < 8; ++j) { u32x2 w; w.x = pk2(v[j].x, v[j].y); w.y = pk2(v[j].z, v[j].w); o[64 * j] = w; }
    }
}

__device__ __forceinline__ void p_moe_prep(const Params& p, LAS unsigned char* lds) {
    const int tid = threadIdx.x, lane = tid & 63, wave = tid >> 6;
    const int gw = blockIdx.x * 8 + wave, NGW = gridDim.x * 8;
    LAS float* scr = (LAS float*)(lds + wave * 8448);
    const float* g2 = p.in[13];
    bf16_t* WguT = (bf16_t*)(p.ws + WS_WGU); bf16_t* WdT = (bf16_t*)(p.ws + WS_WD);
    constexpr int I_G = 32 * 32 * 16;
    constexpr int I_D = 32 * 8 * 64;
    for (int it = gw; it < 2 * I_G + I_D; it += NGW) {
        int r = it;
        if (r < 2 * I_G) { const int which = r >= I_G; if (which) r -= I_G; const int e = r / 512, rr = r % 512, kb = rr / 16, nb = rr % 16;
            const float* W = p.in[which ? 19 : 18] + (size_t)e * 2048 * 512; const int n0 = nb * 32;
            transpose_item(W, 512, kb * 64, n0, WguT, 2048, e * 1024 + (n0 >> 7) * 256 + which * 128 + (n0 & 127), 0, g2, scr, lane); continue; }
        r -= 2 * I_G;
        { const int e = r / 512, rr = r % 512, kb = rr / 64, nb = rr % 64; const float* W = p.in[20] + (size_t)e * 512 * 2048;
          transpose_item(W, 2048, kb * 64, nb * 32, WdT, 512, e * 2048 + nb * 32, 0, nullptr, scr, lane); }
    }
}

struct Unit { int pm, pn, aux; };
template <bool PERM, bool ZERO, class ARow, class BRow>
__device__ __forceinline__ void sgemm_unit(LAS unsigned char* lds, const ARow& arow, const BRow& brow, int kbeg, int kend, f32x4 (&acc)[2][2][4][2], int wr, int wc, int fr, int fq, int tid) {
    if (ZERO) {
#pragma unroll
    for (int a = 0; a < 2; ++a)
#pragma unroll
        for (int b = 0; b < 2; ++b)
#pragma unroll
            for (int m = 0; m < 4; ++m)
#pragma unroll
                for (int n = 0; n < 2; ++n) acc[a][b][m][n] = (f32x4){0.f, 0.f, 0.f, 0.f};
    }
    unsigned ao[4], bo[4]; const bf16_t* const abase = arow.base; const bf16_t* const bbase = brow.base;
#pragma unroll
    for (int i = 0; i < 4; ++i) { const int pz = tid + 512 * i, row = pz >> 3, c8 = pz & 7; ao[i] = arow(row) + c8 * 8; const int Rb = PERM ? ((row & ~31) + perm32(row & 31)) : row; bo[i] = brow(Rb) + c8 * 8; }
    for (int k0 = kbeg; k0 < kend; k0 += 64) {
        bf16x8 ra[4], rb[4];
#pragma unroll
        for (int i = 0; i < 4; ++i) { ra[i] = *(const bf16x8*)(abase + ao[i] + k0); rb[i] = *(const bf16x8*)(bbase + bo[i] + k0); }
        __syncthreads();
#pragma unroll
        for (int i = 0; i < 4; ++i) { const int pz = tid + 512 * i, row = pz >> 3, c8 = pz & 7; *(LAS bf16x8*)(lds + row * 144 + c8 * 16) = ra[i]; *(LAS bf16x8*)(lds + 36864 + row * 144 + c8 * 16) = rb[i]; }
        __syncthreads();
#pragma unroll
        for (int ai = 0; ai < 2; ++ai) {
            bf16x8 At[4][2];
#pragma unroll
            for (int m = 0; m < 4; ++m)
#pragma unroll
                for (int k = 0; k < 2; ++k) At[m][k] = *(const LAS bf16x8*)(lds + (ai * 128 + wr * 64 + m * 16 + fr) * 144 + (k * 32 + fq * 8) * 2);
#pragma unroll
            for (int bj = 0; bj < 2; ++bj) {
                bf16x8 Bf[2][2];
#pragma unroll
                for (int n = 0; n < 2; ++n)
#pragma unroll
                    for (int k = 0; k < 2; ++k) Bf[n][k] = *(const LAS bf16x8*)(lds + 36864 + (bj * 128 + wc * 32 + n * 16 + fr) * 144 + (k * 32 + fq * 8) * 2);
#pragma unroll
                for (int m = 0; m < 4; ++m)
#pragma unroll
                    for (int n = 0; n < 2; ++n)
#pragma unroll
                        for (int k = 0; k < 2; ++k) acc[ai][bj][m][n] = __builtin_amdgcn_mfma_f32_16x16x32_bf16(Bf[n][k], At[m][k], acc[ai][bj][m][n], 0, 0, 0);
            }
        }
    }
}
struct DenseRow { const bf16_t* base; int ld; __device__ __forceinline__ unsigned operator()(int r) const { return (unsigned)(r * ld); } };

__device__ __forceinline__ void p1_inproj(const Params& p, LAS unsigned char* lds) {
    const int tid = threadIdx.x, lane = tid & 63, wid = tid >> 6, wr = wid >> 2, wc = wid & 3, fr = lane & 15, fq = lane >> 4;
    const bf16_t* xb = (const bf16_t*)(p.ws + WS_XB); const bf16_t* WinT = (const bf16_t*)(p.ws + WS_WIN);
    bf16_t* qkv = (bf16_t*)(p.ws + WS_QKV); bf16_t* gates = (bf16_t*)(p.ws + WS_GATES); const float* r1 = (const float*)(p.ws + WS_R1);
    constexpr int NU = 128 * 34;
    for (int ui = blockIdx.x; ui < NU; ui += gridDim.x) {
        Unit u; u.pn = ui / 128; u.pm = ui % 128; u.aux = 0;
        f32x4 acc[2][2][4][2];
        DenseRow ar{xb + (size_t)u.pm * 256 * D, D}, br{WinT + (size_t)u.pn * 256 * D, D};
        sgemm_unit<true, true>(lds, ar, br, 0, D, acc, wr, wc, fr, fq, tid);
        const bool isg = u.pn >= 18; bf16_t* base = isg ? gates : qkv; const int ldc = isg ? NGATE : NQKV; const int colt = (isg ? u.pn - 18 : u.pn) * 256 + wc * 32 + 8 * fq;
#pragma unroll
        for (int ai = 0; ai < 2; ++ai)
#pragma unroll
            for (int m = 0; m < 4; ++m) { const int row = u.pm * 256 + ai * 128 + wr * 64 + m * 16 + fr; const float rs = r1[row]; bf16_t* rowp = base + (size_t)row * ldc + colt;
#pragma unroll
                for (int bj = 0; bj < 2; ++bj) { f32x4 v0 = acc[ai][bj][m][0] * rs, v1 = acc[ai][bj][m][1] * rs;
                    if (isg) {
#pragma unroll
                        for (int j = 0; j < 4; ++j) { v0[j] = sigmoidf_(v0[j]); v1[j] = sigmoidf_(v1[j]); } }
                    u32x4 w; w.x = pk2(v0[0], v0[1]); w.y = pk2(v0[2], v0[3]); w.z = pk2(v1[0], v1[1]); w.w = pk2(v1[2], v1[3]);
                    *(u32x4*)(rowp + bj * 128) = w; } }
    }
}

template <bool NORM, class SrcRow>
__device__ __forceinline__ void stage_chunk(LAS unsigned char* lds, const SrcRow& src, const float* __restrict__ gain, int tid) {
#pragma unroll
    for (int i = 0; i < 4; ++i) { const int pz = tid + 512 * i, row = pz >> 4, ch = pz & 15;
        bf16x8 v = *(const bf16x8*)(src(row) + ch * 8);
        if (NORM) { float f[8]; float ss = 0.f;
#pragma unroll
            for (int j = 0; j < 8; ++j) { f[j] = bf2f(v[j]); ss += f[j] * f[j]; }
            ss += __shfl_xor(ss, 1); ss += __shfl_xor(ss, 2); ss += __shfl_xor(ss, 4); ss += __shfl_xor(ss, 8);
            const float rk = rsqrtf(ss * (1.0f / 128.0f) + EPS); const f32x4 g0 = *(const f32x4*)(gain + ch * 8), g1 = *(const f32x4*)(gain + ch * 8 + 4);
            u32x4 w; w.x = pk2(f[0] * rk * g0.x, f[1] * rk * g0.y); w.y = pk2(f[2] * rk * g0.z, f[3] * rk * g0.w); w.z = pk2(f[4] * rk * g1.x, f[5] * rk * g1.y); w.w = pk2(f[6] * rk * g1.z, f[7] * rk * g1.w);
            v = __builtin_bit_cast(bf16x8, w); }
        *(LAS bf16x8*)(lds + off_b(row, ch)) = v; }
}
__device__ __forceinline__ void load_q(const bf16_t* qp, const float* __restrict__ gain, int g, bf16x8 (&qf)[4]) {
    float f[4][8]; float ss = 0.f;
#pragma unroll
    for (int ks = 0; ks < 4; ++ks) { const bf16x8 v = *(const bf16x8*)(qp + 32 * ks + 8 * g);
#pragma unroll
        for (int j = 0; j < 8; ++j) { f[ks][j] = bf2f(v[j]); ss += f[ks][j] * f[ks][j]; } }
    ss += __shfl_xor(ss, 16); ss += __shfl_xor(ss, 32);
    const float rq = rsqrtf(ss * (1.0f / 128.0f) + EPS) * 0.08838834764831845f;
#pragma unroll
    for (int ks = 0; ks < 4; ++ks) { const f32x4 g0 = *(const f32x4*)(gain + 32 * ks + 8 * g), g1 = *(const f32x4*)(gain + 32 * ks + 8 * g + 4);
        u32x4 w; w.x = pk2(f[ks][0] * rq * g0.x, f[ks][1] * rq * g0.y); w.y = pk2(f[ks][2] * rq * g0.z, f[ks][3] * rq * g0.w); w.z = pk2(f[ks][4] * rq * g1.x, f[ks][5] * rq * g1.y); w.w = pk2(f[ks][6] * rq * g1.z, f[ks][7] * rq * g1.w);
        qf[ks] = __builtin_bit_cast(bf16x8, w); }
}
struct TokRow { const bf16_t* base; __device__ __forceinline__ const bf16_t* operator()(int r) const { return base + (size_t)r * NQKV; } };
struct NatRow { const bf16_t* base;   __device__ __forceinline__ const bf16_t* operator()(int r) const { return base + (size_t)(r & 63) * NQKV + (r >> 6) * 128; } };

__device__ __forceinline__ void attn_window_item(const Params& p, LAS unsigned char* lds, int item) {
    const int tid = threadIdx.x, lane = tid & 63, w = __builtin_amdgcn_readfirstlane(tid >> 6), g = lane >> 4, ql = lane & 15;
    const int b = item >> 10, nb = (item >> 3) & 127, hq = item & 7, kv = hq >> 2;
    const bf16_t* qkv = (const bf16_t*)(p.ws + WS_QKV); bf16_t* o = (bf16_t*)(p.ws + WS_O);
    LAS float* bias = (LAS float*)(lds + 32768);
    __syncthreads();
    if (tid < 257) bias[tid] = p.in[12][t5_bucket(tid - 128) * 8 + hq];
    const int tq = b * SEQ + nb * 128 + 16 * w + ql;
    bf16x8 qf[4]; load_q(qkv + (size_t)tq * NQKV + hq * 128, p.in[3], g, qf);
    f32x4 S1[8], SC[9];
#pragma unroll
    for (int kt = 0; kt < 8; ++kt) S1[kt] = (f32x4){0.f, 0.f, 0.f, 0.f};
#pragma unroll
    for (int s = 0; s < 9; ++s) SC[s] = (f32x4){0.f, 0.f, 0.f, 0.f};
    const bool in0 = nb > 0, in2 = nb < 127;
#pragma unroll
    for (int c = 0; c < 3; ++c) { const int kb = nb - 1 + c; if (kb < 0 || kb > 127) continue;
        __syncthreads();
        stage_chunk<true>(lds, TokRow{qkv + (size_t)(b * SEQ + kb * 128) * NQKV + 1024 + kv * 128}, p.in[4], tid);
        __syncthreads();
#pragma unroll
        for (int kt = 0; kt < 8; ++kt) {
            if (c == 1) {
#pragma unroll
                for (int ks = 0; ks < 4; ++ks) { const bf16x8 kf = *(const LAS bf16x8*)(lds + off_b(16 * kt + ql, 4 * ks + g)); S1[kt] = __builtin_amdgcn_mfma_f32_16x16x32_bf16(kf, qf[ks], S1[kt], 0, 0, 0); }
            } else if (c == 0) { if (kt >= w) {
#pragma unroll
                for (int ks = 0; ks < 4; ++ks) { const bf16x8 kf = *(const LAS bf16x8*)(lds + off_b(16 * kt + ql, 4 * ks + g)); SC[7 - kt] = __builtin_amdgcn_mfma_f32_16x16x32_bf16(kf, qf[ks], SC[7 - kt], 0, 0, 0); } }
            } else { if (kt <= w) {
#pragma unroll
                for (int ks = 0; ks < 4; ++ks) { const bf16x8 kf = *(const LAS bf16x8*)(lds + off_b(16 * kt + ql, 4 * ks + g)); SC[8 - kt] = __builtin_amdgcn_mfma_f32_16x16x32_bf16(kf, qf[ks], SC[8 - kt], 0, 0, 0); } }
            }
        }
    }
    const float sink = p.in[5][hq]; float mx = sink; const int qi = 16 * w + ql;
#pragma unroll
    for (int kt = 0; kt < 8; ++kt)
#pragma unroll
        for (int r = 0; r < 4; ++r) { const int rel = 16 * kt + 4 * g + r - qi; const float sv = S1[kt][r] + bias[rel + 128]; S1[kt][r] = sv; mx = fmaxf(mx, sv); }
#pragma unroll
    for (int s = 0; s < 9; ++s) { const bool c0 = s <= 7 - w; const int kt = c0 ? 7 - s : 8 - s; const int cofs = c0 ? -128 : 128; const bool inr = c0 ? in0 : in2;
#pragma unroll
        for (int r = 0; r < 4; ++r) { const int rel = cofs + 16 * kt + 4 * g + r - qi; const bool valid = inr && rel >= -128 && rel <= 128;
            const float sv = valid ? SC[s][r] + bias[valid ? rel + 128 : 0] : -1e30f; SC[s][r] = sv; mx = fmaxf(mx, sv); } }
    mx = fmaxf(mx, __shfl_xor(mx, 16)); mx = fmaxf(mx, __shfl_xor(mx, 32));
    float l = 0.f;
#pragma unroll
    for (int kt = 0; kt < 8; ++kt)
#pragma unroll
        for (int r = 0; r < 4; ++r) { const float pe = __expf(S1[kt][r] - mx); S1[kt][r] = pe; l += pe; }
#pragma unroll
    for (int s = 0; s < 9; ++s)
#pragma unroll
        for (int r = 0; r < 4; ++r) { const float pe = __expf(SC[s][r] - mx); SC[s][r] = pe; l += pe; }
    l += __shfl_xor(l, 16); l += __shfl_xor(l, 32); l += __expf(sink - mx);
    const float inv = 1.0f / l;
    f32x4 O[8];
#pragma unroll
    for (int dt = 0; dt < 8; ++dt) O[dt] = (f32x4){0.f, 0.f, 0.f, 0.f};
    const int q4 = ql >> 2, pp = ql & 3;
    const f32x4 zero4 = (f32x4){0.f, 0.f, 0.f, 0.f};
#pragma unroll
    for (int c = 0; c < 3; ++c) { const int kb = nb - 1 + c; if (kb < 0 || kb > 127) continue;
        __syncthreads();
        stage_chunk<false>(lds, TokRow{qkv + (size_t)(b * SEQ + kb * 128) * NQKV + 1280 + kv * 128}, nullptr, tid);
        __syncthreads();
#pragma unroll
        for (int kk = 0; kk < 4; ++kk) {
            bool a0, a1; f32x4 p0, p1;
            if (c == 1) { a0 = true; a1 = true; p0 = S1[2 * kk]; p1 = S1[2 * kk + 1]; }
            else if (c == 0) { a0 = 2 * kk >= w; a1 = 2 * kk + 1 >= w; p0 = a0 ? SC[7 - 2 * kk] : zero4; p1 = a1 ? SC[6 - 2 * kk] : zero4; }
            else { a0 = 2 * kk <= w; a1 = 2 * kk + 1 <= w; p0 = a0 ? SC[8 - 2 * kk] : zero4; p1 = a1 ? SC[7 - 2 * kk] : zero4; }
            if (a0 || a1) { u32x4 pw; pw.x = pk2(p0[0], p0[1]); pw.y = pk2(p0[2], p0[3]); pw.z = pk2(p1[0], p1[1]); pw.w = pk2(p1[2], p1[3]);
                const bf16x8 pf = __builtin_bit_cast(bf16x8, pw);
#pragma unroll
                for (int dt = 0; dt < 8; ++dt) { const s16x4 lo = tr_read(lds + off_b(32 * kk + 4 * g + q4, 2 * dt + (pp >> 1)) + 8 * (pp & 1)), hi = tr_read(lds + off_b(32 * kk + 16 + 4 * g + q4, 2 * dt + (pp >> 1)) + 8 * (pp & 1));
                    bf16x8 vf; vf[0] = lo[0]; vf[1] = lo[1]; vf[2] = lo[2]; vf[3] = lo[3]; vf[4] = hi[0]; vf[5] = hi[1]; vf[6] = hi[2]; vf[7] = hi[3];
                    O[dt] = __builtin_amdgcn_mfma_f32_16x16x32_bf16(vf, pf, O[dt], 0, 0, 0); } } }
    }
    bf16_t* op = o + (size_t)tq * D + hq * 128 + 4 * g;
#pragma unroll
    for (int dt = 0; dt < 8; ++dt) { u32x2 w2; w2.x = pk2(O[dt][0] * inv, O[dt][1] * inv); w2.y = pk2(O[dt][2] * inv, O[dt][3] * inv); *(u32x2*)(op + 16 * dt) = w2; }
}

__device__ __forceinline__ void attn_nat_item(const Params& p, LAS unsigned char* lds, int item) {
    const int tid = threadIdx.x, lane = tid & 63, w = tid >> 6, g = lane >> 4, ql = lane & 15;
    const int b = item >> 10, r = (item >> 2) & 255, hp = item & 3, hh = w >> 2, h = 2 * hp + hh, jq = w & 3;
    const int rs = min(max(r - 4, 0), 248); const int w0 = jq == 0 ? 0 : (jq == 1 ? 8 : (jq == 2 ? 24 : 32));
    const bf16_t* qkv = (const bf16_t*)(p.ws + WS_QKV); bf16_t* o = (bf16_t*)(p.ws + WS_O);
    LAS float* rpb = (LAS float*)(lds + 32768);
    __syncthreads();
    for (int i = tid; i < 930; i += 512) rpb[i] = p.in[8][(2 * hp) * 465 + i];
    const int qcol = 16 * jq + ql; const int tq = b * SEQ + r * 64 + qcol;
    bf16x8 qf[4]; load_q(qkv + (size_t)tq * NQKV + 1536 + h * 128, p.in[6], g, qf);
    f32x4 S[8][2];
#pragma unroll
    for (int i = 0; i < 8; ++i) { S[i][0] = (f32x4){0.f, 0.f, 0.f, 0.f}; S[i][1] = (f32x4){0.f, 0.f, 0.f, 0.f}; }
#pragma unroll
    for (int i = 0; i < 8; ++i) {
        __syncthreads();
        stage_chunk<true>(lds, NatRow{qkv + (size_t)(b * SEQ + (rs + i) * 64) * NQKV + 2560 + 2 * hp * 128}, p.in[7], tid);
        __syncthreads();
#pragma unroll
        for (int t = 0; t < 2; ++t)
#pragma unroll
            for (int ks = 0; ks < 4; ++ks) { const bf16x8 kf = *(const LAS bf16x8*)(lds + off_b(hh * 64 + w0 + 16 * t + ql, 4 * ks + g)); S[i][t] = __builtin_amdgcn_mfma_f32_16x16x32_bf16(kf, qf[ks], S[i][t], 0, 0, 0); }
    }
    const int cs = min(max(qcol - 8, 0), 48); float mx = -1e30f;
#pragma unroll
    for (int i = 0; i < 8; ++i) { const int dr = rs + i - r + 7;
#pragma unroll
        for (int t = 0; t < 2; ++t)
#pragma unroll
            for (int rr = 0; rr < 4; ++rr) { const int kc = w0 + 16 * t + 4 * g + rr; const bool valid = kc >= cs && kc < cs + 16; const int dc = kc - qcol + 15;
                const float s = valid ? S[i][t][rr] + rpb[hh * 465 + dr * 31 + (valid ? dc : 0)] : -1e30f; S[i][t][rr] = s; mx = fmaxf(mx, s); } }
    mx = fmaxf(mx, __shfl_xor(mx, 16)); mx = fmaxf(mx, __shfl_xor(mx, 32));
    float l = 0.f;
#pragma unroll
    for (int i = 0; i < 8; ++i)
#pragma unroll
        for (int t = 0; t < 2; ++t)
#pragma unroll
            for (int rr = 0; rr < 4; ++rr) { const float pe = __expf(S[i][t][rr] - mx); S[i][t][rr] = pe; l += pe; }
    l += __shfl_xor(l, 16); l += __shfl_xor(l, 32);
    const float inv = 1.0f / l;
    f32x4 O[8];
#pragma unroll
    for (int dt = 0; dt < 8; ++dt) O[dt] = (f32x4){0.f, 0.f, 0.f, 0.f};
    const int q4 = ql >> 2, pp = ql & 3;
#pragma unroll
    for (int i = 0; i < 8; ++i) {
        __syncthreads();
        stage_chunk<false>(lds, NatRow{qkv + (size_t)(b * SEQ + (rs + i) * 64) * NQKV + 3584 + 2 * hp * 128}, nullptr, tid);
        __syncthreads();
        u32x4 pw; pw.x = pk2(S[i][0][0], S[i][0][1]); pw.y = pk2(S[i][0][2], S[i][0][3]); pw.z = pk2(S[i][1][0], S[i][1][1]); pw.w = pk2(S[i][1][2], S[i][1][3]);
        const bf16x8 pf = __builtin_bit_cast(bf16x8, pw); const int rb = hh * 64 + w0;
#pragma unroll
        for (int dt = 0; dt < 8; ++dt) { const s16x4 lo = tr_read(lds + off_b(rb + 4 * g + q4, 2 * dt + (pp >> 1)) + 8 * (pp & 1)), hi = tr_read(lds + off_b(rb + 16 + 4 * g + q4, 2 * dt + (pp >> 1)) + 8 * (pp & 1));
            bf16x8 vf; vf[0] = lo[0]; vf[1] = lo[1]; vf[2] = lo[2]; vf[3] = lo[3]; vf[4] = hi[0]; vf[5] = hi[1]; vf[6] = hi[2]; vf[7] = hi[3];
            O[dt] = __builtin_amdgcn_mfma_f32_16x16x32_bf16(vf, pf, O[dt], 0, 0, 0); }
    }
    bf16_t* op = o + (size_t)tq * D + 1024 + h * 128 + 4 * g;
#pragma unroll
    for (int dt = 0; dt < 8; ++dt) { u32x2 w2; w2.x = pk2(O[dt][0] * inv, O[dt][1] * inv); w2.y = pk2(O[dt][2] * inv, O[dt][3] * inv); *(u32x2*)(op + 16 * dt) = w2; }
}
__device__ __forceinline__ void p2_attn(const Params& p, LAS unsigned char* lds) {
    for (int it = blockIdx.x; it < 4096; it += gridDim.x) { if (it < 2048) attn_window_item(p, lds, it); else attn_nat_item(p, lds, it - 2048); }
}
__device__ __forceinline__ void p2_attn_w(const Params& p, LAS unsigned char* lds) { for (int it = blockIdx.x; it < 2048; it += gridDim.x) attn_window_item(p, lds, it); }
__device__ __forceinline__ void p2_attn_n(const Params& p, LAS unsigned char* lds) { for (int it = blockIdx.x; it < 2048; it += gridDim.x) attn_nat_item(p, lds, it); }

struct UpHook { const bf16_t* gates;
    __device__ __forceinline__ void operator()(f32x4 (&acc)[2][2][4][2], const Unit& u, int wr, int wc, int fr, int fq) const {
        unsigned goff = (unsigned)(u.pm * 256 + wr * 64 + fr) * NGATE + u.pn * 256 + wc * 32 + 8 * fq;
#pragma unroll
        for (int ai = 0; ai < 2; ++ai) {
#pragma unroll
            for (int m = 0; m < 4; ++m) { asm volatile("" : "+v"(goff));
#pragma unroll
                for (int bj = 0; bj < 2; ++bj) { const bf16x8 sa = *(const bf16x8*)(gates + goff + bj * 128), sb = *(const bf16x8*)(gates + goff + 2048 + bj * 128);
#pragma unroll
                    for (int n = 0; n < 2; ++n)
#pragma unroll
                        for (int j = 0; j < 4; ++j) acc[ai][bj][m][n][j] *= bf2f(sa[4 * n + j]) * __builtin_amdgcn_rcpf(fmaxf(bf2f(sb[4 * n + j]), 1e-30f)); }
                goff += 16 * NGATE; }
            goff += 64 * NGATE; }
    } };
__device__ __forceinline__ void p3_up(const Params& p, LAS unsigned char* lds) {
    const int tid = threadIdx.x, lane = tid & 63, wid = tid >> 6, wr = wid >> 2, wc = wid & 3, fr = lane & 15, fq = lane >> 4;
    const bf16_t* o = (const bf16_t*)(p.ws + WS_O); const bf16_t* WupT = (const bf16_t*)(p.ws + WS_WUP); const bf16_t* gates = (const bf16_t*)(p.ws + WS_GATES); bf16_t* merged = (bf16_t*)(p.ws + WS_XB);
    for (int ui = blockIdx.x; ui < 128 * 8; ui += gridDim.x) {
        Unit u; u.pn = ui / 128; u.pm = ui % 128; u.aux = 0;
        f32x4 acc[2][2][4][2];
        DenseRow ar{o + (size_t)u.pm * 256 * D, D}, br{WupT + (size_t)u.pn * 256 * D, D};
        sgemm_unit<true, true>(lds, ar, br, 0, 1024, acc, wr, wc, fr, fq, tid);
        UpHook{gates}(acc, u, wr, wc, fr, fq);
        sgemm_unit<true, false>(lds, ar, br, 1024, D, acc, wr, wc, fr, fq, tid);
        unsigned goff = (unsigned)(u.pm * 256 + wr * 64 + fr) * NGATE + u.pn * 256 + wc * 32 + 8 * fq;
        unsigned moff = (unsigned)(u.pm * 256 + wr * 64 + fr) * D + u.pn * 256 + wc * 32 + 8 * fq;
#pragma unroll
        for (int ai = 0; ai < 2; ++ai) {
#pragma unroll
            for (int m = 0; m < 4; ++m) { asm volatile("" : "+v"(goff), "+v"(moff));
#pragma unroll
                for (int bj = 0; bj < 2; ++bj) { const bf16x8 sb = *(const bf16x8*)(gates + goff + 2048 + bj * 128);
                    f32x4 v0 = acc[ai][bj][m][0], v1 = acc[ai][bj][m][1];
#pragma unroll
                    for (int j = 0; j < 4; ++j) { v0[j] *= fmaxf(bf2f(sb[j]), 1e-30f); v1[j] *= fmaxf(bf2f(sb[4 + j]), 1e-30f); }
                    u32x4 w; w.x = pk2(v0[0], v0[1]); w.y = pk2(v0[2], v0[3]); w.z = pk2(v1[0], v1[1]); w.w = pk2(v1[2], v1[3]);
                    *(u32x4*)(merged + moff + bj * 128) = w; }
                goff += 16 * NGATE; moff += 16 * D; }
            goff += 64 * NGATE; moff += 64 * D; }
    }
}

__device__ __forceinline__ void p4_out(const Params& p, LAS unsigned char* lds) {
    const int tid = threadIdx.x, lane = tid & 63, wid = tid >> 6, wr = wid >> 2, wc = wid & 3, fr = lane & 15, fq = lane >> 4;
    const bf16_t* merged = (const bf16_t*)(p.ws + WS_XB); const bf16_t* WoutT = (const bf16_t*)(p.ws + WS_WOUT); bf16_t* hb = (bf16_t*)(p.ws + WS_O); const float* x = p.in[0];
    for (int ui = blockIdx.x; ui < 128 * 8; ui += gridDim.x) {
        Unit u; u.pn = ui / 128; u.pm = ui % 128; u.aux = 0;
        f32x4 acc[2][2][4][2];
        DenseRow ar{merged + (size_t)u.pm * 256 * D, D}, br{WoutT + (size_t)u.pn * 256 * D, D};
        sgemm_unit<false, true>(lds, ar, br, 0, D, acc, wr, wc, fr, fq, tid);
#pragma unroll
        for (int ai = 0; ai < 2; ++ai)
#pragma unroll
            for (int m = 0; m < 4; ++m) { const int row = u.pm * 256 + ai * 128 + wr * 64 + m * 16 + fr;
#pragma unroll
                for (int bj = 0; bj < 2; ++bj)
#pragma unroll
                    for (int n = 0; n < 2; ++n) { const size_t off = (size_t)row * D + u.pn * 256 + bj * 128 + wc * 32 + 16 * n + 4 * fq;
                        const f32x4 hv = *(const f32x4*)(x + off) + acc[ai][bj][m][n]; *(f32x4*)(p.out + off) = hv;
                        u32x2 w2; w2.x = pk2(hv[0], hv[1]); w2.y = pk2(hv[2], hv[3]); *(u32x2*)(hb + off) = w2; } }
    }
}

__device__ __forceinline__ void p5_router(const Params& p) {
    const int tid = threadIdx.x, lane = tid & 63, wave = tid >> 6; const int gw = blockIdx.x * 8 + wave, NGW = gridDim.x * 8;
    const float* wrt = (const float*)(p.ws + WS_WRT); float* r2 = (float*)(p.ws + WS_R2); int* cnt = (int*)(p.ws + WS_CNT); int* tokl = (int*)(p.ws + WS_TOK); float* wl = (float*)(p.ws + WS_WL);
    const float* brg = p.in[15]; const float* bre = p.in[17];
    for (int tok = gw; tok < T; tok += NGW) {
        const f32x4* hr = (const f32x4*)(p.out + (size_t)tok * D) + lane; f32x4 v[8]; float ss = 0.f;
#pragma unroll
        for (int j = 0; j < 8; ++j) { v[j] = hr[64 * j]; ss += (v[j].x * v[j].x + v[j].y * v[j].y) + (v[j].z * v[j].z + v[j].w * v[j].w); }
        ss = wave_sum(ss); const float rr = rsqrtf(ss * (1.0f / D) + EPS);
        float mylg = 0.f;
#pragma unroll 2
        for (int jj = 0; jj < 36; ++jj) { const f32x4* wr_ = (const f32x4*)(wrt + jj * 2048) + lane; float a = 0.f;
#pragma unroll
            for (int j = 0; j < 8; ++j) { const f32x4 wv = wr_[64 * j]; a += (v[j].x * wv.x + v[j].y * wv.y) + (v[j].z * wv.z + v[j].w * wv.w); }
            a = wave_sum(a) * rr; if (lane == jj) mylg = a; }
        float gl[4];
#pragma unroll
        for (int i = 0; i < 4; ++i) gl[i] = __shfl(mylg, i) + brg[i];
        int gi = 0; float gm = gl[0];
#pragma unroll
        for (int i = 1; i < 4; ++i) if (gl[i] > gm) { gm = gl[i]; gi = i; }
        float den = 0.f;
#pragma unroll
        for (int i = 0; i < 4; ++i) den += __expf(gl[i] - gm);
        const float pg = 1.0f / den;
        float el[8];
#pragma unroll
        for (int i = 0; i < 8; ++i) el[i] = __shfl(mylg, 4 + gi * 8 + i) + bre[gi * 8 + i];
        int e0 = 0; float v0 = el[0];
#pragma unroll
        for (int i = 1; i < 8; ++i) if (el[i] > v0) { v0 = el[i]; e0 = i; }
        int e1 = -1; float v1 = -3.0e38f;
#pragma unroll
        for (int i = 0; i < 8; ++i) if (i != e0 && el[i] > v1) { v1 = el[i]; e1 = i; }
        const float ex = __expf(v1 - v0); const float s0 = 1.0f / (1.0f + ex), s1 = ex * s0;
        if (lane == 0) { r2[tok] = rr;
            const int L0 = gi * 8 + e0, L1 = 32 + gi * 8 + e1;
            const int p0 = atomicAdd(&cnt[L0], 1); tokl[(size_t)L0 * T + p0] = tok; wl[(size_t)L0 * T + p0] = pg * s0;
            const int p1 = atomicAdd(&cnt[L1], 1); tokl[(size_t)L1 * T + p1] = tok; wl[(size_t)L1 * T + p1] = pg * s1; }
    }
}

__device__ __forceinline__ void build_tiles(const Params& p, LAS int* tab) {
    __syncthreads();
    if (threadIdx.x == 0) { const int* cnt = (const int*)(p.ws + WS_CNT); int nt = 0, slot = 0, k1 = 0;
        for (int L = 0; L < 64; ++L) { if (L == 32) k1 = nt; const int c = cnt[L]; for (int r0 = 0; r0 < c; r0 += 256) { tab[4 + nt * 4 + 0] = L; tab[4 + nt * 4 + 1] = r0; tab[4 + nt * 4 + 2] = slot; tab[4 + nt * 4 + 3] = min(256, c - r0); slot += 256; ++nt; } }
        tab[0] = nt; tab[1] = k1; }
    __syncthreads();
}
struct GatherRow { const bf16_t* base; const int* list; int nrows; __device__ __forceinline__ unsigned operator()(int r) const { const int t = r < nrows ? list[r] : 0; return (unsigned)t * (unsigned)D; } };

__device__ __forceinline__ void p6_gateup(const Params& p, LAS unsigned char* lds) {
    const int tid = threadIdx.x, lane = tid & 63, wid = tid >> 6, wr = wid >> 2, wc = wid & 3, fr = lane & 15, fq = lane >> 4;
    LAS int* tab = (LAS int*)(lds + TAB_OFF); build_tiles(p, tab);
    const int nt = tab[0];
    const bf16_t* hb = (const bf16_t*)(p.ws + WS_O); const bf16_t* WguT = (const bf16_t*)(p.ws + WS_WGU); bf16_t* he = (bf16_t*)(p.ws + WS_HE);
    const int* tokl = (const int*)(p.ws + WS_TOK); const float* r2 = (const float*)(p.ws + WS_R2);
    for (int ui = blockIdx.x; ui < nt * 4; ui += gridDim.x) {
        const int ti = ui >> 2; Unit u; u.pn = ui & 3; u.pm = ti; u.aux = 0;
        const int L = tab[4 + ti * 4], row0 = tab[4 + ti * 4 + 1], slot = tab[4 + ti * 4 + 2], nrows = tab[4 + ti * 4 + 3], e = L & 31;
        f32x4 acc[2][2][4][2];
        GatherRow ar{hb, tokl + (size_t)L * T + row0, nrows}; DenseRow br{WguT + (size_t)(e * 1024 + u.pn * 256) * D, D};
        sgemm_unit<true, true>(lds, ar, br, 0, D, acc, wr, wc, fr, fq, tid);
#pragma unroll
        for (int ai = 0; ai < 2; ++ai)
#pragma unroll
            for (int m = 0; m < 4; ++m) { const int rr = ai * 128 + wr * 64 + m * 16 + fr; const int tk = rr < nrows ? tokl[(size_t)L * T + row0 + rr] : 0; const float rs = r2[tk];
                u32x4 w; unsigned ww[4];
#pragma unroll
                for (int n = 0; n < 2; ++n) { float hv[4];
#pragma unroll
                    for (int j = 0; j < 4; ++j) { const float gt = acc[ai][0][m][n][j] * rs, up = acc[ai][1][m][n][j] * rs; hv[j] = gt * sigmoidf_(gt) * up; }
                    ww[2 * n] = pk2(hv[0], hv[1]); ww[2 * n + 1] = pk2(hv[2], hv[3]); }
                w.x = ww[0]; w.y = ww[1]; w.z = ww[2]; w.w = ww[3];
                *(u32x4*)(he + (size_t)(slot + rr) * 512 + u.pn * 128 + wc * 32 + 8 * fq) = w; }
    }
}
__device__ __forceinline__ void p7_down(const Params& p, LAS unsigned char* lds, int k) {
    const int tid = threadIdx.x, lane = tid & 63, wid = tid >> 6, wr = wid >> 2, wc = wid & 3, fr = lane & 15, fq = lane >> 4;
    LAS int* tab = (LAS int*)(lds + TAB_OFF); build_tiles(p, tab);
    const int t_lo = k ? tab[1] : 0, t_hi = k ? tab[0] : tab[1];
    const bf16_t* he = (const bf16_t*)(p.ws + WS_HE); const bf16_t* WdT = (const bf16_t*)(p.ws + WS_WD);
    const int* tokl = (const int*)(p.ws + WS_TOK); const float* wl = (const float*)(p.ws + WS_WL);
    for (int ui = blockIdx.x; ui < (t_hi - t_lo) * 8; ui += gridDim.x) {
        const int ti = t_lo + (ui >> 3); Unit u; u.pn = ui & 7; u.pm = ti; u.aux = 0;
        const int L = tab[4 + ti * 4], row0 = tab[4 + ti * 4 + 1], slot = tab[4 + ti * 4 + 2], nrows = tab[4 + ti * 4 + 3], e = L & 31;
        f32x4 acc[2][2][4][2];
        DenseRow ar{he + (size_t)slot * 512, 512}, br{WdT + (size_t)(e * 2048 + u.pn * 256) * 512, 512};
        sgemm_unit<false, true>(lds, ar, br, 0, 512, acc, wr, wc, fr, fq, tid);
#pragma unroll
        for (int ai = 0; ai < 2; ++ai)
#pragma unroll
            for (int m = 0; m < 4; ++m) { const int rr = ai * 128 + wr * 64 + m * 16 + fr;
                if (rr < nrows) { const int tk = tokl[(size_t)L * T + row0 + rr]; const float wg = wl[(size_t)L * T + row0 + rr];
#pragma unroll
                    for (int bj = 0; bj < 2; ++bj)
#pragma unroll
                        for (int n = 0; n < 2; ++n) { float* op = p.out + (size_t)tk * D + u.pn * 256 + bj * 128 + wc * 32 + 16 * n + 4 * fq; *(f32x4*)op = *(const f32x4*)op + acc[ai][bj][m][n] * wg; } } }
    }
}

namespace cg = cooperative_groups;
__global__ void __launch_bounds__(512, 2) fwd_megakernel(Params p) {
    extern __shared__ __attribute__((aligned(16))) unsigned char lds_raw[];
    LAS unsigned char* lds = (LAS unsigned char*)lds_raw;
    cg::grid_group grid = cg::this_grid();
    p0_prep(p, lds);            grid.sync();
    p1_inproj(p, lds);          grid.sync();
    p2_attn(p, lds);            grid.sync();
    p_moe_prep(p, lds);
    p3_up(p, lds);              grid.sync();
    p4_out(p, lds);             grid.sync();
    p5_router(p);               grid.sync();
    p6_gateup(p, lds);          grid.sync();
    p7_down(p, lds, 0);         grid.sync();
    p7_down(p, lds, 1);
}

extern "C" void kernel_launch(void* const* d_in, const int* in_sizes, int n_in, void* d_out, int out_size, void* d_ws, size_t ws_size, hipStream_t stream) {
    static int grid_blocks = 0;
    if (!grid_blocks) {
        if (n_in != 21 || out_size != T * D || ws_size < WS_END) { fprintf(stderr, "kernel_launch: unexpected problem (n_in %d out %d ws %zu)\n", n_in, out_size, ws_size); grid_blocks = -1; return; }
        if (hipFuncSetAttribute((const void*)fwd_megakernel, hipFuncAttributeMaxDynamicSharedMemorySize, LDS_BYTES) != hipSuccess) { fprintf(stderr, "kernel_launch: hipFuncSetAttribute failed\n"); grid_blocks = -1; return; }
        int dev = 0, cus = 0, per_cu = 0;
        hipGetDevice(&dev); hipDeviceGetAttribute(&cus, hipDeviceAttributeMultiprocessorCount, dev);
        hipOccupancyMaxActiveBlocksPerMultiprocessor(&per_cu, (const void*)fwd_megakernel, 512, LDS_BYTES);
        if (per_cu < 1 || cus < 1) { fprintf(stderr, "kernel_launch: occupancy query gave %d blocks/CU on %d CUs\n", per_cu, cus); grid_blocks = -1; return; }
        grid_blocks = cus;
    }
    if (grid_blocks < 0) return;
    Params p{};
    for (int i = 0; i < 21; ++i) p.in[i] = (const float*)d_in[i];
    p.out = (float*)d_out; p.ws = (unsigned char*)d_ws;
    void* args[] = {&p};
    hipError_t e = hipLaunchCooperativeKernel((const void*)fwd_megakernel, dim3(grid_blocks), dim3(512), args, LDS_BYTES, stream);
    if (e != hipSuccess) fprintf(stderr, "cooperative launch failed: %s (grid %d)\n", hipGetErrorString(e), grid_blocks);
}
```

```cpp
#include <hip/hip_runtime.h>
#include <hip/hip_cooperative_groups.h>
#include <cstdio>
#include <cstdint>

#define LAS __attribute__((address_space(3)))
typedef unsigned short bf16_t;
typedef short bf16x8 __attribute__((ext_vector_type(8)));
typedef short s16x4 __attribute__((ext_vector_type(4)));
typedef float f32x4 __attribute__((ext_vector_type(4)));
typedef unsigned u32x4 __attribute__((ext_vector_type(4)));
typedef unsigned u32x2 __attribute__((ext_vector_type(2)));
typedef short v4i16_t __attribute__((ext_vector_type(4)));

namespace cfg {
constexpr int T = 32768, D = 2048, SEQ = 16384;
constexpr int NQKV = 4608, NGATE = 4096, NIN = 8704;
constexpr size_t MiB = 1ull << 20;
constexpr size_t WS_XB = 0, WS_QKV = 128 * MiB, WS_GATES = 416 * MiB, WS_O = 672 * MiB, WS_WIN = 800 * MiB, WS_WUP = 834 * MiB, WS_WOUT = 842 * MiB, WS_MISC = 850 * MiB;
constexpr size_t WS_WGU = WS_QKV, WS_WD = WS_QKV + 128 * MiB, WS_HE = WS_QKV + 192 * MiB;
constexpr size_t WS_R1 = WS_MISC, WS_R2 = WS_R1 + (size_t)T * 4, WS_WRT = WS_R2 + (size_t)T * 4, WS_CNT = WS_WRT + 512 * 1024, WS_TOK = WS_CNT + 4096,
                 WS_WL = WS_TOK + 64ull * T * 4, WS_END = WS_WL + 64ull * T * 4;
constexpr int LDS_BYTES = 140 * 1024;
constexpr int TAB_OFF = 132 * 1024;
constexpr float EPS = 1e-6f;
}
using namespace cfg;

struct Params { const float* in[21]; float* out; unsigned char* ws; };

__device__ __forceinline__ float bf2f(short s) { return __uint_as_float(((unsigned)(unsigned short)s) << 16); }
typedef float f32x2 __attribute__((ext_vector_type(2)));
typedef __bf16 bf16x2_t __attribute__((ext_vector_type(2)));
__device__ __forceinline__ unsigned pk2(float lo, float hi) { const f32x2 v = {lo, hi}; return __builtin_bit_cast(unsigned, __builtin_convertvector(v, bf16x2_t)); }
__device__ __forceinline__ float wave_sum(float v) {
#pragma unroll
    for (int o = 1; o < 64; o <<= 1) v += __shfl_xor(v, o);
    return v;
}
__device__ __forceinline__ float sigmoidf_(float v) { return 1.0f / (1.0f + __expf(-v)); }
__device__ __forceinline__ unsigned off_b(unsigned row, unsigned ch) { return 256u * row + 16u * (ch ^ (((row & 3) << 2) | ((row >> 2) & 3))); }
__device__ __forceinline__ s16x4 tr_read(LAS unsigned char* p) { return __builtin_bit_cast(s16x4, __builtin_amdgcn_ds_read_tr16_b64_v4i16((LAS v4i16_t*)p)); }
__host__ __device__ __forceinline__ int perm32(int rho) { const int n = rho >> 4, i = rho & 15; return 8 * (i >> 2) + 4 * n + (i & 3); }
__device__ __forceinline__ int t5_bucket(int rel) {
    const int n = rel < 0 ? -rel : rel; const int ret = rel > 0 ? 16 : 0; int b;
    if (n < 8) b = n; else if (n < 12) b = 8; else if (n < 16) b = 9; else if (n < 23) b = 10; else if (n < 32) b = 11; else if (n < 46) b = 12; else if (n < 64) b = 13; else if (n < 91) b = 14; else b = 15;
    return ret + b;
}

__device__ __forceinline__ void transpose_item(const float* __restrict__ W, int ldw, int k0, int n0, bf16_t* __restrict__ WT, int ldt, int drow0, int dk0, const float* __restrict__ scale, LAS float* scr, int lane) {
#pragma unroll 8
    for (int i = 0; i < 32; ++i) { const int kk = 2 * i + (lane >> 5); float v = W[(size_t)(k0 + kk) * ldw + n0 + (lane & 31)]; if (scale) v *= scale[k0 + kk]; scr[kk * 33 + (lane & 31)] = v; }
    asm volatile("s_waitcnt lgkmcnt(0)" ::: "memory");
    const int c = lane & 7;
#pragma unroll
    for (int j = 0; j < 4; ++j) { const int n = (lane >> 3) + 8 * j; const LAS float* s = scr + (8 * c) * 33 + n;
        u32x4 o; o.x = pk2(s[0 * 33], s[1 * 33]); o.y = pk2(s[2 * 33], s[3 * 33]); o.z = pk2(s[4 * 33], s[5 * 33]); o.w = pk2(s[6 * 33], s[7 * 33]);
        *(u32x4*)(WT + (size_t)(drow0 + n) * ldt + dk0 + k0 + 8 * c) = o; }
    asm volatile("s_waitcnt lgkmcnt(0)" ::: "memory");
}

__device__ __forceinline__ void p0_prep(const Params& p, LAS unsigned char* lds) {
    const int tid = threadIdx.x, lane = tid & 63, wave = tid >> 6;
    const int gw = blockIdx.x * 8 + wave, NGW = gridDim.x * 8;
    LAS float* scr = (LAS float*)(lds + wave * 8448);
    const float* x = p.in[0]; const float* g1 = p.in[1]; const float* w_in = p.in[2];
    bf16_t* xb = (bf16_t*)(p.ws + WS_XB); float* r1 = (float*)(p.ws + WS_R1);
    bf16_t* WinT = (bf16_t*)(p.ws + WS_WIN); bf16_t* WupT = (bf16_t*)(p.ws + WS_WUP); bf16_t* WoutT = (bf16_t*)(p.ws + WS_WOUT);
    constexpr int I_WIN = 32 * 272, I_UP = 16 * 64, I_OUT = 32 * 64, NITEMS = I_WIN + 2 * I_UP + I_OUT;
    for (int it = gw; it < NITEMS; it += NGW) {
        int r = it;
        if (r < I_WIN) { const int kb = r / 272, nb = r % 272; transpose_item(w_in, NIN, kb * 64, nb * 32, WinT, 2048, nb * 32, 0, g1, scr, lane); continue; } r -= I_WIN;
        if (r < I_UP) { const int kb = r / 64, nb = r % 64; transpose_item(p.in[9], 2048, kb * 64, nb * 32, WupT, 2048, nb * 32, 0, nullptr, scr, lane); continue; } r -= I_UP;
        if (r < I_UP) { const int kb = r / 64, nb = r % 64; transpose_item(p.in[10], 2048, kb * 64, nb * 32, WupT, 2048, nb * 32, 1024, nullptr, scr, lane); continue; } r -= I_UP;
        { const int kb = r / 64, nb = r % 64; transpose_item(p.in[11], 2048, kb * 64, nb * 32, WoutT, 2048, nb * 32, 0, nullptr, scr, lane); }
    }
    { float* wrt = (float*)(p.ws + WS_WRT); const float* g2 = p.in[13]; const float* wrg = p.in[14]; const float* wre = p.in[16];
      for (int i = blockIdx.x * 512 + tid; i < 36 * 2048; i += gridDim.x * 512) { const int j = i >> 11, k = i & 2047; wrt[i] = g2[k] * (j < 4 ? wrg[k * 4 + j] : wre[k * 32 + (j - 4)]); } }
    if (blockIdx.x == 0 && tid < 64) ((int*)(p.ws + WS_CNT))[tid] = 0;
    for (int row = gw; row < T; row += NGW) {
        const f32x4* xr = (const f32x4*)(x + (size_t)row * D) + lane; f32x4 v[8]; float ss = 0.f;
#pragma unroll
        for (int j = 0; j < 8; ++j) { v[j] = xr[64 * j]; ss += (v[j].x * v[j].x + v[j].y * v[j].y) + (v[j].z * v[j].z + v[j].w * v[j].w); }
        ss = wave_sum(ss);
        if (lane == 0) r1[row] = rsqrtf(ss * (1.0f / D) + EPS);
        u32x2* o = (u32x2*)(xb + (size_t)row * D) + lane;
#pragma unroll
        for (int j = 0; j < 8; ++j) { u32x2 w; w.x = pk2(v[j].x, v[j].y); w.y = pk2(v[j].z, v[j].w); o[64 * j] = w; }
    }
}

__device__ __forceinline__ void p_moe_prep(const Params& p, LAS unsigned char* lds) {
    const int tid = threadIdx.x, lane = tid & 63, wave = tid >> 6;
    const int gw = blockIdx.x * 8 + wave, NGW = gridDim.x * 8;
    LAS float* scr = (LAS float*)(lds + wave * 8448);
    const float* g2 = p.in[13];
    bf16_t* WguT = (bf16_t*)(p.ws + WS_WGU); bf16_t* WdT = (bf16_t*)(p.ws + WS_WD);
    constexpr int I_G = 32 * 32 * 16;
    constexpr int I_D = 32 * 8 * 64;
    for (int it = gw; it < 2 * I_G + I_D; it += NGW) {
        int r = it;
        if (r < 2 * I_G) { const int which = r >= I_G; if (which) r -= I_G; const int e = r / 512, rr = r % 512, kb = rr / 16, nb = rr % 16;
            const float* W = p.in[which ? 19 : 18] + (size_t)e * 2048 * 512; const int n0 = nb * 32;
            transpose_item(W, 512, kb * 64, n0, WguT, 2048, e * 1024 + (n0 >> 7) * 256 + which * 128 + (n0 & 127), 0, g2, scr, lane); continue; }
        r -= 2 * I_G;
        { const int e = r / 512, rr = r % 512, kb = rr / 64, nb = rr % 64; const float* W = p.in[20] + (size_t)e * 512 * 2048;
          transpose_item(W, 2048, kb * 64, nb * 32, WdT, 512, e * 2048 + nb * 32, 0, nullptr, scr, lane); }
    }
}

struct Unit { int pm, pn, aux; };
template <bool PERM, bool ZERO, class ARow, class BRow>
__device__ __forceinline__ void sgemm_unit(LAS unsigned char* lds, const ARow& arow, const BRow& brow, int kbeg, int kend, f32x4 (&acc)[2][2][4][2], int wr, int wc, int fr, int fq, int tid) {
    if (ZERO) {
#pragma unroll
    for (int a = 0; a < 2; ++a)
#pragma unroll
        for (int b = 0; b < 2; ++b)
#pragma unroll
            for (int m = 0; m < 4; ++m)
#pragma unroll
                for (int n = 0; n < 2; ++n) acc[a][b][m][n] = (f32x4){0.f, 0.f, 0.f, 0.f};
    }
    unsigned ao[4], bo[4]; const bf16_t* const abase = arow.base; const bf16_t* const bbase = brow.base;
#pragma unroll
    for (int i = 0; i < 4; ++i) { const int pz = tid + 512 * i, row = pz >> 3, c8 = pz & 7; ao[i] = arow(row) + c8 * 8; const int Rb = PERM ? ((row & ~31) + perm32(row & 31)) : row; bo[i] = brow(Rb) + c8 * 8; }
    for (int k0 = kbeg; k0 < kend; k0 += 64) {
        bf16x8 ra[4], rb[4];
#pragma unroll
        for (int i = 0; i < 4; ++i) { ra[i] = *(const bf16x8*)(abase + ao[i] + k0); rb[i] = *(const bf16x8*)(bbase + bo[i] + k0); }
        __syncthreads();
#pragma unroll
        for (int i = 0; i < 4; ++i) { const int pz = tid + 512 * i, row = pz >> 3, c8 = pz & 7; *(LAS bf16x8*)(lds + row * 144 + c8 * 16) = ra[i]; *(LAS bf16x8*)(lds + 36864 + row * 144 + c8 * 16) = rb[i]; }
        __syncthreads();
#pragma unroll
        for (int ai = 0; ai < 2; ++ai) {
            bf16x8 At[4][2];
#pragma unroll
            for (int m = 0; m < 4; ++m)
#pragma unroll
                for (int k = 0; k < 2; ++k) At[m][k] = *(const LAS bf16x8*)(lds + (ai * 128 + wr * 64 + m * 16 + fr) * 144 + (k * 32 + fq * 8) * 2);
#pragma unroll
            for (int bj = 0; bj < 2; ++bj) {
                bf16x8 Bf[2][2];
#pragma unroll
                for (int n = 0; n < 2; ++n)
#pragma unroll
                    for (int k = 0; k < 2; ++k) Bf[n][k] = *(const LAS bf16x8*)(lds + 36864 + (bj * 128 + wc * 32 + n * 16 + fr) * 144 + (k * 32 + fq * 8) * 2);
#pragma unroll
                for (int m = 0; m < 4; ++m)
#pragma unroll
                    for (int n = 0; n < 2; ++n)
#pragma unroll
                        for (int k = 0; k < 2; ++k) acc[ai][bj][m][n] = __builtin_amdgcn_mfma_f32_16x16x32_bf16(Bf[n][k], At[m][k], acc[ai][bj][m][n], 0, 0, 0);
            }
        }
    }
}
struct DenseRow { const bf16_t* base; int ld; __device__ __forceinline__ unsigned operator()(int r) const { return (unsigned)(r * ld); } };

namespace pg8 {
constexpr int BM = 256, BK = 64, HALF = 128, HTB = HALF * BK * 2, STAGE_BYTES = 8 * HTB;
__device__ __forceinline__ int lds_byte(int r, int c) { const int st = (r >> 4) * 2 + (c >> 5), rr = r & 15, cc = c & 31, ob = rr * 64 + cc * 2; return st * 1024 + (ob ^ (((ob >> 9) & 1) << 5)); }
__device__ __forceinline__ void stage_rc(int b, int& R, int& C) { const int st = b / 1024, sb = b % 1024, swz = sb ^ (((sb >> 9) & 1) << 5); R = (st >> 1) * 16 + swz / 64; C = (st & 1) * 32 + (swz % 64) / 2; }

template <bool PERM, bool GATHER, class Sched, class Epi>
__device__ __forceinline__ void gemm_phase(LAS unsigned char* lds, const Sched& S, const Epi& E, const int nt, const int lda, const int ldb) {
    int tid_ = threadIdx.x; asm volatile("" : "+v"(tid_));
    const int tid = tid_, wid = __builtin_amdgcn_readfirstlane(tid >> 6), lane = tid & 63, wr = wid >> 2, wc = wid & 3, fr = lane & 15, fq = lane >> 4;
    int R0, C0, R1, C1; stage_rc(tid * 16, R0, C0); stage_rc(tid * 16 + 8192, R1, C1);
    unsigned voffB[2], voffA[2][2];
    { const int Rb0 = PERM ? ((R0 & ~31) + perm32(R0 & 31)) : R0, Rb1 = PERM ? ((R1 & ~31) + perm32(R1 & 31)) : R1;
      voffB[0] = (unsigned)(Rb0 * ldb + C0) * 2u; voffB[1] = (unsigned)(Rb1 * ldb + C1) * 2u; }
    const size_t kstep = (size_t)(BK * 2);
    const size_t hstepB = (size_t)HALF * ldb * 2;
    const unsigned ldsw = (unsigned)wid * 1024u;
    const int aoff = lds_byte(wr * 64 + fr, fq * 8), boff = lds_byte(wc * 32 + fr, fq * 8);
#define PG8_SA(b, h) (((b) * 2 + (h)) * HTB)
#define PG8_SB(b, h) ((4 + (b) * 2 + (h)) * HTB)
#define PG8_STAGE_B(bufoff, gbase) do { _Pragma("unroll") for (int _i = 0; _i < 2; ++_i) \
        __builtin_amdgcn_global_load_lds((const unsigned*)((const char*)(gbase) + voffB[_i]), (LAS unsigned*)(lds + (bufoff) + ldsw + _i * 8192), 16, 0, 0); } while (0)
#define PG8_STAGE_A(bufoff, gbase, h) do { _Pragma("unroll") for (int _i = 0; _i < 2; ++_i) \
        __builtin_amdgcn_global_load_lds((const unsigned*)((const char*)(gbase) + voffA[h][_i]), (LAS unsigned*)(lds + (bufoff) + ldsw + _i * 8192), 16, 0, 0); } while (0)
#define PG8_LDA(dst, b, h) do { _Pragma("unroll") for (int m = 0; m < 4; ++m) _Pragma("unroll") for (int k = 0; k < 2; ++k) dst[m][k] = *(const LAS bf16x8*)(lds + PG8_SA(b, h) + aoff + m * 2048 + k * 1024); } while (0)
#define PG8_LDB(dst, b, h) do { _Pragma("unroll") for (int n = 0; n < 2; ++n) _Pragma("unroll") for (int k = 0; k < 2; ++k) dst[n][k] = *(const LAS bf16x8*)(lds + PG8_SB(b, h) + boff + n * 2048 + k * 1024); } while (0)
#define PG8_MMA(ai, bj, At, Bt) do { __builtin_amdgcn_s_setprio(1); _Pragma("unroll") for (int m = 0; m < 4; ++m) _Pragma("unroll") for (int n = 0; n < 2; ++n) _Pragma("unroll") for (int k = 0; k < 2; ++k) \
        acc[ai][bj][m][n] = __builtin_amdgcn_mfma_f32_16x16x32_bf16(Bt[n][k], At[m][k], acc[ai][bj][m][n], 0, 0, 0); __builtin_amdgcn_s_setprio(0); } while (0)
#define PG8_WAIT_V(n) asm volatile("s_waitcnt vmcnt(" #n ")" ::: "memory")
#define PG8_WAIT_L(n) asm volatile("s_waitcnt lgkmcnt(" #n ")" ::: "memory")
#define PG8_BAR __builtin_amdgcn_s_barrier()
#define PG8_SCHED __builtin_amdgcn_sched_barrier(0)
    Unit cur, nxt; int ui = 0;
    __syncthreads();
    if (!S.next(0, cur)) return;
    if (GATHER) S.a_offs(cur, R0, C0, R1, C1, voffA);
    else { voffA[0][0] = (unsigned)(R0 * lda + C0) * 2u; voffA[0][1] = (unsigned)(R1 * lda + C1) * 2u; voffA[1][0] = voffA[0][0] + (unsigned)(HALF * lda * 2); voffA[1][1] = voffA[0][1] + (unsigned)(HALF * lda * 2); }
    f32x4 acc[2][2][4][2];
#pragma unroll
    for (int a = 0; a < 2; ++a)
#pragma unroll
        for (int b = 0; b < 2; ++b)
#pragma unroll
            for (int m = 0; m < 4; ++m)
#pragma unroll
                for (int n = 0; n < 2; ++n) acc[a][b][m][n] = (f32x4){0.f, 0.f, 0.f, 0.f};
    bf16x8 At[4][2], B0[2][2], B1[2][2];
    const char* cA = S.a_base(cur); const char* cB = S.b_base(cur);
    PG8_STAGE_B(PG8_SB(0, 0), cB); PG8_STAGE_B(PG8_SB(0, 1), cB + hstepB); PG8_STAGE_A(PG8_SA(0, 0), cA, 0); PG8_STAGE_A(PG8_SA(0, 1), cA, 1);
    if (wr == 1) PG8_BAR;
    PG8_WAIT_V(2); PG8_BAR;
    PG8_STAGE_B(PG8_SB(1, 0), cB + kstep); PG8_STAGE_A(PG8_SA(1, 0), cA + kstep, 0); PG8_STAGE_B(PG8_SB(1, 1), cB + hstepB + kstep);
    PG8_WAIT_V(6); PG8_BAR;
    for (;;) {
        const bool has_next = S.next(ui + 1, nxt);
        const char* nA = has_next ? S.a_base(nxt) : cA; const char* nB = has_next ? S.b_base(nxt) : cB;
        unsigned vn[2][2];
        if (GATHER) { if (has_next) S.a_offs(nxt, R0, C0, R1, C1, vn); else { vn[0][0] = voffA[0][0]; vn[0][1] = voffA[0][1]; vn[1][0] = voffA[1][0]; vn[1][1] = voffA[1][1]; } }
        for (int t = 0; t < nt; t += 2) {
            const bool last = (t == nt - 2);
            const char* a1 = cA + (size_t)(t + 1) * kstep;
            const char* a2 = last ? nA : cA + (size_t)(t + 2) * kstep; const char* b2 = last ? nB : cB + (size_t)(t + 2) * kstep;
            const char* a3 = a2 + kstep; const char* b3 = b2 + kstep;
            PG8_LDB(B0, 0, 0); PG8_LDB(B1, 0, 1); PG8_SCHED; PG8_LDA(At, 0, 0); PG8_STAGE_A(PG8_SA(1, 1), a1, 1);
            if (GATHER) { if (last) { voffA[0][0] = vn[0][0]; voffA[0][1] = vn[0][1]; voffA[1][0] = vn[1][0]; voffA[1][1] = vn[1][1]; } }
            PG8_WAIT_V(8); PG8_WAIT_L(0); PG8_BAR; PG8_MMA(0, 0, At, B0); PG8_MMA(0, 1, At, B1); PG8_BAR; PG8_SCHED;
            PG8_LDA(At, 0, 1); PG8_STAGE_B(PG8_SB(0, 0), b2); PG8_STAGE_B(PG8_SB(0, 1), b2 + hstepB); PG8_STAGE_A(PG8_SA(0, 0), a2, 0);
            PG8_WAIT_V(8); PG8_WAIT_L(0); PG8_BAR; PG8_MMA(1, 0, At, B0); PG8_MMA(1, 1, At, B1); PG8_BAR; PG8_SCHED;
            PG8_LDB(B0, 1, 0); PG8_LDB(B1, 1, 1); PG8_SCHED; PG8_LDA(At, 1, 0); PG8_STAGE_A(PG8_SA(0, 1), a2, 1);
            PG8_WAIT_V(8); PG8_WAIT_L(0); PG8_BAR; PG8_MMA(0, 0, At, B0); PG8_MMA(0, 1, At, B1); PG8_BAR; PG8_SCHED;
            PG8_LDA(At, 1, 1); PG8_STAGE_B(PG8_SB(1, 0), b3); PG8_STAGE_B(PG8_SB(1, 1), b3 + hstepB); PG8_STAGE_A(PG8_SA(1, 0), a3, 0);
            PG8_WAIT_V(8); PG8_WAIT_L(0); PG8_BAR; PG8_MMA(1, 0, At, B0); PG8_MMA(1, 1, At, B1); PG8_BAR; PG8_SCHED;
        }
        if (wr == 0) PG8_BAR;
        E(acc, cur, wr, wc, fr, fq);
        if (!has_next) break;
        if (!S.keep_acc(cur)) {
#pragma unroll
        for (int a = 0; a < 2; ++a)
#pragma unroll
            for (int b = 0; b < 2; ++b)
#pragma unroll
                for (int m = 0; m < 4; ++m)
#pragma unroll
                    for (int n = 0; n < 2; ++n) acc[a][b][m][n] = (f32x4){0.f, 0.f, 0.f, 0.f};
        }
        cur = nxt; cA = nA; cB = nB; ++ui;
        if (wr == 1) PG8_BAR;
    }
    PG8_WAIT_V(0);
    PG8_BAR;
#undef PG8_SA
#undef PG8_SB
#undef PG8_STAGE_A
#undef PG8_STAGE_B
#undef PG8_LDA
#undef PG8_LDB
#undef PG8_MMA
#undef PG8_WAIT_V
#undef PG8_WAIT_L
#undef PG8_BAR
#undef PG8_SCHED
}
struct TileOrder {
    int nM, nN, nwg, G, c;
    __device__ __forceinline__ void init(int nM_, int nN_, int G_, int c_) { nM = nM_; nN = nN_; nwg = nM * nN; G = G_; c = c_; }
    __device__ __forceinline__ bool tile(int i, int& pm, int& pn) const {
        const long L = (long)i * G + c; if (L >= nwg) return false;
        int wgid = (int)L; { const int q = nwg / 8, r = nwg % 8, xcd = wgid % 8, off = wgid / 8; wgid = (xcd < r ? xcd * (q + 1) : r * (q + 1) + (xcd - r) * q) + off; }
        const int nig = 8 * nN, gid = wgid / nig, fm = gid * 8, gsz = (nM - fm) < 8 ? (nM - fm) : 8;
        pm = fm + ((wgid % nig) % gsz); pn = (wgid % nig) / gsz; return true;
    }
};
struct DenseSched {
    TileOrder o; const bf16_t* A; const bf16_t* Bt; int lda, ldb;
    __device__ __forceinline__ bool next(int i, Unit& u) const { u.aux = 0; return o.tile(i, u.pm, u.pn); }
    __device__ __forceinline__ const char* a_base(const Unit& u) const { return (const char*)(A + (size_t)u.pm * 256 * lda); }
    __device__ __forceinline__ const char* b_base(const Unit& u) const { return (const char*)(Bt + (size_t)u.pn * 256 * ldb); }
    __device__ __forceinline__ bool keep_acc(const Unit&) const { return false; }
    __device__ __forceinline__ void a_offs(const Unit&, int, int, int, int, unsigned (&)[2][2]) const {}
};
}

struct EpiInProj { bf16_t* qkv; bf16_t* gates; const float* r1;
    __device__ __forceinline__ void operator()(f32x4 (&acc)[2][2][4][2], const Unit& u, int wr, int wc, int fr, int fq) const {
        const bool isg = u.pn >= 18; bf16_t* base = isg ? gates : qkv; const int ldc = isg ? NGATE : NQKV; const int colt = (isg ? u.pn - 18 : u.pn) * 256 + wc * 32 + 8 * fq;
#pragma unroll
        for (int ai = 0; ai < 2; ++ai)
#pragma unroll
            for (int m = 0; m < 4; ++m) { const int row = u.pm * 256 + ai * 128 + wr * 64 + m * 16 + fr; const float rs = r1[row]; bf16_t* rowp = base + (size_t)row * ldc + colt;
#pragma unroll
                for (int bj = 0; bj < 2; ++bj) { f32x4 v0 = acc[ai][bj][m][0] * rs, v1 = acc[ai][bj][m][1] * rs;
                    if (isg) {
#pragma unroll
                        for (int j = 0; j < 4; ++j) { v0[j] = sigmoidf_(v0[j]); v1[j] = sigmoidf_(v1[j]); } }
                    u32x4 w; w.x = pk2(v0[0], v0[1]); w.y = pk2(v0[2], v0[3]); w.z = pk2(v1[0], v1[1]); w.w = pk2(v1[2], v1[3]);
                    *(u32x4*)(rowp + bj * 128) = w; } }
    } };
__device__ __forceinline__ void p1_inproj(const Params& p, LAS unsigned char* lds) {
    pg8::DenseSched S; S.o.init(128, 34, gridDim.x, blockIdx.x); S.A = (const bf16_t*)(p.ws + WS_XB); S.Bt = (const bf16_t*)(p.ws + WS_WIN); S.lda = D; S.ldb = D;
    EpiInProj E{(bf16_t*)(p.ws + WS_QKV), (bf16_t*)(p.ws + WS_GATES), (const float*)(p.ws + WS_R1)};
    pg8::gemm_phase<true, false>(lds, S, E, D / 64, D, D);
}

template <bool NORM, class SrcRow>
__device__ __forceinline__ void stage_chunk(LAS unsigned char* lds, const SrcRow& src, const float* __restrict__ gain, int tid) {
#pragma unroll
    for (int i = 0; i < 4; ++i) { const int pz = tid + 512 * i, row = pz >> 4, ch = pz & 15;
        bf16x8 v = *(const bf16x8*)(src(row) + ch * 8);
        if (NORM) { float f[8]; float ss = 0.f;
#pragma unroll
            for (int j = 0; j < 8; ++j) { f[j] = bf2f(v[j]); ss += f[j] * f[j]; }
            ss += __shfl_xor(ss, 1); ss += __shfl_xor(ss, 2); ss += __shfl_xor(ss, 4); ss += __shfl_xor(ss, 8);
            const float rk = rsqrtf(ss * (1.0f / 128.0f) + EPS); const f32x4 g0 = *(const f32x4*)(gain + ch * 8), g1 = *(const f32x4*)(gain + ch * 8 + 4);
            u32x4 w; w.x = pk2(f[0] * rk * g0.x, f[1] * rk * g0.y); w.y = pk2(f[2] * rk * g0.z, f[3] * rk * g0.w); w.z = pk2(f[4] * rk * g1.x, f[5] * rk * g1.y); w.w = pk2(f[6] * rk * g1.z, f[7] * rk * g1.w);
            v = __builtin_bit_cast(bf16x8, w); }
        *(LAS bf16x8*)(lds + off_b(row, ch)) = v; }
}
__device__ __forceinline__ void load_q(const bf16_t* qp, const float* __restrict__ gain, int g, bf16x8 (&qf)[4]) {
    float f[4][8]; float ss = 0.f;
#pragma unroll
    for (int ks = 0; ks < 4; ++ks) { const bf16x8 v = *(const bf16x8*)(qp + 32 * ks + 8 * g);
#pragma unroll
        for (int j = 0; j < 8; ++j) { f[ks][j] = bf2f(v[j]); ss += f[ks][j] * f[ks][j]; } }
    ss += __shfl_xor(ss, 16); ss += __shfl_xor(ss, 32);
    const float rq = rsqrtf(ss * (1.0f / 128.0f) + EPS) * 0.08838834764831845f;
#pragma unroll
    for (int ks = 0; ks < 4; ++ks) { const f32x4 g0 = *(const f32x4*)(gain + 32 * ks + 8 * g), g1 = *(const f32x4*)(gain + 32 * ks + 8 * g + 4);
        u32x4 w; w.x = pk2(f[ks][0] * rq * g0.x, f[ks][1] * rq * g0.y); w.y = pk2(f[ks][2] * rq * g0.z, f[ks][3] * rq * g0.w); w.z = pk2(f[ks][4] * rq * g1.x, f[ks][5] * rq * g1.y); w.w = pk2(f[ks][6] * rq * g1.z, f[ks][7] * rq * g1.w);
        qf[ks] = __builtin_bit_cast(bf16x8, w); }
}
struct TokRow { const bf16_t* base; __device__ __forceinline__ const bf16_t* operator()(int r) const { return base + (size_t)r * NQKV; } };
struct NatRow { const bf16_t* base;   __device__ __forceinline__ const bf16_t* operator()(int r) const { return base + (size_t)(r & 63) * NQKV + (r >> 6) * 128; } };

__device__ __forceinline__ void attn_window_item(const Params& p, LAS unsigned char* lds, int item) {
    const int tid = threadIdx.x, lane = tid & 63, w = __builtin_amdgcn_readfirstlane(tid >> 6), g = lane >> 4, ql = lane & 15;
    const int b = item >> 10, nb = (item >> 3) & 127, hq = item & 7, kv = hq >> 2;
    const bf16_t* qkv = (const bf16_t*)(p.ws + WS_QKV); bf16_t* o = (bf16_t*)(p.ws + WS_O);
    LAS float* bias = (LAS float*)(lds + 32768);
    __syncthreads();
    if (tid < 257) bias[tid] = p.in[12][t5_bucket(tid - 128) * 8 + hq];
    const int tq = b * SEQ + nb * 128 + 16 * w + ql;
    bf16x8 qf[4]; load_q(qkv + (size_t)tq * NQKV + hq * 128, p.in[3], g, qf);
    f32x4 S1[8], SC[9];
#pragma unroll
    for (int kt = 0; kt < 8; ++kt) S1[kt] = (f32x4){0.f, 0.f, 0.f, 0.f};
#pragma unroll
    for (int s = 0; s < 9; ++s) SC[s] = (f32x4){0.f, 0.f, 0.f, 0.f};
    const bool in0 = nb > 0, in2 = nb < 127;
#pragma unroll
    for (int c = 0; c < 3; ++c) { const int kb = nb - 1 + c; if (kb < 0 || kb > 127) continue;
        __syncthreads();
        stage_chunk<true>(lds, TokRow{qkv + (size_t)(b * SEQ + kb * 128) * NQKV + 1024 + kv * 128}, p.in[4], tid);
        __syncthreads();
#pragma unroll
        for (int kt = 0; kt < 8; ++kt) {
            if (c == 1) {
#pragma unroll
                for (int ks = 0; ks < 4; ++ks) { const bf16x8 kf = *(const LAS bf16x8*)(lds + off_b(16 * kt + ql, 4 * ks + g)); S1[kt] = __builtin_amdgcn_mfma_f32_16x16x32_bf16(kf, qf[ks], S1[kt], 0, 0, 0); }
            } else if (c == 0) { if (kt >= w) {
#pragma unroll
                for (int ks = 0; ks < 4; ++ks) { const bf16x8 kf = *(const LAS bf16x8*)(lds + off_b(16 * kt + ql, 4 * ks + g)); SC[7 - kt] = __builtin_amdgcn_mfma_f32_16x16x32_bf16(kf, qf[ks], SC[7 - kt], 0, 0, 0); } }
            } else { if (kt <= w) {
#pragma unroll
                for (int ks = 0; ks < 4; ++ks) { const bf16x8 kf = *(const LAS bf16x8*)(lds + off_b(16 * kt + ql, 4 * ks + g)); SC[8 - kt] = __builtin_amdgcn_mfma_f32_16x16x32_bf16(kf, qf[ks], SC[8 - kt], 0, 0, 0); } }
            }
        }
    }
    const float sink = p.in[5][hq]; float mx = sink; const int qi = 16 * w + ql;
#pragma unroll
    for (int kt = 0; kt < 8; ++kt)
#pragma unroll
        for (int r = 0; r < 4; ++r) { const int rel = 16 * kt + 4 * g + r - qi; const float sv = S1[kt][r] + bias[rel + 128]; S1[kt][r] = sv; mx = fmaxf(mx, sv); }
#pragma unroll
    for (int s = 0; s < 9; ++s) { const bool c0 = s <= 7 - w; const int kt = c0 ? 7 - s : 8 - s; const int cofs = c0 ? -128 : 128; const bool inr = c0 ? in0 : in2;
#pragma unroll
        for (int r = 0; r < 4; ++r) { const int rel = cofs + 16 * kt + 4 * g + r - qi; const bool valid = inr && rel >= -128 && rel <= 128;
            const float sv = valid ? SC[s][r] + bias[valid ? rel + 128 : 0] : -1e30f; SC[s][r] = sv; mx = fmaxf(mx, sv); } }
    mx = fmaxf(mx, __shfl_xor(mx, 16)); mx = fmaxf(mx, __shfl_xor(mx, 32));
    float l = 0.f;
#pragma unroll
    for (int kt = 0; kt < 8; ++kt)
#pragma unroll
        for (int r = 0; r < 4; ++r) { const float pe = __expf(S1[kt][r] - mx); S1[kt][r] = pe; l += pe; }
#pragma unroll
    for (int s = 0; s < 9; ++s)
#pragma unroll
        for (int r = 0; r < 4; ++r) { const float pe = __expf(SC[s][r] - mx); SC[s][r] = pe; l += pe; }
    l += __shfl_xor(l, 16); l += __shfl_xor(l, 32); l += __expf(sink - mx);
    const float inv = 1.0f / l;
    f32x4 O[8];
#pragma unroll
    for (int dt = 0; dt < 8; ++dt) O[dt] = (f32x4){0.f, 0.f, 0.f, 0.f};
    const int q4 = ql >> 2, pp = ql & 3;
    const f32x4 zero4 = (f32x4){0.f, 0.f, 0.f, 0.f};
#pragma unroll
    for (int c = 0; c < 3; ++c) { const int kb = nb - 1 + c; if (kb < 0 || kb > 127) continue;
        __syncthreads();
        stage_chunk<false>(lds, TokRow{qkv + (size_t)(b * SEQ + kb * 128) * NQKV + 1280 + kv * 128}, nullptr, tid);
        __syncthreads();
#pragma unroll
        for (int kk = 0; kk < 4; ++kk) {
            bool a0, a1; f32x4 p0, p1;
            if (c == 1) { a0 = true; a1 = true; p0 = S1[2 * kk]; p1 = S1[2 * kk + 1]; }
            else if (c == 0) { a0 = 2 * kk >= w; a1 = 2 * kk + 1 >= w; p0 = a0 ? SC[7 - 2 * kk] : zero4; p1 = a1 ? SC[6 - 2 * kk] : zero4; }
            else { a0 = 2 * kk <= w; a1 = 2 * kk + 1 <= w; p0 = a0 ? SC[8 - 2 * kk] : zero4; p1 = a1 ? SC[7 - 2 * kk] : zero4; }
            if (a0 || a1) { u32x4 pw; pw.x = pk2(p0[0], p0[1]); pw.y = pk2(p0[2], p0[3]); pw.z = pk2(p1[0], p1[1]); pw.w = pk2(p1[2], p1[3]);
                const bf16x8 pf = __builtin_bit_cast(bf16x8, pw);
#pragma unroll
                for (int dt = 0; dt < 8; ++dt) { const s16x4 lo = tr_read(lds + off_b(32 * kk + 4 * g + q4, 2 * dt + (pp >> 1)) + 8 * (pp & 1)), hi = tr_read(lds + off_b(32 * kk + 16 + 4 * g + q4, 2 * dt + (pp >> 1)) + 8 * (pp & 1));
                    bf16x8 vf; vf[0] = lo[0]; vf[1] = lo[1]; vf[2] = lo[2]; vf[3] = lo[3]; vf[4] = hi[0]; vf[5] = hi[1]; vf[6] = hi[2]; vf[7] = hi[3];
                    O[dt] = __builtin_amdgcn_mfma_f32_16x16x32_bf16(vf, pf, O[dt], 0, 0, 0); } } }
    }
    bf16_t* op = o + (size_t)tq * D + hq * 128 + 4 * g;
#pragma unroll
    for (int dt = 0; dt < 8; ++dt) { u32x2 w2; w2.x = pk2(O[dt][0] * inv, O[dt][1] * inv); w2.y = pk2(O[dt][2] * inv, O[dt][3] * inv); *(u32x2*)(op + 16 * dt) = w2; }
}

__device__ __forceinline__ void attn_nat_item(const Params& p, LAS unsigned char* lds, int item) {
    const int tid = threadIdx.x, lane = tid & 63, w = tid >> 6, g = lane >> 4, ql = lane & 15;
    const int b = item >> 10, r = (item >> 2) & 255, hp = item & 3, hh = w >> 2, h = 2 * hp + hh, jq = w & 3;
    const int rs = min(max(r - 4, 0), 248); const int w0 = jq == 0 ? 0 : (jq == 1 ? 8 : (jq == 2 ? 24 : 32));
    const bf16_t* qkv = (const bf16_t*)(p.ws + WS_QKV); bf16_t* o = (bf16_t*)(p.ws + WS_O);
    LAS float* rpb = (LAS float*)(lds + 32768);
    __syncthreads();
    for (int i = tid; i < 930; i += 512) rpb[i] = p.in[8][(2 * hp) * 465 + i];
    const int qcol = 16 * jq + ql; const int tq = b * SEQ + r * 64 + qcol;
    bf16x8 qf[4]; load_q(qkv + (size_t)tq * NQKV + 1536 + h * 128, p.in[6], g, qf);
    f32x4 S[8][2];
#pragma unroll
    for (int i = 0; i < 8; ++i) { S[i][0] = (f32x4){0.f, 0.f, 0.f, 0.f}; S[i][1] = (f32x4){0.f, 0.f, 0.f, 0.f}; }
#pragma unroll
    for (int i = 0; i < 8; ++i) {
        __syncthreads();
        stage_chunk<true>(lds, NatRow{qkv + (size_t)(b * SEQ + (rs + i) * 64) * NQKV + 2560 + 2 * hp * 128}, p.in[7], tid);
        __syncthreads();
#pragma unroll
        for (int t = 0; t < 2; ++t)
#pragma unroll
            for (int ks = 0; ks < 4; ++ks) { const bf16x8 kf = *(const LAS bf16x8*)(lds + off_b(hh * 64 + w0 + 16 * t + ql, 4 * ks + g)); S[i][t] = __builtin_amdgcn_mfma_f32_16x16x32_bf16(kf, qf[ks], S[i][t], 0, 0, 0); }
    }
    const int cs = min(max(qcol - 8, 0), 48); float mx = -1e30f;
#pragma unroll
    for (int i = 0; i < 8; ++i) { const int dr = rs + i - r + 7;
#pragma unroll
        for (int t = 0; t < 2; ++t)
#pragma unroll
            for (int rr = 0; rr < 4; ++rr) { const int kc = w0 + 16 * t + 4 * g + rr; const bool valid = kc >= cs && kc < cs + 16; const int dc = kc - qcol + 15;
                const float s = valid ? S[i][t][rr] + rpb[hh * 465 + dr * 31 + (valid ? dc : 0)] : -1e30f; S[i][t][rr] = s; mx = fmaxf(mx, s); } }
    mx = fmaxf(mx, __shfl_xor(mx, 16)); mx = fmaxf(mx, __shfl_xor(mx, 32));
    float l = 0.f;
#pragma unroll
    for (int i = 0; i < 8; ++i)
#pragma unroll
        for (int t = 0; t < 2; ++t)
#pragma unroll
            for (int rr = 0; rr < 4; ++rr) { const float pe = __expf(S[i][t][rr] - mx); S[i][t][rr] = pe; l += pe; }
    l += __shfl_xor(l, 16); l += __shfl_xor(l, 32);
    const float inv = 1.0f / l;
    f32x4 O[8];
#pragma unroll
    for (int dt = 0; dt < 8; ++dt) O[dt] = (f32x4){0.f, 0.f, 0.f, 0.f};
    const int q4 = ql >> 2, pp = ql & 3;
#pragma unroll
    for (int i = 0; i < 8; ++i) {
        __syncthreads();
        stage_chunk<false>(lds, NatRow{qkv + (size_t)(b * SEQ + (rs + i) * 64) * NQKV + 3584 + 2 * hp * 128}, nullptr, tid);
        __syncthreads();
        u32x4 pw; pw.x = pk2(S[i][0][0], S[i][0][1]); pw.y = pk2(S[i][0][2], S[i][0][3]); pw.z = pk2(S[i][1][0], S[i][1][1]); pw.w = pk2(S[i][1][2], S[i][1][3]);
        const bf16x8 pf = __builtin_bit_cast(bf16x8, pw); const int rb = hh * 64 + w0;
#pragma unroll
        for (int dt = 0; dt < 8; ++dt) { const s16x4 lo = tr_read(lds + off_b(rb + 4 * g + q4, 2 * dt + (pp >> 1)) + 8 * (pp & 1)), hi = tr_read(lds + off_b(rb + 16 + 4 * g + q4, 2 * dt + (pp >> 1)) + 8 * (pp & 1));
            bf16x8 vf; vf[0] = lo[0]; vf[1] = lo[1]; vf[2] = lo[2]; vf[3] = lo[3]; vf[4] = hi[0]; vf[5] = hi[1]; vf[6] = hi[2]; vf[7] = hi[3];
            O[dt] = __builtin_amdgcn_mfma_f32_16x16x32_bf16(vf, pf, O[dt], 0, 0, 0); }
    }
    bf16_t* op = o + (size_t)tq * D + 1024 + h * 128 + 4 * g;
#pragma unroll
    for (int dt = 0; dt < 8; ++dt) { u32x2 w2; w2.x = pk2(O[dt][0] * inv, O[dt][1] * inv); w2.y = pk2(O[dt][2] * inv, O[dt][3] * inv); *(u32x2*)(op + 16 * dt) = w2; }
}
__device__ __forceinline__ void p2_attn(const Params& p, LAS unsigned char* lds) {
    for (int it = blockIdx.x; it < 2048; it += gridDim.x) attn_window_item(p, lds, it);
    for (int it = blockIdx.x; it < 2048; it += gridDim.x) attn_nat_item(p, lds, it);
}
__device__ __forceinline__ void p2_attn_w(const Params& p, LAS unsigned char* lds) { for (int it = blockIdx.x; it < 2048; it += gridDim.x) attn_window_item(p, lds, it); }
__device__ __forceinline__ void p2_attn_n(const Params& p, LAS unsigned char* lds) { for (int it = blockIdx.x; it < 2048; it += gridDim.x) attn_nat_item(p, lds, it); }

struct UpHook { const bf16_t* gates;
    __device__ __forceinline__ void operator()(f32x4 (&acc)[2][2][4][2], const Unit& u, int wr, int wc, int fr, int fq) const {
        unsigned goff = (unsigned)(u.pm * 256 + wr * 64 + fr) * NGATE + u.pn * 256 + wc * 32 + 8 * fq;
#pragma unroll
        for (int ai = 0; ai < 2; ++ai) {
#pragma unroll
            for (int m = 0; m < 4; ++m) { asm volatile("" : "+v"(goff));
#pragma unroll
                for (int bj = 0; bj < 2; ++bj) { const bf16x8 sa = *(const bf16x8*)(gates + goff + bj * 128), sb = *(const bf16x8*)(gates + goff + 2048 + bj * 128);
#pragma unroll
                    for (int n = 0; n < 2; ++n)
#pragma unroll
                        for (int j = 0; j < 4; ++j) acc[ai][bj][m][n][j] *= bf2f(sa[4 * n + j]) * __builtin_amdgcn_rcpf(fmaxf(bf2f(sb[4 * n + j]), 1e-30f)); }
                goff += 16 * NGATE; }
            goff += 64 * NGATE; }
    } };
struct UpSched {
    pg8::TileOrder o; const bf16_t* A; const bf16_t* Bt;
    __device__ __forceinline__ bool next(int i, Unit& u) const { u.aux = i & 1; return o.tile(i >> 1, u.pm, u.pn); }
    __device__ __forceinline__ const char* a_base(const Unit& u) const { return (const char*)(A + (size_t)u.pm * 256 * D + u.aux * 1024); }
    __device__ __forceinline__ const char* b_base(const Unit& u) const { return (const char*)(Bt + (size_t)u.pn * 256 * D + u.aux * 1024); }
    __device__ __forceinline__ bool keep_acc(const Unit& u) const { return u.aux == 0; }
    __device__ __forceinline__ void a_offs(const Unit&, int, int, int, int, unsigned (&)[2][2]) const {}
};
struct EpiUp { const bf16_t* gates; bf16_t* merged;
    __device__ __forceinline__ void operator()(f32x4 (&acc)[2][2][4][2], const Unit& u, int wr, int wc, int fr, int fq) const {
        if (u.aux == 0) { UpHook{gates}(acc, u, wr, wc, fr, fq); return; }
        unsigned goff = (unsigned)(u.pm * 256 + wr * 64 + fr) * NGATE + u.pn * 256 + wc * 32 + 8 * fq;
        unsigned moff = (unsigned)(u.pm * 256 + wr * 64 + fr) * D + u.pn * 256 + wc * 32 + 8 * fq;
#pragma unroll
        for (int ai = 0; ai < 2; ++ai) {
#pragma unroll
            for (int m = 0; m < 4; ++m) { asm volatile("" : "+v"(goff), "+v"(moff));
#pragma unroll
                for (int bj = 0; bj < 2; ++bj) { const bf16x8 sb = *(const bf16x8*)(gates + goff + 2048 + bj * 128);
                    f32x4 v0 = acc[ai][bj][m][0], v1 = acc[ai][bj][m][1];
#pragma unroll
                    for (int j = 0; j < 4; ++j) { v0[j] *= fmaxf(bf2f(sb[j]), 1e-30f); v1[j] *= fmaxf(bf2f(sb[4 + j]), 1e-30f); }
                    u32x4 w; w.x = pk2(v0[0], v0[1]); w.y = pk2(v0[2], v0[3]); w.z = pk2(v1[0], v1[1]); w.w = pk2(v1[2], v1[3]);
                    *(u32x4*)(merged + moff + bj * 128) = w; }
                goff += 16 * NGATE; moff += 16 * D; }
            goff += 64 * NGATE; moff += 64 * D; }
    } };
__device__ __forceinline__ void p3_up(const Params& p, LAS unsigned char* lds) {
    UpSched S; S.o.init(128, 8, gridDim.x, blockIdx.x); S.A = (const bf16_t*)(p.ws + WS_O); S.Bt = (const bf16_t*)(p.ws + WS_WUP);
    EpiUp E{(const bf16_t*)(p.ws + WS_GATES), (bf16_t*)(p.ws + WS_XB)};
    pg8::gemm_phase<true, false>(lds, S, E, 1024 / 64, D, D);
}

struct EpiOut { const float* x; float* out; bf16_t* hb;
    __device__ __forceinline__ void operator()(f32x4 (&acc)[2][2][4][2], const Unit& u, int wr, int wc, int fr, int fq) const {
        unsigned off = (unsigned)(u.pm * 256 + wr * 64 + fr) * D + u.pn * 256 + wc * 32 + 4 * fq;
#pragma unroll
        for (int ai = 0; ai < 2; ++ai) {
#pragma unroll
            for (int m = 0; m < 4; ++m) { asm volatile("" : "+v"(off));
#pragma unroll
                for (int bj = 0; bj < 2; ++bj)
#pragma unroll
                    for (int n = 0; n < 2; ++n) { const unsigned o2 = off + bj * 128 + 16 * n;
                        const f32x4 hv = *(const f32x4*)(x + o2) + acc[ai][bj][m][n]; *(f32x4*)(out + o2) = hv;
                        u32x2 w2; w2.x = pk2(hv[0], hv[1]); w2.y = pk2(hv[2], hv[3]); *(u32x2*)(hb + o2) = w2; }
                off += 16 * D; }
            off += 64 * D; }
    } };
__device__ __forceinline__ void p4_out(const Params& p, LAS unsigned char* lds) {
    pg8::DenseSched S; S.o.init(128, 8, gridDim.x, blockIdx.x); S.A = (const bf16_t*)(p.ws + WS_XB); S.Bt = (const bf16_t*)(p.ws + WS_WOUT); S.lda = D; S.ldb = D;
    EpiOut E{p.in[0], p.out, (bf16_t*)(p.ws + WS_O)};
    pg8::gemm_phase<false, false>(lds, S, E, D / 64, D, D);
}

__device__ __forceinline__ void p5_router(const Params& p) {
    const int tid = threadIdx.x, lane = tid & 63, wave = tid >> 6; const int gw = blockIdx.x * 8 + wave, NGW = gridDim.x * 8;
    const float* wrt = (const float*)(p.ws + WS_WRT); float* r2 = (float*)(p.ws + WS_R2); int* cnt = (int*)(p.ws + WS_CNT); int* tokl = (int*)(p.ws + WS_TOK); float* wl = (float*)(p.ws + WS_WL);
    const float* brg = p.in[15]; const float* bre = p.in[17];
    for (int tok = gw; tok < T; tok += NGW) {
        const f32x4* hr = (const f32x4*)(p.out + (size_t)tok * D) + lane; f32x4 v[8]; float ss = 0.f;
#pragma unroll
        for (int j = 0; j < 8; ++j) { v[j] = hr[64 * j]; ss += (v[j].x * v[j].x + v[j].y * v[j].y) + (v[j].z * v[j].z + v[j].w * v[j].w); }
        ss = wave_sum(ss); const float rr = rsqrtf(ss * (1.0f / D) + EPS);
        float mylg = 0.f;
#pragma unroll 2
        for (int jj = 0; jj < 36; ++jj) { const f32x4* wr_ = (const f32x4*)(wrt + jj * 2048) + lane; float a = 0.f;
#pragma unroll
            for (int j = 0; j < 8; ++j) { const f32x4 wv = wr_[64 * j]; a += (v[j].x * wv.x + v[j].y * wv.y) + (v[j].z * wv.z + v[j].w * wv.w); }
            a = wave_sum(a) * rr; if (lane == jj) mylg = a; }
        float gl[4];
#pragma unroll
        for (int i = 0; i < 4; ++i) gl[i] = __shfl(mylg, i) + brg[i];
        int gi = 0; float gm = gl[0];
#pragma unroll
        for (int i = 1; i < 4; ++i) if (gl[i] > gm) { gm = gl[i]; gi = i; }
        float den = 0.f;
#pragma unroll
        for (int i = 0; i < 4; ++i) den += __expf(gl[i] - gm);
        const float pg = 1.0f / den;
        float el[8];
#pragma unroll
        for (int i = 0; i < 8; ++i) el[i] = __shfl(mylg, 4 + gi * 8 + i) + bre[gi * 8 + i];
        int e0 = 0; float v0 = el[0];
#pragma unroll
        for (int i = 1; i < 8; ++i) if (el[i] > v0) { v0 = el[i]; e0 = i; }
        int e1 = -1; float v1 = -3.0e38f;
#pragma unroll
        for (int i = 0; i < 8; ++i) if (i != e0 && el[i] > v1) { v1 = el[i]; e1 = i; }
        const float ex = __expf(v1 - v0); const float s0 = 1.0f / (1.0f + ex), s1 = ex * s0;
        if (lane == 0) { r2[tok] = rr;
            const int L0 = gi * 8 + e0, L1 = 32 + gi * 8 + e1;
            const int p0 = atomicAdd(&cnt[L0], 1); tokl[(size_t)L0 * T + p0] = tok; wl[(size_t)L0 * T + p0] = pg * s0;
            const int p1 = atomicAdd(&cnt[L1], 1); tokl[(size_t)L1 * T + p1] = tok; wl[(size_t)L1 * T + p1] = pg * s1; }
    }
}

__device__ __forceinline__ void build_tiles(const Params& p, LAS int* tab) {
    __syncthreads();
    if (threadIdx.x == 0) { const int* cnt = (const int*)(p.ws + WS_CNT); int nt = 0, slot = 0, k1 = 0;
        for (int L = 0; L < 64; ++L) { if (L == 32) k1 = nt; const int c = cnt[L]; for (int r0 = 0; r0 < c; r0 += 256) { tab[4 + nt * 4 + 0] = L; tab[4 + nt * 4 + 1] = r0; tab[4 + nt * 4 + 2] = slot; tab[4 + nt * 4 + 3] = min(256, c - r0); slot += 256; ++nt; } }
        tab[0] = nt; tab[1] = k1; }
    __syncthreads();
}
template <int NPN> struct MoeOrder { int G, c, t_lo, nt_tiles; const LAS int* tab;
    __device__ __forceinline__ bool unit(int i, Unit& u) const { const long L = (long)i * G + c; if (L >= (long)nt_tiles * NPN) return false;
        const int nwg = nt_tiles * NPN; int wgid = (int)L; { const int q = nwg / 8, r = nwg % 8, xcd = wgid % 8, off = wgid / 8; wgid = (xcd < r ? xcd * (q + 1) : r * (q + 1) + (xcd - r) * q) + off; }
        u.pm = t_lo + wgid / NPN; u.pn = wgid % NPN; u.aux = 0; return true; } };
struct GateUpSched { MoeOrder<4> o; const bf16_t* hb; const bf16_t* WguT; const int* tokl;
    __device__ __forceinline__ bool next(int i, Unit& u) const { return o.unit(i, u); }
    __device__ __forceinline__ const char* a_base(const Unit&) const { return (const char*)hb; }
    __device__ __forceinline__ const char* b_base(const Unit& u) const { const int e = o.tab[4 + u.pm * 4] & 31; return (const char*)(WguT + (size_t)(e * 1024 + u.pn * 256) * D); }
    __device__ __forceinline__ bool keep_acc(const Unit&) const { return false; }
    __device__ __forceinline__ void a_offs(const Unit& u, int R0, int C0, int R1, int C1, unsigned (&v)[2][2]) const {
        const int L = o.tab[4 + u.pm * 4], row0 = o.tab[4 + u.pm * 4 + 1], nrows = o.tab[4 + u.pm * 4 + 3]; const int* lst = tokl + (size_t)L * T + row0;
#pragma unroll
        for (int h = 0; h < 2; ++h) { const int r0 = R0 + 128 * h, r1 = R1 + 128 * h; const int t0 = r0 < nrows ? lst[r0] : 0, t1 = r1 < nrows ? lst[r1] : 0;
            v[h][0] = ((unsigned)t0 * D + C0) * 2u; v[h][1] = ((unsigned)t1 * D + C1) * 2u; } }
};
struct EpiGateUp { const LAS int* tab; const int* tokl; const float* r2; bf16_t* he;
    __device__ __forceinline__ void operator()(f32x4 (&acc)[2][2][4][2], const Unit& u, int wr, int wc, int fr, int fq) const {
        const int L = tab[4 + u.pm * 4], row0 = tab[4 + u.pm * 4 + 1], slot = tab[4 + u.pm * 4 + 2], nrows = tab[4 + u.pm * 4 + 3];
#pragma unroll
        for (int ai = 0; ai < 2; ++ai)
#pragma unroll
            for (int m = 0; m < 4; ++m) { const int rr = ai * 128 + wr * 64 + m * 16 + fr; const int tk = rr < nrows ? tokl[(size_t)L * T + row0 + rr] : 0; const float rs = r2[tk];
                u32x4 w; unsigned ww[4];
#pragma unroll
                for (int n = 0; n < 2; ++n) { float hv[4];
#pragma unroll
                    for (int j = 0; j < 4; ++j) { const float gt = acc[ai][0][m][n][j] * rs, up = acc[ai][1][m][n][j] * rs; hv[j] = gt * sigmoidf_(gt) * up; }
                    ww[2 * n] = pk2(hv[0], hv[1]); ww[2 * n + 1] = pk2(hv[2], hv[3]); }
                w.x = ww[0]; w.y = ww[1]; w.z = ww[2]; w.w = ww[3];
                *(u32x4*)(he + (size_t)(slot + rr) * 512 + u.pn * 128 + wc * 32 + 8 * fq) = w; }
    } };
__device__ __forceinline__ void p6_gateup(const Params& p, LAS unsigned char* lds) {
    LAS int* tab = (LAS int*)(lds + TAB_OFF); build_tiles(p, tab);
    GateUpSched S; S.o.G = gridDim.x; S.o.c = blockIdx.x; S.o.t_lo = 0; S.o.nt_tiles = tab[0]; S.o.tab = tab;
    S.hb = (const bf16_t*)(p.ws + WS_O); S.WguT = (const bf16_t*)(p.ws + WS_WGU); S.tokl = (const int*)(p.ws + WS_TOK);
    EpiGateUp E{tab, (const int*)(p.ws + WS_TOK), (const float*)(p.ws + WS_R2), (bf16_t*)(p.ws + WS_HE)};
    pg8::gemm_phase<true, true>(lds, S, E, D / 64, D, D);
}
struct DownSched { MoeOrder<8> o; const bf16_t* he; const bf16_t* WdT;
    __device__ __forceinline__ bool next(int i, Unit& u) const { return o.unit(i, u); }
    __device__ __forceinline__ const char* a_base(const Unit& u) const { return (const char*)(he + (size_t)o.tab[4 + u.pm * 4 + 2] * 512); }
    __device__ __forceinline__ const char* b_base(const Unit& u) const { const int e = o.tab[4 + u.pm * 4] & 31; return (const char*)(WdT + (size_t)(e * 2048 + u.pn * 256) * 512); }
    __device__ __forceinline__ bool keep_acc(const Unit&) const { return false; }
    __device__ __forceinline__ void a_offs(const Unit&, int, int, int, int, unsigned (&)[2][2]) const {}
};
struct EpiDown { const LAS int* tab; const int* tokl; const float* wl; float* out;
    __device__ __forceinline__ void operator()(f32x4 (&acc)[2][2][4][2], const Unit& u, int wr, int wc, int fr, int fq) const {
        const int L = tab[4 + u.pm * 4], row0 = tab[4 + u.pm * 4 + 1], nrows = tab[4 + u.pm * 4 + 3];
#pragma unroll
        for (int ai = 0; ai < 2; ++ai)
#pragma unroll
            for (int m = 0; m < 4; ++m) { const int rr = ai * 128 + wr * 64 + m * 16 + fr;
                if (rr < nrows) { const int tk = tokl[(size_t)L * T + row0 + rr]; const float wg = wl[(size_t)L * T + row0 + rr];
#pragma unroll
                    for (int bj = 0; bj < 2; ++bj)
#pragma unroll
                        for (int n = 0; n < 2; ++n) { float* op = out + (size_t)tk * D + u.pn * 256 + bj * 128 + wc * 32 + 16 * n + 4 * fq; *(f32x4*)op = *(const f32x4*)op + acc[ai][bj][m][n] * wg; } } }
    } };
__device__ __forceinline__ void p7_down(const Params& p, LAS unsigned char* lds, int k) {
    LAS int* tab = (LAS int*)(lds + TAB_OFF); build_tiles(p, tab);
    DownSched S; S.o.G = gridDim.x; S.o.c = blockIdx.x; S.o.t_lo = k ? tab[1] : 0; S.o.nt_tiles = k ? tab[0] - tab[1] : tab[1]; S.o.tab = tab;
    S.he = (const bf16_t*)(p.ws + WS_HE); S.WdT = (const bf16_t*)(p.ws + WS_WD);
    EpiDown E{tab, (const int*)(p.ws + WS_TOK), (const float*)(p.ws + WS_WL), p.out};
    pg8::gemm_phase<false, false>(lds, S, E, 512 / 64, 512, 512);
}

struct GatherRow { const bf16_t* base; const int* list; int nrows; __device__ __forceinline__ unsigned operator()(int r) const { const int t = r < nrows ? list[r] : 0; return (unsigned)t * (unsigned)D; } };

__device__ __forceinline__ void p6_gateup_s(const Params& p, LAS unsigned char* lds) {
    const int tid = threadIdx.x, lane = tid & 63, wid = tid >> 6, wr = wid >> 2, wc = wid & 3, fr = lane & 15, fq = lane >> 4;
    LAS int* tab = (LAS int*)(lds + TAB_OFF); build_tiles(p, tab);
    const int nt = tab[0];
    const bf16_t* hb = (const bf16_t*)(p.ws + WS_O); const bf16_t* WguT = (const bf16_t*)(p.ws + WS_WGU); bf16_t* he = (bf16_t*)(p.ws + WS_HE);
    const int* tokl = (const int*)(p.ws + WS_TOK); const float* r2 = (const float*)(p.ws + WS_R2);
    for (int ui = blockIdx.x; ui < nt * 4; ui += gridDim.x) {
        const int ti = ui >> 2; Unit u; u.pn = ui & 3; u.pm = ti; u.aux = 0;
        const int L = tab[4 + ti * 4], row0 = tab[4 + ti * 4 + 1], slot = tab[4 + ti * 4 + 2], nrows = tab[4 + ti * 4 + 3], e = L & 31;
        f32x4 acc[2][2][4][2];
        GatherRow ar{hb, tokl + (size_t)L * T + row0, nrows}; DenseRow br{WguT + (size_t)(e * 1024 + u.pn * 256) * D, D};
        sgemm_unit<true, true>(lds, ar, br, 0, D, acc, wr, wc, fr, fq, tid);
#pragma unroll
        for (int ai = 0; ai < 2; ++ai)
#pragma unroll
            for (int m = 0; m < 4; ++m) { const int rr = ai * 128 + wr * 64 + m * 16 + fr; const int tk = rr < nrows ? tokl[(size_t)L * T + row0 + rr] : 0; const float rs = r2[tk];
                u32x4 w; unsigned ww[4];
#pragma unroll
                for (int n = 0; n < 2; ++n) { float hv[4];
#pragma unroll
                    for (int j = 0; j < 4; ++j) { const float gt = acc[ai][0][m][n][j] * rs, up = acc[ai][1][m][n][j] * rs; hv[j] = gt * sigmoidf_(gt) * up; }
                    ww[2 * n] = pk2(hv[0], hv[1]); ww[2 * n + 1] = pk2(hv[2], hv[3]); }
                w.x = ww[0]; w.y = ww[1]; w.z = ww[2]; w.w = ww[3];
                *(u32x4*)(he + (size_t)(slot + rr) * 512 + u.pn * 128 + wc * 32 + 8 * fq) = w; }
    }
}
__device__ __forceinline__ void p7_down_s(const Params& p, LAS unsigned char* lds, int k) {
    const int tid = threadIdx.x, lane = tid & 63, wid = tid >> 6, wr = wid >> 2, wc = wid & 3, fr = lane & 15, fq = lane >> 4;
    LAS int* tab = (LAS int*)(lds + TAB_OFF); build_tiles(p, tab);
    const int t_lo = k ? tab[1] : 0, t_hi = k ? tab[0] : tab[1];
    const bf16_t* he = (const bf16_t*)(p.ws + WS_HE); const bf16_t* WdT = (const bf16_t*)(p.ws + WS_WD);
    const int* tokl = (const int*)(p.ws + WS_TOK); const float* wl = (const float*)(p.ws + WS_WL);
    for (int ui = blockIdx.x; ui < (t_hi - t_lo) * 8; ui += gridDim.x) {
        const int ti = t_lo + (ui >> 3); Unit u; u.pn = ui & 7; u.pm = ti; u.aux = 0;
        const int L = tab[4 + ti * 4], row0 = tab[4 + ti * 4 + 1], slot = tab[4 + ti * 4 + 2], nrows = tab[4 + ti * 4 + 3], e = L & 31;
        f32x4 acc[2][2][4][2];
        DenseRow ar{he + (size_t)slot * 512, 512}, br{WdT + (size_t)(e * 2048 + u.pn * 256) * 512, 512};
        sgemm_unit<false, true>(lds, ar, br, 0, 512, acc, wr, wc, fr, fq, tid);
#pragma unroll
        for (int ai = 0; ai < 2; ++ai)
#pragma unroll
            for (int m = 0; m < 4; ++m) { const int rr = ai * 128 + wr * 64 + m * 16 + fr;
                if (rr < nrows) { const int tk = tokl[(size_t)L * T + row0 + rr]; const float wg = wl[(size_t)L * T + row0 + rr];
#pragma unroll
                    for (int bj = 0; bj < 2; ++bj)
#pragma unroll
                        for (int n = 0; n < 2; ++n) { float* op = p.out + (size_t)tk * D + u.pn * 256 + bj * 128 + wc * 32 + 16 * n + 4 * fq; *(f32x4*)op = *(const f32x4*)op + acc[ai][bj][m][n] * wg; } } }
    }
}

__device__ __forceinline__ void p3_up_s(const Params& p, LAS unsigned char* lds) {
    const int tid = threadIdx.x, lane = tid & 63, wid = tid >> 6, wr = wid >> 2, wc = wid & 3, fr = lane & 15, fq = lane >> 4;
    const bf16_t* o = (const bf16_t*)(p.ws + WS_O); const bf16_t* WupT = (const bf16_t*)(p.ws + WS_WUP); const bf16_t* gates = (const bf16_t*)(p.ws + WS_GATES); bf16_t* merged = (bf16_t*)(p.ws + WS_XB);
    for (int ui = blockIdx.x; ui < 128 * 8; ui += gridDim.x) {
        Unit u; u.pn = ui / 128; u.pm = ui % 128; u.aux = 0;
        f32x4 acc[2][2][4][2];
        DenseRow ar{o + (size_t)u.pm * 256 * D, D}, br{WupT + (size_t)u.pn * 256 * D, D};
        sgemm_unit<true, true>(lds, ar, br, 0, 1024, acc, wr, wc, fr, fq, tid);
        UpHook{gates}(acc, u, wr, wc, fr, fq);
        sgemm_unit<true, false>(lds, ar, br, 1024, D, acc, wr, wc, fr, fq, tid);
        unsigned goff = (unsigned)(u.pm * 256 + wr * 64 + fr) * NGATE + u.pn * 256 + wc * 32 + 8 * fq;
        unsigned moff = (unsigned)(u.pm * 256 + wr * 64 + fr) * D + u.pn * 256 + wc * 32 + 8 * fq;
#pragma unroll
        for (int ai = 0; ai < 2; ++ai) {
#pragma unroll
            for (int m = 0; m < 4; ++m) { asm volatile("" : "+v"(goff), "+v"(moff));
#pragma unroll
                for (int bj = 0; bj < 2; ++bj) { const bf16x8 sb = *(const bf16x8*)(gates + goff + 2048 + bj * 128);
                    f32x4 v0 = acc[ai][bj][m][0], v1 = acc[ai][bj][m][1];
#pragma unroll
                    for (int j = 0; j < 4; ++j) { v0[j] *= fmaxf(bf2f(sb[j]), 1e-30f); v1[j] *= fmaxf(bf2f(sb[4 + j]), 1e-30f); }
                    u32x4 w; w.x = pk2(v0[0], v0[1]); w.y = pk2(v0[2], v0[3]); w.z = pk2(v1[0], v1[1]); w.w = pk2(v1[2], v1[3]);
                    *(u32x4*)(merged + moff + bj * 128) = w; }
                goff += 16 * NGATE; moff += 16 * D; }
            goff += 64 * NGATE; moff += 64 * D; }
    }
}

namespace cg = cooperative_groups;
__global__ void __launch_bounds__(512, 2) fwd_megakernel(Params p) {
    extern __shared__ __attribute__((aligned(16))) unsigned char lds_raw[];
    LAS unsigned char* lds = (LAS unsigned char*)lds_raw;
    cg::grid_group grid = cg::this_grid();
    p0_prep(p, lds);            grid.sync();
    p1_inproj(p, lds);          grid.sync();
    p2_attn(p, lds);            grid.sync();
    p_moe_prep(p, lds);
#ifdef SIMPLE_UP
    p3_up_s(p, lds);              grid.sync();
#else
    p3_up(p, lds);              grid.sync();
#endif
    p4_out(p, lds);             grid.sync();
    p5_router(p);               grid.sync();
#ifdef SIMPLE_MOE
    p6_gateup_s(p, lds);          grid.sync();
    p7_down_s(p, lds, 0);         grid.sync();
    p7_down_s(p, lds, 1);
#else
    p6_gateup(p, lds);          grid.sync();
    p7_down(p, lds, 0);         grid.sync();
    p7_down(p, lds, 1);
#endif
}

extern "C" void kernel_launch(void* const* d_in, const int* in_sizes, int n_in, void* d_out, int out_size, void* d_ws, size_t ws_size, hipStream_t stream) {
    static int grid_blocks = 0;
    if (!grid_blocks) {
        if (n_in != 21 || out_size != T * D || ws_size < WS_END) { fprintf(stderr, "kernel_launch: unexpected problem (n_in %d out %d ws %zu)\n", n_in, out_size, ws_size); grid_blocks = -1; return; }
        if (hipFuncSetAttribute((const void*)fwd_megakernel, hipFuncAttributeMaxDynamicSharedMemorySize, LDS_BYTES) != hipSuccess) { fprintf(stderr, "kernel_launch: hipFuncSetAttribute failed\n"); grid_blocks = -1; return; }
        int dev = 0, cus = 0, per_cu = 0;
        hipGetDevice(&dev); hipDeviceGetAttribute(&cus, hipDeviceAttributeMultiprocessorCount, dev);
        hipOccupancyMaxActiveBlocksPerMultiprocessor(&per_cu, (const void*)fwd_megakernel, 512, LDS_BYTES);
        if (per_cu < 1 || cus < 1) { fprintf(stderr, "kernel_launch: occupancy query gave %d blocks/CU on %d CUs\n", per_cu, cus); grid_blocks = -1; return; }
        grid_blocks = cus;
    }
    if (grid_blocks < 0) return;
    Params p{};
    for (int i = 0; i < 21; ++i) p.in[i] = (const float*)d_in[i];
    p.out = (float*)d_out; p.ws = (unsigned char*)d_ws;
    void* args[] = {&p};
    hipError_t e = hipLaunchCooperativeKernel((const void*)fwd_megakernel, dim3(grid_blocks), dim3(512), args, LDS_BYTES, stream);
    if (e != hipSuccess) fprintf(stderr, "cooperative launch failed: %s (grid %d)\n", hipGetErrorString(e), grid_blocks);
}
```

```cpp
#include <hip/hip_runtime.h>
#include <hip/hip_cooperative_groups.h>
#include <cstdio>
#include <cstdint>

#define LAS __attribute__((address_space(3)))
typedef unsigned short bf16_t;
typedef short bf16x8 __attribute__((ext_vector_type(8)));
typedef short s16x4 __attribute__((ext_vector_type(4)));
typedef float f32x4 __attribute__((ext_vector_type(4)));
typedef unsigned u32x4 __attribute__((ext_vector_type(4)));
typedef unsigned u32x2 __attribute__((ext_vector_type(2)));
typedef short v4i16_t __attribute__((ext_vector_type(4)));

namespace cfg {
constexpr int T = 32768, D = 2048, SEQ = 16384;
constexpr int NQKV = 4608, NGATE = 4096, NIN = 8704;
constexpr size_t MiB = 1ull << 20;
constexpr size_t WS_XB = 0, WS_QKV = 128 * MiB, WS_GATES = 416 * MiB, WS_O = 672 * MiB, WS_WIN = 800 * MiB, WS_WUP = 834 * MiB, WS_WOUT = 842 * MiB, WS_MISC = 850 * MiB;
constexpr size_t WS_WGU = WS_QKV, WS_WD = WS_QKV + 128 * MiB, WS_HE = WS_QKV + 192 * MiB;
constexpr size_t WS_R1 = WS_MISC, WS_R2 = WS_R1 + (size_t)T * 4, WS_WRT = WS_R2 + (size_t)T * 4, WS_CNT = WS_WRT + 512 * 1024, WS_TOK = WS_CNT + 4096,
                 WS_WL = WS_TOK + 64ull * T * 4, WS_END = WS_WL + 64ull * T * 4;
constexpr size_t WS_BAR = WS_END + 4096;
constexpr int LDS_BYTES = 140 * 1024;
constexpr int XBST_OFF = LDS_BYTES - 16;
constexpr int TAB_OFF = 132 * 1024;
constexpr float EPS = 1e-6f;
}
using namespace cfg;

struct Params { const float* in[21]; float* out; unsigned char* ws; };

__device__ __forceinline__ float bf2f(short s) { return __uint_as_float(((unsigned)(unsigned short)s) << 16); }
typedef float f32x2 __attribute__((ext_vector_type(2)));
typedef __bf16 bf16x2_t __attribute__((ext_vector_type(2)));
__device__ __forceinline__ unsigned pk2(float lo, float hi) { const f32x2 v = {lo, hi}; return __builtin_bit_cast(unsigned, __builtin_convertvector(v, bf16x2_t)); }
__device__ __forceinline__ float wave_sum(float v) {
#pragma unroll
    for (int o = 1; o < 64; o <<= 1) v += __shfl_xor(v, o);
    return v;
}
__device__ __forceinline__ float sigmoidf_(float v) { return 1.0f / (1.0f + __expf(-v)); }
__device__ __forceinline__ unsigned off_b(unsigned row, unsigned ch) { return 256u * row + 16u * (ch ^ (((row & 3) << 2) | ((row >> 2) & 3))); }
__device__ __forceinline__ s16x4 tr_read(LAS unsigned char* p) { return __builtin_bit_cast(s16x4, __builtin_amdgcn_ds_read_tr16_b64_v4i16((LAS v4i16_t*)p)); }
__host__ __device__ __forceinline__ int perm32(int rho) { const int n = rho >> 4, i = rho & 15; return 8 * (i >> 2) + 4 * n + (i & 3); }
__device__ __forceinline__ int t5_bucket(int rel) {
    const int n = rel < 0 ? -rel : rel; const int ret = rel > 0 ? 16 : 0; int b;
    if (n < 8) b = n; else if (n < 12) b = 8; else if (n < 16) b = 9; else if (n < 23) b = 10; else if (n < 32) b = 11; else if (n < 46) b = 12; else if (n < 64) b = 13; else if (n < 91) b = 14; else b = 15;
    return ret + b;
}

__device__ __forceinline__ void transpose_item(const float* __restrict__ W, int ldw, int k0, int n0, bf16_t* __restrict__ WT, int ldt, int drow0, int dk0, const float* __restrict__ scale, LAS float* scr, int lane) {
#pragma unroll 8
    for (int i = 0; i < 32; ++i) { const int kk = 2 * i + (lane >> 5); float v = W[(size_t)(k0 + kk) * ldw + n0 + (lane & 31)]; if (scale) v *= scale[k0 + kk]; scr[kk * 33 + (lane & 31)] = v; }
    asm volatile("s_waitcnt lgkmcnt(0)" ::: "memory");
    const int c = lane & 7;
#pragma unroll
    for (int j = 0; j < 4; ++j) { const int n = (lane >> 3) + 8 * j; const LAS float* s = scr + (8 * c) * 33 + n;
        u32x4 o; o.x = pk2(s[0 * 33], s[1 * 33]); o.y = pk2(s[2 * 33], s[3 * 33]); o.z = pk2(s[4 * 33], s[5 * 33]); o.w = pk2(s[6 * 33], s[7 * 33]);
        *(u32x4*)(WT + (size_t)(drow0 + n) * ldt + dk0 + k0 + 8 * c) = o; }
    asm volatile("s_waitcnt lgkmcnt(0)" ::: "memory");
}

__device__ __forceinline__ void p0_prep(const Params& p, LAS unsigned char* lds) {
    const int tid = threadIdx.x, lane = tid & 63, wave = tid >> 6;
    const int gw = blockIdx.x * 8 + wave, NGW = gridDim.x * 8;
    LAS float* scr = (LAS float*)(lds + wave * 8448);
    const float* x = p.in[0]; const float* g1 = p.in[1]; const float* w_in = p.in[2];
    bf16_t* xb = (bf16_t*)(p.ws + WS_XB); float* r1 = (float*)(p.ws + WS_R1);
    bf16_t* WinT = (bf16_t*)(p.ws + WS_WIN); bf16_t* WupT = (bf16_t*)(p.ws + WS_WUP); bf16_t* WoutT = (bf16_t*)(p.ws + WS_WOUT);
    constexpr int I_WIN = 32 * 272, I_UP = 16 * 64, I_OUT = 32 * 64, NITEMS = I_WIN + 2 * I_UP + I_OUT;
    for (int it = gw; it < NITEMS; it += NGW) {
        int r = it;
        if (r < I_WIN) { const int kb = r / 272, nb = r % 272; transpose_item(w_in, NIN, kb * 64, nb * 32, WinT, 2048, nb * 32, 0, g1, scr, lane); continue; } r -= I_WIN;
        if (r < I_UP) { const int kb = r / 64, nb = r % 64; transpose_item(p.in[9], 2048, kb * 64, nb * 32, WupT, 2048, nb * 32, 0, nullptr, scr, lane); continue; } r -= I_UP;
        if (r < I_UP) { const int kb = r / 64, nb = r % 64; transpose_item(p.in[10], 2048, kb * 64, nb * 32, WupT, 2048, nb * 32, 1024, nullptr, scr, lane); continue; } r -= I_UP;
        { const int kb = r / 64, nb = r % 64; transpose_item(p.in[11], 2048, kb * 64, nb * 32, WoutT, 2048, nb * 32, 0, nullptr, scr, lane); }
    }
    { float* wrt = (float*)(p.ws + WS_WRT); const float* g2 = p.in[13]; const float* wrg = p.in[14]; const float* wre = p.in[16];
      for (int i = blockIdx.x * 512 + tid; i < 48 * 2048; i += gridDim.x * 512) { const int row = i >> 11, k = i & 2047, t = row >> 4, r = row & 15; float w;
          if (t == 0) w = wre[k * 32 + (r >> 2) * 8 + (r & 3)]; else if (t == 1) w = wre[k * 32 + (r >> 2) * 8 + 4 + (r & 3)]; else w = (r & 3) == 0 ? wrg[k * 4 + (r >> 2)] : 0.f;
          wrt[i] = g2[k] * w; } }
    if (blockIdx.x == 0 && tid < 64) ((int*)(p.ws + WS_CNT))[tid] = 0;
    for (int row = gw; row < T; row += NGW) {
        const f32x4* xr = (const f32x4*)(x + (size_t)row * D) + lane; f32x4 v[8]; float ss = 0.f;
#pragma unroll
        for (int j = 0; j < 8; ++j) { v[j] = xr[64 * j]; ss += (v[j].x * v[j].x + v[j].y * v[j].y) + (v[j].z * v[j].z + v[j].w * v[j].w); }
        ss = wave_sum(ss);
        if (lane == 0) r1[row] = rsqrtf(ss * (1.0f / D) + EPS);
        u32x2* o = (u32x2*)(xb + (size_t)row * D) + lane;
#pragma unroll
        for (int j = 0; j < 8; ++j) { u32x2 w; w.x = pk2(v[j].x, v[j].y); w.y = pk2(v[j].z, v[j].w); o[64 * j] = w; }
    }
}

__device__ __forceinline__ void p_moe_prep(const Params& p, LAS unsigned char* lds) {
    const int tid = threadIdx.x, lane = tid & 63, wave = tid >> 6;
    const int gw = blockIdx.x * 8 + wave, NGW = gridDim.x * 8;
    LAS float* scr = (LAS float*)(lds + wave * 8448);
    const float* g2 = p.in[13];
    bf16_t* WguT = (bf16_t*)(p.ws + WS_WGU); bf16_t* WdT = (bf16_t*)(p.ws + WS_WD);
    constexpr int I_G = 32 * 32 * 16;
    constexpr int I_D = 32 * 8 * 64;
    for (int it = gw; it < 2 * I_G + I_D; it += NGW) {
        int r = it;
        if (r < 2 * I_G) { const int which = r >= I_G; if (which) r -= I_G; const int e = r / 512, rr = r % 512, kb = rr / 16, nb = rr % 16;
            const float* W = p.in[which ? 19 : 18] + (size_t)e * 2048 * 512; const int n0 = nb * 32;
            transpose_item(W, 512, kb * 64, n0, WguT, 2048, e * 1024 + (n0 >> 7) * 256 + which * 128 + (n0 & 127), 0, g2, scr, lane); continue; }
        r -= 2 * I_G;
        { const int e = r / 512, rr = r % 512, kb = rr / 64, nb = rr % 64; const float* W = p.in[20] + (size_t)e * 512 * 2048;
          transpose_item(W, 2048, kb * 64, nb * 32, WdT, 512, e * 2048 + nb * 32, 0, nullptr, scr, lane); }
    }
}

struct Unit { int pm, pn, aux; };
template <bool PERM, bool ZERO, class ARow, class BRow>
__device__ __forceinline__ void sgemm_unit(LAS unsigned char* lds, const ARow& arow, const BRow& brow, int kbeg, int kend, f32x4 (&acc)[2][2][4][2], int wr, int wc, int fr, int fq, int tid) {
    if (ZERO) {
#pragma unroll
    for (int a = 0; a < 2; ++a)
#pragma unroll
        for (int b = 0; b < 2; ++b)
#pragma unroll
            for (int m = 0; m < 4; ++m)
#pragma unroll
                for (int n = 0; n < 2; ++n) acc[a][b][m][n] = (f32x4){0.f, 0.f, 0.f, 0.f};
    }
    unsigned ao[4], bo[4]; const bf16_t* const abase = arow.base; const bf16_t* const bbase = brow.base;
#pragma unroll
    for (int i = 0; i < 4; ++i) { const int pz = tid + 512 * i, row = pz >> 3, c8 = pz & 7; ao[i] = arow(row) + c8 * 8; const int Rb = PERM ? ((row & ~31) + perm32(row & 31)) : row; bo[i] = brow(Rb) + c8 * 8; }
    for (int k0 = kbeg; k0 < kend; k0 += 64) {
        bf16x8 ra[4], rb[4];
#pragma unroll
        for (int i = 0; i < 4; ++i) { ra[i] = *(const bf16x8*)(abase + ao[i] + k0); rb[i] = *(const bf16x8*)(bbase + bo[i] + k0); }
        __syncthreads();
#pragma unroll
        for (int i = 0; i < 4; ++i) { const int pz = tid + 512 * i, row = pz >> 3, c8 = pz & 7; *(LAS bf16x8*)(lds + row * 144 + c8 * 16) = ra[i]; *(LAS bf16x8*)(lds + 36864 + row * 144 + c8 * 16) = rb[i]; }
        __syncthreads();
#pragma unroll
        for (int ai = 0; ai < 2; ++ai) {
            bf16x8 At[4][2];
#pragma unroll
            for (int m = 0; m < 4; ++m)
#pragma unroll
                for (int k = 0; k < 2; ++k) At[m][k] = *(const LAS bf16x8*)(lds + (ai * 128 + wr * 64 + m * 16 + fr) * 144 + (k * 32 + fq * 8) * 2);
#pragma unroll
            for (int bj = 0; bj < 2; ++bj) {
                bf16x8 Bf[2][2];
#pragma unroll
                for (int n = 0; n < 2; ++n)
#pragma unroll
                    for (int k = 0; k < 2; ++k) Bf[n][k] = *(const LAS bf16x8*)(lds + 36864 + (bj * 128 + wc * 32 + n * 16 + fr) * 144 + (k * 32 + fq * 8) * 2);
#pragma unroll
                for (int m = 0; m < 4; ++m)
#pragma unroll
                    for (int n = 0; n < 2; ++n)
#pragma unroll
                        for (int k = 0; k < 2; ++k) acc[ai][bj][m][n] = __builtin_amdgcn_mfma_f32_16x16x32_bf16(Bf[n][k], At[m][k], acc[ai][bj][m][n], 0, 0, 0);
            }
        }
    }
}
struct DenseRow { const bf16_t* base; int ld; __device__ __forceinline__ unsigned operator()(int r) const { return (unsigned)(r * ld); } };

namespace pg8 {
constexpr int BM = 256, BK = 64, HALF = 128, HTB = HALF * BK * 2, STAGE_BYTES = 8 * HTB;
__device__ __forceinline__ int lds_byte(int r, int c) { const int st = (r >> 4) * 2 + (c >> 5), rr = r & 15, cc = c & 31, ob = rr * 64 + cc * 2; return st * 1024 + (ob ^ (((ob >> 9) & 1) << 5)); }
__device__ __forceinline__ void stage_rc(int b, int& R, int& C) { const int st = b / 1024, sb = b % 1024, swz = sb ^ (((sb >> 9) & 1) << 5); R = (st >> 1) * 16 + swz / 64; C = (st & 1) * 32 + (swz % 64) / 2; }

template <bool PERM, bool GATHER, class Sched, class Epi>
__device__ __forceinline__ void gemm_phase(LAS unsigned char* lds, const Sched& S, const Epi& E, const int nt, const int lda, const int ldb) {
    int tid_ = threadIdx.x; asm volatile("" : "+v"(tid_));
    const int tid = tid_, wid = __builtin_amdgcn_readfirstlane(tid >> 6), lane = tid & 63, wr = wid >> 2, wc = wid & 3, fr = lane & 15, fq = lane >> 4;
    int R0, C0, R1, C1; stage_rc(tid * 16, R0, C0); stage_rc(tid * 16 + 8192, R1, C1);
    unsigned voffB[2], voffA[2][2];
    { const int Rb0 = PERM ? ((R0 & ~31) + perm32(R0 & 31)) : R0, Rb1 = PERM ? ((R1 & ~31) + perm32(R1 & 31)) : R1;
      voffB[0] = (unsigned)(Rb0 * ldb + C0) * 2u; voffB[1] = (unsigned)(Rb1 * ldb + C1) * 2u; }
    const size_t kstep = (size_t)(BK * 2);
    const size_t hstepB = (size_t)HALF * ldb * 2;
    const unsigned ldsw = (unsigned)wid * 1024u;
    const int aoff = lds_byte(wr * 64 + fr, fq * 8), boff = lds_byte(wc * 32 + fr, fq * 8);
#define PG8_SA(b, h) (((b) * 2 + (h)) * HTB)
#define PG8_SB(b, h) ((4 + (b) * 2 + (h)) * HTB)
#define PG8_STAGE_B(bufoff, gbase) do { _Pragma("unroll") for (int _i = 0; _i < 2; ++_i) \
        __builtin_amdgcn_global_load_lds((const unsigned*)((const char*)(gbase) + voffB[_i]), (LAS unsigned*)(lds + (bufoff) + ldsw + _i * 8192), 16, 0, 0); } while (0)
#define PG8_STAGE_A(bufoff, gbase, h) do { _Pragma("unroll") for (int _i = 0; _i < 2; ++_i) \
        __builtin_amdgcn_global_load_lds((const unsigned*)((const char*)(gbase) + voffA[h][_i]), (LAS unsigned*)(lds + (bufoff) + ldsw + _i * 8192), 16, 0, 0); } while (0)
#define PG8_LDA(dst, b, h) do { _Pragma("unroll") for (int m = 0; m < 4; ++m) _Pragma("unroll") for (int k = 0; k < 2; ++k) dst[m][k] = *(const LAS bf16x8*)(lds + PG8_SA(b, h) + aoff + m * 2048 + k * 1024); } while (0)
#define PG8_LDB(dst, b, h) do { _Pragma("unroll") for (int n = 0; n < 2; ++n) _Pragma("unroll") for (int k = 0; k < 2; ++k) dst[n][k] = *(const LAS bf16x8*)(lds + PG8_SB(b, h) + boff + n * 2048 + k * 1024); } while (0)
#define PG8_MMA(ai, bj, At, Bt) do { __builtin_amdgcn_s_setprio(1); _Pragma("unroll") for (int m = 0; m < 4; ++m) _Pragma("unroll") for (int n = 0; n < 2; ++n) _Pragma("unroll") for (int k = 0; k < 2; ++k) \
        acc[ai][bj][m][n] = __builtin_amdgcn_mfma_f32_16x16x32_bf16(Bt[n][k], At[m][k], acc[ai][bj][m][n], 0, 0, 0); __builtin_amdgcn_s_setprio(0); } while (0)
#define PG8_WAIT_V(n) asm volatile("s_waitcnt vmcnt(" #n ")" ::: "memory")
#define PG8_WAIT_L(n) asm volatile("s_waitcnt lgkmcnt(" #n ")" ::: "memory")
#define PG8_BAR __builtin_amdgcn_s_barrier()
#define PG8_SCHED __builtin_amdgcn_sched_barrier(0)
    Unit cur, nxt; int ui = 0;
    __syncthreads();
    if (!S.next(0, cur)) return;
    if (GATHER) S.a_offs(cur, R0, C0, R1, C1, voffA);
    else { voffA[0][0] = (unsigned)(R0 * lda + C0) * 2u; voffA[0][1] = (unsigned)(R1 * lda + C1) * 2u; voffA[1][0] = voffA[0][0] + (unsigned)(HALF * lda * 2); voffA[1][1] = voffA[0][1] + (unsigned)(HALF * lda * 2); }
    f32x4 acc[2][2][4][2];
#pragma unroll
    for (int a = 0; a < 2; ++a)
#pragma unroll
        for (int b = 0; b < 2; ++b)
#pragma unroll
            for (int m = 0; m < 4; ++m)
#pragma unroll
                for (int n = 0; n < 2; ++n) acc[a][b][m][n] = (f32x4){0.f, 0.f, 0.f, 0.f};
    bf16x8 At[4][2], B0[2][2], B1[2][2];
    const char* cA = S.a_base(cur); const char* cB = S.b_base(cur);
    PG8_STAGE_B(PG8_SB(0, 0), cB); PG8_STAGE_B(PG8_SB(0, 1), cB + hstepB); PG8_STAGE_A(PG8_SA(0, 0), cA, 0); PG8_STAGE_A(PG8_SA(0, 1), cA, 1);
    if (wr == 1) PG8_BAR;
    PG8_WAIT_V(2); PG8_BAR;
    PG8_STAGE_B(PG8_SB(1, 0), cB + kstep); PG8_STAGE_A(PG8_SA(1, 0), cA + kstep, 0); PG8_STAGE_B(PG8_SB(1, 1), cB + hstepB + kstep);
    PG8_WAIT_V(6); PG8_BAR;
    for (;;) {
        const bool has_next = S.next(ui + 1, nxt);
        const char* nA = has_next ? S.a_base(nxt) : cA; const char* nB = has_next ? S.b_base(nxt) : cB;
        unsigned vn[2][2];
        if (GATHER) { if (has_next) S.a_offs(nxt, R0, C0, R1, C1, vn); else { vn[0][0] = voffA[0][0]; vn[0][1] = voffA[0][1]; vn[1][0] = voffA[1][0]; vn[1][1] = voffA[1][1]; } }
        for (int t = 0; t < nt; t += 2) {
            const bool last = (t == nt - 2);
            const char* a1 = cA + (size_t)(t + 1) * kstep;
            const char* a2 = last ? nA : cA + (size_t)(t + 2) * kstep; const char* b2 = last ? nB : cB + (size_t)(t + 2) * kstep;
            const char* a3 = a2 + kstep; const char* b3 = b2 + kstep;
            PG8_LDB(B0, 0, 0); PG8_LDB(B1, 0, 1); PG8_SCHED; PG8_LDA(At, 0, 0); PG8_STAGE_A(PG8_SA(1, 1), a1, 1);
            if (GATHER) { if (last) { voffA[0][0] = vn[0][0]; voffA[0][1] = vn[0][1]; voffA[1][0] = vn[1][0]; voffA[1][1] = vn[1][1]; } }
            PG8_WAIT_V(8); PG8_WAIT_L(0); PG8_BAR; PG8_MMA(0, 0, At, B0); PG8_MMA(0, 1, At, B1); PG8_BAR; PG8_SCHED;
            PG8_LDA(At, 0, 1); PG8_STAGE_B(PG8_SB(0, 0), b2); PG8_STAGE_B(PG8_SB(0, 1), b2 + hstepB); PG8_STAGE_A(PG8_SA(0, 0), a2, 0);
            PG8_WAIT_V(8); PG8_WAIT_L(0); PG8_BAR; PG8_MMA(1, 0, At, B0); PG8_MMA(1, 1, At, B1); PG8_BAR; PG8_SCHED;
            PG8_LDB(B0, 1, 0); PG8_LDB(B1, 1, 1); PG8_SCHED; PG8_LDA(At, 1, 0); PG8_STAGE_A(PG8_SA(0, 1), a2, 1);
            PG8_WAIT_V(8); PG8_WAIT_L(0); PG8_BAR; PG8_MMA(0, 0, At, B0); PG8_MMA(0, 1, At, B1); PG8_BAR; PG8_SCHED;
            PG8_LDA(At, 1, 1); PG8_STAGE_B(PG8_SB(1, 0), b3); PG8_STAGE_B(PG8_SB(1, 1), b3 + hstepB); PG8_STAGE_A(PG8_SA(1, 0), a3, 0);
            PG8_WAIT_V(8); PG8_WAIT_L(0); PG8_BAR; PG8_MMA(1, 0, At, B0); PG8_MMA(1, 1, At, B1); PG8_BAR; PG8_SCHED;
        }
        if (wr == 0) PG8_BAR;
        E(acc, cur, wr, wc, fr, fq);
        if (!has_next) break;
        if (!S.keep_acc(cur)) {
#pragma unroll
        for (int a = 0; a < 2; ++a)
#pragma unroll
            for (int b = 0; b < 2; ++b)
#pragma unroll
                for (int m = 0; m < 4; ++m)
#pragma unroll
                    for (int n = 0; n < 2; ++n) acc[a][b][m][n] = (f32x4){0.f, 0.f, 0.f, 0.f};
        }
        cur = nxt; cA = nA; cB = nB; ++ui;
        if (wr == 1) PG8_BAR;
    }
    PG8_WAIT_V(0);
    PG8_BAR;
#undef PG8_SA
#undef PG8_SB
#undef PG8_STAGE_A
#undef PG8_STAGE_B
#undef PG8_LDA
#undef PG8_LDB
#undef PG8_MMA
#undef PG8_WAIT_V
#undef PG8_WAIT_L
#undef PG8_BAR
#undef PG8_SCHED
}
struct TileOrder {
    int nM, nN, nwg, G, c;
    __device__ __forceinline__ void init(int nM_, int nN_, int G_, int c_) { nM = nM_; nN = nN_; nwg = nM * nN; G = G_; c = c_; }
    __device__ __forceinline__ bool tile(int i, int& pm, int& pn) const {
        const long L = (long)i * G + c; if (L >= nwg) return false;
        int wgid = (int)L; { const int q = nwg / 8, r = nwg % 8, xcd = wgid % 8, off = wgid / 8; wgid = (xcd < r ? xcd * (q + 1) : r * (q + 1) + (xcd - r) * q) + off; }
        const int nig = 8 * nN, gid = wgid / nig, fm = gid * 8, gsz = (nM - fm) < 8 ? (nM - fm) : 8;
        pm = fm + ((wgid % nig) % gsz); pn = (wgid % nig) / gsz; return true;
    }
};
struct DenseSched {
    TileOrder o; const bf16_t* A; const bf16_t* Bt; int lda, ldb;
    __device__ __forceinline__ bool next(int i, Unit& u) const { u.aux = 0; return o.tile(i, u.pm, u.pn); }
    __device__ __forceinline__ const char* a_base(const Unit& u) const { return (const char*)(A + (size_t)u.pm * 256 * lda); }
    __device__ __forceinline__ const char* b_base(const Unit& u) const { return (const char*)(Bt + (size_t)u.pn * 256 * ldb); }
    __device__ __forceinline__ bool keep_acc(const Unit&) const { return false; }
    __device__ __forceinline__ void a_offs(const Unit&, int, int, int, int, unsigned (&)[2][2]) const {}
};
}

struct EpiInProj { bf16_t* qkv; bf16_t* gates; const float* r1;
    __device__ __forceinline__ void operator()(f32x4 (&acc)[2][2][4][2], const Unit& u, int wr, int wc, int fr, int fq) const {
        const bool isg = u.pn >= 18; bf16_t* base = isg ? gates : qkv; const int ldc = isg ? NGATE : NQKV; const int colt = (isg ? u.pn - 18 : u.pn) * 256 + wc * 32 + 8 * fq;
#pragma unroll
        for (int ai = 0; ai < 2; ++ai)
#pragma unroll
            for (int m = 0; m < 4; ++m) { const int row = u.pm * 256 + ai * 128 + wr * 64 + m * 16 + fr; const float rs = r1[row]; bf16_t* rowp = base + (size_t)row * ldc + colt;
#pragma unroll
                for (int bj = 0; bj < 2; ++bj) { f32x4 v0 = acc[ai][bj][m][0] * rs, v1 = acc[ai][bj][m][1] * rs;
                    if (isg) {
#pragma unroll
                        for (int j = 0; j < 4; ++j) { v0[j] = sigmoidf_(v0[j]); v1[j] = sigmoidf_(v1[j]); } }
                    u32x4 w; w.x = pk2(v0[0], v0[1]); w.y = pk2(v0[2], v0[3]); w.z = pk2(v1[0], v1[1]); w.w = pk2(v1[2], v1[3]);
                    *(u32x4*)(rowp + bj * 128) = w; } }
    } };
__device__ __forceinline__ void p1_inproj(const Params& p, LAS unsigned char* lds) {
    pg8::DenseSched S; S.o.init(128, 34, gridDim.x, blockIdx.x); S.A = (const bf16_t*)(p.ws + WS_XB); S.Bt = (const bf16_t*)(p.ws + WS_WIN); S.lda = D; S.ldb = D;
    EpiInProj E{(bf16_t*)(p.ws + WS_QKV), (bf16_t*)(p.ws + WS_GATES), (const float*)(p.ws + WS_R1)};
    pg8::gemm_phase<true, false>(lds, S, E, D / 64, D, D);
}

template <bool NORM, class SrcRow>
__device__ __forceinline__ void stage_chunk(LAS unsigned char* lds, const SrcRow& src, const float* __restrict__ gain, int tid) {
#pragma unroll
    for (int i = 0; i < 4; ++i) { const int pz = tid + 512 * i, row = pz >> 4, ch = pz & 15;
        bf16x8 v = *(const bf16x8*)(src(row) + ch * 8);
        if (NORM) { float f[8]; float ss = 0.f;
#pragma unroll
            for (int j = 0; j < 8; ++j) { f[j] = bf2f(v[j]); ss += f[j] * f[j]; }
            ss += __shfl_xor(ss, 1); ss += __shfl_xor(ss, 2); ss += __shfl_xor(ss, 4); ss += __shfl_xor(ss, 8);
            const float rk = rsqrtf(ss * (1.0f / 128.0f) + EPS); const f32x4 g0 = *(const f32x4*)(gain + ch * 8), g1 = *(const f32x4*)(gain + ch * 8 + 4);
            u32x4 w; w.x = pk2(f[0] * rk * g0.x, f[1] * rk * g0.y); w.y = pk2(f[2] * rk * g0.z, f[3] * rk * g0.w); w.z = pk2(f[4] * rk * g1.x, f[5] * rk * g1.y); w.w = pk2(f[6] * rk * g1.z, f[7] * rk * g1.w);
            v = __builtin_bit_cast(bf16x8, w); }
        *(LAS bf16x8*)(lds + off_b(row, ch)) = v; }
}
__device__ __forceinline__ void load_q(const bf16_t* qp, const float* __restrict__ gain, int g, bf16x8 (&qf)[4]) {
    float f[4][8]; float ss = 0.f;
#pragma unroll
    for (int ks = 0; ks < 4; ++ks) { const bf16x8 v = *(const bf16x8*)(qp + 32 * ks + 8 * g);
#pragma unroll
        for (int j = 0; j < 8; ++j) { f[ks][j] = bf2f(v[j]); ss += f[ks][j] * f[ks][j]; } }
    ss += __shfl_xor(ss, 16); ss += __shfl_xor(ss, 32);
    const float rq = rsqrtf(ss * (1.0f / 128.0f) + EPS) * 0.08838834764831845f;
#pragma unroll
    for (int ks = 0; ks < 4; ++ks) { const f32x4 g0 = *(const f32x4*)(gain + 32 * ks + 8 * g), g1 = *(const f32x4*)(gain + 32 * ks + 8 * g + 4);
        u32x4 w; w.x = pk2(f[ks][0] * rq * g0.x, f[ks][1] * rq * g0.y); w.y = pk2(f[ks][2] * rq * g0.z, f[ks][3] * rq * g0.w); w.z = pk2(f[ks][4] * rq * g1.x, f[ks][5] * rq * g1.y); w.w = pk2(f[ks][6] * rq * g1.z, f[ks][7] * rq * g1.w);
        qf[ks] = __builtin_bit_cast(bf16x8, w); }
}
struct TokRow { const bf16_t* base; __device__ __forceinline__ const bf16_t* operator()(int r) const { return base + (size_t)r * NQKV; } };
struct NatRow { const bf16_t* base;   __device__ __forceinline__ const bf16_t* operator()(int r) const { return base + (size_t)(r & 63) * NQKV + (r >> 6) * 128; } };

__device__ __forceinline__ void attn_window_item(const Params& p, LAS unsigned char* lds, int item) {
    const int tid = threadIdx.x, lane = tid & 63, w = __builtin_amdgcn_readfirstlane(tid >> 6), g = lane >> 4, ql = lane & 15;
    const int b = item >> 10, nb = (item >> 3) & 127, hq = item & 7, kv = hq >> 2;
    const bf16_t* qkv = (const bf16_t*)(p.ws + WS_QKV); bf16_t* o = (bf16_t*)(p.ws + WS_O);
    LAS float* bias = (LAS float*)(lds + 32768);
    __syncthreads();
    if (tid < 257) bias[tid] = p.in[12][t5_bucket(tid - 128) * 8 + hq];
    const int tq = b * SEQ + nb * 128 + 16 * w + ql;
    bf16x8 qf[4]; load_q(qkv + (size_t)tq * NQKV + hq * 128, p.in[3], g, qf);
    f32x4 S1[8], SC[9];
#pragma unroll
    for (int kt = 0; kt < 8; ++kt) S1[kt] = (f32x4){0.f, 0.f, 0.f, 0.f};
#pragma unroll
    for (int s = 0; s < 9; ++s) SC[s] = (f32x4){0.f, 0.f, 0.f, 0.f};
    const bool in0 = nb > 0, in2 = nb < 127;
#pragma unroll
    for (int c = 0; c < 3; ++c) { const int kb = nb - 1 + c; if (kb < 0 || kb > 127) continue;
        __syncthreads();
        stage_chunk<true>(lds, TokRow{qkv + (size_t)(b * SEQ + kb * 128) * NQKV + 1024 + kv * 128}, p.in[4], tid);
        __syncthreads();
#pragma unroll
        for (int kt = 0; kt < 8; ++kt) {
            if (c == 1) {
#pragma unroll
                for (int ks = 0; ks < 4; ++ks) { const bf16x8 kf = *(const LAS bf16x8*)(lds + off_b(16 * kt + ql, 4 * ks + g)); S1[kt] = __builtin_amdgcn_mfma_f32_16x16x32_bf16(kf, qf[ks], S1[kt], 0, 0, 0); }
            } else if (c == 0) { if (kt >= w) {
#pragma unroll
                for (int ks = 0; ks < 4; ++ks) { const bf16x8 kf = *(const LAS bf16x8*)(lds + off_b(16 * kt + ql, 4 * ks + g)); SC[7 - kt] = __builtin_amdgcn_mfma_f32_16x16x32_bf16(kf, qf[ks], SC[7 - kt], 0, 0, 0); } }
            } else { if (kt <= w) {
#pragma unroll
                for (int ks = 0; ks < 4; ++ks) { const bf16x8 kf = *(const LAS bf16x8*)(lds + off_b(16 * kt + ql, 4 * ks + g)); SC[8 - kt] = __builtin_amdgcn_mfma_f32_16x16x32_bf16(kf, qf[ks], SC[8 - kt], 0, 0, 0); } }
            }
        }
    }
    const float sink = p.in[5][hq]; float mx = sink; const int qi = 16 * w + ql;
#pragma unroll
    for (int kt = 0; kt < 8; ++kt)
#pragma unroll
        for (int r = 0; r < 4; ++r) { const int rel = 16 * kt + 4 * g + r - qi; const float sv = S1[kt][r] + bias[rel + 128]; S1[kt][r] = sv; mx = fmaxf(mx, sv); }
#pragma unroll
    for (int s = 0; s < 9; ++s) { const bool c0 = s <= 7 - w; const int kt = c0 ? 7 - s : 8 - s; const int cofs = c0 ? -128 : 128; const bool inr = c0 ? in0 : in2;
#pragma unroll
        for (int r = 0; r < 4; ++r) { const int rel = cofs + 16 * kt + 4 * g + r - qi; const bool valid = inr && rel >= -128 && rel <= 128;
            const float sv = valid ? SC[s][r] + bias[valid ? rel + 128 : 0] : -1e30f; SC[s][r] = sv; mx = fmaxf(mx, sv); } }
    mx = fmaxf(mx, __shfl_xor(mx, 16)); mx = fmaxf(mx, __shfl_xor(mx, 32));
    float l = 0.f;
#pragma unroll
    for (int kt = 0; kt < 8; ++kt)
#pragma unroll
        for (int r = 0; r < 4; ++r) { const float pe = __expf(S1[kt][r] - mx); S1[kt][r] = pe; l += pe; }
#pragma unroll
    for (int s = 0; s < 9; ++s)
#pragma unroll
        for (int r = 0; r < 4; ++r) { const float pe = __expf(SC[s][r] - mx); SC[s][r] = pe; l += pe; }
    l += __shfl_xor(l, 16); l += __shfl_xor(l, 32); l += __expf(sink - mx);
    const float inv = 1.0f / l;
    f32x4 O[8];
#pragma unroll
    for (int dt = 0; dt < 8; ++dt) O[dt] = (f32x4){0.f, 0.f, 0.f, 0.f};
    const int q4 = ql >> 2, pp = ql & 3;
    const f32x4 zero4 = (f32x4){0.f, 0.f, 0.f, 0.f};
#pragma unroll
    for (int c = 0; c < 3; ++c) { const int kb = nb - 1 + c; if (kb < 0 || kb > 127) continue;
        __syncthreads();
        stage_chunk<false>(lds, TokRow{qkv + (size_t)(b * SEQ + kb * 128) * NQKV + 1280 + kv * 128}, nullptr, tid);
        __syncthreads();
#pragma unroll
        for (int kk = 0; kk < 4; ++kk) {
            bool a0, a1; f32x4 p0, p1;
            if (c == 1) { a0 = true; a1 = true; p0 = S1[2 * kk]; p1 = S1[2 * kk + 1]; }
            else if (c == 0) { a0 = 2 * kk >= w; a1 = 2 * kk + 1 >= w; p0 = a0 ? SC[7 - 2 * kk] : zero4; p1 = a1 ? SC[6 - 2 * kk] : zero4; }
            else { a0 = 2 * kk <= w; a1 = 2 * kk + 1 <= w; p0 = a0 ? SC[8 - 2 * kk] : zero4; p1 = a1 ? SC[7 - 2 * kk] : zero4; }
            if (a0 || a1) { u32x4 pw; pw.x = pk2(p0[0], p0[1]); pw.y = pk2(p0[2], p0[3]); pw.z = pk2(p1[0], p1[1]); pw.w = pk2(p1[2], p1[3]);
                const bf16x8 pf = __builtin_bit_cast(bf16x8, pw);
#pragma unroll
                for (int dt = 0; dt < 8; ++dt) { const s16x4 lo = tr_read(lds + off_b(32 * kk + 4 * g + q4, 2 * dt + (pp >> 1)) + 8 * (pp & 1)), hi = tr_read(lds + off_b(32 * kk + 16 + 4 * g + q4, 2 * dt + (pp >> 1)) + 8 * (pp & 1));
                    bf16x8 vf; vf[0] = lo[0]; vf[1] = lo[1]; vf[2] = lo[2]; vf[3] = lo[3]; vf[4] = hi[0]; vf[5] = hi[1]; vf[6] = hi[2]; vf[7] = hi[3];
                    O[dt] = __builtin_amdgcn_mfma_f32_16x16x32_bf16(vf, pf, O[dt], 0, 0, 0); } } }
    }
    bf16_t* op = o + (size_t)tq * D + hq * 128 + 4 * g;
#pragma unroll
    for (int dt = 0; dt < 8; ++dt) { u32x2 w2; w2.x = pk2(O[dt][0] * inv, O[dt][1] * inv); w2.y = pk2(O[dt][2] * inv, O[dt][3] * inv); *(u32x2*)(op + 16 * dt) = w2; }
}

__device__ __forceinline__ void attn_nat_item(const Params& p, LAS unsigned char* lds, int item) {
    const int tid = threadIdx.x, lane = tid & 63, w = tid >> 6, g = lane >> 4, ql = lane & 15;
    const int b = item >> 10, r = (item >> 2) & 255, hp = item & 3, hh = w >> 2, h = 2 * hp + hh, jq = w & 3;
    const int rs = min(max(r - 4, 0), 248); const int w0 = jq == 0 ? 0 : (jq == 1 ? 8 : (jq == 2 ? 24 : 32));
    const bf16_t* qkv = (const bf16_t*)(p.ws + WS_QKV); bf16_t* o = (bf16_t*)(p.ws + WS_O);
    LAS float* rpb = (LAS float*)(lds + 32768);
    __syncthreads();
    for (int i = tid; i < 930; i += 512) rpb[i] = p.in[8][(2 * hp) * 465 + i];
    const int qcol = 16 * jq + ql; const int tq = b * SEQ + r * 64 + qcol;
    bf16x8 qf[4]; load_q(qkv + (size_t)tq * NQKV + 1536 + h * 128, p.in[6], g, qf);
    f32x4 S[8][2];
#pragma unroll
    for (int i = 0; i < 8; ++i) { S[i][0] = (f32x4){0.f, 0.f, 0.f, 0.f}; S[i][1] = (f32x4){0.f, 0.f, 0.f, 0.f}; }
#pragma unroll
    for (int i = 0; i < 8; ++i) {
        __syncthreads();
        stage_chunk<true>(lds, NatRow{qkv + (size_t)(b * SEQ + (rs + i) * 64) * NQKV + 2560 + 2 * hp * 128}, p.in[7], tid);
        __syncthreads();
#pragma unroll
        for (int t = 0; t < 2; ++t)
#pragma unroll
            for (int ks = 0; ks < 4; ++ks) { const bf16x8 kf = *(const LAS bf16x8*)(lds + off_b(hh * 64 + w0 + 16 * t + ql, 4 * ks + g)); S[i][t] = __builtin_amdgcn_mfma_f32_16x16x32_bf16(kf, qf[ks], S[i][t], 0, 0, 0); }
    }
    const int cs = min(max(qcol - 8, 0), 48); float mx = -1e30f;
#pragma unroll
    for (int i = 0; i < 8; ++i) { const int dr = rs + i - r + 7;
#pragma unroll
        for (int t = 0; t < 2; ++t)
#pragma unroll
            for (int rr = 0; rr < 4; ++rr) { const int kc = w0 + 16 * t + 4 * g + rr; const bool valid = kc >= cs && kc < cs + 16; const int dc = kc - qcol + 15;
                const float s = valid ? S[i][t][rr] + rpb[hh * 465 + dr * 31 + (valid ? dc : 0)] : -1e30f; S[i][t][rr] = s; mx = fmaxf(mx, s); } }
    mx = fmaxf(mx, __shfl_xor(mx, 16)); mx = fmaxf(mx, __shfl_xor(mx, 32));
    float l = 0.f;
#pragma unroll
    for (int i = 0; i < 8; ++i)
#pragma unroll
        for (int t = 0; t < 2; ++t)
#pragma unroll
            for (int rr = 0; rr < 4; ++rr) { const float pe = __expf(S[i][t][rr] - mx); S[i][t][rr] = pe; l += pe; }
    l += __shfl_xor(l, 16); l += __shfl_xor(l, 32);
    const float inv = 1.0f / l;
    f32x4 O[8];
#pragma unroll
    for (int dt = 0; dt < 8; ++dt) O[dt] = (f32x4){0.f, 0.f, 0.f, 0.f};
    const int q4 = ql >> 2, pp = ql & 3;
#pragma unroll
    for (int i = 0; i < 8; ++i) {
        __syncthreads();
        stage_chunk<false>(lds, NatRow{qkv + (size_t)(b * SEQ + (rs + i) * 64) * NQKV + 3584 + 2 * hp * 128}, nullptr, tid);
        __syncthreads();
        u32x4 pw; pw.x = pk2(S[i][0][0], S[i][0][1]); pw.y = pk2(S[i][0][2], S[i][0][3]); pw.z = pk2(S[i][1][0], S[i][1][1]); pw.w = pk2(S[i][1][2], S[i][1][3]);
        const bf16x8 pf = __builtin_bit_cast(bf16x8, pw); const int rb = hh * 64 + w0;
#pragma unroll
        for (int dt = 0; dt < 8; ++dt) { const s16x4 lo = tr_read(lds + off_b(rb + 4 * g + q4, 2 * dt + (pp >> 1)) + 8 * (pp & 1)), hi = tr_read(lds + off_b(rb + 16 + 4 * g + q4, 2 * dt + (pp >> 1)) + 8 * (pp & 1));
            bf16x8 vf; vf[0] = lo[0]; vf[1] = lo[1]; vf[2] = lo[2]; vf[3] = lo[3]; vf[4] = hi[0]; vf[5] = hi[1]; vf[6] = hi[2]; vf[7] = hi[3];
            O[dt] = __builtin_amdgcn_mfma_f32_16x16x32_bf16(vf, pf, O[dt], 0, 0, 0); }
    }
    bf16_t* op = o + (size_t)tq * D + 1024 + h * 128 + 4 * g;
#pragma unroll
    for (int dt = 0; dt < 8; ++dt) { u32x2 w2; w2.x = pk2(O[dt][0] * inv, O[dt][1] * inv); w2.y = pk2(O[dt][2] * inv, O[dt][3] * inv); *(u32x2*)(op + 16 * dt) = w2; }
}
__device__ __forceinline__ void p2_attn(const Params& p, LAS unsigned char* lds) {
    for (int it = blockIdx.x; it < 2048; it += gridDim.x) attn_window_item(p, lds, it);
    for (int it = blockIdx.x; it < 2048; it += gridDim.x) attn_nat_item(p, lds, it);
}
__device__ __forceinline__ void p2_attn_w(const Params& p, LAS unsigned char* lds) { for (int it = blockIdx.x; it < 2048; it += gridDim.x) attn_window_item(p, lds, it); }
__device__ __forceinline__ void p2_attn_n(const Params& p, LAS unsigned char* lds) { for (int it = blockIdx.x; it < 2048; it += gridDim.x) attn_nat_item(p, lds, it); }

struct UpHook { const bf16_t* gates;
    __device__ __forceinline__ void operator()(f32x4 (&acc)[2][2][4][2], const Unit& u, int wr, int wc, int fr, int fq) const {
        unsigned goff = (unsigned)(u.pm * 256 + wr * 64 + fr) * NGATE + u.pn * 256 + wc * 32 + 8 * fq;
#pragma unroll
        for (int ai = 0; ai < 2; ++ai) {
#pragma unroll
            for (int m = 0; m < 4; ++m) { asm volatile("" : "+v"(goff));
#pragma unroll
                for (int bj = 0; bj < 2; ++bj) { const bf16x8 sa = *(const bf16x8*)(gates + goff + bj * 128), sb = *(const bf16x8*)(gates + goff + 2048 + bj * 128);
#pragma unroll
                    for (int n = 0; n < 2; ++n)
#pragma unroll
                        for (int j = 0; j < 4; ++j) acc[ai][bj][m][n][j] *= bf2f(sa[4 * n + j]) * __builtin_amdgcn_rcpf(fmaxf(bf2f(sb[4 * n + j]), 1e-30f)); }
                goff += 16 * NGATE; }
            goff += 64 * NGATE; }
    } };
struct UpSched {
    pg8::TileOrder o; const bf16_t* A; const bf16_t* Bt;
    __device__ __forceinline__ bool next(int i, Unit& u) const { u.aux = i & 1; return o.tile(i >> 1, u.pm, u.pn); }
    __device__ __forceinline__ const char* a_base(const Unit& u) const { return (const char*)(A + (size_t)u.pm * 256 * D + u.aux * 1024); }
    __device__ __forceinline__ const char* b_base(const Unit& u) const { return (const char*)(Bt + (size_t)u.pn * 256 * D + u.aux * 1024); }
    __device__ __forceinline__ bool keep_acc(const Unit& u) const { return u.aux == 0; }
    __device__ __forceinline__ void a_offs(const Unit&, int, int, int, int, unsigned (&)[2][2]) const {}
};
struct EpiUp { const bf16_t* gates; bf16_t* merged;
    __device__ __forceinline__ void operator()(f32x4 (&acc)[2][2][4][2], const Unit& u, int wr, int wc, int fr, int fq) const {
        if (u.aux == 0) { UpHook{gates}(acc, u, wr, wc, fr, fq); return; }
        unsigned goff = (unsigned)(u.pm * 256 + wr * 64 + fr) * NGATE + u.pn * 256 + wc * 32 + 8 * fq;
        unsigned moff = (unsigned)(u.pm * 256 + wr * 64 + fr) * D + u.pn * 256 + wc * 32 + 8 * fq;
#pragma unroll
        for (int ai = 0; ai < 2; ++ai) {
#pragma unroll
            for (int m = 0; m < 4; ++m) { asm volatile("" : "+v"(goff), "+v"(moff));
#pragma unroll
                for (int bj = 0; bj < 2; ++bj) { const bf16x8 sb = *(const bf16x8*)(gates + goff + 2048 + bj * 128);
                    f32x4 v0 = acc[ai][bj][m][0], v1 = acc[ai][bj][m][1];
#pragma unroll
                    for (int j = 0; j < 4; ++j) { v0[j] *= fmaxf(bf2f(sb[j]), 1e-30f); v1[j] *= fmaxf(bf2f(sb[4 + j]), 1e-30f); }
                    u32x4 w; w.x = pk2(v0[0], v0[1]); w.y = pk2(v0[2], v0[3]); w.z = pk2(v1[0], v1[1]); w.w = pk2(v1[2], v1[3]);
                    *(u32x4*)(merged + moff + bj * 128) = w; }
                goff += 16 * NGATE; moff += 16 * D; }
            goff += 64 * NGATE; moff += 64 * D; }
    } };
__device__ __forceinline__ void p3_up(const Params& p, LAS unsigned char* lds) {
    UpSched S; S.o.init(128, 8, gridDim.x, blockIdx.x); S.A = (const bf16_t*)(p.ws + WS_O); S.Bt = (const bf16_t*)(p.ws + WS_WUP);
    EpiUp E{(const bf16_t*)(p.ws + WS_GATES), (bf16_t*)(p.ws + WS_XB)};
    pg8::gemm_phase<true, false>(lds, S, E, 1024 / 64, D, D);
}

struct EpiOut { const float* x; float* out; bf16_t* hb;
    __device__ __forceinline__ void operator()(f32x4 (&acc)[2][2][4][2], const Unit& u, int wr, int wc, int fr, int fq) const {
        unsigned off = (unsigned)(u.pm * 256 + wr * 64 + fr) * D + u.pn * 256 + wc * 32 + 4 * fq;
#pragma unroll
        for (int ai = 0; ai < 2; ++ai) {
#pragma unroll
            for (int m = 0; m < 4; ++m) { asm volatile("" : "+v"(off));
#pragma unroll
                for (int bj = 0; bj < 2; ++bj)
#pragma unroll
                    for (int n = 0; n < 2; ++n) { const unsigned o2 = off + bj * 128 + 16 * n;
                        const f32x4 hv = *(const f32x4*)(x + o2) + acc[ai][bj][m][n]; *(f32x4*)(out + o2) = hv;
                        u32x2 w2; w2.x = pk2(hv[0], hv[1]); w2.y = pk2(hv[2], hv[3]); *(u32x2*)(hb + o2) = w2; }
                off += 16 * D; }
            off += 64 * D; }
    } };
__device__ __forceinline__ void p4_out(const Params& p, LAS unsigned char* lds) {
    pg8::DenseSched S; S.o.init(128, 8, gridDim.x, blockIdx.x); S.A = (const bf16_t*)(p.ws + WS_XB); S.Bt = (const bf16_t*)(p.ws + WS_WOUT); S.lda = D; S.ldb = D;
    EpiOut E{p.in[0], p.out, (bf16_t*)(p.ws + WS_O)};
    pg8::gemm_phase<false, false>(lds, S, E, D / 64, D, D);
}

__device__ __forceinline__ void p5_router(const Params& p) {
    const int tid = threadIdx.x, lane = tid & 63, wave = tid >> 6, g = lane >> 4, tl = lane & 15; const int gw = blockIdx.x * 8 + wave, NGW = gridDim.x * 8;
    const float* wrt = (const float*)(p.ws + WS_WRT); float* r2 = (float*)(p.ws + WS_R2); int* cnt = (int*)(p.ws + WS_CNT); int* tokl = (int*)(p.ws + WS_TOK); float* wl = (float*)(p.ws + WS_WL);
    const float* brg = p.in[15]; const float* bre = p.in[17];
    for (int tile = gw; tile < T / 16; tile += NGW) {
        const int tok = tile * 16 + tl;
        const f32x4* hp = (const f32x4*)(p.out + (size_t)tok * D + 8 * g);
        const f32x4* w0 = (const f32x4*)(wrt + (size_t)tl * D + 8 * g); const f32x4* w1 = w0 + 16 * D / 4; const f32x4* w2 = w0 + 32 * D / 4;
        f32x4 accA = {0.f, 0.f, 0.f, 0.f}, accB = accA, accC = accA; float ss = 0.f;
        f32x4 xa[8], xb_[8], xc[8], xd[8];
#define RT_LOAD(buf, s) do { buf[0] = hp[8 * (s)]; buf[1] = hp[8 * (s) + 1]; buf[2] = w0[8 * (s)]; buf[3] = w0[8 * (s) + 1]; buf[4] = w1[8 * (s)]; buf[5] = w1[8 * (s) + 1]; buf[6] = w2[8 * (s)]; buf[7] = w2[8 * (s) + 1]; } while (0)
#define RT_COMP(buf) do { \
            ss += (buf[0].x * buf[0].x + buf[0].y * buf[0].y) + (buf[0].z * buf[0].z + buf[0].w * buf[0].w) + (buf[1].x * buf[1].x + buf[1].y * buf[1].y) + (buf[1].z * buf[1].z + buf[1].w * buf[1].w); \
            _Pragma("unroll") for (int i = 0; i < 4; ++i) { accA = __builtin_amdgcn_mfma_f32_16x16x4f32(buf[2][i], buf[0][i], accA, 0, 0, 0); accB = __builtin_amdgcn_mfma_f32_16x16x4f32(buf[4][i], buf[0][i], accB, 0, 0, 0); accC = __builtin_amdgcn_mfma_f32_16x16x4f32(buf[6][i], buf[0][i], accC, 0, 0, 0); } \
            _Pragma("unroll") for (int i = 0; i < 4; ++i) { accA = __builtin_amdgcn_mfma_f32_16x16x4f32(buf[3][i], buf[1][i], accA, 0, 0, 0); accB = __builtin_amdgcn_mfma_f32_16x16x4f32(buf[5][i], buf[1][i], accB, 0, 0, 0); accC = __builtin_amdgcn_mfma_f32_16x16x4f32(buf[7][i], buf[1][i], accC, 0, 0, 0); } } while (0)
#define RT_SB __builtin_amdgcn_sched_barrier(0)
        RT_LOAD(xa, 0); RT_LOAD(xb_, 1); RT_LOAD(xc, 2); RT_SB;
#pragma unroll 1
        for (int s = 0; s < D / 32; s += 4) {
            RT_LOAD(xd, s + 3); RT_SB; RT_COMP(xa); RT_SB;
            RT_LOAD(xa, (s + 4) & 63); RT_SB; RT_COMP(xb_); RT_SB;
            RT_LOAD(xb_, (s + 5) & 63); RT_SB; RT_COMP(xc); RT_SB;
            RT_LOAD(xc, (s + 6) & 63); RT_SB; RT_COMP(xd); RT_SB;
        }
#undef RT_SB
#undef RT_LOAD
#undef RT_COMP
        ss += __shfl_xor(ss, 16); ss += __shfl_xor(ss, 32);
        const float rr = rsqrtf(ss * (1.0f / D) + EPS);
        const float myg = accC[0] * rr + brg[g];
        float gl[4];
#pragma unroll
        for (int j = 0; j < 4; ++j) gl[j] = __shfl(myg, tl + 16 * j);
        int gi = 0; float gm = gl[0];
#pragma unroll
        for (int i = 1; i < 4; ++i) if (gl[i] > gm) { gm = gl[i]; gi = i; }
        float den = 0.f;
#pragma unroll
        for (int i = 0; i < 4; ++i) den += __expf(gl[i] - gm);
        const float pg = 1.0f / den;
        if (g == gi) {
            float el[8];
#pragma unroll
            for (int i = 0; i < 4; ++i) { el[i] = accA[i] * rr + bre[g * 8 + i]; el[4 + i] = accB[i] * rr + bre[g * 8 + 4 + i]; }
            int e0 = 0; float v0 = el[0];
#pragma unroll
            for (int i = 1; i < 8; ++i) if (el[i] > v0) { v0 = el[i]; e0 = i; }
            int e1 = -1; float v1 = -3.0e38f;
#pragma unroll
            for (int i = 0; i < 8; ++i) if (i != e0 && el[i] > v1) { v1 = el[i]; e1 = i; }
            const float ex = __expf(v1 - v0); const float s0 = 1.0f / (1.0f + ex), s1 = ex * s0;
            r2[tok] = rr;
            const int L0 = gi * 8 + e0, L1 = 32 + gi * 8 + e1;
            const int p0 = atomicAdd(&cnt[L0], 1); tokl[(size_t)L0 * T + p0] = tok; wl[(size_t)L0 * T + p0] = pg * s0;
            const int p1 = atomicAdd(&cnt[L1], 1); tokl[(size_t)L1 * T + p1] = tok; wl[(size_t)L1 * T + p1] = pg * s1;
        }
    }
}

__device__ __forceinline__ void build_tiles(const Params& p, LAS int* tab) {
    __syncthreads();
    if (threadIdx.x == 0) { const int* cnt = (const int*)(p.ws + WS_CNT); int nt = 0, slot = 0, k1 = 0;
        for (int L = 0; L < 64; ++L) { if (L == 32) k1 = nt; const int c = cnt[L]; for (int r0 = 0; r0 < c; r0 += 256) { tab[4 + nt * 4 + 0] = L; tab[4 + nt * 4 + 1] = r0; tab[4 + nt * 4 + 2] = slot; tab[4 + nt * 4 + 3] = min(256, c - r0); slot += 256; ++nt; } }
        tab[0] = nt; tab[1] = k1; }
    __syncthreads();
}
template <int NPN> struct MoeOrder { int G, c, t_lo, nt_tiles; const LAS int* tab;
    __device__ __forceinline__ bool unit(int i, Unit& u) const { const long L = (long)i * G + c; if (L >= (long)nt_tiles * NPN) return false;
        const int nwg = nt_tiles * NPN; int wgid = (int)L; { const int q = nwg / 8, r = nwg % 8, xcd = wgid % 8, off = wgid / 8; wgid = (xcd < r ? xcd * (q + 1) : r * (q + 1) + (xcd - r) * q) + off; }
        u.pm = t_lo + wgid / NPN; u.pn = wgid % NPN; u.aux = 0; return true; } };
struct GateUpSched { MoeOrder<4> o; const bf16_t* hb; const bf16_t* WguT; const int* tokl;
    __device__ __forceinline__ bool next(int i, Unit& u) const { return o.unit(i, u); }
    __device__ __forceinline__ const char* a_base(const Unit&) const { return (const char*)hb; }
    __device__ __forceinline__ const char* b_base(const Unit& u) const { const int e = o.tab[4 + u.pm * 4] & 31; return (const char*)(WguT + (size_t)(e * 1024 + u.pn * 256) * D); }
    __device__ __forceinline__ bool keep_acc(const Unit&) const { return false; }
    __device__ __forceinline__ void a_offs(const Unit& u, int R0, int C0, int R1, int C1, unsigned (&v)[2][2]) const {
        const int L = o.tab[4 + u.pm * 4], row0 = o.tab[4 + u.pm * 4 + 1], nrows = o.tab[4 + u.pm * 4 + 3]; const int* lst = tokl + (size_t)L * T + row0;
#pragma unroll
        for (int h = 0; h < 2; ++h) { const int r0 = R0 + 128 * h, r1 = R1 + 128 * h; const int t0 = r0 < nrows ? lst[r0] : 0, t1 = r1 < nrows ? lst[r1] : 0;
            v[h][0] = ((unsigned)t0 * D + C0) * 2u; v[h][1] = ((unsigned)t1 * D + C1) * 2u; } }
};
struct EpiGateUp { const LAS int* tab; const int* tokl; const float* r2; bf16_t* he;
    __device__ __forceinline__ void operator()(f32x4 (&acc)[2][2][4][2], const Unit& u, int wr, int wc, int fr, int fq) const {
        const int L = tab[4 + u.pm * 4], row0 = tab[4 + u.pm * 4 + 1], slot = tab[4 + u.pm * 4 + 2], nrows = tab[4 + u.pm * 4 + 3];
#pragma unroll
        for (int ai = 0; ai < 2; ++ai)
#pragma unroll
            for (int m = 0; m < 4; ++m) { const int rr = ai * 128 + wr * 64 + m * 16 + fr; const int tk = rr < nrows ? tokl[(size_t)L * T + row0 + rr] : 0; const float rs = r2[tk];
                u32x4 w; unsigned ww[4];
#pragma unroll
                for (int n = 0; n < 2; ++n) { float hv[4];
#pragma unroll
                    for (int j = 0; j < 4; ++j) { const float gt = acc[ai][0][m][n][j] * rs, up = acc[ai][1][m][n][j] * rs; hv[j] = gt * sigmoidf_(gt) * up; }
                    ww[2 * n] = pk2(hv[0], hv[1]); ww[2 * n + 1] = pk2(hv[2], hv[3]); }
                w.x = ww[0]; w.y = ww[1]; w.z = ww[2]; w.w = ww[3];
                *(u32x4*)(he + (size_t)(slot + rr) * 512 + u.pn * 128 + wc * 32 + 8 * fq) = w; }
    } };
__device__ __forceinline__ void p6_gateup(const Params& p, LAS unsigned char* lds) {
    LAS int* tab = (LAS int*)(lds + TAB_OFF); build_tiles(p, tab);
    GateUpSched S; S.o.G = gridDim.x; S.o.c = blockIdx.x; S.o.t_lo = 0; S.o.nt_tiles = tab[0]; S.o.tab = tab;
    S.hb = (const bf16_t*)(p.ws + WS_O); S.WguT = (const bf16_t*)(p.ws + WS_WGU); S.tokl = (const int*)(p.ws + WS_TOK);
    EpiGateUp E{tab, (const int*)(p.ws + WS_TOK), (const float*)(p.ws + WS_R2), (bf16_t*)(p.ws + WS_HE)};
    pg8::gemm_phase<true, true>(lds, S, E, D / 64, D, D);
}
struct DownSched { MoeOrder<8> o; const bf16_t* he; const bf16_t* WdT;
    __device__ __forceinline__ bool next(int i, Unit& u) const { return o.unit(i, u); }
    __device__ __forceinline__ const char* a_base(const Unit& u) const { return (const char*)(he + (size_t)o.tab[4 + u.pm * 4 + 2] * 512); }
    __device__ __forceinline__ const char* b_base(const Unit& u) const { const int e = o.tab[4 + u.pm * 4] & 31; return (const char*)(WdT + (size_t)(e * 2048 + u.pn * 256) * 512); }
    __device__ __forceinline__ bool keep_acc(const Unit&) const { return false; }
    __device__ __forceinline__ void a_offs(const Unit&, int, int, int, int, unsigned (&)[2][2]) const {}
};
struct EpiDown { const LAS int* tab; const int* tokl; const float* wl; float* out;
    __device__ __forceinline__ void operator()(f32x4 (&acc)[2][2][4][2], const Unit& u, int wr, int wc, int fr, int fq) const {
        const int L = tab[4 + u.pm * 4], row0 = tab[4 + u.pm * 4 + 1], nrows = tab[4 + u.pm * 4 + 3];
#pragma unroll
        for (int ai = 0; ai < 2; ++ai)
#pragma unroll
            for (int m = 0; m < 4; ++m) { const int rr = ai * 128 + wr * 64 + m * 16 + fr;
                if (rr < nrows) { const int tk = tokl[(size_t)L * T + row0 + rr]; const float wg = wl[(size_t)L * T + row0 + rr];
#pragma unroll
                    for (int bj = 0; bj < 2; ++bj)
#pragma unroll
                        for (int n = 0; n < 2; ++n) { float* op = out + (size_t)tk * D + u.pn * 256 + bj * 128 + wc * 32 + 16 * n + 4 * fq; *(f32x4*)op = *(const f32x4*)op + acc[ai][bj][m][n] * wg; } } }
    } };
__device__ __forceinline__ void p7_down(const Params& p, LAS unsigned char* lds, int k) {
    LAS int* tab = (LAS int*)(lds + TAB_OFF); build_tiles(p, tab);
    DownSched S; S.o.G = gridDim.x; S.o.c = blockIdx.x; S.o.t_lo = k ? tab[1] : 0; S.o.nt_tiles = k ? tab[0] - tab[1] : tab[1]; S.o.tab = tab;
    S.he = (const bf16_t*)(p.ws + WS_HE); S.WdT = (const bf16_t*)(p.ws + WS_WD);
    EpiDown E{tab, (const int*)(p.ws + WS_TOK), (const float*)(p.ws + WS_WL), p.out};
    pg8::gemm_phase<false, false>(lds, S, E, 512 / 64, 512, 512);
}

struct GatherRow { const bf16_t* base; const int* list; int nrows; __device__ __forceinline__ unsigned operator()(int r) const { const int t = r < nrows ? list[r] : 0; return (unsigned)t * (unsigned)D; } };

__device__ __forceinline__ void p6_gateup_s(const Params& p, LAS unsigned char* lds) {
    const int tid = threadIdx.x, lane = tid & 63, wid = tid >> 6, wr = wid >> 2, wc = wid & 3, fr = lane & 15, fq = lane >> 4;
    LAS int* tab = (LAS int*)(lds + TAB_OFF); build_tiles(p, tab);
    const int nt = tab[0];
    const bf16_t* hb = (const bf16_t*)(p.ws + WS_O); const bf16_t* WguT = (const bf16_t*)(p.ws + WS_WGU); bf16_t* he = (bf16_t*)(p.ws + WS_HE);
    const int* tokl = (const int*)(p.ws + WS_TOK); const float* r2 = (const float*)(p.ws + WS_R2);
    for (int ui = blockIdx.x; ui < nt * 4; ui += gridDim.x) {
        const int ti = ui >> 2; Unit u; u.pn = ui & 3; u.pm = ti; u.aux = 0;
        const int L = tab[4 + ti * 4], row0 = tab[4 + ti * 4 + 1], slot = tab[4 + ti * 4 + 2], nrows = tab[4 + ti * 4 + 3], e = L & 31;
        f32x4 acc[2][2][4][2];
        GatherRow ar{hb, tokl + (size_t)L * T + row0, nrows}; DenseRow br{WguT + (size_t)(e * 1024 + u.pn * 256) * D, D};
        sgemm_unit<true, true>(lds, ar, br, 0, D, acc, wr, wc, fr, fq, tid);
#pragma unroll
        for (int ai = 0; ai < 2; ++ai)
#pragma unroll
            for (int m = 0; m < 4; ++m) { const int rr = ai * 128 + wr * 64 + m * 16 + fr; const int tk = rr < nrows ? tokl[(size_t)L * T + row0 + rr] : 0; const float rs = r2[tk];
                u32x4 w; unsigned ww[4];
#pragma unroll
                for (int n = 0; n < 2; ++n) { float hv[4];
#pragma unroll
                    for (int j = 0; j < 4; ++j) { const float gt = acc[ai][0][m][n][j] * rs, up = acc[ai][1][m][n][j] * rs; hv[j] = gt * sigmoidf_(gt) * up; }
                    ww[2 * n] = pk2(hv[0], hv[1]); ww[2 * n + 1] = pk2(hv[2], hv[3]); }
                w.x = ww[0]; w.y = ww[1]; w.z = ww[2]; w.w = ww[3];
                *(u32x4*)(he + (size_t)(slot + rr) * 512 + u.pn * 128 + wc * 32 + 8 * fq) = w; }
    }
}
__device__ __forceinline__ void p7_down_s(const Params& p, LAS unsigned char* lds, int k) {
    const int tid = threadIdx.x, lane = tid & 63, wid = tid >> 6, wr = wid >> 2, wc = wid & 3, fr = lane & 15, fq = lane >> 4;
    LAS int* tab = (LAS int*)(lds + TAB_OFF); build_tiles(p, tab);
    const int t_lo = k ? tab[1] : 0, t_hi = k ? tab[0] : tab[1];
    const bf16_t* he = (const bf16_t*)(p.ws + WS_HE); const bf16_t* WdT = (const bf16_t*)(p.ws + WS_WD);
    const int* tokl = (const int*)(p.ws + WS_TOK); const float* wl = (const float*)(p.ws + WS_WL);
    for (int ui = blockIdx.x; ui < (t_hi - t_lo) * 8; ui += gridDim.x) {
        const int ti = t_lo + (ui >> 3); Unit u; u.pn = ui & 7; u.pm = ti; u.aux = 0;
        const int L = tab[4 + ti * 4], row0 = tab[4 + ti * 4 + 1], slot = tab[4 + ti * 4 + 2], nrows = tab[4 + ti * 4 + 3], e = L & 31;
        f32x4 acc[2][2][4][2];
        DenseRow ar{he + (size_t)slot * 512, 512}, br{WdT + (size_t)(e * 2048 + u.pn * 256) * 512, 512};
        sgemm_unit<false, true>(lds, ar, br, 0, 512, acc, wr, wc, fr, fq, tid);
#pragma unroll
        for (int ai = 0; ai < 2; ++ai)
#pragma unroll
            for (int m = 0; m < 4; ++m) { const int rr = ai * 128 + wr * 64 + m * 16 + fr;
                if (rr < nrows) { const int tk = tokl[(size_t)L * T + row0 + rr]; const float wg = wl[(size_t)L * T + row0 + rr];
#pragma unroll
                    for (int bj = 0; bj < 2; ++bj)
#pragma unroll
                        for (int n = 0; n < 2; ++n) { float* op = p.out + (size_t)tk * D + u.pn * 256 + bj * 128 + wc * 32 + 16 * n + 4 * fq; *(f32x4*)op = *(const f32x4*)op + acc[ai][bj][m][n] * wg; } } }
    }
}

__device__ __forceinline__ void p3_up_s(const Params& p, LAS unsigned char* lds) {
    const int tid = threadIdx.x, lane = tid & 63, wid = tid >> 6, wr = wid >> 2, wc = wid & 3, fr = lane & 15, fq = lane >> 4;
    const bf16_t* o = (const bf16_t*)(p.ws + WS_O); const bf16_t* WupT = (const bf16_t*)(p.ws + WS_WUP); const bf16_t* gates = (const bf16_t*)(p.ws + WS_GATES); bf16_t* merged = (bf16_t*)(p.ws + WS_XB);
    for (int ui = blockIdx.x; ui < 128 * 8; ui += gridDim.x) {
        Unit u; u.pn = ui / 128; u.pm = ui % 128; u.aux = 0;
        f32x4 acc[2][2][4][2];
        DenseRow ar{o + (size_t)u.pm * 256 * D, D}, br{WupT + (size_t)u.pn * 256 * D, D};
        sgemm_unit<true, true>(lds, ar, br, 0, 1024, acc, wr, wc, fr, fq, tid);
        UpHook{gates}(acc, u, wr, wc, fr, fq);
        sgemm_unit<true, false>(lds, ar, br, 1024, D, acc, wr, wc, fr, fq, tid);
        unsigned goff = (unsigned)(u.pm * 256 + wr * 64 + fr) * NGATE + u.pn * 256 + wc * 32 + 8 * fq;
        unsigned moff = (unsigned)(u.pm * 256 + wr * 64 + fr) * D + u.pn * 256 + wc * 32 + 8 * fq;
#pragma unroll
        for (int ai = 0; ai < 2; ++ai) {
#pragma unroll
            for (int m = 0; m < 4; ++m) { asm volatile("" : "+v"(goff), "+v"(moff));
#pragma unroll
                for (int bj = 0; bj < 2; ++bj) { const bf16x8 sb = *(const bf16x8*)(gates + goff + 2048 + bj * 128);
                    f32x4 v0 = acc[ai][bj][m][0], v1 = acc[ai][bj][m][1];
#pragma unroll
                    for (int j = 0; j < 4; ++j) { v0[j] *= fmaxf(bf2f(sb[j]), 1e-30f); v1[j] *= fmaxf(bf2f(sb[4 + j]), 1e-30f); }
                    u32x4 w; w.x = pk2(v0[0], v0[1]); w.y = pk2(v0[2], v0[3]); w.z = pk2(v1[0], v1[1]); w.w = pk2(v1[2], v1[3]);
                    *(u32x4*)(merged + moff + bj * 128) = w; }
                goff += 16 * NGATE; moff += 16 * D; }
            goff += 64 * NGATE; moff += 64 * D; }
    }
}


#define XB_TMO      128
#define XB_XCNT(j)  (256  + 64 * (j))
#define XB_XSUB(j)  (1280 + 64 * (j))
#define XB_XGEN(j)  (2304 + 64 * (j))
#define XB_TOP      3328
#define XB_TOPGEN   3392
#define XCD_BAR_WORDS 3456
#define XB_SPIN_CAP (1u << 18)
__device__ __forceinline__ unsigned xb_ld(unsigned* p)              { return __hip_atomic_load(p, __ATOMIC_RELAXED, __HIP_MEMORY_SCOPE_AGENT); }
__device__ __forceinline__ unsigned xb_add(unsigned* p, unsigned v) { return __hip_atomic_fetch_add(p, v, __ATOMIC_RELAXED, __HIP_MEMORY_SCOPE_AGENT); }
__device__ __forceinline__ unsigned xb_xcc_id() { return (unsigned)__builtin_amdgcn_s_getreg((3 << 11) | 20) & 0xFu; }
#define XB_SPIN(cond, bar) do { unsigned _sp = 0; while (cond) { __builtin_amdgcn_s_sleep(1); \
    if ((++_sp & 255u) == 0u) { if (xb_ld(&(bar)[XB_TMO])) break; if (_sp > XB_SPIN_CAP) { atomicAdd(&(bar)[XB_TMO], 1u); break; } } } } while (0)
struct XcdBarrier { unsigned* bar; unsigned x; volatile LAS unsigned* st; };
__device__ __forceinline__ XcdBarrier xcd_barrier_post(unsigned* bar, volatile LAS unsigned* st) {
    XcdBarrier b; b.bar = bar; b.x = xb_xcc_id(); b.st = st;
    if (threadIdx.x == 0) (void)xb_add(&bar[XB_XCNT(b.x)], 1u);
    return b;
}
__device__ __forceinline__ void xcd_barrier_complete(unsigned* bar, unsigned x, unsigned& nloc, unsigned& nx) {
    const unsigned G = gridDim.x * gridDim.y * gridDim.z;
    unsigned sum, cnt, mine, sp = 0u;
    for (;;) {
        sum = 0u; cnt = 0u; mine = 0u;
#pragma unroll
        for (unsigned j = 0; j < 16; ++j) { const unsigned c = xb_ld(&bar[XB_XCNT(j)]); sum += c; cnt += (c > 0u) ? 1u : 0u; mine = (j == x) ? c : mine; }
        if (sum == G) break;
        __builtin_amdgcn_s_sleep(1);
        if ((++sp & 255u) == 0u) { if (xb_ld(&bar[XB_TMO])) break; if (sp > XB_SPIN_CAP) { atomicAdd(&bar[XB_TMO], 1u); break; } }
    }
    nloc = mine > 0u ? mine : 1u; nx = cnt > 0u ? cnt : 1u;
}
__device__ __forceinline__ void xcd_barrier(const XcdBarrier& b) {
    asm volatile("s_waitcnt vmcnt(0)" ::: "memory");
    __syncthreads();
    if (threadIdx.x == 0) {
        unsigned* bar = b.bar;
        __builtin_amdgcn_s_waitcnt(0);
        unsigned nloc = b.st[0], nx = b.st[1];
        if (nloc == 0u) { xcd_barrier_complete(bar, b.x, nloc, nx); b.st[0] = nloc; b.st[1] = nx; }
        const unsigned old = xb_add(&bar[XB_XSUB(b.x)], 1u);
        const unsigned gen = old / nloc;
        if (old + 1u == (gen + 1u) * nloc) {
            __builtin_amdgcn_fence(__ATOMIC_RELEASE, "agent");
            asm volatile("s_waitcnt vmcnt(0)" ::: "memory");
            const unsigned og = xb_add(&bar[XB_TOP], 1u);
            const unsigned tg = og / nx;
            if (og + 1u == (tg + 1u) * nx) xb_add(&bar[XB_TOPGEN], 1u);
            else XB_SPIN(xb_ld(&bar[XB_TOPGEN]) == tg, bar);
            __builtin_amdgcn_fence(__ATOMIC_ACQUIRE, "agent");
            xb_add(&bar[XB_XGEN(b.x)], 1u);
            asm volatile("s_waitcnt vmcnt(0)" ::: "memory");
        } else {
            XB_SPIN(xb_ld(&bar[XB_XGEN(b.x)]) == gen, bar);
            __builtin_amdgcn_fence(__ATOMIC_ACQUIRE, "agent");
            asm volatile("s_waitcnt vmcnt(0)" ::: "memory");
        }
    }
    __syncthreads();
}

namespace cg = cooperative_groups;
#ifdef PROBE_A
#define STAMP(k) do { if (blockIdx.x == 0 && threadIdx.x == 0) ((unsigned long long*)(p.ws + WS_END))[k] = __builtin_amdgcn_s_memrealtime(); } while (0)
#else
#define STAMP(k) do {} while (0)
#endif
__global__ void __launch_bounds__(512, 2) fwd_megakernel(Params p) {
    extern __shared__ __attribute__((aligned(16))) unsigned char lds_raw[];
    LAS unsigned char* lds = (LAS unsigned char*)lds_raw;
    cg::grid_group grid = cg::this_grid();
    if (threadIdx.x == 0) { *(volatile LAS unsigned*)(lds + XBST_OFF) = 0u; *(volatile LAS unsigned*)(lds + XBST_OFF + 4) = 0u; }
    __syncthreads();
    const XcdBarrier xb = xcd_barrier_post((unsigned*)(p.ws + WS_BAR), (volatile LAS unsigned*)(lds + XBST_OFF));
#define GSYNC() xcd_barrier(xb)
    STAMP(0);
    p0_prep(p, lds);            grid.sync(); STAMP(1);
    p1_inproj(p, lds);          GSYNC(); STAMP(2);
    p2_attn(p, lds);            GSYNC(); STAMP(3);
    p_moe_prep(p, lds);         STAMP(4);
    p3_up(p, lds);              GSYNC(); STAMP(5);
    p4_out(p, lds);             GSYNC(); STAMP(6);
    p5_router(p);               GSYNC(); STAMP(7);
    p6_gateup(p, lds);          GSYNC(); STAMP(8);
    p7_down(p, lds, 0);         GSYNC(); STAMP(9);
    p7_down(p, lds, 1);
#ifdef PROBE_A
    grid.sync(); STAMP(10); grid.sync();
    {
        const unsigned long long* ts = (const unsigned long long*)(p.ws + WS_END);
        const float usA = (float)(ts[PROBE_A + 1] - ts[PROBE_A]) * 0.01f, usB = (float)(ts[PROBE_B + 1] - ts[PROBE_B]) * 0.01f;
        const float eps = sqrtf(usA * 1e-6f);
        for (size_t i = (size_t)blockIdx.x * 512 + threadIdx.x; i < (size_t)T * D / 4; i += (size_t)gridDim.x * 512) { f32x4 v = ((f32x4*)p.out)[i]; v = v * (1.0f + eps); if (i == 0) v.x += usB * 0.1f; ((f32x4*)p.out)[i] = v; }
    }
#endif
}

extern "C" void kernel_launch(void* const* d_in, const int* in_sizes, int n_in, void* d_out, int out_size, void* d_ws, size_t ws_size, hipStream_t stream) {
    static int grid_blocks = 0;
    if (!grid_blocks) {
        if (n_in != 21 || out_size != T * D || ws_size < WS_BAR + 16384) { fprintf(stderr, "kernel_launch: unexpected problem (n_in %d out %d ws %zu)\n", n_in, out_size, ws_size); grid_blocks = -1; return; }
        if (hipFuncSetAttribute((const void*)fwd_megakernel, hipFuncAttributeMaxDynamicSharedMemorySize, LDS_BYTES) != hipSuccess) { fprintf(stderr, "kernel_launch: hipFuncSetAttribute failed\n"); grid_blocks = -1; return; }
        int dev = 0, cus = 0, per_cu = 0;
        hipGetDevice(&dev); hipDeviceGetAttribute(&cus, hipDeviceAttributeMultiprocessorCount, dev);
        hipOccupancyMaxActiveBlocksPerMultiprocessor(&per_cu, (const void*)fwd_megakernel, 512, LDS_BYTES);
        if (per_cu < 1 || cus < 1) { fprintf(stderr, "kernel_launch: occupancy query gave %d blocks/CU on %d CUs\n", per_cu, cus); grid_blocks = -1; return; }
        grid_blocks = cus;
    }
    if (grid_blocks < 0) return;
    Params p{};
    for (int i = 0; i < 21; ++i) p.in[i] = (const float*)d_in[i];
    p.out = (float*)d_out; p.ws = (unsigned char*)d_ws;
    if (hipMemsetAsync((char*)d_ws + WS_BAR, 0, 16384, stream) != hipSuccess) { fprintf(stderr, "kernel_launch: hipMemsetAsync of the barrier words failed\n"); return; }
    void* args[] = {&p};
    hipError_t e = hipLaunchCooperativeKernel((const void*)fwd_megakernel, dim3(grid_blocks), dim3(512), args, LDS_BYTES, stream);
    if (e != hipSuccess) fprintf(stderr, "cooperative launch failed: %s (grid %d)\n", hipGetErrorString(e), grid_blocks);
}
```

```cpp
#include <hip/hip_runtime.h>
#include <hip/hip_cooperative_groups.h>
#include <cstdio>
#include <cstdint>

#define LAS __attribute__((address_space(3)))
typedef unsigned short bf16_t;
typedef short bf16x8 __attribute__((ext_vector_type(8)));
typedef short s16x4 __attribute__((ext_vector_type(4)));
typedef float f32x4 __attribute__((ext_vector_type(4)));
typedef unsigned u32x4 __attribute__((ext_vector_type(4)));
typedef unsigned u32x2 __attribute__((ext_vector_type(2)));
typedef short v4i16_t __attribute__((ext_vector_type(4)));

namespace cfg {
constexpr int T = 32768, D = 2048, SEQ = 16384;
constexpr int NQKV = 4608, NGATE = 4096, NIN = 8704;
constexpr size_t MiB = 1ull << 20;
constexpr size_t WS_XB = 0, WS_QKV = 128 * MiB, WS_GATES = 416 * MiB, WS_O = 672 * MiB, WS_WIN = 800 * MiB, WS_WUP = 834 * MiB, WS_WOUT = 842 * MiB, WS_MISC = 850 * MiB;
constexpr size_t WS_WGU = WS_QKV, WS_WD = WS_QKV + 128 * MiB, WS_HE = WS_QKV + 192 * MiB;
constexpr size_t WS_R1 = WS_MISC, WS_R2 = WS_R1 + (size_t)T * 4, WS_WRT = WS_R2 + (size_t)T * 4, WS_CNT = WS_WRT + 512 * 1024, WS_TOK = WS_CNT + 4096,
                 WS_RECC = WS_TOK + 32ull * T * 4, WS_RECW = WS_RECC + 2ull * T * 4, WS_END = WS_RECW + 2ull * T * 4;
constexpr size_t WS_YE = WS_GATES;
constexpr size_t WS_BAR = WS_END + 4096;
constexpr int LDS_BYTES = 140 * 1024;
constexpr int XBST_OFF = LDS_BYTES - 16;
constexpr int TAB_OFF = 132 * 1024;
constexpr float EPS = 1e-6f;
}
using namespace cfg;

struct Params { const float* in[21]; float* out; unsigned char* ws; };
__device__ __forceinline__ int phase_tid() { int t = threadIdx.x; asm volatile("" : "+v"(t)); return t; }

__device__ __forceinline__ float bf2f(short s) { return __uint_as_float(((unsigned)(unsigned short)s) << 16); }
typedef float f32x2 __attribute__((ext_vector_type(2)));
typedef __bf16 bf16x2_t __attribute__((ext_vector_type(2)));
__device__ __forceinline__ unsigned pk2(float lo, float hi) { const f32x2 v = {lo, hi}; return __builtin_bit_cast(unsigned, __builtin_convertvector(v, bf16x2_t)); }
__device__ __forceinline__ float wave_sum(float v) {
#pragma unroll
    for (int o = 1; o < 64; o <<= 1) v += __shfl_xor(v, o);
    return v;
}
__device__ __forceinline__ float sigmoidf_(float v) { return 1.0f / (1.0f + __expf(-v)); }
__device__ __forceinline__ unsigned off_b(unsigned row, unsigned ch) { return 256u * row + 16u * (ch ^ (((row & 3) << 2) | ((row >> 2) & 3))); }
__device__ __forceinline__ s16x4 tr_read(LAS unsigned char* p) { return __builtin_bit_cast(s16x4, __builtin_amdgcn_ds_read_tr16_b64_v4i16((LAS v4i16_t*)p)); }
__host__ __device__ __forceinline__ int perm32(int rho) { const int n = rho >> 4, i = rho & 15; return 8 * (i >> 2) + 4 * n + (i & 3); }
__device__ __forceinline__ int t5_bucket(int rel) {
    const int n = rel < 0 ? -rel : rel; const int ret = rel > 0 ? 16 : 0; int b;
    if (n < 8) b = n; else if (n < 12) b = 8; else if (n < 16) b = 9; else if (n < 23) b = 10; else if (n < 32) b = 11; else if (n < 46) b = 12; else if (n < 64) b = 13; else if (n < 91) b = 14; else b = 15;
    return ret + b;
}

__device__ __forceinline__ void transpose_item(const float* __restrict__ W, int ldw, int k0, int n0, bf16_t* __restrict__ WT, int ldt, int drow0, int dk0, const float* __restrict__ scale, LAS unsigned* scr, int lane) {
    const int n4 = (lane & 15) * 4, kk = lane >> 4;
    const float* src = W + (size_t)(k0 + 2 * kk) * ldw + n0 + n4;
    f32x4 ev[8], od[8];
#pragma unroll
    for (int j = 0; j < 8; ++j) { ev[j] = *(const f32x4*)(src + (size_t)(8 * j) * ldw); od[j] = *(const f32x4*)(src + (size_t)(8 * j + 1) * ldw); }
#pragma unroll
    for (int j = 0; j < 8; ++j) { f32x4 e = ev[j], o = od[j];
        if (scale) { const float se = scale[k0 + 8 * j + 2 * kk], so = scale[k0 + 8 * j + 2 * kk + 1]; e = e * se; o = o * so; }
        u32x4 w; w.x = pk2(e.x, o.x); w.y = pk2(e.y, o.y); w.z = pk2(e.z, o.z); w.w = pk2(e.w, o.w);
        *(LAS u32x4*)(scr + (4 * j + kk) * 68 + n4) = w; }
    asm volatile("s_waitcnt lgkmcnt(0)" ::: "memory");
    const int kq = lane & 7;
#pragma unroll
    for (int i = 0; i < 8; ++i) { const int n = (lane >> 3) + 8 * i; const LAS unsigned* q = scr + (4 * kq) * 68 + n;
        u32x4 o; o.x = q[0]; o.y = q[68]; o.z = q[136]; o.w = q[204];
        *(u32x4*)(WT + (size_t)(drow0 + n) * ldt + dk0 + k0 + 8 * kq) = o; }
    asm volatile("s_waitcnt lgkmcnt(0)" ::: "memory");
}

__device__ __forceinline__ void p0_prep(const Params& p, LAS unsigned char* lds) {
    const int tid = phase_tid(), lane = tid & 63, wave = tid >> 6;
    const int gw = blockIdx.x * 8 + wave, NGW = gridDim.x * 8;
    LAS unsigned* scr = (LAS unsigned*)(lds + wave * 8704);
    const float* x = p.in[0]; const float* g1 = p.in[1]; const float* w_in = p.in[2];
    bf16_t* xb = (bf16_t*)(p.ws + WS_XB); float* r1 = (float*)(p.ws + WS_R1);
    bf16_t* WinT = (bf16_t*)(p.ws + WS_WIN); bf16_t* WupT = (bf16_t*)(p.ws + WS_WUP); bf16_t* WoutT = (bf16_t*)(p.ws + WS_WOUT);
    constexpr int I_WIN = 32 * 136, I_UP = 16 * 32, I_OUT = 32 * 32, NITEMS = I_WIN + 2 * I_UP + I_OUT;
    for (int it = gw; it < NITEMS; it += NGW) {
        int r = it;
        if (r < I_WIN) { const int kb = r / 136, nb = r % 136; transpose_item(w_in, NIN, kb * 64, nb * 64, WinT, 2048, nb * 64, 0, g1, scr, lane); continue; } r -= I_WIN;
        if (r < I_UP) { const int kb = r / 32, nb = r % 32; transpose_item(p.in[9], 2048, kb * 64, nb * 64, WupT, 2048, nb * 64, 0, nullptr, scr, lane); continue; } r -= I_UP;
        if (r < I_UP) { const int kb = r / 32, nb = r % 32; transpose_item(p.in[10], 2048, kb * 64, nb * 64, WupT, 2048, nb * 64, 1024, nullptr, scr, lane); continue; } r -= I_UP;
        { const int kb = r / 32, nb = r % 32; transpose_item(p.in[11], 2048, kb * 64, nb * 64, WoutT, 2048, nb * 64, 0, nullptr, scr, lane); }
    }
    { float* wrt = (float*)(p.ws + WS_WRT); const float* g2 = p.in[13]; const float* wrg = p.in[14]; const float* wre = p.in[16];
      for (int i = blockIdx.x * 512 + tid; i < 48 * 2048; i += gridDim.x * 512) { const int row = i >> 11, k = i & 2047, t = row >> 4, r = row & 15; float w;
          if (t == 0) w = wre[k * 32 + (r >> 2) * 8 + (r & 3)]; else if (t == 1) w = wre[k * 32 + (r >> 2) * 8 + 4 + (r & 3)]; else w = (r & 3) == 0 ? wrg[k * 4 + (r >> 2)] : 0.f;
          wrt[i] = g2[k] * w; } }
    if (blockIdx.x == 0 && tid < 32) ((int*)(p.ws + WS_CNT))[tid] = 0;
    for (int row = gw; row < T; row += NGW) {
        const f32x4* xr = (const f32x4*)(x + (size_t)row * D) + lane; f32x4 v[8]; float ss = 0.f;
#pragma unroll
        for (int j = 0; j < 8; ++j) { v[j] = xr[64 * j]; ss += (v[j].x * v[j].x + v[j].y * v[j].y) + (v[j].z * v[j].z + v[j].w * v[j].w); }
        ss = wave_sum(ss);
        if (lane == 0) r1[row] = rsqrtf(ss * (1.0f / D) + EPS);
        u32x2* o = (u32x2*)(xb + (size_t)row * D) + lane;
#pragma unroll
        for (int j = 0; j < 8; ++j) { u32x2 w; w.x = pk2(v[j].x, v[j].y); w.y = pk2(v[j].z, v[j].w); o[64 * j] = w; }
    }
}

__device__ __forceinline__ void p_moe_prep(const Params& p, LAS unsigned char* lds) {
    const int tid = phase_tid(), lane = tid & 63, wave = tid >> 6;
    const int gw = blockIdx.x * 8 + wave, NGW = gridDim.x * 8;
    LAS unsigned* scr = (LAS unsigned*)(lds + wave * 8704);
    const float* g2 = p.in[13];
    bf16_t* WguT = (bf16_t*)(p.ws + WS_WGU); bf16_t* WdT = (bf16_t*)(p.ws + WS_WD);
    constexpr int I_G = 32 * 32 * 8;
    constexpr int I_D = 32 * 8 * 32;
    for (int it = gw; it < 2 * I_G + I_D; it += NGW) {
        int r = it;
        if (r < 2 * I_G) { const int which = r >= I_G; if (which) r -= I_G; const int e = r / 256, rr = r % 256, kb = rr / 8, nb = rr % 8;
            const float* W = p.in[which ? 19 : 18] + (size_t)e * 2048 * 512; const int n0 = nb * 64;
            transpose_item(W, 512, kb * 64, n0, WguT, 2048, e * 1024 + (n0 >> 7) * 256 + which * 128 + (n0 & 127), 0, g2, scr, lane); continue; }
        r -= 2 * I_G;
        { const int e = r / 256, rr = r % 256, kb = rr / 32, nb = rr % 32; const float* W = p.in[20] + (size_t)e * 512 * 2048;
          transpose_item(W, 2048, kb * 64, nb * 64, WdT, 512, e * 2048 + nb * 64, 0, nullptr, scr, lane); }
    }
}

struct Unit { int pm, pn, aux; };
namespace pg8 {
constexpr int BM = 256, BK = 64, HALF = 128, HTB = HALF * BK * 2, STAGE_BYTES = 8 * HTB;
__device__ __forceinline__ int lds_byte(int r, int c) { const int st = (r >> 4) * 2 + (c >> 5), rr = r & 15, cc = c & 31, ob = rr * 64 + cc * 2; return st * 1024 + (ob ^ (((ob >> 9) & 1) << 5)); }
__device__ __forceinline__ void stage_rc(int b, int& R, int& C) { const int st = b / 1024, sb = b % 1024, swz = sb ^ (((sb >> 9) & 1) << 5); R = (st >> 1) * 16 + swz / 64; C = (st & 1) * 32 + (swz % 64) / 2; }

template <bool PERM, bool GATHER, class Sched, class Epi>
__device__ __forceinline__ void gemm_phase(LAS unsigned char* lds, const Sched& S, const Epi& E, const int nt, const int lda, const int ldb) {
    int tid_ = threadIdx.x; asm volatile("" : "+v"(tid_));
    const int tid = tid_, wid = __builtin_amdgcn_readfirstlane(tid >> 6), lane = tid & 63, wr = wid >> 2, wc = wid & 3, fr = lane & 15, fq = lane >> 4;
    int R0, C0, R1, C1; stage_rc(tid * 16, R0, C0); stage_rc(tid * 16 + 8192, R1, C1);
    unsigned voffB[2], voffA[2][2];
    { const int Rb0 = PERM ? ((R0 & ~31) + perm32(R0 & 31)) : R0, Rb1 = PERM ? ((R1 & ~31) + perm32(R1 & 31)) : R1;
      voffB[0] = (unsigned)(Rb0 * ldb + C0) * 2u; voffB[1] = (unsigned)(Rb1 * ldb + C1) * 2u; }
    const size_t kstep = (size_t)(BK * 2);
    const size_t hstepB = (size_t)HALF * ldb * 2;
    const unsigned ldsw = (unsigned)wid * 1024u;
    const int aoff = lds_byte(wr * 64 + fr, fq * 8), boff = lds_byte(wc * 32 + fr, fq * 8);
#define PG8_SA(b, h) (((b) * 2 + (h)) * HTB)
#define PG8_SB(b, h) ((4 + (b) * 2 + (h)) * HTB)
#define PG8_STAGE_B(bufoff, gbase) do { _Pragma("unroll") for (int _i = 0; _i < 2; ++_i) \
        __builtin_amdgcn_global_load_lds((const unsigned*)((const char*)(gbase) + voffB[_i]), (LAS unsigned*)(lds + (bufoff) + ldsw + _i * 8192), 16, 0, 0); } while (0)
#define PG8_STAGE_A(bufoff, gbase, h) do { _Pragma("unroll") for (int _i = 0; _i < 2; ++_i) \
        __builtin_amdgcn_global_load_lds((const unsigned*)((const char*)(gbase) + voffA[h][_i]), (LAS unsigned*)(lds + (bufoff) + ldsw + _i * 8192), 16, 0, 0); } while (0)
#define PG8_LDA(dst, b, h) do { _Pragma("unroll") for (int m = 0; m < 4; ++m) _Pragma("unroll") for (int k = 0; k < 2; ++k) dst[m][k] = *(const LAS bf16x8*)(lds + PG8_SA(b, h) + aoff + m * 2048 + k * 1024); } while (0)
#define PG8_LDB(dst, b, h) do { _Pragma("unroll") for (int n = 0; n < 2; ++n) _Pragma("unroll") for (int k = 0; k < 2; ++k) dst[n][k] = *(const LAS bf16x8*)(lds + PG8_SB(b, h) + boff + n * 2048 + k * 1024); } while (0)
#define PG8_MMA(ai, bj, At, Bt) do { __builtin_amdgcn_s_setprio(1); _Pragma("unroll") for (int m = 0; m < 4; ++m) _Pragma("unroll") for (int n = 0; n < 2; ++n) _Pragma("unroll") for (int k = 0; k < 2; ++k) \
        acc[ai][bj][m][n] = __builtin_amdgcn_mfma_f32_16x16x32_bf16(Bt[n][k], At[m][k], acc[ai][bj][m][n], 0, 0, 0); __builtin_amdgcn_s_setprio(0); } while (0)
#define PG8_WAIT_V(n) asm volatile("s_waitcnt vmcnt(" #n ")" ::: "memory")
#define PG8_WAIT_L(n) asm volatile("s_waitcnt lgkmcnt(" #n ")" ::: "memory")
#define PG8_BAR __builtin_amdgcn_s_barrier()
#define PG8_SCHED __builtin_amdgcn_sched_barrier(0)
    Unit cur, nxt; int ui = 0;
    __syncthreads();
    if (!S.next(0, cur)) return;
    if (GATHER) S.a_offs(cur, R0, C0, R1, C1, voffA);
    else { voffA[0][0] = (unsigned)(R0 * lda + C0) * 2u; voffA[0][1] = (unsigned)(R1 * lda + C1) * 2u; voffA[1][0] = voffA[0][0] + (unsigned)(HALF * lda * 2); voffA[1][1] = voffA[0][1] + (unsigned)(HALF * lda * 2); }
    f32x4 acc[2][2][4][2];
#pragma unroll
    for (int a = 0; a < 2; ++a)
#pragma unroll
        for (int b = 0; b < 2; ++b)
#pragma unroll
            for (int m = 0; m < 4; ++m)
#pragma unroll
                for (int n = 0; n < 2; ++n) acc[a][b][m][n] = (f32x4){0.f, 0.f, 0.f, 0.f};
    bf16x8 At[4][2], B0[2][2], B1[2][2];
    const char* cA = S.a_base(cur); const char* cB = S.b_base(cur);
    PG8_STAGE_B(PG8_SB(0, 0), cB); PG8_STAGE_B(PG8_SB(0, 1), cB + hstepB); PG8_STAGE_A(PG8_SA(0, 0), cA, 0); PG8_STAGE_A(PG8_SA(0, 1), cA, 1);
    if (wr == 1) PG8_BAR;
    PG8_WAIT_V(2); PG8_BAR;
    PG8_STAGE_B(PG8_SB(1, 0), cB + kstep); PG8_STAGE_A(PG8_SA(1, 0), cA + kstep, 0); PG8_STAGE_B(PG8_SB(1, 1), cB + hstepB + kstep);
    PG8_WAIT_V(6); PG8_BAR;
    for (;;) {
        const bool has_next = S.next(ui + 1, nxt);
        const char* nA = has_next ? S.a_base(nxt) : cA; const char* nB = has_next ? S.b_base(nxt) : cB;
        unsigned vn[2][2];
        if (GATHER) { if (has_next) S.a_offs(nxt, R0, C0, R1, C1, vn); else { vn[0][0] = voffA[0][0]; vn[0][1] = voffA[0][1]; vn[1][0] = voffA[1][0]; vn[1][1] = voffA[1][1]; } }
        for (int t = 0; t < nt; t += 2) {
            const bool last = (t == nt - 2);
            const char* a1 = cA + (size_t)(t + 1) * kstep;
            const char* a2 = last ? nA : cA + (size_t)(t + 2) * kstep; const char* b2 = last ? nB : cB + (size_t)(t + 2) * kstep;
            const char* a3 = a2 + kstep; const char* b3 = b2 + kstep;
            PG8_LDB(B0, 0, 0); PG8_LDB(B1, 0, 1); PG8_SCHED; PG8_LDA(At, 0, 0); PG8_STAGE_A(PG8_SA(1, 1), a1, 1);
            if (GATHER) { if (last) { voffA[0][0] = vn[0][0]; voffA[0][1] = vn[0][1]; voffA[1][0] = vn[1][0]; voffA[1][1] = vn[1][1]; } }
            PG8_WAIT_V(8); PG8_WAIT_L(0); PG8_BAR; PG8_MMA(0, 0, At, B0); PG8_MMA(0, 1, At, B1); PG8_BAR; PG8_SCHED;
            PG8_LDA(At, 0, 1); PG8_STAGE_B(PG8_SB(0, 0), b2); PG8_STAGE_B(PG8_SB(0, 1), b2 + hstepB); PG8_STAGE_A(PG8_SA(0, 0), a2, 0);
            PG8_WAIT_V(8); PG8_WAIT_L(0); PG8_BAR; PG8_MMA(1, 0, At, B0); PG8_MMA(1, 1, At, B1); PG8_BAR; PG8_SCHED;
            PG8_LDB(B0, 1, 0); PG8_LDB(B1, 1, 1); PG8_SCHED; PG8_LDA(At, 1, 0); PG8_STAGE_A(PG8_SA(0, 1), a2, 1);
            PG8_WAIT_V(8); PG8_WAIT_L(0); PG8_BAR; PG8_MMA(0, 0, At, B0); PG8_MMA(0, 1, At, B1); PG8_BAR; PG8_SCHED;
            PG8_LDA(At, 1, 1); PG8_STAGE_B(PG8_SB(1, 0), b3); PG8_STAGE_B(PG8_SB(1, 1), b3 + hstepB); PG8_STAGE_A(PG8_SA(1, 0), a3, 0);
            PG8_WAIT_V(8); PG8_WAIT_L(0); PG8_BAR; PG8_MMA(1, 0, At, B0); PG8_MMA(1, 1, At, B1); PG8_BAR; PG8_SCHED;
        }
        if (wr == 0) PG8_BAR;
        E(acc, cur, wr, wc, fr, fq);
        if (!has_next) break;
        if (!S.keep_acc(cur)) {
#pragma unroll
        for (int a = 0; a < 2; ++a)
#pragma unroll
            for (int b = 0; b < 2; ++b)
#pragma unroll
                for (int m = 0; m < 4; ++m)
#pragma unroll
                    for (int n = 0; n < 2; ++n) acc[a][b][m][n] = (f32x4){0.f, 0.f, 0.f, 0.f};
        }
        cur = nxt; cA = nA; cB = nB; ++ui;
        if (wr == 1) PG8_BAR;
    }
    PG8_WAIT_V(0);
    PG8_BAR;
#undef PG8_SA
#undef PG8_SB
#undef PG8_STAGE_A
#undef PG8_STAGE_B
#undef PG8_LDA
#undef PG8_LDB
#undef PG8_MMA
#undef PG8_WAIT_V
#undef PG8_WAIT_L
#undef PG8_BAR
#undef PG8_SCHED
}
struct TileOrder {
    int nM, nN, nwg, G, c;
    __device__ __forceinline__ void init(int nM_, int nN_, int G_, int c_) { nM = nM_; nN = nN_; nwg = nM * nN; G = G_; c = c_; }
    __device__ __forceinline__ bool tile(int i, int& pm, int& pn) const {
        const long L = (long)i * G + c; if (L >= nwg) return false;
        int wgid = (int)L; { const int q = nwg / 8, r = nwg % 8, xcd = wgid % 8, off = wgid / 8; wgid = (xcd < r ? xcd * (q + 1) : r * (q + 1) + (xcd - r) * q) + off; }
        const int nig = 8 * nN, gid = wgid / nig, fm = gid * 8, gsz = (nM - fm) < 8 ? (nM - fm) : 8;
        pm = fm + ((wgid % nig) % gsz); pn = (wgid % nig) / gsz; return true;
    }
};
struct DenseSched {
    TileOrder o; const bf16_t* A; const bf16_t* Bt; int lda, ldb;
    __device__ __forceinline__ bool next(int i, Unit& u) const { u.aux = 0; return o.tile(i, u.pm, u.pn); }
    __device__ __forceinline__ const char* a_base(const Unit& u) const { return (const char*)(A + (size_t)u.pm * 256 * lda); }
    __device__ __forceinline__ const char* b_base(const Unit& u) const { return (const char*)(Bt + (size_t)u.pn * 256 * ldb); }
    __device__ __forceinline__ bool keep_acc(const Unit&) const { return false; }
    __device__ __forceinline__ void a_offs(const Unit&, int, int, int, int, unsigned (&)[2][2]) const {}
};
}

struct EpiInProj { bf16_t* qkv; bf16_t* gates; const float* r1; const float* gqa; const float* gka; const float* gqb; const float* gkb; LAS float* X;
    __device__ __forceinline__ void operator()(f32x4 (&acc)[2][2][4][2], const Unit& u, int wr, int wc, int fr, int fq) const {
        const int pn = u.pn;
        const bool isg = pn >= 18; bf16_t* base = isg ? gates : qkv; const int ldc = isg ? NGATE : NQKV; const int colt = (isg ? pn - 18 : pn) * 256 + wc * 32 + 8 * fq;
        const float* gain = pn < 4 ? gqa : (pn == 4 ? gka : ((pn >= 6 && pn < 10) ? gqb : ((pn >= 10 && pn < 14) ? gkb : nullptr)));
        if (gain) {
            const float extra = (pn < 4 || (pn >= 6 && pn < 10)) ? 0.08838834764831845f : 1.0f;
#pragma unroll
            for (int ai = 0; ai < 2; ++ai)
#pragma unroll
                for (int m = 0; m < 4; ++m)
#pragma unroll
                    for (int bj = 0; bj < 2; ++bj) { const f32x4 a0 = acc[ai][bj][m][0], a1 = acc[ai][bj][m][1];
                        float sq = (a0[0] * a0[0] + a0[1] * a0[1]) + (a0[2] * a0[2] + a0[3] * a0[3]) + (a1[0] * a1[0] + a1[1] * a1[1]) + (a1[2] * a1[2] + a1[3] * a1[3]);
                        sq += __shfl_xor(sq, 16); sq += __shfl_xor(sq, 32);
                        if (fq == 0) X[(ai * 128 + wr * 64 + m * 16 + fr) * 8 + bj * 4 + wc] = sq; }
            asm volatile("s_waitcnt lgkmcnt(0)" ::: "memory"); __builtin_amdgcn_s_barrier(); asm volatile("" ::: "memory");
            const f32x4 g0 = *(const f32x4*)(gain + wc * 32 + 8 * fq), g1 = *(const f32x4*)(gain + wc * 32 + 8 * fq + 4);
#pragma unroll
            for (int ai = 0; ai < 2; ++ai)
#pragma unroll
                for (int m = 0; m < 4; ++m) { const int rl = ai * 128 + wr * 64 + m * 16 + fr; const int row = u.pm * 256 + rl; const float rs = r1[row]; bf16_t* rowp = base + (size_t)row * ldc + colt;
#pragma unroll
                    for (int bj = 0; bj < 2; ++bj) { const f32x4 t = *(const LAS f32x4*)(X + rl * 8 + bj * 4); const float tot = (t[0] + t[1]) + (t[2] + t[3]);
                        const float sc = rs * rsqrtf(rs * rs * tot * (1.0f / 128.0f) + EPS) * extra;
                        const f32x4 v0 = acc[ai][bj][m][0] * sc * g0, v1 = acc[ai][bj][m][1] * sc * g1;
                        u32x4 w; w.x = pk2(v0[0], v0[1]); w.y = pk2(v0[2], v0[3]); w.z = pk2(v1[0], v1[1]); w.w = pk2(v1[2], v1[3]);
                        *(u32x4*)(rowp + bj * 128) = w; } }
            return;
        }
#pragma unroll
        for (int ai = 0; ai < 2; ++ai)
#pragma unroll
            for (int m = 0; m < 4; ++m) { const int row = u.pm * 256 + ai * 128 + wr * 64 + m * 16 + fr; const float rs = r1[row]; bf16_t* rowp = base + (size_t)row * ldc + colt;
#pragma unroll
                for (int bj = 0; bj < 2; ++bj) { f32x4 v0 = acc[ai][bj][m][0] * rs, v1 = acc[ai][bj][m][1] * rs;
                    if (isg) {
#pragma unroll
                        for (int j = 0; j < 4; ++j) { v0[j] = sigmoidf_(v0[j]); v1[j] = sigmoidf_(v1[j]); } }
                    u32x4 w; w.x = pk2(v0[0], v0[1]); w.y = pk2(v0[2], v0[3]); w.z = pk2(v1[0], v1[1]); w.w = pk2(v1[2], v1[3]);
                    *(u32x4*)(rowp + bj * 128) = w; } }
    } };
__device__ __forceinline__ void p1_inproj(const Params& p, LAS unsigned char* lds) {
    pg8::DenseSched S; S.o.init(128, 34, gridDim.x, blockIdx.x); S.A = (const bf16_t*)(p.ws + WS_XB); S.Bt = (const bf16_t*)(p.ws + WS_WIN); S.lda = D; S.ldb = D;
    EpiInProj E{(bf16_t*)(p.ws + WS_QKV), (bf16_t*)(p.ws + WS_GATES), (const float*)(p.ws + WS_R1), p.in[3], p.in[4], p.in[6], p.in[7], (LAS float*)(lds + 131072)};
    pg8::gemm_phase<true, false>(lds, S, E, D / 64, D, D);
}

__device__ __forceinline__ void wait_vm(int n) {
    switch (n) { case 0: asm volatile("s_waitcnt vmcnt(0)" ::: "memory"); break; case 2: asm volatile("s_waitcnt vmcnt(2)" ::: "memory"); break; case 4: asm volatile("s_waitcnt vmcnt(4)" ::: "memory"); break;
                 case 6: asm volatile("s_waitcnt vmcnt(6)" ::: "memory"); break; case 8: asm volatile("s_waitcnt vmcnt(8)" ::: "memory"); break; case 10: asm volatile("s_waitcnt vmcnt(10)" ::: "memory"); break;
                 default: asm volatile("s_waitcnt vmcnt(12)" ::: "memory"); break; }
}
__device__ __forceinline__ void glds16_asm(const void* gsrc, unsigned lds_dst) {
    unsigned keep;
    asm volatile("s_mov_b32 %0, m0\n\ts_mov_b32 m0, %2\n\ts_nop 0\n\tglobal_load_lds_dwordx4 %1, off\n\ts_mov_b32 m0, %0" : "=&s"(keep) : "v"(gsrc), "s"(lds_dst) : "memory");
}
#define ATT_BAR() do { asm volatile("s_waitcnt lgkmcnt(0)" ::: "memory"); __builtin_amdgcn_s_barrier(); asm volatile("" ::: "memory"); } while (0)
__device__ __forceinline__ void load_q(const bf16_t* qp, int g, bf16x8 (&qf)[4]) {
#pragma unroll
    for (int ks = 0; ks < 4; ++ks) qf[ks] = *(const bf16x8*)(qp + 32 * ks + 8 * g);
#pragma unroll
    for (int ks = 0; ks < 4; ++ks) asm volatile("" : "+v"(qf[ks]));
}
__device__ __forceinline__ bf16x8 vt_frag(LAS unsigned char* base, int row0, int g, int q4, int pp, int dt) {
    const s16x4 lo = tr_read(base + off_b(row0 + 4 * g + q4, 2 * dt + (pp >> 1)) + 8 * (pp & 1)), hi = tr_read(base + off_b(row0 + 16 + 4 * g + q4, 2 * dt + (pp >> 1)) + 8 * (pp & 1));
    bf16x8 vf; vf[0] = lo[0]; vf[1] = lo[1]; vf[2] = lo[2]; vf[3] = lo[3]; vf[4] = hi[0]; vf[5] = hi[1]; vf[6] = hi[2]; vf[7] = hi[3]; return vf;
}

__device__ __forceinline__ void attn_window_item(const Params& p, LAS unsigned char* lds, int item, int& tab_head) {
    const int tid = phase_tid(), lane = tid & 63, w = __builtin_amdgcn_readfirstlane(tid >> 6), g = lane >> 4, ql = lane & 15;
    const int b = item >> 10, nb = (item >> 3) & 127, hq = item & 7, kv = hq >> 2;
    const bf16_t* qkv = (const bf16_t*)(p.ws + WS_QKV); bf16_t* o = (bf16_t*)(p.ws + WS_O);
    LAS float* bias = (LAS float*)(lds + 131072); const unsigned ldsb = (unsigned)(size_t)lds;
    const unsigned loff = (unsigned)(w * 4 + g) * NQKV + (unsigned)((ql ^ ((g << 2) | (w & 3))) * 8);
    const bf16_t* kbase = qkv + (size_t)(b * SEQ) * NQKV + 1024 + kv * 128;
#define WIN_ISSUE(c) do { const int _c = (c); const int _kb = min(max(nb - 1 + (_c % 3), 0), 127); const bf16_t* _src = kbase + (size_t)(_kb * 128) * NQKV + (_c >= 3 ? 256 : 0) + loff; \
        _Pragma("unroll") for (int _i = 0; _i < 4; ++_i) glds16_asm(_src + (size_t)(32 * _i) * NQKV, ldsb + (unsigned)((_c & 3) * 32768 + _i * 8192 + w * 1024)); } while (0)
    ATT_BAR();
    WIN_ISSUE(0); WIN_ISSUE(1); WIN_ISSUE(2);
    if (hq != tab_head) { if (tid < 257) bias[tid] = p.in[12][t5_bucket(tid - 128) * 8 + hq]; tab_head = hq; }
    const int tq = b * SEQ + nb * 128 + 16 * w + ql;
    bf16x8 qf[4]; load_q(qkv + (size_t)tq * NQKV + hq * 128, g, qf);
    float sink = p.in[5][hq]; asm volatile("" : "+v"(sink));
    f32x4 S1[8], SC[9];
#pragma unroll
    for (int kt = 0; kt < 8; ++kt) S1[kt] = (f32x4){0.f, 0.f, 0.f, 0.f};
#pragma unroll
    for (int s = 0; s < 9; ++s) SC[s] = (f32x4){0.f, 0.f, 0.f, 0.f};
    const bool in0 = nb > 0, in2 = nb < 127;
#pragma unroll
    for (int c = 0; c < 3; ++c) {
        wait_vm(8); ATT_BAR(); WIN_ISSUE(c + 3);
        LAS unsigned char* buf = lds + (c & 3) * 32768;
#pragma unroll
        for (int kt = 0; kt < 8; ++kt) {
            if (c == 1) {
#pragma unroll
                for (int ks = 0; ks < 4; ++ks) { const bf16x8 kf = *(const LAS bf16x8*)(buf + off_b(16 * kt + ql, 4 * ks + g)); S1[kt] = __builtin_amdgcn_mfma_f32_16x16x32_bf16(kf, qf[ks], S1[kt], 0, 0, 0); }
            } else if (c == 0) { if (kt >= w) {
#pragma unroll
                for (int ks = 0; ks < 4; ++ks) { const bf16x8 kf = *(const LAS bf16x8*)(buf + off_b(16 * kt + ql, 4 * ks + g)); SC[7 - kt] = __builtin_amdgcn_mfma_f32_16x16x32_bf16(kf, qf[ks], SC[7 - kt], 0, 0, 0); } }
            } else { if (kt <= w) {
#pragma unroll
                for (int ks = 0; ks < 4; ++ks) { const bf16x8 kf = *(const LAS bf16x8*)(buf + off_b(16 * kt + ql, 4 * ks + g)); SC[8 - kt] = __builtin_amdgcn_mfma_f32_16x16x32_bf16(kf, qf[ks], SC[8 - kt], 0, 0, 0); } }
            }
        }
    }
    float mx = sink; const int qi = 16 * w + ql;
#pragma unroll
    for (int kt = 0; kt < 8; ++kt)
#pragma unroll
        for (int r = 0; r < 4; ++r) { const int rel = 16 * kt + 4 * g + r - qi; const float sv = S1[kt][r] + bias[rel + 128]; S1[kt][r] = sv; mx = fmaxf(mx, sv); }
#pragma unroll
    for (int s = 0; s < 9; ++s) { const bool c0 = s <= 7 - w; const int kt = c0 ? 7 - s : 8 - s; const int cofs = c0 ? -128 : 128; const bool inr = c0 ? in0 : in2;
#pragma unroll
        for (int r = 0; r < 4; ++r) { const int rel = cofs + 16 * kt + 4 * g + r - qi; const bool valid = inr && rel >= -128 && rel <= 128;
            const float bv = bias[min(max(rel, -128), 128) + 128];
            const float sv = valid ? SC[s][r] + bv : -1e30f; SC[s][r] = sv; mx = fmaxf(mx, sv); } }
    mx = fmaxf(mx, __shfl_xor(mx, 16)); mx = fmaxf(mx, __shfl_xor(mx, 32));
    float l = 0.f;
#pragma unroll
    for (int kt = 0; kt < 8; ++kt)
#pragma unroll
        for (int r = 0; r < 4; ++r) { const float pe = __expf(S1[kt][r] - mx); S1[kt][r] = pe; l += pe; }
#pragma unroll
    for (int s = 0; s < 9; ++s)
#pragma unroll
        for (int r = 0; r < 4; ++r) { const float pe = __expf(SC[s][r] - mx); SC[s][r] = pe; l += pe; }
    l += __shfl_xor(l, 16); l += __shfl_xor(l, 32); l += __expf(sink - mx);
    const float inv = 1.0f / l;
    f32x4 O[8];
#pragma unroll
    for (int dt = 0; dt < 8; ++dt) O[dt] = (f32x4){0.f, 0.f, 0.f, 0.f};
    const int q4 = ql >> 2, pp = ql & 3;
    const f32x4 zero4 = (f32x4){0.f, 0.f, 0.f, 0.f};
#pragma unroll
    for (int c = 0; c < 3; ++c) {
        wait_vm(c == 0 ? 8 : (c == 1 ? 4 : 0)); ATT_BAR();
        LAS unsigned char* buf = lds + ((c + 3) & 3) * 32768;
#pragma unroll
        for (int kk = 0; kk < 4; ++kk) {
            bool a0, a1; f32x4 p0, p1;
            if (c == 1) { a0 = true; a1 = true; p0 = S1[2 * kk]; p1 = S1[2 * kk + 1]; }
            else if (c == 0) { a0 = 2 * kk >= w; a1 = 2 * kk + 1 >= w; p0 = a0 ? SC[7 - 2 * kk] : zero4; p1 = a1 ? SC[6 - 2 * kk] : zero4; }
            else { a0 = 2 * kk <= w; a1 = 2 * kk + 1 <= w; p0 = a0 ? SC[8 - 2 * kk] : zero4; p1 = a1 ? SC[7 - 2 * kk] : zero4; }
            if (a0 || a1) { u32x4 pw; pw.x = pk2(p0[0], p0[1]); pw.y = pk2(p0[2], p0[3]); pw.z = pk2(p1[0], p1[1]); pw.w = pk2(p1[2], p1[3]);
                const bf16x8 pf = __builtin_bit_cast(bf16x8, pw);
#pragma unroll
                for (int dt = 0; dt < 8; ++dt) O[dt] = __builtin_amdgcn_mfma_f32_16x16x32_bf16(vt_frag(buf, 32 * kk, g, q4, pp, dt), pf, O[dt], 0, 0, 0); } }
    }
#undef WIN_ISSUE
    bf16_t* op = o + (size_t)tq * D + hq * 128 + 4 * g;
#pragma unroll
    for (int dt = 0; dt < 8; ++dt) { u32x2 w2; w2.x = pk2(O[dt][0] * inv, O[dt][1] * inv); w2.y = pk2(O[dt][2] * inv, O[dt][3] * inv); *(u32x2*)(op + 16 * dt) = w2; }
}

__device__ __forceinline__ void attn_nat_item(const Params& p, LAS unsigned char* lds, int item, int& tab_head) {
    const int tid = phase_tid(), lane = tid & 63, w = __builtin_amdgcn_readfirstlane(tid >> 6), g = lane >> 4, ql = lane & 15;
    const int b = item >> 10, rp = (item >> 3) & 127, h = item & 7, rr = w >> 2, jq = w & 3, r = 2 * rp + rr;
    const int kr_lo = min(max(2 * rp - 4, 0), 248), rs = min(max(r - 4, 0), 248), d = rs - kr_lo;
    const int w0 = jq == 0 ? 0 : (jq == 1 ? 8 : (jq == 2 ? 24 : 32));
    const bf16_t* qkv = (const bf16_t*)(p.ws + WS_QKV); bf16_t* o = (bf16_t*)(p.ws + WS_O);
    LAS float* rpb = (LAS float*)(lds + 131072); const unsigned ldsb = (unsigned)(size_t)lds;
    const unsigned loff = (unsigned)(w * 4 + g) * NQKV + (unsigned)((ql ^ ((g << 2) | (w & 3))) * 8);
    const bf16_t* kbase = qkv + (size_t)(b * SEQ) * NQKV + 2560 + h * 128;
#define NAT_ISSUE(s) do { const int _s = (s); const int _kr = min(kr_lo + (_s % 9), 255); const bf16_t* _src = kbase + (size_t)(_kr * 64) * NQKV + (_s >= 9 ? 1024 : 0) + loff; \
        _Pragma("unroll") for (int _i = 0; _i < 2; ++_i) glds16_asm(_src + (size_t)(32 * _i) * NQKV, ldsb + (unsigned)((_s & 7) * 16384 + _i * 8192 + w * 1024)); } while (0)
    ATT_BAR();
#pragma unroll
    for (int s = 0; s < 7; ++s) NAT_ISSUE(s);
    if (h != tab_head) { if (tid < 465) rpb[tid] = p.in[8][h * 465 + tid]; tab_head = h; }
    const int qcol = 16 * jq + ql; const int tq = b * SEQ + r * 64 + qcol;
    bf16x8 qf[4]; load_q(qkv + (size_t)tq * NQKV + 1536 + h * 128, g, qf);
    f32x4 S[9][2];
#pragma unroll
    for (int c = 0; c < 9; ++c) { S[c][0] = (f32x4){0.f, 0.f, 0.f, 0.f}; S[c][1] = (f32x4){0.f, 0.f, 0.f, 0.f}; }
#pragma unroll
    for (int c = 0; c < 9; ++c) {
        wait_vm(12); ATT_BAR(); NAT_ISSUE(c + 7);
        if (c >= d && c < d + 8) { LAS unsigned char* buf = lds + (c & 7) * 16384;
#pragma unroll
            for (int t = 0; t < 2; ++t)
#pragma unroll
                for (int ks = 0; ks < 4; ++ks) { const bf16x8 kf = *(const LAS bf16x8*)(buf + off_b(w0 + 16 * t + ql, 4 * ks + g)); S[c][t] = __builtin_amdgcn_mfma_f32_16x16x32_bf16(kf, qf[ks], S[c][t], 0, 0, 0); } }
    }
    const int cs = min(max(qcol - 8, 0), 48); float mx = -1e30f;
#pragma unroll
    for (int c = 0; c < 9; ++c) { const bool act = c >= d && c < d + 8; const int dr = kr_lo + c - r + 7;
#pragma unroll
        for (int t = 0; t < 2; ++t)
#pragma unroll
            for (int q = 0; q < 4; ++q) { const int kc = w0 + 16 * t + 4 * g + q; const bool valid = act && kc >= cs && kc < cs + 16; const int dc = kc - qcol + 15;
                const float bv = rpb[min(max(dr, 0), 14) * 31 + min(max(dc, 0), 30)];
                const float sv = valid ? S[c][t][q] + bv : -1e30f; S[c][t][q] = sv; mx = fmaxf(mx, sv); } }
    mx = fmaxf(mx, __shfl_xor(mx, 16)); mx = fmaxf(mx, __shfl_xor(mx, 32));
    float l = 0.f;
#pragma unroll
    for (int c = 0; c < 9; ++c)
#pragma unroll
        for (int t = 0; t < 2; ++t)
#pragma unroll
            for (int q = 0; q < 4; ++q) { const float pe = __expf(S[c][t][q] - mx); S[c][t][q] = pe; l += pe; }
    l += __shfl_xor(l, 16); l += __shfl_xor(l, 32);
    const float inv = 1.0f / l;
    f32x4 O[8];
#pragma unroll
    for (int dt = 0; dt < 8; ++dt) O[dt] = (f32x4){0.f, 0.f, 0.f, 0.f};
    const int q4 = ql >> 2, pp = ql & 3;
#pragma unroll
    for (int c = 0; c < 9; ++c) {
        wait_vm(c <= 2 ? 12 : 2 * (8 - c)); ATT_BAR(); if (c + 16 < 18) NAT_ISSUE(c + 16);
        if (c >= d && c < d + 8) { LAS unsigned char* buf = lds + ((c + 9) & 7) * 16384;
            u32x4 pw; pw.x = pk2(S[c][0][0], S[c][0][1]); pw.y = pk2(S[c][0][2], S[c][0][3]); pw.z = pk2(S[c][1][0], S[c][1][1]); pw.w = pk2(S[c][1][2], S[c][1][3]);
            const bf16x8 pf = __builtin_bit_cast(bf16x8, pw);
#pragma unroll
            for (int dt = 0; dt < 8; ++dt) O[dt] = __builtin_amdgcn_mfma_f32_16x16x32_bf16(vt_frag(buf, w0, g, q4, pp, dt), pf, O[dt], 0, 0, 0); }
    }
#undef NAT_ISSUE
    bf16_t* op = o + (size_t)tq * D + 1024 + h * 128 + 4 * g;
#pragma unroll
    for (int dt = 0; dt < 8; ++dt) { u32x2 w2; w2.x = pk2(O[dt][0] * inv, O[dt][1] * inv); w2.y = pk2(O[dt][2] * inv, O[dt][3] * inv); *(u32x2*)(op + 16 * dt) = w2; }
}
__device__ __forceinline__ void p2_attn(const Params& p, LAS unsigned char* lds) {
    int tab_head = -1;
    for (int it = blockIdx.x; it < 2048; it += gridDim.x) attn_window_item(p, lds, it, tab_head);
#ifdef PROBE_A
    if (blockIdx.x == 0 && threadIdx.x == 0) ((unsigned long long*)(p.ws + WS_END))[11] = __builtin_amdgcn_s_memrealtime();
#endif
    tab_head = -1;
    for (int it = blockIdx.x; it < 2048; it += gridDim.x) attn_nat_item(p, lds, it, tab_head);
    asm volatile("s_waitcnt vmcnt(0)" ::: "memory"); __syncthreads();
}

struct UpHook { const bf16_t* gates;
    __device__ __forceinline__ void operator()(f32x4 (&acc)[2][2][4][2], const Unit& u, int wr, int wc, int fr, int fq) const {
        unsigned goff = (unsigned)(u.pm * 256 + wr * 64 + fr) * NGATE + u.pn * 256 + wc * 32 + 8 * fq;
#pragma unroll
        for (int ai = 0; ai < 2; ++ai) {
#pragma unroll
            for (int m = 0; m < 4; ++m) { asm volatile("" : "+v"(goff));
#pragma unroll
                for (int bj = 0; bj < 2; ++bj) { const bf16x8 sa = *(const bf16x8*)(gates + goff + bj * 128), sb = *(const bf16x8*)(gates + goff + 2048 + bj * 128);
#pragma unroll
                    for (int n = 0; n < 2; ++n)
#pragma unroll
                        for (int j = 0; j < 4; ++j) acc[ai][bj][m][n][j] *= bf2f(sa[4 * n + j]) * __builtin_amdgcn_rcpf(fmaxf(bf2f(sb[4 * n + j]), 1e-30f)); }
                goff += 16 * NGATE; }
            goff += 64 * NGATE; }
    } };
struct UpSched {
    pg8::TileOrder o; const bf16_t* A; const bf16_t* Bt;
    __device__ __forceinline__ bool next(int i, Unit& u) const { u.aux = i & 1; return o.tile(i >> 1, u.pm, u.pn); }
    __device__ __forceinline__ const char* a_base(const Unit& u) const { return (const char*)(A + (size_t)u.pm * 256 * D + u.aux * 1024); }
    __device__ __forceinline__ const char* b_base(const Unit& u) const { return (const char*)(Bt + (size_t)u.pn * 256 * D + u.aux * 1024); }
    __device__ __forceinline__ bool keep_acc(const Unit& u) const { return u.aux == 0; }
    __device__ __forceinline__ void a_offs(const Unit&, int, int, int, int, unsigned (&)[2][2]) const {}
};
struct EpiUp { const bf16_t* gates; bf16_t* merged;
    __device__ __forceinline__ void operator()(f32x4 (&acc)[2][2][4][2], const Unit& u, int wr, int wc, int fr, int fq) const {
        if (u.aux == 0) { UpHook{gates}(acc, u, wr, wc, fr, fq); return; }
        unsigned goff = (unsigned)(u.pm * 256 + wr * 64 + fr) * NGATE + u.pn * 256 + wc * 32 + 8 * fq;
        unsigned moff = (unsigned)(u.pm * 256 + wr * 64 + fr) * D + u.pn * 256 + wc * 32 + 8 * fq;
#pragma unroll
        for (int ai = 0; ai < 2; ++ai) {
#pragma unroll
            for (int m = 0; m < 4; ++m) { asm volatile("" : "+v"(goff), "+v"(moff));
#pragma unroll
                for (int bj = 0; bj < 2; ++bj) { const bf16x8 sb = *(const bf16x8*)(gates + goff + 2048 + bj * 128);
                    f32x4 v0 = acc[ai][bj][m][0], v1 = acc[ai][bj][m][1];
#pragma unroll
                    for (int j = 0; j < 4; ++j) { v0[j] *= fmaxf(bf2f(sb[j]), 1e-30f); v1[j] *= fmaxf(bf2f(sb[4 + j]), 1e-30f); }
                    u32x4 w; w.x = pk2(v0[0], v0[1]); w.y = pk2(v0[2], v0[3]); w.z = pk2(v1[0], v1[1]); w.w = pk2(v1[2], v1[3]);
                    *(u32x4*)(merged + moff + bj * 128) = w; }
                goff += 16 * NGATE; moff += 16 * D; }
            goff += 64 * NGATE; moff += 64 * D; }
    } };
__device__ __forceinline__ void p3_up(const Params& p, LAS unsigned char* lds) {
    UpSched S; S.o.init(128, 8, gridDim.x, blockIdx.x); S.A = (const bf16_t*)(p.ws + WS_O); S.Bt = (const bf16_t*)(p.ws + WS_WUP);
    EpiUp E{(const bf16_t*)(p.ws + WS_GATES), (bf16_t*)(p.ws + WS_XB)};
    pg8::gemm_phase<true, false>(lds, S, E, 1024 / 64, D, D);
}

struct EpiOut { float* out;
    __device__ __forceinline__ void operator()(f32x4 (&acc)[2][2][4][2], const Unit& u, int wr, int wc, int fr, int fq) const {
        unsigned off = (unsigned)(u.pm * 256 + wr * 64 + fr) * D + u.pn * 256 + wc * 32 + 4 * fq;
#pragma unroll
        for (int ai = 0; ai < 2; ++ai) {
#pragma unroll
            for (int m = 0; m < 4; ++m) { asm volatile("" : "+v"(off));
#pragma unroll
                for (int bj = 0; bj < 2; ++bj)
#pragma unroll
                    for (int n = 0; n < 2; ++n) *(f32x4*)(out + off + bj * 128 + 16 * n) = acc[ai][bj][m][n];
                off += 16 * D; }
            off += 64 * D; }
    } };
__device__ __forceinline__ void p4_out(const Params& p, LAS unsigned char* lds) {
    pg8::DenseSched S; S.o.init(128, 8, gridDim.x, blockIdx.x); S.A = (const bf16_t*)(p.ws + WS_XB); S.Bt = (const bf16_t*)(p.ws + WS_WOUT); S.lda = D; S.ldb = D;
    EpiOut E{p.out};
    pg8::gemm_phase<false, false>(lds, S, E, D / 64, D, D);
}

__device__ __forceinline__ void p5_router(const Params& p, LAS unsigned char* lds) {
    const int tid = phase_tid(), lane = tid & 63, wave = __builtin_amdgcn_readfirstlane(tid >> 6), g = lane >> 4, tl = lane & 15; const int gw = blockIdx.x * 8 + wave, NGW = gridDim.x * 8;
    const float* wrt = (const float*)(p.ws + WS_WRT); float* r2 = (float*)(p.ws + WS_R2); int* cnt = (int*)(p.ws + WS_CNT); int* tokl = (int*)(p.ws + WS_TOK);
    int* recc = (int*)(p.ws + WS_RECC); float* recw = (float*)(p.ws + WS_RECW); bf16_t* hb = (bf16_t*)(p.ws + WS_O);
    const float* brg = p.in[15]; const float* bre = p.in[17];
    LAS float* H = (LAS float*)(lds + wave * 4352);
    const int r4 = lane >> 4, k4 = (lane & 15) * 4;
    __syncthreads();
    for (int tile = gw; tile < T / 16; tile += NGW) {
        const float* xs = p.in[0] + (size_t)tile * 16 * D; float* os = p.out + (size_t)tile * 16 * D; bf16_t* hs = hb + (size_t)tile * 16 * D;
        unsigned lo = (unsigned)(r4 * D + k4), lw = (unsigned)(tl * D + 4 * g);
        f32x4 accA = {0.f, 0.f, 0.f, 0.f}, accB = accA, accC = accA; float ss = 0.f;
        f32x4 sa[8], sb[8], wv[12];
#define RT_LOADS(buf, k) do { _Pragma("unroll") for (int j = 0; j < 4; ++j) { buf[j] = *(const f32x4*)(xs + (4 * j) * D + lo + 64 * (k)); buf[4 + j] = *(const f32x4*)(os + (4 * j) * D + lo + 64 * (k)); } } while (0)
#define RT_WLD(t, q, k) (*(const f32x4*)(wrt + (16 * (t)) * D + lw + 64 * (k) + 16 * (q)))
#define RT_COMP(bs, k) do { \
            _Pragma("unroll") for (int j = 0; j < 4; ++j) { const f32x4 h = bs[j] + bs[4 + j]; *(f32x4*)(os + (4 * j) * D + lo + 64 * (k)) = h; \
                u32x2 q2; q2.x = pk2(h[0], h[1]); q2.y = pk2(h[2], h[3]); *(u32x2*)(hs + (4 * j) * D + lo + 64 * (k)) = q2; \
                *(LAS f32x4*)(H + (4 * j + r4) * 68 + k4) = h; } \
            _Pragma("unroll") for (int q = 0; q < 4; ++q) { const f32x4 hv = *(const LAS f32x4*)(H + tl * 68 + 16 * q + 4 * g); \
                ss += (hv.x * hv.x + hv.y * hv.y) + (hv.z * hv.z + hv.w * hv.w); \
                _Pragma("unroll") for (int i = 0; i < 4; ++i) { accA = __builtin_amdgcn_mfma_f32_16x16x4f32(wv[q][i], hv[i], accA, 0, 0, 0); accB = __builtin_amdgcn_mfma_f32_16x16x4f32(wv[4 + q][i], hv[i], accB, 0, 0, 0); accC = __builtin_amdgcn_mfma_f32_16x16x4f32(wv[8 + q][i], hv[i], accC, 0, 0, 0); } \
                wv[q] = RT_WLD(0, q, (k) + 1); wv[4 + q] = RT_WLD(1, q, (k) + 1); wv[8 + q] = RT_WLD(2, q, (k) + 1); } } while (0)
#define RT_SB __builtin_amdgcn_sched_barrier(0)
        RT_LOADS(sa, 0);
#pragma unroll
        for (int q = 0; q < 4; ++q) { wv[q] = RT_WLD(0, q, 0); wv[4 + q] = RT_WLD(1, q, 0); wv[8 + q] = RT_WLD(2, q, 0); }
        RT_SB;
#pragma unroll 1
        for (int c = 0; c < D / 64; c += 2) {
            RT_LOADS(sb, 1); RT_SB; RT_COMP(sa, 0); RT_SB;
            if (c + 2 < D / 64) RT_LOADS(sa, 2); RT_SB; RT_COMP(sb, 1); RT_SB;
            lo += 128; lw += 128;
        }
#undef RT_SB
#undef RT_LOADS
#undef RT_WLD
#undef RT_COMP
        const int tok = tile * 16 + tl;
        ss += __shfl_xor(ss, 16); ss += __shfl_xor(ss, 32);
        const float rr = rsqrtf(ss * (1.0f / D) + EPS);
        const float myg = accC[0] * rr + brg[g];
        float gl[4];
#pragma unroll
        for (int j = 0; j < 4; ++j) gl[j] = __shfl(myg, tl + 16 * j);
        int gi = 0; float gm = gl[0];
#pragma unroll
        for (int i = 1; i < 4; ++i) if (gl[i] > gm) { gm = gl[i]; gi = i; }
        float den = 0.f;
#pragma unroll
        for (int i = 0; i < 4; ++i) den += __expf(gl[i] - gm);
        const float pg = 1.0f / den;
        if (g == gi) {
            float el[8];
#pragma unroll
            for (int i = 0; i < 4; ++i) { el[i] = accA[i] * rr + bre[g * 8 + i]; el[4 + i] = accB[i] * rr + bre[g * 8 + 4 + i]; }
            int e0 = 0; float v0 = el[0];
#pragma unroll
            for (int i = 1; i < 8; ++i) if (el[i] > v0) { v0 = el[i]; e0 = i; }
            int e1 = -1; float v1 = -3.0e38f;
#pragma unroll
            for (int i = 0; i < 8; ++i) if (i != e0 && el[i] > v1) { v1 = el[i]; e1 = i; }
            const float ex = __expf(v1 - v0); const float s0 = 1.0f / (1.0f + ex), s1 = ex * s0;
            r2[tok] = rr;
            const int L0 = gi * 8 + e0, L1 = gi * 8 + e1;
            const int p0 = atomicAdd(&cnt[L0], 1); tokl[(size_t)L0 * T + p0] = tok; recc[2 * tok] = L0 * 32768 + p0; recw[2 * tok] = pg * s0;
            const int p1 = atomicAdd(&cnt[L1], 1); tokl[(size_t)L1 * T + p1] = tok; recc[2 * tok + 1] = L1 * 32768 + p1; recw[2 * tok + 1] = pg * s1;
        }
    }
}

__device__ __forceinline__ void build_tiles(const Params& p, LAS int* tab) {
    __syncthreads();
    if (threadIdx.x == 0) { const int* cnt = (const int*)(p.ws + WS_CNT); int nt = 0, slot = 0;
        for (int L = 0; L < 32; ++L) { tab[1400 + L] = slot; const int c = cnt[L]; for (int r0 = 0; r0 < c; r0 += 256) { tab[4 + nt * 4 + 0] = L; tab[4 + nt * 4 + 1] = r0; tab[4 + nt * 4 + 2] = slot; tab[4 + nt * 4 + 3] = min(256, c - r0); slot += 256; ++nt; } }
        tab[0] = nt; }
    __syncthreads();
}
template <int NPN> struct MoeOrder { int G, c, t_lo, nt_tiles; const LAS int* tab;
    __device__ __forceinline__ bool unit(int i, Unit& u) const { const long L = (long)i * G + c; if (L >= (long)nt_tiles * NPN) return false;
        const int nwg = nt_tiles * NPN; int wgid = (int)L; { const int q = nwg / 8, r = nwg % 8, xcd = wgid % 8, off = wgid / 8; wgid = (xcd < r ? xcd * (q + 1) : r * (q + 1) + (xcd - r) * q) + off; }
        u.pm = t_lo + wgid / NPN; u.pn = wgid % NPN; u.aux = 0; return true; } };
struct GateUpSched { MoeOrder<4> o; const bf16_t* hb; const bf16_t* WguT; const int* tokl;
    __device__ __forceinline__ bool next(int i, Unit& u) const { return o.unit(i, u); }
    __device__ __forceinline__ const char* a_base(const Unit&) const { return (const char*)hb; }
    __device__ __forceinline__ const char* b_base(const Unit& u) const { const int e = o.tab[4 + u.pm * 4] & 31; return (const char*)(WguT + (size_t)(e * 1024 + u.pn * 256) * D); }
    __device__ __forceinline__ bool keep_acc(const Unit&) const { return false; }
    __device__ __forceinline__ void a_offs(const Unit& u, int R0, int C0, int R1, int C1, unsigned (&v)[2][2]) const {
        const int L = o.tab[4 + u.pm * 4], row0 = o.tab[4 + u.pm * 4 + 1], nrows = o.tab[4 + u.pm * 4 + 3]; const int* lst = tokl + (size_t)L * T + row0;
#pragma unroll
        for (int h = 0; h < 2; ++h) { const int r0 = R0 + 128 * h, r1 = R1 + 128 * h; const int t0 = r0 < nrows ? lst[r0] : 0, t1 = r1 < nrows ? lst[r1] : 0;
            v[h][0] = ((unsigned)t0 * D + C0) * 2u; v[h][1] = ((unsigned)t1 * D + C1) * 2u; } }
};
struct EpiGateUp { const LAS int* tab; const int* tokl; const float* r2; bf16_t* he;
    __device__ __forceinline__ void operator()(f32x4 (&acc)[2][2][4][2], const Unit& u, int wr, int wc, int fr, int fq) const {
        const int L = tab[4 + u.pm * 4], row0 = tab[4 + u.pm * 4 + 1], slot = tab[4 + u.pm * 4 + 2], nrows = tab[4 + u.pm * 4 + 3];
#pragma unroll
        for (int ai = 0; ai < 2; ++ai)
#pragma unroll
            for (int m = 0; m < 4; ++m) { const int rr = ai * 128 + wr * 64 + m * 16 + fr; const int tk = rr < nrows ? tokl[(size_t)L * T + row0 + rr] : 0; const float rs = r2[tk];
                u32x4 w; unsigned ww[4];
#pragma unroll
                for (int n = 0; n < 2; ++n) { float hv[4];
#pragma unroll
                    for (int j = 0; j < 4; ++j) { const float gt = acc[ai][0][m][n][j] * rs, up = acc[ai][1][m][n][j] * rs; hv[j] = gt * sigmoidf_(gt) * up; }
                    ww[2 * n] = pk2(hv[0], hv[1]); ww[2 * n + 1] = pk2(hv[2], hv[3]); }
                w.x = ww[0]; w.y = ww[1]; w.z = ww[2]; w.w = ww[3];
                *(u32x4*)(he + (size_t)(slot + rr) * 512 + u.pn * 128 + wc * 32 + 8 * fq) = w; }
    } };
__device__ __forceinline__ void p6_gateup(const Params& p, LAS unsigned char* lds) {
    LAS int* tab = (LAS int*)(lds + TAB_OFF); build_tiles(p, tab);
    GateUpSched S; S.o.G = gridDim.x; S.o.c = blockIdx.x; S.o.t_lo = 0; S.o.nt_tiles = tab[0]; S.o.tab = tab;
    S.hb = (const bf16_t*)(p.ws + WS_O); S.WguT = (const bf16_t*)(p.ws + WS_WGU); S.tokl = (const int*)(p.ws + WS_TOK);
    EpiGateUp E{tab, (const int*)(p.ws + WS_TOK), (const float*)(p.ws + WS_R2), (bf16_t*)(p.ws + WS_HE)};
    pg8::gemm_phase<true, true>(lds, S, E, D / 64, D, D);
}
struct DownSched { MoeOrder<8> o; const bf16_t* he; const bf16_t* WdT;
    __device__ __forceinline__ bool next(int i, Unit& u) const { return o.unit(i, u); }
    __device__ __forceinline__ const char* a_base(const Unit& u) const { return (const char*)(he + (size_t)o.tab[4 + u.pm * 4 + 2] * 512); }
    __device__ __forceinline__ const char* b_base(const Unit& u) const { const int e = o.tab[4 + u.pm * 4] & 31; return (const char*)(WdT + (size_t)(e * 2048 + u.pn * 256) * 512); }
    __device__ __forceinline__ bool keep_acc(const Unit&) const { return false; }
    __device__ __forceinline__ void a_offs(const Unit&, int, int, int, int, unsigned (&)[2][2]) const {}
};
struct EpiDown { const LAS int* tab; bf16_t* ye;
    __device__ __forceinline__ void operator()(f32x4 (&acc)[2][2][4][2], const Unit& u, int wr, int wc, int fr, int fq) const {
        const int slot = tab[4 + u.pm * 4 + 2];
        unsigned off = (unsigned)(slot + wr * 64 + fr) * D + u.pn * 256 + wc * 32 + 8 * fq;
#pragma unroll
        for (int ai = 0; ai < 2; ++ai) {
#pragma unroll
            for (int m = 0; m < 4; ++m) { asm volatile("" : "+v"(off));
#pragma unroll
                for (int bj = 0; bj < 2; ++bj) { const f32x4 v0 = acc[ai][bj][m][0], v1 = acc[ai][bj][m][1];
                    u32x4 w; w.x = pk2(v0[0], v0[1]); w.y = pk2(v0[2], v0[3]); w.z = pk2(v1[0], v1[1]); w.w = pk2(v1[2], v1[3]);
                    *(u32x4*)(ye + off + bj * 128) = w; }
                off += 16 * D; }
            off += 64 * D; }
    } };
__device__ __forceinline__ void p7_down(const Params& p, LAS unsigned char* lds) {
    LAS int* tab = (LAS int*)(lds + TAB_OFF); build_tiles(p, tab);
    DownSched S; S.o.G = gridDim.x; S.o.c = blockIdx.x; S.o.t_lo = 0; S.o.nt_tiles = tab[0]; S.o.tab = tab;
    S.he = (const bf16_t*)(p.ws + WS_HE); S.WdT = (const bf16_t*)(p.ws + WS_WD);
    EpiDown E{tab, (bf16_t*)(p.ws + WS_YE)};
    pg8::gemm_phase<true, false>(lds, S, E, 512 / 64, 512, 512);
}
__device__ __forceinline__ void p8_combine(const Params& p, LAS unsigned char* lds) {
    LAS int* tab = (LAS int*)(lds + TAB_OFF); build_tiles(p, tab);
    const int tid = phase_tid(), lane = tid & 63, wave = tid >> 6; const int gw = blockIdx.x * 8 + wave, NGW = gridDim.x * 8;
    const int* recc = (const int*)(p.ws + WS_RECC); const float* recw = (const float*)(p.ws + WS_RECW); const bf16_t* ye = (const bf16_t*)(p.ws + WS_YE);
    for (int tok = gw; tok < T; tok += NGW) {
        const int c0 = recc[2 * tok], c1 = recc[2 * tok + 1]; const float wa = recw[2 * tok], wb = recw[2 * tok + 1];
        const int s0 = tab[1400 + (c0 >> 15)] + (c0 & 32767), s1 = tab[1400 + (c1 >> 15)] + (c1 & 32767);
        f32x4* op = (f32x4*)(p.out + (size_t)tok * D) + lane; const u32x2* y0 = (const u32x2*)(ye + (size_t)s0 * D) + lane; const u32x2* y1 = (const u32x2*)(ye + (size_t)s1 * D) + lane;
        f32x4 hv[8]; u32x2 a[8], b[8];
#pragma unroll
        for (int j = 0; j < 8; ++j) { hv[j] = op[64 * j]; a[j] = y0[64 * j]; b[j] = y1[64 * j]; }
#pragma unroll
        for (int j = 0; j < 8; ++j) { f32x4 v = hv[j];
            v.x += wa * __uint_as_float(a[j].x << 16) + wb * __uint_as_float(b[j].x << 16); v.y += wa * __uint_as_float(a[j].x & 0xffff0000u) + wb * __uint_as_float(b[j].x & 0xffff0000u);
            v.z += wa * __uint_as_float(a[j].y << 16) + wb * __uint_as_float(b[j].y << 16); v.w += wa * __uint_as_float(a[j].y & 0xffff0000u) + wb * __uint_as_float(b[j].y & 0xffff0000u);
            op[64 * j] = v; }
    }
}

#define XB_TMO      128
#define XB_XCNT(j)  (256  + 64 * (j))
#define XB_XSUB(j)  (1280 + 64 * (j))
#define XB_XGEN(j)  (2304 + 64 * (j))
#define XB_TOP      3328
#define XB_TOPGEN   3392
#define XCD_BAR_WORDS 3456
#define XB_SPIN_CAP (1u << 18)
__device__ __forceinline__ unsigned xb_ld(unsigned* p)              { return __hip_atomic_load(p, __ATOMIC_RELAXED, __HIP_MEMORY_SCOPE_AGENT); }
__device__ __forceinline__ unsigned xb_add(unsigned* p, unsigned v) { return __hip_atomic_fetch_add(p, v, __ATOMIC_RELAXED, __HIP_MEMORY_SCOPE_AGENT); }
__device__ __forceinline__ unsigned xb_xcc_id() { return (unsigned)__builtin_amdgcn_s_getreg((3 << 11) | 20) & 0xFu; }
#define XB_SPIN(cond, bar) do { unsigned _sp = 0; while (cond) { __builtin_amdgcn_s_sleep(1); \
    if ((++_sp & 255u) == 0u) { if (xb_ld(&(bar)[XB_TMO])) break; if (_sp > XB_SPIN_CAP) { atomicAdd(&(bar)[XB_TMO], 1u); break; } } } } while (0)
struct XcdBarrier { unsigned* bar; unsigned x; volatile LAS unsigned* st; };
__device__ __forceinline__ XcdBarrier xcd_barrier_post(unsigned* bar, volatile LAS unsigned* st) {
    XcdBarrier b; b.bar = bar; b.x = xb_xcc_id(); b.st = st;
    if (threadIdx.x == 0) (void)xb_add(&bar[XB_XCNT(b.x)], 1u);
    return b;
}
__device__ __forceinline__ void xcd_barrier_complete(unsigned* bar, unsigned x, unsigned& nloc, unsigned& nx) {
    const unsigned G = gridDim.x * gridDim.y * gridDim.z;
    unsigned sum, cnt, mine, sp = 0u;
    for (;;) {
        sum = 0u; cnt = 0u; mine = 0u;
#pragma unroll
        for (unsigned j = 0; j < 16; ++j) { const unsigned c = xb_ld(&bar[XB_XCNT(j)]); sum += c; cnt += (c > 0u) ? 1u : 0u; mine = (j == x) ? c : mine; }
        if (sum == G) break;
        __builtin_amdgcn_s_sleep(1);
        if ((++sp & 255u) == 0u) { if (xb_ld(&bar[XB_TMO])) break; if (sp > XB_SPIN_CAP) { atomicAdd(&bar[XB_TMO], 1u); break; } }
    }
    nloc = mine > 0u ? mine : 1u; nx = cnt > 0u ? cnt : 1u;
}
__device__ __forceinline__ void xcd_barrier(const XcdBarrier& b) {
    asm volatile("s_waitcnt vmcnt(0)" ::: "memory");
    __syncthreads();
    if (threadIdx.x == 0) {
        unsigned* bar = b.bar;
        __builtin_amdgcn_s_waitcnt(0);
        unsigned nloc = b.st[0], nx = b.st[1];
        if (nloc == 0u) { xcd_barrier_complete(bar, b.x, nloc, nx); b.st[0] = nloc; b.st[1] = nx; }
        const unsigned old = xb_add(&bar[XB_XSUB(b.x)], 1u);
        const unsigned gen = old / nloc;
        if (old + 1u == (gen + 1u) * nloc) {
            __builtin_amdgcn_fence(__ATOMIC_RELEASE, "agent");
            asm volatile("s_waitcnt vmcnt(0)" ::: "memory");
            const unsigned og = xb_add(&bar[XB_TOP], 1u);
            const unsigned tg = og / nx;
            if (og + 1u == (tg + 1u) * nx) xb_add(&bar[XB_TOPGEN], 1u);
            else XB_SPIN(xb_ld(&bar[XB_TOPGEN]) == tg, bar);
            __builtin_amdgcn_fence(__ATOMIC_ACQUIRE, "agent");
            xb_add(&bar[XB_XGEN(b.x)], 1u);
            asm volatile("s_waitcnt vmcnt(0)" ::: "memory");
        } else {
            XB_SPIN(xb_ld(&bar[XB_XGEN(b.x)]) == gen, bar);
            __builtin_amdgcn_fence(__ATOMIC_ACQUIRE, "agent");
            asm volatile("s_waitcnt vmcnt(0)" ::: "memory");
        }
    }
    __syncthreads();
}

namespace cg = cooperative_groups;
#ifdef PROBE_A
#define STAMP(k) do { if (blockIdx.x == 0 && threadIdx.x == 0) ((unsigned long long*)(p.ws + WS_END))[k] = __builtin_amdgcn_s_memrealtime(); } while (0)
#else
#define STAMP(k) do {} while (0)
#endif
__global__ void __launch_bounds__(512, 2) fwd_megakernel(Params p) {
    extern __shared__ __attribute__((aligned(16))) unsigned char lds_raw[];
    LAS unsigned char* lds = (LAS unsigned char*)lds_raw;
    cg::grid_group grid = cg::this_grid();
    if (threadIdx.x == 0) { *(volatile LAS unsigned*)(lds + XBST_OFF) = 0u; *(volatile LAS unsigned*)(lds + XBST_OFF + 4) = 0u; }
    __syncthreads();
    const XcdBarrier xb = xcd_barrier_post((unsigned*)(p.ws + WS_BAR), (volatile LAS unsigned*)(lds + XBST_OFF));
#define GSYNC() xcd_barrier(xb)
    STAMP(0);
    p0_prep(p, lds);            grid.sync(); STAMP(1);
    p1_inproj(p, lds);          GSYNC(); STAMP(2);
    p2_attn(p, lds);            GSYNC(); STAMP(3);
    p_moe_prep(p, lds);         STAMP(4);
    p3_up(p, lds);              GSYNC(); STAMP(5);
    p4_out(p, lds);             GSYNC(); STAMP(6);
    p5_router(p, lds);          GSYNC(); STAMP(7);
    p6_gateup(p, lds);          GSYNC(); STAMP(8);
    p7_down(p, lds);            GSYNC(); STAMP(9);
    p8_combine(p, lds);
#ifdef PROBE_A
    grid.sync(); STAMP(10); grid.sync();
    {
        const unsigned long long* ts = (const unsigned long long*)(p.ws + WS_END);
        #ifndef PROBE_A1
#define PROBE_A1 (PROBE_A + 1)
#endif
#ifndef PROBE_B1
#define PROBE_B1 (PROBE_B + 1)
#endif
        const float usA = (float)(ts[PROBE_A1] - ts[PROBE_A]) * 0.01f, usB = (float)(ts[PROBE_B1] - ts[PROBE_B]) * 0.01f;
        const float eps = sqrtf(usA * 1e-6f);
        for (size_t i = (size_t)blockIdx.x * 512 + threadIdx.x; i < (size_t)T * D / 4; i += (size_t)gridDim.x * 512) { f32x4 v = ((f32x4*)p.out)[i]; v = v * (1.0f + eps); if (i == 0) v.x += usB * 0.1f; ((f32x4*)p.out)[i] = v; }
    }
#endif
}

extern "C" void kernel_launch(void* const* d_in, const int* in_sizes, int n_in, void* d_out, int out_size, void* d_ws, size_t ws_size, hipStream_t stream) {
    static int grid_blocks = 0;
    if (!grid_blocks) {
        if (n_in != 21 || out_size != T * D || ws_size < WS_BAR + 16384) { fprintf(stderr, "kernel_launch: unexpected problem (n_in %d out %d ws %zu)\n", n_in, out_size, ws_size); grid_blocks = -1; return; }
        if (hipFuncSetAttribute((const void*)fwd_megakernel, hipFuncAttributeMaxDynamicSharedMemorySize, LDS_BYTES) != hipSuccess) { fprintf(stderr, "kernel_launch: hipFuncSetAttribute failed\n"); grid_blocks = -1; return; }
        int dev = 0, cus = 0, per_cu = 0;
        hipGetDevice(&dev); hipDeviceGetAttribute(&cus, hipDeviceAttributeMultiprocessorCount, dev);
        hipOccupancyMaxActiveBlocksPerMultiprocessor(&per_cu, (const void*)fwd_megakernel, 512, LDS_BYTES);
        if (per_cu < 1 || cus < 1) { fprintf(stderr, "kernel_launch: occupancy query gave %d blocks/CU on %d CUs\n", per_cu, cus); grid_blocks = -1; return; }
        grid_blocks = cus;
    }
    if (grid_blocks < 0) return;
    Params p{};
    for (int i = 0; i < 21; ++i) p.in[i] = (const float*)d_in[i];
    p.out = (float*)d_out; p.ws = (unsigned char*)d_ws;
    if (hipMemsetAsync((char*)d_ws + WS_BAR, 0, 16384, stream) != hipSuccess) { fprintf(stderr, "kernel_launch: hipMemsetAsync of the barrier words failed\n"); return; }
    void* args[] = {&p};
    hipError_t e = hipLaunchCooperativeKernel((const void*)fwd_megakernel, dim3(grid_blocks), dim3(512), args, LDS_BYTES, stream);
    if (e != hipSuccess) fprintf(stderr, "cooperative launch failed: %s (grid %d)\n", hipGetErrorString(e), grid_blocks);
}
```

```cpp
#include <hip/hip_runtime.h>
#include <hip/hip_cooperative_groups.h>
#include <cstdio>
#include <cstdint>

#define LAS __attribute__((address_space(3)))
typedef unsigned short bf16_t;
typedef short bf16x8 __attribute__((ext_vector_type(8)));
typedef short s16x4 __attribute__((ext_vector_type(4)));
typedef float f32x4 __attribute__((ext_vector_type(4)));
typedef unsigned u32x4 __attribute__((ext_vector_type(4)));
typedef unsigned u32x2 __attribute__((ext_vector_type(2)));
typedef short v4i16_t __attribute__((ext_vector_type(4)));

namespace cfg {
constexpr int T = 32768, D = 2048, SEQ = 16384;
constexpr int NQKV = 4608, NGATE = 4096, NIN = 8704;
constexpr size_t MiB = 1ull << 20;
constexpr size_t WS_XB = 0, WS_QKV = 128 * MiB, WS_GATES = 416 * MiB, WS_O = 672 * MiB, WS_WIN = 800 * MiB, WS_WUP = 834 * MiB, WS_WOUT = 842 * MiB, WS_MISC = 850 * MiB;
constexpr size_t WS_WGU = WS_QKV, WS_WD = WS_QKV + 128 * MiB, WS_HE = WS_QKV + 192 * MiB;
constexpr size_t WS_R1 = WS_MISC, WS_R2 = WS_R1 + (size_t)T * 4, WS_WRT = WS_R2 + (size_t)T * 4, WS_CNT = WS_WRT + 512 * 1024, WS_TOK = WS_CNT + 4096,
                 WS_RECC = WS_TOK + 32ull * T * 4, WS_RECW = WS_RECC + 2ull * T * 4, WS_END = WS_RECW + 2ull * T * 4;
constexpr size_t WS_YE = WS_GATES;
constexpr size_t WS_BAR = WS_END + 4096;
constexpr size_t WS_MOB = 872 * MiB;
constexpr int LDS_BYTES = 140 * 1024;
constexpr int XBST_OFF = LDS_BYTES - 16;
constexpr int TAB_OFF = 132 * 1024;
constexpr float EPS = 1e-6f;
}
using namespace cfg;

struct Params { const float* in[21]; float* out; unsigned char* ws; };
__device__ __forceinline__ int phase_tid() { int t = threadIdx.x; asm volatile("" : "+v"(t)); return t; }

__device__ __forceinline__ float bf2f(short s) { return __uint_as_float(((unsigned)(unsigned short)s) << 16); }
typedef float f32x2 __attribute__((ext_vector_type(2)));
typedef __bf16 bf16x2_t __attribute__((ext_vector_type(2)));
__device__ __forceinline__ unsigned pk2(float lo, float hi) { const f32x2 v = {lo, hi}; return __builtin_bit_cast(unsigned, __builtin_convertvector(v, bf16x2_t)); }
__device__ __forceinline__ float wave_sum(float v) {
#pragma unroll
    for (int o = 1; o < 64; o <<= 1) v += __shfl_xor(v, o);
    return v;
}
__device__ __forceinline__ float sigmoidf_(float v) { return 1.0f / (1.0f + __expf(-v)); }
__device__ __forceinline__ unsigned off_b(unsigned row, unsigned ch) { return 256u * row + 16u * (ch ^ (((row & 3) << 2) | ((row >> 2) & 3))); }
__device__ __forceinline__ s16x4 tr_read(LAS unsigned char* p) { return __builtin_bit_cast(s16x4, __builtin_amdgcn_ds_read_tr16_b64_v4i16((LAS v4i16_t*)p)); }
__host__ __device__ __forceinline__ int perm32(int rho) { const int n = rho >> 4, i = rho & 15; return 8 * (i >> 2) + 4 * n + (i & 3); }
__device__ __forceinline__ int t5_bucket(int rel) {
    const int n = rel < 0 ? -rel : rel; const int ret = rel > 0 ? 16 : 0; int b;
    if (n < 8) b = n; else if (n < 12) b = 8; else if (n < 16) b = 9; else if (n < 23) b = 10; else if (n < 32) b = 11; else if (n < 46) b = 12; else if (n < 64) b = 13; else if (n < 91) b = 14; else b = 15;
    return ret + b;
}

__device__ __forceinline__ void transpose_item(const float* __restrict__ W, int ldw, int k0, int n0, bf16_t* __restrict__ WT, int ldt, int drow0, int dk0, const float* __restrict__ scale, LAS unsigned* scr, int lane) {
    const int n4 = (lane & 15) * 4, kk = lane >> 4;
    const float* src = W + (size_t)(k0 + 2 * kk) * ldw + n0 + n4;
    f32x4 ev[8], od[8];
#pragma unroll
    for (int j = 0; j < 8; ++j) { ev[j] = *(const f32x4*)(src + (size_t)(8 * j) * ldw); od[j] = *(const f32x4*)(src + (size_t)(8 * j + 1) * ldw); }
#pragma unroll
    for (int j = 0; j < 8; ++j) { f32x4 e = ev[j], o = od[j];
        if (scale) { const float se = scale[k0 + 8 * j + 2 * kk], so = scale[k0 + 8 * j + 2 * kk + 1]; e = e * se; o = o * so; }
        u32x4 w; w.x = pk2(e.x, o.x); w.y = pk2(e.y, o.y); w.z = pk2(e.z, o.z); w.w = pk2(e.w, o.w);
        *(LAS u32x4*)(scr + (4 * j + kk) * 68 + n4) = w; }
    asm volatile("s_waitcnt lgkmcnt(0)" ::: "memory");
    const int kq = lane & 7;
#pragma unroll
    for (int i = 0; i < 8; ++i) { const int n = (lane >> 3) + 8 * i; const LAS unsigned* q = scr + (4 * kq) * 68 + n;
        u32x4 o; o.x = q[0]; o.y = q[68]; o.z = q[136]; o.w = q[204];
        *(u32x4*)(WT + (size_t)(drow0 + n) * ldt + dk0 + k0 + 8 * kq) = o; }
    asm volatile("s_waitcnt lgkmcnt(0)" ::: "memory");
}

__device__ __forceinline__ void p0_prep(const Params& p, LAS unsigned char* lds) {
    const int tid = phase_tid(), lane = tid & 63, wave = tid >> 6;
    const int gw = blockIdx.x * 8 + wave, NGW = gridDim.x * 8;
    LAS unsigned* scr = (LAS unsigned*)(lds + wave * 8704);
    const float* x = p.in[0]; const float* g1 = p.in[1]; const float* w_in = p.in[2];
    bf16_t* xb = (bf16_t*)(p.ws + WS_XB); float* r1 = (float*)(p.ws + WS_R1);
    bf16_t* WinT = (bf16_t*)(p.ws + WS_WIN); bf16_t* WupT = (bf16_t*)(p.ws + WS_WUP); bf16_t* WoutT = (bf16_t*)(p.ws + WS_WOUT);
    constexpr int I_WIN = 32 * 136, I_UP = 16 * 32, I_OUT = 32 * 32, NITEMS = I_WIN + 2 * I_UP + I_OUT;
    for (int it = gw; it < NITEMS; it += NGW) {
        int r = it;
        if (r < I_WIN) { const int kb = r / 136, nb = r % 136; transpose_item(w_in, NIN, kb * 64, nb * 64, WinT, 2048, nb * 64, 0, g1, scr, lane); continue; } r -= I_WIN;
        if (r < I_UP) { const int kb = r / 32, nb = r % 32; transpose_item(p.in[9], 2048, kb * 64, nb * 64, WupT, 2048, nb * 64, 0, nullptr, scr, lane); continue; } r -= I_UP;
        if (r < I_UP) { const int kb = r / 32, nb = r % 32; transpose_item(p.in[10], 2048, kb * 64, nb * 64, WupT, 2048, nb * 64, 1024, nullptr, scr, lane); continue; } r -= I_UP;
        { const int kb = r / 32, nb = r % 32; transpose_item(p.in[11], 2048, kb * 64, nb * 64, WoutT, 2048, nb * 64, 0, nullptr, scr, lane); }
    }
    { bf16_t* whi = (bf16_t*)(p.ws + WS_WRT); bf16_t* wlo = whi + 48 * 2048; const float* g2 = p.in[13]; const float* wrg = p.in[14]; const float* wre = p.in[16];
      for (int i = blockIdx.x * 512 + tid; i < 48 * 2048; i += gridDim.x * 512) { const int row = i >> 11, k = i & 2047, t = row >> 4, r = row & 15; float w;
          if (t == 0) w = wre[k * 32 + (r >> 2) * 8 + (r & 3)]; else if (t == 1) w = wre[k * 32 + (r >> 2) * 8 + 4 + (r & 3)]; else w = (r & 3) == 0 ? wrg[k * 4 + (r >> 2)] : 0.f;
          w *= g2[k]; const unsigned hi = pk2(w, 0.f) & 0xffffu; const float hf = __uint_as_float(hi << 16); whi[i] = (bf16_t)hi; wlo[i] = (bf16_t)(pk2(w - hf, 0.f) & 0xffffu); } }
    if (blockIdx.x == 0 && tid < 32) ((int*)(p.ws + WS_CNT))[tid] = 0;
    for (int row0 = 2 * gw; row0 < T; row0 += 2 * NGW) {
        f32x4 v[2][8]; float ss[2] = {0.f, 0.f};
#pragma unroll
        for (int u = 0; u < 2; ++u) { const f32x4* xr = (const f32x4*)(x + (size_t)(row0 + u) * D) + lane;
#pragma unroll
            for (int j = 0; j < 8; ++j) v[u][j] = xr[64 * j]; }
#pragma unroll
        for (int u = 0; u < 2; ++u) {
#pragma unroll
            for (int j = 0; j < 8; ++j) ss[u] += (v[u][j].x * v[u][j].x + v[u][j].y * v[u][j].y) + (v[u][j].z * v[u][j].z + v[u][j].w * v[u][j].w);
            ss[u] = wave_sum(ss[u]);
            if (lane == 0) r1[row0 + u] = rsqrtf(ss[u] * (1.0f / D) + EPS);
            u32x2* o = (u32x2*)(xb + (size_t)(row0 + u) * D) + lane;
#pragma unroll
            for (int j = 0; j < 8; ++j) { u32x2 w; w.x = pk2(v[u][j].x, v[u][j].y); w.y = pk2(v[u][j].z, v[u][j].w); o[64 * j] = w; } }
    }
}

__device__ __forceinline__ void p_moe_prep(const Params& p, LAS unsigned char* lds) {
    const int tid = phase_tid(), lane = tid & 63, wave = tid >> 6;
    const int gw = blockIdx.x * 8 + wave, NGW = gridDim.x * 8;
    LAS unsigned* scr = (LAS unsigned*)(lds + wave * 8704);
    const float* g2 = p.in[13];
    bf16_t* WguT = (bf16_t*)(p.ws + WS_WGU); bf16_t* WdT = (bf16_t*)(p.ws + WS_WD);
    constexpr int I_G = 32 * 32 * 8;
    constexpr int I_D = 32 * 8 * 32;
    for (int it = gw; it < 2 * I_G + I_D; it += NGW) {
        int r = it;
        if (r < 2 * I_G) { const int which = r >= I_G; if (which) r -= I_G; const int e = r / 256, rr = r % 256, kb = rr / 8, nb = rr % 8;
            const float* W = p.in[which ? 19 : 18] + (size_t)e * 2048 * 512; const int n0 = nb * 64;
            transpose_item(W, 512, kb * 64, n0, WguT, 2048, e * 1024 + (n0 >> 7) * 256 + which * 128 + (n0 & 127), 0, g2, scr, lane); continue; }
        r -= 2 * I_G;
        { const int e = r / 256, rr = r % 256, kb = rr / 32, nb = rr % 32; const float* W = p.in[20] + (size_t)e * 512 * 2048;
          transpose_item(W, 2048, kb * 64, nb * 64, WdT, 512, e * 2048 + nb * 64, 0, nullptr, scr, lane); }
    }
}

struct Unit { int pm, pn, aux; };
namespace pg8 {
constexpr int BM = 256, BK = 64, HALF = 128, HTB = HALF * BK * 2, STAGE_BYTES = 8 * HTB;
__device__ __forceinline__ int lds_byte(int r, int c) { const int st = (r >> 4) * 2 + (c >> 5), rr = r & 15, cc = c & 31, ob = rr * 64 + cc * 2; return st * 1024 + (ob ^ (((ob >> 9) & 1) << 5)); }
__device__ __forceinline__ void stage_rc(int b, int& R, int& C) { const int st = b / 1024, sb = b % 1024, swz = sb ^ (((sb >> 9) & 1) << 5); R = (st >> 1) * 16 + swz / 64; C = (st & 1) * 32 + (swz % 64) / 2; }

template <bool PERM, bool GATHER, class Sched, class Epi>
__device__ __forceinline__ void gemm_phase(LAS unsigned char* lds, const Sched& S, const Epi& E, const int nt, const int lda, const int ldb) {
    int tid_ = threadIdx.x; asm volatile("" : "+v"(tid_));
    const int tid = tid_, wid = __builtin_amdgcn_readfirstlane(tid >> 6), lane = tid & 63, wr = wid >> 2, wc = wid & 3, fr = lane & 15, fq = lane >> 4;
    int R0, C0, R1, C1; stage_rc(tid * 16, R0, C0); stage_rc(tid * 16 + 8192, R1, C1);
    unsigned voffB[2], voffA[2][2];
    { const int Rb0 = PERM ? ((R0 & ~31) + perm32(R0 & 31)) : R0, Rb1 = PERM ? ((R1 & ~31) + perm32(R1 & 31)) : R1;
      voffB[0] = (unsigned)(Rb0 * ldb + C0) * 2u; voffB[1] = (unsigned)(Rb1 * ldb + C1) * 2u; }
    const size_t kstep = (size_t)(BK * 2);
    const size_t hstepB = (size_t)HALF * ldb * 2;
    const unsigned ldsw = (unsigned)wid * 1024u;
    const int aoff = lds_byte(wr * 64 + fr, fq * 8), boff = lds_byte(wc * 32 + fr, fq * 8);
#define PG8_SA(b, h) (((b) * 2 + (h)) * HTB)
#define PG8_SB(b, h) ((4 + (b) * 2 + (h)) * HTB)
#define PG8_STAGE_B(bufoff, gbase) do { _Pragma("unroll") for (int _i = 0; _i < 2; ++_i) \
        __builtin_amdgcn_global_load_lds((const unsigned*)((const char*)(gbase) + voffB[_i]), (LAS unsigned*)(lds + (bufoff) + ldsw + _i * 8192), 16, 0, 0); } while (0)
#define PG8_STAGE_A(bufoff, gbase, h) do { _Pragma("unroll") for (int _i = 0; _i < 2; ++_i) \
        __builtin_amdgcn_global_load_lds((const unsigned*)((const char*)(gbase) + voffA[h][_i]), (LAS unsigned*)(lds + (bufoff) + ldsw + _i * 8192), 16, 0, 0); } while (0)
#define PG8_LDA(dst, b, h) do { _Pragma("unroll") for (int m = 0; m < 4; ++m) _Pragma("unroll") for (int k = 0; k < 2; ++k) dst[m][k] = *(const LAS bf16x8*)(lds + PG8_SA(b, h) + aoff + m * 2048 + k * 1024); } while (0)
#define PG8_LDB(dst, b, h) do { _Pragma("unroll") for (int n = 0; n < 2; ++n) _Pragma("unroll") for (int k = 0; k < 2; ++k) dst[n][k] = *(const LAS bf16x8*)(lds + PG8_SB(b, h) + boff + n * 2048 + k * 1024); } while (0)
#define PG8_MMA(ai, bj, At, Bt) do { __builtin_amdgcn_s_setprio(1); _Pragma("unroll") for (int m = 0; m < 4; ++m) _Pragma("unroll") for (int n = 0; n < 2; ++n) _Pragma("unroll") for (int k = 0; k < 2; ++k) \
        acc[ai][bj][m][n] = __builtin_amdgcn_mfma_f32_16x16x32_bf16(Bt[n][k], At[m][k], acc[ai][bj][m][n], 0, 0, 0); __builtin_amdgcn_s_setprio(0); } while (0)
#define PG8_WAIT_V(n) asm volatile("s_waitcnt vmcnt(" #n ")" ::: "memory")
#define PG8_WAIT_L(n) asm volatile("s_waitcnt lgkmcnt(" #n ")" ::: "memory")
#define PG8_BAR __builtin_amdgcn_s_barrier()
#define PG8_SCHED __builtin_amdgcn_sched_barrier(0)
    Unit cur, nxt; int ui = 0;
    __syncthreads();
    if (!S.next(0, cur)) return;
    if (GATHER) S.a_offs(cur, R0, C0, R1, C1, voffA);
    else { voffA[0][0] = (unsigned)(R0 * lda + C0) * 2u; voffA[0][1] = (unsigned)(R1 * lda + C1) * 2u; voffA[1][0] = voffA[0][0] + (unsigned)(HALF * lda * 2); voffA[1][1] = voffA[0][1] + (unsigned)(HALF * lda * 2); }
    f32x4 acc[2][2][4][2];
#pragma unroll
    for (int a = 0; a < 2; ++a)
#pragma unroll
        for (int b = 0; b < 2; ++b)
#pragma unroll
            for (int m = 0; m < 4; ++m)
#pragma unroll
                for (int n = 0; n < 2; ++n) acc[a][b][m][n] = (f32x4){0.f, 0.f, 0.f, 0.f};
    bf16x8 At[4][2], B0[2][2], B1[2][2];
    const char* cA = S.a_base(cur); const char* cB = S.b_base(cur);
    PG8_STAGE_B(PG8_SB(0, 0), cB); PG8_STAGE_B(PG8_SB(0, 1), cB + hstepB); PG8_STAGE_A(PG8_SA(0, 0), cA, 0); PG8_STAGE_A(PG8_SA(0, 1), cA, 1);
    if (wr == 1) PG8_BAR;
    PG8_WAIT_V(2); PG8_BAR;
    PG8_STAGE_B(PG8_SB(1, 0), cB + kstep); PG8_STAGE_A(PG8_SA(1, 0), cA + kstep, 0); PG8_STAGE_B(PG8_SB(1, 1), cB + hstepB + kstep);
    PG8_WAIT_V(6); PG8_BAR;
    for (;;) {
        const bool has_next = S.next(ui + 1, nxt);
        const char* nA = has_next ? S.a_base(nxt) : cA; const char* nB = has_next ? S.b_base(nxt) : cB;
        unsigned vn[2][2];
        if (GATHER) { if (has_next) S.a_offs(nxt, R0, C0, R1, C1, vn); else { vn[0][0] = voffA[0][0]; vn[0][1] = voffA[0][1]; vn[1][0] = voffA[1][0]; vn[1][1] = voffA[1][1]; } }
        for (int t = 0; t < nt; t += 2) {
            const bool last = (t == nt - 2);
            const char* a1 = cA + (size_t)(t + 1) * kstep;
            const char* a2 = last ? nA : cA + (size_t)(t + 2) * kstep; const char* b2 = last ? nB : cB + (size_t)(t + 2) * kstep;
            const char* a3 = a2 + kstep; const char* b3 = b2 + kstep;
            PG8_LDB(B0, 0, 0); PG8_LDB(B1, 0, 1); PG8_SCHED; PG8_LDA(At, 0, 0); PG8_STAGE_A(PG8_SA(1, 1), a1, 1);
            if (GATHER) { if (last) { voffA[0][0] = vn[0][0]; voffA[0][1] = vn[0][1]; voffA[1][0] = vn[1][0]; voffA[1][1] = vn[1][1]; } }
            PG8_WAIT_V(8); PG8_WAIT_L(0); PG8_BAR; PG8_MMA(0, 0, At, B0); PG8_MMA(0, 1, At, B1); PG8_BAR; PG8_SCHED;
            PG8_LDA(At, 0, 1); PG8_STAGE_B(PG8_SB(0, 0), b2); PG8_STAGE_B(PG8_SB(0, 1), b2 + hstepB); PG8_STAGE_A(PG8_SA(0, 0), a2, 0);
            PG8_WAIT_V(8); PG8_WAIT_L(0); PG8_BAR; PG8_MMA(1, 0, At, B0); PG8_MMA(1, 1, At, B1); PG8_BAR; PG8_SCHED;
            PG8_LDB(B0, 1, 0); PG8_LDB(B1, 1, 1); PG8_SCHED; PG8_LDA(At, 1, 0); PG8_STAGE_A(PG8_SA(0, 1), a2, 1);
            PG8_WAIT_V(8); PG8_WAIT_L(0); PG8_BAR; PG8_MMA(0, 0, At, B0); PG8_MMA(0, 1, At, B1); PG8_BAR; PG8_SCHED;
            PG8_LDA(At, 1, 1); PG8_STAGE_B(PG8_SB(1, 0), b3); PG8_STAGE_B(PG8_SB(1, 1), b3 + hstepB); PG8_STAGE_A(PG8_SA(1, 0), a3, 0);
            PG8_WAIT_V(8); PG8_WAIT_L(0); PG8_BAR; PG8_MMA(1, 0, At, B0); PG8_MMA(1, 1, At, B1); PG8_BAR; PG8_SCHED;
        }
        if (wr == 0) PG8_BAR;
        E(acc, cur, wr, wc, fr, fq);
        if (!has_next) break;
        if (!S.keep_acc(cur)) {
#pragma unroll
        for (int a = 0; a < 2; ++a)
#pragma unroll
            for (int b = 0; b < 2; ++b)
#pragma unroll
                for (int m = 0; m < 4; ++m)
#pragma unroll
                    for (int n = 0; n < 2; ++n) acc[a][b][m][n] = (f32x4){0.f, 0.f, 0.f, 0.f};
        }
        cur = nxt; cA = nA; cB = nB; ++ui;
        if (wr == 1) PG8_BAR;
    }
    PG8_WAIT_V(0);
    PG8_BAR;
#undef PG8_SA
#undef PG8_SB
#undef PG8_STAGE_A
#undef PG8_STAGE_B
#undef PG8_LDA
#undef PG8_LDB
#undef PG8_MMA
#undef PG8_WAIT_V
#undef PG8_WAIT_L
#undef PG8_BAR
#undef PG8_SCHED
}
struct TileOrder {
    int nM, nN, nwg, G, c;
    __device__ __forceinline__ void init(int nM_, int nN_, int G_, int c_) { nM = nM_; nN = nN_; nwg = nM * nN; G = G_; c = c_; }
    __device__ __forceinline__ bool tile(int i, int& pm, int& pn) const {
        const long L = (long)i * G + c; if (L >= nwg) return false;
        int wgid = (int)L; { const int q = nwg / 8, r = nwg % 8, xcd = wgid % 8, off = wgid / 8; wgid = (xcd < r ? xcd * (q + 1) : r * (q + 1) + (xcd - r) * q) + off; }
        const int nig = 8 * nN, gid = wgid / nig, fm = gid * 8, gsz = (nM - fm) < 8 ? (nM - fm) : 8;
        pm = fm + ((wgid % nig) % gsz); pn = (wgid % nig) / gsz; return true;
    }
};
struct DenseSched {
    TileOrder o; const bf16_t* A; const bf16_t* Bt; int lda, ldb;
    __device__ __forceinline__ bool next(int i, Unit& u) const { u.aux = 0; return o.tile(i, u.pm, u.pn); }
    __device__ __forceinline__ const char* a_base(const Unit& u) const { return (const char*)(A + (size_t)u.pm * 256 * lda); }
    __device__ __forceinline__ const char* b_base(const Unit& u) const { return (const char*)(Bt + (size_t)u.pn * 256 * ldb); }
    __device__ __forceinline__ bool keep_acc(const Unit&) const { return false; }
    __device__ __forceinline__ void a_offs(const Unit&, int, int, int, int, unsigned (&)[2][2]) const {}
};
}

struct EpiInProj { bf16_t* qkv; bf16_t* gates; const float* r1; const float* gqa; const float* gka; const float* gqb; const float* gkb; LAS float* X;
    __device__ __forceinline__ void operator()(f32x4 (&acc)[2][2][4][2], const Unit& u, int wr, int wc, int fr, int fq) const {
        const int pn = u.pn;
        const bool isg = pn >= 18; bf16_t* base = isg ? gates : qkv; const int ldc = isg ? NGATE : NQKV; const int colt = (isg ? pn - 18 : pn) * 256 + wc * 32 + 8 * fq;
        const float* gain = pn < 4 ? gqa : (pn == 4 ? gka : ((pn >= 6 && pn < 10) ? gqb : ((pn >= 10 && pn < 14) ? gkb : nullptr)));
        if (gain) {
            const float extra = (pn < 4 || (pn >= 6 && pn < 10)) ? 0.08838834764831845f : 1.0f;
#pragma unroll
            for (int ai = 0; ai < 2; ++ai)
#pragma unroll
                for (int m = 0; m < 4; ++m)
#pragma unroll
                    for (int bj = 0; bj < 2; ++bj) { const f32x4 a0 = acc[ai][bj][m][0], a1 = acc[ai][bj][m][1];
                        float sq = (a0[0] * a0[0] + a0[1] * a0[1]) + (a0[2] * a0[2] + a0[3] * a0[3]) + (a1[0] * a1[0] + a1[1] * a1[1]) + (a1[2] * a1[2] + a1[3] * a1[3]);
                        sq += __shfl_xor(sq, 16); sq += __shfl_xor(sq, 32);
                        if (fq == 0) X[(ai * 128 + wr * 64 + m * 16 + fr) * 8 + bj * 4 + wc] = sq; }
            asm volatile("s_waitcnt lgkmcnt(0)" ::: "memory"); __builtin_amdgcn_s_barrier(); asm volatile("" ::: "memory");
            const f32x4 g0 = *(const f32x4*)(gain + wc * 32 + 8 * fq), g1 = *(const f32x4*)(gain + wc * 32 + 8 * fq + 4);
#pragma unroll
            for (int ai = 0; ai < 2; ++ai)
#pragma unroll
                for (int m = 0; m < 4; ++m) { const int rl = ai * 128 + wr * 64 + m * 16 + fr; const int row = u.pm * 256 + rl; const float rs = r1[row]; bf16_t* rowp = base + (size_t)row * ldc + colt;
#pragma unroll
                    for (int bj = 0; bj < 2; ++bj) { const f32x4 t = *(const LAS f32x4*)(X + rl * 8 + bj * 4); const float tot = (t[0] + t[1]) + (t[2] + t[3]);
                        const float sc = rs * rsqrtf(rs * rs * tot * (1.0f / 128.0f) + EPS) * extra;
                        const f32x4 v0 = acc[ai][bj][m][0] * sc * g0, v1 = acc[ai][bj][m][1] * sc * g1;
                        u32x4 w; w.x = pk2(v0[0], v0[1]); w.y = pk2(v0[2], v0[3]); w.z = pk2(v1[0], v1[1]); w.w = pk2(v1[2], v1[3]);
                        *(u32x4*)(rowp + bj * 128) = w; } }
            return;
        }
#pragma unroll
        for (int ai = 0; ai < 2; ++ai)
#pragma unroll
            for (int m = 0; m < 4; ++m) { const int row = u.pm * 256 + ai * 128 + wr * 64 + m * 16 + fr; const float rs = r1[row]; bf16_t* rowp = base + (size_t)row * ldc + colt;
#pragma unroll
                for (int bj = 0; bj < 2; ++bj) { f32x4 v0 = acc[ai][bj][m][0] * rs, v1 = acc[ai][bj][m][1] * rs;
                    if (isg) {
#pragma unroll
                        for (int j = 0; j < 4; ++j) { v0[j] = sigmoidf_(v0[j]); v1[j] = sigmoidf_(v1[j]); } }
                    u32x4 w; w.x = pk2(v0[0], v0[1]); w.y = pk2(v0[2], v0[3]); w.z = pk2(v1[0], v1[1]); w.w = pk2(v1[2], v1[3]);
                    *(u32x4*)(rowp + bj * 128) = w; } }
    } };
__device__ __forceinline__ void p1_inproj(const Params& p, LAS unsigned char* lds) {
    pg8::DenseSched S; S.o.init(128, 34, gridDim.x, blockIdx.x); S.A = (const bf16_t*)(p.ws + WS_XB); S.Bt = (const bf16_t*)(p.ws + WS_WIN); S.lda = D; S.ldb = D;
    EpiInProj E{(bf16_t*)(p.ws + WS_QKV), (bf16_t*)(p.ws + WS_GATES), (const float*)(p.ws + WS_R1), p.in[3], p.in[4], p.in[6], p.in[7], (LAS float*)(lds + 131072)};
    pg8::gemm_phase<true, false>(lds, S, E, D / 64, D, D);
}

__device__ __forceinline__ void wait_vm(int n) {
    switch (n) { case 0: asm volatile("s_waitcnt vmcnt(0)" ::: "memory"); break; case 2: asm volatile("s_waitcnt vmcnt(2)" ::: "memory"); break; case 4: asm volatile("s_waitcnt vmcnt(4)" ::: "memory"); break;
                 case 6: asm volatile("s_waitcnt vmcnt(6)" ::: "memory"); break; case 8: asm volatile("s_waitcnt vmcnt(8)" ::: "memory"); break; case 10: asm volatile("s_waitcnt vmcnt(10)" ::: "memory"); break;
                 default: asm volatile("s_waitcnt vmcnt(12)" ::: "memory"); break; }
}
__device__ __forceinline__ void glds16_asm(const void* gsrc, unsigned lds_dst) {
    unsigned keep;
    asm volatile("s_mov_b32 %0, m0\n\ts_mov_b32 m0, %2\n\ts_nop 0\n\tglobal_load_lds_dwordx4 %1, off\n\ts_mov_b32 m0, %0" : "=&s"(keep) : "v"(gsrc), "s"(lds_dst) : "memory");
}
#define ATT_BAR() do { asm volatile("s_waitcnt lgkmcnt(0)" ::: "memory"); __builtin_amdgcn_s_barrier(); asm volatile("" ::: "memory"); } while (0)
__device__ __forceinline__ void load_q(const bf16_t* qp, int g, bf16x8 (&qf)[4]) {
#pragma unroll
    for (int ks = 0; ks < 4; ++ks) qf[ks] = *(const bf16x8*)(qp + 32 * ks + 8 * g);
#pragma unroll
    for (int ks = 0; ks < 4; ++ks) asm volatile("" : "+v"(qf[ks]));
}
__device__ __forceinline__ bf16x8 vt_frag(LAS unsigned char* base, int row0, int g, int q4, int pp, int dt) {
    const s16x4 lo = tr_read(base + off_b(row0 + 4 * g + q4, 2 * dt + (pp >> 1)) + 8 * (pp & 1)), hi = tr_read(base + off_b(row0 + 16 + 4 * g + q4, 2 * dt + (pp >> 1)) + 8 * (pp & 1));
    bf16x8 vf; vf[0] = lo[0]; vf[1] = lo[1]; vf[2] = lo[2]; vf[3] = lo[3]; vf[4] = hi[0]; vf[5] = hi[1]; vf[6] = hi[2]; vf[7] = hi[3]; return vf;
}

__device__ __forceinline__ void attn_window_item(const Params& p, LAS unsigned char* lds, int item, int& tab_head) {
    const int tid = phase_tid(), lane = tid & 63, w = __builtin_amdgcn_readfirstlane(tid >> 6), g = lane >> 4, ql = lane & 15;
    const int b = item >> 10, nb = (item >> 3) & 127, hq = item & 7, kv = hq >> 2;
    const bf16_t* qkv = (const bf16_t*)(p.ws + WS_QKV); bf16_t* o = (bf16_t*)(p.ws + WS_O);
    LAS float* bias = (LAS float*)(lds + 131072); const unsigned ldsb = (unsigned)(size_t)lds;
    const unsigned loff = (unsigned)(w * 4 + g) * NQKV + (unsigned)((ql ^ ((g << 2) | (w & 3))) * 8);
    const bf16_t* kbase = qkv + (size_t)(b * SEQ) * NQKV + 1024 + kv * 128;
#define WIN_ISSUE(c) do { const int _c = (c); const int _kb = min(max(nb - 1 + (_c % 3), 0), 127); const bf16_t* _src = kbase + (size_t)(_kb * 128) * NQKV + (_c >= 3 ? 256 : 0) + loff; \
        _Pragma("unroll") for (int _i = 0; _i < 4; ++_i) glds16_asm(_src + (size_t)(32 * _i) * NQKV, ldsb + (unsigned)((_c & 3) * 32768 + _i * 8192 + w * 1024)); } while (0)
    ATT_BAR();
    WIN_ISSUE(0); WIN_ISSUE(1); WIN_ISSUE(2);
    if (hq != tab_head) { if (tid < 257) bias[tid] = p.in[12][t5_bucket(tid - 128) * 8 + hq]; tab_head = hq; }
    const int tq = b * SEQ + nb * 128 + 16 * w + ql;
    bf16x8 qf[4]; load_q(qkv + (size_t)tq * NQKV + hq * 128, g, qf);
    float sink = p.in[5][hq]; asm volatile("" : "+v"(sink));
    f32x4 S1[8], SC[9];
#pragma unroll
    for (int kt = 0; kt < 8; ++kt) S1[kt] = (f32x4){0.f, 0.f, 0.f, 0.f};
#pragma unroll
    for (int s = 0; s < 9; ++s) SC[s] = (f32x4){0.f, 0.f, 0.f, 0.f};
    const bool in0 = nb > 0, in2 = nb < 127;
#pragma unroll
    for (int c = 0; c < 3; ++c) {
        wait_vm(8); ATT_BAR(); WIN_ISSUE(c + 3);
        LAS unsigned char* buf = lds + (c & 3) * 32768;
#pragma unroll
        for (int kt = 0; kt < 8; ++kt) {
            if (c == 1) {
#pragma unroll
                for (int ks = 0; ks < 4; ++ks) { const bf16x8 kf = *(const LAS bf16x8*)(buf + off_b(16 * kt + ql, 4 * ks + g)); S1[kt] = __builtin_amdgcn_mfma_f32_16x16x32_bf16(kf, qf[ks], S1[kt], 0, 0, 0); }
            } else if (c == 0) { if (kt >= w) {
#pragma unroll
                for (int ks = 0; ks < 4; ++ks) { const bf16x8 kf = *(const LAS bf16x8*)(buf + off_b(16 * kt + ql, 4 * ks + g)); SC[7 - kt] = __builtin_amdgcn_mfma_f32_16x16x32_bf16(kf, qf[ks], SC[7 - kt], 0, 0, 0); } }
            } else { if (kt <= w) {
#pragma unroll
                for (int ks = 0; ks < 4; ++ks) { const bf16x8 kf = *(const LAS bf16x8*)(buf + off_b(16 * kt + ql, 4 * ks + g)); SC[8 - kt] = __builtin_amdgcn_mfma_f32_16x16x32_bf16(kf, qf[ks], SC[8 - kt], 0, 0, 0); } }
            }
        }
    }
    float mx = sink; const int qi = 16 * w + ql;
#pragma unroll
    for (int kt = 0; kt < 8; ++kt)
#pragma unroll
        for (int r = 0; r < 4; ++r) { const int rel = 16 * kt + 4 * g + r - qi; const float sv = S1[kt][r] + bias[rel + 128]; S1[kt][r] = sv; mx = fmaxf(mx, sv); }
#pragma unroll
    for (int s = 0; s < 9; ++s) { const bool c0 = s <= 7 - w; const int kt = c0 ? 7 - s : 8 - s; const int cofs = c0 ? -128 : 128; const bool inr = c0 ? in0 : in2;
#pragma unroll
        for (int r = 0; r < 4; ++r) { const int rel = cofs + 16 * kt + 4 * g + r - qi; const bool valid = inr && rel >= -128 && rel <= 128;
            const float bv = bias[min(max(rel, -128), 128) + 128];
            const float sv = valid ? SC[s][r] + bv : -1e30f; SC[s][r] = sv; mx = fmaxf(mx, sv); } }
    mx = fmaxf(mx, __shfl_xor(mx, 16)); mx = fmaxf(mx, __shfl_xor(mx, 32));
    float l = 0.f;
#pragma unroll
    for (int kt = 0; kt < 8; ++kt)
#pragma unroll
        for (int r = 0; r < 4; ++r) { const float pe = __expf(S1[kt][r] - mx); S1[kt][r] = pe; l += pe; }
#pragma unroll
    for (int s = 0; s < 9; ++s)
#pragma unroll
        for (int r = 0; r < 4; ++r) { const float pe = __expf(SC[s][r] - mx); SC[s][r] = pe; l += pe; }
    l += __shfl_xor(l, 16); l += __shfl_xor(l, 32); l += __expf(sink - mx);
    const float inv = 1.0f / l;
    f32x4 O[8];
#pragma unroll
    for (int dt = 0; dt < 8; ++dt) O[dt] = (f32x4){0.f, 0.f, 0.f, 0.f};
    const int q4 = ql >> 2, pp = ql & 3;
    const f32x4 zero4 = (f32x4){0.f, 0.f, 0.f, 0.f};
#pragma unroll
    for (int c = 0; c < 3; ++c) {
        wait_vm(c == 0 ? 8 : (c == 1 ? 4 : 0)); ATT_BAR();
        LAS unsigned char* buf = lds + ((c + 3) & 3) * 32768;
#pragma unroll
        for (int kk = 0; kk < 4; ++kk) {
            bool a0, a1; f32x4 p0, p1;
            if (c == 1) { a0 = true; a1 = true; p0 = S1[2 * kk]; p1 = S1[2 * kk + 1]; }
            else if (c == 0) { a0 = 2 * kk >= w; a1 = 2 * kk + 1 >= w; p0 = a0 ? SC[7 - 2 * kk] : zero4; p1 = a1 ? SC[6 - 2 * kk] : zero4; }
            else { a0 = 2 * kk <= w; a1 = 2 * kk + 1 <= w; p0 = a0 ? SC[8 - 2 * kk] : zero4; p1 = a1 ? SC[7 - 2 * kk] : zero4; }
            if (a0 || a1) { u32x4 pw; pw.x = pk2(p0[0], p0[1]); pw.y = pk2(p0[2], p0[3]); pw.z = pk2(p1[0], p1[1]); pw.w = pk2(p1[2], p1[3]);
                const bf16x8 pf = __builtin_bit_cast(bf16x8, pw);
#pragma unroll
                for (int dt = 0; dt < 8; ++dt) O[dt] = __builtin_amdgcn_mfma_f32_16x16x32_bf16(vt_frag(buf, 32 * kk, g, q4, pp, dt), pf, O[dt], 0, 0, 0); } }
    }
#undef WIN_ISSUE
    bf16_t* op = o + (size_t)tq * D + hq * 128 + 4 * g;
#pragma unroll
    for (int dt = 0; dt < 8; ++dt) { u32x2 w2; w2.x = pk2(O[dt][0] * inv, O[dt][1] * inv); w2.y = pk2(O[dt][2] * inv, O[dt][3] * inv); *(u32x2*)(op + 16 * dt) = w2; }
}

__device__ __forceinline__ void attn_nat_item(const Params& p, LAS unsigned char* lds, int item, int& tab_head) {
    const int tid = phase_tid(), lane = tid & 63, w = __builtin_amdgcn_readfirstlane(tid >> 6), g = lane >> 4, ql = lane & 15;
    const int b = item >> 10, rp = (item >> 3) & 127, h = item & 7, rr = w >> 2, jq = w & 3, r = 2 * rp + rr;
    const int kr_lo = min(max(2 * rp - 4, 0), 248), rs = min(max(r - 4, 0), 248), d = rs - kr_lo;
    const int w0 = jq == 0 ? 0 : (jq == 1 ? 8 : (jq == 2 ? 24 : 32));
    const bf16_t* qkv = (const bf16_t*)(p.ws + WS_QKV); bf16_t* o = (bf16_t*)(p.ws + WS_O);
    LAS float* rpb = (LAS float*)(lds + 131072); const unsigned ldsb = (unsigned)(size_t)lds;
    const unsigned loff = (unsigned)(w * 4 + g) * NQKV + (unsigned)((ql ^ ((g << 2) | (w & 3))) * 8);
    const bf16_t* kbase = qkv + (size_t)(b * SEQ) * NQKV + 2560 + h * 128;
#define NAT_ISSUE(s) do { const int _s = (s); const int _kr = min(kr_lo + (_s % 9), 255); const bf16_t* _src = kbase + (size_t)(_kr * 64) * NQKV + (_s >= 9 ? 1024 : 0) + loff; \
        _Pragma("unroll") for (int _i = 0; _i < 2; ++_i) glds16_asm(_src + (size_t)(32 * _i) * NQKV, ldsb + (unsigned)((_s & 7) * 16384 + _i * 8192 + w * 1024)); } while (0)
    ATT_BAR();
#pragma unroll
    for (int s = 0; s < 7; ++s) NAT_ISSUE(s);
    if (h != tab_head) { if (tid < 465) rpb[tid] = p.in[8][h * 465 + tid]; tab_head = h; }
    const int qcol = 16 * jq + ql; const int tq = b * SEQ + r * 64 + qcol;
    bf16x8 qf[4]; load_q(qkv + (size_t)tq * NQKV + 1536 + h * 128, g, qf);
    f32x4 S[9][2];
#pragma unroll
    for (int c = 0; c < 9; ++c) { S[c][0] = (f32x4){0.f, 0.f, 0.f, 0.f}; S[c][1] = (f32x4){0.f, 0.f, 0.f, 0.f}; }
#pragma unroll
    for (int c = 0; c < 9; ++c) {
        wait_vm(12); ATT_BAR(); NAT_ISSUE(c + 7);
        if (c >= d && c < d + 8) { LAS unsigned char* buf = lds + (c & 7) * 16384;
#pragma unroll
            for (int t = 0; t < 2; ++t)
#pragma unroll
                for (int ks = 0; ks < 4; ++ks) { const bf16x8 kf = *(const LAS bf16x8*)(buf + off_b(w0 + 16 * t + ql, 4 * ks + g)); S[c][t] = __builtin_amdgcn_mfma_f32_16x16x32_bf16(kf, qf[ks], S[c][t], 0, 0, 0); } }
    }
    const int cs = min(max(qcol - 8, 0), 48); float mx = -1e30f;
#pragma unroll
    for (int c = 0; c < 9; ++c) { const bool act = c >= d && c < d + 8; const int dr = kr_lo + c - r + 7;
#pragma unroll
        for (int t = 0; t < 2; ++t)
#pragma unroll
            for (int q = 0; q < 4; ++q) { const int kc = w0 + 16 * t + 4 * g + q; const bool valid = act && kc >= cs && kc < cs + 16; const int dc = kc - qcol + 15;
                const float bv = rpb[min(max(dr, 0), 14) * 31 + min(max(dc, 0), 30)];
                const float sv = valid ? S[c][t][q] + bv : -1e30f; S[c][t][q] = sv; mx = fmaxf(mx, sv); } }
    mx = fmaxf(mx, __shfl_xor(mx, 16)); mx = fmaxf(mx, __shfl_xor(mx, 32));
    float l = 0.f;
#pragma unroll
    for (int c = 0; c < 9; ++c)
#pragma unroll
        for (int t = 0; t < 2; ++t)
#pragma unroll
            for (int q = 0; q < 4; ++q) { const float pe = __expf(S[c][t][q] - mx); S[c][t][q] = pe; l += pe; }
    l += __shfl_xor(l, 16); l += __shfl_xor(l, 32);
    const float inv = 1.0f / l;
    f32x4 O[8];
#pragma unroll
    for (int dt = 0; dt < 8; ++dt) O[dt] = (f32x4){0.f, 0.f, 0.f, 0.f};
    const int q4 = ql >> 2, pp = ql & 3;
#pragma unroll
    for (int c = 0; c < 9; ++c) {
        wait_vm(c <= 2 ? 12 : 2 * (8 - c)); ATT_BAR(); if (c + 16 < 18) NAT_ISSUE(c + 16);
        if (c >= d && c < d + 8) { LAS unsigned char* buf = lds + ((c + 9) & 7) * 16384;
            u32x4 pw; pw.x = pk2(S[c][0][0], S[c][0][1]); pw.y = pk2(S[c][0][2], S[c][0][3]); pw.z = pk2(S[c][1][0], S[c][1][1]); pw.w = pk2(S[c][1][2], S[c][1][3]);
            const bf16x8 pf = __builtin_bit_cast(bf16x8, pw);
#pragma unroll
            for (int dt = 0; dt < 8; ++dt) O[dt] = __builtin_amdgcn_mfma_f32_16x16x32_bf16(vt_frag(buf, w0, g, q4, pp, dt), pf, O[dt], 0, 0, 0); }
    }
#undef NAT_ISSUE
    bf16_t* op = o + (size_t)tq * D + 1024 + h * 128 + 4 * g;
#pragma unroll
    for (int dt = 0; dt < 8; ++dt) { u32x2 w2; w2.x = pk2(O[dt][0] * inv, O[dt][1] * inv); w2.y = pk2(O[dt][2] * inv, O[dt][3] * inv); *(u32x2*)(op + 16 * dt) = w2; }
}
__device__ __forceinline__ void p2_attn(const Params& p, LAS unsigned char* lds) {
    int tab_head = -1;
    for (int it = blockIdx.x; it < 2048; it += gridDim.x) attn_window_item(p, lds, it, tab_head);
#ifdef PROBE_A
    if (blockIdx.x == 0 && threadIdx.x == 0) ((unsigned long long*)(p.ws + WS_END))[11] = __builtin_amdgcn_s_memrealtime();
#endif
    tab_head = -1;
    for (int it = blockIdx.x; it < 2048; it += gridDim.x) attn_nat_item(p, lds, it, tab_head);
    asm volatile("s_waitcnt vmcnt(0)" ::: "memory"); __syncthreads();
}

struct UpHook { const bf16_t* gates;
    __device__ __forceinline__ void operator()(f32x4 (&acc)[2][2][4][2], const Unit& u, int wr, int wc, int fr, int fq) const {
        unsigned goff = (unsigned)(u.pm * 256 + wr * 64 + fr) * NGATE + u.pn * 256 + wc * 32 + 8 * fq;
#pragma unroll
        for (int ai = 0; ai < 2; ++ai) {
#pragma unroll
            for (int m = 0; m < 4; ++m) { asm volatile("" : "+v"(goff));
#pragma unroll
                for (int bj = 0; bj < 2; ++bj) { const bf16x8 sa = *(const bf16x8*)(gates + goff + bj * 128), sb = *(const bf16x8*)(gates + goff + 2048 + bj * 128);
#pragma unroll
                    for (int n = 0; n < 2; ++n)
#pragma unroll
                        for (int j = 0; j < 4; ++j) acc[ai][bj][m][n][j] *= bf2f(sa[4 * n + j]) * __builtin_amdgcn_rcpf(fmaxf(bf2f(sb[4 * n + j]), 1e-30f)); }
                goff += 16 * NGATE; }
            goff += 64 * NGATE; }
    } };
struct UpSched {
    pg8::TileOrder o; const bf16_t* A; const bf16_t* Bt;
    __device__ __forceinline__ bool next(int i, Unit& u) const { u.aux = i & 1; return o.tile(i >> 1, u.pm, u.pn); }
    __device__ __forceinline__ const char* a_base(const Unit& u) const { return (const char*)(A + (size_t)u.pm * 256 * D + u.aux * 1024); }
    __device__ __forceinline__ const char* b_base(const Unit& u) const { return (const char*)(Bt + (size_t)u.pn * 256 * D + u.aux * 1024); }
    __device__ __forceinline__ bool keep_acc(const Unit& u) const { return u.aux == 0; }
    __device__ __forceinline__ void a_offs(const Unit&, int, int, int, int, unsigned (&)[2][2]) const {}
};
struct EpiUp { const bf16_t* gates; bf16_t* merged;
    __device__ __forceinline__ void operator()(f32x4 (&acc)[2][2][4][2], const Unit& u, int wr, int wc, int fr, int fq) const {
        if (u.aux == 0) { UpHook{gates}(acc, u, wr, wc, fr, fq); return; }
        unsigned goff = (unsigned)(u.pm * 256 + wr * 64 + fr) * NGATE + u.pn * 256 + wc * 32 + 8 * fq;
        unsigned moff = (unsigned)(u.pm * 256 + wr * 64 + fr) * D + u.pn * 256 + wc * 32 + 8 * fq;
#pragma unroll
        for (int ai = 0; ai < 2; ++ai) {
#pragma unroll
            for (int m = 0; m < 4; ++m) { asm volatile("" : "+v"(goff), "+v"(moff));
#pragma unroll
                for (int bj = 0; bj < 2; ++bj) { const bf16x8 sb = *(const bf16x8*)(gates + goff + 2048 + bj * 128);
                    f32x4 v0 = acc[ai][bj][m][0], v1 = acc[ai][bj][m][1];
#pragma unroll
                    for (int j = 0; j < 4; ++j) { v0[j] *= fmaxf(bf2f(sb[j]), 1e-30f); v1[j] *= fmaxf(bf2f(sb[4 + j]), 1e-30f); }
                    u32x4 w; w.x = pk2(v0[0], v0[1]); w.y = pk2(v0[2], v0[3]); w.z = pk2(v1[0], v1[1]); w.w = pk2(v1[2], v1[3]);
                    *(u32x4*)(merged + moff + bj * 128) = w; }
                goff += 16 * NGATE; moff += 16 * D; }
            goff += 64 * NGATE; moff += 64 * D; }
    } };
__device__ __forceinline__ void p3_up(const Params& p, LAS unsigned char* lds) {
    UpSched S; S.o.init(128, 8, gridDim.x, blockIdx.x); S.A = (const bf16_t*)(p.ws + WS_O); S.Bt = (const bf16_t*)(p.ws + WS_WUP);
    EpiUp E{(const bf16_t*)(p.ws + WS_GATES), (bf16_t*)(p.ws + WS_XB)};
    pg8::gemm_phase<true, false>(lds, S, E, 1024 / 64, D, D);
}

struct EpiOut { bf16_t* mob;
    __device__ __forceinline__ void operator()(f32x4 (&acc)[2][2][4][2], const Unit& u, int wr, int wc, int fr, int fq) const {
        unsigned off = (unsigned)(u.pm * 256 + wr * 64 + fr) * D + u.pn * 256 + wc * 32 + 8 * fq;
#pragma unroll
        for (int ai = 0; ai < 2; ++ai) {
#pragma unroll
            for (int m = 0; m < 4; ++m) { asm volatile("" : "+v"(off));
#pragma unroll
                for (int bj = 0; bj < 2; ++bj) { const f32x4 v0 = acc[ai][bj][m][0], v1 = acc[ai][bj][m][1];
                    u32x4 w; w.x = pk2(v0[0], v0[1]); w.y = pk2(v0[2], v0[3]); w.z = pk2(v1[0], v1[1]); w.w = pk2(v1[2], v1[3]);
                    *(u32x4*)(mob + off + bj * 128) = w; }
                off += 16 * D; }
            off += 64 * D; }
    } };
__device__ __forceinline__ void p4_out(const Params& p, LAS unsigned char* lds) {
    pg8::DenseSched S; S.o.init(128, 8, gridDim.x, blockIdx.x); S.A = (const bf16_t*)(p.ws + WS_XB); S.Bt = (const bf16_t*)(p.ws + WS_WOUT); S.lda = D; S.ldb = D;
    EpiOut E{(bf16_t*)(p.ws + WS_MOB)};
    pg8::gemm_phase<true, false>(lds, S, E, D / 64, D, D);
}

__device__ __forceinline__ void p5_router(const Params& p, LAS unsigned char* lds) {
    const int tid = phase_tid(), lane = tid & 63, wave = __builtin_amdgcn_readfirstlane(tid >> 6), g = lane >> 4, tl = lane & 15;
    const bf16_t* wsp = (const bf16_t*)(p.ws + WS_WRT); float* r2 = (float*)(p.ws + WS_R2); int* cnt = (int*)(p.ws + WS_CNT); int* tokl = (int*)(p.ws + WS_TOK);
    int* recc = (int*)(p.ws + WS_RECC); float* recw = (float*)(p.ws + WS_RECW); bf16_t* hb = (bf16_t*)(p.ws + WS_O); const bf16_t* mob = (const bf16_t*)(p.ws + WS_MOB);
    const float* brg = p.in[15]; const float* bre = p.in[17];
    LAS float* H = (LAS float*)(lds + wave * 4352);
    LAS unsigned char* WL = lds + 36864;
    const int r4 = lane >> 4, k4 = (lane & 15) * 4;
    const int pa0 = tid / 384, pr0 = (tid % 384) >> 3, ps0 = tid & 7, pi1 = 512 + tid, pa1 = pi1 / 384, pr1 = (pi1 % 384) >> 3;
    const unsigned wsrc0 = (unsigned)(pa0 * 48 * 2048 + pr0 * D + ps0 * 8), wsrc1 = (unsigned)(pa1 * 48 * 2048 + pr1 * D + ps0 * 8);
    const unsigned wdst0 = (unsigned)(pa0 * 6144 + pr0 * 128 + ((ps0 ^ (pr0 & 7)) << 4)), wdst1 = (unsigned)(pa1 * 6144 + pr1 * 128 + ((ps0 ^ (pr1 & 7)) << 4));
    for (int round = blockIdx.x; round < T / 128; round += gridDim.x) {
        const int tile = round * 8 + wave;
        const float* xs = p.in[0] + (size_t)tile * 16 * D; const bf16_t* ms = mob + (size_t)tile * 16 * D; bf16_t* hs = hb + (size_t)tile * 16 * D;
        unsigned lo = (unsigned)(r4 * D + k4);
        f32x4 accA = {0.f, 0.f, 0.f, 0.f}, accB = accA, accC = accA; float ss = 0.f;
        f32x4 xa[4], xb_[4], xc[4]; u32x2 ma[4], mb[4], mc[4]; u32x4 wr0, wr1;
#define RT_LOADS(bx, bm, k) do { _Pragma("unroll") for (int j = 0; j < 4; ++j) { bx[j] = *(const f32x4*)(xs + (4 * j) * D + lo + 64 * (k)); bm[j] = *(const u32x2*)(ms + (4 * j) * D + lo + 64 * (k)); } } while (0)
#define RT_SPLIT(f0, f1, hi, lw) do { hi = pk2(f0, f1); lw = pk2((f0) - __uint_as_float(hi << 16), (f1) - __uint_as_float(hi & 0xffff0000u)); } while (0)
#define RT_COMP(bx, bm, k, wbuf) do { \
            _Pragma("unroll") for (int j = 0; j < 4; ++j) { f32x4 h = bx[j]; h.x += __uint_as_float(bm[j].x << 16); h.y += __uint_as_float(bm[j].x & 0xffff0000u); h.z += __uint_as_float(bm[j].y << 16); h.w += __uint_as_float(bm[j].y & 0xffff0000u); \
                u32x2 q2; q2.x = pk2(h[0], h[1]); q2.y = pk2(h[2], h[3]); *(u32x2*)(hs + (4 * j) * D + lo + 64 * (k)) = q2; \
                *(LAS f32x4*)(H + (4 * j + r4) * 68 + k4) = h; } \
            _Pragma("unroll") for (int ks = 0; ks < 2; ++ks) { const f32x4 h0 = *(const LAS f32x4*)(H + tl * 68 + 32 * ks + 8 * g), h1 = *(const LAS f32x4*)(H + tl * 68 + 32 * ks + 8 * g + 4); \
                ss += (h0.x * h0.x + h0.y * h0.y) + (h0.z * h0.z + h0.w * h0.w) + (h1.x * h1.x + h1.y * h1.y) + (h1.z * h1.z + h1.w * h1.w); \
                u32x4 hh, hl; RT_SPLIT(h0.x, h0.y, hh.x, hl.x); RT_SPLIT(h0.z, h0.w, hh.y, hl.y); RT_SPLIT(h1.x, h1.y, hh.z, hl.z); RT_SPLIT(h1.z, h1.w, hh.w, hl.w); \
                const bf16x8 bh = __builtin_bit_cast(bf16x8, hh), bl = __builtin_bit_cast(bf16x8, hl); const unsigned so_ = (unsigned)(((4 * ks + g) ^ (tl & 7)) << 4); \
                _Pragma("unroll") for (int t = 0; t < 3; ++t) { const bf16x8 ah = *(const LAS bf16x8*)((wbuf) + (16 * t + tl) * 128 + so_), al = *(const LAS bf16x8*)((wbuf) + 6144 + (16 * t + tl) * 128 + so_); \
                    f32x4& ac = (t == 0 ? accA : (t == 1 ? accB : accC)); \
                    ac = __builtin_amdgcn_mfma_f32_16x16x32_bf16(ah, bh, ac, 0, 0, 0); ac = __builtin_amdgcn_mfma_f32_16x16x32_bf16(al, bh, ac, 0, 0, 0); ac = __builtin_amdgcn_mfma_f32_16x16x32_bf16(ah, bl, ac, 0, 0, 0); } } } while (0)
#define RT_WLOAD(c) do { wr0 = *(const u32x4*)(wsp + wsrc0 + 64 * (c)); if (tid < 256) wr1 = *(const u32x4*)(wsp + wsrc1 + 64 * (c)); } while (0)
#define RT_WSTORE(wbuf) do { *(LAS u32x4*)((wbuf) + wdst0) = wr0; if (tid < 256) *(LAS u32x4*)((wbuf) + wdst1) = wr1; } while (0)
        __syncthreads();
        RT_WLOAD(0); RT_LOADS(xa, ma, 0); RT_LOADS(xb_, mb, 1);
        RT_WSTORE(WL); RT_WLOAD(1);
        __syncthreads();
#pragma unroll 1
        for (int c = 0; c < D / 64 - 2; c += 3) {
            const int pz = c & 1;
            RT_LOADS(xc, mc, 2); RT_COMP(xa, ma, 0, WL + pz * 12288); RT_WSTORE(WL + (pz ^ 1) * 12288); RT_WLOAD(c + 2); __syncthreads();
            RT_LOADS(xa, ma, 3); RT_COMP(xb_, mb, 1, WL + (pz ^ 1) * 12288); RT_WSTORE(WL + pz * 12288); RT_WLOAD(c + 3); __syncthreads();
            RT_LOADS(xb_, mb, 4); RT_COMP(xc, mc, 2, WL + pz * 12288); RT_WSTORE(WL + (pz ^ 1) * 12288); RT_WLOAD((c + 4) & 31); __syncthreads();
            lo += 192;
        }
        RT_COMP(xa, ma, 0, WL); RT_WSTORE(WL + 12288); __syncthreads();
        RT_COMP(xb_, mb, 1, WL + 12288);
#undef RT_LOADS
#undef RT_SPLIT
#undef RT_COMP
#undef RT_WLOAD
#undef RT_WSTORE
        const int tok = tile * 16 + tl;
        ss += __shfl_xor(ss, 16); ss += __shfl_xor(ss, 32);
        const float rr = rsqrtf(ss * (1.0f / D) + EPS);
        const float myg = accC[0] * rr + brg[g];
        float gl[4];
#pragma unroll
        for (int j = 0; j < 4; ++j) gl[j] = __shfl(myg, tl + 16 * j);
        int gi = 0; float gm = gl[0];
#pragma unroll
        for (int i = 1; i < 4; ++i) if (gl[i] > gm) { gm = gl[i]; gi = i; }
        float den = 0.f;
#pragma unroll
        for (int i = 0; i < 4; ++i) den += __expf(gl[i] - gm);
        const float pg = 1.0f / den;
        int L0 = 0, L1 = 0; float wt0 = 0.f, wt1 = 0.f; const bool owner = (g == gi);
        if (owner) {
            float el[8];
#pragma unroll
            for (int i = 0; i < 4; ++i) { el[i] = accA[i] * rr + bre[g * 8 + i]; el[4 + i] = accB[i] * rr + bre[g * 8 + 4 + i]; }
            int e0 = 0; float v0 = el[0];
#pragma unroll
            for (int i = 1; i < 8; ++i) if (el[i] > v0) { v0 = el[i]; e0 = i; }
            int e1 = -1; float v1 = -3.0e38f;
#pragma unroll
            for (int i = 0; i < 8; ++i) if (i != e0 && el[i] > v1) { v1 = el[i]; e1 = i; }
            const float ex = __expf(v1 - v0); const float s0 = 1.0f / (1.0f + ex), s1 = ex * s0;
            r2[tok] = rr; L0 = gi * 8 + e0; L1 = gi * 8 + e1; wt0 = pg * s0; wt1 = pg * s1;
        }
        LAS int* cl = (LAS int*)(lds + 61440);
        if (tid < 32) cl[tid] = 0;
        __syncthreads();
        int q0 = 0, q1 = 0;
        if (owner) { q0 = __hip_atomic_fetch_add(&cl[L0], 1, __ATOMIC_RELAXED, __HIP_MEMORY_SCOPE_WORKGROUP); q1 = __hip_atomic_fetch_add(&cl[L1], 1, __ATOMIC_RELAXED, __HIP_MEMORY_SCOPE_WORKGROUP); }
        __syncthreads();
        if (tid < 32) { const int n = cl[tid]; cl[32 + tid] = n ? atomicAdd(&cnt[tid], n) : 0; }
        __syncthreads();
        if (owner) { const int p0 = cl[32 + L0] + q0, p1 = cl[32 + L1] + q1;
            tokl[(size_t)L0 * T + p0] = tok; recc[2 * tok] = L0 * 32768 + p0; recw[2 * tok] = wt0;
            tokl[(size_t)L1 * T + p1] = tok; recc[2 * tok + 1] = L1 * 32768 + p1; recw[2 * tok + 1] = wt1; }
    }
    __syncthreads();
}

__device__ __forceinline__ void build_tiles(const Params& p, LAS int* tab) {
    __syncthreads();
    if (threadIdx.x == 0) { const int* cnt = (const int*)(p.ws + WS_CNT); int nt = 0, slot = 0;
        for (int L = 0; L < 32; ++L) { tab[1400 + L] = slot; const int c = cnt[L]; for (int r0 = 0; r0 < c; r0 += 256) { tab[4 + nt * 4 + 0] = L; tab[4 + nt * 4 + 1] = r0; tab[4 + nt * 4 + 2] = slot; tab[4 + nt * 4 + 3] = min(256, c - r0); slot += 256; ++nt; } }
        tab[0] = nt; }
    __syncthreads();
}
template <int NPN> struct MoeOrder { int G, c, t_lo, nt_tiles; const LAS int* tab;
    __device__ __forceinline__ bool unit(int i, Unit& u) const { const long L = (long)i * G + c; if (L >= (long)nt_tiles * NPN) return false;
        const int nwg = nt_tiles * NPN; int wgid = (int)L; { const int q = nwg / 8, r = nwg % 8, xcd = wgid % 8, off = wgid / 8; wgid = (xcd < r ? xcd * (q + 1) : r * (q + 1) + (xcd - r) * q) + off; }
        u.pm = t_lo + wgid / NPN; u.pn = wgid % NPN; u.aux = 0; return true; } };
struct GateUpSched { MoeOrder<4> o; const bf16_t* hb; const bf16_t* WguT; const int* tokl;
    __device__ __forceinline__ bool next(int i, Unit& u) const { return o.unit(i, u); }
    __device__ __forceinline__ const char* a_base(const Unit&) const { return (const char*)hb; }
    __device__ __forceinline__ const char* b_base(const Unit& u) const { const int e = o.tab[4 + u.pm * 4] & 31; return (const char*)(WguT + (size_t)(e * 1024 + u.pn * 256) * D); }
    __device__ __forceinline__ bool keep_acc(const Unit&) const { return false; }
    __device__ __forceinline__ void a_offs(const Unit& u, int R0, int C0, int R1, int C1, unsigned (&v)[2][2]) const {
        const int L = o.tab[4 + u.pm * 4], row0 = o.tab[4 + u.pm * 4 + 1], nrows = o.tab[4 + u.pm * 4 + 3]; const int* lst = tokl + (size_t)L * T + row0;
#pragma unroll
        for (int h = 0; h < 2; ++h) { const int r0 = R0 + 128 * h, r1 = R1 + 128 * h; const int t0 = r0 < nrows ? lst[r0] : 0, t1 = r1 < nrows ? lst[r1] : 0;
            v[h][0] = ((unsigned)t0 * D + C0) * 2u; v[h][1] = ((unsigned)t1 * D + C1) * 2u; } }
};
struct EpiGateUp { const LAS int* tab; const int* tokl; const float* r2; bf16_t* he;
    __device__ __forceinline__ void operator()(f32x4 (&acc)[2][2][4][2], const Unit& u, int wr, int wc, int fr, int fq) const {
        const int L = tab[4 + u.pm * 4], row0 = tab[4 + u.pm * 4 + 1], slot = tab[4 + u.pm * 4 + 2], nrows = tab[4 + u.pm * 4 + 3];
#pragma unroll
        for (int ai = 0; ai < 2; ++ai)
#pragma unroll
            for (int m = 0; m < 4; ++m) { const int rr = ai * 128 + wr * 64 + m * 16 + fr; const int tk = rr < nrows ? tokl[(size_t)L * T + row0 + rr] : 0; const float rs = r2[tk];
                u32x4 w; unsigned ww[4];
#pragma unroll
                for (int n = 0; n < 2; ++n) { float hv[4];
#pragma unroll
                    for (int j = 0; j < 4; ++j) { const float gt = acc[ai][0][m][n][j] * rs, up = acc[ai][1][m][n][j] * rs; hv[j] = gt * sigmoidf_(gt) * up; }
                    ww[2 * n] = pk2(hv[0], hv[1]); ww[2 * n + 1] = pk2(hv[2], hv[3]); }
                w.x = ww[0]; w.y = ww[1]; w.z = ww[2]; w.w = ww[3];
                *(u32x4*)(he + (size_t)(slot + rr) * 512 + u.pn * 128 + wc * 32 + 8 * fq) = w; }
    } };
__device__ __forceinline__ void p6_gateup(const Params& p, LAS unsigned char* lds) {
    LAS int* tab = (LAS int*)(lds + TAB_OFF); build_tiles(p, tab);
    GateUpSched S; S.o.G = gridDim.x; S.o.c = blockIdx.x; S.o.t_lo = 0; S.o.nt_tiles = tab[0]; S.o.tab = tab;
    S.hb = (const bf16_t*)(p.ws + WS_O); S.WguT = (const bf16_t*)(p.ws + WS_WGU); S.tokl = (const int*)(p.ws + WS_TOK);
    EpiGateUp E{tab, (const int*)(p.ws + WS_TOK), (const float*)(p.ws + WS_R2), (bf16_t*)(p.ws + WS_HE)};
    pg8::gemm_phase<true, true>(lds, S, E, D / 64, D, D);
}
struct DownSched { MoeOrder<8> o; const bf16_t* he; const bf16_t* WdT;
    __device__ __forceinline__ bool next(int i, Unit& u) const { return o.unit(i, u); }
    __device__ __forceinline__ const char* a_base(const Unit& u) const { return (const char*)(he + (size_t)o.tab[4 + u.pm * 4 + 2] * 512); }
    __device__ __forceinline__ const char* b_base(const Unit& u) const { const int e = o.tab[4 + u.pm * 4] & 31; return (const char*)(WdT + (size_t)(e * 2048 + u.pn * 256) * 512); }
    __device__ __forceinline__ bool keep_acc(const Unit&) const { return false; }
    __device__ __forceinline__ void a_offs(const Unit&, int, int, int, int, unsigned (&)[2][2]) const {}
};
struct EpiDown { const LAS int* tab; bf16_t* ye;
    __device__ __forceinline__ void operator()(f32x4 (&acc)[2][2][4][2], const Unit& u, int wr, int wc, int fr, int fq) const {
        const int slot = tab[4 + u.pm * 4 + 2];
        unsigned off = (unsigned)(slot + wr * 64 + fr) * D + u.pn * 256 + wc * 32 + 8 * fq;
#pragma unroll
        for (int ai = 0; ai < 2; ++ai) {
#pragma unroll
            for (int m = 0; m < 4; ++m) { asm volatile("" : "+v"(off));
#pragma unroll
                for (int bj = 0; bj < 2; ++bj) { const f32x4 v0 = acc[ai][bj][m][0], v1 = acc[ai][bj][m][1];
                    u32x4 w; w.x = pk2(v0[0], v0[1]); w.y = pk2(v0[2], v0[3]); w.z = pk2(v1[0], v1[1]); w.w = pk2(v1[2], v1[3]);
                    *(u32x4*)(ye + off + bj * 128) = w; }
                off += 16 * D; }
            off += 64 * D; }
    } };
__device__ __forceinline__ void p7_down(const Params& p, LAS unsigned char* lds) {
    LAS int* tab = (LAS int*)(lds + TAB_OFF); build_tiles(p, tab);
    DownSched S; S.o.G = gridDim.x; S.o.c = blockIdx.x; S.o.t_lo = 0; S.o.nt_tiles = tab[0]; S.o.tab = tab;
    S.he = (const bf16_t*)(p.ws + WS_HE); S.WdT = (const bf16_t*)(p.ws + WS_WD);
    EpiDown E{tab, (bf16_t*)(p.ws + WS_YE)};
    pg8::gemm_phase<true, false>(lds, S, E, 512 / 64, 512, 512);
}
__device__ __forceinline__ void p8_combine(const Params& p, LAS unsigned char* lds) {
    LAS int* tab = (LAS int*)(lds + TAB_OFF); build_tiles(p, tab);
    const int tid = phase_tid(), lane = tid & 63, wave = tid >> 6; const int gw = blockIdx.x * 8 + wave, NGW = gridDim.x * 8;
    const int* recc = (const int*)(p.ws + WS_RECC); const float* recw = (const float*)(p.ws + WS_RECW); const bf16_t* ye = (const bf16_t*)(p.ws + WS_YE); const bf16_t* mob = (const bf16_t*)(p.ws + WS_MOB);
    for (int tok = gw; tok < T; tok += NGW) {
        const int c0 = recc[2 * tok], c1 = recc[2 * tok + 1]; const float wa = recw[2 * tok], wb = recw[2 * tok + 1];
        const int s0 = tab[1400 + (c0 >> 15)] + (c0 & 32767), s1 = tab[1400 + (c1 >> 15)] + (c1 & 32767);
        const f32x4* xp = (const f32x4*)(p.in[0] + (size_t)tok * D) + lane; f32x4* op = (f32x4*)(p.out + (size_t)tok * D) + lane;
        const u32x2* mp = (const u32x2*)(mob + (size_t)tok * D) + lane; const u32x2* y0 = (const u32x2*)(ye + (size_t)s0 * D) + lane; const u32x2* y1 = (const u32x2*)(ye + (size_t)s1 * D) + lane;
        f32x4 hv[8]; u32x2 m[8], a[8], b[8];
#pragma unroll
        for (int j = 0; j < 8; ++j) { hv[j] = xp[64 * j]; m[j] = mp[64 * j]; a[j] = y0[64 * j]; b[j] = y1[64 * j]; }
#pragma unroll
        for (int j = 0; j < 8; ++j) { f32x4 v = hv[j];
            v.x += __uint_as_float(m[j].x << 16) + wa * __uint_as_float(a[j].x << 16) + wb * __uint_as_float(b[j].x << 16); v.y += __uint_as_float(m[j].x & 0xffff0000u) + wa * __uint_as_float(a[j].x & 0xffff0000u) + wb * __uint_as_float(b[j].x & 0xffff0000u);
            v.z += __uint_as_float(m[j].y << 16) + wa * __uint_as_float(a[j].y << 16) + wb * __uint_as_float(b[j].y << 16); v.w += __uint_as_float(m[j].y & 0xffff0000u) + wa * __uint_as_float(a[j].y & 0xffff0000u) + wb * __uint_as_float(b[j].y & 0xffff0000u);
            op[64 * j] = v; }
    }
}

#define XB_TMO      128
#define XB_XCNT(j)  (256  + 64 * (j))
#define XB_XSUB(j)  (1280 + 64 * (j))
#define XB_XGEN(j)  (2304 + 64 * (j))
#define XB_TOP      3328
#define XB_TOPGEN   3392
#define XCD_BAR_WORDS 3456
#define XB_SPIN_CAP (1u << 18)
__device__ __forceinline__ unsigned xb_ld(unsigned* p)              { return __hip_atomic_load(p, __ATOMIC_RELAXED, __HIP_MEMORY_SCOPE_AGENT); }
__device__ __forceinline__ unsigned xb_add(unsigned* p, unsigned v) { return __hip_atomic_fetch_add(p, v, __ATOMIC_RELAXED, __HIP_MEMORY_SCOPE_AGENT); }
__device__ __forceinline__ unsigned xb_xcc_id() { return (unsigned)__builtin_amdgcn_s_getreg((3 << 11) | 20) & 0xFu; }
#define XB_SPIN(cond, bar) do { unsigned _sp = 0; while (cond) { __builtin_amdgcn_s_sleep(1); \
    if ((++_sp & 255u) == 0u) { if (xb_ld(&(bar)[XB_TMO])) break; if (_sp > XB_SPIN_CAP) { atomicAdd(&(bar)[XB_TMO], 1u); break; } } } } while (0)
struct XcdBarrier { unsigned* bar; unsigned x; volatile LAS unsigned* st; };
__device__ __forceinline__ XcdBarrier xcd_barrier_post(unsigned* bar, volatile LAS unsigned* st) {
    XcdBarrier b; b.bar = bar; b.x = xb_xcc_id(); b.st = st;
    if (threadIdx.x == 0) (void)xb_add(&bar[XB_XCNT(b.x)], 1u);
    return b;
}
__device__ __forceinline__ void xcd_barrier_complete(unsigned* bar, unsigned x, unsigned& nloc, unsigned& nx) {
    const unsigned G = gridDim.x * gridDim.y * gridDim.z;
    unsigned sum, cnt, mine, sp = 0u;
    for (;;) {
        sum = 0u; cnt = 0u; mine = 0u;
#pragma unroll
        for (unsigned j = 0; j < 16; ++j) { const unsigned c = xb_ld(&bar[XB_XCNT(j)]); sum += c; cnt += (c > 0u) ? 1u : 0u; mine = (j == x) ? c : mine; }
        if (sum == G) break;
        __builtin_amdgcn_s_sleep(1);
        if ((++sp & 255u) == 0u) { if (xb_ld(&bar[XB_TMO])) break; if (sp > XB_SPIN_CAP) { atomicAdd(&bar[XB_TMO], 1u); break; } }
    }
    nloc = mine > 0u ? mine : 1u; nx = cnt > 0u ? cnt : 1u;
}
__device__ __forceinline__ void xcd_barrier(const XcdBarrier& b) {
    asm volatile("s_waitcnt vmcnt(0)" ::: "memory");
    __syncthreads();
    if (threadIdx.x == 0) {
        unsigned* bar = b.bar;
        __builtin_amdgcn_s_waitcnt(0);
        unsigned nloc = b.st[0], nx = b.st[1];
        if (nloc == 0u) { xcd_barrier_complete(bar, b.x, nloc, nx); b.st[0] = nloc; b.st[1] = nx; }
        const unsigned old = xb_add(&bar[XB_XSUB(b.x)], 1u);
        const unsigned gen = old / nloc;
        if (old + 1u == (gen + 1u) * nloc) {
            __builtin_amdgcn_fence(__ATOMIC_RELEASE, "agent");
            asm volatile("s_waitcnt vmcnt(0)" ::: "memory");
            const unsigned og = xb_add(&bar[XB_TOP], 1u);
            const unsigned tg = og / nx;
            if (og + 1u == (tg + 1u) * nx) xb_add(&bar[XB_TOPGEN], 1u);
            else XB_SPIN(xb_ld(&bar[XB_TOPGEN]) == tg, bar);
            __builtin_amdgcn_fence(__ATOMIC_ACQUIRE, "agent");
            xb_add(&bar[XB_XGEN(b.x)], 1u);
            asm volatile("s_waitcnt vmcnt(0)" ::: "memory");
        } else {
            XB_SPIN(xb_ld(&bar[XB_XGEN(b.x)]) == gen, bar);
            __builtin_amdgcn_fence(__ATOMIC_ACQUIRE, "agent");
            asm volatile("s_waitcnt vmcnt(0)" ::: "memory");
        }
    }
    __syncthreads();
}

namespace cg = cooperative_groups;
#ifdef PROBE_A
#define STAMP(k) do { if (blockIdx.x == 0 && threadIdx.x == 0) ((unsigned long long*)(p.ws + WS_END))[k] = __builtin_amdgcn_s_memrealtime(); } while (0)
#else
#define STAMP(k) do {} while (0)
#endif
__global__ void __launch_bounds__(512, 2) fwd_megakernel(Params p) {
    extern __shared__ __attribute__((aligned(16))) unsigned char lds_raw[];
    LAS unsigned char* lds = (LAS unsigned char*)lds_raw;
    cg::grid_group grid = cg::this_grid();
    if (threadIdx.x == 0) { *(volatile LAS unsigned*)(lds + XBST_OFF) = 0u; *(volatile LAS unsigned*)(lds + XBST_OFF + 4) = 0u; }
    __syncthreads();
    const XcdBarrier xb = xcd_barrier_post((unsigned*)(p.ws + WS_BAR), (volatile LAS unsigned*)(lds + XBST_OFF));
#define GSYNC() xcd_barrier(xb)
    STAMP(0);
    p0_prep(p, lds);            grid.sync(); STAMP(1);
    p1_inproj(p, lds);          GSYNC(); STAMP(2);
    p2_attn(p, lds);            GSYNC(); STAMP(3);
    p_moe_prep(p, lds);         STAMP(4);
    p3_up(p, lds);              GSYNC(); STAMP(5);
    p4_out(p, lds);             GSYNC(); STAMP(6);
    p5_router(p, lds);          GSYNC(); STAMP(7);
    p6_gateup(p, lds);          GSYNC(); STAMP(8);
    p7_down(p, lds);            GSYNC(); STAMP(9);
    p8_combine(p, lds);
#ifdef PROBE_A
    grid.sync(); STAMP(10); grid.sync();
    {
        const unsigned long long* ts = (const unsigned long long*)(p.ws + WS_END);
        #ifndef PROBE_A1
#define PROBE_A1 (PROBE_A + 1)
#endif
#ifndef PROBE_B1
#define PROBE_B1 (PROBE_B + 1)
#endif
        const float usA = (float)(ts[PROBE_A1] - ts[PROBE_A]) * 0.01f, usB = (float)(ts[PROBE_B1] - ts[PROBE_B]) * 0.01f;
        const float eps = sqrtf(usA * 1e-6f);
        for (size_t i = (size_t)blockIdx.x * 512 + threadIdx.x; i < (size_t)T * D / 4; i += (size_t)gridDim.x * 512) { f32x4 v = ((f32x4*)p.out)[i]; v = v * (1.0f + eps); if (i == 0) v.x += usB * 0.1f; ((f32x4*)p.out)[i] = v; }
    }
#endif
}

extern "C" void kernel_launch(void* const* d_in, const int* in_sizes, int n_in, void* d_out, int out_size, void* d_ws, size_t ws_size, hipStream_t stream) {
    static int grid_blocks = 0;
    if (!grid_blocks) {
        if (n_in != 21 || out_size != T * D || ws_size < WS_MOB + 128 * MiB) { fprintf(stderr, "kernel_launch: unexpected problem (n_in %d out %d ws %zu)\n", n_in, out_size, ws_size); grid_blocks = -1; return; }
        if (hipFuncSetAttribute((const void*)fwd_megakernel, hipFuncAttributeMaxDynamicSharedMemorySize, LDS_BYTES) != hipSuccess) { fprintf(stderr, "kernel_launch: hipFuncSetAttribute failed\n"); grid_blocks = -1; return; }
        int dev = 0, cus = 0, per_cu = 0;
        hipGetDevice(&dev); hipDeviceGetAttribute(&cus, hipDeviceAttributeMultiprocessorCount, dev);
        hipOccupancyMaxActiveBlocksPerMultiprocessor(&per_cu, (const void*)fwd_megakernel, 512, LDS_BYTES);
        if (per_cu < 1 || cus < 1) { fprintf(stderr, "kernel_launch: occupancy query gave %d blocks/CU on %d CUs\n", per_cu, cus); grid_blocks = -1; return; }
        grid_blocks = cus;
    }
    if (grid_blocks < 0) return;
    Params p{};
    for (int i = 0; i < 21; ++i) p.in[i] = (const float*)d_in[i];
    p.out = (float*)d_out; p.ws = (unsigned char*)d_ws;
    if (hipMemsetAsync((char*)d_ws + WS_BAR, 0, 16384, stream) != hipSuccess) { fprintf(stderr, "kernel_launch: hipMemsetAsync of the barrier words failed\n"); return; }
    void* args[] = {&p};
    hipError_t e = hipLaunchCooperativeKernel((const void*)fwd_megakernel, dim3(grid_blocks), dim3(512), args, LDS_BYTES, stream);
    if (e != hipSuccess) fprintf(stderr, "cooperative launch failed: %s (grid %d)\n", hipGetErrorString(e), grid_blocks);
}
```

```cpp
#include <hip/hip_runtime.h>
#include <hip/hip_cooperative_groups.h>
#include <cstdio>
#include <cstdint>

#define LAS __attribute__((address_space(3)))
typedef unsigned short bf16_t;
typedef short bf16x8 __attribute__((ext_vector_type(8)));
typedef short s16x4 __attribute__((ext_vector_type(4)));
typedef float f32x4 __attribute__((ext_vector_type(4)));
typedef unsigned u32x4 __attribute__((ext_vector_type(4)));
typedef unsigned u32x2 __attribute__((ext_vector_type(2)));
typedef short v4i16_t __attribute__((ext_vector_type(4)));

namespace cfg {
constexpr int T = 32768, D = 2048, SEQ = 16384;
constexpr int NQKV = 4608, NGATE = 4096, NIN = 8704;
constexpr size_t MiB = 1ull << 20;
constexpr size_t WS_XB = 0, WS_QKV = 128 * MiB, WS_GATES = 416 * MiB, WS_O = 672 * MiB, WS_WIN = 800 * MiB, WS_WUP = 834 * MiB, WS_WOUT = 842 * MiB, WS_MISC = 850 * MiB;
constexpr size_t WS_WGU = WS_QKV, WS_WD = WS_QKV + 128 * MiB, WS_HE = WS_QKV + 192 * MiB;
constexpr size_t WS_R1 = WS_MISC, WS_R2 = WS_R1 + (size_t)T * 4, WS_WRT = WS_R2 + (size_t)T * 4, WS_CNT = WS_WRT + 512 * 1024, WS_TOK = WS_CNT + 4096,
                 WS_RECC = WS_TOK + 32ull * T * 4, WS_RECW = WS_RECC + 2ull * T * 4, WS_R2L = WS_RECW + 2ull * T * 4, WS_END = WS_R2L + 32ull * T * 4;
constexpr size_t WS_YE_LO = 0, WS_YE_HI = WS_GATES;
constexpr size_t WS_BAR = WS_END + 4096;
constexpr size_t WS_MOB = 872 * MiB;
constexpr int LDS_BYTES = 140 * 1024;
constexpr int XBST_OFF = LDS_BYTES - 16;
constexpr int TAB_OFF = 132 * 1024;
constexpr float EPS = 1e-6f;
}
using namespace cfg;

struct Params { const float* in[21]; float* out; unsigned char* ws; };
__device__ __forceinline__ int phase_tid() { int t = threadIdx.x; asm volatile("" : "+v"(t)); return t; }

__device__ __forceinline__ float bf2f(short s) { return __uint_as_float(((unsigned)(unsigned short)s) << 16); }
typedef float f32x2 __attribute__((ext_vector_type(2)));
typedef __bf16 bf16x2_t __attribute__((ext_vector_type(2)));
__device__ __forceinline__ unsigned pk2(float lo, float hi) { const f32x2 v = {lo, hi}; return __builtin_bit_cast(unsigned, __builtin_convertvector(v, bf16x2_t)); }
__device__ __forceinline__ float wave_sum(float v) {
#pragma unroll
    for (int o = 1; o < 64; o <<= 1) v += __shfl_xor(v, o);
    return v;
}
__device__ __forceinline__ float sigmoidf_(float v) { return 1.0f / (1.0f + __expf(-v)); }
__device__ __forceinline__ unsigned off_b(unsigned row, unsigned ch) { return 256u * row + 16u * (ch ^ (((row & 3) << 2) | ((row >> 2) & 3))); }
__device__ __forceinline__ s16x4 tr_read(LAS unsigned char* p) { return __builtin_bit_cast(s16x4, __builtin_amdgcn_ds_read_tr16_b64_v4i16((LAS v4i16_t*)p)); }
__host__ __device__ __forceinline__ int perm32(int rho) { const int n = rho >> 4, i = rho & 15; return 8 * (i >> 2) + 4 * n + (i & 3); }
__device__ __forceinline__ int t5_bucket(int rel) {
    const int n = rel < 0 ? -rel : rel; const int ret = rel > 0 ? 16 : 0; int b;
    if (n < 8) b = n; else if (n < 12) b = 8; else if (n < 16) b = 9; else if (n < 23) b = 10; else if (n < 32) b = 11; else if (n < 46) b = 12; else if (n < 64) b = 13; else if (n < 91) b = 14; else b = 15;
    return ret + b;
}

__device__ __forceinline__ void transpose_item(const float* __restrict__ W, int ldw, int k0, int n0, bf16_t* __restrict__ WT, int ldt, int drow0, int dk0, const float* __restrict__ scale, LAS unsigned* scr, int lane) {
    const int n4 = (lane & 15) * 4, kk = lane >> 4;
    const float* src = W + (size_t)(k0 + 2 * kk) * ldw + n0 + n4;
    f32x4 ev[8], od[8];
#pragma unroll
    for (int j = 0; j < 8; ++j) { ev[j] = *(const f32x4*)(src + (size_t)(8 * j) * ldw); od[j] = *(const f32x4*)(src + (size_t)(8 * j + 1) * ldw); }
#pragma unroll
    for (int j = 0; j < 8; ++j) { f32x4 e = ev[j], o = od[j];
        if (scale) { const float se = scale[k0 + 8 * j + 2 * kk], so = scale[k0 + 8 * j + 2 * kk + 1]; e = e * se; o = o * so; }
        u32x4 w; w.x = pk2(e.x, o.x); w.y = pk2(e.y, o.y); w.z = pk2(e.z, o.z); w.w = pk2(e.w, o.w);
        *(LAS u32x4*)(scr + (4 * j + kk) * 68 + n4) = w; }
    asm volatile("s_waitcnt lgkmcnt(0)" ::: "memory");
    const int kq = lane & 7;
#pragma unroll
    for (int i = 0; i < 8; ++i) { const int n = (lane >> 3) + 8 * i; const LAS unsigned* q = scr + (4 * kq) * 68 + n;
        u32x4 o; o.x = q[0]; o.y = q[68]; o.z = q[136]; o.w = q[204];
        *(u32x4*)(WT + (size_t)(drow0 + n) * ldt + dk0 + k0 + 8 * kq) = o; }
    asm volatile("s_waitcnt lgkmcnt(0)" ::: "memory");
}

__device__ __forceinline__ void p0_prep(const Params& p, LAS unsigned char* lds) {
    const int tid = phase_tid(), lane = tid & 63, wave = tid >> 6;
    const int gw = blockIdx.x * 8 + wave, NGW = gridDim.x * 8;
    LAS unsigned* scr = (LAS unsigned*)(lds + wave * 8704);
    const float* x = p.in[0]; const float* g1 = p.in[1]; const float* w_in = p.in[2];
    bf16_t* xb = (bf16_t*)(p.ws + WS_XB); float* r1 = (float*)(p.ws + WS_R1);
    bf16_t* WinT = (bf16_t*)(p.ws + WS_WIN); bf16_t* WupT = (bf16_t*)(p.ws + WS_WUP); bf16_t* WoutT = (bf16_t*)(p.ws + WS_WOUT);
    constexpr int I_WIN = 32 * 136, I_UP = 16 * 32, I_OUT = 32 * 32, NITEMS = I_WIN + 2 * I_UP + I_OUT;
    for (int it = gw; it < NITEMS; it += NGW) {
        int r = it;
        if (r < I_WIN) { const int kb = r / 136, nb = r % 136; const int n0 = nb * 64; int drow = n0;
            if (n0 >= NQKV) { const int c = (n0 - NQKV) & 2047, isb = (n0 - NQKV) >> 11; drow = NQKV + (c >> 7) * 256 + isb * 128 + (c & 127); }
            transpose_item(w_in, NIN, kb * 64, n0, WinT, 2048, drow, 0, g1, scr, lane); continue; } r -= I_WIN;
        if (r < I_UP) { const int kb = r / 32, nb = r % 32; transpose_item(p.in[9], 2048, kb * 64, nb * 64, WupT, 2048, nb * 64, 0, nullptr, scr, lane); continue; } r -= I_UP;
        if (r < I_UP) { const int kb = r / 32, nb = r % 32; transpose_item(p.in[10], 2048, kb * 64, nb * 64, WupT, 2048, nb * 64, 1024, nullptr, scr, lane); continue; } r -= I_UP;
        { const int kb = r / 32, nb = r % 32; transpose_item(p.in[11], 2048, kb * 64, nb * 64, WoutT, 2048, nb * 64, 0, nullptr, scr, lane); }
    }
    { bf16_t* whi = (bf16_t*)(p.ws + WS_WRT); bf16_t* wlo = whi + 48 * 2048; const float* g2 = p.in[13]; const float* wrg = p.in[14]; const float* wre = p.in[16];
      for (int i = blockIdx.x * 512 + tid; i < 48 * 2048; i += gridDim.x * 512) { const int row = i >> 11, k = i & 2047, t = row >> 4, r = row & 15; float w;
          if (t == 0) w = wre[k * 32 + (r >> 2) * 8 + (r & 3)]; else if (t == 1) w = wre[k * 32 + (r >> 2) * 8 + 4 + (r & 3)]; else w = (r & 3) == 0 ? wrg[k * 4 + (r >> 2)] : 0.f;
          w *= g2[k]; const unsigned hi = pk2(w, 0.f) & 0xffffu; const float hf = __uint_as_float(hi << 16); whi[i] = (bf16_t)hi; wlo[i] = (bf16_t)(pk2(w - hf, 0.f) & 0xffffu); } }
    if (blockIdx.x == 0 && tid < 32) ((int*)(p.ws + WS_CNT))[tid] = 0;
    for (int row0 = 2 * gw; row0 < T; row0 += 2 * NGW) {
        f32x4 v[2][8]; float ss[2] = {0.f, 0.f};
#pragma unroll
        for (int u = 0; u < 2; ++u) { const f32x4* xr = (const f32x4*)(x + (size_t)(row0 + u) * D) + lane;
#pragma unroll
            for (int j = 0; j < 8; ++j) v[u][j] = xr[64 * j]; }
#pragma unroll
        for (int u = 0; u < 2; ++u) {
#pragma unroll
            for (int j = 0; j < 8; ++j) ss[u] += (v[u][j].x * v[u][j].x + v[u][j].y * v[u][j].y) + (v[u][j].z * v[u][j].z + v[u][j].w * v[u][j].w);
            ss[u] = wave_sum(ss[u]);
            if (lane == 0) r1[row0 + u] = rsqrtf(ss[u] * (1.0f / D) + EPS);
            u32x2* o = (u32x2*)(xb + (size_t)(row0 + u) * D) + lane;
#pragma unroll
            for (int j = 0; j < 8; ++j) { u32x2 w; w.x = pk2(v[u][j].x, v[u][j].y); w.y = pk2(v[u][j].z, v[u][j].w); o[64 * j] = w; } }
    }
}

__device__ __forceinline__ void p_moe_prep(const Params& p, LAS unsigned char* lds) {
    const int tid = phase_tid(), lane = tid & 63, wave = tid >> 6;
    const int gw = blockIdx.x * 8 + wave, NGW = gridDim.x * 8;
    LAS unsigned* scr = (LAS unsigned*)(lds + wave * 8704);
    const float* g2 = p.in[13];
    bf16_t* WguT = (bf16_t*)(p.ws + WS_WGU); bf16_t* WdT = (bf16_t*)(p.ws + WS_WD);
    constexpr int I_G = 32 * 32 * 8;
    constexpr int I_D = 32 * 8 * 32;
    for (int it = gw; it < 2 * I_G + I_D; it += NGW) {
        int r = it;
        if (r < 2 * I_G) { const int which = r >= I_G; if (which) r -= I_G; const int e = r / 256, rr = r % 256, kb = rr / 8, nb = rr % 8;
            const float* W = p.in[which ? 19 : 18] + (size_t)e * 2048 * 512; const int n0 = nb * 64;
            transpose_item(W, 512, kb * 64, n0, WguT, 2048, e * 1024 + (n0 >> 7) * 256 + which * 128 + (n0 & 127), 0, g2, scr, lane); continue; }
        r -= 2 * I_G;
        { const int e = r / 256, rr = r % 256, kb = rr / 32, nb = rr % 32; const float* W = p.in[20] + (size_t)e * 512 * 2048;
          transpose_item(W, 2048, kb * 64, nb * 64, WdT, 512, e * 2048 + nb * 64, 0, nullptr, scr, lane); }
    }
}

struct Unit { int pm, pn, aux; };
namespace pg8 {
constexpr int BM = 256, BK = 64, HALF = 128, HTB = HALF * BK * 2, STAGE_BYTES = 8 * HTB;
__device__ __forceinline__ int lds_byte(int r, int c) { const int st = (r >> 4) * 2 + (c >> 5), rr = r & 15, cc = c & 31, ob = rr * 64 + cc * 2; return st * 1024 + (ob ^ (((ob >> 9) & 1) << 5)); }
__device__ __forceinline__ void stage_rc(int b, int& R, int& C) { const int st = b / 1024, sb = b % 1024, swz = sb ^ (((sb >> 9) & 1) << 5); R = (st >> 1) * 16 + swz / 64; C = (st & 1) * 32 + (swz % 64) / 2; }

template <bool PERM, bool GATHER, class Sched, class Epi>
__device__ __forceinline__ void gemm_phase(LAS unsigned char* lds, const Sched& S, const Epi& E, const int nt, const int lda, const int ldb) {
    int tid_ = threadIdx.x; asm volatile("" : "+v"(tid_));
    const int tid = tid_, wid = __builtin_amdgcn_readfirstlane(tid >> 6), lane = tid & 63, wr = wid >> 2, wc = wid & 3, fr = lane & 15, fq = lane >> 4;
    int R0, C0, R1, C1; stage_rc(tid * 16, R0, C0); stage_rc(tid * 16 + 8192, R1, C1);
    unsigned voffB[2], voffA[2][2];
    { const int Rb0 = PERM ? ((R0 & ~31) + perm32(R0 & 31)) : R0, Rb1 = PERM ? ((R1 & ~31) + perm32(R1 & 31)) : R1;
      voffB[0] = (unsigned)(Rb0 * ldb + C0) * 2u; voffB[1] = (unsigned)(Rb1 * ldb + C1) * 2u; }
    const size_t kstep = (size_t)(BK * 2);
    const size_t hstepB = (size_t)HALF * ldb * 2;
    const unsigned ldsw = (unsigned)wid * 1024u;
    const int aoff = lds_byte(wr * 64 + fr, fq * 8), boff = lds_byte(wc * 32 + fr, fq * 8);
#define PG8_SA(b, h) (((b) * 2 + (h)) * HTB)
#define PG8_SB(b, h) ((4 + (b) * 2 + (h)) * HTB)
#define PG8_STAGE_B(bufoff, gbase) do { _Pragma("unroll") for (int _i = 0; _i < 2; ++_i) \
        __builtin_amdgcn_global_load_lds((const unsigned*)((const char*)(gbase) + voffB[_i]), (LAS unsigned*)(lds + (bufoff) + ldsw + _i * 8192), 16, 0, 0); } while (0)
#define PG8_STAGE_A(bufoff, gbase, h) do { _Pragma("unroll") for (int _i = 0; _i < 2; ++_i) \
        __builtin_amdgcn_global_load_lds((const unsigned*)((const char*)(gbase) + voffA[h][_i]), (LAS unsigned*)(lds + (bufoff) + ldsw + _i * 8192), 16, 0, 0); } while (0)
#define PG8_LDA(dst, b, h) do { _Pragma("unroll") for (int m = 0; m < 4; ++m) _Pragma("unroll") for (int k = 0; k < 2; ++k) dst[m][k] = *(const LAS bf16x8*)(lds + PG8_SA(b, h) + aoff + m * 2048 + k * 1024); } while (0)
#define PG8_LDB(dst, b, h) do { _Pragma("unroll") for (int n = 0; n < 2; ++n) _Pragma("unroll") for (int k = 0; k < 2; ++k) dst[n][k] = *(const LAS bf16x8*)(lds + PG8_SB(b, h) + boff + n * 2048 + k * 1024); } while (0)
#define PG8_MMA(ai, bj, At, Bt) do { __builtin_amdgcn_s_setprio(1); _Pragma("unroll") for (int m = 0; m < 4; ++m) _Pragma("unroll") for (int n = 0; n < 2; ++n) _Pragma("unroll") for (int k = 0; k < 2; ++k) \
        acc[ai][bj][m][n] = __builtin_amdgcn_mfma_f32_16x16x32_bf16(Bt[n][k], At[m][k], acc[ai][bj][m][n], 0, 0, 0); __builtin_amdgcn_s_setprio(0); } while (0)
#define PG8_WAIT_V(n) asm volatile("s_waitcnt vmcnt(" #n ")" ::: "memory")
#define PG8_WAIT_L(n) asm volatile("s_waitcnt lgkmcnt(" #n ")" ::: "memory")
#define PG8_BAR __builtin_amdgcn_s_barrier()
#define PG8_SCHED __builtin_amdgcn_sched_barrier(0)
    Unit cur, nxt; int ui = 0;
    __syncthreads();
    if (!S.next(0, cur)) return;
    if (GATHER) S.a_offs(cur, R0, C0, R1, C1, voffA);
    else { voffA[0][0] = (unsigned)(R0 * lda + C0) * 2u; voffA[0][1] = (unsigned)(R1 * lda + C1) * 2u; voffA[1][0] = voffA[0][0] + (unsigned)(HALF * lda * 2); voffA[1][1] = voffA[0][1] + (unsigned)(HALF * lda * 2); }
    f32x4 acc[2][2][4][2];
#pragma unroll
    for (int a = 0; a < 2; ++a)
#pragma unroll
        for (int b = 0; b < 2; ++b)
#pragma unroll
            for (int m = 0; m < 4; ++m)
#pragma unroll
                for (int n = 0; n < 2; ++n) acc[a][b][m][n] = (f32x4){0.f, 0.f, 0.f, 0.f};
    bf16x8 At[4][2], B0[2][2], B1[2][2];
    const char* cA = S.a_base(cur); const char* cB = S.b_base(cur);
    PG8_STAGE_B(PG8_SB(0, 0), cB); PG8_STAGE_B(PG8_SB(0, 1), cB + hstepB); PG8_STAGE_A(PG8_SA(0, 0), cA, 0); PG8_STAGE_A(PG8_SA(0, 1), cA, 1);
    if (wr == 1) PG8_BAR;
    PG8_WAIT_V(2); PG8_BAR;
    PG8_STAGE_B(PG8_SB(1, 0), cB + kstep); PG8_STAGE_A(PG8_SA(1, 0), cA + kstep, 0); PG8_STAGE_B(PG8_SB(1, 1), cB + hstepB + kstep);
    PG8_WAIT_V(6); PG8_BAR;
    for (;;) {
        const bool has_next = S.next(ui + 1, nxt);
        const char* nA = has_next ? S.a_base(nxt) : cA; const char* nB = has_next ? S.b_base(nxt) : cB;
        unsigned vn[2][2];
        if (GATHER) { if (has_next) S.a_offs(nxt, R0, C0, R1, C1, vn); else { vn[0][0] = voffA[0][0]; vn[0][1] = voffA[0][1]; vn[1][0] = voffA[1][0]; vn[1][1] = voffA[1][1]; } }
        for (int t = 0; t < nt; t += 2) {
            const bool last = (t == nt - 2);
            const char* a1 = cA + (size_t)(t + 1) * kstep;
            const char* a2 = last ? nA : cA + (size_t)(t + 2) * kstep; const char* b2 = last ? nB : cB + (size_t)(t + 2) * kstep;
            const char* a3 = a2 + kstep; const char* b3 = b2 + kstep;
            PG8_LDB(B0, 0, 0); PG8_LDB(B1, 0, 1); PG8_SCHED; PG8_LDA(At, 0, 0); PG8_STAGE_A(PG8_SA(1, 1), a1, 1);
            if (GATHER) { if (last) { voffA[0][0] = vn[0][0]; voffA[0][1] = vn[0][1]; voffA[1][0] = vn[1][0]; voffA[1][1] = vn[1][1]; } }
            PG8_WAIT_V(8); PG8_WAIT_L(0); PG8_BAR; PG8_MMA(0, 0, At, B0); PG8_MMA(0, 1, At, B1); PG8_BAR; PG8_SCHED;
            PG8_LDA(At, 0, 1); PG8_STAGE_B(PG8_SB(0, 0), b2); PG8_STAGE_B(PG8_SB(0, 1), b2 + hstepB); PG8_STAGE_A(PG8_SA(0, 0), a2, 0);
            PG8_WAIT_V(8); PG8_WAIT_L(0); PG8_BAR; PG8_MMA(1, 0, At, B0); PG8_MMA(1, 1, At, B1); PG8_BAR; PG8_SCHED;
            PG8_LDB(B0, 1, 0); PG8_LDB(B1, 1, 1); PG8_SCHED; PG8_LDA(At, 1, 0); PG8_STAGE_A(PG8_SA(0, 1), a2, 1);
            PG8_WAIT_V(8); PG8_WAIT_L(0); PG8_BAR; PG8_MMA(0, 0, At, B0); PG8_MMA(0, 1, At, B1); PG8_BAR; PG8_SCHED;
            PG8_LDA(At, 1, 1); PG8_STAGE_B(PG8_SB(1, 0), b3); PG8_STAGE_B(PG8_SB(1, 1), b3 + hstepB); PG8_STAGE_A(PG8_SA(1, 0), a3, 0);
            PG8_WAIT_V(8); PG8_WAIT_L(0); PG8_BAR; PG8_MMA(1, 0, At, B0); PG8_MMA(1, 1, At, B1); PG8_BAR; PG8_SCHED;
        }
        if (wr == 0) PG8_BAR;
        E(acc, cur, wr, wc, fr, fq);
        if (!has_next) break;
        if (!S.keep_acc(cur)) {
#pragma unroll
        for (int a = 0; a < 2; ++a)
#pragma unroll
            for (int b = 0; b < 2; ++b)
#pragma unroll
                for (int m = 0; m < 4; ++m)
#pragma unroll
                    for (int n = 0; n < 2; ++n) acc[a][b][m][n] = (f32x4){0.f, 0.f, 0.f, 0.f};
        }
        cur = nxt; cA = nA; cB = nB; ++ui;
        if (wr == 1) PG8_BAR;
    }
    PG8_WAIT_V(0);
    PG8_BAR;
#undef PG8_SA
#undef PG8_SB
#undef PG8_STAGE_A
#undef PG8_STAGE_B
#undef PG8_LDA
#undef PG8_LDB
#undef PG8_MMA
#undef PG8_WAIT_V
#undef PG8_WAIT_L
#undef PG8_BAR
#undef PG8_SCHED
}
struct TileOrder {
    int nM, nN, nwg, G, c;
    __device__ __forceinline__ void init(int nM_, int nN_, int G_, int c_) { nM = nM_; nN = nN_; nwg = nM * nN; G = G_; c = c_; }
    __device__ __forceinline__ bool tile(int i, int& pm, int& pn) const {
        const long L = (long)i * G + c; if (L >= nwg) return false;
        int wgid = (int)L; { const int q = nwg / 8, r = nwg % 8, xcd = wgid % 8, off = wgid / 8; wgid = (xcd < r ? xcd * (q + 1) : r * (q + 1) + (xcd - r) * q) + off; }
        const int nig = 8 * nN, gid = wgid / nig, fm = gid * 8, gsz = (nM - fm) < 8 ? (nM - fm) : 8;
        pm = fm + ((wgid % nig) % gsz); pn = (wgid % nig) / gsz; return true;
    }
};
struct DenseSched {
    TileOrder o; const bf16_t* A; const bf16_t* Bt; int lda, ldb;
    __device__ __forceinline__ bool next(int i, Unit& u) const { u.aux = 0; return o.tile(i, u.pm, u.pn); }
    __device__ __forceinline__ const char* a_base(const Unit& u) const { return (const char*)(A + (size_t)u.pm * 256 * lda); }
    __device__ __forceinline__ const char* b_base(const Unit& u) const { return (const char*)(Bt + (size_t)u.pn * 256 * ldb); }
    __device__ __forceinline__ bool keep_acc(const Unit&) const { return false; }
    __device__ __forceinline__ void a_offs(const Unit&, int, int, int, int, unsigned (&)[2][2]) const {}
};
}

struct EpiInProj { bf16_t* qkv; bf16_t* gates; const float* r1; const float* gqa; const float* gka; const float* gqb; const float* gkb; LAS float* X;
    __device__ __forceinline__ void operator()(f32x4 (&acc)[2][2][4][2], const Unit& u, int wr, int wc, int fr, int fq) const {
        const int pn = u.pn;
        const bool isg = pn >= 18; bf16_t* base = isg ? gates : qkv; const int ldc = isg ? NGATE : NQKV; const int colt = (isg ? pn - 18 : pn) * 256 + wc * 32 + 8 * fq;
        const float* gain = pn < 4 ? gqa : (pn == 4 ? gka : ((pn >= 6 && pn < 10) ? gqb : ((pn >= 10 && pn < 14) ? gkb : nullptr)));
        if (gain) {
            const float extra = (pn < 4 || (pn >= 6 && pn < 10)) ? 0.08838834764831845f : 1.0f;
#pragma unroll
            for (int ai = 0; ai < 2; ++ai)
#pragma unroll
                for (int m = 0; m < 4; ++m)
#pragma unroll
                    for (int bj = 0; bj < 2; ++bj) { const f32x4 a0 = acc[ai][bj][m][0], a1 = acc[ai][bj][m][1];
                        float sq = (a0[0] * a0[0] + a0[1] * a0[1]) + (a0[2] * a0[2] + a0[3] * a0[3]) + (a1[0] * a1[0] + a1[1] * a1[1]) + (a1[2] * a1[2] + a1[3] * a1[3]);
                        sq += __shfl_xor(sq, 16); sq += __shfl_xor(sq, 32);
                        if (fq == 0) X[(ai * 128 + wr * 64 + m * 16 + fr) * 8 + bj * 4 + wc] = sq; }
            asm volatile("s_waitcnt lgkmcnt(0)" ::: "memory"); __builtin_amdgcn_s_barrier(); asm volatile("" ::: "memory");
            const f32x4 g0 = *(const f32x4*)(gain + wc * 32 + 8 * fq), g1 = *(const f32x4*)(gain + wc * 32 + 8 * fq + 4);
#pragma unroll
            for (int ai = 0; ai < 2; ++ai)
#pragma unroll
                for (int m = 0; m < 4; ++m) { const int rl = ai * 128 + wr * 64 + m * 16 + fr; const int row = u.pm * 256 + rl; const float rs = r1[row]; bf16_t* rowp = base + (size_t)row * ldc + colt;
#pragma unroll
                    for (int bj = 0; bj < 2; ++bj) { const f32x4 t = *(const LAS f32x4*)(X + rl * 8 + bj * 4); const float tot = (t[0] + t[1]) + (t[2] + t[3]);
                        const float sc = rs * rsqrtf(rs * rs * tot * (1.0f / 128.0f) + EPS) * extra;
                        const f32x4 v0 = acc[ai][bj][m][0] * sc * g0, v1 = acc[ai][bj][m][1] * sc * g1;
                        u32x4 w; w.x = pk2(v0[0], v0[1]); w.y = pk2(v0[2], v0[3]); w.z = pk2(v1[0], v1[1]); w.w = pk2(v1[2], v1[3]);
                        *(u32x4*)(rowp + bj * 128) = w; } }
            return;
        }
        if (isg) {
            const int cg = (pn - 18) * 128 + wc * 32 + 8 * fq;
#pragma unroll
            for (int ai = 0; ai < 2; ++ai)
#pragma unroll
                for (int m = 0; m < 4; ++m) { const int row = u.pm * 256 + ai * 128 + wr * 64 + m * 16 + fr; const float rs = r1[row]; bf16_t* rowp = gates + (size_t)row * NGATE + cg;
                    float ra[8], sb[8];
#pragma unroll
                    for (int n = 0; n < 2; ++n)
#pragma unroll
                        for (int j = 0; j < 4; ++j) { const float ea = __expf(-acc[ai][0][m][n][j] * rs), eb = fminf(__expf(-acc[ai][1][m][n][j] * rs), 1e30f);
                            sb[4 * n + j] = __builtin_amdgcn_rcpf(1.0f + eb); ra[4 * n + j] = (1.0f + eb) * __builtin_amdgcn_rcpf(1.0f + ea); }
                    u32x4 w; w.x = pk2(ra[0], ra[1]); w.y = pk2(ra[2], ra[3]); w.z = pk2(ra[4], ra[5]); w.w = pk2(ra[6], ra[7]); *(u32x4*)rowp = w;
                    w.x = pk2(sb[0], sb[1]); w.y = pk2(sb[2], sb[3]); w.z = pk2(sb[4], sb[5]); w.w = pk2(sb[6], sb[7]); *(u32x4*)(rowp + 2048) = w; }
            return;
        }
#pragma unroll
        for (int ai = 0; ai < 2; ++ai)
#pragma unroll
            for (int m = 0; m < 4; ++m) { const int row = u.pm * 256 + ai * 128 + wr * 64 + m * 16 + fr; const float rs = r1[row]; bf16_t* rowp = base + (size_t)row * ldc + colt;
#pragma unroll
                for (int bj = 0; bj < 2; ++bj) { const f32x4 v0 = acc[ai][bj][m][0] * rs, v1 = acc[ai][bj][m][1] * rs;
                    u32x4 w; w.x = pk2(v0[0], v0[1]); w.y = pk2(v0[2], v0[3]); w.z = pk2(v1[0], v1[1]); w.w = pk2(v1[2], v1[3]);
                    *(u32x4*)(rowp + bj * 128) = w; } }
    } };
__device__ __forceinline__ void p1_inproj(const Params& p, LAS unsigned char* lds) {
    pg8::DenseSched S; S.o.init(128, 34, gridDim.x, blockIdx.x); S.A = (const bf16_t*)(p.ws + WS_XB); S.Bt = (const bf16_t*)(p.ws + WS_WIN); S.lda = D; S.ldb = D;
    EpiInProj E{(bf16_t*)(p.ws + WS_QKV), (bf16_t*)(p.ws + WS_GATES), (const float*)(p.ws + WS_R1), p.in[3], p.in[4], p.in[6], p.in[7], (LAS float*)(lds + 131072)};
    pg8::gemm_phase<true, false>(lds, S, E, D / 64, D, D);
}

__device__ __forceinline__ void wait_vm(int n) {
    switch (n) { case 0: asm volatile("s_waitcnt vmcnt(0)" ::: "memory"); break; case 2: asm volatile("s_waitcnt vmcnt(2)" ::: "memory"); break; case 4: asm volatile("s_waitcnt vmcnt(4)" ::: "memory"); break;
                 case 6: asm volatile("s_waitcnt vmcnt(6)" ::: "memory"); break; case 8: asm volatile("s_waitcnt vmcnt(8)" ::: "memory"); break; case 10: asm volatile("s_waitcnt vmcnt(10)" ::: "memory"); break;
                 default: asm volatile("s_waitcnt vmcnt(12)" ::: "memory"); break; }
}
__device__ __forceinline__ void glds16_asm(const void* gsrc, unsigned lds_dst) {
    unsigned keep;
    asm volatile("s_mov_b32 %0, m0\n\ts_mov_b32 m0, %2\n\ts_nop 0\n\tglobal_load_lds_dwordx4 %1, off\n\ts_mov_b32 m0, %0" : "=&s"(keep) : "v"(gsrc), "s"(lds_dst) : "memory");
}
#define ATT_BAR() do { asm volatile("s_waitcnt lgkmcnt(0)" ::: "memory"); __builtin_amdgcn_s_barrier(); asm volatile("" ::: "memory"); } while (0)
__device__ __forceinline__ void load_q(const bf16_t* qp, int g, bf16x8 (&qf)[4]) {
#pragma unroll
    for (int ks = 0; ks < 4; ++ks) qf[ks] = *(const bf16x8*)(qp + 32 * ks + 8 * g);
#pragma unroll
    for (int ks = 0; ks < 4; ++ks) asm volatile("" : "+v"(qf[ks]));
}
__device__ __forceinline__ bf16x8 vt_frag(LAS unsigned char* base, int row0, int g, int q4, int pp, int dt) {
    const s16x4 lo = tr_read(base + off_b(row0 + 4 * g + q4, 2 * dt + (pp >> 1)) + 8 * (pp & 1)), hi = tr_read(base + off_b(row0 + 16 + 4 * g + q4, 2 * dt + (pp >> 1)) + 8 * (pp & 1));
    bf16x8 vf; vf[0] = lo[0]; vf[1] = lo[1]; vf[2] = lo[2]; vf[3] = lo[3]; vf[4] = hi[0]; vf[5] = hi[1]; vf[6] = hi[2]; vf[7] = hi[3]; return vf;
}

__device__ __forceinline__ void attn_window_item(const Params& p, LAS unsigned char* lds, int item, int& tab_head) {
    const int tid = phase_tid(), lane = tid & 63, w = __builtin_amdgcn_readfirstlane(tid >> 6), g = lane >> 4, ql = lane & 15;
    const int b = item >> 10, nb = (item >> 3) & 127, hq = item & 7, kv = hq >> 2;
    const bf16_t* qkv = (const bf16_t*)(p.ws + WS_QKV); bf16_t* o = (bf16_t*)(p.ws + WS_O);
    LAS float* bias = (LAS float*)(lds + 131072); const unsigned ldsb = (unsigned)(size_t)lds;
    const unsigned loff = (unsigned)(w * 4 + g) * NQKV + (unsigned)((ql ^ ((g << 2) | (w & 3))) * 8);
    const bf16_t* kbase = qkv + (size_t)(b * SEQ) * NQKV + 1024 + kv * 128;
#define WIN_ISSUE(c) do { const int _c = (c); const int _kb = min(max(nb - 1 + (_c % 3), 0), 127); const bf16_t* _src = kbase + (size_t)(_kb * 128) * NQKV + (_c >= 3 ? 256 : 0) + loff; \
        _Pragma("unroll") for (int _i = 0; _i < 4; ++_i) glds16_asm(_src + (size_t)(32 * _i) * NQKV, ldsb + (unsigned)((_c & 3) * 32768 + _i * 8192 + w * 1024)); } while (0)
    ATT_BAR();
    WIN_ISSUE(0); WIN_ISSUE(1); WIN_ISSUE(2);
    if (hq != tab_head) { if (tid < 257) bias[tid] = p.in[12][t5_bucket(tid - 128) * 8 + hq]; tab_head = hq; }
    const int tq = b * SEQ + nb * 128 + 16 * w + ql;
    bf16x8 qf[4]; load_q(qkv + (size_t)tq * NQKV + hq * 128, g, qf);
    float sink = p.in[5][hq]; asm volatile("" : "+v"(sink));
    f32x4 S1[8], SC[9];
#pragma unroll
    for (int kt = 0; kt < 8; ++kt) S1[kt] = (f32x4){0.f, 0.f, 0.f, 0.f};
#pragma unroll
    for (int s = 0; s < 9; ++s) SC[s] = (f32x4){0.f, 0.f, 0.f, 0.f};
    const bool in0 = nb > 0, in2 = nb < 127;
#pragma unroll
    for (int c = 0; c < 3; ++c) {
        wait_vm(8); ATT_BAR(); WIN_ISSUE(c + 3);
        LAS unsigned char* buf = lds + (c & 3) * 32768;
#pragma unroll
        for (int kt = 0; kt < 8; ++kt) {
            if (c == 1) {
#pragma unroll
                for (int ks = 0; ks < 4; ++ks) { const bf16x8 kf = *(const LAS bf16x8*)(buf + off_b(16 * kt + ql, 4 * ks + g)); S1[kt] = __builtin_amdgcn_mfma_f32_16x16x32_bf16(kf, qf[ks], S1[kt], 0, 0, 0); }
            } else if (c == 0) { if (kt >= w) {
#pragma unroll
                for (int ks = 0; ks < 4; ++ks) { const bf16x8 kf = *(const LAS bf16x8*)(buf + off_b(16 * kt + ql, 4 * ks + g)); SC[7 - kt] = __builtin_amdgcn_mfma_f32_16x16x32_bf16(kf, qf[ks], SC[7 - kt], 0, 0, 0); } }
            } else { if (kt <= w) {
#pragma unroll
                for (int ks = 0; ks < 4; ++ks) { const bf16x8 kf = *(const LAS bf16x8*)(buf + off_b(16 * kt + ql, 4 * ks + g)); SC[8 - kt] = __builtin_amdgcn_mfma_f32_16x16x32_bf16(kf, qf[ks], SC[8 - kt], 0, 0, 0); } }
            }
        }
    }
    float mx = sink; const int qi = 16 * w + ql;
#pragma unroll
    for (int kt = 0; kt < 8; ++kt)
#pragma unroll
        for (int r = 0; r < 4; ++r) { const int rel = 16 * kt + 4 * g + r - qi; const float sv = S1[kt][r] + bias[rel + 128]; S1[kt][r] = sv; mx = fmaxf(mx, sv); }
#pragma unroll
    for (int s = 0; s < 9; ++s) { const bool c0 = s <= 7 - w; const int kt = c0 ? 7 - s : 8 - s; const int cofs = c0 ? -128 : 128; const bool inr = c0 ? in0 : in2;
#pragma unroll
        for (int r = 0; r < 4; ++r) { const int rel = cofs + 16 * kt + 4 * g + r - qi; const bool valid = inr && rel >= -128 && rel <= 128;
            const float bv = bias[min(max(rel, -128), 128) + 128];
            const float sv = valid ? SC[s][r] + bv : -1e30f; SC[s][r] = sv; mx = fmaxf(mx, sv); } }
    mx = fmaxf(mx, __shfl_xor(mx, 16)); mx = fmaxf(mx, __shfl_xor(mx, 32));
    float l = 0.f;
#pragma unroll
    for (int kt = 0; kt < 8; ++kt)
#pragma unroll
        for (int r = 0; r < 4; ++r) { const float pe = __expf(S1[kt][r] - mx); S1[kt][r] = pe; l += pe; }
#pragma unroll
    for (int s = 0; s < 9; ++s)
#pragma unroll
        for (int r = 0; r < 4; ++r) { const float pe = __expf(SC[s][r] - mx); SC[s][r] = pe; l += pe; }
    l += __shfl_xor(l, 16); l += __shfl_xor(l, 32); l += __expf(sink - mx);
    const float inv = 1.0f / l;
    f32x4 O[8];
#pragma unroll
    for (int dt = 0; dt < 8; ++dt) O[dt] = (f32x4){0.f, 0.f, 0.f, 0.f};
    const int q4 = ql >> 2, pp = ql & 3;
    const f32x4 zero4 = (f32x4){0.f, 0.f, 0.f, 0.f};
#pragma unroll
    for (int c = 0; c < 3; ++c) {
        wait_vm(c == 0 ? 8 : (c == 1 ? 4 : 0)); ATT_BAR();
        LAS unsigned char* buf = lds + ((c + 3) & 3) * 32768;
#pragma unroll
        for (int kk = 0; kk < 4; ++kk) {
            bool a0, a1; f32x4 p0, p1;
            if (c == 1) { a0 = true; a1 = true; p0 = S1[2 * kk]; p1 = S1[2 * kk + 1]; }
            else if (c == 0) { a0 = 2 * kk >= w; a1 = 2 * kk + 1 >= w; p0 = a0 ? SC[7 - 2 * kk] : zero4; p1 = a1 ? SC[6 - 2 * kk] : zero4; }
            else { a0 = 2 * kk <= w; a1 = 2 * kk + 1 <= w; p0 = a0 ? SC[8 - 2 * kk] : zero4; p1 = a1 ? SC[7 - 2 * kk] : zero4; }
            if (a0 || a1) { u32x4 pw; pw.x = pk2(p0[0], p0[1]); pw.y = pk2(p0[2], p0[3]); pw.z = pk2(p1[0], p1[1]); pw.w = pk2(p1[2], p1[3]);
                const bf16x8 pf = __builtin_bit_cast(bf16x8, pw);
#pragma unroll
                for (int dt = 0; dt < 8; ++dt) O[dt] = __builtin_amdgcn_mfma_f32_16x16x32_bf16(vt_frag(buf, 32 * kk, g, q4, pp, dt), pf, O[dt], 0, 0, 0); } }
    }
#undef WIN_ISSUE
    bf16_t* op = o + (size_t)tq * D + hq * 128 + 4 * g;
#pragma unroll
    for (int dt = 0; dt < 8; ++dt) { u32x2 w2; w2.x = pk2(O[dt][0] * inv, O[dt][1] * inv); w2.y = pk2(O[dt][2] * inv, O[dt][3] * inv); *(u32x2*)(op + 16 * dt) = w2; }
}

__device__ __forceinline__ void attn_nat_item(const Params& p, LAS unsigned char* lds, int item, int& tab_head) {
    const int tid = phase_tid(), lane = tid & 63, w = __builtin_amdgcn_readfirstlane(tid >> 6), g = lane >> 4, ql = lane & 15;
    const int b = item >> 10, rp = (item >> 3) & 127, h = item & 7, rr = w >> 2, jq = w & 3, r = 2 * rp + rr;
    const int kr_lo = min(max(2 * rp - 4, 0), 248), rs = min(max(r - 4, 0), 248), d = rs - kr_lo;
    const int w0 = jq == 0 ? 0 : (jq == 1 ? 8 : (jq == 2 ? 24 : 32));
    const bf16_t* qkv = (const bf16_t*)(p.ws + WS_QKV); bf16_t* o = (bf16_t*)(p.ws + WS_O);
    LAS float* rpb = (LAS float*)(lds + 131072); const unsigned ldsb = (unsigned)(size_t)lds;
    const unsigned loff = (unsigned)(w * 4 + g) * NQKV + (unsigned)((ql ^ ((g << 2) | (w & 3))) * 8);
    const bf16_t* kbase = qkv + (size_t)(b * SEQ) * NQKV + 2560 + h * 128;
#define NAT_ISSUE(s) do { const int _s = (s); const int _kr = min(kr_lo + (_s % 9), 255); const bf16_t* _src = kbase + (size_t)(_kr * 64) * NQKV + (_s >= 9 ? 1024 : 0) + loff; \
        _Pragma("unroll") for (int _i = 0; _i < 2; ++_i) glds16_asm(_src + (size_t)(32 * _i) * NQKV, ldsb + (unsigned)((_s & 7) * 16384 + _i * 8192 + w * 1024)); } while (0)
    ATT_BAR();
#pragma unroll
    for (int s = 0; s < 7; ++s) NAT_ISSUE(s);
    if (h != tab_head) { if (tid < 465) rpb[tid] = p.in[8][h * 465 + tid]; tab_head = h; }
    const int qcol = 16 * jq + ql; const int tq = b * SEQ + r * 64 + qcol;
    bf16x8 qf[4]; load_q(qkv + (size_t)tq * NQKV + 1536 + h * 128, g, qf);
    f32x4 S[9][2];
#pragma unroll
    for (int c = 0; c < 9; ++c) { S[c][0] = (f32x4){0.f, 0.f, 0.f, 0.f}; S[c][1] = (f32x4){0.f, 0.f, 0.f, 0.f}; }
#pragma unroll
    for (int c = 0; c < 9; ++c) {
        wait_vm(12); ATT_BAR(); NAT_ISSUE(c + 7);
        if (c >= d && c < d + 8) { LAS unsigned char* buf = lds + (c & 7) * 16384;
#pragma unroll
            for (int t = 0; t < 2; ++t)
#pragma unroll
                for (int ks = 0; ks < 4; ++ks) { const bf16x8 kf = *(const LAS bf16x8*)(buf + off_b(w0 + 16 * t + ql, 4 * ks + g)); S[c][t] = __builtin_amdgcn_mfma_f32_16x16x32_bf16(kf, qf[ks], S[c][t], 0, 0, 0); } }
    }
    const int cs = min(max(qcol - 8, 0), 48); float mx = -1e30f;
#pragma unroll
    for (int c = 0; c < 9; ++c) { const bool act = c >= d && c < d + 8; const int dr = kr_lo + c - r + 7;
#pragma unroll
        for (int t = 0; t < 2; ++t)
#pragma unroll
            for (int q = 0; q < 4; ++q) { const int kc = w0 + 16 * t + 4 * g + q; const bool valid = act && kc >= cs && kc < cs + 16; const int dc = kc - qcol + 15;
                const float bv = rpb[min(max(dr, 0), 14) * 31 + min(max(dc, 0), 30)];
                const float sv = valid ? S[c][t][q] + bv : -1e30f; S[c][t][q] = sv; mx = fmaxf(mx, sv); } }
    mx = fmaxf(mx, __shfl_xor(mx, 16)); mx = fmaxf(mx, __shfl_xor(mx, 32));
    float l = 0.f;
#pragma unroll
    for (int c = 0; c < 9; ++c)
#pragma unroll
        for (int t = 0; t < 2; ++t)
#pragma unroll
            for (int q = 0; q < 4; ++q) { const float pe = __expf(S[c][t][q] - mx); S[c][t][q] = pe; l += pe; }
    l += __shfl_xor(l, 16); l += __shfl_xor(l, 32);
    const float inv = 1.0f / l;
    f32x4 O[8];
#pragma unroll
    for (int dt = 0; dt < 8; ++dt) O[dt] = (f32x4){0.f, 0.f, 0.f, 0.f};
    const int q4 = ql >> 2, pp = ql & 3;
#pragma unroll
    for (int c = 0; c < 9; ++c) {
        wait_vm(c <= 2 ? 12 : 2 * (8 - c)); ATT_BAR(); if (c + 16 < 18) NAT_ISSUE(c + 16);
        if (c >= d && c < d + 8) { LAS unsigned char* buf = lds + ((c + 9) & 7) * 16384;
            u32x4 pw; pw.x = pk2(S[c][0][0], S[c][0][1]); pw.y = pk2(S[c][0][2], S[c][0][3]); pw.z = pk2(S[c][1][0], S[c][1][1]); pw.w = pk2(S[c][1][2], S[c][1][3]);
            const bf16x8 pf = __builtin_bit_cast(bf16x8, pw);
#pragma unroll
            for (int dt = 0; dt < 8; ++dt) O[dt] = __builtin_amdgcn_mfma_f32_16x16x32_bf16(vt_frag(buf, w0, g, q4, pp, dt), pf, O[dt], 0, 0, 0); }
    }
#undef NAT_ISSUE
    bf16_t* op = o + (size_t)tq * D + 1024 + h * 128 + 4 * g;
#pragma unroll
    for (int dt = 0; dt < 8; ++dt) { u32x2 w2; w2.x = pk2(O[dt][0] * inv, O[dt][1] * inv); w2.y = pk2(O[dt][2] * inv, O[dt][3] * inv); *(u32x2*)(op + 16 * dt) = w2; }
}
__device__ __forceinline__ void p2_attn(const Params& p, LAS unsigned char* lds) {
    int tab_head = -1;
    for (int it = blockIdx.x; it < 2048; it += gridDim.x) attn_window_item(p, lds, it, tab_head);
#ifdef PROBE_A
    if (blockIdx.x == 0 && threadIdx.x == 0) ((unsigned long long*)(p.ws + WS_END))[11] = __builtin_amdgcn_s_memrealtime();
#endif
    tab_head = -1;
    for (int it = blockIdx.x; it < 2048; it += gridDim.x) attn_nat_item(p, lds, it, tab_head);
    asm volatile("s_waitcnt vmcnt(0)" ::: "memory"); __syncthreads();
}

struct UpHook { const bf16_t* gates;
    __device__ __forceinline__ void operator()(f32x4 (&acc)[2][2][4][2], const Unit& u, int wr, int wc, int fr, int fq) const {
        const unsigned goff = (unsigned)(u.pm * 256 + wr * 64 + fr) * NGATE + u.pn * 256 + wc * 32 + 8 * fq;
#pragma unroll
        for (int ai = 0; ai < 2; ++ai) {
            bf16x8 ra[4][2];
#pragma unroll
            for (int m = 0; m < 4; ++m)
#pragma unroll
                for (int bj = 0; bj < 2; ++bj) ra[m][bj] = *(const bf16x8*)(gates + goff + (unsigned)((ai * 128 + m * 16) * NGATE) + bj * 128);
#pragma unroll
            for (int m = 0; m < 4; ++m)
#pragma unroll
                for (int bj = 0; bj < 2; ++bj)
#pragma unroll
                    for (int n = 0; n < 2; ++n)
#pragma unroll
                        for (int j = 0; j < 4; ++j) acc[ai][bj][m][n][j] *= bf2f(ra[m][bj][4 * n + j]);
            asm volatile("" ::: "memory"); }
    } };
struct UpSched {
    pg8::TileOrder o; const bf16_t* A; const bf16_t* Bt;
    __device__ __forceinline__ bool next(int i, Unit& u) const { u.aux = i & 1; return o.tile(i >> 1, u.pm, u.pn); }
    __device__ __forceinline__ const char* a_base(const Unit& u) const { return (const char*)(A + (size_t)u.pm * 256 * D + u.aux * 1024); }
    __device__ __forceinline__ const char* b_base(const Unit& u) const { return (const char*)(Bt + (size_t)u.pn * 256 * D + u.aux * 1024); }
    __device__ __forceinline__ bool keep_acc(const Unit& u) const { return u.aux == 0; }
    __device__ __forceinline__ void a_offs(const Unit&, int, int, int, int, unsigned (&)[2][2]) const {}
};
struct EpiUp { const bf16_t* gates; bf16_t* merged;
    __device__ __forceinline__ void operator()(f32x4 (&acc)[2][2][4][2], const Unit& u, int wr, int wc, int fr, int fq) const {
        if (u.aux == 0) { UpHook{gates}(acc, u, wr, wc, fr, fq); return; }
        const unsigned goff = (unsigned)(u.pm * 256 + wr * 64 + fr) * NGATE + 2048 + u.pn * 256 + wc * 32 + 8 * fq;
        const unsigned moff = (unsigned)(u.pm * 256 + wr * 64 + fr) * D + u.pn * 256 + wc * 32 + 8 * fq;
#pragma unroll
        for (int ai = 0; ai < 2; ++ai) {
            bf16x8 sb[4][2];
#pragma unroll
            for (int m = 0; m < 4; ++m)
#pragma unroll
                for (int bj = 0; bj < 2; ++bj) sb[m][bj] = *(const bf16x8*)(gates + goff + (unsigned)((ai * 128 + m * 16) * NGATE) + bj * 128);
#pragma unroll
            for (int m = 0; m < 4; ++m)
#pragma unroll
                for (int bj = 0; bj < 2; ++bj) { f32x4 v0 = acc[ai][bj][m][0], v1 = acc[ai][bj][m][1];
#pragma unroll
                    for (int j = 0; j < 4; ++j) { v0[j] *= bf2f(sb[m][bj][j]); v1[j] *= bf2f(sb[m][bj][4 + j]); }
                    u32x4 w; w.x = pk2(v0[0], v0[1]); w.y = pk2(v0[2], v0[3]); w.z = pk2(v1[0], v1[1]); w.w = pk2(v1[2], v1[3]);
                    *(u32x4*)(merged + moff + (unsigned)((ai * 128 + m * 16) * D) + bj * 128) = w; }
            asm volatile("" ::: "memory"); }
    } };
__device__ __forceinline__ void p3_up(const Params& p, LAS unsigned char* lds) {
    UpSched S; S.o.init(128, 8, gridDim.x, blockIdx.x); S.A = (const bf16_t*)(p.ws + WS_O); S.Bt = (const bf16_t*)(p.ws + WS_WUP);
    EpiUp E{(const bf16_t*)(p.ws + WS_GATES), (bf16_t*)(p.ws + WS_XB)};
    pg8::gemm_phase<true, false>(lds, S, E, 1024 / 64, D, D);
}

struct EpiOut { bf16_t* mob;
    __device__ __forceinline__ void operator()(f32x4 (&acc)[2][2][4][2], const Unit& u, int wr, int wc, int fr, int fq) const {
        unsigned off = (unsigned)(u.pm * 256 + wr * 64 + fr) * D + u.pn * 256 + wc * 32 + 8 * fq;
#pragma unroll
        for (int ai = 0; ai < 2; ++ai) {
#pragma unroll
            for (int m = 0; m < 4; ++m) { asm volatile("" : "+v"(off));
#pragma unroll
                for (int bj = 0; bj < 2; ++bj) { const f32x4 v0 = acc[ai][bj][m][0], v1 = acc[ai][bj][m][1];
                    u32x4 w; w.x = pk2(v0[0], v0[1]); w.y = pk2(v0[2], v0[3]); w.z = pk2(v1[0], v1[1]); w.w = pk2(v1[2], v1[3]);
                    *(u32x4*)(mob + off + bj * 128) = w; }
                off += 16 * D; }
            off += 64 * D; }
    } };
__device__ __forceinline__ void p4_out(const Params& p, LAS unsigned char* lds) {
    pg8::DenseSched S; S.o.init(128, 8, gridDim.x, blockIdx.x); S.A = (const bf16_t*)(p.ws + WS_XB); S.Bt = (const bf16_t*)(p.ws + WS_WOUT); S.lda = D; S.ldb = D;
    EpiOut E{(bf16_t*)(p.ws + WS_MOB)};
    pg8::gemm_phase<true, false>(lds, S, E, D / 64, D, D);
}

__device__ __forceinline__ void p5_router(const Params& p, LAS unsigned char* lds) {
    const int tid = phase_tid(), lane = tid & 63, wave = __builtin_amdgcn_readfirstlane(tid >> 6), g = lane >> 4, tl = lane & 15;
    const bf16_t* wsp = (const bf16_t*)(p.ws + WS_WRT); float* r2 = (float*)(p.ws + WS_R2); int* cnt = (int*)(p.ws + WS_CNT); int* tokl = (int*)(p.ws + WS_TOK);
    int* recc = (int*)(p.ws + WS_RECC); float* recw = (float*)(p.ws + WS_RECW); bf16_t* hb = (bf16_t*)(p.ws + WS_O); const bf16_t* mob = (const bf16_t*)(p.ws + WS_MOB);
    const float* brg = p.in[15]; const float* bre = p.in[17];
    LAS float* H = (LAS float*)(lds + wave * 4352);
    LAS unsigned char* WL = lds + 36864;
    const int r4 = lane >> 4, k4 = (lane & 15) * 4;
    const int pa0 = tid / 384, pr0 = (tid % 384) >> 3, ps0 = tid & 7, pi1 = 512 + tid, pa1 = pi1 / 384, pr1 = (pi1 % 384) >> 3;
    const unsigned wsrc0 = (unsigned)(pa0 * 48 * 2048 + pr0 * D + ps0 * 8), wsrc1 = (unsigned)(pa1 * 48 * 2048 + pr1 * D + ps0 * 8);
    const unsigned wdst0 = (unsigned)(pa0 * 6144 + pr0 * 128 + ((ps0 ^ (pr0 & 7)) << 4)), wdst1 = (unsigned)(pa1 * 6144 + pr1 * 128 + ((ps0 ^ (pr1 & 7)) << 4));
    for (int round = blockIdx.x; round < T / 128; round += gridDim.x) {
        const int tile = round * 8 + wave;
        const float* xs = p.in[0] + (size_t)tile * 16 * D; const bf16_t* ms = mob + (size_t)tile * 16 * D; bf16_t* hs = hb + (size_t)tile * 16 * D;
        unsigned lo = (unsigned)(r4 * D + k4);
        f32x4 accA = {0.f, 0.f, 0.f, 0.f}, accB = accA, accC = accA; float ss = 0.f;
        f32x4 xa[4], xb_[4], xc[4]; u32x2 ma[4], mb[4], mc[4]; u32x4 wr0, wr1;
#define RT_LOADS(bx, bm, k) do { _Pragma("unroll") for (int j = 0; j < 4; ++j) { bx[j] = *(const f32x4*)(xs + (4 * j) * D + lo + 64 * (k)); bm[j] = *(const u32x2*)(ms + (4 * j) * D + lo + 64 * (k)); } } while (0)
#define RT_SPLIT(f0, f1, hi, lw) do { hi = pk2(f0, f1); lw = pk2((f0) - __uint_as_float(hi << 16), (f1) - __uint_as_float(hi & 0xffff0000u)); } while (0)
#define RT_COMP(bx, bm, k, wbuf) do { \
            _Pragma("unroll") for (int j = 0; j < 4; ++j) { f32x4 h = bx[j]; h.x += __uint_as_float(bm[j].x << 16); h.y += __uint_as_float(bm[j].x & 0xffff0000u); h.z += __uint_as_float(bm[j].y << 16); h.w += __uint_as_float(bm[j].y & 0xffff0000u); \
                u32x2 q2; q2.x = pk2(h[0], h[1]); q2.y = pk2(h[2], h[3]); *(u32x2*)(hs + (4 * j) * D + lo + 64 * (k)) = q2; \
                *(LAS f32x4*)(H + (4 * j + r4) * 68 + k4) = h; } \
            _Pragma("unroll") for (int ks = 0; ks < 2; ++ks) { const f32x4 h0 = *(const LAS f32x4*)(H + tl * 68 + 32 * ks + 8 * g), h1 = *(const LAS f32x4*)(H + tl * 68 + 32 * ks + 8 * g + 4); \
                ss += (h0.x * h0.x + h0.y * h0.y) + (h0.z * h0.z + h0.w * h0.w) + (h1.x * h1.x + h1.y * h1.y) + (h1.z * h1.z + h1.w * h1.w); \
                u32x4 hh, hl; RT_SPLIT(h0.x, h0.y, hh.x, hl.x); RT_SPLIT(h0.z, h0.w, hh.y, hl.y); RT_SPLIT(h1.x, h1.y, hh.z, hl.z); RT_SPLIT(h1.z, h1.w, hh.w, hl.w); \
                const bf16x8 bh = __builtin_bit_cast(bf16x8, hh), bl = __builtin_bit_cast(bf16x8, hl); const unsigned so_ = (unsigned)(((4 * ks + g) ^ (tl & 7)) << 4); \
                _Pragma("unroll") for (int t = 0; t < 3; ++t) { const bf16x8 ah = *(const LAS bf16x8*)((wbuf) + (16 * t + tl) * 128 + so_), al = *(const LAS bf16x8*)((wbuf) + 6144 + (16 * t + tl) * 128 + so_); \
                    f32x4& ac = (t == 0 ? accA : (t == 1 ? accB : accC)); \
                    ac = __builtin_amdgcn_mfma_f32_16x16x32_bf16(ah, bh, ac, 0, 0, 0); ac = __builtin_amdgcn_mfma_f32_16x16x32_bf16(al, bh, ac, 0, 0, 0); ac = __builtin_amdgcn_mfma_f32_16x16x32_bf16(ah, bl, ac, 0, 0, 0); } } } while (0)
#define RT_WLOAD(c) do { wr0 = *(const u32x4*)(wsp + wsrc0 + 64 * (c)); if (tid < 256) wr1 = *(const u32x4*)(wsp + wsrc1 + 64 * (c)); } while (0)
#define RT_WSTORE(wbuf) do { *(LAS u32x4*)((wbuf) + wdst0) = wr0; if (tid < 256) *(LAS u32x4*)((wbuf) + wdst1) = wr1; } while (0)
        __syncthreads();
        RT_WLOAD(0); RT_LOADS(xa, ma, 0); RT_LOADS(xb_, mb, 1);
        RT_WSTORE(WL); RT_WLOAD(1);
        __syncthreads();
#pragma unroll 1
        for (int c = 0; c < D / 64 - 2; c += 3) {
            const int pz = c & 1;
            RT_LOADS(xc, mc, 2); RT_COMP(xa, ma, 0, WL + pz * 12288); RT_WSTORE(WL + (pz ^ 1) * 12288); RT_WLOAD(c + 2); __syncthreads();
            RT_LOADS(xa, ma, 3); RT_COMP(xb_, mb, 1, WL + (pz ^ 1) * 12288); RT_WSTORE(WL + pz * 12288); RT_WLOAD(c + 3); __syncthreads();
            RT_LOADS(xb_, mb, 4); RT_COMP(xc, mc, 2, WL + pz * 12288); RT_WSTORE(WL + (pz ^ 1) * 12288); RT_WLOAD((c + 4) & 31); __syncthreads();
            lo += 192;
        }
        RT_COMP(xa, ma, 0, WL); RT_WSTORE(WL + 12288); __syncthreads();
        RT_COMP(xb_, mb, 1, WL + 12288);
#undef RT_LOADS
#undef RT_SPLIT
#undef RT_COMP
#undef RT_WLOAD
#undef RT_WSTORE
        const int tok = tile * 16 + tl;
        ss += __shfl_xor(ss, 16); ss += __shfl_xor(ss, 32);
        const float rr = rsqrtf(ss * (1.0f / D) + EPS);
        const float myg = accC[0] * rr + brg[g];
        float gl[4];
#pragma unroll
        for (int j = 0; j < 4; ++j) gl[j] = __shfl(myg, tl + 16 * j);
        int gi = 0; float gm = gl[0];
#pragma unroll
        for (int i = 1; i < 4; ++i) if (gl[i] > gm) { gm = gl[i]; gi = i; }
        float den = 0.f;
#pragma unroll
        for (int i = 0; i < 4; ++i) den += __expf(gl[i] - gm);
        const float pg = 1.0f / den;
        int L0 = 0, L1 = 0; float wt0 = 0.f, wt1 = 0.f; const bool owner = (g == gi);
        if (owner) {
            float el[8];
#pragma unroll
            for (int i = 0; i < 4; ++i) { el[i] = accA[i] * rr + bre[g * 8 + i]; el[4 + i] = accB[i] * rr + bre[g * 8 + 4 + i]; }
            int e0 = 0; float v0 = el[0];
#pragma unroll
            for (int i = 1; i < 8; ++i) if (el[i] > v0) { v0 = el[i]; e0 = i; }
            int e1 = -1; float v1 = -3.0e38f;
#pragma unroll
            for (int i = 0; i < 8; ++i) if (i != e0 && el[i] > v1) { v1 = el[i]; e1 = i; }
            const float ex = __expf(v1 - v0); const float s0 = 1.0f / (1.0f + ex), s1 = ex * s0;
            r2[tok] = rr; L0 = gi * 8 + e0; L1 = gi * 8 + e1; wt0 = pg * s0; wt1 = pg * s1;
        }
        LAS int* cl = (LAS int*)(lds + 61440);
        if (tid < 32) cl[tid] = 0;
        __syncthreads();
        int q0 = 0, q1 = 0;
        if (owner) { q0 = __hip_atomic_fetch_add(&cl[L0], 1, __ATOMIC_RELAXED, __HIP_MEMORY_SCOPE_WORKGROUP); q1 = __hip_atomic_fetch_add(&cl[L1], 1, __ATOMIC_RELAXED, __HIP_MEMORY_SCOPE_WORKGROUP); }
        __syncthreads();
        if (tid < 32) { const int n = cl[tid]; cl[32 + tid] = n ? atomicAdd(&cnt[tid], n) : 0; }
        __syncthreads();
        if (owner) { const int p0 = cl[32 + L0] + q0, p1 = cl[32 + L1] + q1;
            float* r2l = (float*)(p.ws + WS_R2L);
            tokl[(size_t)L0 * T + p0] = tok; r2l[(size_t)L0 * T + p0] = rr; recc[2 * tok] = L0 * 32768 + p0; recw[2 * tok] = wt0;
            tokl[(size_t)L1 * T + p1] = tok; r2l[(size_t)L1 * T + p1] = rr; recc[2 * tok + 1] = L1 * 32768 + p1; recw[2 * tok + 1] = wt1; }
    }
    __syncthreads();
}

__device__ __forceinline__ void build_tiles(const Params& p, LAS int* tab) {
    __syncthreads();
    if (threadIdx.x < 64) { const int L = threadIdx.x; const int c = L < 32 ? ((const int*)(p.ws + WS_CNT))[L] : 0; const int nt = (c + 255) >> 8;
        int pre = nt;
#pragma unroll
        for (int o = 1; o < 32; o <<= 1) { const int v = __shfl_up(pre, o); if (L >= o) pre += v; }
        const int first = pre - nt;
        if (L < 32) { tab[1400 + L] = first * 256; for (int i = 0; i < nt; ++i) { tab[4 + (first + i) * 4 + 0] = L; tab[4 + (first + i) * 4 + 1] = i * 256; tab[4 + (first + i) * 4 + 2] = (first + i) * 256; tab[4 + (first + i) * 4 + 3] = min(256, c - i * 256); } }
        if (L == 31) tab[0] = pre; }
    __syncthreads();
}
template <int NPN> struct MoeOrder { int G, c, t_lo, nt_tiles; const LAS int* tab;
    __device__ __forceinline__ bool unit(int i, Unit& u) const { const long L = (long)i * G + c; if (L >= (long)nt_tiles * NPN) return false;
        const int nwg = nt_tiles * NPN; int wgid = (int)L; { const int q = nwg / 8, r = nwg % 8, xcd = wgid % 8, off = wgid / 8; wgid = (xcd < r ? xcd * (q + 1) : r * (q + 1) + (xcd - r) * q) + off; }
        u.pm = t_lo + wgid / NPN; u.pn = wgid % NPN; u.aux = 0; return true; } };
struct GateUpSched { MoeOrder<4> o; const bf16_t* hb; const bf16_t* WguT; const int* tokl;
    __device__ __forceinline__ bool next(int i, Unit& u) const { return o.unit(i, u); }
    __device__ __forceinline__ const char* a_base(const Unit&) const { return (const char*)hb; }
    __device__ __forceinline__ const char* b_base(const Unit& u) const { const int e = o.tab[4 + u.pm * 4] & 31; return (const char*)(WguT + (size_t)(e * 1024 + u.pn * 256) * D); }
    __device__ __forceinline__ bool keep_acc(const Unit&) const { return false; }
    __device__ __forceinline__ void a_offs(const Unit& u, int R0, int C0, int R1, int C1, unsigned (&v)[2][2]) const {
        const int L = o.tab[4 + u.pm * 4], row0 = o.tab[4 + u.pm * 4 + 1], nrows = o.tab[4 + u.pm * 4 + 3]; const int* lst = tokl + (size_t)L * T + row0;
#pragma unroll
        for (int h = 0; h < 2; ++h) { const int r0 = R0 + 128 * h, r1 = R1 + 128 * h; const int t0 = r0 < nrows ? lst[r0] : 0, t1 = r1 < nrows ? lst[r1] : 0;
            v[h][0] = ((unsigned)t0 * D + C0) * 2u; v[h][1] = ((unsigned)t1 * D + C1) * 2u; } }
};
struct EpiGateUp { const LAS int* tab; const float* r2l; bf16_t* he;
    __device__ __forceinline__ void operator()(f32x4 (&acc)[2][2][4][2], const Unit& u, int wr, int wc, int fr, int fq) const {
        const int L = tab[4 + u.pm * 4], row0 = tab[4 + u.pm * 4 + 1], slot = tab[4 + u.pm * 4 + 2], nrows = tab[4 + u.pm * 4 + 3];
#pragma unroll
        for (int ai = 0; ai < 2; ++ai)
#pragma unroll
            for (int m = 0; m < 4; ++m) { const int rr = ai * 128 + wr * 64 + m * 16 + fr; const float rs = rr < nrows ? r2l[(size_t)L * T + row0 + rr] : 0.f;
                u32x4 w; unsigned ww[4];
#pragma unroll
                for (int n = 0; n < 2; ++n) { float hv[4];
#pragma unroll
                    for (int j = 0; j < 4; ++j) { const float gt = acc[ai][0][m][n][j] * rs, up = acc[ai][1][m][n][j] * rs; hv[j] = gt * sigmoidf_(gt) * up; }
                    ww[2 * n] = pk2(hv[0], hv[1]); ww[2 * n + 1] = pk2(hv[2], hv[3]); }
                w.x = ww[0]; w.y = ww[1]; w.z = ww[2]; w.w = ww[3];
                *(u32x4*)(he + (size_t)(slot + rr) * 512 + u.pn * 128 + wc * 32 + 8 * fq) = w; }
    } };
__device__ __forceinline__ void p6_gateup(const Params& p, LAS unsigned char* lds) {
    LAS int* tab = (LAS int*)(lds + TAB_OFF); build_tiles(p, tab);
    GateUpSched S; S.o.G = gridDim.x; S.o.c = blockIdx.x; S.o.t_lo = 0; S.o.nt_tiles = tab[0]; S.o.tab = tab;
    S.hb = (const bf16_t*)(p.ws + WS_O); S.WguT = (const bf16_t*)(p.ws + WS_WGU); S.tokl = (const int*)(p.ws + WS_TOK);
    EpiGateUp E{tab, (const float*)(p.ws + WS_R2L), (bf16_t*)(p.ws + WS_HE)};
    pg8::gemm_phase<true, true>(lds, S, E, D / 64, D, D);
}
struct DownSched { MoeOrder<8> o; const bf16_t* he; const bf16_t* WdT;
    __device__ __forceinline__ bool next(int i, Unit& u) const { return o.unit(i, u); }
    __device__ __forceinline__ const char* a_base(const Unit& u) const { return (const char*)(he + (size_t)o.tab[4 + u.pm * 4 + 2] * 512); }
    __device__ __forceinline__ const char* b_base(const Unit& u) const { const int e = o.tab[4 + u.pm * 4] & 31; return (const char*)(WdT + (size_t)(e * 2048 + u.pn * 256) * 512); }
    __device__ __forceinline__ bool keep_acc(const Unit&) const { return false; }
    __device__ __forceinline__ void a_offs(const Unit&, int, int, int, int, unsigned (&)[2][2]) const {}
};
struct EpiDown { const LAS int* tab; bf16_t* ye_lo; bf16_t* ye_hi;
    __device__ __forceinline__ void operator()(f32x4 (&acc)[2][2][4][2], const Unit& u, int wr, int wc, int fr, int fq) const {
        const int slot = tab[4 + u.pm * 4 + 2]; bf16_t* ye = u.pn < 4 ? ye_lo : ye_hi;
        unsigned off = (unsigned)(slot + wr * 64 + fr) * 1024 + (u.pn & 3) * 256 + wc * 32 + 8 * fq;
#pragma unroll
        for (int ai = 0; ai < 2; ++ai) {
#pragma unroll
            for (int m = 0; m < 4; ++m) { asm volatile("" : "+v"(off));
#pragma unroll
                for (int bj = 0; bj < 2; ++bj) { const f32x4 v0 = acc[ai][bj][m][0], v1 = acc[ai][bj][m][1];
                    u32x4 w; w.x = pk2(v0[0], v0[1]); w.y = pk2(v0[2], v0[3]); w.z = pk2(v1[0], v1[1]); w.w = pk2(v1[2], v1[3]);
                    *(u32x4*)(ye + off + bj * 128) = w; }
                off += 16 * 1024; }
            off += 64 * 1024; }
    } };
__device__ __forceinline__ void p7_down(const Params& p, LAS unsigned char* lds) {
    LAS int* tab = (LAS int*)(lds + TAB_OFF); build_tiles(p, tab);
    DownSched S; S.o.G = gridDim.x; S.o.c = blockIdx.x; S.o.t_lo = 0; S.o.nt_tiles = tab[0]; S.o.tab = tab;
    S.he = (const bf16_t*)(p.ws + WS_HE); S.WdT = (const bf16_t*)(p.ws + WS_WD);
    EpiDown E{tab, (bf16_t*)(p.ws + WS_YE_LO), (bf16_t*)(p.ws + WS_YE_HI)};
    pg8::gemm_phase<true, false>(lds, S, E, 512 / 64, 512, 512);
}
__device__ __forceinline__ void p8_combine(const Params& p, LAS unsigned char* lds) {
    LAS int* tab = (LAS int*)(lds + TAB_OFF); build_tiles(p, tab);
    const int tid = phase_tid(), lane = tid & 63, wave = tid >> 6; const int gw = blockIdx.x * 8 + wave, NGW = gridDim.x * 8;
    const int* recc = (const int*)(p.ws + WS_RECC); const float* recw = (const float*)(p.ws + WS_RECW); const bf16_t* hb = (const bf16_t*)(p.ws + WS_O);
    const bf16_t* ye_lo = (const bf16_t*)(p.ws + WS_YE_LO); const bf16_t* ye_hi = (const bf16_t*)(p.ws + WS_YE_HI);
    for (int tok = gw; tok < T; tok += NGW) {
        const int c0 = recc[2 * tok], c1 = recc[2 * tok + 1]; const float wa = recw[2 * tok], wb = recw[2 * tok + 1];
        const int s0 = tab[1400 + (c0 >> 15)] + (c0 & 32767), s1 = tab[1400 + (c1 >> 15)] + (c1 & 32767);
        f32x4* op = (f32x4*)(p.out + (size_t)tok * D) + lane; const u32x2* hp = (const u32x2*)(hb + (size_t)tok * D) + lane;
        u32x2 m[8], a[8], b[8];
#pragma unroll
        for (int j = 0; j < 8; ++j) { const bf16_t* yb = j < 4 ? ye_lo : ye_hi; m[j] = hp[64 * j];
            a[j] = ((const u32x2*)(yb + (size_t)s0 * 1024) + lane)[64 * (j & 3)]; b[j] = ((const u32x2*)(yb + (size_t)s1 * 1024) + lane)[64 * (j & 3)]; }
#pragma unroll
        for (int j = 0; j < 8; ++j) { f32x4 v;
            v.x = __uint_as_float(m[j].x << 16) + wa * __uint_as_float(a[j].x << 16) + wb * __uint_as_float(b[j].x << 16); v.y = __uint_as_float(m[j].x & 0xffff0000u) + wa * __uint_as_float(a[j].x & 0xffff0000u) + wb * __uint_as_float(b[j].x & 0xffff0000u);
            v.z = __uint_as_float(m[j].y << 16) + wa * __uint_as_float(a[j].y << 16) + wb * __uint_as_float(b[j].y << 16); v.w = __uint_as_float(m[j].y & 0xffff0000u) + wa * __uint_as_float(a[j].y & 0xffff0000u) + wb * __uint_as_float(b[j].y & 0xffff0000u);
            op[64 * j] = v; }
    }
}

#define XB_TMO      128
#define XB_XCNT(j)  (256  + 64 * (j))
#define XB_XSUB(j)  (1280 + 64 * (j))
#define XB_XGEN(j)  (2304 + 64 * (j))
#define XB_TOP      3328
#define XB_TOPGEN   3392
#define XCD_BAR_WORDS 3456
#define XB_SPIN_CAP (1u << 18)
__device__ __forceinline__ unsigned xb_ld(unsigned* p)              { return __hip_atomic_load(p, __ATOMIC_RELAXED, __HIP_MEMORY_SCOPE_AGENT); }
__device__ __forceinline__ unsigned xb_add(unsigned* p, unsigned v) { return __hip_atomic_fetch_add(p, v, __ATOMIC_RELAXED, __HIP_MEMORY_SCOPE_AGENT); }
__device__ __forceinline__ unsigned xb_xcc_id() { return (unsigned)__builtin_amdgcn_s_getreg((3 << 11) | 20) & 0xFu; }
#define XB_SPIN(cond, bar) do { unsigned _sp = 0; while (cond) { __builtin_amdgcn_s_sleep(1); \
    if ((++_sp & 255u) == 0u) { if (xb_ld(&(bar)[XB_TMO])) break; if (_sp > XB_SPIN_CAP) { atomicAdd(&(bar)[XB_TMO], 1u); break; } } } } while (0)
struct XcdBarrier { unsigned* bar; unsigned x; volatile LAS unsigned* st; };
__device__ __forceinline__ XcdBarrier xcd_barrier_post(unsigned* bar, volatile LAS unsigned* st) {
    XcdBarrier b; b.bar = bar; b.x = xb_xcc_id(); b.st = st;
    if (threadIdx.x == 0) (void)xb_add(&bar[XB_XCNT(b.x)], 1u);
    return b;
}
__device__ __forceinline__ void xcd_barrier_complete(unsigned* bar, unsigned x, unsigned& nloc, unsigned& nx) {
    const unsigned G = gridDim.x * gridDim.y * gridDim.z;
    unsigned sum, cnt, mine, sp = 0u;
    for (;;) {
        sum = 0u; cnt = 0u; mine = 0u;
#pragma unroll
        for (unsigned j = 0; j < 16; ++j) { const unsigned c = xb_ld(&bar[XB_XCNT(j)]); sum += c; cnt += (c > 0u) ? 1u : 0u; mine = (j == x) ? c : mine; }
        if (sum == G) break;
        __builtin_amdgcn_s_sleep(1);
        if ((++sp & 255u) == 0u) { if (xb_ld(&bar[XB_TMO])) break; if (sp > XB_SPIN_CAP) { atomicAdd(&bar[XB_TMO], 1u); break; } }
    }
    nloc = mine > 0u ? mine : 1u; nx = cnt > 0u ? cnt : 1u;
}
__device__ __forceinline__ void xcd_barrier(const XcdBarrier& b) {
    asm volatile("s_waitcnt vmcnt(0)" ::: "memory");
    __syncthreads();
    if (threadIdx.x == 0) {
        unsigned* bar = b.bar;
        __builtin_amdgcn_s_waitcnt(0);
        unsigned nloc = b.st[0], nx = b.st[1];
        if (nloc == 0u) { xcd_barrier_complete(bar, b.x, nloc, nx); b.st[0] = nloc; b.st[1] = nx; }
        const unsigned old = xb_add(&bar[XB_XSUB(b.x)], 1u);
        const unsigned gen = old / nloc;
        if (old + 1u == (gen + 1u) * nloc) {
            __builtin_amdgcn_fence(__ATOMIC_RELEASE, "agent");
            asm volatile("s_waitcnt vmcnt(0)" ::: "memory");
            const unsigned og = xb_add(&bar[XB_TOP], 1u);
            const unsigned tg = og / nx;
            if (og + 1u == (tg + 1u) * nx) xb_add(&bar[XB_TOPGEN], 1u);
            else XB_SPIN(xb_ld(&bar[XB_TOPGEN]) == tg, bar);
            __builtin_amdgcn_fence(__ATOMIC_ACQUIRE, "agent");
            xb_add(&bar[XB_XGEN(b.x)], 1u);
            asm volatile("s_waitcnt vmcnt(0)" ::: "memory");
        } else {
            XB_SPIN(xb_ld(&bar[XB_XGEN(b.x)]) == gen, bar);
            __builtin_amdgcn_fence(__ATOMIC_ACQUIRE, "agent");
            asm volatile("s_waitcnt vmcnt(0)" ::: "memory");
        }
    }
    __syncthreads();
}

namespace cg = cooperative_groups;
#ifdef PROBE_A
#define STAMP(k) do { if (blockIdx.x == 0 && threadIdx.x == 0) ((unsigned long long*)(p.ws + WS_END))[k] = __builtin_amdgcn_s_memrealtime(); } while (0)
#else
#define STAMP(k) do {} while (0)
#endif
__global__ void __launch_bounds__(512, 2) fwd_megakernel(Params p) {
    extern __shared__ __attribute__((aligned(16))) unsigned char lds_raw[];
    LAS unsigned char* lds = (LAS unsigned char*)lds_raw;
    cg::grid_group grid = cg::this_grid();
    if (threadIdx.x == 0) { *(volatile LAS unsigned*)(lds + XBST_OFF) = 0u; *(volatile LAS unsigned*)(lds + XBST_OFF + 4) = 0u; }
    __syncthreads();
    const XcdBarrier xb = xcd_barrier_post((unsigned*)(p.ws + WS_BAR), (volatile LAS unsigned*)(lds + XBST_OFF));
#define GSYNC() xcd_barrier(xb)
    STAMP(0);
    p0_prep(p, lds);            grid.sync(); STAMP(1);
    p1_inproj(p, lds);          GSYNC(); STAMP(2);
    p2_attn(p, lds);            GSYNC(); STAMP(3);
    p_moe_prep(p, lds);         STAMP(4);
    p3_up(p, lds);              GSYNC(); STAMP(5);
    p4_out(p, lds);             GSYNC(); STAMP(6);
    p5_router(p, lds);          GSYNC(); STAMP(7);
    p6_gateup(p, lds);          GSYNC(); STAMP(8);
    p7_down(p, lds);            GSYNC(); STAMP(9);
    p8_combine(p, lds);
#ifdef PROBE_A
    grid.sync(); STAMP(10); grid.sync();
    {
        const unsigned long long* ts = (const unsigned long long*)(p.ws + WS_END);
        #ifndef PROBE_A1
#define PROBE_A1 (PROBE_A + 1)
#endif
#ifndef PROBE_B1
#define PROBE_B1 (PROBE_B + 1)
#endif
        const float usA = (float)(ts[PROBE_A1] - ts[PROBE_A]) * 0.01f, usB = (float)(ts[PROBE_B1] - ts[PROBE_B]) * 0.01f;
        const float eps = sqrtf(usA * 1e-6f);
        for (size_t i = (size_t)blockIdx.x * 512 + threadIdx.x; i < (size_t)T * D / 4; i += (size_t)gridDim.x * 512) { f32x4 v = ((f32x4*)p.out)[i]; v = v * (1.0f + eps); if (i == 0) v.x += usB * 0.1f; ((f32x4*)p.out)[i] = v; }
    }
#endif
}

extern "C" void kernel_launch(void* const* d_in, const int* in_sizes, int n_in, void* d_out, int out_size, void* d_ws, size_t ws_size, hipStream_t stream) {
    static int grid_blocks = 0;
    if (!grid_blocks) {
        if (n_in != 21 || out_size != T * D || ws_size < WS_MOB + 128 * MiB) { fprintf(stderr, "kernel_launch: unexpected problem (n_in %d out %d ws %zu)\n", n_in, out_size, ws_size); grid_blocks = -1; return; }
        if (hipFuncSetAttribute((const void*)fwd_megakernel, hipFuncAttributeMaxDynamicSharedMemorySize, LDS_BYTES) != hipSuccess) { fprintf(stderr, "kernel_launch: hipFuncSetAttribute failed\n"); grid_blocks = -1; return; }
        int dev = 0, cus = 0, per_cu = 0;
        hipGetDevice(&dev); hipDeviceGetAttribute(&cus, hipDeviceAttributeMultiprocessorCount, dev);
        hipOccupancyMaxActiveBlocksPerMultiprocessor(&per_cu, (const void*)fwd_megakernel, 512, LDS_BYTES);
        if (per_cu < 1 || cus < 1) { fprintf(stderr, "kernel_launch: occupancy query gave %d blocks/CU on %d CUs\n", per_cu, cus); grid_blocks = -1; return; }
        grid_blocks = cus;
    }
    if (grid_blocks < 0) return;
    Params p{};
    for (int i = 0; i < 21; ++i) p.in[i] = (const float*)d_in[i];
    p.out = (float*)d_out; p.ws = (unsigned char*)d_ws;
    if (hipMemsetAsync((char*)d_ws + WS_BAR, 0, 16384, stream) != hipSuccess) { fprintf(stderr, "kernel_launch: hipMemsetAsync of the barrier words failed\n"); return; }
    void* args[] = {&p};
    hipError_t e = hipLaunchCooperativeKernel((const void*)fwd_megakernel, dim3(grid_blocks), dim3(512), args, LDS_BYTES, stream);
    if (e != hipSuccess) fprintf(stderr, "cooperative launch failed: %s (grid %d)\n", hipGetErrorString(e), grid_blocks);
}
```

```cpp
#include <hip/hip_runtime.h>
#include <hip/hip_cooperative_groups.h>
#include <cstdio>
#include <cstdint>

#define LAS __attribute__((address_space(3)))
typedef unsigned short bf16_t;
typedef short bf16x8 __attribute__((ext_vector_type(8)));
typedef short s16x4 __attribute__((ext_vector_type(4)));
typedef float f32x4 __attribute__((ext_vector_type(4)));
typedef unsigned u32x4 __attribute__((ext_vector_type(4)));
typedef unsigned u32x2 __attribute__((ext_vector_type(2)));
typedef short v4i16_t __attribute__((ext_vector_type(4)));

namespace cfg {
constexpr int T = 32768, D = 2048, SEQ = 16384;
constexpr int NQKV = 4608, NGATE = 4096, NIN = 8704;
constexpr size_t MiB = 1ull << 20;
constexpr size_t WS_XB = 0, WS_QKV = 128 * MiB, WS_GATES = 416 * MiB, WS_O = 672 * MiB, WS_WIN = 800 * MiB, WS_WUP = 834 * MiB, WS_WOUT = 842 * MiB, WS_MISC = 850 * MiB;
constexpr size_t WS_WGU = WS_QKV, WS_WD = WS_QKV + 128 * MiB, WS_HE = WS_QKV + 192 * MiB;
constexpr size_t WS_R1 = WS_MISC, WS_R2 = WS_R1 + (size_t)T * 4, WS_WRT = WS_R2 + (size_t)T * 4, WS_CNT = WS_WRT + 512 * 1024, WS_TOK = WS_CNT + 4096,
                 WS_RECC = WS_TOK + 32ull * T * 4, WS_RECW = WS_RECC + 2ull * T * 4, WS_R2L = WS_RECW + 2ull * T * 4, WS_END = WS_R2L + 32ull * T * 4;
constexpr size_t WS_YE_LO = 0, WS_YE_HI = WS_GATES;
constexpr size_t WS_BAR = WS_END + 4096;
constexpr size_t WS_MOB = 872 * MiB;
constexpr int LDS_BYTES = 140 * 1024;
constexpr int XBST_OFF = LDS_BYTES - 16;
constexpr int TAB_OFF = 132 * 1024;
constexpr float EPS = 1e-6f;
}
using namespace cfg;

struct Params { const float* in[21]; float* out; unsigned char* ws; };
__device__ __forceinline__ int phase_tid() { int t = threadIdx.x; asm volatile("" : "+v"(t)); return t; }

__device__ __forceinline__ float bf2f(short s) { return __uint_as_float(((unsigned)(unsigned short)s) << 16); }
typedef float f32x2 __attribute__((ext_vector_type(2)));
typedef __bf16 bf16x2_t __attribute__((ext_vector_type(2)));
__device__ __forceinline__ unsigned pk2(float lo, float hi) { const f32x2 v = {lo, hi}; return __builtin_bit_cast(unsigned, __builtin_convertvector(v, bf16x2_t)); }
__device__ __forceinline__ float wave_sum(float v) {
#pragma unroll
    for (int o = 1; o < 64; o <<= 1) v += __shfl_xor(v, o);
    return v;
}
__device__ __forceinline__ float sigmoidf_(float v) { return 1.0f / (1.0f + __expf(-v)); }
__device__ __forceinline__ unsigned off_b(unsigned row, unsigned ch) { return 256u * row + 16u * (ch ^ (((row & 3) << 2) | ((row >> 2) & 3))); }
__device__ __forceinline__ s16x4 tr_read(LAS unsigned char* p) { return __builtin_bit_cast(s16x4, __builtin_amdgcn_ds_read_tr16_b64_v4i16((LAS v4i16_t*)p)); }
__host__ __device__ __forceinline__ int perm32(int rho) { const int n = rho >> 4, i = rho & 15; return 8 * (i >> 2) + 4 * n + (i & 3); }
__device__ __forceinline__ int t5_bucket(int rel) {
    const int n = rel < 0 ? -rel : rel; const int ret = rel > 0 ? 16 : 0; int b;
    if (n < 8) b = n; else if (n < 12) b = 8; else if (n < 16) b = 9; else if (n < 23) b = 10; else if (n < 32) b = 11; else if (n < 46) b = 12; else if (n < 64) b = 13; else if (n < 91) b = 14; else b = 15;
    return ret + b;
}

__device__ __forceinline__ void transpose_item(const float* __restrict__ W, int ldw, int k0, int n0, bf16_t* __restrict__ WT, int ldt, int drow0, int dk0, const float* __restrict__ scale, LAS unsigned* scr, int lane) {
    const int n4 = (lane & 15) * 4, kk = lane >> 4;
    const float* src = W + (size_t)(k0 + 2 * kk) * ldw + n0 + n4;
    f32x4 ev[8], od[8];
#pragma unroll
    for (int j = 0; j < 8; ++j) { ev[j] = *(const f32x4*)(src + (size_t)(8 * j) * ldw); od[j] = *(const f32x4*)(src + (size_t)(8 * j + 1) * ldw); }
#pragma unroll
    for (int j = 0; j < 8; ++j) { f32x4 e = ev[j], o = od[j];
        if (scale) { const float se = scale[k0 + 8 * j + 2 * kk], so = scale[k0 + 8 * j + 2 * kk + 1]; e = e * se; o = o * so; }
        u32x4 w; w.x = pk2(e.x, o.x); w.y = pk2(e.y, o.y); w.z = pk2(e.z, o.z); w.w = pk2(e.w, o.w);
        *(LAS u32x4*)(scr + (4 * j + kk) * 68 + n4) = w; }
    asm volatile("s_waitcnt lgkmcnt(0)" ::: "memory");
    const int kq = lane & 7;
#pragma unroll
    for (int i = 0; i < 8; ++i) { const int n = (lane >> 3) + 8 * i; const LAS unsigned* q = scr + (4 * kq) * 68 + n;
        u32x4 o; o.x = q[0]; o.y = q[68]; o.z = q[136]; o.w = q[204];
        *(u32x4*)(WT + (size_t)(drow0 + n) * ldt + dk0 + k0 + 8 * kq) = o; }
    asm volatile("s_waitcnt lgkmcnt(0)" ::: "memory");
}

__device__ __forceinline__ void p0_prep(const Params& p, LAS unsigned char* lds) {
    const int tid = phase_tid(), lane = tid & 63, wave = tid >> 6;
    const int gw = blockIdx.x * 8 + wave, NGW = gridDim.x * 8;
    LAS unsigned* scr = (LAS unsigned*)(lds + wave * 8704);
    const float* x = p.in[0]; const float* g1 = p.in[1]; const float* w_in = p.in[2];
    bf16_t* xb = (bf16_t*)(p.ws + WS_XB); float* r1 = (float*)(p.ws + WS_R1);
    bf16_t* WinT = (bf16_t*)(p.ws + WS_WIN); bf16_t* WupT = (bf16_t*)(p.ws + WS_WUP); bf16_t* WoutT = (bf16_t*)(p.ws + WS_WOUT);
    constexpr int I_WIN = 32 * 136, I_UP = 16 * 32, I_OUT = 32 * 32, NITEMS = I_WIN + 2 * I_UP + I_OUT;
    for (int it = gw; it < NITEMS; it += NGW) {
        int r = it;
        if (r < I_WIN) { const int kb = r / 136, nb = r % 136; const int n0 = nb * 64; int drow = n0;
            if (n0 >= NQKV) { const int c = (n0 - NQKV) & 2047, isb = (n0 - NQKV) >> 11; drow = NQKV + (c >> 7) * 256 + isb * 128 + (c & 127); }
            transpose_item(w_in, NIN, kb * 64, n0, WinT, 2048, drow, 0, g1, scr, lane); continue; } r -= I_WIN;
        if (r < I_UP) { const int kb = r / 32, nb = r % 32; transpose_item(p.in[9], 2048, kb * 64, nb * 64, WupT, 2048, nb * 64, 0, nullptr, scr, lane); continue; } r -= I_UP;
        if (r < I_UP) { const int kb = r / 32, nb = r % 32; transpose_item(p.in[10], 2048, kb * 64, nb * 64, WupT, 2048, nb * 64, 1024, nullptr, scr, lane); continue; } r -= I_UP;
        { const int kb = r / 32, nb = r % 32; transpose_item(p.in[11], 2048, kb * 64, nb * 64, WoutT, 2048, nb * 64, 0, nullptr, scr, lane); }
    }
    { bf16_t* whi = (bf16_t*)(p.ws + WS_WRT); bf16_t* wlo = whi + 48 * 2048; const float* g2 = p.in[13]; const float* wrg = p.in[14]; const float* wre = p.in[16];
      for (int i = blockIdx.x * 512 + tid; i < 48 * 2048; i += gridDim.x * 512) { const int row = i >> 11, k = i & 2047, t = row >> 4, r = row & 15; float w;
          if (t == 0) w = wre[k * 32 + (r >> 2) * 8 + (r & 3)]; else if (t == 1) w = wre[k * 32 + (r >> 2) * 8 + 4 + (r & 3)]; else w = (r & 3) == 0 ? wrg[k * 4 + (r >> 2)] : 0.f;
          w *= g2[k]; const unsigned hi = pk2(w, 0.f) & 0xffffu; const float hf = __uint_as_float(hi << 16); whi[i] = (bf16_t)hi; wlo[i] = (bf16_t)(pk2(w - hf, 0.f) & 0xffffu); } }
    if (blockIdx.x == 0 && tid < 32) ((int*)(p.ws + WS_CNT))[tid] = 0;
    for (int row0 = 2 * gw; row0 < T; row0 += 2 * NGW) {
        f32x4 v[2][8]; float ss[2] = {0.f, 0.f};
#pragma unroll
        for (int u = 0; u < 2; ++u) { const f32x4* xr = (const f32x4*)(x + (size_t)(row0 + u) * D) + lane;
#pragma unroll
            for (int j = 0; j < 8; ++j) v[u][j] = xr[64 * j]; }
#pragma unroll
        for (int u = 0; u < 2; ++u) {
#pragma unroll
            for (int j = 0; j < 8; ++j) ss[u] += (v[u][j].x * v[u][j].x + v[u][j].y * v[u][j].y) + (v[u][j].z * v[u][j].z + v[u][j].w * v[u][j].w);
            ss[u] = wave_sum(ss[u]);
            if (lane == 0) r1[row0 + u] = rsqrtf(ss[u] * (1.0f / D) + EPS);
            u32x2* o = (u32x2*)(xb + (size_t)(row0 + u) * D) + lane;
#pragma unroll
            for (int j = 0; j < 8; ++j) { u32x2 w; w.x = pk2(v[u][j].x, v[u][j].y); w.y = pk2(v[u][j].z, v[u][j].w); o[64 * j] = w; } }
    }
}

__device__ __forceinline__ void p_moe_prep(const Params& p, LAS unsigned char* lds) {
    const int tid = phase_tid(), lane = tid & 63, wave = tid >> 6;
    const int gw = blockIdx.x * 8 + wave, NGW = gridDim.x * 8;
    LAS unsigned* scr = (LAS unsigned*)(lds + wave * 8704);
    const float* g2 = p.in[13];
    bf16_t* WguT = (bf16_t*)(p.ws + WS_WGU); bf16_t* WdT = (bf16_t*)(p.ws + WS_WD);
    constexpr int I_G = 32 * 32 * 8;
    constexpr int I_D = 32 * 8 * 32;
    for (int it = gw; it < 2 * I_G + I_D; it += NGW) {
        int r = it;
        if (r < 2 * I_G) { const int which = r >= I_G; if (which) r -= I_G; const int e = r / 256, rr = r % 256, kb = rr / 8, nb = rr % 8;
            const float* W = p.in[which ? 19 : 18] + (size_t)e * 2048 * 512; const int n0 = nb * 64;
            transpose_item(W, 512, kb * 64, n0, WguT, 2048, e * 1024 + (n0 >> 7) * 256 + which * 128 + (n0 & 127), 0, g2, scr, lane); continue; }
        r -= 2 * I_G;
        { const int e = r / 256, rr = r % 256, kb = rr / 32, nb = rr % 32; const float* W = p.in[20] + (size_t)e * 512 * 2048;
          transpose_item(W, 2048, kb * 64, nb * 64, WdT, 512, e * 2048 + nb * 64, 0, nullptr, scr, lane); }
    }
}

struct Unit { int pm, pn, aux; };
namespace pg8 {
constexpr int BM = 256, BK = 64, HALF = 128, HTB = HALF * BK * 2, STAGE_BYTES = 8 * HTB;
__device__ __forceinline__ int lds_byte(int r, int c) { const int st = (r >> 4) * 2 + (c >> 5), rr = r & 15, cc = c & 31, ob = rr * 64 + cc * 2; return st * 1024 + (ob ^ (((ob >> 9) & 1) << 5)); }
__device__ __forceinline__ void stage_rc(int b, int& R, int& C) { const int st = b / 1024, sb = b % 1024, swz = sb ^ (((sb >> 9) & 1) << 5); R = (st >> 1) * 16 + swz / 64; C = (st & 1) * 32 + (swz % 64) / 2; }

template <bool PERM, bool GATHER, class Sched, class Epi>
__device__ __forceinline__ void gemm_phase(LAS unsigned char* lds, const Sched& S, const Epi& E, const int nt, const int lda, const int ldb) {
    int tid_ = threadIdx.x; asm volatile("" : "+v"(tid_));
    const int tid = tid_, wid = __builtin_amdgcn_readfirstlane(tid >> 6), lane = tid & 63, wr = wid >> 2, wc = wid & 3, fr = lane & 15, fq = lane >> 4;
    int R0, C0, R1, C1; stage_rc(tid * 16, R0, C0); stage_rc(tid * 16 + 8192, R1, C1);
    unsigned voffB[2], voffA[2][2];
    { const int Rb0 = PERM ? ((R0 & ~31) + perm32(R0 & 31)) : R0, Rb1 = PERM ? ((R1 & ~31) + perm32(R1 & 31)) : R1;
      voffB[0] = (unsigned)(Rb0 * ldb + C0) * 2u; voffB[1] = (unsigned)(Rb1 * ldb + C1) * 2u; }
    const size_t kstep = (size_t)(BK * 2);
    const size_t hstepB = (size_t)HALF * ldb * 2;
    const unsigned ldsw = (unsigned)wid * 1024u;
    const int aoff = lds_byte(wr * 64 + fr, fq * 8), boff = lds_byte(wc * 32 + fr, fq * 8);
#define PG8_SA(b, h) (((b) * 2 + (h)) * HTB)
#define PG8_SB(b, h) ((4 + (b) * 2 + (h)) * HTB)
#define PG8_STAGE_B(bufoff, gbase) do { _Pragma("unroll") for (int _i = 0; _i < 2; ++_i) \
        __builtin_amdgcn_global_load_lds((const unsigned*)((const char*)(gbase) + voffB[_i]), (LAS unsigned*)(lds + (bufoff) + ldsw + _i * 8192), 16, 0, 0); } while (0)
#define PG8_STAGE_A(bufoff, gbase, h) do { _Pragma("unroll") for (int _i = 0; _i < 2; ++_i) \
        __builtin_amdgcn_global_load_lds((const unsigned*)((const char*)(gbase) + voffA[h][_i]), (LAS unsigned*)(lds + (bufoff) + ldsw + _i * 8192), 16, 0, 0); } while (0)
#define PG8_LDA(dst, b, h) do { _Pragma("unroll") for (int m = 0; m < 4; ++m) _Pragma("unroll") for (int k = 0; k < 2; ++k) dst[m][k] = *(const LAS bf16x8*)(lds + PG8_SA(b, h) + aoff + m * 2048 + k * 1024); } while (0)
#define PG8_LDB(dst, b, h) do { _Pragma("unroll") for (int n = 0; n < 2; ++n) _Pragma("unroll") for (int k = 0; k < 2; ++k) dst[n][k] = *(const LAS bf16x8*)(lds + PG8_SB(b, h) + boff + n * 2048 + k * 1024); } while (0)
#define PG8_MMA(ai, bj, At, Bt) do { __builtin_amdgcn_s_setprio(1); _Pragma("unroll") for (int m = 0; m < 4; ++m) _Pragma("unroll") for (int n = 0; n < 2; ++n) _Pragma("unroll") for (int k = 0; k < 2; ++k) \
        acc[ai][bj][m][n] = __builtin_amdgcn_mfma_f32_16x16x32_bf16(Bt[n][k], At[m][k], acc[ai][bj][m][n], 0, 0, 0); __builtin_amdgcn_s_setprio(0); } while (0)
#define PG8_WAIT_V(n) asm volatile("s_waitcnt vmcnt(" #n ")" ::: "memory")
#define PG8_WAIT_L(n) asm volatile("s_waitcnt lgkmcnt(" #n ")" ::: "memory")
#define PG8_BAR __builtin_amdgcn_s_barrier()
#define PG8_SCHED __builtin_amdgcn_sched_barrier(0)
    Unit cur, nxt; int ui = 0;
    __syncthreads();
    if (!S.next(0, cur)) return;
    if (GATHER) S.a_offs(cur, R0, C0, R1, C1, voffA);
    else { voffA[0][0] = (unsigned)(R0 * lda + C0) * 2u; voffA[0][1] = (unsigned)(R1 * lda + C1) * 2u; voffA[1][0] = voffA[0][0] + (unsigned)(HALF * lda * 2); voffA[1][1] = voffA[0][1] + (unsigned)(HALF * lda * 2); }
    f32x4 acc[2][2][4][2];
#pragma unroll
    for (int a = 0; a < 2; ++a)
#pragma unroll
        for (int b = 0; b < 2; ++b)
#pragma unroll
            for (int m = 0; m < 4; ++m)
#pragma unroll
                for (int n = 0; n < 2; ++n) acc[a][b][m][n] = (f32x4){0.f, 0.f, 0.f, 0.f};
    bf16x8 At[4][2], B0[2][2], B1[2][2];
    const char* cA = S.a_base(cur); const char* cB = S.b_base(cur);
    PG8_STAGE_B(PG8_SB(0, 0), cB); PG8_STAGE_B(PG8_SB(0, 1), cB + hstepB); PG8_STAGE_A(PG8_SA(0, 0), cA, 0); PG8_STAGE_A(PG8_SA(0, 1), cA, 1);
    if (wr == 1) PG8_BAR;
    PG8_WAIT_V(2); PG8_BAR;
    PG8_STAGE_B(PG8_SB(1, 0), cB + kstep); PG8_STAGE_A(PG8_SA(1, 0), cA + kstep, 0); PG8_STAGE_B(PG8_SB(1, 1), cB + hstepB + kstep);
    PG8_WAIT_V(6); PG8_BAR;
    for (;;) {
        const bool has_next = S.next(ui + 1, nxt);
        const char* nA = has_next ? S.a_base(nxt) : cA; const char* nB = has_next ? S.b_base(nxt) : cB;
        unsigned vn[2][2];
        if (GATHER) { if (has_next) S.a_offs(nxt, R0, C0, R1, C1, vn); else { vn[0][0] = voffA[0][0]; vn[0][1] = voffA[0][1]; vn[1][0] = voffA[1][0]; vn[1][1] = voffA[1][1]; } }
        for (int t = 0; t < nt; t += 2) {
            const bool last = (t == nt - 2);
            const char* a1 = cA + (size_t)(t + 1) * kstep;
            const char* a2 = last ? nA : cA + (size_t)(t + 2) * kstep; const char* b2 = last ? nB : cB + (size_t)(t + 2) * kstep;
            const char* a3 = a2 + kstep; const char* b3 = b2 + kstep;
            PG8_LDB(B0, 0, 0); PG8_LDB(B1, 0, 1); PG8_SCHED; PG8_LDA(At, 0, 0); PG8_STAGE_A(PG8_SA(1, 1), a1, 1);
            if (GATHER) { if (last) { voffA[0][0] = vn[0][0]; voffA[0][1] = vn[0][1]; voffA[1][0] = vn[1][0]; voffA[1][1] = vn[1][1]; } }
            PG8_WAIT_V(8); PG8_WAIT_L(0); PG8_BAR; PG8_MMA(0, 0, At, B0); PG8_MMA(0, 1, At, B1); PG8_BAR; PG8_SCHED;
            PG8_LDA(At, 0, 1); PG8_STAGE_B(PG8_SB(0, 0), b2); PG8_STAGE_B(PG8_SB(0, 1), b2 + hstepB); PG8_STAGE_A(PG8_SA(0, 0), a2, 0);
            PG8_WAIT_V(8); PG8_WAIT_L(0); PG8_BAR; PG8_MMA(1, 0, At, B0); PG8_MMA(1, 1, At, B1); PG8_BAR; PG8_SCHED;
            PG8_LDB(B0, 1, 0); PG8_LDB(B1, 1, 1); PG8_SCHED; PG8_LDA(At, 1, 0); PG8_STAGE_A(PG8_SA(0, 1), a2, 1);
            PG8_WAIT_V(8); PG8_WAIT_L(0); PG8_BAR; PG8_MMA(0, 0, At, B0); PG8_MMA(0, 1, At, B1); PG8_BAR; PG8_SCHED;
            PG8_LDA(At, 1, 1); PG8_STAGE_B(PG8_SB(1, 0), b3); PG8_STAGE_B(PG8_SB(1, 1), b3 + hstepB); PG8_STAGE_A(PG8_SA(1, 0), a3, 0);
            PG8_WAIT_V(8); PG8_WAIT_L(0); PG8_BAR; PG8_MMA(1, 0, At, B0); PG8_MMA(1, 1, At, B1); PG8_BAR; PG8_SCHED;
        }
        if (wr == 0) PG8_BAR;
        E(acc, cur, wr, wc, fr, fq);
        if (!has_next) break;
        if (!S.keep_acc(cur)) {
#pragma unroll
        for (int a = 0; a < 2; ++a)
#pragma unroll
            for (int b = 0; b < 2; ++b)
#pragma unroll
                for (int m = 0; m < 4; ++m)
#pragma unroll
                    for (int n = 0; n < 2; ++n) acc[a][b][m][n] = (f32x4){0.f, 0.f, 0.f, 0.f};
        }
        cur = nxt; cA = nA; cB = nB; ++ui;
        if (wr == 1) PG8_BAR;
    }
    PG8_WAIT_V(0);
    PG8_BAR;
#undef PG8_SA
#undef PG8_SB
#undef PG8_STAGE_A
#undef PG8_STAGE_B
#undef PG8_LDA
#undef PG8_LDB
#undef PG8_MMA
#undef PG8_WAIT_V
#undef PG8_WAIT_L
#undef PG8_BAR
#undef PG8_SCHED
}
struct TileOrder {
    int nM, nN, nwg, G, c;
    __device__ __forceinline__ void init(int nM_, int nN_, int G_, int c_) { nM = nM_; nN = nN_; nwg = nM * nN; G = G_; c = c_; }
    __device__ __forceinline__ bool tile(int i, int& pm, int& pn) const {
        const long L = (long)i * G + c; if (L >= nwg) return false;
        int wgid = (int)L; { const int q = nwg / 8, r = nwg % 8, xcd = wgid % 8, off = wgid / 8; wgid = (xcd < r ? xcd * (q + 1) : r * (q + 1) + (xcd - r) * q) + off; }
        const int nig = 8 * nN, gid = wgid / nig, fm = gid * 8, gsz = (nM - fm) < 8 ? (nM - fm) : 8;
        pm = fm + ((wgid % nig) % gsz); pn = (wgid % nig) / gsz; return true;
    }
};
struct DenseSched {
    TileOrder o; const bf16_t* A; const bf16_t* Bt; int lda, ldb;
    __device__ __forceinline__ bool next(int i, Unit& u) const { u.aux = 0; return o.tile(i, u.pm, u.pn); }
    __device__ __forceinline__ const char* a_base(const Unit& u) const { return (const char*)(A + (size_t)u.pm * 256 * lda); }
    __device__ __forceinline__ const char* b_base(const Unit& u) const { return (const char*)(Bt + (size_t)u.pn * 256 * ldb); }
    __device__ __forceinline__ bool keep_acc(const Unit&) const { return false; }
    __device__ __forceinline__ void a_offs(const Unit&, int, int, int, int, unsigned (&)[2][2]) const {}
};
}

struct EpiInProj { bf16_t* qkv; bf16_t* gates; const float* r1; const float* gqa; const float* gka; const float* gqb; const float* gkb; LAS float* X;
    __device__ __forceinline__ void operator()(f32x4 (&acc)[2][2][4][2], const Unit& u, int wr, int wc, int fr, int fq) const {
        const int pn = u.pn;
        const bool isg = pn >= 18; bf16_t* base = isg ? gates : qkv; const int ldc = isg ? NGATE : NQKV; const int colt = (isg ? pn - 18 : pn) * 256 + wc * 32 + 8 * fq;
        const float* gain = pn < 4 ? gqa : (pn == 4 ? gka : ((pn >= 6 && pn < 10) ? gqb : ((pn >= 10 && pn < 14) ? gkb : nullptr)));
        if (gain) {
            const float extra = (pn < 4 || (pn >= 6 && pn < 10)) ? 0.08838834764831845f * 1.4426950408889634f : 1.0f;
#pragma unroll
            for (int ai = 0; ai < 2; ++ai)
#pragma unroll
                for (int m = 0; m < 4; ++m)
#pragma unroll
                    for (int bj = 0; bj < 2; ++bj) { const f32x4 a0 = acc[ai][bj][m][0], a1 = acc[ai][bj][m][1];
                        float sq = (a0[0] * a0[0] + a0[1] * a0[1]) + (a0[2] * a0[2] + a0[3] * a0[3]) + (a1[0] * a1[0] + a1[1] * a1[1]) + (a1[2] * a1[2] + a1[3] * a1[3]);
                        sq += __shfl_xor(sq, 16); sq += __shfl_xor(sq, 32);
                        if (fq == 0) X[(ai * 128 + wr * 64 + m * 16 + fr) * 8 + bj * 4 + wc] = sq; }
            asm volatile("s_waitcnt lgkmcnt(0)" ::: "memory"); __builtin_amdgcn_s_barrier(); asm volatile("" ::: "memory");
            const f32x4 g0 = *(const f32x4*)(gain + wc * 32 + 8 * fq), g1 = *(const f32x4*)(gain + wc * 32 + 8 * fq + 4);
#pragma unroll
            for (int ai = 0; ai < 2; ++ai)
#pragma unroll
                for (int m = 0; m < 4; ++m) { const int rl = ai * 128 + wr * 64 + m * 16 + fr; const int row = u.pm * 256 + rl; const float rs = r1[row]; bf16_t* rowp = base + (size_t)row * ldc + colt;
#pragma unroll
                    for (int bj = 0; bj < 2; ++bj) { const f32x4 t = *(const LAS f32x4*)(X + rl * 8 + bj * 4); const float tot = (t[0] + t[1]) + (t[2] + t[3]);
                        const float sc = rs * rsqrtf(rs * rs * tot * (1.0f / 128.0f) + EPS) * extra;
                        const f32x4 v0 = acc[ai][bj][m][0] * sc * g0, v1 = acc[ai][bj][m][1] * sc * g1;
                        u32x4 w; w.x = pk2(v0[0], v0[1]); w.y = pk2(v0[2], v0[3]); w.z = pk2(v1[0], v1[1]); w.w = pk2(v1[2], v1[3]);
                        *(u32x4*)(rowp + bj * 128) = w; } }
            return;
        }
        if (isg) {
            const int cg = (pn - 18) * 128 + wc * 32 + 8 * fq;
#pragma unroll
            for (int ai = 0; ai < 2; ++ai)
#pragma unroll
                for (int m = 0; m < 4; ++m) { const int row = u.pm * 256 + ai * 128 + wr * 64 + m * 16 + fr; const float rs = r1[row]; bf16_t* rowp = gates + (size_t)row * NGATE + cg;
                    float ra[8], sb[8];
#pragma unroll
                    for (int n = 0; n < 2; ++n)
#pragma unroll
                        for (int j = 0; j < 4; ++j) { const float ea = __expf(-acc[ai][0][m][n][j] * rs), eb = fminf(__expf(-acc[ai][1][m][n][j] * rs), 1e30f);
                            sb[4 * n + j] = __builtin_amdgcn_rcpf(1.0f + eb); ra[4 * n + j] = (1.0f + eb) * __builtin_amdgcn_rcpf(1.0f + ea); }
                    u32x4 w; w.x = pk2(ra[0], ra[1]); w.y = pk2(ra[2], ra[3]); w.z = pk2(ra[4], ra[5]); w.w = pk2(ra[6], ra[7]); *(u32x4*)rowp = w;
                    w.x = pk2(sb[0], sb[1]); w.y = pk2(sb[2], sb[3]); w.z = pk2(sb[4], sb[5]); w.w = pk2(sb[6], sb[7]); *(u32x4*)(rowp + 2048) = w; }
            return;
        }
#pragma unroll
        for (int ai = 0; ai < 2; ++ai)
#pragma unroll
            for (int m = 0; m < 4; ++m) { const int row = u.pm * 256 + ai * 128 + wr * 64 + m * 16 + fr; const float rs = r1[row]; bf16_t* rowp = base + (size_t)row * ldc + colt;
#pragma unroll
                for (int bj = 0; bj < 2; ++bj) { const f32x4 v0 = acc[ai][bj][m][0] * rs, v1 = acc[ai][bj][m][1] * rs;
                    u32x4 w; w.x = pk2(v0[0], v0[1]); w.y = pk2(v0[2], v0[3]); w.z = pk2(v1[0], v1[1]); w.w = pk2(v1[2], v1[3]);
                    *(u32x4*)(rowp + bj * 128) = w; } }
    } };
__device__ __forceinline__ void p1_inproj(const Params& p, LAS unsigned char* lds) {
    pg8::DenseSched S; S.o.init(128, 34, gridDim.x, blockIdx.x); S.A = (const bf16_t*)(p.ws + WS_XB); S.Bt = (const bf16_t*)(p.ws + WS_WIN); S.lda = D; S.ldb = D;
    EpiInProj E{(bf16_t*)(p.ws + WS_QKV), (bf16_t*)(p.ws + WS_GATES), (const float*)(p.ws + WS_R1), p.in[3], p.in[4], p.in[6], p.in[7], (LAS float*)(lds + 131072)};
    pg8::gemm_phase<true, false>(lds, S, E, D / 64, D, D);
}

__device__ __forceinline__ void wait_vm(int n) {
    switch (n) { case 0: asm volatile("s_waitcnt vmcnt(0)" ::: "memory"); break; case 2: asm volatile("s_waitcnt vmcnt(2)" ::: "memory"); break; case 4: asm volatile("s_waitcnt vmcnt(4)" ::: "memory"); break;
                 case 6: asm volatile("s_waitcnt vmcnt(6)" ::: "memory"); break; case 8: asm volatile("s_waitcnt vmcnt(8)" ::: "memory"); break; case 10: asm volatile("s_waitcnt vmcnt(10)" ::: "memory"); break;
                 default: asm volatile("s_waitcnt vmcnt(12)" ::: "memory"); break; }
}
__device__ __forceinline__ void glds16_asm(const void* gsrc, unsigned lds_dst) {
    unsigned keep;
    asm volatile("s_mov_b32 %0, m0\n\ts_mov_b32 m0, %2\n\ts_nop 0\n\tglobal_load_lds_dwordx4 %1, off\n\ts_mov_b32 m0, %0" : "=&s"(keep) : "v"(gsrc), "s"(lds_dst) : "memory");
}
#define ATT_BAR() do { asm volatile("s_waitcnt lgkmcnt(0)" ::: "memory"); __builtin_amdgcn_s_barrier(); asm volatile("" ::: "memory"); } while (0)
__device__ __forceinline__ void load_q(const bf16_t* qp, int g, bf16x8 (&qf)[4]) {
#pragma unroll
    for (int ks = 0; ks < 4; ++ks) qf[ks] = *(const bf16x8*)(qp + 32 * ks + 8 * g);
#pragma unroll
    for (int ks = 0; ks < 4; ++ks) asm volatile("" : "+v"(qf[ks]));
}
__device__ __forceinline__ bf16x8 vt_frag(LAS unsigned char* base, int row0, int g, int q4, int pp, int dt) {
    const s16x4 lo = tr_read(base + off_b(row0 + 4 * g + q4, 2 * dt + (pp >> 1)) + 8 * (pp & 1)), hi = tr_read(base + off_b(row0 + 16 + 4 * g + q4, 2 * dt + (pp >> 1)) + 8 * (pp & 1));
    bf16x8 vf; vf[0] = lo[0]; vf[1] = lo[1]; vf[2] = lo[2]; vf[3] = lo[3]; vf[4] = hi[0]; vf[5] = hi[1]; vf[6] = hi[2]; vf[7] = hi[3]; return vf;
}

__device__ __forceinline__ void attn_window_item(const Params& p, LAS unsigned char* lds, int item, int& tab_head) {
    const int tid = phase_tid(), lane = tid & 63, w = __builtin_amdgcn_readfirstlane(tid >> 6), g = lane >> 4, ql = lane & 15;
    const int b = item >> 10, nb = (item >> 3) & 127, hq = item & 7, kv = hq >> 2;
    const bf16_t* qkv = (const bf16_t*)(p.ws + WS_QKV); bf16_t* o = (bf16_t*)(p.ws + WS_O);
    LAS float* bias = (LAS float*)(lds + 131072); const unsigned ldsb = (unsigned)(size_t)lds;
    const unsigned loff = (unsigned)(w * 4 + g) * NQKV + (unsigned)((ql ^ ((g << 2) | (w & 3))) * 8);
    const bf16_t* kbase = qkv + (size_t)(b * SEQ) * NQKV + 1024 + kv * 128;
#define WIN_ISSUE(c) do { const int _c = (c); const int _kb = min(max(nb - 1 + (_c % 3), 0), 127); const bf16_t* _src = kbase + (size_t)(_kb * 128) * NQKV + (_c >= 3 ? 256 : 0) + loff; \
        _Pragma("unroll") for (int _i = 0; _i < 4; ++_i) glds16_asm(_src + (size_t)(32 * _i) * NQKV, ldsb + (unsigned)((_c & 3) * 32768 + _i * 8192 + w * 1024)); } while (0)
    ATT_BAR();
    WIN_ISSUE(0); WIN_ISSUE(1); WIN_ISSUE(2);
    if (hq != tab_head) { if (tid < 257) bias[tid] = p.in[12][t5_bucket(tid - 128) * 8 + hq] * 1.4426950408889634f; tab_head = hq; }
    const int tq = b * SEQ + nb * 128 + 16 * w + ql;
    bf16x8 qf[4]; load_q(qkv + (size_t)tq * NQKV + hq * 128, g, qf);
    float sink = p.in[5][hq] * 1.4426950408889634f; asm volatile("" : "+v"(sink));
    f32x4 S1[8], SC[9];
#pragma unroll
    for (int kt = 0; kt < 8; ++kt) S1[kt] = (f32x4){0.f, 0.f, 0.f, 0.f};
#pragma unroll
    for (int s = 0; s < 9; ++s) SC[s] = (f32x4){0.f, 0.f, 0.f, 0.f};
    const bool in0 = nb > 0, in2 = nb < 127;
#pragma unroll
    for (int c = 0; c < 3; ++c) {
        wait_vm(8); ATT_BAR(); WIN_ISSUE(c + 3);
        LAS unsigned char* buf = lds + (c & 3) * 32768;
#pragma unroll
        for (int kt = 0; kt < 8; ++kt) {
            if (c == 1) {
#pragma unroll
                for (int ks = 0; ks < 4; ++ks) { const bf16x8 kf = *(const LAS bf16x8*)(buf + off_b(16 * kt + ql, 4 * ks + g)); S1[kt] = __builtin_amdgcn_mfma_f32_16x16x32_bf16(kf, qf[ks], S1[kt], 0, 0, 0); }
            } else if (c == 0) { if (kt >= w) {
#pragma unroll
                for (int ks = 0; ks < 4; ++ks) { const bf16x8 kf = *(const LAS bf16x8*)(buf + off_b(16 * kt + ql, 4 * ks + g)); SC[7 - kt] = __builtin_amdgcn_mfma_f32_16x16x32_bf16(kf, qf[ks], SC[7 - kt], 0, 0, 0); } }
            } else { if (kt <= w) {
#pragma unroll
                for (int ks = 0; ks < 4; ++ks) { const bf16x8 kf = *(const LAS bf16x8*)(buf + off_b(16 * kt + ql, 4 * ks + g)); SC[8 - kt] = __builtin_amdgcn_mfma_f32_16x16x32_bf16(kf, qf[ks], SC[8 - kt], 0, 0, 0); } }
            }
        }
    }
    float mx = sink; const int qi = 16 * w + ql;
#pragma unroll
    for (int kt = 0; kt < 8; ++kt)
#pragma unroll
        for (int r = 0; r < 4; ++r) { const int rel = 16 * kt + 4 * g + r - qi; const float sv = S1[kt][r] + bias[rel + 128]; S1[kt][r] = sv; mx = fmaxf(mx, sv); }
#pragma unroll
    for (int s = 0; s < 9; ++s) { const bool c0 = s <= 7 - w; const int kt = c0 ? 7 - s : 8 - s; const int cofs = c0 ? -128 : 128; const bool inr = c0 ? in0 : in2;
#pragma unroll
        for (int r = 0; r < 4; ++r) { const int rel = cofs + 16 * kt + 4 * g + r - qi; const bool valid = inr && rel >= -128 && rel <= 128;
            const float bv = bias[rel + 128];
            const float sv = valid ? SC[s][r] + bv : -1e30f; SC[s][r] = sv; mx = fmaxf(mx, sv); } }
    mx = fmaxf(mx, __shfl_xor(mx, 16)); mx = fmaxf(mx, __shfl_xor(mx, 32));
    float l = 0.f;
#pragma unroll
    for (int kt = 0; kt < 8; ++kt)
#pragma unroll
        for (int r = 0; r < 4; ++r) { const float pe = __builtin_amdgcn_exp2f(S1[kt][r] - mx); S1[kt][r] = pe; l += pe; }
#pragma unroll
    for (int s = 0; s < 9; ++s)
#pragma unroll
        for (int r = 0; r < 4; ++r) { const float pe = __builtin_amdgcn_exp2f(SC[s][r] - mx); SC[s][r] = pe; l += pe; }
    l += __shfl_xor(l, 16); l += __shfl_xor(l, 32); l += __builtin_amdgcn_exp2f(sink - mx);
    const float inv = 1.0f / l;
    f32x4 O[8];
#pragma unroll
    for (int dt = 0; dt < 8; ++dt) O[dt] = (f32x4){0.f, 0.f, 0.f, 0.f};
    const int q4 = ql >> 2, pp = ql & 3;
    const f32x4 zero4 = (f32x4){0.f, 0.f, 0.f, 0.f};
#pragma unroll
    for (int c = 0; c < 3; ++c) {
        wait_vm(c == 0 ? 8 : (c == 1 ? 4 : 0)); ATT_BAR();
        LAS unsigned char* buf = lds + ((c + 3) & 3) * 32768;
#pragma unroll
        for (int kk = 0; kk < 4; ++kk) {
            bool a0, a1; f32x4 p0, p1;
            if (c == 1) { a0 = true; a1 = true; p0 = S1[2 * kk]; p1 = S1[2 * kk + 1]; }
            else if (c == 0) { a0 = 2 * kk >= w; a1 = 2 * kk + 1 >= w; p0 = a0 ? SC[7 - 2 * kk] : zero4; p1 = a1 ? SC[6 - 2 * kk] : zero4; }
            else { a0 = 2 * kk <= w; a1 = 2 * kk + 1 <= w; p0 = a0 ? SC[8 - 2 * kk] : zero4; p1 = a1 ? SC[7 - 2 * kk] : zero4; }
            if (a0 || a1) { u32x4 pw; pw.x = pk2(p0[0], p0[1]); pw.y = pk2(p0[2], p0[3]); pw.z = pk2(p1[0], p1[1]); pw.w = pk2(p1[2], p1[3]);
                const bf16x8 pf = __builtin_bit_cast(bf16x8, pw);
#pragma unroll
                for (int dt = 0; dt < 8; ++dt) O[dt] = __builtin_amdgcn_mfma_f32_16x16x32_bf16(vt_frag(buf, 32 * kk, g, q4, pp, dt), pf, O[dt], 0, 0, 0); } }
    }
#undef WIN_ISSUE
    bf16_t* op = o + (size_t)tq * D + hq * 128 + 4 * g;
#pragma unroll
    for (int dt = 0; dt < 8; ++dt) { u32x2 w2; w2.x = pk2(O[dt][0] * inv, O[dt][1] * inv); w2.y = pk2(O[dt][2] * inv, O[dt][3] * inv); *(u32x2*)(op + 16 * dt) = w2; }
}

__device__ __forceinline__ void attn_nat_item(const Params& p, LAS unsigned char* lds, int item, int& tab_head) {
    const int tid = phase_tid(), lane = tid & 63, w = __builtin_amdgcn_readfirstlane(tid >> 6), g = lane >> 4, ql = lane & 15;
    const int b = item >> 9, rp = (item >> 2) & 127, hp = item & 3, hh = w >> 2, h = 2 * hp + hh, jq = w & 3;
    const int kr_lo = min(max(2 * rp - 4, 0), 248);
    const int d0 = min(max(2 * rp - 4, 0), 248) - kr_lo, d1 = min(max(2 * rp - 3, 0), 248) - kr_lo;
    const int w0 = jq == 0 ? 0 : (jq == 1 ? 8 : (jq == 2 ? 24 : 32));
    const bf16_t* qkv = (const bf16_t*)(p.ws + WS_QKV); bf16_t* o = (bf16_t*)(p.ws + WS_O);
    LAS float* rpb = (LAS float*)(lds + 131072); const unsigned ldsb = (unsigned)(size_t)lds;
    const unsigned loff = (unsigned)(w * 4 + g) * NQKV + (unsigned)((ql ^ ((g << 2) | (w & 3))) * 8);
    const bf16_t* kbase = qkv + (size_t)(b * SEQ) * NQKV + 2560 + 2 * hp * 128;
#define NAT_ISSUE(s) do { const int _s = (s); const int _kr = min(kr_lo + (_s % 9), 255); const bf16_t* _src = kbase + (size_t)(_kr * 64) * NQKV + (_s >= 9 ? 1024 : 0) + loff; \
        _Pragma("unroll") for (int _i = 0; _i < 4; ++_i) glds16_asm(_src + (size_t)(32 * (_i & 1)) * NQKV + 128 * (_i >> 1), ldsb + (unsigned)((_s & 3) * 32768 + _i * 8192 + w * 1024)); } while (0)
    ATT_BAR();
    NAT_ISSUE(0); NAT_ISSUE(1); NAT_ISSUE(2);
    if (hp != tab_head) { for (int i = tid; i < 930; i += 512) rpb[i] = p.in[8][2 * hp * 465 + i] * 1.4426950408889634f; tab_head = hp; }
    const int qcol = 16 * jq + ql; const int tq0 = b * SEQ + (2 * rp) * 64 + qcol;
    bf16x8 qf[2][4]; load_q(qkv + (size_t)tq0 * NQKV + 1536 + h * 128, g, qf[0]); load_q(qkv + (size_t)(tq0 + 64) * NQKV + 1536 + h * 128, g, qf[1]);
    f32x4 S[2][9][2];
#pragma unroll
    for (int u = 0; u < 2; ++u)
#pragma unroll
        for (int c = 0; c < 9; ++c) { S[u][c][0] = (f32x4){0.f, 0.f, 0.f, 0.f}; S[u][c][1] = (f32x4){0.f, 0.f, 0.f, 0.f}; }
#pragma unroll
    for (int c = 0; c < 9; ++c) {
        wait_vm(8); ATT_BAR(); NAT_ISSUE(c + 3);
        const bool a0 = c >= d0 && c < d0 + 8, a1 = c >= d1 && c < d1 + 8;
        LAS unsigned char* buf = lds + (c & 3) * 32768 + hh * 16384;
#pragma unroll
        for (int t = 0; t < 2; ++t)
#pragma unroll
            for (int ks = 0; ks < 4; ++ks) { const bf16x8 kf = *(const LAS bf16x8*)(buf + off_b(w0 + 16 * t + ql, 4 * ks + g));
                if (a0) S[0][c][t] = __builtin_amdgcn_mfma_f32_16x16x32_bf16(kf, qf[0][ks], S[0][c][t], 0, 0, 0);
                if (a1) S[1][c][t] = __builtin_amdgcn_mfma_f32_16x16x32_bf16(kf, qf[1][ks], S[1][c][t], 0, 0, 0); }
    }
    const int cs = min(max(qcol - 8, 0), 48); float inv[2];
    unsigned P[2][9][4];
    int dcv[2][4]; bool cv[2][4];
#pragma unroll
    for (int t = 0; t < 2; ++t)
#pragma unroll
        for (int q = 0; q < 4; ++q) { const int kc = w0 + 16 * t + 4 * g + q; cv[t][q] = kc >= cs && kc < cs + 16; dcv[t][q] = hh * 465 + kc - qcol + 15; }
#pragma unroll
    for (int u = 0; u < 2; ++u) { const int du = u ? d1 : d0; const int r = 2 * rp + u; float mx = -1e30f;
#pragma unroll
        for (int c = 0; c < 9; ++c) { const bool act = c >= du && c < du + 8;
            if (act) { const int rowb = (kr_lo + c - r + 7) * 31;
#pragma unroll
                for (int t = 0; t < 2; ++t)
#pragma unroll
                    for (int q = 0; q < 4; ++q) { const float sv = cv[t][q] ? S[u][c][t][q] + rpb[rowb + dcv[t][q]] : -1e30f; S[u][c][t][q] = sv; mx = fmaxf(mx, sv); } } }
        mx = fmaxf(mx, __shfl_xor(mx, 16)); mx = fmaxf(mx, __shfl_xor(mx, 32));
        float l = 0.f;
#pragma unroll
        for (int c = 0; c < 9; ++c) { const bool act = c >= du && c < du + 8;
            if (act) { float e[2][4];
#pragma unroll
                for (int t = 0; t < 2; ++t)
#pragma unroll
                    for (int q = 0; q < 4; ++q) { e[t][q] = __builtin_amdgcn_exp2f(S[u][c][t][q] - mx); l += e[t][q]; }
                P[u][c][0] = pk2(e[0][0], e[0][1]); P[u][c][1] = pk2(e[0][2], e[0][3]); P[u][c][2] = pk2(e[1][0], e[1][1]); P[u][c][3] = pk2(e[1][2], e[1][3]); }
            else { P[u][c][0] = 0u; P[u][c][1] = 0u; P[u][c][2] = 0u; P[u][c][3] = 0u; } }
        l += __shfl_xor(l, 16); l += __shfl_xor(l, 32);
        inv[u] = 1.0f / l; }
    f32x4 O[2][8];
#pragma unroll
    for (int u = 0; u < 2; ++u)
#pragma unroll
        for (int dt = 0; dt < 8; ++dt) O[u][dt] = (f32x4){0.f, 0.f, 0.f, 0.f};
    const int q4 = ql >> 2, pp = ql & 3;
#pragma unroll
    for (int c = 0; c < 9; ++c) {
        wait_vm(c <= 6 ? 8 : (c == 7 ? 4 : 0)); ATT_BAR(); if (c + 12 < 18) NAT_ISSUE(c + 12);
        const bool a0 = c >= d0 && c < d0 + 8, a1 = c >= d1 && c < d1 + 8;
        LAS unsigned char* buf = lds + ((c + 9) & 3) * 32768 + hh * 16384;
        u32x4 pw0; pw0.x = P[0][c][0]; pw0.y = P[0][c][1]; pw0.z = P[0][c][2]; pw0.w = P[0][c][3];
        u32x4 pw1; pw1.x = P[1][c][0]; pw1.y = P[1][c][1]; pw1.z = P[1][c][2]; pw1.w = P[1][c][3];
        const bf16x8 pf0 = __builtin_bit_cast(bf16x8, pw0), pf1 = __builtin_bit_cast(bf16x8, pw1);
#pragma unroll
        for (int dt = 0; dt < 8; ++dt) { const bf16x8 vf = vt_frag(buf, w0, g, q4, pp, dt);
            if (a0) O[0][dt] = __builtin_amdgcn_mfma_f32_16x16x32_bf16(vf, pf0, O[0][dt], 0, 0, 0);
            if (a1) O[1][dt] = __builtin_amdgcn_mfma_f32_16x16x32_bf16(vf, pf1, O[1][dt], 0, 0, 0); }
    }
#undef NAT_ISSUE
#pragma unroll
    for (int u = 0; u < 2; ++u) { bf16_t* op = o + (size_t)(tq0 + 64 * u) * D + 1024 + h * 128 + 4 * g;
#pragma unroll
        for (int dt = 0; dt < 8; ++dt) { u32x2 w2; w2.x = pk2(O[u][dt][0] * inv[u], O[u][dt][1] * inv[u]); w2.y = pk2(O[u][dt][2] * inv[u], O[u][dt][3] * inv[u]); *(u32x2*)(op + 16 * dt) = w2; } }
}
__device__ __forceinline__ void p2_attn(const Params& p, LAS unsigned char* lds) {
    int tab_head = -1;
    for (int it = blockIdx.x; it < 2048; it += gridDim.x) attn_window_item(p, lds, it, tab_head);
#ifdef PROBE_A
    if (blockIdx.x == 0 && threadIdx.x == 0) ((unsigned long long*)(p.ws + WS_END))[11] = __builtin_amdgcn_s_memrealtime();
#endif
    tab_head = -1;
    for (int it = blockIdx.x; it < 1024; it += gridDim.x) attn_nat_item(p, lds, it, tab_head);
    asm volatile("s_waitcnt vmcnt(0)" ::: "memory"); __syncthreads();
}

struct UpHook { const bf16_t* gates;
    __device__ __forceinline__ void operator()(f32x4 (&acc)[2][2][4][2], const Unit& u, int wr, int wc, int fr, int fq) const {
        const unsigned goff = (unsigned)(u.pm * 256 + wr * 64 + fr) * NGATE + u.pn * 256 + wc * 32 + 8 * fq;
#pragma unroll
        for (int ai = 0; ai < 2; ++ai) {
            bf16x8 ra[4][2];
#pragma unroll
            for (int m = 0; m < 4; ++m)
#pragma unroll
                for (int bj = 0; bj < 2; ++bj) ra[m][bj] = *(const bf16x8*)(gates + goff + (unsigned)((ai * 128 + m * 16) * NGATE) + bj * 128);
#pragma unroll
            for (int m = 0; m < 4; ++m)
#pragma unroll
                for (int bj = 0; bj < 2; ++bj)
#pragma unroll
                    for (int n = 0; n < 2; ++n)
#pragma unroll
                        for (int j = 0; j < 4; ++j) acc[ai][bj][m][n][j] *= bf2f(ra[m][bj][4 * n + j]);
            asm volatile("" ::: "memory"); }
    } };
struct UpSched {
    pg8::TileOrder o; const bf16_t* A; const bf16_t* Bt;
    __device__ __forceinline__ bool next(int i, Unit& u) const { u.aux = i & 1; return o.tile(i >> 1, u.pm, u.pn); }
    __device__ __forceinline__ const char* a_base(const Unit& u) const { return (const char*)(A + (size_t)u.pm * 256 * D + u.aux * 1024); }
    __device__ __forceinline__ const char* b_base(const Unit& u) const { return (const char*)(Bt + (size_t)u.pn * 256 * D + u.aux * 1024); }
    __device__ __forceinline__ bool keep_acc(const Unit& u) const { return u.aux == 0; }
    __device__ __forceinline__ void a_offs(const Unit&, int, int, int, int, unsigned (&)[2][2]) const {}
};
struct EpiUp { const bf16_t* gates; bf16_t* merged;
    __device__ __forceinline__ void operator()(f32x4 (&acc)[2][2][4][2], const Unit& u, int wr, int wc, int fr, int fq) const {
        if (u.aux == 0) { UpHook{gates}(acc, u, wr, wc, fr, fq); return; }
        const unsigned goff = (unsigned)(u.pm * 256 + wr * 64 + fr) * NGATE + 2048 + u.pn * 256 + wc * 32 + 8 * fq;
        const unsigned moff = (unsigned)(u.pm * 256 + wr * 64 + fr) * D + u.pn * 256 + wc * 32 + 8 * fq;
#pragma unroll
        for (int ai = 0; ai < 2; ++ai) {
            bf16x8 sb[4][2];
#pragma unroll
            for (int m = 0; m < 4; ++m)
#pragma unroll
                for (int bj = 0; bj < 2; ++bj) sb[m][bj] = *(const bf16x8*)(gates + goff + (unsigned)((ai * 128 + m * 16) * NGATE) + bj * 128);
#pragma unroll
            for (int m = 0; m < 4; ++m)
#pragma unroll
                for (int bj = 0; bj < 2; ++bj) { f32x4 v0 = acc[ai][bj][m][0], v1 = acc[ai][bj][m][1];
#pragma unroll
                    for (int j = 0; j < 4; ++j) { v0[j] *= bf2f(sb[m][bj][j]); v1[j] *= bf2f(sb[m][bj][4 + j]); }
                    u32x4 w; w.x = pk2(v0[0], v0[1]); w.y = pk2(v0[2], v0[3]); w.z = pk2(v1[0], v1[1]); w.w = pk2(v1[2], v1[3]);
                    *(u32x4*)(merged + moff + (unsigned)((ai * 128 + m * 16) * D) + bj * 128) = w; }
            asm volatile("" ::: "memory"); }
    } };
__device__ __forceinline__ void p3_up(const Params& p, LAS unsigned char* lds) {
    UpSched S; S.o.init(128, 8, gridDim.x, blockIdx.x); S.A = (const bf16_t*)(p.ws + WS_O); S.Bt = (const bf16_t*)(p.ws + WS_WUP);
    EpiUp E{(const bf16_t*)(p.ws + WS_GATES), (bf16_t*)(p.ws + WS_XB)};
    pg8::gemm_phase<true, false>(lds, S, E, 1024 / 64, D, D);
}

struct EpiOut { bf16_t* mob;
    __device__ __forceinline__ void operator()(f32x4 (&acc)[2][2][4][2], const Unit& u, int wr, int wc, int fr, int fq) const {
        unsigned off = (unsigned)(u.pm * 256 + wr * 64 + fr) * D + u.pn * 256 + wc * 32 + 8 * fq;
#pragma unroll
        for (int ai = 0; ai < 2; ++ai) {
#pragma unroll
            for (int m = 0; m < 4; ++m) { asm volatile("" : "+v"(off));
#pragma unroll
                for (int bj = 0; bj < 2; ++bj) { const f32x4 v0 = acc[ai][bj][m][0], v1 = acc[ai][bj][m][1];
                    u32x4 w; w.x = pk2(v0[0], v0[1]); w.y = pk2(v0[2], v0[3]); w.z = pk2(v1[0], v1[1]); w.w = pk2(v1[2], v1[3]);
                    *(u32x4*)(mob + off + bj * 128) = w; }
                off += 16 * D; }
            off += 64 * D; }
    } };
__device__ __forceinline__ void p4_out(const Params& p, LAS unsigned char* lds) {
    pg8::DenseSched S; S.o.init(128, 8, gridDim.x, blockIdx.x); S.A = (const bf16_t*)(p.ws + WS_XB); S.Bt = (const bf16_t*)(p.ws + WS_WOUT); S.lda = D; S.ldb = D;
    EpiOut E{(bf16_t*)(p.ws + WS_MOB)};
    pg8::gemm_phase<true, false>(lds, S, E, D / 64, D, D);
}

__device__ __forceinline__ void p5_router(const Params& p, LAS unsigned char* lds) {
    const int tid = phase_tid(), lane = tid & 63, wave = __builtin_amdgcn_readfirstlane(tid >> 6), g = lane >> 4, tl = lane & 15;
    const bf16_t* wsp = (const bf16_t*)(p.ws + WS_WRT); float* r2 = (float*)(p.ws + WS_R2); int* cnt = (int*)(p.ws + WS_CNT); int* tokl = (int*)(p.ws + WS_TOK);
    int* recc = (int*)(p.ws + WS_RECC); float* recw = (float*)(p.ws + WS_RECW); bf16_t* hb = (bf16_t*)(p.ws + WS_O); const bf16_t* mob = (const bf16_t*)(p.ws + WS_MOB);
    const float* brg = p.in[15]; const float* bre = p.in[17];
    LAS float* H = (LAS float*)(lds + wave * 4352);
    LAS unsigned char* WL = lds + 36864;
    const int r4 = lane >> 4, k4 = (lane & 15) * 4;
    const int pa0 = tid / 384, pr0 = (tid % 384) >> 3, ps0 = tid & 7, pi1 = 512 + tid, pa1 = pi1 / 384, pr1 = (pi1 % 384) >> 3;
    const unsigned wsrc0 = (unsigned)(pa0 * 48 * 2048 + pr0 * D + ps0 * 8), wsrc1 = (unsigned)(pa1 * 48 * 2048 + pr1 * D + ps0 * 8);
    const unsigned wdst0 = (unsigned)(pa0 * 6144 + pr0 * 128 + ((ps0 ^ (pr0 & 7)) << 4)), wdst1 = (unsigned)(pa1 * 6144 + pr1 * 128 + ((ps0 ^ (pr1 & 7)) << 4));
    for (int round = blockIdx.x; round < T / 128; round += gridDim.x) {
        const int tile = round * 8 + wave;
        const float* xs = p.in[0] + (size_t)tile * 16 * D; const bf16_t* ms = mob + (size_t)tile * 16 * D; bf16_t* hs = hb + (size_t)tile * 16 * D;
        unsigned lo = (unsigned)(r4 * D + k4);
        f32x4 accA = {0.f, 0.f, 0.f, 0.f}, accB = accA, accC = accA; float ss = 0.f;
        f32x4 xa[4], xb_[4], xc[4]; u32x2 ma[4], mb[4], mc[4]; u32x4 wr0, wr1;
#define RT_LOADS(bx, bm, k) do { _Pragma("unroll") for (int j = 0; j < 4; ++j) { bx[j] = *(const f32x4*)(xs + (4 * j) * D + lo + 64 * (k)); bm[j] = *(const u32x2*)(ms + (4 * j) * D + lo + 64 * (k)); } } while (0)
#define RT_SPLIT(f0, f1, hi, lw) do { hi = pk2(f0, f1); lw = pk2((f0) - __uint_as_float(hi << 16), (f1) - __uint_as_float(hi & 0xffff0000u)); } while (0)
#define RT_COMP(bx, bm, k, wbuf) do { \
            _Pragma("unroll") for (int j = 0; j < 4; ++j) { f32x4 h = bx[j]; h.x += __uint_as_float(bm[j].x << 16); h.y += __uint_as_float(bm[j].x & 0xffff0000u); h.z += __uint_as_float(bm[j].y << 16); h.w += __uint_as_float(bm[j].y & 0xffff0000u); \
                u32x2 q2; q2.x = pk2(h[0], h[1]); q2.y = pk2(h[2], h[3]); *(u32x2*)(hs + (4 * j) * D + lo + 64 * (k)) = q2; \
                *(LAS f32x4*)(H + (4 * j + r4) * 68 + k4) = h; } \
            _Pragma("unroll") for (int ks = 0; ks < 2; ++ks) { const f32x4 h0 = *(const LAS f32x4*)(H + tl * 68 + 32 * ks + 8 * g), h1 = *(const LAS f32x4*)(H + tl * 68 + 32 * ks + 8 * g + 4); \
                ss += (h0.x * h0.x + h0.y * h0.y) + (h0.z * h0.z + h0.w * h0.w) + (h1.x * h1.x + h1.y * h1.y) + (h1.z * h1.z + h1.w * h1.w); \
                u32x4 hh, hl; RT_SPLIT(h0.x, h0.y, hh.x, hl.x); RT_SPLIT(h0.z, h0.w, hh.y, hl.y); RT_SPLIT(h1.x, h1.y, hh.z, hl.z); RT_SPLIT(h1.z, h1.w, hh.w, hl.w); \
                const bf16x8 bh = __builtin_bit_cast(bf16x8, hh), bl = __builtin_bit_cast(bf16x8, hl); const unsigned so_ = (unsigned)(((4 * ks + g) ^ (tl & 7)) << 4); \
                _Pragma("unroll") for (int t = 0; t < 3; ++t) { const bf16x8 ah = *(const LAS bf16x8*)((wbuf) + (16 * t + tl) * 128 + so_), al = *(const LAS bf16x8*)((wbuf) + 6144 + (16 * t + tl) * 128 + so_); \
                    f32x4& ac = (t == 0 ? accA : (t == 1 ? accB : accC)); \
                    ac = __builtin_amdgcn_mfma_f32_16x16x32_bf16(ah, bh, ac, 0, 0, 0); ac = __builtin_amdgcn_mfma_f32_16x16x32_bf16(al, bh, ac, 0, 0, 0); ac = __builtin_amdgcn_mfma_f32_16x16x32_bf16(ah, bl, ac, 0, 0, 0); } } } while (0)
#define RT_WLOAD(c) do { wr0 = *(const u32x4*)(wsp + wsrc0 + 64 * (c)); if (tid < 256) wr1 = *(const u32x4*)(wsp + wsrc1 + 64 * (c)); } while (0)
#define RT_WSTORE(wbuf) do { *(LAS u32x4*)((wbuf) + wdst0) = wr0; if (tid < 256) *(LAS u32x4*)((wbuf) + wdst1) = wr1; } while (0)
        __syncthreads();
        RT_WLOAD(0); RT_LOADS(xa, ma, 0); RT_LOADS(xb_, mb, 1);
        RT_WSTORE(WL); RT_WLOAD(1);
        __syncthreads();
#pragma unroll 1
        for (int c = 0; c < D / 64 - 2; c += 3) {
            const int pz = c & 1;
            RT_LOADS(xc, mc, 2); RT_COMP(xa, ma, 0, WL + pz * 12288); RT_WSTORE(WL + (pz ^ 1) * 12288); RT_WLOAD(c + 2); __syncthreads();
            RT_LOADS(xa, ma, 3); RT_COMP(xb_, mb, 1, WL + (pz ^ 1) * 12288); RT_WSTORE(WL + pz * 12288); RT_WLOAD(c + 3); __syncthreads();
            RT_LOADS(xb_, mb, 4); RT_COMP(xc, mc, 2, WL + pz * 12288); RT_WSTORE(WL + (pz ^ 1) * 12288); RT_WLOAD((c + 4) & 31); __syncthreads();
            lo += 192;
        }
        RT_COMP(xa, ma, 0, WL); RT_WSTORE(WL + 12288); __syncthreads();
        RT_COMP(xb_, mb, 1, WL + 12288);
#undef RT_LOADS
#undef RT_SPLIT
#undef RT_COMP
#undef RT_WLOAD
#undef RT_WSTORE
        const int tok = tile * 16 + tl;
        ss += __shfl_xor(ss, 16); ss += __shfl_xor(ss, 32);
        const float rr = rsqrtf(ss * (1.0f / D) + EPS);
        const float myg = accC[0] * rr + brg[g];
        float gl[4];
#pragma unroll
        for (int j = 0; j < 4; ++j) gl[j] = __shfl(myg, tl + 16 * j);
        int gi = 0; float gm = gl[0];
#pragma unroll
        for (int i = 1; i < 4; ++i) if (gl[i] > gm) { gm = gl[i]; gi = i; }
        float den = 0.f;
#pragma unroll
        for (int i = 0; i < 4; ++i) den += __expf(gl[i] - gm);
        const float pg = 1.0f / den;
        int L0 = 0, L1 = 0; float wt0 = 0.f, wt1 = 0.f; const bool owner = (g == gi);
        if (owner) {
            float el[8];
#pragma unroll
            for (int i = 0; i < 4; ++i) { el[i] = accA[i] * rr + bre[g * 8 + i]; el[4 + i] = accB[i] * rr + bre[g * 8 + 4 + i]; }
            int e0 = 0; float v0 = el[0];
#pragma unroll
            for (int i = 1; i < 8; ++i) if (el[i] > v0) { v0 = el[i]; e0 = i; }
            int e1 = -1; float v1 = -3.0e38f;
#pragma unroll
            for (int i = 0; i < 8; ++i) if (i != e0 && el[i] > v1) { v1 = el[i]; e1 = i; }
            const float ex = __expf(v1 - v0); const float s0 = 1.0f / (1.0f + ex), s1 = ex * s0;
            r2[tok] = rr; L0 = gi * 8 + e0; L1 = gi * 8 + e1; wt0 = pg * s0; wt1 = pg * s1;
        }
        LAS int* cl = (LAS int*)(lds + 61440);
        if (tid < 32) cl[tid] = 0;
        __syncthreads();
        int q0 = 0, q1 = 0;
        if (owner) { q0 = __hip_atomic_fetch_add(&cl[L0], 1, __ATOMIC_RELAXED, __HIP_MEMORY_SCOPE_WORKGROUP); q1 = __hip_atomic_fetch_add(&cl[L1], 1, __ATOMIC_RELAXED, __HIP_MEMORY_SCOPE_WORKGROUP); }
        __syncthreads();
        if (tid < 32) { const int n = cl[tid]; cl[32 + tid] = n ? atomicAdd(&cnt[tid], n) : 0; }
        __syncthreads();
        if (owner) { const int p0 = cl[32 + L0] + q0, p1 = cl[32 + L1] + q1;
            float* r2l = (float*)(p.ws + WS_R2L);
            tokl[(size_t)L0 * T + p0] = tok; r2l[(size_t)L0 * T + p0] = rr; recc[2 * tok] = L0 * 32768 + p0; recw[2 * tok] = wt0;
            tokl[(size_t)L1 * T + p1] = tok; r2l[(size_t)L1 * T + p1] = rr; recc[2 * tok + 1] = L1 * 32768 + p1; recw[2 * tok + 1] = wt1; }
    }
    __syncthreads();
}

__device__ __forceinline__ void build_tiles(const Params& p, LAS int* tab) {
    __syncthreads();
    if (threadIdx.x < 64) { const int L = threadIdx.x; const int c = L < 32 ? ((const int*)(p.ws + WS_CNT))[L] : 0; const int nt = (c + 255) >> 8;
        int pre = nt;
#pragma unroll
        for (int o = 1; o < 32; o <<= 1) { const int v = __shfl_up(pre, o); if (L >= o) pre += v; }
        const int first = pre - nt;
        if (L < 32) { tab[1400 + L] = first * 256; for (int i = 0; i < nt; ++i) { tab[4 + (first + i) * 4 + 0] = L; tab[4 + (first + i) * 4 + 1] = i * 256; tab[4 + (first + i) * 4 + 2] = (first + i) * 256; tab[4 + (first + i) * 4 + 3] = min(256, c - i * 256); } }
        if (L == 31) tab[0] = pre; }
    __syncthreads();
}
template <int NPN> struct MoeOrder { int G, c, t_lo, nt_tiles; const LAS int* tab;
    __device__ __forceinline__ bool unit(int i, Unit& u) const { const long L = (long)i * G + c; if (L >= (long)nt_tiles * NPN) return false;
        const int nwg = nt_tiles * NPN; int wgid = (int)L; { const int q = nwg / 8, r = nwg % 8, xcd = wgid % 8, off = wgid / 8; wgid = (xcd < r ? xcd * (q + 1) : r * (q + 1) + (xcd - r) * q) + off; }
        u.pm = t_lo + wgid / NPN; u.pn = wgid % NPN; u.aux = 0; return true; } };
struct GateUpSched { MoeOrder<4> o; const bf16_t* hb; const bf16_t* WguT; const int* tokl;
    __device__ __forceinline__ bool next(int i, Unit& u) const { return o.unit(i, u); }
    __device__ __forceinline__ const char* a_base(const Unit&) const { return (const char*)hb; }
    __device__ __forceinline__ const char* b_base(const Unit& u) const { const int e = o.tab[4 + u.pm * 4] & 31; return (const char*)(WguT + (size_t)(e * 1024 + u.pn * 256) * D); }
    __device__ __forceinline__ bool keep_acc(const Unit&) const { return false; }
    __device__ __forceinline__ void a_offs(const Unit& u, int R0, int C0, int R1, int C1, unsigned (&v)[2][2]) const {
        const int L = o.tab[4 + u.pm * 4], row0 = o.tab[4 + u.pm * 4 + 1], nrows = o.tab[4 + u.pm * 4 + 3]; const int* lst = tokl + (size_t)L * T + row0;
#pragma unroll
        for (int h = 0; h < 2; ++h) { const int r0 = R0 + 128 * h, r1 = R1 + 128 * h; const int t0 = r0 < nrows ? lst[r0] : 0, t1 = r1 < nrows ? lst[r1] : 0;
            v[h][0] = ((unsigned)t0 * D + C0) * 2u; v[h][1] = ((unsigned)t1 * D + C1) * 2u; } }
};
struct EpiGateUp { const LAS int* tab; const float* r2l; bf16_t* he;
    __device__ __forceinline__ void operator()(f32x4 (&acc)[2][2][4][2], const Unit& u, int wr, int wc, int fr, int fq) const {
        const int L = tab[4 + u.pm * 4], row0 = tab[4 + u.pm * 4 + 1], slot = tab[4 + u.pm * 4 + 2], nrows = tab[4 + u.pm * 4 + 3];
#pragma unroll
        for (int ai = 0; ai < 2; ++ai)
#pragma unroll
            for (int m = 0; m < 4; ++m) { const int rr = ai * 128 + wr * 64 + m * 16 + fr; const float rs = rr < nrows ? r2l[(size_t)L * T + row0 + rr] : 0.f;
                u32x4 w; unsigned ww[4];
#pragma unroll
                for (int n = 0; n < 2; ++n) { float hv[4];
#pragma unroll
                    for (int j = 0; j < 4; ++j) { const float gt = acc[ai][0][m][n][j] * rs, up = acc[ai][1][m][n][j] * rs; hv[j] = gt * sigmoidf_(gt) * up; }
                    ww[2 * n] = pk2(hv[0], hv[1]); ww[2 * n + 1] = pk2(hv[2], hv[3]); }
                w.x = ww[0]; w.y = ww[1]; w.z = ww[2]; w.w = ww[3];
                *(u32x4*)(he + (size_t)(slot + rr) * 512 + u.pn * 128 + wc * 32 + 8 * fq) = w; }
    } };
__device__ __forceinline__ void p6_gateup(const Params& p, LAS unsigned char* lds) {
    LAS int* tab = (LAS int*)(lds + TAB_OFF); build_tiles(p, tab);
    GateUpSched S; S.o.G = gridDim.x; S.o.c = blockIdx.x; S.o.t_lo = 0; S.o.nt_tiles = tab[0]; S.o.tab = tab;
    S.hb = (const bf16_t*)(p.ws + WS_O); S.WguT = (const bf16_t*)(p.ws + WS_WGU); S.tokl = (const int*)(p.ws + WS_TOK);
    EpiGateUp E{tab, (const float*)(p.ws + WS_R2L), (bf16_t*)(p.ws + WS_HE)};
    pg8::gemm_phase<true, true>(lds, S, E, D / 64, D, D);
}
struct DownSched { MoeOrder<8> o; const bf16_t* he; const bf16_t* WdT;
    __device__ __forceinline__ bool next(int i, Unit& u) const { return o.unit(i, u); }
    __device__ __forceinline__ const char* a_base(const Unit& u) const { return (const char*)(he + (size_t)o.tab[4 + u.pm * 4 + 2] * 512); }
    __device__ __forceinline__ const char* b_base(const Unit& u) const { const int e = o.tab[4 + u.pm * 4] & 31; return (const char*)(WdT + (size_t)(e * 2048 + u.pn * 256) * 512); }
    __device__ __forceinline__ bool keep_acc(const Unit&) const { return false; }
    __device__ __forceinline__ void a_offs(const Unit&, int, int, int, int, unsigned (&)[2][2]) const {}
};
struct EpiDown { const LAS int* tab; bf16_t* ye_lo; bf16_t* ye_hi;
    __device__ __forceinline__ void operator()(f32x4 (&acc)[2][2][4][2], const Unit& u, int wr, int wc, int fr, int fq) const {
        const int slot = tab[4 + u.pm * 4 + 2]; bf16_t* ye = u.pn < 4 ? ye_lo : ye_hi;
        unsigned off = (unsigned)(slot + wr * 64 + fr) * 1024 + (u.pn & 3) * 256 + wc * 32 + 8 * fq;
#pragma unroll
        for (int ai = 0; ai < 2; ++ai) {
#pragma unroll
            for (int m = 0; m < 4; ++m) { asm volatile("" : "+v"(off));
#pragma unroll
                for (int bj = 0; bj < 2; ++bj) { const f32x4 v0 = acc[ai][bj][m][0], v1 = acc[ai][bj][m][1];
                    u32x4 w; w.x = pk2(v0[0], v0[1]); w.y = pk2(v0[2], v0[3]); w.z = pk2(v1[0], v1[1]); w.w = pk2(v1[2], v1[3]);
                    *(u32x4*)(ye + off + bj * 128) = w; }
                off += 16 * 1024; }
            off += 64 * 1024; }
    } };
__device__ __forceinline__ void p7_down(const Params& p, LAS unsigned char* lds) {
    LAS int* tab = (LAS int*)(lds + TAB_OFF); build_tiles(p, tab);
    DownSched S; S.o.G = gridDim.x; S.o.c = blockIdx.x; S.o.t_lo = 0; S.o.nt_tiles = tab[0]; S.o.tab = tab;
    S.he = (const bf16_t*)(p.ws + WS_HE); S.WdT = (const bf16_t*)(p.ws + WS_WD);
    EpiDown E{tab, (bf16_t*)(p.ws + WS_YE_LO), (bf16_t*)(p.ws + WS_YE_HI)};
    pg8::gemm_phase<true, false>(lds, S, E, 512 / 64, 512, 512);
}
__device__ __forceinline__ void p8_combine(const Params& p, LAS unsigned char* lds) {
    LAS int* tab = (LAS int*)(lds + TAB_OFF); build_tiles(p, tab);
    const int tid = phase_tid(), lane = tid & 63, wave = tid >> 6; const int gw = blockIdx.x * 8 + wave, NGW = gridDim.x * 8;
    const int* recc = (const int*)(p.ws + WS_RECC); const float* recw = (const float*)(p.ws + WS_RECW); const bf16_t* hb = (const bf16_t*)(p.ws + WS_O);
    const bf16_t* ye_lo = (const bf16_t*)(p.ws + WS_YE_LO); const bf16_t* ye_hi = (const bf16_t*)(p.ws + WS_YE_HI);
    for (int tok = gw; tok < T; tok += NGW) {
        const int c0 = recc[2 * tok], c1 = recc[2 * tok + 1]; const float wa = recw[2 * tok], wb = recw[2 * tok + 1];
        const int s0 = tab[1400 + (c0 >> 15)] + (c0 & 32767), s1 = tab[1400 + (c1 >> 15)] + (c1 & 32767);
        f32x4* op = (f32x4*)(p.out + (size_t)tok * D) + lane; const u32x2* hp = (const u32x2*)(hb + (size_t)tok * D) + lane;
        u32x2 m[8], a[8], b[8];
#pragma unroll
        for (int j = 0; j < 8; ++j) { const bf16_t* yb = j < 4 ? ye_lo : ye_hi; m[j] = hp[64 * j];
            a[j] = ((const u32x2*)(yb + (size_t)s0 * 1024) + lane)[64 * (j & 3)]; b[j] = ((const u32x2*)(yb + (size_t)s1 * 1024) + lane)[64 * (j & 3)]; }
#pragma unroll
        for (int j = 0; j < 8; ++j) { f32x4 v;
            v.x = __uint_as_float(m[j].x << 16) + wa * __uint_as_float(a[j].x << 16) + wb * __uint_as_float(b[j].x << 16); v.y = __uint_as_float(m[j].x & 0xffff0000u) + wa * __uint_as_float(a[j].x & 0xffff0000u) + wb * __uint_as_float(b[j].x & 0xffff0000u);
            v.z = __uint_as_float(m[j].y << 16) + wa * __uint_as_float(a[j].y << 16) + wb * __uint_as_float(b[j].y << 16); v.w = __uint_as_float(m[j].y & 0xffff0000u) + wa * __uint_as_float(a[j].y & 0xffff0000u) + wb * __uint_as_float(b[j].y & 0xffff0000u);
            op[64 * j] = v; }
    }
}

#define XB_TMO      128
#define XB_XCNT(j)  (256  + 64 * (j))
#define XB_XSUB(j)  (1280 + 64 * (j))
#define XB_XGEN(j)  (2304 + 64 * (j))
#define XB_TOP      3328
#define XB_TOPGEN   3392
#define XCD_BAR_WORDS 3456
#define XB_SPIN_CAP (1u << 18)
__device__ __forceinline__ unsigned xb_ld(unsigned* p)              { return __hip_atomic_load(p, __ATOMIC_RELAXED, __HIP_MEMORY_SCOPE_AGENT); }
__device__ __forceinline__ unsigned xb_add(unsigned* p, unsigned v) { return __hip_atomic_fetch_add(p, v, __ATOMIC_RELAXED, __HIP_MEMORY_SCOPE_AGENT); }
__device__ __forceinline__ unsigned xb_xcc_id() { return (unsigned)__builtin_amdgcn_s_getreg((3 << 11) | 20) & 0xFu; }
#define XB_SPIN(cond, bar) do { unsigned _sp = 0; while (cond) { __builtin_amdgcn_s_sleep(1); \
    if ((++_sp & 255u) == 0u) { if (xb_ld(&(bar)[XB_TMO])) break; if (_sp > XB_SPIN_CAP) { atomicAdd(&(bar)[XB_TMO], 1u); break; } } } } while (0)
struct XcdBarrier { unsigned* bar; unsigned x; volatile LAS unsigned* st; };
__device__ __forceinline__ XcdBarrier xcd_barrier_post(unsigned* bar, volatile LAS unsigned* st) {
    XcdBarrier b; b.bar = bar; b.x = xb_xcc_id(); b.st = st;
    if (threadIdx.x == 0) (void)xb_add(&bar[XB_XCNT(b.x)], 1u);
    return b;
}
__device__ __forceinline__ void xcd_barrier_complete(unsigned* bar, unsigned x, unsigned& nloc, unsigned& nx) {
    const unsigned G = gridDim.x * gridDim.y * gridDim.z;
    unsigned sum, cnt, mine, sp = 0u;
    for (;;) {
        sum = 0u; cnt = 0u; mine = 0u;
#pragma unroll
        for (unsigned j = 0; j < 16; ++j) { const unsigned c = xb_ld(&bar[XB_XCNT(j)]); sum += c; cnt += (c > 0u) ? 1u : 0u; mine = (j == x) ? c : mine; }
        if (sum == G) break;
        __builtin_amdgcn_s_sleep(1);
        if ((++sp & 255u) == 0u) { if (xb_ld(&bar[XB_TMO])) break; if (sp > XB_SPIN_CAP) { atomicAdd(&bar[XB_TMO], 1u); break; } }
    }
    nloc = mine > 0u ? mine : 1u; nx = cnt > 0u ? cnt : 1u;
}
__device__ __forceinline__ void xcd_barrier(const XcdBarrier& b) {
    asm volatile("s_waitcnt vmcnt(0)" ::: "memory");
    __syncthreads();
    if (threadIdx.x == 0) {
        unsigned* bar = b.bar;
        __builtin_amdgcn_s_waitcnt(0);
        unsigned nloc = b.st[0], nx = b.st[1];
        if (nloc == 0u) { xcd_barrier_complete(bar, b.x, nloc, nx); b.st[0] = nloc; b.st[1] = nx; }
        const unsigned old = xb_add(&bar[XB_XSUB(b.x)], 1u);
        const unsigned gen = old / nloc;
        if (old + 1u == (gen + 1u) * nloc) {
            __builtin_amdgcn_fence(__ATOMIC_RELEASE, "agent");
            asm volatile("s_waitcnt vmcnt(0)" ::: "memory");
            const unsigned og = xb_add(&bar[XB_TOP], 1u);
            const unsigned tg = og / nx;
            if (og + 1u == (tg + 1u) * nx) xb_add(&bar[XB_TOPGEN], 1u);
            else XB_SPIN(xb_ld(&bar[XB_TOPGEN]) == tg, bar);
            __builtin_amdgcn_fence(__ATOMIC_ACQUIRE, "agent");
            xb_add(&bar[XB_XGEN(b.x)], 1u);
            asm volatile("s_waitcnt vmcnt(0)" ::: "memory");
        } else {
            XB_SPIN(xb_ld(&bar[XB_XGEN(b.x)]) == gen, bar);
            __builtin_amdgcn_fence(__ATOMIC_ACQUIRE, "agent");
            asm volatile("s_waitcnt vmcnt(0)" ::: "memory");
        }
    }
    __syncthreads();
}

namespace cg = cooperative_groups;
#ifdef PROBE_A
#define STAMP(k) do { if (blockIdx.x == 0 && threadIdx.x == 0) ((unsigned long long*)(p.ws + WS_END))[k] = __builtin_amdgcn_s_memrealtime(); } while (0)
#else
#define STAMP(k) do {} while (0)
#endif
__global__ void __launch_bounds__(512, 2) fwd_megakernel(Params p) {
    extern __shared__ __attribute__((aligned(16))) unsigned char lds_raw[];
    LAS unsigned char* lds = (LAS unsigned char*)lds_raw;
    cg::grid_group grid = cg::this_grid();
    if (threadIdx.x == 0) { *(volatile LAS unsigned*)(lds + XBST_OFF) = 0u; *(volatile LAS unsigned*)(lds + XBST_OFF + 4) = 0u; }
    if (blockIdx.x == 0) for (int i = threadIdx.x; i < XCD_BAR_WORDS; i += 512) ((unsigned*)(p.ws + WS_BAR))[i] = 0u;
    __syncthreads();
#define GSYNC() xcd_barrier(xb)
    STAMP(0);
    p0_prep(p, lds);            grid.sync(); STAMP(1);
    const XcdBarrier xb = xcd_barrier_post((unsigned*)(p.ws + WS_BAR), (volatile LAS unsigned*)(lds + XBST_OFF));
    p1_inproj(p, lds);          GSYNC(); STAMP(2);
    p2_attn(p, lds);            GSYNC(); STAMP(3);
    p_moe_prep(p, lds);         STAMP(4);
    p3_up(p, lds);              GSYNC(); STAMP(5);
    p4_out(p, lds);             GSYNC(); STAMP(6);
    p5_router(p, lds);          GSYNC(); STAMP(7);
    p6_gateup(p, lds);          GSYNC(); STAMP(8);
    p7_down(p, lds);            GSYNC(); STAMP(9);
    p8_combine(p, lds);
#ifdef PROBE_A
    grid.sync(); STAMP(10); grid.sync();
    {
        const unsigned long long* ts = (const unsigned long long*)(p.ws + WS_END);
        #ifndef PROBE_A1
#define PROBE_A1 (PROBE_A + 1)
#endif
#ifndef PROBE_B1
#define PROBE_B1 (PROBE_B + 1)
#endif
        const float usA = (float)(ts[PROBE_A1] - ts[PROBE_A]) * 0.01f, usB = (float)(ts[PROBE_B1] - ts[PROBE_B]) * 0.01f;
        const float eps = sqrtf(usA * 1e-6f);
        for (size_t i = (size_t)blockIdx.x * 512 + threadIdx.x; i < (size_t)T * D / 4; i += (size_t)gridDim.x * 512) { f32x4 v = ((f32x4*)p.out)[i]; v = v * (1.0f + eps); if (i == 0) v.x += usB * 0.1f; ((f32x4*)p.out)[i] = v; }
    }
#endif
}

extern "C" void kernel_launch(void* const* d_in, const int* in_sizes, int n_in, void* d_out, int out_size, void* d_ws, size_t ws_size, hipStream_t stream) {
    static int grid_blocks = 0;
    if (!grid_blocks) {
        if (n_in != 21 || out_size != T * D || ws_size < WS_MOB + 128 * MiB) { fprintf(stderr, "kernel_launch: unexpected problem (n_in %d out %d ws %zu)\n", n_in, out_size, ws_size); grid_blocks = -1; return; }
        if (hipFuncSetAttribute((const void*)fwd_megakernel, hipFuncAttributeMaxDynamicSharedMemorySize, LDS_BYTES) != hipSuccess) { fprintf(stderr, "kernel_launch: hipFuncSetAttribute failed\n"); grid_blocks = -1; return; }
        int dev = 0, cus = 0, per_cu = 0;
        hipGetDevice(&dev); hipDeviceGetAttribute(&cus, hipDeviceAttributeMultiprocessorCount, dev);
        hipOccupancyMaxActiveBlocksPerMultiprocessor(&per_cu, (const void*)fwd_megakernel, 512, LDS_BYTES);
        if (per_cu < 1 || cus < 1) { fprintf(stderr, "kernel_launch: occupancy query gave %d blocks/CU on %d CUs\n", per_cu, cus); grid_blocks = -1; return; }
        grid_blocks = cus;
    }
    if (grid_blocks < 0) return;
    Params p{};
    for (int i = 0; i < 21; ++i) p.in[i] = (const float*)d_in[i];
    p.out = (float*)d_out; p.ws = (unsigned char*)d_ws;
    void* args[] = {&p};
    hipError_t e = hipLaunchCooperativeKernel((const void*)fwd_megakernel, dim3(grid_blocks), dim3(512), args, LDS_BYTES, stream);
    if (e != hipSuccess) fprintf(stderr, "cooperative launch failed: %s (grid %d)\n", hipGetErrorString(e), grid_blocks);
}
```

```cpp
#include <hip/hip_runtime.h>
#include <hip/hip_cooperative_groups.h>
#include <cstdio>
#include <cstdint>

#define LAS __attribute__((address_space(3)))
typedef unsigned short bf16_t;
typedef short bf16x8 __attribute__((ext_vector_type(8)));
typedef short s16x4 __attribute__((ext_vector_type(4)));
typedef float f32x4 __attribute__((ext_vector_type(4)));
typedef unsigned u32x4 __attribute__((ext_vector_type(4)));
typedef unsigned u32x2 __attribute__((ext_vector_type(2)));
typedef short v4i16_t __attribute__((ext_vector_type(4)));

namespace cfg {
constexpr int T = 32768, D = 2048, SEQ = 16384;
constexpr int NQKV = 4608, NGATE = 4096, NIN = 8704;
constexpr size_t MiB = 1ull << 20;
constexpr size_t WS_XB = 0, WS_QKV = 128 * MiB, WS_GATES = 416 * MiB, WS_O = 672 * MiB, WS_WIN = 800 * MiB, WS_WUP = 834 * MiB, WS_WOUT = 842 * MiB, WS_MISC = 850 * MiB;
constexpr size_t WS_WGU = WS_QKV, WS_WD = WS_QKV + 128 * MiB, WS_HE = WS_QKV + 192 * MiB;
constexpr size_t WS_R1 = WS_MISC, WS_R2 = WS_R1 + (size_t)T * 4, WS_WRT = WS_R2 + (size_t)T * 4, WS_CNT = WS_WRT + 512 * 1024, WS_TOK = WS_CNT + 4096,
                 WS_RECC = WS_TOK + 32ull * T * 4, WS_RECW = WS_RECC + 2ull * T * 4, WS_R2L = WS_RECW + 2ull * T * 4, WS_END = WS_R2L + 32ull * T * 4;
constexpr size_t WS_H8 = WS_GATES + 144 * MiB;
constexpr size_t WS_YE_LO = 0, WS_YE_HI = WS_GATES;
constexpr size_t WS_BAR = WS_END + 4096;
constexpr size_t WS_MOB = 872 * MiB;
constexpr int LDS_BYTES = 140 * 1024;
constexpr int XBST_OFF = LDS_BYTES - 16;
constexpr int TAB_OFF = 132 * 1024;
constexpr float EPS = 1e-6f;
}
using namespace cfg;

struct Params { const float* in[21]; float* out; unsigned char* ws; };
__device__ __forceinline__ int phase_tid() { int t = threadIdx.x; asm volatile("" : "+v"(t)); return t; }

__device__ __forceinline__ float bf2f(short s) { return __uint_as_float(((unsigned)(unsigned short)s) << 16); }
typedef float f32x2 __attribute__((ext_vector_type(2)));
typedef __bf16 bf16x2_t __attribute__((ext_vector_type(2)));
__device__ __forceinline__ unsigned pk2(float lo, float hi) { const f32x2 v = {lo, hi}; return __builtin_bit_cast(unsigned, __builtin_convertvector(v, bf16x2_t)); }
__device__ __forceinline__ unsigned pk4_fp8(float a, float b, float c, float d) { int w = 0; w = __builtin_amdgcn_cvt_pk_fp8_f32(a, b, w, false); w = __builtin_amdgcn_cvt_pk_fp8_f32(c, d, w, true); return (unsigned)w; }
__device__ __forceinline__ float wave_sum(float v) {
#pragma unroll
    for (int o = 1; o < 64; o <<= 1) v += __shfl_xor(v, o);
    return v;
}
__device__ __forceinline__ float sigmoidf_(float v) { return 1.0f / (1.0f + __expf(-v)); }
__device__ __forceinline__ unsigned off_b(unsigned row, unsigned ch) { return 256u * row + 16u * (ch ^ (((row & 3) << 2) | ((row >> 2) & 3))); }
__device__ __forceinline__ s16x4 tr_read(LAS unsigned char* p) { return __builtin_bit_cast(s16x4, __builtin_amdgcn_ds_read_tr16_b64_v4i16((LAS v4i16_t*)p)); }
__host__ __device__ __forceinline__ int perm32(int rho) { const int n = rho >> 4, i = rho & 15; return 8 * (i >> 2) + 4 * n + (i & 3); }
__device__ __forceinline__ int t5_bucket(int rel) {
    const int n = rel < 0 ? -rel : rel; const int ret = rel > 0 ? 16 : 0; int b;
    if (n < 8) b = n; else if (n < 12) b = 8; else if (n < 16) b = 9; else if (n < 23) b = 10; else if (n < 32) b = 11; else if (n < 46) b = 12; else if (n < 64) b = 13; else if (n < 91) b = 14; else b = 15;
    return ret + b;
}

template <bool FP8>
__device__ __forceinline__ void transpose_item(const float* __restrict__ W, int ldw, int k0, int n0, bf16_t* __restrict__ WT, int ldt, int drow0, int dk0, const float* __restrict__ scale, LAS unsigned* scr, int lane, float f8scale = 1.f) {
    const int n4 = (lane & 15) * 4, kk = lane >> 4;
    const float* src = W + (size_t)(k0 + 2 * kk) * ldw + n0 + n4;
    f32x4 ev[8], od[8];
#pragma unroll
    for (int j = 0; j < 8; ++j) { ev[j] = *(const f32x4*)(src + (size_t)(8 * j) * ldw); od[j] = *(const f32x4*)(src + (size_t)(8 * j + 1) * ldw); }
#pragma unroll
    for (int j = 0; j < 8; ++j) { f32x4 e = ev[j], o = od[j];
        if (scale) { const float se = scale[k0 + 8 * j + 2 * kk], so = scale[k0 + 8 * j + 2 * kk + 1]; e = e * se; o = o * so; }
        u32x4 w; w.x = pk2(e.x, o.x); w.y = pk2(e.y, o.y); w.z = pk2(e.z, o.z); w.w = pk2(e.w, o.w);
        *(LAS u32x4*)(scr + (4 * j + kk) * 68 + n4) = w; }
    asm volatile("s_waitcnt lgkmcnt(0)" ::: "memory");
    const int kq = lane & 7;
#pragma unroll
    for (int i = 0; i < 8; ++i) { const int n = (lane >> 3) + 8 * i; const LAS unsigned* q = scr + (4 * kq) * 68 + n;
        u32x4 o; o.x = q[0]; o.y = q[68]; o.z = q[136]; o.w = q[204];
        if (FP8) { u32x2 f; f.x = pk4_fp8(__uint_as_float(o.x << 16) * f8scale, __uint_as_float(o.x & 0xffff0000u) * f8scale, __uint_as_float(o.y << 16) * f8scale, __uint_as_float(o.y & 0xffff0000u) * f8scale);
            f.y = pk4_fp8(__uint_as_float(o.z << 16) * f8scale, __uint_as_float(o.z & 0xffff0000u) * f8scale, __uint_as_float(o.w << 16) * f8scale, __uint_as_float(o.w & 0xffff0000u) * f8scale);
            *(u32x2*)((unsigned char*)WT + (size_t)(drow0 + n) * ldt + dk0 + k0 + 8 * kq) = f; }
        else *(u32x4*)(WT + (size_t)(drow0 + n) * ldt + dk0 + k0 + 8 * kq) = o; }
    asm volatile("s_waitcnt lgkmcnt(0)" ::: "memory");
}

__device__ __forceinline__ void p0_prep(const Params& p, LAS unsigned char* lds) {
    const int tid = phase_tid(), lane = tid & 63, wave = tid >> 6;
    const int gw = blockIdx.x * 8 + wave, NGW = gridDim.x * 8;
    LAS unsigned* scr = (LAS unsigned*)(lds + wave * 8704);
    const float* x = p.in[0]; const float* g1 = p.in[1]; const float* w_in = p.in[2];
    bf16_t* xb = (bf16_t*)(p.ws + WS_XB); float* r1 = (float*)(p.ws + WS_R1);
    bf16_t* WinT = (bf16_t*)(p.ws + WS_WIN); bf16_t* WupT = (bf16_t*)(p.ws + WS_WUP); bf16_t* WoutT = (bf16_t*)(p.ws + WS_WOUT);
    constexpr int I_WIN = 32 * 136, I_UP = 16 * 32, I_OUT = 32 * 32, NITEMS = I_WIN + 2 * I_UP + I_OUT;
    for (int it = gw; it < NITEMS; it += NGW) {
        int r = it;
        if (r < I_WIN) { const int kb = r / 136, nb = r % 136; const int n0 = nb * 64; int drow = n0;
            if (n0 >= NQKV) { const int c = (n0 - NQKV) & 2047, isb = (n0 - NQKV) >> 11; drow = NQKV + (c >> 7) * 256 + isb * 128 + (c & 127); }
            transpose_item<false>(w_in, NIN, kb * 64, n0, WinT, 2048, drow, 0, g1, scr, lane); continue; } r -= I_WIN;
        if (r < I_UP) { const int kb = r / 32, nb = r % 32; transpose_item<false>(p.in[9], 2048, kb * 64, nb * 64, WupT, 2048, nb * 64, 0, nullptr, scr, lane); continue; } r -= I_UP;
        if (r < I_UP) { const int kb = r / 32, nb = r % 32; transpose_item<false>(p.in[10], 2048, kb * 64, nb * 64, WupT, 2048, nb * 64, 1024, nullptr, scr, lane); continue; } r -= I_UP;
        { const int kb = r / 32, nb = r % 32; transpose_item<false>(p.in[11], 2048, kb * 64, nb * 64, WoutT, 2048, nb * 64, 0, nullptr, scr, lane); }
    }
    { bf16_t* whi = (bf16_t*)(p.ws + WS_WRT); bf16_t* wlo = whi + 48 * 2048; const float* g2 = p.in[13]; const float* wrg = p.in[14]; const float* wre = p.in[16];
      for (int i = blockIdx.x * 512 + tid; i < 48 * 2048; i += gridDim.x * 512) { const int row = i >> 11, k = i & 2047, t = row >> 4, r = row & 15; float w;
          if (t == 0) w = wre[k * 32 + (r >> 2) * 8 + (r & 3)]; else if (t == 1) w = wre[k * 32 + (r >> 2) * 8 + 4 + (r & 3)]; else w = (r & 3) == 0 ? wrg[k * 4 + (r >> 2)] : 0.f;
          w *= g2[k]; const unsigned hi = pk2(w, 0.f) & 0xffffu; const float hf = __uint_as_float(hi << 16); whi[i] = (bf16_t)hi; wlo[i] = (bf16_t)(pk2(w - hf, 0.f) & 0xffffu); } }
    if (blockIdx.x == 0 && tid < 32) ((int*)(p.ws + WS_CNT))[tid] = 0;
    for (int row0 = 2 * gw; row0 < T; row0 += 2 * NGW) {
        f32x4 v[2][8]; float ss[2] = {0.f, 0.f};
#pragma unroll
        for (int u = 0; u < 2; ++u) { const f32x4* xr = (const f32x4*)(x + (size_t)(row0 + u) * D) + lane;
#pragma unroll
            for (int j = 0; j < 8; ++j) v[u][j] = xr[64 * j]; }
#pragma unroll
        for (int u = 0; u < 2; ++u) {
#pragma unroll
            for (int j = 0; j < 8; ++j) ss[u] += (v[u][j].x * v[u][j].x + v[u][j].y * v[u][j].y) + (v[u][j].z * v[u][j].z + v[u][j].w * v[u][j].w);
            ss[u] = wave_sum(ss[u]);
            if (lane == 0) r1[row0 + u] = rsqrtf(ss[u] * (1.0f / D) + EPS);
            u32x2* o = (u32x2*)(xb + (size_t)(row0 + u) * D) + lane;
#pragma unroll
            for (int j = 0; j < 8; ++j) { u32x2 w; w.x = pk2(v[u][j].x, v[u][j].y); w.y = pk2(v[u][j].z, v[u][j].w); o[64 * j] = w; } }
    }
}

__device__ __forceinline__ void p_moe_prep(const Params& p, LAS unsigned char* lds) {
    const int tid = phase_tid(), lane = tid & 63, wave = tid >> 6;
    const int gw = blockIdx.x * 8 + wave, NGW = gridDim.x * 8;
    LAS unsigned* scr = (LAS unsigned*)(lds + wave * 8704);
    const float* g2 = p.in[13];
    bf16_t* WguT = (bf16_t*)(p.ws + WS_WGU); bf16_t* WdT = (bf16_t*)(p.ws + WS_WD);
    constexpr int I_G = 32 * 32 * 8;
    constexpr int I_D = 32 * 8 * 32;
    for (int it = gw; it < 2 * I_G + I_D; it += NGW) {
        int r = it;
        if (r < 2 * I_G) { const int which = r >= I_G; if (which) r -= I_G; const int e = r / 256, rr = r % 256, kb = rr / 8, nb = rr % 8;
            const float* W = p.in[which ? 19 : 18] + (size_t)e * 2048 * 512; const int n0 = nb * 64;
            transpose_item<true>(W, 512, kb * 64, n0, WguT, 2048, e * 1024 + (n0 >> 7) * 256 + which * 128 + (n0 & 127), 0, g2, scr, lane, 64.f); continue; }
        r -= 2 * I_G;
        { const int e = r / 256, rr = r % 256, kb = rr / 32, nb = rr % 32; const float* W = p.in[20] + (size_t)e * 512 * 2048;
          transpose_item<false>(W, 2048, kb * 64, nb * 64, WdT, 512, e * 2048 + nb * 64, 0, nullptr, scr, lane); }
    }
}

struct Unit { int pm, pn, aux; };
namespace pg8 {
constexpr int BM = 256, BK = 64, HALF = 128, HTB = HALF * BK * 2, STAGE_BYTES = 8 * HTB;
__device__ __forceinline__ int lds_byte(int r, int c) { const int st = (r >> 4) * 2 + (c >> 5), rr = r & 15, cc = c & 31, ob = rr * 64 + cc * 2; return st * 1024 + (ob ^ (((ob >> 9) & 1) << 5)); }
__device__ __forceinline__ void stage_rc(int b, int& R, int& C) { const int st = b / 1024, sb = b % 1024, swz = sb ^ (((sb >> 9) & 1) << 5); R = (st >> 1) * 16 + swz / 64; C = (st & 1) * 32 + (swz % 64) / 2; }

template <bool PERM, bool GATHER, class Sched, class Epi, bool FP8 = false>
__device__ __forceinline__ void gemm_phase(LAS unsigned char* lds, const Sched& S, const Epi& E, const int nt, const int lda, const int ldb) {
    int tid_ = threadIdx.x; asm volatile("" : "+v"(tid_));
    const int tid = tid_, wid = __builtin_amdgcn_readfirstlane(tid >> 6), lane = tid & 63, wr = wid >> 2, wc = wid & 3, fr = lane & 15, fq = lane >> 4;
    int R0, C0, R1, C1; stage_rc(tid * 16, R0, C0); stage_rc(tid * 16 + 8192, R1, C1);
    unsigned voffB[2], voffA[2][2];
    { const int Rb0 = PERM ? ((R0 & ~31) + perm32(R0 & 31)) : R0, Rb1 = PERM ? ((R1 & ~31) + perm32(R1 & 31)) : R1;
      voffB[0] = (unsigned)(Rb0 * ldb + C0) * 2u; voffB[1] = (unsigned)(Rb1 * ldb + C1) * 2u; }
    const size_t kstep = (size_t)(BK * 2);
    const size_t hstepB = (size_t)HALF * ldb * 2;
    const unsigned ldsw = (unsigned)wid * 1024u;
    const int aoff = lds_byte(wr * 64 + fr, fq * 8), boff = lds_byte(wc * 32 + fr, fq * 8);
#define PG8_SA(b, h) (((b) * 2 + (h)) * HTB)
#define PG8_SB(b, h) ((4 + (b) * 2 + (h)) * HTB)
#define PG8_STAGE_B(bufoff, gbase) do { _Pragma("unroll") for (int _i = 0; _i < 2; ++_i) \
        __builtin_amdgcn_global_load_lds((const unsigned*)((const char*)(gbase) + voffB[_i]), (LAS unsigned*)(lds + (bufoff) + ldsw + _i * 8192), 16, 0, 0); } while (0)
#define PG8_STAGE_A(bufoff, gbase, h) do { _Pragma("unroll") for (int _i = 0; _i < 2; ++_i) \
        __builtin_amdgcn_global_load_lds((const unsigned*)((const char*)(gbase) + voffA[h][_i]), (LAS unsigned*)(lds + (bufoff) + ldsw + _i * 8192), 16, 0, 0); } while (0)
#define PG8_LDA(dst, b, h) do { _Pragma("unroll") for (int m = 0; m < 4; ++m) _Pragma("unroll") for (int k = 0; k < 2; ++k) dst[m][k] = *(const LAS bf16x8*)(lds + PG8_SA(b, h) + aoff + m * 2048 + k * 1024); } while (0)
#define PG8_LDB(dst, b, h) do { _Pragma("unroll") for (int n = 0; n < 2; ++n) _Pragma("unroll") for (int k = 0; k < 2; ++k) dst[n][k] = *(const LAS bf16x8*)(lds + PG8_SB(b, h) + boff + n * 2048 + k * 1024); } while (0)
#define PG8_MMA(ai, bj, At, Bt) do { __builtin_amdgcn_s_setprio(1); _Pragma("unroll") for (int m = 0; m < 4; ++m) _Pragma("unroll") for (int n = 0; n < 2; ++n) { \
        if (FP8) { typedef int v8i_ __attribute__((ext_vector_type(8))); typedef int v4i_ __attribute__((ext_vector_type(4))); \
            const v4i_ b0_ = __builtin_bit_cast(v4i_, Bt[n][0]), b1_ = __builtin_bit_cast(v4i_, Bt[n][1]), a0_ = __builtin_bit_cast(v4i_, At[m][0]), a1_ = __builtin_bit_cast(v4i_, At[m][1]); \
            const v8i_ bb_ = {b0_[0], b0_[1], b0_[2], b0_[3], b1_[0], b1_[1], b1_[2], b1_[3]}, aa_ = {a0_[0], a0_[1], a0_[2], a0_[3], a1_[0], a1_[1], a1_[2], a1_[3]}; \
            acc[ai][bj][m][n] = __builtin_amdgcn_mfma_scale_f32_16x16x128_f8f6f4(bb_, aa_, acc[ai][bj][m][n], 0, 0, 0, 0x7f7f7f7f, 0, 0x7f7f7f7f); } \
        else { _Pragma("unroll") for (int k = 0; k < 2; ++k) acc[ai][bj][m][n] = __builtin_amdgcn_mfma_f32_16x16x32_bf16(Bt[n][k], At[m][k], acc[ai][bj][m][n], 0, 0, 0); } } \
        __builtin_amdgcn_s_setprio(0); } while (0)
#define PG8_WAIT_V(n) asm volatile("s_waitcnt vmcnt(" #n ")" ::: "memory")
#define PG8_WAIT_L(n) asm volatile("s_waitcnt lgkmcnt(" #n ")" ::: "memory")
#define PG8_BAR __builtin_amdgcn_s_barrier()
#define PG8_SCHED __builtin_amdgcn_sched_barrier(0)
    Unit cur, nxt; int ui = 0;
    __syncthreads();
    if (!S.next(0, cur)) return;
    if (GATHER) S.a_offs(cur, R0, C0, R1, C1, voffA);
    else { voffA[0][0] = (unsigned)(R0 * lda + C0) * 2u; voffA[0][1] = (unsigned)(R1 * lda + C1) * 2u; voffA[1][0] = voffA[0][0] + (unsigned)(HALF * lda * 2); voffA[1][1] = voffA[0][1] + (unsigned)(HALF * lda * 2); }
    f32x4 acc[2][2][4][2];
#pragma unroll
    for (int a = 0; a < 2; ++a)
#pragma unroll
        for (int b = 0; b < 2; ++b)
#pragma unroll
            for (int m = 0; m < 4; ++m)
#pragma unroll
                for (int n = 0; n < 2; ++n) acc[a][b][m][n] = (f32x4){0.f, 0.f, 0.f, 0.f};
    bf16x8 At[4][2], B0[2][2], B1[2][2];
    const char* cA = S.a_base(cur); const char* cB = S.b_base(cur);
    PG8_STAGE_B(PG8_SB(0, 0), cB); PG8_STAGE_B(PG8_SB(0, 1), cB + hstepB); PG8_STAGE_A(PG8_SA(0, 0), cA, 0); PG8_STAGE_A(PG8_SA(0, 1), cA, 1);
    if (wr == 1) PG8_BAR;
    PG8_WAIT_V(2); PG8_BAR;
    PG8_STAGE_B(PG8_SB(1, 0), cB + kstep); PG8_STAGE_A(PG8_SA(1, 0), cA + kstep, 0); PG8_STAGE_B(PG8_SB(1, 1), cB + hstepB + kstep);
    PG8_WAIT_V(6); PG8_BAR;
    for (;;) {
        const bool has_next = S.next(ui + 1, nxt);
        const char* nA = has_next ? S.a_base(nxt) : cA; const char* nB = has_next ? S.b_base(nxt) : cB;
        unsigned vn[2][2];
        if (GATHER) { if (has_next) S.a_offs(nxt, R0, C0, R1, C1, vn); else { vn[0][0] = voffA[0][0]; vn[0][1] = voffA[0][1]; vn[1][0] = voffA[1][0]; vn[1][1] = voffA[1][1]; } }
        for (int t = 0; t < nt; t += 2) {
            const bool last = (t == nt - 2);
            const char* a1 = cA + (size_t)(t + 1) * kstep;
            const char* a2 = last ? nA : cA + (size_t)(t + 2) * kstep; const char* b2 = last ? nB : cB + (size_t)(t + 2) * kstep;
            const char* a3 = a2 + kstep; const char* b3 = b2 + kstep;
            PG8_LDB(B0, 0, 0); PG8_LDB(B1, 0, 1); PG8_SCHED; PG8_LDA(At, 0, 0); PG8_STAGE_A(PG8_SA(1, 1), a1, 1);
            if (GATHER) { if (last) { voffA[0][0] = vn[0][0]; voffA[0][1] = vn[0][1]; voffA[1][0] = vn[1][0]; voffA[1][1] = vn[1][1]; } }
            PG8_WAIT_V(8); PG8_WAIT_L(0); PG8_BAR; PG8_MMA(0, 0, At, B0); PG8_MMA(0, 1, At, B1); PG8_BAR; PG8_SCHED;
            PG8_LDA(At, 0, 1); PG8_STAGE_B(PG8_SB(0, 0), b2); PG8_STAGE_B(PG8_SB(0, 1), b2 + hstepB); PG8_STAGE_A(PG8_SA(0, 0), a2, 0);
            PG8_WAIT_V(8); PG8_WAIT_L(0); PG8_BAR; PG8_MMA(1, 0, At, B0); PG8_MMA(1, 1, At, B1); PG8_BAR; PG8_SCHED;
            PG8_LDB(B0, 1, 0); PG8_LDB(B1, 1, 1); PG8_SCHED; PG8_LDA(At, 1, 0); PG8_STAGE_A(PG8_SA(0, 1), a2, 1);
            PG8_WAIT_V(8); PG8_WAIT_L(0); PG8_BAR; PG8_MMA(0, 0, At, B0); PG8_MMA(0, 1, At, B1); PG8_BAR; PG8_SCHED;
            PG8_LDA(At, 1, 1); PG8_STAGE_B(PG8_SB(1, 0), b3); PG8_STAGE_B(PG8_SB(1, 1), b3 + hstepB); PG8_STAGE_A(PG8_SA(1, 0), a3, 0);
            PG8_WAIT_V(8); PG8_WAIT_L(0); PG8_BAR; PG8_MMA(1, 0, At, B0); PG8_MMA(1, 1, At, B1); PG8_BAR; PG8_SCHED;
        }
        if (wr == 0) PG8_BAR;
        E(acc, cur, wr, wc, fr, fq);
        if (!has_next) break;
        if (!S.keep_acc(cur)) {
#pragma unroll
        for (int a = 0; a < 2; ++a)
#pragma unroll
            for (int b = 0; b < 2; ++b)
#pragma unroll
                for (int m = 0; m < 4; ++m)
#pragma unroll
                    for (int n = 0; n < 2; ++n) acc[a][b][m][n] = (f32x4){0.f, 0.f, 0.f, 0.f};
        }
        cur = nxt; cA = nA; cB = nB; ++ui;
        if (wr == 1) PG8_BAR;
    }
    PG8_WAIT_V(0);
    PG8_BAR;
#undef PG8_SA
#undef PG8_SB
#undef PG8_STAGE_A
#undef PG8_STAGE_B
#undef PG8_LDA
#undef PG8_LDB
#undef PG8_MMA
#undef PG8_WAIT_V
#undef PG8_WAIT_L
#undef PG8_BAR
#undef PG8_SCHED
}
struct TileOrder {
    int nM, nN, nwg, G, c;
    __device__ __forceinline__ void init(int nM_, int nN_, int G_, int c_) { nM = nM_; nN = nN_; nwg = nM * nN; G = G_; c = c_; }
    __device__ __forceinline__ bool tile(int i, int& pm, int& pn) const {
        const long L = (long)i * G + c; if (L >= nwg) return false;
        int wgid = (int)L; { const int q = nwg / 8, r = nwg % 8, xcd = wgid % 8, off = wgid / 8; wgid = (xcd < r ? xcd * (q + 1) : r * (q + 1) + (xcd - r) * q) + off; }
        const int nig = 8 * nN, gid = wgid / nig, fm = gid * 8, gsz = (nM - fm) < 8 ? (nM - fm) : 8;
        pm = fm + ((wgid % nig) % gsz); pn = (wgid % nig) / gsz; return true;
    }
};
struct DenseSched {
    TileOrder o; const bf16_t* A; const bf16_t* Bt; int lda, ldb;
    __device__ __forceinline__ bool next(int i, Unit& u) const { u.aux = 0; return o.tile(i, u.pm, u.pn); }
    __device__ __forceinline__ const char* a_base(const Unit& u) const { return (const char*)(A + (size_t)u.pm * 256 * lda); }
    __device__ __forceinline__ const char* b_base(const Unit& u) const { return (const char*)(Bt + (size_t)u.pn * 256 * ldb); }
    __device__ __forceinline__ bool keep_acc(const Unit&) const { return false; }
    __device__ __forceinline__ void a_offs(const Unit&, int, int, int, int, unsigned (&)[2][2]) const {}
};
}

struct EpiInProj { bf16_t* qkv; bf16_t* gates; const float* r1; const float* gqa; const float* gka; const float* gqb; const float* gkb; LAS float* X;
    __device__ __forceinline__ void operator()(f32x4 (&acc)[2][2][4][2], const Unit& u, int wr, int wc, int fr, int fq) const {
        const int pn = u.pn;
        const bool isg = pn >= 18; bf16_t* base = isg ? gates : qkv; const int ldc = isg ? NGATE : NQKV; const int colt = (isg ? pn - 18 : pn) * 256 + wc * 32 + 8 * fq;
        const float* gain = pn < 4 ? gqa : (pn == 4 ? gka : ((pn >= 6 && pn < 10) ? gqb : ((pn >= 10 && pn < 14) ? gkb : nullptr)));
        if (gain) {
            const float extra = (pn < 4 || (pn >= 6 && pn < 10)) ? 0.08838834764831845f * 1.4426950408889634f : 1.0f;
#pragma unroll
            for (int ai = 0; ai < 2; ++ai)
#pragma unroll
                for (int m = 0; m < 4; ++m)
#pragma unroll
                    for (int bj = 0; bj < 2; ++bj) { const f32x4 a0 = acc[ai][bj][m][0], a1 = acc[ai][bj][m][1];
                        float sq = (a0[0] * a0[0] + a0[1] * a0[1]) + (a0[2] * a0[2] + a0[3] * a0[3]) + (a1[0] * a1[0] + a1[1] * a1[1]) + (a1[2] * a1[2] + a1[3] * a1[3]);
                        sq += __shfl_xor(sq, 16); sq += __shfl_xor(sq, 32);
                        if (fq == 0) X[(ai * 128 + wr * 64 + m * 16 + fr) * 8 + bj * 4 + wc] = sq; }
            asm volatile("s_waitcnt lgkmcnt(0)" ::: "memory"); __builtin_amdgcn_s_barrier(); asm volatile("" ::: "memory");
            const f32x4 g0 = *(const f32x4*)(gain + wc * 32 + 8 * fq), g1 = *(const f32x4*)(gain + wc * 32 + 8 * fq + 4);
#pragma unroll
            for (int ai = 0; ai < 2; ++ai)
#pragma unroll
                for (int m = 0; m < 4; ++m) { const int rl = ai * 128 + wr * 64 + m * 16 + fr; const int row = u.pm * 256 + rl; const float rs = r1[row]; bf16_t* rowp = base + (size_t)row * ldc + colt;
#pragma unroll
                    for (int bj = 0; bj < 2; ++bj) { const f32x4 t = *(const LAS f32x4*)(X + rl * 8 + bj * 4); const float tot = (t[0] + t[1]) + (t[2] + t[3]);
                        const float sc = rs * rsqrtf(rs * rs * tot * (1.0f / 128.0f) + EPS) * extra;
                        const f32x4 v0 = acc[ai][bj][m][0] * sc * g0, v1 = acc[ai][bj][m][1] * sc * g1;
                        u32x4 w; w.x = pk2(v0[0], v0[1]); w.y = pk2(v0[2], v0[3]); w.z = pk2(v1[0], v1[1]); w.w = pk2(v1[2], v1[3]);
                        *(u32x4*)(rowp + bj * 128) = w; } }
            return;
        }
        if (isg) {
            const int cg = (pn - 18) * 128 + wc * 32 + 8 * fq;
#pragma unroll
            for (int ai = 0; ai < 2; ++ai)
#pragma unroll
                for (int m = 0; m < 4; ++m) { const int row = u.pm * 256 + ai * 128 + wr * 64 + m * 16 + fr; const float rs = r1[row]; bf16_t* rowp = gates + (size_t)row * NGATE + cg;
                    float ra[8], sb[8];
#pragma unroll
                    for (int n = 0; n < 2; ++n)
#pragma unroll
                        for (int j = 0; j < 4; ++j) { const float ea = __expf(-acc[ai][0][m][n][j] * rs), eb = fminf(__expf(-acc[ai][1][m][n][j] * rs), 1e30f);
                            sb[4 * n + j] = __builtin_amdgcn_rcpf(1.0f + eb); ra[4 * n + j] = (1.0f + eb) * __builtin_amdgcn_rcpf(1.0f + ea); }
                    u32x4 w; w.x = pk2(ra[0], ra[1]); w.y = pk2(ra[2], ra[3]); w.z = pk2(ra[4], ra[5]); w.w = pk2(ra[6], ra[7]); *(u32x4*)rowp = w;
                    w.x = pk2(sb[0], sb[1]); w.y = pk2(sb[2], sb[3]); w.z = pk2(sb[4], sb[5]); w.w = pk2(sb[6], sb[7]); *(u32x4*)(rowp + 2048) = w; }
            return;
        }
#pragma unroll
        for (int ai = 0; ai < 2; ++ai)
#pragma unroll
            for (int m = 0; m < 4; ++m) { const int row = u.pm * 256 + ai * 128 + wr * 64 + m * 16 + fr; const float rs = r1[row]; bf16_t* rowp = base + (size_t)row * ldc + colt;
#pragma unroll
                for (int bj = 0; bj < 2; ++bj) { const f32x4 v0 = acc[ai][bj][m][0] * rs, v1 = acc[ai][bj][m][1] * rs;
                    u32x4 w; w.x = pk2(v0[0], v0[1]); w.y = pk2(v0[2], v0[3]); w.z = pk2(v1[0], v1[1]); w.w = pk2(v1[2], v1[3]);
                    *(u32x4*)(rowp + bj * 128) = w; } }
    } };
__device__ __forceinline__ void p1_inproj(const Params& p, LAS unsigned char* lds) {
    pg8::DenseSched S; S.o.init(128, 34, gridDim.x, blockIdx.x); S.A = (const bf16_t*)(p.ws + WS_XB); S.Bt = (const bf16_t*)(p.ws + WS_WIN); S.lda = D; S.ldb = D;
    EpiInProj E{(bf16_t*)(p.ws + WS_QKV), (bf16_t*)(p.ws + WS_GATES), (const float*)(p.ws + WS_R1), p.in[3], p.in[4], p.in[6], p.in[7], (LAS float*)(lds + 131072)};
    pg8::gemm_phase<true, false>(lds, S, E, D / 64, D, D);
}

__device__ __forceinline__ void wait_vm(int n) {
    switch (n) { case 0: asm volatile("s_waitcnt vmcnt(0)" ::: "memory"); break; case 2: asm volatile("s_waitcnt vmcnt(2)" ::: "memory"); break; case 4: asm volatile("s_waitcnt vmcnt(4)" ::: "memory"); break;
                 case 6: asm volatile("s_waitcnt vmcnt(6)" ::: "memory"); break; case 8: asm volatile("s_waitcnt vmcnt(8)" ::: "memory"); break; case 10: asm volatile("s_waitcnt vmcnt(10)" ::: "memory"); break;
                 default: asm volatile("s_waitcnt vmcnt(12)" ::: "memory"); break; }
}
__device__ __forceinline__ void glds16_asm(const void* gsrc, unsigned lds_dst) {
    unsigned keep;
    asm volatile("s_mov_b32 %0, m0\n\ts_mov_b32 m0, %2\n\ts_nop 0\n\tglobal_load_lds_dwordx4 %1, off\n\ts_mov_b32 m0, %0" : "=&s"(keep) : "v"(gsrc), "s"(lds_dst) : "memory");
}
#define ATT_BAR() do { asm volatile("s_waitcnt lgkmcnt(0)" ::: "memory"); __builtin_amdgcn_s_barrier(); asm volatile("" ::: "memory"); } while (0)
__device__ __forceinline__ void load_q(const bf16_t* qp, int g, bf16x8 (&qf)[4]) {
#pragma unroll
    for (int ks = 0; ks < 4; ++ks) qf[ks] = *(const bf16x8*)(qp + 32 * ks + 8 * g);
#pragma unroll
    for (int ks = 0; ks < 4; ++ks) asm volatile("" : "+v"(qf[ks]));
}
__device__ __forceinline__ bf16x8 vt_frag(LAS unsigned char* base, int row0, int g, int q4, int pp, int dt) {
    const s16x4 lo = tr_read(base + off_b(row0 + 4 * g + q4, 2 * dt + (pp >> 1)) + 8 * (pp & 1)), hi = tr_read(base + off_b(row0 + 16 + 4 * g + q4, 2 * dt + (pp >> 1)) + 8 * (pp & 1));
    bf16x8 vf; vf[0] = lo[0]; vf[1] = lo[1]; vf[2] = lo[2]; vf[3] = lo[3]; vf[4] = hi[0]; vf[5] = hi[1]; vf[6] = hi[2]; vf[7] = hi[3]; return vf;
}

__device__ __forceinline__ void attn_window_item(const Params& p, LAS unsigned char* lds, int item, int& tab_head) {
    const int tid = phase_tid(), lane = tid & 63, w = __builtin_amdgcn_readfirstlane(tid >> 6), g = lane >> 4, ql = lane & 15;
    const int b = item >> 10, nb = (item >> 3) & 127, hq = item & 7, kv = hq >> 2;
    const bf16_t* qkv = (const bf16_t*)(p.ws + WS_QKV); bf16_t* o = (bf16_t*)(p.ws + WS_O);
    LAS float* bias = (LAS float*)(lds + 131072); const unsigned ldsb = (unsigned)(size_t)lds;
    const unsigned loff = (unsigned)(w * 4 + g) * NQKV + (unsigned)((ql ^ ((g << 2) | (w & 3))) * 8);
    const bf16_t* kbase = qkv + (size_t)(b * SEQ) * NQKV + 1024 + kv * 128;
#define WIN_ISSUE(c) do { const int _c = (c); const int _kb = min(max(nb - 1 + (_c % 3), 0), 127); const bf16_t* _src = kbase + (size_t)(_kb * 128) * NQKV + (_c >= 3 ? 256 : 0) + loff; \
        _Pragma("unroll") for (int _i = 0; _i < 4; ++_i) glds16_asm(_src + (size_t)(32 * _i) * NQKV, ldsb + (unsigned)((_c & 3) * 32768 + _i * 8192 + w * 1024)); } while (0)
    ATT_BAR();
    WIN_ISSUE(0); WIN_ISSUE(1); WIN_ISSUE(2);
    if (hq != tab_head) { if (tid < 257) bias[tid] = p.in[12][t5_bucket(tid - 128) * 8 + hq] * 1.4426950408889634f; tab_head = hq; }
    const int tq = b * SEQ + nb * 128 + 16 * w + ql;
    bf16x8 qf[4]; load_q(qkv + (size_t)tq * NQKV + hq * 128, g, qf);
    float sink = p.in[5][hq] * 1.4426950408889634f; asm volatile("" : "+v"(sink));
    f32x4 S1[8], SC[9];
#pragma unroll
    for (int kt = 0; kt < 8; ++kt) S1[kt] = (f32x4){0.f, 0.f, 0.f, 0.f};
#pragma unroll
    for (int s = 0; s < 9; ++s) SC[s] = (f32x4){0.f, 0.f, 0.f, 0.f};
    const bool in0 = nb > 0, in2 = nb < 127;
#pragma unroll
    for (int c = 0; c < 3; ++c) {
        wait_vm(8); ATT_BAR(); WIN_ISSUE(c + 3);
        LAS unsigned char* buf = lds + (c & 3) * 32768;
#pragma unroll
        for (int kt = 0; kt < 8; ++kt) {
            if (c == 1) {
#pragma unroll
                for (int ks = 0; ks < 4; ++ks) { const bf16x8 kf = *(const LAS bf16x8*)(buf + off_b(16 * kt + ql, 4 * ks + g)); S1[kt] = __builtin_amdgcn_mfma_f32_16x16x32_bf16(kf, qf[ks], S1[kt], 0, 0, 0); }
            } else if (c == 0) { if (kt >= w) {
#pragma unroll
                for (int ks = 0; ks < 4; ++ks) { const bf16x8 kf = *(const LAS bf16x8*)(buf + off_b(16 * kt + ql, 4 * ks + g)); SC[7 - kt] = __builtin_amdgcn_mfma_f32_16x16x32_bf16(kf, qf[ks], SC[7 - kt], 0, 0, 0); } }
            } else { if (kt <= w) {
#pragma unroll
                for (int ks = 0; ks < 4; ++ks) { const bf16x8 kf = *(const LAS bf16x8*)(buf + off_b(16 * kt + ql, 4 * ks + g)); SC[8 - kt] = __builtin_amdgcn_mfma_f32_16x16x32_bf16(kf, qf[ks], SC[8 - kt], 0, 0, 0); } }
            }
        }
    }
    float mx = sink; const int qi = 16 * w + ql;
#pragma unroll
    for (int kt = 0; kt < 8; ++kt)
#pragma unroll
        for (int r = 0; r < 4; ++r) { const int rel = 16 * kt + 4 * g + r - qi; const float sv = S1[kt][r] + bias[rel + 128]; S1[kt][r] = sv; mx = fmaxf(mx, sv); }
#pragma unroll
    for (int s = 0; s < 9; ++s) { const bool c0 = s <= 7 - w; const int kt = c0 ? 7 - s : 8 - s; const int cofs = c0 ? -128 : 128; const bool inr = c0 ? in0 : in2;
#pragma unroll
        for (int r = 0; r < 4; ++r) { const int rel = cofs + 16 * kt + 4 * g + r - qi; const bool valid = inr && rel >= -128 && rel <= 128;
            const float bv = bias[rel + 128];
            const float sv = valid ? SC[s][r] + bv : -1e30f; SC[s][r] = sv; mx = fmaxf(mx, sv); } }
    mx = fmaxf(mx, __shfl_xor(mx, 16)); mx = fmaxf(mx, __shfl_xor(mx, 32));
    float l = 0.f;
#pragma unroll
    for (int kt = 0; kt < 8; ++kt)
#pragma unroll
        for (int r = 0; r < 4; ++r) { const float pe = __builtin_amdgcn_exp2f(S1[kt][r] - mx); S1[kt][r] = pe; l += pe; }
#pragma unroll
    for (int s = 0; s < 9; ++s)
#pragma unroll
        for (int r = 0; r < 4; ++r) { const float pe = __builtin_amdgcn_exp2f(SC[s][r] - mx); SC[s][r] = pe; l += pe; }
    l += __shfl_xor(l, 16); l += __shfl_xor(l, 32); l += __builtin_amdgcn_exp2f(sink - mx);
    const float inv = 1.0f / l;
    f32x4 O[8];
#pragma unroll
    for (int dt = 0; dt < 8; ++dt) O[dt] = (f32x4){0.f, 0.f, 0.f, 0.f};
    const int q4 = ql >> 2, pp = ql & 3;
    const f32x4 zero4 = (f32x4){0.f, 0.f, 0.f, 0.f};
#pragma unroll
    for (int c = 0; c < 3; ++c) {
        wait_vm(c == 0 ? 8 : (c == 1 ? 4 : 0)); ATT_BAR();
        LAS unsigned char* buf = lds + ((c + 3) & 3) * 32768;
#pragma unroll
        for (int kk = 0; kk < 4; ++kk) {
            bool a0, a1; f32x4 p0, p1;
            if (c == 1) { a0 = true; a1 = true; p0 = S1[2 * kk]; p1 = S1[2 * kk + 1]; }
            else if (c == 0) { a0 = 2 * kk >= w; a1 = 2 * kk + 1 >= w; p0 = a0 ? SC[7 - 2 * kk] : zero4; p1 = a1 ? SC[6 - 2 * kk] : zero4; }
            else { a0 = 2 * kk <= w; a1 = 2 * kk + 1 <= w; p0 = a0 ? SC[8 - 2 * kk] : zero4; p1 = a1 ? SC[7 - 2 * kk] : zero4; }
            if (a0 || a1) { u32x4 pw; pw.x = pk2(p0[0], p0[1]); pw.y = pk2(p0[2], p0[3]); pw.z = pk2(p1[0], p1[1]); pw.w = pk2(p1[2], p1[3]);
                const bf16x8 pf = __builtin_bit_cast(bf16x8, pw);
#pragma unroll
                for (int dt = 0; dt < 8; ++dt) O[dt] = __builtin_amdgcn_mfma_f32_16x16x32_bf16(vt_frag(buf, 32 * kk, g, q4, pp, dt), pf, O[dt], 0, 0, 0); } }
    }
#undef WIN_ISSUE
    bf16_t* op = o + (size_t)tq * D + hq * 128 + 4 * g;
#pragma unroll
    for (int dt = 0; dt < 8; ++dt) { u32x2 w2; w2.x = pk2(O[dt][0] * inv, O[dt][1] * inv); w2.y = pk2(O[dt][2] * inv, O[dt][3] * inv); *(u32x2*)(op + 16 * dt) = w2; }
}

__device__ __forceinline__ void attn_nat_item(const Params& p, LAS unsigned char* lds, int item, int& tab_head) {
    const int tid = phase_tid(), lane = tid & 63, w = __builtin_amdgcn_readfirstlane(tid >> 6), g = lane >> 4, ql = lane & 15;
    const int b = item >> 9, rp = (item >> 2) & 127, hp = item & 3, hh = w >> 2, h = 2 * hp + hh, jq = w & 3;
    const int kr_lo = min(max(2 * rp - 4, 0), 248);
    const int d0 = min(max(2 * rp - 4, 0), 248) - kr_lo, d1 = min(max(2 * rp - 3, 0), 248) - kr_lo;
    const int w0 = jq == 0 ? 0 : (jq == 1 ? 8 : (jq == 2 ? 24 : 32));
    const bf16_t* qkv = (const bf16_t*)(p.ws + WS_QKV); bf16_t* o = (bf16_t*)(p.ws + WS_O);
    LAS float* rpb = (LAS float*)(lds + 131072); const unsigned ldsb = (unsigned)(size_t)lds;
    const unsigned loff = (unsigned)(w * 4 + g) * NQKV + (unsigned)((ql ^ ((g << 2) | (w & 3))) * 8);
    const bf16_t* kbase = qkv + (size_t)(b * SEQ) * NQKV + 2560 + 2 * hp * 128;
#define NAT_ISSUE(s) do { const int _s = (s); const int _kr = min(kr_lo + (_s % 9), 255); const bf16_t* _src = kbase + (size_t)(_kr * 64) * NQKV + (_s >= 9 ? 1024 : 0) + loff; \
        _Pragma("unroll") for (int _i = 0; _i < 4; ++_i) glds16_asm(_src + (size_t)(32 * (_i & 1)) * NQKV + 128 * (_i >> 1), ldsb + (unsigned)((_s & 3) * 32768 + _i * 8192 + w * 1024)); } while (0)
    ATT_BAR();
    NAT_ISSUE(0); NAT_ISSUE(1); NAT_ISSUE(2);
    if (hp != tab_head) { for (int i = tid; i < 930; i += 512) rpb[i] = p.in[8][2 * hp * 465 + i] * 1.4426950408889634f; tab_head = hp; }
    const int qcol = 16 * jq + ql; const int tq0 = b * SEQ + (2 * rp) * 64 + qcol;
    bf16x8 qf[2][4]; load_q(qkv + (size_t)tq0 * NQKV + 1536 + h * 128, g, qf[0]); load_q(qkv + (size_t)(tq0 + 64) * NQKV + 1536 + h * 128, g, qf[1]);
    f32x4 S[2][9][2];
#pragma unroll
    for (int u = 0; u < 2; ++u)
#pragma unroll
        for (int c = 0; c < 9; ++c) { S[u][c][0] = (f32x4){0.f, 0.f, 0.f, 0.f}; S[u][c][1] = (f32x4){0.f, 0.f, 0.f, 0.f}; }
#pragma unroll
    for (int c = 0; c < 9; ++c) {
        wait_vm(8); ATT_BAR(); NAT_ISSUE(c + 3);
        const bool a0 = c >= d0 && c < d0 + 8, a1 = c >= d1 && c < d1 + 8;
        LAS unsigned char* buf = lds + (c & 3) * 32768 + hh * 16384;
#pragma unroll
        for (int t = 0; t < 2; ++t)
#pragma unroll
            for (int ks = 0; ks < 4; ++ks) { const bf16x8 kf = *(const LAS bf16x8*)(buf + off_b(w0 + 16 * t + ql, 4 * ks + g));
                if (a0) S[0][c][t] = __builtin_amdgcn_mfma_f32_16x16x32_bf16(kf, qf[0][ks], S[0][c][t], 0, 0, 0);
                if (a1) S[1][c][t] = __builtin_amdgcn_mfma_f32_16x16x32_bf16(kf, qf[1][ks], S[1][c][t], 0, 0, 0); }
    }
    const int cs = min(max(qcol - 8, 0), 48); float inv[2];
    unsigned P[2][9][4];
    int dcv[2][4]; bool cv[2][4];
#pragma unroll
    for (int t = 0; t < 2; ++t)
#pragma unroll
        for (int q = 0; q < 4; ++q) { const int kc = w0 + 16 * t + 4 * g + q; cv[t][q] = kc >= cs && kc < cs + 16; dcv[t][q] = hh * 465 + kc - qcol + 15; }
#pragma unroll
    for (int u = 0; u < 2; ++u) { const int du = u ? d1 : d0; const int r = 2 * rp + u; float mx = -1e30f;
#pragma unroll
        for (int c = 0; c < 9; ++c) { const bool act = c >= du && c < du + 8;
            if (act) { const int rowb = (kr_lo + c - r + 7) * 31;
#pragma unroll
                for (int t = 0; t < 2; ++t)
#pragma unroll
                    for (int q = 0; q < 4; ++q) { const float sv = cv[t][q] ? S[u][c][t][q] + rpb[rowb + dcv[t][q]] : -1e30f; S[u][c][t][q] = sv; mx = fmaxf(mx, sv); } } }
        mx = fmaxf(mx, __shfl_xor(mx, 16)); mx = fmaxf(mx, __shfl_xor(mx, 32));
        float l = 0.f;
#pragma unroll
        for (int c = 0; c < 9; ++c) { const bool act = c >= du && c < du + 8;
            if (act) { float e[2][4];
#pragma unroll
                for (int t = 0; t < 2; ++t)
#pragma unroll
                    for (int q = 0; q < 4; ++q) { e[t][q] = __builtin_amdgcn_exp2f(S[u][c][t][q] - mx); l += e[t][q]; }
                P[u][c][0] = pk2(e[0][0], e[0][1]); P[u][c][1] = pk2(e[0][2], e[0][3]); P[u][c][2] = pk2(e[1][0], e[1][1]); P[u][c][3] = pk2(e[1][2], e[1][3]); }
            else { P[u][c][0] = 0u; P[u][c][1] = 0u; P[u][c][2] = 0u; P[u][c][3] = 0u; } }
        l += __shfl_xor(l, 16); l += __shfl_xor(l, 32);
        inv[u] = 1.0f / l; }
    f32x4 O[2][8];
#pragma unroll
    for (int u = 0; u < 2; ++u)
#pragma unroll
        for (int dt = 0; dt < 8; ++dt) O[u][dt] = (f32x4){0.f, 0.f, 0.f, 0.f};
    const int q4 = ql >> 2, pp = ql & 3;
#pragma unroll
    for (int c = 0; c < 9; ++c) {
        wait_vm(c <= 6 ? 8 : (c == 7 ? 4 : 0)); ATT_BAR(); if (c + 12 < 18) NAT_ISSUE(c + 12);
        const bool a0 = c >= d0 && c < d0 + 8, a1 = c >= d1 && c < d1 + 8;
        LAS unsigned char* buf = lds + ((c + 9) & 3) * 32768 + hh * 16384;
        u32x4 pw0; pw0.x = P[0][c][0]; pw0.y = P[0][c][1]; pw0.z = P[0][c][2]; pw0.w = P[0][c][3];
        u32x4 pw1; pw1.x = P[1][c][0]; pw1.y = P[1][c][1]; pw1.z = P[1][c][2]; pw1.w = P[1][c][3];
        const bf16x8 pf0 = __builtin_bit_cast(bf16x8, pw0), pf1 = __builtin_bit_cast(bf16x8, pw1);
#pragma unroll
        for (int dt = 0; dt < 8; ++dt) { const bf16x8 vf = vt_frag(buf, w0, g, q4, pp, dt);
            if (a0) O[0][dt] = __builtin_amdgcn_mfma_f32_16x16x32_bf16(vf, pf0, O[0][dt], 0, 0, 0);
            if (a1) O[1][dt] = __builtin_amdgcn_mfma_f32_16x16x32_bf16(vf, pf1, O[1][dt], 0, 0, 0); }
    }
#undef NAT_ISSUE
#pragma unroll
    for (int u = 0; u < 2; ++u) { bf16_t* op = o + (size_t)(tq0 + 64 * u) * D + 1024 + h * 128 + 4 * g;
#pragma unroll
        for (int dt = 0; dt < 8; ++dt) { u32x2 w2; w2.x = pk2(O[u][dt][0] * inv[u], O[u][dt][1] * inv[u]); w2.y = pk2(O[u][dt][2] * inv[u], O[u][dt][3] * inv[u]); *(u32x2*)(op + 16 * dt) = w2; } }
}
__device__ __forceinline__ void p2_attn(const Params& p, LAS unsigned char* lds) {
    int tab_head = -1;
    for (int it = blockIdx.x; it < 2048; it += gridDim.x) attn_window_item(p, lds, it, tab_head);
#ifdef PROBE_A
    if (blockIdx.x == 0 && threadIdx.x == 0) ((unsigned long long*)(p.ws + WS_END))[11] = __builtin_amdgcn_s_memrealtime();
#endif
    tab_head = -1;
    for (int it = blockIdx.x; it < 1024; it += gridDim.x) attn_nat_item(p, lds, it, tab_head);
    asm volatile("s_waitcnt vmcnt(0)" ::: "memory"); __syncthreads();
}

struct UpHook { const bf16_t* gates;
    __device__ __forceinline__ void operator()(f32x4 (&acc)[2][2][4][2], const Unit& u, int wr, int wc, int fr, int fq) const {
        const unsigned goff = (unsigned)(u.pm * 256 + wr * 64 + fr) * NGATE + u.pn * 256 + wc * 32 + 8 * fq;
#pragma unroll
        for (int ai = 0; ai < 2; ++ai) {
            bf16x8 ra[4][2];
#pragma unroll
            for (int m = 0; m < 4; ++m)
#pragma unroll
                for (int bj = 0; bj < 2; ++bj) ra[m][bj] = *(const bf16x8*)(gates + goff + (unsigned)((ai * 128 + m * 16) * NGATE) + bj * 128);
#pragma unroll
            for (int m = 0; m < 4; ++m)
#pragma unroll
                for (int bj = 0; bj < 2; ++bj)
#pragma unroll
                    for (int n = 0; n < 2; ++n)
#pragma unroll
                        for (int j = 0; j < 4; ++j) acc[ai][bj][m][n][j] *= bf2f(ra[m][bj][4 * n + j]);
            asm volatile("" ::: "memory"); }
    } };
struct UpSched {
    pg8::TileOrder o; const bf16_t* A; const bf16_t* Bt;
    __device__ __forceinline__ bool next(int i, Unit& u) const { u.aux = i & 1; return o.tile(i >> 1, u.pm, u.pn); }
    __device__ __forceinline__ const char* a_base(const Unit& u) const { return (const char*)(A + (size_t)u.pm * 256 * D + u.aux * 1024); }
    __device__ __forceinline__ const char* b_base(const Unit& u) const { return (const char*)(Bt + (size_t)u.pn * 256 * D + u.aux * 1024); }
    __device__ __forceinline__ bool keep_acc(const Unit& u) const { return u.aux == 0; }
    __device__ __forceinline__ void a_offs(const Unit&, int, int, int, int, unsigned (&)[2][2]) const {}
};
struct EpiUp { const bf16_t* gates; bf16_t* merged;
    __device__ __forceinline__ void operator()(f32x4 (&acc)[2][2][4][2], const Unit& u, int wr, int wc, int fr, int fq) const {
        if (u.aux == 0) { UpHook{gates}(acc, u, wr, wc, fr, fq); return; }
        const unsigned goff = (unsigned)(u.pm * 256 + wr * 64 + fr) * NGATE + 2048 + u.pn * 256 + wc * 32 + 8 * fq;
        const unsigned moff = (unsigned)(u.pm * 256 + wr * 64 + fr) * D + u.pn * 256 + wc * 32 + 8 * fq;
#pragma unroll
        for (int ai = 0; ai < 2; ++ai) {
            bf16x8 sb[4][2];
#pragma unroll
            for (int m = 0; m < 4; ++m)
#pragma unroll
                for (int bj = 0; bj < 2; ++bj) sb[m][bj] = *(const bf16x8*)(gates + goff + (unsigned)((ai * 128 + m * 16) * NGATE) + bj * 128);
#pragma unroll
            for (int m = 0; m < 4; ++m)
#pragma unroll
                for (int bj = 0; bj < 2; ++bj) { f32x4 v0 = acc[ai][bj][m][0], v1 = acc[ai][bj][m][1];
#pragma unroll
                    for (int j = 0; j < 4; ++j) { v0[j] *= bf2f(sb[m][bj][j]); v1[j] *= bf2f(sb[m][bj][4 + j]); }
                    u32x4 w; w.x = pk2(v0[0], v0[1]); w.y = pk2(v0[2], v0[3]); w.z = pk2(v1[0], v1[1]); w.w = pk2(v1[2], v1[3]);
                    *(u32x4*)(merged + moff + (unsigned)((ai * 128 + m * 16) * D) + bj * 128) = w; }
            asm volatile("" ::: "memory"); }
    } };
__device__ __forceinline__ void p3_up(const Params& p, LAS unsigned char* lds) {
    UpSched S; S.o.init(128, 8, gridDim.x, blockIdx.x); S.A = (const bf16_t*)(p.ws + WS_O); S.Bt = (const bf16_t*)(p.ws + WS_WUP);
    EpiUp E{(const bf16_t*)(p.ws + WS_GATES), (bf16_t*)(p.ws + WS_XB)};
    pg8::gemm_phase<true, false>(lds, S, E, 1024 / 64, D, D);
}

struct EpiOut { bf16_t* mob;
    __device__ __forceinline__ void operator()(f32x4 (&acc)[2][2][4][2], const Unit& u, int wr, int wc, int fr, int fq) const {
        unsigned off = (unsigned)(u.pm * 256 + wr * 64 + fr) * D + u.pn * 256 + wc * 32 + 8 * fq;
#pragma unroll
        for (int ai = 0; ai < 2; ++ai) {
#pragma unroll
            for (int m = 0; m < 4; ++m) { asm volatile("" : "+v"(off));
#pragma unroll
                for (int bj = 0; bj < 2; ++bj) { const f32x4 v0 = acc[ai][bj][m][0], v1 = acc[ai][bj][m][1];
                    u32x4 w; w.x = pk2(v0[0], v0[1]); w.y = pk2(v0[2], v0[3]); w.z = pk2(v1[0], v1[1]); w.w = pk2(v1[2], v1[3]);
                    *(u32x4*)(mob + off + bj * 128) = w; }
                off += 16 * D; }
            off += 64 * D; }
    } };
__device__ __forceinline__ void p4_out(const Params& p, LAS unsigned char* lds) {
    pg8::DenseSched S; S.o.init(128, 8, gridDim.x, blockIdx.x); S.A = (const bf16_t*)(p.ws + WS_XB); S.Bt = (const bf16_t*)(p.ws + WS_WOUT); S.lda = D; S.ldb = D;
    EpiOut E{(bf16_t*)(p.ws + WS_MOB)};
    pg8::gemm_phase<true, false>(lds, S, E, D / 64, D, D);
}

__device__ __forceinline__ void p5_router(const Params& p, LAS unsigned char* lds) {
    const int tid = phase_tid(), lane = tid & 63, wave = __builtin_amdgcn_readfirstlane(tid >> 6), g = lane >> 4, tl = lane & 15;
    const bf16_t* wsp = (const bf16_t*)(p.ws + WS_WRT); float* r2 = (float*)(p.ws + WS_R2); int* cnt = (int*)(p.ws + WS_CNT); int* tokl = (int*)(p.ws + WS_TOK);
    int* recc = (int*)(p.ws + WS_RECC); float* recw = (float*)(p.ws + WS_RECW); bf16_t* hb = (bf16_t*)(p.ws + WS_O); const bf16_t* mob = (const bf16_t*)(p.ws + WS_MOB); unsigned char* h8 = p.ws + WS_H8;
    const float* brg = p.in[15]; const float* bre = p.in[17];
    LAS float* H = (LAS float*)(lds + wave * 4352);
    LAS unsigned char* WL = lds + 36864;
    const int r4 = lane >> 4, k4 = (lane & 15) * 4;
    const int pa0 = tid / 384, pr0 = (tid % 384) >> 3, ps0 = tid & 7, pi1 = 512 + tid, pa1 = pi1 / 384, pr1 = (pi1 % 384) >> 3;
    const unsigned wsrc0 = (unsigned)(pa0 * 48 * 2048 + pr0 * D + ps0 * 8), wsrc1 = (unsigned)(pa1 * 48 * 2048 + pr1 * D + ps0 * 8);
    const unsigned wdst0 = (unsigned)(pa0 * 6144 + pr0 * 128 + ((ps0 ^ (pr0 & 7)) << 4)), wdst1 = (unsigned)(pa1 * 6144 + pr1 * 128 + ((ps0 ^ (pr1 & 7)) << 4));
    for (int round = blockIdx.x; round < T / 128; round += gridDim.x) {
        const int tile = round * 8 + wave;
        const float* xs = p.in[0] + (size_t)tile * 16 * D; const bf16_t* ms = mob + (size_t)tile * 16 * D; bf16_t* hs = hb + (size_t)tile * 16 * D; unsigned char* h8s = h8 + (size_t)tile * 16 * D;
        unsigned lo = (unsigned)(r4 * D + k4);
        f32x4 accA = {0.f, 0.f, 0.f, 0.f}, accB = accA, accC = accA; float ss = 0.f;
        f32x4 xa[4], xb_[4], xc[4]; u32x2 ma[4], mb[4], mc[4]; u32x4 wr0, wr1;
#define RT_LOADS(bx, bm, k) do { _Pragma("unroll") for (int j = 0; j < 4; ++j) { bx[j] = *(const f32x4*)(xs + (4 * j) * D + lo + 64 * (k)); bm[j] = *(const u32x2*)(ms + (4 * j) * D + lo + 64 * (k)); } } while (0)
#define RT_SPLIT(f0, f1, hi, lw) do { hi = pk2(f0, f1); lw = pk2((f0) - __uint_as_float(hi << 16), (f1) - __uint_as_float(hi & 0xffff0000u)); } while (0)
#define RT_COMP(bx, bm, k, wbuf) do { \
            _Pragma("unroll") for (int j = 0; j < 4; ++j) { f32x4 h = bx[j]; h.x += __uint_as_float(bm[j].x << 16); h.y += __uint_as_float(bm[j].x & 0xffff0000u); h.z += __uint_as_float(bm[j].y << 16); h.w += __uint_as_float(bm[j].y & 0xffff0000u); \
                u32x2 q2; q2.x = pk2(h[0], h[1]); q2.y = pk2(h[2], h[3]); *(u32x2*)(hs + (4 * j) * D + lo + 64 * (k)) = q2; \
                *(unsigned*)(h8s + (4 * j) * D + lo + 64 * (k)) = pk4_fp8(h[0], h[1], h[2], h[3]); \
                *(LAS f32x4*)(H + (4 * j + r4) * 68 + k4) = h; } \
            _Pragma("unroll") for (int ks = 0; ks < 2; ++ks) { const f32x4 h0 = *(const LAS f32x4*)(H + tl * 68 + 32 * ks + 8 * g), h1 = *(const LAS f32x4*)(H + tl * 68 + 32 * ks + 8 * g + 4); \
                ss += (h0.x * h0.x + h0.y * h0.y) + (h0.z * h0.z + h0.w * h0.w) + (h1.x * h1.x + h1.y * h1.y) + (h1.z * h1.z + h1.w * h1.w); \
                u32x4 hh, hl; RT_SPLIT(h0.x, h0.y, hh.x, hl.x); RT_SPLIT(h0.z, h0.w, hh.y, hl.y); RT_SPLIT(h1.x, h1.y, hh.z, hl.z); RT_SPLIT(h1.z, h1.w, hh.w, hl.w); \
                const bf16x8 bh = __builtin_bit_cast(bf16x8, hh), bl = __builtin_bit_cast(bf16x8, hl); const unsigned so_ = (unsigned)(((4 * ks + g) ^ (tl & 7)) << 4); \
                _Pragma("unroll") for (int t = 0; t < 3; ++t) { const bf16x8 ah = *(const LAS bf16x8*)((wbuf) + (16 * t + tl) * 128 + so_), al = *(const LAS bf16x8*)((wbuf) + 6144 + (16 * t + tl) * 128 + so_); \
                    f32x4& ac = (t == 0 ? accA : (t == 1 ? accB : accC)); \
                    ac = __builtin_amdgcn_mfma_f32_16x16x32_bf16(ah, bh, ac, 0, 0, 0); ac = __builtin_amdgcn_mfma_f32_16x16x32_bf16(al, bh, ac, 0, 0, 0); ac = __builtin_amdgcn_mfma_f32_16x16x32_bf16(ah, bl, ac, 0, 0, 0); } } } while (0)
#define RT_WLOAD(c) do { wr0 = *(const u32x4*)(wsp + wsrc0 + 64 * (c)); if (tid < 256) wr1 = *(const u32x4*)(wsp + wsrc1 + 64 * (c)); } while (0)
#define RT_WSTORE(wbuf) do { *(LAS u32x4*)((wbuf) + wdst0) = wr0; if (tid < 256) *(LAS u32x4*)((wbuf) + wdst1) = wr1; } while (0)
        __syncthreads();
        RT_WLOAD(0); RT_LOADS(xa, ma, 0); RT_LOADS(xb_, mb, 1);
        RT_WSTORE(WL); RT_WLOAD(1);
        __syncthreads();
#pragma unroll 1
        for (int c = 0; c < D / 64 - 2; c += 3) {
            const int pz = c & 1;
            RT_LOADS(xc, mc, 2); RT_COMP(xa, ma, 0, WL + pz * 12288); RT_WSTORE(WL + (pz ^ 1) * 12288); RT_WLOAD(c + 2); __syncthreads();
            RT_LOADS(xa, ma, 3); RT_COMP(xb_, mb, 1, WL + (pz ^ 1) * 12288); RT_WSTORE(WL + pz * 12288); RT_WLOAD(c + 3); __syncthreads();
            RT_LOADS(xb_, mb, 4); RT_COMP(xc, mc, 2, WL + pz * 12288); RT_WSTORE(WL + (pz ^ 1) * 12288); RT_WLOAD((c + 4) & 31); __syncthreads();
            lo += 192;
        }
        RT_COMP(xa, ma, 0, WL); RT_WSTORE(WL + 12288); __syncthreads();
        RT_COMP(xb_, mb, 1, WL + 12288);
#undef RT_LOADS
#undef RT_SPLIT
#undef RT_COMP
#undef RT_WLOAD
#undef RT_WSTORE
        const int tok = tile * 16 + tl;
        ss += __shfl_xor(ss, 16); ss += __shfl_xor(ss, 32);
        const float rr = rsqrtf(ss * (1.0f / D) + EPS);
        const float myg = accC[0] * rr + brg[g];
        float gl[4];
#pragma unroll
        for (int j = 0; j < 4; ++j) gl[j] = __shfl(myg, tl + 16 * j);
        int gi = 0; float gm = gl[0];
#pragma unroll
        for (int i = 1; i < 4; ++i) if (gl[i] > gm) { gm = gl[i]; gi = i; }
        float den = 0.f;
#pragma unroll
        for (int i = 0; i < 4; ++i) den += __expf(gl[i] - gm);
        const float pg = 1.0f / den;
        int L0 = 0, L1 = 0; float wt0 = 0.f, wt1 = 0.f; const bool owner = (g == gi);
        if (owner) {
            float el[8];
#pragma unroll
            for (int i = 0; i < 4; ++i) { el[i] = accA[i] * rr + bre[g * 8 + i]; el[4 + i] = accB[i] * rr + bre[g * 8 + 4 + i]; }
            int e0 = 0; float v0 = el[0];
#pragma unroll
            for (int i = 1; i < 8; ++i) if (el[i] > v0) { v0 = el[i]; e0 = i; }
            int e1 = -1; float v1 = -3.0e38f;
#pragma unroll
            for (int i = 0; i < 8; ++i) if (i != e0 && el[i] > v1) { v1 = el[i]; e1 = i; }
            const float ex = __expf(v1 - v0); const float s0 = 1.0f / (1.0f + ex), s1 = ex * s0;
            r2[tok] = rr; L0 = gi * 8 + e0; L1 = gi * 8 + e1; wt0 = pg * s0; wt1 = pg * s1;
        }
        LAS int* cl = (LAS int*)(lds + 61440);
        if (tid < 32) cl[tid] = 0;
        __syncthreads();
        int q0 = 0, q1 = 0;
        if (owner) { q0 = __hip_atomic_fetch_add(&cl[L0], 1, __ATOMIC_RELAXED, __HIP_MEMORY_SCOPE_WORKGROUP); q1 = __hip_atomic_fetch_add(&cl[L1], 1, __ATOMIC_RELAXED, __HIP_MEMORY_SCOPE_WORKGROUP); }
        __syncthreads();
        if (tid < 32) { const int n = cl[tid]; cl[32 + tid] = n ? atomicAdd(&cnt[tid], n) : 0; }
        __syncthreads();
        if (owner) { const int p0 = cl[32 + L0] + q0, p1 = cl[32 + L1] + q1;
            float* r2l = (float*)(p.ws + WS_R2L);
            tokl[(size_t)L0 * T + p0] = tok; r2l[(size_t)L0 * T + p0] = rr; recc[2 * tok] = L0 * 32768 + p0; recw[2 * tok] = wt0;
            tokl[(size_t)L1 * T + p1] = tok; r2l[(size_t)L1 * T + p1] = rr; recc[2 * tok + 1] = L1 * 32768 + p1; recw[2 * tok + 1] = wt1; }
    }
    __syncthreads();
}

__device__ __forceinline__ void build_tiles(const Params& p, LAS int* tab) {
    __syncthreads();
    if (threadIdx.x < 64) { const int L = threadIdx.x; const int c = L < 32 ? ((const int*)(p.ws + WS_CNT))[L] : 0; const int nt = (c + 255) >> 8;
        int pre = nt;
#pragma unroll
        for (int o = 1; o < 32; o <<= 1) { const int v = __shfl_up(pre, o); if (L >= o) pre += v; }
        const int first = pre - nt;
        if (L < 32) { tab[1400 + L] = first * 256; for (int i = 0; i < nt; ++i) { tab[4 + (first + i) * 4 + 0] = L; tab[4 + (first + i) * 4 + 1] = i * 256; tab[4 + (first + i) * 4 + 2] = (first + i) * 256; tab[4 + (first + i) * 4 + 3] = min(256, c - i * 256); } }
        if (L == 31) tab[0] = pre; }
    __syncthreads();
}
template <int NPN> struct MoeOrder { int G, c, t_lo, nt_tiles; const LAS int* tab;
    __device__ __forceinline__ bool unit(int i, Unit& u) const { const long L = (long)i * G + c; if (L >= (long)nt_tiles * NPN) return false;
        const int nwg = nt_tiles * NPN; int wgid = (int)L; { const int q = nwg / 8, r = nwg % 8, xcd = wgid % 8, off = wgid / 8; wgid = (xcd < r ? xcd * (q + 1) : r * (q + 1) + (xcd - r) * q) + off; }
        u.pm = t_lo + wgid / NPN; u.pn = wgid % NPN; u.aux = 0; return true; } };
struct GateUpSched { MoeOrder<4> o; const unsigned char* hb; const unsigned char* WguT; const int* tokl;
    __device__ __forceinline__ bool next(int i, Unit& u) const { return o.unit(i, u); }
    __device__ __forceinline__ const char* a_base(const Unit&) const { return (const char*)hb; }
    __device__ __forceinline__ const char* b_base(const Unit& u) const { const int e = o.tab[4 + u.pm * 4] & 31; return (const char*)(WguT + (size_t)(e * 1024 + u.pn * 256) * D); }
    __device__ __forceinline__ bool keep_acc(const Unit&) const { return false; }
    __device__ __forceinline__ void a_offs(const Unit& u, int R0, int C0, int R1, int C1, unsigned (&v)[2][2]) const {
        const int L = o.tab[4 + u.pm * 4], row0 = o.tab[4 + u.pm * 4 + 1], nrows = o.tab[4 + u.pm * 4 + 3]; const int* lst = tokl + (size_t)L * T + row0;
#pragma unroll
        for (int h = 0; h < 2; ++h) { const int r0 = R0 + 128 * h, r1 = R1 + 128 * h; const int t0 = r0 < nrows ? lst[r0] : 0, t1 = r1 < nrows ? lst[r1] : 0;
            v[h][0] = (unsigned)t0 * D + C0 * 2u; v[h][1] = (unsigned)t1 * D + C1 * 2u; } }
};
struct EpiGateUp { const LAS int* tab; const float* r2l; bf16_t* he;
    __device__ __forceinline__ void operator()(f32x4 (&acc)[2][2][4][2], const Unit& u, int wr, int wc, int fr, int fq) const {
        const int L = tab[4 + u.pm * 4], row0 = tab[4 + u.pm * 4 + 1], slot = tab[4 + u.pm * 4 + 2], nrows = tab[4 + u.pm * 4 + 3];
#pragma unroll
        for (int ai = 0; ai < 2; ++ai)
#pragma unroll
            for (int m = 0; m < 4; ++m) { const int rr = ai * 128 + wr * 64 + m * 16 + fr; const float rs = rr < nrows ? r2l[(size_t)L * T + row0 + rr] * (1.0f / 64.0f) : 0.f;
                u32x4 w; unsigned ww[4];
#pragma unroll
                for (int n = 0; n < 2; ++n) { float hv[4];
#pragma unroll
                    for (int j = 0; j < 4; ++j) { const float gt = acc[ai][0][m][n][j] * rs, up = acc[ai][1][m][n][j] * rs; hv[j] = gt * sigmoidf_(gt) * up; }
                    ww[2 * n] = pk2(hv[0], hv[1]); ww[2 * n + 1] = pk2(hv[2], hv[3]); }
                w.x = ww[0]; w.y = ww[1]; w.z = ww[2]; w.w = ww[3];
                *(u32x4*)(he + (size_t)(slot + rr) * 512 + u.pn * 128 + wc * 32 + 8 * fq) = w; }
    } };
__device__ __forceinline__ void p6_gateup(const Params& p, LAS unsigned char* lds) {
    LAS int* tab = (LAS int*)(lds + TAB_OFF); build_tiles(p, tab);
    GateUpSched S; S.o.G = gridDim.x; S.o.c = blockIdx.x; S.o.t_lo = 0; S.o.nt_tiles = tab[0]; S.o.tab = tab;
    S.hb = p.ws + WS_H8; S.WguT = p.ws + WS_WGU; S.tokl = (const int*)(p.ws + WS_TOK);
    EpiGateUp E{tab, (const float*)(p.ws + WS_R2L), (bf16_t*)(p.ws + WS_HE)};
    pg8::gemm_phase<true, true, GateUpSched, EpiGateUp, true>(lds, S, E, D / 128, D / 2, D / 2);
}
struct DownSched { MoeOrder<8> o; const bf16_t* he; const bf16_t* WdT;
    __device__ __forceinline__ bool next(int i, Unit& u) const { return o.unit(i, u); }
    __device__ __forceinline__ const char* a_base(const Unit& u) const { return (const char*)(he + (size_t)o.tab[4 + u.pm * 4 + 2] * 512); }
    __device__ __forceinline__ const char* b_base(const Unit& u) const { const int e = o.tab[4 + u.pm * 4] & 31; return (const char*)(WdT + (size_t)(e * 2048 + u.pn * 256) * 512); }
    __device__ __forceinline__ bool keep_acc(const Unit&) const { return false; }
    __device__ __forceinline__ void a_offs(const Unit&, int, int, int, int, unsigned (&)[2][2]) const {}
};
struct EpiDown { const LAS int* tab; bf16_t* ye_lo; bf16_t* ye_hi;
    __device__ __forceinline__ void operator()(f32x4 (&acc)[2][2][4][2], const Unit& u, int wr, int wc, int fr, int fq) const {
        const int slot = tab[4 + u.pm * 4 + 2]; bf16_t* ye = u.pn < 4 ? ye_lo : ye_hi;
        unsigned off = (unsigned)(slot + wr * 64 + fr) * 1024 + (u.pn & 3) * 256 + wc * 32 + 8 * fq;
#pragma unroll
        for (int ai = 0; ai < 2; ++ai) {
#pragma unroll
            for (int m = 0; m < 4; ++m) { asm volatile("" : "+v"(off));
#pragma unroll
                for (int bj = 0; bj < 2; ++bj) { const f32x4 v0 = acc[ai][bj][m][0], v1 = acc[ai][bj][m][1];
                    u32x4 w; w.x = pk2(v0[0], v0[1]); w.y = pk2(v0[2], v0[3]); w.z = pk2(v1[0], v1[1]); w.w = pk2(v1[2], v1[3]);
                    *(u32x4*)(ye + off + bj * 128) = w; }
                off += 16 * 1024; }
            off += 64 * 1024; }
    } };
__device__ __forceinline__ void p7_down(const Params& p, LAS unsigned char* lds) {
    LAS int* tab = (LAS int*)(lds + TAB_OFF); build_tiles(p, tab);
    DownSched S; S.o.G = gridDim.x; S.o.c = blockIdx.x; S.o.t_lo = 0; S.o.nt_tiles = tab[0]; S.o.tab = tab;
    S.he = (const bf16_t*)(p.ws + WS_HE); S.WdT = (const bf16_t*)(p.ws + WS_WD);
    EpiDown E{tab, (bf16_t*)(p.ws + WS_YE_LO), (bf16_t*)(p.ws + WS_YE_HI)};
    pg8::gemm_phase<true, false>(lds, S, E, 512 / 64, 512, 512);
}
__device__ __forceinline__ void p8_combine(const Params& p, LAS unsigned char* lds) {
    LAS int* tab = (LAS int*)(lds + TAB_OFF); build_tiles(p, tab);
    const int tid = phase_tid(), lane = tid & 63, wave = tid >> 6; const int gw = blockIdx.x * 8 + wave, NGW = gridDim.x * 8;
    const int* recc = (const int*)(p.ws + WS_RECC); const float* recw = (const float*)(p.ws + WS_RECW); const bf16_t* hb = (const bf16_t*)(p.ws + WS_O);
    const bf16_t* ye_lo = (const bf16_t*)(p.ws + WS_YE_LO); const bf16_t* ye_hi = (const bf16_t*)(p.ws + WS_YE_HI);
    for (int tok = gw; tok < T; tok += NGW) {
        const int c0 = recc[2 * tok], c1 = recc[2 * tok + 1]; const float wa = recw[2 * tok], wb = recw[2 * tok + 1];
        const int s0 = tab[1400 + (c0 >> 15)] + (c0 & 32767), s1 = tab[1400 + (c1 >> 15)] + (c1 & 32767);
        f32x4* op = (f32x4*)(p.out + (size_t)tok * D) + lane; const u32x2* hp = (const u32x2*)(hb + (size_t)tok * D) + lane;
        u32x2 m[8], a[8], b[8];
#pragma unroll
        for (int j = 0; j < 8; ++j) { const bf16_t* yb = j < 4 ? ye_lo : ye_hi; m[j] = hp[64 * j];
            a[j] = ((const u32x2*)(yb + (size_t)s0 * 1024) + lane)[64 * (j & 3)]; b[j] = ((const u32x2*)(yb + (size_t)s1 * 1024) + lane)[64 * (j & 3)]; }
#pragma unroll
        for (int j = 0; j < 8; ++j) { f32x4 v;
            v.x = __uint_as_float(m[j].x << 16) + wa * __uint_as_float(a[j].x << 16) + wb * __uint_as_float(b[j].x << 16); v.y = __uint_as_float(m[j].x & 0xffff0000u) + wa * __uint_as_float(a[j].x & 0xffff0000u) + wb * __uint_as_float(b[j].x & 0xffff0000u);
            v.z = __uint_as_float(m[j].y << 16) + wa * __uint_as_float(a[j].y << 16) + wb * __uint_as_float(b[j].y << 16); v.w = __uint_as_float(m[j].y & 0xffff0000u) + wa * __uint_as_float(a[j].y & 0xffff0000u) + wb * __uint_as_float(b[j].y & 0xffff0000u);
            op[64 * j] = v; }
    }
}

#define XB_TMO      128
#define XB_XCNT(j)  (256  + 64 * (j))
#define XB_XSUB(j)  (1280 + 64 * (j))
#define XB_XGEN(j)  (2304 + 64 * (j))
#define XB_TOP      3328
#define XB_TOPGEN   3392
#define XCD_BAR_WORDS 3456
#define XB_SPIN_CAP (1u << 18)
__device__ __forceinline__ unsigned xb_ld(unsigned* p)              { return __hip_atomic_load(p, __ATOMIC_RELAXED, __HIP_MEMORY_SCOPE_AGENT); }
__device__ __forceinline__ unsigned xb_add(unsigned* p, unsigned v) { return __hip_atomic_fetch_add(p, v, __ATOMIC_RELAXED, __HIP_MEMORY_SCOPE_AGENT); }
__device__ __forceinline__ unsigned xb_xcc_id() { return (unsigned)__builtin_amdgcn_s_getreg((3 << 11) | 20) & 0xFu; }
#define XB_SPIN(cond, bar) do { unsigned _sp = 0; while (cond) { __builtin_amdgcn_s_sleep(1); \
    if ((++_sp & 255u) == 0u) { if (xb_ld(&(bar)[XB_TMO])) break; if (_sp > XB_SPIN_CAP) { atomicAdd(&(bar)[XB_TMO], 1u); break; } } } } while (0)
struct XcdBarrier { unsigned* bar; unsigned x; volatile LAS unsigned* st; };
__device__ __forceinline__ XcdBarrier xcd_barrier_post(unsigned* bar, volatile LAS unsigned* st) {
    XcdBarrier b; b.bar = bar; b.x = xb_xcc_id(); b.st = st;
    if (threadIdx.x == 0) (void)xb_add(&bar[XB_XCNT(b.x)], 1u);
    return b;
}
__device__ __forceinline__ void xcd_barrier_complete(unsigned* bar, unsigned x, unsigned& nloc, unsigned& nx) {
    const unsigned G = gridDim.x * gridDim.y * gridDim.z;
    unsigned sum, cnt, mine, sp = 0u;
    for (;;) {
        sum = 0u; cnt = 0u; mine = 0u;
#pragma unroll
        for (unsigned j = 0; j < 16; ++j) { const unsigned c = xb_ld(&bar[XB_XCNT(j)]); sum += c; cnt += (c > 0u) ? 1u : 0u; mine = (j == x) ? c : mine; }
        if (sum == G) break;
        __builtin_amdgcn_s_sleep(1);
        if ((++sp & 255u) == 0u) { if (xb_ld(&bar[XB_TMO])) break; if (sp > XB_SPIN_CAP) { atomicAdd(&bar[XB_TMO], 1u); break; } }
    }
    nloc = mine > 0u ? mine : 1u; nx = cnt > 0u ? cnt : 1u;
}
__device__ __forceinline__ void xcd_barrier(const XcdBarrier& b) {
    asm volatile("s_waitcnt vmcnt(0)" ::: "memory");
    __syncthreads();
    if (threadIdx.x == 0) {
        unsigned* bar = b.bar;
        __builtin_amdgcn_s_waitcnt(0);
        unsigned nloc = b.st[0], nx = b.st[1];
        if (nloc == 0u) { xcd_barrier_complete(bar, b.x, nloc, nx); b.st[0] = nloc; b.st[1] = nx; }
        const unsigned old = xb_add(&bar[XB_XSUB(b.x)], 1u);
        const unsigned gen = old / nloc;
        if (old + 1u == (gen + 1u) * nloc) {
            __builtin_amdgcn_fence(__ATOMIC_RELEASE, "agent");
            asm volatile("s_waitcnt vmcnt(0)" ::: "memory");
            const unsigned og = xb_add(&bar[XB_TOP], 1u);
            const unsigned tg = og / nx;
            if (og + 1u == (tg + 1u) * nx) xb_add(&bar[XB_TOPGEN], 1u);
            else XB_SPIN(xb_ld(&bar[XB_TOPGEN]) == tg, bar);
            __builtin_amdgcn_fence(__ATOMIC_ACQUIRE, "agent");
            xb_add(&bar[XB_XGEN(b.x)], 1u);
            asm volatile("s_waitcnt vmcnt(0)" ::: "memory");
        } else {
            XB_SPIN(xb_ld(&bar[XB_XGEN(b.x)]) == gen, bar);
            __builtin_amdgcn_fence(__ATOMIC_ACQUIRE, "agent");
            asm volatile("s_waitcnt vmcnt(0)" ::: "memory");
        }
    }
    __syncthreads();
}

namespace cg = cooperative_groups;
#ifdef PROBE_A
#define STAMP(k) do { if (blockIdx.x == 0 && threadIdx.x == 0) ((unsigned long long*)(p.ws + WS_END))[k] = __builtin_amdgcn_s_memrealtime(); } while (0)
#else
#define STAMP(k) do {} while (0)
#endif
__global__ void __launch_bounds__(512, 2) fwd_megakernel(Params p) {
    extern __shared__ __attribute__((aligned(16))) unsigned char lds_raw[];
    LAS unsigned char* lds = (LAS unsigned char*)lds_raw;
    cg::grid_group grid = cg::this_grid();
    if (threadIdx.x == 0) { *(volatile LAS unsigned*)(lds + XBST_OFF) = 0u; *(volatile LAS unsigned*)(lds + XBST_OFF + 4) = 0u; }
    if (blockIdx.x == 0) for (int i = threadIdx.x; i < XCD_BAR_WORDS; i += 512) ((unsigned*)(p.ws + WS_BAR))[i] = 0u;
    __syncthreads();
#define GSYNC() xcd_barrier(xb)
    STAMP(0);
    p0_prep(p, lds);            grid.sync(); STAMP(1);
    const XcdBarrier xb = xcd_barrier_post((unsigned*)(p.ws + WS_BAR), (volatile LAS unsigned*)(lds + XBST_OFF));
    p1_inproj(p, lds);          GSYNC(); STAMP(2);
    p2_attn(p, lds);            GSYNC(); STAMP(3);
    p_moe_prep(p, lds);         STAMP(4);
    p3_up(p, lds);              GSYNC(); STAMP(5);
    p4_out(p, lds);             GSYNC(); STAMP(6);
    p5_router(p, lds);          GSYNC(); STAMP(7);
    p6_gateup(p, lds);          GSYNC(); STAMP(8);
    p7_down(p, lds);            GSYNC(); STAMP(9);
    p8_combine(p, lds);
#ifdef PROBE_A
    grid.sync(); STAMP(10); grid.sync();
    {
        const unsigned long long* ts = (const unsigned long long*)(p.ws + WS_END);
        #ifndef PROBE_A1
#define PROBE_A1 (PROBE_A + 1)
#endif
#ifndef PROBE_B1
#define PROBE_B1 (PROBE_B + 1)
#endif
        const float usA = (float)(ts[PROBE_A1] - ts[PROBE_A]) * 0.01f, usB = (float)(ts[PROBE_B1] - ts[PROBE_B]) * 0.01f;
        const float eps = sqrtf(usA * 1e-6f);
        for (size_t i = (size_t)blockIdx.x * 512 + threadIdx.x; i < (size_t)T * D / 4; i += (size_t)gridDim.x * 512) { f32x4 v = ((f32x4*)p.out)[i]; v = v * (1.0f + eps); if (i == 0) v.x += usB * 0.1f; ((f32x4*)p.out)[i] = v; }
    }
#endif
}

extern "C" void kernel_launch(void* const* d_in, const int* in_sizes, int n_in, void* d_out, int out_size, void* d_ws, size_t ws_size, hipStream_t stream) {
    static int grid_blocks = 0;
    if (!grid_blocks) {
        if (n_in != 21 || out_size != T * D || ws_size < WS_MOB + 128 * MiB) { fprintf(stderr, "kernel_launch: unexpected problem (n_in %d out %d ws %zu)\n", n_in, out_size, ws_size); grid_blocks = -1; return; }
        if (hipFuncSetAttribute((const void*)fwd_megakernel, hipFuncAttributeMaxDynamicSharedMemorySize, LDS_BYTES) != hipSuccess) { fprintf(stderr, "kernel_launch: hipFuncSetAttribute failed\n"); grid_blocks = -1; return; }
        int dev = 0, cus = 0, per_cu = 0;
        hipGetDevice(&dev); hipDeviceGetAttribute(&cus, hipDeviceAttributeMultiprocessorCount, dev);
        hipOccupancyMaxActiveBlocksPerMultiprocessor(&per_cu, (const void*)fwd_megakernel, 512, LDS_BYTES);
        if (per_cu < 1 || cus < 1) { fprintf(stderr, "kernel_launch: occupancy query gave %d blocks/CU on %d CUs\n", per_cu, cus); grid_blocks = -1; return; }
        grid_blocks = cus;
    }
    if (grid_blocks < 0) return;
    Params p{};
    for (int i = 0; i < 21; ++i) p.in[i] = (const float*)d_in[i];
    p.out = (float*)d_out; p.ws = (unsigned char*)d_ws;
    void* args[] = {&p};
    hipError_t e = hipLaunchCooperativeKernel((const void*)fwd_megakernel, dim3(grid_blocks), dim3(512), args, LDS_BYTES, stream);
    if (e != hipSuccess) fprintf(stderr, "cooperative launch failed: %s (grid %d)\n", hipGetErrorString(e), grid_blocks);
}
```

```cpp
#include <hip/hip_runtime.h>
#include <hip/hip_cooperative_groups.h>
#include <cstdio>
#include <cstdint>

#define LAS __attribute__((address_space(3)))
typedef unsigned short bf16_t;
typedef short bf16x8 __attribute__((ext_vector_type(8)));
typedef short s16x4 __attribute__((ext_vector_type(4)));
typedef float f32x4 __attribute__((ext_vector_type(4)));
typedef unsigned u32x4 __attribute__((ext_vector_type(4)));
typedef unsigned u32x2 __attribute__((ext_vector_type(2)));
typedef short v4i16_t __attribute__((ext_vector_type(4)));

namespace cfg {
constexpr int T = 32768, D = 2048, SEQ = 16384;
constexpr int NQKV = 4608, NGATE = 4096, NIN = 8704;
constexpr size_t MiB = 1ull << 20;
constexpr size_t WS_XB = 0, WS_QKV = 128 * MiB, WS_GATES = 416 * MiB, WS_O = 672 * MiB, WS_WIN = 800 * MiB, WS_WUP = 834 * MiB, WS_WOUT = 842 * MiB, WS_MISC = 850 * MiB;
constexpr size_t WS_WGU = WS_QKV, WS_WD = WS_QKV + 128 * MiB, WS_HE = WS_QKV + 192 * MiB;
constexpr size_t WS_R1 = WS_MISC, WS_R2 = WS_R1 + (size_t)T * 4, WS_WRT = WS_R2 + (size_t)T * 4, WS_CNT = WS_WRT + 512 * 1024, WS_TOK = WS_CNT + 4096,
                 WS_RECC = WS_TOK + 32ull * T * 4, WS_RECW = WS_RECC + 2ull * T * 4, WS_R2L = WS_RECW + 2ull * T * 4, WS_END = WS_R2L + 32ull * T * 4;
constexpr size_t WS_H8 = WS_GATES + 144 * MiB;
constexpr size_t WS_YE_LO = 0, WS_YE_HI = WS_GATES;
constexpr size_t WS_BAR = WS_END + 4096;
constexpr size_t WS_MOB = 872 * MiB;
constexpr int LDS_BYTES = 140 * 1024;
constexpr int XBST_OFF = LDS_BYTES - 16;
constexpr int TAB_OFF = 132 * 1024;
constexpr float EPS = 1e-6f;
}
using namespace cfg;

struct Params { const float* in[21]; float* out; unsigned char* ws; };
__device__ __forceinline__ int phase_tid() { int t = threadIdx.x; asm volatile("" : "+v"(t)); return t; }

__device__ __forceinline__ float bf2f(short s) { return __uint_as_float(((unsigned)(unsigned short)s) << 16); }
typedef float f32x2 __attribute__((ext_vector_type(2)));
typedef __bf16 bf16x2_t __attribute__((ext_vector_type(2)));
__device__ __forceinline__ unsigned pk2(float lo, float hi) { const f32x2 v = {lo, hi}; return __builtin_bit_cast(unsigned, __builtin_convertvector(v, bf16x2_t)); }
__device__ __forceinline__ unsigned pk4_fp8(float a, float b, float c, float d) { int w = 0; w = __builtin_amdgcn_cvt_pk_fp8_f32(a, b, w, false); w = __builtin_amdgcn_cvt_pk_fp8_f32(c, d, w, true); return (unsigned)w; }
__device__ __forceinline__ float wave_sum(float v) {
#pragma unroll
    for (int o = 1; o < 64; o <<= 1) v += __shfl_xor(v, o);
    return v;
}
__device__ __forceinline__ float sigmoidf_(float v) { return 1.0f / (1.0f + __expf(-v)); }
__device__ __forceinline__ unsigned off_b(unsigned row, unsigned ch) { return 256u * row + 16u * (ch ^ (((row & 3) << 2) | ((row >> 2) & 3))); }
__device__ __forceinline__ s16x4 tr_read(LAS unsigned char* p) { return __builtin_bit_cast(s16x4, __builtin_amdgcn_ds_read_tr16_b64_v4i16((LAS v4i16_t*)p)); }
__host__ __device__ __forceinline__ int perm32(int rho) { const int n = rho >> 4, i = rho & 15; return 8 * (i >> 2) + 4 * n + (i & 3); }
__device__ __forceinline__ int t5_bucket(int rel) {
    const int n = rel < 0 ? -rel : rel; const int ret = rel > 0 ? 16 : 0; int b;
    if (n < 8) b = n; else if (n < 12) b = 8; else if (n < 16) b = 9; else if (n < 23) b = 10; else if (n < 32) b = 11; else if (n < 46) b = 12; else if (n < 64) b = 13; else if (n < 91) b = 14; else b = 15;
    return ret + b;
}

template <bool FP8>
__device__ __forceinline__ void transpose_item(const float* __restrict__ W, int ldw, int k0, int n0, bf16_t* __restrict__ WT, int ldt, int drow0, int dk0, const float* __restrict__ scale, LAS unsigned* scr, int lane, float f8scale = 1.f) {
    const int n4 = (lane & 15) * 4, kk = lane >> 4;
    const float* src = W + (size_t)(k0 + 2 * kk) * ldw + n0 + n4;
    f32x4 ev[8], od[8];
#pragma unroll
    for (int j = 0; j < 8; ++j) { ev[j] = *(const f32x4*)(src + (size_t)(8 * j) * ldw); od[j] = *(const f32x4*)(src + (size_t)(8 * j + 1) * ldw); }
#pragma unroll
    for (int j = 0; j < 8; ++j) { f32x4 e = ev[j], o = od[j];
        if (scale) { const float se = scale[k0 + 8 * j + 2 * kk], so = scale[k0 + 8 * j + 2 * kk + 1]; e = e * se; o = o * so; }
        u32x4 w; w.x = pk2(e.x, o.x); w.y = pk2(e.y, o.y); w.z = pk2(e.z, o.z); w.w = pk2(e.w, o.w);
        *(LAS u32x4*)(scr + (4 * j + kk) * 68 + n4) = w; }
    asm volatile("s_waitcnt lgkmcnt(0)" ::: "memory");
    const int kq = lane & 7;
#pragma unroll
    for (int i = 0; i < 8; ++i) { const int n = (lane >> 3) + 8 * i; const LAS unsigned* q = scr + (4 * kq) * 68 + n;
        u32x4 o; o.x = q[0]; o.y = q[68]; o.z = q[136]; o.w = q[204];
        if (FP8) { u32x2 f; f.x = pk4_fp8(__uint_as_float(o.x << 16) * f8scale, __uint_as_float(o.x & 0xffff0000u) * f8scale, __uint_as_float(o.y << 16) * f8scale, __uint_as_float(o.y & 0xffff0000u) * f8scale);
            f.y = pk4_fp8(__uint_as_float(o.z << 16) * f8scale, __uint_as_float(o.z & 0xffff0000u) * f8scale, __uint_as_float(o.w << 16) * f8scale, __uint_as_float(o.w & 0xffff0000u) * f8scale);
            *(u32x2*)((unsigned char*)WT + (size_t)(drow0 + n) * ldt + dk0 + k0 + 8 * kq) = f; }
        else *(u32x4*)(WT + (size_t)(drow0 + n) * ldt + dk0 + k0 + 8 * kq) = o; }
    asm volatile("s_waitcnt lgkmcnt(0)" ::: "memory");
}

__device__ __forceinline__ void p0_prep(const Params& p, LAS unsigned char* lds) {
    const int tid = phase_tid(), lane = tid & 63, wave = tid >> 6;
    const int gw = blockIdx.x * 8 + wave, NGW = gridDim.x * 8;
    LAS unsigned* scr = (LAS unsigned*)(lds + wave * 8704);
    const float* x = p.in[0]; const float* g1 = p.in[1]; const float* w_in = p.in[2];
    bf16_t* xb = (bf16_t*)(p.ws + WS_XB); float* r1 = (float*)(p.ws + WS_R1);
    bf16_t* WinT = (bf16_t*)(p.ws + WS_WIN); bf16_t* WupT = (bf16_t*)(p.ws + WS_WUP); bf16_t* WoutT = (bf16_t*)(p.ws + WS_WOUT);
    constexpr int I_WIN = 32 * 136, I_UP = 16 * 32, I_OUT = 32 * 32, NITEMS = I_WIN + 2 * I_UP + I_OUT;
    for (int it = gw; it < NITEMS; it += NGW) {
        int r = it;
        if (r < I_WIN) { const int kb = r / 136, nb = r % 136; const int n0 = nb * 64; int drow = n0;
            if (n0 >= NQKV) { const int c = (n0 - NQKV) & 2047, isb = (n0 - NQKV) >> 11; drow = NQKV + (c >> 7) * 256 + isb * 128 + (c & 127); }
            transpose_item<false>(w_in, NIN, kb * 64, n0, WinT, 2048, drow, 0, g1, scr, lane); continue; } r -= I_WIN;
        if (r < I_UP) { const int kb = r / 32, nb = r % 32; transpose_item<false>(p.in[9], 2048, kb * 64, nb * 64, WupT, 2048, nb * 64, 0, nullptr, scr, lane); continue; } r -= I_UP;
        if (r < I_UP) { const int kb = r / 32, nb = r % 32; transpose_item<false>(p.in[10], 2048, kb * 64, nb * 64, WupT, 2048, nb * 64, 1024, nullptr, scr, lane); continue; } r -= I_UP;
        { const int kb = r / 32, nb = r % 32; transpose_item<false>(p.in[11], 2048, kb * 64, nb * 64, WoutT, 2048, nb * 64, 0, nullptr, scr, lane); }
    }
    { bf16_t* whi = (bf16_t*)(p.ws + WS_WRT); bf16_t* wlo = whi + 48 * 2048; const float* g2 = p.in[13]; const float* wrg = p.in[14]; const float* wre = p.in[16];
      for (int i = blockIdx.x * 512 + tid; i < 48 * 2048; i += gridDim.x * 512) { const int row = i >> 11, k = i & 2047, t = row >> 4, r = row & 15; float w;
          if (t == 0) w = wre[k * 32 + (r >> 2) * 8 + (r & 3)]; else if (t == 1) w = wre[k * 32 + (r >> 2) * 8 + 4 + (r & 3)]; else w = (r & 3) == 0 ? wrg[k * 4 + (r >> 2)] : 0.f;
          w *= g2[k]; const unsigned hi = pk2(w, 0.f) & 0xffffu; const float hf = __uint_as_float(hi << 16); whi[i] = (bf16_t)hi; wlo[i] = (bf16_t)(pk2(w - hf, 0.f) & 0xffffu); } }
    if (blockIdx.x == 0 && tid < 32) ((int*)(p.ws + WS_CNT))[tid] = 0;
    for (int row0 = 2 * gw; row0 < T; row0 += 2 * NGW) {
        f32x4 v[2][8]; float ss[2] = {0.f, 0.f};
#pragma unroll
        for (int u = 0; u < 2; ++u) { const f32x4* xr = (const f32x4*)(x + (size_t)(row0 + u) * D) + lane;
#pragma unroll
            for (int j = 0; j < 8; ++j) v[u][j] = xr[64 * j]; }
#pragma unroll
        for (int u = 0; u < 2; ++u) {
#pragma unroll
            for (int j = 0; j < 8; ++j) ss[u] += (v[u][j].x * v[u][j].x + v[u][j].y * v[u][j].y) + (v[u][j].z * v[u][j].z + v[u][j].w * v[u][j].w);
            ss[u] = wave_sum(ss[u]);
            if (lane == 0) r1[row0 + u] = rsqrtf(ss[u] * (1.0f / D) + EPS);
            u32x2* o = (u32x2*)(xb + (size_t)(row0 + u) * D) + lane;
#pragma unroll
            for (int j = 0; j < 8; ++j) { u32x2 w; w.x = pk2(v[u][j].x, v[u][j].y); w.y = pk2(v[u][j].z, v[u][j].w); o[64 * j] = w; } }
    }
}

__device__ __forceinline__ void p_moe_prep(const Params& p, LAS unsigned char* lds) {
    const int tid = phase_tid(), lane = tid & 63, wave = tid >> 6;
    const int gw = blockIdx.x * 8 + wave, NGW = gridDim.x * 8;
    LAS unsigned* scr = (LAS unsigned*)(lds + wave * 8704);
    const float* g2 = p.in[13];
    bf16_t* WguT = (bf16_t*)(p.ws + WS_WGU); bf16_t* WdT = (bf16_t*)(p.ws + WS_WD);
    constexpr int I_G = 32 * 32 * 8;
    constexpr int I_D = 32 * 8 * 32;
    for (int it = gw; it < 2 * I_G + I_D; it += NGW) {
        int r = it;
        if (r < 2 * I_G) { const int which = r >= I_G; if (which) r -= I_G; const int e = r / 256, rr = r % 256, kb = rr / 8, nb = rr % 8;
            const float* W = p.in[which ? 19 : 18] + (size_t)e * 2048 * 512; const int n0 = nb * 64;
            transpose_item<true>(W, 512, kb * 64, n0, WguT, 2048, e * 1024 + (n0 >> 7) * 256 + which * 128 + (n0 & 127), 0, g2, scr, lane, 64.f); continue; }
        r -= 2 * I_G;
        { const int e = r / 256, rr = r % 256, kb = rr / 32, nb = rr % 32; const float* W = p.in[20] + (size_t)e * 512 * 2048;
          transpose_item<false>(W, 2048, kb * 64, nb * 64, WdT, 512, e * 2048 + nb * 64, 0, nullptr, scr, lane); }
    }
}

struct Unit { int pm, pn, aux; };
namespace pg8 {
constexpr int BM = 256, BK = 64, HALF = 128, HTB = HALF * BK * 2, STAGE_BYTES = 8 * HTB;
__device__ __forceinline__ int lds_byte(int r, int c) { const int st = (r >> 4) * 2 + (c >> 5), rr = r & 15, cc = c & 31, ob = rr * 64 + cc * 2; return st * 1024 + (ob ^ (((ob >> 9) & 1) << 5)); }
__device__ __forceinline__ void stage_rc(int b, int& R, int& C) { const int st = b / 1024, sb = b % 1024, swz = sb ^ (((sb >> 9) & 1) << 5); R = (st >> 1) * 16 + swz / 64; C = (st & 1) * 32 + (swz % 64) / 2; }

template <bool PERM, bool GATHER, class Sched, class Epi, bool FP8 = false, bool ALIGN_EPI = true>
__device__ __forceinline__ void gemm_phase(LAS unsigned char* lds, const Sched& S, const Epi& E, const int nt, const int lda, const int ldb) {
    int tid_ = threadIdx.x; asm volatile("" : "+v"(tid_));
    const int tid = tid_, wid = __builtin_amdgcn_readfirstlane(tid >> 6), lane = tid & 63, wr = wid >> 2, wc = wid & 3, fr = lane & 15, fq = lane >> 4;
    int R0, C0, R1, C1; stage_rc(tid * 16, R0, C0); stage_rc(tid * 16 + 8192, R1, C1);
    unsigned voffB[2], voffA[2][2];
    { const int Rb0 = PERM ? ((R0 & ~31) + perm32(R0 & 31)) : R0, Rb1 = PERM ? ((R1 & ~31) + perm32(R1 & 31)) : R1;
      voffB[0] = (unsigned)(Rb0 * ldb + C0) * 2u; voffB[1] = (unsigned)(Rb1 * ldb + C1) * 2u; }
    const size_t kstep = (size_t)(BK * 2);
    const size_t hstepB = (size_t)HALF * ldb * 2;
    const unsigned ldsw = (unsigned)wid * 1024u;
    const int aoff = lds_byte(wr * 64 + fr, fq * 8), boff = lds_byte(wc * 32 + fr, fq * 8);
#define PG8_SA(b, h) (((b) * 2 + (h)) * HTB)
#define PG8_SB(b, h) ((4 + (b) * 2 + (h)) * HTB)
#define PG8_STAGE_B(bufoff, gbase) do { _Pragma("unroll") for (int _i = 0; _i < 2; ++_i) \
        __builtin_amdgcn_global_load_lds((const unsigned*)((const char*)(gbase) + voffB[_i]), (LAS unsigned*)(lds + (bufoff) + ldsw + _i * 8192), 16, 0, 0); } while (0)
#define PG8_STAGE_A(bufoff, gbase, h) do { _Pragma("unroll") for (int _i = 0; _i < 2; ++_i) \
        __builtin_amdgcn_global_load_lds((const unsigned*)((const char*)(gbase) + voffA[h][_i]), (LAS unsigned*)(lds + (bufoff) + ldsw + _i * 8192), 16, 0, 0); } while (0)
#define PG8_LDA(dst, b, h) do { _Pragma("unroll") for (int m = 0; m < 4; ++m) _Pragma("unroll") for (int k = 0; k < 2; ++k) dst[m][k] = *(const LAS bf16x8*)(lds + PG8_SA(b, h) + aoff + m * 2048 + k * 1024); } while (0)
#define PG8_LDB(dst, b, h) do { _Pragma("unroll") for (int n = 0; n < 2; ++n) _Pragma("unroll") for (int k = 0; k < 2; ++k) dst[n][k] = *(const LAS bf16x8*)(lds + PG8_SB(b, h) + boff + n * 2048 + k * 1024); } while (0)
#define PG8_MMA(ai, bj, At, Bt) do { __builtin_amdgcn_s_setprio(1); _Pragma("unroll") for (int m = 0; m < 4; ++m) _Pragma("unroll") for (int n = 0; n < 2; ++n) { \
        if (FP8) { typedef int v8i_ __attribute__((ext_vector_type(8))); typedef int v4i_ __attribute__((ext_vector_type(4))); \
            const v4i_ b0_ = __builtin_bit_cast(v4i_, Bt[n][0]), b1_ = __builtin_bit_cast(v4i_, Bt[n][1]), a0_ = __builtin_bit_cast(v4i_, At[m][0]), a1_ = __builtin_bit_cast(v4i_, At[m][1]); \
            const v8i_ bb_ = {b0_[0], b0_[1], b0_[2], b0_[3], b1_[0], b1_[1], b1_[2], b1_[3]}, aa_ = {a0_[0], a0_[1], a0_[2], a0_[3], a1_[0], a1_[1], a1_[2], a1_[3]}; \
            acc[ai][bj][m][n] = __builtin_amdgcn_mfma_scale_f32_16x16x128_f8f6f4(bb_, aa_, acc[ai][bj][m][n], 0, 0, 0, 0x7f7f7f7f, 0, 0x7f7f7f7f); } \
        else { _Pragma("unroll") for (int k = 0; k < 2; ++k) acc[ai][bj][m][n] = __builtin_amdgcn_mfma_f32_16x16x32_bf16(Bt[n][k], At[m][k], acc[ai][bj][m][n], 0, 0, 0); } } \
        __builtin_amdgcn_s_setprio(0); } while (0)
#define PG8_WAIT_V(n) asm volatile("s_waitcnt vmcnt(" #n ")" ::: "memory")
#define PG8_WAIT_L(n) asm volatile("s_waitcnt lgkmcnt(" #n ")" ::: "memory")
#define PG8_BAR __builtin_amdgcn_s_barrier()
#define PG8_SCHED __builtin_amdgcn_sched_barrier(0)
    Unit cur, nxt; int ui = 0;
    __syncthreads();
    if (!S.next(0, cur)) return;
    if (GATHER) S.a_offs(cur, R0, C0, R1, C1, voffA);
    else { voffA[0][0] = (unsigned)(R0 * lda + C0) * 2u; voffA[0][1] = (unsigned)(R1 * lda + C1) * 2u; voffA[1][0] = voffA[0][0] + (unsigned)(HALF * lda * 2); voffA[1][1] = voffA[0][1] + (unsigned)(HALF * lda * 2); }
    f32x4 acc[2][2][4][2];
#pragma unroll
    for (int a = 0; a < 2; ++a)
#pragma unroll
        for (int b = 0; b < 2; ++b)
#pragma unroll
            for (int m = 0; m < 4; ++m)
#pragma unroll
                for (int n = 0; n < 2; ++n) acc[a][b][m][n] = (f32x4){0.f, 0.f, 0.f, 0.f};
    bf16x8 At[4][2], B0[2][2], B1[2][2];
    const char* cA = S.a_base(cur); const char* cB = S.b_base(cur);
    PG8_STAGE_B(PG8_SB(0, 0), cB); PG8_STAGE_B(PG8_SB(0, 1), cB + hstepB); PG8_STAGE_A(PG8_SA(0, 0), cA, 0); PG8_STAGE_A(PG8_SA(0, 1), cA, 1);
    if (wr == 1) PG8_BAR;
    PG8_WAIT_V(2); PG8_BAR;
    PG8_STAGE_B(PG8_SB(1, 0), cB + kstep); PG8_STAGE_A(PG8_SA(1, 0), cA + kstep, 0); PG8_STAGE_B(PG8_SB(1, 1), cB + hstepB + kstep);
    PG8_WAIT_V(6); PG8_BAR;
    for (;;) {
        const bool has_next = S.next(ui + 1, nxt);
        const char* nA = has_next ? S.a_base(nxt) : cA; const char* nB = has_next ? S.b_base(nxt) : cB;
        unsigned vn[2][2];
        if (GATHER) { if (has_next) S.a_offs(nxt, R0, C0, R1, C1, vn); else { vn[0][0] = voffA[0][0]; vn[0][1] = voffA[0][1]; vn[1][0] = voffA[1][0]; vn[1][1] = voffA[1][1]; } }
        for (int t = 0; t < nt; t += 2) {
            const bool last = (t == nt - 2);
            const char* a1 = cA + (size_t)(t + 1) * kstep;
            const char* a2 = last ? nA : cA + (size_t)(t + 2) * kstep; const char* b2 = last ? nB : cB + (size_t)(t + 2) * kstep;
            const char* a3 = a2 + kstep; const char* b3 = b2 + kstep;
            PG8_LDB(B0, 0, 0); PG8_LDB(B1, 0, 1); PG8_SCHED; PG8_LDA(At, 0, 0); PG8_STAGE_A(PG8_SA(1, 1), a1, 1);
            if (GATHER) { if (last) { voffA[0][0] = vn[0][0]; voffA[0][1] = vn[0][1]; voffA[1][0] = vn[1][0]; voffA[1][1] = vn[1][1]; } }
            PG8_WAIT_V(8); PG8_WAIT_L(0); PG8_BAR; PG8_MMA(0, 0, At, B0); PG8_MMA(0, 1, At, B1); PG8_BAR; PG8_SCHED;
            PG8_LDA(At, 0, 1); PG8_STAGE_B(PG8_SB(0, 0), b2); PG8_STAGE_B(PG8_SB(0, 1), b2 + hstepB); PG8_STAGE_A(PG8_SA(0, 0), a2, 0);
            PG8_WAIT_V(8); PG8_WAIT_L(0); PG8_BAR; PG8_MMA(1, 0, At, B0); PG8_MMA(1, 1, At, B1); PG8_BAR; PG8_SCHED;
            PG8_LDB(B0, 1, 0); PG8_LDB(B1, 1, 1); PG8_SCHED; PG8_LDA(At, 1, 0); PG8_STAGE_A(PG8_SA(0, 1), a2, 1);
            PG8_WAIT_V(8); PG8_WAIT_L(0); PG8_BAR; PG8_MMA(0, 0, At, B0); PG8_MMA(0, 1, At, B1); PG8_BAR; PG8_SCHED;
            PG8_LDA(At, 1, 1); PG8_STAGE_B(PG8_SB(1, 0), b3); PG8_STAGE_B(PG8_SB(1, 1), b3 + hstepB); PG8_STAGE_A(PG8_SA(1, 0), a3, 0);
            PG8_WAIT_V(8); PG8_WAIT_L(0); PG8_BAR; PG8_MMA(1, 0, At, B0); PG8_MMA(1, 1, At, B1); PG8_BAR; PG8_SCHED;
        }
        if (ALIGN_EPI) { if (wr == 0) PG8_BAR; }
        E(acc, cur, wr, wc, fr, fq);
        if (!has_next) break;
        if (!S.keep_acc(cur)) {
#pragma unroll
        for (int a = 0; a < 2; ++a)
#pragma unroll
            for (int b = 0; b < 2; ++b)
#pragma unroll
                for (int m = 0; m < 4; ++m)
#pragma unroll
                    for (int n = 0; n < 2; ++n) acc[a][b][m][n] = (f32x4){0.f, 0.f, 0.f, 0.f};
        }
        cur = nxt; cA = nA; cB = nB; ++ui;
        if (ALIGN_EPI) { if (wr == 1) PG8_BAR; }
    }
    PG8_WAIT_V(0);
    if (!ALIGN_EPI) { if (wr == 0) PG8_BAR; }
    PG8_BAR;
#undef PG8_SA
#undef PG8_SB
#undef PG8_STAGE_A
#undef PG8_STAGE_B
#undef PG8_LDA
#undef PG8_LDB
#undef PG8_MMA
#undef PG8_WAIT_V
#undef PG8_WAIT_L
#undef PG8_BAR
#undef PG8_SCHED
}
struct TileOrder {
    int nM, nN, nwg, G, c;
    __device__ __forceinline__ void init(int nM_, int nN_, int G_, int c_) { nM = nM_; nN = nN_; nwg = nM * nN; G = G_; c = c_; }
    __device__ __forceinline__ bool tile(int i, int& pm, int& pn) const {
        const long L = (long)i * G + c; if (L >= nwg) return false;
        int wgid = (int)L; { const int q = nwg / 8, r = nwg % 8, xcd = wgid % 8, off = wgid / 8; wgid = (xcd < r ? xcd * (q + 1) : r * (q + 1) + (xcd - r) * q) + off; }
        const int nig = 8 * nN, gid = wgid / nig, fm = gid * 8, gsz = (nM - fm) < 8 ? (nM - fm) : 8;
        pm = fm + ((wgid % nig) % gsz); pn = (wgid % nig) / gsz; return true;
    }
};
struct DenseSched {
    TileOrder o; const bf16_t* A; const bf16_t* Bt; int lda, ldb;
    __device__ __forceinline__ bool next(int i, Unit& u) const { u.aux = 0; return o.tile(i, u.pm, u.pn); }
    __device__ __forceinline__ const char* a_base(const Unit& u) const { return (const char*)(A + (size_t)u.pm * 256 * lda); }
    __device__ __forceinline__ const char* b_base(const Unit& u) const { return (const char*)(Bt + (size_t)u.pn * 256 * ldb); }
    __device__ __forceinline__ bool keep_acc(const Unit&) const { return false; }
    __device__ __forceinline__ void a_offs(const Unit&, int, int, int, int, unsigned (&)[2][2]) const {}
};
}

struct EpiInProj { bf16_t* qkv; bf16_t* gates; const float* r1; const float* gqa; const float* gka; const float* gqb; const float* gkb; LAS float* X;
    __device__ __forceinline__ void operator()(f32x4 (&acc)[2][2][4][2], const Unit& u, int wr, int wc, int fr, int fq) const {
        const int pn = u.pn;
        const bool isg = pn >= 18; bf16_t* base = isg ? gates : qkv; const int ldc = isg ? NGATE : NQKV; const int colt = (isg ? pn - 18 : pn) * 256 + wc * 32 + 8 * fq;
        const float* gain = pn < 4 ? gqa : (pn == 4 ? gka : ((pn >= 6 && pn < 10) ? gqb : ((pn >= 10 && pn < 14) ? gkb : nullptr)));
        if (gain) {
            const float extra = (pn < 4 || (pn >= 6 && pn < 10)) ? 0.08838834764831845f * 1.4426950408889634f : 1.0f;
#pragma unroll
            for (int ai = 0; ai < 2; ++ai)
#pragma unroll
                for (int m = 0; m < 4; ++m)
#pragma unroll
                    for (int bj = 0; bj < 2; ++bj) { const f32x4 a0 = acc[ai][bj][m][0], a1 = acc[ai][bj][m][1];
                        float sq = (a0[0] * a0[0] + a0[1] * a0[1]) + (a0[2] * a0[2] + a0[3] * a0[3]) + (a1[0] * a1[0] + a1[1] * a1[1]) + (a1[2] * a1[2] + a1[3] * a1[3]);
                        sq += __shfl_xor(sq, 16); sq += __shfl_xor(sq, 32);
                        if (fq == 0) X[(ai * 128 + wr * 64 + m * 16 + fr) * 8 + bj * 4 + wc] = sq; }
            asm volatile("s_waitcnt lgkmcnt(0)" ::: "memory"); __builtin_amdgcn_s_barrier(); asm volatile("" ::: "memory");
            const f32x4 g0 = *(const f32x4*)(gain + wc * 32 + 8 * fq), g1 = *(const f32x4*)(gain + wc * 32 + 8 * fq + 4);
#pragma unroll
            for (int ai = 0; ai < 2; ++ai)
#pragma unroll
                for (int m = 0; m < 4; ++m) { const int rl = ai * 128 + wr * 64 + m * 16 + fr; const int row = u.pm * 256 + rl; const float rs = r1[row]; bf16_t* rowp = base + (size_t)row * ldc + colt;
#pragma unroll
                    for (int bj = 0; bj < 2; ++bj) { const f32x4 t = *(const LAS f32x4*)(X + rl * 8 + bj * 4); const float tot = (t[0] + t[1]) + (t[2] + t[3]);
                        const float sc = rs * rsqrtf(rs * rs * tot * (1.0f / 128.0f) + EPS) * extra;
                        const f32x4 v0 = acc[ai][bj][m][0] * sc * g0, v1 = acc[ai][bj][m][1] * sc * g1;
                        u32x4 w; w.x = pk2(v0[0], v0[1]); w.y = pk2(v0[2], v0[3]); w.z = pk2(v1[0], v1[1]); w.w = pk2(v1[2], v1[3]);
                        *(u32x4*)(rowp + bj * 128) = w; } }
            return;
        }
        if (isg) {
            const int cg = (pn - 18) * 128 + wc * 32 + 8 * fq;
#pragma unroll
            for (int ai = 0; ai < 2; ++ai)
#pragma unroll
                for (int m = 0; m < 4; ++m) { const int row = u.pm * 256 + ai * 128 + wr * 64 + m * 16 + fr; const float rs = r1[row]; bf16_t* rowp = gates + (size_t)row * NGATE + cg;
                    float ra[8], sb[8];
#pragma unroll
                    for (int n = 0; n < 2; ++n)
#pragma unroll
                        for (int j = 0; j < 4; ++j) { const float ea = __expf(-acc[ai][0][m][n][j] * rs), eb = fminf(__expf(-acc[ai][1][m][n][j] * rs), 1e30f);
                            sb[4 * n + j] = __builtin_amdgcn_rcpf(1.0f + eb); ra[4 * n + j] = (1.0f + eb) * __builtin_amdgcn_rcpf(1.0f + ea); }
                    u32x4 w; w.x = pk2(ra[0], ra[1]); w.y = pk2(ra[2], ra[3]); w.z = pk2(ra[4], ra[5]); w.w = pk2(ra[6], ra[7]); *(u32x4*)rowp = w;
                    w.x = pk2(sb[0], sb[1]); w.y = pk2(sb[2], sb[3]); w.z = pk2(sb[4], sb[5]); w.w = pk2(sb[6], sb[7]); *(u32x4*)(rowp + 2048) = w; }
            return;
        }
#pragma unroll
        for (int ai = 0; ai < 2; ++ai)
#pragma unroll
            for (int m = 0; m < 4; ++m) { const int row = u.pm * 256 + ai * 128 + wr * 64 + m * 16 + fr; const float rs = r1[row]; bf16_t* rowp = base + (size_t)row * ldc + colt;
#pragma unroll
                for (int bj = 0; bj < 2; ++bj) { const f32x4 v0 = acc[ai][bj][m][0] * rs, v1 = acc[ai][bj][m][1] * rs;
                    u32x4 w; w.x = pk2(v0[0], v0[1]); w.y = pk2(v0[2], v0[3]); w.z = pk2(v1[0], v1[1]); w.w = pk2(v1[2], v1[3]);
                    *(u32x4*)(rowp + bj * 128) = w; } }
    } };
__device__ __forceinline__ void p1_inproj(const Params& p, LAS unsigned char* lds) {
    pg8::DenseSched S; S.o.init(128, 34, gridDim.x, blockIdx.x); S.A = (const bf16_t*)(p.ws + WS_XB); S.Bt = (const bf16_t*)(p.ws + WS_WIN); S.lda = D; S.ldb = D;
    EpiInProj E{(bf16_t*)(p.ws + WS_QKV), (bf16_t*)(p.ws + WS_GATES), (const float*)(p.ws + WS_R1), p.in[3], p.in[4], p.in[6], p.in[7], (LAS float*)(lds + 131072)};
    pg8::gemm_phase<true, false>(lds, S, E, D / 64, D, D);
}

__device__ __forceinline__ void wait_vm(int n) {
    switch (n) { case 0: asm volatile("s_waitcnt vmcnt(0)" ::: "memory"); break; case 2: asm volatile("s_waitcnt vmcnt(2)" ::: "memory"); break; case 4: asm volatile("s_waitcnt vmcnt(4)" ::: "memory"); break;
                 case 6: asm volatile("s_waitcnt vmcnt(6)" ::: "memory"); break; case 8: asm volatile("s_waitcnt vmcnt(8)" ::: "memory"); break; case 10: asm volatile("s_waitcnt vmcnt(10)" ::: "memory"); break;
                 default: asm volatile("s_waitcnt vmcnt(12)" ::: "memory"); break; }
}
__device__ __forceinline__ void glds16_asm(const void* gsrc, unsigned lds_dst) {
    unsigned keep;
    asm volatile("s_mov_b32 %0, m0\n\ts_mov_b32 m0, %2\n\ts_nop 0\n\tglobal_load_lds_dwordx4 %1, off\n\ts_mov_b32 m0, %0" : "=&s"(keep) : "v"(gsrc), "s"(lds_dst) : "memory");
}
#define ATT_BAR() do { asm volatile("s_waitcnt lgkmcnt(0)" ::: "memory"); __builtin_amdgcn_s_barrier(); asm volatile("" ::: "memory"); } while (0)
__device__ __forceinline__ void load_q(const bf16_t* qp, int g, bf16x8 (&qf)[4]) {
#pragma unroll
    for (int ks = 0; ks < 4; ++ks) qf[ks] = *(const bf16x8*)(qp + 32 * ks + 8 * g);
#pragma unroll
    for (int ks = 0; ks < 4; ++ks) asm volatile("" : "+v"(qf[ks]));
}
__device__ __forceinline__ bf16x8 vt_frag(LAS unsigned char* base, int row0, int g, int q4, int pp, int dt) {
    const s16x4 lo = tr_read(base + off_b(row0 + 4 * g + q4, 2 * dt + (pp >> 1)) + 8 * (pp & 1)), hi = tr_read(base + off_b(row0 + 16 + 4 * g + q4, 2 * dt + (pp >> 1)) + 8 * (pp & 1));
    bf16x8 vf; vf[0] = lo[0]; vf[1] = lo[1]; vf[2] = lo[2]; vf[3] = lo[3]; vf[4] = hi[0]; vf[5] = hi[1]; vf[6] = hi[2]; vf[7] = hi[3]; return vf;
}

__device__ __forceinline__ void attn_window_item(const Params& p, LAS unsigned char* lds, int item, int& tab_head) {
    const int tid = phase_tid(), lane = tid & 63, w = __builtin_amdgcn_readfirstlane(tid >> 6), g = lane >> 4, ql = lane & 15;
    const int b = item >> 10, nb = (item >> 3) & 127, hq = item & 7, kv = hq >> 2;
    const bf16_t* qkv = (const bf16_t*)(p.ws + WS_QKV); bf16_t* o = (bf16_t*)(p.ws + WS_O);
    LAS float* bias = (LAS float*)(lds + 131072); const unsigned ldsb = (unsigned)(size_t)lds;
    const unsigned loff = (unsigned)(w * 4 + g) * NQKV + (unsigned)((ql ^ ((g << 2) | (w & 3))) * 8);
    const bf16_t* kbase = qkv + (size_t)(b * SEQ) * NQKV + 1024 + kv * 128;
#define WIN_ISSUE(c) do { const int _c = (c); const int _kb = min(max(nb - 1 + (_c % 3), 0), 127); const bf16_t* _src = kbase + (size_t)(_kb * 128) * NQKV + (_c >= 3 ? 256 : 0) + loff; \
        _Pragma("unroll") for (int _i = 0; _i < 4; ++_i) glds16_asm(_src + (size_t)(32 * _i) * NQKV, ldsb + (unsigned)((_c & 3) * 32768 + _i * 8192 + w * 1024)); } while (0)
    ATT_BAR();
    WIN_ISSUE(0); WIN_ISSUE(1); WIN_ISSUE(2);
    if (hq != tab_head) { if (tid < 257) bias[tid] = p.in[12][t5_bucket(tid - 128) * 8 + hq] * 1.4426950408889634f; tab_head = hq; }
    const int tq = b * SEQ + nb * 128 + 16 * w + ql;
    bf16x8 qf[4]; load_q(qkv + (size_t)tq * NQKV + hq * 128, g, qf);
    float sink = p.in[5][hq] * 1.4426950408889634f; asm volatile("" : "+v"(sink));
    f32x4 S1[8], SC[9];
#pragma unroll
    for (int kt = 0; kt < 8; ++kt) S1[kt] = (f32x4){0.f, 0.f, 0.f, 0.f};
#pragma unroll
    for (int s = 0; s < 9; ++s) SC[s] = (f32x4){0.f, 0.f, 0.f, 0.f};
    const bool in0 = nb > 0, in2 = nb < 127;
#pragma unroll
    for (int c = 0; c < 3; ++c) {
        wait_vm(8); ATT_BAR(); WIN_ISSUE(c + 3);
        LAS unsigned char* buf = lds + (c & 3) * 32768;
#pragma unroll
        for (int kt = 0; kt < 8; ++kt) {
            if (c == 1) {
#pragma unroll
                for (int ks = 0; ks < 4; ++ks) { const bf16x8 kf = *(const LAS bf16x8*)(buf + off_b(16 * kt + ql, 4 * ks + g)); S1[kt] = __builtin_amdgcn_mfma_f32_16x16x32_bf16(kf, qf[ks], S1[kt], 0, 0, 0); }
            } else if (c == 0) { if (kt >= w) {
#pragma unroll
                for (int ks = 0; ks < 4; ++ks) { const bf16x8 kf = *(const LAS bf16x8*)(buf + off_b(16 * kt + ql, 4 * ks + g)); SC[7 - kt] = __builtin_amdgcn_mfma_f32_16x16x32_bf16(kf, qf[ks], SC[7 - kt], 0, 0, 0); } }
            } else { if (kt <= w) {
#pragma unroll
                for (int ks = 0; ks < 4; ++ks) { const bf16x8 kf = *(const LAS bf16x8*)(buf + off_b(16 * kt + ql, 4 * ks + g)); SC[8 - kt] = __builtin_amdgcn_mfma_f32_16x16x32_bf16(kf, qf[ks], SC[8 - kt], 0, 0, 0); } }
            }
        }
    }
    float mx = sink; const int qi = 16 * w + ql;
#pragma unroll
    for (int kt = 0; kt < 8; ++kt)
#pragma unroll
        for (int r = 0; r < 4; ++r) { const int rel = 16 * kt + 4 * g + r - qi; const float sv = S1[kt][r] + bias[rel + 128]; S1[kt][r] = sv; mx = fmaxf(mx, sv); }
#pragma unroll
    for (int s = 0; s < 9; ++s) { const bool c0 = s <= 7 - w; const int kt = c0 ? 7 - s : 8 - s; const int cofs = c0 ? -128 : 128; const bool inr = c0 ? in0 : in2;
#pragma unroll
        for (int r = 0; r < 4; ++r) { const int rel = cofs + 16 * kt + 4 * g + r - qi; const bool valid = inr && rel >= -128 && rel <= 128;
            const float bv = bias[rel + 128];
            const float sv = valid ? SC[s][r] + bv : -1e30f; SC[s][r] = sv; mx = fmaxf(mx, sv); } }
    mx = fmaxf(mx, __shfl_xor(mx, 16)); mx = fmaxf(mx, __shfl_xor(mx, 32));
    float l = 0.f;
#pragma unroll
    for (int kt = 0; kt < 8; ++kt)
#pragma unroll
        for (int r = 0; r < 4; ++r) { const float pe = __builtin_amdgcn_exp2f(S1[kt][r] - mx); S1[kt][r] = pe; l += pe; }
#pragma unroll
    for (int s = 0; s < 9; ++s)
#pragma unroll
        for (int r = 0; r < 4; ++r) { const float pe = __builtin_amdgcn_exp2f(SC[s][r] - mx); SC[s][r] = pe; l += pe; }
    l += __shfl_xor(l, 16); l += __shfl_xor(l, 32); l += __builtin_amdgcn_exp2f(sink - mx);
    const float inv = 1.0f / l;
    f32x4 O[8];
#pragma unroll
    for (int dt = 0; dt < 8; ++dt) O[dt] = (f32x4){0.f, 0.f, 0.f, 0.f};
    const int q4 = ql >> 2, pp = ql & 3;
    const f32x4 zero4 = (f32x4){0.f, 0.f, 0.f, 0.f};
#pragma unroll
    for (int c = 0; c < 3; ++c) {
        wait_vm(c == 0 ? 8 : (c == 1 ? 4 : 0)); ATT_BAR();
        LAS unsigned char* buf = lds + ((c + 3) & 3) * 32768;
#pragma unroll
        for (int kk = 0; kk < 4; ++kk) {
            bool a0, a1; f32x4 p0, p1;
            if (c == 1) { a0 = true; a1 = true; p0 = S1[2 * kk]; p1 = S1[2 * kk + 1]; }
            else if (c == 0) { a0 = 2 * kk >= w; a1 = 2 * kk + 1 >= w; p0 = a0 ? SC[7 - 2 * kk] : zero4; p1 = a1 ? SC[6 - 2 * kk] : zero4; }
            else { a0 = 2 * kk <= w; a1 = 2 * kk + 1 <= w; p0 = a0 ? SC[8 - 2 * kk] : zero4; p1 = a1 ? SC[7 - 2 * kk] : zero4; }
            if (a0 || a1) { u32x4 pw; pw.x = pk2(p0[0], p0[1]); pw.y = pk2(p0[2], p0[3]); pw.z = pk2(p1[0], p1[1]); pw.w = pk2(p1[2], p1[3]);
                const bf16x8 pf = __builtin_bit_cast(bf16x8, pw);
#pragma unroll
                for (int dt = 0; dt < 8; ++dt) O[dt] = __builtin_amdgcn_mfma_f32_16x16x32_bf16(vt_frag(buf, 32 * kk, g, q4, pp, dt), pf, O[dt], 0, 0, 0); } }
    }
#undef WIN_ISSUE
    bf16_t* op = o + (size_t)tq * D + hq * 128 + 4 * g;
#pragma unroll
    for (int dt = 0; dt < 8; ++dt) { u32x2 w2; w2.x = pk2(O[dt][0] * inv, O[dt][1] * inv); w2.y = pk2(O[dt][2] * inv, O[dt][3] * inv); *(u32x2*)(op + 16 * dt) = w2; }
}

__device__ __forceinline__ void attn_nat_item(const Params& p, LAS unsigned char* lds, int item, int& tab_head) {
    const int tid = phase_tid(), lane = tid & 63, w = __builtin_amdgcn_readfirstlane(tid >> 6), g = lane >> 4, ql = lane & 15;
    const int b = item >> 9, rp = (item >> 2) & 127, hp = item & 3, hh = w >> 2, h = 2 * hp + hh, jq = w & 3;
    const int kr_lo = min(max(2 * rp - 4, 0), 248);
    const int d0 = min(max(2 * rp - 4, 0), 248) - kr_lo, d1 = min(max(2 * rp - 3, 0), 248) - kr_lo;
    const int w0 = jq == 0 ? 0 : (jq == 1 ? 8 : (jq == 2 ? 24 : 32));
    const bf16_t* qkv = (const bf16_t*)(p.ws + WS_QKV); bf16_t* o = (bf16_t*)(p.ws + WS_O);
    LAS float* rpb = (LAS float*)(lds + 131072); const unsigned ldsb = (unsigned)(size_t)lds;
    const unsigned loff = (unsigned)(w * 4 + g) * NQKV + (unsigned)((ql ^ ((g << 2) | (w & 3))) * 8);
    const bf16_t* kbase = qkv + (size_t)(b * SEQ) * NQKV + 2560 + 2 * hp * 128;
#define NAT_ISSUE(s) do { const int _s = (s); const int _kr = min(kr_lo + (_s % 9), 255); const bf16_t* _src = kbase + (size_t)(_kr * 64) * NQKV + (_s >= 9 ? 1024 : 0) + loff; \
        _Pragma("unroll") for (int _i = 0; _i < 4; ++_i) glds16_asm(_src + (size_t)(32 * (_i & 1)) * NQKV + 128 * (_i >> 1), ldsb + (unsigned)((_s & 3) * 32768 + _i * 8192 + w * 1024)); } while (0)
    ATT_BAR();
    NAT_ISSUE(0); NAT_ISSUE(1); NAT_ISSUE(2);
    if (hp != tab_head) { for (int i = tid; i < 930; i += 512) rpb[i] = p.in[8][2 * hp * 465 + i] * 1.4426950408889634f; tab_head = hp; }
    const int qcol = 16 * jq + ql; const int tq0 = b * SEQ + (2 * rp) * 64 + qcol;
    bf16x8 qf[2][4]; load_q(qkv + (size_t)tq0 * NQKV + 1536 + h * 128, g, qf[0]); load_q(qkv + (size_t)(tq0 + 64) * NQKV + 1536 + h * 128, g, qf[1]);
    f32x4 S[2][9][2];
#pragma unroll
    for (int u = 0; u < 2; ++u)
#pragma unroll
        for (int c = 0; c < 9; ++c) { S[u][c][0] = (f32x4){0.f, 0.f, 0.f, 0.f}; S[u][c][1] = (f32x4){0.f, 0.f, 0.f, 0.f}; }
#pragma unroll
    for (int c = 0; c < 9; ++c) {
        wait_vm(8); ATT_BAR(); NAT_ISSUE(c + 3);
        const bool a0 = c >= d0 && c < d0 + 8, a1 = c >= d1 && c < d1 + 8;
        LAS unsigned char* buf = lds + (c & 3) * 32768 + hh * 16384;
#pragma unroll
        for (int t = 0; t < 2; ++t)
#pragma unroll
            for (int ks = 0; ks < 4; ++ks) { const bf16x8 kf = *(const LAS bf16x8*)(buf + off_b(w0 + 16 * t + ql, 4 * ks + g));
                if (a0) S[0][c][t] = __builtin_amdgcn_mfma_f32_16x16x32_bf16(kf, qf[0][ks], S[0][c][t], 0, 0, 0);
                if (a1) S[1][c][t] = __builtin_amdgcn_mfma_f32_16x16x32_bf16(kf, qf[1][ks], S[1][c][t], 0, 0, 0); }
    }
    const int cs = min(max(qcol - 8, 0), 48); float inv[2];
    unsigned P[2][9][4];
    int dcv[2][4]; bool cv[2][4];
#pragma unroll
    for (int t = 0; t < 2; ++t)
#pragma unroll
        for (int q = 0; q < 4; ++q) { const int kc = w0 + 16 * t + 4 * g + q; cv[t][q] = kc >= cs && kc < cs + 16; dcv[t][q] = hh * 465 + kc - qcol + 15; }
#pragma unroll
    for (int u = 0; u < 2; ++u) { const int du = u ? d1 : d0; const int r = 2 * rp + u; float mx = -1e30f;
#pragma unroll
        for (int c = 0; c < 9; ++c) { const bool act = c >= du && c < du + 8;
            if (act) { const int rowb = (kr_lo + c - r + 7) * 31;
#pragma unroll
                for (int t = 0; t < 2; ++t)
#pragma unroll
                    for (int q = 0; q < 4; ++q) { const float sv = cv[t][q] ? S[u][c][t][q] + rpb[rowb + dcv[t][q]] : -1e30f; S[u][c][t][q] = sv; mx = fmaxf(mx, sv); } } }
        mx = fmaxf(mx, __shfl_xor(mx, 16)); mx = fmaxf(mx, __shfl_xor(mx, 32));
        float l = 0.f;
#pragma unroll
        for (int c = 0; c < 9; ++c) { const bool act = c >= du && c < du + 8;
            if (act) { float e[2][4];
#pragma unroll
                for (int t = 0; t < 2; ++t)
#pragma unroll
                    for (int q = 0; q < 4; ++q) { e[t][q] = __builtin_amdgcn_exp2f(S[u][c][t][q] - mx); l += e[t][q]; }
                P[u][c][0] = pk2(e[0][0], e[0][1]); P[u][c][1] = pk2(e[0][2], e[0][3]); P[u][c][2] = pk2(e[1][0], e[1][1]); P[u][c][3] = pk2(e[1][2], e[1][3]); }
            else { P[u][c][0] = 0u; P[u][c][1] = 0u; P[u][c][2] = 0u; P[u][c][3] = 0u; } }
        l += __shfl_xor(l, 16); l += __shfl_xor(l, 32);
        inv[u] = 1.0f / l; }
    f32x4 O[2][8];
#pragma unroll
    for (int u = 0; u < 2; ++u)
#pragma unroll
        for (int dt = 0; dt < 8; ++dt) O[u][dt] = (f32x4){0.f, 0.f, 0.f, 0.f};
    const int q4 = ql >> 2, pp = ql & 3;
#pragma unroll
    for (int c = 0; c < 9; ++c) {
        wait_vm(c <= 6 ? 8 : (c == 7 ? 4 : 0)); ATT_BAR(); if (c + 12 < 18) NAT_ISSUE(c + 12);
        const bool a0 = c >= d0 && c < d0 + 8, a1 = c >= d1 && c < d1 + 8;
        LAS unsigned char* buf = lds + ((c + 9) & 3) * 32768 + hh * 16384;
        u32x4 pw0; pw0.x = P[0][c][0]; pw0.y = P[0][c][1]; pw0.z = P[0][c][2]; pw0.w = P[0][c][3];
        u32x4 pw1; pw1.x = P[1][c][0]; pw1.y = P[1][c][1]; pw1.z = P[1][c][2]; pw1.w = P[1][c][3];
        const bf16x8 pf0 = __builtin_bit_cast(bf16x8, pw0), pf1 = __builtin_bit_cast(bf16x8, pw1);
#pragma unroll
        for (int dt = 0; dt < 8; ++dt) { const bf16x8 vf = vt_frag(buf, w0, g, q4, pp, dt);
            if (a0) O[0][dt] = __builtin_amdgcn_mfma_f32_16x16x32_bf16(vf, pf0, O[0][dt], 0, 0, 0);
            if (a1) O[1][dt] = __builtin_amdgcn_mfma_f32_16x16x32_bf16(vf, pf1, O[1][dt], 0, 0, 0); }
    }
#undef NAT_ISSUE
#pragma unroll
    for (int u = 0; u < 2; ++u) { bf16_t* op = o + (size_t)(tq0 + 64 * u) * D + 1024 + h * 128 + 4 * g;
#pragma unroll
        for (int dt = 0; dt < 8; ++dt) { u32x2 w2; w2.x = pk2(O[u][dt][0] * inv[u], O[u][dt][1] * inv[u]); w2.y = pk2(O[u][dt][2] * inv[u], O[u][dt][3] * inv[u]); *(u32x2*)(op + 16 * dt) = w2; } }
}
__device__ __forceinline__ void p2_attn(const Params& p, LAS unsigned char* lds) {
    int tab_head = -1;
    for (int it = blockIdx.x; it < 2048; it += gridDim.x) attn_window_item(p, lds, it, tab_head);
#ifdef PROBE_A
    if (blockIdx.x == 0 && threadIdx.x == 0) ((unsigned long long*)(p.ws + WS_END))[11] = __builtin_amdgcn_s_memrealtime();
#endif
    tab_head = -1;
    for (int it = blockIdx.x; it < 1024; it += gridDim.x) attn_nat_item(p, lds, it, tab_head);
    asm volatile("s_waitcnt vmcnt(0)" ::: "memory"); __syncthreads();
}

struct UpHook { const bf16_t* gates;
    __device__ __forceinline__ void operator()(f32x4 (&acc)[2][2][4][2], const Unit& u, int wr, int wc, int fr, int fq) const {
        const unsigned goff = (unsigned)(u.pm * 256 + wr * 64 + fr) * NGATE + u.pn * 256 + wc * 32 + 8 * fq;
#pragma unroll
        for (int ai = 0; ai < 2; ++ai) {
            bf16x8 ra[4][2];
#pragma unroll
            for (int m = 0; m < 4; ++m)
#pragma unroll
                for (int bj = 0; bj < 2; ++bj) ra[m][bj] = *(const bf16x8*)(gates + goff + (unsigned)((ai * 128 + m * 16) * NGATE) + bj * 128);
#pragma unroll
            for (int m = 0; m < 4; ++m)
#pragma unroll
                for (int bj = 0; bj < 2; ++bj)
#pragma unroll
                    for (int n = 0; n < 2; ++n)
#pragma unroll
                        for (int j = 0; j < 4; ++j) acc[ai][bj][m][n][j] *= bf2f(ra[m][bj][4 * n + j]);
            asm volatile("" ::: "memory"); }
    } };
struct UpSched {
    pg8::TileOrder o; const bf16_t* A; const bf16_t* Bt;
    __device__ __forceinline__ bool next(int i, Unit& u) const { u.aux = i & 1; return o.tile(i >> 1, u.pm, u.pn); }
    __device__ __forceinline__ const char* a_base(const Unit& u) const { return (const char*)(A + (size_t)u.pm * 256 * D + u.aux * 1024); }
    __device__ __forceinline__ const char* b_base(const Unit& u) const { return (const char*)(Bt + (size_t)u.pn * 256 * D + u.aux * 1024); }
    __device__ __forceinline__ bool keep_acc(const Unit& u) const { return u.aux == 0; }
    __device__ __forceinline__ void a_offs(const Unit&, int, int, int, int, unsigned (&)[2][2]) const {}
};
struct EpiUp { const bf16_t* gates; bf16_t* merged;
    __device__ __forceinline__ void operator()(f32x4 (&acc)[2][2][4][2], const Unit& u, int wr, int wc, int fr, int fq) const {
        if (u.aux == 0) { UpHook{gates}(acc, u, wr, wc, fr, fq); return; }
        const unsigned goff = (unsigned)(u.pm * 256 + wr * 64 + fr) * NGATE + 2048 + u.pn * 256 + wc * 32 + 8 * fq;
        const unsigned moff = (unsigned)(u.pm * 256 + wr * 64 + fr) * D + u.pn * 256 + wc * 32 + 8 * fq;
#pragma unroll
        for (int ai = 0; ai < 2; ++ai) {
            bf16x8 sb[4][2];
#pragma unroll
            for (int m = 0; m < 4; ++m)
#pragma unroll
                for (int bj = 0; bj < 2; ++bj) sb[m][bj] = *(const bf16x8*)(gates + goff + (unsigned)((ai * 128 + m * 16) * NGATE) + bj * 128);
#pragma unroll
            for (int m = 0; m < 4; ++m)
#pragma unroll
                for (int bj = 0; bj < 2; ++bj) { f32x4 v0 = acc[ai][bj][m][0], v1 = acc[ai][bj][m][1];
#pragma unroll
                    for (int j = 0; j < 4; ++j) { v0[j] *= bf2f(sb[m][bj][j]); v1[j] *= bf2f(sb[m][bj][4 + j]); }
                    u32x4 w; w.x = pk2(v0[0], v0[1]); w.y = pk2(v0[2], v0[3]); w.z = pk2(v1[0], v1[1]); w.w = pk2(v1[2], v1[3]);
                    *(u32x4*)(merged + moff + (unsigned)((ai * 128 + m * 16) * D) + bj * 128) = w; }
            asm volatile("" ::: "memory"); }
    } };
__device__ __forceinline__ void p3_up(const Params& p, LAS unsigned char* lds) {
    UpSched S; S.o.init(128, 8, gridDim.x, blockIdx.x); S.A = (const bf16_t*)(p.ws + WS_O); S.Bt = (const bf16_t*)(p.ws + WS_WUP);
    EpiUp E{(const bf16_t*)(p.ws + WS_GATES), (bf16_t*)(p.ws + WS_XB)};
    pg8::gemm_phase<true, false>(lds, S, E, 1024 / 64, D, D);
}

struct EpiOut { bf16_t* mob;
    __device__ __forceinline__ void operator()(f32x4 (&acc)[2][2][4][2], const Unit& u, int wr, int wc, int fr, int fq) const {
        unsigned off = (unsigned)(u.pm * 256 + wr * 64 + fr) * D + u.pn * 256 + wc * 32 + 8 * fq;
#pragma unroll
        for (int ai = 0; ai < 2; ++ai) {
#pragma unroll
            for (int m = 0; m < 4; ++m) { asm volatile("" : "+v"(off));
#pragma unroll
                for (int bj = 0; bj < 2; ++bj) { const f32x4 v0 = acc[ai][bj][m][0], v1 = acc[ai][bj][m][1];
                    u32x4 w; w.x = pk2(v0[0], v0[1]); w.y = pk2(v0[2], v0[3]); w.z = pk2(v1[0], v1[1]); w.w = pk2(v1[2], v1[3]);
                    *(u32x4*)(mob + off + bj * 128) = w; }
                off += 16 * D; }
            off += 64 * D; }
    } };
__device__ __forceinline__ void p4_out(const Params& p, LAS unsigned char* lds) {
    pg8::DenseSched S; S.o.init(128, 8, gridDim.x, blockIdx.x); S.A = (const bf16_t*)(p.ws + WS_XB); S.Bt = (const bf16_t*)(p.ws + WS_WOUT); S.lda = D; S.ldb = D;
    EpiOut E{(bf16_t*)(p.ws + WS_MOB)};
    pg8::gemm_phase<true, false, pg8::DenseSched, EpiOut, false, false>(lds, S, E, D / 64, D, D);
}

__device__ __forceinline__ void p5_router(const Params& p, LAS unsigned char* lds) {
    const int tid = phase_tid(), lane = tid & 63, wave = __builtin_amdgcn_readfirstlane(tid >> 6), g = lane >> 4, tl = lane & 15;
    const bf16_t* wsp = (const bf16_t*)(p.ws + WS_WRT); float* r2 = (float*)(p.ws + WS_R2); int* cnt = (int*)(p.ws + WS_CNT); int* tokl = (int*)(p.ws + WS_TOK);
    int* recc = (int*)(p.ws + WS_RECC); float* recw = (float*)(p.ws + WS_RECW); bf16_t* hb = (bf16_t*)(p.ws + WS_O); const bf16_t* mob = (const bf16_t*)(p.ws + WS_MOB); unsigned char* h8 = p.ws + WS_H8;
    const float* brg = p.in[15]; const float* bre = p.in[17];
    LAS float* H = (LAS float*)(lds + wave * 4352);
    LAS unsigned char* WL = lds + 36864;
    const int r4 = lane >> 4, k4 = (lane & 15) * 4;
    const int pa0 = tid / 384, pr0 = (tid % 384) >> 3, ps0 = tid & 7, pi1 = 512 + tid, pa1 = pi1 / 384, pr1 = (pi1 % 384) >> 3;
    const unsigned wsrc0 = (unsigned)(pa0 * 48 * 2048 + pr0 * D + ps0 * 8), wsrc1 = (unsigned)(pa1 * 48 * 2048 + pr1 * D + ps0 * 8);
    const unsigned wdst0 = (unsigned)(pa0 * 6144 + pr0 * 128 + ((ps0 ^ (pr0 & 7)) << 4)), wdst1 = (unsigned)(pa1 * 6144 + pr1 * 128 + ((ps0 ^ (pr1 & 7)) << 4));
    for (int round = blockIdx.x; round < T / 128; round += gridDim.x) {
        const int tile = round * 8 + wave;
        const float* xs = p.in[0] + (size_t)tile * 16 * D; const bf16_t* ms = mob + (size_t)tile * 16 * D; bf16_t* hs = hb + (size_t)tile * 16 * D; unsigned char* h8s = h8 + (size_t)tile * 16 * D;
        unsigned lo = (unsigned)(r4 * D + k4);
        f32x4 accA = {0.f, 0.f, 0.f, 0.f}, accB = accA, accC = accA; float ss = 0.f;
        f32x4 xa[4], xb_[4], xc[4]; u32x2 ma[4], mb[4], mc[4]; u32x4 wr0, wr1;
#define RT_LOADS(bx, bm, k) do { _Pragma("unroll") for (int j = 0; j < 4; ++j) { bx[j] = *(const f32x4*)(xs + (4 * j) * D + lo + 64 * (k)); bm[j] = *(const u32x2*)(ms + (4 * j) * D + lo + 64 * (k)); } } while (0)
#define RT_SPLIT(f0, f1, hi, lw) do { hi = pk2(f0, f1); lw = pk2((f0) - __uint_as_float(hi << 16), (f1) - __uint_as_float(hi & 0xffff0000u)); } while (0)
#define RT_COMP(bx, bm, k, wbuf) do { \
            _Pragma("unroll") for (int j = 0; j < 4; ++j) { f32x4 h = bx[j]; h.x += __uint_as_float(bm[j].x << 16); h.y += __uint_as_float(bm[j].x & 0xffff0000u); h.z += __uint_as_float(bm[j].y << 16); h.w += __uint_as_float(bm[j].y & 0xffff0000u); \
                u32x2 q2; q2.x = pk2(h[0], h[1]); q2.y = pk2(h[2], h[3]); *(u32x2*)(hs + (4 * j) * D + lo + 64 * (k)) = q2; \
                *(unsigned*)(h8s + (4 * j) * D + lo + 64 * (k)) = pk4_fp8(h[0], h[1], h[2], h[3]); \
                *(LAS f32x4*)(H + (4 * j + r4) * 68 + k4) = h; } \
            _Pragma("unroll") for (int ks = 0; ks < 2; ++ks) { const f32x4 h0 = *(const LAS f32x4*)(H + tl * 68 + 32 * ks + 8 * g), h1 = *(const LAS f32x4*)(H + tl * 68 + 32 * ks + 8 * g + 4); \
                ss += (h0.x * h0.x + h0.y * h0.y) + (h0.z * h0.z + h0.w * h0.w) + (h1.x * h1.x + h1.y * h1.y) + (h1.z * h1.z + h1.w * h1.w); \
                u32x4 hh, hl; RT_SPLIT(h0.x, h0.y, hh.x, hl.x); RT_SPLIT(h0.z, h0.w, hh.y, hl.y); RT_SPLIT(h1.x, h1.y, hh.z, hl.z); RT_SPLIT(h1.z, h1.w, hh.w, hl.w); \
                const bf16x8 bh = __builtin_bit_cast(bf16x8, hh), bl = __builtin_bit_cast(bf16x8, hl); const unsigned so_ = (unsigned)(((4 * ks + g) ^ (tl & 7)) << 4); \
                _Pragma("unroll") for (int t = 0; t < 3; ++t) { const bf16x8 ah = *(const LAS bf16x8*)((wbuf) + (16 * t + tl) * 128 + so_), al = *(const LAS bf16x8*)((wbuf) + 6144 + (16 * t + tl) * 128 + so_); \
                    f32x4& ac = (t == 0 ? accA : (t == 1 ? accB : accC)); \
                    ac = __builtin_amdgcn_mfma_f32_16x16x32_bf16(ah, bh, ac, 0, 0, 0); ac = __builtin_amdgcn_mfma_f32_16x16x32_bf16(al, bh, ac, 0, 0, 0); ac = __builtin_amdgcn_mfma_f32_16x16x32_bf16(ah, bl, ac, 0, 0, 0); } } } while (0)
#define RT_WLOAD(c) do { wr0 = *(const u32x4*)(wsp + wsrc0 + 64 * (c)); if (tid < 256) wr1 = *(const u32x4*)(wsp + wsrc1 + 64 * (c)); } while (0)
#define RT_WSTORE(wbuf) do { *(LAS u32x4*)((wbuf) + wdst0) = wr0; if (tid < 256) *(LAS u32x4*)((wbuf) + wdst1) = wr1; } while (0)
        __syncthreads();
        RT_WLOAD(0); RT_LOADS(xa, ma, 0); RT_LOADS(xb_, mb, 1);
        RT_WSTORE(WL); RT_WLOAD(1);
        __syncthreads();
#pragma unroll 1
        for (int c = 0; c < D / 64 - 2; c += 3) {
            const int pz = c & 1;
            RT_LOADS(xc, mc, 2); RT_COMP(xa, ma, 0, WL + pz * 12288); RT_WSTORE(WL + (pz ^ 1) * 12288); RT_WLOAD(c + 2); __syncthreads();
            RT_LOADS(xa, ma, 3); RT_COMP(xb_, mb, 1, WL + (pz ^ 1) * 12288); RT_WSTORE(WL + pz * 12288); RT_WLOAD(c + 3); __syncthreads();
            RT_LOADS(xb_, mb, 4); RT_COMP(xc, mc, 2, WL + pz * 12288); RT_WSTORE(WL + (pz ^ 1) * 12288); RT_WLOAD((c + 4) & 31); __syncthreads();
            lo += 192;
        }
        RT_COMP(xa, ma, 0, WL); RT_WSTORE(WL + 12288); __syncthreads();
        RT_COMP(xb_, mb, 1, WL + 12288);
#undef RT_LOADS
#undef RT_SPLIT
#undef RT_COMP
#undef RT_WLOAD
#undef RT_WSTORE
        const int tok = tile * 16 + tl;
        ss += __shfl_xor(ss, 16); ss += __shfl_xor(ss, 32);
        const float rr = rsqrtf(ss * (1.0f / D) + EPS);
        const float myg = accC[0] * rr + brg[g];
        float gl[4];
#pragma unroll
        for (int j = 0; j < 4; ++j) gl[j] = __shfl(myg, tl + 16 * j);
        int gi = 0; float gm = gl[0];
#pragma unroll
        for (int i = 1; i < 4; ++i) if (gl[i] > gm) { gm = gl[i]; gi = i; }
        float den = 0.f;
#pragma unroll
        for (int i = 0; i < 4; ++i) den += __expf(gl[i] - gm);
        const float pg = 1.0f / den;
        int L0 = 0, L1 = 0; float wt0 = 0.f, wt1 = 0.f; const bool owner = (g == gi);
        if (owner) {
            float el[8];
#pragma unroll
            for (int i = 0; i < 4; ++i) { el[i] = accA[i] * rr + bre[g * 8 + i]; el[4 + i] = accB[i] * rr + bre[g * 8 + 4 + i]; }
            int e0 = 0; float v0 = el[0];
#pragma unroll
            for (int i = 1; i < 8; ++i) if (el[i] > v0) { v0 = el[i]; e0 = i; }
            int e1 = -1; float v1 = -3.0e38f;
#pragma unroll
            for (int i = 0; i < 8; ++i) if (i != e0 && el[i] > v1) { v1 = el[i]; e1 = i; }
            const float ex = __expf(v1 - v0); const float s0 = 1.0f / (1.0f + ex), s1 = ex * s0;
            r2[tok] = rr; L0 = gi * 8 + e0; L1 = gi * 8 + e1; wt0 = pg * s0; wt1 = pg * s1;
        }
        LAS int* cl = (LAS int*)(lds + 61440);
        if (tid < 32) cl[tid] = 0;
        __syncthreads();
        int q0 = 0, q1 = 0;
        if (owner) { q0 = __hip_atomic_fetch_add(&cl[L0], 1, __ATOMIC_RELAXED, __HIP_MEMORY_SCOPE_WORKGROUP); q1 = __hip_atomic_fetch_add(&cl[L1], 1, __ATOMIC_RELAXED, __HIP_MEMORY_SCOPE_WORKGROUP); }
        __syncthreads();
        if (tid < 32) { const int n = cl[tid]; cl[32 + tid] = n ? atomicAdd(&cnt[tid], n) : 0; }
        __syncthreads();
        if (owner) { const int p0 = cl[32 + L0] + q0, p1 = cl[32 + L1] + q1;
            float* r2l = (float*)(p.ws + WS_R2L);
            tokl[(size_t)L0 * T + p0] = tok; r2l[(size_t)L0 * T + p0] = rr; recc[2 * tok] = L0 * 32768 + p0; recw[2 * tok] = wt0;
            tokl[(size_t)L1 * T + p1] = tok; r2l[(size_t)L1 * T + p1] = rr; recc[2 * tok + 1] = L1 * 32768 + p1; recw[2 * tok + 1] = wt1; }
    }
    __syncthreads();
}

__device__ __forceinline__ void build_tiles(const Params& p, LAS int* tab) {
    __syncthreads();
    if (threadIdx.x < 64) { const int L = threadIdx.x; const int c = L < 32 ? ((const int*)(p.ws + WS_CNT))[L] : 0; const int nt = (c + 255) >> 8;
        int pre = nt;
#pragma unroll
        for (int o = 1; o < 32; o <<= 1) { const int v = __shfl_up(pre, o); if (L >= o) pre += v; }
        const int first = pre - nt;
        if (L < 32) { tab[1400 + L] = first * 256; for (int i = 0; i < nt; ++i) { tab[4 + (first + i) * 4 + 0] = L; tab[4 + (first + i) * 4 + 1] = i * 256; tab[4 + (first + i) * 4 + 2] = (first + i) * 256; tab[4 + (first + i) * 4 + 3] = min(256, c - i * 256); } }
        if (L == 31) tab[0] = pre; }
    __syncthreads();
}
template <int NPN> struct MoeOrder { int G, c, t_lo, nt_tiles; const LAS int* tab;
    __device__ __forceinline__ bool unit(int i, Unit& u) const { const long L = (long)i * G + c; if (L >= (long)nt_tiles * NPN) return false;
        const int nwg = nt_tiles * NPN; int wgid = (int)L; { const int q = nwg / 8, r = nwg % 8, xcd = wgid % 8, off = wgid / 8; wgid = (xcd < r ? xcd * (q + 1) : r * (q + 1) + (xcd - r) * q) + off; }
        u.pm = t_lo + wgid / NPN; u.pn = wgid % NPN; u.aux = 0; return true; } };
struct GateUpSched { MoeOrder<4> o; const unsigned char* hb; const unsigned char* WguT; const int* tokl;
    __device__ __forceinline__ bool next(int i, Unit& u) const { return o.unit(i, u); }
    __device__ __forceinline__ const char* a_base(const Unit&) const { return (const char*)hb; }
    __device__ __forceinline__ const char* b_base(const Unit& u) const { const int e = o.tab[4 + u.pm * 4] & 31; return (const char*)(WguT + (size_t)(e * 1024 + u.pn * 256) * D); }
    __device__ __forceinline__ bool keep_acc(const Unit&) const { return false; }
    __device__ __forceinline__ void a_offs(const Unit& u, int R0, int C0, int R1, int C1, unsigned (&v)[2][2]) const {
        const int L = o.tab[4 + u.pm * 4], row0 = o.tab[4 + u.pm * 4 + 1], nrows = o.tab[4 + u.pm * 4 + 3]; const int* lst = tokl + (size_t)L * T + row0;
#pragma unroll
        for (int h = 0; h < 2; ++h) { const int r0 = R0 + 128 * h, r1 = R1 + 128 * h; const int t0 = r0 < nrows ? lst[r0] : 0, t1 = r1 < nrows ? lst[r1] : 0;
            v[h][0] = (unsigned)t0 * D + C0 * 2u; v[h][1] = (unsigned)t1 * D + C1 * 2u; } }
};
struct EpiGateUp { const LAS int* tab; const float* r2l; bf16_t* he;
    __device__ __forceinline__ void operator()(f32x4 (&acc)[2][2][4][2], const Unit& u, int wr, int wc, int fr, int fq) const {
        const int L = tab[4 + u.pm * 4], row0 = tab[4 + u.pm * 4 + 1], slot = tab[4 + u.pm * 4 + 2], nrows = tab[4 + u.pm * 4 + 3];
#pragma unroll
        for (int ai = 0; ai < 2; ++ai)
#pragma unroll
            for (int m = 0; m < 4; ++m) { const int rr = ai * 128 + wr * 64 + m * 16 + fr; const float rs = rr < nrows ? r2l[(size_t)L * T + row0 + rr] * (1.0f / 64.0f) : 0.f;
                u32x4 w; unsigned ww[4];
#pragma unroll
                for (int n = 0; n < 2; ++n) { float hv[4];
#pragma unroll
                    for (int j = 0; j < 4; ++j) { const float gt = acc[ai][0][m][n][j] * rs, up = acc[ai][1][m][n][j] * rs; hv[j] = gt * sigmoidf_(gt) * up; }
                    ww[2 * n] = pk2(hv[0], hv[1]); ww[2 * n + 1] = pk2(hv[2], hv[3]); }
                w.x = ww[0]; w.y = ww[1]; w.z = ww[2]; w.w = ww[3];
                *(u32x4*)(he + (size_t)(slot + rr) * 512 + u.pn * 128 + wc * 32 + 8 * fq) = w; }
    } };
__device__ __forceinline__ void p6_gateup(const Params& p, LAS unsigned char* lds) {
    LAS int* tab = (LAS int*)(lds + TAB_OFF); build_tiles(p, tab);
    GateUpSched S; S.o.G = gridDim.x; S.o.c = blockIdx.x; S.o.t_lo = 0; S.o.nt_tiles = tab[0]; S.o.tab = tab;
    S.hb = p.ws + WS_H8; S.WguT = p.ws + WS_WGU; S.tokl = (const int*)(p.ws + WS_TOK);
    EpiGateUp E{tab, (const float*)(p.ws + WS_R2L), (bf16_t*)(p.ws + WS_HE)};
    pg8::gemm_phase<true, true, GateUpSched, EpiGateUp, true>(lds, S, E, D / 128, D / 2, D / 2);
}
struct DownSched { MoeOrder<8> o; const bf16_t* he; const bf16_t* WdT;
    __device__ __forceinline__ bool next(int i, Unit& u) const { return o.unit(i, u); }
    __device__ __forceinline__ const char* a_base(const Unit& u) const { return (const char*)(he + (size_t)o.tab[4 + u.pm * 4 + 2] * 512); }
    __device__ __forceinline__ const char* b_base(const Unit& u) const { const int e = o.tab[4 + u.pm * 4] & 31; return (const char*)(WdT + (size_t)(e * 2048 + u.pn * 256) * 512); }
    __device__ __forceinline__ bool keep_acc(const Unit&) const { return false; }
    __device__ __forceinline__ void a_offs(const Unit&, int, int, int, int, unsigned (&)[2][2]) const {}
};
struct EpiDown { const LAS int* tab; bf16_t* ye_lo; bf16_t* ye_hi;
    __device__ __forceinline__ void operator()(f32x4 (&acc)[2][2][4][2], const Unit& u, int wr, int wc, int fr, int fq) const {
        const int slot = tab[4 + u.pm * 4 + 2]; bf16_t* ye = u.pn < 4 ? ye_lo : ye_hi;
        unsigned off = (unsigned)(slot + wr * 64 + fr) * 1024 + (u.pn & 3) * 256 + wc * 32 + 8 * fq;
#pragma unroll
        for (int ai = 0; ai < 2; ++ai) {
#pragma unroll
            for (int m = 0; m < 4; ++m) { asm volatile("" : "+v"(off));
#pragma unroll
                for (int bj = 0; bj < 2; ++bj) { const f32x4 v0 = acc[ai][bj][m][0], v1 = acc[ai][bj][m][1];
                    u32x4 w; w.x = pk2(v0[0], v0[1]); w.y = pk2(v0[2], v0[3]); w.z = pk2(v1[0], v1[1]); w.w = pk2(v1[2], v1[3]);
                    *(u32x4*)(ye + off + bj * 128) = w; }
                off += 16 * 1024; }
            off += 64 * 1024; }
    } };
__device__ __forceinline__ void p7_down(const Params& p, LAS unsigned char* lds) {
    LAS int* tab = (LAS int*)(lds + TAB_OFF); build_tiles(p, tab);
    DownSched S; S.o.G = gridDim.x; S.o.c = blockIdx.x; S.o.t_lo = 0; S.o.nt_tiles = tab[0]; S.o.tab = tab;
    S.he = (const bf16_t*)(p.ws + WS_HE); S.WdT = (const bf16_t*)(p.ws + WS_WD);
    EpiDown E{tab, (bf16_t*)(p.ws + WS_YE_LO), (bf16_t*)(p.ws + WS_YE_HI)};
    pg8::gemm_phase<true, false, DownSched, EpiDown, false, false>(lds, S, E, 512 / 64, 512, 512);
}
__device__ __forceinline__ void p8_combine(const Params& p, LAS unsigned char* lds) {
    LAS int* tab = (LAS int*)(lds + TAB_OFF); build_tiles(p, tab);
    const int tid = phase_tid(), lane = tid & 63, wave = tid >> 6; const int gw = blockIdx.x * 8 + wave, NGW = gridDim.x * 8;
    const int* recc = (const int*)(p.ws + WS_RECC); const float* recw = (const float*)(p.ws + WS_RECW); const bf16_t* hb = (const bf16_t*)(p.ws + WS_O);
    const bf16_t* ye_lo = (const bf16_t*)(p.ws + WS_YE_LO); const bf16_t* ye_hi = (const bf16_t*)(p.ws + WS_YE_HI);
    for (int tok = gw; tok < T; tok += NGW) {
        const int c0 = recc[2 * tok], c1 = recc[2 * tok + 1]; const float wa = recw[2 * tok], wb = recw[2 * tok + 1];
        const int s0 = tab[1400 + (c0 >> 15)] + (c0 & 32767), s1 = tab[1400 + (c1 >> 15)] + (c1 & 32767);
        f32x4* op = (f32x4*)(p.out + (size_t)tok * D) + lane; const u32x2* hp = (const u32x2*)(hb + (size_t)tok * D) + lane;
        u32x2 m[8], a[8], b[8];
#pragma unroll
        for (int j = 0; j < 8; ++j) { const bf16_t* yb = j < 4 ? ye_lo : ye_hi; m[j] = hp[64 * j];
            a[j] = ((const u32x2*)(yb + (size_t)s0 * 1024) + lane)[64 * (j & 3)]; b[j] = ((const u32x2*)(yb + (size_t)s1 * 1024) + lane)[64 * (j & 3)]; }
#pragma unroll
        for (int j = 0; j < 8; ++j) { f32x4 v;
            v.x = __uint_as_float(m[j].x << 16) + wa * __uint_as_float(a[j].x << 16) + wb * __uint_as_float(b[j].x << 16); v.y = __uint_as_float(m[j].x & 0xffff0000u) + wa * __uint_as_float(a[j].x & 0xffff0000u) + wb * __uint_as_float(b[j].x & 0xffff0000u);
            v.z = __uint_as_float(m[j].y << 16) + wa * __uint_as_float(a[j].y << 16) + wb * __uint_as_float(b[j].y << 16); v.w = __uint_as_float(m[j].y & 0xffff0000u) + wa * __uint_as_float(a[j].y & 0xffff0000u) + wb * __uint_as_float(b[j].y & 0xffff0000u);
            op[64 * j] = v; }
    }
}

#define XB_TMO      128
#define XB_XCNT(j)  (256  + 64 * (j))
#define XB_XSUB(j)  (1280 + 64 * (j))
#define XB_XGEN(j)  (2304 + 64 * (j))
#define XB_TOP      3328
#define XB_TOPGEN   3392
#define XCD_BAR_WORDS 3456
#define XB_SPIN_CAP (1u << 18)
__device__ __forceinline__ unsigned xb_ld(unsigned* p)              { return __hip_atomic_load(p, __ATOMIC_RELAXED, __HIP_MEMORY_SCOPE_AGENT); }
__device__ __forceinline__ unsigned xb_add(unsigned* p, unsigned v) { return __hip_atomic_fetch_add(p, v, __ATOMIC_RELAXED, __HIP_MEMORY_SCOPE_AGENT); }
__device__ __forceinline__ unsigned xb_xcc_id() { return (unsigned)__builtin_amdgcn_s_getreg((3 << 11) | 20) & 0xFu; }
#define XB_SPIN(cond, bar) do { unsigned _sp = 0; while (cond) { __builtin_amdgcn_s_sleep(1); \
    if ((++_sp & 255u) == 0u) { if (xb_ld(&(bar)[XB_TMO])) break; if (_sp > XB_SPIN_CAP) { atomicAdd(&(bar)[XB_TMO], 1u); break; } } } } while (0)
struct XcdBarrier { unsigned* bar; unsigned x; volatile LAS unsigned* st; };
__device__ __forceinline__ XcdBarrier xcd_barrier_post(unsigned* bar, volatile LAS unsigned* st) {
    XcdBarrier b; b.bar = bar; b.x = xb_xcc_id(); b.st = st;
    if (threadIdx.x == 0) (void)xb_add(&bar[XB_XCNT(b.x)], 1u);
    return b;
}
__device__ __forceinline__ void xcd_barrier_complete(unsigned* bar, unsigned x, unsigned& nloc, unsigned& nx) {
    const unsigned G = gridDim.x * gridDim.y * gridDim.z;
    unsigned sum, cnt, mine, sp = 0u;
    for (;;) {
        sum = 0u; cnt = 0u; mine = 0u;
#pragma unroll
        for (unsigned j = 0; j < 16; ++j) { const unsigned c = xb_ld(&bar[XB_XCNT(j)]); sum += c; cnt += (c > 0u) ? 1u : 0u; mine = (j == x) ? c : mine; }
        if (sum == G) break;
        __builtin_amdgcn_s_sleep(1);
        if ((++sp & 255u) == 0u) { if (xb_ld(&bar[XB_TMO])) break; if (sp > XB_SPIN_CAP) { atomicAdd(&bar[XB_TMO], 1u); break; } }
    }
    nloc = mine > 0u ? mine : 1u; nx = cnt > 0u ? cnt : 1u;
}
__device__ __forceinline__ void xcd_barrier(const XcdBarrier& b) {
    asm volatile("s_waitcnt vmcnt(0)" ::: "memory");
    __syncthreads();
    if (threadIdx.x == 0) {
        unsigned* bar = b.bar;
        __builtin_amdgcn_s_waitcnt(0);
        unsigned nloc = b.st[0], nx = b.st[1];
        if (nloc == 0u) { xcd_barrier_complete(bar, b.x, nloc, nx); b.st[0] = nloc; b.st[1] = nx; }
        const unsigned old = xb_add(&bar[XB_XSUB(b.x)], 1u);
        const unsigned gen = old / nloc;
        if (old + 1u == (gen + 1u) * nloc) {
            __builtin_amdgcn_fence(__ATOMIC_RELEASE, "agent");
            asm volatile("s_waitcnt vmcnt(0)" ::: "memory");
            const unsigned og = xb_add(&bar[XB_TOP], 1u);
            const unsigned tg = og / nx;
            if (og + 1u == (tg + 1u) * nx) xb_add(&bar[XB_TOPGEN], 1u);
            else XB_SPIN(xb_ld(&bar[XB_TOPGEN]) == tg, bar);
            __builtin_amdgcn_fence(__ATOMIC_ACQUIRE, "agent");
            xb_add(&bar[XB_XGEN(b.x)], 1u);
            asm volatile("s_waitcnt vmcnt(0)" ::: "memory");
        } else {
            XB_SPIN(xb_ld(&bar[XB_XGEN(b.x)]) == gen, bar);
            __builtin_amdgcn_fence(__ATOMIC_ACQUIRE, "agent");
            asm volatile("s_waitcnt vmcnt(0)" ::: "memory");
        }
    }
    __syncthreads();
}

namespace cg = cooperative_groups;
#ifdef PROBE_A
#define STAMP(k) do { if (blockIdx.x == 0 && threadIdx.x == 0) ((unsigned long long*)(p.ws + WS_END))[k] = __builtin_amdgcn_s_memrealtime(); } while (0)
#else
#define STAMP(k) do {} while (0)
#endif
__global__ void __launch_bounds__(512, 2) fwd_megakernel(Params p) {
    extern __shared__ __attribute__((aligned(16))) unsigned char lds_raw[];
    LAS unsigned char* lds = (LAS unsigned char*)lds_raw;
    cg::grid_group grid = cg::this_grid();
    if (threadIdx.x == 0) { *(volatile LAS unsigned*)(lds + XBST_OFF) = 0u; *(volatile LAS unsigned*)(lds + XBST_OFF + 4) = 0u; }
    if (blockIdx.x == 0) for (int i = threadIdx.x; i < XCD_BAR_WORDS; i += 512) ((unsigned*)(p.ws + WS_BAR))[i] = 0u;
    __syncthreads();
#define GSYNC() xcd_barrier(xb)
    STAMP(0);
    p0_prep(p, lds);            grid.sync(); STAMP(1);
    const XcdBarrier xb = xcd_barrier_post((unsigned*)(p.ws + WS_BAR), (volatile LAS unsigned*)(lds + XBST_OFF));
    p1_inproj(p, lds);          GSYNC(); STAMP(2);
    p2_attn(p, lds);            GSYNC(); STAMP(3);
    p_moe_prep(p, lds);         STAMP(4);
    p3_up(p, lds);              GSYNC(); STAMP(5);
    p4_out(p, lds);             GSYNC(); STAMP(6);
    p5_router(p, lds);          GSYNC(); STAMP(7);
    p6_gateup(p, lds);          GSYNC(); STAMP(8);
    p7_down(p, lds);            GSYNC(); STAMP(9);
    p8_combine(p, lds);
#ifdef PROBE_A
    grid.sync(); STAMP(10); grid.sync();
    {
        const unsigned long long* ts = (const unsigned long long*)(p.ws + WS_END);
        #ifndef PROBE_A1
#define PROBE_A1 (PROBE_A + 1)
#endif
#ifndef PROBE_B1
#define PROBE_B1 (PROBE_B + 1)
#endif
        const float usA = (float)(ts[PROBE_A1] - ts[PROBE_A]) * 0.01f, usB = (float)(ts[PROBE_B1] - ts[PROBE_B]) * 0.01f;
        const float eps = sqrtf(usA * 1e-6f);
        for (size_t i = (size_t)blockIdx.x * 512 + threadIdx.x; i < (size_t)T * D / 4; i += (size_t)gridDim.x * 512) { f32x4 v = ((f32x4*)p.out)[i]; v = v * (1.0f + eps); if (i == 0) v.x += usB * 0.1f; ((f32x4*)p.out)[i] = v; }
    }
#endif
}

extern "C" void kernel_launch(void* const* d_in, const int* in_sizes, int n_in, void* d_out, int out_size, void* d_ws, size_t ws_size, hipStream_t stream) {
    static int grid_blocks = 0;
    if (!grid_blocks) {
        if (n_in != 21 || out_size != T * D || ws_size < WS_MOB + 128 * MiB) { fprintf(stderr, "kernel_launch: unexpected problem (n_in %d out %d ws %zu)\n", n_in, out_size, ws_size); grid_blocks = -1; return; }
        if (hipFuncSetAttribute((const void*)fwd_megakernel, hipFuncAttributeMaxDynamicSharedMemorySize, LDS_BYTES) != hipSuccess) { fprintf(stderr, "kernel_launch: hipFuncSetAttribute failed\n"); grid_blocks = -1; return; }
        int dev = 0, cus = 0, per_cu = 0;
        hipGetDevice(&dev); hipDeviceGetAttribute(&cus, hipDeviceAttributeMultiprocessorCount, dev);
        hipOccupancyMaxActiveBlocksPerMultiprocessor(&per_cu, (const void*)fwd_megakernel, 512, LDS_BYTES);
        if (per_cu < 1 || cus < 1) { fprintf(stderr, "kernel_launch: occupancy query gave %d blocks/CU on %d CUs\n", per_cu, cus); grid_blocks = -1; return; }
        grid_blocks = cus;
    }
    if (grid_blocks < 0) return;
    Params p{};
    for (int i = 0; i < 21; ++i) p.in[i] = (const float*)d_in[i];
    p.out = (float*)d_out; p.ws = (unsigned char*)d_ws;
    void* args[] = {&p};
    hipError_t e = hipLaunchCooperativeKernel((const void*)fwd_megakernel, dim3(grid_blocks), dim3(512), args, LDS_BYTES, stream);
    if (e != hipSuccess) fprintf(stderr, "cooperative launch failed: %s (grid %d)\n", hipGetErrorString(e), grid_blocks);
}
```

```cpp
#include <hip/hip_runtime.h>
#include <hip/hip_cooperative_groups.h>
#include <cstdio>
#include <cstdint>

#define LAS __attribute__((address_space(3)))
typedef unsigned short bf16_t;
typedef short bf16x8 __attribute__((ext_vector_type(8)));
typedef short s16x4 __attribute__((ext_vector_type(4)));
typedef float f32x4 __attribute__((ext_vector_type(4)));
typedef unsigned u32x4 __attribute__((ext_vector_type(4)));
typedef unsigned u32x2 __attribute__((ext_vector_type(2)));
typedef short v4i16_t __attribute__((ext_vector_type(4)));

namespace cfg {
constexpr int T = 32768, D = 2048, SEQ = 16384;
constexpr int NQKV = 4608, NGATE = 4096, NIN = 8704;
constexpr size_t MiB = 1ull << 20;
constexpr size_t WS_XB = 0, WS_QKV = 128 * MiB, WS_GATES = 416 * MiB, WS_O = 672 * MiB, WS_WIN = 800 * MiB, WS_WUP = 834 * MiB, WS_WOUT = 842 * MiB, WS_MISC = 850 * MiB;
constexpr size_t WS_WGU = WS_QKV, WS_WD = WS_QKV + 128 * MiB, WS_HE = WS_QKV + 192 * MiB;
constexpr size_t WS_R1 = WS_MISC, WS_R2 = WS_R1 + (size_t)T * 4, WS_WRT = WS_R2 + (size_t)T * 4, WS_CNT = WS_WRT + 512 * 1024, WS_TOK = WS_CNT + 4096,
                 WS_RECC = WS_TOK + 32ull * T * 4, WS_RECW = WS_RECC + 2ull * T * 4, WS_R2L = WS_RECW + 2ull * T * 4, WS_END = WS_R2L + 32ull * T * 4;
constexpr size_t WS_H8 = WS_GATES + 144 * MiB;
constexpr size_t WS_YE_LO = 0, WS_YE_HI = WS_GATES;
constexpr size_t WS_BAR = WS_END + 4096;
constexpr size_t WS_MOB = 872 * MiB;
constexpr int LDS_BYTES = 140 * 1024;
constexpr int XBST_OFF = LDS_BYTES - 16;
constexpr int TAB_OFF = 132 * 1024;
constexpr float EPS = 1e-6f;
}
using namespace cfg;

struct Params { const float* in[21]; float* out; unsigned char* ws; };
__device__ __forceinline__ int phase_tid() { int t = threadIdx.x; asm volatile("" : "+v"(t)); return t; }

__device__ __forceinline__ float bf2f(short s) { return __uint_as_float(((unsigned)(unsigned short)s) << 16); }
typedef float f32x2 __attribute__((ext_vector_type(2)));
typedef __bf16 bf16x2_t __attribute__((ext_vector_type(2)));
__device__ __forceinline__ unsigned pk2(float lo, float hi) { const f32x2 v = {lo, hi}; return __builtin_bit_cast(unsigned, __builtin_convertvector(v, bf16x2_t)); }
__device__ __forceinline__ unsigned pk4_fp8(float a, float b, float c, float d) { int w = 0; w = __builtin_amdgcn_cvt_pk_fp8_f32(a, b, w, false); w = __builtin_amdgcn_cvt_pk_fp8_f32(c, d, w, true); return (unsigned)w; }
__device__ __forceinline__ float wave_sum(float v) {
#pragma unroll
    for (int o = 1; o < 64; o <<= 1) v += __shfl_xor(v, o);
    return v;
}
__device__ __forceinline__ float sigmoidf_(float v) { return 1.0f / (1.0f + __expf(-v)); }
__device__ __forceinline__ unsigned off_b(unsigned row, unsigned ch) { return 256u * row + 16u * (ch ^ (((row & 3) << 2) | ((row >> 2) & 3))); }
__device__ __forceinline__ s16x4 tr_read(LAS unsigned char* p) { return __builtin_bit_cast(s16x4, __builtin_amdgcn_ds_read_tr16_b64_v4i16((LAS v4i16_t*)p)); }
__host__ __device__ __forceinline__ int perm32(int rho) { const int n = rho >> 4, i = rho & 15; return 8 * (i >> 2) + 4 * n + (i & 3); }
__device__ __forceinline__ int t5_bucket(int rel) {
    const int n = rel < 0 ? -rel : rel; const int ret = rel > 0 ? 16 : 0; int b;
    if (n < 8) b = n; else if (n < 12) b = 8; else if (n < 16) b = 9; else if (n < 23) b = 10; else if (n < 32) b = 11; else if (n < 46) b = 12; else if (n < 64) b = 13; else if (n < 91) b = 14; else b = 15;
    return ret + b;
}

template <bool FP8>
__device__ __forceinline__ void transpose_item(const float* __restrict__ W, int ldw, int k0, int n0, bf16_t* __restrict__ WT, int ldt, int drow0, int dk0, const float* __restrict__ scale, LAS unsigned* scr, int lane, float f8scale = 1.f) {
    const int n4 = (lane & 15) * 4, kk = lane >> 4;
    const float* src = W + (size_t)(k0 + 2 * kk) * ldw + n0 + n4;
    f32x4 ev[8], od[8];
#pragma unroll
    for (int j = 0; j < 8; ++j) { ev[j] = *(const f32x4*)(src + (size_t)(8 * j) * ldw); od[j] = *(const f32x4*)(src + (size_t)(8 * j + 1) * ldw); }
#pragma unroll
    for (int j = 0; j < 8; ++j) { f32x4 e = ev[j], o = od[j];
        if (scale) { const float se = scale[k0 + 8 * j + 2 * kk], so = scale[k0 + 8 * j + 2 * kk + 1]; e = e * se; o = o * so; }
        u32x4 w; w.x = pk2(e.x, o.x); w.y = pk2(e.y, o.y); w.z = pk2(e.z, o.z); w.w = pk2(e.w, o.w);
        *(LAS u32x4*)(scr + (4 * j + kk) * 68 + n4) = w; }
    asm volatile("s_waitcnt lgkmcnt(0)" ::: "memory");
    const int kq = lane & 7;
#pragma unroll
    for (int i = 0; i < 8; ++i) { const int n = (lane >> 3) + 8 * i; const LAS unsigned* q = scr + (4 * kq) * 68 + n;
        u32x4 o; o.x = q[0]; o.y = q[68]; o.z = q[136]; o.w = q[204];
        if (FP8) { u32x2 f; f.x = pk4_fp8(__uint_as_float(o.x << 16) * f8scale, __uint_as_float(o.x & 0xffff0000u) * f8scale, __uint_as_float(o.y << 16) * f8scale, __uint_as_float(o.y & 0xffff0000u) * f8scale);
            f.y = pk4_fp8(__uint_as_float(o.z << 16) * f8scale, __uint_as_float(o.z & 0xffff0000u) * f8scale, __uint_as_float(o.w << 16) * f8scale, __uint_as_float(o.w & 0xffff0000u) * f8scale);
            *(u32x2*)((unsigned char*)WT + (size_t)(drow0 + n) * ldt + dk0 + k0 + 8 * kq) = f; }
        else *(u32x4*)(WT + (size_t)(drow0 + n) * ldt + dk0 + k0 + 8 * kq) = o; }
    asm volatile("s_waitcnt lgkmcnt(0)" ::: "memory");
}

__device__ __forceinline__ void p0_prep(const Params& p, LAS unsigned char* lds) {
    const int tid = phase_tid(), lane = tid & 63, wave = tid >> 6;
    const int gw = blockIdx.x * 8 + wave, NGW = gridDim.x * 8;
    LAS unsigned* scr = (LAS unsigned*)(lds + wave * 8704);
    const float* x = p.in[0]; const float* g1 = p.in[1]; const float* w_in = p.in[2];
    bf16_t* xb = (bf16_t*)(p.ws + WS_XB); float* r1 = (float*)(p.ws + WS_R1);
    bf16_t* WinT = (bf16_t*)(p.ws + WS_WIN); bf16_t* WupT = (bf16_t*)(p.ws + WS_WUP); bf16_t* WoutT = (bf16_t*)(p.ws + WS_WOUT);
    constexpr int I_WIN = 32 * 136, I_UP = 16 * 32, I_OUT = 32 * 32, NITEMS = I_WIN + 2 * I_UP + I_OUT;
    for (int it = gw; it < NITEMS; it += NGW) {
        int r = it;
        if (r < I_WIN) { const int kb = r / 136, nb = r % 136; const int n0 = nb * 64; int drow = n0;
            if (n0 >= NQKV) { const int c = (n0 - NQKV) & 2047, isb = (n0 - NQKV) >> 11; drow = NQKV + (c >> 7) * 256 + isb * 128 + (c & 127); }
            transpose_item<false>(w_in, NIN, kb * 64, n0, WinT, 2048, drow, 0, g1, scr, lane); continue; } r -= I_WIN;
        if (r < I_UP) { const int kb = r / 32, nb = r % 32; transpose_item<false>(p.in[9], 2048, kb * 64, nb * 64, WupT, 2048, nb * 64, 0, nullptr, scr, lane); continue; } r -= I_UP;
        if (r < I_UP) { const int kb = r / 32, nb = r % 32; transpose_item<false>(p.in[10], 2048, kb * 64, nb * 64, WupT, 2048, nb * 64, 1024, nullptr, scr, lane); continue; } r -= I_UP;
        { const int kb = r / 32, nb = r % 32; transpose_item<false>(p.in[11], 2048, kb * 64, nb * 64, WoutT, 2048, nb * 64, 0, nullptr, scr, lane); }
    }
    { bf16_t* whi = (bf16_t*)(p.ws + WS_WRT); bf16_t* wlo = whi + 48 * 2048; const float* g2 = p.in[13]; const float* wrg = p.in[14]; const float* wre = p.in[16];
      for (int i = blockIdx.x * 512 + tid; i < 48 * 2048; i += gridDim.x * 512) { const int row = i >> 11, k = i & 2047, t = row >> 4, r = row & 15; float w;
          if (t == 0) w = wre[k * 32 + (r >> 2) * 8 + (r & 3)]; else if (t == 1) w = wre[k * 32 + (r >> 2) * 8 + 4 + (r & 3)]; else w = (r & 3) == 0 ? wrg[k * 4 + (r >> 2)] : 0.f;
          w *= g2[k]; const unsigned hi = pk2(w, 0.f) & 0xffffu; const float hf = __uint_as_float(hi << 16); whi[i] = (bf16_t)hi; wlo[i] = (bf16_t)(pk2(w - hf, 0.f) & 0xffffu); } }
    if (blockIdx.x == 0 && tid < 32) ((int*)(p.ws + WS_CNT))[tid] = 0;
    for (int row0 = 2 * gw; row0 < T; row0 += 2 * NGW) {
        f32x4 v[2][8]; float ss[2] = {0.f, 0.f};
#pragma unroll
        for (int u = 0; u < 2; ++u) { const f32x4* xr = (const f32x4*)(x + (size_t)(row0 + u) * D) + lane;
#pragma unroll
            for (int j = 0; j < 8; ++j) v[u][j] = xr[64 * j]; }
#pragma unroll
        for (int u = 0; u < 2; ++u) {
#pragma unroll
            for (int j = 0; j < 8; ++j) ss[u] += (v[u][j].x * v[u][j].x + v[u][j].y * v[u][j].y) + (v[u][j].z * v[u][j].z + v[u][j].w * v[u][j].w);
            ss[u] = wave_sum(ss[u]);
            if (lane == 0) r1[row0 + u] = rsqrtf(ss[u] * (1.0f / D) + EPS);
            u32x2* o = (u32x2*)(xb + (size_t)(row0 + u) * D) + lane;
#pragma unroll
            for (int j = 0; j < 8; ++j) { u32x2 w; w.x = pk2(v[u][j].x, v[u][j].y); w.y = pk2(v[u][j].z, v[u][j].w); o[64 * j] = w; } }
    }
}

__device__ __forceinline__ void p_moe_prep(const Params& p, LAS unsigned char* lds) {
    const int tid = phase_tid(), lane = tid & 63, wave = tid >> 6;
    const int gw = blockIdx.x * 8 + wave, NGW = gridDim.x * 8;
    LAS unsigned* scr = (LAS unsigned*)(lds + wave * 8704);
    const float* g2 = p.in[13];
    bf16_t* WguT = (bf16_t*)(p.ws + WS_WGU); bf16_t* WdT = (bf16_t*)(p.ws + WS_WD);
    constexpr int I_G = 32 * 32 * 8;
    constexpr int I_D = 32 * 8 * 32;
    for (int it = gw; it < 2 * I_G + I_D; it += NGW) {
        int r = it;
        if (r < 2 * I_G) { const int which = r >= I_G; if (which) r -= I_G; const int e = r / 256, rr = r % 256, kb = rr / 8, nb = rr % 8;
            const float* W = p.in[which ? 19 : 18] + (size_t)e * 2048 * 512; const int n0 = nb * 64;
            transpose_item<true>(W, 512, kb * 64, n0, WguT, 2048, e * 1024 + (n0 >> 7) * 256 + which * 128 + (n0 & 127), 0, g2, scr, lane, 64.f); continue; }
        r -= 2 * I_G;
        { const int e = r / 256, rr = r % 256, kb = rr / 32, nb = rr % 32; const float* W = p.in[20] + (size_t)e * 512 * 2048;
          transpose_item<false>(W, 2048, kb * 64, nb * 64, WdT, 512, e * 2048 + nb * 64, 0, nullptr, scr, lane); }
    }
}

struct Unit { int pm, pn, aux; };
namespace pg8 {
constexpr int BM = 256, BK = 64, HALF = 128, HTB = HALF * BK * 2, STAGE_BYTES = 8 * HTB;
__device__ __forceinline__ int lds_byte(int r, int c) { const int st = (r >> 4) * 2 + (c >> 5), rr = r & 15, cc = c & 31, ob = rr * 64 + cc * 2; return st * 1024 + (ob ^ (((ob >> 9) & 1) << 5)); }
__device__ __forceinline__ void stage_rc(int b, int& R, int& C) { const int st = b / 1024, sb = b % 1024, swz = sb ^ (((sb >> 9) & 1) << 5); R = (st >> 1) * 16 + swz / 64; C = (st & 1) * 32 + (swz % 64) / 2; }

template <bool PERM, bool GATHER, class Sched, class Epi, bool FP8 = false, bool ALIGN_EPI = true>
__device__ __forceinline__ void gemm_phase(LAS unsigned char* lds, const Sched& S, const Epi& E, const int nt, const int lda, const int ldb) {
    int tid_ = threadIdx.x; asm volatile("" : "+v"(tid_));
    const int tid = tid_, wid = __builtin_amdgcn_readfirstlane(tid >> 6), lane = tid & 63, wr = wid >> 2, wc = wid & 3, fr = lane & 15, fq = lane >> 4;
    int R0, C0, R1, C1; stage_rc(tid * 16, R0, C0); stage_rc(tid * 16 + 8192, R1, C1);
    unsigned voffB[2], voffA[2][2];
    { const int Rb0 = PERM ? ((R0 & ~31) + perm32(R0 & 31)) : R0, Rb1 = PERM ? ((R1 & ~31) + perm32(R1 & 31)) : R1;
      voffB[0] = (unsigned)(Rb0 * ldb + C0) * 2u; voffB[1] = (unsigned)(Rb1 * ldb + C1) * 2u; }
    const size_t kstep = (size_t)(BK * 2);
    const size_t hstepB = (size_t)HALF * ldb * 2;
    const unsigned ldsw = (unsigned)wid * 1024u;
    const int aoff = lds_byte(wr * 64 + fr, fq * 8), boff = lds_byte(wc * 32 + fr, fq * 8);
#define PG8_SA(b, h) (((b) * 2 + (h)) * HTB)
#define PG8_SB(b, h) ((4 + (b) * 2 + (h)) * HTB)
#define PG8_STAGE_B(bufoff, gbase) do { _Pragma("unroll") for (int _i = 0; _i < 2; ++_i) \
        __builtin_amdgcn_global_load_lds((const unsigned*)((const char*)(gbase) + voffB[_i]), (LAS unsigned*)(lds + (bufoff) + ldsw + _i * 8192), 16, 0, 0); } while (0)
#define PG8_STAGE_A(bufoff, gbase, h) do { _Pragma("unroll") for (int _i = 0; _i < 2; ++_i) \
        __builtin_amdgcn_global_load_lds((const unsigned*)((const char*)(gbase) + voffA[h][_i]), (LAS unsigned*)(lds + (bufoff) + ldsw + _i * 8192), 16, 0, 0); } while (0)
#define PG8_LDA(dst, b, h) do { _Pragma("unroll") for (int m = 0; m < 4; ++m) _Pragma("unroll") for (int k = 0; k < 2; ++k) dst[m][k] = *(const LAS bf16x8*)(lds + PG8_SA(b, h) + aoff + m * 2048 + k * 1024); } while (0)
#define PG8_LDB(dst, b, h) do { _Pragma("unroll") for (int n = 0; n < 2; ++n) _Pragma("unroll") for (int k = 0; k < 2; ++k) dst[n][k] = *(const LAS bf16x8*)(lds + PG8_SB(b, h) + boff + n * 2048 + k * 1024); } while (0)
#define PG8_MMA(ai, bj, At, Bt) do { __builtin_amdgcn_s_setprio(1); _Pragma("unroll") for (int m = 0; m < 4; ++m) _Pragma("unroll") for (int n = 0; n < 2; ++n) { \
        if (FP8) { typedef int v8i_ __attribute__((ext_vector_type(8))); typedef int v4i_ __attribute__((ext_vector_type(4))); \
            const v4i_ b0_ = __builtin_bit_cast(v4i_, Bt[n][0]), b1_ = __builtin_bit_cast(v4i_, Bt[n][1]), a0_ = __builtin_bit_cast(v4i_, At[m][0]), a1_ = __builtin_bit_cast(v4i_, At[m][1]); \
            const v8i_ bb_ = {b0_[0], b0_[1], b0_[2], b0_[3], b1_[0], b1_[1], b1_[2], b1_[3]}, aa_ = {a0_[0], a0_[1], a0_[2], a0_[3], a1_[0], a1_[1], a1_[2], a1_[3]}; \
            acc[ai][bj][m][n] = __builtin_amdgcn_mfma_scale_f32_16x16x128_f8f6f4(bb_, aa_, acc[ai][bj][m][n], 0, 0, 0, 0x7f7f7f7f, 0, 0x7f7f7f7f); } \
        else { _Pragma("unroll") for (int k = 0; k < 2; ++k) acc[ai][bj][m][n] = __builtin_amdgcn_mfma_f32_16x16x32_bf16(Bt[n][k], At[m][k], acc[ai][bj][m][n], 0, 0, 0); } } \
        __builtin_amdgcn_s_setprio(0); } while (0)
#define PG8_WAIT_V(n) asm volatile("s_waitcnt vmcnt(" #n ")" ::: "memory")
#define PG8_WAIT_L(n) asm volatile("s_waitcnt lgkmcnt(" #n ")" ::: "memory")
#define PG8_BAR __builtin_amdgcn_s_barrier()
#define PG8_SCHED __builtin_amdgcn_sched_barrier(0)
    Unit cur, nxt; int ui = 0;
    __syncthreads();
    if (!S.next(0, cur)) return;
    if (GATHER) S.a_offs(cur, R0, C0, R1, C1, voffA);
    else { voffA[0][0] = (unsigned)(R0 * lda + C0) * 2u; voffA[0][1] = (unsigned)(R1 * lda + C1) * 2u; voffA[1][0] = voffA[0][0] + (unsigned)(HALF * lda * 2); voffA[1][1] = voffA[0][1] + (unsigned)(HALF * lda * 2); }
    f32x4 acc[2][2][4][2];
#pragma unroll
    for (int a = 0; a < 2; ++a)
#pragma unroll
        for (int b = 0; b < 2; ++b)
#pragma unroll
            for (int m = 0; m < 4; ++m)
#pragma unroll
                for (int n = 0; n < 2; ++n) acc[a][b][m][n] = (f32x4){0.f, 0.f, 0.f, 0.f};
    bf16x8 At[4][2], B0[2][2], B1[2][2];
    const char* cA = S.a_base(cur); const char* cB = S.b_base(cur);
    PG8_STAGE_B(PG8_SB(0, 0), cB); PG8_STAGE_B(PG8_SB(0, 1), cB + hstepB); PG8_STAGE_A(PG8_SA(0, 0), cA, 0); PG8_STAGE_A(PG8_SA(0, 1), cA, 1);
    if (wr == 1) PG8_BAR;
    PG8_WAIT_V(2); PG8_BAR;
    PG8_STAGE_B(PG8_SB(1, 0), cB + kstep); PG8_STAGE_A(PG8_SA(1, 0), cA + kstep, 0); PG8_STAGE_B(PG8_SB(1, 1), cB + hstepB + kstep);
    PG8_WAIT_V(6); PG8_BAR;
    for (;;) {
        const bool has_next = S.next(ui + 1, nxt);
        const char* nA = has_next ? S.a_base(nxt) : cA; const char* nB = has_next ? S.b_base(nxt) : cB;
        unsigned vn[2][2];
        if (GATHER) { if (has_next) S.a_offs(nxt, R0, C0, R1, C1, vn); else { vn[0][0] = voffA[0][0]; vn[0][1] = voffA[0][1]; vn[1][0] = voffA[1][0]; vn[1][1] = voffA[1][1]; } }
        for (int t = 0; t < nt; t += 2) {
            const bool last = (t == nt - 2);
            const char* a1 = cA + (size_t)(t + 1) * kstep;
            const char* a2 = last ? nA : cA + (size_t)(t + 2) * kstep; const char* b2 = last ? nB : cB + (size_t)(t + 2) * kstep;
            const char* a3 = a2 + kstep; const char* b3 = b2 + kstep;
            PG8_LDB(B0, 0, 0); PG8_LDB(B1, 0, 1); PG8_SCHED; PG8_LDA(At, 0, 0); PG8_STAGE_A(PG8_SA(1, 1), a1, 1);
            if (GATHER) { if (last) { voffA[0][0] = vn[0][0]; voffA[0][1] = vn[0][1]; voffA[1][0] = vn[1][0]; voffA[1][1] = vn[1][1]; } }
            PG8_WAIT_V(8); PG8_WAIT_L(0); PG8_BAR; PG8_MMA(0, 0, At, B0); PG8_MMA(0, 1, At, B1); PG8_BAR; PG8_SCHED;
            PG8_LDA(At, 0, 1); PG8_STAGE_B(PG8_SB(0, 0), b2); PG8_STAGE_B(PG8_SB(0, 1), b2 + hstepB); PG8_STAGE_A(PG8_SA(0, 0), a2, 0);
            PG8_WAIT_V(8); PG8_WAIT_L(0); PG8_BAR; PG8_MMA(1, 0, At, B0); PG8_MMA(1, 1, At, B1); PG8_BAR; PG8_SCHED;
            PG8_LDB(B0, 1, 0); PG8_LDB(B1, 1, 1); PG8_SCHED; PG8_LDA(At, 1, 0); PG8_STAGE_A(PG8_SA(0, 1), a2, 1);
            PG8_WAIT_V(8); PG8_WAIT_L(0); PG8_BAR; PG8_MMA(0, 0, At, B0); PG8_MMA(0, 1, At, B1); PG8_BAR; PG8_SCHED;
            PG8_LDA(At, 1, 1); PG8_STAGE_B(PG8_SB(1, 0), b3); PG8_STAGE_B(PG8_SB(1, 1), b3 + hstepB); PG8_STAGE_A(PG8_SA(1, 0), a3, 0);
            PG8_WAIT_V(8); PG8_WAIT_L(0); PG8_BAR; PG8_MMA(1, 0, At, B0); PG8_MMA(1, 1, At, B1); PG8_BAR; PG8_SCHED;
        }
        if (ALIGN_EPI) { if (wr == 0) PG8_BAR; }
        E(acc, cur, wr, wc, fr, fq);
        if (!has_next) break;
        if (!S.keep_acc(cur)) {
#pragma unroll
        for (int a = 0; a < 2; ++a)
#pragma unroll
            for (int b = 0; b < 2; ++b)
#pragma unroll
                for (int m = 0; m < 4; ++m)
#pragma unroll
                    for (int n = 0; n < 2; ++n) acc[a][b][m][n] = (f32x4){0.f, 0.f, 0.f, 0.f};
        }
        cur = nxt; cA = nA; cB = nB; ++ui;
        if (ALIGN_EPI) { if (wr == 1) PG8_BAR; }
    }
    PG8_WAIT_V(0);
    if (!ALIGN_EPI) { if (wr == 0) PG8_BAR; }
    PG8_BAR;
#undef PG8_SA
#undef PG8_SB
#undef PG8_STAGE_A
#undef PG8_STAGE_B
#undef PG8_LDA
#undef PG8_LDB
#undef PG8_MMA
#undef PG8_WAIT_V
#undef PG8_WAIT_L
#undef PG8_BAR
#undef PG8_SCHED
}
struct TileOrder {
    int nM, nN, nwg, G, c;
    __device__ __forceinline__ void init(int nM_, int nN_, int G_, int c_) { nM = nM_; nN = nN_; nwg = nM * nN; G = G_; c = c_; }
    __device__ __forceinline__ bool tile(int i, int& pm, int& pn) const {
        const long L = (long)i * G + c; if (L >= nwg) return false;
        int wgid = (int)L; { const int q = nwg / 8, r = nwg % 8, xcd = wgid % 8, off = wgid / 8; wgid = (xcd < r ? xcd * (q + 1) : r * (q + 1) + (xcd - r) * q) + off; }
        const int nig = 8 * nN, gid = wgid / nig, fm = gid * 8, gsz = (nM - fm) < 8 ? (nM - fm) : 8;
        pm = fm + ((wgid % nig) % gsz); pn = (wgid % nig) / gsz; return true;
    }
};
struct DenseSched {
    TileOrder o; const bf16_t* A; const bf16_t* Bt; int lda, ldb;
    __device__ __forceinline__ bool next(int i, Unit& u) const { u.aux = 0; return o.tile(i, u.pm, u.pn); }
    __device__ __forceinline__ const char* a_base(const Unit& u) const { return (const char*)(A + (size_t)u.pm * 256 * lda); }
    __device__ __forceinline__ const char* b_base(const Unit& u) const { return (const char*)(Bt + (size_t)u.pn * 256 * ldb); }
    __device__ __forceinline__ bool keep_acc(const Unit&) const { return false; }
    __device__ __forceinline__ void a_offs(const Unit&, int, int, int, int, unsigned (&)[2][2]) const {}
};
}

struct EpiInProj { bf16_t* qkv; bf16_t* gates; const float* r1; const float* gqa; const float* gka; const float* gqb; const float* gkb; LAS float* X;
    __device__ __forceinline__ void operator()(f32x4 (&acc)[2][2][4][2], const Unit& u, int wr, int wc, int fr, int fq) const {
        const int pn = u.pn;
        const bool isg = pn >= 18; bf16_t* base = isg ? gates : qkv; const int ldc = isg ? NGATE : NQKV; const int colt = (isg ? pn - 18 : pn) * 256 + wc * 32 + 8 * fq;
        const float* gain = pn < 4 ? gqa : (pn == 4 ? gka : ((pn >= 6 && pn < 10) ? gqb : ((pn >= 10 && pn < 14) ? gkb : nullptr)));
        if (gain) {
            const float extra = (pn < 4 || (pn >= 6 && pn < 10)) ? 0.08838834764831845f * 1.4426950408889634f : 1.0f;
#pragma unroll
            for (int ai = 0; ai < 2; ++ai)
#pragma unroll
                for (int m = 0; m < 4; ++m)
#pragma unroll
                    for (int bj = 0; bj < 2; ++bj) { const f32x4 a0 = acc[ai][bj][m][0], a1 = acc[ai][bj][m][1];
                        float sq = (a0[0] * a0[0] + a0[1] * a0[1]) + (a0[2] * a0[2] + a0[3] * a0[3]) + (a1[0] * a1[0] + a1[1] * a1[1]) + (a1[2] * a1[2] + a1[3] * a1[3]);
                        sq += __shfl_xor(sq, 16); sq += __shfl_xor(sq, 32);
                        if (fq == 0) X[(ai * 128 + wr * 64 + m * 16 + fr) * 8 + bj * 4 + wc] = sq; }
            asm volatile("s_waitcnt lgkmcnt(0)" ::: "memory"); __builtin_amdgcn_s_barrier(); asm volatile("" ::: "memory");
            const f32x4 g0 = *(const f32x4*)(gain + wc * 32 + 8 * fq), g1 = *(const f32x4*)(gain + wc * 32 + 8 * fq + 4);
#pragma unroll
            for (int ai = 0; ai < 2; ++ai)
#pragma unroll
                for (int m = 0; m < 4; ++m) { const int rl = ai * 128 + wr * 64 + m * 16 + fr; const int row = u.pm * 256 + rl; const float rs = r1[row]; bf16_t* rowp = base + (size_t)row * ldc + colt;
#pragma unroll
                    for (int bj = 0; bj < 2; ++bj) { const f32x4 t = *(const LAS f32x4*)(X + rl * 8 + bj * 4); const float tot = (t[0] + t[1]) + (t[2] + t[3]);
                        const float sc = rs * rsqrtf(rs * rs * tot * (1.0f / 128.0f) + EPS) * extra;
                        const f32x4 v0 = acc[ai][bj][m][0] * sc * g0, v1 = acc[ai][bj][m][1] * sc * g1;
                        u32x4 w; w.x = pk2(v0[0], v0[1]); w.y = pk2(v0[2], v0[3]); w.z = pk2(v1[0], v1[1]); w.w = pk2(v1[2], v1[3]);
                        *(u32x4*)(rowp + bj * 128) = w; } }
            return;
        }
        if (isg) {
            const int cg = (pn - 18) * 128 + wc * 32 + 8 * fq;
#pragma unroll
            for (int ai = 0; ai < 2; ++ai)
#pragma unroll
                for (int m = 0; m < 4; ++m) { const int row = u.pm * 256 + ai * 128 + wr * 64 + m * 16 + fr; const float rs = r1[row]; bf16_t* rowp = gates + (size_t)row * NGATE + cg;
                    float ra[8], sb[8];
#pragma unroll
                    for (int n = 0; n < 2; ++n)
#pragma unroll
                        for (int j = 0; j < 4; ++j) { const float ea = __expf(-acc[ai][0][m][n][j] * rs), eb = fminf(__expf(-acc[ai][1][m][n][j] * rs), 1e30f);
                            sb[4 * n + j] = __builtin_amdgcn_rcpf(1.0f + eb); ra[4 * n + j] = (1.0f + eb) * __builtin_amdgcn_rcpf(1.0f + ea); }
                    u32x4 w; w.x = pk2(ra[0], ra[1]); w.y = pk2(ra[2], ra[3]); w.z = pk2(ra[4], ra[5]); w.w = pk2(ra[6], ra[7]); *(u32x4*)rowp = w;
                    w.x = pk2(sb[0], sb[1]); w.y = pk2(sb[2], sb[3]); w.z = pk2(sb[4], sb[5]); w.w = pk2(sb[6], sb[7]); *(u32x4*)(rowp + 2048) = w; }
            return;
        }
#pragma unroll
        for (int ai = 0; ai < 2; ++ai)
#pragma unroll
            for (int m = 0; m < 4; ++m) { const int row = u.pm * 256 + ai * 128 + wr * 64 + m * 16 + fr; const float rs = r1[row]; bf16_t* rowp = base + (size_t)row * ldc + colt;
#pragma unroll
                for (int bj = 0; bj < 2; ++bj) { const f32x4 v0 = acc[ai][bj][m][0] * rs, v1 = acc[ai][bj][m][1] * rs;
                    u32x4 w; w.x = pk2(v0[0], v0[1]); w.y = pk2(v0[2], v0[3]); w.z = pk2(v1[0], v1[1]); w.w = pk2(v1[2], v1[3]);
                    *(u32x4*)(rowp + bj * 128) = w; } }
    } };
__device__ __forceinline__ void p1_inproj(const Params& p, LAS unsigned char* lds) {
    pg8::DenseSched S; S.o.init(128, 34, gridDim.x, blockIdx.x); S.A = (const bf16_t*)(p.ws + WS_XB); S.Bt = (const bf16_t*)(p.ws + WS_WIN); S.lda = D; S.ldb = D;
    EpiInProj E{(bf16_t*)(p.ws + WS_QKV), (bf16_t*)(p.ws + WS_GATES), (const float*)(p.ws + WS_R1), p.in[3], p.in[4], p.in[6], p.in[7], (LAS float*)(lds + 131072)};
    pg8::gemm_phase<true, false>(lds, S, E, D / 64, D, D);
}

__device__ __forceinline__ void wait_vm(int n) {
    switch (n) { case 0: asm volatile("s_waitcnt vmcnt(0)" ::: "memory"); break; case 2: asm volatile("s_waitcnt vmcnt(2)" ::: "memory"); break; case 4: asm volatile("s_waitcnt vmcnt(4)" ::: "memory"); break;
                 case 6: asm volatile("s_waitcnt vmcnt(6)" ::: "memory"); break; case 8: asm volatile("s_waitcnt vmcnt(8)" ::: "memory"); break; case 10: asm volatile("s_waitcnt vmcnt(10)" ::: "memory"); break;
                 default: asm volatile("s_waitcnt vmcnt(12)" ::: "memory"); break; }
}
__device__ __forceinline__ void glds16_asm(const void* gsrc, unsigned lds_dst) {
    unsigned keep;
    asm volatile("s_mov_b32 %0, m0\n\ts_mov_b32 m0, %2\n\ts_nop 0\n\tglobal_load_lds_dwordx4 %1, off\n\ts_mov_b32 m0, %0" : "=&s"(keep) : "v"(gsrc), "s"(lds_dst) : "memory");
}
#define ATT_BAR() do { asm volatile("s_waitcnt lgkmcnt(0)" ::: "memory"); __builtin_amdgcn_s_barrier(); asm volatile("" ::: "memory"); } while (0)
__device__ __forceinline__ void load_q(const bf16_t* qp, int g, bf16x8 (&qf)[4]) {
#pragma unroll
    for (int ks = 0; ks < 4; ++ks) qf[ks] = *(const bf16x8*)(qp + 32 * ks + 8 * g);
#pragma unroll
    for (int ks = 0; ks < 4; ++ks) asm volatile("" : "+v"(qf[ks]));
}
__device__ __forceinline__ bf16x8 vt_frag(LAS unsigned char* base, int row0, int g, int q4, int pp, int dt) {
    const s16x4 lo = tr_read(base + off_b(row0 + 4 * g + q4, 2 * dt + (pp >> 1)) + 8 * (pp & 1)), hi = tr_read(base + off_b(row0 + 16 + 4 * g + q4, 2 * dt + (pp >> 1)) + 8 * (pp & 1));
    bf16x8 vf; vf[0] = lo[0]; vf[1] = lo[1]; vf[2] = lo[2]; vf[3] = lo[3]; vf[4] = hi[0]; vf[5] = hi[1]; vf[6] = hi[2]; vf[7] = hi[3]; return vf;
}

__device__ __forceinline__ void attn_window_item(const Params& p, LAS unsigned char* lds, int item, int& tab_head) {
    const int tid = phase_tid(), lane = tid & 63, w = __builtin_amdgcn_readfirstlane(tid >> 6), g = lane >> 4, ql = lane & 15;
    const int b = item >> 9, nb = (item >> 2) & 127, hpq = item & 3, kv = hpq >> 1, hq0 = 2 * hpq;
    const bf16_t* qkv = (const bf16_t*)(p.ws + WS_QKV); bf16_t* o = (bf16_t*)(p.ws + WS_O);
    LAS float* bias = (LAS float*)(lds + 131072); const unsigned ldsb = (unsigned)(size_t)lds;
    const unsigned loff = (unsigned)(w * 4 + g) * NQKV + (unsigned)((ql ^ ((g << 2) | (w & 3))) * 8);
    const bf16_t* kbase = qkv + (size_t)(b * SEQ) * NQKV + 1024 + kv * 128;
#define WIN_ISSUE(c) do { const int _c = (c); const int _kb = min(max(nb - 1 + (_c % 3), 0), 127); const bf16_t* _src = kbase + (size_t)(_kb * 128) * NQKV + (_c >= 3 ? 256 : 0) + loff; \
        _Pragma("unroll") for (int _i = 0; _i < 4; ++_i) glds16_asm(_src + (size_t)(32 * _i) * NQKV, ldsb + (unsigned)((_c & 3) * 32768 + _i * 8192 + w * 1024)); } while (0)
    ATT_BAR();
    WIN_ISSUE(0); WIN_ISSUE(1); WIN_ISSUE(2);
    if (hpq != tab_head) { for (int i = tid; i < 2 * 257; i += 512) { const int hh = i >= 257, j = i - 257 * hh; bias[hh * 264 + j] = p.in[12][t5_bucket(j - 128) * 8 + hq0 + hh] * 1.4426950408889634f; } tab_head = hpq; }
    const int tq = b * SEQ + nb * 128 + 16 * w + ql;
    bf16x8 qf[2][4]; load_q(qkv + (size_t)tq * NQKV + hq0 * 128, g, qf[0]); load_q(qkv + (size_t)tq * NQKV + (hq0 + 1) * 128, g, qf[1]);
    float sink[2]; sink[0] = p.in[5][hq0] * 1.4426950408889634f; sink[1] = p.in[5][hq0 + 1] * 1.4426950408889634f; asm volatile("" : "+v"(sink[0]), "+v"(sink[1]));
    f32x4 S1[2][8], SC[2][9];
#pragma unroll
    for (int u = 0; u < 2; ++u) {
#pragma unroll
        for (int kt = 0; kt < 8; ++kt) S1[u][kt] = (f32x4){0.f, 0.f, 0.f, 0.f};
#pragma unroll
        for (int s = 0; s < 9; ++s) SC[u][s] = (f32x4){0.f, 0.f, 0.f, 0.f}; }
    const bool in0 = nb > 0, in2 = nb < 127;
#pragma unroll
    for (int c = 0; c < 3; ++c) {
        wait_vm(8); ATT_BAR(); WIN_ISSUE(c + 3);
        LAS unsigned char* buf = lds + (c & 3) * 32768;
#pragma unroll
        for (int kt = 0; kt < 8; ++kt) {
            const bool act = (c == 1) || (c == 0 ? kt >= w : kt <= w);
            if (act) {
#pragma unroll
                for (int ks = 0; ks < 4; ++ks) { const bf16x8 kf = *(const LAS bf16x8*)(buf + off_b(16 * kt + ql, 4 * ks + g));
#pragma unroll
                    for (int u = 0; u < 2; ++u) {
                        if (c == 1) S1[u][kt] = __builtin_amdgcn_mfma_f32_16x16x32_bf16(kf, qf[u][ks], S1[u][kt], 0, 0, 0);
                        else if (c == 0) SC[u][7 - kt] = __builtin_amdgcn_mfma_f32_16x16x32_bf16(kf, qf[u][ks], SC[u][7 - kt], 0, 0, 0);
                        else SC[u][8 - kt] = __builtin_amdgcn_mfma_f32_16x16x32_bf16(kf, qf[u][ks], SC[u][8 - kt], 0, 0, 0); } } }
        }
    }
    const int qi = 16 * w + ql; float inv[2];
    unsigned P1[2][4][4], PC[2][9][2];
#pragma unroll
    for (int u = 0; u < 2; ++u) { float mx = sink[u]; const LAS float* bt = bias + u * 264;
#pragma unroll
        for (int kt = 0; kt < 8; ++kt)
#pragma unroll
            for (int r = 0; r < 4; ++r) { const int rel = 16 * kt + 4 * g + r - qi; const float sv = S1[u][kt][r] + bt[rel + 128]; S1[u][kt][r] = sv; mx = fmaxf(mx, sv); }
#pragma unroll
        for (int s = 0; s < 9; ++s) { const bool c0 = s <= 7 - w; const int kt = c0 ? 7 - s : 8 - s; const int cofs = c0 ? -128 : 128; const bool inr = c0 ? in0 : in2;
#pragma unroll
            for (int r = 0; r < 4; ++r) { const int rel = cofs + 16 * kt + 4 * g + r - qi; const bool valid = inr && rel >= -128 && rel <= 128;
                const float bv = bt[rel + 128];
                const float sv = valid ? SC[u][s][r] + bv : -1e30f; SC[u][s][r] = sv; mx = fmaxf(mx, sv); } }
        mx = fmaxf(mx, __shfl_xor(mx, 16)); mx = fmaxf(mx, __shfl_xor(mx, 32));
        float l = 0.f;
#pragma unroll
        for (int kk = 0; kk < 4; ++kk) { float e[8];
#pragma unroll
            for (int r = 0; r < 4; ++r) { e[r] = __builtin_amdgcn_exp2f(S1[u][2 * kk][r] - mx); e[4 + r] = __builtin_amdgcn_exp2f(S1[u][2 * kk + 1][r] - mx); l += e[r] + e[4 + r]; }
            P1[u][kk][0] = pk2(e[0], e[1]); P1[u][kk][1] = pk2(e[2], e[3]); P1[u][kk][2] = pk2(e[4], e[5]); P1[u][kk][3] = pk2(e[6], e[7]); }
#pragma unroll
        for (int s = 0; s < 9; ++s) { float e[4];
#pragma unroll
            for (int r = 0; r < 4; ++r) { e[r] = __builtin_amdgcn_exp2f(SC[u][s][r] - mx); l += e[r]; }
            PC[u][s][0] = pk2(e[0], e[1]); PC[u][s][1] = pk2(e[2], e[3]); }
        l += __shfl_xor(l, 16); l += __shfl_xor(l, 32); l += __builtin_amdgcn_exp2f(sink[u] - mx);
        inv[u] = 1.0f / l; }
    f32x4 O[2][8];
#pragma unroll
    for (int u = 0; u < 2; ++u)
#pragma unroll
        for (int dt = 0; dt < 8; ++dt) O[u][dt] = (f32x4){0.f, 0.f, 0.f, 0.f};
    const int q4 = ql >> 2, pp = ql & 3;
#pragma unroll
    for (int c = 0; c < 3; ++c) {
        wait_vm(c == 0 ? 8 : (c == 1 ? 4 : 0)); ATT_BAR();
        LAS unsigned char* buf = lds + ((c + 3) & 3) * 32768;
#pragma unroll
        for (int kk = 0; kk < 4; ++kk) {
            bool a0, a1;
            if (c == 1) { a0 = true; a1 = true; } else if (c == 0) { a0 = 2 * kk >= w; a1 = 2 * kk + 1 >= w; } else { a0 = 2 * kk <= w; a1 = 2 * kk + 1 <= w; }
            if (a0 || a1) { bf16x8 pf[2];
#pragma unroll
                for (int u = 0; u < 2; ++u) { u32x4 pw;
                    if (c == 1) { pw.x = P1[u][kk][0]; pw.y = P1[u][kk][1]; pw.z = P1[u][kk][2]; pw.w = P1[u][kk][3]; }
                    else if (c == 0) { pw.x = a0 ? PC[u][7 - 2 * kk][0] : 0u; pw.y = a0 ? PC[u][7 - 2 * kk][1] : 0u; pw.z = a1 ? PC[u][6 - 2 * kk][0] : 0u; pw.w = a1 ? PC[u][6 - 2 * kk][1] : 0u; }
                    else { pw.x = a0 ? PC[u][8 - 2 * kk][0] : 0u; pw.y = a0 ? PC[u][8 - 2 * kk][1] : 0u; pw.z = a1 ? PC[u][7 - 2 * kk][0] : 0u; pw.w = a1 ? PC[u][7 - 2 * kk][1] : 0u; }
                    pf[u] = __builtin_bit_cast(bf16x8, pw); }
#pragma unroll
                for (int dt = 0; dt < 8; ++dt) { const bf16x8 vf = vt_frag(buf, 32 * kk, g, q4, pp, dt);
                    O[0][dt] = __builtin_amdgcn_mfma_f32_16x16x32_bf16(vf, pf[0], O[0][dt], 0, 0, 0); O[1][dt] = __builtin_amdgcn_mfma_f32_16x16x32_bf16(vf, pf[1], O[1][dt], 0, 0, 0); } } }
    }
#undef WIN_ISSUE
#pragma unroll
    for (int u = 0; u < 2; ++u) { bf16_t* op = o + (size_t)tq * D + (hq0 + u) * 128 + 4 * g;
#pragma unroll
        for (int dt = 0; dt < 8; ++dt) { u32x2 w2; w2.x = pk2(O[u][dt][0] * inv[u], O[u][dt][1] * inv[u]); w2.y = pk2(O[u][dt][2] * inv[u], O[u][dt][3] * inv[u]); *(u32x2*)(op + 16 * dt) = w2; } }
}

__device__ __forceinline__ void attn_nat_item(const Params& p, LAS unsigned char* lds, int item, int& tab_head) {
    const int tid = phase_tid(), lane = tid & 63, w = __builtin_amdgcn_readfirstlane(tid >> 6), g = lane >> 4, ql = lane & 15;
    const int b = item >> 9, rp = (item >> 2) & 127, hp = item & 3, hh = w >> 2, h = 2 * hp + hh, jq = w & 3;
    const int kr_lo = min(max(2 * rp - 4, 0), 248);
    const int d0 = min(max(2 * rp - 4, 0), 248) - kr_lo, d1 = min(max(2 * rp - 3, 0), 248) - kr_lo;
    const int w0 = jq == 0 ? 0 : (jq == 1 ? 8 : (jq == 2 ? 24 : 32));
    const bf16_t* qkv = (const bf16_t*)(p.ws + WS_QKV); bf16_t* o = (bf16_t*)(p.ws + WS_O);
    LAS float* rpb = (LAS float*)(lds + 131072); const unsigned ldsb = (unsigned)(size_t)lds;
    const unsigned loff = (unsigned)(w * 4 + g) * NQKV + (unsigned)((ql ^ ((g << 2) | (w & 3))) * 8);
    const bf16_t* kbase = qkv + (size_t)(b * SEQ) * NQKV + 2560 + 2 * hp * 128;
#define NAT_ISSUE(s) do { const int _s = (s); const int _kr = min(kr_lo + (_s % 9), 255); const bf16_t* _src = kbase + (size_t)(_kr * 64) * NQKV + (_s >= 9 ? 1024 : 0) + loff; \
        _Pragma("unroll") for (int _i = 0; _i < 4; ++_i) glds16_asm(_src + (size_t)(32 * (_i & 1)) * NQKV + 128 * (_i >> 1), ldsb + (unsigned)((_s & 3) * 32768 + _i * 8192 + w * 1024)); } while (0)
    ATT_BAR();
    NAT_ISSUE(0); NAT_ISSUE(1); NAT_ISSUE(2);
    if (hp != tab_head) { for (int i = tid; i < 930; i += 512) rpb[i] = p.in[8][2 * hp * 465 + i] * 1.4426950408889634f; tab_head = hp; }
    const int qcol = 16 * jq + ql; const int tq0 = b * SEQ + (2 * rp) * 64 + qcol;
    bf16x8 qf[2][4]; load_q(qkv + (size_t)tq0 * NQKV + 1536 + h * 128, g, qf[0]); load_q(qkv + (size_t)(tq0 + 64) * NQKV + 1536 + h * 128, g, qf[1]);
    f32x4 S[2][9][2];
#pragma unroll
    for (int u = 0; u < 2; ++u)
#pragma unroll
        for (int c = 0; c < 9; ++c) { S[u][c][0] = (f32x4){0.f, 0.f, 0.f, 0.f}; S[u][c][1] = (f32x4){0.f, 0.f, 0.f, 0.f}; }
#pragma unroll
    for (int c = 0; c < 9; ++c) {
        wait_vm(8); ATT_BAR(); NAT_ISSUE(c + 3);
        const bool a0 = c >= d0 && c < d0 + 8, a1 = c >= d1 && c < d1 + 8;
        LAS unsigned char* buf = lds + (c & 3) * 32768 + hh * 16384;
#pragma unroll
        for (int t = 0; t < 2; ++t)
#pragma unroll
            for (int ks = 0; ks < 4; ++ks) { const bf16x8 kf = *(const LAS bf16x8*)(buf + off_b(w0 + 16 * t + ql, 4 * ks + g));
                if (a0) S[0][c][t] = __builtin_amdgcn_mfma_f32_16x16x32_bf16(kf, qf[0][ks], S[0][c][t], 0, 0, 0);
                if (a1) S[1][c][t] = __builtin_amdgcn_mfma_f32_16x16x32_bf16(kf, qf[1][ks], S[1][c][t], 0, 0, 0); }
    }
    const int cs = min(max(qcol - 8, 0), 48); float inv[2];
    unsigned P[2][9][4];
    int dcv[2][4]; bool cv[2][4];
#pragma unroll
    for (int t = 0; t < 2; ++t)
#pragma unroll
        for (int q = 0; q < 4; ++q) { const int kc = w0 + 16 * t + 4 * g + q; cv[t][q] = kc >= cs && kc < cs + 16; dcv[t][q] = hh * 465 + kc - qcol + 15; }
#pragma unroll
    for (int u = 0; u < 2; ++u) { const int du = u ? d1 : d0; const int r = 2 * rp + u; float mx = -1e30f;
#pragma unroll
        for (int c = 0; c < 9; ++c) { const bool act = c >= du && c < du + 8;
            if (act) { const int rowb = (kr_lo + c - r + 7) * 31;
#pragma unroll
                for (int t = 0; t < 2; ++t)
#pragma unroll
                    for (int q = 0; q < 4; ++q) { const float sv = cv[t][q] ? S[u][c][t][q] + rpb[rowb + dcv[t][q]] : -1e30f; S[u][c][t][q] = sv; mx = fmaxf(mx, sv); } } }
        mx = fmaxf(mx, __shfl_xor(mx, 16)); mx = fmaxf(mx, __shfl_xor(mx, 32));
        float l = 0.f;
#pragma unroll
        for (int c = 0; c < 9; ++c) { const bool act = c >= du && c < du + 8;
            if (act) { float e[2][4];
#pragma unroll
                for (int t = 0; t < 2; ++t)
#pragma unroll
                    for (int q = 0; q < 4; ++q) { e[t][q] = __builtin_amdgcn_exp2f(S[u][c][t][q] - mx); l += e[t][q]; }
                P[u][c][0] = pk2(e[0][0], e[0][1]); P[u][c][1] = pk2(e[0][2], e[0][3]); P[u][c][2] = pk2(e[1][0], e[1][1]); P[u][c][3] = pk2(e[1][2], e[1][3]); }
            else { P[u][c][0] = 0u; P[u][c][1] = 0u; P[u][c][2] = 0u; P[u][c][3] = 0u; } }
        l += __shfl_xor(l, 16); l += __shfl_xor(l, 32);
        inv[u] = 1.0f / l; }
    f32x4 O[2][8];
#pragma unroll
    for (int u = 0; u < 2; ++u)
#pragma unroll
        for (int dt = 0; dt < 8; ++dt) O[u][dt] = (f32x4){0.f, 0.f, 0.f, 0.f};
    const int q4 = ql >> 2, pp = ql & 3;
#pragma unroll
    for (int c = 0; c < 9; ++c) {
        wait_vm(c <= 6 ? 8 : (c == 7 ? 4 : 0)); ATT_BAR(); if (c + 12 < 18) NAT_ISSUE(c + 12);
        const bool a0 = c >= d0 && c < d0 + 8, a1 = c >= d1 && c < d1 + 8;
        LAS unsigned char* buf = lds + ((c + 9) & 3) * 32768 + hh * 16384;
        u32x4 pw0; pw0.x = P[0][c][0]; pw0.y = P[0][c][1]; pw0.z = P[0][c][2]; pw0.w = P[0][c][3];
        u32x4 pw1; pw1.x = P[1][c][0]; pw1.y = P[1][c][1]; pw1.z = P[1][c][2]; pw1.w = P[1][c][3];
        const bf16x8 pf0 = __builtin_bit_cast(bf16x8, pw0), pf1 = __builtin_bit_cast(bf16x8, pw1);
#pragma unroll
        for (int dt = 0; dt < 8; ++dt) { const bf16x8 vf = vt_frag(buf, w0, g, q4, pp, dt);
            if (a0) O[0][dt] = __builtin_amdgcn_mfma_f32_16x16x32_bf16(vf, pf0, O[0][dt], 0, 0, 0);
            if (a1) O[1][dt] = __builtin_amdgcn_mfma_f32_16x16x32_bf16(vf, pf1, O[1][dt], 0, 0, 0); }
    }
#undef NAT_ISSUE
#pragma unroll
    for (int u = 0; u < 2; ++u) { bf16_t* op = o + (size_t)(tq0 + 64 * u) * D + 1024 + h * 128 + 4 * g;
#pragma unroll
        for (int dt = 0; dt < 8; ++dt) { u32x2 w2; w2.x = pk2(O[u][dt][0] * inv[u], O[u][dt][1] * inv[u]); w2.y = pk2(O[u][dt][2] * inv[u], O[u][dt][3] * inv[u]); *(u32x2*)(op + 16 * dt) = w2; } }
}
__device__ __forceinline__ void p2_attn(const Params& p, LAS unsigned char* lds) {
    int tab_head = -1;
    for (int it = blockIdx.x; it < 1024; it += gridDim.x) attn_window_item(p, lds, it, tab_head);
#ifdef PROBE_A
    if (blockIdx.x == 0 && threadIdx.x == 0) ((unsigned long long*)(p.ws + WS_END))[11] = __builtin_amdgcn_s_memrealtime();
#endif
    tab_head = -1;
    for (int it = blockIdx.x; it < 1024; it += gridDim.x) attn_nat_item(p, lds, it, tab_head);
    asm volatile("s_waitcnt vmcnt(0)" ::: "memory"); __syncthreads();
}

struct UpHook { const bf16_t* gates;
    __device__ __forceinline__ void operator()(f32x4 (&acc)[2][2][4][2], const Unit& u, int wr, int wc, int fr, int fq) const {
        const unsigned goff = (unsigned)(u.pm * 256 + wr * 64 + fr) * NGATE + u.pn * 256 + wc * 32 + 8 * fq;
#pragma unroll
        for (int ai = 0; ai < 2; ++ai) {
            bf16x8 ra[4][2];
#pragma unroll
            for (int m = 0; m < 4; ++m)
#pragma unroll
                for (int bj = 0; bj < 2; ++bj) ra[m][bj] = *(const bf16x8*)(gates + goff + (unsigned)((ai * 128 + m * 16) * NGATE) + bj * 128);
#pragma unroll
            for (int m = 0; m < 4; ++m)
#pragma unroll
                for (int bj = 0; bj < 2; ++bj)
#pragma unroll
                    for (int n = 0; n < 2; ++n)
#pragma unroll
                        for (int j = 0; j < 4; ++j) acc[ai][bj][m][n][j] *= bf2f(ra[m][bj][4 * n + j]);
            asm volatile("" ::: "memory"); }
    } };
struct UpSched {
    pg8::TileOrder o; const bf16_t* A; const bf16_t* Bt;
    __device__ __forceinline__ bool next(int i, Unit& u) const { u.aux = i & 1; return o.tile(i >> 1, u.pm, u.pn); }
    __device__ __forceinline__ const char* a_base(const Unit& u) const { return (const char*)(A + (size_t)u.pm * 256 * D + u.aux * 1024); }
    __device__ __forceinline__ const char* b_base(const Unit& u) const { return (const char*)(Bt + (size_t)u.pn * 256 * D + u.aux * 1024); }
    __device__ __forceinline__ bool keep_acc(const Unit& u) const { return u.aux == 0; }
    __device__ __forceinline__ void a_offs(const Unit&, int, int, int, int, unsigned (&)[2][2]) const {}
};
struct EpiUp { const bf16_t* gates; bf16_t* merged;
    __device__ __forceinline__ void operator()(f32x4 (&acc)[2][2][4][2], const Unit& u, int wr, int wc, int fr, int fq) const {
        if (u.aux == 0) { UpHook{gates}(acc, u, wr, wc, fr, fq); return; }
        const unsigned goff = (unsigned)(u.pm * 256 + wr * 64 + fr) * NGATE + 2048 + u.pn * 256 + wc * 32 + 8 * fq;
        const unsigned moff = (unsigned)(u.pm * 256 + wr * 64 + fr) * D + u.pn * 256 + wc * 32 + 8 * fq;
#pragma unroll
        for (int ai = 0; ai < 2; ++ai) {
            bf16x8 sb[4][2];
#pragma unroll
            for (int m = 0; m < 4; ++m)
#pragma unroll
                for (int bj = 0; bj < 2; ++bj) sb[m][bj] = *(const bf16x8*)(gates + goff + (unsigned)((ai * 128 + m * 16) * NGATE) + bj * 128);
#pragma unroll
            for (int m = 0; m < 4; ++m)
#pragma unroll
                for (int bj = 0; bj < 2; ++bj) { f32x4 v0 = acc[ai][bj][m][0], v1 = acc[ai][bj][m][1];
#pragma unroll
                    for (int j = 0; j < 4; ++j) { v0[j] *= bf2f(sb[m][bj][j]); v1[j] *= bf2f(sb[m][bj][4 + j]); }
                    u32x4 w; w.x = pk2(v0[0], v0[1]); w.y = pk2(v0[2], v0[3]); w.z = pk2(v1[0], v1[1]); w.w = pk2(v1[2], v1[3]);
                    *(u32x4*)(merged + moff + (unsigned)((ai * 128 + m * 16) * D) + bj * 128) = w; }
            asm volatile("" ::: "memory"); }
    } };
__device__ __forceinline__ void p3_up(const Params& p, LAS unsigned char* lds) {
    UpSched S; S.o.init(128, 8, gridDim.x, blockIdx.x); S.A = (const bf16_t*)(p.ws + WS_O); S.Bt = (const bf16_t*)(p.ws + WS_WUP);
    EpiUp E{(const bf16_t*)(p.ws + WS_GATES), (bf16_t*)(p.ws + WS_XB)};
    pg8::gemm_phase<true, false>(lds, S, E, 1024 / 64, D, D);
}

struct EpiOut { bf16_t* mob;
    __device__ __forceinline__ void operator()(f32x4 (&acc)[2][2][4][2], const Unit& u, int wr, int wc, int fr, int fq) const {
        unsigned off = (unsigned)(u.pm * 256 + wr * 64 + fr) * D + u.pn * 256 + wc * 32 + 8 * fq;
#pragma unroll
        for (int ai = 0; ai < 2; ++ai) {
#pragma unroll
            for (int m = 0; m < 4; ++m) { asm volatile("" : "+v"(off));
#pragma unroll
                for (int bj = 0; bj < 2; ++bj) { const f32x4 v0 = acc[ai][bj][m][0], v1 = acc[ai][bj][m][1];
                    u32x4 w; w.x = pk2(v0[0], v0[1]); w.y = pk2(v0[2], v0[3]); w.z = pk2(v1[0], v1[1]); w.w = pk2(v1[2], v1[3]);
                    *(u32x4*)(mob + off + bj * 128) = w; }
                off += 16 * D; }
            off += 64 * D; }
    } };
__device__ __forceinline__ void p4_out(const Params& p, LAS unsigned char* lds) {
    pg8::DenseSched S; S.o.init(128, 8, gridDim.x, blockIdx.x); S.A = (const bf16_t*)(p.ws + WS_XB); S.Bt = (const bf16_t*)(p.ws + WS_WOUT); S.lda = D; S.ldb = D;
    EpiOut E{(bf16_t*)(p.ws + WS_MOB)};
    pg8::gemm_phase<true, false, pg8::DenseSched, EpiOut, false, false>(lds, S, E, D / 64, D, D);
}

__device__ __forceinline__ void p5_router(const Params& p, LAS unsigned char* lds) {
    const int tid = phase_tid(), lane = tid & 63, wave = __builtin_amdgcn_readfirstlane(tid >> 6), g = lane >> 4, tl = lane & 15;
    const bf16_t* wsp = (const bf16_t*)(p.ws + WS_WRT); float* r2 = (float*)(p.ws + WS_R2); int* cnt = (int*)(p.ws + WS_CNT); int* tokl = (int*)(p.ws + WS_TOK);
    int* recc = (int*)(p.ws + WS_RECC); float* recw = (float*)(p.ws + WS_RECW); bf16_t* hb = (bf16_t*)(p.ws + WS_O); const bf16_t* mob = (const bf16_t*)(p.ws + WS_MOB); unsigned char* h8 = p.ws + WS_H8;
    const float* brg = p.in[15]; const float* bre = p.in[17];
    LAS float* H = (LAS float*)(lds + wave * 4352);
    LAS unsigned char* WL = lds + 36864;
    const int r4 = lane >> 4, k4 = (lane & 15) * 4;
    const int pa0 = tid / 384, pr0 = (tid % 384) >> 3, ps0 = tid & 7, pi1 = 512 + tid, pa1 = pi1 / 384, pr1 = (pi1 % 384) >> 3;
    const unsigned wsrc0 = (unsigned)(pa0 * 48 * 2048 + pr0 * D + ps0 * 8), wsrc1 = (unsigned)(pa1 * 48 * 2048 + pr1 * D + ps0 * 8);
    const unsigned wdst0 = (unsigned)(pa0 * 6144 + pr0 * 128 + ((ps0 ^ (pr0 & 7)) << 4)), wdst1 = (unsigned)(pa1 * 6144 + pr1 * 128 + ((ps0 ^ (pr1 & 7)) << 4));
    for (int round = blockIdx.x; round < T / 128; round += gridDim.x) {
        const int tile = round * 8 + wave;
        const float* xs = p.in[0] + (size_t)tile * 16 * D; const bf16_t* ms = mob + (size_t)tile * 16 * D; bf16_t* hs = hb + (size_t)tile * 16 * D; unsigned char* h8s = h8 + (size_t)tile * 16 * D;
        unsigned lo = (unsigned)(r4 * D + k4);
        f32x4 accA = {0.f, 0.f, 0.f, 0.f}, accB = accA, accC = accA; float ss = 0.f;
        f32x4 xa[4], xb_[4], xc[4]; u32x2 ma[4], mb[4], mc[4]; u32x4 wr0, wr1;
#define RT_LOADS(bx, bm, k) do { _Pragma("unroll") for (int j = 0; j < 4; ++j) { bx[j] = *(const f32x4*)(xs + (4 * j) * D + lo + 64 * (k)); bm[j] = *(const u32x2*)(ms + (4 * j) * D + lo + 64 * (k)); } } while (0)
#define RT_SPLIT(f0, f1, hi, lw) do { hi = pk2(f0, f1); lw = pk2((f0) - __uint_as_float(hi << 16), (f1) - __uint_as_float(hi & 0xffff0000u)); } while (0)
#define RT_COMP(bx, bm, k, wbuf) do { \
            _Pragma("unroll") for (int j = 0; j < 4; ++j) { f32x4 h = bx[j]; h.x += __uint_as_float(bm[j].x << 16); h.y += __uint_as_float(bm[j].x & 0xffff0000u); h.z += __uint_as_float(bm[j].y << 16); h.w += __uint_as_float(bm[j].y & 0xffff0000u); \
                u32x2 q2; q2.x = pk2(h[0], h[1]); q2.y = pk2(h[2], h[3]); *(u32x2*)(hs + (4 * j) * D + lo + 64 * (k)) = q2; \
                *(unsigned*)(h8s + (4 * j) * D + lo + 64 * (k)) = pk4_fp8(h[0], h[1], h[2], h[3]); \
                *(LAS f32x4*)(H + (4 * j + r4) * 68 + k4) = h; } \
            _Pragma("unroll") for (int ks = 0; ks < 2; ++ks) { const f32x4 h0 = *(const LAS f32x4*)(H + tl * 68 + 32 * ks + 8 * g), h1 = *(const LAS f32x4*)(H + tl * 68 + 32 * ks + 8 * g + 4); \
                ss += (h0.x * h0.x + h0.y * h0.y) + (h0.z * h0.z + h0.w * h0.w) + (h1.x * h1.x + h1.y * h1.y) + (h1.z * h1.z + h1.w * h1.w); \
                u32x4 hh, hl; RT_SPLIT(h0.x, h0.y, hh.x, hl.x); RT_SPLIT(h0.z, h0.w, hh.y, hl.y); RT_SPLIT(h1.x, h1.y, hh.z, hl.z); RT_SPLIT(h1.z, h1.w, hh.w, hl.w); \
                const bf16x8 bh = __builtin_bit_cast(bf16x8, hh), bl = __builtin_bit_cast(bf16x8, hl); const unsigned so_ = (unsigned)(((4 * ks + g) ^ (tl & 7)) << 4); \
                _Pragma("unroll") for (int t = 0; t < 3; ++t) { const bf16x8 ah = *(const LAS bf16x8*)((wbuf) + (16 * t + tl) * 128 + so_), al = *(const LAS bf16x8*)((wbuf) + 6144 + (16 * t + tl) * 128 + so_); \
                    f32x4& ac = (t == 0 ? accA : (t == 1 ? accB : accC)); \
                    ac = __builtin_amdgcn_mfma_f32_16x16x32_bf16(ah, bh, ac, 0, 0, 0); ac = __builtin_amdgcn_mfma_f32_16x16x32_bf16(al, bh, ac, 0, 0, 0); ac = __builtin_amdgcn_mfma_f32_16x16x32_bf16(ah, bl, ac, 0, 0, 0); } } } while (0)
#define RT_WLOAD(c) do { wr0 = *(const u32x4*)(wsp + wsrc0 + 64 * (c)); if (tid < 256) wr1 = *(const u32x4*)(wsp + wsrc1 + 64 * (c)); } while (0)
#define RT_WSTORE(wbuf) do { *(LAS u32x4*)((wbuf) + wdst0) = wr0; if (tid < 256) *(LAS u32x4*)((wbuf) + wdst1) = wr1; } while (0)
        __syncthreads();
        RT_WLOAD(0); RT_LOADS(xa, ma, 0); RT_LOADS(xb_, mb, 1);
        RT_WSTORE(WL); RT_WLOAD(1);
        __syncthreads();
#pragma unroll 1
        for (int c = 0; c < D / 64 - 2; c += 3) {
            const int pz = c & 1;
            RT_LOADS(xc, mc, 2); RT_COMP(xa, ma, 0, WL + pz * 12288); RT_WSTORE(WL + (pz ^ 1) * 12288); RT_WLOAD(c + 2); __syncthreads();
            RT_LOADS(xa, ma, 3); RT_COMP(xb_, mb, 1, WL + (pz ^ 1) * 12288); RT_WSTORE(WL + pz * 12288); RT_WLOAD(c + 3); __syncthreads();
            RT_LOADS(xb_, mb, 4); RT_COMP(xc, mc, 2, WL + pz * 12288); RT_WSTORE(WL + (pz ^ 1) * 12288); RT_WLOAD((c + 4) & 31); __syncthreads();
            lo += 192;
        }
        RT_COMP(xa, ma, 0, WL); RT_WSTORE(WL + 12288); __syncthreads();
        RT_COMP(xb_, mb, 1, WL + 12288);
#undef RT_LOADS
#undef RT_SPLIT
#undef RT_COMP
#undef RT_WLOAD
#undef RT_WSTORE
        const int tok = tile * 16 + tl;
        ss += __shfl_xor(ss, 16); ss += __shfl_xor(ss, 32);
        const float rr = rsqrtf(ss * (1.0f / D) + EPS);
        const float myg = accC[0] * rr + brg[g];
        float gl[4];
#pragma unroll
        for (int j = 0; j < 4; ++j) gl[j] = __shfl(myg, tl + 16 * j);
        int gi = 0; float gm = gl[0];
#pragma unroll
        for (int i = 1; i < 4; ++i) if (gl[i] > gm) { gm = gl[i]; gi = i; }
        float den = 0.f;
#pragma unroll
        for (int i = 0; i < 4; ++i) den += __expf(gl[i] - gm);
        const float pg = 1.0f / den;
        int L0 = 0, L1 = 0; float wt0 = 0.f, wt1 = 0.f; const bool owner = (g == gi);
        if (owner) {
            float el[8];
#pragma unroll
            for (int i = 0; i < 4; ++i) { el[i] = accA[i] * rr + bre[g * 8 + i]; el[4 + i] = accB[i] * rr + bre[g * 8 + 4 + i]; }
            int e0 = 0; float v0 = el[0];
#pragma unroll
            for (int i = 1; i < 8; ++i) if (el[i] > v0) { v0 = el[i]; e0 = i; }
            int e1 = -1; float v1 = -3.0e38f;
#pragma unroll
            for (int i = 0; i < 8; ++i) if (i != e0 && el[i] > v1) { v1 = el[i]; e1 = i; }
            const float ex = __expf(v1 - v0); const float s0 = 1.0f / (1.0f + ex), s1 = ex * s0;
            r2[tok] = rr; L0 = gi * 8 + e0; L1 = gi * 8 + e1; wt0 = pg * s0; wt1 = pg * s1;
        }
        LAS int* cl = (LAS int*)(lds + 61440);
        if (tid < 32) cl[tid] = 0;
        __syncthreads();
        int q0 = 0, q1 = 0;
        if (owner) { q0 = __hip_atomic_fetch_add(&cl[L0], 1, __ATOMIC_RELAXED, __HIP_MEMORY_SCOPE_WORKGROUP); q1 = __hip_atomic_fetch_add(&cl[L1], 1, __ATOMIC_RELAXED, __HIP_MEMORY_SCOPE_WORKGROUP); }
        __syncthreads();
        if (tid < 32) { const int n = cl[tid]; cl[32 + tid] = n ? atomicAdd(&cnt[tid], n) : 0; }
        __syncthreads();
        if (owner) { const int p0 = cl[32 + L0] + q0, p1 = cl[32 + L1] + q1;
            float* r2l = (float*)(p.ws + WS_R2L);
            tokl[(size_t)L0 * T + p0] = tok; r2l[(size_t)L0 * T + p0] = rr; recc[2 * tok] = L0 * 32768 + p0; recw[2 * tok] = wt0;
            tokl[(size_t)L1 * T + p1] = tok; r2l[(size_t)L1 * T + p1] = rr; recc[2 * tok + 1] = L1 * 32768 + p1; recw[2 * tok + 1] = wt1; }
    }
    __syncthreads();
}

__device__ __forceinline__ void build_tiles(const Params& p, LAS int* tab) {
    __syncthreads();
    if (threadIdx.x < 64) { const int L = threadIdx.x; const int c = L < 32 ? ((const int*)(p.ws + WS_CNT))[L] : 0; const int nt = (c + 255) >> 8;
        int pre = nt;
#pragma unroll
        for (int o = 1; o < 32; o <<= 1) { const int v = __shfl_up(pre, o); if (L >= o) pre += v; }
        const int first = pre - nt;
        if (L < 32) { tab[1400 + L] = first * 256; for (int i = 0; i < nt; ++i) { tab[4 + (first + i) * 4 + 0] = L; tab[4 + (first + i) * 4 + 1] = i * 256; tab[4 + (first + i) * 4 + 2] = (first + i) * 256; tab[4 + (first + i) * 4 + 3] = min(256, c - i * 256); } }
        if (L == 31) tab[0] = pre; }
    __syncthreads();
}
template <int NPN> struct MoeOrder { int G, c, t_lo, nt_tiles; const LAS int* tab;
    __device__ __forceinline__ bool unit(int i, Unit& u) const { const long L = (long)i * G + c; if (L >= (long)nt_tiles * NPN) return false;
        const int nwg = nt_tiles * NPN; int wgid = (int)L; { const int q = nwg / 8, r = nwg % 8, xcd = wgid % 8, off = wgid / 8; wgid = (xcd < r ? xcd * (q + 1) : r * (q + 1) + (xcd - r) * q) + off; }
        u.pm = t_lo + wgid / NPN; u.pn = wgid % NPN; u.aux = 0; return true; } };
struct GateUpSched { MoeOrder<4> o; const unsigned char* hb; const unsigned char* WguT; const int* tokl;
    __device__ __forceinline__ bool next(int i, Unit& u) const { return o.unit(i, u); }
    __device__ __forceinline__ const char* a_base(const Unit&) const { return (const char*)hb; }
    __device__ __forceinline__ const char* b_base(const Unit& u) const { const int e = o.tab[4 + u.pm * 4] & 31; return (const char*)(WguT + (size_t)(e * 1024 + u.pn * 256) * D); }
    __device__ __forceinline__ bool keep_acc(const Unit&) const { return false; }
    __device__ __forceinline__ void a_offs(const Unit& u, int R0, int C0, int R1, int C1, unsigned (&v)[2][2]) const {
        const int L = o.tab[4 + u.pm * 4], row0 = o.tab[4 + u.pm * 4 + 1], nrows = o.tab[4 + u.pm * 4 + 3]; const int* lst = tokl + (size_t)L * T + row0;
#pragma unroll
        for (int h = 0; h < 2; ++h) { const int r0 = R0 + 128 * h, r1 = R1 + 128 * h; const int t0 = r0 < nrows ? lst[r0] : 0, t1 = r1 < nrows ? lst[r1] : 0;
            v[h][0] = (unsigned)t0 * D + C0 * 2u; v[h][1] = (unsigned)t1 * D + C1 * 2u; } }
};
struct EpiGateUp { const LAS int* tab; const float* r2l; bf16_t* he;
    __device__ __forceinline__ void operator()(f32x4 (&acc)[2][2][4][2], const Unit& u, int wr, int wc, int fr, int fq) const {
        const int L = tab[4 + u.pm * 4], row0 = tab[4 + u.pm * 4 + 1], slot = tab[4 + u.pm * 4 + 2], nrows = tab[4 + u.pm * 4 + 3];
#pragma unroll
        for (int ai = 0; ai < 2; ++ai)
#pragma unroll
            for (int m = 0; m < 4; ++m) { const int rr = ai * 128 + wr * 64 + m * 16 + fr; const float rs = rr < nrows ? r2l[(size_t)L * T + row0 + rr] * (1.0f / 64.0f) : 0.f;
                u32x4 w; unsigned ww[4];
#pragma unroll
                for (int n = 0; n < 2; ++n) { float hv[4];
#pragma unroll
                    for (int j = 0; j < 4; ++j) { const float gt = acc[ai][0][m][n][j] * rs, up = acc[ai][1][m][n][j] * rs; hv[j] = gt * sigmoidf_(gt) * up; }
                    ww[2 * n] = pk2(hv[0], hv[1]); ww[2 * n + 1] = pk2(hv[2], hv[3]); }
                w.x = ww[0]; w.y = ww[1]; w.z = ww[2]; w.w = ww[3];
                *(u32x4*)(he + (size_t)(slot + rr) * 512 + u.pn * 128 + wc * 32 + 8 * fq) = w; }
    } };
__device__ __forceinline__ void p6_gateup(const Params& p, LAS unsigned char* lds) {
    LAS int* tab = (LAS int*)(lds + TAB_OFF); build_tiles(p, tab);
    GateUpSched S; S.o.G = gridDim.x; S.o.c = blockIdx.x; S.o.t_lo = 0; S.o.nt_tiles = tab[0]; S.o.tab = tab;
    S.hb = p.ws + WS_H8; S.WguT = p.ws + WS_WGU; S.tokl = (const int*)(p.ws + WS_TOK);
    EpiGateUp E{tab, (const float*)(p.ws + WS_R2L), (bf16_t*)(p.ws + WS_HE)};
    pg8::gemm_phase<true, true, GateUpSched, EpiGateUp, true>(lds, S, E, D / 128, D / 2, D / 2);
}
struct DownSched { MoeOrder<8> o; const bf16_t* he; const bf16_t* WdT;
    __device__ __forceinline__ bool next(int i, Unit& u) const { return o.unit(i, u); }
    __device__ __forceinline__ const char* a_base(const Unit& u) const { return (const char*)(he + (size_t)o.tab[4 + u.pm * 4 + 2] * 512); }
    __device__ __forceinline__ const char* b_base(const Unit& u) const { const int e = o.tab[4 + u.pm * 4] & 31; return (const char*)(WdT + (size_t)(e * 2048 + u.pn * 256) * 512); }
    __device__ __forceinline__ bool keep_acc(const Unit&) const { return false; }
    __device__ __forceinline__ void a_offs(const Unit&, int, int, int, int, unsigned (&)[2][2]) const {}
};
struct EpiDown { const LAS int* tab; bf16_t* ye_lo; bf16_t* ye_hi;
    __device__ __forceinline__ void operator()(f32x4 (&acc)[2][2][4][2], const Unit& u, int wr, int wc, int fr, int fq) const {
        const int slot = tab[4 + u.pm * 4 + 2]; bf16_t* ye = u.pn < 4 ? ye_lo : ye_hi;
        unsigned off = (unsigned)(slot + wr * 64 + fr) * 1024 + (u.pn & 3) * 256 + wc * 32 + 8 * fq;
#pragma unroll
        for (int ai = 0; ai < 2; ++ai) {
#pragma unroll
            for (int m = 0; m < 4; ++m) { asm volatile("" : "+v"(off));
#pragma unroll
                for (int bj = 0; bj < 2; ++bj) { const f32x4 v0 = acc[ai][bj][m][0], v1 = acc[ai][bj][m][1];
                    u32x4 w; w.x = pk2(v0[0], v0[1]); w.y = pk2(v0[2], v0[3]); w.z = pk2(v1[0], v1[1]); w.w = pk2(v1[2], v1[3]);
                    *(u32x4*)(ye + off + bj * 128) = w; }
                off += 16 * 1024; }
            off += 64 * 1024; }
    } };
__device__ __forceinline__ void p7_down(const Params& p, LAS unsigned char* lds) {
    LAS int* tab = (LAS int*)(lds + TAB_OFF); build_tiles(p, tab);
    DownSched S; S.o.G = gridDim.x; S.o.c = blockIdx.x; S.o.t_lo = 0; S.o.nt_tiles = tab[0]; S.o.tab = tab;
    S.he = (const bf16_t*)(p.ws + WS_HE); S.WdT = (const bf16_t*)(p.ws + WS_WD);
    EpiDown E{tab, (bf16_t*)(p.ws + WS_YE_LO), (bf16_t*)(p.ws + WS_YE_HI)};
    pg8::gemm_phase<true, false, DownSched, EpiDown, false, false>(lds, S, E, 512 / 64, 512, 512);
}
__device__ __forceinline__ void p8_combine(const Params& p, LAS unsigned char* lds) {
    LAS int* tab = (LAS int*)(lds + TAB_OFF); build_tiles(p, tab);
    const int tid = phase_tid(), lane = tid & 63, wave = tid >> 6; const int gw = blockIdx.x * 8 + wave, NGW = gridDim.x * 8;
    const int* recc = (const int*)(p.ws + WS_RECC); const float* recw = (const float*)(p.ws + WS_RECW); const bf16_t* hb = (const bf16_t*)(p.ws + WS_O);
    const bf16_t* ye_lo = (const bf16_t*)(p.ws + WS_YE_LO); const bf16_t* ye_hi = (const bf16_t*)(p.ws + WS_YE_HI);
    for (int tok = gw; tok < T; tok += NGW) {
        const int c0 = recc[2 * tok], c1 = recc[2 * tok + 1]; const float wa = recw[2 * tok], wb = recw[2 * tok + 1];
        const int s0 = tab[1400 + (c0 >> 15)] + (c0 & 32767), s1 = tab[1400 + (c1 >> 15)] + (c1 & 32767);
        f32x4* op = (f32x4*)(p.out + (size_t)tok * D) + lane; const u32x2* hp = (const u32x2*)(hb + (size_t)tok * D) + lane;
        u32x2 m[8], a[8], b[8];
#pragma unroll
        for (int j = 0; j < 8; ++j) { const bf16_t* yb = j < 4 ? ye_lo : ye_hi; m[j] = hp[64 * j];
            a[j] = ((const u32x2*)(yb + (size_t)s0 * 1024) + lane)[64 * (j & 3)]; b[j] = ((const u32x2*)(yb + (size_t)s1 * 1024) + lane)[64 * (j & 3)]; }
#pragma unroll
        for (int j = 0; j < 8; ++j) { f32x4 v;
            v.x = __uint_as_float(m[j].x << 16) + wa * __uint_as_float(a[j].x << 16) + wb * __uint_as_float(b[j].x << 16); v.y = __uint_as_float(m[j].x & 0xffff0000u) + wa * __uint_as_float(a[j].x & 0xffff0000u) + wb * __uint_as_float(b[j].x & 0xffff0000u);
            v.z = __uint_as_float(m[j].y << 16) + wa * __uint_as_float(a[j].y << 16) + wb * __uint_as_float(b[j].y << 16); v.w = __uint_as_float(m[j].y & 0xffff0000u) + wa * __uint_as_float(a[j].y & 0xffff0000u) + wb * __uint_as_float(b[j].y & 0xffff0000u);
            op[64 * j] = v; }
    }
}

#define XB_TMO      128
#define XB_XCNT(j)  (256  + 64 * (j))
#define XB_XSUB(j)  (1280 + 64 * (j))
#define XB_XGEN(j)  (2304 + 64 * (j))
#define XB_TOP      3328
#define XB_TOPGEN   3392
#define XCD_BAR_WORDS 3456
#define XB_SPIN_CAP (1u << 18)
__device__ __forceinline__ unsigned xb_ld(unsigned* p)              { return __hip_atomic_load(p, __ATOMIC_RELAXED, __HIP_MEMORY_SCOPE_AGENT); }
__device__ __forceinline__ unsigned xb_add(unsigned* p, unsigned v) { return __hip_atomic_fetch_add(p, v, __ATOMIC_RELAXED, __HIP_MEMORY_SCOPE_AGENT); }
__device__ __forceinline__ unsigned xb_xcc_id() { return (unsigned)__builtin_amdgcn_s_getreg((3 << 11) | 20) & 0xFu; }
#define XB_SPIN(cond, bar) do { unsigned _sp = 0; while (cond) { __builtin_amdgcn_s_sleep(1); \
    if ((++_sp & 255u) == 0u) { if (xb_ld(&(bar)[XB_TMO])) break; if (_sp > XB_SPIN_CAP) { atomicAdd(&(bar)[XB_TMO], 1u); break; } } } } while (0)
struct XcdBarrier { unsigned* bar; unsigned x; volatile LAS unsigned* st; };
__device__ __forceinline__ XcdBarrier xcd_barrier_post(unsigned* bar, volatile LAS unsigned* st) {
    XcdBarrier b; b.bar = bar; b.x = xb_xcc_id(); b.st = st;
    if (threadIdx.x == 0) (void)xb_add(&bar[XB_XCNT(b.x)], 1u);
    return b;
}
__device__ __forceinline__ void xcd_barrier_complete(unsigned* bar, unsigned x, unsigned& nloc, unsigned& nx) {
    const unsigned G = gridDim.x * gridDim.y * gridDim.z;
    unsigned sum, cnt, mine, sp = 0u;
    for (;;) {
        sum = 0u; cnt = 0u; mine = 0u;
#pragma unroll
        for (unsigned j = 0; j < 16; ++j) { const unsigned c = xb_ld(&bar[XB_XCNT(j)]); sum += c; cnt += (c > 0u) ? 1u : 0u; mine = (j == x) ? c : mine; }
        if (sum == G) break;
        __builtin_amdgcn_s_sleep(1);
        if ((++sp & 255u) == 0u) { if (xb_ld(&bar[XB_TMO])) break; if (sp > XB_SPIN_CAP) { atomicAdd(&bar[XB_TMO], 1u); break; } }
    }
    nloc = mine > 0u ? mine : 1u; nx = cnt > 0u ? cnt : 1u;
}
__device__ __forceinline__ void xcd_barrier(const XcdBarrier& b) {
    asm volatile("s_waitcnt vmcnt(0)" ::: "memory");
    __syncthreads();
    if (threadIdx.x == 0) {
        unsigned* bar = b.bar;
        __builtin_amdgcn_s_waitcnt(0);
        unsigned nloc = b.st[0], nx = b.st[1];
        if (nloc == 0u) { xcd_barrier_complete(bar, b.x, nloc, nx); b.st[0] = nloc; b.st[1] = nx; }
        const unsigned old = xb_add(&bar[XB_XSUB(b.x)], 1u);
        const unsigned gen = old / nloc;
        if (old + 1u == (gen + 1u) * nloc) {
            __builtin_amdgcn_fence(__ATOMIC_RELEASE, "agent");
            asm volatile("s_waitcnt vmcnt(0)" ::: "memory");
            const unsigned og = xb_add(&bar[XB_TOP], 1u);
            const unsigned tg = og / nx;
            if (og + 1u == (tg + 1u) * nx) xb_add(&bar[XB_TOPGEN], 1u);
            else XB_SPIN(xb_ld(&bar[XB_TOPGEN]) == tg, bar);
            __builtin_amdgcn_fence(__ATOMIC_ACQUIRE, "agent");
            xb_add(&bar[XB_XGEN(b.x)], 1u);
            asm volatile("s_waitcnt vmcnt(0)" ::: "memory");
        } else {
            XB_SPIN(xb_ld(&bar[XB_XGEN(b.x)]) == gen, bar);
            __builtin_amdgcn_fence(__ATOMIC_ACQUIRE, "agent");
            asm volatile("s_waitcnt vmcnt(0)" ::: "memory");
        }
    }
    __syncthreads();
}

namespace cg = cooperative_groups;
#ifdef PROBE_A
#define STAMP(k) do { if (blockIdx.x == 0 && threadIdx.x == 0) ((unsigned long long*)(p.ws + WS_END))[k] = __builtin_amdgcn_s_memrealtime(); } while (0)
#else
#define STAMP(k) do {} while (0)
#endif
__global__ void __launch_bounds__(512, 2) fwd_megakernel(Params p) {
    extern __shared__ __attribute__((aligned(16))) unsigned char lds_raw[];
    LAS unsigned char* lds = (LAS unsigned char*)lds_raw;
    cg::grid_group grid = cg::this_grid();
    if (threadIdx.x == 0) { *(volatile LAS unsigned*)(lds + XBST_OFF) = 0u; *(volatile LAS unsigned*)(lds + XBST_OFF + 4) = 0u; }
    if (blockIdx.x == 0) for (int i = threadIdx.x; i < XCD_BAR_WORDS; i += 512) ((unsigned*)(p.ws + WS_BAR))[i] = 0u;
    __syncthreads();
#define GSYNC() xcd_barrier(xb)
    STAMP(0);
    p0_prep(p, lds);            grid.sync(); STAMP(1);
    const XcdBarrier xb = xcd_barrier_post((unsigned*)(p.ws + WS_BAR), (volatile LAS unsigned*)(lds + XBST_OFF));
    p1_inproj(p, lds);          GSYNC(); STAMP(2);
    p2_attn(p, lds);            GSYNC(); STAMP(3);
    p_moe_prep(p, lds);         STAMP(4);
    p3_up(p, lds);              GSYNC(); STAMP(5);
    p4_out(p, lds);             GSYNC(); STAMP(6);
    p5_router(p, lds);          GSYNC(); STAMP(7);
    p6_gateup(p, lds);          GSYNC(); STAMP(8);
    p7_down(p, lds);            GSYNC(); STAMP(9);
    p8_combine(p, lds);
#ifdef PROBE_A
    grid.sync(); STAMP(10); grid.sync();
    {
        const unsigned long long* ts = (const unsigned long long*)(p.ws + WS_END);
        #ifndef PROBE_A1
#define PROBE_A1 (PROBE_A + 1)
#endif
#ifndef PROBE_B1
#define PROBE_B1 (PROBE_B + 1)
#endif
        const float usA = (float)(ts[PROBE_A1] - ts[PROBE_A]) * 0.01f, usB = (float)(ts[PROBE_B1] - ts[PROBE_B]) * 0.01f;
        const float eps = sqrtf(usA * 1e-6f);
        for (size_t i = (size_t)blockIdx.x * 512 + threadIdx.x; i < (size_t)T * D / 4; i += (size_t)gridDim.x * 512) { f32x4 v = ((f32x4*)p.out)[i]; v = v * (1.0f + eps); if (i == 0) v.x += usB * 0.1f; ((f32x4*)p.out)[i] = v; }
    }
#endif
}

extern "C" void kernel_launch(void* const* d_in, const int* in_sizes, int n_in, void* d_out, int out_size, void* d_ws, size_t ws_size, hipStream_t stream) {
    static int grid_blocks = 0;
    if (!grid_blocks) {
        if (n_in != 21 || out_size != T * D || ws_size < WS_MOB + 128 * MiB) { fprintf(stderr, "kernel_launch: unexpected problem (n_in %d out %d ws %zu)\n", n_in, out_size, ws_size); grid_blocks = -1; return; }
        if (hipFuncSetAttribute((const void*)fwd_megakernel, hipFuncAttributeMaxDynamicSharedMemorySize, LDS_BYTES) != hipSuccess) { fprintf(stderr, "kernel_launch: hipFuncSetAttribute failed\n"); grid_blocks = -1; return; }
        int dev = 0, cus = 0, per_cu = 0;
        hipGetDevice(&dev); hipDeviceGetAttribute(&cus, hipDeviceAttributeMultiprocessorCount, dev);
        hipOccupancyMaxActiveBlocksPerMultiprocessor(&per_cu, (const void*)fwd_megakernel, 512, LDS_BYTES);
        if (per_cu < 1 || cus < 1) { fprintf(stderr, "kernel_launch: occupancy query gave %d blocks/CU on %d CUs\n", per_cu, cus); grid_blocks = -1; return; }
        grid_blocks = cus;
    }
    if (grid_blocks < 0) return;
    Params p{};
    for (int i = 0; i < 21; ++i) p.in[i] = (const float*)d_in[i];
    p.out = (float*)d_out; p.ws = (unsigned char*)d_ws;
    void* args[] = {&p};
    hipError_t e = hipLaunchCooperativeKernel((const void*)fwd_megakernel, dim3(grid_blocks), dim3(512), args, LDS_BYTES, stream);
    if (e != hipSuccess) fprintf(stderr, "cooperative launch failed: %s (grid %d)\n", hipGetErrorString(e), grid_blocks);
}
```

```cpp
#include <hip/hip_runtime.h>
#include <hip/hip_cooperative_groups.h>
#include <cstdio>
#include <cstdint>

#define LAS __attribute__((address_space(3)))
typedef unsigned short bf16_t;
typedef short bf16x8 __attribute__((ext_vector_type(8)));
typedef short s16x4 __attribute__((ext_vector_type(4)));
typedef float f32x4 __attribute__((ext_vector_type(4)));
typedef unsigned u32x4 __attribute__((ext_vector_type(4)));
typedef unsigned u32x2 __attribute__((ext_vector_type(2)));
typedef short v4i16_t __attribute__((ext_vector_type(4)));

namespace cfg {
constexpr int T = 32768, D = 2048, SEQ = 16384;
constexpr int NQKV = 4608, NGATE = 4096, NIN = 8704;
constexpr size_t MiB = 1ull << 20;
constexpr size_t WS_XB = 0, WS_QKV = 128 * MiB, WS_GATES = 416 * MiB, WS_O = 672 * MiB, WS_WIN = 800 * MiB, WS_WUP = 834 * MiB, WS_WOUT = 842 * MiB, WS_MISC = 850 * MiB;
constexpr size_t WS_WGU = 0, WS_WD = 64 * MiB, WS_MG = WS_QKV, WS_HE = WS_QKV + 192 * MiB;
constexpr size_t WS_R1 = WS_MISC, WS_R2 = WS_R1 + (size_t)T * 4, WS_WRT = WS_R2 + (size_t)T * 4, WS_CNT = WS_WRT + 512 * 1024, WS_TOK = WS_CNT + 4096,
                 WS_RECC = WS_TOK + 32ull * T * 4, WS_RECW = WS_RECC + 2ull * T * 4, WS_R2L = WS_RECW + 2ull * T * 4, WS_END = WS_R2L + 32ull * T * 4;
constexpr size_t WS_H8 = WS_GATES + 144 * MiB;
constexpr size_t WS_YE_LO = WS_QKV, WS_YE_HI = WS_GATES;
constexpr size_t WS_BAR = WS_END + 4096;
constexpr size_t WS_MOB = 872 * MiB;
constexpr int LDS_BYTES = 140 * 1024;
constexpr int XBST_OFF = LDS_BYTES - 16;
constexpr int TAB_OFF = 132 * 1024;
constexpr float EPS = 1e-6f;
}
using namespace cfg;

struct Params { const float* in[21]; float* out; unsigned char* ws; };
__device__ __forceinline__ int phase_tid() { int t = threadIdx.x; asm volatile("" : "+v"(t)); return t; }

__device__ __forceinline__ float bf2f(short s) { return __uint_as_float(((unsigned)(unsigned short)s) << 16); }
typedef float f32x2 __attribute__((ext_vector_type(2)));
typedef __bf16 bf16x2_t __attribute__((ext_vector_type(2)));
__device__ __forceinline__ unsigned pk2(float lo, float hi) { const f32x2 v = {lo, hi}; return __builtin_bit_cast(unsigned, __builtin_convertvector(v, bf16x2_t)); }
__device__ __forceinline__ unsigned pk4_fp8(float a, float b, float c, float d) { int w = 0; w = __builtin_amdgcn_cvt_pk_fp8_f32(a, b, w, false); w = __builtin_amdgcn_cvt_pk_fp8_f32(c, d, w, true); return (unsigned)w; }
__device__ __forceinline__ float wave_sum(float v) {
#pragma unroll
    for (int o = 1; o < 64; o <<= 1) v += __shfl_xor(v, o);
    return v;
}
__device__ __forceinline__ float sigmoidf_(float v) { return 1.0f / (1.0f + __expf(-v)); }
__device__ __forceinline__ unsigned off_b(unsigned row, unsigned ch) { return 256u * row + 16u * (ch ^ (((row & 3) << 2) | ((row >> 2) & 3))); }
__device__ __forceinline__ s16x4 tr_read(LAS unsigned char* p) { return __builtin_bit_cast(s16x4, __builtin_amdgcn_ds_read_tr16_b64_v4i16((LAS v4i16_t*)p)); }
__host__ __device__ __forceinline__ int perm32(int rho) { const int n = rho >> 4, i = rho & 15; return 8 * (i >> 2) + 4 * n + (i & 3); }
__device__ __forceinline__ int t5_bucket(int rel) {
    const int n = rel < 0 ? -rel : rel; const int ret = rel > 0 ? 16 : 0; int b;
    if (n < 8) b = n; else if (n < 12) b = 8; else if (n < 16) b = 9; else if (n < 23) b = 10; else if (n < 32) b = 11; else if (n < 46) b = 12; else if (n < 64) b = 13; else if (n < 91) b = 14; else b = 15;
    return ret + b;
}

template <bool FP8>
__device__ __forceinline__ void transpose_item(const float* __restrict__ W, int ldw, int k0, int n0, bf16_t* __restrict__ WT, int ldt, int drow0, int dk0, const float* __restrict__ scale, LAS unsigned* scr, int lane, float f8scale = 1.f) {
    const int n4 = (lane & 15) * 4, kk = lane >> 4;
    const float* src = W + (size_t)(k0 + 2 * kk) * ldw + n0 + n4;
    f32x4 ev[8], od[8];
#pragma unroll
    for (int j = 0; j < 8; ++j) { ev[j] = *(const f32x4*)(src + (size_t)(8 * j) * ldw); od[j] = *(const f32x4*)(src + (size_t)(8 * j + 1) * ldw); }
#pragma unroll
    for (int j = 0; j < 8; ++j) { f32x4 e = ev[j], o = od[j];
        if (scale) { const float se = scale[k0 + 8 * j + 2 * kk], so = scale[k0 + 8 * j + 2 * kk + 1]; e = e * se; o = o * so; }
        u32x4 w; w.x = pk2(e.x, o.x); w.y = pk2(e.y, o.y); w.z = pk2(e.z, o.z); w.w = pk2(e.w, o.w);
        *(LAS u32x4*)(scr + (4 * j + kk) * 68 + n4) = w; }
    asm volatile("s_waitcnt lgkmcnt(0)" ::: "memory");
    const int kq = lane & 7;
#pragma unroll
    for (int i = 0; i < 8; ++i) { const int n = (lane >> 3) + 8 * i; const LAS unsigned* q = scr + (4 * kq) * 68 + n;
        u32x4 o; o.x = q[0]; o.y = q[68]; o.z = q[136]; o.w = q[204];
        if (FP8) { u32x2 f; f.x = pk4_fp8(__uint_as_float(o.x << 16) * f8scale, __uint_as_float(o.x & 0xffff0000u) * f8scale, __uint_as_float(o.y << 16) * f8scale, __uint_as_float(o.y & 0xffff0000u) * f8scale);
            f.y = pk4_fp8(__uint_as_float(o.z << 16) * f8scale, __uint_as_float(o.z & 0xffff0000u) * f8scale, __uint_as_float(o.w << 16) * f8scale, __uint_as_float(o.w & 0xffff0000u) * f8scale);
            *(u32x2*)((unsigned char*)WT + (size_t)(drow0 + n) * ldt + dk0 + k0 + 8 * kq) = f; }
        else *(u32x4*)(WT + (size_t)(drow0 + n) * ldt + dk0 + k0 + 8 * kq) = o; }
    asm volatile("s_waitcnt lgkmcnt(0)" ::: "memory");
}

__device__ __forceinline__ void p0_prep(const Params& p, LAS unsigned char* lds) {
    const int tid = phase_tid(), lane = tid & 63, wave = tid >> 6;
    const int gw = blockIdx.x * 8 + wave, NGW = gridDim.x * 8;
    LAS unsigned* scr = (LAS unsigned*)(lds + wave * 8704);
    const float* x = p.in[0]; const float* g1 = p.in[1]; const float* w_in = p.in[2];
    bf16_t* xb = (bf16_t*)(p.ws + WS_XB); float* r1 = (float*)(p.ws + WS_R1);
    bf16_t* WinT = (bf16_t*)(p.ws + WS_WIN); bf16_t* WupT = (bf16_t*)(p.ws + WS_WUP); bf16_t* WoutT = (bf16_t*)(p.ws + WS_WOUT);
    constexpr int I_WIN = 32 * 136, I_UP = 16 * 32, I_OUT = 32 * 32, NITEMS = I_WIN + 2 * I_UP + I_OUT;
    for (int it = gw; it < NITEMS; it += NGW) {
        int r = it;
        if (r < I_WIN) { const int kb = r / 136, nb = r % 136; const int n0 = nb * 64; int drow = n0;
            if (n0 >= NQKV) { const int c = (n0 - NQKV) & 2047, isb = (n0 - NQKV) >> 11; drow = NQKV + (c >> 7) * 256 + isb * 128 + (c & 127); }
            transpose_item<false>(w_in, NIN, kb * 64, n0, WinT, 2048, drow, 0, g1, scr, lane); continue; } r -= I_WIN;
        if (r < I_UP) { const int kb = r / 32, nb = r % 32; transpose_item<false>(p.in[9], 2048, kb * 64, nb * 64, WupT, 2048, nb * 64, 0, nullptr, scr, lane); continue; } r -= I_UP;
        if (r < I_UP) { const int kb = r / 32, nb = r % 32; transpose_item<false>(p.in[10], 2048, kb * 64, nb * 64, WupT, 2048, nb * 64, 1024, nullptr, scr, lane); continue; } r -= I_UP;
        { const int kb = r / 32, nb = r % 32; transpose_item<false>(p.in[11], 2048, kb * 64, nb * 64, WoutT, 2048, nb * 64, 0, nullptr, scr, lane); }
    }
    { bf16_t* whi = (bf16_t*)(p.ws + WS_WRT); bf16_t* wlo = whi + 48 * 2048; const float* g2 = p.in[13]; const float* wrg = p.in[14]; const float* wre = p.in[16];
      for (int i = blockIdx.x * 512 + tid; i < 48 * 2048; i += gridDim.x * 512) { const int row = i >> 11, k = i & 2047, t = row >> 4, r = row & 15; float w;
          if (t == 0) w = wre[k * 32 + (r >> 2) * 8 + (r & 3)]; else if (t == 1) w = wre[k * 32 + (r >> 2) * 8 + 4 + (r & 3)]; else w = (r & 3) == 0 ? wrg[k * 4 + (r >> 2)] : 0.f;
          w *= g2[k]; const unsigned hi = pk2(w, 0.f) & 0xffffu; const float hf = __uint_as_float(hi << 16); whi[i] = (bf16_t)hi; wlo[i] = (bf16_t)(pk2(w - hf, 0.f) & 0xffffu); } }
    if (blockIdx.x == 0 && tid < 32) ((int*)(p.ws + WS_CNT))[tid] = 0;
    for (int row0 = 2 * gw; row0 < T; row0 += 2 * NGW) {
        f32x4 v[2][8]; float ss[2] = {0.f, 0.f};
#pragma unroll
        for (int u = 0; u < 2; ++u) { const f32x4* xr = (const f32x4*)(x + (size_t)(row0 + u) * D) + lane;
#pragma unroll
            for (int j = 0; j < 8; ++j) v[u][j] = xr[64 * j]; }
#pragma unroll
        for (int u = 0; u < 2; ++u) {
#pragma unroll
            for (int j = 0; j < 8; ++j) ss[u] += (v[u][j].x * v[u][j].x + v[u][j].y * v[u][j].y) + (v[u][j].z * v[u][j].z + v[u][j].w * v[u][j].w);
            ss[u] = wave_sum(ss[u]);
            if (lane == 0) r1[row0 + u] = rsqrtf(ss[u] * (1.0f / D) + EPS);
            u32x2* o = (u32x2*)(xb + (size_t)(row0 + u) * D) + lane;
#pragma unroll
            for (int j = 0; j < 8; ++j) { u32x2 w; w.x = pk2(v[u][j].x, v[u][j].y); w.y = pk2(v[u][j].z, v[u][j].w); o[64 * j] = w; } }
    }
}

constexpr int MOE_ITEMS = 2 * 32 * 32 * 8 + 32 * 8 * 32;
__device__ __forceinline__ void moe_prep_batch(const Params& p, LAS unsigned char* lds, int bi) {
    const int tid = phase_tid(), lane = tid & 63, wave = tid >> 6;
    LAS unsigned* scr = (LAS unsigned*)(lds + wave * 8704);
    const float* g2 = p.in[13];
    bf16_t* WguT = (bf16_t*)(p.ws + WS_WGU); bf16_t* WdT = (bf16_t*)(p.ws + WS_WD);
    constexpr int I_G = 32 * 32 * 8;
    int r = (bi * (int)gridDim.x + (int)blockIdx.x) * 8 + wave;
    if (r >= MOE_ITEMS) return;
    if (r < 2 * I_G) { const int which = r >= I_G; if (which) r -= I_G; const int e = r / 256, rr = r % 256, kb = rr / 8, nb = rr % 8;
        const float* W = p.in[which ? 19 : 18] + (size_t)e * 2048 * 512; const int n0 = nb * 64;
        transpose_item<true>(W, 512, kb * 64, n0, WguT, 2048, e * 1024 + (n0 >> 7) * 256 + which * 128 + (n0 & 127), 0, g2, scr, lane, 64.f); return; }
    r -= 2 * I_G;
    { const int e = r / 256, rr = r % 256, kb = rr / 32, nb = rr % 32; const float* W = p.in[20] + (size_t)e * 512 * 2048;
      transpose_item<false>(W, 2048, kb * 64, nb * 64, WdT, 512, e * 2048 + nb * 64, 0, nullptr, scr, lane); }
}

struct Unit { int pm, pn, aux; };
namespace pg8 {
constexpr int BM = 256, BK = 64, HALF = 128, HTB = HALF * BK * 2, STAGE_BYTES = 8 * HTB;
__device__ __forceinline__ int lds_byte(int r, int c) { const int st = (r >> 4) * 2 + (c >> 5), rr = r & 15, cc = c & 31, ob = rr * 64 + cc * 2; return st * 1024 + (ob ^ (((ob >> 9) & 1) << 5)); }
__device__ __forceinline__ void stage_rc(int b, int& R, int& C) { const int st = b / 1024, sb = b % 1024, swz = sb ^ (((sb >> 9) & 1) << 5); R = (st >> 1) * 16 + swz / 64; C = (st & 1) * 32 + (swz % 64) / 2; }

template <bool PERM, bool GATHER, class Sched, class Epi, bool FP8 = false, bool ALIGN_EPI = true>
__device__ __forceinline__ void gemm_phase(LAS unsigned char* lds, const Sched& S, const Epi& E, const int nt, const int lda, const int ldb) {
    int tid_ = threadIdx.x; asm volatile("" : "+v"(tid_));
    const int tid = tid_, wid = __builtin_amdgcn_readfirstlane(tid >> 6), lane = tid & 63, wr = wid >> 2, wc = wid & 3, fr = lane & 15, fq = lane >> 4;
    int R0, C0, R1, C1; stage_rc(tid * 16, R0, C0); stage_rc(tid * 16 + 8192, R1, C1);
    unsigned voffB[2], voffA[2][2];
    { const int Rb0 = PERM ? ((R0 & ~31) + perm32(R0 & 31)) : R0, Rb1 = PERM ? ((R1 & ~31) + perm32(R1 & 31)) : R1;
      voffB[0] = (unsigned)(Rb0 * ldb + C0) * 2u; voffB[1] = (unsigned)(Rb1 * ldb + C1) * 2u; }
    const size_t kstep = (size_t)(BK * 2);
    const size_t hstepB = (size_t)HALF * ldb * 2;
    const unsigned ldsw = (unsigned)wid * 1024u;
    const int aoff = lds_byte(wr * 64 + fr, fq * 8), boff = lds_byte(wc * 32 + fr, fq * 8);
#define PG8_SA(b, h) (((b) * 2 + (h)) * HTB)
#define PG8_SB(b, h) ((4 + (b) * 2 + (h)) * HTB)
#define PG8_STAGE_B(bufoff, gbase) do { _Pragma("unroll") for (int _i = 0; _i < 2; ++_i) \
        __builtin_amdgcn_global_load_lds((const unsigned*)((const char*)(gbase) + voffB[_i]), (LAS unsigned*)(lds + (bufoff) + ldsw + _i * 8192), 16, 0, 0); } while (0)
#define PG8_STAGE_A(bufoff, gbase, h) do { _Pragma("unroll") for (int _i = 0; _i < 2; ++_i) \
        __builtin_amdgcn_global_load_lds((const unsigned*)((const char*)(gbase) + voffA[h][_i]), (LAS unsigned*)(lds + (bufoff) + ldsw + _i * 8192), 16, 0, 0); } while (0)
#define PG8_LDA(dst, b, h) do { _Pragma("unroll") for (int m = 0; m < 4; ++m) _Pragma("unroll") for (int k = 0; k < 2; ++k) dst[m][k] = *(const LAS bf16x8*)(lds + PG8_SA(b, h) + aoff + m * 2048 + k * 1024); } while (0)
#define PG8_LDB(dst, b, h) do { _Pragma("unroll") for (int n = 0; n < 2; ++n) _Pragma("unroll") for (int k = 0; k < 2; ++k) dst[n][k] = *(const LAS bf16x8*)(lds + PG8_SB(b, h) + boff + n * 2048 + k * 1024); } while (0)
#define PG8_MMA(ai, bj, At, Bt) do { __builtin_amdgcn_s_setprio(1); _Pragma("unroll") for (int m = 0; m < 4; ++m) _Pragma("unroll") for (int n = 0; n < 2; ++n) { \
        if (FP8) { typedef int v8i_ __attribute__((ext_vector_type(8))); typedef int v4i_ __attribute__((ext_vector_type(4))); \
            const v4i_ b0_ = __builtin_bit_cast(v4i_, Bt[n][0]), b1_ = __builtin_bit_cast(v4i_, Bt[n][1]), a0_ = __builtin_bit_cast(v4i_, At[m][0]), a1_ = __builtin_bit_cast(v4i_, At[m][1]); \
            const v8i_ bb_ = {b0_[0], b0_[1], b0_[2], b0_[3], b1_[0], b1_[1], b1_[2], b1_[3]}, aa_ = {a0_[0], a0_[1], a0_[2], a0_[3], a1_[0], a1_[1], a1_[2], a1_[3]}; \
            acc[ai][bj][m][n] = __builtin_amdgcn_mfma_scale_f32_16x16x128_f8f6f4(bb_, aa_, acc[ai][bj][m][n], 0, 0, 0, 0x7f7f7f7f, 0, 0x7f7f7f7f); } \
        else { _Pragma("unroll") for (int k = 0; k < 2; ++k) acc[ai][bj][m][n] = __builtin_amdgcn_mfma_f32_16x16x32_bf16(Bt[n][k], At[m][k], acc[ai][bj][m][n], 0, 0, 0); } } \
        __builtin_amdgcn_s_setprio(0); } while (0)
#define PG8_WAIT_V(n) asm volatile("s_waitcnt vmcnt(" #n ")" ::: "memory")
#define PG8_WAIT_L(n) asm volatile("s_waitcnt lgkmcnt(" #n ")" ::: "memory")
#define PG8_BAR __builtin_amdgcn_s_barrier()
#define PG8_SCHED __builtin_amdgcn_sched_barrier(0)
    Unit cur, nxt; int ui = 0;
    __syncthreads();
    if (!S.next(0, cur)) return;
    if (GATHER) S.a_offs(cur, R0, C0, R1, C1, voffA);
    else { voffA[0][0] = (unsigned)(R0 * lda + C0) * 2u; voffA[0][1] = (unsigned)(R1 * lda + C1) * 2u; voffA[1][0] = voffA[0][0] + (unsigned)(HALF * lda * 2); voffA[1][1] = voffA[0][1] + (unsigned)(HALF * lda * 2); }
    f32x4 acc[2][2][4][2];
#pragma unroll
    for (int a = 0; a < 2; ++a)
#pragma unroll
        for (int b = 0; b < 2; ++b)
#pragma unroll
            for (int m = 0; m < 4; ++m)
#pragma unroll
                for (int n = 0; n < 2; ++n) acc[a][b][m][n] = (f32x4){0.f, 0.f, 0.f, 0.f};
    bf16x8 At[4][2], B0[2][2], B1[2][2];
    const char* cA = S.a_base(cur); const char* cB = S.b_base(cur);
    PG8_STAGE_B(PG8_SB(0, 0), cB); PG8_STAGE_B(PG8_SB(0, 1), cB + hstepB); PG8_STAGE_A(PG8_SA(0, 0), cA, 0); PG8_STAGE_A(PG8_SA(0, 1), cA, 1);
    if (wr == 1) PG8_BAR;
    PG8_WAIT_V(2); PG8_BAR;
    PG8_STAGE_B(PG8_SB(1, 0), cB + kstep); PG8_STAGE_A(PG8_SA(1, 0), cA + kstep, 0); PG8_STAGE_B(PG8_SB(1, 1), cB + hstepB + kstep);
    PG8_WAIT_V(6); PG8_BAR;
    for (;;) {
        const bool has_next = S.next(ui + 1, nxt);
        const char* nA = has_next ? S.a_base(nxt) : cA; const char* nB = has_next ? S.b_base(nxt) : cB;
        unsigned vn[2][2];
        if (GATHER) { if (has_next) S.a_offs(nxt, R0, C0, R1, C1, vn); else { vn[0][0] = voffA[0][0]; vn[0][1] = voffA[0][1]; vn[1][0] = voffA[1][0]; vn[1][1] = voffA[1][1]; } }
        for (int t = 0; t < nt; t += 2) {
            const bool last = (t == nt - 2);
            const char* a1 = cA + (size_t)(t + 1) * kstep;
            const char* a2 = last ? nA : cA + (size_t)(t + 2) * kstep; const char* b2 = last ? nB : cB + (size_t)(t + 2) * kstep;
            const char* a3 = a2 + kstep; const char* b3 = b2 + kstep;
            PG8_LDB(B0, 0, 0); PG8_LDB(B1, 0, 1); PG8_SCHED; PG8_LDA(At, 0, 0); PG8_STAGE_A(PG8_SA(1, 1), a1, 1);
            if (GATHER) { if (last) { voffA[0][0] = vn[0][0]; voffA[0][1] = vn[0][1]; voffA[1][0] = vn[1][0]; voffA[1][1] = vn[1][1]; } }
            PG8_WAIT_V(8); PG8_WAIT_L(0); PG8_BAR; PG8_MMA(0, 0, At, B0); PG8_MMA(0, 1, At, B1); PG8_BAR; PG8_SCHED;
            PG8_LDA(At, 0, 1); PG8_STAGE_B(PG8_SB(0, 0), b2); PG8_STAGE_B(PG8_SB(0, 1), b2 + hstepB); PG8_STAGE_A(PG8_SA(0, 0), a2, 0);
            PG8_WAIT_V(8); PG8_WAIT_L(0); PG8_BAR; PG8_MMA(1, 0, At, B0); PG8_MMA(1, 1, At, B1); PG8_BAR; PG8_SCHED;
            PG8_LDB(B0, 1, 0); PG8_LDB(B1, 1, 1); PG8_SCHED; PG8_LDA(At, 1, 0); PG8_STAGE_A(PG8_SA(0, 1), a2, 1);
            PG8_WAIT_V(8); PG8_WAIT_L(0); PG8_BAR; PG8_MMA(0, 0, At, B0); PG8_MMA(0, 1, At, B1); PG8_BAR; PG8_SCHED;
            PG8_LDA(At, 1, 1); PG8_STAGE_B(PG8_SB(1, 0), b3); PG8_STAGE_B(PG8_SB(1, 1), b3 + hstepB); PG8_STAGE_A(PG8_SA(1, 0), a3, 0);
            PG8_WAIT_V(8); PG8_WAIT_L(0); PG8_BAR; PG8_MMA(1, 0, At, B0); PG8_MMA(1, 1, At, B1); PG8_BAR; PG8_SCHED;
        }
        if (ALIGN_EPI) { if (wr == 0) PG8_BAR; }
        E(acc, cur, wr, wc, fr, fq);
        if (!has_next) break;
        if (!S.keep_acc(cur)) {
#pragma unroll
        for (int a = 0; a < 2; ++a)
#pragma unroll
            for (int b = 0; b < 2; ++b)
#pragma unroll
                for (int m = 0; m < 4; ++m)
#pragma unroll
                    for (int n = 0; n < 2; ++n) acc[a][b][m][n] = (f32x4){0.f, 0.f, 0.f, 0.f};
        }
        cur = nxt; cA = nA; cB = nB; ++ui;
        if (ALIGN_EPI) { if (wr == 1) PG8_BAR; }
    }
    PG8_WAIT_V(0);
    if (!ALIGN_EPI) { if (wr == 0) PG8_BAR; }
    PG8_BAR;
#undef PG8_SA
#undef PG8_SB
#undef PG8_STAGE_A
#undef PG8_STAGE_B
#undef PG8_LDA
#undef PG8_LDB
#undef PG8_MMA
#undef PG8_WAIT_V
#undef PG8_WAIT_L
#undef PG8_BAR
#undef PG8_SCHED
}
struct TileOrder {
    int nM, nN, nwg, G, c;
    __device__ __forceinline__ void init(int nM_, int nN_, int G_, int c_) { nM = nM_; nN = nN_; nwg = nM * nN; G = G_; c = c_; }
    __device__ __forceinline__ bool tile(int i, int& pm, int& pn) const {
        const long L = (long)i * G + c; if (L >= nwg) return false;
        int wgid = (int)L; { const int q = nwg / 8, r = nwg % 8, xcd = wgid % 8, off = wgid / 8; wgid = (xcd < r ? xcd * (q + 1) : r * (q + 1) + (xcd - r) * q) + off; }
        const int nig = 8 * nN, gid = wgid / nig, fm = gid * 8, gsz = (nM - fm) < 8 ? (nM - fm) : 8;
        pm = fm + ((wgid % nig) % gsz); pn = (wgid % nig) / gsz; return true;
    }
};
struct DenseSched {
    TileOrder o; const bf16_t* A; const bf16_t* Bt; int lda, ldb;
    __device__ __forceinline__ bool next(int i, Unit& u) const { u.aux = 0; return o.tile(i, u.pm, u.pn); }
    __device__ __forceinline__ const char* a_base(const Unit& u) const { return (const char*)(A + (size_t)u.pm * 256 * lda); }
    __device__ __forceinline__ const char* b_base(const Unit& u) const { return (const char*)(Bt + (size_t)u.pn * 256 * ldb); }
    __device__ __forceinline__ bool keep_acc(const Unit&) const { return false; }
    __device__ __forceinline__ void a_offs(const Unit&, int, int, int, int, unsigned (&)[2][2]) const {}
};
}

struct EpiInProj { bf16_t* qkv; bf16_t* gates; const float* r1; const float* gqa; const float* gka; const float* gqb; const float* gkb; LAS float* X;
    __device__ __forceinline__ void operator()(f32x4 (&acc)[2][2][4][2], const Unit& u, int wr, int wc, int fr, int fq) const {
        const int pn = u.pn;
        const bool isg = pn >= 18; bf16_t* base = isg ? gates : qkv; const int ldc = isg ? NGATE : NQKV; const int colt = (isg ? pn - 18 : pn) * 256 + wc * 32 + 8 * fq;
        const float* gain = pn < 4 ? gqa : (pn == 4 ? gka : ((pn >= 6 && pn < 10) ? gqb : ((pn >= 10 && pn < 14) ? gkb : nullptr)));
        if (gain) {
            const float extra = (pn < 4 || (pn >= 6 && pn < 10)) ? 0.08838834764831845f * 1.4426950408889634f : 1.0f;
#pragma unroll
            for (int ai = 0; ai < 2; ++ai)
#pragma unroll
                for (int m = 0; m < 4; ++m)
#pragma unroll
                    for (int bj = 0; bj < 2; ++bj) { const f32x4 a0 = acc[ai][bj][m][0], a1 = acc[ai][bj][m][1];
                        float sq = (a0[0] * a0[0] + a0[1] * a0[1]) + (a0[2] * a0[2] + a0[3] * a0[3]) + (a1[0] * a1[0] + a1[1] * a1[1]) + (a1[2] * a1[2] + a1[3] * a1[3]);
                        sq += __shfl_xor(sq, 16); sq += __shfl_xor(sq, 32);
                        if (fq == 0) X[(ai * 128 + wr * 64 + m * 16 + fr) * 8 + bj * 4 + wc] = sq; }
            asm volatile("s_waitcnt lgkmcnt(0)" ::: "memory"); __builtin_amdgcn_s_barrier(); asm volatile("" ::: "memory");
            const f32x4 g0 = *(const f32x4*)(gain + wc * 32 + 8 * fq), g1 = *(const f32x4*)(gain + wc * 32 + 8 * fq + 4);
#pragma unroll
            for (int ai = 0; ai < 2; ++ai)
#pragma unroll
                for (int m = 0; m < 4; ++m) { const int rl = ai * 128 + wr * 64 + m * 16 + fr; const int row = u.pm * 256 + rl; const float rs = r1[row]; bf16_t* rowp = base + (size_t)row * ldc + colt;
#pragma unroll
                    for (int bj = 0; bj < 2; ++bj) { const f32x4 t = *(const LAS f32x4*)(X + rl * 8 + bj * 4); const float tot = (t[0] + t[1]) + (t[2] + t[3]);
                        const float sc = rs * rsqrtf(rs * rs * tot * (1.0f / 128.0f) + EPS) * extra;
                        const f32x4 v0 = acc[ai][bj][m][0] * sc * g0, v1 = acc[ai][bj][m][1] * sc * g1;
                        u32x4 w; w.x = pk2(v0[0], v0[1]); w.y = pk2(v0[2], v0[3]); w.z = pk2(v1[0], v1[1]); w.w = pk2(v1[2], v1[3]);
                        *(u32x4*)(rowp + bj * 128) = w; } }
            return;
        }
        if (isg) {
            const int cg = (pn - 18) * 128 + wc * 32 + 8 * fq;
#pragma unroll
            for (int ai = 0; ai < 2; ++ai)
#pragma unroll
                for (int m = 0; m < 4; ++m) { const int row = u.pm * 256 + ai * 128 + wr * 64 + m * 16 + fr; const float rs = r1[row]; bf16_t* rowp = gates + (size_t)row * NGATE + cg;
                    float ra[8], sb[8];
#pragma unroll
                    for (int n = 0; n < 2; ++n)
#pragma unroll
                        for (int j = 0; j < 4; ++j) { const float ea = __expf(-acc[ai][0][m][n][j] * rs), eb = fminf(__expf(-acc[ai][1][m][n][j] * rs), 1e30f);
                            sb[4 * n + j] = __builtin_amdgcn_rcpf(1.0f + eb); ra[4 * n + j] = (1.0f + eb) * __builtin_amdgcn_rcpf(1.0f + ea); }
                    u32x4 w; w.x = pk2(ra[0], ra[1]); w.y = pk2(ra[2], ra[3]); w.z = pk2(ra[4], ra[5]); w.w = pk2(ra[6], ra[7]); *(u32x4*)rowp = w;
                    w.x = pk2(sb[0], sb[1]); w.y = pk2(sb[2], sb[3]); w.z = pk2(sb[4], sb[5]); w.w = pk2(sb[6], sb[7]); *(u32x4*)(rowp + 2048) = w; }
            return;
        }
#pragma unroll
        for (int ai = 0; ai < 2; ++ai)
#pragma unroll
            for (int m = 0; m < 4; ++m) { const int row = u.pm * 256 + ai * 128 + wr * 64 + m * 16 + fr; const float rs = r1[row]; bf16_t* rowp = base + (size_t)row * ldc + colt;
#pragma unroll
                for (int bj = 0; bj < 2; ++bj) { const f32x4 v0 = acc[ai][bj][m][0] * rs, v1 = acc[ai][bj][m][1] * rs;
                    u32x4 w; w.x = pk2(v0[0], v0[1]); w.y = pk2(v0[2], v0[3]); w.z = pk2(v1[0], v1[1]); w.w = pk2(v1[2], v1[3]);
                    *(u32x4*)(rowp + bj * 128) = w; } }
    } };
__device__ __forceinline__ void p1_inproj(const Params& p, LAS unsigned char* lds) {
    pg8::DenseSched S; S.o.init(128, 34, gridDim.x, blockIdx.x); S.A = (const bf16_t*)(p.ws + WS_XB); S.Bt = (const bf16_t*)(p.ws + WS_WIN); S.lda = D; S.ldb = D;
    EpiInProj E{(bf16_t*)(p.ws + WS_QKV), (bf16_t*)(p.ws + WS_GATES), (const float*)(p.ws + WS_R1), p.in[3], p.in[4], p.in[6], p.in[7], (LAS float*)(lds + 131072)};
    pg8::gemm_phase<true, false>(lds, S, E, D / 64, D, D);
}

__device__ __forceinline__ void wait_vm(int n) {
    switch (n) { case 0: asm volatile("s_waitcnt vmcnt(0)" ::: "memory"); break; case 2: asm volatile("s_waitcnt vmcnt(2)" ::: "memory"); break; case 4: asm volatile("s_waitcnt vmcnt(4)" ::: "memory"); break;
                 case 6: asm volatile("s_waitcnt vmcnt(6)" ::: "memory"); break; case 8: asm volatile("s_waitcnt vmcnt(8)" ::: "memory"); break; case 10: asm volatile("s_waitcnt vmcnt(10)" ::: "memory"); break;
                 default: asm volatile("s_waitcnt vmcnt(12)" ::: "memory"); break; }
}
__device__ __forceinline__ void glds16_asm(const void* gsrc, unsigned lds_dst) {
    unsigned keep;
    asm volatile("s_mov_b32 %0, m0\n\ts_mov_b32 m0, %2\n\ts_nop 0\n\tglobal_load_lds_dwordx4 %1, off\n\ts_mov_b32 m0, %0" : "=&s"(keep) : "v"(gsrc), "s"(lds_dst) : "memory");
}
#define ATT_BAR() do { asm volatile("s_waitcnt lgkmcnt(0)" ::: "memory"); __builtin_amdgcn_s_barrier(); asm volatile("" ::: "memory"); } while (0)
__device__ __forceinline__ void load_q(const bf16_t* qp, int g, bf16x8 (&qf)[4]) {
#pragma unroll
    for (int ks = 0; ks < 4; ++ks) qf[ks] = *(const bf16x8*)(qp + 32 * ks + 8 * g);
#pragma unroll
    for (int ks = 0; ks < 4; ++ks) asm volatile("" : "+v"(qf[ks]));
}
__device__ __forceinline__ bf16x8 vt_frag(LAS unsigned char* base, int row0, int g, int q4, int pp, int dt) {
    const s16x4 lo = tr_read(base + off_b(row0 + 4 * g + q4, 2 * dt + (pp >> 1)) + 8 * (pp & 1)), hi = tr_read(base + off_b(row0 + 16 + 4 * g + q4, 2 * dt + (pp >> 1)) + 8 * (pp & 1));
    bf16x8 vf; vf[0] = lo[0]; vf[1] = lo[1]; vf[2] = lo[2]; vf[3] = lo[3]; vf[4] = hi[0]; vf[5] = hi[1]; vf[6] = hi[2]; vf[7] = hi[3]; return vf;
}

__device__ __forceinline__ void attn_window_item(const Params& p, LAS unsigned char* lds, int item, int& tab_head) {
    const int tid = phase_tid(), lane = tid & 63, w = __builtin_amdgcn_readfirstlane(tid >> 6), g = lane >> 4, ql = lane & 15;
    const int b = item >> 9, nb = (item >> 2) & 127, hpq = item & 3, kv = hpq >> 1, hq0 = 2 * hpq;
    const bf16_t* qkv = (const bf16_t*)(p.ws + WS_QKV); bf16_t* o = (bf16_t*)(p.ws + WS_O);
    LAS float* bias = (LAS float*)(lds + 131072); const unsigned ldsb = (unsigned)(size_t)lds;
    const unsigned loff = (unsigned)(w * 4 + g) * NQKV + (unsigned)((ql ^ ((g << 2) | (w & 3))) * 8);
    const bf16_t* kbase = qkv + (size_t)(b * SEQ) * NQKV + 1024 + kv * 128;
#define WIN_ISSUE(c) do { const int _c = (c); const int _kb = min(max(nb - 1 + (_c % 3), 0), 127); const bf16_t* _src = kbase + (size_t)(_kb * 128) * NQKV + (_c >= 3 ? 256 : 0) + loff; \
        _Pragma("unroll") for (int _i = 0; _i < 4; ++_i) glds16_asm(_src + (size_t)(32 * _i) * NQKV, ldsb + (unsigned)((_c & 3) * 32768 + _i * 8192 + w * 1024)); } while (0)
    ATT_BAR();
    WIN_ISSUE(0); WIN_ISSUE(1); WIN_ISSUE(2);
    if (hpq != tab_head) { for (int i = tid; i < 2 * 257; i += 512) { const int hh = i >= 257, j = i - 257 * hh; bias[hh * 264 + j] = p.in[12][t5_bucket(j - 128) * 8 + hq0 + hh] * 1.4426950408889634f; } tab_head = hpq; }
    const int tq = b * SEQ + nb * 128 + 16 * w + ql;
    bf16x8 qf[2][4]; load_q(qkv + (size_t)tq * NQKV + hq0 * 128, g, qf[0]); load_q(qkv + (size_t)tq * NQKV + (hq0 + 1) * 128, g, qf[1]);
    float sink[2]; sink[0] = p.in[5][hq0] * 1.4426950408889634f; sink[1] = p.in[5][hq0 + 1] * 1.4426950408889634f; asm volatile("" : "+v"(sink[0]), "+v"(sink[1]));
    f32x4 S1[2][8], SC[2][9];
#pragma unroll
    for (int u = 0; u < 2; ++u) {
#pragma unroll
        for (int kt = 0; kt < 8; ++kt) S1[u][kt] = (f32x4){0.f, 0.f, 0.f, 0.f};
#pragma unroll
        for (int s = 0; s < 9; ++s) SC[u][s] = (f32x4){0.f, 0.f, 0.f, 0.f}; }
    const bool in0 = nb > 0, in2 = nb < 127;
#pragma unroll
    for (int c = 0; c < 3; ++c) {
        wait_vm(8); ATT_BAR(); WIN_ISSUE(c + 3);
        LAS unsigned char* buf = lds + (c & 3) * 32768;
#pragma unroll
        for (int kt = 0; kt < 8; ++kt) {
            const bool act = (c == 1) || (c == 0 ? kt >= w : kt <= w);
            if (act) {
#pragma unroll
                for (int ks = 0; ks < 4; ++ks) { const bf16x8 kf = *(const LAS bf16x8*)(buf + off_b(16 * kt + ql, 4 * ks + g));
#pragma unroll
                    for (int u = 0; u < 2; ++u) {
                        if (c == 1) S1[u][kt] = __builtin_amdgcn_mfma_f32_16x16x32_bf16(kf, qf[u][ks], S1[u][kt], 0, 0, 0);
                        else if (c == 0) SC[u][7 - kt] = __builtin_amdgcn_mfma_f32_16x16x32_bf16(kf, qf[u][ks], SC[u][7 - kt], 0, 0, 0);
                        else SC[u][8 - kt] = __builtin_amdgcn_mfma_f32_16x16x32_bf16(kf, qf[u][ks], SC[u][8 - kt], 0, 0, 0); } } }
        }
    }
    const int qi = 16 * w + ql; float inv[2];
    unsigned P1[2][4][4], PC[2][9][2];
#pragma unroll
    for (int u = 0; u < 2; ++u) { float mx = sink[u]; const LAS float* bt = bias + u * 264;
#pragma unroll
        for (int kt = 0; kt < 8; ++kt)
#pragma unroll
            for (int r = 0; r < 4; ++r) { const int rel = 16 * kt + 4 * g + r - qi; const float sv = S1[u][kt][r] + bt[rel + 128]; S1[u][kt][r] = sv; mx = fmaxf(mx, sv); }
#pragma unroll
        for (int s = 0; s < 9; ++s) { const bool c0 = s <= 7 - w; const int kt = c0 ? 7 - s : 8 - s; const int cofs = c0 ? -128 : 128; const bool inr = c0 ? in0 : in2;
#pragma unroll
            for (int r = 0; r < 4; ++r) { const int rel = cofs + 16 * kt + 4 * g + r - qi; const bool valid = inr && rel >= -128 && rel <= 128;
                const float bv = bt[rel + 128];
                const float sv = valid ? SC[u][s][r] + bv : -1e30f; SC[u][s][r] = sv; mx = fmaxf(mx, sv); } }
        mx = fmaxf(mx, __shfl_xor(mx, 16)); mx = fmaxf(mx, __shfl_xor(mx, 32));
        float l = 0.f;
#pragma unroll
        for (int kk = 0; kk < 4; ++kk) { float e[8];
#pragma unroll
            for (int r = 0; r < 4; ++r) { e[r] = __builtin_amdgcn_exp2f(S1[u][2 * kk][r] - mx); e[4 + r] = __builtin_amdgcn_exp2f(S1[u][2 * kk + 1][r] - mx); l += e[r] + e[4 + r]; }
            P1[u][kk][0] = pk2(e[0], e[1]); P1[u][kk][1] = pk2(e[2], e[3]); P1[u][kk][2] = pk2(e[4], e[5]); P1[u][kk][3] = pk2(e[6], e[7]); }
#pragma unroll
        for (int s = 0; s < 9; ++s) { float e[4];
#pragma unroll
            for (int r = 0; r < 4; ++r) { e[r] = __builtin_amdgcn_exp2f(SC[u][s][r] - mx); l += e[r]; }
            PC[u][s][0] = pk2(e[0], e[1]); PC[u][s][1] = pk2(e[2], e[3]); }
        l += __shfl_xor(l, 16); l += __shfl_xor(l, 32); l += __builtin_amdgcn_exp2f(sink[u] - mx);
        inv[u] = 1.0f / l; }
    f32x4 O[2][8];
#pragma unroll
    for (int u = 0; u < 2; ++u)
#pragma unroll
        for (int dt = 0; dt < 8; ++dt) O[u][dt] = (f32x4){0.f, 0.f, 0.f, 0.f};
    const int q4 = ql >> 2, pp = ql & 3;
#pragma unroll
    for (int c = 0; c < 3; ++c) {
        wait_vm(c == 0 ? 8 : (c == 1 ? 4 : 0)); ATT_BAR();
        LAS unsigned char* buf = lds + ((c + 3) & 3) * 32768;
#pragma unroll
        for (int kk = 0; kk < 4; ++kk) {
            bool a0, a1;
            if (c == 1) { a0 = true; a1 = true; } else if (c == 0) { a0 = 2 * kk >= w; a1 = 2 * kk + 1 >= w; } else { a0 = 2 * kk <= w; a1 = 2 * kk + 1 <= w; }
            if (a0 || a1) { bf16x8 pf[2];
#pragma unroll
                for (int u = 0; u < 2; ++u) { u32x4 pw;
                    if (c == 1) { pw.x = P1[u][kk][0]; pw.y = P1[u][kk][1]; pw.z = P1[u][kk][2]; pw.w = P1[u][kk][3]; }
                    else if (c == 0) { pw.x = a0 ? PC[u][7 - 2 * kk][0] : 0u; pw.y = a0 ? PC[u][7 - 2 * kk][1] : 0u; pw.z = a1 ? PC[u][6 - 2 * kk][0] : 0u; pw.w = a1 ? PC[u][6 - 2 * kk][1] : 0u; }
                    else { pw.x = a0 ? PC[u][8 - 2 * kk][0] : 0u; pw.y = a0 ? PC[u][8 - 2 * kk][1] : 0u; pw.z = a1 ? PC[u][7 - 2 * kk][0] : 0u; pw.w = a1 ? PC[u][7 - 2 * kk][1] : 0u; }
                    pf[u] = __builtin_bit_cast(bf16x8, pw); }
#pragma unroll
                for (int dt = 0; dt < 8; ++dt) { const bf16x8 vf = vt_frag(buf, 32 * kk, g, q4, pp, dt);
                    O[0][dt] = __builtin_amdgcn_mfma_f32_16x16x32_bf16(vf, pf[0], O[0][dt], 0, 0, 0); O[1][dt] = __builtin_amdgcn_mfma_f32_16x16x32_bf16(vf, pf[1], O[1][dt], 0, 0, 0); } } }
    }
#undef WIN_ISSUE
#pragma unroll
    for (int u = 0; u < 2; ++u) { bf16_t* op = o + (size_t)tq * D + (hq0 + u) * 128 + 4 * g;
#pragma unroll
        for (int dt = 0; dt < 8; ++dt) { u32x2 w2; w2.x = pk2(O[u][dt][0] * inv[u], O[u][dt][1] * inv[u]); w2.y = pk2(O[u][dt][2] * inv[u], O[u][dt][3] * inv[u]); *(u32x2*)(op + 16 * dt) = w2; } }
}

__device__ __forceinline__ void attn_nat_item(const Params& p, LAS unsigned char* lds, int item, int& tab_head) {
    const int tid = phase_tid(), lane = tid & 63, w = __builtin_amdgcn_readfirstlane(tid >> 6), g = lane >> 4, ql = lane & 15;
    const int b = item >> 9, rp = (item >> 2) & 127, hp = item & 3, hh = w >> 2, h = 2 * hp + hh, jq = w & 3;
    const int kr_lo = min(max(2 * rp - 4, 0), 248);
    const int d0 = min(max(2 * rp - 4, 0), 248) - kr_lo, d1 = min(max(2 * rp - 3, 0), 248) - kr_lo;
    const int w0 = jq == 0 ? 0 : (jq == 1 ? 8 : (jq == 2 ? 24 : 32));
    const bf16_t* qkv = (const bf16_t*)(p.ws + WS_QKV); bf16_t* o = (bf16_t*)(p.ws + WS_O);
    LAS float* rpb = (LAS float*)(lds + 131072); const unsigned ldsb = (unsigned)(size_t)lds;
    const unsigned loff = (unsigned)(w * 4 + g) * NQKV + (unsigned)((ql ^ ((g << 2) | (w & 3))) * 8);
    const bf16_t* kbase = qkv + (size_t)(b * SEQ) * NQKV + 2560 + 2 * hp * 128;
#define NAT_ISSUE(s) do { const int _s = (s); const int _kr = min(kr_lo + (_s % 9), 255); const bf16_t* _src = kbase + (size_t)(_kr * 64) * NQKV + (_s >= 9 ? 1024 : 0) + loff; \
        _Pragma("unroll") for (int _i = 0; _i < 4; ++_i) glds16_asm(_src + (size_t)(32 * (_i & 1)) * NQKV + 128 * (_i >> 1), ldsb + (unsigned)((_s & 3) * 32768 + _i * 8192 + w * 1024)); } while (0)
    ATT_BAR();
    NAT_ISSUE(0); NAT_ISSUE(1); NAT_ISSUE(2);
    if (hp != tab_head) { for (int i = tid; i < 930; i += 512) rpb[i] = p.in[8][2 * hp * 465 + i] * 1.4426950408889634f; tab_head = hp; }
    const int qcol = 16 * jq + ql; const int tq0 = b * SEQ + (2 * rp) * 64 + qcol;
    bf16x8 qf[2][4]; load_q(qkv + (size_t)tq0 * NQKV + 1536 + h * 128, g, qf[0]); load_q(qkv + (size_t)(tq0 + 64) * NQKV + 1536 + h * 128, g, qf[1]);
    f32x4 S[2][9][2];
#pragma unroll
    for (int u = 0; u < 2; ++u)
#pragma unroll
        for (int c = 0; c < 9; ++c) { S[u][c][0] = (f32x4){0.f, 0.f, 0.f, 0.f}; S[u][c][1] = (f32x4){0.f, 0.f, 0.f, 0.f}; }
#pragma unroll
    for (int c = 0; c < 9; ++c) {
        wait_vm(8); ATT_BAR(); NAT_ISSUE(c + 3);
        const bool a0 = c >= d0 && c < d0 + 8, a1 = c >= d1 && c < d1 + 8;
        LAS unsigned char* buf = lds + (c & 3) * 32768 + hh * 16384;
#pragma unroll
        for (int t = 0; t < 2; ++t)
#pragma unroll
            for (int ks = 0; ks < 4; ++ks) { const bf16x8 kf = *(const LAS bf16x8*)(buf + off_b(w0 + 16 * t + ql, 4 * ks + g));
                if (a0) S[0][c][t] = __builtin_amdgcn_mfma_f32_16x16x32_bf16(kf, qf[0][ks], S[0][c][t], 0, 0, 0);
                if (a1) S[1][c][t] = __builtin_amdgcn_mfma_f32_16x16x32_bf16(kf, qf[1][ks], S[1][c][t], 0, 0, 0); }
    }
    const int cs = min(max(qcol - 8, 0), 48); float inv[2];
    unsigned P[2][9][4];
    int dcv[2][4]; bool cv[2][4];
#pragma unroll
    for (int t = 0; t < 2; ++t)
#pragma unroll
        for (int q = 0; q < 4; ++q) { const int kc = w0 + 16 * t + 4 * g + q; cv[t][q] = kc >= cs && kc < cs + 16; dcv[t][q] = hh * 465 + kc - qcol + 15; }
#pragma unroll
    for (int u = 0; u < 2; ++u) { const int du = u ? d1 : d0; const int r = 2 * rp + u; float mx = -1e30f;
#pragma unroll
        for (int c = 0; c < 9; ++c) { const bool act = c >= du && c < du + 8;
            if (act) { const int rowb = (kr_lo + c - r + 7) * 31;
#pragma unroll
                for (int t = 0; t < 2; ++t)
#pragma unroll
                    for (int q = 0; q < 4; ++q) { const float sv = cv[t][q] ? S[u][c][t][q] + rpb[rowb + dcv[t][q]] : -1e30f; S[u][c][t][q] = sv; mx = fmaxf(mx, sv); } } }
        mx = fmaxf(mx, __shfl_xor(mx, 16)); mx = fmaxf(mx, __shfl_xor(mx, 32));
        float l = 0.f;
#pragma unroll
        for (int c = 0; c < 9; ++c) { const bool act = c >= du && c < du + 8;
            if (act) { float e[2][4];
#pragma unroll
                for (int t = 0; t < 2; ++t)
#pragma unroll
                    for (int q = 0; q < 4; ++q) { e[t][q] = __builtin_amdgcn_exp2f(S[u][c][t][q] - mx); l += e[t][q]; }
                P[u][c][0] = pk2(e[0][0], e[0][1]); P[u][c][1] = pk2(e[0][2], e[0][3]); P[u][c][2] = pk2(e[1][0], e[1][1]); P[u][c][3] = pk2(e[1][2], e[1][3]); }
            else { P[u][c][0] = 0u; P[u][c][1] = 0u; P[u][c][2] = 0u; P[u][c][3] = 0u; } }
        l += __shfl_xor(l, 16); l += __shfl_xor(l, 32);
        inv[u] = 1.0f / l; }
    f32x4 O[2][8];
#pragma unroll
    for (int u = 0; u < 2; ++u)
#pragma unroll
        for (int dt = 0; dt < 8; ++dt) O[u][dt] = (f32x4){0.f, 0.f, 0.f, 0.f};
    const int q4 = ql >> 2, pp = ql & 3;
#pragma unroll
    for (int c = 0; c < 9; ++c) {
        wait_vm(c <= 6 ? 8 : (c == 7 ? 4 : 0)); ATT_BAR(); if (c + 12 < 18) NAT_ISSUE(c + 12);
        const bool a0 = c >= d0 && c < d0 + 8, a1 = c >= d1 && c < d1 + 8;
        LAS unsigned char* buf = lds + ((c + 9) & 3) * 32768 + hh * 16384;
        u32x4 pw0; pw0.x = P[0][c][0]; pw0.y = P[0][c][1]; pw0.z = P[0][c][2]; pw0.w = P[0][c][3];
        u32x4 pw1; pw1.x = P[1][c][0]; pw1.y = P[1][c][1]; pw1.z = P[1][c][2]; pw1.w = P[1][c][3];
        const bf16x8 pf0 = __builtin_bit_cast(bf16x8, pw0), pf1 = __builtin_bit_cast(bf16x8, pw1);
#pragma unroll
        for (int dt = 0; dt < 8; ++dt) { const bf16x8 vf = vt_frag(buf, w0, g, q4, pp, dt);
            if (a0) O[0][dt] = __builtin_amdgcn_mfma_f32_16x16x32_bf16(vf, pf0, O[0][dt], 0, 0, 0);
            if (a1) O[1][dt] = __builtin_amdgcn_mfma_f32_16x16x32_bf16(vf, pf1, O[1][dt], 0, 0, 0); }
    }
#undef NAT_ISSUE
#pragma unroll
    for (int u = 0; u < 2; ++u) { bf16_t* op = o + (size_t)(tq0 + 64 * u) * D + 1024 + h * 128 + 4 * g;
#pragma unroll
        for (int dt = 0; dt < 8; ++dt) { u32x2 w2; w2.x = pk2(O[u][dt][0] * inv[u], O[u][dt][1] * inv[u]); w2.y = pk2(O[u][dt][2] * inv[u], O[u][dt][3] * inv[u]); *(u32x2*)(op + 16 * dt) = w2; } }
}
__device__ __forceinline__ void p2_attn(const Params& p, LAS unsigned char* lds) {
    int tab_head = -1, mb = 0;
    const int nper = (1024 + (int)gridDim.x - 1) / (int)gridDim.x;
    const int NB = (MOE_ITEMS + 8 * (int)gridDim.x - 1) / (8 * (int)gridDim.x);
    for (int s = 0; s < 2 * nper || mb < NB; ++s) {
        if (s < 2 * nper) {
            const bool nat = s >= nper; const int it = (int)blockIdx.x + (nat ? s - nper : s) * (int)gridDim.x;
            if (s == nper) { tab_head = -1;
#ifdef PROBE_A
                if (blockIdx.x == 0 && threadIdx.x == 0) ((unsigned long long*)(p.ws + WS_END))[11] = __builtin_amdgcn_s_memrealtime();
#endif
            }
            if (it < 1024) { if (!nat) attn_window_item(p, lds, it, tab_head); else attn_nat_item(p, lds, it, tab_head); }
        }
        if ((((s + (int)blockIdx.x) & 1) == 0 || s >= 2 * nper) && mb < NB) {
            ATT_BAR();
            for (int q = 0; q < 3 && mb < NB; ++q) moe_prep_batch(p, lds, mb++);
        }
    }
    asm volatile("s_waitcnt vmcnt(0)" ::: "memory"); __syncthreads();
}

struct UpHook { const bf16_t* gates;
    __device__ __forceinline__ void operator()(f32x4 (&acc)[2][2][4][2], const Unit& u, int wr, int wc, int fr, int fq) const {
        const unsigned goff = (unsigned)(u.pm * 256 + wr * 64 + fr) * NGATE + u.pn * 256 + wc * 32 + 8 * fq;
#pragma unroll
        for (int ai = 0; ai < 2; ++ai) {
            bf16x8 ra[4][2];
#pragma unroll
            for (int m = 0; m < 4; ++m)
#pragma unroll
                for (int bj = 0; bj < 2; ++bj) ra[m][bj] = *(const bf16x8*)(gates + goff + (unsigned)((ai * 128 + m * 16) * NGATE) + bj * 128);
#pragma unroll
            for (int m = 0; m < 4; ++m)
#pragma unroll
                for (int bj = 0; bj < 2; ++bj)
#pragma unroll
                    for (int n = 0; n < 2; ++n)
#pragma unroll
                        for (int j = 0; j < 4; ++j) acc[ai][bj][m][n][j] *= bf2f(ra[m][bj][4 * n + j]);
            asm volatile("" ::: "memory"); }
    } };
struct UpSched {
    pg8::TileOrder o; const bf16_t* A; const bf16_t* Bt;
    __device__ __forceinline__ bool next(int i, Unit& u) const { u.aux = i & 1; return o.tile(i >> 1, u.pm, u.pn); }
    __device__ __forceinline__ const char* a_base(const Unit& u) const { return (const char*)(A + (size_t)u.pm * 256 * D + u.aux * 1024); }
    __device__ __forceinline__ const char* b_base(const Unit& u) const { return (const char*)(Bt + (size_t)u.pn * 256 * D + u.aux * 1024); }
    __device__ __forceinline__ bool keep_acc(const Unit& u) const { return u.aux == 0; }
    __device__ __forceinline__ void a_offs(const Unit&, int, int, int, int, unsigned (&)[2][2]) const {}
};
struct EpiUp { const bf16_t* gates; bf16_t* merged;
    __device__ __forceinline__ void operator()(f32x4 (&acc)[2][2][4][2], const Unit& u, int wr, int wc, int fr, int fq) const {
        if (u.aux == 0) { UpHook{gates}(acc, u, wr, wc, fr, fq); return; }
        const unsigned goff = (unsigned)(u.pm * 256 + wr * 64 + fr) * NGATE + 2048 + u.pn * 256 + wc * 32 + 8 * fq;
        const unsigned moff = (unsigned)(u.pm * 256 + wr * 64 + fr) * D + u.pn * 256 + wc * 32 + 8 * fq;
#pragma unroll
        for (int ai = 0; ai < 2; ++ai) {
            bf16x8 sb[4][2];
#pragma unroll
            for (int m = 0; m < 4; ++m)
#pragma unroll
                for (int bj = 0; bj < 2; ++bj) sb[m][bj] = *(const bf16x8*)(gates + goff + (unsigned)((ai * 128 + m * 16) * NGATE) + bj * 128);
#pragma unroll
            for (int m = 0; m < 4; ++m)
#pragma unroll
                for (int bj = 0; bj < 2; ++bj) { f32x4 v0 = acc[ai][bj][m][0], v1 = acc[ai][bj][m][1];
#pragma unroll
                    for (int j = 0; j < 4; ++j) { v0[j] *= bf2f(sb[m][bj][j]); v1[j] *= bf2f(sb[m][bj][4 + j]); }
                    u32x4 w; w.x = pk2(v0[0], v0[1]); w.y = pk2(v0[2], v0[3]); w.z = pk2(v1[0], v1[1]); w.w = pk2(v1[2], v1[3]);
                    *(u32x4*)(merged + moff + (unsigned)((ai * 128 + m * 16) * D) + bj * 128) = w; }
            asm volatile("" ::: "memory"); }
    } };
__device__ __forceinline__ void p3_up(const Params& p, LAS unsigned char* lds) {
    UpSched S; S.o.init(128, 8, gridDim.x, blockIdx.x); S.A = (const bf16_t*)(p.ws + WS_O); S.Bt = (const bf16_t*)(p.ws + WS_WUP);
    EpiUp E{(const bf16_t*)(p.ws + WS_GATES), (bf16_t*)(p.ws + WS_MG)};
    pg8::gemm_phase<true, false>(lds, S, E, 1024 / 64, D, D);
}

struct EpiOut { bf16_t* mob;
    __device__ __forceinline__ void operator()(f32x4 (&acc)[2][2][4][2], const Unit& u, int wr, int wc, int fr, int fq) const {
        unsigned off = (unsigned)(u.pm * 256 + wr * 64 + fr) * D + u.pn * 256 + wc * 32 + 8 * fq;
#pragma unroll
        for (int ai = 0; ai < 2; ++ai) {
#pragma unroll
            for (int m = 0; m < 4; ++m) { asm volatile("" : "+v"(off));
#pragma unroll
                for (int bj = 0; bj < 2; ++bj) { const f32x4 v0 = acc[ai][bj][m][0], v1 = acc[ai][bj][m][1];
                    u32x4 w; w.x = pk2(v0[0], v0[1]); w.y = pk2(v0[2], v0[3]); w.z = pk2(v1[0], v1[1]); w.w = pk2(v1[2], v1[3]);
                    *(u32x4*)(mob + off + bj * 128) = w; }
                off += 16 * D; }
            off += 64 * D; }
    } };
__device__ __forceinline__ void p4_out(const Params& p, LAS unsigned char* lds) {
    pg8::DenseSched S; S.o.init(128, 8, gridDim.x, blockIdx.x); S.A = (const bf16_t*)(p.ws + WS_MG); S.Bt = (const bf16_t*)(p.ws + WS_WOUT); S.lda = D; S.ldb = D;
    EpiOut E{(bf16_t*)(p.ws + WS_MOB)};
    pg8::gemm_phase<true, false, pg8::DenseSched, EpiOut, false, false>(lds, S, E, D / 64, D, D);
}

__device__ __forceinline__ void p5_router(const Params& p, LAS unsigned char* lds) {
    const int tid = phase_tid(), lane = tid & 63, wave = __builtin_amdgcn_readfirstlane(tid >> 6), g = lane >> 4, tl = lane & 15;
    const bf16_t* wsp = (const bf16_t*)(p.ws + WS_WRT); float* r2 = (float*)(p.ws + WS_R2); int* cnt = (int*)(p.ws + WS_CNT); int* tokl = (int*)(p.ws + WS_TOK);
    int* recc = (int*)(p.ws + WS_RECC); float* recw = (float*)(p.ws + WS_RECW); bf16_t* hb = (bf16_t*)(p.ws + WS_O); const bf16_t* mob = (const bf16_t*)(p.ws + WS_MOB); unsigned char* h8 = p.ws + WS_H8;
    const float* brg = p.in[15]; const float* bre = p.in[17];
    LAS float* H = (LAS float*)(lds + wave * 4352);
    LAS unsigned char* WL = lds + 36864;
    const int r4 = lane >> 4, k4 = (lane & 15) * 4;
    const int pa0 = tid / 384, pr0 = (tid % 384) >> 3, ps0 = tid & 7, pi1 = 512 + tid, pa1 = pi1 / 384, pr1 = (pi1 % 384) >> 3;
    const unsigned wsrc0 = (unsigned)(pa0 * 48 * 2048 + pr0 * D + ps0 * 8), wsrc1 = (unsigned)(pa1 * 48 * 2048 + pr1 * D + ps0 * 8);
    const unsigned wdst0 = (unsigned)(pa0 * 6144 + pr0 * 128 + ((ps0 ^ (pr0 & 7)) << 4)), wdst1 = (unsigned)(pa1 * 6144 + pr1 * 128 + ((ps0 ^ (pr1 & 7)) << 4));
    for (int round = blockIdx.x; round < T / 128; round += gridDim.x) {
        const int tile = round * 8 + wave;
        const float* xs = p.in[0] + (size_t)tile * 16 * D; const bf16_t* ms = mob + (size_t)tile * 16 * D; bf16_t* hs = hb + (size_t)tile * 16 * D; unsigned char* h8s = h8 + (size_t)tile * 16 * D;
        unsigned lo = (unsigned)(r4 * D + k4);
        f32x4 accA = {0.f, 0.f, 0.f, 0.f}, accB = accA, accC = accA; float ss = 0.f;
        f32x4 xa[4], xb_[4], xc[4]; u32x2 ma[4], mb[4], mc[4]; u32x4 wr0, wr1;
#define RT_LOADS(bx, bm, k) do { _Pragma("unroll") for (int j = 0; j < 4; ++j) { bx[j] = *(const f32x4*)(xs + (4 * j) * D + lo + 64 * (k)); bm[j] = *(const u32x2*)(ms + (4 * j) * D + lo + 64 * (k)); } } while (0)
#define RT_SPLIT(f0, f1, hi, lw) do { hi = pk2(f0, f1); lw = pk2((f0) - __uint_as_float(hi << 16), (f1) - __uint_as_float(hi & 0xffff0000u)); } while (0)
#define RT_COMP(bx, bm, k, wbuf) do { \
            _Pragma("unroll") for (int j = 0; j < 4; ++j) { f32x4 h = bx[j]; h.x += __uint_as_float(bm[j].x << 16); h.y += __uint_as_float(bm[j].x & 0xffff0000u); h.z += __uint_as_float(bm[j].y << 16); h.w += __uint_as_float(bm[j].y & 0xffff0000u); \
                u32x2 q2; q2.x = pk2(h[0], h[1]); q2.y = pk2(h[2], h[3]); *(u32x2*)(hs + (4 * j) * D + lo + 64 * (k)) = q2; \
                *(unsigned*)(h8s + (4 * j) * D + lo + 64 * (k)) = pk4_fp8(h[0], h[1], h[2], h[3]); \
                *(LAS f32x4*)(H + (4 * j + r4) * 68 + k4) = h; } \
            _Pragma("unroll") for (int ks = 0; ks < 2; ++ks) { const f32x4 h0 = *(const LAS f32x4*)(H + tl * 68 + 32 * ks + 8 * g), h1 = *(const LAS f32x4*)(H + tl * 68 + 32 * ks + 8 * g + 4); \
                ss += (h0.x * h0.x + h0.y * h0.y) + (h0.z * h0.z + h0.w * h0.w) + (h1.x * h1.x + h1.y * h1.y) + (h1.z * h1.z + h1.w * h1.w); \
                u32x4 hh, hl; RT_SPLIT(h0.x, h0.y, hh.x, hl.x); RT_SPLIT(h0.z, h0.w, hh.y, hl.y); RT_SPLIT(h1.x, h1.y, hh.z, hl.z); RT_SPLIT(h1.z, h1.w, hh.w, hl.w); \
                const bf16x8 bh = __builtin_bit_cast(bf16x8, hh), bl = __builtin_bit_cast(bf16x8, hl); const unsigned so_ = (unsigned)(((4 * ks + g) ^ (tl & 7)) << 4); \
                _Pragma("unroll") for (int t = 0; t < 3; ++t) { const bf16x8 ah = *(const LAS bf16x8*)((wbuf) + (16 * t + tl) * 128 + so_), al = *(const LAS bf16x8*)((wbuf) + 6144 + (16 * t + tl) * 128 + so_); \
                    f32x4& ac = (t == 0 ? accA : (t == 1 ? accB : accC)); \
                    ac = __builtin_amdgcn_mfma_f32_16x16x32_bf16(ah, bh, ac, 0, 0, 0); ac = __builtin_amdgcn_mfma_f32_16x16x32_bf16(al, bh, ac, 0, 0, 0); ac = __builtin_amdgcn_mfma_f32_16x16x32_bf16(ah, bl, ac, 0, 0, 0); } } } while (0)
#define RT_WLOAD(c) do { wr0 = *(const u32x4*)(wsp + wsrc0 + 64 * (c)); if (tid < 256) wr1 = *(const u32x4*)(wsp + wsrc1 + 64 * (c)); } while (0)
#define RT_WSTORE(wbuf) do { *(LAS u32x4*)((wbuf) + wdst0) = wr0; if (tid < 256) *(LAS u32x4*)((wbuf) + wdst1) = wr1; } while (0)
        __syncthreads();
        RT_WLOAD(0); RT_LOADS(xa, ma, 0); RT_LOADS(xb_, mb, 1);
        RT_WSTORE(WL); RT_WLOAD(1);
        __syncthreads();
#pragma unroll 1
        for (int c = 0; c < D / 64 - 2; c += 3) {
            const int pz = c & 1;
            RT_LOADS(xc, mc, 2); RT_COMP(xa, ma, 0, WL + pz * 12288); RT_WSTORE(WL + (pz ^ 1) * 12288); RT_WLOAD(c + 2); __syncthreads();
            RT_LOADS(xa, ma, 3); RT_COMP(xb_, mb, 1, WL + (pz ^ 1) * 12288); RT_WSTORE(WL + pz * 12288); RT_WLOAD(c + 3); __syncthreads();
            RT_LOADS(xb_, mb, 4); RT_COMP(xc, mc, 2, WL + pz * 12288); RT_WSTORE(WL + (pz ^ 1) * 12288); RT_WLOAD((c + 4) & 31); __syncthreads();
            lo += 192;
        }
        RT_COMP(xa, ma, 0, WL); RT_WSTORE(WL + 12288); __syncthreads();
        RT_COMP(xb_, mb, 1, WL + 12288);
#undef RT_LOADS
#undef RT_SPLIT
#undef RT_COMP
#undef RT_WLOAD
#undef RT_WSTORE
        const int tok = tile * 16 + tl;
        ss += __shfl_xor(ss, 16); ss += __shfl_xor(ss, 32);
        const float rr = rsqrtf(ss * (1.0f / D) + EPS);
        const float myg = accC[0] * rr + brg[g];
        float gl[4];
#pragma unroll
        for (int j = 0; j < 4; ++j) gl[j] = __shfl(myg, tl + 16 * j);
        int gi = 0; float gm = gl[0];
#pragma unroll
        for (int i = 1; i < 4; ++i) if (gl[i] > gm) { gm = gl[i]; gi = i; }
        float den = 0.f;
#pragma unroll
        for (int i = 0; i < 4; ++i) den += __expf(gl[i] - gm);
        const float pg = 1.0f / den;
        int L0 = 0, L1 = 0; float wt0 = 0.f, wt1 = 0.f; const bool owner = (g == gi);
        if (owner) {
            float el[8];
#pragma unroll
            for (int i = 0; i < 4; ++i) { el[i] = accA[i] * rr + bre[g * 8 + i]; el[4 + i] = accB[i] * rr + bre[g * 8 + 4 + i]; }
            int e0 = 0; float v0 = el[0];
#pragma unroll
            for (int i = 1; i < 8; ++i) if (el[i] > v0) { v0 = el[i]; e0 = i; }
            int e1 = -1; float v1 = -3.0e38f;
#pragma unroll
            for (int i = 0; i < 8; ++i) if (i != e0 && el[i] > v1) { v1 = el[i]; e1 = i; }
            const float ex = __expf(v1 - v0); const float s0 = 1.0f / (1.0f + ex), s1 = ex * s0;
            r2[tok] = rr; L0 = gi * 8 + e0; L1 = gi * 8 + e1; wt0 = pg * s0; wt1 = pg * s1;
        }
        LAS int* cl = (LAS int*)(lds + 61440);
        if (tid < 32) cl[tid] = 0;
        __syncthreads();
        int q0 = 0, q1 = 0;
        if (owner) { q0 = __hip_atomic_fetch_add(&cl[L0], 1, __ATOMIC_RELAXED, __HIP_MEMORY_SCOPE_WORKGROUP); q1 = __hip_atomic_fetch_add(&cl[L1], 1, __ATOMIC_RELAXED, __HIP_MEMORY_SCOPE_WORKGROUP); }
        __syncthreads();
        if (tid < 32) { const int n = cl[tid]; cl[32 + tid] = n ? atomicAdd(&cnt[tid], n) : 0; }
        __syncthreads();
        if (owner) { const int p0 = cl[32 + L0] + q0, p1 = cl[32 + L1] + q1;
            float* r2l = (float*)(p.ws + WS_R2L);
            tokl[(size_t)L0 * T + p0] = tok; r2l[(size_t)L0 * T + p0] = rr; recc[2 * tok] = L0 * 32768 + p0; recw[2 * tok] = wt0;
            tokl[(size_t)L1 * T + p1] = tok; r2l[(size_t)L1 * T + p1] = rr; recc[2 * tok + 1] = L1 * 32768 + p1; recw[2 * tok + 1] = wt1; }
    }
    __syncthreads();
}

__device__ __forceinline__ void build_tiles(const Params& p, LAS int* tab) {
    __syncthreads();
    if (threadIdx.x < 64) { const int L = threadIdx.x; const int c = L < 32 ? ((const int*)(p.ws + WS_CNT))[L] : 0; const int nt = (c + 255) >> 8;
        int pre = nt;
#pragma unroll
        for (int o = 1; o < 32; o <<= 1) { const int v = __shfl_up(pre, o); if (L >= o) pre += v; }
        const int first = pre - nt;
        if (L < 32) { tab[1400 + L] = first * 256; for (int i = 0; i < nt; ++i) { tab[4 + (first + i) * 4 + 0] = L; tab[4 + (first + i) * 4 + 1] = i * 256; tab[4 + (first + i) * 4 + 2] = (first + i) * 256; tab[4 + (first + i) * 4 + 3] = min(256, c - i * 256); } }
        if (L == 31) tab[0] = pre; }
    __syncthreads();
}
template <int NPN> struct MoeOrder { int G, c, t_lo, nt_tiles; const LAS int* tab;
    __device__ __forceinline__ bool unit(int i, Unit& u) const { const long L = (long)i * G + c; if (L >= (long)nt_tiles * NPN) return false;
        const int nwg = nt_tiles * NPN; int wgid = (int)L; { const int q = nwg / 8, r = nwg % 8, xcd = wgid % 8, off = wgid / 8; wgid = (xcd < r ? xcd * (q + 1) : r * (q + 1) + (xcd - r) * q) + off; }
        u.pm = t_lo + wgid / NPN; u.pn = wgid % NPN; u.aux = 0; return true; } };
struct GateUpSched { MoeOrder<4> o; const unsigned char* hb; const unsigned char* WguT; const int* tokl;
    __device__ __forceinline__ bool next(int i, Unit& u) const { return o.unit(i, u); }
    __device__ __forceinline__ const char* a_base(const Unit&) const { return (const char*)hb; }
    __device__ __forceinline__ const char* b_base(const Unit& u) const { const int e = o.tab[4 + u.pm * 4] & 31; return (const char*)(WguT + (size_t)(e * 1024 + u.pn * 256) * D); }
    __device__ __forceinline__ bool keep_acc(const Unit&) const { return false; }
    __device__ __forceinline__ void a_offs(const Unit& u, int R0, int C0, int R1, int C1, unsigned (&v)[2][2]) const {
        const int L = o.tab[4 + u.pm * 4], row0 = o.tab[4 + u.pm * 4 + 1], nrows = o.tab[4 + u.pm * 4 + 3]; const int* lst = tokl + (size_t)L * T + row0;
#pragma unroll
        for (int h = 0; h < 2; ++h) { const int r0 = R0 + 128 * h, r1 = R1 + 128 * h; const int t0 = r0 < nrows ? lst[r0] : 0, t1 = r1 < nrows ? lst[r1] : 0;
            v[h][0] = (unsigned)t0 * D + C0 * 2u; v[h][1] = (unsigned)t1 * D + C1 * 2u; } }
};
struct EpiGateUp { const LAS int* tab; const float* r2l; bf16_t* he;
    __device__ __forceinline__ void operator()(f32x4 (&acc)[2][2][4][2], const Unit& u, int wr, int wc, int fr, int fq) const {
        const int L = tab[4 + u.pm * 4], row0 = tab[4 + u.pm * 4 + 1], slot = tab[4 + u.pm * 4 + 2], nrows = tab[4 + u.pm * 4 + 3];
#pragma unroll
        for (int ai = 0; ai < 2; ++ai)
#pragma unroll
            for (int m = 0; m < 4; ++m) { const int rr = ai * 128 + wr * 64 + m * 16 + fr; const float rs = rr < nrows ? r2l[(size_t)L * T + row0 + rr] * (1.0f / 64.0f) : 0.f;
                u32x4 w; unsigned ww[4];
#pragma unroll
                for (int n = 0; n < 2; ++n) { float hv[4];
#pragma unroll
                    for (int j = 0; j < 4; ++j) { const float gt = acc[ai][0][m][n][j] * rs, up = acc[ai][1][m][n][j] * rs; hv[j] = gt * sigmoidf_(gt) * up; }
                    ww[2 * n] = pk2(hv[0], hv[1]); ww[2 * n + 1] = pk2(hv[2], hv[3]); }
                w.x = ww[0]; w.y = ww[1]; w.z = ww[2]; w.w = ww[3];
                *(u32x4*)(he + (size_t)(slot + rr) * 512 + u.pn * 128 + wc * 32 + 8 * fq) = w; }
    } };
__device__ __forceinline__ void p6_gateup(const Params& p, LAS unsigned char* lds) {
    LAS int* tab = (LAS int*)(lds + TAB_OFF); build_tiles(p, tab);
    GateUpSched S; S.o.G = gridDim.x; S.o.c = blockIdx.x; S.o.t_lo = 0; S.o.nt_tiles = tab[0]; S.o.tab = tab;
    S.hb = p.ws + WS_H8; S.WguT = p.ws + WS_WGU; S.tokl = (const int*)(p.ws + WS_TOK);
    EpiGateUp E{tab, (const float*)(p.ws + WS_R2L), (bf16_t*)(p.ws + WS_HE)};
    pg8::gemm_phase<true, true, GateUpSched, EpiGateUp, true>(lds, S, E, D / 128, D / 2, D / 2);
}
struct DownSched { MoeOrder<8> o; const bf16_t* he; const bf16_t* WdT;
    __device__ __forceinline__ bool next(int i, Unit& u) const { return o.unit(i, u); }
    __device__ __forceinline__ const char* a_base(const Unit& u) const { return (const char*)(he + (size_t)o.tab[4 + u.pm * 4 + 2] * 512); }
    __device__ __forceinline__ const char* b_base(const Unit& u) const { const int e = o.tab[4 + u.pm * 4] & 31; return (const char*)(WdT + (size_t)(e * 2048 + u.pn * 256) * 512); }
    __device__ __forceinline__ bool keep_acc(const Unit&) const { return false; }
    __device__ __forceinline__ void a_offs(const Unit&, int, int, int, int, unsigned (&)[2][2]) const {}
};
struct EpiDown { const LAS int* tab; bf16_t* ye_lo; bf16_t* ye_hi;
    __device__ __forceinline__ void operator()(f32x4 (&acc)[2][2][4][2], const Unit& u, int wr, int wc, int fr, int fq) const {
        const int slot = tab[4 + u.pm * 4 + 2]; bf16_t* ye = u.pn < 4 ? ye_lo : ye_hi;
        unsigned off = (unsigned)(slot + wr * 64 + fr) * 1024 + (u.pn & 3) * 256 + wc * 32 + 8 * fq;
#pragma unroll
        for (int ai = 0; ai < 2; ++ai) {
#pragma unroll
            for (int m = 0; m < 4; ++m) { asm volatile("" : "+v"(off));
#pragma unroll
                for (int bj = 0; bj < 2; ++bj) { const f32x4 v0 = acc[ai][bj][m][0], v1 = acc[ai][bj][m][1];
                    u32x4 w; w.x = pk2(v0[0], v0[1]); w.y = pk2(v0[2], v0[3]); w.z = pk2(v1[0], v1[1]); w.w = pk2(v1[2], v1[3]);
                    *(u32x4*)(ye + off + bj * 128) = w; }
                off += 16 * 1024; }
            off += 64 * 1024; }
    } };
__device__ __forceinline__ void p7_down(const Params& p, LAS unsigned char* lds) {
    LAS int* tab = (LAS int*)(lds + TAB_OFF); build_tiles(p, tab);
    DownSched S; S.o.G = gridDim.x; S.o.c = blockIdx.x; S.o.t_lo = 0; S.o.nt_tiles = tab[0]; S.o.tab = tab;
    S.he = (const bf16_t*)(p.ws + WS_HE); S.WdT = (const bf16_t*)(p.ws + WS_WD);
    EpiDown E{tab, (bf16_t*)(p.ws + WS_YE_LO), (bf16_t*)(p.ws + WS_YE_HI)};
    pg8::gemm_phase<true, false, DownSched, EpiDown, false, false>(lds, S, E, 512 / 64, 512, 512);
}
__device__ __forceinline__ void p8_combine(const Params& p, LAS unsigned char* lds) {
    LAS int* tab = (LAS int*)(lds + TAB_OFF); build_tiles(p, tab);
    const int tid = phase_tid(), lane = tid & 63, wave = tid >> 6; const int gw = blockIdx.x * 8 + wave, NGW = gridDim.x * 8;
    const int* recc = (const int*)(p.ws + WS_RECC); const float* recw = (const float*)(p.ws + WS_RECW); const bf16_t* hb = (const bf16_t*)(p.ws + WS_O);
    const bf16_t* ye_lo = (const bf16_t*)(p.ws + WS_YE_LO); const bf16_t* ye_hi = (const bf16_t*)(p.ws + WS_YE_HI);
    for (int tok = gw; tok < T; tok += NGW) {
        const int c0 = recc[2 * tok], c1 = recc[2 * tok + 1]; const float wa = recw[2 * tok], wb = recw[2 * tok + 1];
        const int s0 = tab[1400 + (c0 >> 15)] + (c0 & 32767), s1 = tab[1400 + (c1 >> 15)] + (c1 & 32767);
        f32x4* op = (f32x4*)(p.out + (size_t)tok * D) + lane; const u32x2* hp = (const u32x2*)(hb + (size_t)tok * D) + lane;
        u32x2 m[8], a[8], b[8];
#pragma unroll
        for (int j = 0; j < 8; ++j) { const bf16_t* yb = j < 4 ? ye_lo : ye_hi; m[j] = hp[64 * j];
            a[j] = ((const u32x2*)(yb + (size_t)s0 * 1024) + lane)[64 * (j & 3)]; b[j] = ((const u32x2*)(yb + (size_t)s1 * 1024) + lane)[64 * (j & 3)]; }
#pragma unroll
        for (int j = 0; j < 8; ++j) { f32x4 v;
            v.x = __uint_as_float(m[j].x << 16) + wa * __uint_as_float(a[j].x << 16) + wb * __uint_as_float(b[j].x << 16); v.y = __uint_as_float(m[j].x & 0xffff0000u) + wa * __uint_as_float(a[j].x & 0xffff0000u) + wb * __uint_as_float(b[j].x & 0xffff0000u);
            v.z = __uint_as_float(m[j].y << 16) + wa * __uint_as_float(a[j].y << 16) + wb * __uint_as_float(b[j].y << 16); v.w = __uint_as_float(m[j].y & 0xffff0000u) + wa * __uint_as_float(a[j].y & 0xffff0000u) + wb * __uint_as_float(b[j].y & 0xffff0000u);
            op[64 * j] = v; }
    }
}

#define XB_TMO      128
#define XB_XCNT(j)  (256  + 64 * (j))
#define XB_XSUB(j)  (1280 + 64 * (j))
#define XB_XGEN(j)  (2304 + 64 * (j))
#define XB_TOP      3328
#define XB_TOPGEN   3392
#define XCD_BAR_WORDS 3456
#define XB_SPIN_CAP (1u << 18)
__device__ __forceinline__ unsigned xb_ld(unsigned* p)              { return __hip_atomic_load(p, __ATOMIC_RELAXED, __HIP_MEMORY_SCOPE_AGENT); }
__device__ __forceinline__ unsigned xb_add(unsigned* p, unsigned v) { return __hip_atomic_fetch_add(p, v, __ATOMIC_RELAXED, __HIP_MEMORY_SCOPE_AGENT); }
__device__ __forceinline__ unsigned xb_xcc_id() { return (unsigned)__builtin_amdgcn_s_getreg((3 << 11) | 20) & 0xFu; }
#define XB_SPIN(cond, bar) do { unsigned _sp = 0; while (cond) { __builtin_amdgcn_s_sleep(1); \
    if ((++_sp & 255u) == 0u) { if (xb_ld(&(bar)[XB_TMO])) break; if (_sp > XB_SPIN_CAP) { atomicAdd(&(bar)[XB_TMO], 1u); break; } } } } while (0)
struct XcdBarrier { unsigned* bar; unsigned x; volatile LAS unsigned* st; };
__device__ __forceinline__ XcdBarrier xcd_barrier_post(unsigned* bar, volatile LAS unsigned* st) {
    XcdBarrier b; b.bar = bar; b.x = xb_xcc_id(); b.st = st;
    if (threadIdx.x == 0) (void)xb_add(&bar[XB_XCNT(b.x)], 1u);
    return b;
}
__device__ __forceinline__ void xcd_barrier_complete(unsigned* bar, unsigned x, unsigned& nloc, unsigned& nx) {
    const unsigned G = gridDim.x * gridDim.y * gridDim.z;
    unsigned sum, cnt, mine, sp = 0u;
    for (;;) {
        sum = 0u; cnt = 0u; mine = 0u;
#pragma unroll
        for (unsigned j = 0; j < 16; ++j) { const unsigned c = xb_ld(&bar[XB_XCNT(j)]); sum += c; cnt += (c > 0u) ? 1u : 0u; mine = (j == x) ? c : mine; }
        if (sum == G) break;
        __builtin_amdgcn_s_sleep(1);
        if ((++sp & 255u) == 0u) { if (xb_ld(&bar[XB_TMO])) break; if (sp > XB_SPIN_CAP) { atomicAdd(&bar[XB_TMO], 1u); break; } }
    }
    nloc = mine > 0u ? mine : 1u; nx = cnt > 0u ? cnt : 1u;
}
__device__ __forceinline__ void xcd_barrier(const XcdBarrier& b) {
    asm volatile("s_waitcnt vmcnt(0)" ::: "memory");
    __syncthreads();
    if (threadIdx.x == 0) {
        unsigned* bar = b.bar;
        __builtin_amdgcn_s_waitcnt(0);
        unsigned nloc = b.st[0], nx = b.st[1];
        if (nloc == 0u) { xcd_barrier_complete(bar, b.x, nloc, nx); b.st[0] = nloc; b.st[1] = nx; }
        const unsigned old = xb_add(&bar[XB_XSUB(b.x)], 1u);
        const unsigned gen = old / nloc;
        if (old + 1u == (gen + 1u) * nloc) {
            __builtin_amdgcn_fence(__ATOMIC_RELEASE, "agent");
            asm volatile("s_waitcnt vmcnt(0)" ::: "memory");
            const unsigned og = xb_add(&bar[XB_TOP], 1u);
            const unsigned tg = og / nx;
            if (og + 1u == (tg + 1u) * nx) xb_add(&bar[XB_TOPGEN], 1u);
            else XB_SPIN(xb_ld(&bar[XB_TOPGEN]) == tg, bar);
            __builtin_amdgcn_fence(__ATOMIC_ACQUIRE, "agent");
            xb_add(&bar[XB_XGEN(b.x)], 1u);
            asm volatile("s_waitcnt vmcnt(0)" ::: "memory");
        } else {
            XB_SPIN(xb_ld(&bar[XB_XGEN(b.x)]) == gen, bar);
            __builtin_amdgcn_fence(__ATOMIC_ACQUIRE, "agent");
            asm volatile("s_waitcnt vmcnt(0)" ::: "memory");
        }
    }
    __syncthreads();
}

namespace cg = cooperative_groups;
#ifdef PROBE_A
#define STAMP(k) do { if (blockIdx.x == 0 && threadIdx.x == 0) ((unsigned long long*)(p.ws + WS_END))[k] = __builtin_amdgcn_s_memrealtime(); } while (0)
#else
#define STAMP(k) do {} while (0)
#endif
__global__ void __launch_bounds__(512, 2) fwd_megakernel(Params p) {
    extern __shared__ __attribute__((aligned(16))) unsigned char lds_raw[];
    LAS unsigned char* lds = (LAS unsigned char*)lds_raw;
    cg::grid_group grid = cg::this_grid();
    if (threadIdx.x == 0) { *(volatile LAS unsigned*)(lds + XBST_OFF) = 0u; *(volatile LAS unsigned*)(lds + XBST_OFF + 4) = 0u; }
    if (blockIdx.x == 0) for (int i = threadIdx.x; i < XCD_BAR_WORDS; i += 512) ((unsigned*)(p.ws + WS_BAR))[i] = 0u;
    __syncthreads();
#define GSYNC() xcd_barrier(xb)
    STAMP(0);
    p0_prep(p, lds);            grid.sync(); STAMP(1);
    const XcdBarrier xb = xcd_barrier_post((unsigned*)(p.ws + WS_BAR), (volatile LAS unsigned*)(lds + XBST_OFF));
    p1_inproj(p, lds);          GSYNC(); STAMP(2);
    p2_attn(p, lds);            GSYNC(); STAMP(3);
    STAMP(4);
    p3_up(p, lds);              GSYNC(); STAMP(5);
    p4_out(p, lds);             GSYNC(); STAMP(6);
    p5_router(p, lds);          GSYNC(); STAMP(7);
    p6_gateup(p, lds);          GSYNC(); STAMP(8);
    p7_down(p, lds);            GSYNC(); STAMP(9);
    p8_combine(p, lds);
#ifdef PROBE_A
    grid.sync(); STAMP(10); grid.sync();
    {
        const unsigned long long* ts = (const unsigned long long*)(p.ws + WS_END);
        #ifndef PROBE_A1
#define PROBE_A1 (PROBE_A + 1)
#endif
#ifndef PROBE_B1
#define PROBE_B1 (PROBE_B + 1)
#endif
        const float usA = (float)(ts[PROBE_A1] - ts[PROBE_A]) * 0.01f, usB = (float)(ts[PROBE_B1] - ts[PROBE_B]) * 0.01f;
        const float eps = sqrtf(usA * 1e-6f);
        for (size_t i = (size_t)blockIdx.x * 512 + threadIdx.x; i < (size_t)T * D / 4; i += (size_t)gridDim.x * 512) { f32x4 v = ((f32x4*)p.out)[i]; v = v * (1.0f + eps); if (i == 0) v.x += usB * 0.1f; ((f32x4*)p.out)[i] = v; }
    }
#endif
}

extern "C" void kernel_launch(void* const* d_in, const int* in_sizes, int n_in, void* d_out, int out_size, void* d_ws, size_t ws_size, hipStream_t stream) {
    static int grid_blocks = 0;
    if (!grid_blocks) {
        if (n_in != 21 || out_size != T * D || ws_size < WS_MOB + 128 * MiB) { fprintf(stderr, "kernel_launch: unexpected problem (n_in %d out %d ws %zu)\n", n_in, out_size, ws_size); grid_blocks = -1; return; }
        if (hipFuncSetAttribute((const void*)fwd_megakernel, hipFuncAttributeMaxDynamicSharedMemorySize, LDS_BYTES) != hipSuccess) { fprintf(stderr, "kernel_launch: hipFuncSetAttribute failed\n"); grid_blocks = -1; return; }
        int dev = 0, cus = 0, per_cu = 0;
        hipGetDevice(&dev); hipDeviceGetAttribute(&cus, hipDeviceAttributeMultiprocessorCount, dev);
        hipOccupancyMaxActiveBlocksPerMultiprocessor(&per_cu, (const void*)fwd_megakernel, 512, LDS_BYTES);
        if (per_cu < 1 || cus < 1) { fprintf(stderr, "kernel_launch: occupancy query gave %d blocks/CU on %d CUs\n", per_cu, cus); grid_blocks = -1; return; }
        grid_blocks = cus;
    }
    if (grid_blocks < 0) return;
    Params p{};
    for (int i = 0; i < 21; ++i) p.in[i] = (const float*)d_in[i];
    p.out = (float*)d_out; p.ws = (unsigned char*)d_ws;
    void* args[] = {&p};
    hipError_t e = hipLaunchCooperativeKernel((const void*)fwd_megakernel, dim3(grid_blocks), dim3(512), args, LDS_BYTES, stream);
    if (e != hipSuccess) fprintf(stderr, "cooperative launch failed: %s (grid %d)\n", hipGetErrorString(e), grid_blocks);
}
```

```cpp
#include <hip/hip_runtime.h>
#include <hip/hip_cooperative_groups.h>
#include <cstdio>
#include <cstdint>

#define LAS __attribute__((address_space(3)))
typedef unsigned short bf16_t;
typedef short bf16x8 __attribute__((ext_vector_type(8)));
typedef short s16x4 __attribute__((ext_vector_type(4)));
typedef float f32x4 __attribute__((ext_vector_type(4)));
typedef unsigned u32x4 __attribute__((ext_vector_type(4)));
typedef unsigned u32x2 __attribute__((ext_vector_type(2)));
typedef short v4i16_t __attribute__((ext_vector_type(4)));

namespace cfg {
constexpr int T = 32768, D = 2048, SEQ = 16384;
constexpr int NQKV = 4608, NGATE = 4096, NIN = 8704;
constexpr size_t MiB = 1ull << 20;
constexpr size_t WS_XB = 0, WS_QKV = 128 * MiB, WS_GATES = 416 * MiB, WS_O = 672 * MiB, WS_WIN = 800 * MiB, WS_WUP = 834 * MiB, WS_WOUT = 842 * MiB, WS_MISC = 850 * MiB;
constexpr size_t WS_WGU = 872 * MiB, WS_WD = 936 * MiB, WS_MG = WS_QKV, WS_HE = WS_QKV + 192 * MiB;
constexpr size_t WS_R1 = WS_MISC, WS_R2 = WS_R1 + (size_t)T * 4, WS_WRT = WS_R2 + (size_t)T * 4, WS_CNT = WS_WRT + 512 * 1024, WS_TOK = WS_CNT + 4096,
                 WS_RECC = WS_TOK + 32ull * T * 4, WS_RECW = WS_RECC + 2ull * T * 4, WS_R2L = WS_RECW + 2ull * T * 4, WS_END = WS_R2L + 32ull * T * 4;
constexpr size_t WS_H8 = WS_GATES + 144 * MiB;
constexpr size_t WS_YE = WS_QKV;
constexpr size_t WS_BAR = WS_END + 4096;
constexpr size_t WS_TOP = 1000 * MiB;
constexpr int LDS_BYTES = 140 * 1024;
constexpr int XBST_OFF = LDS_BYTES - 16;
constexpr int TAB_OFF = 132 * 1024;
constexpr float EPS = 1e-6f;
}
using namespace cfg;

struct Params { const float* in[21]; float* out; unsigned char* ws; };
__device__ __forceinline__ int phase_tid() { int t = threadIdx.x; asm volatile("" : "+v"(t)); return t; }

__device__ __forceinline__ float bf2f(short s) { return __uint_as_float(((unsigned)(unsigned short)s) << 16); }
typedef float f32x2 __attribute__((ext_vector_type(2)));
typedef __bf16 bf16x2_t __attribute__((ext_vector_type(2)));
__device__ __forceinline__ unsigned pk2(float lo, float hi) { const f32x2 v = {lo, hi}; return __builtin_bit_cast(unsigned, __builtin_convertvector(v, bf16x2_t)); }
__device__ __forceinline__ unsigned pk4_fp8(float a, float b, float c, float d) { int w = 0; w = __builtin_amdgcn_cvt_pk_fp8_f32(a, b, w, false); w = __builtin_amdgcn_cvt_pk_fp8_f32(c, d, w, true); return (unsigned)w; }
__device__ __forceinline__ float wave_sum(float v) {
#pragma unroll
    for (int o = 1; o < 64; o <<= 1) v += __shfl_xor(v, o);
    return v;
}
__device__ __forceinline__ float sigmoidf_(float v) { return 1.0f / (1.0f + __expf(-v)); }
__device__ __forceinline__ unsigned off_b(unsigned row, unsigned ch) { return 256u * row + 16u * (ch ^ (((row & 3) << 2) | ((row >> 2) & 3))); }
__device__ __forceinline__ s16x4 tr_read(LAS unsigned char* p) { return __builtin_bit_cast(s16x4, __builtin_amdgcn_ds_read_tr16_b64_v4i16((LAS v4i16_t*)p)); }
__host__ __device__ __forceinline__ int perm32(int rho) { const int n = rho >> 4, i = rho & 15; return 8 * (i >> 2) + 4 * n + (i & 3); }
__device__ __forceinline__ int t5_bucket(int rel) {
    const int n = rel < 0 ? -rel : rel; const int ret = rel > 0 ? 16 : 0; int b;
    if (n < 8) b = n; else if (n < 12) b = 8; else if (n < 16) b = 9; else if (n < 23) b = 10; else if (n < 32) b = 11; else if (n < 46) b = 12; else if (n < 64) b = 13; else if (n < 91) b = 14; else b = 15;
    return ret + b;
}

template <bool FP8>
__device__ __forceinline__ void transpose_item(const float* __restrict__ W, int ldw, int k0, int n0, bf16_t* __restrict__ WT, int ldt, int drow0, int dk0, const float* __restrict__ scale, LAS unsigned* scr, int lane, float f8scale = 1.f) {
    const int n4 = (lane & 15) * 4, kk = lane >> 4;
    const float* src = W + (size_t)(k0 + 2 * kk) * ldw + n0 + n4;
    f32x4 ev[8], od[8];
#pragma unroll
    for (int j = 0; j < 8; ++j) { ev[j] = *(const f32x4*)(src + (size_t)(8 * j) * ldw); od[j] = *(const f32x4*)(src + (size_t)(8 * j + 1) * ldw); }
#pragma unroll
    for (int j = 0; j < 8; ++j) { f32x4 e = ev[j], o = od[j];
        if (scale) { const float se = scale[k0 + 8 * j + 2 * kk], so = scale[k0 + 8 * j + 2 * kk + 1]; e = e * se; o = o * so; }
        u32x4 w; w.x = pk2(e.x, o.x); w.y = pk2(e.y, o.y); w.z = pk2(e.z, o.z); w.w = pk2(e.w, o.w);
        *(LAS u32x4*)(scr + (4 * j + kk) * 68 + n4) = w; }
    asm volatile("s_waitcnt lgkmcnt(0)" ::: "memory");
    const int kq = lane & 7;
#pragma unroll
    for (int i = 0; i < 8; ++i) { const int n = (lane >> 3) + 8 * i; const LAS unsigned* q = scr + (4 * kq) * 68 + n;
        u32x4 o; o.x = q[0]; o.y = q[68]; o.z = q[136]; o.w = q[204];
        if (FP8) { u32x2 f; f.x = pk4_fp8(__uint_as_float(o.x << 16) * f8scale, __uint_as_float(o.x & 0xffff0000u) * f8scale, __uint_as_float(o.y << 16) * f8scale, __uint_as_float(o.y & 0xffff0000u) * f8scale);
            f.y = pk4_fp8(__uint_as_float(o.z << 16) * f8scale, __uint_as_float(o.z & 0xffff0000u) * f8scale, __uint_as_float(o.w << 16) * f8scale, __uint_as_float(o.w & 0xffff0000u) * f8scale);
            *(u32x2*)((unsigned char*)WT + (size_t)(drow0 + n) * ldt + dk0 + k0 + 8 * kq) = f; }
        else *(u32x4*)(WT + (size_t)(drow0 + n) * ldt + dk0 + k0 + 8 * kq) = o; }
    asm volatile("s_waitcnt lgkmcnt(0)" ::: "memory");
}

__device__ __forceinline__ void p0_prep(const Params& p, LAS unsigned char* lds) {
    const int tid = phase_tid(), lane = tid & 63, wave = tid >> 6;
    const int gw = blockIdx.x * 8 + wave, NGW = gridDim.x * 8;
    LAS unsigned* scr = (LAS unsigned*)(lds + wave * 8704);
    const float* x = p.in[0]; const float* g1 = p.in[1]; const float* w_in = p.in[2];
    bf16_t* xb = (bf16_t*)(p.ws + WS_XB); float* r1 = (float*)(p.ws + WS_R1);
    bf16_t* WinT = (bf16_t*)(p.ws + WS_WIN); bf16_t* WupT = (bf16_t*)(p.ws + WS_WUP); bf16_t* WoutT = (bf16_t*)(p.ws + WS_WOUT);
    constexpr int I_WIN = 32 * 136, I_UP = 16 * 32, I_OUT = 32 * 32, NITEMS = I_WIN + 2 * I_UP + I_OUT;
    for (int it = gw; it < NITEMS; it += NGW) {
        int r = it;
        if (r < I_WIN) { const int kb = r / 136, nb = r % 136; const int n0 = nb * 64; int drow = n0;
            if (n0 >= NQKV) { const int c = (n0 - NQKV) & 2047, isb = (n0 - NQKV) >> 11; drow = NQKV + (c >> 7) * 256 + isb * 128 + (c & 127); }
            transpose_item<false>(w_in, NIN, kb * 64, n0, WinT, 2048, drow, 0, g1, scr, lane); continue; } r -= I_WIN;
        if (r < I_UP) { const int kb = r / 32, nb = r % 32; transpose_item<false>(p.in[9], 2048, kb * 64, nb * 64, WupT, 2048, nb * 64, 0, nullptr, scr, lane); continue; } r -= I_UP;
        if (r < I_UP) { const int kb = r / 32, nb = r % 32; transpose_item<false>(p.in[10], 2048, kb * 64, nb * 64, WupT, 2048, nb * 64, 1024, nullptr, scr, lane); continue; } r -= I_UP;
        { const int kb = r / 32, nb = r % 32; transpose_item<false>(p.in[11], 2048, kb * 64, nb * 64, WoutT, 2048, nb * 64, 0, nullptr, scr, lane); }
    }
    { bf16_t* whi = (bf16_t*)(p.ws + WS_WRT); bf16_t* wlo = whi + 48 * 2048; const float* g2 = p.in[13]; const float* wrg = p.in[14]; const float* wre = p.in[16];
      for (int i = blockIdx.x * 512 + tid; i < 48 * 2048; i += gridDim.x * 512) { const int row = i >> 11, k = i & 2047, t = row >> 4, r = row & 15; float w;
          if (t == 0) w = wre[k * 32 + (r >> 2) * 8 + (r & 3)]; else if (t == 1) w = wre[k * 32 + (r >> 2) * 8 + 4 + (r & 3)]; else w = (r & 3) == 0 ? wrg[k * 4 + (r >> 2)] : 0.f;
          w *= g2[k]; const unsigned hi = pk2(w, 0.f) & 0xffffu; const float hf = __uint_as_float(hi << 16); whi[i] = (bf16_t)hi; wlo[i] = (bf16_t)(pk2(w - hf, 0.f) & 0xffffu); } }
    if (blockIdx.x == 0 && tid < 32) ((int*)(p.ws + WS_CNT))[tid] = 0;
    for (int row0 = 2 * gw; row0 < T; row0 += 2 * NGW) {
        f32x4 v[2][8]; float ss[2] = {0.f, 0.f};
#pragma unroll
        for (int u = 0; u < 2; ++u) { const f32x4* xr = (const f32x4*)(x + (size_t)(row0 + u) * D) + lane;
#pragma unroll
            for (int j = 0; j < 8; ++j) v[u][j] = xr[64 * j]; }
#pragma unroll
        for (int u = 0; u < 2; ++u) {
#pragma unroll
            for (int j = 0; j < 8; ++j) ss[u] += (v[u][j].x * v[u][j].x + v[u][j].y * v[u][j].y) + (v[u][j].z * v[u][j].z + v[u][j].w * v[u][j].w);
            ss[u] = wave_sum(ss[u]);
            if (lane == 0) r1[row0 + u] = rsqrtf(ss[u] * (1.0f / D) + EPS);
            u32x2* o = (u32x2*)(xb + (size_t)(row0 + u) * D) + lane;
#pragma unroll
            for (int j = 0; j < 8; ++j) { u32x2 w; w.x = pk2(v[u][j].x, v[u][j].y); w.y = pk2(v[u][j].z, v[u][j].w); o[64 * j] = w; } }
    }
}

constexpr int MOE_ITEMS = 2 * 32 * 32 * 8 + 32 * 8 * 32;
__device__ __forceinline__ void moe_prep_batch(const Params& p, LAS unsigned char* lds, int bi) {
    const int tid = phase_tid(), lane = tid & 63, wave = tid >> 6;
    LAS unsigned* scr = (LAS unsigned*)(lds + wave * 8704);
    const float* g2 = p.in[13];
    bf16_t* WguT = (bf16_t*)(p.ws + WS_WGU); bf16_t* WdT = (bf16_t*)(p.ws + WS_WD);
    constexpr int I_G = 32 * 32 * 8;
    int r = (bi * (int)gridDim.x + (int)blockIdx.x) * 8 + wave;
    if (r >= MOE_ITEMS) return;
    if (r < 2 * I_G) { const int which = r >= I_G; if (which) r -= I_G; const int e = r / 256, rr = r % 256, kb = rr / 8, nb = rr % 8;
        const float* W = p.in[which ? 19 : 18] + (size_t)e * 2048 * 512; const int n0 = nb * 64;
        transpose_item<true>(W, 512, kb * 64, n0, WguT, 2048, e * 1024 + (n0 >> 7) * 256 + which * 128 + (n0 & 127), 0, g2, scr, lane, 64.f); return; }
    r -= 2 * I_G;
    { const int e = r / 256, rr = r % 256, kb = rr / 32, nb = rr % 32; const float* W = p.in[20] + (size_t)e * 512 * 2048;
      transpose_item<false>(W, 2048, kb * 64, nb * 64, WdT, 512, e * 2048 + nb * 64, 0, nullptr, scr, lane); }
}

struct Unit { int pm, pn, aux; };
namespace pg8 {
constexpr int BM = 256, BK = 64, HALF = 128, HTB = HALF * BK * 2, STAGE_BYTES = 8 * HTB;
__device__ __forceinline__ int lds_byte(int r, int c) { const int st = (r >> 4) * 2 + (c >> 5), rr = r & 15, cc = c & 31, ob = rr * 64 + cc * 2; return st * 1024 + (ob ^ (((ob >> 9) & 1) << 5)); }
__device__ __forceinline__ void stage_rc(int b, int& R, int& C) { const int st = b / 1024, sb = b % 1024, swz = sb ^ (((sb >> 9) & 1) << 5); R = (st >> 1) * 16 + swz / 64; C = (st & 1) * 32 + (swz % 64) / 2; }

template <bool PERM, bool GATHER, class Sched, class Epi, bool FP8 = false, bool ALIGN_EPI = true>
__device__ __forceinline__ void gemm_phase(LAS unsigned char* lds, const Sched& S, const Epi& E, const int nt, const int lda, const int ldb) {
    int tid_ = threadIdx.x; asm volatile("" : "+v"(tid_));
    const int tid = tid_, wid = __builtin_amdgcn_readfirstlane(tid >> 6), lane = tid & 63, wr = wid >> 2, wc = wid & 3, fr = lane & 15, fq = lane >> 4;
    int R0, C0, R1, C1; stage_rc(tid * 16, R0, C0); stage_rc(tid * 16 + 8192, R1, C1);
    unsigned voffB[2], voffA[2][2];
    { const int Rb0 = PERM ? ((R0 & ~31) + perm32(R0 & 31)) : R0, Rb1 = PERM ? ((R1 & ~31) + perm32(R1 & 31)) : R1;
      voffB[0] = (unsigned)(Rb0 * ldb + C0) * 2u; voffB[1] = (unsigned)(Rb1 * ldb + C1) * 2u; }
    const size_t kstep = (size_t)(BK * 2);
    const size_t hstepB = (size_t)HALF * ldb * 2;
    const unsigned ldsw = (unsigned)wid * 1024u;
    const int aoff = lds_byte(wr * 64 + fr, fq * 8), boff = lds_byte(wc * 32 + fr, fq * 8);
#define PG8_SA(b, h) (((b) * 2 + (h)) * HTB)
#define PG8_SB(b, h) ((4 + (b) * 2 + (h)) * HTB)
#define PG8_STAGE_B(bufoff, gbase) do { _Pragma("unroll") for (int _i = 0; _i < 2; ++_i) \
        __builtin_amdgcn_global_load_lds((const unsigned*)((const char*)(gbase) + voffB[_i]), (LAS unsigned*)(lds + (bufoff) + ldsw + _i * 8192), 16, 0, 0); } while (0)
#define PG8_STAGE_A(bufoff, gbase, h) do { _Pragma("unroll") for (int _i = 0; _i < 2; ++_i) \
        __builtin_amdgcn_global_load_lds((const unsigned*)((const char*)(gbase) + voffA[h][_i]), (LAS unsigned*)(lds + (bufoff) + ldsw + _i * 8192), 16, 0, 0); } while (0)
#define PG8_LDA(dst, b, h) do { _Pragma("unroll") for (int m = 0; m < 4; ++m) _Pragma("unroll") for (int k = 0; k < 2; ++k) dst[m][k] = *(const LAS bf16x8*)(lds + PG8_SA(b, h) + aoff + m * 2048 + k * 1024); } while (0)
#define PG8_LDB(dst, b, h) do { _Pragma("unroll") for (int n = 0; n < 2; ++n) _Pragma("unroll") for (int k = 0; k < 2; ++k) dst[n][k] = *(const LAS bf16x8*)(lds + PG8_SB(b, h) + boff + n * 2048 + k * 1024); } while (0)
#define PG8_MMA(ai, bj, At, Bt) do { __builtin_amdgcn_s_setprio(1); _Pragma("unroll") for (int m = 0; m < 4; ++m) _Pragma("unroll") for (int n = 0; n < 2; ++n) { \
        if (FP8) { typedef int v8i_ __attribute__((ext_vector_type(8))); typedef int v4i_ __attribute__((ext_vector_type(4))); \
            const v4i_ b0_ = __builtin_bit_cast(v4i_, Bt[n][0]), b1_ = __builtin_bit_cast(v4i_, Bt[n][1]), a0_ = __builtin_bit_cast(v4i_, At[m][0]), a1_ = __builtin_bit_cast(v4i_, At[m][1]); \
            const v8i_ bb_ = {b0_[0], b0_[1], b0_[2], b0_[3], b1_[0], b1_[1], b1_[2], b1_[3]}, aa_ = {a0_[0], a0_[1], a0_[2], a0_[3], a1_[0], a1_[1], a1_[2], a1_[3]}; \
            acc[ai][bj][m][n] = __builtin_amdgcn_mfma_scale_f32_16x16x128_f8f6f4(bb_, aa_, acc[ai][bj][m][n], 0, 0, 0, 0x7f7f7f7f, 0, 0x7f7f7f7f); } \
        else { _Pragma("unroll") for (int k = 0; k < 2; ++k) acc[ai][bj][m][n] = __builtin_amdgcn_mfma_f32_16x16x32_bf16(Bt[n][k], At[m][k], acc[ai][bj][m][n], 0, 0, 0); } } \
        __builtin_amdgcn_s_setprio(0); } while (0)
#define PG8_WAIT_V(n) asm volatile("s_waitcnt vmcnt(" #n ")" ::: "memory")
#define PG8_WAIT_L(n) asm volatile("s_waitcnt lgkmcnt(" #n ")" ::: "memory")
#define PG8_BAR __builtin_amdgcn_s_barrier()
#define PG8_SCHED __builtin_amdgcn_sched_barrier(0)
    Unit cur, nxt; int ui = 0;
    __syncthreads();
    if (!S.next(0, cur)) return;
    if (GATHER) S.a_offs(cur, R0, C0, R1, C1, voffA);
    else { voffA[0][0] = (unsigned)(R0 * lda + C0) * 2u; voffA[0][1] = (unsigned)(R1 * lda + C1) * 2u; voffA[1][0] = voffA[0][0] + (unsigned)(HALF * lda * 2); voffA[1][1] = voffA[0][1] + (unsigned)(HALF * lda * 2); }
    f32x4 acc[2][2][4][2];
#pragma unroll
    for (int a = 0; a < 2; ++a)
#pragma unroll
        for (int b = 0; b < 2; ++b)
#pragma unroll
            for (int m = 0; m < 4; ++m)
#pragma unroll
                for (int n = 0; n < 2; ++n) acc[a][b][m][n] = (f32x4){0.f, 0.f, 0.f, 0.f};
    bf16x8 At[4][2], B0[2][2], B1[2][2];
    const char* cA = S.a_base(cur); const char* cB = S.b_base(cur);
    PG8_STAGE_B(PG8_SB(0, 0), cB); PG8_STAGE_B(PG8_SB(0, 1), cB + hstepB); PG8_STAGE_A(PG8_SA(0, 0), cA, 0); PG8_STAGE_A(PG8_SA(0, 1), cA, 1);
    if (wr == 1) PG8_BAR;
    PG8_WAIT_V(2); PG8_BAR;
    PG8_STAGE_B(PG8_SB(1, 0), cB + kstep); PG8_STAGE_A(PG8_SA(1, 0), cA + kstep, 0); PG8_STAGE_B(PG8_SB(1, 1), cB + hstepB + kstep);
    PG8_WAIT_V(6); PG8_BAR;
    for (;;) {
        const bool has_next = S.next(ui + 1, nxt);
        const char* nA = has_next ? S.a_base(nxt) : cA; const char* nB = has_next ? S.b_base(nxt) : cB;
        unsigned vn[2][2];
        if (GATHER) { if (has_next) S.a_offs(nxt, R0, C0, R1, C1, vn); else { vn[0][0] = voffA[0][0]; vn[0][1] = voffA[0][1]; vn[1][0] = voffA[1][0]; vn[1][1] = voffA[1][1]; } }
        for (int t = 0; t < nt; t += 2) {
            const bool last = (t == nt - 2);
            const char* a1 = cA + (size_t)(t + 1) * kstep;
            const char* a2 = last ? nA : cA + (size_t)(t + 2) * kstep; const char* b2 = last ? nB : cB + (size_t)(t + 2) * kstep;
            const char* a3 = a2 + kstep; const char* b3 = b2 + kstep;
            PG8_LDB(B0, 0, 0); PG8_LDB(B1, 0, 1); PG8_SCHED; PG8_LDA(At, 0, 0); PG8_STAGE_A(PG8_SA(1, 1), a1, 1);
            if (GATHER) { if (last) { voffA[0][0] = vn[0][0]; voffA[0][1] = vn[0][1]; voffA[1][0] = vn[1][0]; voffA[1][1] = vn[1][1]; } }
            PG8_WAIT_V(8); PG8_WAIT_L(0); PG8_BAR; PG8_MMA(0, 0, At, B0); PG8_MMA(0, 1, At, B1); PG8_BAR; PG8_SCHED;
            PG8_LDA(At, 0, 1); PG8_STAGE_B(PG8_SB(0, 0), b2); PG8_STAGE_B(PG8_SB(0, 1), b2 + hstepB); PG8_STAGE_A(PG8_SA(0, 0), a2, 0);
            PG8_WAIT_V(8); PG8_WAIT_L(0); PG8_BAR; PG8_MMA(1, 0, At, B0); PG8_MMA(1, 1, At, B1); PG8_BAR; PG8_SCHED;
            PG8_LDB(B0, 1, 0); PG8_LDB(B1, 1, 1); PG8_SCHED; PG8_LDA(At, 1, 0); PG8_STAGE_A(PG8_SA(0, 1), a2, 1);
            PG8_WAIT_V(8); PG8_WAIT_L(0); PG8_BAR; PG8_MMA(0, 0, At, B0); PG8_MMA(0, 1, At, B1); PG8_BAR; PG8_SCHED;
            PG8_LDA(At, 1, 1); PG8_STAGE_B(PG8_SB(1, 0), b3); PG8_STAGE_B(PG8_SB(1, 1), b3 + hstepB); PG8_STAGE_A(PG8_SA(1, 0), a3, 0);
            PG8_WAIT_V(8); PG8_WAIT_L(0); PG8_BAR; PG8_MMA(1, 0, At, B0); PG8_MMA(1, 1, At, B1); PG8_BAR; PG8_SCHED;
        }
        if (ALIGN_EPI) { if (wr == 0) PG8_BAR; }
        E(acc, cur, wr, wc, fr, fq);
        if (!has_next) break;
        if (!S.keep_acc(cur)) {
#pragma unroll
        for (int a = 0; a < 2; ++a)
#pragma unroll
            for (int b = 0; b < 2; ++b)
#pragma unroll
                for (int m = 0; m < 4; ++m)
#pragma unroll
                    for (int n = 0; n < 2; ++n) acc[a][b][m][n] = (f32x4){0.f, 0.f, 0.f, 0.f};
        }
        cur = nxt; cA = nA; cB = nB; ++ui;
        if (ALIGN_EPI) { if (wr == 1) PG8_BAR; }
    }
    PG8_WAIT_V(0);
    if (!ALIGN_EPI) { if (wr == 0) PG8_BAR; }
    PG8_BAR;
#undef PG8_SA
#undef PG8_SB
#undef PG8_STAGE_A
#undef PG8_STAGE_B
#undef PG8_LDA
#undef PG8_LDB
#undef PG8_MMA
#undef PG8_WAIT_V
#undef PG8_WAIT_L
#undef PG8_BAR
#undef PG8_SCHED
}
struct TileOrder {
    int nM, nN, nwg, G, c;
    __device__ __forceinline__ void init(int nM_, int nN_, int G_, int c_) { nM = nM_; nN = nN_; nwg = nM * nN; G = G_; c = c_; }
    __device__ __forceinline__ bool tile(int i, int& pm, int& pn) const {
        const long L = (long)i * G + c; if (L >= nwg) return false;
        int wgid = (int)L; { const int q = nwg / 8, r = nwg % 8, xcd = wgid % 8, off = wgid / 8; wgid = (xcd < r ? xcd * (q + 1) : r * (q + 1) + (xcd - r) * q) + off; }
        const int nig = 8 * nN, gid = wgid / nig, fm = gid * 8, gsz = (nM - fm) < 8 ? (nM - fm) : 8;
        pm = fm + ((wgid % nig) % gsz); pn = (wgid % nig) / gsz; return true;
    }
};
struct DenseSched {
    TileOrder o; const bf16_t* A; const bf16_t* Bt; int lda, ldb;
    __device__ __forceinline__ bool next(int i, Unit& u) const { u.aux = 0; return o.tile(i, u.pm, u.pn); }
    __device__ __forceinline__ const char* a_base(const Unit& u) const { return (const char*)(A + (size_t)u.pm * 256 * lda); }
    __device__ __forceinline__ const char* b_base(const Unit& u) const { return (const char*)(Bt + (size_t)u.pn * 256 * ldb); }
    __device__ __forceinline__ bool keep_acc(const Unit&) const { return false; }
    __device__ __forceinline__ void a_offs(const Unit&, int, int, int, int, unsigned (&)[2][2]) const {}
};
}

struct EpiInProj { bf16_t* qkv; bf16_t* gates; const float* r1; const float* gqa; const float* gka; const float* gqb; const float* gkb; LAS float* X;
    __device__ __forceinline__ void operator()(f32x4 (&acc)[2][2][4][2], const Unit& u, int wr, int wc, int fr, int fq) const {
        const int pn = u.pn;
        const bool isg = pn >= 18; bf16_t* base = isg ? gates : qkv; const int ldc = isg ? NGATE : NQKV; const int colt = (isg ? pn - 18 : pn) * 256 + wc * 32 + 8 * fq;
        const float* gain = pn < 4 ? gqa : (pn == 4 ? gka : ((pn >= 6 && pn < 10) ? gqb : ((pn >= 10 && pn < 14) ? gkb : nullptr)));
        if (gain) {
            const float extra = (pn < 4 || (pn >= 6 && pn < 10)) ? 0.08838834764831845f * 1.4426950408889634f : 1.0f;
#pragma unroll
            for (int ai = 0; ai < 2; ++ai)
#pragma unroll
                for (int m = 0; m < 4; ++m)
#pragma unroll
                    for (int bj = 0; bj < 2; ++bj) { const f32x4 a0 = acc[ai][bj][m][0], a1 = acc[ai][bj][m][1];
                        float sq = (a0[0] * a0[0] + a0[1] * a0[1]) + (a0[2] * a0[2] + a0[3] * a0[3]) + (a1[0] * a1[0] + a1[1] * a1[1]) + (a1[2] * a1[2] + a1[3] * a1[3]);
                        sq += __shfl_xor(sq, 16); sq += __shfl_xor(sq, 32);
                        if (fq == 0) X[(ai * 128 + wr * 64 + m * 16 + fr) * 8 + bj * 4 + wc] = sq; }
            asm volatile("s_waitcnt lgkmcnt(0)" ::: "memory"); __builtin_amdgcn_s_barrier(); asm volatile("" ::: "memory");
            const f32x4 g0 = *(const f32x4*)(gain + wc * 32 + 8 * fq), g1 = *(const f32x4*)(gain + wc * 32 + 8 * fq + 4);
#pragma unroll
            for (int ai = 0; ai < 2; ++ai)
#pragma unroll
                for (int m = 0; m < 4; ++m) { const int rl = ai * 128 + wr * 64 + m * 16 + fr; const int row = u.pm * 256 + rl; const float rs = r1[row]; bf16_t* rowp = base + (size_t)row * ldc + colt;
#pragma unroll
                    for (int bj = 0; bj < 2; ++bj) { const f32x4 t = *(const LAS f32x4*)(X + rl * 8 + bj * 4); const float tot = (t[0] + t[1]) + (t[2] + t[3]);
                        const float sc = rs * rsqrtf(rs * rs * tot * (1.0f / 128.0f) + EPS) * extra;
                        const f32x4 v0 = acc[ai][bj][m][0] * sc * g0, v1 = acc[ai][bj][m][1] * sc * g1;
                        u32x4 w; w.x = pk2(v0[0], v0[1]); w.y = pk2(v0[2], v0[3]); w.z = pk2(v1[0], v1[1]); w.w = pk2(v1[2], v1[3]);
                        *(u32x4*)(rowp + bj * 128) = w; } }
            return;
        }
        if (isg) {
            const int cg = (pn - 18) * 128 + wc * 32 + 8 * fq;
#pragma unroll
            for (int ai = 0; ai < 2; ++ai)
#pragma unroll
                for (int m = 0; m < 4; ++m) { const int row = u.pm * 256 + ai * 128 + wr * 64 + m * 16 + fr; const float rs = r1[row]; bf16_t* rowp = gates + (size_t)row * NGATE + cg;
                    float ra[8], sb[8];
#pragma unroll
                    for (int n = 0; n < 2; ++n)
#pragma unroll
                        for (int j = 0; j < 4; ++j) { const float ea = __expf(-acc[ai][0][m][n][j] * rs), eb = fminf(__expf(-acc[ai][1][m][n][j] * rs), 1e30f);
                            sb[4 * n + j] = __builtin_amdgcn_rcpf(1.0f + eb); ra[4 * n + j] = (1.0f + eb) * __builtin_amdgcn_rcpf(1.0f + ea); }
                    u32x4 w; w.x = pk2(ra[0], ra[1]); w.y = pk2(ra[2], ra[3]); w.z = pk2(ra[4], ra[5]); w.w = pk2(ra[6], ra[7]); *(u32x4*)rowp = w;
                    w.x = pk2(sb[0], sb[1]); w.y = pk2(sb[2], sb[3]); w.z = pk2(sb[4], sb[5]); w.w = pk2(sb[6], sb[7]); *(u32x4*)(rowp + 2048) = w; }
            return;
        }
#pragma unroll
        for (int ai = 0; ai < 2; ++ai)
#pragma unroll
            for (int m = 0; m < 4; ++m) { const int row = u.pm * 256 + ai * 128 + wr * 64 + m * 16 + fr; const float rs = r1[row]; bf16_t* rowp = base + (size_t)row * ldc + colt;
#pragma unroll
                for (int bj = 0; bj < 2; ++bj) { const f32x4 v0 = acc[ai][bj][m][0] * rs, v1 = acc[ai][bj][m][1] * rs;
                    u32x4 w; w.x = pk2(v0[0], v0[1]); w.y = pk2(v0[2], v0[3]); w.z = pk2(v1[0], v1[1]); w.w = pk2(v1[2], v1[3]);
                    *(u32x4*)(rowp + bj * 128) = w; } }
    } };
__device__ __forceinline__ void p1_inproj(const Params& p, LAS unsigned char* lds) {
    pg8::DenseSched S; S.o.init(128, 34, gridDim.x, blockIdx.x); S.A = (const bf16_t*)(p.ws + WS_XB); S.Bt = (const bf16_t*)(p.ws + WS_WIN); S.lda = D; S.ldb = D;
    EpiInProj E{(bf16_t*)(p.ws + WS_QKV), (bf16_t*)(p.ws + WS_GATES), (const float*)(p.ws + WS_R1), p.in[3], p.in[4], p.in[6], p.in[7], (LAS float*)(lds + 131072)};
    pg8::gemm_phase<true, false>(lds, S, E, D / 64, D, D);
}

__device__ __forceinline__ void wait_vm(int n) {
    switch (n) { case 0: asm volatile("s_waitcnt vmcnt(0)" ::: "memory"); break; case 2: asm volatile("s_waitcnt vmcnt(2)" ::: "memory"); break; case 4: asm volatile("s_waitcnt vmcnt(4)" ::: "memory"); break;
                 case 6: asm volatile("s_waitcnt vmcnt(6)" ::: "memory"); break; case 8: asm volatile("s_waitcnt vmcnt(8)" ::: "memory"); break; case 10: asm volatile("s_waitcnt vmcnt(10)" ::: "memory"); break;
                 default: asm volatile("s_waitcnt vmcnt(12)" ::: "memory"); break; }
}
__device__ __forceinline__ void glds16_asm(const void* gsrc, unsigned lds_dst) {
    unsigned keep;
    asm volatile("s_mov_b32 %0, m0\n\ts_mov_b32 m0, %2\n\ts_nop 0\n\tglobal_load_lds_dwordx4 %1, off\n\ts_mov_b32 m0, %0" : "=&s"(keep) : "v"(gsrc), "s"(lds_dst) : "memory");
}
#define ATT_BAR() do { asm volatile("s_waitcnt lgkmcnt(0)" ::: "memory"); __builtin_amdgcn_s_barrier(); asm volatile("" ::: "memory"); } while (0)
__device__ __forceinline__ void load_q(const bf16_t* qp, int g, bf16x8 (&qf)[4]) {
#pragma unroll
    for (int ks = 0; ks < 4; ++ks) qf[ks] = *(const bf16x8*)(qp + 32 * ks + 8 * g);
#pragma unroll
    for (int ks = 0; ks < 4; ++ks) asm volatile("" : "+v"(qf[ks]));
}
__device__ __forceinline__ bf16x8 vt_frag(LAS unsigned char* base, int row0, int g, int q4, int pp, int dt) {
    const s16x4 lo = tr_read(base + off_b(row0 + 4 * g + q4, 2 * dt + (pp >> 1)) + 8 * (pp & 1)), hi = tr_read(base + off_b(row0 + 16 + 4 * g + q4, 2 * dt + (pp >> 1)) + 8 * (pp & 1));
    bf16x8 vf; vf[0] = lo[0]; vf[1] = lo[1]; vf[2] = lo[2]; vf[3] = lo[3]; vf[4] = hi[0]; vf[5] = hi[1]; vf[6] = hi[2]; vf[7] = hi[3]; return vf;
}

__device__ __forceinline__ void attn_window_item(const Params& p, LAS unsigned char* lds, int item, int& tab_head) {
    const int tid = phase_tid(), lane = tid & 63, w = __builtin_amdgcn_readfirstlane(tid >> 6), g = lane >> 4, ql = lane & 15;
    const int b = item >> 9, nb = (item >> 2) & 127, hpq = item & 3, kv = hpq >> 1, hq0 = 2 * hpq;
    const bf16_t* qkv = (const bf16_t*)(p.ws + WS_QKV); bf16_t* o = (bf16_t*)(p.ws + WS_O);
    LAS float* bias = (LAS float*)(lds + 131072); const unsigned ldsb = (unsigned)(size_t)lds;
    const unsigned loff = (unsigned)(w * 4 + g) * NQKV + (unsigned)((ql ^ ((g << 2) | (w & 3))) * 8);
    const bf16_t* kbase = qkv + (size_t)(b * SEQ) * NQKV + 1024 + kv * 128;
#define WIN_ISSUE(c) do { const int _c = (c); const int _kb = min(max(nb - 1 + (_c % 3), 0), 127); const bf16_t* _src = kbase + (size_t)(_kb * 128) * NQKV + (_c >= 3 ? 256 : 0) + loff; \
        _Pragma("unroll") for (int _i = 0; _i < 4; ++_i) glds16_asm(_src + (size_t)(32 * _i) * NQKV, ldsb + (unsigned)((_c & 3) * 32768 + _i * 8192 + w * 1024)); } while (0)
    ATT_BAR();
    WIN_ISSUE(0); WIN_ISSUE(1); WIN_ISSUE(2);
    if (hpq != tab_head) { for (int i = tid; i < 2 * 257; i += 512) { const int hh = i >= 257, j = i - 257 * hh; bias[hh * 264 + j] = p.in[12][t5_bucket(j - 128) * 8 + hq0 + hh] * 1.4426950408889634f; } tab_head = hpq; }
    const int tq = b * SEQ + nb * 128 + 16 * w + ql;
    bf16x8 qf[2][4]; load_q(qkv + (size_t)tq * NQKV + hq0 * 128, g, qf[0]); load_q(qkv + (size_t)tq * NQKV + (hq0 + 1) * 128, g, qf[1]);
    float sink[2]; sink[0] = p.in[5][hq0] * 1.4426950408889634f; sink[1] = p.in[5][hq0 + 1] * 1.4426950408889634f; asm volatile("" : "+v"(sink[0]), "+v"(sink[1]));
    f32x4 S1[2][8], SC[2][9];
#pragma unroll
    for (int u = 0; u < 2; ++u) {
#pragma unroll
        for (int kt = 0; kt < 8; ++kt) S1[u][kt] = (f32x4){0.f, 0.f, 0.f, 0.f};
#pragma unroll
        for (int s = 0; s < 9; ++s) SC[u][s] = (f32x4){0.f, 0.f, 0.f, 0.f}; }
    const bool in0 = nb > 0, in2 = nb < 127;
#pragma unroll
    for (int c = 0; c < 3; ++c) {
        wait_vm(8); ATT_BAR(); WIN_ISSUE(c + 3);
        LAS unsigned char* buf = lds + (c & 3) * 32768;
#pragma unroll
        for (int kt = 0; kt < 8; ++kt) {
            const bool act = (c == 1) || (c == 0 ? kt >= w : kt <= w);
            if (act) {
#pragma unroll
                for (int ks = 0; ks < 4; ++ks) { const bf16x8 kf = *(const LAS bf16x8*)(buf + off_b(16 * kt + ql, 4 * ks + g));
#pragma unroll
                    for (int u = 0; u < 2; ++u) {
                        if (c == 1) S1[u][kt] = __builtin_amdgcn_mfma_f32_16x16x32_bf16(kf, qf[u][ks], S1[u][kt], 0, 0, 0);
                        else if (c == 0) SC[u][7 - kt] = __builtin_amdgcn_mfma_f32_16x16x32_bf16(kf, qf[u][ks], SC[u][7 - kt], 0, 0, 0);
                        else SC[u][8 - kt] = __builtin_amdgcn_mfma_f32_16x16x32_bf16(kf, qf[u][ks], SC[u][8 - kt], 0, 0, 0); } } }
        }
    }
    const int qi = 16 * w + ql; float inv[2];
    unsigned P1[2][4][4], PC[2][9][2];
#pragma unroll
    for (int u = 0; u < 2; ++u) { float mx = sink[u]; const LAS float* bt = bias + u * 264;
#pragma unroll
        for (int kt = 0; kt < 8; ++kt)
#pragma unroll
            for (int r = 0; r < 4; ++r) { const int rel = 16 * kt + 4 * g + r - qi; const float sv = S1[u][kt][r] + bt[rel + 128]; S1[u][kt][r] = sv; mx = fmaxf(mx, sv); }
#pragma unroll
        for (int s = 0; s < 9; ++s) { const bool c0 = s <= 7 - w; const int kt = c0 ? 7 - s : 8 - s; const int cofs = c0 ? -128 : 128; const bool inr = c0 ? in0 : in2;
#pragma unroll
            for (int r = 0; r < 4; ++r) { const int rel = cofs + 16 * kt + 4 * g + r - qi; const bool valid = inr && rel >= -128 && rel <= 128;
                const float bv = bt[rel + 128];
                const float sv = valid ? SC[u][s][r] + bv : -1e30f; SC[u][s][r] = sv; mx = fmaxf(mx, sv); } }
        mx = fmaxf(mx, __shfl_xor(mx, 16)); mx = fmaxf(mx, __shfl_xor(mx, 32));
        float l = 0.f;
#pragma unroll
        for (int kk = 0; kk < 4; ++kk) { float e[8];
#pragma unroll
            for (int r = 0; r < 4; ++r) { e[r] = __builtin_amdgcn_exp2f(S1[u][2 * kk][r] - mx); e[4 + r] = __builtin_amdgcn_exp2f(S1[u][2 * kk + 1][r] - mx); l += e[r] + e[4 + r]; }
            P1[u][kk][0] = pk2(e[0], e[1]); P1[u][kk][1] = pk2(e[2], e[3]); P1[u][kk][2] = pk2(e[4], e[5]); P1[u][kk][3] = pk2(e[6], e[7]); }
#pragma unroll
        for (int s = 0; s < 9; ++s) { float e[4];
#pragma unroll
            for (int r = 0; r < 4; ++r) { e[r] = __builtin_amdgcn_exp2f(SC[u][s][r] - mx); l += e[r]; }
            PC[u][s][0] = pk2(e[0], e[1]); PC[u][s][1] = pk2(e[2], e[3]); }
        l += __shfl_xor(l, 16); l += __shfl_xor(l, 32); l += __builtin_amdgcn_exp2f(sink[u] - mx);
        inv[u] = 1.0f / l; }
    f32x4 O[2][8];
#pragma unroll
    for (int u = 0; u < 2; ++u)
#pragma unroll
        for (int dt = 0; dt < 8; ++dt) O[u][dt] = (f32x4){0.f, 0.f, 0.f, 0.f};
    const int q4 = ql >> 2, pp = ql & 3;
#pragma unroll
    for (int c = 0; c < 3; ++c) {
        wait_vm(c == 0 ? 8 : (c == 1 ? 4 : 0)); ATT_BAR();
        LAS unsigned char* buf = lds + ((c + 3) & 3) * 32768;
#pragma unroll
        for (int kk = 0; kk < 4; ++kk) {
            bool a0, a1;
            if (c == 1) { a0 = true; a1 = true; } else if (c == 0) { a0 = 2 * kk >= w; a1 = 2 * kk + 1 >= w; } else { a0 = 2 * kk <= w; a1 = 2 * kk + 1 <= w; }
            if (a0 || a1) { bf16x8 pf[2];
#pragma unroll
                for (int u = 0; u < 2; ++u) { u32x4 pw;
                    if (c == 1) { pw.x = P1[u][kk][0]; pw.y = P1[u][kk][1]; pw.z = P1[u][kk][2]; pw.w = P1[u][kk][3]; }
                    else if (c == 0) { pw.x = a0 ? PC[u][7 - 2 * kk][0] : 0u; pw.y = a0 ? PC[u][7 - 2 * kk][1] : 0u; pw.z = a1 ? PC[u][6 - 2 * kk][0] : 0u; pw.w = a1 ? PC[u][6 - 2 * kk][1] : 0u; }
                    else { pw.x = a0 ? PC[u][8 - 2 * kk][0] : 0u; pw.y = a0 ? PC[u][8 - 2 * kk][1] : 0u; pw.z = a1 ? PC[u][7 - 2 * kk][0] : 0u; pw.w = a1 ? PC[u][7 - 2 * kk][1] : 0u; }
                    pf[u] = __builtin_bit_cast(bf16x8, pw); }
#pragma unroll
                for (int dt = 0; dt < 8; ++dt) { const bf16x8 vf = vt_frag(buf, 32 * kk, g, q4, pp, dt);
                    O[0][dt] = __builtin_amdgcn_mfma_f32_16x16x32_bf16(vf, pf[0], O[0][dt], 0, 0, 0); O[1][dt] = __builtin_amdgcn_mfma_f32_16x16x32_bf16(vf, pf[1], O[1][dt], 0, 0, 0); } } }
    }
#undef WIN_ISSUE
#pragma unroll
    for (int u = 0; u < 2; ++u) { bf16_t* op = o + (size_t)tq * D + (hq0 + u) * 128 + 4 * g;
#pragma unroll
        for (int dt = 0; dt < 8; ++dt) { u32x2 w2; w2.x = pk2(O[u][dt][0] * inv[u], O[u][dt][1] * inv[u]); w2.y = pk2(O[u][dt][2] * inv[u], O[u][dt][3] * inv[u]); *(u32x2*)(op + 16 * dt) = w2; } }
}

__device__ __forceinline__ void attn_nat_item(const Params& p, LAS unsigned char* lds, int item, int& tab_head) {
    const int tid = phase_tid(), lane = tid & 63, w = __builtin_amdgcn_readfirstlane(tid >> 6), g = lane >> 4, ql = lane & 15;
    const int b = item >> 9, rp = (item >> 2) & 127, hp = item & 3, hh = w >> 2, h = 2 * hp + hh, jq = w & 3;
    const int kr_lo = min(max(2 * rp - 4, 0), 248);
    const int d0 = min(max(2 * rp - 4, 0), 248) - kr_lo, d1 = min(max(2 * rp - 3, 0), 248) - kr_lo;
    const int w0 = jq == 0 ? 0 : (jq == 1 ? 8 : (jq == 2 ? 24 : 32));
    const bf16_t* qkv = (const bf16_t*)(p.ws + WS_QKV); bf16_t* o = (bf16_t*)(p.ws + WS_O);
    LAS float* rpb = (LAS float*)(lds + 131072); const unsigned ldsb = (unsigned)(size_t)lds;
    const unsigned loff = (unsigned)(w * 4 + g) * NQKV + (unsigned)((ql ^ ((g << 2) | (w & 3))) * 8);
    const bf16_t* kbase = qkv + (size_t)(b * SEQ) * NQKV + 2560 + 2 * hp * 128;
#define NAT_ISSUE(s) do { const int _s = (s); const int _kr = min(kr_lo + (_s % 9), 255); const bf16_t* _src = kbase + (size_t)(_kr * 64) * NQKV + (_s >= 9 ? 1024 : 0) + loff; \
        _Pragma("unroll") for (int _i = 0; _i < 4; ++_i) glds16_asm(_src + (size_t)(32 * (_i & 1)) * NQKV + 128 * (_i >> 1), ldsb + (unsigned)((_s & 3) * 32768 + _i * 8192 + w * 1024)); } while (0)
    ATT_BAR();
    NAT_ISSUE(0); NAT_ISSUE(1); NAT_ISSUE(2);
    if (hp != tab_head) { for (int i = tid; i < 930; i += 512) rpb[i] = p.in[8][2 * hp * 465 + i] * 1.4426950408889634f; tab_head = hp; }
    const int qcol = 16 * jq + ql; const int tq0 = b * SEQ + (2 * rp) * 64 + qcol;
    bf16x8 qf[2][4]; load_q(qkv + (size_t)tq0 * NQKV + 1536 + h * 128, g, qf[0]); load_q(qkv + (size_t)(tq0 + 64) * NQKV + 1536 + h * 128, g, qf[1]);
    f32x4 S[2][9][2];
#pragma unroll
    for (int u = 0; u < 2; ++u)
#pragma unroll
        for (int c = 0; c < 9; ++c) { S[u][c][0] = (f32x4){0.f, 0.f, 0.f, 0.f}; S[u][c][1] = (f32x4){0.f, 0.f, 0.f, 0.f}; }
#pragma unroll
    for (int c = 0; c < 9; ++c) {
        wait_vm(8); ATT_BAR(); NAT_ISSUE(c + 3);
        const bool a0 = c >= d0 && c < d0 + 8, a1 = c >= d1 && c < d1 + 8;
        LAS unsigned char* buf = lds + (c & 3) * 32768 + hh * 16384;
#pragma unroll
        for (int t = 0; t < 2; ++t)
#pragma unroll
            for (int ks = 0; ks < 4; ++ks) { const bf16x8 kf = *(const LAS bf16x8*)(buf + off_b(w0 + 16 * t + ql, 4 * ks + g));
                if (a0) S[0][c][t] = __builtin_amdgcn_mfma_f32_16x16x32_bf16(kf, qf[0][ks], S[0][c][t], 0, 0, 0);
                if (a1) S[1][c][t] = __builtin_amdgcn_mfma_f32_16x16x32_bf16(kf, qf[1][ks], S[1][c][t], 0, 0, 0); }
    }
    const int cs = min(max(qcol - 8, 0), 48); float inv[2];
    unsigned P[2][9][4];
    int dcv[2][4]; bool cv[2][4];
#pragma unroll
    for (int t = 0; t < 2; ++t)
#pragma unroll
        for (int q = 0; q < 4; ++q) { const int kc = w0 + 16 * t + 4 * g + q; cv[t][q] = kc >= cs && kc < cs + 16; dcv[t][q] = hh * 465 + kc - qcol + 15; }
#pragma unroll
    for (int u = 0; u < 2; ++u) { const int du = u ? d1 : d0; const int r = 2 * rp + u; float mx = -1e30f;
#pragma unroll
        for (int c = 0; c < 9; ++c) { const bool act = c >= du && c < du + 8;
            if (act) { const int rowb = (kr_lo + c - r + 7) * 31;
#pragma unroll
                for (int t = 0; t < 2; ++t)
#pragma unroll
                    for (int q = 0; q < 4; ++q) { const float sv = cv[t][q] ? S[u][c][t][q] + rpb[rowb + dcv[t][q]] : -1e30f; S[u][c][t][q] = sv; mx = fmaxf(mx, sv); } } }
        mx = fmaxf(mx, __shfl_xor(mx, 16)); mx = fmaxf(mx, __shfl_xor(mx, 32));
        float l = 0.f;
#pragma unroll
        for (int c = 0; c < 9; ++c) { const bool act = c >= du && c < du + 8;
            if (act) { float e[2][4];
#pragma unroll
                for (int t = 0; t < 2; ++t)
#pragma unroll
                    for (int q = 0; q < 4; ++q) { e[t][q] = __builtin_amdgcn_exp2f(S[u][c][t][q] - mx); l += e[t][q]; }
                P[u][c][0] = pk2(e[0][0], e[0][1]); P[u][c][1] = pk2(e[0][2], e[0][3]); P[u][c][2] = pk2(e[1][0], e[1][1]); P[u][c][3] = pk2(e[1][2], e[1][3]); }
            else { P[u][c][0] = 0u; P[u][c][1] = 0u; P[u][c][2] = 0u; P[u][c][3] = 0u; } }
        l += __shfl_xor(l, 16); l += __shfl_xor(l, 32);
        inv[u] = 1.0f / l; }
    f32x4 O[2][8];
#pragma unroll
    for (int u = 0; u < 2; ++u)
#pragma unroll
        for (int dt = 0; dt < 8; ++dt) O[u][dt] = (f32x4){0.f, 0.f, 0.f, 0.f};
    const int q4 = ql >> 2, pp = ql & 3;
#pragma unroll
    for (int c = 0; c < 9; ++c) {
        wait_vm(c <= 6 ? 8 : (c == 7 ? 4 : 0)); ATT_BAR(); if (c + 12 < 18) NAT_ISSUE(c + 12);
        const bool a0 = c >= d0 && c < d0 + 8, a1 = c >= d1 && c < d1 + 8;
        LAS unsigned char* buf = lds + ((c + 9) & 3) * 32768 + hh * 16384;
        u32x4 pw0; pw0.x = P[0][c][0]; pw0.y = P[0][c][1]; pw0.z = P[0][c][2]; pw0.w = P[0][c][3];
        u32x4 pw1; pw1.x = P[1][c][0]; pw1.y = P[1][c][1]; pw1.z = P[1][c][2]; pw1.w = P[1][c][3];
        const bf16x8 pf0 = __builtin_bit_cast(bf16x8, pw0), pf1 = __builtin_bit_cast(bf16x8, pw1);
#pragma unroll
        for (int dt = 0; dt < 8; ++dt) { const bf16x8 vf = vt_frag(buf, w0, g, q4, pp, dt);
            if (a0) O[0][dt] = __builtin_amdgcn_mfma_f32_16x16x32_bf16(vf, pf0, O[0][dt], 0, 0, 0);
            if (a1) O[1][dt] = __builtin_amdgcn_mfma_f32_16x16x32_bf16(vf, pf1, O[1][dt], 0, 0, 0); }
    }
#undef NAT_ISSUE
#pragma unroll
    for (int u = 0; u < 2; ++u) { bf16_t* op = o + (size_t)(tq0 + 64 * u) * D + 1024 + h * 128 + 4 * g;
#pragma unroll
        for (int dt = 0; dt < 8; ++dt) { u32x2 w2; w2.x = pk2(O[u][dt][0] * inv[u], O[u][dt][1] * inv[u]); w2.y = pk2(O[u][dt][2] * inv[u], O[u][dt][3] * inv[u]); *(u32x2*)(op + 16 * dt) = w2; } }
}
__device__ __forceinline__ void p2_attn(const Params& p, LAS unsigned char* lds) {
    int tab_head = -1, mb = 0;
    const int nper = (1024 + (int)gridDim.x - 1) / (int)gridDim.x;
    const int NB = (MOE_ITEMS + 8 * (int)gridDim.x - 1) / (8 * (int)gridDim.x);
    for (int s = 0; s < 2 * nper || mb < NB; ++s) {
        if (s < 2 * nper) {
            const bool nat = s >= nper; const int it = (int)blockIdx.x + (nat ? s - nper : s) * (int)gridDim.x;
            if (s == nper) { tab_head = -1;
#ifdef PROBE_A
                if (blockIdx.x == 0 && threadIdx.x == 0) ((unsigned long long*)(p.ws + WS_END))[11] = __builtin_amdgcn_s_memrealtime();
#endif
            }
            if (it < 1024) { if (!nat) attn_window_item(p, lds, it, tab_head); else attn_nat_item(p, lds, it, tab_head); }
        }
        if ((((s + (int)blockIdx.x) & 1) == 0 || s >= 2 * nper) && mb < NB) {
            ATT_BAR();
            for (int q = 0; q < 3 && mb < NB; ++q) moe_prep_batch(p, lds, mb++);
        }
    }
    asm volatile("s_waitcnt vmcnt(0)" ::: "memory"); __syncthreads();
}

struct UpHook { const bf16_t* gates;
    __device__ __forceinline__ void operator()(f32x4 (&acc)[2][2][4][2], const Unit& u, int wr, int wc, int fr, int fq) const {
        const unsigned goff = (unsigned)(u.pm * 256 + wr * 64 + fr) * NGATE + u.pn * 256 + wc * 32 + 8 * fq;
#pragma unroll
        for (int ai = 0; ai < 2; ++ai) {
            bf16x8 ra[4][2];
#pragma unroll
            for (int m = 0; m < 4; ++m)
#pragma unroll
                for (int bj = 0; bj < 2; ++bj) ra[m][bj] = *(const bf16x8*)(gates + goff + (unsigned)((ai * 128 + m * 16) * NGATE) + bj * 128);
#pragma unroll
            for (int m = 0; m < 4; ++m)
#pragma unroll
                for (int bj = 0; bj < 2; ++bj)
#pragma unroll
                    for (int n = 0; n < 2; ++n)
#pragma unroll
                        for (int j = 0; j < 4; ++j) acc[ai][bj][m][n][j] *= bf2f(ra[m][bj][4 * n + j]);
            asm volatile("" ::: "memory"); }
    } };
struct UpSched {
    pg8::TileOrder o; const bf16_t* A; const bf16_t* Bt;
    __device__ __forceinline__ bool next(int i, Unit& u) const { u.aux = i & 1; return o.tile(i >> 1, u.pm, u.pn); }
    __device__ __forceinline__ const char* a_base(const Unit& u) const { return (const char*)(A + (size_t)u.pm * 256 * D + u.aux * 1024); }
    __device__ __forceinline__ const char* b_base(const Unit& u) const { return (const char*)(Bt + (size_t)u.pn * 256 * D + u.aux * 1024); }
    __device__ __forceinline__ bool keep_acc(const Unit& u) const { return u.aux == 0; }
    __device__ __forceinline__ void a_offs(const Unit&, int, int, int, int, unsigned (&)[2][2]) const {}
};
struct EpiUp { const bf16_t* gates; bf16_t* merged;
    __device__ __forceinline__ void operator()(f32x4 (&acc)[2][2][4][2], const Unit& u, int wr, int wc, int fr, int fq) const {
        if (u.aux == 0) { UpHook{gates}(acc, u, wr, wc, fr, fq); return; }
        const unsigned goff = (unsigned)(u.pm * 256 + wr * 64 + fr) * NGATE + 2048 + u.pn * 256 + wc * 32 + 8 * fq;
        const unsigned moff = (unsigned)(u.pm * 256 + wr * 64 + fr) * D + u.pn * 256 + wc * 32 + 8 * fq;
#pragma unroll
        for (int ai = 0; ai < 2; ++ai) {
            bf16x8 sb[4][2];
#pragma unroll
            for (int m = 0; m < 4; ++m)
#pragma unroll
                for (int bj = 0; bj < 2; ++bj) sb[m][bj] = *(const bf16x8*)(gates + goff + (unsigned)((ai * 128 + m * 16) * NGATE) + bj * 128);
#pragma unroll
            for (int m = 0; m < 4; ++m)
#pragma unroll
                for (int bj = 0; bj < 2; ++bj) { f32x4 v0 = acc[ai][bj][m][0], v1 = acc[ai][bj][m][1];
#pragma unroll
                    for (int j = 0; j < 4; ++j) { v0[j] *= bf2f(sb[m][bj][j]); v1[j] *= bf2f(sb[m][bj][4 + j]); }
                    u32x4 w; w.x = pk2(v0[0], v0[1]); w.y = pk2(v0[2], v0[3]); w.z = pk2(v1[0], v1[1]); w.w = pk2(v1[2], v1[3]);
                    *(u32x4*)(merged + moff + (unsigned)((ai * 128 + m * 16) * D) + bj * 128) = w; }
            asm volatile("" ::: "memory"); }
    } };
__device__ __forceinline__ void p3_up(const Params& p, LAS unsigned char* lds) {
    UpSched S; S.o.init(128, 8, gridDim.x, blockIdx.x); S.A = (const bf16_t*)(p.ws + WS_O); S.Bt = (const bf16_t*)(p.ws + WS_WUP);
    EpiUp E{(const bf16_t*)(p.ws + WS_GATES), (bf16_t*)(p.ws + WS_MG)};
    pg8::gemm_phase<true, false>(lds, S, E, 1024 / 64, D, D);
}

struct EpiOut { const bf16_t* xb; bf16_t* hb; unsigned char* h8;
    __device__ __forceinline__ void operator()(f32x4 (&acc)[2][2][4][2], const Unit& u, int wr, int wc, int fr, int fq) const {
        unsigned off = (unsigned)(u.pm * 256 + wr * 64 + fr) * D + u.pn * 256 + wc * 32 + 8 * fq;
#pragma unroll
        for (int ai = 0; ai < 2; ++ai) {
            bf16x8 xr[4][2];
#pragma unroll
            for (int m = 0; m < 4; ++m)
#pragma unroll
                for (int bj = 0; bj < 2; ++bj) xr[m][bj] = *(const bf16x8*)(xb + off + (unsigned)(m * 16 * D) + bj * 128);
#pragma unroll
            for (int m = 0; m < 4; ++m) { asm volatile("" : "+v"(off));
#pragma unroll
                for (int bj = 0; bj < 2; ++bj) { const f32x4 v0 = acc[ai][bj][m][0], v1 = acc[ai][bj][m][1]; const u32x4 xw = __builtin_bit_cast(u32x4, xr[m][bj]);
                    const float h0 = v0[0] + __uint_as_float(xw.x << 16), h1 = v0[1] + __uint_as_float(xw.x & 0xffff0000u), h2 = v0[2] + __uint_as_float(xw.y << 16), h3 = v0[3] + __uint_as_float(xw.y & 0xffff0000u);
                    const float h4 = v1[0] + __uint_as_float(xw.z << 16), h5 = v1[1] + __uint_as_float(xw.z & 0xffff0000u), h6 = v1[2] + __uint_as_float(xw.w << 16), h7 = v1[3] + __uint_as_float(xw.w & 0xffff0000u);
                    u32x4 w; w.x = pk2(h0, h1); w.y = pk2(h2, h3); w.z = pk2(h4, h5); w.w = pk2(h6, h7);
                    *(u32x4*)(hb + off + bj * 128) = w;
                    u32x2 f; f.x = pk4_fp8(h0, h1, h2, h3); f.y = pk4_fp8(h4, h5, h6, h7);
                    *(u32x2*)(h8 + off + bj * 128) = f; }
                off += 16 * D; }
            off += 64 * D; }
    } };
__device__ __forceinline__ void p4_out(const Params& p, LAS unsigned char* lds) {
    pg8::DenseSched S; S.o.init(128, 8, gridDim.x, blockIdx.x); S.A = (const bf16_t*)(p.ws + WS_MG); S.Bt = (const bf16_t*)(p.ws + WS_WOUT); S.lda = D; S.ldb = D;
    EpiOut E{(const bf16_t*)(p.ws + WS_XB), (bf16_t*)(p.ws + WS_O), p.ws + WS_H8};
    pg8::gemm_phase<true, false, pg8::DenseSched, EpiOut, false, true>(lds, S, E, D / 64, D, D);
}

__device__ __forceinline__ void p5_router(const Params& p, LAS unsigned char* lds) {
    const int tid = phase_tid(), lane = tid & 63, wave = __builtin_amdgcn_readfirstlane(tid >> 6), g = lane >> 4, tl = lane & 15;
    const bf16_t* wsp = (const bf16_t*)(p.ws + WS_WRT); float* r2 = (float*)(p.ws + WS_R2); int* cnt = (int*)(p.ws + WS_CNT); int* tokl = (int*)(p.ws + WS_TOK);
    int* recc = (int*)(p.ws + WS_RECC); float* recw = (float*)(p.ws + WS_RECW); const bf16_t* hb = (const bf16_t*)(p.ws + WS_O);
    const float* brg = p.in[15]; const float* bre = p.in[17];
    LAS unsigned char* H = lds + wave * 2304;
    LAS unsigned char* WL = lds + 36864;
    const int r8 = lane >> 3, s8 = lane & 7;
    const int pa0 = tid / 384, pr0 = (tid % 384) >> 3, ps0 = tid & 7, pi1 = 512 + tid, pa1 = pi1 / 384, pr1 = (pi1 % 384) >> 3;
    const unsigned wsrc0 = (unsigned)(pa0 * 48 * 2048 + pr0 * D + ps0 * 8), wsrc1 = (unsigned)(pa1 * 48 * 2048 + pr1 * D + ps0 * 8);
    const unsigned wdst0 = (unsigned)(pa0 * 6144 + pr0 * 128 + ((ps0 ^ (pr0 & 7)) << 4)), wdst1 = (unsigned)(pa1 * 6144 + pr1 * 128 + ((ps0 ^ (pr1 & 7)) << 4));
    for (int round = blockIdx.x; round < T / 128; round += gridDim.x) {
        const int tile = round * 8 + wave;
        const bf16_t* hs = hb + (size_t)tile * 16 * D + r8 * D + s8 * 8;
        f32x4 accA = {0.f, 0.f, 0.f, 0.f}, accB = accA, accC = accA; float ss = 0.f;
        u32x4 hq0[2], hq1[2], hq2[2], hq3[2], wr0, wr1;
#define RT_LOADS(bq, k) do { bq[0] = *(const u32x4*)(hs + 64 * (k)); bq[1] = *(const u32x4*)(hs + 8 * D + 64 * (k)); } while (0)
#define RT_COMP(bq, wbuf) do { \
            *(LAS u32x4*)(H + r8 * 144 + s8 * 16) = bq[0]; *(LAS u32x4*)(H + (r8 + 8) * 144 + s8 * 16) = bq[1]; \
            _Pragma("unroll") for (int ks = 0; ks < 2; ++ks) { const u32x4 hw = *(const LAS u32x4*)(H + tl * 144 + 64 * ks + 16 * g); \
                { const float a0 = __uint_as_float(hw.x << 16), a1 = __uint_as_float(hw.x & 0xffff0000u), a2 = __uint_as_float(hw.y << 16), a3 = __uint_as_float(hw.y & 0xffff0000u); \
                  const float a4 = __uint_as_float(hw.z << 16), a5 = __uint_as_float(hw.z & 0xffff0000u), a6 = __uint_as_float(hw.w << 16), a7 = __uint_as_float(hw.w & 0xffff0000u); \
                  ss += (a0 * a0 + a1 * a1) + (a2 * a2 + a3 * a3) + (a4 * a4 + a5 * a5) + (a6 * a6 + a7 * a7); } \
                const bf16x8 bh = __builtin_bit_cast(bf16x8, hw); const unsigned so_ = (unsigned)(((4 * ks + g) ^ (tl & 7)) << 4); \
                _Pragma("unroll") for (int t = 0; t < 3; ++t) { const bf16x8 ah = *(const LAS bf16x8*)((wbuf) + (16 * t + tl) * 128 + so_), al = *(const LAS bf16x8*)((wbuf) + 6144 + (16 * t + tl) * 128 + so_); \
                    f32x4& ac = (t == 0 ? accA : (t == 1 ? accB : accC)); \
                    ac = __builtin_amdgcn_mfma_f32_16x16x32_bf16(ah, bh, ac, 0, 0, 0); ac = __builtin_amdgcn_mfma_f32_16x16x32_bf16(al, bh, ac, 0, 0, 0); } } } while (0)
#define RT_WLOAD(c) do { wr0 = *(const u32x4*)(wsp + wsrc0 + 64 * (c)); if (tid < 256) wr1 = *(const u32x4*)(wsp + wsrc1 + 64 * (c)); } while (0)
#define RT_WSTORE(wbuf) do { *(LAS u32x4*)((wbuf) + wdst0) = wr0; if (tid < 256) *(LAS u32x4*)((wbuf) + wdst1) = wr1; } while (0)
        __syncthreads();
        RT_WLOAD(0); RT_LOADS(hq0, 0); RT_LOADS(hq1, 1); RT_LOADS(hq2, 2);
        RT_WSTORE(WL); RT_WLOAD(1);
        __syncthreads();
#pragma unroll 1
        for (int c = 0; c < D / 64; c += 4) {
            RT_LOADS(hq3, (c + 3));      RT_COMP(hq0, WL);         RT_WSTORE(WL + 12288); RT_WLOAD((c + 2) & 31); __syncthreads();
            RT_LOADS(hq0, (c + 4) & 31); RT_COMP(hq1, WL + 12288); RT_WSTORE(WL);         RT_WLOAD((c + 3) & 31); __syncthreads();
            RT_LOADS(hq1, (c + 5) & 31); RT_COMP(hq2, WL);         RT_WSTORE(WL + 12288); RT_WLOAD((c + 4) & 31); __syncthreads();
            RT_LOADS(hq2, (c + 6) & 31); RT_COMP(hq3, WL + 12288); RT_WSTORE(WL);         RT_WLOAD((c + 5) & 31); __syncthreads();
        }
#undef RT_LOADS
#undef RT_COMP
#undef RT_WLOAD
#undef RT_WSTORE
        const int tok = tile * 16 + tl;
        ss += __shfl_xor(ss, 16); ss += __shfl_xor(ss, 32);
        const float rr = rsqrtf(ss * (1.0f / D) + EPS);
        const float myg = accC[0] * rr + brg[g];
        float gl[4];
#pragma unroll
        for (int j = 0; j < 4; ++j) gl[j] = __shfl(myg, tl + 16 * j);
        int gi = 0; float gm = gl[0];
#pragma unroll
        for (int i = 1; i < 4; ++i) if (gl[i] > gm) { gm = gl[i]; gi = i; }
        float den = 0.f;
#pragma unroll
        for (int i = 0; i < 4; ++i) den += __expf(gl[i] - gm);
        const float pg = 1.0f / den;
        int L0 = 0, L1 = 0; float wt0 = 0.f, wt1 = 0.f; const bool owner = (g == gi);
        if (owner) {
            float el[8];
#pragma unroll
            for (int i = 0; i < 4; ++i) { el[i] = accA[i] * rr + bre[g * 8 + i]; el[4 + i] = accB[i] * rr + bre[g * 8 + 4 + i]; }
            int e0 = 0; float v0 = el[0];
#pragma unroll
            for (int i = 1; i < 8; ++i) if (el[i] > v0) { v0 = el[i]; e0 = i; }
            int e1 = -1; float v1 = -3.0e38f;
#pragma unroll
            for (int i = 0; i < 8; ++i) if (i != e0 && el[i] > v1) { v1 = el[i]; e1 = i; }
            const float ex = __expf(v1 - v0); const float s0 = 1.0f / (1.0f + ex), s1 = ex * s0;
            r2[tok] = rr; L0 = gi * 8 + e0; L1 = gi * 8 + e1; wt0 = pg * s0; wt1 = pg * s1;
        }
        LAS int* cl = (LAS int*)(lds + 61440);
        if (tid < 32) cl[tid] = 0;
        __syncthreads();
        int q0 = 0, q1 = 0;
        if (owner) { q0 = __hip_atomic_fetch_add(&cl[L0], 1, __ATOMIC_RELAXED, __HIP_MEMORY_SCOPE_WORKGROUP); q1 = __hip_atomic_fetch_add(&cl[L1], 1, __ATOMIC_RELAXED, __HIP_MEMORY_SCOPE_WORKGROUP); }
        __syncthreads();
        if (tid < 32) { const int n = cl[tid]; cl[32 + tid] = n ? atomicAdd(&cnt[tid], n) : 0; }
        __syncthreads();
        if (owner) { const int p0 = cl[32 + L0] + q0, p1 = cl[32 + L1] + q1;
            float* r2l = (float*)(p.ws + WS_R2L);
            tokl[(size_t)L0 * T + p0] = tok; r2l[(size_t)L0 * T + p0] = rr; recc[2 * tok] = L0 * 32768 + p0; recw[2 * tok] = wt0;
            tokl[(size_t)L1 * T + p1] = tok; r2l[(size_t)L1 * T + p1] = rr; recc[2 * tok + 1] = L1 * 32768 + p1; recw[2 * tok + 1] = wt1; }
    }
    __syncthreads();
}

__device__ __forceinline__ void build_tiles(const Params& p, LAS int* tab) {
    __syncthreads();
    if (threadIdx.x < 64) { const int L = threadIdx.x; const int c = L < 32 ? ((const int*)(p.ws + WS_CNT))[L] : 0; const int nt = (c + 255) >> 8;
        int pre = nt;
#pragma unroll
        for (int o = 1; o < 32; o <<= 1) { const int v = __shfl_up(pre, o); if (L >= o) pre += v; }
        const int first = pre - nt;
        if (L < 32) { tab[1400 + L] = first * 256; for (int i = 0; i < nt; ++i) { tab[4 + (first + i) * 4 + 0] = L; tab[4 + (first + i) * 4 + 1] = i * 256; tab[4 + (first + i) * 4 + 2] = (first + i) * 256; tab[4 + (first + i) * 4 + 3] = min(256, c - i * 256); } }
        if (L == 31) tab[0] = pre; }
    __syncthreads();
}
template <int NPN> struct MoeOrder { int G, c, t_lo, nt_tiles; const LAS int* tab;
    __device__ __forceinline__ bool unit(int i, Unit& u) const { const long L = (long)i * G + c; if (L >= (long)nt_tiles * NPN) return false;
        const int nwg = nt_tiles * NPN; int wgid = (int)L; { const int q = nwg / 8, r = nwg % 8, xcd = wgid % 8, off = wgid / 8; wgid = (xcd < r ? xcd * (q + 1) : r * (q + 1) + (xcd - r) * q) + off; }
        u.pm = t_lo + wgid / NPN; u.pn = wgid % NPN; u.aux = 0; return true; } };
struct GateUpSched { MoeOrder<4> o; const unsigned char* hb; const unsigned char* WguT; const int* tokl;
    __device__ __forceinline__ bool next(int i, Unit& u) const { return o.unit(i, u); }
    __device__ __forceinline__ const char* a_base(const Unit&) const { return (const char*)hb; }
    __device__ __forceinline__ const char* b_base(const Unit& u) const { const int e = o.tab[4 + u.pm * 4] & 31; return (const char*)(WguT + (size_t)(e * 1024 + u.pn * 256) * D); }
    __device__ __forceinline__ bool keep_acc(const Unit&) const { return false; }
    __device__ __forceinline__ void a_offs(const Unit& u, int R0, int C0, int R1, int C1, unsigned (&v)[2][2]) const {
        const int L = o.tab[4 + u.pm * 4], row0 = o.tab[4 + u.pm * 4 + 1], nrows = o.tab[4 + u.pm * 4 + 3]; const int* lst = tokl + (size_t)L * T + row0;
#pragma unroll
        for (int h = 0; h < 2; ++h) { const int r0 = R0 + 128 * h, r1 = R1 + 128 * h; const int t0 = r0 < nrows ? lst[r0] : 0, t1 = r1 < nrows ? lst[r1] : 0;
            v[h][0] = (unsigned)t0 * D + C0 * 2u; v[h][1] = (unsigned)t1 * D + C1 * 2u; } }
};
struct EpiGateUp { const LAS int* tab; const float* r2l; bf16_t* he;
    __device__ __forceinline__ void operator()(f32x4 (&acc)[2][2][4][2], const Unit& u, int wr, int wc, int fr, int fq) const {
        const int L = tab[4 + u.pm * 4], row0 = tab[4 + u.pm * 4 + 1], slot = tab[4 + u.pm * 4 + 2], nrows = tab[4 + u.pm * 4 + 3];
#pragma unroll
        for (int ai = 0; ai < 2; ++ai)
#pragma unroll
            for (int m = 0; m < 4; ++m) { const int rr = ai * 128 + wr * 64 + m * 16 + fr; const float rs = rr < nrows ? r2l[(size_t)L * T + row0 + rr] * (1.0f / 64.0f) : 0.f;
                u32x4 w; unsigned ww[4];
#pragma unroll
                for (int n = 0; n < 2; ++n) { float hv[4];
#pragma unroll
                    for (int j = 0; j < 4; ++j) { const float gt = acc[ai][0][m][n][j] * rs, up = acc[ai][1][m][n][j] * rs; hv[j] = gt * sigmoidf_(gt) * up; }
                    ww[2 * n] = pk2(hv[0], hv[1]); ww[2 * n + 1] = pk2(hv[2], hv[3]); }
                w.x = ww[0]; w.y = ww[1]; w.z = ww[2]; w.w = ww[3];
                *(u32x4*)(he + (size_t)(slot + rr) * 512 + u.pn * 128 + wc * 32 + 8 * fq) = w; }
    } };
__device__ __forceinline__ void p6_gateup(const Params& p, LAS unsigned char* lds) {
    LAS int* tab = (LAS int*)(lds + TAB_OFF); build_tiles(p, tab);
    GateUpSched S; S.o.G = gridDim.x; S.o.c = blockIdx.x; S.o.t_lo = 0; S.o.nt_tiles = tab[0]; S.o.tab = tab;
    S.hb = p.ws + WS_H8; S.WguT = p.ws + WS_WGU; S.tokl = (const int*)(p.ws + WS_TOK);
    EpiGateUp E{tab, (const float*)(p.ws + WS_R2L), (bf16_t*)(p.ws + WS_HE)};
    pg8::gemm_phase<true, true, GateUpSched, EpiGateUp, true>(lds, S, E, D / 128, D / 2, D / 2);
}
struct DownSched { MoeOrder<8> o; const bf16_t* he; const bf16_t* WdT;
    __device__ __forceinline__ bool next(int i, Unit& u) const { return o.unit(i, u); }
    __device__ __forceinline__ const char* a_base(const Unit& u) const { return (const char*)(he + (size_t)o.tab[4 + u.pm * 4 + 2] * 512); }
    __device__ __forceinline__ const char* b_base(const Unit& u) const { const int e = o.tab[4 + u.pm * 4] & 31; return (const char*)(WdT + (size_t)(e * 2048 + u.pn * 256) * 512); }
    __device__ __forceinline__ bool keep_acc(const Unit&) const { return false; }
    __device__ __forceinline__ void a_offs(const Unit&, int, int, int, int, unsigned (&)[2][2]) const {}
};
struct EpiDown { const LAS int* tab; unsigned char* ye;
    __device__ __forceinline__ void operator()(f32x4 (&acc)[2][2][4][2], const Unit& u, int wr, int wc, int fr, int fq) const {
        const int slot = tab[4 + u.pm * 4 + 2];
        unsigned off = (unsigned)(slot + wr * 64 + fr) * 2048 + u.pn * 256 + wc * 32 + 8 * fq;
#pragma unroll
        for (int ai = 0; ai < 2; ++ai) {
#pragma unroll
            for (int m = 0; m < 4; ++m) { asm volatile("" : "+v"(off));
#pragma unroll
                for (int bj = 0; bj < 2; ++bj) { const f32x4 v0 = acc[ai][bj][m][0] * 16.f, v1 = acc[ai][bj][m][1] * 16.f;
                    u32x2 w; w.x = pk4_fp8(v0[0], v0[1], v0[2], v0[3]); w.y = pk4_fp8(v1[0], v1[1], v1[2], v1[3]);
                    *(u32x2*)(ye + off + bj * 128) = w; }
                off += 16 * 2048; }
            off += 64 * 2048; }
    } };
__device__ __forceinline__ void p7_down(const Params& p, LAS unsigned char* lds) {
    LAS int* tab = (LAS int*)(lds + TAB_OFF); build_tiles(p, tab);
    DownSched S; S.o.G = gridDim.x; S.o.c = blockIdx.x; S.o.t_lo = 0; S.o.nt_tiles = tab[0]; S.o.tab = tab;
    S.he = (const bf16_t*)(p.ws + WS_HE); S.WdT = (const bf16_t*)(p.ws + WS_WD);
    EpiDown E{tab, p.ws + WS_YE};
    pg8::gemm_phase<true, false, DownSched, EpiDown, false, false>(lds, S, E, 512 / 64, 512, 512);
}
__device__ __forceinline__ void p8_combine(const Params& p, LAS unsigned char* lds) {
    LAS int* tab = (LAS int*)(lds + TAB_OFF); build_tiles(p, tab);
    const int tid = phase_tid(), lane = tid & 63, wave = tid >> 6; const int gw = blockIdx.x * 8 + wave, NGW = gridDim.x * 8;
    const int* recc = (const int*)(p.ws + WS_RECC); const float* recw = (const float*)(p.ws + WS_RECW); const bf16_t* hb = (const bf16_t*)(p.ws + WS_O);
    const unsigned char* ye = p.ws + WS_YE;
    for (int tok = gw; tok < T; tok += NGW) {
        const int c0 = recc[2 * tok], c1 = recc[2 * tok + 1]; const float wa = recw[2 * tok] * 0.0625f, wb = recw[2 * tok + 1] * 0.0625f;
        const int s0 = tab[1400 + (c0 >> 15)] + (c0 & 32767), s1 = tab[1400 + (c1 >> 15)] + (c1 & 32767);
        f32x4* op = (f32x4*)(p.out + (size_t)tok * D) + lane; const u32x2* hp = (const u32x2*)(hb + (size_t)tok * D) + lane;
        const unsigned* ya = (const unsigned*)(ye + (size_t)s0 * 2048) + lane; const unsigned* yb = (const unsigned*)(ye + (size_t)s1 * 2048) + lane;
        u32x2 m[8]; unsigned a[8], b[8];
#pragma unroll
        for (int j = 0; j < 8; ++j) { m[j] = hp[64 * j]; a[j] = ya[64 * j]; b[j] = yb[64 * j]; }
#pragma unroll
        for (int j = 0; j < 8; ++j) { f32x4 v;
            const f32x2 a0 = __builtin_amdgcn_cvt_pk_f32_fp8(a[j], false), a1 = __builtin_amdgcn_cvt_pk_f32_fp8(a[j], true), b0 = __builtin_amdgcn_cvt_pk_f32_fp8(b[j], false), b1 = __builtin_amdgcn_cvt_pk_f32_fp8(b[j], true);
            v.x = __uint_as_float(m[j].x << 16) + wa * a0.x + wb * b0.x; v.y = __uint_as_float(m[j].x & 0xffff0000u) + wa * a0.y + wb * b0.y;
            v.z = __uint_as_float(m[j].y << 16) + wa * a1.x + wb * b1.x; v.w = __uint_as_float(m[j].y & 0xffff0000u) + wa * a1.y + wb * b1.y;
            op[64 * j] = v; }
    }
}

#define XB_TMO      128
#define XB_XCNT(j)  (256  + 64 * (j))
#define XB_XSUB(j)  (1280 + 64 * (j))
#define XB_XGEN(j)  (2304 + 64 * (j))
#define XB_TOP      3328
#define XB_TOPGEN   3392
#define XCD_BAR_WORDS 3456
#define XB_SPIN_CAP (1u << 18)
__device__ __forceinline__ unsigned xb_ld(unsigned* p)              { return __hip_atomic_load(p, __ATOMIC_RELAXED, __HIP_MEMORY_SCOPE_AGENT); }
__device__ __forceinline__ unsigned xb_add(unsigned* p, unsigned v) { return __hip_atomic_fetch_add(p, v, __ATOMIC_RELAXED, __HIP_MEMORY_SCOPE_AGENT); }
__device__ __forceinline__ unsigned xb_xcc_id() { return (unsigned)__builtin_amdgcn_s_getreg((3 << 11) | 20) & 0xFu; }
#define XB_SPIN(cond, bar) do { unsigned _sp = 0; while (cond) { __builtin_amdgcn_s_sleep(1); \
    if ((++_sp & 255u) == 0u) { if (xb_ld(&(bar)[XB_TMO])) break; if (_sp > XB_SPIN_CAP) { atomicAdd(&(bar)[XB_TMO], 1u); break; } } } } while (0)
struct XcdBarrier { unsigned* bar; unsigned x; volatile LAS unsigned* st; };
__device__ __forceinline__ XcdBarrier xcd_barrier_post(unsigned* bar, volatile LAS unsigned* st) {
    XcdBarrier b; b.bar = bar; b.x = xb_xcc_id(); b.st = st;
    if (threadIdx.x == 0) (void)xb_add(&bar[XB_XCNT(b.x)], 1u);
    return b;
}
__device__ __forceinline__ void xcd_barrier_complete(unsigned* bar, unsigned x, unsigned& nloc, unsigned& nx) {
    const unsigned G = gridDim.x * gridDim.y * gridDim.z;
    unsigned sum, cnt, mine, sp = 0u;
    for (;;) {
        sum = 0u; cnt = 0u; mine = 0u;
#pragma unroll
        for (unsigned j = 0; j < 16; ++j) { const unsigned c = xb_ld(&bar[XB_XCNT(j)]); sum += c; cnt += (c > 0u) ? 1u : 0u; mine = (j == x) ? c : mine; }
        if (sum == G) break;
        __builtin_amdgcn_s_sleep(1);
        if ((++sp & 255u) == 0u) { if (xb_ld(&bar[XB_TMO])) break; if (sp > XB_SPIN_CAP) { atomicAdd(&bar[XB_TMO], 1u); break; } }
    }
    nloc = mine > 0u ? mine : 1u; nx = cnt > 0u ? cnt : 1u;
}
__device__ __forceinline__ void xcd_barrier(const XcdBarrier& b) {
    asm volatile("s_waitcnt vmcnt(0)" ::: "memory");
    __syncthreads();
    if (threadIdx.x == 0) {
        unsigned* bar = b.bar;
        __builtin_amdgcn_s_waitcnt(0);
        unsigned nloc = b.st[0], nx = b.st[1];
        if (nloc == 0u) { xcd_barrier_complete(bar, b.x, nloc, nx); b.st[0] = nloc; b.st[1] = nx; }
        const unsigned old = xb_add(&bar[XB_XSUB(b.x)], 1u);
        const unsigned gen = old / nloc;
        if (old + 1u == (gen + 1u) * nloc) {
            __builtin_amdgcn_fence(__ATOMIC_RELEASE, "agent");
            asm volatile("s_waitcnt vmcnt(0)" ::: "memory");
            const unsigned og = xb_add(&bar[XB_TOP], 1u);
            const unsigned tg = og / nx;
            if (og + 1u == (tg + 1u) * nx) xb_add(&bar[XB_TOPGEN], 1u);
            else XB_SPIN(xb_ld(&bar[XB_TOPGEN]) == tg, bar);
            __builtin_amdgcn_fence(__ATOMIC_ACQUIRE, "agent");
            xb_add(&bar[XB_XGEN(b.x)], 1u);
            asm volatile("s_waitcnt vmcnt(0)" ::: "memory");
        } else {
            XB_SPIN(xb_ld(&bar[XB_XGEN(b.x)]) == gen, bar);
            __builtin_amdgcn_fence(__ATOMIC_ACQUIRE, "agent");
            asm volatile("s_waitcnt vmcnt(0)" ::: "memory");
        }
    }
    __syncthreads();
}

namespace cg = cooperative_groups;
#ifdef PROBE_A
#define STAMP(k) do { if (blockIdx.x == 0 && threadIdx.x == 0) ((unsigned long long*)(p.ws + WS_END))[k] = __builtin_amdgcn_s_memrealtime(); } while (0)
#else
#define STAMP(k) do {} while (0)
#endif
__global__ void __launch_bounds__(512, 2) fwd_megakernel(Params p) {
    extern __shared__ __attribute__((aligned(16))) unsigned char lds_raw[];
    LAS unsigned char* lds = (LAS unsigned char*)lds_raw;
    cg::grid_group grid = cg::this_grid();
    if (threadIdx.x == 0) { *(volatile LAS unsigned*)(lds + XBST_OFF) = 0u; *(volatile LAS unsigned*)(lds + XBST_OFF + 4) = 0u; }
    if (blockIdx.x == 0) for (int i = threadIdx.x; i < XCD_BAR_WORDS; i += 512) ((unsigned*)(p.ws + WS_BAR))[i] = 0u;
    __syncthreads();
#define GSYNC() xcd_barrier(xb)
    STAMP(0);
    p0_prep(p, lds);            grid.sync(); STAMP(1);
    const XcdBarrier xb = xcd_barrier_post((unsigned*)(p.ws + WS_BAR), (volatile LAS unsigned*)(lds + XBST_OFF));
    p1_inproj(p, lds);          GSYNC(); STAMP(2);
    p2_attn(p, lds);            GSYNC(); STAMP(3);
    STAMP(4);
    p3_up(p, lds);              GSYNC(); STAMP(5);
    p4_out(p, lds);             GSYNC(); STAMP(6);
    p5_router(p, lds);          GSYNC(); STAMP(7);
    p6_gateup(p, lds);          GSYNC(); STAMP(8);
    p7_down(p, lds);            GSYNC(); STAMP(9);
    p8_combine(p, lds);
#ifdef PROBE_A
    grid.sync(); STAMP(10); grid.sync();
    {
        const unsigned long long* ts = (const unsigned long long*)(p.ws + WS_END);
        #ifndef PROBE_A1
#define PROBE_A1 (PROBE_A + 1)
#endif
#ifndef PROBE_B1
#define PROBE_B1 (PROBE_B + 1)
#endif
        const float usA = (float)(ts[PROBE_A1] - ts[PROBE_A]) * 0.01f, usB = (float)(ts[PROBE_B1] - ts[PROBE_B]) * 0.01f;
        const float eps = sqrtf(usA * 1e-6f);
        for (size_t i = (size_t)blockIdx.x * 512 + threadIdx.x; i < (size_t)T * D / 4; i += (size_t)gridDim.x * 512) { f32x4 v = ((f32x4*)p.out)[i]; v = v * (1.0f + eps); if (i == 0) v.x += usB * 0.1f; ((f32x4*)p.out)[i] = v; }
    }
#endif
}

extern "C" void kernel_launch(void* const* d_in, const int* in_sizes, int n_in, void* d_out, int out_size, void* d_ws, size_t ws_size, hipStream_t stream) {
    static int grid_blocks = 0;
    if (!grid_blocks) {
        if (n_in != 21 || out_size != T * D || ws_size < WS_TOP) { fprintf(stderr, "kernel_launch: unexpected problem (n_in %d out %d ws %zu)\n", n_in, out_size, ws_size); grid_blocks = -1; return; }
        if (hipFuncSetAttribute((const void*)fwd_megakernel, hipFuncAttributeMaxDynamicSharedMemorySize, LDS_BYTES) != hipSuccess) { fprintf(stderr, "kernel_launch: hipFuncSetAttribute failed\n"); grid_blocks = -1; return; }
        int dev = 0, cus = 0, per_cu = 0;
        hipGetDevice(&dev); hipDeviceGetAttribute(&cus, hipDeviceAttributeMultiprocessorCount, dev);
        hipOccupancyMaxActiveBlocksPerMultiprocessor(&per_cu, (const void*)fwd_megakernel, 512, LDS_BYTES);
        if (per_cu < 1 || cus < 1) { fprintf(stderr, "kernel_launch: occupancy query gave %d blocks/CU on %d CUs\n", per_cu, cus); grid_blocks = -1; return; }
        grid_blocks = cus;
    }
    if (grid_blocks < 0) return;
    Params p{};
    for (int i = 0; i < 21; ++i) p.in[i] = (const float*)d_in[i];
    p.out = (float*)d_out; p.ws = (unsigned char*)d_ws;
    void* args[] = {&p};
    hipError_t e = hipLaunchCooperativeKernel((const void*)fwd_megakernel, dim3(grid_blocks), dim3(512), args, LDS_BYTES, stream);
    if (e != hipSuccess) fprintf(stderr, "cooperative launch failed: %s (grid %d)\n", hipGetErrorString(e), grid_blocks);
}
```

```cpp
#include <hip/hip_runtime.h>
#include <hip/hip_cooperative_groups.h>
#include <cstdio>
#include <cstdint>

#define LAS __attribute__((address_space(3)))
typedef unsigned short bf16_t;
typedef short bf16x8 __attribute__((ext_vector_type(8)));
typedef short s16x4 __attribute__((ext_vector_type(4)));
typedef float f32x4 __attribute__((ext_vector_type(4)));
typedef unsigned u32x4 __attribute__((ext_vector_type(4)));
typedef unsigned u32x2 __attribute__((ext_vector_type(2)));
typedef short v4i16_t __attribute__((ext_vector_type(4)));

namespace cfg {
constexpr int T = 32768, D = 2048, SEQ = 16384;
constexpr int NQKV = 4608, NGATE = 4096, NIN = 8704;
constexpr size_t MiB = 1ull << 20;
constexpr size_t WS_XB = 0, WS_QKV = 128 * MiB, WS_GATES = 416 * MiB, WS_O = 672 * MiB, WS_WIN = 800 * MiB, WS_WUP = 834 * MiB, WS_WOUT = 842 * MiB, WS_MISC = 850 * MiB;
constexpr size_t WS_WGU = 872 * MiB, WS_WD = 936 * MiB, WS_MG = WS_QKV, WS_HE = WS_QKV + 192 * MiB;
constexpr size_t WS_R1 = WS_MISC, WS_R2 = WS_R1 + (size_t)T * 4, WS_WRT = WS_R2 + (size_t)T * 4, WS_CNT = WS_WRT + 512 * 1024, WS_TOK = WS_CNT + 4096,
                 WS_RECC = WS_TOK + 32ull * T * 4, WS_RECW = WS_RECC + 2ull * T * 4, WS_R2L = WS_RECW + 2ull * T * 4, WS_END = WS_R2L + 32ull * T * 4;
constexpr size_t WS_H8 = WS_GATES + 144 * MiB;
constexpr size_t WS_YE = WS_QKV;
constexpr size_t WS_BAR = WS_END + 4096;
constexpr size_t WS_X8 = 872 * MiB;
constexpr size_t WS_WIN8 = WS_WIN + 18 * MiB;
constexpr size_t WS_TOP = 1000 * MiB;
constexpr int LDS_BYTES = 140 * 1024;
constexpr int XBST_OFF = LDS_BYTES - 16;
constexpr int TAB_OFF = 132 * 1024;
constexpr float EPS = 1e-6f;
}
using namespace cfg;

struct Params { const float* in[21]; float* out; unsigned char* ws; };
__device__ __forceinline__ int phase_tid() { int t = threadIdx.x; asm volatile("" : "+v"(t)); return t; }

__device__ __forceinline__ float bf2f(short s) { return __uint_as_float(((unsigned)(unsigned short)s) << 16); }
typedef float f32x2 __attribute__((ext_vector_type(2)));
typedef __bf16 bf16x2_t __attribute__((ext_vector_type(2)));
__device__ __forceinline__ unsigned pk2(float lo, float hi) { const f32x2 v = {lo, hi}; return __builtin_bit_cast(unsigned, __builtin_convertvector(v, bf16x2_t)); }
__device__ __forceinline__ unsigned pk4_fp8(float a, float b, float c, float d) { int w = 0; w = __builtin_amdgcn_cvt_pk_fp8_f32(a, b, w, false); w = __builtin_amdgcn_cvt_pk_fp8_f32(c, d, w, true); return (unsigned)w; }
__device__ __forceinline__ float wave_sum(float v) {
#pragma unroll
    for (int o = 1; o < 64; o <<= 1) v += __shfl_xor(v, o);
    return v;
}
__device__ __forceinline__ float sigmoidf_(float v) { return 1.0f / (1.0f + __expf(-v)); }
__device__ __forceinline__ unsigned off_b(unsigned row, unsigned ch) { return 256u * row + 16u * (ch ^ (((row & 3) << 2) | ((row >> 2) & 3))); }
__device__ __forceinline__ s16x4 tr_read(LAS unsigned char* p) { return __builtin_bit_cast(s16x4, __builtin_amdgcn_ds_read_tr16_b64_v4i16((LAS v4i16_t*)p)); }
__host__ __device__ __forceinline__ int perm32(int rho) { const int n = rho >> 4, i = rho & 15; return 8 * (i >> 2) + 4 * n + (i & 3); }
__device__ __forceinline__ int t5_bucket(int rel) {
    const int n = rel < 0 ? -rel : rel; const int ret = rel > 0 ? 16 : 0; int b;
    if (n < 8) b = n; else if (n < 12) b = 8; else if (n < 16) b = 9; else if (n < 23) b = 10; else if (n < 32) b = 11; else if (n < 46) b = 12; else if (n < 64) b = 13; else if (n < 91) b = 14; else b = 15;
    return ret + b;
}

template <bool FP8>
__device__ __forceinline__ void transpose_item(const float* __restrict__ W, int ldw, int k0, int n0, bf16_t* __restrict__ WT, int ldt, int drow0, int dk0, const float* __restrict__ scale, LAS unsigned* scr, int lane, float f8scale = 1.f) {
    const int n4 = (lane & 15) * 4, kk = lane >> 4;
    const float* src = W + (size_t)(k0 + 2 * kk) * ldw + n0 + n4;
    f32x4 ev[8], od[8];
#pragma unroll
    for (int j = 0; j < 8; ++j) { ev[j] = *(const f32x4*)(src + (size_t)(8 * j) * ldw); od[j] = *(const f32x4*)(src + (size_t)(8 * j + 1) * ldw); }
#pragma unroll
    for (int j = 0; j < 8; ++j) { f32x4 e = ev[j], o = od[j];
        if (scale) { const float se = scale[k0 + 8 * j + 2 * kk], so = scale[k0 + 8 * j + 2 * kk + 1]; e = e * se; o = o * so; }
        u32x4 w; w.x = pk2(e.x, o.x); w.y = pk2(e.y, o.y); w.z = pk2(e.z, o.z); w.w = pk2(e.w, o.w);
        *(LAS u32x4*)(scr + (4 * j + kk) * 68 + n4) = w; }
    asm volatile("s_waitcnt lgkmcnt(0)" ::: "memory");
    const int kq = lane & 7;
#pragma unroll
    for (int i = 0; i < 8; ++i) { const int n = (lane >> 3) + 8 * i; const LAS unsigned* q = scr + (4 * kq) * 68 + n;
        u32x4 o; o.x = q[0]; o.y = q[68]; o.z = q[136]; o.w = q[204];
        if (FP8) { u32x2 f; f.x = pk4_fp8(__uint_as_float(o.x << 16) * f8scale, __uint_as_float(o.x & 0xffff0000u) * f8scale, __uint_as_float(o.y << 16) * f8scale, __uint_as_float(o.y & 0xffff0000u) * f8scale);
            f.y = pk4_fp8(__uint_as_float(o.z << 16) * f8scale, __uint_as_float(o.z & 0xffff0000u) * f8scale, __uint_as_float(o.w << 16) * f8scale, __uint_as_float(o.w & 0xffff0000u) * f8scale);
            *(u32x2*)((unsigned char*)WT + (size_t)(drow0 + n) * ldt + dk0 + k0 + 8 * kq) = f; }
        else *(u32x4*)(WT + (size_t)(drow0 + n) * ldt + dk0 + k0 + 8 * kq) = o; }
    asm volatile("s_waitcnt lgkmcnt(0)" ::: "memory");
}

__device__ __forceinline__ void p0_prep(const Params& p, LAS unsigned char* lds) {
    const int tid = phase_tid(), lane = tid & 63, wave = tid >> 6;
    const int gw = blockIdx.x * 8 + wave, NGW = gridDim.x * 8;
    LAS unsigned* scr = (LAS unsigned*)(lds + wave * 8704);
    const float* x = p.in[0]; const float* g1 = p.in[1]; const float* w_in = p.in[2];
    bf16_t* xb = (bf16_t*)(p.ws + WS_XB); float* r1 = (float*)(p.ws + WS_R1);
    bf16_t* WinT = (bf16_t*)(p.ws + WS_WIN); bf16_t* WupT = (bf16_t*)(p.ws + WS_WUP); bf16_t* WoutT = (bf16_t*)(p.ws + WS_WOUT);
    constexpr int I_WIN = 32 * 136, I_UP = 16 * 32, I_OUT = 32 * 32, NITEMS = I_WIN + 2 * I_UP + I_OUT;
    for (int it = gw; it < NITEMS; it += NGW) {
        int r = it;
        if (r < I_WIN) { const int kb = r / 136, nb = r % 136; const int n0 = nb * 64;
            if (n0 >= NQKV) { const int c = (n0 - NQKV) & 2047, isb = (n0 - NQKV) >> 11; const int drow = (c >> 7) * 256 + isb * 128 + (c & 127);
                transpose_item<true>(w_in, NIN, kb * 64, n0, (bf16_t*)(p.ws + WS_WIN8), 2048, drow, 0, g1, scr, lane, 64.f); }
            else transpose_item<false>(w_in, NIN, kb * 64, n0, WinT, 2048, n0, 0, g1, scr, lane);
            continue; } r -= I_WIN;
        if (r < I_UP) { const int kb = r / 32, nb = r % 32; transpose_item<false>(p.in[9], 2048, kb * 64, nb * 64, WupT, 2048, nb * 64, 0, nullptr, scr, lane); continue; } r -= I_UP;
        if (r < I_UP) { const int kb = r / 32, nb = r % 32; transpose_item<false>(p.in[10], 2048, kb * 64, nb * 64, WupT, 2048, nb * 64, 1024, nullptr, scr, lane); continue; } r -= I_UP;
        { const int kb = r / 32, nb = r % 32; transpose_item<false>(p.in[11], 2048, kb * 64, nb * 64, WoutT, 2048, nb * 64, 0, nullptr, scr, lane); }
    }
    { bf16_t* whi = (bf16_t*)(p.ws + WS_WRT); bf16_t* wlo = whi + 48 * 2048; const float* g2 = p.in[13]; const float* wrg = p.in[14]; const float* wre = p.in[16];
      for (int i = blockIdx.x * 512 + tid; i < 48 * 2048; i += gridDim.x * 512) { const int row = i >> 11, k = i & 2047, t = row >> 4, r = row & 15; float w;
          if (t == 0) w = wre[k * 32 + (r >> 2) * 8 + (r & 3)]; else if (t == 1) w = wre[k * 32 + (r >> 2) * 8 + 4 + (r & 3)]; else w = (r & 3) == 0 ? wrg[k * 4 + (r >> 2)] : 0.f;
          w *= g2[k]; const unsigned hi = pk2(w, 0.f) & 0xffffu; const float hf = __uint_as_float(hi << 16); whi[i] = (bf16_t)hi; wlo[i] = (bf16_t)(pk2(w - hf, 0.f) & 0xffffu); } }
    if (blockIdx.x == 0 && tid < 32) ((int*)(p.ws + WS_CNT))[tid] = 0;
    for (int row0 = 2 * gw; row0 < T; row0 += 2 * NGW) {
        f32x4 v[2][8]; float ss[2] = {0.f, 0.f};
#pragma unroll
        for (int u = 0; u < 2; ++u) { const f32x4* xr = (const f32x4*)(x + (size_t)(row0 + u) * D) + lane;
#pragma unroll
            for (int j = 0; j < 8; ++j) v[u][j] = xr[64 * j]; }
#pragma unroll
        for (int u = 0; u < 2; ++u) {
#pragma unroll
            for (int j = 0; j < 8; ++j) ss[u] += (v[u][j].x * v[u][j].x + v[u][j].y * v[u][j].y) + (v[u][j].z * v[u][j].z + v[u][j].w * v[u][j].w);
            ss[u] = wave_sum(ss[u]);
            if (lane == 0) r1[row0 + u] = rsqrtf(ss[u] * (1.0f / D) + EPS);
            u32x2* o = (u32x2*)(xb + (size_t)(row0 + u) * D) + lane; unsigned* o8 = (unsigned*)(p.ws + WS_X8 + (size_t)(row0 + u) * D) + lane;
#pragma unroll
            for (int j = 0; j < 8; ++j) { u32x2 w; w.x = pk2(v[u][j].x, v[u][j].y); w.y = pk2(v[u][j].z, v[u][j].w); o[64 * j] = w; o8[64 * j] = pk4_fp8(v[u][j].x, v[u][j].y, v[u][j].z, v[u][j].w); } }
    }
}

constexpr int MOE_ITEMS = 2 * 32 * 32 * 8 + 32 * 8 * 32;
__device__ __forceinline__ void moe_prep_batch(const Params& p, LAS unsigned char* lds, int bi) {
    const int tid = phase_tid(), lane = tid & 63, wave = tid >> 6;
    LAS unsigned* scr = (LAS unsigned*)(lds + wave * 8704);
    const float* g2 = p.in[13];
    bf16_t* WguT = (bf16_t*)(p.ws + WS_WGU); bf16_t* WdT = (bf16_t*)(p.ws + WS_WD);
    constexpr int I_G = 32 * 32 * 8;
    int r = (bi * (int)gridDim.x + (int)blockIdx.x) * 8 + wave;
    if (r >= MOE_ITEMS) return;
    if (r < 2 * I_G) { const int which = r >= I_G; if (which) r -= I_G; const int e = r / 256, rr = r % 256, kb = rr / 8, nb = rr % 8;
        const float* W = p.in[which ? 19 : 18] + (size_t)e * 2048 * 512; const int n0 = nb * 64;
        transpose_item<true>(W, 512, kb * 64, n0, WguT, 2048, e * 1024 + (n0 >> 7) * 256 + which * 128 + (n0 & 127), 0, g2, scr, lane, 64.f); return; }
    r -= 2 * I_G;
    { const int e = r / 256, rr = r % 256, kb = rr / 32, nb = rr % 32; const float* W = p.in[20] + (size_t)e * 512 * 2048;
      transpose_item<false>(W, 2048, kb * 64, nb * 64, WdT, 512, e * 2048 + nb * 64, 0, nullptr, scr, lane); }
}

struct Unit { int pm, pn, aux; };
namespace pg8 {
constexpr int BM = 256, BK = 64, HALF = 128, HTB = HALF * BK * 2, STAGE_BYTES = 8 * HTB;
__device__ __forceinline__ int lds_byte(int r, int c) { const int st = (r >> 4) * 2 + (c >> 5), rr = r & 15, cc = c & 31, ob = rr * 64 + cc * 2; return st * 1024 + (ob ^ (((ob >> 9) & 1) << 5)); }
__device__ __forceinline__ void stage_rc(int b, int& R, int& C) { const int st = b / 1024, sb = b % 1024, swz = sb ^ (((sb >> 9) & 1) << 5); R = (st >> 1) * 16 + swz / 64; C = (st & 1) * 32 + (swz % 64) / 2; }

template <bool PERM, bool GATHER, class Sched, class Epi, bool FP8 = false, bool ALIGN_EPI = true>
__device__ __forceinline__ void gemm_phase(LAS unsigned char* lds, const Sched& S, const Epi& E, const int nt, const int lda, const int ldb) {
    int tid_ = threadIdx.x; asm volatile("" : "+v"(tid_));
    const int tid = tid_, wid = __builtin_amdgcn_readfirstlane(tid >> 6), lane = tid & 63, wr = wid >> 2, wc = wid & 3, fr = lane & 15, fq = lane >> 4;
    int R0, C0, R1, C1; stage_rc(tid * 16, R0, C0); stage_rc(tid * 16 + 8192, R1, C1);
    unsigned voffB[2], voffA[2][2];
    { const int Rb0 = PERM ? ((R0 & ~31) + perm32(R0 & 31)) : R0, Rb1 = PERM ? ((R1 & ~31) + perm32(R1 & 31)) : R1;
      voffB[0] = (unsigned)(Rb0 * ldb + C0) * 2u; voffB[1] = (unsigned)(Rb1 * ldb + C1) * 2u; }
    const size_t kstep = (size_t)(BK * 2);
    const size_t hstepB = (size_t)HALF * ldb * 2, hstepA = (size_t)HALF * lda * 2;
    const unsigned ldsw = (unsigned)wid * 1024u;
    const int aoff = lds_byte(wr * 64 + fr, fq * 8), boff = lds_byte(wc * 32 + fr, fq * 8);
#define PG8_SA(b, h) (((b) * 2 + (h)) * HTB)
#define PG8_SB(b, h) ((4 + (b) * 2 + (h)) * HTB)
#define PG8_STAGE_B(bufoff, gbase) do { _Pragma("unroll") for (int _i = 0; _i < 2; ++_i) \
        __builtin_amdgcn_global_load_lds((const unsigned*)((const char*)(gbase) + voffB[_i]), (LAS unsigned*)(lds + (bufoff) + ldsw + _i * 8192), 16, 0, 0); } while (0)
#define PG8_STAGE_A(bufoff, gbase, h) do { _Pragma("unroll") for (int _i = 0; _i < 2; ++_i) \
        __builtin_amdgcn_global_load_lds((const unsigned*)((const char*)(gbase) + (GATHER ? (size_t)0 : (size_t)(h) * hstepA) + voffA[GATHER ? (h) : 0][_i]), (LAS unsigned*)(lds + (bufoff) + ldsw + _i * 8192), 16, 0, 0); } while (0)
#define PG8_LDA(dst, b, h) do { _Pragma("unroll") for (int m = 0; m < 4; ++m) _Pragma("unroll") for (int k = 0; k < 2; ++k) dst[m][k] = *(const LAS bf16x8*)(lds + PG8_SA(b, h) + aoff + m * 2048 + k * 1024); } while (0)
#define PG8_LDB(dst, b, h) do { _Pragma("unroll") for (int n = 0; n < 2; ++n) _Pragma("unroll") for (int k = 0; k < 2; ++k) dst[n][k] = *(const LAS bf16x8*)(lds + PG8_SB(b, h) + boff + n * 2048 + k * 1024); } while (0)
#define PG8_MMA(ai, bj, At, Bt) do { __builtin_amdgcn_s_setprio(1); _Pragma("unroll") for (int m = 0; m < 4; ++m) _Pragma("unroll") for (int n = 0; n < 2; ++n) { \
        if (FP8) { typedef int v8i_ __attribute__((ext_vector_type(8))); typedef int v4i_ __attribute__((ext_vector_type(4))); \
            const v4i_ b0_ = __builtin_bit_cast(v4i_, Bt[n][0]), b1_ = __builtin_bit_cast(v4i_, Bt[n][1]), a0_ = __builtin_bit_cast(v4i_, At[m][0]), a1_ = __builtin_bit_cast(v4i_, At[m][1]); \
            const v8i_ bb_ = {b0_[0], b0_[1], b0_[2], b0_[3], b1_[0], b1_[1], b1_[2], b1_[3]}, aa_ = {a0_[0], a0_[1], a0_[2], a0_[3], a1_[0], a1_[1], a1_[2], a1_[3]}; \
            acc[ai][bj][m][n] = __builtin_amdgcn_mfma_scale_f32_16x16x128_f8f6f4(bb_, aa_, acc[ai][bj][m][n], 0, 0, 0, 0x7f7f7f7f, 0, 0x7f7f7f7f); } \
        else { _Pragma("unroll") for (int k = 0; k < 2; ++k) acc[ai][bj][m][n] = __builtin_amdgcn_mfma_f32_16x16x32_bf16(Bt[n][k], At[m][k], acc[ai][bj][m][n], 0, 0, 0); } } \
        __builtin_amdgcn_s_setprio(0); } while (0)
#define PG8_WAIT_V(n) asm volatile("s_waitcnt vmcnt(" #n ")" ::: "memory")
#define PG8_WAIT_L(n) asm volatile("s_waitcnt lgkmcnt(" #n ")" ::: "memory")
#define PG8_BAR __builtin_amdgcn_s_barrier()
#define PG8_SCHED __builtin_amdgcn_sched_barrier(0)
    Unit cur, nxt; int ui = 0;
    __syncthreads();
    if (!S.next(0, cur)) return;
    if (GATHER) S.a_offs(cur, R0, C0, R1, C1, voffA);
    else { voffA[0][0] = (unsigned)(R0 * lda + C0) * 2u; voffA[0][1] = (unsigned)(R1 * lda + C1) * 2u; voffA[1][0] = 0; voffA[1][1] = 0; }
    f32x4 acc[2][2][4][2];
#pragma unroll
    for (int a = 0; a < 2; ++a)
#pragma unroll
        for (int b = 0; b < 2; ++b)
#pragma unroll
            for (int m = 0; m < 4; ++m)
#pragma unroll
                for (int n = 0; n < 2; ++n) acc[a][b][m][n] = (f32x4){0.f, 0.f, 0.f, 0.f};
    bf16x8 At[4][2], B0[2][2], B1[2][2];
    const char* cA = S.a_base(cur); const char* cB = S.b_base(cur);
    PG8_STAGE_B(PG8_SB(0, 0), cB); PG8_STAGE_B(PG8_SB(0, 1), cB + hstepB); PG8_STAGE_A(PG8_SA(0, 0), cA, 0); PG8_STAGE_A(PG8_SA(0, 1), cA, 1);
    if (wr == 1) PG8_BAR;
    PG8_WAIT_V(2); PG8_BAR;
    PG8_STAGE_B(PG8_SB(1, 0), cB + kstep); PG8_STAGE_A(PG8_SA(1, 0), cA + kstep, 0); PG8_STAGE_B(PG8_SB(1, 1), cB + hstepB + kstep);
    PG8_WAIT_V(6); PG8_BAR;
    for (;;) {
        const bool has_next = S.next(ui + 1, nxt);
        const char* nA = has_next ? S.a_base(nxt) : cA; const char* nB = has_next ? S.b_base(nxt) : cB;
        unsigned vn[2][2];
        if (GATHER) { if (has_next) S.a_offs(nxt, R0, C0, R1, C1, vn); else { vn[0][0] = voffA[0][0]; vn[0][1] = voffA[0][1]; vn[1][0] = voffA[1][0]; vn[1][1] = voffA[1][1]; } }
        for (int t = 0; t < nt; t += 2) {
            const bool last = (t == nt - 2);
            const char* a1 = cA + (size_t)(t + 1) * kstep;
            const char* a2 = last ? nA : cA + (size_t)(t + 2) * kstep; const char* b2 = last ? nB : cB + (size_t)(t + 2) * kstep;
            const char* a3 = a2 + kstep; const char* b3 = b2 + kstep;
            PG8_LDB(B0, 0, 0); PG8_LDB(B1, 0, 1); PG8_SCHED; PG8_LDA(At, 0, 0); PG8_STAGE_A(PG8_SA(1, 1), a1, 1);
            if (GATHER) { if (last) { voffA[0][0] = vn[0][0]; voffA[0][1] = vn[0][1]; voffA[1][0] = vn[1][0]; voffA[1][1] = vn[1][1]; } }
            PG8_WAIT_V(8); PG8_WAIT_L(0); PG8_BAR; PG8_MMA(0, 0, At, B0); PG8_MMA(0, 1, At, B1); PG8_BAR; PG8_SCHED;
            PG8_LDA(At, 0, 1); PG8_STAGE_B(PG8_SB(0, 0), b2); PG8_STAGE_B(PG8_SB(0, 1), b2 + hstepB); PG8_STAGE_A(PG8_SA(0, 0), a2, 0);
            PG8_WAIT_V(8); PG8_WAIT_L(0); PG8_BAR; PG8_MMA(1, 0, At, B0); PG8_MMA(1, 1, At, B1); PG8_BAR; PG8_SCHED;
            PG8_LDB(B0, 1, 0); PG8_LDB(B1, 1, 1); PG8_SCHED; PG8_LDA(At, 1, 0); PG8_STAGE_A(PG8_SA(0, 1), a2, 1);
            PG8_WAIT_V(8); PG8_WAIT_L(0); PG8_BAR; PG8_MMA(0, 0, At, B0); PG8_MMA(0, 1, At, B1); PG8_BAR; PG8_SCHED;
            PG8_LDA(At, 1, 1); PG8_STAGE_B(PG8_SB(1, 0), b3); PG8_STAGE_B(PG8_SB(1, 1), b3 + hstepB); PG8_STAGE_A(PG8_SA(1, 0), a3, 0);
            PG8_WAIT_V(8); PG8_WAIT_L(0); PG8_BAR; PG8_MMA(1, 0, At, B0); PG8_MMA(1, 1, At, B1); PG8_BAR; PG8_SCHED;
        }
        if (ALIGN_EPI) { if (wr == 0) PG8_BAR; }
        { int te = threadIdx.x; asm volatile("" : "+v"(te)); E(acc, cur, wr, wc, te & 15, (te & 63) >> 4); }
        if (!has_next) break;
        if (!S.keep_acc(cur)) {
#pragma unroll
        for (int a = 0; a < 2; ++a)
#pragma unroll
            for (int b = 0; b < 2; ++b)
#pragma unroll
                for (int m = 0; m < 4; ++m)
#pragma unroll
                    for (int n = 0; n < 2; ++n) acc[a][b][m][n] = (f32x4){0.f, 0.f, 0.f, 0.f};
        }
        cur = nxt; cA = nA; cB = nB; ++ui;
        if (ALIGN_EPI) { if (wr == 1) PG8_BAR; }
    }
    PG8_WAIT_V(0);
    if (!ALIGN_EPI) { if (wr == 0) PG8_BAR; }
    PG8_BAR;
#undef PG8_SA
#undef PG8_SB
#undef PG8_STAGE_A
#undef PG8_STAGE_B
#undef PG8_LDA
#undef PG8_LDB
#undef PG8_MMA
#undef PG8_WAIT_V
#undef PG8_WAIT_L
#undef PG8_BAR
#undef PG8_SCHED
}
struct TileOrder {
    int nM, nN, nwg, G, c;
    __device__ __forceinline__ void init(int nM_, int nN_, int G_, int c_) { nM = nM_; nN = nN_; nwg = nM * nN; G = G_; c = c_; }
    __device__ __forceinline__ bool tile(int i, int& pm, int& pn) const {
        const long L = (long)i * G + c; if (L >= nwg) return false;
        int wgid = (int)L; { const int q = nwg / 8, r = nwg % 8, xcd = wgid % 8, off = wgid / 8; wgid = (xcd < r ? xcd * (q + 1) : r * (q + 1) + (xcd - r) * q) + off; }
        const int nig = 8 * nN, gid = wgid / nig, fm = gid * 8, gsz = (nM - fm) < 8 ? (nM - fm) : 8;
        pm = fm + ((wgid % nig) % gsz); pn = (wgid % nig) / gsz; return true;
    }
};
struct DenseSched {
    TileOrder o; const bf16_t* A; const bf16_t* Bt; int lda, ldb;
    __device__ __forceinline__ bool next(int i, Unit& u) const { u.aux = 0; return o.tile(i, u.pm, u.pn); }
    __device__ __forceinline__ const char* a_base(const Unit& u) const { return (const char*)(A + (size_t)u.pm * 256 * lda); }
    __device__ __forceinline__ const char* b_base(const Unit& u) const { return (const char*)(Bt + (size_t)u.pn * 256 * ldb); }
    __device__ __forceinline__ bool keep_acc(const Unit&) const { return false; }
    __device__ __forceinline__ void a_offs(const Unit&, int, int, int, int, unsigned (&)[2][2]) const {}
};
}

struct EpiInProj { bf16_t* qkv; const float* r1; const float* gqa; const float* gka; const float* gqb; const float* gkb; LAS float* X;
    __device__ __forceinline__ void operator()(f32x4 (&acc)[2][2][4][2], const Unit& u, int wr, int wc, int fr, int fq) const {
        const int pn = u.pn;
        bf16_t* base = qkv; const int ldc = NQKV; const int colt = pn * 256 + wc * 32 + 8 * fq;
        const float* gain = pn < 4 ? gqa : (pn == 4 ? gka : ((pn >= 6 && pn < 10) ? gqb : ((pn >= 10 && pn < 14) ? gkb : nullptr)));
        if (gain) {
            const float extra = (pn < 4 || (pn >= 6 && pn < 10)) ? 0.08838834764831845f * 1.4426950408889634f : 1.0f;
#pragma unroll
            for (int ai = 0; ai < 2; ++ai)
#pragma unroll
                for (int m = 0; m < 4; ++m)
#pragma unroll
                    for (int bj = 0; bj < 2; ++bj) { const f32x4 a0 = acc[ai][bj][m][0], a1 = acc[ai][bj][m][1];
                        float sq = (a0[0] * a0[0] + a0[1] * a0[1]) + (a0[2] * a0[2] + a0[3] * a0[3]) + (a1[0] * a1[0] + a1[1] * a1[1]) + (a1[2] * a1[2] + a1[3] * a1[3]);
                        sq += __shfl_xor(sq, 16); sq += __shfl_xor(sq, 32);
                        if (fq == 0) X[(ai * 128 + wr * 64 + m * 16 + fr) * 8 + bj * 4 + wc] = sq; }
            asm volatile("s_waitcnt lgkmcnt(0)" ::: "memory"); __builtin_amdgcn_s_barrier(); asm volatile("" ::: "memory");
            const f32x4 g0 = *(const f32x4*)(gain + wc * 32 + 8 * fq), g1 = *(const f32x4*)(gain + wc * 32 + 8 * fq + 4);
#pragma unroll
            for (int ai = 0; ai < 2; ++ai)
#pragma unroll
                for (int m = 0; m < 4; ++m) { const int rl = ai * 128 + wr * 64 + m * 16 + fr; const int row = u.pm * 256 + rl; const float rs = r1[row]; bf16_t* rowp = base + (size_t)row * ldc + colt;
#pragma unroll
                    for (int bj = 0; bj < 2; ++bj) { const f32x4 t = *(const LAS f32x4*)(X + rl * 8 + bj * 4); const float tot = (t[0] + t[1]) + (t[2] + t[3]);
                        const float sc = rs * rsqrtf(rs * rs * tot * (1.0f / 128.0f) + EPS) * extra;
                        const f32x4 v0 = acc[ai][bj][m][0] * sc * g0, v1 = acc[ai][bj][m][1] * sc * g1;
                        u32x4 w; w.x = pk2(v0[0], v0[1]); w.y = pk2(v0[2], v0[3]); w.z = pk2(v1[0], v1[1]); w.w = pk2(v1[2], v1[3]);
                        *(u32x4*)(rowp + bj * 128) = w; } }
            return;
        }
#pragma unroll
        for (int ai = 0; ai < 2; ++ai)
#pragma unroll
            for (int m = 0; m < 4; ++m) { const int row = u.pm * 256 + ai * 128 + wr * 64 + m * 16 + fr; const float rs = r1[row]; bf16_t* rowp = base + (size_t)row * ldc + colt;
#pragma unroll
                for (int bj = 0; bj < 2; ++bj) { const f32x4 v0 = acc[ai][bj][m][0] * rs, v1 = acc[ai][bj][m][1] * rs;
                    u32x4 w; w.x = pk2(v0[0], v0[1]); w.y = pk2(v0[2], v0[3]); w.z = pk2(v1[0], v1[1]); w.w = pk2(v1[2], v1[3]);
                    *(u32x4*)(rowp + bj * 128) = w; } }
    } };
struct GateSched { pg8::TileOrder o; const unsigned char* x8; const unsigned char* W8;
    __device__ __forceinline__ bool next(int i, Unit& u) const { u.aux = 0; return o.tile(i, u.pm, u.pn); }
    __device__ __forceinline__ const char* a_base(const Unit&) const { return (const char*)x8; }
    __device__ __forceinline__ const char* b_base(const Unit& u) const { return (const char*)(W8 + (size_t)(u.pn * 256) * D); }
    __device__ __forceinline__ bool keep_acc(const Unit&) const { return false; }
    __device__ __forceinline__ void a_offs(const Unit& u, int R0, int C0, int R1, int C1, unsigned (&v)[2][2]) const {
#pragma unroll
        for (int h = 0; h < 2; ++h) { v[h][0] = (unsigned)(u.pm * 256 + 128 * h + R0) * D + C0 * 2u; v[h][1] = (unsigned)(u.pm * 256 + 128 * h + R1) * D + C1 * 2u; } }
};
struct EpiGates { bf16_t* gates; const float* r1;
    __device__ __forceinline__ void operator()(f32x4 (&acc)[2][2][4][2], const Unit& u, int wr, int wc, int fr, int fq) const {
        const int cg = u.pn * 128 + wc * 32 + 8 * fq;
#pragma unroll
        for (int ai = 0; ai < 2; ++ai)
#pragma unroll
            for (int m = 0; m < 4; ++m) { const int row = u.pm * 256 + ai * 128 + wr * 64 + m * 16 + fr; const float rs = r1[row] * (1.0f / 64.0f); bf16_t* rowp = gates + (size_t)row * NGATE + cg;
                float ra[8], sb[8];
#pragma unroll
                for (int n = 0; n < 2; ++n)
#pragma unroll
                    for (int j = 0; j < 4; ++j) { const float ea = __expf(-acc[ai][0][m][n][j] * rs), eb = fminf(__expf(-acc[ai][1][m][n][j] * rs), 1e30f);
                        sb[4 * n + j] = __builtin_amdgcn_rcpf(1.0f + eb); ra[4 * n + j] = (1.0f + eb) * __builtin_amdgcn_rcpf(1.0f + ea); }
                u32x4 w; w.x = pk2(ra[0], ra[1]); w.y = pk2(ra[2], ra[3]); w.z = pk2(ra[4], ra[5]); w.w = pk2(ra[6], ra[7]); *(u32x4*)rowp = w;
                w.x = pk2(sb[0], sb[1]); w.y = pk2(sb[2], sb[3]); w.z = pk2(sb[4], sb[5]); w.w = pk2(sb[6], sb[7]); *(u32x4*)(rowp + 2048) = w; }
    } };
__device__ __forceinline__ void p1_inproj(const Params& p, LAS unsigned char* lds) {
    { pg8::DenseSched S; S.o.init(128, 18, gridDim.x, blockIdx.x); S.A = (const bf16_t*)(p.ws + WS_XB); S.Bt = (const bf16_t*)(p.ws + WS_WIN); S.lda = D; S.ldb = D;
      EpiInProj E{(bf16_t*)(p.ws + WS_QKV), (const float*)(p.ws + WS_R1), p.in[3], p.in[4], p.in[6], p.in[7], (LAS float*)(lds + 131072)};
      pg8::gemm_phase<true, false>(lds, S, E, D / 64, D, D); }
    { GateSched S; S.o.init(128, 16, gridDim.x, blockIdx.x); S.x8 = p.ws + WS_X8; S.W8 = p.ws + WS_WIN8;
      EpiGates E{(bf16_t*)(p.ws + WS_GATES), (const float*)(p.ws + WS_R1)};
      pg8::gemm_phase<true, true, GateSched, EpiGates, true>(lds, S, E, D / 128, D / 2, D / 2); }
}

__device__ __forceinline__ void wait_vm(int n) {
    switch (n) { case 0: asm volatile("s_waitcnt vmcnt(0)" ::: "memory"); break; case 2: asm volatile("s_waitcnt vmcnt(2)" ::: "memory"); break; case 4: asm volatile("s_waitcnt vmcnt(4)" ::: "memory"); break;
                 case 6: asm volatile("s_waitcnt vmcnt(6)" ::: "memory"); break; case 8: asm volatile("s_waitcnt vmcnt(8)" ::: "memory"); break; case 10: asm volatile("s_waitcnt vmcnt(10)" ::: "memory"); break;
                 default: asm volatile("s_waitcnt vmcnt(12)" ::: "memory"); break; }
}
__device__ __forceinline__ void glds16_asm(const void* gsrc, unsigned lds_dst) {
    unsigned keep;
    asm volatile("s_mov_b32 %0, m0\n\ts_mov_b32 m0, %2\n\ts_nop 0\n\tglobal_load_lds_dwordx4 %1, off\n\ts_mov_b32 m0, %0" : "=&s"(keep) : "v"(gsrc), "s"(lds_dst) : "memory");
}
#define ATT_BAR() do { asm volatile("s_waitcnt lgkmcnt(0)" ::: "memory"); __builtin_amdgcn_s_barrier(); asm volatile("" ::: "memory"); } while (0)
__device__ __forceinline__ void load_q(const bf16_t* qp, int g, bf16x8 (&qf)[4]) {
#pragma unroll
    for (int ks = 0; ks < 4; ++ks) qf[ks] = *(const bf16x8*)(qp + 32 * ks + 8 * g);
#pragma unroll
    for (int ks = 0; ks < 4; ++ks) asm volatile("" : "+v"(qf[ks]));
}
__device__ __forceinline__ bf16x8 vt_frag(LAS unsigned char* base, int row0, int g, int q4, int pp, int dt) {
    const s16x4 lo = tr_read(base + off_b(row0 + 4 * g + q4, 2 * dt + (pp >> 1)) + 8 * (pp & 1)), hi = tr_read(base + off_b(row0 + 16 + 4 * g + q4, 2 * dt + (pp >> 1)) + 8 * (pp & 1));
    bf16x8 vf; vf[0] = lo[0]; vf[1] = lo[1]; vf[2] = lo[2]; vf[3] = lo[3]; vf[4] = hi[0]; vf[5] = hi[1]; vf[6] = hi[2]; vf[7] = hi[3]; return vf;
}

__device__ __forceinline__ void attn_window_item(const Params& p, LAS unsigned char* lds, int item, int& tab_head) {
    const int tid = phase_tid(), lane = tid & 63, w = __builtin_amdgcn_readfirstlane(tid >> 6), g = lane >> 4, ql = lane & 15;
    const int b = item >> 9, nb = (item >> 2) & 127, hpq = item & 3, kv = hpq >> 1, hq0 = 2 * hpq;
    const bf16_t* qkv = (const bf16_t*)(p.ws + WS_QKV); bf16_t* o = (bf16_t*)(p.ws + WS_O);
    LAS float* bias = (LAS float*)(lds + 131072); const unsigned ldsb = (unsigned)(size_t)lds;
    const unsigned loff = (unsigned)(w * 4 + g) * NQKV + (unsigned)((ql ^ ((g << 2) | (w & 3))) * 8);
    const bf16_t* kbase = qkv + (size_t)(b * SEQ) * NQKV + 1024 + kv * 128;
#define WIN_ISSUE(c) do { const int _c = (c); const int _kb = min(max(nb - 1 + (_c % 3), 0), 127); const bf16_t* _src = kbase + (size_t)(_kb * 128) * NQKV + (_c >= 3 ? 256 : 0) + loff; \
        _Pragma("unroll") for (int _i = 0; _i < 4; ++_i) glds16_asm(_src + (size_t)(32 * _i) * NQKV, ldsb + (unsigned)((_c & 3) * 32768 + _i * 8192 + w * 1024)); } while (0)
    ATT_BAR();
    WIN_ISSUE(0); WIN_ISSUE(1); WIN_ISSUE(2);
    if (hpq != tab_head) { for (int i = tid; i < 2 * 257; i += 512) { const int hh = i >= 257, j = i - 257 * hh; bias[hh * 264 + j] = p.in[12][t5_bucket(j - 128) * 8 + hq0 + hh] * 1.4426950408889634f; } tab_head = hpq; }
    const int tq = b * SEQ + nb * 128 + 16 * w + ql;
    bf16x8 qf[2][4]; load_q(qkv + (size_t)tq * NQKV + hq0 * 128, g, qf[0]); load_q(qkv + (size_t)tq * NQKV + (hq0 + 1) * 128, g, qf[1]);
    float sink[2]; sink[0] = p.in[5][hq0] * 1.4426950408889634f; sink[1] = p.in[5][hq0 + 1] * 1.4426950408889634f; asm volatile("" : "+v"(sink[0]), "+v"(sink[1]));
    f32x4 S1[2][8], SC[2][9];
#pragma unroll
    for (int u = 0; u < 2; ++u) {
#pragma unroll
        for (int kt = 0; kt < 8; ++kt) S1[u][kt] = (f32x4){0.f, 0.f, 0.f, 0.f};
#pragma unroll
        for (int s = 0; s < 9; ++s) SC[u][s] = (f32x4){0.f, 0.f, 0.f, 0.f}; }
    const bool in0 = nb > 0, in2 = nb < 127;
#pragma unroll
    for (int c = 0; c < 3; ++c) {
        wait_vm(8); ATT_BAR(); WIN_ISSUE(c + 3);
        LAS unsigned char* buf = lds + (c & 3) * 32768;
#pragma unroll
        for (int kt = 0; kt < 8; ++kt) {
            const bool act = (c == 1) || (c == 0 ? kt >= w : kt <= w);
            if (act) {
#pragma unroll
                for (int ks = 0; ks < 4; ++ks) { const bf16x8 kf = *(const LAS bf16x8*)(buf + off_b(16 * kt + ql, 4 * ks + g));
#pragma unroll
                    for (int u = 0; u < 2; ++u) {
                        if (c == 1) S1[u][kt] = __builtin_amdgcn_mfma_f32_16x16x32_bf16(kf, qf[u][ks], S1[u][kt], 0, 0, 0);
                        else if (c == 0) SC[u][7 - kt] = __builtin_amdgcn_mfma_f32_16x16x32_bf16(kf, qf[u][ks], SC[u][7 - kt], 0, 0, 0);
                        else SC[u][8 - kt] = __builtin_amdgcn_mfma_f32_16x16x32_bf16(kf, qf[u][ks], SC[u][8 - kt], 0, 0, 0); } } }
        }
    }
    const int qi = 16 * w + ql; float inv[2];
    unsigned P1[2][4][4], PC[2][9][2];
#pragma unroll
    for (int u = 0; u < 2; ++u) { float mx = sink[u]; const LAS float* bt = bias + u * 264;
#pragma unroll
        for (int kt = 0; kt < 8; ++kt)
#pragma unroll
            for (int r = 0; r < 4; ++r) { const int rel = 16 * kt + 4 * g + r - qi; const float sv = S1[u][kt][r] + bt[rel + 128]; S1[u][kt][r] = sv; mx = fmaxf(mx, sv); }
#pragma unroll
        for (int s = 0; s < 9; ++s) { const bool c0 = s <= 7 - w; const int kt = c0 ? 7 - s : 8 - s; const int cofs = c0 ? -128 : 128; const bool inr = c0 ? in0 : in2;
#pragma unroll
            for (int r = 0; r < 4; ++r) { const int rel = cofs + 16 * kt + 4 * g + r - qi; const bool valid = inr && rel >= -128 && rel <= 128;
                const float bv = bt[rel + 128];
                const float sv = valid ? SC[u][s][r] + bv : -1e30f; SC[u][s][r] = sv; mx = fmaxf(mx, sv); } }
        mx = fmaxf(mx, __shfl_xor(mx, 16)); mx = fmaxf(mx, __shfl_xor(mx, 32));
        float l = 0.f;
#pragma unroll
        for (int kk = 0; kk < 4; ++kk) { float e[8];
#pragma unroll
            for (int r = 0; r < 4; ++r) { e[r] = __builtin_amdgcn_exp2f(S1[u][2 * kk][r] - mx); e[4 + r] = __builtin_amdgcn_exp2f(S1[u][2 * kk + 1][r] - mx); l += e[r] + e[4 + r]; }
            P1[u][kk][0] = pk2(e[0], e[1]); P1[u][kk][1] = pk2(e[2], e[3]); P1[u][kk][2] = pk2(e[4], e[5]); P1[u][kk][3] = pk2(e[6], e[7]); }
#pragma unroll
        for (int s = 0; s < 9; ++s) { float e[4];
#pragma unroll
            for (int r = 0; r < 4; ++r) { e[r] = __builtin_amdgcn_exp2f(SC[u][s][r] - mx); l += e[r]; }
            PC[u][s][0] = pk2(e[0], e[1]); PC[u][s][1] = pk2(e[2], e[3]); }
        l += __shfl_xor(l, 16); l += __shfl_xor(l, 32); l += __builtin_amdgcn_exp2f(sink[u] - mx);
        inv[u] = 1.0f / l; }
    f32x4 O[2][8];
#pragma unroll
    for (int u = 0; u < 2; ++u)
#pragma unroll
        for (int dt = 0; dt < 8; ++dt) O[u][dt] = (f32x4){0.f, 0.f, 0.f, 0.f};
    const int q4 = ql >> 2, pp = ql & 3;
#pragma unroll
    for (int c = 0; c < 3; ++c) {
        wait_vm(c == 0 ? 8 : (c == 1 ? 4 : 0)); ATT_BAR();
        LAS unsigned char* buf = lds + ((c + 3) & 3) * 32768;
#pragma unroll
        for (int kk = 0; kk < 4; ++kk) {
            bool a0, a1;
            if (c == 1) { a0 = true; a1 = true; } else if (c == 0) { a0 = 2 * kk >= w; a1 = 2 * kk + 1 >= w; } else { a0 = 2 * kk <= w; a1 = 2 * kk + 1 <= w; }
            if (a0 || a1) { bf16x8 pf[2];
#pragma unroll
                for (int u = 0; u < 2; ++u) { u32x4 pw;
                    if (c == 1) { pw.x = P1[u][kk][0]; pw.y = P1[u][kk][1]; pw.z = P1[u][kk][2]; pw.w = P1[u][kk][3]; }
                    else if (c == 0) { pw.x = a0 ? PC[u][7 - 2 * kk][0] : 0u; pw.y = a0 ? PC[u][7 - 2 * kk][1] : 0u; pw.z = a1 ? PC[u][6 - 2 * kk][0] : 0u; pw.w = a1 ? PC[u][6 - 2 * kk][1] : 0u; }
                    else { pw.x = a0 ? PC[u][8 - 2 * kk][0] : 0u; pw.y = a0 ? PC[u][8 - 2 * kk][1] : 0u; pw.z = a1 ? PC[u][7 - 2 * kk][0] : 0u; pw.w = a1 ? PC[u][7 - 2 * kk][1] : 0u; }
                    pf[u] = __builtin_bit_cast(bf16x8, pw); }
#pragma unroll
                for (int dt = 0; dt < 8; ++dt) { const bf16x8 vf = vt_frag(buf, 32 * kk, g, q4, pp, dt);
                    O[0][dt] = __builtin_amdgcn_mfma_f32_16x16x32_bf16(vf, pf[0], O[0][dt], 0, 0, 0); O[1][dt] = __builtin_amdgcn_mfma_f32_16x16x32_bf16(vf, pf[1], O[1][dt], 0, 0, 0); } } }
    }
#undef WIN_ISSUE
#pragma unroll
    for (int u = 0; u < 2; ++u) { bf16_t* op = o + (size_t)tq * D + (hq0 + u) * 128 + 4 * g;
#pragma unroll
        for (int dt = 0; dt < 8; ++dt) { u32x2 w2; w2.x = pk2(O[u][dt][0] * inv[u], O[u][dt][1] * inv[u]); w2.y = pk2(O[u][dt][2] * inv[u], O[u][dt][3] * inv[u]); *(u32x2*)(op + 16 * dt) = w2; } }
}

__device__ __forceinline__ void attn_nat_item(const Params& p, LAS unsigned char* lds, int item, int& tab_head) {
    const int tid = phase_tid(), lane = tid & 63, w = __builtin_amdgcn_readfirstlane(tid >> 6), g = lane >> 4, ql = lane & 15;
    const int b = item >> 9, rp = (item >> 2) & 127, hp = item & 3, hh = w >> 2, h = 2 * hp + hh, jq = w & 3;
    const int kr_lo = min(max(2 * rp - 4, 0), 248);
    const int d0 = min(max(2 * rp - 4, 0), 248) - kr_lo, d1 = min(max(2 * rp - 3, 0), 248) - kr_lo;
    const int w0 = jq == 0 ? 0 : (jq == 1 ? 8 : (jq == 2 ? 24 : 32));
    const bf16_t* qkv = (const bf16_t*)(p.ws + WS_QKV); bf16_t* o = (bf16_t*)(p.ws + WS_O);
    LAS float* rpb = (LAS float*)(lds + 131072); const unsigned ldsb = (unsigned)(size_t)lds;
    const unsigned loff = (unsigned)(w * 4 + g) * NQKV + (unsigned)((ql ^ ((g << 2) | (w & 3))) * 8);
    const bf16_t* kbase = qkv + (size_t)(b * SEQ) * NQKV + 2560 + 2 * hp * 128;
#define NAT_ISSUE(s) do { const int _s = (s); const int _kr = min(kr_lo + (_s % 9), 255); const bf16_t* _src = kbase + (size_t)(_kr * 64) * NQKV + (_s >= 9 ? 1024 : 0) + loff; \
        _Pragma("unroll") for (int _i = 0; _i < 4; ++_i) glds16_asm(_src + (size_t)(32 * (_i & 1)) * NQKV + 128 * (_i >> 1), ldsb + (unsigned)((_s & 3) * 32768 + _i * 8192 + w * 1024)); } while (0)
    ATT_BAR();
    NAT_ISSUE(0); NAT_ISSUE(1); NAT_ISSUE(2);
    if (hp != tab_head) { for (int i = tid; i < 930; i += 512) rpb[i] = p.in[8][2 * hp * 465 + i] * 1.4426950408889634f; tab_head = hp; }
    const int qcol = 16 * jq + ql; const int tq0 = b * SEQ + (2 * rp) * 64 + qcol;
    bf16x8 qf[2][4]; load_q(qkv + (size_t)tq0 * NQKV + 1536 + h * 128, g, qf[0]); load_q(qkv + (size_t)(tq0 + 64) * NQKV + 1536 + h * 128, g, qf[1]);
    f32x4 S[2][9][2];
#pragma unroll
    for (int u = 0; u < 2; ++u)
#pragma unroll
        for (int c = 0; c < 9; ++c) { S[u][c][0] = (f32x4){0.f, 0.f, 0.f, 0.f}; S[u][c][1] = (f32x4){0.f, 0.f, 0.f, 0.f}; }
#pragma unroll
    for (int c = 0; c < 9; ++c) {
        wait_vm(8); ATT_BAR(); NAT_ISSUE(c + 3);
        const bool a0 = c >= d0 && c < d0 + 8, a1 = c >= d1 && c < d1 + 8;
        LAS unsigned char* buf = lds + (c & 3) * 32768 + hh * 16384;
#pragma unroll
        for (int t = 0; t < 2; ++t)
#pragma unroll
            for (int ks = 0; ks < 4; ++ks) { const bf16x8 kf = *(const LAS bf16x8*)(buf + off_b(w0 + 16 * t + ql, 4 * ks + g));
                if (a0) S[0][c][t] = __builtin_amdgcn_mfma_f32_16x16x32_bf16(kf, qf[0][ks], S[0][c][t], 0, 0, 0);
                if (a1) S[1][c][t] = __builtin_amdgcn_mfma_f32_16x16x32_bf16(kf, qf[1][ks], S[1][c][t], 0, 0, 0); }
    }
    const int cs = min(max(qcol - 8, 0), 48); float inv[2];
    unsigned P[2][9][4];
    int dcv[2][4]; bool cv[2][4];
#pragma unroll
    for (int t = 0; t < 2; ++t)
#pragma unroll
        for (int q = 0; q < 4; ++q) { const int kc = w0 + 16 * t + 4 * g + q; cv[t][q] = kc >= cs && kc < cs + 16; dcv[t][q] = hh * 465 + kc - qcol + 15; }
#pragma unroll
    for (int u = 0; u < 2; ++u) { const int du = u ? d1 : d0; const int r = 2 * rp + u; float mx = -1e30f;
#pragma unroll
        for (int c = 0; c < 9; ++c) { const bool act = c >= du && c < du + 8;
            if (act) { const int rowb = (kr_lo + c - r + 7) * 31;
#pragma unroll
                for (int t = 0; t < 2; ++t)
#pragma unroll
                    for (int q = 0; q < 4; ++q) { const float sv = cv[t][q] ? S[u][c][t][q] + rpb[rowb + dcv[t][q]] : -1e30f; S[u][c][t][q] = sv; mx = fmaxf(mx, sv); } } }
        mx = fmaxf(mx, __shfl_xor(mx, 16)); mx = fmaxf(mx, __shfl_xor(mx, 32));
        float l = 0.f;
#pragma unroll
        for (int c = 0; c < 9; ++c) { const bool act = c >= du && c < du + 8;
            if (act) { float e[2][4];
#pragma unroll
                for (int t = 0; t < 2; ++t)
#pragma unroll
                    for (int q = 0; q < 4; ++q) { e[t][q] = __builtin_amdgcn_exp2f(S[u][c][t][q] - mx); l += e[t][q]; }
                P[u][c][0] = pk2(e[0][0], e[0][1]); P[u][c][1] = pk2(e[0][2], e[0][3]); P[u][c][2] = pk2(e[1][0], e[1][1]); P[u][c][3] = pk2(e[1][2], e[1][3]); }
            else { P[u][c][0] = 0u; P[u][c][1] = 0u; P[u][c][2] = 0u; P[u][c][3] = 0u; } }
        l += __shfl_xor(l, 16); l += __shfl_xor(l, 32);
        inv[u] = 1.0f / l; }
    f32x4 O[2][8];
#pragma unroll
    for (int u = 0; u < 2; ++u)
#pragma unroll
        for (int dt = 0; dt < 8; ++dt) O[u][dt] = (f32x4){0.f, 0.f, 0.f, 0.f};
    const int q4 = ql >> 2, pp = ql & 3;
#pragma unroll
    for (int c = 0; c < 9; ++c) {
        wait_vm(c <= 6 ? 8 : (c == 7 ? 4 : 0)); ATT_BAR(); if (c + 12 < 18) NAT_ISSUE(c + 12);
        const bool a0 = c >= d0 && c < d0 + 8, a1 = c >= d1 && c < d1 + 8;
        LAS unsigned char* buf = lds + ((c + 9) & 3) * 32768 + hh * 16384;
        u32x4 pw0; pw0.x = P[0][c][0]; pw0.y = P[0][c][1]; pw0.z = P[0][c][2]; pw0.w = P[0][c][3];
        u32x4 pw1; pw1.x = P[1][c][0]; pw1.y = P[1][c][1]; pw1.z = P[1][c][2]; pw1.w = P[1][c][3];
        const bf16x8 pf0 = __builtin_bit_cast(bf16x8, pw0), pf1 = __builtin_bit_cast(bf16x8, pw1);
#pragma unroll
        for (int dt = 0; dt < 8; ++dt) { const bf16x8 vf = vt_frag(buf, w0, g, q4, pp, dt);
            if (a0) O[0][dt] = __builtin_amdgcn_mfma_f32_16x16x32_bf16(vf, pf0, O[0][dt], 0, 0, 0);
            if (a1) O[1][dt] = __builtin_amdgcn_mfma_f32_16x16x32_bf16(vf, pf1, O[1][dt], 0, 0, 0); }
    }
#undef NAT_ISSUE
#pragma unroll
    for (int u = 0; u < 2; ++u) { bf16_t* op = o + (size_t)(tq0 + 64 * u) * D + 1024 + h * 128 + 4 * g;
#pragma unroll
        for (int dt = 0; dt < 8; ++dt) { u32x2 w2; w2.x = pk2(O[u][dt][0] * inv[u], O[u][dt][1] * inv[u]); w2.y = pk2(O[u][dt][2] * inv[u], O[u][dt][3] * inv[u]); *(u32x2*)(op + 16 * dt) = w2; } }
}
__device__ __forceinline__ void p2_attn(const Params& p, LAS unsigned char* lds) {
    int tab_head = -1, mb = 0;
    const int nper = (1024 + (int)gridDim.x - 1) / (int)gridDim.x;
    const int NB = (MOE_ITEMS + 8 * (int)gridDim.x - 1) / (8 * (int)gridDim.x);
    for (int s = 0; s < 2 * nper || mb < NB; ++s) {
        if (s < 2 * nper) {
            const bool nat = s >= nper; const int it = (int)blockIdx.x + (nat ? s - nper : s) * (int)gridDim.x;
            if (s == nper) { tab_head = -1;
#ifdef PROBE_A
                if (blockIdx.x == 0 && threadIdx.x == 0) ((unsigned long long*)(p.ws + WS_END))[11] = __builtin_amdgcn_s_memrealtime();
#endif
            }
            if (it < 1024) { if (!nat) attn_window_item(p, lds, it, tab_head); else attn_nat_item(p, lds, it, tab_head); }
        }
        if ((((s + (int)blockIdx.x) & 1) == 0 || s >= 2 * nper) && mb < NB) {
            ATT_BAR();
            for (int q = 0; q < 3 && mb < NB; ++q) moe_prep_batch(p, lds, mb++);
        }
    }
    asm volatile("s_waitcnt vmcnt(0)" ::: "memory"); __syncthreads();
}

struct UpHook { const bf16_t* gates;
    __device__ __forceinline__ void operator()(f32x4 (&acc)[2][2][4][2], const Unit& u, int wr, int wc, int fr, int fq) const {
        const unsigned goff = (unsigned)(u.pm * 256 + wr * 64 + fr) * NGATE + u.pn * 256 + wc * 32 + 8 * fq;
#pragma unroll
        for (int ai = 0; ai < 2; ++ai) {
            bf16x8 ra[4][2];
#pragma unroll
            for (int m = 0; m < 4; ++m)
#pragma unroll
                for (int bj = 0; bj < 2; ++bj) ra[m][bj] = *(const bf16x8*)(gates + goff + (unsigned)((ai * 128 + m * 16) * NGATE) + bj * 128);
#pragma unroll
            for (int m = 0; m < 4; ++m)
#pragma unroll
                for (int bj = 0; bj < 2; ++bj)
#pragma unroll
                    for (int n = 0; n < 2; ++n)
#pragma unroll
                        for (int j = 0; j < 4; ++j) acc[ai][bj][m][n][j] *= bf2f(ra[m][bj][4 * n + j]);
            asm volatile("" ::: "memory"); }
    } };
struct UpSched {
    pg8::TileOrder o; const bf16_t* A; const bf16_t* Bt;
    __device__ __forceinline__ bool next(int i, Unit& u) const { u.aux = i & 1; return o.tile(i >> 1, u.pm, u.pn); }
    __device__ __forceinline__ const char* a_base(const Unit& u) const { return (const char*)(A + (size_t)u.pm * 256 * D + u.aux * 1024); }
    __device__ __forceinline__ const char* b_base(const Unit& u) const { return (const char*)(Bt + (size_t)u.pn * 256 * D + u.aux * 1024); }
    __device__ __forceinline__ bool keep_acc(const Unit& u) const { return u.aux == 0; }
    __device__ __forceinline__ void a_offs(const Unit&, int, int, int, int, unsigned (&)[2][2]) const {}
};
struct EpiUp { const bf16_t* gates; bf16_t* merged;
    __device__ __forceinline__ void operator()(f32x4 (&acc)[2][2][4][2], const Unit& u, int wr, int wc, int fr, int fq) const {
        if (u.aux == 0) { UpHook{gates}(acc, u, wr, wc, fr, fq); return; }
        const unsigned goff = (unsigned)(u.pm * 256 + wr * 64 + fr) * NGATE + 2048 + u.pn * 256 + wc * 32 + 8 * fq;
        const unsigned moff = (unsigned)(u.pm * 256 + wr * 64 + fr) * D + u.pn * 256 + wc * 32 + 8 * fq;
#pragma unroll
        for (int ai = 0; ai < 2; ++ai) {
            bf16x8 sb[4][2];
#pragma unroll
            for (int m = 0; m < 4; ++m)
#pragma unroll
                for (int bj = 0; bj < 2; ++bj) sb[m][bj] = *(const bf16x8*)(gates + goff + (unsigned)((ai * 128 + m * 16) * NGATE) + bj * 128);
#pragma unroll
            for (int m = 0; m < 4; ++m)
#pragma unroll
                for (int bj = 0; bj < 2; ++bj) { f32x4 v0 = acc[ai][bj][m][0], v1 = acc[ai][bj][m][1];
#pragma unroll
                    for (int j = 0; j < 4; ++j) { v0[j] *= bf2f(sb[m][bj][j]); v1[j] *= bf2f(sb[m][bj][4 + j]); }
                    u32x4 w; w.x = pk2(v0[0], v0[1]); w.y = pk2(v0[2], v0[3]); w.z = pk2(v1[0], v1[1]); w.w = pk2(v1[2], v1[3]);
                    *(u32x4*)(merged + moff + (unsigned)((ai * 128 + m * 16) * D) + bj * 128) = w; }
            asm volatile("" ::: "memory"); }
    } };
__device__ __forceinline__ void p3_up(const Params& p, LAS unsigned char* lds) {
    UpSched S; S.o.init(128, 8, gridDim.x, blockIdx.x); S.A = (const bf16_t*)(p.ws + WS_O); S.Bt = (const bf16_t*)(p.ws + WS_WUP);
    EpiUp E{(const bf16_t*)(p.ws + WS_GATES), (bf16_t*)(p.ws + WS_MG)};
    pg8::gemm_phase<true, false>(lds, S, E, 1024 / 64, D, D);
}

struct EpiOut { const bf16_t* xb; bf16_t* hb; unsigned char* h8;
    __device__ __forceinline__ void operator()(f32x4 (&acc)[2][2][4][2], const Unit& u, int wr, int wc, int fr, int fq) const {
        unsigned off = (unsigned)(u.pm * 256 + wr * 64 + fr) * D + u.pn * 256 + wc * 32 + 8 * fq;
#pragma unroll
        for (int ai = 0; ai < 2; ++ai) {
            bf16x8 xr[4][2];
#pragma unroll
            for (int m = 0; m < 4; ++m)
#pragma unroll
                for (int bj = 0; bj < 2; ++bj) xr[m][bj] = *(const bf16x8*)(xb + off + (unsigned)(m * 16 * D) + bj * 128);
#pragma unroll
            for (int m = 0; m < 4; ++m) { asm volatile("" : "+v"(off));
#pragma unroll
                for (int bj = 0; bj < 2; ++bj) { const f32x4 v0 = acc[ai][bj][m][0], v1 = acc[ai][bj][m][1]; const u32x4 xw = __builtin_bit_cast(u32x4, xr[m][bj]);
                    const float h0 = v0[0] + __uint_as_float(xw.x << 16), h1 = v0[1] + __uint_as_float(xw.x & 0xffff0000u), h2 = v0[2] + __uint_as_float(xw.y << 16), h3 = v0[3] + __uint_as_float(xw.y & 0xffff0000u);
                    const float h4 = v1[0] + __uint_as_float(xw.z << 16), h5 = v1[1] + __uint_as_float(xw.z & 0xffff0000u), h6 = v1[2] + __uint_as_float(xw.w << 16), h7 = v1[3] + __uint_as_float(xw.w & 0xffff0000u);
                    u32x4 w; w.x = pk2(h0, h1); w.y = pk2(h2, h3); w.z = pk2(h4, h5); w.w = pk2(h6, h7);
                    *(u32x4*)(hb + off + bj * 128) = w;
                    u32x2 f; f.x = pk4_fp8(h0, h1, h2, h3); f.y = pk4_fp8(h4, h5, h6, h7);
                    *(u32x2*)(h8 + off + bj * 128) = f; }
                off += 16 * D; }
            off += 64 * D; }
    } };
__device__ __forceinline__ void p4_out(const Params& p, LAS unsigned char* lds) {
    pg8::DenseSched S; S.o.init(128, 8, gridDim.x, blockIdx.x); S.A = (const bf16_t*)(p.ws + WS_MG); S.Bt = (const bf16_t*)(p.ws + WS_WOUT); S.lda = D; S.ldb = D;
    EpiOut E{(const bf16_t*)(p.ws + WS_XB), (bf16_t*)(p.ws + WS_O), p.ws + WS_H8};
    pg8::gemm_phase<true, false, pg8::DenseSched, EpiOut, false, false>(lds, S, E, D / 64, D, D);
}

__device__ __forceinline__ void p5_router(const Params& p, LAS unsigned char* lds) {
    const int tid = phase_tid(), lane = tid & 63, wave = __builtin_amdgcn_readfirstlane(tid >> 6), g = lane >> 4, tl = lane & 15;
    const bf16_t* wsp = (const bf16_t*)(p.ws + WS_WRT); float* r2 = (float*)(p.ws + WS_R2); int* cnt = (int*)(p.ws + WS_CNT); int* tokl = (int*)(p.ws + WS_TOK);
    int* recc = (int*)(p.ws + WS_RECC); float* recw = (float*)(p.ws + WS_RECW); const bf16_t* hb = (const bf16_t*)(p.ws + WS_O);
    const float* brg = p.in[15]; const float* bre = p.in[17];
    LAS unsigned char* H = lds + wave * 2304;
    LAS unsigned char* WL = lds + 36864;
    const int r8 = lane >> 3, s8 = lane & 7;
    const int pa0 = tid / 384, pr0 = (tid % 384) >> 3, ps0 = tid & 7, pi1 = 512 + tid, pa1 = pi1 / 384, pr1 = (pi1 % 384) >> 3;
    const unsigned wsrc0 = (unsigned)(pa0 * 48 * 2048 + pr0 * D + ps0 * 8), wsrc1 = (unsigned)(pa1 * 48 * 2048 + pr1 * D + ps0 * 8);
    const unsigned wdst0 = (unsigned)(pa0 * 6144 + pr0 * 128 + ((ps0 ^ (pr0 & 7)) << 4)), wdst1 = (unsigned)(pa1 * 6144 + pr1 * 128 + ((ps0 ^ (pr1 & 7)) << 4));
    for (int round = blockIdx.x; round < T / 128; round += gridDim.x) {
        const int tile = round * 8 + wave;
        const bf16_t* hs = hb + (size_t)tile * 16 * D + r8 * D + s8 * 8;
        f32x4 accA = {0.f, 0.f, 0.f, 0.f}, accB = accA, accC = accA; float ss = 0.f;
        u32x4 hq0[2], hq1[2], hq2[2], hq3[2], wr0, wr1;
#define RT_LOADS(bq, k) do { bq[0] = *(const u32x4*)(hs + 64 * (k)); bq[1] = *(const u32x4*)(hs + 8 * D + 64 * (k)); } while (0)
#define RT_COMP(bq, wbuf) do { \
            *(LAS u32x4*)(H + r8 * 144 + s8 * 16) = bq[0]; *(LAS u32x4*)(H + (r8 + 8) * 144 + s8 * 16) = bq[1]; \
            _Pragma("unroll") for (int ks = 0; ks < 2; ++ks) { const u32x4 hw = *(const LAS u32x4*)(H + tl * 144 + 64 * ks + 16 * g); \
                { const float a0 = __uint_as_float(hw.x << 16), a1 = __uint_as_float(hw.x & 0xffff0000u), a2 = __uint_as_float(hw.y << 16), a3 = __uint_as_float(hw.y & 0xffff0000u); \
                  const float a4 = __uint_as_float(hw.z << 16), a5 = __uint_as_float(hw.z & 0xffff0000u), a6 = __uint_as_float(hw.w << 16), a7 = __uint_as_float(hw.w & 0xffff0000u); \
                  ss += (a0 * a0 + a1 * a1) + (a2 * a2 + a3 * a3) + (a4 * a4 + a5 * a5) + (a6 * a6 + a7 * a7); } \
                const bf16x8 bh = __builtin_bit_cast(bf16x8, hw); const unsigned so_ = (unsigned)(((4 * ks + g) ^ (tl & 7)) << 4); \
                _Pragma("unroll") for (int t = 0; t < 3; ++t) { const bf16x8 ah = *(const LAS bf16x8*)((wbuf) + (16 * t + tl) * 128 + so_), al = *(const LAS bf16x8*)((wbuf) + 6144 + (16 * t + tl) * 128 + so_); \
                    f32x4& ac = (t == 0 ? accA : (t == 1 ? accB : accC)); \
                    ac = __builtin_amdgcn_mfma_f32_16x16x32_bf16(ah, bh, ac, 0, 0, 0); ac = __builtin_amdgcn_mfma_f32_16x16x32_bf16(al, bh, ac, 0, 0, 0); } } } while (0)
#define RT_WLOAD(c) do { wr0 = *(const u32x4*)(wsp + wsrc0 + 64 * (c)); if (tid < 256) wr1 = *(const u32x4*)(wsp + wsrc1 + 64 * (c)); } while (0)
#define RT_WSTORE(wbuf) do { *(LAS u32x4*)((wbuf) + wdst0) = wr0; if (tid < 256) *(LAS u32x4*)((wbuf) + wdst1) = wr1; } while (0)
        __syncthreads();
        RT_WLOAD(0); RT_LOADS(hq0, 0); RT_LOADS(hq1, 1); RT_LOADS(hq2, 2);
        RT_WSTORE(WL); RT_WLOAD(1);
        __syncthreads();
#pragma unroll 1
        for (int c = 0; c < D / 64; c += 4) {
            RT_LOADS(hq3, (c + 3));      RT_COMP(hq0, WL);         RT_WSTORE(WL + 12288); RT_WLOAD((c + 2) & 31); __syncthreads();
            RT_LOADS(hq0, (c + 4) & 31); RT_COMP(hq1, WL + 12288); RT_WSTORE(WL);         RT_WLOAD((c + 3) & 31); __syncthreads();
            RT_LOADS(hq1, (c + 5) & 31); RT_COMP(hq2, WL);         RT_WSTORE(WL + 12288); RT_WLOAD((c + 4) & 31); __syncthreads();
            RT_LOADS(hq2, (c + 6) & 31); RT_COMP(hq3, WL + 12288); RT_WSTORE(WL);         RT_WLOAD((c + 5) & 31); __syncthreads();
        }
#undef RT_LOADS
#undef RT_COMP
#undef RT_WLOAD
#undef RT_WSTORE
        const int tok = tile * 16 + tl;
        ss += __shfl_xor(ss, 16); ss += __shfl_xor(ss, 32);
        const float rr = rsqrtf(ss * (1.0f / D) + EPS);
        const float myg = accC[0] * rr + brg[g];
        float gl[4];
#pragma unroll
        for (int j = 0; j < 4; ++j) gl[j] = __shfl(myg, tl + 16 * j);
        int gi = 0; float gm = gl[0];
#pragma unroll
        for (int i = 1; i < 4; ++i) if (gl[i] > gm) { gm = gl[i]; gi = i; }
        float den = 0.f;
#pragma unroll
        for (int i = 0; i < 4; ++i) den += __expf(gl[i] - gm);
        const float pg = 1.0f / den;
        int L0 = 0, L1 = 0; float wt0 = 0.f, wt1 = 0.f; const bool owner = (g == gi);
        if (owner) {
            float el[8];
#pragma unroll
            for (int i = 0; i < 4; ++i) { el[i] = accA[i] * rr + bre[g * 8 + i]; el[4 + i] = accB[i] * rr + bre[g * 8 + 4 + i]; }
            int e0 = 0; float v0 = el[0];
#pragma unroll
            for (int i = 1; i < 8; ++i) if (el[i] > v0) { v0 = el[i]; e0 = i; }
            int e1 = -1; float v1 = -3.0e38f;
#pragma unroll
            for (int i = 0; i < 8; ++i) if (i != e0 && el[i] > v1) { v1 = el[i]; e1 = i; }
            const float ex = __expf(v1 - v0); const float s0 = 1.0f / (1.0f + ex), s1 = ex * s0;
            r2[tok] = rr; L0 = gi * 8 + e0; L1 = gi * 8 + e1; wt0 = pg * s0; wt1 = pg * s1;
        }
        LAS int* cl = (LAS int*)(lds + 61440);
        if (tid < 32) cl[tid] = 0;
        __syncthreads();
        int q0 = 0, q1 = 0;
        if (owner) { q0 = __hip_atomic_fetch_add(&cl[L0], 1, __ATOMIC_RELAXED, __HIP_MEMORY_SCOPE_WORKGROUP); q1 = __hip_atomic_fetch_add(&cl[L1], 1, __ATOMIC_RELAXED, __HIP_MEMORY_SCOPE_WORKGROUP); }
        __syncthreads();
        if (tid < 32) { const int n = cl[tid]; cl[32 + tid] = n ? atomicAdd(&cnt[tid], n) : 0; }
        __syncthreads();
        if (owner) { const int p0 = cl[32 + L0] + q0, p1 = cl[32 + L1] + q1;
            float* r2l = (float*)(p.ws + WS_R2L);
            tokl[(size_t)L0 * T + p0] = tok; r2l[(size_t)L0 * T + p0] = rr; recc[2 * tok] = L0 * 32768 + p0; recw[2 * tok] = wt0;
            tokl[(size_t)L1 * T + p1] = tok; r2l[(size_t)L1 * T + p1] = rr; recc[2 * tok + 1] = L1 * 32768 + p1; recw[2 * tok + 1] = wt1; }
    }
    __syncthreads();
}

__device__ __forceinline__ void build_tiles(const Params& p, LAS int* tab) {
    __syncthreads();
    if (threadIdx.x < 64) { const int L = threadIdx.x; const int c = L < 32 ? ((const int*)(p.ws + WS_CNT))[L] : 0; const int nt = (c + 255) >> 8;
        int pre = nt;
#pragma unroll
        for (int o = 1; o < 32; o <<= 1) { const int v = __shfl_up(pre, o); if (L >= o) pre += v; }
        const int first = pre - nt;
        if (L < 32) { tab[1400 + L] = first * 256; for (int i = 0; i < nt; ++i) { tab[4 + (first + i) * 4 + 0] = L; tab[4 + (first + i) * 4 + 1] = i * 256; tab[4 + (first + i) * 4 + 2] = (first + i) * 256; tab[4 + (first + i) * 4 + 3] = min(256, c - i * 256); } }
        if (L == 31) tab[0] = pre; }
    __syncthreads();
}
template <int NPN> struct MoeOrder { int G, c, t_lo, nt_tiles; const LAS int* tab;
    __device__ __forceinline__ bool unit(int i, Unit& u) const { const long L = (long)i * G + c; if (L >= (long)nt_tiles * NPN) return false;
        const int nwg = nt_tiles * NPN; int wgid = (int)L; { const int q = nwg / 8, r = nwg % 8, xcd = wgid % 8, off = wgid / 8; wgid = (xcd < r ? xcd * (q + 1) : r * (q + 1) + (xcd - r) * q) + off; }
        u.pm = t_lo + wgid / NPN; u.pn = wgid % NPN; u.aux = 0; return true; } };
struct GateUpSched { MoeOrder<4> o; const unsigned char* hb; const unsigned char* WguT; const int* tokl;
    __device__ __forceinline__ bool next(int i, Unit& u) const { return o.unit(i, u); }
    __device__ __forceinline__ const char* a_base(const Unit&) const { return (const char*)hb; }
    __device__ __forceinline__ const char* b_base(const Unit& u) const { const int e = o.tab[4 + u.pm * 4] & 31; return (const char*)(WguT + (size_t)(e * 1024 + u.pn * 256) * D); }
    __device__ __forceinline__ bool keep_acc(const Unit&) const { return false; }
    __device__ __forceinline__ void a_offs(const Unit& u, int R0, int C0, int R1, int C1, unsigned (&v)[2][2]) const {
        const int L = o.tab[4 + u.pm * 4], row0 = o.tab[4 + u.pm * 4 + 1], nrows = o.tab[4 + u.pm * 4 + 3]; const int* lst = tokl + (size_t)L * T + row0;
#pragma unroll
        for (int h = 0; h < 2; ++h) { const int r0 = R0 + 128 * h, r1 = R1 + 128 * h; const int t0 = r0 < nrows ? lst[r0] : 0, t1 = r1 < nrows ? lst[r1] : 0;
            v[h][0] = (unsigned)t0 * D + C0 * 2u; v[h][1] = (unsigned)t1 * D + C1 * 2u; } }
};
struct EpiGateUp { const LAS int* tab; const float* r2l; bf16_t* he;
    __device__ __forceinline__ void operator()(f32x4 (&acc)[2][2][4][2], const Unit& u, int wr, int wc, int fr, int fq) const {
        const int L = tab[4 + u.pm * 4], row0 = tab[4 + u.pm * 4 + 1], slot = tab[4 + u.pm * 4 + 2], nrows = tab[4 + u.pm * 4 + 3];
#pragma unroll
        for (int ai = 0; ai < 2; ++ai)
#pragma unroll
            for (int m = 0; m < 4; ++m) { const int rr = ai * 128 + wr * 64 + m * 16 + fr; const float rs = rr < nrows ? r2l[(size_t)L * T + row0 + rr] * (1.0f / 64.0f) : 0.f;
                u32x4 w; unsigned ww[4];
#pragma unroll
                for (int n = 0; n < 2; ++n) { float hv[4];
#pragma unroll
                    for (int j = 0; j < 4; ++j) { const float gt = acc[ai][0][m][n][j] * rs, up = acc[ai][1][m][n][j] * rs; hv[j] = gt * sigmoidf_(gt) * up; }
                    ww[2 * n] = pk2(hv[0], hv[1]); ww[2 * n + 1] = pk2(hv[2], hv[3]); }
                w.x = ww[0]; w.y = ww[1]; w.z = ww[2]; w.w = ww[3];
                *(u32x4*)(he + (size_t)(slot + rr) * 512 + u.pn * 128 + wc * 32 + 8 * fq) = w; }
    } };
__device__ __forceinline__ void p6_gateup(const Params& p, LAS unsigned char* lds) {
    LAS int* tab = (LAS int*)(lds + TAB_OFF); build_tiles(p, tab);
    GateUpSched S; S.o.G = gridDim.x; S.o.c = blockIdx.x; S.o.t_lo = 0; S.o.nt_tiles = tab[0]; S.o.tab = tab;
    S.hb = p.ws + WS_H8; S.WguT = p.ws + WS_WGU; S.tokl = (const int*)(p.ws + WS_TOK);
    EpiGateUp E{tab, (const float*)(p.ws + WS_R2L), (bf16_t*)(p.ws + WS_HE)};
    pg8::gemm_phase<true, true, GateUpSched, EpiGateUp, true>(lds, S, E, D / 128, D / 2, D / 2);
}
struct DownSched { MoeOrder<8> o; const bf16_t* he; const bf16_t* WdT;
    __device__ __forceinline__ bool next(int i, Unit& u) const { return o.unit(i, u); }
    __device__ __forceinline__ const char* a_base(const Unit& u) const { return (const char*)(he + (size_t)o.tab[4 + u.pm * 4 + 2] * 512); }
    __device__ __forceinline__ const char* b_base(const Unit& u) const { const int e = o.tab[4 + u.pm * 4] & 31; return (const char*)(WdT + (size_t)(e * 2048 + u.pn * 256) * 512); }
    __device__ __forceinline__ bool keep_acc(const Unit&) const { return false; }
    __device__ __forceinline__ void a_offs(const Unit&, int, int, int, int, unsigned (&)[2][2]) const {}
};
struct EpiDown { const LAS int* tab; unsigned char* ye;
    __device__ __forceinline__ void operator()(f32x4 (&acc)[2][2][4][2], const Unit& u, int wr, int wc, int fr, int fq) const {
        const int slot = tab[4 + u.pm * 4 + 2];
        unsigned off = (unsigned)(slot + wr * 64 + fr) * 2048 + u.pn * 256 + wc * 32 + 8 * fq;
#pragma unroll
        for (int ai = 0; ai < 2; ++ai) {
#pragma unroll
            for (int m = 0; m < 4; ++m) { asm volatile("" : "+v"(off));
#pragma unroll
                for (int bj = 0; bj < 2; ++bj) { const f32x4 v0 = acc[ai][bj][m][0] * 16.f, v1 = acc[ai][bj][m][1] * 16.f;
                    u32x2 w; w.x = pk4_fp8(v0[0], v0[1], v0[2], v0[3]); w.y = pk4_fp8(v1[0], v1[1], v1[2], v1[3]);
                    *(u32x2*)(ye + off + bj * 128) = w; }
                off += 16 * 2048; }
            off += 64 * 2048; }
    } };
__device__ __forceinline__ void p7_down(const Params& p, LAS unsigned char* lds) {
    LAS int* tab = (LAS int*)(lds + TAB_OFF); build_tiles(p, tab);
    DownSched S; S.o.G = gridDim.x; S.o.c = blockIdx.x; S.o.t_lo = 0; S.o.nt_tiles = tab[0]; S.o.tab = tab;
    S.he = (const bf16_t*)(p.ws + WS_HE); S.WdT = (const bf16_t*)(p.ws + WS_WD);
    EpiDown E{tab, p.ws + WS_YE};
    pg8::gemm_phase<true, false, DownSched, EpiDown, false, false>(lds, S, E, 512 / 64, 512, 512);
}
__device__ __forceinline__ void p8_combine(const Params& p, LAS unsigned char* lds) {
    LAS int* tab = (LAS int*)(lds + TAB_OFF); build_tiles(p, tab);
    const int tid = phase_tid(), lane = tid & 63, wave = tid >> 6; const int gw = blockIdx.x * 8 + wave, NGW = gridDim.x * 8;
    const int* recc = (const int*)(p.ws + WS_RECC); const float* recw = (const float*)(p.ws + WS_RECW); const bf16_t* hb = (const bf16_t*)(p.ws + WS_O);
    const unsigned char* ye = p.ws + WS_YE;
    for (int tok = gw; tok < T; tok += NGW) {
        const int c0 = recc[2 * tok], c1 = recc[2 * tok + 1]; const float wa = recw[2 * tok] * 0.0625f, wb = recw[2 * tok + 1] * 0.0625f;
        const int s0 = tab[1400 + (c0 >> 15)] + (c0 & 32767), s1 = tab[1400 + (c1 >> 15)] + (c1 & 32767);
        f32x4* op = (f32x4*)(p.out + (size_t)tok * D) + lane; const u32x2* hp = (const u32x2*)(hb + (size_t)tok * D) + lane;
        const unsigned* ya = (const unsigned*)(ye + (size_t)s0 * 2048) + lane; const unsigned* yb = (const unsigned*)(ye + (size_t)s1 * 2048) + lane;
        u32x2 m[8]; unsigned a[8], b[8];
#pragma unroll
        for (int j = 0; j < 8; ++j) { m[j] = hp[64 * j]; a[j] = ya[64 * j]; b[j] = yb[64 * j]; }
#pragma unroll
        for (int j = 0; j < 8; ++j) { f32x4 v;
            const f32x2 a0 = __builtin_amdgcn_cvt_pk_f32_fp8(a[j], false), a1 = __builtin_amdgcn_cvt_pk_f32_fp8(a[j], true), b0 = __builtin_amdgcn_cvt_pk_f32_fp8(b[j], false), b1 = __builtin_amdgcn_cvt_pk_f32_fp8(b[j], true);
            v.x = __uint_as_float(m[j].x << 16) + wa * a0.x + wb * b0.x; v.y = __uint_as_float(m[j].x & 0xffff0000u) + wa * a0.y + wb * b0.y;
            v.z = __uint_as_float(m[j].y << 16) + wa * a1.x + wb * b1.x; v.w = __uint_as_float(m[j].y & 0xffff0000u) + wa * a1.y + wb * b1.y;
            op[64 * j] = v; }
    }
}

#define XB_TMO      128
#define XB_XCNT(j)  (256  + 64 * (j))
#define XB_XSUB(j)  (1280 + 64 * (j))
#define XB_XGEN(j)  (2304 + 64 * (j))
#define XB_TOP      3328
#define XB_TOPGEN   3392
#define XCD_BAR_WORDS 3456
#define XB_SPIN_CAP (1u << 18)
__device__ __forceinline__ unsigned xb_ld(unsigned* p)              { return __hip_atomic_load(p, __ATOMIC_RELAXED, __HIP_MEMORY_SCOPE_AGENT); }
__device__ __forceinline__ unsigned xb_add(unsigned* p, unsigned v) { return __hip_atomic_fetch_add(p, v, __ATOMIC_RELAXED, __HIP_MEMORY_SCOPE_AGENT); }
__device__ __forceinline__ unsigned xb_xcc_id() { return (unsigned)__builtin_amdgcn_s_getreg((3 << 11) | 20) & 0xFu; }
#define XB_SPIN(cond, bar) do { unsigned _sp = 0; while (cond) { __builtin_amdgcn_s_sleep(1); \
    if ((++_sp & 255u) == 0u) { if (xb_ld(&(bar)[XB_TMO])) break; if (_sp > XB_SPIN_CAP) { atomicAdd(&(bar)[XB_TMO], 1u); break; } } } } while (0)
struct XcdBarrier { unsigned* bar; unsigned x; volatile LAS unsigned* st; };
__device__ __forceinline__ XcdBarrier xcd_barrier_post(unsigned* bar, volatile LAS unsigned* st) {
    XcdBarrier b; b.bar = bar; b.x = xb_xcc_id(); b.st = st;
    if (threadIdx.x == 0) (void)xb_add(&bar[XB_XCNT(b.x)], 1u);
    return b;
}
__device__ __forceinline__ void xcd_barrier_complete(unsigned* bar, unsigned x, unsigned& nloc, unsigned& nx) {
    const unsigned G = gridDim.x * gridDim.y * gridDim.z;
    unsigned sum, cnt, mine, sp = 0u;
    for (;;) {
        sum = 0u; cnt = 0u; mine = 0u;
#pragma unroll
        for (unsigned j = 0; j < 16; ++j) { const unsigned c = xb_ld(&bar[XB_XCNT(j)]); sum += c; cnt += (c > 0u) ? 1u : 0u; mine = (j == x) ? c : mine; }
        if (sum == G) break;
        __builtin_amdgcn_s_sleep(1);
        if ((++sp & 255u) == 0u) { if (xb_ld(&bar[XB_TMO])) break; if (sp > XB_SPIN_CAP) { atomicAdd(&bar[XB_TMO], 1u); break; } }
    }
    nloc = mine > 0u ? mine : 1u; nx = cnt > 0u ? cnt : 1u;
}
__device__ __forceinline__ void xcd_barrier(const XcdBarrier& b) {
    asm volatile("s_waitcnt vmcnt(0)" ::: "memory");
    __syncthreads();
    if (threadIdx.x == 0) {
        unsigned* bar = b.bar;
        __builtin_amdgcn_s_waitcnt(0);
        unsigned nloc = b.st[0], nx = b.st[1];
        if (nloc == 0u) { xcd_barrier_complete(bar, b.x, nloc, nx); b.st[0] = nloc; b.st[1] = nx; }
        const unsigned old = xb_add(&bar[XB_XSUB(b.x)], 1u);
        const unsigned gen = old / nloc;
        if (old + 1u == (gen + 1u) * nloc) {
            __builtin_amdgcn_fence(__ATOMIC_RELEASE, "agent");
            asm volatile("s_waitcnt vmcnt(0)" ::: "memory");
            const unsigned og = xb_add(&bar[XB_TOP], 1u);
            const unsigned tg = og / nx;
            if (og + 1u == (tg + 1u) * nx) xb_add(&bar[XB_TOPGEN], 1u);
            else XB_SPIN(xb_ld(&bar[XB_TOPGEN]) == tg, bar);
            __builtin_amdgcn_fence(__ATOMIC_ACQUIRE, "agent");
            xb_add(&bar[XB_XGEN(b.x)], 1u);
            asm volatile("s_waitcnt vmcnt(0)" ::: "memory");
        } else {
            XB_SPIN(xb_ld(&bar[XB_XGEN(b.x)]) == gen, bar);
            __builtin_amdgcn_fence(__ATOMIC_ACQUIRE, "agent");
            asm volatile("s_waitcnt vmcnt(0)" ::: "memory");
        }
    }
    __syncthreads();
}

namespace cg = cooperative_groups;
#ifdef PROBE_A
#define STAMP(k) do { if (blockIdx.x == 0 && threadIdx.x == 0) ((unsigned long long*)(p.ws + WS_END))[k] = __builtin_amdgcn_s_memrealtime(); } while (0)
#else
#define STAMP(k) do {} while (0)
#endif
__global__ void __launch_bounds__(512, 2) fwd_megakernel(Params p) {
    extern __shared__ __attribute__((aligned(16))) unsigned char lds_raw[];
    LAS unsigned char* lds = (LAS unsigned char*)lds_raw;
    cg::grid_group grid = cg::this_grid();
    if (threadIdx.x == 0) { *(volatile LAS unsigned*)(lds + XBST_OFF) = 0u; *(volatile LAS unsigned*)(lds + XBST_OFF + 4) = 0u; }
    if (blockIdx.x == 0) for (int i = threadIdx.x; i < XCD_BAR_WORDS; i += 512) ((unsigned*)(p.ws + WS_BAR))[i] = 0u;
    __syncthreads();
#define GSYNC() xcd_barrier(xb)
    STAMP(0);
    p0_prep(p, lds);            grid.sync(); STAMP(1);
    const XcdBarrier xb = xcd_barrier_post((unsigned*)(p.ws + WS_BAR), (volatile LAS unsigned*)(lds + XBST_OFF));
    p1_inproj(p, lds);          GSYNC(); STAMP(2);
    p2_attn(p, lds);            GSYNC(); STAMP(3);
    STAMP(4);
    p3_up(p, lds);              GSYNC(); STAMP(5);
    p4_out(p, lds);             GSYNC(); STAMP(6);
    p5_router(p, lds);          GSYNC(); STAMP(7);
    p6_gateup(p, lds);          GSYNC(); STAMP(8);
    p7_down(p, lds);            GSYNC(); STAMP(9);
    p8_combine(p, lds);
#ifdef PROBE_A
    grid.sync(); STAMP(10); grid.sync();
    {
        const unsigned long long* ts = (const unsigned long long*)(p.ws + WS_END);
        #ifndef PROBE_A1
#define PROBE_A1 (PROBE_A + 1)
#endif
#ifndef PROBE_B1
#define PROBE_B1 (PROBE_B + 1)
#endif
        const float usA = (float)(ts[PROBE_A1] - ts[PROBE_A]) * 0.01f, usB = (float)(ts[PROBE_B1] - ts[PROBE_B]) * 0.01f;
        const float eps = sqrtf(usA * 1e-6f);
        for (size_t i = (size_t)blockIdx.x * 512 + threadIdx.x; i < (size_t)T * D / 4; i += (size_t)gridDim.x * 512) { f32x4 v = ((f32x4*)p.out)[i]; v = v * (1.0f + eps); if (i == 0) v.x += usB * 0.1f; ((f32x4*)p.out)[i] = v; }
    }
#endif
}

extern "C" void kernel_launch(void* const* d_in, const int* in_sizes, int n_in, void* d_out, int out_size, void* d_ws, size_t ws_size, hipStream_t stream) {
    static int grid_blocks = 0;
    if (!grid_blocks) {
        if (n_in != 21 || out_size != T * D || ws_size < WS_TOP) { fprintf(stderr, "kernel_launch: unexpected problem (n_in %d out %d ws %zu)\n", n_in, out_size, ws_size); grid_blocks = -1; return; }
        if (hipFuncSetAttribute((const void*)fwd_megakernel, hipFuncAttributeMaxDynamicSharedMemorySize, LDS_BYTES) != hipSuccess) { fprintf(stderr, "kernel_launch: hipFuncSetAttribute failed\n"); grid_blocks = -1; return; }
        int dev = 0, cus = 0, per_cu = 0;
        hipGetDevice(&dev); hipDeviceGetAttribute(&cus, hipDeviceAttributeMultiprocessorCount, dev);
        hipOccupancyMaxActiveBlocksPerMultiprocessor(&per_cu, (const void*)fwd_megakernel, 512, LDS_BYTES);
        if (per_cu < 1 || cus < 1) { fprintf(stderr, "kernel_launch: occupancy query gave %d blocks/CU on %d CUs\n", per_cu, cus); grid_blocks = -1; return; }
        grid_blocks = cus;
    }
    if (grid_blocks < 0) return;
    Params p{};
    for (int i = 0; i < 21; ++i) p.in[i] = (const float*)d_in[i];
    p.out = (float*)d_out; p.ws = (unsigned char*)d_ws;
    void* args[] = {&p};
    hipError_t e = hipLaunchCooperativeKernel((const void*)fwd_megakernel, dim3(grid_blocks), dim3(512), args, LDS_BYTES, stream);
    if (e != hipSuccess) fprintf(stderr, "cooperative launch failed: %s (grid %d)\n", hipGetErrorString(e), grid_blocks);
}
```

```cpp
#include <hip/hip_runtime.h>
#include <hip/hip_cooperative_groups.h>
#include <cstdio>
#include <cstdint>

#define LAS __attribute__((address_space(3)))
typedef unsigned short bf16_t;
typedef short bf16x8 __attribute__((ext_vector_type(8)));
typedef short s16x4 __attribute__((ext_vector_type(4)));
typedef float f32x4 __attribute__((ext_vector_type(4)));
typedef unsigned u32x4 __attribute__((ext_vector_type(4)));
typedef unsigned u32x2 __attribute__((ext_vector_type(2)));
typedef short v4i16_t __attribute__((ext_vector_type(4)));

namespace cfg {
constexpr int T = 32768, D = 2048, SEQ = 16384;
constexpr int NQKV = 4608, NGATE = 4096, NIN = 8704;
constexpr size_t MiB = 1ull << 20;
constexpr size_t WS_XB = 0, WS_QKV = 128 * MiB, WS_GATES = 416 * MiB, WS_O = 672 * MiB, WS_WIN = 800 * MiB, WS_WUP = 834 * MiB, WS_WOUT = 842 * MiB, WS_MISC = 850 * MiB;
constexpr size_t WS_WGU = 872 * MiB, WS_WD = 936 * MiB, WS_MG = WS_QKV, WS_HE = WS_QKV + 192 * MiB;
constexpr size_t WS_R1 = WS_MISC, WS_R2 = WS_R1 + (size_t)T * 4, WS_WRT = WS_R2 + (size_t)T * 4, WS_CNT = WS_WRT + 512 * 1024, WS_TOK = WS_CNT + 4096,
                 WS_RECC = WS_TOK + 32ull * T * 4, WS_RECW = WS_RECC + 2ull * T * 4, WS_R2L = WS_RECW + 2ull * T * 4, WS_END = WS_R2L + 32ull * T * 4;
constexpr size_t WS_H8 = WS_GATES + 144 * MiB;
constexpr size_t WS_YE = WS_QKV;
constexpr size_t WS_BAR = WS_END + 4096;
constexpr size_t WS_X8 = 872 * MiB;
constexpr size_t WS_TOP = 1000 * MiB;
constexpr int LDS_BYTES = 140 * 1024;
constexpr int XBST_OFF = LDS_BYTES - 16;
constexpr int TAB_OFF = 132 * 1024;
constexpr float EPS = 1e-6f;
}
using namespace cfg;

struct Params { const float* in[21]; float* out; unsigned char* ws; };
__device__ __forceinline__ int phase_tid() { int t = threadIdx.x; asm volatile("" : "+v"(t)); return t; }

__device__ __forceinline__ float bf2f(short s) { return __uint_as_float(((unsigned)(unsigned short)s) << 16); }
typedef float f32x2 __attribute__((ext_vector_type(2)));
typedef __bf16 bf16x2_t __attribute__((ext_vector_type(2)));
__device__ __forceinline__ unsigned pk2(float lo, float hi) { const f32x2 v = {lo, hi}; return __builtin_bit_cast(unsigned, __builtin_convertvector(v, bf16x2_t)); }
__device__ __forceinline__ unsigned pk4_fp8(float a, float b, float c, float d) { int w = 0; w = __builtin_amdgcn_cvt_pk_fp8_f32(a, b, w, false); w = __builtin_amdgcn_cvt_pk_fp8_f32(c, d, w, true); return (unsigned)w; }
__device__ __forceinline__ float wave_sum(float v) {
#pragma unroll
    for (int o = 1; o < 64; o <<= 1) v += __shfl_xor(v, o);
    return v;
}
__device__ __forceinline__ float sigmoidf_(float v) { return 1.0f / (1.0f + __expf(-v)); }
__device__ __forceinline__ unsigned off_b(unsigned row, unsigned ch) { return 256u * row + 16u * (ch ^ (((row & 3) << 2) | ((row >> 2) & 3))); }
__device__ __forceinline__ s16x4 tr_read(LAS unsigned char* p) { return __builtin_bit_cast(s16x4, __builtin_amdgcn_ds_read_tr16_b64_v4i16((LAS v4i16_t*)p)); }
__host__ __device__ __forceinline__ int perm32(int rho) { const int n = rho >> 4, i = rho & 15; return 8 * (i >> 2) + 4 * n + (i & 3); }
__device__ __forceinline__ int t5_bucket(int rel) {
    const int n = rel < 0 ? -rel : rel; const int ret = rel > 0 ? 16 : 0; int b;
    if (n < 8) b = n; else if (n < 12) b = 8; else if (n < 16) b = 9; else if (n < 23) b = 10; else if (n < 32) b = 11; else if (n < 46) b = 12; else if (n < 64) b = 13; else if (n < 91) b = 14; else b = 15;
    return ret + b;
}

template <bool FP8>
__device__ __forceinline__ void transpose_item(const float* __restrict__ W, int ldw, int k0, int n0, bf16_t* __restrict__ WT, int ldt, int drow0, int dk0, const float* __restrict__ scale, LAS unsigned* scr, int lane, float f8scale = 1.f) {
    const int n4 = (lane & 15) * 4, kk = lane >> 4;
    const float* src = W + (size_t)(k0 + 2 * kk) * ldw + n0 + n4;
    f32x4 ev[8], od[8];
#pragma unroll
    for (int j = 0; j < 8; ++j) { ev[j] = *(const f32x4*)(src + (size_t)(8 * j) * ldw); od[j] = *(const f32x4*)(src + (size_t)(8 * j + 1) * ldw); }
#pragma unroll
    for (int j = 0; j < 8; ++j) { f32x4 e = ev[j], o = od[j];
        if (scale) { const float se = scale[k0 + 8 * j + 2 * kk], so = scale[k0 + 8 * j + 2 * kk + 1]; e = e * se; o = o * so; }
        u32x4 w; w.x = pk2(e.x, o.x); w.y = pk2(e.y, o.y); w.z = pk2(e.z, o.z); w.w = pk2(e.w, o.w);
        *(LAS u32x4*)(scr + (4 * j + kk) * 68 + n4) = w; }
    asm volatile("s_waitcnt lgkmcnt(0)" ::: "memory");
    const int kq = lane & 7;
#pragma unroll
    for (int i = 0; i < 8; ++i) { const int n = (lane >> 3) + 8 * i; const LAS unsigned* q = scr + (4 * kq) * 68 + n;
        u32x4 o; o.x = q[0]; o.y = q[68]; o.z = q[136]; o.w = q[204];
        if (FP8) { u32x2 f; f.x = pk4_fp8(__uint_as_float(o.x << 16) * f8scale, __uint_as_float(o.x & 0xffff0000u) * f8scale, __uint_as_float(o.y << 16) * f8scale, __uint_as_float(o.y & 0xffff0000u) * f8scale);
            f.y = pk4_fp8(__uint_as_float(o.z << 16) * f8scale, __uint_as_float(o.z & 0xffff0000u) * f8scale, __uint_as_float(o.w << 16) * f8scale, __uint_as_float(o.w & 0xffff0000u) * f8scale);
            *(u32x2*)((unsigned char*)WT + (size_t)(drow0 + n) * ldt + dk0 + k0 + 8 * kq) = f; }
        else *(u32x4*)(WT + (size_t)(drow0 + n) * ldt + dk0 + k0 + 8 * kq) = o; }
    asm volatile("s_waitcnt lgkmcnt(0)" ::: "memory");
}

__device__ __forceinline__ void p0_prep(const Params& p, LAS unsigned char* lds) {
    const int tid = phase_tid(), lane = tid & 63, wave = tid >> 6;
    const int gw = blockIdx.x * 8 + wave, NGW = gridDim.x * 8;
    LAS unsigned* scr = (LAS unsigned*)(lds + wave * 8704);
    const float* x = p.in[0]; const float* g1 = p.in[1]; const float* w_in = p.in[2];
    bf16_t* xb = (bf16_t*)(p.ws + WS_XB); float* r1 = (float*)(p.ws + WS_R1);
    bf16_t* WinT = (bf16_t*)(p.ws + WS_WIN); bf16_t* WupT = (bf16_t*)(p.ws + WS_WUP); bf16_t* WoutT = (bf16_t*)(p.ws + WS_WOUT);
    constexpr int I_WIN = 32 * 136, I_UP = 16 * 32, I_OUT = 32 * 32, NITEMS = I_WIN + 2 * I_UP + I_OUT;
    for (int it = gw; it < NITEMS; it += NGW) {
        int r = it;
        if (r < I_WIN) { const int kb = r / 136, nb = r % 136; const int n0 = nb * 64;
            int drow = n0;
            if (n0 >= NQKV) { const int c = (n0 - NQKV) & 2047, isb = (n0 - NQKV) >> 11; drow = NQKV + (c >> 7) * 256 + isb * 128 + (c & 127); }
            transpose_item<true>(w_in, NIN, kb * 64, n0, WinT, 2048, drow, 0, g1, scr, lane, 64.f); continue; } r -= I_WIN;
        if (r < I_UP) { const int kb = r / 32, nb = r % 32; transpose_item<false>(p.in[9], 2048, kb * 64, nb * 64, WupT, 2048, nb * 64, 0, nullptr, scr, lane); continue; } r -= I_UP;
        if (r < I_UP) { const int kb = r / 32, nb = r % 32; transpose_item<false>(p.in[10], 2048, kb * 64, nb * 64, WupT, 2048, nb * 64, 1024, nullptr, scr, lane); continue; } r -= I_UP;
        { const int kb = r / 32, nb = r % 32; transpose_item<false>(p.in[11], 2048, kb * 64, nb * 64, WoutT, 2048, nb * 64, 0, nullptr, scr, lane); }
    }
    { bf16_t* whi = (bf16_t*)(p.ws + WS_WRT); bf16_t* wlo = whi + 48 * 2048; const float* g2 = p.in[13]; const float* wrg = p.in[14]; const float* wre = p.in[16];
      for (int i = blockIdx.x * 512 + tid; i < 48 * 2048; i += gridDim.x * 512) { const int row = i >> 11, k = i & 2047, t = row >> 4, r = row & 15; float w;
          if (t == 0) w = wre[k * 32 + (r >> 2) * 8 + (r & 3)]; else if (t == 1) w = wre[k * 32 + (r >> 2) * 8 + 4 + (r & 3)]; else w = (r & 3) == 0 ? wrg[k * 4 + (r >> 2)] : 0.f;
          w *= g2[k]; const unsigned hi = pk2(w, 0.f) & 0xffffu; const float hf = __uint_as_float(hi << 16); whi[i] = (bf16_t)hi; wlo[i] = (bf16_t)(pk2(w - hf, 0.f) & 0xffffu); } }
    if (blockIdx.x == 0 && tid < 32) ((int*)(p.ws + WS_CNT))[tid] = 0;
    for (int row0 = 2 * gw; row0 < T; row0 += 2 * NGW) {
        f32x4 v[2][8]; float ss[2] = {0.f, 0.f};
#pragma unroll
        for (int u = 0; u < 2; ++u) { const f32x4* xr = (const f32x4*)(x + (size_t)(row0 + u) * D) + lane;
#pragma unroll
            for (int j = 0; j < 8; ++j) v[u][j] = xr[64 * j]; }
#pragma unroll
        for (int u = 0; u < 2; ++u) {
#pragma unroll
            for (int j = 0; j < 8; ++j) ss[u] += (v[u][j].x * v[u][j].x + v[u][j].y * v[u][j].y) + (v[u][j].z * v[u][j].z + v[u][j].w * v[u][j].w);
            ss[u] = wave_sum(ss[u]);
            if (lane == 0) r1[row0 + u] = rsqrtf(ss[u] * (1.0f / D) + EPS);
            u32x2* o = (u32x2*)(xb + (size_t)(row0 + u) * D) + lane; unsigned* o8 = (unsigned*)(p.ws + WS_X8 + (size_t)(row0 + u) * D) + lane;
#pragma unroll
            for (int j = 0; j < 8; ++j) { u32x2 w; w.x = pk2(v[u][j].x, v[u][j].y); w.y = pk2(v[u][j].z, v[u][j].w); o[64 * j] = w; o8[64 * j] = pk4_fp8(v[u][j].x, v[u][j].y, v[u][j].z, v[u][j].w); } }
    }
}

constexpr int MOE_ITEMS = 2 * 32 * 32 * 8 + 32 * 8 * 32;
__device__ __forceinline__ void moe_prep_batch(const Params& p, LAS unsigned char* lds, int bi) {
    const int tid = phase_tid(), lane = tid & 63, wave = tid >> 6;
    LAS unsigned* scr = (LAS unsigned*)(lds + wave * 8704);
    const float* g2 = p.in[13];
    bf16_t* WguT = (bf16_t*)(p.ws + WS_WGU); bf16_t* WdT = (bf16_t*)(p.ws + WS_WD);
    constexpr int I_G = 32 * 32 * 8;
    int r = (bi * (int)gridDim.x + (int)blockIdx.x) * 8 + wave;
    if (r >= MOE_ITEMS) return;
    if (r < 2 * I_G) { const int which = r >= I_G; if (which) r -= I_G; const int e = r / 256, rr = r % 256, kb = rr / 8, nb = rr % 8;
        const float* W = p.in[which ? 19 : 18] + (size_t)e * 2048 * 512; const int n0 = nb * 64;
        transpose_item<true>(W, 512, kb * 64, n0, WguT, 2048, e * 1024 + (n0 >> 7) * 256 + which * 128 + (n0 & 127), 0, g2, scr, lane, 64.f); return; }
    r -= 2 * I_G;
    { const int e = r / 256, rr = r % 256, kb = rr / 32, nb = rr % 32; const float* W = p.in[20] + (size_t)e * 512 * 2048;
      transpose_item<false>(W, 2048, kb * 64, nb * 64, WdT, 512, e * 2048 + nb * 64, 0, nullptr, scr, lane); }
}

struct Unit { int pm, pn, aux; };
namespace pg8 {
constexpr int BM = 256, BK = 64, HALF = 128, HTB = HALF * BK * 2, STAGE_BYTES = 8 * HTB;
__device__ __forceinline__ int lds_byte(int r, int c) { const int st = (r >> 4) * 2 + (c >> 5), rr = r & 15, cc = c & 31, ob = rr * 64 + cc * 2; return st * 1024 + (ob ^ (((ob >> 9) & 1) << 5)); }
__device__ __forceinline__ void stage_rc(int b, int& R, int& C) { const int st = b / 1024, sb = b % 1024, swz = sb ^ (((sb >> 9) & 1) << 5); R = (st >> 1) * 16 + swz / 64; C = (st & 1) * 32 + (swz % 64) / 2; }

template <bool PERM, bool GATHER, class Sched, class Epi, bool FP8 = false, bool ALIGN_EPI = true>
__device__ __forceinline__ void gemm_phase(LAS unsigned char* lds, const Sched& S, const Epi& E, const int nt, const int lda, const int ldb) {
    int tid_ = threadIdx.x; asm volatile("" : "+v"(tid_));
    const int tid = tid_, wid = __builtin_amdgcn_readfirstlane(tid >> 6), lane = tid & 63, wr = wid >> 2, wc = wid & 3, fr = lane & 15, fq = lane >> 4;
    int R0, C0, R1, C1; stage_rc(tid * 16, R0, C0); stage_rc(tid * 16 + 8192, R1, C1);
    unsigned voffB[2], voffA[2][2];
    { const int Rb0 = PERM ? ((R0 & ~31) + perm32(R0 & 31)) : R0, Rb1 = PERM ? ((R1 & ~31) + perm32(R1 & 31)) : R1;
      voffB[0] = (unsigned)(Rb0 * ldb + C0) * 2u; voffB[1] = (unsigned)(Rb1 * ldb + C1) * 2u; }
    const size_t kstep = (size_t)(BK * 2);
    const size_t hstepB = (size_t)HALF * ldb * 2, hstepA = (size_t)HALF * lda * 2;
    const unsigned ldsw = (unsigned)wid * 1024u;
    const int aoff = lds_byte(wr * 64 + fr, fq * 8), boff = lds_byte(wc * 32 + fr, fq * 8);
#define PG8_SA(b, h) (((b) * 2 + (h)) * HTB)
#define PG8_SB(b, h) ((4 + (b) * 2 + (h)) * HTB)
#define PG8_STAGE_B(bufoff, gbase) do { _Pragma("unroll") for (int _i = 0; _i < 2; ++_i) \
        __builtin_amdgcn_global_load_lds((const unsigned*)((const char*)(gbase) + voffB[_i]), (LAS unsigned*)(lds + (bufoff) + ldsw + _i * 8192), 16, 0, 0); } while (0)
#define PG8_STAGE_A(bufoff, gbase, h) do { _Pragma("unroll") for (int _i = 0; _i < 2; ++_i) \
        __builtin_amdgcn_global_load_lds((const unsigned*)((const char*)(gbase) + (GATHER ? (size_t)0 : (size_t)(h) * hstepA) + voffA[GATHER ? (h) : 0][_i]), (LAS unsigned*)(lds + (bufoff) + ldsw + _i * 8192), 16, 0, 0); } while (0)
#define PG8_LDA(dst, b, h) do { _Pragma("unroll") for (int m = 0; m < 4; ++m) _Pragma("unroll") for (int k = 0; k < 2; ++k) dst[m][k] = *(const LAS bf16x8*)(lds + PG8_SA(b, h) + aoff + m * 2048 + k * 1024); } while (0)
#define PG8_LDB(dst, b, h) do { _Pragma("unroll") for (int n = 0; n < 2; ++n) _Pragma("unroll") for (int k = 0; k < 2; ++k) dst[n][k] = *(const LAS bf16x8*)(lds + PG8_SB(b, h) + boff + n * 2048 + k * 1024); } while (0)
#define PG8_MMA(ai, bj, At, Bt) do { __builtin_amdgcn_s_setprio(1); _Pragma("unroll") for (int m = 0; m < 4; ++m) _Pragma("unroll") for (int n = 0; n < 2; ++n) { \
        if (FP8) { typedef int v8i_ __attribute__((ext_vector_type(8))); typedef int v4i_ __attribute__((ext_vector_type(4))); \
            const v4i_ b0_ = __builtin_bit_cast(v4i_, Bt[n][0]), b1_ = __builtin_bit_cast(v4i_, Bt[n][1]), a0_ = __builtin_bit_cast(v4i_, At[m][0]), a1_ = __builtin_bit_cast(v4i_, At[m][1]); \
            const v8i_ bb_ = {b0_[0], b0_[1], b0_[2], b0_[3], b1_[0], b1_[1], b1_[2], b1_[3]}, aa_ = {a0_[0], a0_[1], a0_[2], a0_[3], a1_[0], a1_[1], a1_[2], a1_[3]}; \
            acc[ai][bj][m][n] = __builtin_amdgcn_mfma_scale_f32_16x16x128_f8f6f4(bb_, aa_, acc[ai][bj][m][n], 0, 0, 0, 0x7f7f7f7f, 0, 0x7f7f7f7f); } \
        else { _Pragma("unroll") for (int k = 0; k < 2; ++k) acc[ai][bj][m][n] = __builtin_amdgcn_mfma_f32_16x16x32_bf16(Bt[n][k], At[m][k], acc[ai][bj][m][n], 0, 0, 0); } } \
        __builtin_amdgcn_s_setprio(0); } while (0)
#define PG8_WAIT_V(n) asm volatile("s_waitcnt vmcnt(" #n ")" ::: "memory")
#define PG8_WAIT_L(n) asm volatile("s_waitcnt lgkmcnt(" #n ")" ::: "memory")
#define PG8_BAR __builtin_amdgcn_s_barrier()
#define PG8_SCHED __builtin_amdgcn_sched_barrier(0)
    Unit cur, nxt; int ui = 0;
    __syncthreads();
    if (!S.next(0, cur)) return;
    if (GATHER) S.a_offs(cur, R0, C0, R1, C1, voffA);
    else { voffA[0][0] = (unsigned)(R0 * lda + C0) * 2u; voffA[0][1] = (unsigned)(R1 * lda + C1) * 2u; voffA[1][0] = 0; voffA[1][1] = 0; }
    f32x4 acc[2][2][4][2];
#pragma unroll
    for (int a = 0; a < 2; ++a)
#pragma unroll
        for (int b = 0; b < 2; ++b)
#pragma unroll
            for (int m = 0; m < 4; ++m)
#pragma unroll
                for (int n = 0; n < 2; ++n) acc[a][b][m][n] = (f32x4){0.f, 0.f, 0.f, 0.f};
    bf16x8 At[4][2], B0[2][2], B1[2][2];
    const char* cA = S.a_base(cur); const char* cB = S.b_base(cur);
    PG8_STAGE_B(PG8_SB(0, 0), cB); PG8_STAGE_B(PG8_SB(0, 1), cB + hstepB); PG8_STAGE_A(PG8_SA(0, 0), cA, 0); PG8_STAGE_A(PG8_SA(0, 1), cA, 1);
    if (wr == 1) PG8_BAR;
    PG8_WAIT_V(2); PG8_BAR;
    PG8_STAGE_B(PG8_SB(1, 0), cB + kstep); PG8_STAGE_A(PG8_SA(1, 0), cA + kstep, 0); PG8_STAGE_B(PG8_SB(1, 1), cB + hstepB + kstep);
    PG8_WAIT_V(6); PG8_BAR;
    for (;;) {
        const bool has_next = S.next(ui + 1, nxt);
        const char* nA = has_next ? S.a_base(nxt) : cA; const char* nB = has_next ? S.b_base(nxt) : cB;
        unsigned vn[2][2];
        if (GATHER) { if (has_next) S.a_offs(nxt, R0, C0, R1, C1, vn); else { vn[0][0] = voffA[0][0]; vn[0][1] = voffA[0][1]; vn[1][0] = voffA[1][0]; vn[1][1] = voffA[1][1]; } }
        for (int t = 0; t < nt; t += 2) {
            const bool last = (t == nt - 2);
            const char* a1 = cA + (size_t)(t + 1) * kstep;
            const char* a2 = last ? nA : cA + (size_t)(t + 2) * kstep; const char* b2 = last ? nB : cB + (size_t)(t + 2) * kstep;
            const char* a3 = a2 + kstep; const char* b3 = b2 + kstep;
            PG8_LDB(B0, 0, 0); PG8_LDB(B1, 0, 1); PG8_SCHED; PG8_LDA(At, 0, 0); PG8_STAGE_A(PG8_SA(1, 1), a1, 1);
            if (GATHER) { if (last) { voffA[0][0] = vn[0][0]; voffA[0][1] = vn[0][1]; voffA[1][0] = vn[1][0]; voffA[1][1] = vn[1][1]; } }
            PG8_WAIT_V(8); PG8_WAIT_L(0); PG8_BAR; PG8_MMA(0, 0, At, B0); PG8_MMA(0, 1, At, B1); PG8_BAR; PG8_SCHED;
            PG8_LDA(At, 0, 1); PG8_STAGE_B(PG8_SB(0, 0), b2); PG8_STAGE_B(PG8_SB(0, 1), b2 + hstepB); PG8_STAGE_A(PG8_SA(0, 0), a2, 0);
            PG8_WAIT_V(8); PG8_WAIT_L(0); PG8_BAR; PG8_MMA(1, 0, At, B0); PG8_MMA(1, 1, At, B1); PG8_BAR; PG8_SCHED;
            PG8_LDB(B0, 1, 0); PG8_LDB(B1, 1, 1); PG8_SCHED; PG8_LDA(At, 1, 0); PG8_STAGE_A(PG8_SA(0, 1), a2, 1);
            PG8_WAIT_V(8); PG8_WAIT_L(0); PG8_BAR; PG8_MMA(0, 0, At, B0); PG8_MMA(0, 1, At, B1); PG8_BAR; PG8_SCHED;
            PG8_LDA(At, 1, 1); PG8_STAGE_B(PG8_SB(1, 0), b3); PG8_STAGE_B(PG8_SB(1, 1), b3 + hstepB); PG8_STAGE_A(PG8_SA(1, 0), a3, 0);
            PG8_WAIT_V(8); PG8_WAIT_L(0); PG8_BAR; PG8_MMA(1, 0, At, B0); PG8_MMA(1, 1, At, B1); PG8_BAR; PG8_SCHED;
        }
        if (ALIGN_EPI) { if (wr == 0) PG8_BAR; }
        { int te = threadIdx.x; asm volatile("" : "+v"(te)); E(acc, cur, wr, wc, te & 15, (te & 63) >> 4); }
        if (!has_next) break;
        if (!S.keep_acc(cur)) {
#pragma unroll
        for (int a = 0; a < 2; ++a)
#pragma unroll
            for (int b = 0; b < 2; ++b)
#pragma unroll
                for (int m = 0; m < 4; ++m)
#pragma unroll
                    for (int n = 0; n < 2; ++n) acc[a][b][m][n] = (f32x4){0.f, 0.f, 0.f, 0.f};
        }
        cur = nxt; cA = nA; cB = nB; ++ui;
        if (ALIGN_EPI) { if (wr == 1) PG8_BAR; }
    }
    PG8_WAIT_V(0);
    if (!ALIGN_EPI) { if (wr == 0) PG8_BAR; }
    PG8_BAR;
#undef PG8_SA
#undef PG8_SB
#undef PG8_STAGE_A
#undef PG8_STAGE_B
#undef PG8_LDA
#undef PG8_LDB
#undef PG8_MMA
#undef PG8_WAIT_V
#undef PG8_WAIT_L
#undef PG8_BAR
#undef PG8_SCHED
}
struct TileOrder {
    int nM, nN, nwg, G, c;
    __device__ __forceinline__ void init(int nM_, int nN_, int G_, int c_) { nM = nM_; nN = nN_; nwg = nM * nN; G = G_; c = c_; }
    __device__ __forceinline__ bool tile(int i, int& pm, int& pn) const {
        const long L = (long)i * G + c; if (L >= nwg) return false;
        int wgid = (int)L; { const int q = nwg / 8, r = nwg % 8, xcd = wgid % 8, off = wgid / 8; wgid = (xcd < r ? xcd * (q + 1) : r * (q + 1) + (xcd - r) * q) + off; }
        const int nig = 8 * nN, gid = wgid / nig, fm = gid * 8, gsz = (nM - fm) < 8 ? (nM - fm) : 8;
        pm = fm + ((wgid % nig) % gsz); pn = (wgid % nig) / gsz; return true;
    }
};
struct DenseSched {
    TileOrder o; const bf16_t* A; const bf16_t* Bt; int lda, ldb;
    __device__ __forceinline__ bool next(int i, Unit& u) const { u.aux = 0; return o.tile(i, u.pm, u.pn); }
    __device__ __forceinline__ const char* a_base(const Unit& u) const { return (const char*)(A + (size_t)u.pm * 256 * lda); }
    __device__ __forceinline__ const char* b_base(const Unit& u) const { return (const char*)(Bt + (size_t)u.pn * 256 * ldb); }
    __device__ __forceinline__ bool keep_acc(const Unit&) const { return false; }
    __device__ __forceinline__ void a_offs(const Unit&, int, int, int, int, unsigned (&)[2][2]) const {}
};
}

struct EpiInProj { bf16_t* qkv; const float* r1; const float* gqa; const float* gka; const float* gqb; const float* gkb; LAS float* X;
    __device__ __forceinline__ void operator()(f32x4 (&acc)[2][2][4][2], const Unit& u, int wr, int wc, int fr, int fq) const {
        const int pn = u.pn;
        bf16_t* base = qkv; const int ldc = NQKV; const int colt = pn * 256 + wc * 32 + 8 * fq;
        const float* gain = pn < 4 ? gqa : (pn == 4 ? gka : ((pn >= 6 && pn < 10) ? gqb : ((pn >= 10 && pn < 14) ? gkb : nullptr)));
        if (gain) {
            const float extra = (pn < 4 || (pn >= 6 && pn < 10)) ? 0.08838834764831845f * 1.4426950408889634f : 1.0f;
#pragma unroll
            for (int ai = 0; ai < 2; ++ai)
#pragma unroll
                for (int m = 0; m < 4; ++m)
#pragma unroll
                    for (int bj = 0; bj < 2; ++bj) { const f32x4 a0 = acc[ai][bj][m][0], a1 = acc[ai][bj][m][1];
                        float sq = (a0[0] * a0[0] + a0[1] * a0[1]) + (a0[2] * a0[2] + a0[3] * a0[3]) + (a1[0] * a1[0] + a1[1] * a1[1]) + (a1[2] * a1[2] + a1[3] * a1[3]);
                        sq += __shfl_xor(sq, 16); sq += __shfl_xor(sq, 32);
                        if (fq == 0) X[(ai * 128 + wr * 64 + m * 16 + fr) * 8 + bj * 4 + wc] = sq; }
            asm volatile("s_waitcnt lgkmcnt(0)" ::: "memory"); __builtin_amdgcn_s_barrier(); asm volatile("" ::: "memory");
            const f32x4 g0 = *(const f32x4*)(gain + wc * 32 + 8 * fq), g1 = *(const f32x4*)(gain + wc * 32 + 8 * fq + 4);
#pragma unroll
            for (int ai = 0; ai < 2; ++ai)
#pragma unroll
                for (int m = 0; m < 4; ++m) { const int rl = ai * 128 + wr * 64 + m * 16 + fr; const int row = u.pm * 256 + rl; const float rs = r1[row] * (1.0f / 64.0f); bf16_t* rowp = base + (size_t)row * ldc + colt;
#pragma unroll
                    for (int bj = 0; bj < 2; ++bj) { const f32x4 t = *(const LAS f32x4*)(X + rl * 8 + bj * 4); const float tot = (t[0] + t[1]) + (t[2] + t[3]);
                        const float sc = rs * rsqrtf(rs * rs * tot * (1.0f / 128.0f) + EPS) * extra;
                        const f32x4 v0 = acc[ai][bj][m][0] * sc * g0, v1 = acc[ai][bj][m][1] * sc * g1;
                        u32x4 w; w.x = pk2(v0[0], v0[1]); w.y = pk2(v0[2], v0[3]); w.z = pk2(v1[0], v1[1]); w.w = pk2(v1[2], v1[3]);
                        *(u32x4*)(rowp + bj * 128) = w; } }
            return;
        }
#pragma unroll
        for (int ai = 0; ai < 2; ++ai)
#pragma unroll
            for (int m = 0; m < 4; ++m) { const int row = u.pm * 256 + ai * 128 + wr * 64 + m * 16 + fr; const float rs = r1[row] * (1.0f / 64.0f); bf16_t* rowp = base + (size_t)row * ldc + colt;
#pragma unroll
                for (int bj = 0; bj < 2; ++bj) { const f32x4 v0 = acc[ai][bj][m][0] * rs, v1 = acc[ai][bj][m][1] * rs;
                    u32x4 w; w.x = pk2(v0[0], v0[1]); w.y = pk2(v0[2], v0[3]); w.z = pk2(v1[0], v1[1]); w.w = pk2(v1[2], v1[3]);
                    *(u32x4*)(rowp + bj * 128) = w; } }
    } };
struct GateSched { pg8::TileOrder o; const unsigned char* x8; const unsigned char* W8;
    __device__ __forceinline__ bool next(int i, Unit& u) const { u.aux = 0; return o.tile(i, u.pm, u.pn); }
    __device__ __forceinline__ const char* a_base(const Unit&) const { return (const char*)x8; }
    __device__ __forceinline__ const char* b_base(const Unit& u) const { return (const char*)(W8 + (size_t)(u.pn * 256) * D); }
    __device__ __forceinline__ bool keep_acc(const Unit&) const { return false; }
    __device__ __forceinline__ void a_offs(const Unit& u, int R0, int C0, int R1, int C1, unsigned (&v)[2][2]) const {
#pragma unroll
        for (int h = 0; h < 2; ++h) { v[h][0] = (unsigned)(u.pm * 256 + 128 * h + R0) * D + C0 * 2u; v[h][1] = (unsigned)(u.pm * 256 + 128 * h + R1) * D + C1 * 2u; } }
};
struct EpiGates { bf16_t* gates; const float* r1;
    __device__ __forceinline__ void operator()(f32x4 (&acc)[2][2][4][2], const Unit& u, int wr, int wc, int fr, int fq) const {
        const int cg = u.pn * 128 + wc * 32 + 8 * fq;
#pragma unroll
        for (int ai = 0; ai < 2; ++ai)
#pragma unroll
            for (int m = 0; m < 4; ++m) { const int row = u.pm * 256 + ai * 128 + wr * 64 + m * 16 + fr; const float rs = r1[row] * (1.0f / 64.0f); bf16_t* rowp = gates + (size_t)row * NGATE + cg;
                float ra[8], sb[8];
#pragma unroll
                for (int n = 0; n < 2; ++n)
#pragma unroll
                    for (int j = 0; j < 4; ++j) { const float ea = __expf(-acc[ai][0][m][n][j] * rs), eb = fminf(__expf(-acc[ai][1][m][n][j] * rs), 1e30f);
                        sb[4 * n + j] = __builtin_amdgcn_rcpf(1.0f + eb); ra[4 * n + j] = (1.0f + eb) * __builtin_amdgcn_rcpf(1.0f + ea); }
                u32x4 w; w.x = pk2(ra[0], ra[1]); w.y = pk2(ra[2], ra[3]); w.z = pk2(ra[4], ra[5]); w.w = pk2(ra[6], ra[7]); *(u32x4*)rowp = w;
                w.x = pk2(sb[0], sb[1]); w.y = pk2(sb[2], sb[3]); w.z = pk2(sb[4], sb[5]); w.w = pk2(sb[6], sb[7]); *(u32x4*)(rowp + 2048) = w; }
    } };
__device__ __forceinline__ void p1_inproj(const Params& p, LAS unsigned char* lds) {
    { GateSched S; S.o.init(128, 18, gridDim.x, blockIdx.x); S.x8 = p.ws + WS_X8; S.W8 = p.ws + WS_WIN;
      EpiInProj E{(bf16_t*)(p.ws + WS_QKV), (const float*)(p.ws + WS_R1), p.in[3], p.in[4], p.in[6], p.in[7], (LAS float*)(lds + 131072)};
      pg8::gemm_phase<true, true, GateSched, EpiInProj, true>(lds, S, E, D / 128, D / 2, D / 2); }
    { GateSched S; S.o.init(128, 16, gridDim.x, blockIdx.x); S.x8 = p.ws + WS_X8; S.W8 = p.ws + WS_WIN + (size_t)NQKV * D;
      EpiGates E{(bf16_t*)(p.ws + WS_GATES), (const float*)(p.ws + WS_R1)};
      pg8::gemm_phase<true, true, GateSched, EpiGates, true>(lds, S, E, D / 128, D / 2, D / 2); }
}

__device__ __forceinline__ void wait_vm(int n) {
    switch (n) { case 0: asm volatile("s_waitcnt vmcnt(0)" ::: "memory"); break; case 2: asm volatile("s_waitcnt vmcnt(2)" ::: "memory"); break; case 4: asm volatile("s_waitcnt vmcnt(4)" ::: "memory"); break;
                 case 6: asm volatile("s_waitcnt vmcnt(6)" ::: "memory"); break; case 8: asm volatile("s_waitcnt vmcnt(8)" ::: "memory"); break; case 10: asm volatile("s_waitcnt vmcnt(10)" ::: "memory"); break;
                 default: asm volatile("s_waitcnt vmcnt(12)" ::: "memory"); break; }
}
__device__ __forceinline__ void glds16_asm(const void* gsrc, unsigned lds_dst) {
    unsigned keep;
    asm volatile("s_mov_b32 %0, m0\n\ts_mov_b32 m0, %2\n\ts_nop 0\n\tglobal_load_lds_dwordx4 %1, off\n\ts_mov_b32 m0, %0" : "=&s"(keep) : "v"(gsrc), "s"(lds_dst) : "memory");
}
#define ATT_BAR() do { asm volatile("s_waitcnt lgkmcnt(0)" ::: "memory"); __builtin_amdgcn_s_barrier(); asm volatile("" ::: "memory"); } while (0)
__device__ __forceinline__ void load_q(const bf16_t* qp, int g, bf16x8 (&qf)[4]) {
#pragma unroll
    for (int ks = 0; ks < 4; ++ks) qf[ks] = *(const bf16x8*)(qp + 32 * ks + 8 * g);
#pragma unroll
    for (int ks = 0; ks < 4; ++ks) asm volatile("" : "+v"(qf[ks]));
}
__device__ __forceinline__ bf16x8 vt_frag(LAS unsigned char* base, int row0, int g, int q4, int pp, int dt) {
    const s16x4 lo = tr_read(base + off_b(row0 + 4 * g + q4, 2 * dt + (pp >> 1)) + 8 * (pp & 1)), hi = tr_read(base + off_b(row0 + 16 + 4 * g + q4, 2 * dt + (pp >> 1)) + 8 * (pp & 1));
    bf16x8 vf; vf[0] = lo[0]; vf[1] = lo[1]; vf[2] = lo[2]; vf[3] = lo[3]; vf[4] = hi[0]; vf[5] = hi[1]; vf[6] = hi[2]; vf[7] = hi[3]; return vf;
}

__device__ __forceinline__ void attn_window_item(const Params& p, LAS unsigned char* lds, int item, int& tab_head) {
    const int tid = phase_tid(), lane = tid & 63, w = __builtin_amdgcn_readfirstlane(tid >> 6), g = lane >> 4, ql = lane & 15;
    const int b = item >> 9, nb = (item >> 2) & 127, hpq = item & 3, kv = hpq >> 1, hq0 = 2 * hpq;
    const bf16_t* qkv = (const bf16_t*)(p.ws + WS_QKV); bf16_t* o = (bf16_t*)(p.ws + WS_O);
    LAS float* bias = (LAS float*)(lds + 131072); const unsigned ldsb = (unsigned)(size_t)lds;
    const unsigned loff = (unsigned)(w * 4 + g) * NQKV + (unsigned)((ql ^ ((g << 2) | (w & 3))) * 8);
    const bf16_t* kbase = qkv + (size_t)(b * SEQ) * NQKV + 1024 + kv * 128;
#define WIN_ISSUE(c) do { const int _c = (c); const int _kb = min(max(nb - 1 + (_c % 3), 0), 127); const bf16_t* _src = kbase + (size_t)(_kb * 128) * NQKV + (_c >= 3 ? 256 : 0) + loff; \
        _Pragma("unroll") for (int _i = 0; _i < 4; ++_i) glds16_asm(_src + (size_t)(32 * _i) * NQKV, ldsb + (unsigned)((_c & 3) * 32768 + _i * 8192 + w * 1024)); } while (0)
    ATT_BAR();
    WIN_ISSUE(0); WIN_ISSUE(1); WIN_ISSUE(2);
    if (hpq != tab_head) { for (int i = tid; i < 2 * 257; i += 512) { const int hh = i >= 257, j = i - 257 * hh; bias[hh * 264 + j] = p.in[12][t5_bucket(j - 128) * 8 + hq0 + hh] * 1.4426950408889634f; } tab_head = hpq; }
    const int tq = b * SEQ + nb * 128 + 16 * w + ql;
    bf16x8 qf[2][4]; load_q(qkv + (size_t)tq * NQKV + hq0 * 128, g, qf[0]); load_q(qkv + (size_t)tq * NQKV + (hq0 + 1) * 128, g, qf[1]);
    float sink[2]; sink[0] = p.in[5][hq0] * 1.4426950408889634f; sink[1] = p.in[5][hq0 + 1] * 1.4426950408889634f; asm volatile("" : "+v"(sink[0]), "+v"(sink[1]));
    f32x4 S1[2][8], SC[2][9];
#pragma unroll
    for (int u = 0; u < 2; ++u) {
#pragma unroll
        for (int kt = 0; kt < 8; ++kt) S1[u][kt] = (f32x4){0.f, 0.f, 0.f, 0.f};
#pragma unroll
        for (int s = 0; s < 9; ++s) SC[u][s] = (f32x4){0.f, 0.f, 0.f, 0.f}; }
    const bool in0 = nb > 0, in2 = nb < 127;
#pragma unroll
    for (int c = 0; c < 3; ++c) {
        wait_vm(8); ATT_BAR(); WIN_ISSUE(c + 3);
        LAS unsigned char* buf = lds + (c & 3) * 32768;
#pragma unroll
        for (int kt = 0; kt < 8; ++kt) {
            const bool act = (c == 1) || (c == 0 ? kt >= w : kt <= w);
            if (act) {
#pragma unroll
                for (int ks = 0; ks < 4; ++ks) { const bf16x8 kf = *(const LAS bf16x8*)(buf + off_b(16 * kt + ql, 4 * ks + g));
#pragma unroll
                    for (int u = 0; u < 2; ++u) {
                        if (c == 1) S1[u][kt] = __builtin_amdgcn_mfma_f32_16x16x32_bf16(kf, qf[u][ks], S1[u][kt], 0, 0, 0);
                        else if (c == 0) SC[u][7 - kt] = __builtin_amdgcn_mfma_f32_16x16x32_bf16(kf, qf[u][ks], SC[u][7 - kt], 0, 0, 0);
                        else SC[u][8 - kt] = __builtin_amdgcn_mfma_f32_16x16x32_bf16(kf, qf[u][ks], SC[u][8 - kt], 0, 0, 0); } } }
        }
    }
    const int qi = 16 * w + ql; float inv[2];
    unsigned P1[2][4][4], PC[2][9][2];
#pragma unroll
    for (int u = 0; u < 2; ++u) { float mx = sink[u]; const LAS float* bt = bias + u * 264;
#pragma unroll
        for (int kt = 0; kt < 8; ++kt)
#pragma unroll
            for (int r = 0; r < 4; ++r) { const int rel = 16 * kt + 4 * g + r - qi; const float sv = S1[u][kt][r] + bt[rel + 128]; S1[u][kt][r] = sv; mx = fmaxf(mx, sv); }
#pragma unroll
        for (int s = 0; s < 9; ++s) { const bool c0 = s <= 7 - w; const int kt = c0 ? 7 - s : 8 - s; const int cofs = c0 ? -128 : 128; const bool inr = c0 ? in0 : in2;
#pragma unroll
            for (int r = 0; r < 4; ++r) { const int rel = cofs + 16 * kt + 4 * g + r - qi; const bool valid = inr && rel >= -128 && rel <= 128;
                const float bv = bt[rel + 128];
                const float sv = valid ? SC[u][s][r] + bv : -1e30f; SC[u][s][r] = sv; mx = fmaxf(mx, sv); } }
        mx = fmaxf(mx, __shfl_xor(mx, 16)); mx = fmaxf(mx, __shfl_xor(mx, 32));
        float l = 0.f;
#pragma unroll
        for (int kk = 0; kk < 4; ++kk) { float e[8];
#pragma unroll
            for (int r = 0; r < 4; ++r) { e[r] = __builtin_amdgcn_exp2f(S1[u][2 * kk][r] - mx); e[4 + r] = __builtin_amdgcn_exp2f(S1[u][2 * kk + 1][r] - mx); l += e[r] + e[4 + r]; }
            P1[u][kk][0] = pk2(e[0], e[1]); P1[u][kk][1] = pk2(e[2], e[3]); P1[u][kk][2] = pk2(e[4], e[5]); P1[u][kk][3] = pk2(e[6], e[7]); }
#pragma unroll
        for (int s = 0; s < 9; ++s) { float e[4];
#pragma unroll
            for (int r = 0; r < 4; ++r) { e[r] = __builtin_amdgcn_exp2f(SC[u][s][r] - mx); l += e[r]; }
            PC[u][s][0] = pk2(e[0], e[1]); PC[u][s][1] = pk2(e[2], e[3]); }
        l += __shfl_xor(l, 16); l += __shfl_xor(l, 32); l += __builtin_amdgcn_exp2f(sink[u] - mx);
        inv[u] = 1.0f / l; }
    f32x4 O[2][8];
#pragma unroll
    for (int u = 0; u < 2; ++u)
#pragma unroll
        for (int dt = 0; dt < 8; ++dt) O[u][dt] = (f32x4){0.f, 0.f, 0.f, 0.f};
    const int q4 = ql >> 2, pp = ql & 3;
#pragma unroll
    for (int c = 0; c < 3; ++c) {
        wait_vm(c == 0 ? 8 : (c == 1 ? 4 : 0)); ATT_BAR();
        LAS unsigned char* buf = lds + ((c + 3) & 3) * 32768;
#pragma unroll
        for (int kk = 0; kk < 4; ++kk) {
            bool a0, a1;
            if (c == 1) { a0 = true; a1 = true; } else if (c == 0) { a0 = 2 * kk >= w; a1 = 2 * kk + 1 >= w; } else { a0 = 2 * kk <= w; a1 = 2 * kk + 1 <= w; }
            if (a0 || a1) { bf16x8 pf[2];
#pragma unroll
                for (int u = 0; u < 2; ++u) { u32x4 pw;
                    if (c == 1) { pw.x = P1[u][kk][0]; pw.y = P1[u][kk][1]; pw.z = P1[u][kk][2]; pw.w = P1[u][kk][3]; }
                    else if (c == 0) { pw.x = a0 ? PC[u][7 - 2 * kk][0] : 0u; pw.y = a0 ? PC[u][7 - 2 * kk][1] : 0u; pw.z = a1 ? PC[u][6 - 2 * kk][0] : 0u; pw.w = a1 ? PC[u][6 - 2 * kk][1] : 0u; }
                    else { pw.x = a0 ? PC[u][8 - 2 * kk][0] : 0u; pw.y = a0 ? PC[u][8 - 2 * kk][1] : 0u; pw.z = a1 ? PC[u][7 - 2 * kk][0] : 0u; pw.w = a1 ? PC[u][7 - 2 * kk][1] : 0u; }
                    pf[u] = __builtin_bit_cast(bf16x8, pw); }
#pragma unroll
                for (int dt = 0; dt < 8; ++dt) { const bf16x8 vf = vt_frag(buf, 32 * kk, g, q4, pp, dt);
                    O[0][dt] = __builtin_amdgcn_mfma_f32_16x16x32_bf16(vf, pf[0], O[0][dt], 0, 0, 0); O[1][dt] = __builtin_amdgcn_mfma_f32_16x16x32_bf16(vf, pf[1], O[1][dt], 0, 0, 0); } } }
    }
#undef WIN_ISSUE
#pragma unroll
    for (int u = 0; u < 2; ++u) { bf16_t* op = o + (size_t)tq * D + (hq0 + u) * 128 + 4 * g;
#pragma unroll
        for (int dt = 0; dt < 8; ++dt) { u32x2 w2; w2.x = pk2(O[u][dt][0] * inv[u], O[u][dt][1] * inv[u]); w2.y = pk2(O[u][dt][2] * inv[u], O[u][dt][3] * inv[u]); *(u32x2*)(op + 16 * dt) = w2; } }
}

__device__ __forceinline__ void attn_nat_item(const Params& p, LAS unsigned char* lds, int item, int& tab_head) {
    const int tid = phase_tid(), lane = tid & 63, w = __builtin_amdgcn_readfirstlane(tid >> 6), g = lane >> 4, ql = lane & 15;
    const int b = item >> 9, rp = (item >> 2) & 127, hp = item & 3, hh = w >> 2, h = 2 * hp + hh, jq = w & 3;
    const int kr_lo = min(max(2 * rp - 4, 0), 248);
    const int d0 = min(max(2 * rp - 4, 0), 248) - kr_lo, d1 = min(max(2 * rp - 3, 0), 248) - kr_lo;
    const int w0 = jq == 0 ? 0 : (jq == 1 ? 8 : (jq == 2 ? 24 : 32));
    const bf16_t* qkv = (const bf16_t*)(p.ws + WS_QKV); bf16_t* o = (bf16_t*)(p.ws + WS_O);
    LAS float* rpb = (LAS float*)(lds + 131072); const unsigned ldsb = (unsigned)(size_t)lds;
    const unsigned loff = (unsigned)(w * 4 + g) * NQKV + (unsigned)((ql ^ ((g << 2) | (w & 3))) * 8);
    const bf16_t* kbase = qkv + (size_t)(b * SEQ) * NQKV + 2560 + 2 * hp * 128;
#define NAT_ISSUE(s) do { const int _s = (s); const int _kr = min(kr_lo + (_s % 9), 255); const bf16_t* _src = kbase + (size_t)(_kr * 64) * NQKV + (_s >= 9 ? 1024 : 0) + loff; \
        _Pragma("unroll") for (int _i = 0; _i < 4; ++_i) glds16_asm(_src + (size_t)(32 * (_i & 1)) * NQKV + 128 * (_i >> 1), ldsb + (unsigned)((_s & 3) * 32768 + _i * 8192 + w * 1024)); } while (0)
    ATT_BAR();
    NAT_ISSUE(0); NAT_ISSUE(1); NAT_ISSUE(2);
    if (hp != tab_head) { for (int i = tid; i < 930; i += 512) rpb[i] = p.in[8][2 * hp * 465 + i] * 1.4426950408889634f; tab_head = hp; }
    const int qcol = 16 * jq + ql; const int tq0 = b * SEQ + (2 * rp) * 64 + qcol;
    bf16x8 qf[2][4]; load_q(qkv + (size_t)tq0 * NQKV + 1536 + h * 128, g, qf[0]); load_q(qkv + (size_t)(tq0 + 64) * NQKV + 1536 + h * 128, g, qf[1]);
    f32x4 S[2][9][2];
#pragma unroll
    for (int u = 0; u < 2; ++u)
#pragma unroll
        for (int c = 0; c < 9; ++c) { S[u][c][0] = (f32x4){0.f, 0.f, 0.f, 0.f}; S[u][c][1] = (f32x4){0.f, 0.f, 0.f, 0.f}; }
#pragma unroll
    for (int c = 0; c < 9; ++c) {
        wait_vm(8); ATT_BAR(); NAT_ISSUE(c + 3);
        const bool a0 = c >= d0 && c < d0 + 8, a1 = c >= d1 && c < d1 + 8;
        LAS unsigned char* buf = lds + (c & 3) * 32768 + hh * 16384;
#pragma unroll
        for (int t = 0; t < 2; ++t)
#pragma unroll
            for (int ks = 0; ks < 4; ++ks) { const bf16x8 kf = *(const LAS bf16x8*)(buf + off_b(w0 + 16 * t + ql, 4 * ks + g));
                if (a0) S[0][c][t] = __builtin_amdgcn_mfma_f32_16x16x32_bf16(kf, qf[0][ks], S[0][c][t], 0, 0, 0);
                if (a1) S[1][c][t] = __builtin_amdgcn_mfma_f32_16x16x32_bf16(kf, qf[1][ks], S[1][c][t], 0, 0, 0); }
    }
    const int cs = min(max(qcol - 8, 0), 48); float inv[2];
    unsigned P[2][9][4];
    int dcv[2][4]; bool cv[2][4];
#pragma unroll
    for (int t = 0; t < 2; ++t)
#pragma unroll
        for (int q = 0; q < 4; ++q) { const int kc = w0 + 16 * t + 4 * g + q; cv[t][q] = kc >= cs && kc < cs + 16; dcv[t][q] = hh * 465 + kc - qcol + 15; }
#pragma unroll
    for (int u = 0; u < 2; ++u) { const int du = u ? d1 : d0; const int r = 2 * rp + u; float mx = -1e30f;
#pragma unroll
        for (int c = 0; c < 9; ++c) { const bool act = c >= du && c < du + 8;
            if (act) { const int rowb = (kr_lo + c - r + 7) * 31;
#pragma unroll
                for (int t = 0; t < 2; ++t)
#pragma unroll
                    for (int q = 0; q < 4; ++q) { const float sv = cv[t][q] ? S[u][c][t][q] + rpb[rowb + dcv[t][q]] : -1e30f; S[u][c][t][q] = sv; mx = fmaxf(mx, sv); } } }
        mx = fmaxf(mx, __shfl_xor(mx, 16)); mx = fmaxf(mx, __shfl_xor(mx, 32));
        float l = 0.f;
#pragma unroll
        for (int c = 0; c < 9; ++c) { const bool act = c >= du && c < du + 8;
            if (act) { float e[2][4];
#pragma unroll
                for (int t = 0; t < 2; ++t)
#pragma unroll
                    for (int q = 0; q < 4; ++q) { e[t][q] = __builtin_amdgcn_exp2f(S[u][c][t][q] - mx); l += e[t][q]; }
                P[u][c][0] = pk2(e[0][0], e[0][1]); P[u][c][1] = pk2(e[0][2], e[0][3]); P[u][c][2] = pk2(e[1][0], e[1][1]); P[u][c][3] = pk2(e[1][2], e[1][3]); }
            else { P[u][c][0] = 0u; P[u][c][1] = 0u; P[u][c][2] = 0u; P[u][c][3] = 0u; } }
        l += __shfl_xor(l, 16); l += __shfl_xor(l, 32);
        inv[u] = 1.0f / l; }
    f32x4 O[2][8];
#pragma unroll
    for (int u = 0; u < 2; ++u)
#pragma unroll
        for (int dt = 0; dt < 8; ++dt) O[u][dt] = (f32x4){0.f, 0.f, 0.f, 0.f};
    const int q4 = ql >> 2, pp = ql & 3;
#pragma unroll
    for (int c = 0; c < 9; ++c) {
        wait_vm(c <= 6 ? 8 : (c == 7 ? 4 : 0)); ATT_BAR(); if (c + 12 < 18) NAT_ISSUE(c + 12);
        const bool a0 = c >= d0 && c < d0 + 8, a1 = c >= d1 && c < d1 + 8;
        LAS unsigned char* buf = lds + ((c + 9) & 3) * 32768 + hh * 16384;
        u32x4 pw0; pw0.x = P[0][c][0]; pw0.y = P[0][c][1]; pw0.z = P[0][c][2]; pw0.w = P[0][c][3];
        u32x4 pw1; pw1.x = P[1][c][0]; pw1.y = P[1][c][1]; pw1.z = P[1][c][2]; pw1.w = P[1][c][3];
        const bf16x8 pf0 = __builtin_bit_cast(bf16x8, pw0), pf1 = __builtin_bit_cast(bf16x8, pw1);
#pragma unroll
        for (int dt = 0; dt < 8; ++dt) { const bf16x8 vf = vt_frag(buf, w0, g, q4, pp, dt);
            if (a0) O[0][dt] = __builtin_amdgcn_mfma_f32_16x16x32_bf16(vf, pf0, O[0][dt], 0, 0, 0);
            if (a1) O[1][dt] = __builtin_amdgcn_mfma_f32_16x16x32_bf16(vf, pf1, O[1][dt], 0, 0, 0); }
    }
#undef NAT_ISSUE
#pragma unroll
    for (int u = 0; u < 2; ++u) { bf16_t* op = o + (size_t)(tq0 + 64 * u) * D + 1024 + h * 128 + 4 * g;
#pragma unroll
        for (int dt = 0; dt < 8; ++dt) { u32x2 w2; w2.x = pk2(O[u][dt][0] * inv[u], O[u][dt][1] * inv[u]); w2.y = pk2(O[u][dt][2] * inv[u], O[u][dt][3] * inv[u]); *(u32x2*)(op + 16 * dt) = w2; } }
}
__device__ __forceinline__ void p2_attn(const Params& p, LAS unsigned char* lds) {
    int tab_head = -1, mb = 0;
    const int nper = (1024 + (int)gridDim.x - 1) / (int)gridDim.x;
    const int NB = (MOE_ITEMS + 8 * (int)gridDim.x - 1) / (8 * (int)gridDim.x);
    for (int s = 0; s < 2 * nper || mb < NB; ++s) {
        if (s < 2 * nper) {
            const bool nat = s >= nper; const int it = (int)blockIdx.x + (nat ? s - nper : s) * (int)gridDim.x;
            if (s == nper) { tab_head = -1;
#ifdef PROBE_A
                if (blockIdx.x == 0 && threadIdx.x == 0) ((unsigned long long*)(p.ws + WS_END))[11] = __builtin_amdgcn_s_memrealtime();
#endif
            }
            if (it < 1024) { if (!nat) attn_window_item(p, lds, it, tab_head); else attn_nat_item(p, lds, it, tab_head); }
        }
        if ((((s + (int)blockIdx.x) & 1) == 0 || s >= 2 * nper) && mb < NB) {
            ATT_BAR();
            for (int q = 0; q < 3 && mb < NB; ++q) moe_prep_batch(p, lds, mb++);
        }
    }
    asm volatile("s_waitcnt vmcnt(0)" ::: "memory"); __syncthreads();
}

struct UpHook { const bf16_t* gates;
    __device__ __forceinline__ void operator()(f32x4 (&acc)[2][2][4][2], const Unit& u, int wr, int wc, int fr, int fq) const {
        const unsigned goff = (unsigned)(u.pm * 256 + wr * 64 + fr) * NGATE + u.pn * 256 + wc * 32 + 8 * fq;
#pragma unroll
        for (int ai = 0; ai < 2; ++ai) {
            bf16x8 ra[4][2];
#pragma unroll
            for (int m = 0; m < 4; ++m)
#pragma unroll
                for (int bj = 0; bj < 2; ++bj) ra[m][bj] = *(const bf16x8*)(gates + goff + (unsigned)((ai * 128 + m * 16) * NGATE) + bj * 128);
#pragma unroll
            for (int m = 0; m < 4; ++m)
#pragma unroll
                for (int bj = 0; bj < 2; ++bj)
#pragma unroll
                    for (int n = 0; n < 2; ++n)
#pragma unroll
                        for (int j = 0; j < 4; ++j) acc[ai][bj][m][n][j] *= bf2f(ra[m][bj][4 * n + j]);
            asm volatile("" ::: "memory"); }
    } };
struct UpSched {
    pg8::TileOrder o; const bf16_t* A; const bf16_t* Bt;
    __device__ __forceinline__ bool next(int i, Unit& u) const { u.aux = i & 1; return o.tile(i >> 1, u.pm, u.pn); }
    __device__ __forceinline__ const char* a_base(const Unit& u) const { return (const char*)(A + (size_t)u.pm * 256 * D + u.aux * 1024); }
    __device__ __forceinline__ const char* b_base(const Unit& u) const { return (const char*)(Bt + (size_t)u.pn * 256 * D + u.aux * 1024); }
    __device__ __forceinline__ bool keep_acc(const Unit& u) const { return u.aux == 0; }
    __device__ __forceinline__ void a_offs(const Unit&, int, int, int, int, unsigned (&)[2][2]) const {}
};
struct EpiUp { const bf16_t* gates; bf16_t* merged;
    __device__ __forceinline__ void operator()(f32x4 (&acc)[2][2][4][2], const Unit& u, int wr, int wc, int fr, int fq) const {
        if (u.aux == 0) { UpHook{gates}(acc, u, wr, wc, fr, fq); return; }
        const unsigned goff = (unsigned)(u.pm * 256 + wr * 64 + fr) * NGATE + 2048 + u.pn * 256 + wc * 32 + 8 * fq;
        const unsigned moff = (unsigned)(u.pm * 256 + wr * 64 + fr) * D + u.pn * 256 + wc * 32 + 8 * fq;
#pragma unroll
        for (int ai = 0; ai < 2; ++ai) {
            bf16x8 sb[4][2];
#pragma unroll
            for (int m = 0; m < 4; ++m)
#pragma unroll
                for (int bj = 0; bj < 2; ++bj) sb[m][bj] = *(const bf16x8*)(gates + goff + (unsigned)((ai * 128 + m * 16) * NGATE) + bj * 128);
#pragma unroll
            for (int m = 0; m < 4; ++m)
#pragma unroll
                for (int bj = 0; bj < 2; ++bj) { f32x4 v0 = acc[ai][bj][m][0], v1 = acc[ai][bj][m][1];
#pragma unroll
                    for (int j = 0; j < 4; ++j) { v0[j] *= bf2f(sb[m][bj][j]); v1[j] *= bf2f(sb[m][bj][4 + j]); }
                    u32x4 w; w.x = pk2(v0[0], v0[1]); w.y = pk2(v0[2], v0[3]); w.z = pk2(v1[0], v1[1]); w.w = pk2(v1[2], v1[3]);
                    *(u32x4*)(merged + moff + (unsigned)((ai * 128 + m * 16) * D) + bj * 128) = w; }
            asm volatile("" ::: "memory"); }
    } };
__device__ __forceinline__ void p3_up(const Params& p, LAS unsigned char* lds) {
    UpSched S; S.o.init(128, 8, gridDim.x, blockIdx.x); S.A = (const bf16_t*)(p.ws + WS_O); S.Bt = (const bf16_t*)(p.ws + WS_WUP);
    EpiUp E{(const bf16_t*)(p.ws + WS_GATES), (bf16_t*)(p.ws + WS_MG)};
    pg8::gemm_phase<true, false>(lds, S, E, 1024 / 64, D, D);
}

struct EpiOut { const bf16_t* xb; bf16_t* hb; unsigned char* h8;
    __device__ __forceinline__ void operator()(f32x4 (&acc)[2][2][4][2], const Unit& u, int wr, int wc, int fr, int fq) const {
        unsigned off = (unsigned)(u.pm * 256 + wr * 64 + fr) * D + u.pn * 256 + wc * 32 + 8 * fq;
#pragma unroll
        for (int ai = 0; ai < 2; ++ai) {
            bf16x8 xr[4][2];
#pragma unroll
            for (int m = 0; m < 4; ++m)
#pragma unroll
                for (int bj = 0; bj < 2; ++bj) xr[m][bj] = *(const bf16x8*)(xb + off + (unsigned)(m * 16 * D) + bj * 128);
#pragma unroll
            for (int m = 0; m < 4; ++m) { asm volatile("" : "+v"(off));
#pragma unroll
                for (int bj = 0; bj < 2; ++bj) { const f32x4 v0 = acc[ai][bj][m][0], v1 = acc[ai][bj][m][1]; const u32x4 xw = __builtin_bit_cast(u32x4, xr[m][bj]);
                    const float h0 = v0[0] + __uint_as_float(xw.x << 16), h1 = v0[1] + __uint_as_float(xw.x & 0xffff0000u), h2 = v0[2] + __uint_as_float(xw.y << 16), h3 = v0[3] + __uint_as_float(xw.y & 0xffff0000u);
                    const float h4 = v1[0] + __uint_as_float(xw.z << 16), h5 = v1[1] + __uint_as_float(xw.z & 0xffff0000u), h6 = v1[2] + __uint_as_float(xw.w << 16), h7 = v1[3] + __uint_as_float(xw.w & 0xffff0000u);
                    u32x4 w; w.x = pk2(h0, h1); w.y = pk2(h2, h3); w.z = pk2(h4, h5); w.w = pk2(h6, h7);
                    *(u32x4*)(hb + off + bj * 128) = w;
                    u32x2 f; f.x = pk4_fp8(h0, h1, h2, h3); f.y = pk4_fp8(h4, h5, h6, h7);
                    *(u32x2*)(h8 + off + bj * 128) = f; }
                off += 16 * D; }
            off += 64 * D; }
    } };
__device__ __forceinline__ void p4_out(const Params& p, LAS unsigned char* lds) {
    pg8::DenseSched S; S.o.init(128, 8, gridDim.x, blockIdx.x); S.A = (const bf16_t*)(p.ws + WS_MG); S.Bt = (const bf16_t*)(p.ws + WS_WOUT); S.lda = D; S.ldb = D;
    EpiOut E{(const bf16_t*)(p.ws + WS_XB), (bf16_t*)(p.ws + WS_O), p.ws + WS_H8};
    pg8::gemm_phase<true, false, pg8::DenseSched, EpiOut, false, false>(lds, S, E, D / 64, D, D);
}

__device__ __forceinline__ void p5_router(const Params& p, LAS unsigned char* lds) {
    const int tid = phase_tid(), lane = tid & 63, wave = __builtin_amdgcn_readfirstlane(tid >> 6), g = lane >> 4, tl = lane & 15;
    const bf16_t* wsp = (const bf16_t*)(p.ws + WS_WRT); float* r2 = (float*)(p.ws + WS_R2); int* cnt = (int*)(p.ws + WS_CNT); int* tokl = (int*)(p.ws + WS_TOK);
    int* recc = (int*)(p.ws + WS_RECC); float* recw = (float*)(p.ws + WS_RECW); const bf16_t* hb = (const bf16_t*)(p.ws + WS_O);
    const float* brg = p.in[15]; const float* bre = p.in[17];
    LAS unsigned char* H = lds + wave * 2304;
    LAS unsigned char* WL = lds + 36864;
    const int r8 = lane >> 3, s8 = lane & 7;
    const int pa0 = tid / 384, pr0 = (tid % 384) >> 3, ps0 = tid & 7, pi1 = 512 + tid, pa1 = pi1 / 384, pr1 = (pi1 % 384) >> 3;
    const unsigned wsrc0 = (unsigned)(pa0 * 48 * 2048 + pr0 * D + ps0 * 8), wsrc1 = (unsigned)(pa1 * 48 * 2048 + pr1 * D + ps0 * 8);
    const unsigned wdst0 = (unsigned)(pa0 * 6144 + pr0 * 128 + ((ps0 ^ (pr0 & 7)) << 4)), wdst1 = (unsigned)(pa1 * 6144 + pr1 * 128 + ((ps0 ^ (pr1 & 7)) << 4));
    for (int round = blockIdx.x; round < T / 128; round += gridDim.x) {
        const int tile = round * 8 + wave;
        const bf16_t* hs = hb + (size_t)tile * 16 * D + r8 * D + s8 * 8;
        f32x4 accA = {0.f, 0.f, 0.f, 0.f}, accB = accA, accC = accA; float ss = 0.f;
        u32x4 hq0[2], hq1[2], hq2[2], hq3[2], wr0, wr1;
#define RT_LOADS(bq, k) do { bq[0] = *(const u32x4*)(hs + 64 * (k)); bq[1] = *(const u32x4*)(hs + 8 * D + 64 * (k)); } while (0)
#define RT_COMP(bq, wbuf) do { \
            *(LAS u32x4*)(H + r8 * 144 + s8 * 16) = bq[0]; *(LAS u32x4*)(H + (r8 + 8) * 144 + s8 * 16) = bq[1]; \
            _Pragma("unroll") for (int ks = 0; ks < 2; ++ks) { const u32x4 hw = *(const LAS u32x4*)(H + tl * 144 + 64 * ks + 16 * g); \
                { const float a0 = __uint_as_float(hw.x << 16), a1 = __uint_as_float(hw.x & 0xffff0000u), a2 = __uint_as_float(hw.y << 16), a3 = __uint_as_float(hw.y & 0xffff0000u); \
                  const float a4 = __uint_as_float(hw.z << 16), a5 = __uint_as_float(hw.z & 0xffff0000u), a6 = __uint_as_float(hw.w << 16), a7 = __uint_as_float(hw.w & 0xffff0000u); \
                  ss += (a0 * a0 + a1 * a1) + (a2 * a2 + a3 * a3) + (a4 * a4 + a5 * a5) + (a6 * a6 + a7 * a7); } \
                const bf16x8 bh = __builtin_bit_cast(bf16x8, hw); const unsigned so_ = (unsigned)(((4 * ks + g) ^ (tl & 7)) << 4); \
                _Pragma("unroll") for (int t = 0; t < 3; ++t) { const bf16x8 ah = *(const LAS bf16x8*)((wbuf) + (16 * t + tl) * 128 + so_), al = *(const LAS bf16x8*)((wbuf) + 6144 + (16 * t + tl) * 128 + so_); \
                    f32x4& ac = (t == 0 ? accA : (t == 1 ? accB : accC)); \
                    ac = __builtin_amdgcn_mfma_f32_16x16x32_bf16(ah, bh, ac, 0, 0, 0); ac = __builtin_amdgcn_mfma_f32_16x16x32_bf16(al, bh, ac, 0, 0, 0); } } } while (0)
#define RT_WLOAD(c) do { wr0 = *(const u32x4*)(wsp + wsrc0 + 64 * (c)); if (tid < 256) wr1 = *(const u32x4*)(wsp + wsrc1 + 64 * (c)); } while (0)
#define RT_WSTORE(wbuf) do { *(LAS u32x4*)((wbuf) + wdst0) = wr0; if (tid < 256) *(LAS u32x4*)((wbuf) + wdst1) = wr1; } while (0)
        __syncthreads();
        RT_WLOAD(0); RT_LOADS(hq0, 0); RT_LOADS(hq1, 1); RT_LOADS(hq2, 2);
        RT_WSTORE(WL); RT_WLOAD(1);
        __syncthreads();
#pragma unroll 1
        for (int c = 0; c < D / 64; c += 4) {
            RT_LOADS(hq3, (c + 3));      RT_COMP(hq0, WL);         RT_WSTORE(WL + 12288); RT_WLOAD((c + 2) & 31); __syncthreads();
            RT_LOADS(hq0, (c + 4) & 31); RT_COMP(hq1, WL + 12288); RT_WSTORE(WL);         RT_WLOAD((c + 3) & 31); __syncthreads();
            RT_LOADS(hq1, (c + 5) & 31); RT_COMP(hq2, WL);         RT_WSTORE(WL + 12288); RT_WLOAD((c + 4) & 31); __syncthreads();
            RT_LOADS(hq2, (c + 6) & 31); RT_COMP(hq3, WL + 12288); RT_WSTORE(WL);         RT_WLOAD((c + 5) & 31); __syncthreads();
        }
#undef RT_LOADS
#undef RT_COMP
#undef RT_WLOAD
#undef RT_WSTORE
        const int tok = tile * 16 + tl;
        ss += __shfl_xor(ss, 16); ss += __shfl_xor(ss, 32);
        const float rr = rsqrtf(ss * (1.0f / D) + EPS);
        const float myg = accC[0] * rr + brg[g];
        float gl[4];
#pragma unroll
        for (int j = 0; j < 4; ++j) gl[j] = __shfl(myg, tl + 16 * j);
        int gi = 0; float gm = gl[0];
#pragma unroll
        for (int i = 1; i < 4; ++i) if (gl[i] > gm) { gm = gl[i]; gi = i; }
        float den = 0.f;
#pragma unroll
        for (int i = 0; i < 4; ++i) den += __expf(gl[i] - gm);
        const float pg = 1.0f / den;
        int L0 = 0, L1 = 0; float wt0 = 0.f, wt1 = 0.f; const bool owner = (g == gi);
        if (owner) {
            float el[8];
#pragma unroll
            for (int i = 0; i < 4; ++i) { el[i] = accA[i] * rr + bre[g * 8 + i]; el[4 + i] = accB[i] * rr + bre[g * 8 + 4 + i]; }
            int e0 = 0; float v0 = el[0];
#pragma unroll
            for (int i = 1; i < 8; ++i) if (el[i] > v0) { v0 = el[i]; e0 = i; }
            int e1 = -1; float v1 = -3.0e38f;
#pragma unroll
            for (int i = 0; i < 8; ++i) if (i != e0 && el[i] > v1) { v1 = el[i]; e1 = i; }
            const float ex = __expf(v1 - v0); const float s0 = 1.0f / (1.0f + ex), s1 = ex * s0;
            r2[tok] = rr; L0 = gi * 8 + e0; L1 = gi * 8 + e1; wt0 = pg * s0; wt1 = pg * s1;
        }
        LAS int* cl = (LAS int*)(lds + 61440);
        if (tid < 32) cl[tid] = 0;
        __syncthreads();
        int q0 = 0, q1 = 0;
        if (owner) { q0 = __hip_atomic_fetch_add(&cl[L0], 1, __ATOMIC_RELAXED, __HIP_MEMORY_SCOPE_WORKGROUP); q1 = __hip_atomic_fetch_add(&cl[L1], 1, __ATOMIC_RELAXED, __HIP_MEMORY_SCOPE_WORKGROUP); }
        __syncthreads();
        if (tid < 32) { const int n = cl[tid]; cl[32 + tid] = n ? atomicAdd(&cnt[tid], n) : 0; }
        __syncthreads();
        if (owner) { const int p0 = cl[32 + L0] + q0, p1 = cl[32 + L1] + q1;
            float* r2l = (float*)(p.ws + WS_R2L);
            tokl[(size_t)L0 * T + p0] = tok; r2l[(size_t)L0 * T + p0] = rr; recc[2 * tok] = L0 * 32768 + p0; recw[2 * tok] = wt0;
            tokl[(size_t)L1 * T + p1] = tok; r2l[(size_t)L1 * T + p1] = rr; recc[2 * tok + 1] = L1 * 32768 + p1; recw[2 * tok + 1] = wt1; }
    }
    __syncthreads();
}

__device__ __forceinline__ void build_tiles(const Params& p, LAS int* tab) {
    __syncthreads();
    if (threadIdx.x < 64) { const int L = threadIdx.x; const int c = L < 32 ? ((const int*)(p.ws + WS_CNT))[L] : 0; const int nt = (c + 255) >> 8;
        int pre = nt;
#pragma unroll
        for (int o = 1; o < 32; o <<= 1) { const int v = __shfl_up(pre, o); if (L >= o) pre += v; }
        const int first = pre - nt;
        if (L < 32) { tab[1400 + L] = first * 256; for (int i = 0; i < nt; ++i) { tab[4 + (first + i) * 4 + 0] = L; tab[4 + (first + i) * 4 + 1] = i * 256; tab[4 + (first + i) * 4 + 2] = (first + i) * 256; tab[4 + (first + i) * 4 + 3] = min(256, c - i * 256); } }
        if (L == 31) tab[0] = pre; }
    __syncthreads();
}
template <int NPN> struct MoeOrder { int G, c, t_lo, nt_tiles; const LAS int* tab;
    __device__ __forceinline__ bool unit(int i, Unit& u) const { const long L = (long)i * G + c; if (L >= (long)nt_tiles * NPN) return false;
        const int nwg = nt_tiles * NPN; int wgid = (int)L; { const int q = nwg / 8, r = nwg % 8, xcd = wgid % 8, off = wgid / 8; wgid = (xcd < r ? xcd * (q + 1) : r * (q + 1) + (xcd - r) * q) + off; }
        u.pm = t_lo + wgid / NPN; u.pn = wgid % NPN; u.aux = 0; return true; } };
struct GateUpSched { MoeOrder<4> o; const unsigned char* hb; const unsigned char* WguT; const int* tokl;
    __device__ __forceinline__ bool next(int i, Unit& u) const { return o.unit(i, u); }
    __device__ __forceinline__ const char* a_base(const Unit&) const { return (const char*)hb; }
    __device__ __forceinline__ const char* b_base(const Unit& u) const { const int e = o.tab[4 + u.pm * 4] & 31; return (const char*)(WguT + (size_t)(e * 1024 + u.pn * 256) * D); }
    __device__ __forceinline__ bool keep_acc(const Unit&) const { return false; }
    __device__ __forceinline__ void a_offs(const Unit& u, int R0, int C0, int R1, int C1, unsigned (&v)[2][2]) const {
        const int L = o.tab[4 + u.pm * 4], row0 = o.tab[4 + u.pm * 4 + 1], nrows = o.tab[4 + u.pm * 4 + 3]; const int* lst = tokl + (size_t)L * T + row0;
#pragma unroll
        for (int h = 0; h < 2; ++h) { const int r0 = R0 + 128 * h, r1 = R1 + 128 * h; const int t0 = r0 < nrows ? lst[r0] : 0, t1 = r1 < nrows ? lst[r1] : 0;
            v[h][0] = (unsigned)t0 * D + C0 * 2u; v[h][1] = (unsigned)t1 * D + C1 * 2u; } }
};
struct EpiGateUp { const LAS int* tab; const float* r2l; bf16_t* he;
    __device__ __forceinline__ void operator()(f32x4 (&acc)[2][2][4][2], const Unit& u, int wr, int wc, int fr, int fq) const {
        const int L = tab[4 + u.pm * 4], row0 = tab[4 + u.pm * 4 + 1], slot = tab[4 + u.pm * 4 + 2], nrows = tab[4 + u.pm * 4 + 3];
#pragma unroll
        for (int ai = 0; ai < 2; ++ai)
#pragma unroll
            for (int m = 0; m < 4; ++m) { const int rr = ai * 128 + wr * 64 + m * 16 + fr; const float rs = rr < nrows ? r2l[(size_t)L * T + row0 + rr] * (1.0f / 64.0f) : 0.f;
                u32x4 w; unsigned ww[4];
#pragma unroll
                for (int n = 0; n < 2; ++n) { float hv[4];
#pragma unroll
                    for (int j = 0; j < 4; ++j) { const float gt = acc[ai][0][m][n][j] * rs, up = acc[ai][1][m][n][j] * rs; hv[j] = gt * sigmoidf_(gt) * up; }
                    ww[2 * n] = pk2(hv[0], hv[1]); ww[2 * n + 1] = pk2(hv[2], hv[3]); }
                w.x = ww[0]; w.y = ww[1]; w.z = ww[2]; w.w = ww[3];
                *(u32x4*)(he + (size_t)(slot + rr) * 512 + u.pn * 128 + wc * 32 + 8 * fq) = w; }
    } };
__device__ __forceinline__ void p6_gateup(const Params& p, LAS unsigned char* lds) {
    LAS int* tab = (LAS int*)(lds + TAB_OFF); build_tiles(p, tab);
    GateUpSched S; S.o.G = gridDim.x; S.o.c = blockIdx.x; S.o.t_lo = 0; S.o.nt_tiles = tab[0]; S.o.tab = tab;
    S.hb = p.ws + WS_H8; S.WguT = p.ws + WS_WGU; S.tokl = (const int*)(p.ws + WS_TOK);
    EpiGateUp E{tab, (const float*)(p.ws + WS_R2L), (bf16_t*)(p.ws + WS_HE)};
    pg8::gemm_phase<true, true, GateUpSched, EpiGateUp, true>(lds, S, E, D / 128, D / 2, D / 2);
}
struct DownSched { MoeOrder<8> o; const bf16_t* he; const bf16_t* WdT;
    __device__ __forceinline__ bool next(int i, Unit& u) const { return o.unit(i, u); }
    __device__ __forceinline__ const char* a_base(const Unit& u) const { return (const char*)(he + (size_t)o.tab[4 + u.pm * 4 + 2] * 512); }
    __device__ __forceinline__ const char* b_base(const Unit& u) const { const int e = o.tab[4 + u.pm * 4] & 31; return (const char*)(WdT + (size_t)(e * 2048 + u.pn * 256) * 512); }
    __device__ __forceinline__ bool keep_acc(const Unit&) const { return false; }
    __device__ __forceinline__ void a_offs(const Unit&, int, int, int, int, unsigned (&)[2][2]) const {}
};
struct EpiDown { const LAS int* tab; unsigned char* ye;
    __device__ __forceinline__ void operator()(f32x4 (&acc)[2][2][4][2], const Unit& u, int wr, int wc, int fr, int fq) const {
        const int slot = tab[4 + u.pm * 4 + 2];
        unsigned off = (unsigned)(slot + wr * 64 + fr) * 2048 + u.pn * 256 + wc * 32 + 8 * fq;
#pragma unroll
        for (int ai = 0; ai < 2; ++ai) {
#pragma unroll
            for (int m = 0; m < 4; ++m) { asm volatile("" : "+v"(off));
#pragma unroll
                for (int bj = 0; bj < 2; ++bj) { const f32x4 v0 = acc[ai][bj][m][0] * 16.f, v1 = acc[ai][bj][m][1] * 16.f;
                    u32x2 w; w.x = pk4_fp8(v0[0], v0[1], v0[2], v0[3]); w.y = pk4_fp8(v1[0], v1[1], v1[2], v1[3]);
                    *(u32x2*)(ye + off + bj * 128) = w; }
                off += 16 * 2048; }
            off += 64 * 2048; }
    } };
__device__ __forceinline__ void p7_down(const Params& p, LAS unsigned char* lds) {
    LAS int* tab = (LAS int*)(lds + TAB_OFF); build_tiles(p, tab);
    DownSched S; S.o.G = gridDim.x; S.o.c = blockIdx.x; S.o.t_lo = 0; S.o.nt_tiles = tab[0]; S.o.tab = tab;
    S.he = (const bf16_t*)(p.ws + WS_HE); S.WdT = (const bf16_t*)(p.ws + WS_WD);
    EpiDown E{tab, p.ws + WS_YE};
    pg8::gemm_phase<true, false, DownSched, EpiDown, false, false>(lds, S, E, 512 / 64, 512, 512);
}
__device__ __forceinline__ void p8_combine(const Params& p, LAS unsigned char* lds) {
    LAS int* tab = (LAS int*)(lds + TAB_OFF); build_tiles(p, tab);
    const int tid = phase_tid(), lane = tid & 63, wave = tid >> 6; const int gw = blockIdx.x * 8 + wave, NGW = gridDim.x * 8;
    const int* recc = (const int*)(p.ws + WS_RECC); const float* recw = (const float*)(p.ws + WS_RECW); const bf16_t* hb = (const bf16_t*)(p.ws + WS_O);
    const unsigned char* ye = p.ws + WS_YE;
    for (int tok = gw; tok < T; tok += NGW) {
        const int c0 = recc[2 * tok], c1 = recc[2 * tok + 1]; const float wa = recw[2 * tok] * 0.0625f, wb = recw[2 * tok + 1] * 0.0625f;
        const int s0 = tab[1400 + (c0 >> 15)] + (c0 & 32767), s1 = tab[1400 + (c1 >> 15)] + (c1 & 32767);
        f32x4* op = (f32x4*)(p.out + (size_t)tok * D) + lane; const u32x2* hp = (const u32x2*)(hb + (size_t)tok * D) + lane;
        const unsigned* ya = (const unsigned*)(ye + (size_t)s0 * 2048) + lane; const unsigned* yb = (const unsigned*)(ye + (size_t)s1 * 2048) + lane;
        u32x2 m[8]; unsigned a[8], b[8];
#pragma unroll
        for (int j = 0; j < 8; ++j) { m[j] = hp[64 * j]; a[j] = ya[64 * j]; b[j] = yb[64 * j]; }
#pragma unroll
        for (int j = 0; j < 8; ++j) { f32x4 v;
            const f32x2 a0 = __builtin_amdgcn_cvt_pk_f32_fp8(a[j], false), a1 = __builtin_amdgcn_cvt_pk_f32_fp8(a[j], true), b0 = __builtin_amdgcn_cvt_pk_f32_fp8(b[j], false), b1 = __builtin_amdgcn_cvt_pk_f32_fp8(b[j], true);
            v.x = __uint_as_float(m[j].x << 16) + wa * a0.x + wb * b0.x; v.y = __uint_as_float(m[j].x & 0xffff0000u) + wa * a0.y + wb * b0.y;
            v.z = __uint_as_float(m[j].y << 16) + wa * a1.x + wb * b1.x; v.w = __uint_as_float(m[j].y & 0xffff0000u) + wa * a1.y + wb * b1.y;
            op[64 * j] = v; }
    }
}

#define XB_TMO      128
#define XB_XCNT(j)  (256  + 64 * (j))
#define XB_XSUB(j)  (1280 + 64 * (j))
#define XB_XGEN(j)  (2304 + 64 * (j))
#define XB_TOP      3328
#define XB_TOPGEN   3392
#define XCD_BAR_WORDS 3456
#define XB_SPIN_CAP (1u << 18)
__device__ __forceinline__ unsigned xb_ld(unsigned* p)              { return __hip_atomic_load(p, __ATOMIC_RELAXED, __HIP_MEMORY_SCOPE_AGENT); }
__device__ __forceinline__ unsigned xb_add(unsigned* p, unsigned v) { return __hip_atomic_fetch_add(p, v, __ATOMIC_RELAXED, __HIP_MEMORY_SCOPE_AGENT); }
__device__ __forceinline__ unsigned xb_xcc_id() { return (unsigned)__builtin_amdgcn_s_getreg((3 << 11) | 20) & 0xFu; }
#define XB_SPIN(cond, bar) do { unsigned _sp = 0; while (cond) { __builtin_amdgcn_s_sleep(1); \
    if ((++_sp & 255u) == 0u) { if (xb_ld(&(bar)[XB_TMO])) break; if (_sp > XB_SPIN_CAP) { atomicAdd(&(bar)[XB_TMO], 1u); break; } } } } while (0)
struct XcdBarrier { unsigned* bar; unsigned x; volatile LAS unsigned* st; };
__device__ __forceinline__ XcdBarrier xcd_barrier_post(unsigned* bar, volatile LAS unsigned* st) {
    XcdBarrier b; b.bar = bar; b.x = xb_xcc_id(); b.st = st;
    if (threadIdx.x == 0) (void)xb_add(&bar[XB_XCNT(b.x)], 1u);
    return b;
}
__device__ __forceinline__ void xcd_barrier_complete(unsigned* bar, unsigned x, unsigned& nloc, unsigned& nx) {
    const unsigned G = gridDim.x * gridDim.y * gridDim.z;
    unsigned sum, cnt, mine, sp = 0u;
    for (;;) {
        sum = 0u; cnt = 0u; mine = 0u;
#pragma unroll
        for (unsigned j = 0; j < 16; ++j) { const unsigned c = xb_ld(&bar[XB_XCNT(j)]); sum += c; cnt += (c > 0u) ? 1u : 0u; mine = (j == x) ? c : mine; }
        if (sum == G) break;
        __builtin_amdgcn_s_sleep(1);
        if ((++sp & 255u) == 0u) { if (xb_ld(&bar[XB_TMO])) break; if (sp > XB_SPIN_CAP) { atomicAdd(&bar[XB_TMO], 1u); break; } }
    }
    nloc = mine > 0u ? mine : 1u; nx = cnt > 0u ? cnt : 1u;
}
__device__ __forceinline__ void xcd_barrier(const XcdBarrier& b) {
    asm volatile("s_waitcnt vmcnt(0)" ::: "memory");
    __syncthreads();
    if (threadIdx.x == 0) {
        unsigned* bar = b.bar;
        __builtin_amdgcn_s_waitcnt(0);
        unsigned nloc = b.st[0], nx = b.st[1];
        if (nloc == 0u) { xcd_barrier_complete(bar, b.x, nloc, nx); b.st[0] = nloc; b.st[1] = nx; }
        const unsigned old = xb_add(&bar[XB_XSUB(b.x)], 1u);
        const unsigned gen = old / nloc;
        if (old + 1u == (gen + 1u) * nloc) {
            __builtin_amdgcn_fence(__ATOMIC_RELEASE, "agent");
            asm volatile("s_waitcnt vmcnt(0)" ::: "memory");
            const unsigned og = xb_add(&bar[XB_TOP], 1u);
            const unsigned tg = og / nx;
            if (og + 1u == (tg + 1u) * nx) xb_add(&bar[XB_TOPGEN], 1u);
            else XB_SPIN(xb_ld(&bar[XB_TOPGEN]) == tg, bar);
            __builtin_amdgcn_fence(__ATOMIC_ACQUIRE, "agent");
            xb_add(&bar[XB_XGEN(b.x)], 1u);
            asm volatile("s_waitcnt vmcnt(0)" ::: "memory");
        } else {
            XB_SPIN(xb_ld(&bar[XB_XGEN(b.x)]) == gen, bar);
            __builtin_amdgcn_fence(__ATOMIC_ACQUIRE, "agent");
            asm volatile("s_waitcnt vmcnt(0)" ::: "memory");
        }
    }
    __syncthreads();
}

namespace cg = cooperative_groups;
#ifdef PROBE_A
#define STAMP(k) do { if (blockIdx.x == 0 && threadIdx.x == 0) ((unsigned long long*)(p.ws + WS_END))[k] = __builtin_amdgcn_s_memrealtime(); } while (0)
#else
#define STAMP(k) do {} while (0)
#endif
__global__ void __launch_bounds__(512, 2) fwd_megakernel(Params p) {
    extern __shared__ __attribute__((aligned(16))) unsigned char lds_raw[];
    LAS unsigned char* lds = (LAS unsigned char*)lds_raw;
    cg::grid_group grid = cg::this_grid();
    if (threadIdx.x == 0) { *(volatile LAS unsigned*)(lds + XBST_OFF) = 0u; *(volatile LAS unsigned*)(lds + XBST_OFF + 4) = 0u; }
    if (blockIdx.x == 0) for (int i = threadIdx.x; i < XCD_BAR_WORDS; i += 512) ((unsigned*)(p.ws + WS_BAR))[i] = 0u;
    __syncthreads();
#define GSYNC() xcd_barrier(xb)
    STAMP(0);
    p0_prep(p, lds);            grid.sync(); STAMP(1);
    const XcdBarrier xb = xcd_barrier_post((unsigned*)(p.ws + WS_BAR), (volatile LAS unsigned*)(lds + XBST_OFF));
    p1_inproj(p, lds);          GSYNC(); STAMP(2);
    p2_attn(p, lds);            GSYNC(); STAMP(3);
    STAMP(4);
    p3_up(p, lds);              GSYNC(); STAMP(5);
    p4_out(p, lds);             GSYNC(); STAMP(6);
    p5_router(p, lds);          GSYNC(); STAMP(7);
    p6_gateup(p, lds);          GSYNC(); STAMP(8);
    p7_down(p, lds);            GSYNC(); STAMP(9);
    p8_combine(p, lds);
#ifdef PROBE_A
    grid.sync(); STAMP(10); grid.sync();
    {
        const unsigned long long* ts = (const unsigned long long*)(p.ws + WS_END);
        #ifndef PROBE_A1
#define PROBE_A1 (PROBE_A + 1)
#endif
#ifndef PROBE_B1
#define PROBE_B1 (PROBE_B + 1)
#endif
        const float usA = (float)(ts[PROBE_A1] - ts[PROBE_A]) * 0.01f, usB = (float)(ts[PROBE_B1] - ts[PROBE_B]) * 0.01f;
        const float eps = sqrtf(usA * 1e-6f);
        for (size_t i = (size_t)blockIdx.x * 512 + threadIdx.x; i < (size_t)T * D / 4; i += (size_t)gridDim.x * 512) { f32x4 v = ((f32x4*)p.out)[i]; v = v * (1.0f + eps); if (i == 0) v.x += usB * 0.1f; ((f32x4*)p.out)[i] = v; }
    }
#endif
}

extern "C" void kernel_launch(void* const* d_in, const int* in_sizes, int n_in, void* d_out, int out_size, void* d_ws, size_t ws_size, hipStream_t stream) {
    static int grid_blocks = 0;
    if (!grid_blocks) {
        if (n_in != 21 || out_size != T * D || ws_size < WS_TOP) { fprintf(stderr, "kernel_launch: unexpected problem (n_in %d out %d ws %zu)\n", n_in, out_size, ws_size); grid_blocks = -1; return; }
        if (hipFuncSetAttribute((const void*)fwd_megakernel, hipFuncAttributeMaxDynamicSharedMemorySize, LDS_BYTES) != hipSuccess) { fprintf(stderr, "kernel_launch: hipFuncSetAttribute failed\n"); grid_blocks = -1; return; }
        int dev = 0, cus = 0, per_cu = 0;
        hipGetDevice(&dev); hipDeviceGetAttribute(&cus, hipDeviceAttributeMultiprocessorCount, dev);
        hipOccupancyMaxActiveBlocksPerMultiprocessor(&per_cu, (const void*)fwd_megakernel, 512, LDS_BYTES);
        if (per_cu < 1 || cus < 1) { fprintf(stderr, "kernel_launch: occupancy query gave %d blocks/CU on %d CUs\n", per_cu, cus); grid_blocks = -1; return; }
        grid_blocks = cus;
    }
    if (grid_blocks < 0) return;
    Params p{};
    for (int i = 0; i < 21; ++i) p.in[i] = (const float*)d_in[i];
    p.out = (float*)d_out; p.ws = (unsigned char*)d_ws;
    void* args[] = {&p};
    hipError_t e = hipLaunchCooperativeKernel((const void*)fwd_megakernel, dim3(grid_blocks), dim3(512), args, LDS_BYTES, stream);
    if (e != hipSuccess) fprintf(stderr, "cooperative launch failed: %s (grid %d)\n", hipGetErrorString(e), grid_blocks);
}
```

```cpp
#include <hip/hip_runtime.h>
#include <hip/hip_cooperative_groups.h>
#include <cstdio>
#include <cstdint>

#define LAS __attribute__((address_space(3)))
typedef unsigned short bf16_t;
typedef short bf16x8 __attribute__((ext_vector_type(8)));
typedef short s16x4 __attribute__((ext_vector_type(4)));
typedef float f32x4 __attribute__((ext_vector_type(4)));
typedef unsigned u32x4 __attribute__((ext_vector_type(4)));
typedef unsigned u32x2 __attribute__((ext_vector_type(2)));
typedef short v4i16_t __attribute__((ext_vector_type(4)));

namespace cfg {
constexpr int T = 32768, D = 2048, SEQ = 16384;
constexpr int NQKV = 4608, NGATE = 4096, NIN = 8704;
constexpr size_t MiB = 1ull << 20;
constexpr size_t WS_XB = 0, WS_QKV = 128 * MiB, WS_GATES = 416 * MiB, WS_O = 672 * MiB, WS_WIN = 800 * MiB, WS_WUP = 834 * MiB, WS_WOUT = 842 * MiB, WS_MISC = 850 * MiB;
constexpr size_t WS_WGU = 872 * MiB, WS_WD = 936 * MiB, WS_MG = WS_QKV, WS_HE = WS_QKV + 192 * MiB;
constexpr size_t WS_R1 = WS_MISC, WS_R2 = WS_R1 + (size_t)T * 4, WS_WRT = WS_R2 + (size_t)T * 4, WS_CNT = WS_WRT + 512 * 1024, WS_TOK = WS_CNT + 4096,
                 WS_RECC = WS_TOK + 32ull * T * 4, WS_RECW = WS_RECC + 2ull * T * 4, WS_R2L = WS_RECW + 2ull * T * 4, WS_END = WS_R2L + 32ull * T * 4;
constexpr size_t WS_H8 = WS_GATES + 144 * MiB;
constexpr size_t WS_YE = WS_QKV;
constexpr size_t WS_BAR = WS_END + 4096;
constexpr size_t WS_X8 = 872 * MiB;
constexpr size_t WS_TOP = 1000 * MiB;
constexpr int LDS_BYTES = 140 * 1024;
constexpr int XBST_OFF = LDS_BYTES - 16;
constexpr int TAB_OFF = 132 * 1024;
constexpr float EPS = 1e-6f;
}
using namespace cfg;

struct Params { const float* in[21]; float* out; unsigned char* ws; };
__device__ __forceinline__ int phase_tid() { int t = threadIdx.x; asm volatile("" : "+v"(t)); return t; }

__device__ __forceinline__ float bf2f(short s) { return __uint_as_float(((unsigned)(unsigned short)s) << 16); }
typedef float f32x2 __attribute__((ext_vector_type(2)));
typedef __bf16 bf16x2_t __attribute__((ext_vector_type(2)));
__device__ __forceinline__ unsigned pk2(float lo, float hi) { const f32x2 v = {lo, hi}; return __builtin_bit_cast(unsigned, __builtin_convertvector(v, bf16x2_t)); }
__device__ __forceinline__ unsigned pk4_fp8(float a, float b, float c, float d) { int w = 0; w = __builtin_amdgcn_cvt_pk_fp8_f32(a, b, w, false); w = __builtin_amdgcn_cvt_pk_fp8_f32(c, d, w, true); return (unsigned)w; }
__device__ __forceinline__ float wave_sum(float v) {
#pragma unroll
    for (int o = 1; o < 64; o <<= 1) v += __shfl_xor(v, o);
    return v;
}
__device__ __forceinline__ float sigmoidf_(float v) { return 1.0f / (1.0f + __expf(-v)); }
__device__ __forceinline__ unsigned off_b(unsigned row, unsigned ch) { return 256u * row + 16u * (ch ^ (((row & 3) << 2) | ((row >> 2) & 3))); }
__device__ __forceinline__ s16x4 tr_read(LAS unsigned char* p) { return __builtin_bit_cast(s16x4, __builtin_amdgcn_ds_read_tr16_b64_v4i16((LAS v4i16_t*)p)); }
__host__ __device__ __forceinline__ int perm32(int rho) { const int n = rho >> 4, i = rho & 15; return 8 * (i >> 2) + 4 * n + (i & 3); }
__device__ __forceinline__ int t5_bucket(int rel) {
    const int n = rel < 0 ? -rel : rel; const int ret = rel > 0 ? 16 : 0; int b;
    if (n < 8) b = n; else if (n < 12) b = 8; else if (n < 16) b = 9; else if (n < 23) b = 10; else if (n < 32) b = 11; else if (n < 46) b = 12; else if (n < 64) b = 13; else if (n < 91) b = 14; else b = 15;
    return ret + b;
}

template <bool FP8>
__device__ __forceinline__ void transpose_item(const float* __restrict__ W, int ldw, int k0, int n0, bf16_t* __restrict__ WT, int ldt, int drow0, int dk0, const float* __restrict__ scale, LAS unsigned* scr, int lane, float f8scale = 1.f) {
    const int n4 = (lane & 15) * 4, kk = lane >> 4;
    const float* src = W + (size_t)(k0 + 2 * kk) * ldw + n0 + n4;
    f32x4 ev[8], od[8];
#pragma unroll
    for (int j = 0; j < 8; ++j) { ev[j] = *(const f32x4*)(src + (size_t)(8 * j) * ldw); od[j] = *(const f32x4*)(src + (size_t)(8 * j + 1) * ldw); }
#pragma unroll
    for (int j = 0; j < 8; ++j) { f32x4 e = ev[j], o = od[j];
        if (scale) { const float se = scale[k0 + 8 * j + 2 * kk], so = scale[k0 + 8 * j + 2 * kk + 1]; e = e * se; o = o * so; }
        u32x4 w; w.x = pk2(e.x, o.x); w.y = pk2(e.y, o.y); w.z = pk2(e.z, o.z); w.w = pk2(e.w, o.w);
        *(LAS u32x4*)(scr + (4 * j + kk) * 68 + n4) = w; }
    asm volatile("s_waitcnt lgkmcnt(0)" ::: "memory");
    const int kq = lane & 7;
#pragma unroll
    for (int i = 0; i < 8; ++i) { const int n = (lane >> 3) + 8 * i; const LAS unsigned* q = scr + (4 * kq) * 68 + n;
        u32x4 o; o.x = q[0]; o.y = q[68]; o.z = q[136]; o.w = q[204];
        if (FP8) { u32x2 f; f.x = pk4_fp8(__uint_as_float(o.x << 16) * f8scale, __uint_as_float(o.x & 0xffff0000u) * f8scale, __uint_as_float(o.y << 16) * f8scale, __uint_as_float(o.y & 0xffff0000u) * f8scale);
            f.y = pk4_fp8(__uint_as_float(o.z << 16) * f8scale, __uint_as_float(o.z & 0xffff0000u) * f8scale, __uint_as_float(o.w << 16) * f8scale, __uint_as_float(o.w & 0xffff0000u) * f8scale);
            *(u32x2*)((unsigned char*)WT + (size_t)(drow0 + n) * ldt + dk0 + k0 + 8 * kq) = f; }
        else *(u32x4*)(WT + (size_t)(drow0 + n) * ldt + dk0 + k0 + 8 * kq) = o; }
    asm volatile("s_waitcnt lgkmcnt(0)" ::: "memory");
}

__device__ __forceinline__ void p0_prep(const Params& p, LAS unsigned char* lds) {
    const int tid = phase_tid(), lane = tid & 63, wave = tid >> 6;
    const int gw = blockIdx.x * 8 + wave, NGW = gridDim.x * 8;
    LAS unsigned* scr = (LAS unsigned*)(lds + wave * 8704);
    const float* x = p.in[0]; const float* g1 = p.in[1]; const float* w_in = p.in[2];
    bf16_t* xb = (bf16_t*)(p.ws + WS_XB); float* r1 = (float*)(p.ws + WS_R1);
    bf16_t* WinT = (bf16_t*)(p.ws + WS_WIN); bf16_t* WupT = (bf16_t*)(p.ws + WS_WUP); bf16_t* WoutT = (bf16_t*)(p.ws + WS_WOUT);
    constexpr int I_WIN = 32 * 136, I_UP = 16 * 32, I_OUT = 32 * 32, NITEMS = I_WIN + 2 * I_UP + I_OUT;
    for (int it = gw; it < NITEMS; it += NGW) {
        int r = it;
        if (r < I_WIN) { const int kb = r / 136, nb = r % 136; const int n0 = nb * 64;
            int drow = n0;
            if (n0 >= NQKV) { const int c = (n0 - NQKV) & 2047, isb = (n0 - NQKV) >> 11; drow = NQKV + (c >> 7) * 256 + isb * 128 + (c & 127); }
            transpose_item<true>(w_in, NIN, kb * 64, n0, WinT, 2048, drow, 0, g1, scr, lane, 64.f); continue; } r -= I_WIN;
        if (r < I_UP) { const int kb = r / 32, nb = r % 32; transpose_item<false>(p.in[9], 2048, kb * 64, nb * 64, WupT, 2048, nb * 64, 0, nullptr, scr, lane); continue; } r -= I_UP;
        if (r < I_UP) { const int kb = r / 32, nb = r % 32; transpose_item<false>(p.in[10], 2048, kb * 64, nb * 64, WupT, 2048, nb * 64, 1024, nullptr, scr, lane); continue; } r -= I_UP;
        { const int kb = r / 32, nb = r % 32; transpose_item<false>(p.in[11], 2048, kb * 64, nb * 64, WoutT, 2048, nb * 64, 0, nullptr, scr, lane); }
    }
    { bf16_t* whi = (bf16_t*)(p.ws + WS_WRT); bf16_t* wlo = whi + 48 * 2048; const float* g2 = p.in[13]; const float* wrg = p.in[14]; const float* wre = p.in[16];
      for (int i = blockIdx.x * 512 + tid; i < 48 * 2048; i += gridDim.x * 512) { const int row = i >> 11, k = i & 2047, t = row >> 4, r = row & 15; float w;
          if (t == 0) w = wre[k * 32 + (r >> 2) * 8 + (r & 3)]; else if (t == 1) w = wre[k * 32 + (r >> 2) * 8 + 4 + (r & 3)]; else w = (r & 3) == 0 ? wrg[k * 4 + (r >> 2)] : 0.f;
          w *= g2[k]; const unsigned hi = pk2(w, 0.f) & 0xffffu; const float hf = __uint_as_float(hi << 16); whi[i] = (bf16_t)hi; wlo[i] = (bf16_t)(pk2(w - hf, 0.f) & 0xffffu); } }
    if (blockIdx.x == 0 && tid < 32) ((int*)(p.ws + WS_CNT))[tid] = 0;
    for (int row0 = 2 * gw; row0 < T; row0 += 2 * NGW) {
        f32x4 v[2][8]; float ss[2] = {0.f, 0.f};
#pragma unroll
        for (int u = 0; u < 2; ++u) { const f32x4* xr = (const f32x4*)(x + (size_t)(row0 + u) * D) + lane;
#pragma unroll
            for (int j = 0; j < 8; ++j) v[u][j] = xr[64 * j]; }
#pragma unroll
        for (int u = 0; u < 2; ++u) {
#pragma unroll
            for (int j = 0; j < 8; ++j) ss[u] += (v[u][j].x * v[u][j].x + v[u][j].y * v[u][j].y) + (v[u][j].z * v[u][j].z + v[u][j].w * v[u][j].w);
            ss[u] = wave_sum(ss[u]);
            if (lane == 0) r1[row0 + u] = rsqrtf(ss[u] * (1.0f / D) + EPS);
            u32x2* o = (u32x2*)(xb + (size_t)(row0 + u) * D) + lane; unsigned* o8 = (unsigned*)(p.ws + WS_X8 + (size_t)(row0 + u) * D) + lane;
#pragma unroll
            for (int j = 0; j < 8; ++j) { u32x2 w; w.x = pk2(v[u][j].x, v[u][j].y); w.y = pk2(v[u][j].z, v[u][j].w); o[64 * j] = w; o8[64 * j] = pk4_fp8(v[u][j].x, v[u][j].y, v[u][j].z, v[u][j].w); } }
    }
}

constexpr int MOE_ITEMS = 2 * 32 * 32 * 8 + 32 * 8 * 32;
__device__ __forceinline__ void moe_prep_batch(const Params& p, LAS unsigned char* lds, int bi) {
    const int tid = phase_tid(), lane = tid & 63, wave = tid >> 6;
    LAS unsigned* scr = (LAS unsigned*)(lds + wave * 8704);
    const float* g2 = p.in[13];
    bf16_t* WguT = (bf16_t*)(p.ws + WS_WGU); bf16_t* WdT = (bf16_t*)(p.ws + WS_WD);
    constexpr int I_G = 32 * 32 * 8;
    int r = (bi * (int)gridDim.x + (int)blockIdx.x) * 8 + wave;
    if (r >= MOE_ITEMS) return;
    if (r < 2 * I_G) { const int which = r >= I_G; if (which) r -= I_G; const int e = r / 256, rr = r % 256, kb = rr / 8, nb = rr % 8;
        const float* W = p.in[which ? 19 : 18] + (size_t)e * 2048 * 512; const int n0 = nb * 64;
        transpose_item<true>(W, 512, kb * 64, n0, WguT, 2048, e * 1024 + (n0 >> 7) * 256 + which * 128 + (n0 & 127), 0, g2, scr, lane, 64.f); return; }
    r -= 2 * I_G;
    { const int e = r / 256, rr = r % 256, kb = rr / 32, nb = rr % 32; const float* W = p.in[20] + (size_t)e * 512 * 2048;
      transpose_item<true>(W, 2048, kb * 64, nb * 64, WdT, 512, e * 2048 + nb * 64, 0, nullptr, scr, lane, 64.f); }
}

struct Unit { int pm, pn, aux; };
namespace pg8 {
constexpr int BM = 256, BK = 64, HALF = 128, HTB = HALF * BK * 2, STAGE_BYTES = 8 * HTB;
__device__ __forceinline__ int lds_byte(int r, int c) { const int st = (r >> 4) * 2 + (c >> 5), rr = r & 15, cc = c & 31, ob = rr * 64 + cc * 2; return st * 1024 + (ob ^ (((ob >> 9) & 1) << 5)); }
__device__ __forceinline__ void stage_rc(int b, int& R, int& C) { const int st = b / 1024, sb = b % 1024, swz = sb ^ (((sb >> 9) & 1) << 5); R = (st >> 1) * 16 + swz / 64; C = (st & 1) * 32 + (swz % 64) / 2; }

template <bool PERM, bool GATHER, class Sched, class Epi, bool FP8 = false, bool ALIGN_EPI = true>
__device__ __forceinline__ void gemm_phase(LAS unsigned char* lds, const Sched& S, const Epi& E, const int nt, const int lda, const int ldb) {
    int tid_ = threadIdx.x; asm volatile("" : "+v"(tid_));
    const int tid = tid_, wid = __builtin_amdgcn_readfirstlane(tid >> 6), lane = tid & 63, wr = wid >> 2, wc = wid & 3, fr = lane & 15, fq = lane >> 4;
    int R0, C0, R1, C1; stage_rc(tid * 16, R0, C0); stage_rc(tid * 16 + 8192, R1, C1);
    unsigned voffB[2], voffA[2][2];
    { const int Rb0 = PERM ? ((R0 & ~31) + perm32(R0 & 31)) : R0, Rb1 = PERM ? ((R1 & ~31) + perm32(R1 & 31)) : R1;
      voffB[0] = (unsigned)(Rb0 * ldb + C0) * 2u; voffB[1] = (unsigned)(Rb1 * ldb + C1) * 2u; }
    const size_t kstep = (size_t)(BK * 2);
    const size_t hstepB = (size_t)HALF * ldb * 2, hstepA = (size_t)HALF * lda * 2;
    const unsigned ldsw = (unsigned)wid * 1024u;
    const int aoff = lds_byte(wr * 64 + fr, fq * 8), boff = lds_byte(wc * 32 + fr, fq * 8);
#define PG8_SA(b, h) (((b) * 2 + (h)) * HTB)
#define PG8_SB(b, h) ((4 + (b) * 2 + (h)) * HTB)
#define PG8_STAGE_B(bufoff, gbase) do { _Pragma("unroll") for (int _i = 0; _i < 2; ++_i) \
        __builtin_amdgcn_global_load_lds((const unsigned*)((const char*)(gbase) + voffB[_i]), (LAS unsigned*)(lds + (bufoff) + ldsw + _i * 8192), 16, 0, 0); } while (0)
#define PG8_STAGE_A(bufoff, gbase, h) do { _Pragma("unroll") for (int _i = 0; _i < 2; ++_i) \
        __builtin_amdgcn_global_load_lds((const unsigned*)((const char*)(gbase) + (GATHER ? (size_t)0 : (size_t)(h) * hstepA) + voffA[GATHER ? (h) : 0][_i]), (LAS unsigned*)(lds + (bufoff) + ldsw + _i * 8192), 16, 0, 0); } while (0)
#define PG8_LDA(dst, b, h) do { _Pragma("unroll") for (int m = 0; m < 4; ++m) _Pragma("unroll") for (int k = 0; k < 2; ++k) dst[m][k] = *(const LAS bf16x8*)(lds + PG8_SA(b, h) + aoff + m * 2048 + k * 1024); } while (0)
#define PG8_LDB(dst, b, h) do { _Pragma("unroll") for (int n = 0; n < 2; ++n) _Pragma("unroll") for (int k = 0; k < 2; ++k) dst[n][k] = *(const LAS bf16x8*)(lds + PG8_SB(b, h) + boff + n * 2048 + k * 1024); } while (0)
#define PG8_MMA(ai, bj, At, Bt) do { __builtin_amdgcn_s_setprio(1); _Pragma("unroll") for (int m = 0; m < 4; ++m) _Pragma("unroll") for (int n = 0; n < 2; ++n) { \
        if (FP8) { typedef int v8i_ __attribute__((ext_vector_type(8))); typedef int v4i_ __attribute__((ext_vector_type(4))); \
            const v4i_ b0_ = __builtin_bit_cast(v4i_, Bt[n][0]), b1_ = __builtin_bit_cast(v4i_, Bt[n][1]), a0_ = __builtin_bit_cast(v4i_, At[m][0]), a1_ = __builtin_bit_cast(v4i_, At[m][1]); \
            const v8i_ bb_ = {b0_[0], b0_[1], b0_[2], b0_[3], b1_[0], b1_[1], b1_[2], b1_[3]}, aa_ = {a0_[0], a0_[1], a0_[2], a0_[3], a1_[0], a1_[1], a1_[2], a1_[3]}; \
            acc[ai][bj][m][n] = __builtin_amdgcn_mfma_scale_f32_16x16x128_f8f6f4(bb_, aa_, acc[ai][bj][m][n], 0, 0, 0, 0x7f7f7f7f, 0, 0x7f7f7f7f); } \
        else { _Pragma("unroll") for (int k = 0; k < 2; ++k) acc[ai][bj][m][n] = __builtin_amdgcn_mfma_f32_16x16x32_bf16(Bt[n][k], At[m][k], acc[ai][bj][m][n], 0, 0, 0); } } \
        __builtin_amdgcn_s_setprio(0); } while (0)
#define PG8_WAIT_V(n) asm volatile("s_waitcnt vmcnt(" #n ")" ::: "memory")
#define PG8_WAIT_L(n) asm volatile("s_waitcnt lgkmcnt(" #n ")" ::: "memory")
#define PG8_BAR __builtin_amdgcn_s_barrier()
#define PG8_SCHED __builtin_amdgcn_sched_barrier(0)
    Unit cur, nxt; int ui = 0;
    __syncthreads();
    if (!S.next(0, cur)) return;
    if (GATHER) S.a_offs(cur, R0, C0, R1, C1, voffA);
    else { voffA[0][0] = (unsigned)(R0 * lda + C0) * 2u; voffA[0][1] = (unsigned)(R1 * lda + C1) * 2u; voffA[1][0] = 0; voffA[1][1] = 0; }
    f32x4 acc[2][2][4][2];
#pragma unroll
    for (int a = 0; a < 2; ++a)
#pragma unroll
        for (int b = 0; b < 2; ++b)
#pragma unroll
            for (int m = 0; m < 4; ++m)
#pragma unroll
                for (int n = 0; n < 2; ++n) acc[a][b][m][n] = (f32x4){0.f, 0.f, 0.f, 0.f};
    bf16x8 At[4][2], B0[2][2], B1[2][2];
    const char* cA = S.a_base(cur); const char* cB = S.b_base(cur);
    PG8_STAGE_B(PG8_SB(0, 0), cB); PG8_STAGE_B(PG8_SB(0, 1), cB + hstepB); PG8_STAGE_A(PG8_SA(0, 0), cA, 0); PG8_STAGE_A(PG8_SA(0, 1), cA, 1);
    if (wr == 1) PG8_BAR;
    PG8_WAIT_V(2); PG8_BAR;
    PG8_STAGE_B(PG8_SB(1, 0), cB + kstep); PG8_STAGE_A(PG8_SA(1, 0), cA + kstep, 0); PG8_STAGE_B(PG8_SB(1, 1), cB + hstepB + kstep);
    PG8_WAIT_V(6); PG8_BAR;
    for (;;) {
        const bool has_next = S.next(ui + 1, nxt);
        const char* nA = has_next ? S.a_base(nxt) : cA; const char* nB = has_next ? S.b_base(nxt) : cB;
        unsigned vn[2][2];
        if (GATHER) { if (has_next) S.a_offs(nxt, R0, C0, R1, C1, vn); else { vn[0][0] = voffA[0][0]; vn[0][1] = voffA[0][1]; vn[1][0] = voffA[1][0]; vn[1][1] = voffA[1][1]; } }
        for (int t = 0; t < nt; t += 2) {
            const bool last = (t == nt - 2);
            const char* a1 = cA + (size_t)(t + 1) * kstep;
            const char* a2 = last ? nA : cA + (size_t)(t + 2) * kstep; const char* b2 = last ? nB : cB + (size_t)(t + 2) * kstep;
            const char* a3 = a2 + kstep; const char* b3 = b2 + kstep;
            PG8_LDB(B0, 0, 0); PG8_LDB(B1, 0, 1); PG8_SCHED; PG8_LDA(At, 0, 0); PG8_STAGE_A(PG8_SA(1, 1), a1, 1);
            if (GATHER) { if (last) { voffA[0][0] = vn[0][0]; voffA[0][1] = vn[0][1]; voffA[1][0] = vn[1][0]; voffA[1][1] = vn[1][1]; } }
            PG8_WAIT_V(8); PG8_WAIT_L(0); PG8_BAR; PG8_MMA(0, 0, At, B0); PG8_MMA(0, 1, At, B1); PG8_BAR; PG8_SCHED;
            PG8_LDA(At, 0, 1); PG8_STAGE_B(PG8_SB(0, 0), b2); PG8_STAGE_B(PG8_SB(0, 1), b2 + hstepB); PG8_STAGE_A(PG8_SA(0, 0), a2, 0);
            PG8_WAIT_V(8); PG8_WAIT_L(0); PG8_BAR; PG8_MMA(1, 0, At, B0); PG8_MMA(1, 1, At, B1); PG8_BAR; PG8_SCHED;
            PG8_LDB(B0, 1, 0); PG8_LDB(B1, 1, 1); PG8_SCHED; PG8_LDA(At, 1, 0); PG8_STAGE_A(PG8_SA(0, 1), a2, 1);
            PG8_WAIT_V(8); PG8_WAIT_L(0); PG8_BAR; PG8_MMA(0, 0, At, B0); PG8_MMA(0, 1, At, B1); PG8_BAR; PG8_SCHED;
            PG8_LDA(At, 1, 1); PG8_STAGE_B(PG8_SB(1, 0), b3); PG8_STAGE_B(PG8_SB(1, 1), b3 + hstepB); PG8_STAGE_A(PG8_SA(1, 0), a3, 0);
            PG8_WAIT_V(8); PG8_WAIT_L(0); PG8_BAR; PG8_MMA(1, 0, At, B0); PG8_MMA(1, 1, At, B1); PG8_BAR; PG8_SCHED;
        }
        if (ALIGN_EPI) { if (wr == 0) PG8_BAR; }
        { int te = threadIdx.x; asm volatile("" : "+v"(te)); E(acc, cur, wr, wc, te & 15, (te & 63) >> 4); }
        if (!has_next) break;
        if (!S.keep_acc(cur)) {
#pragma unroll
        for (int a = 0; a < 2; ++a)
#pragma unroll
            for (int b = 0; b < 2; ++b)
#pragma unroll
                for (int m = 0; m < 4; ++m)
#pragma unroll
                    for (int n = 0; n < 2; ++n) acc[a][b][m][n] = (f32x4){0.f, 0.f, 0.f, 0.f};
        }
        cur = nxt; cA = nA; cB = nB; ++ui;
        if (ALIGN_EPI) { if (wr == 1) PG8_BAR; }
    }
    PG8_WAIT_V(0);
    if (!ALIGN_EPI) { if (wr == 0) PG8_BAR; }
    PG8_BAR;
#undef PG8_SA
#undef PG8_SB
#undef PG8_STAGE_A
#undef PG8_STAGE_B
#undef PG8_LDA
#undef PG8_LDB
#undef PG8_MMA
#undef PG8_WAIT_V
#undef PG8_WAIT_L
#undef PG8_BAR
#undef PG8_SCHED
}
struct TileOrder {
    int nM, nN, nwg, G, c;
    __device__ __forceinline__ void init(int nM_, int nN_, int G_, int c_) { nM = nM_; nN = nN_; nwg = nM * nN; G = G_; c = c_; }
    __device__ __forceinline__ bool tile(int i, int& pm, int& pn) const {
        const long L = (long)i * G + c; if (L >= nwg) return false;
        int wgid = (int)L; { const int q = nwg / 8, r = nwg % 8, xcd = wgid % 8, off = wgid / 8; wgid = (xcd < r ? xcd * (q + 1) : r * (q + 1) + (xcd - r) * q) + off; }
        const int nig = 8 * nN, gid = wgid / nig, fm = gid * 8, gsz = (nM - fm) < 8 ? (nM - fm) : 8;
        pm = fm + ((wgid % nig) % gsz); pn = (wgid % nig) / gsz; return true;
    }
};
struct DenseSched {
    TileOrder o; const bf16_t* A; const bf16_t* Bt; int lda, ldb;
    __device__ __forceinline__ bool next(int i, Unit& u) const { u.aux = 0; return o.tile(i, u.pm, u.pn); }
    __device__ __forceinline__ const char* a_base(const Unit& u) const { return (const char*)(A + (size_t)u.pm * 256 * lda); }
    __device__ __forceinline__ const char* b_base(const Unit& u) const { return (const char*)(Bt + (size_t)u.pn * 256 * ldb); }
    __device__ __forceinline__ bool keep_acc(const Unit&) const { return false; }
    __device__ __forceinline__ void a_offs(const Unit&, int, int, int, int, unsigned (&)[2][2]) const {}
};
}

struct EpiInProj { bf16_t* qkv; const float* r1; const float* gqa; const float* gka; const float* gqb; const float* gkb; LAS float* X;
    __device__ __forceinline__ void operator()(f32x4 (&acc)[2][2][4][2], const Unit& u, int wr, int wc, int fr, int fq) const {
        const int pn = u.pn;
        bf16_t* base = qkv; const int ldc = NQKV; const int colt = pn * 256 + wc * 32 + 8 * fq;
        const float* gain = pn < 4 ? gqa : (pn == 4 ? gka : ((pn >= 6 && pn < 10) ? gqb : ((pn >= 10 && pn < 14) ? gkb : nullptr)));
        if (gain) {
            const float extra = (pn < 4 || (pn >= 6 && pn < 10)) ? 0.08838834764831845f * 1.4426950408889634f : 1.0f;
#pragma unroll
            for (int ai = 0; ai < 2; ++ai)
#pragma unroll
                for (int m = 0; m < 4; ++m)
#pragma unroll
                    for (int bj = 0; bj < 2; ++bj) { const f32x4 a0 = acc[ai][bj][m][0], a1 = acc[ai][bj][m][1];
                        float sq = (a0[0] * a0[0] + a0[1] * a0[1]) + (a0[2] * a0[2] + a0[3] * a0[3]) + (a1[0] * a1[0] + a1[1] * a1[1]) + (a1[2] * a1[2] + a1[3] * a1[3]);
                        sq += __shfl_xor(sq, 16); sq += __shfl_xor(sq, 32);
                        if (fq == 0) X[(ai * 128 + wr * 64 + m * 16 + fr) * 8 + bj * 4 + wc] = sq; }
            asm volatile("s_waitcnt lgkmcnt(0)" ::: "memory"); __builtin_amdgcn_s_barrier(); asm volatile("" ::: "memory");
            const f32x4 g0 = *(const f32x4*)(gain + wc * 32 + 8 * fq), g1 = *(const f32x4*)(gain + wc * 32 + 8 * fq + 4);
#pragma unroll
            for (int ai = 0; ai < 2; ++ai)
#pragma unroll
                for (int m = 0; m < 4; ++m) { const int rl = ai * 128 + wr * 64 + m * 16 + fr; const int row = u.pm * 256 + rl; const float rs = r1[row] * (1.0f / 64.0f); bf16_t* rowp = base + (size_t)row * ldc + colt;
#pragma unroll
                    for (int bj = 0; bj < 2; ++bj) { const f32x4 t = *(const LAS f32x4*)(X + rl * 8 + bj * 4); const float tot = (t[0] + t[1]) + (t[2] + t[3]);
                        const float sc = rs * rsqrtf(rs * rs * tot * (1.0f / 128.0f) + EPS) * extra;
                        const f32x4 v0 = acc[ai][bj][m][0] * sc * g0, v1 = acc[ai][bj][m][1] * sc * g1;
                        u32x4 w; w.x = pk2(v0[0], v0[1]); w.y = pk2(v0[2], v0[3]); w.z = pk2(v1[0], v1[1]); w.w = pk2(v1[2], v1[3]);
                        *(u32x4*)(rowp + bj * 128) = w; } }
            return;
        }
#pragma unroll
        for (int ai = 0; ai < 2; ++ai)
#pragma unroll
            for (int m = 0; m < 4; ++m) { const int row = u.pm * 256 + ai * 128 + wr * 64 + m * 16 + fr; const float rs = r1[row] * (1.0f / 64.0f); bf16_t* rowp = base + (size_t)row * ldc + colt;
#pragma unroll
                for (int bj = 0; bj < 2; ++bj) { const f32x4 v0 = acc[ai][bj][m][0] * rs, v1 = acc[ai][bj][m][1] * rs;
                    u32x4 w; w.x = pk2(v0[0], v0[1]); w.y = pk2(v0[2], v0[3]); w.z = pk2(v1[0], v1[1]); w.w = pk2(v1[2], v1[3]);
                    *(u32x4*)(rowp + bj * 128) = w; } }
    } };
struct GateSched { pg8::TileOrder o; const unsigned char* x8; const unsigned char* W8;
    __device__ __forceinline__ bool next(int i, Unit& u) const { u.aux = 0; return o.tile(i, u.pm, u.pn); }
    __device__ __forceinline__ const char* a_base(const Unit&) const { return (const char*)x8; }
    __device__ __forceinline__ const char* b_base(const Unit& u) const { return (const char*)(W8 + (size_t)(u.pn * 256) * D); }
    __device__ __forceinline__ bool keep_acc(const Unit&) const { return false; }
    __device__ __forceinline__ void a_offs(const Unit& u, int R0, int C0, int R1, int C1, unsigned (&v)[2][2]) const {
#pragma unroll
        for (int h = 0; h < 2; ++h) { v[h][0] = (unsigned)(u.pm * 256 + 128 * h + R0) * D + C0 * 2u; v[h][1] = (unsigned)(u.pm * 256 + 128 * h + R1) * D + C1 * 2u; } }
};
struct EpiGates { bf16_t* gates; const float* r1;
    __device__ __forceinline__ void operator()(f32x4 (&acc)[2][2][4][2], const Unit& u, int wr, int wc, int fr, int fq) const {
        const int cg = u.pn * 128 + wc * 32 + 8 * fq;
#pragma unroll
        for (int ai = 0; ai < 2; ++ai)
#pragma unroll
            for (int m = 0; m < 4; ++m) { const int row = u.pm * 256 + ai * 128 + wr * 64 + m * 16 + fr; const float rs = r1[row] * (1.0f / 64.0f); bf16_t* rowp = gates + (size_t)row * NGATE + cg;
                float ra[8], sb[8];
#pragma unroll
                for (int n = 0; n < 2; ++n)
#pragma unroll
                    for (int j = 0; j < 4; ++j) { const float ea = __expf(-acc[ai][0][m][n][j] * rs), eb = fminf(__expf(-acc[ai][1][m][n][j] * rs), 1e30f);
                        sb[4 * n + j] = __builtin_amdgcn_rcpf(1.0f + eb); ra[4 * n + j] = (1.0f + eb) * __builtin_amdgcn_rcpf(1.0f + ea); }
                u32x4 w; w.x = pk2(ra[0], ra[1]); w.y = pk2(ra[2], ra[3]); w.z = pk2(ra[4], ra[5]); w.w = pk2(ra[6], ra[7]); *(u32x4*)rowp = w;
                w.x = pk2(sb[0], sb[1]); w.y = pk2(sb[2], sb[3]); w.z = pk2(sb[4], sb[5]); w.w = pk2(sb[6], sb[7]); *(u32x4*)(rowp + 2048) = w; }
    } };
__device__ __forceinline__ void p1_inproj(const Params& p, LAS unsigned char* lds) {
    { GateSched S; S.o.init(128, 18, gridDim.x, blockIdx.x); S.x8 = p.ws + WS_X8; S.W8 = p.ws + WS_WIN;
      EpiInProj E{(bf16_t*)(p.ws + WS_QKV), (const float*)(p.ws + WS_R1), p.in[3], p.in[4], p.in[6], p.in[7], (LAS float*)(lds + 131072)};
      pg8::gemm_phase<true, true, GateSched, EpiInProj, true>(lds, S, E, D / 128, D / 2, D / 2); }
    { GateSched S; S.o.init(128, 16, gridDim.x, blockIdx.x); S.x8 = p.ws + WS_X8; S.W8 = p.ws + WS_WIN + (size_t)NQKV * D;
      EpiGates E{(bf16_t*)(p.ws + WS_GATES), (const float*)(p.ws + WS_R1)};
      pg8::gemm_phase<true, true, GateSched, EpiGates, true>(lds, S, E, D / 128, D / 2, D / 2); }
}

__device__ __forceinline__ void wait_vm(int n) {
    switch (n) { case 0: asm volatile("s_waitcnt vmcnt(0)" ::: "memory"); break; case 2: asm volatile("s_waitcnt vmcnt(2)" ::: "memory"); break; case 4: asm volatile("s_waitcnt vmcnt(4)" ::: "memory"); break;
                 case 6: asm volatile("s_waitcnt vmcnt(6)" ::: "memory"); break; case 8: asm volatile("s_waitcnt vmcnt(8)" ::: "memory"); break; case 10: asm volatile("s_waitcnt vmcnt(10)" ::: "memory"); break;
                 default: asm volatile("s_waitcnt vmcnt(12)" ::: "memory"); break; }
}
__device__ __forceinline__ void glds16_asm(const void* gsrc, unsigned lds_dst) {
    unsigned keep;
    asm volatile("s_mov_b32 %0, m0\n\ts_mov_b32 m0, %2\n\ts_nop 0\n\tglobal_load_lds_dwordx4 %1, off\n\ts_mov_b32 m0, %0" : "=&s"(keep) : "v"(gsrc), "s"(lds_dst) : "memory");
}
#define ATT_BAR() do { asm volatile("s_waitcnt lgkmcnt(0)" ::: "memory"); __builtin_amdgcn_s_barrier(); asm volatile("" ::: "memory"); } while (0)
__device__ __forceinline__ void load_q(const bf16_t* qp, int g, bf16x8 (&qf)[4]) {
#pragma unroll
    for (int ks = 0; ks < 4; ++ks) qf[ks] = *(const bf16x8*)(qp + 32 * ks + 8 * g);
#pragma unroll
    for (int ks = 0; ks < 4; ++ks) asm volatile("" : "+v"(qf[ks]));
}
__device__ __forceinline__ bf16x8 vt_frag(LAS unsigned char* base, int row0, int g, int q4, int pp, int dt) {
    const s16x4 lo = tr_read(base + off_b(row0 + 4 * g + q4, 2 * dt + (pp >> 1)) + 8 * (pp & 1)), hi = tr_read(base + off_b(row0 + 16 + 4 * g + q4, 2 * dt + (pp >> 1)) + 8 * (pp & 1));
    bf16x8 vf; vf[0] = lo[0]; vf[1] = lo[1]; vf[2] = lo[2]; vf[3] = lo[3]; vf[4] = hi[0]; vf[5] = hi[1]; vf[6] = hi[2]; vf[7] = hi[3]; return vf;
}

__device__ __forceinline__ void attn_window_item(const Params& p, LAS unsigned char* lds, int item, int& tab_head) {
    const int tid = phase_tid(), lane = tid & 63, w = __builtin_amdgcn_readfirstlane(tid >> 6), g = lane >> 4, ql = lane & 15;
    const int b = item >> 9, nb = (item >> 2) & 127, hpq = item & 3, kv = hpq >> 1, hq0 = 2 * hpq;
    const bf16_t* qkv = (const bf16_t*)(p.ws + WS_QKV); bf16_t* o = (bf16_t*)(p.ws + WS_O);
    LAS float* bias = (LAS float*)(lds + 131072); const unsigned ldsb = (unsigned)(size_t)lds;
    const unsigned loff = (unsigned)(w * 4 + g) * NQKV + (unsigned)((ql ^ ((g << 2) | (w & 3))) * 8);
    const bf16_t* kbase = qkv + (size_t)(b * SEQ) * NQKV + 1024 + kv * 128;
#define WIN_ISSUE(c) do { const int _c = (c); const int _kb = min(max(nb - 1 + (_c % 3), 0), 127); const bf16_t* _src = kbase + (size_t)(_kb * 128) * NQKV + (_c >= 3 ? 256 : 0) + loff; \
        _Pragma("unroll") for (int _i = 0; _i < 4; ++_i) glds16_asm(_src + (size_t)(32 * _i) * NQKV, ldsb + (unsigned)((_c & 3) * 32768 + _i * 8192 + w * 1024)); } while (0)
    ATT_BAR();
    WIN_ISSUE(0); WIN_ISSUE(1); WIN_ISSUE(2);
    if (hpq != tab_head) { for (int i = tid; i < 2 * 257; i += 512) { const int hh = i >= 257, j = i - 257 * hh; bias[hh * 264 + j] = p.in[12][t5_bucket(j - 128) * 8 + hq0 + hh] * 1.4426950408889634f; } tab_head = hpq; }
    const int tq = b * SEQ + nb * 128 + 16 * w + ql;
    bf16x8 qf[2][4]; load_q(qkv + (size_t)tq * NQKV + hq0 * 128, g, qf[0]); load_q(qkv + (size_t)tq * NQKV + (hq0 + 1) * 128, g, qf[1]);
    float sink[2]; sink[0] = p.in[5][hq0] * 1.4426950408889634f; sink[1] = p.in[5][hq0 + 1] * 1.4426950408889634f; asm volatile("" : "+v"(sink[0]), "+v"(sink[1]));
    f32x4 S1[2][8], SC[2][9];
#pragma unroll
    for (int u = 0; u < 2; ++u) {
#pragma unroll
        for (int kt = 0; kt < 8; ++kt) S1[u][kt] = (f32x4){0.f, 0.f, 0.f, 0.f};
#pragma unroll
        for (int s = 0; s < 9; ++s) SC[u][s] = (f32x4){0.f, 0.f, 0.f, 0.f}; }
    const bool in0 = nb > 0, in2 = nb < 127;
#pragma unroll
    for (int c = 0; c < 3; ++c) {
        wait_vm(8); ATT_BAR(); WIN_ISSUE(c + 3);
        LAS unsigned char* buf = lds + (c & 3) * 32768;
#pragma unroll
        for (int kt = 0; kt < 8; ++kt) {
            const bool act = (c == 1) || (c == 0 ? kt >= w : kt <= w);
            if (act) {
#pragma unroll
                for (int ks = 0; ks < 4; ++ks) { const bf16x8 kf = *(const LAS bf16x8*)(buf + off_b(16 * kt + ql, 4 * ks + g));
#pragma unroll
                    for (int u = 0; u < 2; ++u) {
                        if (c == 1) S1[u][kt] = __builtin_amdgcn_mfma_f32_16x16x32_bf16(kf, qf[u][ks], S1[u][kt], 0, 0, 0);
                        else if (c == 0) SC[u][7 - kt] = __builtin_amdgcn_mfma_f32_16x16x32_bf16(kf, qf[u][ks], SC[u][7 - kt], 0, 0, 0);
                        else SC[u][8 - kt] = __builtin_amdgcn_mfma_f32_16x16x32_bf16(kf, qf[u][ks], SC[u][8 - kt], 0, 0, 0); } } }
        }
    }
    const int qi = 16 * w + ql; float inv[2];
    unsigned P1[2][4][4], PC[2][9][2];
#pragma unroll
    for (int u = 0; u < 2; ++u) { float mx = sink[u]; const LAS float* bt = bias + u * 264;
#pragma unroll
        for (int kt = 0; kt < 8; ++kt)
#pragma unroll
            for (int r = 0; r < 4; ++r) { const int rel = 16 * kt + 4 * g + r - qi; const float sv = S1[u][kt][r] + bt[rel + 128]; S1[u][kt][r] = sv; mx = fmaxf(mx, sv); }
#pragma unroll
        for (int s = 0; s < 9; ++s) { const bool c0 = s <= 7 - w; const int kt = c0 ? 7 - s : 8 - s; const int cofs = c0 ? -128 : 128; const bool inr = c0 ? in0 : in2;
#pragma unroll
            for (int r = 0; r < 4; ++r) { const int rel = cofs + 16 * kt + 4 * g + r - qi; const bool valid = inr && rel >= -128 && rel <= 128;
                const float bv = bt[rel + 128];
                const float sv = valid ? SC[u][s][r] + bv : -1e30f; SC[u][s][r] = sv; mx = fmaxf(mx, sv); } }
        mx = fmaxf(mx, __shfl_xor(mx, 16)); mx = fmaxf(mx, __shfl_xor(mx, 32));
        float l = 0.f;
#pragma unroll
        for (int kk = 0; kk < 4; ++kk) { float e[8];
#pragma unroll
            for (int r = 0; r < 4; ++r) { e[r] = __builtin_amdgcn_exp2f(S1[u][2 * kk][r] - mx); e[4 + r] = __builtin_amdgcn_exp2f(S1[u][2 * kk + 1][r] - mx); l += e[r] + e[4 + r]; }
            P1[u][kk][0] = pk2(e[0], e[1]); P1[u][kk][1] = pk2(e[2], e[3]); P1[u][kk][2] = pk2(e[4], e[5]); P1[u][kk][3] = pk2(e[6], e[7]); }
#pragma unroll
        for (int s = 0; s < 9; ++s) { float e[4];
#pragma unroll
            for (int r = 0; r < 4; ++r) { e[r] = __builtin_amdgcn_exp2f(SC[u][s][r] - mx); l += e[r]; }
            PC[u][s][0] = pk2(e[0], e[1]); PC[u][s][1] = pk2(e[2], e[3]); }
        l += __shfl_xor(l, 16); l += __shfl_xor(l, 32); l += __builtin_amdgcn_exp2f(sink[u] - mx);
        inv[u] = 1.0f / l; }
    f32x4 O[2][8];
#pragma unroll
    for (int u = 0; u < 2; ++u)
#pragma unroll
        for (int dt = 0; dt < 8; ++dt) O[u][dt] = (f32x4){0.f, 0.f, 0.f, 0.f};
    const int q4 = ql >> 2, pp = ql & 3;
#pragma unroll
    for (int c = 0; c < 3; ++c) {
        wait_vm(c == 0 ? 8 : (c == 1 ? 4 : 0)); ATT_BAR();
        LAS unsigned char* buf = lds + ((c + 3) & 3) * 32768;
#pragma unroll
        for (int kk = 0; kk < 4; ++kk) {
            bool a0, a1;
            if (c == 1) { a0 = true; a1 = true; } else if (c == 0) { a0 = 2 * kk >= w; a1 = 2 * kk + 1 >= w; } else { a0 = 2 * kk <= w; a1 = 2 * kk + 1 <= w; }
            if (a0 || a1) { bf16x8 pf[2];
#pragma unroll
                for (int u = 0; u < 2; ++u) { u32x4 pw;
                    if (c == 1) { pw.x = P1[u][kk][0]; pw.y = P1[u][kk][1]; pw.z = P1[u][kk][2]; pw.w = P1[u][kk][3]; }
                    else if (c == 0) { pw.x = a0 ? PC[u][7 - 2 * kk][0] : 0u; pw.y = a0 ? PC[u][7 - 2 * kk][1] : 0u; pw.z = a1 ? PC[u][6 - 2 * kk][0] : 0u; pw.w = a1 ? PC[u][6 - 2 * kk][1] : 0u; }
                    else { pw.x = a0 ? PC[u][8 - 2 * kk][0] : 0u; pw.y = a0 ? PC[u][8 - 2 * kk][1] : 0u; pw.z = a1 ? PC[u][7 - 2 * kk][0] : 0u; pw.w = a1 ? PC[u][7 - 2 * kk][1] : 0u; }
                    pf[u] = __builtin_bit_cast(bf16x8, pw); }
#pragma unroll
                for (int dt = 0; dt < 8; ++dt) { const bf16x8 vf = vt_frag(buf, 32 * kk, g, q4, pp, dt);
                    O[0][dt] = __builtin_amdgcn_mfma_f32_16x16x32_bf16(vf, pf[0], O[0][dt], 0, 0, 0); O[1][dt] = __builtin_amdgcn_mfma_f32_16x16x32_bf16(vf, pf[1], O[1][dt], 0, 0, 0); } } }
    }
#undef WIN_ISSUE
#pragma unroll
    for (int u = 0; u < 2; ++u) { bf16_t* op = o + (size_t)tq * D + (hq0 + u) * 128 + 4 * g;
#pragma unroll
        for (int dt = 0; dt < 8; ++dt) { u32x2 w2; w2.x = pk2(O[u][dt][0] * inv[u], O[u][dt][1] * inv[u]); w2.y = pk2(O[u][dt][2] * inv[u], O[u][dt][3] * inv[u]); *(u32x2*)(op + 16 * dt) = w2; } }
}

__device__ __forceinline__ void attn_nat_item(const Params& p, LAS unsigned char* lds, int item, int& tab_head) {
    const int tid = phase_tid(), lane = tid & 63, w = __builtin_amdgcn_readfirstlane(tid >> 6), g = lane >> 4, ql = lane & 15;
    const int b = item >> 9, rp = (item >> 2) & 127, hp = item & 3, hh = w >> 2, h = 2 * hp + hh, jq = w & 3;
    const int kr_lo = min(max(2 * rp - 4, 0), 248);
    const int d0 = min(max(2 * rp - 4, 0), 248) - kr_lo, d1 = min(max(2 * rp - 3, 0), 248) - kr_lo;
    const int w0 = jq == 0 ? 0 : (jq == 1 ? 8 : (jq == 2 ? 24 : 32));
    const bf16_t* qkv = (const bf16_t*)(p.ws + WS_QKV); bf16_t* o = (bf16_t*)(p.ws + WS_O);
    LAS float* rpb = (LAS float*)(lds + 131072); const unsigned ldsb = (unsigned)(size_t)lds;
    const unsigned loff = (unsigned)(w * 4 + g) * NQKV + (unsigned)((ql ^ ((g << 2) | (w & 3))) * 8);
    const bf16_t* kbase = qkv + (size_t)(b * SEQ) * NQKV + 2560 + 2 * hp * 128;
#define NAT_ISSUE(s) do { const int _s = (s); const int _kr = min(kr_lo + (_s % 9), 255); const bf16_t* _src = kbase + (size_t)(_kr * 64) * NQKV + (_s >= 9 ? 1024 : 0) + loff; \
        _Pragma("unroll") for (int _i = 0; _i < 4; ++_i) glds16_asm(_src + (size_t)(32 * (_i & 1)) * NQKV + 128 * (_i >> 1), ldsb + (unsigned)((_s & 3) * 32768 + _i * 8192 + w * 1024)); } while (0)
    ATT_BAR();
    NAT_ISSUE(0); NAT_ISSUE(1); NAT_ISSUE(2);
    if (hp != tab_head) { for (int i = tid; i < 930; i += 512) rpb[i] = p.in[8][2 * hp * 465 + i] * 1.4426950408889634f; tab_head = hp; }
    const int qcol = 16 * jq + ql; const int tq0 = b * SEQ + (2 * rp) * 64 + qcol;
    bf16x8 qf[2][4]; load_q(qkv + (size_t)tq0 * NQKV + 1536 + h * 128, g, qf[0]); load_q(qkv + (size_t)(tq0 + 64) * NQKV + 1536 + h * 128, g, qf[1]);
    f32x4 S[2][9][2];
#pragma unroll
    for (int u = 0; u < 2; ++u)
#pragma unroll
        for (int c = 0; c < 9; ++c) { S[u][c][0] = (f32x4){0.f, 0.f, 0.f, 0.f}; S[u][c][1] = (f32x4){0.f, 0.f, 0.f, 0.f}; }
#pragma unroll
    for (int c = 0; c < 9; ++c) {
        wait_vm(8); ATT_BAR(); NAT_ISSUE(c + 3);
        const bool a0 = c >= d0 && c < d0 + 8, a1 = c >= d1 && c < d1 + 8;
        LAS unsigned char* buf = lds + (c & 3) * 32768 + hh * 16384;
#pragma unroll
        for (int t = 0; t < 2; ++t)
#pragma unroll
            for (int ks = 0; ks < 4; ++ks) { const bf16x8 kf = *(const LAS bf16x8*)(buf + off_b(w0 + 16 * t + ql, 4 * ks + g));
                if (a0) S[0][c][t] = __builtin_amdgcn_mfma_f32_16x16x32_bf16(kf, qf[0][ks], S[0][c][t], 0, 0, 0);
                if (a1) S[1][c][t] = __builtin_amdgcn_mfma_f32_16x16x32_bf16(kf, qf[1][ks], S[1][c][t], 0, 0, 0); }
    }
    const int cs = min(max(qcol - 8, 0), 48); float inv[2];
    unsigned P[2][9][4];
    int dcv[2][4]; bool cv[2][4];
#pragma unroll
    for (int t = 0; t < 2; ++t)
#pragma unroll
        for (int q = 0; q < 4; ++q) { const int kc = w0 + 16 * t + 4 * g + q; cv[t][q] = kc >= cs && kc < cs + 16; dcv[t][q] = hh * 465 + kc - qcol + 15; }
#pragma unroll
    for (int u = 0; u < 2; ++u) { const int du = u ? d1 : d0; const int r = 2 * rp + u; float mx = -1e30f;
#pragma unroll
        for (int c = 0; c < 9; ++c) { const bool act = c >= du && c < du + 8;
            if (act) { const int rowb = (kr_lo + c - r + 7) * 31;
#pragma unroll
                for (int t = 0; t < 2; ++t)
#pragma unroll
                    for (int q = 0; q < 4; ++q) { const float sv = cv[t][q] ? S[u][c][t][q] + rpb[rowb + dcv[t][q]] : -1e30f; S[u][c][t][q] = sv; mx = fmaxf(mx, sv); } } }
        mx = fmaxf(mx, __shfl_xor(mx, 16)); mx = fmaxf(mx, __shfl_xor(mx, 32));
        float l = 0.f;
#pragma unroll
        for (int c = 0; c < 9; ++c) { const bool act = c >= du && c < du + 8;
            if (act) { float e[2][4];
#pragma unroll
                for (int t = 0; t < 2; ++t)
#pragma unroll
                    for (int q = 0; q < 4; ++q) { e[t][q] = __builtin_amdgcn_exp2f(S[u][c][t][q] - mx); l += e[t][q]; }
                P[u][c][0] = pk2(e[0][0], e[0][1]); P[u][c][1] = pk2(e[0][2], e[0][3]); P[u][c][2] = pk2(e[1][0], e[1][1]); P[u][c][3] = pk2(e[1][2], e[1][3]); }
            else { P[u][c][0] = 0u; P[u][c][1] = 0u; P[u][c][2] = 0u; P[u][c][3] = 0u; } }
        l += __shfl_xor(l, 16); l += __shfl_xor(l, 32);
        inv[u] = 1.0f / l; }
    f32x4 O[2][8];
#pragma unroll
    for (int u = 0; u < 2; ++u)
#pragma unroll
        for (int dt = 0; dt < 8; ++dt) O[u][dt] = (f32x4){0.f, 0.f, 0.f, 0.f};
    const int q4 = ql >> 2, pp = ql & 3;
#pragma unroll
    for (int c = 0; c < 9; ++c) {
        wait_vm(c <= 6 ? 8 : (c == 7 ? 4 : 0)); ATT_BAR(); if (c + 12 < 18) NAT_ISSUE(c + 12);
        const bool a0 = c >= d0 && c < d0 + 8, a1 = c >= d1 && c < d1 + 8;
        LAS unsigned char* buf = lds + ((c + 9) & 3) * 32768 + hh * 16384;
        u32x4 pw0; pw0.x = P[0][c][0]; pw0.y = P[0][c][1]; pw0.z = P[0][c][2]; pw0.w = P[0][c][3];
        u32x4 pw1; pw1.x = P[1][c][0]; pw1.y = P[1][c][1]; pw1.z = P[1][c][2]; pw1.w = P[1][c][3];
        const bf16x8 pf0 = __builtin_bit_cast(bf16x8, pw0), pf1 = __builtin_bit_cast(bf16x8, pw1);
#pragma unroll
        for (int dt = 0; dt < 8; ++dt) { const bf16x8 vf = vt_frag(buf, w0, g, q4, pp, dt);
            if (a0) O[0][dt] = __builtin_amdgcn_mfma_f32_16x16x32_bf16(vf, pf0, O[0][dt], 0, 0, 0);
            if (a1) O[1][dt] = __builtin_amdgcn_mfma_f32_16x16x32_bf16(vf, pf1, O[1][dt], 0, 0, 0); }
    }
#undef NAT_ISSUE
#pragma unroll
    for (int u = 0; u < 2; ++u) { bf16_t* op = o + (size_t)(tq0 + 64 * u) * D + 1024 + h * 128 + 4 * g;
#pragma unroll
        for (int dt = 0; dt < 8; ++dt) { u32x2 w2; w2.x = pk2(O[u][dt][0] * inv[u], O[u][dt][1] * inv[u]); w2.y = pk2(O[u][dt][2] * inv[u], O[u][dt][3] * inv[u]); *(u32x2*)(op + 16 * dt) = w2; } }
}
__device__ __forceinline__ void p2_attn(const Params& p, LAS unsigned char* lds) {
    int tab_head = -1, mb = 0;
    const int nper = (1024 + (int)gridDim.x - 1) / (int)gridDim.x;
    const int NB = (MOE_ITEMS + 8 * (int)gridDim.x - 1) / (8 * (int)gridDim.x);
    for (int s = 0; s < 2 * nper || mb < NB; ++s) {
        if (s < 2 * nper) {
            const bool nat = s >= nper; const int it = (int)blockIdx.x + (nat ? s - nper : s) * (int)gridDim.x;
            if (s == nper) { tab_head = -1;
#ifdef PROBE_A
                if (blockIdx.x == 0 && threadIdx.x == 0) ((unsigned long long*)(p.ws + WS_END))[11] = __builtin_amdgcn_s_memrealtime();
#endif
            }
            if (it < 1024) { if (!nat) attn_window_item(p, lds, it, tab_head); else attn_nat_item(p, lds, it, tab_head); }
        }
        if ((((s + (int)blockIdx.x) & 1) == 0 || s >= 2 * nper) && mb < NB) {
            ATT_BAR();
            for (int q = 0; q < 3 && mb < NB; ++q) moe_prep_batch(p, lds, mb++);
        }
    }
    asm volatile("s_waitcnt vmcnt(0)" ::: "memory"); __syncthreads();
}

struct UpHook { const bf16_t* gates;
    __device__ __forceinline__ void operator()(f32x4 (&acc)[2][2][4][2], const Unit& u, int wr, int wc, int fr, int fq) const {
        const unsigned goff = (unsigned)(u.pm * 256 + wr * 64 + fr) * NGATE + u.pn * 256 + wc * 32 + 8 * fq;
#pragma unroll
        for (int ai = 0; ai < 2; ++ai) {
            bf16x8 ra[4][2];
#pragma unroll
            for (int m = 0; m < 4; ++m)
#pragma unroll
                for (int bj = 0; bj < 2; ++bj) ra[m][bj] = *(const bf16x8*)(gates + goff + (unsigned)((ai * 128 + m * 16) * NGATE) + bj * 128);
#pragma unroll
            for (int m = 0; m < 4; ++m)
#pragma unroll
                for (int bj = 0; bj < 2; ++bj)
#pragma unroll
                    for (int n = 0; n < 2; ++n)
#pragma unroll
                        for (int j = 0; j < 4; ++j) acc[ai][bj][m][n][j] *= bf2f(ra[m][bj][4 * n + j]);
            asm volatile("" ::: "memory"); }
    } };
struct UpSched {
    pg8::TileOrder o; const bf16_t* A; const bf16_t* Bt;
    __device__ __forceinline__ bool next(int i, Unit& u) const { u.aux = i & 1; return o.tile(i >> 1, u.pm, u.pn); }
    __device__ __forceinline__ const char* a_base(const Unit& u) const { return (const char*)(A + (size_t)u.pm * 256 * D + u.aux * 1024); }
    __device__ __forceinline__ const char* b_base(const Unit& u) const { return (const char*)(Bt + (size_t)u.pn * 256 * D + u.aux * 1024); }
    __device__ __forceinline__ bool keep_acc(const Unit& u) const { return u.aux == 0; }
    __device__ __forceinline__ void a_offs(const Unit&, int, int, int, int, unsigned (&)[2][2]) const {}
};
struct EpiUp { const bf16_t* gates; bf16_t* merged;
    __device__ __forceinline__ void operator()(f32x4 (&acc)[2][2][4][2], const Unit& u, int wr, int wc, int fr, int fq) const {
        if (u.aux == 0) { UpHook{gates}(acc, u, wr, wc, fr, fq); return; }
        const unsigned goff = (unsigned)(u.pm * 256 + wr * 64 + fr) * NGATE + 2048 + u.pn * 256 + wc * 32 + 8 * fq;
        const unsigned moff = (unsigned)(u.pm * 256 + wr * 64 + fr) * D + u.pn * 256 + wc * 32 + 8 * fq;
#pragma unroll
        for (int ai = 0; ai < 2; ++ai) {
            bf16x8 sb[4][2];
#pragma unroll
            for (int m = 0; m < 4; ++m)
#pragma unroll
                for (int bj = 0; bj < 2; ++bj) sb[m][bj] = *(const bf16x8*)(gates + goff + (unsigned)((ai * 128 + m * 16) * NGATE) + bj * 128);
#pragma unroll
            for (int m = 0; m < 4; ++m)
#pragma unroll
                for (int bj = 0; bj < 2; ++bj) { f32x4 v0 = acc[ai][bj][m][0], v1 = acc[ai][bj][m][1];
#pragma unroll
                    for (int j = 0; j < 4; ++j) { v0[j] *= bf2f(sb[m][bj][j]); v1[j] *= bf2f(sb[m][bj][4 + j]); }
                    u32x4 w; w.x = pk2(v0[0], v0[1]); w.y = pk2(v0[2], v0[3]); w.z = pk2(v1[0], v1[1]); w.w = pk2(v1[2], v1[3]);
                    *(u32x4*)(merged + moff + (unsigned)((ai * 128 + m * 16) * D) + bj * 128) = w; }
            asm volatile("" ::: "memory"); }
    } };
__device__ __forceinline__ void p3_up(const Params& p, LAS unsigned char* lds) {
    UpSched S; S.o.init(128, 8, gridDim.x, blockIdx.x); S.A = (const bf16_t*)(p.ws + WS_O); S.Bt = (const bf16_t*)(p.ws + WS_WUP);
    EpiUp E{(const bf16_t*)(p.ws + WS_GATES), (bf16_t*)(p.ws + WS_MG)};
    pg8::gemm_phase<true, false>(lds, S, E, 1024 / 64, D, D);
}

struct EpiOut { const bf16_t* xb; bf16_t* hb; unsigned char* h8;
    __device__ __forceinline__ void operator()(f32x4 (&acc)[2][2][4][2], const Unit& u, int wr, int wc, int fr, int fq) const {
        unsigned off = (unsigned)(u.pm * 256 + wr * 64 + fr) * D + u.pn * 256 + wc * 32 + 8 * fq;
#pragma unroll
        for (int ai = 0; ai < 2; ++ai) {
            bf16x8 xr[4][2];
#pragma unroll
            for (int m = 0; m < 4; ++m)
#pragma unroll
                for (int bj = 0; bj < 2; ++bj) xr[m][bj] = *(const bf16x8*)(xb + off + (unsigned)(m * 16 * D) + bj * 128);
#pragma unroll
            for (int m = 0; m < 4; ++m) { asm volatile("" : "+v"(off));
#pragma unroll
                for (int bj = 0; bj < 2; ++bj) { const f32x4 v0 = acc[ai][bj][m][0], v1 = acc[ai][bj][m][1]; const u32x4 xw = __builtin_bit_cast(u32x4, xr[m][bj]);
                    const float h0 = v0[0] + __uint_as_float(xw.x << 16), h1 = v0[1] + __uint_as_float(xw.x & 0xffff0000u), h2 = v0[2] + __uint_as_float(xw.y << 16), h3 = v0[3] + __uint_as_float(xw.y & 0xffff0000u);
                    const float h4 = v1[0] + __uint_as_float(xw.z << 16), h5 = v1[1] + __uint_as_float(xw.z & 0xffff0000u), h6 = v1[2] + __uint_as_float(xw.w << 16), h7 = v1[3] + __uint_as_float(xw.w & 0xffff0000u);
                    u32x4 w; w.x = pk2(h0, h1); w.y = pk2(h2, h3); w.z = pk2(h4, h5); w.w = pk2(h6, h7);
                    *(u32x4*)(hb + off + bj * 128) = w;
                    u32x2 f; f.x = pk4_fp8(h0, h1, h2, h3); f.y = pk4_fp8(h4, h5, h6, h7);
                    *(u32x2*)(h8 + off + bj * 128) = f; }
                off += 16 * D; }
            off += 64 * D; }
    } };
__device__ __forceinline__ void p4_out(const Params& p, LAS unsigned char* lds) {
    pg8::DenseSched S; S.o.init(128, 8, gridDim.x, blockIdx.x); S.A = (const bf16_t*)(p.ws + WS_MG); S.Bt = (const bf16_t*)(p.ws + WS_WOUT); S.lda = D; S.ldb = D;
    EpiOut E{(const bf16_t*)(p.ws + WS_XB), (bf16_t*)(p.ws + WS_O), p.ws + WS_H8};
    pg8::gemm_phase<true, false, pg8::DenseSched, EpiOut, false, false>(lds, S, E, D / 64, D, D);
}

__device__ __forceinline__ void p5_router(const Params& p, LAS unsigned char* lds) {
    const int tid = phase_tid(), lane = tid & 63, wave = __builtin_amdgcn_readfirstlane(tid >> 6), g = lane >> 4, tl = lane & 15;
    const bf16_t* wsp = (const bf16_t*)(p.ws + WS_WRT); float* r2 = (float*)(p.ws + WS_R2); int* cnt = (int*)(p.ws + WS_CNT); int* tokl = (int*)(p.ws + WS_TOK);
    int* recc = (int*)(p.ws + WS_RECC); float* recw = (float*)(p.ws + WS_RECW); const bf16_t* hb = (const bf16_t*)(p.ws + WS_O);
    const float* brg = p.in[15]; const float* bre = p.in[17];
    LAS unsigned char* H = lds + wave * 2304;
    LAS unsigned char* WL = lds + 36864;
    const int r8 = lane >> 3, s8 = lane & 7;
    const int pa0 = tid / 384, pr0 = (tid % 384) >> 3, ps0 = tid & 7, pi1 = 512 + tid, pa1 = pi1 / 384, pr1 = (pi1 % 384) >> 3;
    const unsigned wsrc0 = (unsigned)(pa0 * 48 * 2048 + pr0 * D + ps0 * 8), wsrc1 = (unsigned)(pa1 * 48 * 2048 + pr1 * D + ps0 * 8);
    const unsigned wdst0 = (unsigned)(pa0 * 6144 + pr0 * 128 + ((ps0 ^ (pr0 & 7)) << 4)), wdst1 = (unsigned)(pa1 * 6144 + pr1 * 128 + ((ps0 ^ (pr1 & 7)) << 4));
    for (int round = blockIdx.x; round < T / 128; round += gridDim.x) {
        const int tile = round * 8 + wave;
        const bf16_t* hs = hb + (size_t)tile * 16 * D + r8 * D + s8 * 8;
        f32x4 accA = {0.f, 0.f, 0.f, 0.f}, accB = accA, accC = accA; float ss = 0.f;
        u32x4 hq0[2], hq1[2], hq2[2], hq3[2], wr0, wr1;
#define RT_LOADS(bq, k) do { bq[0] = *(const u32x4*)(hs + 64 * (k)); bq[1] = *(const u32x4*)(hs + 8 * D + 64 * (k)); } while (0)
#define RT_COMP(bq, wbuf) do { \
            *(LAS u32x4*)(H + r8 * 144 + s8 * 16) = bq[0]; *(LAS u32x4*)(H + (r8 + 8) * 144 + s8 * 16) = bq[1]; \
            _Pragma("unroll") for (int ks = 0; ks < 2; ++ks) { const u32x4 hw = *(const LAS u32x4*)(H + tl * 144 + 64 * ks + 16 * g); \
                { const float a0 = __uint_as_float(hw.x << 16), a1 = __uint_as_float(hw.x & 0xffff0000u), a2 = __uint_as_float(hw.y << 16), a3 = __uint_as_float(hw.y & 0xffff0000u); \
                  const float a4 = __uint_as_float(hw.z << 16), a5 = __uint_as_float(hw.z & 0xffff0000u), a6 = __uint_as_float(hw.w << 16), a7 = __uint_as_float(hw.w & 0xffff0000u); \
                  ss += (a0 * a0 + a1 * a1) + (a2 * a2 + a3 * a3) + (a4 * a4 + a5 * a5) + (a6 * a6 + a7 * a7); } \
                const bf16x8 bh = __builtin_bit_cast(bf16x8, hw); const unsigned so_ = (unsigned)(((4 * ks + g) ^ (tl & 7)) << 4); \
                _Pragma("unroll") for (int t = 0; t < 3; ++t) { const bf16x8 ah = *(const LAS bf16x8*)((wbuf) + (16 * t + tl) * 128 + so_), al = *(const LAS bf16x8*)((wbuf) + 6144 + (16 * t + tl) * 128 + so_); \
                    f32x4& ac = (t == 0 ? accA : (t == 1 ? accB : accC)); \
                    ac = __builtin_amdgcn_mfma_f32_16x16x32_bf16(ah, bh, ac, 0, 0, 0); ac = __builtin_amdgcn_mfma_f32_16x16x32_bf16(al, bh, ac, 0, 0, 0); } } } while (0)
#define RT_WLOAD(c) do { wr0 = *(const u32x4*)(wsp + wsrc0 + 64 * (c)); if (tid < 256) wr1 = *(const u32x4*)(wsp + wsrc1 + 64 * (c)); } while (0)
#define RT_WSTORE(wbuf) do { *(LAS u32x4*)((wbuf) + wdst0) = wr0; if (tid < 256) *(LAS u32x4*)((wbuf) + wdst1) = wr1; } while (0)
        __syncthreads();
        RT_WLOAD(0); RT_LOADS(hq0, 0); RT_LOADS(hq1, 1); RT_LOADS(hq2, 2);
        RT_WSTORE(WL); RT_WLOAD(1);
        __syncthreads();
#pragma unroll 1
        for (int c = 0; c < D / 64; c += 4) {
            RT_LOADS(hq3, (c + 3));      RT_COMP(hq0, WL);         RT_WSTORE(WL + 12288); RT_WLOAD((c + 2) & 31); __syncthreads();
            RT_LOADS(hq0, (c + 4) & 31); RT_COMP(hq1, WL + 12288); RT_WSTORE(WL);         RT_WLOAD((c + 3) & 31); __syncthreads();
            RT_LOADS(hq1, (c + 5) & 31); RT_COMP(hq2, WL);         RT_WSTORE(WL + 12288); RT_WLOAD((c + 4) & 31); __syncthreads();
            RT_LOADS(hq2, (c + 6) & 31); RT_COMP(hq3, WL + 12288); RT_WSTORE(WL);         RT_WLOAD((c + 5) & 31); __syncthreads();
        }
#undef RT_LOADS
#undef RT_COMP
#undef RT_WLOAD
#undef RT_WSTORE
        const int tok = tile * 16 + tl;
        ss += __shfl_xor(ss, 16); ss += __shfl_xor(ss, 32);
        const float rr = rsqrtf(ss * (1.0f / D) + EPS);
        const float myg = accC[0] * rr + brg[g];
        float gl[4];
#pragma unroll
        for (int j = 0; j < 4; ++j) gl[j] = __shfl(myg, tl + 16 * j);
        int gi = 0; float gm = gl[0];
#pragma unroll
        for (int i = 1; i < 4; ++i) if (gl[i] > gm) { gm = gl[i]; gi = i; }
        float den = 0.f;
#pragma unroll
        for (int i = 0; i < 4; ++i) den += __expf(gl[i] - gm);
        const float pg = 1.0f / den;
        int L0 = 0, L1 = 0; float wt0 = 0.f, wt1 = 0.f; const bool owner = (g == gi);
        if (owner) {
            float el[8];
#pragma unroll
            for (int i = 0; i < 4; ++i) { el[i] = accA[i] * rr + bre[g * 8 + i]; el[4 + i] = accB[i] * rr + bre[g * 8 + 4 + i]; }
            int e0 = 0; float v0 = el[0];
#pragma unroll
            for (int i = 1; i < 8; ++i) if (el[i] > v0) { v0 = el[i]; e0 = i; }
            int e1 = -1; float v1 = -3.0e38f;
#pragma unroll
            for (int i = 0; i < 8; ++i) if (i != e0 && el[i] > v1) { v1 = el[i]; e1 = i; }
            const float ex = __expf(v1 - v0); const float s0 = 1.0f / (1.0f + ex), s1 = ex * s0;
            r2[tok] = rr; L0 = gi * 8 + e0; L1 = gi * 8 + e1; wt0 = pg * s0; wt1 = pg * s1;
        }
        LAS int* cl = (LAS int*)(lds + 61440);
        if (tid < 32) cl[tid] = 0;
        __syncthreads();
        int q0 = 0, q1 = 0;
        if (owner) { q0 = __hip_atomic_fetch_add(&cl[L0], 1, __ATOMIC_RELAXED, __HIP_MEMORY_SCOPE_WORKGROUP); q1 = __hip_atomic_fetch_add(&cl[L1], 1, __ATOMIC_RELAXED, __HIP_MEMORY_SCOPE_WORKGROUP); }
        __syncthreads();
        if (tid < 32) { const int n = cl[tid]; cl[32 + tid] = n ? atomicAdd(&cnt[tid], n) : 0; }
        __syncthreads();
        if (owner) { const int p0 = cl[32 + L0] + q0, p1 = cl[32 + L1] + q1;
            float* r2l = (float*)(p.ws + WS_R2L);
            tokl[(size_t)L0 * T + p0] = tok; r2l[(size_t)L0 * T + p0] = rr; recc[2 * tok] = L0 * 32768 + p0; recw[2 * tok] = wt0;
            tokl[(size_t)L1 * T + p1] = tok; r2l[(size_t)L1 * T + p1] = rr; recc[2 * tok + 1] = L1 * 32768 + p1; recw[2 * tok + 1] = wt1; }
    }
    __syncthreads();
}

__device__ __forceinline__ void build_tiles(const Params& p, LAS int* tab) {
    __syncthreads();
    if (threadIdx.x < 64) { const int L = threadIdx.x; const int c = L < 32 ? ((const int*)(p.ws + WS_CNT))[L] : 0; const int nt = (c + 255) >> 8;
        int pre = nt;
#pragma unroll
        for (int o = 1; o < 32; o <<= 1) { const int v = __shfl_up(pre, o); if (L >= o) pre += v; }
        const int first = pre - nt;
        if (L < 32) { tab[1400 + L] = first * 256; for (int i = 0; i < nt; ++i) { tab[4 + (first + i) * 4 + 0] = L; tab[4 + (first + i) * 4 + 1] = i * 256; tab[4 + (first + i) * 4 + 2] = (first + i) * 256; tab[4 + (first + i) * 4 + 3] = min(256, c - i * 256); } }
        if (L == 31) tab[0] = pre; }
    __syncthreads();
}
template <int NPN> struct MoeOrder { int G, c, t_lo, nt_tiles; const LAS int* tab;
    __device__ __forceinline__ bool unit(int i, Unit& u) const { const long L = (long)i * G + c; if (L >= (long)nt_tiles * NPN) return false;
        const int nwg = nt_tiles * NPN; int wgid = (int)L; { const int q = nwg / 8, r = nwg % 8, xcd = wgid % 8, off = wgid / 8; wgid = (xcd < r ? xcd * (q + 1) : r * (q + 1) + (xcd - r) * q) + off; }
        u.pm = t_lo + wgid / NPN; u.pn = wgid % NPN; u.aux = 0; return true; } };
struct GateUpSched { MoeOrder<4> o; const unsigned char* hb; const unsigned char* WguT; const int* tokl;
    __device__ __forceinline__ bool next(int i, Unit& u) const { return o.unit(i, u); }
    __device__ __forceinline__ const char* a_base(const Unit&) const { return (const char*)hb; }
    __device__ __forceinline__ const char* b_base(const Unit& u) const { const int e = o.tab[4 + u.pm * 4] & 31; return (const char*)(WguT + (size_t)(e * 1024 + u.pn * 256) * D); }
    __device__ __forceinline__ bool keep_acc(const Unit&) const { return false; }
    __device__ __forceinline__ void a_offs(const Unit& u, int R0, int C0, int R1, int C1, unsigned (&v)[2][2]) const {
        const int L = o.tab[4 + u.pm * 4], row0 = o.tab[4 + u.pm * 4 + 1], nrows = o.tab[4 + u.pm * 4 + 3]; const int* lst = tokl + (size_t)L * T + row0;
#pragma unroll
        for (int h = 0; h < 2; ++h) { const int r0 = R0 + 128 * h, r1 = R1 + 128 * h; const int t0 = r0 < nrows ? lst[r0] : 0, t1 = r1 < nrows ? lst[r1] : 0;
            v[h][0] = (unsigned)t0 * D + C0 * 2u; v[h][1] = (unsigned)t1 * D + C1 * 2u; } }
};
struct EpiGateUp { const LAS int* tab; const float* r2l; unsigned char* he;
    __device__ __forceinline__ void operator()(f32x4 (&acc)[2][2][4][2], const Unit& u, int wr, int wc, int fr, int fq) const {
        const int L = tab[4 + u.pm * 4], row0 = tab[4 + u.pm * 4 + 1], slot = tab[4 + u.pm * 4 + 2], nrows = tab[4 + u.pm * 4 + 3];
#pragma unroll
        for (int ai = 0; ai < 2; ++ai)
#pragma unroll
            for (int m = 0; m < 4; ++m) { const int rr = ai * 128 + wr * 64 + m * 16 + fr; const float rs = rr < nrows ? r2l[(size_t)L * T + row0 + rr] * (1.0f / 64.0f) : 0.f;
                u32x2 w; unsigned ww[2];
#pragma unroll
                for (int n = 0; n < 2; ++n) { float hv[4];
#pragma unroll
                    for (int j = 0; j < 4; ++j) { const float gt = acc[ai][0][m][n][j] * rs, up = acc[ai][1][m][n][j] * rs; hv[j] = gt * sigmoidf_(gt) * up * 4.0f; }
                    ww[n] = pk4_fp8(hv[0], hv[1], hv[2], hv[3]); }
                w.x = ww[0]; w.y = ww[1];
                *(u32x2*)(he + (size_t)(slot + rr) * 512 + u.pn * 128 + wc * 32 + 8 * fq) = w; }
    } };
__device__ __forceinline__ void p6_gateup(const Params& p, LAS unsigned char* lds) {
    LAS int* tab = (LAS int*)(lds + TAB_OFF); build_tiles(p, tab);
    GateUpSched S; S.o.G = gridDim.x; S.o.c = blockIdx.x; S.o.t_lo = 0; S.o.nt_tiles = tab[0]; S.o.tab = tab;
    S.hb = p.ws + WS_H8; S.WguT = p.ws + WS_WGU; S.tokl = (const int*)(p.ws + WS_TOK);
    EpiGateUp E{tab, (const float*)(p.ws + WS_R2L), p.ws + WS_HE};
    pg8::gemm_phase<true, true, GateUpSched, EpiGateUp, true>(lds, S, E, D / 128, D / 2, D / 2);
}
struct DownSched { MoeOrder<8> o; const unsigned char* he; const unsigned char* WdT;
    __device__ __forceinline__ bool next(int i, Unit& u) const { return o.unit(i, u); }
    __device__ __forceinline__ const char* a_base(const Unit&) const { return (const char*)he; }
    __device__ __forceinline__ const char* b_base(const Unit& u) const { const int e = o.tab[4 + u.pm * 4] & 31; return (const char*)(WdT + (size_t)(e * 2048 + u.pn * 256) * 512); }
    __device__ __forceinline__ bool keep_acc(const Unit&) const { return false; }
    __device__ __forceinline__ void a_offs(const Unit& u, int R0, int C0, int R1, int C1, unsigned (&v)[2][2]) const {
        const int slot = o.tab[4 + u.pm * 4 + 2];
#pragma unroll
        for (int h = 0; h < 2; ++h) { v[h][0] = (unsigned)(slot + 128 * h + R0) * 512u + C0 * 2u; v[h][1] = (unsigned)(slot + 128 * h + R1) * 512u + C1 * 2u; } }
};
struct EpiDown { const LAS int* tab; unsigned char* ye;
    __device__ __forceinline__ void operator()(f32x4 (&acc)[2][2][4][2], const Unit& u, int wr, int wc, int fr, int fq) const {
        const int slot = tab[4 + u.pm * 4 + 2];
        unsigned off = (unsigned)(slot + wr * 64 + fr) * 2048 + u.pn * 256 + wc * 32 + 8 * fq;
#pragma unroll
        for (int ai = 0; ai < 2; ++ai) {
#pragma unroll
            for (int m = 0; m < 4; ++m) { asm volatile("" : "+v"(off));
#pragma unroll
                for (int bj = 0; bj < 2; ++bj) { const f32x4 v0 = acc[ai][bj][m][0] * 0.0625f, v1 = acc[ai][bj][m][1] * 0.0625f;
                    u32x2 w; w.x = pk4_fp8(v0[0], v0[1], v0[2], v0[3]); w.y = pk4_fp8(v1[0], v1[1], v1[2], v1[3]);
                    *(u32x2*)(ye + off + bj * 128) = w; }
                off += 16 * 2048; }
            off += 64 * 2048; }
    } };
__device__ __forceinline__ void p7_down(const Params& p, LAS unsigned char* lds) {
    LAS int* tab = (LAS int*)(lds + TAB_OFF); build_tiles(p, tab);
    DownSched S; S.o.G = gridDim.x; S.o.c = blockIdx.x; S.o.t_lo = 0; S.o.nt_tiles = tab[0]; S.o.tab = tab;
    S.he = p.ws + WS_HE; S.WdT = p.ws + WS_WD;
    EpiDown E{tab, p.ws + WS_YE};
    int ntv = 512 / 128; asm volatile("" : "+s"(ntv));
    pg8::gemm_phase<true, true, DownSched, EpiDown, true, false>(lds, S, E, ntv, 256, 256);
}
__device__ __forceinline__ void p8_combine(const Params& p, LAS unsigned char* lds) {
    LAS int* tab = (LAS int*)(lds + TAB_OFF); build_tiles(p, tab);
    const int tid = phase_tid(), lane = tid & 63, wave = tid >> 6; const int gw = blockIdx.x * 8 + wave, NGW = gridDim.x * 8;
    const int* recc = (const int*)(p.ws + WS_RECC); const float* recw = (const float*)(p.ws + WS_RECW); const bf16_t* hb = (const bf16_t*)(p.ws + WS_O);
    const unsigned char* ye = p.ws + WS_YE;
    for (int tok = gw; tok < T; tok += NGW) {
        const int c0 = recc[2 * tok], c1 = recc[2 * tok + 1]; const float wa = recw[2 * tok] * 0.0625f, wb = recw[2 * tok + 1] * 0.0625f;
        const int s0 = tab[1400 + (c0 >> 15)] + (c0 & 32767), s1 = tab[1400 + (c1 >> 15)] + (c1 & 32767);
        f32x4* op = (f32x4*)(p.out + (size_t)tok * D) + lane; const u32x2* hp = (const u32x2*)(hb + (size_t)tok * D) + lane;
        const unsigned* ya = (const unsigned*)(ye + (size_t)s0 * 2048) + lane; const unsigned* yb = (const unsigned*)(ye + (size_t)s1 * 2048) + lane;
        u32x2 m[8]; unsigned a[8], b[8];
#pragma unroll
        for (int j = 0; j < 8; ++j) { m[j] = hp[64 * j]; a[j] = ya[64 * j]; b[j] = yb[64 * j]; }
#pragma unroll
        for (int j = 0; j < 8; ++j) { f32x4 v;
            const f32x2 a0 = __builtin_amdgcn_cvt_pk_f32_fp8(a[j], false), a1 = __builtin_amdgcn_cvt_pk_f32_fp8(a[j], true), b0 = __builtin_amdgcn_cvt_pk_f32_fp8(b[j], false), b1 = __builtin_amdgcn_cvt_pk_f32_fp8(b[j], true);
            v.x = __uint_as_float(m[j].x << 16) + wa * a0.x + wb * b0.x; v.y = __uint_as_float(m[j].x & 0xffff0000u) + wa * a0.y + wb * b0.y;
            v.z = __uint_as_float(m[j].y << 16) + wa * a1.x + wb * b1.x; v.w = __uint_as_float(m[j].y & 0xffff0000u) + wa * a1.y + wb * b1.y;
            op[64 * j] = v; }
    }
}

#define XB_TMO      128
#define XB_XCNT(j)  (256  + 64 * (j))
#define XB_XSUB(j)  (1280 + 64 * (j))
#define XB_XGEN(j)  (2304 + 64 * (j))
#define XB_TOP      3328
#define XB_TOPGEN   3392
#define XCD_BAR_WORDS 3456
#define XB_SPIN_CAP (1u << 18)
__device__ __forceinline__ unsigned xb_ld(unsigned* p)              { return __hip_atomic_load(p, __ATOMIC_RELAXED, __HIP_MEMORY_SCOPE_AGENT); }
__device__ __forceinline__ unsigned xb_add(unsigned* p, unsigned v) { return __hip_atomic_fetch_add(p, v, __ATOMIC_RELAXED, __HIP_MEMORY_SCOPE_AGENT); }
__device__ __forceinline__ unsigned xb_xcc_id() { return (unsigned)__builtin_amdgcn_s_getreg((3 << 11) | 20) & 0xFu; }
#define XB_SPIN(cond, bar) do { unsigned _sp = 0; while (cond) { __builtin_amdgcn_s_sleep(1); \
    if ((++_sp & 255u) == 0u) { if (xb_ld(&(bar)[XB_TMO])) break; if (_sp > XB_SPIN_CAP) { atomicAdd(&(bar)[XB_TMO], 1u); break; } } } } while (0)
struct XcdBarrier { unsigned* bar; unsigned x; volatile LAS unsigned* st; };
__device__ __forceinline__ XcdBarrier xcd_barrier_post(unsigned* bar, volatile LAS unsigned* st) {
    XcdBarrier b; b.bar = bar; b.x = xb_xcc_id(); b.st = st;
    if (threadIdx.x == 0) (void)xb_add(&bar[XB_XCNT(b.x)], 1u);
    return b;
}
__device__ __forceinline__ void xcd_barrier_complete(unsigned* bar, unsigned x, unsigned& nloc, unsigned& nx) {
    const unsigned G = gridDim.x * gridDim.y * gridDim.z;
    unsigned sum, cnt, mine, sp = 0u;
    for (;;) {
        sum = 0u; cnt = 0u; mine = 0u;
#pragma unroll
        for (unsigned j = 0; j < 16; ++j) { const unsigned c = xb_ld(&bar[XB_XCNT(j)]); sum += c; cnt += (c > 0u) ? 1u : 0u; mine = (j == x) ? c : mine; }
        if (sum == G) break;
        __builtin_amdgcn_s_sleep(1);
        if ((++sp & 255u) == 0u) { if (xb_ld(&bar[XB_TMO])) break; if (sp > XB_SPIN_CAP) { atomicAdd(&bar[XB_TMO], 1u); break; } }
    }
    nloc = mine > 0u ? mine : 1u; nx = cnt > 0u ? cnt : 1u;
}
__device__ __forceinline__ void xcd_barrier(const XcdBarrier& b) {
    asm volatile("s_waitcnt vmcnt(0)" ::: "memory");
    __syncthreads();
    if (threadIdx.x == 0) {
        unsigned* bar = b.bar;
        __builtin_amdgcn_s_waitcnt(0);
        unsigned nloc = b.st[0], nx = b.st[1];
        if (nloc == 0u) { xcd_barrier_complete(bar, b.x, nloc, nx); b.st[0] = nloc; b.st[1] = nx; }
        const unsigned old = xb_add(&bar[XB_XSUB(b.x)], 1u);
        const unsigned gen = old / nloc;
        if (old + 1u == (gen + 1u) * nloc) {
            __builtin_amdgcn_fence(__ATOMIC_RELEASE, "agent");
            asm volatile("s_waitcnt vmcnt(0)" ::: "memory");
            const unsigned og = xb_add(&bar[XB_TOP], 1u);
            const unsigned tg = og / nx;
            if (og + 1u == (tg + 1u) * nx) xb_add(&bar[XB_TOPGEN], 1u);
            else XB_SPIN(xb_ld(&bar[XB_TOPGEN]) == tg, bar);
            __builtin_amdgcn_fence(__ATOMIC_ACQUIRE, "agent");
            xb_add(&bar[XB_XGEN(b.x)], 1u);
            asm volatile("s_waitcnt vmcnt(0)" ::: "memory");
        } else {
            XB_SPIN(xb_ld(&bar[XB_XGEN(b.x)]) == gen, bar);
            __builtin_amdgcn_fence(__ATOMIC_ACQUIRE, "agent");
            asm volatile("s_waitcnt vmcnt(0)" ::: "memory");
        }
    }
    __syncthreads();
}

namespace cg = cooperative_groups;
#ifdef PROBE_A
#define STAMP(k) do { if (blockIdx.x == 0 && threadIdx.x == 0) ((unsigned long long*)(p.ws + WS_END))[k] = __builtin_amdgcn_s_memrealtime(); } while (0)
#else
#define STAMP(k) do {} while (0)
#endif
__global__ void __launch_bounds__(512, 2) fwd_megakernel(Params p) {
    extern __shared__ __attribute__((aligned(16))) unsigned char lds_raw[];
    LAS unsigned char* lds = (LAS unsigned char*)lds_raw;
    cg::grid_group grid = cg::this_grid();
    if (threadIdx.x == 0) { *(volatile LAS unsigned*)(lds + XBST_OFF) = 0u; *(volatile LAS unsigned*)(lds + XBST_OFF + 4) = 0u; }
    if (blockIdx.x == 0) for (int i = threadIdx.x; i < XCD_BAR_WORDS; i += 512) ((unsigned*)(p.ws + WS_BAR))[i] = 0u;
    __syncthreads();
#define GSYNC() xcd_barrier(xb)
    STAMP(0);
    p0_prep(p, lds);            grid.sync(); STAMP(1);
    const XcdBarrier xb = xcd_barrier_post((unsigned*)(p.ws + WS_BAR), (volatile LAS unsigned*)(lds + XBST_OFF));
    p1_inproj(p, lds);          GSYNC(); STAMP(2);
    p2_attn(p, lds);            GSYNC(); STAMP(3);
    STAMP(4);
    p3_up(p, lds);              GSYNC(); STAMP(5);
    p4_out(p, lds);             GSYNC(); STAMP(6);
    p5_router(p, lds);          GSYNC(); STAMP(7);
    p6_gateup(p, lds);          GSYNC(); STAMP(8);
    p7_down(p, lds);            GSYNC(); STAMP(9);
    p8_combine(p, lds);
#ifdef PROBE_A
    grid.sync(); STAMP(10); grid.sync();
    {
        const unsigned long long* ts = (const unsigned long long*)(p.ws + WS_END);
        #ifndef PROBE_A1
#define PROBE_A1 (PROBE_A + 1)
#endif
#ifndef PROBE_B1
#define PROBE_B1 (PROBE_B + 1)
#endif
        const float usA = (float)(ts[PROBE_A1] - ts[PROBE_A]) * 0.01f, usB = (float)(ts[PROBE_B1] - ts[PROBE_B]) * 0.01f;
        const float eps = sqrtf(usA * 1e-6f);
        for (size_t i = (size_t)blockIdx.x * 512 + threadIdx.x; i < (size_t)T * D / 4; i += (size_t)gridDim.x * 512) { f32x4 v = ((f32x4*)p.out)[i]; v = v * (1.0f + eps); if (i == 0) v.x += usB * 0.1f; ((f32x4*)p.out)[i] = v; }
    }
#endif
}

extern "C" void kernel_launch(void* const* d_in, const int* in_sizes, int n_in, void* d_out, int out_size, void* d_ws, size_t ws_size, hipStream_t stream) {
    static int grid_blocks = 0;
    if (!grid_blocks) {
        if (n_in != 21 || out_size != T * D || ws_size < WS_TOP) { fprintf(stderr, "kernel_launch: unexpected problem (n_in %d out %d ws %zu)\n", n_in, out_size, ws_size); grid_blocks = -1; return; }
        if (hipFuncSetAttribute((const void*)fwd_megakernel, hipFuncAttributeMaxDynamicSharedMemorySize, LDS_BYTES) != hipSuccess) { fprintf(stderr, "kernel_launch: hipFuncSetAttribute failed\n"); grid_blocks = -1; return; }
        int dev = 0, cus = 0, per_cu = 0;
        hipGetDevice(&dev); hipDeviceGetAttribute(&cus, hipDeviceAttributeMultiprocessorCount, dev);
        hipOccupancyMaxActiveBlocksPerMultiprocessor(&per_cu, (const void*)fwd_megakernel, 512, LDS_BYTES);
        if (per_cu < 1 || cus < 1) { fprintf(stderr, "kernel_launch: occupancy query gave %d blocks/CU on %d CUs\n", per_cu, cus); grid_blocks = -1; return; }
        grid_blocks = cus;
    }
    if (grid_blocks < 0) return;
    Params p{};
    for (int i = 0; i < 21; ++i) p.in[i] = (const float*)d_in[i];
    p.out = (float*)d_out; p.ws = (unsigned char*)d_ws;
    void* args[] = {&p};
    hipError_t e = hipLaunchCooperativeKernel((const void*)fwd_megakernel, dim3(grid_blocks), dim3(512), args, LDS_BYTES, stream);
    if (e != hipSuccess) fprintf(stderr, "cooperative launch failed: %s (grid %d)\n", hipGetErrorString(e), grid_blocks);
}
```

```cpp
#include <hip/hip_runtime.h>
#include <hip/hip_cooperative_groups.h>
#include <cstdio>
#include <cstdint>

#define LAS __attribute__((address_space(3)))
typedef unsigned short bf16_t;
typedef short bf16x8 __attribute__((ext_vector_type(8)));
typedef short s16x4 __attribute__((ext_vector_type(4)));
typedef float f32x4 __attribute__((ext_vector_type(4)));
typedef unsigned u32x4 __attribute__((ext_vector_type(4)));
typedef unsigned u32x2 __attribute__((ext_vector_type(2)));
typedef short v4i16_t __attribute__((ext_vector_type(4)));

namespace cfg {
constexpr int T = 32768, D = 2048, SEQ = 16384;
constexpr int NQKV = 4608, NGATE = 4096, NIN = 8704;
constexpr size_t MiB = 1ull << 20;
constexpr size_t WS_XB = 0, WS_QKV = 128 * MiB, WS_GATES = 416 * MiB, WS_O = 672 * MiB, WS_WIN = 800 * MiB, WS_WUP = 834 * MiB, WS_WOUT = 842 * MiB, WS_MISC = 850 * MiB;
constexpr size_t WS_WGU = 872 * MiB, WS_WD = 936 * MiB, WS_MG = WS_QKV, WS_HE = WS_QKV + 192 * MiB;
constexpr size_t WS_R1 = WS_MISC, WS_R2 = WS_R1 + (size_t)T * 4, WS_WRT = WS_R2 + (size_t)T * 4, WS_CNT = WS_WRT + 512 * 1024, WS_TOK = WS_CNT + 4096,
                 WS_RECC = WS_TOK + 32ull * T * 4, WS_RECW = WS_RECC + 2ull * T * 4, WS_R2L = WS_RECW + 2ull * T * 4, WS_END = WS_R2L + 32ull * T * 4;
constexpr size_t WS_H8 = WS_GATES + 144 * MiB;
constexpr size_t WS_YE = WS_QKV;
constexpr size_t WS_BAR = WS_END + 4096;
constexpr size_t WS_X8 = 872 * MiB;
constexpr size_t WS_TOP = 1000 * MiB;
constexpr int LDS_BYTES = 140 * 1024;
constexpr int XBST_OFF = LDS_BYTES - 16;
constexpr int TAB_OFF = 132 * 1024;
constexpr float EPS = 1e-6f;
}
using namespace cfg;

struct Params { const float* in[21]; float* out; unsigned char* ws; };
__device__ __forceinline__ int phase_tid() { int t = threadIdx.x; asm volatile("" : "+v"(t)); return t; }

__device__ __forceinline__ float bf2f(short s) { return __uint_as_float(((unsigned)(unsigned short)s) << 16); }
typedef float f32x2 __attribute__((ext_vector_type(2)));
typedef __bf16 bf16x2_t __attribute__((ext_vector_type(2)));
__device__ __forceinline__ unsigned pk2(float lo, float hi) { const f32x2 v = {lo, hi}; return __builtin_bit_cast(unsigned, __builtin_convertvector(v, bf16x2_t)); }
__device__ __forceinline__ unsigned pk4_fp8(float a, float b, float c, float d) { int w = 0; w = __builtin_amdgcn_cvt_pk_fp8_f32(a, b, w, false); w = __builtin_amdgcn_cvt_pk_fp8_f32(c, d, w, true); return (unsigned)w; }
__device__ __forceinline__ float wave_sum(float v) {
#pragma unroll
    for (int o = 1; o < 64; o <<= 1) v += __shfl_xor(v, o);
    return v;
}
__device__ __forceinline__ float sigmoidf_(float v) { return 1.0f / (1.0f + __expf(-v)); }
__device__ __forceinline__ unsigned off_b(unsigned row, unsigned ch) { return 256u * row + 16u * (ch ^ (((row & 3) << 2) | ((row >> 2) & 3))); }
__device__ __forceinline__ s16x4 tr_read(LAS unsigned char* p) { return __builtin_bit_cast(s16x4, __builtin_amdgcn_ds_read_tr16_b64_v4i16((LAS v4i16_t*)p)); }
__host__ __device__ __forceinline__ int perm32(int rho) { const int n = rho >> 4, i = rho & 15; return 8 * (i >> 2) + 4 * n + (i & 3); }
__device__ __forceinline__ int t5_bucket(int rel) {
    const int n = rel < 0 ? -rel : rel; const int ret = rel > 0 ? 16 : 0; int b;
    if (n < 8) b = n; else if (n < 12) b = 8; else if (n < 16) b = 9; else if (n < 23) b = 10; else if (n < 32) b = 11; else if (n < 46) b = 12; else if (n < 64) b = 13; else if (n < 91) b = 14; else b = 15;
    return ret + b;
}

template <bool FP8>
__device__ __forceinline__ void transpose_item(const float* __restrict__ W, int ldw, int k0, int n0, bf16_t* __restrict__ WT, int ldt, int drow0, int dk0, const float* __restrict__ scale, LAS unsigned* scr, int lane, float f8scale = 1.f) {
    const int n4 = (lane & 15) * 4, kk = lane >> 4;
    const float* src = W + (size_t)(k0 + 2 * kk) * ldw + n0 + n4;
    f32x4 ev[8], od[8];
#pragma unroll
    for (int j = 0; j < 8; ++j) { ev[j] = *(const f32x4*)(src + (size_t)(8 * j) * ldw); od[j] = *(const f32x4*)(src + (size_t)(8 * j + 1) * ldw); }
#pragma unroll
    for (int j = 0; j < 8; ++j) { f32x4 e = ev[j], o = od[j];
        if (scale) { const float se = scale[k0 + 8 * j + 2 * kk], so = scale[k0 + 8 * j + 2 * kk + 1]; e = e * se; o = o * so; }
        u32x4 w; w.x = pk2(e.x, o.x); w.y = pk2(e.y, o.y); w.z = pk2(e.z, o.z); w.w = pk2(e.w, o.w);
        *(LAS u32x4*)(scr + (4 * j + kk) * 68 + n4) = w; }
    asm volatile("s_waitcnt lgkmcnt(0)" ::: "memory");
    const int kq = lane & 7;
#pragma unroll
    for (int i = 0; i < 8; ++i) { const int n = (lane >> 3) + 8 * i; const LAS unsigned* q = scr + (4 * kq) * 68 + n;
        u32x4 o; o.x = q[0]; o.y = q[68]; o.z = q[136]; o.w = q[204];
        if (FP8) { u32x2 f; f.x = pk4_fp8(__uint_as_float(o.x << 16) * f8scale, __uint_as_float(o.x & 0xffff0000u) * f8scale, __uint_as_float(o.y << 16) * f8scale, __uint_as_float(o.y & 0xffff0000u) * f8scale);
            f.y = pk4_fp8(__uint_as_float(o.z << 16) * f8scale, __uint_as_float(o.z & 0xffff0000u) * f8scale, __uint_as_float(o.w << 16) * f8scale, __uint_as_float(o.w & 0xffff0000u) * f8scale);
            *(u32x2*)((unsigned char*)WT + (size_t)(drow0 + n) * ldt + dk0 + k0 + 8 * kq) = f; }
        else *(u32x4*)(WT + (size_t)(drow0 + n) * ldt + dk0 + k0 + 8 * kq) = o; }
    asm volatile("s_waitcnt lgkmcnt(0)" ::: "memory");
}

__device__ __forceinline__ void p0_prep(const Params& p, LAS unsigned char* lds) {
    const int tid = phase_tid(), lane = tid & 63, wave = tid >> 6;
    const int gw = blockIdx.x * 8 + wave, NGW = gridDim.x * 8;
    LAS unsigned* scr = (LAS unsigned*)(lds + wave * 8704);
    const float* x = p.in[0]; const float* g1 = p.in[1]; const float* w_in = p.in[2];
    bf16_t* xb = (bf16_t*)(p.ws + WS_XB); float* r1 = (float*)(p.ws + WS_R1);
    bf16_t* WinT = (bf16_t*)(p.ws + WS_WIN); bf16_t* WupT = (bf16_t*)(p.ws + WS_WUP); bf16_t* WoutT = (bf16_t*)(p.ws + WS_WOUT);
    constexpr int I_WIN = 32 * 136, I_UP = 16 * 32, I_OUT = 32 * 32, NITEMS = I_WIN + 2 * I_UP + I_OUT;
    for (int it = gw; it < NITEMS; it += NGW) {
        int r = it;
        if (r < I_WIN) { const int kb = r / 136, nb = r % 136; const int n0 = nb * 64;
            int drow = n0;
            if (n0 >= NQKV) { const int c = (n0 - NQKV) & 2047, isb = (n0 - NQKV) >> 11; drow = NQKV + (c >> 7) * 256 + isb * 128 + (c & 127); }
            transpose_item<true>(w_in, NIN, kb * 64, n0, WinT, 2048, drow, 0, g1, scr, lane, 64.f); continue; } r -= I_WIN;
        if (r < I_UP) { const int kb = r / 32, nb = r % 32; transpose_item<false>(p.in[9], 2048, kb * 64, nb * 64, WupT, 2048, nb * 64, 0, nullptr, scr, lane); continue; } r -= I_UP;
        if (r < I_UP) { const int kb = r / 32, nb = r % 32; transpose_item<false>(p.in[10], 2048, kb * 64, nb * 64, WupT, 2048, nb * 64, 1024, nullptr, scr, lane); continue; } r -= I_UP;
        { const int kb = r / 32, nb = r % 32; transpose_item<true>(p.in[11], 2048, kb * 64, nb * 64, WoutT, 2048, nb * 64, 0, nullptr, scr, lane, 64.f); }
    }
    { bf16_t* whi = (bf16_t*)(p.ws + WS_WRT); bf16_t* wlo = whi + 48 * 2048; const float* g2 = p.in[13]; const float* wrg = p.in[14]; const float* wre = p.in[16];
      for (int i = blockIdx.x * 512 + tid; i < 48 * 2048; i += gridDim.x * 512) { const int row = i >> 11, k = i & 2047, t = row >> 4, r = row & 15; float w;
          if (t == 0) w = wre[k * 32 + (r >> 2) * 8 + (r & 3)]; else if (t == 1) w = wre[k * 32 + (r >> 2) * 8 + 4 + (r & 3)]; else w = (r & 3) == 0 ? wrg[k * 4 + (r >> 2)] : 0.f;
          w *= g2[k]; const unsigned hi = pk2(w, 0.f) & 0xffffu; const float hf = __uint_as_float(hi << 16); whi[i] = (bf16_t)hi; wlo[i] = (bf16_t)(pk2(w - hf, 0.f) & 0xffffu); } }
    if (blockIdx.x == 0 && tid < 32) ((int*)(p.ws + WS_CNT))[tid] = 0;
    for (int row0 = 2 * gw; row0 < T; row0 += 2 * NGW) {
        f32x4 v[2][8]; float ss[2] = {0.f, 0.f};
#pragma unroll
        for (int u = 0; u < 2; ++u) { const f32x4* xr = (const f32x4*)(x + (size_t)(row0 + u) * D) + lane;
#pragma unroll
            for (int j = 0; j < 8; ++j) v[u][j] = xr[64 * j]; }
#pragma unroll
        for (int u = 0; u < 2; ++u) {
#pragma unroll
            for (int j = 0; j < 8; ++j) ss[u] += (v[u][j].x * v[u][j].x + v[u][j].y * v[u][j].y) + (v[u][j].z * v[u][j].z + v[u][j].w * v[u][j].w);
            ss[u] = wave_sum(ss[u]);
            if (lane == 0) r1[row0 + u] = rsqrtf(ss[u] * (1.0f / D) + EPS);
            u32x2* o = (u32x2*)(xb + (size_t)(row0 + u) * D) + lane; unsigned* o8 = (unsigned*)(p.ws + WS_X8 + (size_t)(row0 + u) * D) + lane;
#pragma unroll
            for (int j = 0; j < 8; ++j) { u32x2 w; w.x = pk2(v[u][j].x, v[u][j].y); w.y = pk2(v[u][j].z, v[u][j].w); o[64 * j] = w; o8[64 * j] = pk4_fp8(v[u][j].x, v[u][j].y, v[u][j].z, v[u][j].w); } }
    }
}

constexpr int MOE_ITEMS = 2 * 32 * 32 * 8 + 32 * 8 * 32;
__device__ __forceinline__ void moe_prep_batch(const Params& p, LAS unsigned char* lds, int bi) {
    const int tid = phase_tid(), lane = tid & 63, wave = tid >> 6;
    LAS unsigned* scr = (LAS unsigned*)(lds + wave * 8704);
    const float* g2 = p.in[13];
    bf16_t* WguT = (bf16_t*)(p.ws + WS_WGU); bf16_t* WdT = (bf16_t*)(p.ws + WS_WD);
    constexpr int I_G = 32 * 32 * 8;
    int r = (bi * (int)gridDim.x + (int)blockIdx.x) * 8 + wave;
    if (r >= MOE_ITEMS) return;
    if (r < 2 * I_G) { const int which = r >= I_G; if (which) r -= I_G; const int e = r / 256, rr = r % 256, kb = rr / 8, nb = rr % 8;
        const float* W = p.in[which ? 19 : 18] + (size_t)e * 2048 * 512; const int n0 = nb * 64;
        transpose_item<true>(W, 512, kb * 64, n0, WguT, 2048, e * 1024 + (n0 >> 7) * 256 + which * 128 + (n0 & 127), 0, g2, scr, lane, 64.f); return; }
    r -= 2 * I_G;
    { const int e = r / 256, rr = r % 256, kb = rr / 32, nb = rr % 32; const float* W = p.in[20] + (size_t)e * 512 * 2048;
      transpose_item<true>(W, 2048, kb * 64, nb * 64, WdT, 512, e * 2048 + nb * 64, 0, nullptr, scr, lane, 64.f); }
}

struct Unit { int pm, pn, aux; };
namespace pg8 {
constexpr int BM = 256, BK = 64, HALF = 128, HTB = HALF * BK * 2, STAGE_BYTES = 8 * HTB;
__device__ __forceinline__ int lds_byte(int r, int c) { const int st = (r >> 4) * 2 + (c >> 5), rr = r & 15, cc = c & 31, ob = rr * 64 + cc * 2; return st * 1024 + (ob ^ (((ob >> 9) & 1) << 5)); }
__device__ __forceinline__ void stage_rc(int b, int& R, int& C) { const int st = b / 1024, sb = b % 1024, swz = sb ^ (((sb >> 9) & 1) << 5); R = (st >> 1) * 16 + swz / 64; C = (st & 1) * 32 + (swz % 64) / 2; }

template <bool PERM, bool GATHER, class Sched, class Epi, bool FP8 = false, bool ALIGN_EPI = true>
__device__ __forceinline__ void gemm_phase(LAS unsigned char* lds, const Sched& S, const Epi& E, const int nt, const int lda, const int ldb) {
    int tid_ = threadIdx.x; asm volatile("" : "+v"(tid_));
    const int tid = tid_, wid = __builtin_amdgcn_readfirstlane(tid >> 6), lane = tid & 63, wr = wid >> 2, wc = wid & 3, fr = lane & 15, fq = lane >> 4;
    int R0, C0, R1, C1; stage_rc(tid * 16, R0, C0); stage_rc(tid * 16 + 8192, R1, C1);
    unsigned voffB[2], voffA[2][2];
    { const int Rb0 = PERM ? ((R0 & ~31) + perm32(R0 & 31)) : R0, Rb1 = PERM ? ((R1 & ~31) + perm32(R1 & 31)) : R1;
      voffB[0] = (unsigned)(Rb0 * ldb + C0) * 2u; voffB[1] = (unsigned)(Rb1 * ldb + C1) * 2u; }
    const size_t kstep = (size_t)(BK * 2);
    const size_t hstepB = (size_t)HALF * ldb * 2, hstepA = (size_t)HALF * lda * 2;
    const unsigned ldsw = (unsigned)wid * 1024u;
    const int aoff = lds_byte(wr * 64 + fr, fq * 8), boff = lds_byte(wc * 32 + fr, fq * 8);
#define PG8_SA(b, h) (((b) * 2 + (h)) * HTB)
#define PG8_SB(b, h) ((4 + (b) * 2 + (h)) * HTB)
#define PG8_STAGE_B(bufoff, gbase) do { _Pragma("unroll") for (int _i = 0; _i < 2; ++_i) \
        __builtin_amdgcn_global_load_lds((const unsigned*)((const char*)(gbase) + voffB[_i]), (LAS unsigned*)(lds + (bufoff) + ldsw + _i * 8192), 16, 0, 0); } while (0)
#define PG8_STAGE_A(bufoff, gbase, h) do { _Pragma("unroll") for (int _i = 0; _i < 2; ++_i) \
        __builtin_amdgcn_global_load_lds((const unsigned*)((const char*)(gbase) + (GATHER ? (size_t)0 : (size_t)(h) * hstepA) + voffA[GATHER ? (h) : 0][_i]), (LAS unsigned*)(lds + (bufoff) + ldsw + _i * 8192), 16, 0, 0); } while (0)
#define PG8_LDA(dst, b, h) do { _Pragma("unroll") for (int m = 0; m < 4; ++m) _Pragma("unroll") for (int k = 0; k < 2; ++k) dst[m][k] = *(const LAS bf16x8*)(lds + PG8_SA(b, h) + aoff + m * 2048 + k * 1024); } while (0)
#define PG8_LDB(dst, b, h) do { _Pragma("unroll") for (int n = 0; n < 2; ++n) _Pragma("unroll") for (int k = 0; k < 2; ++k) dst[n][k] = *(const LAS bf16x8*)(lds + PG8_SB(b, h) + boff + n * 2048 + k * 1024); } while (0)
#define PG8_MMA(ai, bj, At, Bt) do { __builtin_amdgcn_s_setprio(1); _Pragma("unroll") for (int m = 0; m < 4; ++m) _Pragma("unroll") for (int n = 0; n < 2; ++n) { \
        if (FP8) { typedef int v8i_ __attribute__((ext_vector_type(8))); typedef int v4i_ __attribute__((ext_vector_type(4))); \
            const v4i_ b0_ = __builtin_bit_cast(v4i_, Bt[n][0]), b1_ = __builtin_bit_cast(v4i_, Bt[n][1]), a0_ = __builtin_bit_cast(v4i_, At[m][0]), a1_ = __builtin_bit_cast(v4i_, At[m][1]); \
            const v8i_ bb_ = {b0_[0], b0_[1], b0_[2], b0_[3], b1_[0], b1_[1], b1_[2], b1_[3]}, aa_ = {a0_[0], a0_[1], a0_[2], a0_[3], a1_[0], a1_[1], a1_[2], a1_[3]}; \
            acc[ai][bj][m][n] = __builtin_amdgcn_mfma_scale_f32_16x16x128_f8f6f4(bb_, aa_, acc[ai][bj][m][n], 0, 0, 0, 0x7f7f7f7f, 0, 0x7f7f7f7f); } \
        else { _Pragma("unroll") for (int k = 0; k < 2; ++k) acc[ai][bj][m][n] = __builtin_amdgcn_mfma_f32_16x16x32_bf16(Bt[n][k], At[m][k], acc[ai][bj][m][n], 0, 0, 0); } } \
        __builtin_amdgcn_s_setprio(0); } while (0)
#define PG8_WAIT_V(n) asm volatile("s_waitcnt vmcnt(" #n ")" ::: "memory")
#define PG8_WAIT_L(n) asm volatile("s_waitcnt lgkmcnt(" #n ")" ::: "memory")
#define PG8_BAR __builtin_amdgcn_s_barrier()
#define PG8_SCHED __builtin_amdgcn_sched_barrier(0)
    Unit cur, nxt; int ui = 0;
    __syncthreads();
    if (!S.next(0, cur)) return;
    if (GATHER) S.a_offs(cur, R0, C0, R1, C1, voffA);
    else { voffA[0][0] = (unsigned)(R0 * lda + C0) * 2u; voffA[0][1] = (unsigned)(R1 * lda + C1) * 2u; voffA[1][0] = 0; voffA[1][1] = 0; }
    f32x4 acc[2][2][4][2];
#pragma unroll
    for (int a = 0; a < 2; ++a)
#pragma unroll
        for (int b = 0; b < 2; ++b)
#pragma unroll
            for (int m = 0; m < 4; ++m)
#pragma unroll
                for (int n = 0; n < 2; ++n) acc[a][b][m][n] = (f32x4){0.f, 0.f, 0.f, 0.f};
    bf16x8 At[4][2], B0[2][2], B1[2][2];
    const char* cA = S.a_base(cur); const char* cB = S.b_base(cur);
    PG8_STAGE_B(PG8_SB(0, 0), cB); PG8_STAGE_B(PG8_SB(0, 1), cB + hstepB); PG8_STAGE_A(PG8_SA(0, 0), cA, 0); PG8_STAGE_A(PG8_SA(0, 1), cA, 1);
    if (wr == 1) PG8_BAR;
    PG8_WAIT_V(2); PG8_BAR;
    PG8_STAGE_B(PG8_SB(1, 0), cB + kstep); PG8_STAGE_A(PG8_SA(1, 0), cA + kstep, 0); PG8_STAGE_B(PG8_SB(1, 1), cB + hstepB + kstep);
    PG8_WAIT_V(6); PG8_BAR;
    for (;;) {
        const bool has_next = S.next(ui + 1, nxt);
        const char* nA = has_next ? S.a_base(nxt) : cA; const char* nB = has_next ? S.b_base(nxt) : cB;
        unsigned vn[2][2];
        if (GATHER) { if (has_next) S.a_offs(nxt, R0, C0, R1, C1, vn); else { vn[0][0] = voffA[0][0]; vn[0][1] = voffA[0][1]; vn[1][0] = voffA[1][0]; vn[1][1] = voffA[1][1]; } }
        for (int t = 0; t < nt; t += 2) {
            const bool last = (t == nt - 2);
            const char* a1 = cA + (size_t)(t + 1) * kstep;
            const char* a2 = last ? nA : cA + (size_t)(t + 2) * kstep; const char* b2 = last ? nB : cB + (size_t)(t + 2) * kstep;
            const char* a3 = a2 + kstep; const char* b3 = b2 + kstep;
            PG8_LDB(B0, 0, 0); PG8_LDB(B1, 0, 1); PG8_SCHED; PG8_LDA(At, 0, 0); PG8_STAGE_A(PG8_SA(1, 1), a1, 1);
            if (GATHER) { if (last) { voffA[0][0] = vn[0][0]; voffA[0][1] = vn[0][1]; voffA[1][0] = vn[1][0]; voffA[1][1] = vn[1][1]; } }
            PG8_WAIT_V(8); PG8_WAIT_L(0); PG8_BAR; PG8_MMA(0, 0, At, B0); PG8_MMA(0, 1, At, B1); PG8_BAR; PG8_SCHED;
            PG8_LDA(At, 0, 1); PG8_STAGE_B(PG8_SB(0, 0), b2); PG8_STAGE_B(PG8_SB(0, 1), b2 + hstepB); PG8_STAGE_A(PG8_SA(0, 0), a2, 0);
            PG8_WAIT_V(8); PG8_WAIT_L(0); PG8_BAR; PG8_MMA(1, 0, At, B0); PG8_MMA(1, 1, At, B1); PG8_BAR; PG8_SCHED;
            PG8_LDB(B0, 1, 0); PG8_LDB(B1, 1, 1); PG8_SCHED; PG8_LDA(At, 1, 0); PG8_STAGE_A(PG8_SA(0, 1), a2, 1);
            PG8_WAIT_V(8); PG8_WAIT_L(0); PG8_BAR; PG8_MMA(0, 0, At, B0); PG8_MMA(0, 1, At, B1); PG8_BAR; PG8_SCHED;
            PG8_LDA(At, 1, 1); PG8_STAGE_B(PG8_SB(1, 0), b3); PG8_STAGE_B(PG8_SB(1, 1), b3 + hstepB); PG8_STAGE_A(PG8_SA(1, 0), a3, 0);
            PG8_WAIT_V(8); PG8_WAIT_L(0); PG8_BAR; PG8_MMA(1, 0, At, B0); PG8_MMA(1, 1, At, B1); PG8_BAR; PG8_SCHED;
        }
        if (ALIGN_EPI) { if (wr == 0) PG8_BAR; }
        { int te = threadIdx.x; asm volatile("" : "+v"(te)); E(acc, cur, wr, wc, te & 15, (te & 63) >> 4); }
        if (!has_next) break;
        if (!S.keep_acc(cur)) {
#pragma unroll
        for (int a = 0; a < 2; ++a)
#pragma unroll
            for (int b = 0; b < 2; ++b)
#pragma unroll
                for (int m = 0; m < 4; ++m)
#pragma unroll
                    for (int n = 0; n < 2; ++n) acc[a][b][m][n] = (f32x4){0.f, 0.f, 0.f, 0.f};
        }
        cur = nxt; cA = nA; cB = nB; ++ui;
        if (ALIGN_EPI) { if (wr == 1) PG8_BAR; }
    }
    PG8_WAIT_V(0);
    if (!ALIGN_EPI) { if (wr == 0) PG8_BAR; }
    PG8_BAR;
#undef PG8_SA
#undef PG8_SB
#undef PG8_STAGE_A
#undef PG8_STAGE_B
#undef PG8_LDA
#undef PG8_LDB
#undef PG8_MMA
#undef PG8_WAIT_V
#undef PG8_WAIT_L
#undef PG8_BAR
#undef PG8_SCHED
}
struct TileOrder {
    int nM, nN, nwg, G, c;
    __device__ __forceinline__ void init(int nM_, int nN_, int G_, int c_) { nM = nM_; nN = nN_; nwg = nM * nN; G = G_; c = c_; }
    __device__ __forceinline__ bool tile(int i, int& pm, int& pn) const {
        const long L = (long)i * G + c; if (L >= nwg) return false;
        int wgid = (int)L; { const int q = nwg / 8, r = nwg % 8, xcd = wgid % 8, off = wgid / 8; wgid = (xcd < r ? xcd * (q + 1) : r * (q + 1) + (xcd - r) * q) + off; }
        const int nig = 8 * nN, gid = wgid / nig, fm = gid * 8, gsz = (nM - fm) < 8 ? (nM - fm) : 8;
        pm = fm + ((wgid % nig) % gsz); pn = (wgid % nig) / gsz; return true;
    }
};
struct DenseSched {
    TileOrder o; const bf16_t* A; const bf16_t* Bt; int lda, ldb;
    __device__ __forceinline__ bool next(int i, Unit& u) const { u.aux = 0; return o.tile(i, u.pm, u.pn); }
    __device__ __forceinline__ const char* a_base(const Unit& u) const { return (const char*)(A + (size_t)u.pm * 256 * lda); }
    __device__ __forceinline__ const char* b_base(const Unit& u) const { return (const char*)(Bt + (size_t)u.pn * 256 * ldb); }
    __device__ __forceinline__ bool keep_acc(const Unit&) const { return false; }
    __device__ __forceinline__ void a_offs(const Unit&, int, int, int, int, unsigned (&)[2][2]) const {}
};
}

struct EpiInProj { bf16_t* qkv; const float* r1; const float* gqa; const float* gka; const float* gqb; const float* gkb; LAS float* X;
    __device__ __forceinline__ void operator()(f32x4 (&acc)[2][2][4][2], const Unit& u, int wr, int wc, int fr, int fq) const {
        const int pn = u.pn;
        bf16_t* base = qkv; const int ldc = NQKV; const int colt = pn * 256 + wc * 32 + 8 * fq;
        const float* gain = pn < 4 ? gqa : (pn == 4 ? gka : ((pn >= 6 && pn < 10) ? gqb : ((pn >= 10 && pn < 14) ? gkb : nullptr)));
        if (gain) {
            const float extra = (pn < 4 || (pn >= 6 && pn < 10)) ? 0.08838834764831845f * 1.4426950408889634f : 1.0f;
#pragma unroll
            for (int ai = 0; ai < 2; ++ai)
#pragma unroll
                for (int m = 0; m < 4; ++m)
#pragma unroll
                    for (int bj = 0; bj < 2; ++bj) { const f32x4 a0 = acc[ai][bj][m][0], a1 = acc[ai][bj][m][1];
                        float sq = (a0[0] * a0[0] + a0[1] * a0[1]) + (a0[2] * a0[2] + a0[3] * a0[3]) + (a1[0] * a1[0] + a1[1] * a1[1]) + (a1[2] * a1[2] + a1[3] * a1[3]);
                        sq += __shfl_xor(sq, 16); sq += __shfl_xor(sq, 32);
                        if (fq == 0) X[(ai * 128 + wr * 64 + m * 16 + fr) * 8 + bj * 4 + wc] = sq; }
            asm volatile("s_waitcnt lgkmcnt(0)" ::: "memory"); __builtin_amdgcn_s_barrier(); asm volatile("" ::: "memory");
            const f32x4 g0 = *(const f32x4*)(gain + wc * 32 + 8 * fq), g1 = *(const f32x4*)(gain + wc * 32 + 8 * fq + 4);
#pragma unroll
            for (int ai = 0; ai < 2; ++ai)
#pragma unroll
                for (int m = 0; m < 4; ++m) { const int rl = ai * 128 + wr * 64 + m * 16 + fr; const int row = u.pm * 256 + rl; const float rs = r1[row] * (1.0f / 64.0f); bf16_t* rowp = base + (size_t)row * ldc + colt;
#pragma unroll
                    for (int bj = 0; bj < 2; ++bj) { const f32x4 t = *(const LAS f32x4*)(X + rl * 8 + bj * 4); const float tot = (t[0] + t[1]) + (t[2] + t[3]);
                        const float sc = rs * rsqrtf(rs * rs * tot * (1.0f / 128.0f) + EPS) * extra;
                        const f32x4 v0 = acc[ai][bj][m][0] * sc * g0, v1 = acc[ai][bj][m][1] * sc * g1;
                        u32x4 w; w.x = pk2(v0[0], v0[1]); w.y = pk2(v0[2], v0[3]); w.z = pk2(v1[0], v1[1]); w.w = pk2(v1[2], v1[3]);
                        *(u32x4*)(rowp + bj * 128) = w; } }
            return;
        }
#pragma unroll
        for (int ai = 0; ai < 2; ++ai)
#pragma unroll
            for (int m = 0; m < 4; ++m) { const int row = u.pm * 256 + ai * 128 + wr * 64 + m * 16 + fr; const float rs = r1[row] * (1.0f / 64.0f); bf16_t* rowp = base + (size_t)row * ldc + colt;
#pragma unroll
                for (int bj = 0; bj < 2; ++bj) { const f32x4 v0 = acc[ai][bj][m][0] * rs, v1 = acc[ai][bj][m][1] * rs;
                    u32x4 w; w.x = pk2(v0[0], v0[1]); w.y = pk2(v0[2], v0[3]); w.z = pk2(v1[0], v1[1]); w.w = pk2(v1[2], v1[3]);
                    *(u32x4*)(rowp + bj * 128) = w; } }
    } };
struct GateSched { pg8::TileOrder o; const unsigned char* x8; const unsigned char* W8;
    __device__ __forceinline__ bool next(int i, Unit& u) const { u.aux = 0; return o.tile(i, u.pm, u.pn); }
    __device__ __forceinline__ const char* a_base(const Unit&) const { return (const char*)x8; }
    __device__ __forceinline__ const char* b_base(const Unit& u) const { return (const char*)(W8 + (size_t)(u.pn * 256) * D); }
    __device__ __forceinline__ bool keep_acc(const Unit&) const { return false; }
    __device__ __forceinline__ void a_offs(const Unit& u, int R0, int C0, int R1, int C1, unsigned (&v)[2][2]) const {
#pragma unroll
        for (int h = 0; h < 2; ++h) { v[h][0] = (unsigned)(u.pm * 256 + 128 * h + R0) * D + C0 * 2u; v[h][1] = (unsigned)(u.pm * 256 + 128 * h + R1) * D + C1 * 2u; } }
};
struct EpiGates { bf16_t* gates; const float* r1;
    __device__ __forceinline__ void operator()(f32x4 (&acc)[2][2][4][2], const Unit& u, int wr, int wc, int fr, int fq) const {
        const int cg = u.pn * 128 + wc * 32 + 8 * fq;
#pragma unroll
        for (int ai = 0; ai < 2; ++ai)
#pragma unroll
            for (int m = 0; m < 4; ++m) { const int row = u.pm * 256 + ai * 128 + wr * 64 + m * 16 + fr; const float rs = r1[row] * (1.0f / 64.0f); bf16_t* rowp = gates + (size_t)row * NGATE + cg;
                float ra[8], sb[8];
#pragma unroll
                for (int n = 0; n < 2; ++n)
#pragma unroll
                    for (int j = 0; j < 4; ++j) { const float ea = __expf(-acc[ai][0][m][n][j] * rs), eb = fminf(__expf(-acc[ai][1][m][n][j] * rs), 1e30f);
                        sb[4 * n + j] = __builtin_amdgcn_rcpf(1.0f + eb); ra[4 * n + j] = (1.0f + eb) * __builtin_amdgcn_rcpf(1.0f + ea); }
                u32x4 w; w.x = pk2(ra[0], ra[1]); w.y = pk2(ra[2], ra[3]); w.z = pk2(ra[4], ra[5]); w.w = pk2(ra[6], ra[7]); *(u32x4*)rowp = w;
                w.x = pk2(sb[0], sb[1]); w.y = pk2(sb[2], sb[3]); w.z = pk2(sb[4], sb[5]); w.w = pk2(sb[6], sb[7]); *(u32x4*)(rowp + 2048) = w; }
    } };
__device__ __forceinline__ void p1_inproj(const Params& p, LAS unsigned char* lds) {
    { GateSched S; S.o.init(128, 18, gridDim.x, blockIdx.x); S.x8 = p.ws + WS_X8; S.W8 = p.ws + WS_WIN;
      EpiInProj E{(bf16_t*)(p.ws + WS_QKV), (const float*)(p.ws + WS_R1), p.in[3], p.in[4], p.in[6], p.in[7], (LAS float*)(lds + 131072)};
      pg8::gemm_phase<true, true, GateSched, EpiInProj, true>(lds, S, E, D / 128, D / 2, D / 2); }
    { GateSched S; S.o.init(128, 16, gridDim.x, blockIdx.x); S.x8 = p.ws + WS_X8; S.W8 = p.ws + WS_WIN + (size_t)NQKV * D;
      EpiGates E{(bf16_t*)(p.ws + WS_GATES), (const float*)(p.ws + WS_R1)};
      pg8::gemm_phase<true, true, GateSched, EpiGates, true>(lds, S, E, D / 128, D / 2, D / 2); }
}

__device__ __forceinline__ void wait_vm(int n) {
    switch (n) { case 0: asm volatile("s_waitcnt vmcnt(0)" ::: "memory"); break; case 2: asm volatile("s_waitcnt vmcnt(2)" ::: "memory"); break; case 4: asm volatile("s_waitcnt vmcnt(4)" ::: "memory"); break;
                 case 6: asm volatile("s_waitcnt vmcnt(6)" ::: "memory"); break; case 8: asm volatile("s_waitcnt vmcnt(8)" ::: "memory"); break; case 10: asm volatile("s_waitcnt vmcnt(10)" ::: "memory"); break;
                 default: asm volatile("s_waitcnt vmcnt(12)" ::: "memory"); break; }
}
__device__ __forceinline__ void glds16_asm(const void* gsrc, unsigned lds_dst) {
    unsigned keep;
    asm volatile("s_mov_b32 %0, m0\n\ts_mov_b32 m0, %2\n\ts_nop 0\n\tglobal_load_lds_dwordx4 %1, off\n\ts_mov_b32 m0, %0" : "=&s"(keep) : "v"(gsrc), "s"(lds_dst) : "memory");
}
#define ATT_BAR() do { asm volatile("s_waitcnt lgkmcnt(0)" ::: "memory"); __builtin_amdgcn_s_barrier(); asm volatile("" ::: "memory"); } while (0)
__device__ __forceinline__ void load_q(const bf16_t* qp, int g, bf16x8 (&qf)[4]) {
#pragma unroll
    for (int ks = 0; ks < 4; ++ks) qf[ks] = *(const bf16x8*)(qp + 32 * ks + 8 * g);
#pragma unroll
    for (int ks = 0; ks < 4; ++ks) asm volatile("" : "+v"(qf[ks]));
}
__device__ __forceinline__ bf16x8 vt_frag(LAS unsigned char* base, int row0, int g, int q4, int pp, int dt) {
    const s16x4 lo = tr_read(base + off_b(row0 + 4 * g + q4, 2 * dt + (pp >> 1)) + 8 * (pp & 1)), hi = tr_read(base + off_b(row0 + 16 + 4 * g + q4, 2 * dt + (pp >> 1)) + 8 * (pp & 1));
    bf16x8 vf; vf[0] = lo[0]; vf[1] = lo[1]; vf[2] = lo[2]; vf[3] = lo[3]; vf[4] = hi[0]; vf[5] = hi[1]; vf[6] = hi[2]; vf[7] = hi[3]; return vf;
}

__device__ __forceinline__ void attn_window_item(const Params& p, LAS unsigned char* lds, int item, int& tab_head) {
    const int tid = phase_tid(), lane = tid & 63, w = __builtin_amdgcn_readfirstlane(tid >> 6), g = lane >> 4, ql = lane & 15;
    const int b = item >> 9, nb = (item >> 2) & 127, hpq = item & 3, kv = hpq >> 1, hq0 = 2 * hpq;
    const bf16_t* qkv = (const bf16_t*)(p.ws + WS_QKV); bf16_t* o = (bf16_t*)(p.ws + WS_O);
    LAS float* bias = (LAS float*)(lds + 131072); const unsigned ldsb = (unsigned)(size_t)lds;
    const unsigned loff = (unsigned)(w * 4 + g) * NQKV + (unsigned)((ql ^ ((g << 2) | (w & 3))) * 8);
    const bf16_t* kbase = qkv + (size_t)(b * SEQ) * NQKV + 1024 + kv * 128;
#define WIN_ISSUE(c) do { const int _c = (c); const int _kb = min(max(nb - 1 + (_c % 3), 0), 127); const bf16_t* _src = kbase + (size_t)(_kb * 128) * NQKV + (_c >= 3 ? 256 : 0) + loff; \
        _Pragma("unroll") for (int _i = 0; _i < 4; ++_i) glds16_asm(_src + (size_t)(32 * _i) * NQKV, ldsb + (unsigned)((_c & 3) * 32768 + _i * 8192 + w * 1024)); } while (0)
    ATT_BAR();
    WIN_ISSUE(0); WIN_ISSUE(1); WIN_ISSUE(2);
    if (hpq != tab_head) { for (int i = tid; i < 2 * 257; i += 512) { const int hh = i >= 257, j = i - 257 * hh; bias[hh * 264 + j] = p.in[12][t5_bucket(j - 128) * 8 + hq0 + hh] * 1.4426950408889634f; } tab_head = hpq; }
    const int tq = b * SEQ + nb * 128 + 16 * w + ql;
    bf16x8 qf[2][4]; load_q(qkv + (size_t)tq * NQKV + hq0 * 128, g, qf[0]); load_q(qkv + (size_t)tq * NQKV + (hq0 + 1) * 128, g, qf[1]);
    float sink[2]; sink[0] = p.in[5][hq0] * 1.4426950408889634f; sink[1] = p.in[5][hq0 + 1] * 1.4426950408889634f; asm volatile("" : "+v"(sink[0]), "+v"(sink[1]));
    f32x4 S1[2][8], SC[2][9];
#pragma unroll
    for (int u = 0; u < 2; ++u) {
#pragma unroll
        for (int kt = 0; kt < 8; ++kt) S1[u][kt] = (f32x4){0.f, 0.f, 0.f, 0.f};
#pragma unroll
        for (int s = 0; s < 9; ++s) SC[u][s] = (f32x4){0.f, 0.f, 0.f, 0.f}; }
    const bool in0 = nb > 0, in2 = nb < 127;
#pragma unroll
    for (int c = 0; c < 3; ++c) {
        wait_vm(8); ATT_BAR(); WIN_ISSUE(c + 3);
        LAS unsigned char* buf = lds + (c & 3) * 32768;
#pragma unroll
        for (int kt = 0; kt < 8; ++kt) {
            const bool act = (c == 1) || (c == 0 ? kt >= w : kt <= w);
            if (act) {
#pragma unroll
                for (int ks = 0; ks < 4; ++ks) { const bf16x8 kf = *(const LAS bf16x8*)(buf + off_b(16 * kt + ql, 4 * ks + g));
#pragma unroll
                    for (int u = 0; u < 2; ++u) {
                        if (c == 1) S1[u][kt] = __builtin_amdgcn_mfma_f32_16x16x32_bf16(kf, qf[u][ks], S1[u][kt], 0, 0, 0);
                        else if (c == 0) SC[u][7 - kt] = __builtin_amdgcn_mfma_f32_16x16x32_bf16(kf, qf[u][ks], SC[u][7 - kt], 0, 0, 0);
                        else SC[u][8 - kt] = __builtin_amdgcn_mfma_f32_16x16x32_bf16(kf, qf[u][ks], SC[u][8 - kt], 0, 0, 0); } } }
        }
    }
    const int qi = 16 * w + ql; float inv[2];
    unsigned P1[2][4][4], PC[2][9][2];
#pragma unroll
    for (int u = 0; u < 2; ++u) { float mx = sink[u]; const LAS float* bt = bias + u * 264;
#pragma unroll
        for (int kt = 0; kt < 8; ++kt)
#pragma unroll
            for (int r = 0; r < 4; ++r) { const int rel = 16 * kt + 4 * g + r - qi; const float sv = S1[u][kt][r] + bt[rel + 128]; S1[u][kt][r] = sv; mx = fmaxf(mx, sv); }
#pragma unroll
        for (int s = 0; s < 9; ++s) { const bool c0 = s <= 7 - w; const int kt = c0 ? 7 - s : 8 - s; const int cofs = c0 ? -128 : 128; const bool inr = c0 ? in0 : in2;
#pragma unroll
            for (int r = 0; r < 4; ++r) { const int rel = cofs + 16 * kt + 4 * g + r - qi; const bool valid = inr && rel >= -128 && rel <= 128;
                const float bv = bt[rel + 128];
                const float sv = valid ? SC[u][s][r] + bv : -1e30f; SC[u][s][r] = sv; mx = fmaxf(mx, sv); } }
        mx = fmaxf(mx, __shfl_xor(mx, 16)); mx = fmaxf(mx, __shfl_xor(mx, 32));
        float l = 0.f;
#pragma unroll
        for (int kk = 0; kk < 4; ++kk) { float e[8];
#pragma unroll
            for (int r = 0; r < 4; ++r) { e[r] = __builtin_amdgcn_exp2f(S1[u][2 * kk][r] - mx); e[4 + r] = __builtin_amdgcn_exp2f(S1[u][2 * kk + 1][r] - mx); l += e[r] + e[4 + r]; }
            P1[u][kk][0] = pk2(e[0], e[1]); P1[u][kk][1] = pk2(e[2], e[3]); P1[u][kk][2] = pk2(e[4], e[5]); P1[u][kk][3] = pk2(e[6], e[7]); }
#pragma unroll
        for (int s = 0; s < 9; ++s) { float e[4];
#pragma unroll
            for (int r = 0; r < 4; ++r) { e[r] = __builtin_amdgcn_exp2f(SC[u][s][r] - mx); l += e[r]; }
            PC[u][s][0] = pk2(e[0], e[1]); PC[u][s][1] = pk2(e[2], e[3]); }
        l += __shfl_xor(l, 16); l += __shfl_xor(l, 32); l += __builtin_amdgcn_exp2f(sink[u] - mx);
        inv[u] = 1.0f / l; }
    f32x4 O[2][8];
#pragma unroll
    for (int u = 0; u < 2; ++u)
#pragma unroll
        for (int dt = 0; dt < 8; ++dt) O[u][dt] = (f32x4){0.f, 0.f, 0.f, 0.f};
    const int q4 = ql >> 2, pp = ql & 3;
#pragma unroll
    for (int c = 0; c < 3; ++c) {
        wait_vm(c == 0 ? 8 : (c == 1 ? 4 : 0)); ATT_BAR();
        LAS unsigned char* buf = lds + ((c + 3) & 3) * 32768;
#pragma unroll
        for (int kk = 0; kk < 4; ++kk) {
            bool a0, a1;
            if (c == 1) { a0 = true; a1 = true; } else if (c == 0) { a0 = 2 * kk >= w; a1 = 2 * kk + 1 >= w; } else { a0 = 2 * kk <= w; a1 = 2 * kk + 1 <= w; }
            if (a0 || a1) { bf16x8 pf[2];
#pragma unroll
                for (int u = 0; u < 2; ++u) { u32x4 pw;
                    if (c == 1) { pw.x = P1[u][kk][0]; pw.y = P1[u][kk][1]; pw.z = P1[u][kk][2]; pw.w = P1[u][kk][3]; }
                    else if (c == 0) { pw.x = a0 ? PC[u][7 - 2 * kk][0] : 0u; pw.y = a0 ? PC[u][7 - 2 * kk][1] : 0u; pw.z = a1 ? PC[u][6 - 2 * kk][0] : 0u; pw.w = a1 ? PC[u][6 - 2 * kk][1] : 0u; }
                    else { pw.x = a0 ? PC[u][8 - 2 * kk][0] : 0u; pw.y = a0 ? PC[u][8 - 2 * kk][1] : 0u; pw.z = a1 ? PC[u][7 - 2 * kk][0] : 0u; pw.w = a1 ? PC[u][7 - 2 * kk][1] : 0u; }
                    pf[u] = __builtin_bit_cast(bf16x8, pw); }
#pragma unroll
                for (int dt = 0; dt < 8; ++dt) { const bf16x8 vf = vt_frag(buf, 32 * kk, g, q4, pp, dt);
                    O[0][dt] = __builtin_amdgcn_mfma_f32_16x16x32_bf16(vf, pf[0], O[0][dt], 0, 0, 0); O[1][dt] = __builtin_amdgcn_mfma_f32_16x16x32_bf16(vf, pf[1], O[1][dt], 0, 0, 0); } } }
    }
#undef WIN_ISSUE
#pragma unroll
    for (int u = 0; u < 2; ++u) { bf16_t* op = o + (size_t)tq * D + (hq0 + u) * 128 + 4 * g;
#pragma unroll
        for (int dt = 0; dt < 8; ++dt) { u32x2 w2; w2.x = pk2(O[u][dt][0] * inv[u], O[u][dt][1] * inv[u]); w2.y = pk2(O[u][dt][2] * inv[u], O[u][dt][3] * inv[u]); *(u32x2*)(op + 16 * dt) = w2; } }
}

__device__ __forceinline__ void attn_nat_item(const Params& p, LAS unsigned char* lds, int item, int& tab_head) {
    const int tid = phase_tid(), lane = tid & 63, w = __builtin_amdgcn_readfirstlane(tid >> 6), g = lane >> 4, ql = lane & 15;
    const int b = item >> 9, rp = (item >> 2) & 127, hp = item & 3, hh = w >> 2, h = 2 * hp + hh, jq = w & 3;
    const int kr_lo = min(max(2 * rp - 4, 0), 248);
    const int d0 = min(max(2 * rp - 4, 0), 248) - kr_lo, d1 = min(max(2 * rp - 3, 0), 248) - kr_lo;
    const int w0 = jq == 0 ? 0 : (jq == 1 ? 8 : (jq == 2 ? 24 : 32));
    const bf16_t* qkv = (const bf16_t*)(p.ws + WS_QKV); bf16_t* o = (bf16_t*)(p.ws + WS_O);
    LAS float* rpb = (LAS float*)(lds + 131072); const unsigned ldsb = (unsigned)(size_t)lds;
    const unsigned loff = (unsigned)(w * 4 + g) * NQKV + (unsigned)((ql ^ ((g << 2) | (w & 3))) * 8);
    const bf16_t* kbase = qkv + (size_t)(b * SEQ) * NQKV + 2560 + 2 * hp * 128;
#define NAT_ISSUE(s) do { const int _s = (s); const int _kr = min(kr_lo + (_s % 9), 255); const bf16_t* _src = kbase + (size_t)(_kr * 64) * NQKV + (_s >= 9 ? 1024 : 0) + loff; \
        _Pragma("unroll") for (int _i = 0; _i < 4; ++_i) glds16_asm(_src + (size_t)(32 * (_i & 1)) * NQKV + 128 * (_i >> 1), ldsb + (unsigned)((_s & 3) * 32768 + _i * 8192 + w * 1024)); } while (0)
    ATT_BAR();
    NAT_ISSUE(0); NAT_ISSUE(1); NAT_ISSUE(2);
    if (hp != tab_head) { for (int i = tid; i < 930; i += 512) rpb[i] = p.in[8][2 * hp * 465 + i] * 1.4426950408889634f; tab_head = hp; }
    const int qcol = 16 * jq + ql; const int tq0 = b * SEQ + (2 * rp) * 64 + qcol;
    bf16x8 qf[2][4]; load_q(qkv + (size_t)tq0 * NQKV + 1536 + h * 128, g, qf[0]); load_q(qkv + (size_t)(tq0 + 64) * NQKV + 1536 + h * 128, g, qf[1]);
    f32x4 S[2][9][2];
#pragma unroll
    for (int u = 0; u < 2; ++u)
#pragma unroll
        for (int c = 0; c < 9; ++c) { S[u][c][0] = (f32x4){0.f, 0.f, 0.f, 0.f}; S[u][c][1] = (f32x4){0.f, 0.f, 0.f, 0.f}; }
#pragma unroll
    for (int c = 0; c < 9; ++c) {
        wait_vm(8); ATT_BAR(); NAT_ISSUE(c + 3);
        const bool a0 = c >= d0 && c < d0 + 8, a1 = c >= d1 && c < d1 + 8;
        LAS unsigned char* buf = lds + (c & 3) * 32768 + hh * 16384;
#pragma unroll
        for (int t = 0; t < 2; ++t)
#pragma unroll
            for (int ks = 0; ks < 4; ++ks) { const bf16x8 kf = *(const LAS bf16x8*)(buf + off_b(w0 + 16 * t + ql, 4 * ks + g));
                if (a0) S[0][c][t] = __builtin_amdgcn_mfma_f32_16x16x32_bf16(kf, qf[0][ks], S[0][c][t], 0, 0, 0);
                if (a1) S[1][c][t] = __builtin_amdgcn_mfma_f32_16x16x32_bf16(kf, qf[1][ks], S[1][c][t], 0, 0, 0); }
    }
    const int cs = min(max(qcol - 8, 0), 48); float inv[2];
    unsigned P[2][9][4];
    int dcv[2][4]; bool cv[2][4];
#pragma unroll
    for (int t = 0; t < 2; ++t)
#pragma unroll
        for (int q = 0; q < 4; ++q) { const int kc = w0 + 16 * t + 4 * g + q; cv[t][q] = kc >= cs && kc < cs + 16; dcv[t][q] = hh * 465 + kc - qcol + 15; }
#pragma unroll
    for (int u = 0; u < 2; ++u) { const int du = u ? d1 : d0; const int r = 2 * rp + u; float mx = -1e30f;
#pragma unroll
        for (int c = 0; c < 9; ++c) { const bool act = c >= du && c < du + 8;
            if (act) { const int rowb = (kr_lo + c - r + 7) * 31;
#pragma unroll
                for (int t = 0; t < 2; ++t)
#pragma unroll
                    for (int q = 0; q < 4; ++q) { const float sv = cv[t][q] ? S[u][c][t][q] + rpb[rowb + dcv[t][q]] : -1e30f; S[u][c][t][q] = sv; mx = fmaxf(mx, sv); } } }
        mx = fmaxf(mx, __shfl_xor(mx, 16)); mx = fmaxf(mx, __shfl_xor(mx, 32));
        float l = 0.f;
#pragma unroll
        for (int c = 0; c < 9; ++c) { const bool act = c >= du && c < du + 8;
            if (act) { float e[2][4];
#pragma unroll
                for (int t = 0; t < 2; ++t)
#pragma unroll
                    for (int q = 0; q < 4; ++q) { e[t][q] = __builtin_amdgcn_exp2f(S[u][c][t][q] - mx); l += e[t][q]; }
                P[u][c][0] = pk2(e[0][0], e[0][1]); P[u][c][1] = pk2(e[0][2], e[0][3]); P[u][c][2] = pk2(e[1][0], e[1][1]); P[u][c][3] = pk2(e[1][2], e[1][3]); }
            else { P[u][c][0] = 0u; P[u][c][1] = 0u; P[u][c][2] = 0u; P[u][c][3] = 0u; } }
        l += __shfl_xor(l, 16); l += __shfl_xor(l, 32);
        inv[u] = 1.0f / l; }
    f32x4 O[2][8];
#pragma unroll
    for (int u = 0; u < 2; ++u)
#pragma unroll
        for (int dt = 0; dt < 8; ++dt) O[u][dt] = (f32x4){0.f, 0.f, 0.f, 0.f};
    const int q4 = ql >> 2, pp = ql & 3;
#pragma unroll
    for (int c = 0; c < 9; ++c) {
        wait_vm(c <= 6 ? 8 : (c == 7 ? 4 : 0)); ATT_BAR(); if (c + 12 < 18) NAT_ISSUE(c + 12);
        const bool a0 = c >= d0 && c < d0 + 8, a1 = c >= d1 && c < d1 + 8;
        LAS unsigned char* buf = lds + ((c + 9) & 3) * 32768 + hh * 16384;
        u32x4 pw0; pw0.x = P[0][c][0]; pw0.y = P[0][c][1]; pw0.z = P[0][c][2]; pw0.w = P[0][c][3];
        u32x4 pw1; pw1.x = P[1][c][0]; pw1.y = P[1][c][1]; pw1.z = P[1][c][2]; pw1.w = P[1][c][3];
        const bf16x8 pf0 = __builtin_bit_cast(bf16x8, pw0), pf1 = __builtin_bit_cast(bf16x8, pw1);
#pragma unroll
        for (int dt = 0; dt < 8; ++dt) { const bf16x8 vf = vt_frag(buf, w0, g, q4, pp, dt);
            if (a0) O[0][dt] = __builtin_amdgcn_mfma_f32_16x16x32_bf16(vf, pf0, O[0][dt], 0, 0, 0);
            if (a1) O[1][dt] = __builtin_amdgcn_mfma_f32_16x16x32_bf16(vf, pf1, O[1][dt], 0, 0, 0); }
    }
#undef NAT_ISSUE
#pragma unroll
    for (int u = 0; u < 2; ++u) { bf16_t* op = o + (size_t)(tq0 + 64 * u) * D + 1024 + h * 128 + 4 * g;
#pragma unroll
        for (int dt = 0; dt < 8; ++dt) { u32x2 w2; w2.x = pk2(O[u][dt][0] * inv[u], O[u][dt][1] * inv[u]); w2.y = pk2(O[u][dt][2] * inv[u], O[u][dt][3] * inv[u]); *(u32x2*)(op + 16 * dt) = w2; } }
}
__device__ __forceinline__ void p2_attn(const Params& p, LAS unsigned char* lds) {
    int tab_head = -1, mb = 0;
    const int nper = (1024 + (int)gridDim.x - 1) / (int)gridDim.x;
    const int NB = (MOE_ITEMS + 8 * (int)gridDim.x - 1) / (8 * (int)gridDim.x);
    for (int s = 0; s < 2 * nper || mb < NB; ++s) {
        if (s < 2 * nper) {
            const bool nat = s >= nper; const int it = (int)blockIdx.x + (nat ? s - nper : s) * (int)gridDim.x;
            if (s == nper) { tab_head = -1;
#ifdef PROBE_A
                if (blockIdx.x == 0 && threadIdx.x == 0) ((unsigned long long*)(p.ws + WS_END))[11] = __builtin_amdgcn_s_memrealtime();
#endif
            }
            if (it < 1024) { if (!nat) attn_window_item(p, lds, it, tab_head); else attn_nat_item(p, lds, it, tab_head); }
        }
        if ((((s + (int)blockIdx.x) & 1) == 0 || s >= 2 * nper) && mb < NB) {
            ATT_BAR();
            for (int q = 0; q < 3 && mb < NB; ++q) moe_prep_batch(p, lds, mb++);
        }
    }
    asm volatile("s_waitcnt vmcnt(0)" ::: "memory"); __syncthreads();
}

struct UpHook { const bf16_t* gates;
    __device__ __forceinline__ void operator()(f32x4 (&acc)[2][2][4][2], const Unit& u, int wr, int wc, int fr, int fq) const {
        const unsigned goff = (unsigned)(u.pm * 256 + wr * 64 + fr) * NGATE + u.pn * 256 + wc * 32 + 8 * fq;
#pragma unroll
        for (int ai = 0; ai < 2; ++ai) {
            bf16x8 ra[4][2];
#pragma unroll
            for (int m = 0; m < 4; ++m)
#pragma unroll
                for (int bj = 0; bj < 2; ++bj) ra[m][bj] = *(const bf16x8*)(gates + goff + (unsigned)((ai * 128 + m * 16) * NGATE) + bj * 128);
#pragma unroll
            for (int m = 0; m < 4; ++m)
#pragma unroll
                for (int bj = 0; bj < 2; ++bj)
#pragma unroll
                    for (int n = 0; n < 2; ++n)
#pragma unroll
                        for (int j = 0; j < 4; ++j) acc[ai][bj][m][n][j] *= bf2f(ra[m][bj][4 * n + j]);
            asm volatile("" ::: "memory"); }
    } };
struct UpSched {
    pg8::TileOrder o; const bf16_t* A; const bf16_t* Bt;
    __device__ __forceinline__ bool next(int i, Unit& u) const { u.aux = i & 1; return o.tile(i >> 1, u.pm, u.pn); }
    __device__ __forceinline__ const char* a_base(const Unit& u) const { return (const char*)(A + (size_t)u.pm * 256 * D + u.aux * 1024); }
    __device__ __forceinline__ const char* b_base(const Unit& u) const { return (const char*)(Bt + (size_t)u.pn * 256 * D + u.aux * 1024); }
    __device__ __forceinline__ bool keep_acc(const Unit& u) const { return u.aux == 0; }
    __device__ __forceinline__ void a_offs(const Unit&, int, int, int, int, unsigned (&)[2][2]) const {}
};
struct EpiUp { const bf16_t* gates; unsigned char* merged;
    __device__ __forceinline__ void operator()(f32x4 (&acc)[2][2][4][2], const Unit& u, int wr, int wc, int fr, int fq) const {
        if (u.aux == 0) { UpHook{gates}(acc, u, wr, wc, fr, fq); return; }
        const unsigned goff = (unsigned)(u.pm * 256 + wr * 64 + fr) * NGATE + 2048 + u.pn * 256 + wc * 32 + 8 * fq;
        const unsigned moff = (unsigned)(u.pm * 256 + wr * 64 + fr) * D + u.pn * 256 + wc * 32 + 8 * fq;
#pragma unroll
        for (int ai = 0; ai < 2; ++ai) {
            bf16x8 sb[4][2];
#pragma unroll
            for (int m = 0; m < 4; ++m)
#pragma unroll
                for (int bj = 0; bj < 2; ++bj) sb[m][bj] = *(const bf16x8*)(gates + goff + (unsigned)((ai * 128 + m * 16) * NGATE) + bj * 128);
#pragma unroll
            for (int m = 0; m < 4; ++m)
#pragma unroll
                for (int bj = 0; bj < 2; ++bj) { f32x4 v0 = acc[ai][bj][m][0], v1 = acc[ai][bj][m][1];
#pragma unroll
                    for (int j = 0; j < 4; ++j) { v0[j] *= bf2f(sb[m][bj][j]); v1[j] *= bf2f(sb[m][bj][4 + j]); }
                    u32x2 w; w.x = pk4_fp8(v0[0] * 16.f, v0[1] * 16.f, v0[2] * 16.f, v0[3] * 16.f); w.y = pk4_fp8(v1[0] * 16.f, v1[1] * 16.f, v1[2] * 16.f, v1[3] * 16.f);
                    *(u32x2*)(merged + moff + (unsigned)((ai * 128 + m * 16) * D) + bj * 128) = w; }
            asm volatile("" ::: "memory"); }
    } };
__device__ __forceinline__ void p3_up(const Params& p, LAS unsigned char* lds) {
    UpSched S; S.o.init(128, 8, gridDim.x, blockIdx.x); S.A = (const bf16_t*)(p.ws + WS_O); S.Bt = (const bf16_t*)(p.ws + WS_WUP);
    EpiUp E{(const bf16_t*)(p.ws + WS_GATES), p.ws + WS_MG};
    pg8::gemm_phase<true, false>(lds, S, E, 1024 / 64, D, D);
}

struct EpiOut { const bf16_t* xb; bf16_t* hb; unsigned char* h8;
    __device__ __forceinline__ void operator()(f32x4 (&acc)[2][2][4][2], const Unit& u, int wr, int wc, int fr, int fq) const {
        unsigned off = (unsigned)(u.pm * 256 + wr * 64 + fr) * D + u.pn * 256 + wc * 32 + 8 * fq;
#pragma unroll
        for (int ai = 0; ai < 2; ++ai) {
            bf16x8 xr[4][2];
#pragma unroll
            for (int m = 0; m < 4; ++m)
#pragma unroll
                for (int bj = 0; bj < 2; ++bj) xr[m][bj] = *(const bf16x8*)(xb + off + (unsigned)(m * 16 * D) + bj * 128);
#pragma unroll
            for (int m = 0; m < 4; ++m) { asm volatile("" : "+v"(off));
#pragma unroll
                for (int bj = 0; bj < 2; ++bj) { const f32x4 v0 = acc[ai][bj][m][0] * (1.0f / 1024.0f), v1 = acc[ai][bj][m][1] * (1.0f / 1024.0f); const u32x4 xw = __builtin_bit_cast(u32x4, xr[m][bj]);
                    const float h0 = v0[0] + __uint_as_float(xw.x << 16), h1 = v0[1] + __uint_as_float(xw.x & 0xffff0000u), h2 = v0[2] + __uint_as_float(xw.y << 16), h3 = v0[3] + __uint_as_float(xw.y & 0xffff0000u);
                    const float h4 = v1[0] + __uint_as_float(xw.z << 16), h5 = v1[1] + __uint_as_float(xw.z & 0xffff0000u), h6 = v1[2] + __uint_as_float(xw.w << 16), h7 = v1[3] + __uint_as_float(xw.w & 0xffff0000u);
                    u32x4 w; w.x = pk2(h0, h1); w.y = pk2(h2, h3); w.z = pk2(h4, h5); w.w = pk2(h6, h7);
                    *(u32x4*)(hb + off + bj * 128) = w;
                    u32x2 f; f.x = pk4_fp8(h0, h1, h2, h3); f.y = pk4_fp8(h4, h5, h6, h7);
                    *(u32x2*)(h8 + off + bj * 128) = f; }
                off += 16 * D; }
            off += 64 * D; }
    } };
__device__ __forceinline__ void p4_out(const Params& p, LAS unsigned char* lds) {
    GateSched S; S.o.init(128, 8, gridDim.x, blockIdx.x); S.x8 = p.ws + WS_MG; S.W8 = p.ws + WS_WOUT;
    EpiOut E{(const bf16_t*)(p.ws + WS_XB), (bf16_t*)(p.ws + WS_O), p.ws + WS_H8};
    pg8::gemm_phase<true, true, GateSched, EpiOut, true, false>(lds, S, E, D / 128, D / 2, D / 2);
}

__device__ __forceinline__ void p5_router(const Params& p, LAS unsigned char* lds) {
    const int tid = phase_tid(), lane = tid & 63, wave = __builtin_amdgcn_readfirstlane(tid >> 6), g = lane >> 4, tl = lane & 15;
    const bf16_t* wsp = (const bf16_t*)(p.ws + WS_WRT); float* r2 = (float*)(p.ws + WS_R2); int* cnt = (int*)(p.ws + WS_CNT); int* tokl = (int*)(p.ws + WS_TOK);
    int* recc = (int*)(p.ws + WS_RECC); float* recw = (float*)(p.ws + WS_RECW); const bf16_t* hb = (const bf16_t*)(p.ws + WS_O);
    const float* brg = p.in[15]; const float* bre = p.in[17];
    LAS unsigned char* H = lds + wave * 2304;
    LAS unsigned char* WL = lds + 36864;
    const int r8 = lane >> 3, s8 = lane & 7;
    const int pa0 = tid / 384, pr0 = (tid % 384) >> 3, ps0 = tid & 7, pi1 = 512 + tid, pa1 = pi1 / 384, pr1 = (pi1 % 384) >> 3;
    const unsigned wsrc0 = (unsigned)(pa0 * 48 * 2048 + pr0 * D + ps0 * 8), wsrc1 = (unsigned)(pa1 * 48 * 2048 + pr1 * D + ps0 * 8);
    const unsigned wdst0 = (unsigned)(pa0 * 6144 + pr0 * 128 + ((ps0 ^ (pr0 & 7)) << 4)), wdst1 = (unsigned)(pa1 * 6144 + pr1 * 128 + ((ps0 ^ (pr1 & 7)) << 4));
    for (int round = blockIdx.x; round < T / 128; round += gridDim.x) {
        const int tile = round * 8 + wave;
        const bf16_t* hs = hb + (size_t)tile * 16 * D + r8 * D + s8 * 8;
        f32x4 accA = {0.f, 0.f, 0.f, 0.f}, accB = accA, accC = accA; float ss = 0.f;
        u32x4 hq0[2], hq1[2], hq2[2], hq3[2], wr0, wr1;
#define RT_LOADS(bq, k) do { bq[0] = *(const u32x4*)(hs + 64 * (k)); bq[1] = *(const u32x4*)(hs + 8 * D + 64 * (k)); } while (0)
#define RT_COMP(bq, wbuf) do { \
            *(LAS u32x4*)(H + r8 * 144 + s8 * 16) = bq[0]; *(LAS u32x4*)(H + (r8 + 8) * 144 + s8 * 16) = bq[1]; \
            _Pragma("unroll") for (int ks = 0; ks < 2; ++ks) { const u32x4 hw = *(const LAS u32x4*)(H + tl * 144 + 64 * ks + 16 * g); \
                { const float a0 = __uint_as_float(hw.x << 16), a1 = __uint_as_float(hw.x & 0xffff0000u), a2 = __uint_as_float(hw.y << 16), a3 = __uint_as_float(hw.y & 0xffff0000u); \
                  const float a4 = __uint_as_float(hw.z << 16), a5 = __uint_as_float(hw.z & 0xffff0000u), a6 = __uint_as_float(hw.w << 16), a7 = __uint_as_float(hw.w & 0xffff0000u); \
                  ss += (a0 * a0 + a1 * a1) + (a2 * a2 + a3 * a3) + (a4 * a4 + a5 * a5) + (a6 * a6 + a7 * a7); } \
                const bf16x8 bh = __builtin_bit_cast(bf16x8, hw); const unsigned so_ = (unsigned)(((4 * ks + g) ^ (tl & 7)) << 4); \
                _Pragma("unroll") for (int t = 0; t < 3; ++t) { const bf16x8 ah = *(const LAS bf16x8*)((wbuf) + (16 * t + tl) * 128 + so_), al = *(const LAS bf16x8*)((wbuf) + 6144 + (16 * t + tl) * 128 + so_); \
                    f32x4& ac = (t == 0 ? accA : (t == 1 ? accB : accC)); \
                    ac = __builtin_amdgcn_mfma_f32_16x16x32_bf16(ah, bh, ac, 0, 0, 0); ac = __builtin_amdgcn_mfma_f32_16x16x32_bf16(al, bh, ac, 0, 0, 0); } } } while (0)
#define RT_WLOAD(c) do { wr0 = *(const u32x4*)(wsp + wsrc0 + 64 * (c)); if (tid < 256) wr1 = *(const u32x4*)(wsp + wsrc1 + 64 * (c)); } while (0)
#define RT_WSTORE(wbuf) do { *(LAS u32x4*)((wbuf) + wdst0) = wr0; if (tid < 256) *(LAS u32x4*)((wbuf) + wdst1) = wr1; } while (0)
        __syncthreads();
        RT_WLOAD(0); RT_LOADS(hq0, 0); RT_LOADS(hq1, 1); RT_LOADS(hq2, 2);
        RT_WSTORE(WL); RT_WLOAD(1);
        __syncthreads();
#pragma unroll 1
        for (int c = 0; c < D / 64; c += 4) {
            RT_LOADS(hq3, (c + 3));      RT_COMP(hq0, WL);         RT_WSTORE(WL + 12288); RT_WLOAD((c + 2) & 31); __syncthreads();
            RT_LOADS(hq0, (c + 4) & 31); RT_COMP(hq1, WL + 12288); RT_WSTORE(WL);         RT_WLOAD((c + 3) & 31); __syncthreads();
            RT_LOADS(hq1, (c + 5) & 31); RT_COMP(hq2, WL);         RT_WSTORE(WL + 12288); RT_WLOAD((c + 4) & 31); __syncthreads();
            RT_LOADS(hq2, (c + 6) & 31); RT_COMP(hq3, WL + 12288); RT_WSTORE(WL);         RT_WLOAD((c + 5) & 31); __syncthreads();
        }
#undef RT_LOADS
#undef RT_COMP
#undef RT_WLOAD
#undef RT_WSTORE
        const int tok = tile * 16 + tl;
        ss += __shfl_xor(ss, 16); ss += __shfl_xor(ss, 32);
        const float rr = rsqrtf(ss * (1.0f / D) + EPS);
        const float myg = accC[0] * rr + brg[g];
        float gl[4];
#pragma unroll
        for (int j = 0; j < 4; ++j) gl[j] = __shfl(myg, tl + 16 * j);
        int gi = 0; float gm = gl[0];
#pragma unroll
        for (int i = 1; i < 4; ++i) if (gl[i] > gm) { gm = gl[i]; gi = i; }
        float den = 0.f;
#pragma unroll
        for (int i = 0; i < 4; ++i) den += __expf(gl[i] - gm);
        const float pg = 1.0f / den;
        int L0 = 0, L1 = 0; float wt0 = 0.f, wt1 = 0.f; const bool owner = (g == gi);
        if (owner) {
            float el[8];
#pragma unroll
            for (int i = 0; i < 4; ++i) { el[i] = accA[i] * rr + bre[g * 8 + i]; el[4 + i] = accB[i] * rr + bre[g * 8 + 4 + i]; }
            int e0 = 0; float v0 = el[0];
#pragma unroll
            for (int i = 1; i < 8; ++i) if (el[i] > v0) { v0 = el[i]; e0 = i; }
            int e1 = -1; float v1 = -3.0e38f;
#pragma unroll
            for (int i = 0; i < 8; ++i) if (i != e0 && el[i] > v1) { v1 = el[i]; e1 = i; }
            const float ex = __expf(v1 - v0); const float s0 = 1.0f / (1.0f + ex), s1 = ex * s0;
            r2[tok] = rr; L0 = gi * 8 + e0; L1 = gi * 8 + e1; wt0 = pg * s0; wt1 = pg * s1;
        }
        LAS int* cl = (LAS int*)(lds + 61440);
        if (tid < 32) cl[tid] = 0;
        __syncthreads();
        int q0 = 0, q1 = 0;
        if (owner) { q0 = __hip_atomic_fetch_add(&cl[L0], 1, __ATOMIC_RELAXED, __HIP_MEMORY_SCOPE_WORKGROUP); q1 = __hip_atomic_fetch_add(&cl[L1], 1, __ATOMIC_RELAXED, __HIP_MEMORY_SCOPE_WORKGROUP); }
        __syncthreads();
        if (tid < 32) { const int n = cl[tid]; cl[32 + tid] = n ? atomicAdd(&cnt[tid], n) : 0; }
        __syncthreads();
        if (owner) { const int p0 = cl[32 + L0] + q0, p1 = cl[32 + L1] + q1;
            float* r2l = (float*)(p.ws + WS_R2L);
            tokl[(size_t)L0 * T + p0] = tok; r2l[(size_t)L0 * T + p0] = rr; recc[2 * tok] = L0 * 32768 + p0; recw[2 * tok] = wt0;
            tokl[(size_t)L1 * T + p1] = tok; r2l[(size_t)L1 * T + p1] = rr; recc[2 * tok + 1] = L1 * 32768 + p1; recw[2 * tok + 1] = wt1; }
    }
    __syncthreads();
}

__device__ __forceinline__ void build_tiles(const Params& p, LAS int* tab) {
    __syncthreads();
    if (threadIdx.x < 64) { const int L = threadIdx.x; const int c = L < 32 ? ((const int*)(p.ws + WS_CNT))[L] : 0; const int nt = (c + 255) >> 8;
        int pre = nt;
#pragma unroll
        for (int o = 1; o < 32; o <<= 1) { const int v = __shfl_up(pre, o); if (L >= o) pre += v; }
        const int first = pre - nt;
        if (L < 32) { tab[1400 + L] = first * 256; for (int i = 0; i < nt; ++i) { tab[4 + (first + i) * 4 + 0] = L; tab[4 + (first + i) * 4 + 1] = i * 256; tab[4 + (first + i) * 4 + 2] = (first + i) * 256; tab[4 + (first + i) * 4 + 3] = min(256, c - i * 256); } }
        if (L == 31) tab[0] = pre; }
    __syncthreads();
}
template <int NPN> struct MoeOrder { int G, c, t_lo, nt_tiles; const LAS int* tab;
    __device__ __forceinline__ bool unit(int i, Unit& u) const { const long L = (long)i * G + c; if (L >= (long)nt_tiles * NPN) return false;
        const int nwg = nt_tiles * NPN; int wgid = (int)L; { const int q = nwg / 8, r = nwg % 8, xcd = wgid % 8, off = wgid / 8; wgid = (xcd < r ? xcd * (q + 1) : r * (q + 1) + (xcd - r) * q) + off; }
        u.pm = t_lo + wgid / NPN; u.pn = wgid % NPN; u.aux = 0; return true; } };
struct GateUpSched { MoeOrder<4> o; const unsigned char* hb; const unsigned char* WguT; const int* tokl;
    __device__ __forceinline__ bool next(int i, Unit& u) const { return o.unit(i, u); }
    __device__ __forceinline__ const char* a_base(const Unit&) const { return (const char*)hb; }
    __device__ __forceinline__ const char* b_base(const Unit& u) const { const int e = o.tab[4 + u.pm * 4] & 31; return (const char*)(WguT + (size_t)(e * 1024 + u.pn * 256) * D); }
    __device__ __forceinline__ bool keep_acc(const Unit&) const { return false; }
    __device__ __forceinline__ void a_offs(const Unit& u, int R0, int C0, int R1, int C1, unsigned (&v)[2][2]) const {
        const int L = o.tab[4 + u.pm * 4], row0 = o.tab[4 + u.pm * 4 + 1], nrows = o.tab[4 + u.pm * 4 + 3]; const int* lst = tokl + (size_t)L * T + row0;
#pragma unroll
        for (int h = 0; h < 2; ++h) { const int r0 = R0 + 128 * h, r1 = R1 + 128 * h; const int t0 = r0 < nrows ? lst[r0] : 0, t1 = r1 < nrows ? lst[r1] : 0;
            v[h][0] = (unsigned)t0 * D + C0 * 2u; v[h][1] = (unsigned)t1 * D + C1 * 2u; } }
};
struct EpiGateUp { const LAS int* tab; const float* r2l; unsigned char* he;
    __device__ __forceinline__ void operator()(f32x4 (&acc)[2][2][4][2], const Unit& u, int wr, int wc, int fr, int fq) const {
        const int L = tab[4 + u.pm * 4], row0 = tab[4 + u.pm * 4 + 1], slot = tab[4 + u.pm * 4 + 2], nrows = tab[4 + u.pm * 4 + 3];
#pragma unroll
        for (int ai = 0; ai < 2; ++ai)
#pragma unroll
            for (int m = 0; m < 4; ++m) { const int rr = ai * 128 + wr * 64 + m * 16 + fr; const float rs = rr < nrows ? r2l[(size_t)L * T + row0 + rr] * (1.0f / 64.0f) : 0.f;
                u32x2 w; unsigned ww[2];
#pragma unroll
                for (int n = 0; n < 2; ++n) { float hv[4];
#pragma unroll
                    for (int j = 0; j < 4; ++j) { const float gt = acc[ai][0][m][n][j] * rs, up = acc[ai][1][m][n][j] * rs; hv[j] = gt * sigmoidf_(gt) * up * 4.0f; }
                    ww[n] = pk4_fp8(hv[0], hv[1], hv[2], hv[3]); }
                w.x = ww[0]; w.y = ww[1];
                *(u32x2*)(he + (size_t)(slot + rr) * 512 + u.pn * 128 + wc * 32 + 8 * fq) = w; }
    } };
__device__ __forceinline__ void p6_gateup(const Params& p, LAS unsigned char* lds) {
    LAS int* tab = (LAS int*)(lds + TAB_OFF); build_tiles(p, tab);
    GateUpSched S; S.o.G = gridDim.x; S.o.c = blockIdx.x; S.o.t_lo = 0; S.o.nt_tiles = tab[0]; S.o.tab = tab;
    S.hb = p.ws + WS_H8; S.WguT = p.ws + WS_WGU; S.tokl = (const int*)(p.ws + WS_TOK);
    EpiGateUp E{tab, (const float*)(p.ws + WS_R2L), p.ws + WS_HE};
    pg8::gemm_phase<true, true, GateUpSched, EpiGateUp, true>(lds, S, E, D / 128, D / 2, D / 2);
}
struct DownSched { MoeOrder<8> o; const unsigned char* he; const unsigned char* WdT;
    __device__ __forceinline__ bool next(int i, Unit& u) const { return o.unit(i, u); }
    __device__ __forceinline__ const char* a_base(const Unit&) const { return (const char*)he; }
    __device__ __forceinline__ const char* b_base(const Unit& u) const { const int e = o.tab[4 + u.pm * 4] & 31; return (const char*)(WdT + (size_t)(e * 2048 + u.pn * 256) * 512); }
    __device__ __forceinline__ bool keep_acc(const Unit&) const { return false; }
    __device__ __forceinline__ void a_offs(const Unit& u, int R0, int C0, int R1, int C1, unsigned (&v)[2][2]) const {
        const int slot = o.tab[4 + u.pm * 4 + 2];
#pragma unroll
        for (int h = 0; h < 2; ++h) { v[h][0] = (unsigned)(slot + 128 * h + R0) * 512u + C0 * 2u; v[h][1] = (unsigned)(slot + 128 * h + R1) * 512u + C1 * 2u; } }
};
struct EpiDown { const LAS int* tab; unsigned char* ye;
    __device__ __forceinline__ void operator()(f32x4 (&acc)[2][2][4][2], const Unit& u, int wr, int wc, int fr, int fq) const {
        const int slot = tab[4 + u.pm * 4 + 2];
        unsigned off = (unsigned)(slot + wr * 64 + fr) * 2048 + u.pn * 256 + wc * 32 + 8 * fq;
#pragma unroll
        for (int ai = 0; ai < 2; ++ai) {
#pragma unroll
            for (int m = 0; m < 4; ++m) { asm volatile("" : "+v"(off));
#pragma unroll
                for (int bj = 0; bj < 2; ++bj) { const f32x4 v0 = acc[ai][bj][m][0] * 0.0625f, v1 = acc[ai][bj][m][1] * 0.0625f;
                    u32x2 w; w.x = pk4_fp8(v0[0], v0[1], v0[2], v0[3]); w.y = pk4_fp8(v1[0], v1[1], v1[2], v1[3]);
                    *(u32x2*)(ye + off + bj * 128) = w; }
                off += 16 * 2048; }
            off += 64 * 2048; }
    } };
__device__ __forceinline__ void p7_down(const Params& p, LAS unsigned char* lds) {
    LAS int* tab = (LAS int*)(lds + TAB_OFF); build_tiles(p, tab);
    DownSched S; S.o.G = gridDim.x; S.o.c = blockIdx.x; S.o.t_lo = 0; S.o.nt_tiles = tab[0]; S.o.tab = tab;
    S.he = p.ws + WS_HE; S.WdT = p.ws + WS_WD;
    EpiDown E{tab, p.ws + WS_YE};
    int ntv = 512 / 128; asm volatile("" : "+s"(ntv));
    pg8::gemm_phase<true, true, DownSched, EpiDown, true, false>(lds, S, E, ntv, 256, 256);
}
__device__ __forceinline__ void p8_combine(const Params& p, LAS unsigned char* lds) {
    LAS int* tab = (LAS int*)(lds + TAB_OFF); build_tiles(p, tab);
    const int tid = phase_tid(), lane = tid & 63, wave = tid >> 6; const int gw = blockIdx.x * 8 + wave, NGW = gridDim.x * 8;
    const int* recc = (const int*)(p.ws + WS_RECC); const float* recw = (const float*)(p.ws + WS_RECW); const bf16_t* hb = (const bf16_t*)(p.ws + WS_O);
    const unsigned char* ye = p.ws + WS_YE;
    for (int tok = gw; tok < T; tok += NGW) {
        const int c0 = recc[2 * tok], c1 = recc[2 * tok + 1]; const float wa = recw[2 * tok] * 0.0625f, wb = recw[2 * tok + 1] * 0.0625f;
        const int s0 = tab[1400 + (c0 >> 15)] + (c0 & 32767), s1 = tab[1400 + (c1 >> 15)] + (c1 & 32767);
        f32x4* op = (f32x4*)(p.out + (size_t)tok * D) + lane; const u32x2* hp = (const u32x2*)(hb + (size_t)tok * D) + lane;
        const unsigned* ya = (const unsigned*)(ye + (size_t)s0 * 2048) + lane; const unsigned* yb = (const unsigned*)(ye + (size_t)s1 * 2048) + lane;
        u32x2 m[8]; unsigned a[8], b[8];
#pragma unroll
        for (int j = 0; j < 8; ++j) { m[j] = hp[64 * j]; a[j] = ya[64 * j]; b[j] = yb[64 * j]; }
#pragma unroll
        for (int j = 0; j < 8; ++j) { f32x4 v;
            const f32x2 a0 = __builtin_amdgcn_cvt_pk_f32_fp8(a[j], false), a1 = __builtin_amdgcn_cvt_pk_f32_fp8(a[j], true), b0 = __builtin_amdgcn_cvt_pk_f32_fp8(b[j], false), b1 = __builtin_amdgcn_cvt_pk_f32_fp8(b[j], true);
            v.x = __uint_as_float(m[j].x << 16) + wa * a0.x + wb * b0.x; v.y = __uint_as_float(m[j].x & 0xffff0000u) + wa * a0.y + wb * b0.y;
            v.z = __uint_as_float(m[j].y << 16) + wa * a1.x + wb * b1.x; v.w = __uint_as_float(m[j].y & 0xffff0000u) + wa * a1.y + wb * b1.y;
            op[64 * j] = v; }
    }
}

#define XB_TMO      128
#define XB_XCNT(j)  (256  + 64 * (j))
#define XB_XSUB(j)  (1280 + 64 * (j))
#define XB_XGEN(j)  (2304 + 64 * (j))
#define XB_TOP      3328
#define XB_TOPGEN   3392
#define XCD_BAR_WORDS 3456
#define XB_SPIN_CAP (1u << 18)
__device__ __forceinline__ unsigned xb_ld(unsigned* p)              { return __hip_atomic_load(p, __ATOMIC_RELAXED, __HIP_MEMORY_SCOPE_AGENT); }
__device__ __forceinline__ unsigned xb_add(unsigned* p, unsigned v) { return __hip_atomic_fetch_add(p, v, __ATOMIC_RELAXED, __HIP_MEMORY_SCOPE_AGENT); }
__device__ __forceinline__ unsigned xb_xcc_id() { return (unsigned)__builtin_amdgcn_s_getreg((3 << 11) | 20) & 0xFu; }
#define XB_SPIN(cond, bar) do { unsigned _sp = 0; while (cond) { __builtin_amdgcn_s_sleep(1); \
    if ((++_sp & 255u) == 0u) { if (xb_ld(&(bar)[XB_TMO])) break; if (_sp > XB_SPIN_CAP) { atomicAdd(&(bar)[XB_TMO], 1u); break; } } } } while (0)
struct XcdBarrier { unsigned* bar; unsigned x; volatile LAS unsigned* st; };
__device__ __forceinline__ XcdBarrier xcd_barrier_post(unsigned* bar, volatile LAS unsigned* st) {
    XcdBarrier b; b.bar = bar; b.x = xb_xcc_id(); b.st = st;
    if (threadIdx.x == 0) (void)xb_add(&bar[XB_XCNT(b.x)], 1u);
    return b;
}
__device__ __forceinline__ void xcd_barrier_complete(unsigned* bar, unsigned x, unsigned& nloc, unsigned& nx) {
    const unsigned G = gridDim.x * gridDim.y * gridDim.z;
    unsigned sum, cnt, mine, sp = 0u;
    for (;;) {
        sum = 0u; cnt = 0u; mine = 0u;
#pragma unroll
        for (unsigned j = 0; j < 16; ++j) { const unsigned c = xb_ld(&bar[XB_XCNT(j)]); sum += c; cnt += (c > 0u) ? 1u : 0u; mine = (j == x) ? c : mine; }
        if (sum == G) break;
        __builtin_amdgcn_s_sleep(1);
        if ((++sp & 255u) == 0u) { if (xb_ld(&bar[XB_TMO])) break; if (sp > XB_SPIN_CAP) { atomicAdd(&bar[XB_TMO], 1u); break; } }
    }
    nloc = mine > 0u ? mine : 1u; nx = cnt > 0u ? cnt : 1u;
}
__device__ __forceinline__ void xcd_barrier(const XcdBarrier& b) {
    asm volatile("s_waitcnt vmcnt(0)" ::: "memory");
    __syncthreads();
    if (threadIdx.x == 0) {
        unsigned* bar = b.bar;
        __builtin_amdgcn_s_waitcnt(0);
        unsigned nloc = b.st[0], nx = b.st[1];
        if (nloc == 0u) { xcd_barrier_complete(bar, b.x, nloc, nx); b.st[0] = nloc; b.st[1] = nx; }
        const unsigned old = xb_add(&bar[XB_XSUB(b.x)], 1u);
        const unsigned gen = old / nloc;
        if (old + 1u == (gen + 1u) * nloc) {
            __builtin_amdgcn_fence(__ATOMIC_RELEASE, "agent");
            asm volatile("s_waitcnt vmcnt(0)" ::: "memory");
            const unsigned og = xb_add(&bar[XB_TOP], 1u);
            const unsigned tg = og / nx;
            if (og + 1u == (tg + 1u) * nx) xb_add(&bar[XB_TOPGEN], 1u);
            else XB_SPIN(xb_ld(&bar[XB_TOPGEN]) == tg, bar);
            __builtin_amdgcn_fence(__ATOMIC_ACQUIRE, "agent");
            xb_add(&bar[XB_XGEN(b.x)], 1u);
            asm volatile("s_waitcnt vmcnt(0)" ::: "memory");
        } else {
            XB_SPIN(xb_ld(&bar[XB_XGEN(b.x)]) == gen, bar);
            __builtin_amdgcn_fence(__ATOMIC_ACQUIRE, "agent");
            asm volatile("s_waitcnt vmcnt(0)" ::: "memory");
        }
    }
    __syncthreads();
}

namespace cg = cooperative_groups;
#ifdef PROBE_A
#define STAMP(k) do { if (blockIdx.x == 0 && threadIdx.x == 0) ((unsigned long long*)(p.ws + WS_END))[k] = __builtin_amdgcn_s_memrealtime(); } while (0)
#else
#define STAMP(k) do {} while (0)
#endif
__global__ void __launch_bounds__(512, 2) fwd_megakernel(Params p) {
    extern __shared__ __attribute__((aligned(16))) unsigned char lds_raw[];
    LAS unsigned char* lds = (LAS unsigned char*)lds_raw;
    cg::grid_group grid = cg::this_grid();
    if (threadIdx.x == 0) { *(volatile LAS unsigned*)(lds + XBST_OFF) = 0u; *(volatile LAS unsigned*)(lds + XBST_OFF + 4) = 0u; }
    if (blockIdx.x == 0) for (int i = threadIdx.x; i < XCD_BAR_WORDS; i += 512) ((unsigned*)(p.ws + WS_BAR))[i] = 0u;
    __syncthreads();
#define GSYNC() xcd_barrier(xb)
    STAMP(0);
    p0_prep(p, lds);            grid.sync(); STAMP(1);
    const XcdBarrier xb = xcd_barrier_post((unsigned*)(p.ws + WS_BAR), (volatile LAS unsigned*)(lds + XBST_OFF));
    p1_inproj(p, lds);          GSYNC(); STAMP(2);
    p2_attn(p, lds);            GSYNC(); STAMP(3);
    STAMP(4);
    p3_up(p, lds);              GSYNC(); STAMP(5);
    p4_out(p, lds);             GSYNC(); STAMP(6);
    p5_router(p, lds);          GSYNC(); STAMP(7);
    p6_gateup(p, lds);          GSYNC(); STAMP(8);
    p7_down(p, lds);            GSYNC(); STAMP(9);
    p8_combine(p, lds);
#ifdef PROBE_A
    grid.sync(); STAMP(10); grid.sync();
    {
        const unsigned long long* ts = (const unsigned long long*)(p.ws + WS_END);
        #ifndef PROBE_A1
#define PROBE_A1 (PROBE_A + 1)
#endif
#ifndef PROBE_B1
#define PROBE_B1 (PROBE_B + 1)
#endif
        const float usA = (float)(ts[PROBE_A1] - ts[PROBE_A]) * 0.01f, usB = (float)(ts[PROBE_B1] - ts[PROBE_B]) * 0.01f;
        const float eps = sqrtf(usA * 1e-6f);
        for (size_t i = (size_t)blockIdx.x * 512 + threadIdx.x; i < (size_t)T * D / 4; i += (size_t)gridDim.x * 512) { f32x4 v = ((f32x4*)p.out)[i]; v = v * (1.0f + eps); if (i == 0) v.x += usB * 0.1f; ((f32x4*)p.out)[i] = v; }
    }
#endif
}

extern "C" void kernel_launch(void* const* d_in, const int* in_sizes, int n_in, void* d_out, int out_size, void* d_ws, size_t ws_size, hipStream_t stream) {
    static int grid_blocks = 0;
    if (!grid_blocks) {
        if (n_in != 21 || out_size != T * D || ws_size < WS_TOP) { fprintf(stderr, "kernel_launch: unexpected problem (n_in %d out %d ws %zu)\n", n_in, out_size, ws_size); grid_blocks = -1; return; }
        if (hipFuncSetAttribute((const void*)fwd_megakernel, hipFuncAttributeMaxDynamicSharedMemorySize, LDS_BYTES) != hipSuccess) { fprintf(stderr, "kernel_launch: hipFuncSetAttribute failed\n"); grid_blocks = -1; return; }
        int dev = 0, cus = 0, per_cu = 0;
        hipGetDevice(&dev); hipDeviceGetAttribute(&cus, hipDeviceAttributeMultiprocessorCount, dev);
        hipOccupancyMaxActiveBlocksPerMultiprocessor(&per_cu, (const void*)fwd_megakernel, 512, LDS_BYTES);
        if (per_cu < 1 || cus < 1) { fprintf(stderr, "kernel_launch: occupancy query gave %d blocks/CU on %d CUs\n", per_cu, cus); grid_blocks = -1; return; }
        grid_blocks = cus;
    }
    if (grid_blocks < 0) return;
    Params p{};
    for (int i = 0; i < 21; ++i) p.in[i] = (const float*)d_in[i];
    p.out = (float*)d_out; p.ws = (unsigned char*)d_ws;
    void* args[] = {&p};
    hipError_t e = hipLaunchCooperativeKernel((const void*)fwd_megakernel, dim3(grid_blocks), dim3(512), args, LDS_BYTES, stream);
    if (e != hipSuccess) fprintf(stderr, "cooperative launch failed: %s (grid %d)\n", hipGetErrorString(e), grid_blocks);
}
```

```cpp
#include <hip/hip_runtime.h>
#include <hip/hip_cooperative_groups.h>
#include <cstdio>
#include <cstdint>

#define LAS __attribute__((address_space(3)))
typedef unsigned short bf16_t;
typedef short bf16x8 __attribute__((ext_vector_type(8)));
typedef short s16x4 __attribute__((ext_vector_type(4)));
typedef float f32x4 __attribute__((ext_vector_type(4)));
typedef unsigned u32x4 __attribute__((ext_vector_type(4)));
typedef unsigned u32x2 __attribute__((ext_vector_type(2)));
typedef short v4i16_t __attribute__((ext_vector_type(4)));

namespace cfg {
constexpr int T = 32768, D = 2048, SEQ = 16384;
constexpr int NQKV = 4608, NGATE = 4096, NIN = 8704;
constexpr size_t MiB = 1ull << 20;
constexpr size_t WS_XB = 0, WS_QKV = 128 * MiB, WS_GATES = 416 * MiB, WS_O = 672 * MiB, WS_WIN = 800 * MiB, WS_WUP = 834 * MiB, WS_WOUT = 842 * MiB, WS_MISC = 850 * MiB;
constexpr size_t WS_WGU = 872 * MiB, WS_WD = 936 * MiB, WS_MG = WS_QKV, WS_HE = WS_QKV + 192 * MiB;
constexpr size_t WS_R1 = WS_MISC, WS_R2 = WS_R1 + (size_t)T * 4, WS_WRT = WS_R2 + (size_t)T * 4, WS_CNT = WS_WRT + 512 * 1024, WS_TOK = WS_CNT + 4096,
                 WS_RECC = WS_TOK + 32ull * T * 4, WS_RECW = WS_RECC + 2ull * T * 4, WS_R2L = WS_RECW + 2ull * T * 4, WS_END = WS_R2L + 32ull * T * 4;
constexpr size_t WS_H8 = WS_GATES + 144 * MiB;
constexpr size_t WS_YE = WS_QKV;
constexpr size_t WS_BAR = WS_END + 4096;
constexpr size_t WS_X8 = 872 * MiB;
constexpr size_t WS_O8 = WS_O + 64 * MiB;
constexpr size_t WS_TOP = 1000 * MiB;
constexpr int LDS_BYTES = 140 * 1024;
constexpr int XBST_OFF = LDS_BYTES - 16;
constexpr int TAB_OFF = 132 * 1024;
constexpr float EPS = 1e-6f;
}
using namespace cfg;

struct Params { const float* in[21]; float* out; unsigned char* ws; };
__device__ __forceinline__ int phase_tid() { int t = threadIdx.x; asm volatile("" : "+v"(t)); return t; }

__device__ __forceinline__ float bf2f(short s) { return __uint_as_float(((unsigned)(unsigned short)s) << 16); }
typedef float f32x2 __attribute__((ext_vector_type(2)));
typedef __bf16 bf16x2_t __attribute__((ext_vector_type(2)));
__device__ __forceinline__ unsigned pk2(float lo, float hi) { const f32x2 v = {lo, hi}; return __builtin_bit_cast(unsigned, __builtin_convertvector(v, bf16x2_t)); }
__device__ __forceinline__ unsigned pk4_fp8(float a, float b, float c, float d) { int w = 0; w = __builtin_amdgcn_cvt_pk_fp8_f32(a, b, w, false); w = __builtin_amdgcn_cvt_pk_fp8_f32(c, d, w, true); return (unsigned)w; }
__device__ __forceinline__ float wave_sum(float v) {
#pragma unroll
    for (int o = 1; o < 64; o <<= 1) v += __shfl_xor(v, o);
    return v;
}
__device__ __forceinline__ float sigmoidf_(float v) { return 1.0f / (1.0f + __expf(-v)); }
__device__ __forceinline__ unsigned off_b(unsigned row, unsigned ch) { return 256u * row + 16u * (ch ^ (((row & 3) << 2) | ((row >> 2) & 3))); }
__device__ __forceinline__ s16x4 tr_read(LAS unsigned char* p) { return __builtin_bit_cast(s16x4, __builtin_amdgcn_ds_read_tr16_b64_v4i16((LAS v4i16_t*)p)); }
__host__ __device__ __forceinline__ int perm32(int rho) { const int n = rho >> 4, i = rho & 15; return 8 * (i >> 2) + 4 * n + (i & 3); }
__device__ __forceinline__ int t5_bucket(int rel) {
    const int n = rel < 0 ? -rel : rel; const int ret = rel > 0 ? 16 : 0; int b;
    if (n < 8) b = n; else if (n < 12) b = 8; else if (n < 16) b = 9; else if (n < 23) b = 10; else if (n < 32) b = 11; else if (n < 46) b = 12; else if (n < 64) b = 13; else if (n < 91) b = 14; else b = 15;
    return ret + b;
}

template <bool FP8>
__device__ __forceinline__ void transpose_item(const float* __restrict__ W, int ldw, int k0, int n0, bf16_t* __restrict__ WT, int ldt, int drow0, int dk0, const float* __restrict__ scale, LAS unsigned* scr, int lane, float f8scale = 1.f) {
    const int n4 = (lane & 15) * 4, kk = lane >> 4;
    const float* src = W + (size_t)(k0 + 2 * kk) * ldw + n0 + n4;
    f32x4 ev[8], od[8];
#pragma unroll
    for (int j = 0; j < 8; ++j) { ev[j] = *(const f32x4*)(src + (size_t)(8 * j) * ldw); od[j] = *(const f32x4*)(src + (size_t)(8 * j + 1) * ldw); }
#pragma unroll
    for (int j = 0; j < 8; ++j) { f32x4 e = ev[j], o = od[j];
        if (scale) { const float se = scale[k0 + 8 * j + 2 * kk], so = scale[k0 + 8 * j + 2 * kk + 1]; e = e * se; o = o * so; }
        u32x4 w; w.x = pk2(e.x, o.x); w.y = pk2(e.y, o.y); w.z = pk2(e.z, o.z); w.w = pk2(e.w, o.w);
        *(LAS u32x4*)(scr + (4 * j + kk) * 68 + n4) = w; }
    asm volatile("s_waitcnt lgkmcnt(0)" ::: "memory");
    const int kq = lane & 7;
#pragma unroll
    for (int i = 0; i < 8; ++i) { const int n = (lane >> 3) + 8 * i; const LAS unsigned* q = scr + (4 * kq) * 68 + n;
        u32x4 o; o.x = q[0]; o.y = q[68]; o.z = q[136]; o.w = q[204];
        if (FP8) { u32x2 f; f.x = pk4_fp8(__uint_as_float(o.x << 16) * f8scale, __uint_as_float(o.x & 0xffff0000u) * f8scale, __uint_as_float(o.y << 16) * f8scale, __uint_as_float(o.y & 0xffff0000u) * f8scale);
            f.y = pk4_fp8(__uint_as_float(o.z << 16) * f8scale, __uint_as_float(o.z & 0xffff0000u) * f8scale, __uint_as_float(o.w << 16) * f8scale, __uint_as_float(o.w & 0xffff0000u) * f8scale);
            *(u32x2*)((unsigned char*)WT + (size_t)(drow0 + n) * ldt + dk0 + k0 + 8 * kq) = f; }
        else *(u32x4*)(WT + (size_t)(drow0 + n) * ldt + dk0 + k0 + 8 * kq) = o; }
    asm volatile("s_waitcnt lgkmcnt(0)" ::: "memory");
}

__device__ __forceinline__ void p0_prep(const Params& p, LAS unsigned char* lds) {
    const int tid = phase_tid(), lane = tid & 63, wave = tid >> 6;
    const int gw = blockIdx.x * 8 + wave, NGW = gridDim.x * 8;
    LAS unsigned* scr = (LAS unsigned*)(lds + wave * 8704);
    const float* x = p.in[0]; const float* g1 = p.in[1]; const float* w_in = p.in[2];
    bf16_t* xb = (bf16_t*)(p.ws + WS_XB); float* r1 = (float*)(p.ws + WS_R1);
    bf16_t* WinT = (bf16_t*)(p.ws + WS_WIN); bf16_t* WupT = (bf16_t*)(p.ws + WS_WUP); bf16_t* WoutT = (bf16_t*)(p.ws + WS_WOUT);
    constexpr int I_WIN = 32 * 136, I_UP = 16 * 32, I_OUT = 32 * 32, NITEMS = I_WIN + 2 * I_UP + I_OUT;
    for (int it = gw; it < NITEMS; it += NGW) {
        int r = it;
        if (r < I_WIN) { const int kb = r / 136, nb = r % 136; const int n0 = nb * 64;
            int drow = n0;
            if (n0 >= NQKV) { const int c = (n0 - NQKV) & 2047, isb = (n0 - NQKV) >> 11; drow = NQKV + (c >> 7) * 256 + isb * 128 + (c & 127); }
            transpose_item<true>(w_in, NIN, kb * 64, n0, WinT, 2048, drow, 0, g1, scr, lane, 64.f); continue; } r -= I_WIN;
        if (r < I_UP) { const int kb = r / 32, nb = r % 32; transpose_item<true>(p.in[9], 2048, kb * 64, nb * 64, WupT, 2048, nb * 64, 0, nullptr, scr, lane, 64.f); continue; } r -= I_UP;
        if (r < I_UP) { const int kb = r / 32, nb = r % 32; transpose_item<true>(p.in[10], 2048, kb * 64, nb * 64, WupT, 2048, nb * 64, 1024, nullptr, scr, lane, 64.f); continue; } r -= I_UP;
        { const int kb = r / 32, nb = r % 32; transpose_item<true>(p.in[11], 2048, kb * 64, nb * 64, WoutT, 2048, nb * 64, 0, nullptr, scr, lane, 64.f); }
    }
    { bf16_t* whi = (bf16_t*)(p.ws + WS_WRT); bf16_t* wlo = whi + 48 * 2048; const float* g2 = p.in[13]; const float* wrg = p.in[14]; const float* wre = p.in[16];
      for (int i = blockIdx.x * 512 + tid; i < 48 * 2048; i += gridDim.x * 512) { const int row = i >> 11, k = i & 2047, t = row >> 4, r = row & 15; float w;
          if (t == 0) w = wre[k * 32 + (r >> 2) * 8 + (r & 3)]; else if (t == 1) w = wre[k * 32 + (r >> 2) * 8 + 4 + (r & 3)]; else w = (r & 3) == 0 ? wrg[k * 4 + (r >> 2)] : 0.f;
          w *= g2[k]; const unsigned hi = pk2(w, 0.f) & 0xffffu; const float hf = __uint_as_float(hi << 16); whi[i] = (bf16_t)hi; wlo[i] = (bf16_t)(pk2(w - hf, 0.f) & 0xffffu); } }
    if (blockIdx.x == 0 && tid < 32) ((int*)(p.ws + WS_CNT))[tid] = 0;
    for (int row0 = 2 * gw; row0 < T; row0 += 2 * NGW) {
        f32x4 v[2][8]; float ss[2] = {0.f, 0.f};
#pragma unroll
        for (int u = 0; u < 2; ++u) { const f32x4* xr = (const f32x4*)(x + (size_t)(row0 + u) * D) + lane;
#pragma unroll
            for (int j = 0; j < 8; ++j) v[u][j] = xr[64 * j]; }
#pragma unroll
        for (int u = 0; u < 2; ++u) {
#pragma unroll
            for (int j = 0; j < 8; ++j) ss[u] += (v[u][j].x * v[u][j].x + v[u][j].y * v[u][j].y) + (v[u][j].z * v[u][j].z + v[u][j].w * v[u][j].w);
            ss[u] = wave_sum(ss[u]);
            if (lane == 0) r1[row0 + u] = rsqrtf(ss[u] * (1.0f / D) + EPS);
            u32x2* o = (u32x2*)(xb + (size_t)(row0 + u) * D) + lane; unsigned* o8 = (unsigned*)(p.ws + WS_X8 + (size_t)(row0 + u) * D) + lane;
#pragma unroll
            for (int j = 0; j < 8; ++j) { u32x2 w; w.x = pk2(v[u][j].x, v[u][j].y); w.y = pk2(v[u][j].z, v[u][j].w); o[64 * j] = w; o8[64 * j] = pk4_fp8(v[u][j].x, v[u][j].y, v[u][j].z, v[u][j].w); } }
    }
}

constexpr int MOE_ITEMS = 2 * 32 * 32 * 8 + 32 * 8 * 32;
__device__ __forceinline__ void moe_prep_batch(const Params& p, LAS unsigned char* lds, int bi) {
    const int tid = phase_tid(), lane = tid & 63, wave = tid >> 6;
    LAS unsigned* scr = (LAS unsigned*)(lds + wave * 8704);
    const float* g2 = p.in[13];
    bf16_t* WguT = (bf16_t*)(p.ws + WS_WGU); bf16_t* WdT = (bf16_t*)(p.ws + WS_WD);
    constexpr int I_G = 32 * 32 * 8;
    int r = (bi * (int)gridDim.x + (int)blockIdx.x) * 8 + wave;
    if (r >= MOE_ITEMS) return;
    if (r < 2 * I_G) { const int which = r >= I_G; if (which) r -= I_G; const int e = r / 256, rr = r % 256, kb = rr / 8, nb = rr % 8;
        const float* W = p.in[which ? 19 : 18] + (size_t)e * 2048 * 512; const int n0 = nb * 64;
        transpose_item<true>(W, 512, kb * 64, n0, WguT, 2048, e * 1024 + (n0 >> 7) * 256 + which * 128 + (n0 & 127), 0, g2, scr, lane, 64.f); return; }
    r -= 2 * I_G;
    { const int e = r / 256, rr = r % 256, kb = rr / 32, nb = rr % 32; const float* W = p.in[20] + (size_t)e * 512 * 2048;
      transpose_item<true>(W, 2048, kb * 64, nb * 64, WdT, 512, e * 2048 + nb * 64, 0, nullptr, scr, lane, 64.f); }
}

struct Unit { int pm, pn, aux; };
namespace pg8 {
constexpr int BM = 256, BK = 64, HALF = 128, HTB = HALF * BK * 2, STAGE_BYTES = 8 * HTB;
__device__ __forceinline__ int lds_byte(int r, int c) { const int st = (r >> 4) * 2 + (c >> 5), rr = r & 15, cc = c & 31, ob = rr * 64 + cc * 2; return st * 1024 + (ob ^ (((ob >> 9) & 1) << 5)); }
__device__ __forceinline__ void stage_rc(int b, int& R, int& C) { const int st = b / 1024, sb = b % 1024, swz = sb ^ (((sb >> 9) & 1) << 5); R = (st >> 1) * 16 + swz / 64; C = (st & 1) * 32 + (swz % 64) / 2; }

template <bool PERM, bool GATHER, class Sched, class Epi, bool FP8 = false, bool ALIGN_EPI = true>
__device__ __forceinline__ void gemm_phase(LAS unsigned char* lds, const Sched& S, const Epi& E, const int nt, const int lda, const int ldb) {
    int tid_ = threadIdx.x; asm volatile("" : "+v"(tid_));
    const int tid = tid_, wid = __builtin_amdgcn_readfirstlane(tid >> 6), lane = tid & 63, wr = wid >> 2, wc = wid & 3, fr = lane & 15, fq = lane >> 4;
    int R0, C0, R1, C1; stage_rc(tid * 16, R0, C0); stage_rc(tid * 16 + 8192, R1, C1);
    unsigned voffB[2], voffA[2][2];
    { const int Rb0 = PERM ? ((R0 & ~31) + perm32(R0 & 31)) : R0, Rb1 = PERM ? ((R1 & ~31) + perm32(R1 & 31)) : R1;
      voffB[0] = (unsigned)(Rb0 * ldb + C0) * 2u; voffB[1] = (unsigned)(Rb1 * ldb + C1) * 2u; }
    const size_t kstep = (size_t)(BK * 2);
    const size_t hstepB = (size_t)HALF * ldb * 2, hstepA = (size_t)HALF * lda * 2;
    const unsigned ldsw = (unsigned)wid * 1024u;
    const int aoff = lds_byte(wr * 64 + fr, fq * 8), boff = lds_byte(wc * 32 + fr, fq * 8);
#define PG8_SA(b, h) (((b) * 2 + (h)) * HTB)
#define PG8_SB(b, h) ((4 + (b) * 2 + (h)) * HTB)
#define PG8_STAGE_B(bufoff, gbase) do { _Pragma("unroll") for (int _i = 0; _i < 2; ++_i) \
        __builtin_amdgcn_global_load_lds((const unsigned*)((const char*)(gbase) + voffB[_i]), (LAS unsigned*)(lds + (bufoff) + ldsw + _i * 8192), 16, 0, 0); } while (0)
#define PG8_STAGE_A(bufoff, gbase, h) do { _Pragma("unroll") for (int _i = 0; _i < 2; ++_i) \
        __builtin_amdgcn_global_load_lds((const unsigned*)((const char*)(gbase) + (GATHER ? (size_t)0 : (size_t)(h) * hstepA) + voffA[GATHER ? (h) : 0][_i]), (LAS unsigned*)(lds + (bufoff) + ldsw + _i * 8192), 16, 0, 0); } while (0)
#define PG8_LDA(dst, b, h) do { _Pragma("unroll") for (int m = 0; m < 4; ++m) _Pragma("unroll") for (int k = 0; k < 2; ++k) dst[m][k] = *(const LAS bf16x8*)(lds + PG8_SA(b, h) + aoff + m * 2048 + k * 1024); } while (0)
#define PG8_LDB(dst, b, h) do { _Pragma("unroll") for (int n = 0; n < 2; ++n) _Pragma("unroll") for (int k = 0; k < 2; ++k) dst[n][k] = *(const LAS bf16x8*)(lds + PG8_SB(b, h) + boff + n * 2048 + k * 1024); } while (0)
#define PG8_MMA(ai, bj, At, Bt) do { __builtin_amdgcn_s_setprio(1); _Pragma("unroll") for (int m = 0; m < 4; ++m) _Pragma("unroll") for (int n = 0; n < 2; ++n) { \
        if (FP8) { typedef int v8i_ __attribute__((ext_vector_type(8))); typedef int v4i_ __attribute__((ext_vector_type(4))); \
            const v4i_ b0_ = __builtin_bit_cast(v4i_, Bt[n][0]), b1_ = __builtin_bit_cast(v4i_, Bt[n][1]), a0_ = __builtin_bit_cast(v4i_, At[m][0]), a1_ = __builtin_bit_cast(v4i_, At[m][1]); \
            const v8i_ bb_ = {b0_[0], b0_[1], b0_[2], b0_[3], b1_[0], b1_[1], b1_[2], b1_[3]}, aa_ = {a0_[0], a0_[1], a0_[2], a0_[3], a1_[0], a1_[1], a1_[2], a1_[3]}; \
            acc[ai][bj][m][n] = __builtin_amdgcn_mfma_scale_f32_16x16x128_f8f6f4(bb_, aa_, acc[ai][bj][m][n], 0, 0, 0, 0x7f7f7f7f, 0, 0x7f7f7f7f); } \
        else { _Pragma("unroll") for (int k = 0; k < 2; ++k) acc[ai][bj][m][n] = __builtin_amdgcn_mfma_f32_16x16x32_bf16(Bt[n][k], At[m][k], acc[ai][bj][m][n], 0, 0, 0); } } \
        __builtin_amdgcn_s_setprio(0); } while (0)
#define PG8_WAIT_V(n) asm volatile("s_waitcnt vmcnt(" #n ")" ::: "memory")
#define PG8_WAIT_L(n) asm volatile("s_waitcnt lgkmcnt(" #n ")" ::: "memory")
#define PG8_BAR __builtin_amdgcn_s_barrier()
#define PG8_SCHED __builtin_amdgcn_sched_barrier(0)
    Unit cur, nxt; int ui = 0;
    __syncthreads();
    if (!S.next(0, cur)) return;
    if (GATHER) S.a_offs(cur, R0, C0, R1, C1, voffA);
    else { voffA[0][0] = (unsigned)(R0 * lda + C0) * 2u; voffA[0][1] = (unsigned)(R1 * lda + C1) * 2u; voffA[1][0] = 0; voffA[1][1] = 0; }
    f32x4 acc[2][2][4][2];
#pragma unroll
    for (int a = 0; a < 2; ++a)
#pragma unroll
        for (int b = 0; b < 2; ++b)
#pragma unroll
            for (int m = 0; m < 4; ++m)
#pragma unroll
                for (int n = 0; n < 2; ++n) acc[a][b][m][n] = (f32x4){0.f, 0.f, 0.f, 0.f};
    bf16x8 At[4][2], B0[2][2], B1[2][2];
    const char* cA = S.a_base(cur); const char* cB = S.b_base(cur);
    PG8_STAGE_B(PG8_SB(0, 0), cB); PG8_STAGE_B(PG8_SB(0, 1), cB + hstepB); PG8_STAGE_A(PG8_SA(0, 0), cA, 0); PG8_STAGE_A(PG8_SA(0, 1), cA, 1);
    if (wr == 1) PG8_BAR;
    PG8_WAIT_V(2); PG8_BAR;
    PG8_STAGE_B(PG8_SB(1, 0), cB + kstep); PG8_STAGE_A(PG8_SA(1, 0), cA + kstep, 0); PG8_STAGE_B(PG8_SB(1, 1), cB + hstepB + kstep);
    PG8_WAIT_V(6); PG8_BAR;
    for (;;) {
        const bool has_next = S.next(ui + 1, nxt);
        const char* nA = has_next ? S.a_base(nxt) : cA; const char* nB = has_next ? S.b_base(nxt) : cB;
        unsigned vn[2][2];
        if (GATHER) { if (has_next) S.a_offs(nxt, R0, C0, R1, C1, vn); else { vn[0][0] = voffA[0][0]; vn[0][1] = voffA[0][1]; vn[1][0] = voffA[1][0]; vn[1][1] = voffA[1][1]; } }
        for (int t = 0; t < nt; t += 2) {
            const bool last = (t == nt - 2);
            const char* a1 = cA + (size_t)(t + 1) * kstep;
            const char* a2 = last ? nA : cA + (size_t)(t + 2) * kstep; const char* b2 = last ? nB : cB + (size_t)(t + 2) * kstep;
            const char* a3 = a2 + kstep; const char* b3 = b2 + kstep;
            PG8_LDB(B0, 0, 0); PG8_LDB(B1, 0, 1); PG8_SCHED; PG8_LDA(At, 0, 0); PG8_STAGE_A(PG8_SA(1, 1), a1, 1);
            if (GATHER) { if (last) { voffA[0][0] = vn[0][0]; voffA[0][1] = vn[0][1]; voffA[1][0] = vn[1][0]; voffA[1][1] = vn[1][1]; } }
            PG8_WAIT_V(8); PG8_WAIT_L(0); PG8_BAR; PG8_MMA(0, 0, At, B0); PG8_MMA(0, 1, At, B1); PG8_BAR; PG8_SCHED;
            PG8_LDA(At, 0, 1); PG8_STAGE_B(PG8_SB(0, 0), b2); PG8_STAGE_B(PG8_SB(0, 1), b2 + hstepB); PG8_STAGE_A(PG8_SA(0, 0), a2, 0);
            PG8_WAIT_V(8); PG8_WAIT_L(0); PG8_BAR; PG8_MMA(1, 0, At, B0); PG8_MMA(1, 1, At, B1); PG8_BAR; PG8_SCHED;
            PG8_LDB(B0, 1, 0); PG8_LDB(B1, 1, 1); PG8_SCHED; PG8_LDA(At, 1, 0); PG8_STAGE_A(PG8_SA(0, 1), a2, 1);
            PG8_WAIT_V(8); PG8_WAIT_L(0); PG8_BAR; PG8_MMA(0, 0, At, B0); PG8_MMA(0, 1, At, B1); PG8_BAR; PG8_SCHED;
            PG8_LDA(At, 1, 1); PG8_STAGE_B(PG8_SB(1, 0), b3); PG8_STAGE_B(PG8_SB(1, 1), b3 + hstepB); PG8_STAGE_A(PG8_SA(1, 0), a3, 0);
            PG8_WAIT_V(8); PG8_WAIT_L(0); PG8_BAR; PG8_MMA(1, 0, At, B0); PG8_MMA(1, 1, At, B1); PG8_BAR; PG8_SCHED;
        }
        if (ALIGN_EPI) { if (wr == 0) PG8_BAR; }
        { int te = threadIdx.x; asm volatile("" : "+v"(te)); E(acc, cur, wr, wc, te & 15, (te & 63) >> 4); }
        if (!has_next) break;
        if (!S.keep_acc(cur)) {
#pragma unroll
        for (int a = 0; a < 2; ++a)
#pragma unroll
            for (int b = 0; b < 2; ++b)
#pragma unroll
                for (int m = 0; m < 4; ++m)
#pragma unroll
                    for (int n = 0; n < 2; ++n) acc[a][b][m][n] = (f32x4){0.f, 0.f, 0.f, 0.f};
        }
        cur = nxt; cA = nA; cB = nB; ++ui;
        if (ALIGN_EPI) { if (wr == 1) PG8_BAR; }
    }
    PG8_WAIT_V(0);
    if (!ALIGN_EPI) { if (wr == 0) PG8_BAR; }
    PG8_BAR;
#undef PG8_SA
#undef PG8_SB
#undef PG8_STAGE_A
#undef PG8_STAGE_B
#undef PG8_LDA
#undef PG8_LDB
#undef PG8_MMA
#undef PG8_WAIT_V
#undef PG8_WAIT_L
#undef PG8_BAR
#undef PG8_SCHED
}
struct TileOrder {
    int nM, nN, nwg, G, c;
    __device__ __forceinline__ void init(int nM_, int nN_, int G_, int c_) { nM = nM_; nN = nN_; nwg = nM * nN; G = G_; c = c_; }
    __device__ __forceinline__ bool tile(int i, int& pm, int& pn) const {
        const long L = (long)i * G + c; if (L >= nwg) return false;
        int wgid = (int)L; { const int q = nwg / 8, r = nwg % 8, xcd = wgid % 8, off = wgid / 8; wgid = (xcd < r ? xcd * (q + 1) : r * (q + 1) + (xcd - r) * q) + off; }
        const int nig = 8 * nN, gid = wgid / nig, fm = gid * 8, gsz = (nM - fm) < 8 ? (nM - fm) : 8;
        pm = fm + ((wgid % nig) % gsz); pn = (wgid % nig) / gsz; return true;
    }
};
struct DenseSched {
    TileOrder o; const bf16_t* A; const bf16_t* Bt; int lda, ldb;
    __device__ __forceinline__ bool next(int i, Unit& u) const { u.aux = 0; return o.tile(i, u.pm, u.pn); }
    __device__ __forceinline__ const char* a_base(const Unit& u) const { return (const char*)(A + (size_t)u.pm * 256 * lda); }
    __device__ __forceinline__ const char* b_base(const Unit& u) const { return (const char*)(Bt + (size_t)u.pn * 256 * ldb); }
    __device__ __forceinline__ bool keep_acc(const Unit&) const { return false; }
    __device__ __forceinline__ void a_offs(const Unit&, int, int, int, int, unsigned (&)[2][2]) const {}
};
}

struct EpiInProj { bf16_t* qkv; const float* r1; const float* gqa; const float* gka; const float* gqb; const float* gkb; LAS float* X;
    __device__ __forceinline__ void operator()(f32x4 (&acc)[2][2][4][2], const Unit& u, int wr, int wc, int fr, int fq) const {
        const int pn = u.pn;
        bf16_t* base = qkv; const int ldc = NQKV; const int colt = pn * 256 + wc * 32 + 8 * fq;
        const float* gain = pn < 4 ? gqa : (pn == 4 ? gka : ((pn >= 6 && pn < 10) ? gqb : ((pn >= 10 && pn < 14) ? gkb : nullptr)));
        if (gain) {
            const float extra = (pn < 4 || (pn >= 6 && pn < 10)) ? 0.08838834764831845f * 1.4426950408889634f : 1.0f;
#pragma unroll
            for (int ai = 0; ai < 2; ++ai)
#pragma unroll
                for (int m = 0; m < 4; ++m)
#pragma unroll
                    for (int bj = 0; bj < 2; ++bj) { const f32x4 a0 = acc[ai][bj][m][0], a1 = acc[ai][bj][m][1];
                        float sq = (a0[0] * a0[0] + a0[1] * a0[1]) + (a0[2] * a0[2] + a0[3] * a0[3]) + (a1[0] * a1[0] + a1[1] * a1[1]) + (a1[2] * a1[2] + a1[3] * a1[3]);
                        sq += __shfl_xor(sq, 16); sq += __shfl_xor(sq, 32);
                        if (fq == 0) X[(ai * 128 + wr * 64 + m * 16 + fr) * 8 + bj * 4 + wc] = sq; }
            asm volatile("s_waitcnt lgkmcnt(0)" ::: "memory"); __builtin_amdgcn_s_barrier(); asm volatile("" ::: "memory");
            const f32x4 g0 = *(const f32x4*)(gain + wc * 32 + 8 * fq), g1 = *(const f32x4*)(gain + wc * 32 + 8 * fq + 4);
#pragma unroll
            for (int ai = 0; ai < 2; ++ai)
#pragma unroll
                for (int m = 0; m < 4; ++m) { const int rl = ai * 128 + wr * 64 + m * 16 + fr; const int row = u.pm * 256 + rl; const float rs = r1[row] * (1.0f / 64.0f); bf16_t* rowp = base + (size_t)row * ldc + colt;
#pragma unroll
                    for (int bj = 0; bj < 2; ++bj) { const f32x4 t = *(const LAS f32x4*)(X + rl * 8 + bj * 4); const float tot = (t[0] + t[1]) + (t[2] + t[3]);
                        const float sc = rs * rsqrtf(rs * rs * tot * (1.0f / 128.0f) + EPS) * extra;
                        const f32x4 v0 = acc[ai][bj][m][0] * sc * g0, v1 = acc[ai][bj][m][1] * sc * g1;
                        u32x4 w; w.x = pk2(v0[0], v0[1]); w.y = pk2(v0[2], v0[3]); w.z = pk2(v1[0], v1[1]); w.w = pk2(v1[2], v1[3]);
                        *(u32x4*)(rowp + bj * 128) = w; } }
            return;
        }
#pragma unroll
        for (int ai = 0; ai < 2; ++ai)
#pragma unroll
            for (int m = 0; m < 4; ++m) { const int row = u.pm * 256 + ai * 128 + wr * 64 + m * 16 + fr; const float rs = r1[row] * (1.0f / 64.0f); bf16_t* rowp = base + (size_t)row * ldc + colt;
#pragma unroll
                for (int bj = 0; bj < 2; ++bj) { const f32x4 v0 = acc[ai][bj][m][0] * rs, v1 = acc[ai][bj][m][1] * rs;
                    u32x4 w; w.x = pk2(v0[0], v0[1]); w.y = pk2(v0[2], v0[3]); w.z = pk2(v1[0], v1[1]); w.w = pk2(v1[2], v1[3]);
                    *(u32x4*)(rowp + bj * 128) = w; } }
    } };
struct GateSched { pg8::TileOrder o; const unsigned char* x8; const unsigned char* W8;
    __device__ __forceinline__ bool next(int i, Unit& u) const { u.aux = 0; return o.tile(i, u.pm, u.pn); }
    __device__ __forceinline__ const char* a_base(const Unit&) const { return (const char*)x8; }
    __device__ __forceinline__ const char* b_base(const Unit& u) const { return (const char*)(W8 + (size_t)(u.pn * 256) * D); }
    __device__ __forceinline__ bool keep_acc(const Unit&) const { return false; }
    __device__ __forceinline__ void a_offs(const Unit& u, int R0, int C0, int R1, int C1, unsigned (&v)[2][2]) const {
#pragma unroll
        for (int h = 0; h < 2; ++h) { v[h][0] = (unsigned)(u.pm * 256 + 128 * h + R0) * D + C0 * 2u; v[h][1] = (unsigned)(u.pm * 256 + 128 * h + R1) * D + C1 * 2u; } }
};
struct EpiGates { bf16_t* gates; const float* r1;
    __device__ __forceinline__ void operator()(f32x4 (&acc)[2][2][4][2], const Unit& u, int wr, int wc, int fr, int fq) const {
        const int cg = u.pn * 128 + wc * 32 + 8 * fq;
#pragma unroll
        for (int ai = 0; ai < 2; ++ai)
#pragma unroll
            for (int m = 0; m < 4; ++m) { const int row = u.pm * 256 + ai * 128 + wr * 64 + m * 16 + fr; const float rs = r1[row] * (1.0f / 64.0f); bf16_t* rowp = gates + (size_t)row * NGATE + cg;
                float ra[8], sb[8];
#pragma unroll
                for (int n = 0; n < 2; ++n)
#pragma unroll
                    for (int j = 0; j < 4; ++j) { const float ea = __expf(-acc[ai][0][m][n][j] * rs), eb = fminf(__expf(-acc[ai][1][m][n][j] * rs), 1e30f);
                        sb[4 * n + j] = __builtin_amdgcn_rcpf(1.0f + eb); ra[4 * n + j] = (1.0f + eb) * __builtin_amdgcn_rcpf(1.0f + ea); }
                u32x4 w; w.x = pk2(ra[0], ra[1]); w.y = pk2(ra[2], ra[3]); w.z = pk2(ra[4], ra[5]); w.w = pk2(ra[6], ra[7]); *(u32x4*)rowp = w;
                w.x = pk2(sb[0], sb[1]); w.y = pk2(sb[2], sb[3]); w.z = pk2(sb[4], sb[5]); w.w = pk2(sb[6], sb[7]); *(u32x4*)(rowp + 2048) = w; }
    } };
__device__ __forceinline__ void p1_inproj(const Params& p, LAS unsigned char* lds) {
    { GateSched S; S.o.init(128, 18, gridDim.x, blockIdx.x); S.x8 = p.ws + WS_X8; S.W8 = p.ws + WS_WIN;
      EpiInProj E{(bf16_t*)(p.ws + WS_QKV), (const float*)(p.ws + WS_R1), p.in[3], p.in[4], p.in[6], p.in[7], (LAS float*)(lds + 131072)};
      pg8::gemm_phase<true, true, GateSched, EpiInProj, true>(lds, S, E, D / 128, D / 2, D / 2); }
    { GateSched S; S.o.init(128, 16, gridDim.x, blockIdx.x); S.x8 = p.ws + WS_X8; S.W8 = p.ws + WS_WIN + (size_t)NQKV * D;
      EpiGates E{(bf16_t*)(p.ws + WS_GATES), (const float*)(p.ws + WS_R1)};
      pg8::gemm_phase<true, true, GateSched, EpiGates, true>(lds, S, E, D / 128, D / 2, D / 2); }
}

__device__ __forceinline__ void wait_vm(int n) {
    switch (n) { case 0: asm volatile("s_waitcnt vmcnt(0)" ::: "memory"); break; case 2: asm volatile("s_waitcnt vmcnt(2)" ::: "memory"); break; case 4: asm volatile("s_waitcnt vmcnt(4)" ::: "memory"); break;
                 case 6: asm volatile("s_waitcnt vmcnt(6)" ::: "memory"); break; case 8: asm volatile("s_waitcnt vmcnt(8)" ::: "memory"); break; case 10: asm volatile("s_waitcnt vmcnt(10)" ::: "memory"); break;
                 default: asm volatile("s_waitcnt vmcnt(12)" ::: "memory"); break; }
}
__device__ __forceinline__ void glds16_asm(const void* gsrc, unsigned lds_dst) {
    unsigned keep;
    asm volatile("s_mov_b32 %0, m0\n\ts_mov_b32 m0, %2\n\ts_nop 0\n\tglobal_load_lds_dwordx4 %1, off\n\ts_mov_b32 m0, %0" : "=&s"(keep) : "v"(gsrc), "s"(lds_dst) : "memory");
}
#define ATT_BAR() do { asm volatile("s_waitcnt lgkmcnt(0)" ::: "memory"); __builtin_amdgcn_s_barrier(); asm volatile("" ::: "memory"); } while (0)
__device__ __forceinline__ void load_q(const bf16_t* qp, int g, bf16x8 (&qf)[4]) {
#pragma unroll
    for (int ks = 0; ks < 4; ++ks) qf[ks] = *(const bf16x8*)(qp + 32 * ks + 8 * g);
#pragma unroll
    for (int ks = 0; ks < 4; ++ks) asm volatile("" : "+v"(qf[ks]));
}
__device__ __forceinline__ bf16x8 vt_frag(LAS unsigned char* base, int row0, int g, int q4, int pp, int dt) {
    const s16x4 lo = tr_read(base + off_b(row0 + 4 * g + q4, 2 * dt + (pp >> 1)) + 8 * (pp & 1)), hi = tr_read(base + off_b(row0 + 16 + 4 * g + q4, 2 * dt + (pp >> 1)) + 8 * (pp & 1));
    bf16x8 vf; vf[0] = lo[0]; vf[1] = lo[1]; vf[2] = lo[2]; vf[3] = lo[3]; vf[4] = hi[0]; vf[5] = hi[1]; vf[6] = hi[2]; vf[7] = hi[3]; return vf;
}

__device__ __forceinline__ void attn_window_item(const Params& p, LAS unsigned char* lds, int item, int& tab_head) {
    const int tid = phase_tid(), lane = tid & 63, w = __builtin_amdgcn_readfirstlane(tid >> 6), g = lane >> 4, ql = lane & 15;
    const int b = item >> 9, nb = (item >> 2) & 127, hpq = item & 3, kv = hpq >> 1, hq0 = 2 * hpq;
    const bf16_t* qkv = (const bf16_t*)(p.ws + WS_QKV); unsigned char* o = p.ws + WS_O8;
    LAS float* bias = (LAS float*)(lds + 131072); const unsigned ldsb = (unsigned)(size_t)lds;
    const unsigned loff = (unsigned)(w * 4 + g) * NQKV + (unsigned)((ql ^ ((g << 2) | (w & 3))) * 8);
    const bf16_t* kbase = qkv + (size_t)(b * SEQ) * NQKV + 1024 + kv * 128;
#define WIN_ISSUE(c) do { const int _c = (c); const int _kb = min(max(nb - 1 + (_c % 3), 0), 127); const bf16_t* _src = kbase + (size_t)(_kb * 128) * NQKV + (_c >= 3 ? 256 : 0) + loff; \
        _Pragma("unroll") for (int _i = 0; _i < 4; ++_i) glds16_asm(_src + (size_t)(32 * _i) * NQKV, ldsb + (unsigned)((_c & 3) * 32768 + _i * 8192 + w * 1024)); } while (0)
    ATT_BAR();
    WIN_ISSUE(0); WIN_ISSUE(1); WIN_ISSUE(2);
    if (hpq != tab_head) { for (int i = tid; i < 2 * 257; i += 512) { const int hh = i >= 257, j = i - 257 * hh; bias[hh * 264 + j] = p.in[12][t5_bucket(j - 128) * 8 + hq0 + hh] * 1.4426950408889634f; } tab_head = hpq; }
    const int tq = b * SEQ + nb * 128 + 16 * w + ql;
    bf16x8 qf[2][4]; load_q(qkv + (size_t)tq * NQKV + hq0 * 128, g, qf[0]); load_q(qkv + (size_t)tq * NQKV + (hq0 + 1) * 128, g, qf[1]);
    float sink[2]; sink[0] = p.in[5][hq0] * 1.4426950408889634f; sink[1] = p.in[5][hq0 + 1] * 1.4426950408889634f; asm volatile("" : "+v"(sink[0]), "+v"(sink[1]));
    f32x4 S1[2][8], SC[2][9];
#pragma unroll
    for (int u = 0; u < 2; ++u) {
#pragma unroll
        for (int kt = 0; kt < 8; ++kt) S1[u][kt] = (f32x4){0.f, 0.f, 0.f, 0.f};
#pragma unroll
        for (int s = 0; s < 9; ++s) SC[u][s] = (f32x4){0.f, 0.f, 0.f, 0.f}; }
    const bool in0 = nb > 0, in2 = nb < 127;
#pragma unroll
    for (int c = 0; c < 3; ++c) {
        wait_vm(8); ATT_BAR(); WIN_ISSUE(c + 3);
        LAS unsigned char* buf = lds + (c & 3) * 32768;
#pragma unroll
        for (int kt = 0; kt < 8; ++kt) {
            const bool act = (c == 1) || (c == 0 ? kt >= w : kt <= w);
            if (act) {
#pragma unroll
                for (int ks = 0; ks < 4; ++ks) { const bf16x8 kf = *(const LAS bf16x8*)(buf + off_b(16 * kt + ql, 4 * ks + g));
#pragma unroll
                    for (int u = 0; u < 2; ++u) {
                        if (c == 1) S1[u][kt] = __builtin_amdgcn_mfma_f32_16x16x32_bf16(kf, qf[u][ks], S1[u][kt], 0, 0, 0);
                        else if (c == 0) SC[u][7 - kt] = __builtin_amdgcn_mfma_f32_16x16x32_bf16(kf, qf[u][ks], SC[u][7 - kt], 0, 0, 0);
                        else SC[u][8 - kt] = __builtin_amdgcn_mfma_f32_16x16x32_bf16(kf, qf[u][ks], SC[u][8 - kt], 0, 0, 0); } } }
        }
    }
    const int qi = 16 * w + ql; float inv[2];
    unsigned P1[2][4][4], PC[2][9][2];
#pragma unroll
    for (int u = 0; u < 2; ++u) { float mx = sink[u]; const LAS float* bt = bias + u * 264;
#pragma unroll
        for (int kt = 0; kt < 8; ++kt)
#pragma unroll
            for (int r = 0; r < 4; ++r) { const int rel = 16 * kt + 4 * g + r - qi; const float sv = S1[u][kt][r] + bt[rel + 128]; S1[u][kt][r] = sv; mx = fmaxf(mx, sv); }
#pragma unroll
        for (int s = 0; s < 9; ++s) { const bool c0 = s <= 7 - w; const int kt = c0 ? 7 - s : 8 - s; const int cofs = c0 ? -128 : 128; const bool inr = c0 ? in0 : in2;
#pragma unroll
            for (int r = 0; r < 4; ++r) { const int rel = cofs + 16 * kt + 4 * g + r - qi; const bool valid = inr && rel >= -128 && rel <= 128;
                const float bv = bt[rel + 128];
                const float sv = valid ? SC[u][s][r] + bv : -1e30f; SC[u][s][r] = sv; mx = fmaxf(mx, sv); } }
        mx = fmaxf(mx, __shfl_xor(mx, 16)); mx = fmaxf(mx, __shfl_xor(mx, 32));
        float l = 0.f;
#pragma unroll
        for (int kk = 0; kk < 4; ++kk) { float e[8];
#pragma unroll
            for (int r = 0; r < 4; ++r) { e[r] = __builtin_amdgcn_exp2f(S1[u][2 * kk][r] - mx); e[4 + r] = __builtin_amdgcn_exp2f(S1[u][2 * kk + 1][r] - mx); l += e[r] + e[4 + r]; }
            P1[u][kk][0] = pk2(e[0], e[1]); P1[u][kk][1] = pk2(e[2], e[3]); P1[u][kk][2] = pk2(e[4], e[5]); P1[u][kk][3] = pk2(e[6], e[7]); }
#pragma unroll
        for (int s = 0; s < 9; ++s) { float e[4];
#pragma unroll
            for (int r = 0; r < 4; ++r) { e[r] = __builtin_amdgcn_exp2f(SC[u][s][r] - mx); l += e[r]; }
            PC[u][s][0] = pk2(e[0], e[1]); PC[u][s][1] = pk2(e[2], e[3]); }
        l += __shfl_xor(l, 16); l += __shfl_xor(l, 32); l += __builtin_amdgcn_exp2f(sink[u] - mx);
        inv[u] = 1.0f / l; }
    f32x4 O[2][8];
#pragma unroll
    for (int u = 0; u < 2; ++u)
#pragma unroll
        for (int dt = 0; dt < 8; ++dt) O[u][dt] = (f32x4){0.f, 0.f, 0.f, 0.f};
    const int q4 = ql >> 2, pp = ql & 3;
#pragma unroll
    for (int c = 0; c < 3; ++c) {
        wait_vm(c == 0 ? 8 : (c == 1 ? 4 : 0)); ATT_BAR();
        LAS unsigned char* buf = lds + ((c + 3) & 3) * 32768;
#pragma unroll
        for (int kk = 0; kk < 4; ++kk) {
            bool a0, a1;
            if (c == 1) { a0 = true; a1 = true; } else if (c == 0) { a0 = 2 * kk >= w; a1 = 2 * kk + 1 >= w; } else { a0 = 2 * kk <= w; a1 = 2 * kk + 1 <= w; }
            if (a0 || a1) { bf16x8 pf[2];
#pragma unroll
                for (int u = 0; u < 2; ++u) { u32x4 pw;
                    if (c == 1) { pw.x = P1[u][kk][0]; pw.y = P1[u][kk][1]; pw.z = P1[u][kk][2]; pw.w = P1[u][kk][3]; }
                    else if (c == 0) { pw.x = a0 ? PC[u][7 - 2 * kk][0] : 0u; pw.y = a0 ? PC[u][7 - 2 * kk][1] : 0u; pw.z = a1 ? PC[u][6 - 2 * kk][0] : 0u; pw.w = a1 ? PC[u][6 - 2 * kk][1] : 0u; }
                    else { pw.x = a0 ? PC[u][8 - 2 * kk][0] : 0u; pw.y = a0 ? PC[u][8 - 2 * kk][1] : 0u; pw.z = a1 ? PC[u][7 - 2 * kk][0] : 0u; pw.w = a1 ? PC[u][7 - 2 * kk][1] : 0u; }
                    pf[u] = __builtin_bit_cast(bf16x8, pw); }
#pragma unroll
                for (int dt = 0; dt < 8; ++dt) { const bf16x8 vf = vt_frag(buf, 32 * kk, g, q4, pp, dt);
                    O[0][dt] = __builtin_amdgcn_mfma_f32_16x16x32_bf16(vf, pf[0], O[0][dt], 0, 0, 0); O[1][dt] = __builtin_amdgcn_mfma_f32_16x16x32_bf16(vf, pf[1], O[1][dt], 0, 0, 0); } } }
    }
#undef WIN_ISSUE
#pragma unroll
    for (int u = 0; u < 2; ++u) { unsigned char* op = o + (size_t)tq * D + (hq0 + u) * 128 + 4 * g; const float sc = inv[u] * 16.f;
#pragma unroll
        for (int dt = 0; dt < 8; ++dt) *(unsigned*)(op + 16 * dt) = pk4_fp8(O[u][dt][0] * sc, O[u][dt][1] * sc, O[u][dt][2] * sc, O[u][dt][3] * sc); }
}

__device__ __forceinline__ void attn_nat_item(const Params& p, LAS unsigned char* lds, int item, int& tab_head) {
    const int tid = phase_tid(), lane = tid & 63, w = __builtin_amdgcn_readfirstlane(tid >> 6), g = lane >> 4, ql = lane & 15;
    const int b = item >> 9, rp = (item >> 2) & 127, hp = item & 3, hh = w >> 2, h = 2 * hp + hh, jq = w & 3;
    const int kr_lo = min(max(2 * rp - 4, 0), 248);
    const int d0 = min(max(2 * rp - 4, 0), 248) - kr_lo, d1 = min(max(2 * rp - 3, 0), 248) - kr_lo;
    const int w0 = jq == 0 ? 0 : (jq == 1 ? 8 : (jq == 2 ? 24 : 32));
    const bf16_t* qkv = (const bf16_t*)(p.ws + WS_QKV); unsigned char* o = p.ws + WS_O8;
    LAS float* rpb = (LAS float*)(lds + 131072); const unsigned ldsb = (unsigned)(size_t)lds;
    const unsigned loff = (unsigned)(w * 4 + g) * NQKV + (unsigned)((ql ^ ((g << 2) | (w & 3))) * 8);
    const bf16_t* kbase = qkv + (size_t)(b * SEQ) * NQKV + 2560 + 2 * hp * 128;
#define NAT_ISSUE(s) do { const int _s = (s); const int _kr = min(kr_lo + (_s % 9), 255); const bf16_t* _src = kbase + (size_t)(_kr * 64) * NQKV + (_s >= 9 ? 1024 : 0) + loff; \
        _Pragma("unroll") for (int _i = 0; _i < 4; ++_i) glds16_asm(_src + (size_t)(32 * (_i & 1)) * NQKV + 128 * (_i >> 1), ldsb + (unsigned)((_s & 3) * 32768 + _i * 8192 + w * 1024)); } while (0)
    ATT_BAR();
    NAT_ISSUE(0); NAT_ISSUE(1); NAT_ISSUE(2);
    if (hp != tab_head) { for (int i = tid; i < 930; i += 512) rpb[i] = p.in[8][2 * hp * 465 + i] * 1.4426950408889634f; tab_head = hp; }
    const int qcol = 16 * jq + ql; const int tq0 = b * SEQ + (2 * rp) * 64 + qcol;
    bf16x8 qf[2][4]; load_q(qkv + (size_t)tq0 * NQKV + 1536 + h * 128, g, qf[0]); load_q(qkv + (size_t)(tq0 + 64) * NQKV + 1536 + h * 128, g, qf[1]);
    f32x4 S[2][9][2];
#pragma unroll
    for (int u = 0; u < 2; ++u)
#pragma unroll
        for (int c = 0; c < 9; ++c) { S[u][c][0] = (f32x4){0.f, 0.f, 0.f, 0.f}; S[u][c][1] = (f32x4){0.f, 0.f, 0.f, 0.f}; }
#pragma unroll
    for (int c = 0; c < 9; ++c) {
        wait_vm(8); ATT_BAR(); NAT_ISSUE(c + 3);
        const bool a0 = c >= d0 && c < d0 + 8, a1 = c >= d1 && c < d1 + 8;
        LAS unsigned char* buf = lds + (c & 3) * 32768 + hh * 16384;
#pragma unroll
        for (int t = 0; t < 2; ++t)
#pragma unroll
            for (int ks = 0; ks < 4; ++ks) { const bf16x8 kf = *(const LAS bf16x8*)(buf + off_b(w0 + 16 * t + ql, 4 * ks + g));
                if (a0) S[0][c][t] = __builtin_amdgcn_mfma_f32_16x16x32_bf16(kf, qf[0][ks], S[0][c][t], 0, 0, 0);
                if (a1) S[1][c][t] = __builtin_amdgcn_mfma_f32_16x16x32_bf16(kf, qf[1][ks], S[1][c][t], 0, 0, 0); }
    }
    const int cs = min(max(qcol - 8, 0), 48); float inv[2];
    unsigned P[2][9][4];
    int dcv[2][4]; bool cv[2][4];
#pragma unroll
    for (int t = 0; t < 2; ++t)
#pragma unroll
        for (int q = 0; q < 4; ++q) { const int kc = w0 + 16 * t + 4 * g + q; cv[t][q] = kc >= cs && kc < cs + 16; dcv[t][q] = hh * 465 + kc - qcol + 15; }
#pragma unroll
    for (int u = 0; u < 2; ++u) { const int du = u ? d1 : d0; const int r = 2 * rp + u; float mx = -1e30f;
#pragma unroll
        for (int c = 0; c < 9; ++c) { const bool act = c >= du && c < du + 8;
            if (act) { const int rowb = (kr_lo + c - r + 7) * 31;
#pragma unroll
                for (int t = 0; t < 2; ++t)
#pragma unroll
                    for (int q = 0; q < 4; ++q) { const float sv = cv[t][q] ? S[u][c][t][q] + rpb[rowb + dcv[t][q]] : -1e30f; S[u][c][t][q] = sv; mx = fmaxf(mx, sv); } } }
        mx = fmaxf(mx, __shfl_xor(mx, 16)); mx = fmaxf(mx, __shfl_xor(mx, 32));
        float l = 0.f;
#pragma unroll
        for (int c = 0; c < 9; ++c) { const bool act = c >= du && c < du + 8;
            if (act) { float e[2][4];
#pragma unroll
                for (int t = 0; t < 2; ++t)
#pragma unroll
                    for (int q = 0; q < 4; ++q) { e[t][q] = __builtin_amdgcn_exp2f(S[u][c][t][q] - mx); l += e[t][q]; }
                P[u][c][0] = pk2(e[0][0], e[0][1]); P[u][c][1] = pk2(e[0][2], e[0][3]); P[u][c][2] = pk2(e[1][0], e[1][1]); P[u][c][3] = pk2(e[1][2], e[1][3]); }
            else { P[u][c][0] = 0u; P[u][c][1] = 0u; P[u][c][2] = 0u; P[u][c][3] = 0u; } }
        l += __shfl_xor(l, 16); l += __shfl_xor(l, 32);
        inv[u] = 1.0f / l; }
    f32x4 O[2][8];
#pragma unroll
    for (int u = 0; u < 2; ++u)
#pragma unroll
        for (int dt = 0; dt < 8; ++dt) O[u][dt] = (f32x4){0.f, 0.f, 0.f, 0.f};
    const int q4 = ql >> 2, pp = ql & 3;
#pragma unroll
    for (int c = 0; c < 9; ++c) {
        wait_vm(c <= 6 ? 8 : (c == 7 ? 4 : 0)); ATT_BAR(); if (c + 12 < 18) NAT_ISSUE(c + 12);
        const bool a0 = c >= d0 && c < d0 + 8, a1 = c >= d1 && c < d1 + 8;
        LAS unsigned char* buf = lds + ((c + 9) & 3) * 32768 + hh * 16384;
        u32x4 pw0; pw0.x = P[0][c][0]; pw0.y = P[0][c][1]; pw0.z = P[0][c][2]; pw0.w = P[0][c][3];
        u32x4 pw1; pw1.x = P[1][c][0]; pw1.y = P[1][c][1]; pw1.z = P[1][c][2]; pw1.w = P[1][c][3];
        const bf16x8 pf0 = __builtin_bit_cast(bf16x8, pw0), pf1 = __builtin_bit_cast(bf16x8, pw1);
#pragma unroll
        for (int dt = 0; dt < 8; ++dt) { const bf16x8 vf = vt_frag(buf, w0, g, q4, pp, dt);
            if (a0) O[0][dt] = __builtin_amdgcn_mfma_f32_16x16x32_bf16(vf, pf0, O[0][dt], 0, 0, 0);
            if (a1) O[1][dt] = __builtin_amdgcn_mfma_f32_16x16x32_bf16(vf, pf1, O[1][dt], 0, 0, 0); }
    }
#undef NAT_ISSUE
#pragma unroll
    for (int u = 0; u < 2; ++u) { unsigned char* op = o + (size_t)(tq0 + 64 * u) * D + 1024 + h * 128 + 4 * g; const float sc = inv[u] * 16.f;
#pragma unroll
        for (int dt = 0; dt < 8; ++dt) *(unsigned*)(op + 16 * dt) = pk4_fp8(O[u][dt][0] * sc, O[u][dt][1] * sc, O[u][dt][2] * sc, O[u][dt][3] * sc); }
}
__device__ __forceinline__ void p2_attn(const Params& p, LAS unsigned char* lds) {
    int tab_head = -1, mb = 0;
    const int nper = (1024 + (int)gridDim.x - 1) / (int)gridDim.x;
    const int NB = (MOE_ITEMS + 8 * (int)gridDim.x - 1) / (8 * (int)gridDim.x);
    for (int s = 0; s < 2 * nper || mb < NB; ++s) {
        if (s < 2 * nper) {
            const bool nat = s >= nper; const int it = (int)blockIdx.x + (nat ? s - nper : s) * (int)gridDim.x;
            if (s == nper) { tab_head = -1;
#ifdef PROBE_A
                if (blockIdx.x == 0 && threadIdx.x == 0) ((unsigned long long*)(p.ws + WS_END))[11] = __builtin_amdgcn_s_memrealtime();
#endif
            }
            if (it < 1024) { if (!nat) attn_window_item(p, lds, it, tab_head); else attn_nat_item(p, lds, it, tab_head); }
        }
        if ((((s + (int)blockIdx.x) & 1) == 0 || s >= 2 * nper) && mb < NB) {
            ATT_BAR();
            for (int q = 0; q < 3 && mb < NB; ++q) moe_prep_batch(p, lds, mb++);
        }
    }
    asm volatile("s_waitcnt vmcnt(0)" ::: "memory"); __syncthreads();
}

struct UpHook { const bf16_t* gates;
    __device__ __forceinline__ void operator()(f32x4 (&acc)[2][2][4][2], const Unit& u, int wr, int wc, int fr, int fq) const {
        const unsigned goff = (unsigned)(u.pm * 256 + wr * 64 + fr) * NGATE + u.pn * 256 + wc * 32 + 8 * fq;
#pragma unroll
        for (int ai = 0; ai < 2; ++ai) {
            bf16x8 ra[4][2];
#pragma unroll
            for (int m = 0; m < 4; ++m)
#pragma unroll
                for (int bj = 0; bj < 2; ++bj) ra[m][bj] = *(const bf16x8*)(gates + goff + (unsigned)((ai * 128 + m * 16) * NGATE) + bj * 128);
#pragma unroll
            for (int m = 0; m < 4; ++m)
#pragma unroll
                for (int bj = 0; bj < 2; ++bj)
#pragma unroll
                    for (int n = 0; n < 2; ++n)
#pragma unroll
                        for (int j = 0; j < 4; ++j) acc[ai][bj][m][n][j] *= bf2f(ra[m][bj][4 * n + j]);
            asm volatile("" ::: "memory"); }
    } };
struct UpSched {
    pg8::TileOrder o; const unsigned char* A; const unsigned char* Bt;
    __device__ __forceinline__ bool next(int i, Unit& u) const { u.aux = i & 1; return o.tile(i >> 1, u.pm, u.pn); }
    __device__ __forceinline__ const char* a_base(const Unit&) const { return (const char*)A; }
    __device__ __forceinline__ const char* b_base(const Unit& u) const { return (const char*)(Bt + (size_t)u.pn * 256 * D + u.aux * 1024); }
    __device__ __forceinline__ bool keep_acc(const Unit& u) const { return u.aux == 0; }
    __device__ __forceinline__ void a_offs(const Unit& u, int R0, int C0, int R1, int C1, unsigned (&v)[2][2]) const {
#pragma unroll
        for (int h = 0; h < 2; ++h) { v[h][0] = (unsigned)(u.pm * 256 + 128 * h + R0) * D + u.aux * 1024 + C0 * 2u; v[h][1] = (unsigned)(u.pm * 256 + 128 * h + R1) * D + u.aux * 1024 + C1 * 2u; } }
};
struct EpiUp { const bf16_t* gates; unsigned char* merged;
    __device__ __forceinline__ void operator()(f32x4 (&acc)[2][2][4][2], const Unit& u, int wr, int wc, int fr, int fq) const {
        if (u.aux == 0) { UpHook{gates}(acc, u, wr, wc, fr, fq); return; }
        const unsigned goff = (unsigned)(u.pm * 256 + wr * 64 + fr) * NGATE + 2048 + u.pn * 256 + wc * 32 + 8 * fq;
        const unsigned moff = (unsigned)(u.pm * 256 + wr * 64 + fr) * D + u.pn * 256 + wc * 32 + 8 * fq;
#pragma unroll
        for (int ai = 0; ai < 2; ++ai) {
            bf16x8 sb[4][2];
#pragma unroll
            for (int m = 0; m < 4; ++m)
#pragma unroll
                for (int bj = 0; bj < 2; ++bj) sb[m][bj] = *(const bf16x8*)(gates + goff + (unsigned)((ai * 128 + m * 16) * NGATE) + bj * 128);
#pragma unroll
            for (int m = 0; m < 4; ++m)
#pragma unroll
                for (int bj = 0; bj < 2; ++bj) { f32x4 v0 = acc[ai][bj][m][0], v1 = acc[ai][bj][m][1];
#pragma unroll
                    for (int j = 0; j < 4; ++j) { v0[j] *= bf2f(sb[m][bj][j]) * (1.0f / 64.0f); v1[j] *= bf2f(sb[m][bj][4 + j]) * (1.0f / 64.0f); }
                    u32x2 w; w.x = pk4_fp8(v0[0], v0[1], v0[2], v0[3]); w.y = pk4_fp8(v1[0], v1[1], v1[2], v1[3]);
                    *(u32x2*)(merged + moff + (unsigned)((ai * 128 + m * 16) * D) + bj * 128) = w; }
            asm volatile("" ::: "memory"); }
    } };
__device__ __forceinline__ void p3_up(const Params& p, LAS unsigned char* lds) {
    UpSched S; S.o.init(128, 8, gridDim.x, blockIdx.x); S.A = p.ws + WS_O8; S.Bt = p.ws + WS_WUP;
    EpiUp E{(const bf16_t*)(p.ws + WS_GATES), p.ws + WS_MG};
    int ntv = 1024 / 128; asm volatile("" : "+s"(ntv));
    pg8::gemm_phase<true, true, UpSched, EpiUp, true>(lds, S, E, ntv, D / 2, D / 2);
}

struct EpiOut { const bf16_t* xb; bf16_t* hb; unsigned char* h8;
    __device__ __forceinline__ void operator()(f32x4 (&acc)[2][2][4][2], const Unit& u, int wr, int wc, int fr, int fq) const {
        unsigned off = (unsigned)(u.pm * 256 + wr * 64 + fr) * D + u.pn * 256 + wc * 32 + 8 * fq;
#pragma unroll
        for (int ai = 0; ai < 2; ++ai) {
            bf16x8 xr[4][2];
#pragma unroll
            for (int m = 0; m < 4; ++m)
#pragma unroll
                for (int bj = 0; bj < 2; ++bj) xr[m][bj] = *(const bf16x8*)(xb + off + (unsigned)(m * 16 * D) + bj * 128);
#pragma unroll
            for (int m = 0; m < 4; ++m) { asm volatile("" : "+v"(off));
#pragma unroll
                for (int bj = 0; bj < 2; ++bj) { const f32x4 v0 = acc[ai][bj][m][0] * (1.0f / 1024.0f), v1 = acc[ai][bj][m][1] * (1.0f / 1024.0f); const u32x4 xw = __builtin_bit_cast(u32x4, xr[m][bj]);
                    const float h0 = v0[0] + __uint_as_float(xw.x << 16), h1 = v0[1] + __uint_as_float(xw.x & 0xffff0000u), h2 = v0[2] + __uint_as_float(xw.y << 16), h3 = v0[3] + __uint_as_float(xw.y & 0xffff0000u);
                    const float h4 = v1[0] + __uint_as_float(xw.z << 16), h5 = v1[1] + __uint_as_float(xw.z & 0xffff0000u), h6 = v1[2] + __uint_as_float(xw.w << 16), h7 = v1[3] + __uint_as_float(xw.w & 0xffff0000u);
                    u32x4 w; w.x = pk2(h0, h1); w.y = pk2(h2, h3); w.z = pk2(h4, h5); w.w = pk2(h6, h7);
                    *(u32x4*)(hb + off + bj * 128) = w;
                    u32x2 f; f.x = pk4_fp8(h0, h1, h2, h3); f.y = pk4_fp8(h4, h5, h6, h7);
                    *(u32x2*)(h8 + off + bj * 128) = f; }
                off += 16 * D; }
            off += 64 * D; }
    } };
__device__ __forceinline__ void p4_out(const Params& p, LAS unsigned char* lds) {
    GateSched S; S.o.init(128, 8, gridDim.x, blockIdx.x); S.x8 = p.ws + WS_MG; S.W8 = p.ws + WS_WOUT;
    EpiOut E{(const bf16_t*)(p.ws + WS_XB), (bf16_t*)(p.ws + WS_O), p.ws + WS_H8};
    pg8::gemm_phase<true, true, GateSched, EpiOut, true, false>(lds, S, E, D / 128, D / 2, D / 2);
}

__device__ __forceinline__ void p5_router(const Params& p, LAS unsigned char* lds) {
    const int tid = phase_tid(), lane = tid & 63, wave = __builtin_amdgcn_readfirstlane(tid >> 6), g = lane >> 4, tl = lane & 15;
    const bf16_t* wsp = (const bf16_t*)(p.ws + WS_WRT); float* r2 = (float*)(p.ws + WS_R2); int* cnt = (int*)(p.ws + WS_CNT); int* tokl = (int*)(p.ws + WS_TOK);
    int* recc = (int*)(p.ws + WS_RECC); float* recw = (float*)(p.ws + WS_RECW); const bf16_t* hb = (const bf16_t*)(p.ws + WS_O);
    const float* brg = p.in[15]; const float* bre = p.in[17];
    LAS unsigned char* H = lds + wave * 2304;
    LAS unsigned char* WL = lds + 36864;
    const int r8 = lane >> 3, s8 = lane & 7;
    const int pa0 = tid / 384, pr0 = (tid % 384) >> 3, ps0 = tid & 7, pi1 = 512 + tid, pa1 = pi1 / 384, pr1 = (pi1 % 384) >> 3;
    const unsigned wsrc0 = (unsigned)(pa0 * 48 * 2048 + pr0 * D + ps0 * 8), wsrc1 = (unsigned)(pa1 * 48 * 2048 + pr1 * D + ps0 * 8);
    const unsigned wdst0 = (unsigned)(pa0 * 6144 + pr0 * 128 + ((ps0 ^ (pr0 & 7)) << 4)), wdst1 = (unsigned)(pa1 * 6144 + pr1 * 128 + ((ps0 ^ (pr1 & 7)) << 4));
    for (int round = blockIdx.x; round < T / 128; round += gridDim.x) {
        const int tile = round * 8 + wave;
        const bf16_t* hs = hb + (size_t)tile * 16 * D + r8 * D + s8 * 8;
        f32x4 accA = {0.f, 0.f, 0.f, 0.f}, accB = accA, accC = accA; float ss = 0.f;
        u32x4 hq0[2], hq1[2], hq2[2], hq3[2], wr0, wr1;
#define RT_LOADS(bq, k) do { bq[0] = *(const u32x4*)(hs + 64 * (k)); bq[1] = *(const u32x4*)(hs + 8 * D + 64 * (k)); } while (0)
#define RT_COMP(bq, wbuf) do { \
            *(LAS u32x4*)(H + r8 * 144 + s8 * 16) = bq[0]; *(LAS u32x4*)(H + (r8 + 8) * 144 + s8 * 16) = bq[1]; \
            _Pragma("unroll") for (int ks = 0; ks < 2; ++ks) { const u32x4 hw = *(const LAS u32x4*)(H + tl * 144 + 64 * ks + 16 * g); \
                { const float a0 = __uint_as_float(hw.x << 16), a1 = __uint_as_float(hw.x & 0xffff0000u), a2 = __uint_as_float(hw.y << 16), a3 = __uint_as_float(hw.y & 0xffff0000u); \
                  const float a4 = __uint_as_float(hw.z << 16), a5 = __uint_as_float(hw.z & 0xffff0000u), a6 = __uint_as_float(hw.w << 16), a7 = __uint_as_float(hw.w & 0xffff0000u); \
                  ss += (a0 * a0 + a1 * a1) + (a2 * a2 + a3 * a3) + (a4 * a4 + a5 * a5) + (a6 * a6 + a7 * a7); } \
                const bf16x8 bh = __builtin_bit_cast(bf16x8, hw); const unsigned so_ = (unsigned)(((4 * ks + g) ^ (tl & 7)) << 4); \
                _Pragma("unroll") for (int t = 0; t < 3; ++t) { const bf16x8 ah = *(const LAS bf16x8*)((wbuf) + (16 * t + tl) * 128 + so_), al = *(const LAS bf16x8*)((wbuf) + 6144 + (16 * t + tl) * 128 + so_); \
                    f32x4& ac = (t == 0 ? accA : (t == 1 ? accB : accC)); \
                    ac = __builtin_amdgcn_mfma_f32_16x16x32_bf16(ah, bh, ac, 0, 0, 0); ac = __builtin_amdgcn_mfma_f32_16x16x32_bf16(al, bh, ac, 0, 0, 0); } } } while (0)
#define RT_WLOAD(c) do { wr0 = *(const u32x4*)(wsp + wsrc0 + 64 * (c)); if (tid < 256) wr1 = *(const u32x4*)(wsp + wsrc1 + 64 * (c)); } while (0)
#define RT_WSTORE(wbuf) do { *(LAS u32x4*)((wbuf) + wdst0) = wr0; if (tid < 256) *(LAS u32x4*)((wbuf) + wdst1) = wr1; } while (0)
        __syncthreads();
        RT_WLOAD(0); RT_LOADS(hq0, 0); RT_LOADS(hq1, 1); RT_LOADS(hq2, 2);
        RT_WSTORE(WL); RT_WLOAD(1);
        __syncthreads();
#pragma unroll 1
        for (int c = 0; c < D / 64; c += 4) {
            RT_LOADS(hq3, (c + 3));      RT_COMP(hq0, WL);         RT_WSTORE(WL + 12288); RT_WLOAD((c + 2) & 31); __syncthreads();
            RT_LOADS(hq0, (c + 4) & 31); RT_COMP(hq1, WL + 12288); RT_WSTORE(WL);         RT_WLOAD((c + 3) & 31); __syncthreads();
            RT_LOADS(hq1, (c + 5) & 31); RT_COMP(hq2, WL);         RT_WSTORE(WL + 12288); RT_WLOAD((c + 4) & 31); __syncthreads();
            RT_LOADS(hq2, (c + 6) & 31); RT_COMP(hq3, WL + 12288); RT_WSTORE(WL);         RT_WLOAD((c + 5) & 31); __syncthreads();
        }
#undef RT_LOADS
#undef RT_COMP
#undef RT_WLOAD
#undef RT_WSTORE
        const int tok = tile * 16 + tl;
        ss += __shfl_xor(ss, 16); ss += __shfl_xor(ss, 32);
        const float rr = rsqrtf(ss * (1.0f / D) + EPS);
        const float myg = accC[0] * rr + brg[g];
        float gl[4];
#pragma unroll
        for (int j = 0; j < 4; ++j) gl[j] = __shfl(myg, tl + 16 * j);
        int gi = 0; float gm = gl[0];
#pragma unroll
        for (int i = 1; i < 4; ++i) if (gl[i] > gm) { gm = gl[i]; gi = i; }
        float den = 0.f;
#pragma unroll
        for (int i = 0; i < 4; ++i) den += __expf(gl[i] - gm);
        const float pg = 1.0f / den;
        int L0 = 0, L1 = 0; float wt0 = 0.f, wt1 = 0.f; const bool owner = (g == gi);
        if (owner) {
            float el[8];
#pragma unroll
            for (int i = 0; i < 4; ++i) { el[i] = accA[i] * rr + bre[g * 8 + i]; el[4 + i] = accB[i] * rr + bre[g * 8 + 4 + i]; }
            int e0 = 0; float v0 = el[0];
#pragma unroll
            for (int i = 1; i < 8; ++i) if (el[i] > v0) { v0 = el[i]; e0 = i; }
            int e1 = -1; float v1 = -3.0e38f;
#pragma unroll
            for (int i = 0; i < 8; ++i) if (i != e0 && el[i] > v1) { v1 = el[i]; e1 = i; }
            const float ex = __expf(v1 - v0); const float s0 = 1.0f / (1.0f + ex), s1 = ex * s0;
            r2[tok] = rr; L0 = gi * 8 + e0; L1 = gi * 8 + e1; wt0 = pg * s0; wt1 = pg * s1;
        }
        LAS int* cl = (LAS int*)(lds + 61440);
        if (tid < 32) cl[tid] = 0;
        __syncthreads();
        int q0 = 0, q1 = 0;
        if (owner) { q0 = __hip_atomic_fetch_add(&cl[L0], 1, __ATOMIC_RELAXED, __HIP_MEMORY_SCOPE_WORKGROUP); q1 = __hip_atomic_fetch_add(&cl[L1], 1, __ATOMIC_RELAXED, __HIP_MEMORY_SCOPE_WORKGROUP); }
        __syncthreads();
        if (tid < 32) { const int n = cl[tid]; cl[32 + tid] = n ? atomicAdd(&cnt[tid], n) : 0; }
        __syncthreads();
        if (owner) { const int p0 = cl[32 + L0] + q0, p1 = cl[32 + L1] + q1;
            float* r2l = (float*)(p.ws + WS_R2L);
            tokl[(size_t)L0 * T + p0] = tok; r2l[(size_t)L0 * T + p0] = rr; recc[2 * tok] = L0 * 32768 + p0; recw[2 * tok] = wt0;
            tokl[(size_t)L1 * T + p1] = tok; r2l[(size_t)L1 * T + p1] = rr; recc[2 * tok + 1] = L1 * 32768 + p1; recw[2 * tok + 1] = wt1; }
    }
    __syncthreads();
}

__device__ __forceinline__ void build_tiles(const Params& p, LAS int* tab) {
    __syncthreads();
    if (threadIdx.x < 64) { const int L = threadIdx.x; const int c = L < 32 ? ((const int*)(p.ws + WS_CNT))[L] : 0; const int nt = (c + 255) >> 8;
        int pre = nt;
#pragma unroll
        for (int o = 1; o < 32; o <<= 1) { const int v = __shfl_up(pre, o); if (L >= o) pre += v; }
        const int first = pre - nt;
        if (L < 32) { tab[1400 + L] = first * 256; for (int i = 0; i < nt; ++i) { tab[4 + (first + i) * 4 + 0] = L; tab[4 + (first + i) * 4 + 1] = i * 256; tab[4 + (first + i) * 4 + 2] = (first + i) * 256; tab[4 + (first + i) * 4 + 3] = min(256, c - i * 256); } }
        if (L == 31) tab[0] = pre; }
    __syncthreads();
}
template <int NPN> struct MoeOrder { int G, c, t_lo, nt_tiles; const LAS int* tab;
    __device__ __forceinline__ bool unit(int i, Unit& u) const { const long L = (long)i * G + c; if (L >= (long)nt_tiles * NPN) return false;
        const int nwg = nt_tiles * NPN; int wgid = (int)L; { const int q = nwg / 8, r = nwg % 8, xcd = wgid % 8, off = wgid / 8; wgid = (xcd < r ? xcd * (q + 1) : r * (q + 1) + (xcd - r) * q) + off; }
        u.pm = t_lo + wgid / NPN; u.pn = wgid % NPN; u.aux = 0; return true; } };
struct GateUpSched { MoeOrder<4> o; const unsigned char* hb; const unsigned char* WguT; const int* tokl;
    __device__ __forceinline__ bool next(int i, Unit& u) const { return o.unit(i, u); }
    __device__ __forceinline__ const char* a_base(const Unit&) const { return (const char*)hb; }
    __device__ __forceinline__ const char* b_base(const Unit& u) const { const int e = o.tab[4 + u.pm * 4] & 31; return (const char*)(WguT + (size_t)(e * 1024 + u.pn * 256) * D); }
    __device__ __forceinline__ bool keep_acc(const Unit&) const { return false; }
    __device__ __forceinline__ void a_offs(const Unit& u, int R0, int C0, int R1, int C1, unsigned (&v)[2][2]) const {
        const int L = o.tab[4 + u.pm * 4], row0 = o.tab[4 + u.pm * 4 + 1], nrows = o.tab[4 + u.pm * 4 + 3]; const int* lst = tokl + (size_t)L * T + row0;
#pragma unroll
        for (int h = 0; h < 2; ++h) { const int r0 = R0 + 128 * h, r1 = R1 + 128 * h; const int t0 = r0 < nrows ? lst[r0] : 0, t1 = r1 < nrows ? lst[r1] : 0;
            v[h][0] = (unsigned)t0 * D + C0 * 2u; v[h][1] = (unsigned)t1 * D + C1 * 2u; } }
};
struct EpiGateUp { const LAS int* tab; const float* r2l; unsigned char* he;
    __device__ __forceinline__ void operator()(f32x4 (&acc)[2][2][4][2], const Unit& u, int wr, int wc, int fr, int fq) const {
        const int L = tab[4 + u.pm * 4], row0 = tab[4 + u.pm * 4 + 1], slot = tab[4 + u.pm * 4 + 2], nrows = tab[4 + u.pm * 4 + 3];
#pragma unroll
        for (int ai = 0; ai < 2; ++ai)
#pragma unroll
            for (int m = 0; m < 4; ++m) { const int rr = ai * 128 + wr * 64 + m * 16 + fr; const float rs = rr < nrows ? r2l[(size_t)L * T + row0 + rr] * (1.0f / 64.0f) : 0.f;
                u32x2 w; unsigned ww[2];
#pragma unroll
                for (int n = 0; n < 2; ++n) { float hv[4];
#pragma unroll
                    for (int j = 0; j < 4; ++j) { const float gt = acc[ai][0][m][n][j] * rs, up = acc[ai][1][m][n][j] * rs; hv[j] = gt * sigmoidf_(gt) * up * 4.0f; }
                    ww[n] = pk4_fp8(hv[0], hv[1], hv[2], hv[3]); }
                w.x = ww[0]; w.y = ww[1];
                *(u32x2*)(he + (size_t)(slot + rr) * 512 + u.pn * 128 + wc * 32 + 8 * fq) = w; }
    } };
__device__ __forceinline__ void p6_gateup(const Params& p, LAS unsigned char* lds) {
    LAS int* tab = (LAS int*)(lds + TAB_OFF); build_tiles(p, tab);
    GateUpSched S; S.o.G = gridDim.x; S.o.c = blockIdx.x; S.o.t_lo = 0; S.o.nt_tiles = tab[0]; S.o.tab = tab;
    S.hb = p.ws + WS_H8; S.WguT = p.ws + WS_WGU; S.tokl = (const int*)(p.ws + WS_TOK);
    EpiGateUp E{tab, (const float*)(p.ws + WS_R2L), p.ws + WS_HE};
    pg8::gemm_phase<true, true, GateUpSched, EpiGateUp, true>(lds, S, E, D / 128, D / 2, D / 2);
}
struct DownSched { MoeOrder<8> o; const unsigned char* he; const unsigned char* WdT;
    __device__ __forceinline__ bool next(int i, Unit& u) const { return o.unit(i, u); }
    __device__ __forceinline__ const char* a_base(const Unit&) const { return (const char*)he; }
    __device__ __forceinline__ const char* b_base(const Unit& u) const { const int e = o.tab[4 + u.pm * 4] & 31; return (const char*)(WdT + (size_t)(e * 2048 + u.pn * 256) * 512); }
    __device__ __forceinline__ bool keep_acc(const Unit&) const { return false; }
    __device__ __forceinline__ void a_offs(const Unit& u, int R0, int C0, int R1, int C1, unsigned (&v)[2][2]) const {
        const int slot = o.tab[4 + u.pm * 4 + 2];
#pragma unroll
        for (int h = 0; h < 2; ++h) { v[h][0] = (unsigned)(slot + 128 * h + R0) * 512u + C0 * 2u; v[h][1] = (unsigned)(slot + 128 * h + R1) * 512u + C1 * 2u; } }
};
struct EpiDown { const LAS int* tab; unsigned char* ye;
    __device__ __forceinline__ void operator()(f32x4 (&acc)[2][2][4][2], const Unit& u, int wr, int wc, int fr, int fq) const {
        const int slot = tab[4 + u.pm * 4 + 2];
        unsigned off = (unsigned)(slot + wr * 64 + fr) * 2048 + u.pn * 256 + wc * 32 + 8 * fq;
#pragma unroll
        for (int ai = 0; ai < 2; ++ai) {
#pragma unroll
            for (int m = 0; m < 4; ++m) { asm volatile("" : "+v"(off));
#pragma unroll
                for (int bj = 0; bj < 2; ++bj) { const f32x4 v0 = acc[ai][bj][m][0] * 0.0625f, v1 = acc[ai][bj][m][1] * 0.0625f;
                    u32x2 w; w.x = pk4_fp8(v0[0], v0[1], v0[2], v0[3]); w.y = pk4_fp8(v1[0], v1[1], v1[2], v1[3]);
                    *(u32x2*)(ye + off + bj * 128) = w; }
                off += 16 * 2048; }
            off += 64 * 2048; }
    } };
__device__ __forceinline__ void p7_down(const Params& p, LAS unsigned char* lds) {
    LAS int* tab = (LAS int*)(lds + TAB_OFF); build_tiles(p, tab);
    DownSched S; S.o.G = gridDim.x; S.o.c = blockIdx.x; S.o.t_lo = 0; S.o.nt_tiles = tab[0]; S.o.tab = tab;
    S.he = p.ws + WS_HE; S.WdT = p.ws + WS_WD;
    EpiDown E{tab, p.ws + WS_YE};
    int ntv = 512 / 128; asm volatile("" : "+s"(ntv));
    pg8::gemm_phase<true, true, DownSched, EpiDown, true, false>(lds, S, E, ntv, 256, 256);
}
__device__ __forceinline__ void p8_combine(const Params& p, LAS unsigned char* lds) {
    LAS int* tab = (LAS int*)(lds + TAB_OFF); build_tiles(p, tab);
    const int tid = phase_tid(), lane = tid & 63, wave = tid >> 6; const int gw = blockIdx.x * 8 + wave, NGW = gridDim.x * 8;
    const int* recc = (const int*)(p.ws + WS_RECC); const float* recw = (const float*)(p.ws + WS_RECW); const bf16_t* hb = (const bf16_t*)(p.ws + WS_O);
    const unsigned char* ye = p.ws + WS_YE;
    for (int tok = gw; tok < T; tok += NGW) {
        const int c0 = recc[2 * tok], c1 = recc[2 * tok + 1]; const float wa = recw[2 * tok] * 0.0625f, wb = recw[2 * tok + 1] * 0.0625f;
        const int s0 = tab[1400 + (c0 >> 15)] + (c0 & 32767), s1 = tab[1400 + (c1 >> 15)] + (c1 & 32767);
        f32x4* op = (f32x4*)(p.out + (size_t)tok * D) + lane; const u32x2* hp = (const u32x2*)(hb + (size_t)tok * D) + lane;
        const unsigned* ya = (const unsigned*)(ye + (size_t)s0 * 2048) + lane; const unsigned* yb = (const unsigned*)(ye + (size_t)s1 * 2048) + lane;
        u32x2 m[8]; unsigned a[8], b[8];
#pragma unroll
        for (int j = 0; j < 8; ++j) { m[j] = hp[64 * j]; a[j] = ya[64 * j]; b[j] = yb[64 * j]; }
#pragma unroll
        for (int j = 0; j < 8; ++j) { f32x4 v;
            const f32x2 a0 = __builtin_amdgcn_cvt_pk_f32_fp8(a[j], false), a1 = __builtin_amdgcn_cvt_pk_f32_fp8(a[j], true), b0 = __builtin_amdgcn_cvt_pk_f32_fp8(b[j], false), b1 = __builtin_amdgcn_cvt_pk_f32_fp8(b[j], true);
            v.x = __uint_as_float(m[j].x << 16) + wa * a0.x + wb * b0.x; v.y = __uint_as_float(m[j].x & 0xffff0000u) + wa * a0.y + wb * b0.y;
            v.z = __uint_as_float(m[j].y << 16) + wa * a1.x + wb * b1.x; v.w = __uint_as_float(m[j].y & 0xffff0000u) + wa * a1.y + wb * b1.y;
            op[64 * j] = v; }
    }
}

#define XB_TMO      128
#define XB_XCNT(j)  (256  + 64 * (j))
#define XB_XSUB(j)  (1280 + 64 * (j))
#define XB_XGEN(j)  (2304 + 64 * (j))
#define XB_TOP      3328
#define XB_TOPGEN   3392
#define XCD_BAR_WORDS 3456
#define XB_SPIN_CAP (1u << 18)
__device__ __forceinline__ unsigned xb_ld(unsigned* p)              { return __hip_atomic_load(p, __ATOMIC_RELAXED, __HIP_MEMORY_SCOPE_AGENT); }
__device__ __forceinline__ unsigned xb_add(unsigned* p, unsigned v) { return __hip_atomic_fetch_add(p, v, __ATOMIC_RELAXED, __HIP_MEMORY_SCOPE_AGENT); }
__device__ __forceinline__ unsigned xb_xcc_id() { return (unsigned)__builtin_amdgcn_s_getreg((3 << 11) | 20) & 0xFu; }
#define XB_SPIN(cond, bar) do { unsigned _sp = 0; while (cond) { __builtin_amdgcn_s_sleep(1); \
    if ((++_sp & 255u) == 0u) { if (xb_ld(&(bar)[XB_TMO])) break; if (_sp > XB_SPIN_CAP) { atomicAdd(&(bar)[XB_TMO], 1u); break; } } } } while (0)
struct XcdBarrier { unsigned* bar; unsigned x; volatile LAS unsigned* st; };
__device__ __forceinline__ XcdBarrier xcd_barrier_post(unsigned* bar, volatile LAS unsigned* st) {
    XcdBarrier b; b.bar = bar; b.x = xb_xcc_id(); b.st = st;
    if (threadIdx.x == 0) (void)xb_add(&bar[XB_XCNT(b.x)], 1u);
    return b;
}
__device__ __forceinline__ void xcd_barrier_complete(unsigned* bar, unsigned x, unsigned& nloc, unsigned& nx) {
    const unsigned G = gridDim.x * gridDim.y * gridDim.z;
    unsigned sum, cnt, mine, sp = 0u;
    for (;;) {
        sum = 0u; cnt = 0u; mine = 0u;
#pragma unroll
        for (unsigned j = 0; j < 16; ++j) { const unsigned c = xb_ld(&bar[XB_XCNT(j)]); sum += c; cnt += (c > 0u) ? 1u : 0u; mine = (j == x) ? c : mine; }
        if (sum == G) break;
        __builtin_amdgcn_s_sleep(1);
        if ((++sp & 255u) == 0u) { if (xb_ld(&bar[XB_TMO])) break; if (sp > XB_SPIN_CAP) { atomicAdd(&bar[XB_TMO], 1u); break; } }
    }
    nloc = mine > 0u ? mine : 1u; nx = cnt > 0u ? cnt : 1u;
}
__device__ __forceinline__ void xcd_barrier(const XcdBarrier& b) {
    asm volatile("s_waitcnt vmcnt(0)" ::: "memory");
    __syncthreads();
    if (threadIdx.x == 0) {
        unsigned* bar = b.bar;
        __builtin_amdgcn_s_waitcnt(0);
        unsigned nloc = b.st[0], nx = b.st[1];
        if (nloc == 0u) { xcd_barrier_complete(bar, b.x, nloc, nx); b.st[0] = nloc; b.st[1] = nx; }
        const unsigned old = xb_add(&bar[XB_XSUB(b.x)], 1u);
        const unsigned gen = old / nloc;
        if (old + 1u == (gen + 1u) * nloc) {
            __builtin_amdgcn_fence(__ATOMIC_RELEASE, "agent");
            asm volatile("s_waitcnt vmcnt(0)" ::: "memory");
            const unsigned og = xb_add(&bar[XB_TOP], 1u);
            const unsigned tg = og / nx;
            if (og + 1u == (tg + 1u) * nx) xb_add(&bar[XB_TOPGEN], 1u);
            else XB_SPIN(xb_ld(&bar[XB_TOPGEN]) == tg, bar);
            __builtin_amdgcn_fence(__ATOMIC_ACQUIRE, "agent");
            xb_add(&bar[XB_XGEN(b.x)], 1u);
            asm volatile("s_waitcnt vmcnt(0)" ::: "memory");
        } else {
            XB_SPIN(xb_ld(&bar[XB_XGEN(b.x)]) == gen, bar);
            __builtin_amdgcn_fence(__ATOMIC_ACQUIRE, "agent");
            asm volatile("s_waitcnt vmcnt(0)" ::: "memory");
        }
    }
    __syncthreads();
}

namespace cg = cooperative_groups;
#ifdef PROBE_A
#define STAMP(k) do { if (blockIdx.x == 0 && threadIdx.x == 0) ((unsigned long long*)(p.ws + WS_END))[k] = __builtin_amdgcn_s_memrealtime(); } while (0)
#else
#define STAMP(k) do {} while (0)
#endif
__global__ void __launch_bounds__(512, 2) fwd_megakernel(Params p) {
    extern __shared__ __attribute__((aligned(16))) unsigned char lds_raw[];
    LAS unsigned char* lds = (LAS unsigned char*)lds_raw;
    cg::grid_group grid = cg::this_grid();
    if (threadIdx.x == 0) { *(volatile LAS unsigned*)(lds + XBST_OFF) = 0u; *(volatile LAS unsigned*)(lds + XBST_OFF + 4) = 0u; }
    if (blockIdx.x == 0) for (int i = threadIdx.x; i < XCD_BAR_WORDS; i += 512) ((unsigned*)(p.ws + WS_BAR))[i] = 0u;
    __syncthreads();
#define GSYNC() xcd_barrier(xb)
    STAMP(0);
    p0_prep(p, lds);            grid.sync(); STAMP(1);
    const XcdBarrier xb = xcd_barrier_post((unsigned*)(p.ws + WS_BAR), (volatile LAS unsigned*)(lds + XBST_OFF));
    p1_inproj(p, lds);          GSYNC(); STAMP(2);
    p2_attn(p, lds);            GSYNC(); STAMP(3);
    STAMP(4);
    p3_up(p, lds);              GSYNC(); STAMP(5);
    p4_out(p, lds);             GSYNC(); STAMP(6);
    p5_router(p, lds);          GSYNC(); STAMP(7);
    p6_gateup(p, lds);          GSYNC(); STAMP(8);
    p7_down(p, lds);            GSYNC(); STAMP(9);
    p8_combine(p, lds);
#ifdef PROBE_A
    grid.sync(); STAMP(10); grid.sync();
    {
        const unsigned long long* ts = (const unsigned long long*)(p.ws + WS_END);
        #ifndef PROBE_A1
#define PROBE_A1 (PROBE_A + 1)
#endif
#ifndef PROBE_B1
#define PROBE_B1 (PROBE_B + 1)
#endif
        const float usA = (float)(ts[PROBE_A1] - ts[PROBE_A]) * 0.01f, usB = (float)(ts[PROBE_B1] - ts[PROBE_B]) * 0.01f;
        const float eps = sqrtf(usA * 1e-6f);
        for (size_t i = (size_t)blockIdx.x * 512 + threadIdx.x; i < (size_t)T * D / 4; i += (size_t)gridDim.x * 512) { f32x4 v = ((f32x4*)p.out)[i]; v = v * (1.0f + eps); if (i == 0) v.x += usB * 0.1f; ((f32x4*)p.out)[i] = v; }
    }
#endif
}

extern "C" void kernel_launch(void* const* d_in, const int* in_sizes, int n_in, void* d_out, int out_size, void* d_ws, size_t ws_size, hipStream_t stream) {
    static int grid_blocks = 0;
    if (!grid_blocks) {
        if (n_in != 21 || out_size != T * D || ws_size < WS_TOP) { fprintf(stderr, "kernel_launch: unexpected problem (n_in %d out %d ws %zu)\n", n_in, out_size, ws_size); grid_blocks = -1; return; }
        if (hipFuncSetAttribute((const void*)fwd_megakernel, hipFuncAttributeMaxDynamicSharedMemorySize, LDS_BYTES) != hipSuccess) { fprintf(stderr, "kernel_launch: hipFuncSetAttribute failed\n"); grid_blocks = -1; return; }
        int dev = 0, cus = 0, per_cu = 0;
        hipGetDevice(&dev); hipDeviceGetAttribute(&cus, hipDeviceAttributeMultiprocessorCount, dev);
        hipOccupancyMaxActiveBlocksPerMultiprocessor(&per_cu, (const void*)fwd_megakernel, 512, LDS_BYTES);
        if (per_cu < 1 || cus < 1) { fprintf(stderr, "kernel_launch: occupancy query gave %d blocks/CU on %d CUs\n", per_cu, cus); grid_blocks = -1; return; }
        grid_blocks = cus;
    }
    if (grid_blocks < 0) return;
    Params p{};
    for (int i = 0; i < 21; ++i) p.in[i] = (const float*)d_in[i];
    p.out = (float*)d_out; p.ws = (unsigned char*)d_ws;
    void* args[] = {&p};
    hipError_t e = hipLaunchCooperativeKernel((const void*)fwd_megakernel, dim3(grid_blocks), dim3(512), args, LDS_BYTES, stream);
    if (e != hipSuccess) fprintf(stderr, "cooperative launch failed: %s (grid %d)\n", hipGetErrorString(e), grid_blocks);
}
```

```cpp
#include <hip/hip_runtime.h>
#include <hip/hip_cooperative_groups.h>
#include <cstdio>
#include <cstdint>

#define LAS __attribute__((address_space(3)))
typedef unsigned short bf16_t;
typedef short bf16x8 __attribute__((ext_vector_type(8)));
typedef short s16x4 __attribute__((ext_vector_type(4)));
typedef float f32x4 __attribute__((ext_vector_type(4)));
typedef unsigned u32x4 __attribute__((ext_vector_type(4)));
typedef unsigned u32x2 __attribute__((ext_vector_type(2)));
typedef short v4i16_t __attribute__((ext_vector_type(4)));

namespace cfg {
constexpr int T = 32768, D = 2048, SEQ = 16384;
constexpr int NQKV = 4608, NGATE = 4096, NIN = 8704;
constexpr size_t MiB = 1ull << 20;
constexpr size_t WS_XB = 0, WS_QKV = 128 * MiB, WS_GATES = 416 * MiB, WS_O = 672 * MiB, WS_WIN = 800 * MiB, WS_WUP = 834 * MiB, WS_WOUT = 842 * MiB, WS_MISC = 850 * MiB;
constexpr size_t WS_WGU = 872 * MiB, WS_WD = 936 * MiB, WS_MG = WS_QKV, WS_HE = WS_QKV + 192 * MiB;
constexpr size_t WS_R1 = WS_MISC, WS_R2 = WS_R1 + (size_t)T * 4, WS_WRT = WS_R2 + (size_t)T * 4, WS_CNT = WS_WRT + 512 * 1024, WS_TOK = WS_CNT + 4096,
                 WS_RECC = WS_TOK + 32ull * T * 4, WS_RECW = WS_RECC + 2ull * T * 4, WS_R2L = WS_RECW + 2ull * T * 4, WS_END = WS_R2L + 32ull * T * 4;
constexpr size_t WS_H8 = WS_GATES + 144 * MiB;
constexpr size_t WS_YE = WS_QKV;
constexpr size_t WS_BAR = WS_END + 4096;
constexpr size_t WS_X8 = 872 * MiB;
constexpr size_t WS_O8 = WS_O + 64 * MiB;
constexpr size_t WS_TOP = 1000 * MiB;
constexpr int LDS_BYTES = 140 * 1024;
constexpr int XBST_OFF = LDS_BYTES - 16;
constexpr int TAB_OFF = 132 * 1024;
constexpr float EPS = 1e-6f;
}
using namespace cfg;

struct Params { const float* in[21]; float* out; unsigned char* ws; };
__device__ __forceinline__ int phase_tid() { int t = threadIdx.x; asm volatile("" : "+v"(t)); return t; }

__device__ __forceinline__ float bf2f(short s) { return __uint_as_float(((unsigned)(unsigned short)s) << 16); }
typedef float f32x2 __attribute__((ext_vector_type(2)));
typedef __bf16 bf16x2_t __attribute__((ext_vector_type(2)));
__device__ __forceinline__ unsigned pk2(float lo, float hi) { const f32x2 v = {lo, hi}; return __builtin_bit_cast(unsigned, __builtin_convertvector(v, bf16x2_t)); }
__device__ __forceinline__ unsigned pk4_fp8(float a, float b, float c, float d) { int w = 0; w = __builtin_amdgcn_cvt_pk_fp8_f32(a, b, w, false); w = __builtin_amdgcn_cvt_pk_fp8_f32(c, d, w, true); return (unsigned)w; }
__device__ __forceinline__ float wave_sum(float v) {
#pragma unroll
    for (int o = 1; o < 64; o <<= 1) v += __shfl_xor(v, o);
    return v;
}
__device__ __forceinline__ float sigmoidf_(float v) { return 1.0f / (1.0f + __expf(-v)); }
__device__ __forceinline__ unsigned off_b(unsigned row, unsigned ch) { return 256u * row + 16u * (ch ^ (((row & 3) << 2) | ((row >> 2) & 3))); }
__device__ __forceinline__ s16x4 tr_read(LAS unsigned char* p) { return __builtin_bit_cast(s16x4, __builtin_amdgcn_ds_read_tr16_b64_v4i16((LAS v4i16_t*)p)); }
__host__ __device__ __forceinline__ int perm32(int rho) { const int n = rho >> 4, i = rho & 15; return 8 * (i >> 2) + 4 * n + (i & 3); }
__device__ __forceinline__ int t5_bucket(int rel) {
    const int n = rel < 0 ? -rel : rel; const int ret = rel > 0 ? 16 : 0; int b;
    if (n < 8) b = n; else if (n < 12) b = 8; else if (n < 16) b = 9; else if (n < 23) b = 10; else if (n < 32) b = 11; else if (n < 46) b = 12; else if (n < 64) b = 13; else if (n < 91) b = 14; else b = 15;
    return ret + b;
}

template <bool FP8>
__device__ __forceinline__ void transpose_item(const float* __restrict__ W, int ldw, int k0, int n0, bf16_t* __restrict__ WT, int ldt, int drow0, int dk0, const float* __restrict__ scale, LAS unsigned* scr, int lane, float f8scale = 1.f) {
    const int n4 = (lane & 15) * 4, kk = lane >> 4;
    const float* src = W + (size_t)(k0 + 2 * kk) * ldw + n0 + n4;
    f32x4 ev[8], od[8];
#pragma unroll
    for (int j = 0; j < 8; ++j) { ev[j] = *(const f32x4*)(src + (size_t)(8 * j) * ldw); od[j] = *(const f32x4*)(src + (size_t)(8 * j + 1) * ldw); }
#pragma unroll
    for (int j = 0; j < 8; ++j) { f32x4 e = ev[j], o = od[j];
        if (scale) { const float se = scale[k0 + 8 * j + 2 * kk], so = scale[k0 + 8 * j + 2 * kk + 1]; e = e * se; o = o * so; }
        u32x4 w; w.x = pk2(e.x, o.x); w.y = pk2(e.y, o.y); w.z = pk2(e.z, o.z); w.w = pk2(e.w, o.w);
        *(LAS u32x4*)(scr + (4 * j + kk) * 68 + n4) = w; }
    asm volatile("s_waitcnt lgkmcnt(0)" ::: "memory");
    const int kq = lane & 7;
#pragma unroll
    for (int i = 0; i < 8; ++i) { const int n = (lane >> 3) + 8 * i; const LAS unsigned* q = scr + (4 * kq) * 68 + n;
        u32x4 o; o.x = q[0]; o.y = q[68]; o.z = q[136]; o.w = q[204];
        if (FP8) { u32x2 f; f.x = pk4_fp8(__uint_as_float(o.x << 16) * f8scale, __uint_as_float(o.x & 0xffff0000u) * f8scale, __uint_as_float(o.y << 16) * f8scale, __uint_as_float(o.y & 0xffff0000u) * f8scale);
            f.y = pk4_fp8(__uint_as_float(o.z << 16) * f8scale, __uint_as_float(o.z & 0xffff0000u) * f8scale, __uint_as_float(o.w << 16) * f8scale, __uint_as_float(o.w & 0xffff0000u) * f8scale);
            *(u32x2*)((unsigned char*)WT + (size_t)(drow0 + n) * ldt + dk0 + k0 + 8 * kq) = f; }
        else *(u32x4*)(WT + (size_t)(drow0 + n) * ldt + dk0 + k0 + 8 * kq) = o; }
    asm volatile("s_waitcnt lgkmcnt(0)" ::: "memory");
}

__device__ __forceinline__ void p0_prep(const Params& p, LAS unsigned char* lds) {
    const int tid = phase_tid(), lane = tid & 63, wave = tid >> 6;
    const int gw = blockIdx.x * 8 + wave, NGW = gridDim.x * 8;
    LAS unsigned* scr = (LAS unsigned*)(lds + wave * 8704);
    const float* x = p.in[0]; const float* g1 = p.in[1]; const float* w_in = p.in[2];
    bf16_t* xb = (bf16_t*)(p.ws + WS_XB); float* r1 = (float*)(p.ws + WS_R1);
    bf16_t* WinT = (bf16_t*)(p.ws + WS_WIN); bf16_t* WupT = (bf16_t*)(p.ws + WS_WUP); bf16_t* WoutT = (bf16_t*)(p.ws + WS_WOUT);
    constexpr int I_WIN = 32 * 136, I_UP = 16 * 32, I_OUT = 32 * 32, NITEMS = I_WIN + 2 * I_UP + I_OUT;
    for (int it = gw; it < NITEMS; it += NGW) {
        int r = it;
        if (r < I_WIN) { const int kb = r / 136, nb = r % 136; const int n0 = nb * 64;
            int drow = n0;
            if (n0 >= NQKV) { const int c = (n0 - NQKV) & 2047, isb = (n0 - NQKV) >> 11; drow = NQKV + (c >> 7) * 256 + isb * 128 + (c & 127); }
            transpose_item<true>(w_in, NIN, kb * 64, n0, WinT, 2048, drow, 0, g1, scr, lane, 64.f); continue; } r -= I_WIN;
        if (r < I_UP) { const int kb = r / 32, nb = r % 32; transpose_item<true>(p.in[9], 2048, kb * 64, nb * 64, WupT, 2048, nb * 64, 0, nullptr, scr, lane, 64.f); continue; } r -= I_UP;
        if (r < I_UP) { const int kb = r / 32, nb = r % 32; transpose_item<true>(p.in[10], 2048, kb * 64, nb * 64, WupT, 2048, nb * 64, 1024, nullptr, scr, lane, 64.f); continue; } r -= I_UP;
        { const int kb = r / 32, nb = r % 32; transpose_item<true>(p.in[11], 2048, kb * 64, nb * 64, WoutT, 2048, nb * 64, 0, nullptr, scr, lane, 64.f); }
    }
    { bf16_t* whi = (bf16_t*)(p.ws + WS_WRT); bf16_t* wlo = whi + 48 * 2048; const float* g2 = p.in[13]; const float* wrg = p.in[14]; const float* wre = p.in[16];
      for (int i = blockIdx.x * 512 + tid; i < 48 * 2048; i += gridDim.x * 512) { const int row = i >> 11, k = i & 2047, t = row >> 4, r = row & 15; float w;
          if (t == 0) w = wre[k * 32 + (r >> 2) * 8 + (r & 3)]; else if (t == 1) w = wre[k * 32 + (r >> 2) * 8 + 4 + (r & 3)]; else w = (r & 3) == 0 ? wrg[k * 4 + (r >> 2)] : 0.f;
          w *= g2[k]; const unsigned hi = pk2(w, 0.f) & 0xffffu; const float hf = __uint_as_float(hi << 16); whi[i] = (bf16_t)hi; wlo[i] = (bf16_t)(pk2(w - hf, 0.f) & 0xffffu); } }
    if (blockIdx.x == 0 && tid < 32) ((int*)(p.ws + WS_CNT))[tid] = 0;
    for (int row0 = 2 * gw; row0 < T; row0 += 2 * NGW) {
        f32x4 v[2][8]; float ss[2] = {0.f, 0.f};
#pragma unroll
        for (int u = 0; u < 2; ++u) { const f32x4* xr = (const f32x4*)(x + (size_t)(row0 + u) * D) + lane;
#pragma unroll
            for (int j = 0; j < 8; ++j) v[u][j] = xr[64 * j]; }
#pragma unroll
        for (int u = 0; u < 2; ++u) {
#pragma unroll
            for (int j = 0; j < 8; ++j) ss[u] += (v[u][j].x * v[u][j].x + v[u][j].y * v[u][j].y) + (v[u][j].z * v[u][j].z + v[u][j].w * v[u][j].w);
            ss[u] = wave_sum(ss[u]);
            if (lane == 0) r1[row0 + u] = rsqrtf(ss[u] * (1.0f / D) + EPS);
            u32x2* o = (u32x2*)(xb + (size_t)(row0 + u) * D) + lane; unsigned* o8 = (unsigned*)(p.ws + WS_X8 + (size_t)(row0 + u) * D) + lane;
#pragma unroll
            for (int j = 0; j < 8; ++j) { u32x2 w; w.x = pk2(v[u][j].x, v[u][j].y); w.y = pk2(v[u][j].z, v[u][j].w); o[64 * j] = w; o8[64 * j] = pk4_fp8(v[u][j].x, v[u][j].y, v[u][j].z, v[u][j].w); } }
    }
}

constexpr int MOE_ITEMS = 2 * 32 * 32 * 8 + 32 * 8 * 32;
__device__ __forceinline__ void moe_prep_batch(const Params& p, LAS unsigned char* lds, int bi) {
    const int tid = phase_tid(), lane = tid & 63, wave = tid >> 6;
    LAS unsigned* scr = (LAS unsigned*)(lds + wave * 8704);
    const float* g2 = p.in[13];
    bf16_t* WguT = (bf16_t*)(p.ws + WS_WGU); bf16_t* WdT = (bf16_t*)(p.ws + WS_WD);
    constexpr int I_G = 32 * 32 * 8;
    int r = (bi * (int)gridDim.x + (int)blockIdx.x) * 8 + wave;
    if (r >= MOE_ITEMS) return;
    if (r < 2 * I_G) { const int which = r >= I_G; if (which) r -= I_G; const int e = r / 256, rr = r % 256, kb = rr / 8, nb = rr % 8;
        const float* W = p.in[which ? 19 : 18] + (size_t)e * 2048 * 512; const int n0 = nb * 64;
        transpose_item<true>(W, 512, kb * 64, n0, WguT, 2048, e * 1024 + (n0 >> 7) * 256 + which * 128 + (n0 & 127), 0, g2, scr, lane, 64.f); return; }
    r -= 2 * I_G;
    { const int e = r / 256, rr = r % 256, kb = rr / 32, nb = rr % 32; const float* W = p.in[20] + (size_t)e * 512 * 2048;
      transpose_item<true>(W, 2048, kb * 64, nb * 64, WdT, 512, e * 2048 + nb * 64, 0, nullptr, scr, lane, 64.f); }
}

struct Unit { int pm, pn, aux; };
namespace pg8 {
constexpr int BM = 256, BK = 64, HALF = 128, HTB = HALF * BK * 2, STAGE_BYTES = 8 * HTB;
__device__ __forceinline__ int lds_byte(int r, int c) { const int st = (r >> 4) * 2 + (c >> 5), rr = r & 15, cc = c & 31, ob = rr * 64 + cc * 2; return st * 1024 + (ob ^ (((ob >> 9) & 1) << 5)); }
__device__ __forceinline__ void stage_rc(int b, int& R, int& C) { const int st = b / 1024, sb = b % 1024, swz = sb ^ (((sb >> 9) & 1) << 5); R = (st >> 1) * 16 + swz / 64; C = (st & 1) * 32 + (swz % 64) / 2; }

template <bool PERM, bool GATHER, class Sched, class Epi, bool FP8 = false, bool ALIGN_EPI = true>
__device__ __forceinline__ void gemm_phase(LAS unsigned char* lds, const Sched& S, const Epi& E, const int nt, const int lda, const int ldb) {
    int tid_ = threadIdx.x; asm volatile("" : "+v"(tid_));
    const int tid = tid_, wid = __builtin_amdgcn_readfirstlane(tid >> 6), lane = tid & 63, wr = wid >> 2, wc = wid & 3, fr = lane & 15, fq = lane >> 4;
    int R0, C0, R1, C1; stage_rc(tid * 16, R0, C0); stage_rc(tid * 16 + 8192, R1, C1);
    unsigned voffB[2], voffA[2][2];
    { const int Rb0 = PERM ? ((R0 & ~31) + perm32(R0 & 31)) : R0, Rb1 = PERM ? ((R1 & ~31) + perm32(R1 & 31)) : R1;
      voffB[0] = (unsigned)(Rb0 * ldb + C0) * 2u; voffB[1] = (unsigned)(Rb1 * ldb + C1) * 2u; }
    const size_t kstep = (size_t)(BK * 2);
    const size_t hstepB = (size_t)HALF * ldb * 2, hstepA = (size_t)HALF * lda * 2;
    const unsigned ldsw = (unsigned)wid * 1024u;
    const int aoff = lds_byte(wr * 64 + fr, fq * 8), boff = lds_byte(wc * 32 + fr, fq * 8);
#define PG8_SA(b, h) (((b) * 2 + (h)) * HTB)
#define PG8_SB(b, h) ((4 + (b) * 2 + (h)) * HTB)
#define PG8_STAGE_B(bufoff, gbase) do { _Pragma("unroll") for (int _i = 0; _i < 2; ++_i) \
        __builtin_amdgcn_global_load_lds((const unsigned*)((const char*)(gbase) + voffB[_i]), (LAS unsigned*)(lds + (bufoff) + ldsw + _i * 8192), 16, 0, 0); } while (0)
#define PG8_STAGE_A(bufoff, gbase, h) do { _Pragma("unroll") for (int _i = 0; _i < 2; ++_i) \
        __builtin_amdgcn_global_load_lds((const unsigned*)((const char*)(gbase) + (GATHER ? (size_t)0 : (size_t)(h) * hstepA) + voffA[GATHER ? (h) : 0][_i]), (LAS unsigned*)(lds + (bufoff) + ldsw + _i * 8192), 16, 0, 0); } while (0)
#define PG8_LDA(dst, b, h) do { _Pragma("unroll") for (int m = 0; m < 4; ++m) _Pragma("unroll") for (int k = 0; k < 2; ++k) dst[m][k] = *(const LAS bf16x8*)(lds + PG8_SA(b, h) + aoff + m * 2048 + k * 1024); } while (0)
#define PG8_LDB(dst, b, h) do { _Pragma("unroll") for (int n = 0; n < 2; ++n) _Pragma("unroll") for (int k = 0; k < 2; ++k) dst[n][k] = *(const LAS bf16x8*)(lds + PG8_SB(b, h) + boff + n * 2048 + k * 1024); } while (0)
#define PG8_MMA(ai, bj, At, Bt) do { __builtin_amdgcn_s_setprio(1); _Pragma("unroll") for (int m = 0; m < 4; ++m) _Pragma("unroll") for (int n = 0; n < 2; ++n) { \
        if (FP8) { typedef int v8i_ __attribute__((ext_vector_type(8))); typedef int v4i_ __attribute__((ext_vector_type(4))); \
            const v4i_ b0_ = __builtin_bit_cast(v4i_, Bt[n][0]), b1_ = __builtin_bit_cast(v4i_, Bt[n][1]), a0_ = __builtin_bit_cast(v4i_, At[m][0]), a1_ = __builtin_bit_cast(v4i_, At[m][1]); \
            const v8i_ bb_ = {b0_[0], b0_[1], b0_[2], b0_[3], b1_[0], b1_[1], b1_[2], b1_[3]}, aa_ = {a0_[0], a0_[1], a0_[2], a0_[3], a1_[0], a1_[1], a1_[2], a1_[3]}; \
            acc[ai][bj][m][n] = __builtin_amdgcn_mfma_scale_f32_16x16x128_f8f6f4(bb_, aa_, acc[ai][bj][m][n], 0, 0, 0, 0x7f7f7f7f, 0, 0x7f7f7f7f); } \
        else { _Pragma("unroll") for (int k = 0; k < 2; ++k) acc[ai][bj][m][n] = __builtin_amdgcn_mfma_f32_16x16x32_bf16(Bt[n][k], At[m][k], acc[ai][bj][m][n], 0, 0, 0); } } \
        __builtin_amdgcn_s_setprio(0); } while (0)
#define PG8_WAIT_V(n) asm volatile("s_waitcnt vmcnt(" #n ")" ::: "memory")
#define PG8_WAIT_L(n) asm volatile("s_waitcnt lgkmcnt(" #n ")" ::: "memory")
#define PG8_BAR __builtin_amdgcn_s_barrier()
#define PG8_SCHED __builtin_amdgcn_sched_barrier(0)
    Unit cur, nxt; int ui = 0;
    __syncthreads();
    if (!S.next(0, cur)) return;
    if (GATHER) S.a_offs(cur, R0, C0, R1, C1, voffA);
    else { voffA[0][0] = (unsigned)(R0 * lda + C0) * 2u; voffA[0][1] = (unsigned)(R1 * lda + C1) * 2u; voffA[1][0] = 0; voffA[1][1] = 0; }
    f32x4 acc[2][2][4][2];
#pragma unroll
    for (int a = 0; a < 2; ++a)
#pragma unroll
        for (int b = 0; b < 2; ++b)
#pragma unroll
            for (int m = 0; m < 4; ++m)
#pragma unroll
                for (int n = 0; n < 2; ++n) acc[a][b][m][n] = (f32x4){0.f, 0.f, 0.f, 0.f};
    bf16x8 At[4][2], B0[2][2], B1[2][2];
    const char* cA = S.a_base(cur); const char* cB = S.b_base(cur);
    PG8_STAGE_B(PG8_SB(0, 0), cB); PG8_STAGE_B(PG8_SB(0, 1), cB + hstepB); PG8_STAGE_A(PG8_SA(0, 0), cA, 0); PG8_STAGE_A(PG8_SA(0, 1), cA, 1);
    if (wr == 1) PG8_BAR;
    PG8_WAIT_V(2); PG8_BAR;
    PG8_STAGE_B(PG8_SB(1, 0), cB + kstep); PG8_STAGE_A(PG8_SA(1, 0), cA + kstep, 0); PG8_STAGE_B(PG8_SB(1, 1), cB + hstepB + kstep);
    PG8_WAIT_V(6); PG8_BAR;
    for (;;) {
        const bool has_next = S.next(ui + 1, nxt);
        const char* nA = has_next ? S.a_base(nxt) : cA; const char* nB = has_next ? S.b_base(nxt) : cB;
        unsigned vn[2][2];
        if (GATHER) { if (has_next) S.a_offs(nxt, R0, C0, R1, C1, vn); else { vn[0][0] = voffA[0][0]; vn[0][1] = voffA[0][1]; vn[1][0] = voffA[1][0]; vn[1][1] = voffA[1][1]; } }
        for (int t = 0; t < nt; t += 2) {
            const bool last = (t == nt - 2);
            const char* a1 = cA + (size_t)(t + 1) * kstep;
            const char* a2 = last ? nA : cA + (size_t)(t + 2) * kstep; const char* b2 = last ? nB : cB + (size_t)(t + 2) * kstep;
            const char* a3 = a2 + kstep; const char* b3 = b2 + kstep;
            PG8_LDB(B0, 0, 0); PG8_LDB(B1, 0, 1); PG8_SCHED; PG8_LDA(At, 0, 0); PG8_STAGE_A(PG8_SA(1, 1), a1, 1);
            if (GATHER) { if (last) { voffA[0][0] = vn[0][0]; voffA[0][1] = vn[0][1]; voffA[1][0] = vn[1][0]; voffA[1][1] = vn[1][1]; } }
            PG8_WAIT_V(8); PG8_WAIT_L(0); PG8_BAR; PG8_MMA(0, 0, At, B0); PG8_MMA(0, 1, At, B1); PG8_BAR; PG8_SCHED;
            PG8_LDA(At, 0, 1); PG8_STAGE_B(PG8_SB(0, 0), b2); PG8_STAGE_B(PG8_SB(0, 1), b2 + hstepB); PG8_STAGE_A(PG8_SA(0, 0), a2, 0);
            PG8_WAIT_V(8); PG8_WAIT_L(0); PG8_BAR; PG8_MMA(1, 0, At, B0); PG8_MMA(1, 1, At, B1); PG8_BAR; PG8_SCHED;
            PG8_LDB(B0, 1, 0); PG8_LDB(B1, 1, 1); PG8_SCHED; PG8_LDA(At, 1, 0); PG8_STAGE_A(PG8_SA(0, 1), a2, 1);
            PG8_WAIT_V(8); PG8_WAIT_L(0); PG8_BAR; PG8_MMA(0, 0, At, B0); PG8_MMA(0, 1, At, B1); PG8_BAR; PG8_SCHED;
            PG8_LDA(At, 1, 1); PG8_STAGE_B(PG8_SB(1, 0), b3); PG8_STAGE_B(PG8_SB(1, 1), b3 + hstepB); PG8_STAGE_A(PG8_SA(1, 0), a3, 0);
            PG8_WAIT_V(8); PG8_WAIT_L(0); PG8_BAR; PG8_MMA(1, 0, At, B0); PG8_MMA(1, 1, At, B1); PG8_BAR; PG8_SCHED;
        }
        if (ALIGN_EPI) { if (wr == 0) PG8_BAR; }
        { int te = threadIdx.x; asm volatile("" : "+v"(te)); E(acc, cur, wr, wc, te & 15, (te & 63) >> 4); }
        if (!has_next) break;
        if (!S.keep_acc(cur)) {
#pragma unroll
        for (int a = 0; a < 2; ++a)
#pragma unroll
            for (int b = 0; b < 2; ++b)
#pragma unroll
                for (int m = 0; m < 4; ++m)
#pragma unroll
                    for (int n = 0; n < 2; ++n) acc[a][b][m][n] = (f32x4){0.f, 0.f, 0.f, 0.f};
        }
        cur = nxt; cA = nA; cB = nB; ++ui;
        if (ALIGN_EPI) { if (wr == 1) PG8_BAR; }
    }
    PG8_WAIT_V(0);
    if (!ALIGN_EPI) { if (wr == 0) PG8_BAR; }
    PG8_BAR;
#undef PG8_SA
#undef PG8_SB
#undef PG8_STAGE_A
#undef PG8_STAGE_B
#undef PG8_LDA
#undef PG8_LDB
#undef PG8_MMA
#undef PG8_WAIT_V
#undef PG8_WAIT_L
#undef PG8_BAR
#undef PG8_SCHED
}
struct TileOrder {
    int nM, nN, nwg, G, c;
    __device__ __forceinline__ void init(int nM_, int nN_, int G_, int c_) { nM = nM_; nN = nN_; nwg = nM * nN; G = G_; c = c_; }
    __device__ __forceinline__ bool tile(int i, int& pm, int& pn) const {
        const long L = (long)i * G + c; if (L >= nwg) return false;
        int wgid = (int)L; { const int q = nwg / 8, r = nwg % 8, xcd = wgid % 8, off = wgid / 8; wgid = (xcd < r ? xcd * (q + 1) : r * (q + 1) + (xcd - r) * q) + off; }
        const int nig = 8 * nN, gid = wgid / nig, fm = gid * 8, gsz = (nM - fm) < 8 ? (nM - fm) : 8;
        pm = fm + ((wgid % nig) % gsz); pn = (wgid % nig) / gsz; return true;
    }
};
struct DenseSched {
    TileOrder o; const bf16_t* A; const bf16_t* Bt; int lda, ldb;
    __device__ __forceinline__ bool next(int i, Unit& u) const { u.aux = 0; return o.tile(i, u.pm, u.pn); }
    __device__ __forceinline__ const char* a_base(const Unit& u) const { return (const char*)(A + (size_t)u.pm * 256 * lda); }
    __device__ __forceinline__ const char* b_base(const Unit& u) const { return (const char*)(Bt + (size_t)u.pn * 256 * ldb); }
    __device__ __forceinline__ bool keep_acc(const Unit&) const { return false; }
    __device__ __forceinline__ void a_offs(const Unit&, int, int, int, int, unsigned (&)[2][2]) const {}
};
}

struct EpiInProj { bf16_t* qkv; const float* r1; const float* gqa; const float* gka; const float* gqb; const float* gkb; LAS float* X;
    __device__ __forceinline__ void operator()(f32x4 (&acc)[2][2][4][2], const Unit& u, int wr, int wc, int fr, int fq) const {
        const int pn = u.pn;
        bf16_t* base = qkv; const int ldc = NQKV; const int colt = pn * 256 + wc * 32 + 8 * fq;
        const float* gain = pn < 4 ? gqa : (pn == 4 ? gka : ((pn >= 6 && pn < 10) ? gqb : ((pn >= 10 && pn < 14) ? gkb : nullptr)));
        if (gain) {
            const float extra = (pn < 4 || (pn >= 6 && pn < 10)) ? 0.08838834764831845f * 1.4426950408889634f : 1.0f;
#pragma unroll
            for (int ai = 0; ai < 2; ++ai)
#pragma unroll
                for (int m = 0; m < 4; ++m)
#pragma unroll
                    for (int bj = 0; bj < 2; ++bj) { const f32x4 a0 = acc[ai][bj][m][0], a1 = acc[ai][bj][m][1];
                        float sq = (a0[0] * a0[0] + a0[1] * a0[1]) + (a0[2] * a0[2] + a0[3] * a0[3]) + (a1[0] * a1[0] + a1[1] * a1[1]) + (a1[2] * a1[2] + a1[3] * a1[3]);
                        sq += __shfl_xor(sq, 16); sq += __shfl_xor(sq, 32);
                        if (fq == 0) X[(ai * 128 + wr * 64 + m * 16 + fr) * 8 + bj * 4 + wc] = sq; }
            asm volatile("s_waitcnt lgkmcnt(0)" ::: "memory"); __builtin_amdgcn_s_barrier(); asm volatile("" ::: "memory");
            const f32x4 g0 = *(const f32x4*)(gain + wc * 32 + 8 * fq), g1 = *(const f32x4*)(gain + wc * 32 + 8 * fq + 4);
#pragma unroll
            for (int ai = 0; ai < 2; ++ai)
#pragma unroll
                for (int m = 0; m < 4; ++m) { const int rl = ai * 128 + wr * 64 + m * 16 + fr; const int row = u.pm * 256 + rl; const float rs = r1[row] * (1.0f / 64.0f); bf16_t* rowp = base + (size_t)row * ldc + colt;
#pragma unroll
                    for (int bj = 0; bj < 2; ++bj) { const f32x4 t = *(const LAS f32x4*)(X + rl * 8 + bj * 4); const float tot = (t[0] + t[1]) + (t[2] + t[3]);
                        const float sc = rs * rsqrtf(rs * rs * tot * (1.0f / 128.0f) + EPS) * extra;
                        const f32x4 v0 = acc[ai][bj][m][0] * sc * g0, v1 = acc[ai][bj][m][1] * sc * g1;
                        u32x4 w; w.x = pk2(v0[0], v0[1]); w.y = pk2(v0[2], v0[3]); w.z = pk2(v1[0], v1[1]); w.w = pk2(v1[2], v1[3]);
                        *(u32x4*)(rowp + bj * 128) = w; } }
            return;
        }
#pragma unroll
        for (int ai = 0; ai < 2; ++ai)
#pragma unroll
            for (int m = 0; m < 4; ++m) { const int row = u.pm * 256 + ai * 128 + wr * 64 + m * 16 + fr; const float rs = r1[row] * (1.0f / 64.0f); bf16_t* rowp = base + (size_t)row * ldc + colt;
#pragma unroll
                for (int bj = 0; bj < 2; ++bj) { const f32x4 v0 = acc[ai][bj][m][0] * rs, v1 = acc[ai][bj][m][1] * rs;
                    u32x4 w; w.x = pk2(v0[0], v0[1]); w.y = pk2(v0[2], v0[3]); w.z = pk2(v1[0], v1[1]); w.w = pk2(v1[2], v1[3]);
                    *(u32x4*)(rowp + bj * 128) = w; } }
    } };
struct GateSched { pg8::TileOrder o; const unsigned char* x8; const unsigned char* W8;
    __device__ __forceinline__ bool next(int i, Unit& u) const { u.aux = 0; return o.tile(i, u.pm, u.pn); }
    __device__ __forceinline__ const char* a_base(const Unit&) const { return (const char*)x8; }
    __device__ __forceinline__ const char* b_base(const Unit& u) const { return (const char*)(W8 + (size_t)(u.pn * 256) * D); }
    __device__ __forceinline__ bool keep_acc(const Unit&) const { return false; }
    __device__ __forceinline__ void a_offs(const Unit& u, int R0, int C0, int R1, int C1, unsigned (&v)[2][2]) const {
#pragma unroll
        for (int h = 0; h < 2; ++h) { v[h][0] = (unsigned)(u.pm * 256 + 128 * h + R0) * D + C0 * 2u; v[h][1] = (unsigned)(u.pm * 256 + 128 * h + R1) * D + C1 * 2u; } }
};
struct EpiGates { bf16_t* gates; const float* r1;
    __device__ __forceinline__ void operator()(f32x4 (&acc)[2][2][4][2], const Unit& u, int wr, int wc, int fr, int fq) const {
        const int cg = u.pn * 128 + wc * 32 + 8 * fq;
#pragma unroll
        for (int ai = 0; ai < 2; ++ai)
#pragma unroll
            for (int m = 0; m < 4; ++m) { const int row = u.pm * 256 + ai * 128 + wr * 64 + m * 16 + fr; const float rs = r1[row] * (1.0f / 64.0f); bf16_t* rowp = gates + (size_t)row * NGATE + cg;
                float ra[8], sb[8];
#pragma unroll
                for (int n = 0; n < 2; ++n)
#pragma unroll
                    for (int j = 0; j < 4; ++j) { const float ea = __expf(-acc[ai][0][m][n][j] * rs), eb = fminf(__expf(-acc[ai][1][m][n][j] * rs), 1e30f);
                        sb[4 * n + j] = __builtin_amdgcn_rcpf(1.0f + eb); ra[4 * n + j] = (1.0f + eb) * __builtin_amdgcn_rcpf(1.0f + ea); }
                u32x4 w; w.x = pk2(ra[0], ra[1]); w.y = pk2(ra[2], ra[3]); w.z = pk2(ra[4], ra[5]); w.w = pk2(ra[6], ra[7]); *(u32x4*)rowp = w;
                w.x = pk2(sb[0], sb[1]); w.y = pk2(sb[2], sb[3]); w.z = pk2(sb[4], sb[5]); w.w = pk2(sb[6], sb[7]); *(u32x4*)(rowp + 2048) = w; }
    } };
__device__ __forceinline__ void p1_inproj(const Params& p, LAS unsigned char* lds) {
    { GateSched S; S.o.init(128, 18, gridDim.x, blockIdx.x); S.x8 = p.ws + WS_X8; S.W8 = p.ws + WS_WIN;
      EpiInProj E{(bf16_t*)(p.ws + WS_QKV), (const float*)(p.ws + WS_R1), p.in[3], p.in[4], p.in[6], p.in[7], (LAS float*)(lds + 131072)};
      pg8::gemm_phase<true, true, GateSched, EpiInProj, true>(lds, S, E, D / 128, D / 2, D / 2); }
    { GateSched S; S.o.init(128, 16, gridDim.x, blockIdx.x); S.x8 = p.ws + WS_X8; S.W8 = p.ws + WS_WIN + (size_t)NQKV * D;
      EpiGates E{(bf16_t*)(p.ws + WS_GATES), (const float*)(p.ws + WS_R1)};
      pg8::gemm_phase<true, true, GateSched, EpiGates, true>(lds, S, E, D / 128, D / 2, D / 2); }
}

__device__ __forceinline__ void wait_vm(int n) {
    switch (n) { case 0: asm volatile("s_waitcnt vmcnt(0)" ::: "memory"); break; case 2: asm volatile("s_waitcnt vmcnt(2)" ::: "memory"); break; case 4: asm volatile("s_waitcnt vmcnt(4)" ::: "memory"); break;
                 case 6: asm volatile("s_waitcnt vmcnt(6)" ::: "memory"); break; case 8: asm volatile("s_waitcnt vmcnt(8)" ::: "memory"); break; case 10: asm volatile("s_waitcnt vmcnt(10)" ::: "memory"); break;
                 default: asm volatile("s_waitcnt vmcnt(12)" ::: "memory"); break; }
}
__device__ __forceinline__ void glds16_asm(const void* gsrc, unsigned lds_dst) {
    unsigned keep;
    asm volatile("s_mov_b32 %0, m0\n\ts_mov_b32 m0, %2\n\ts_nop 0\n\tglobal_load_lds_dwordx4 %1, off\n\ts_mov_b32 m0, %0" : "=&s"(keep) : "v"(gsrc), "s"(lds_dst) : "memory");
}
#define ATT_BAR() do { asm volatile("s_waitcnt lgkmcnt(0)" ::: "memory"); __builtin_amdgcn_s_barrier(); asm volatile("" ::: "memory"); } while (0)
__device__ __forceinline__ void load_q(const bf16_t* qp, int g, bf16x8 (&qf)[4]) {
#pragma unroll
    for (int ks = 0; ks < 4; ++ks) qf[ks] = *(const bf16x8*)(qp + 32 * ks + 8 * g);
#pragma unroll
    for (int ks = 0; ks < 4; ++ks) asm volatile("" : "+v"(qf[ks]));
}
__device__ __forceinline__ bf16x8 vt_frag(LAS unsigned char* base, int row0, int g, int q4, int pp, int dt) {
    const s16x4 lo = tr_read(base + off_b(row0 + 4 * g + q4, 2 * dt + (pp >> 1)) + 8 * (pp & 1)), hi = tr_read(base + off_b(row0 + 16 + 4 * g + q4, 2 * dt + (pp >> 1)) + 8 * (pp & 1));
    bf16x8 vf; vf[0] = lo[0]; vf[1] = lo[1]; vf[2] = lo[2]; vf[3] = lo[3]; vf[4] = hi[0]; vf[5] = hi[1]; vf[6] = hi[2]; vf[7] = hi[3]; return vf;
}

__device__ __forceinline__ void attn_window_item(const Params& p, LAS unsigned char* lds, int item, int& tab_head) {
    const int tid = phase_tid(), lane = tid & 63, w = __builtin_amdgcn_readfirstlane(tid >> 6), g = lane >> 4, ql = lane & 15;
    const int b = item >> 9, nb = (item >> 2) & 127, hpq = item & 3, kv = hpq >> 1, hq0 = 2 * hpq;
    const bf16_t* qkv = (const bf16_t*)(p.ws + WS_QKV); unsigned char* o = p.ws + WS_O8;
    LAS float* bias = (LAS float*)(lds + 131072); const unsigned ldsb = (unsigned)(size_t)lds;
    const unsigned loff = (unsigned)(w * 4 + g) * NQKV + (unsigned)((ql ^ ((g << 2) | (w & 3))) * 8);
    const bf16_t* kbase = qkv + (size_t)(b * SEQ) * NQKV + 1024 + kv * 128;
#define WIN_ISSUE(c) do { const int _c = (c); const int _kb = min(max(nb - 1 + (_c % 3), 0), 127); const bf16_t* _src = kbase + (size_t)(_kb * 128) * NQKV + (_c >= 3 ? 256 : 0) + loff; \
        _Pragma("unroll") for (int _i = 0; _i < 4; ++_i) glds16_asm(_src + (size_t)(32 * _i) * NQKV, ldsb + (unsigned)((_c & 3) * 32768 + _i * 8192 + w * 1024)); } while (0)
    ATT_BAR();
    WIN_ISSUE(0); WIN_ISSUE(1); WIN_ISSUE(2);
    if (hpq != tab_head) { for (int i = tid; i < 2 * 257; i += 512) { const int hh = i >= 257, j = i - 257 * hh; bias[hh * 264 + j] = p.in[12][t5_bucket(j - 128) * 8 + hq0 + hh] * 1.4426950408889634f; } tab_head = hpq; }
    const int tq = b * SEQ + nb * 128 + 16 * w + ql;
    bf16x8 qf[2][4]; load_q(qkv + (size_t)tq * NQKV + hq0 * 128, g, qf[0]); load_q(qkv + (size_t)tq * NQKV + (hq0 + 1) * 128, g, qf[1]);
    float sink[2]; sink[0] = p.in[5][hq0] * 1.4426950408889634f; sink[1] = p.in[5][hq0 + 1] * 1.4426950408889634f; asm volatile("" : "+v"(sink[0]), "+v"(sink[1]));
    f32x4 S1[2][8], SC[2][9];
#pragma unroll
    for (int u = 0; u < 2; ++u) {
#pragma unroll
        for (int kt = 0; kt < 8; ++kt) S1[u][kt] = (f32x4){0.f, 0.f, 0.f, 0.f};
#pragma unroll
        for (int s = 0; s < 9; ++s) SC[u][s] = (f32x4){0.f, 0.f, 0.f, 0.f}; }
    const bool in0 = nb > 0, in2 = nb < 127;
#pragma unroll
    for (int c = 0; c < 3; ++c) {
        wait_vm(8); ATT_BAR(); WIN_ISSUE(c + 3);
        LAS unsigned char* buf = lds + (c & 3) * 32768;
#pragma unroll
        for (int kt = 0; kt < 8; ++kt) {
            const bool act = (c == 1) || (c == 0 ? kt >= w : kt <= w);
            if (act) {
#pragma unroll
                for (int ks = 0; ks < 4; ++ks) { const bf16x8 kf = *(const LAS bf16x8*)(buf + off_b(16 * kt + ql, 4 * ks + g));
#pragma unroll
                    for (int u = 0; u < 2; ++u) {
                        if (c == 1) S1[u][kt] = __builtin_amdgcn_mfma_f32_16x16x32_bf16(kf, qf[u][ks], S1[u][kt], 0, 0, 0);
                        else if (c == 0) SC[u][7 - kt] = __builtin_amdgcn_mfma_f32_16x16x32_bf16(kf, qf[u][ks], SC[u][7 - kt], 0, 0, 0);
                        else SC[u][8 - kt] = __builtin_amdgcn_mfma_f32_16x16x32_bf16(kf, qf[u][ks], SC[u][8 - kt], 0, 0, 0); } } }
        }
    }
    const int qi = 16 * w + ql; float inv[2];
    unsigned P1[2][4][4], PC[2][9][2];
#pragma unroll
    for (int u = 0; u < 2; ++u) { float mx = sink[u]; const LAS float* bt = bias + u * 264;
#pragma unroll
        for (int kt = 0; kt < 8; ++kt)
#pragma unroll
            for (int r = 0; r < 4; ++r) { const int rel = 16 * kt + 4 * g + r - qi; const float sv = S1[u][kt][r] + bt[rel + 128]; S1[u][kt][r] = sv; mx = fmaxf(mx, sv); }
#pragma unroll
        for (int s = 0; s < 9; ++s) { const bool c0 = s <= 7 - w; const int kt = c0 ? 7 - s : 8 - s; const int cofs = c0 ? -128 : 128; const bool inr = c0 ? in0 : in2;
#pragma unroll
            for (int r = 0; r < 4; ++r) { const int rel = cofs + 16 * kt + 4 * g + r - qi; const bool valid = inr && rel >= -128 && rel <= 128;
                const float bv = bt[rel + 128];
                const float sv = valid ? SC[u][s][r] + bv : -1e30f; SC[u][s][r] = sv; mx = fmaxf(mx, sv); } }
        mx = fmaxf(mx, __shfl_xor(mx, 16)); mx = fmaxf(mx, __shfl_xor(mx, 32));
        float l = 0.f;
#pragma unroll
        for (int kk = 0; kk < 4; ++kk) { float e[8];
#pragma unroll
            for (int r = 0; r < 4; ++r) { e[r] = __builtin_amdgcn_exp2f(S1[u][2 * kk][r] - mx); e[4 + r] = __builtin_amdgcn_exp2f(S1[u][2 * kk + 1][r] - mx); l += e[r] + e[4 + r]; }
            P1[u][kk][0] = pk2(e[0], e[1]); P1[u][kk][1] = pk2(e[2], e[3]); P1[u][kk][2] = pk2(e[4], e[5]); P1[u][kk][3] = pk2(e[6], e[7]); }
#pragma unroll
        for (int s = 0; s < 9; ++s) { float e[4];
#pragma unroll
            for (int r = 0; r < 4; ++r) { e[r] = __builtin_amdgcn_exp2f(SC[u][s][r] - mx); l += e[r]; }
            PC[u][s][0] = pk2(e[0], e[1]); PC[u][s][1] = pk2(e[2], e[3]); }
        l += __shfl_xor(l, 16); l += __shfl_xor(l, 32); l += __builtin_amdgcn_exp2f(sink[u] - mx);
        inv[u] = 1.0f / l; }
    f32x4 O[2][8];
#pragma unroll
    for (int u = 0; u < 2; ++u)
#pragma unroll
        for (int dt = 0; dt < 8; ++dt) O[u][dt] = (f32x4){0.f, 0.f, 0.f, 0.f};
    const int q4 = ql >> 2, pp = ql & 3;
#pragma unroll
    for (int c = 0; c < 3; ++c) {
        wait_vm(c == 0 ? 8 : (c == 1 ? 4 : 0)); ATT_BAR();
        LAS unsigned char* buf = lds + ((c + 3) & 3) * 32768;
#pragma unroll
        for (int kk = 0; kk < 4; ++kk) {
            bool a0, a1;
            if (c == 1) { a0 = true; a1 = true; } else if (c == 0) { a0 = 2 * kk >= w; a1 = 2 * kk + 1 >= w; } else { a0 = 2 * kk <= w; a1 = 2 * kk + 1 <= w; }
            if (a0 || a1) { bf16x8 pf[2];
#pragma unroll
                for (int u = 0; u < 2; ++u) { u32x4 pw;
                    if (c == 1) { pw.x = P1[u][kk][0]; pw.y = P1[u][kk][1]; pw.z = P1[u][kk][2]; pw.w = P1[u][kk][3]; }
                    else if (c == 0) { pw.x = a0 ? PC[u][7 - 2 * kk][0] : 0u; pw.y = a0 ? PC[u][7 - 2 * kk][1] : 0u; pw.z = a1 ? PC[u][6 - 2 * kk][0] : 0u; pw.w = a1 ? PC[u][6 - 2 * kk][1] : 0u; }
                    else { pw.x = a0 ? PC[u][8 - 2 * kk][0] : 0u; pw.y = a0 ? PC[u][8 - 2 * kk][1] : 0u; pw.z = a1 ? PC[u][7 - 2 * kk][0] : 0u; pw.w = a1 ? PC[u][7 - 2 * kk][1] : 0u; }
                    pf[u] = __builtin_bit_cast(bf16x8, pw); }
#pragma unroll
                for (int dt = 0; dt < 8; ++dt) { const bf16x8 vf = vt_frag(buf, 32 * kk, g, q4, pp, dt);
                    O[0][dt] = __builtin_amdgcn_mfma_f32_16x16x32_bf16(vf, pf[0], O[0][dt], 0, 0, 0); O[1][dt] = __builtin_amdgcn_mfma_f32_16x16x32_bf16(vf, pf[1], O[1][dt], 0, 0, 0); } } }
    }
#undef WIN_ISSUE
#pragma unroll
    for (int u = 0; u < 2; ++u) { unsigned char* op = o + (size_t)tq * D + (hq0 + u) * 128 + 4 * g; const float sc = inv[u] * 16.f;
#pragma unroll
        for (int dt = 0; dt < 8; ++dt) *(unsigned*)(op + 16 * dt) = pk4_fp8(O[u][dt][0] * sc, O[u][dt][1] * sc, O[u][dt][2] * sc, O[u][dt][3] * sc); }
}

__device__ __forceinline__ void attn_nat_item(const Params& p, LAS unsigned char* lds, int item, int& tab_head) {
    const int tid = phase_tid(), lane = tid & 63, w = __builtin_amdgcn_readfirstlane(tid >> 6), g = lane >> 4, ql = lane & 15;
    const int b = item >> 9, rp = (item >> 2) & 127, hp = item & 3, hh = w >> 2, h = 2 * hp + hh, jq = w & 3;
    const int kr_lo = min(max(2 * rp - 4, 0), 248);
    const int d0 = min(max(2 * rp - 4, 0), 248) - kr_lo, d1 = min(max(2 * rp - 3, 0), 248) - kr_lo;
    const int w0 = jq == 0 ? 0 : (jq == 1 ? 8 : (jq == 2 ? 24 : 32));
    const bf16_t* qkv = (const bf16_t*)(p.ws + WS_QKV); unsigned char* o = p.ws + WS_O8;
    LAS float* rpb = (LAS float*)(lds + 131072); const unsigned ldsb = (unsigned)(size_t)lds;
    const unsigned loff = (unsigned)(w * 4 + g) * NQKV + (unsigned)((ql ^ ((g << 2) | (w & 3))) * 8);
    const bf16_t* kbase = qkv + (size_t)(b * SEQ) * NQKV + 2560 + 2 * hp * 128;
#define NAT_ISSUE(s) do { const int _s = (s); const int _kr = min(kr_lo + (_s % 9), 255); const bf16_t* _src = kbase + (size_t)(_kr * 64) * NQKV + (_s >= 9 ? 1024 : 0) + loff; \
        _Pragma("unroll") for (int _i = 0; _i < 4; ++_i) glds16_asm(_src + (size_t)(32 * (_i & 1)) * NQKV + 128 * (_i >> 1), ldsb + (unsigned)((_s & 3) * 32768 + _i * 8192 + w * 1024)); } while (0)
    ATT_BAR();
    NAT_ISSUE(0); NAT_ISSUE(1); NAT_ISSUE(2);
    if (hp != tab_head) { for (int i = tid; i < 930; i += 512) rpb[i] = p.in[8][2 * hp * 465 + i] * 1.4426950408889634f; tab_head = hp; }
    const int qcol = 16 * jq + ql; const int tq0 = b * SEQ + (2 * rp) * 64 + qcol;
    bf16x8 qf[2][4]; load_q(qkv + (size_t)tq0 * NQKV + 1536 + h * 128, g, qf[0]); load_q(qkv + (size_t)(tq0 + 64) * NQKV + 1536 + h * 128, g, qf[1]);
    f32x4 S[2][9][2];
#pragma unroll
    for (int u = 0; u < 2; ++u)
#pragma unroll
        for (int c = 0; c < 9; ++c) { S[u][c][0] = (f32x4){0.f, 0.f, 0.f, 0.f}; S[u][c][1] = (f32x4){0.f, 0.f, 0.f, 0.f}; }
#pragma unroll
    for (int c = 0; c < 9; ++c) {
        wait_vm(8); ATT_BAR(); NAT_ISSUE(c + 3);
        const bool a0 = c >= d0 && c < d0 + 8, a1 = c >= d1 && c < d1 + 8;
        LAS unsigned char* buf = lds + (c & 3) * 32768 + hh * 16384;
#pragma unroll
        for (int t = 0; t < 2; ++t)
#pragma unroll
            for (int ks = 0; ks < 4; ++ks) { const bf16x8 kf = *(const LAS bf16x8*)(buf + off_b(w0 + 16 * t + ql, 4 * ks + g));
                if (a0) S[0][c][t] = __builtin_amdgcn_mfma_f32_16x16x32_bf16(kf, qf[0][ks], S[0][c][t], 0, 0, 0);
                if (a1) S[1][c][t] = __builtin_amdgcn_mfma_f32_16x16x32_bf16(kf, qf[1][ks], S[1][c][t], 0, 0, 0); }
    }
    const int cs = min(max(qcol - 8, 0), 48); float inv[2];
    unsigned P[2][9][4];
    int dcv[2][4]; bool cv[2][4];
#pragma unroll
    for (int t = 0; t < 2; ++t)
#pragma unroll
        for (int q = 0; q < 4; ++q) { const int kc = w0 + 16 * t + 4 * g + q; cv[t][q] = kc >= cs && kc < cs + 16; dcv[t][q] = hh * 465 + kc - qcol + 15; }
#pragma unroll
    for (int u = 0; u < 2; ++u) { const int du = u ? d1 : d0; const int r = 2 * rp + u; float mx = -1e30f;
#pragma unroll
        for (int c = 0; c < 9; ++c) { const bool act = c >= du && c < du + 8;
            if (act) { const int rowb = (kr_lo + c - r + 7) * 31;
#pragma unroll
                for (int t = 0; t < 2; ++t)
#pragma unroll
                    for (int q = 0; q < 4; ++q) { const float sv = cv[t][q] ? S[u][c][t][q] + rpb[rowb + dcv[t][q]] : -1e30f; S[u][c][t][q] = sv; mx = fmaxf(mx, sv); } } }
        mx = fmaxf(mx, __shfl_xor(mx, 16)); mx = fmaxf(mx, __shfl_xor(mx, 32));
        float l = 0.f;
#pragma unroll
        for (int c = 0; c < 9; ++c) { const bool act = c >= du && c < du + 8;
            if (act) { float e[2][4];
#pragma unroll
                for (int t = 0; t < 2; ++t)
#pragma unroll
                    for (int q = 0; q < 4; ++q) { e[t][q] = __builtin_amdgcn_exp2f(S[u][c][t][q] - mx); l += e[t][q]; }
                P[u][c][0] = pk2(e[0][0], e[0][1]); P[u][c][1] = pk2(e[0][2], e[0][3]); P[u][c][2] = pk2(e[1][0], e[1][1]); P[u][c][3] = pk2(e[1][2], e[1][3]); }
            else { P[u][c][0] = 0u; P[u][c][1] = 0u; P[u][c][2] = 0u; P[u][c][3] = 0u; } }
        l += __shfl_xor(l, 16); l += __shfl_xor(l, 32);
        inv[u] = 1.0f / l; }
    f32x4 O[2][8];
#pragma unroll
    for (int u = 0; u < 2; ++u)
#pragma unroll
        for (int dt = 0; dt < 8; ++dt) O[u][dt] = (f32x4){0.f, 0.f, 0.f, 0.f};
    const int q4 = ql >> 2, pp = ql & 3;
#pragma unroll
    for (int c = 0; c < 9; ++c) {
        wait_vm(c <= 6 ? 8 : (c == 7 ? 4 : 0)); ATT_BAR(); if (c + 12 < 18) NAT_ISSUE(c + 12);
        const bool a0 = c >= d0 && c < d0 + 8, a1 = c >= d1 && c < d1 + 8;
        LAS unsigned char* buf = lds + ((c + 9) & 3) * 32768 + hh * 16384;
        u32x4 pw0; pw0.x = P[0][c][0]; pw0.y = P[0][c][1]; pw0.z = P[0][c][2]; pw0.w = P[0][c][3];
        u32x4 pw1; pw1.x = P[1][c][0]; pw1.y = P[1][c][1]; pw1.z = P[1][c][2]; pw1.w = P[1][c][3];
        const bf16x8 pf0 = __builtin_bit_cast(bf16x8, pw0), pf1 = __builtin_bit_cast(bf16x8, pw1);
#pragma unroll
        for (int dt = 0; dt < 8; ++dt) { const bf16x8 vf = vt_frag(buf, w0, g, q4, pp, dt);
            if (a0) O[0][dt] = __builtin_amdgcn_mfma_f32_16x16x32_bf16(vf, pf0, O[0][dt], 0, 0, 0);
            if (a1) O[1][dt] = __builtin_amdgcn_mfma_f32_16x16x32_bf16(vf, pf1, O[1][dt], 0, 0, 0); }
    }
#undef NAT_ISSUE
#pragma unroll
    for (int u = 0; u < 2; ++u) { unsigned char* op = o + (size_t)(tq0 + 64 * u) * D + 1024 + h * 128 + 4 * g; const float sc = inv[u] * 16.f;
#pragma unroll
        for (int dt = 0; dt < 8; ++dt) *(unsigned*)(op + 16 * dt) = pk4_fp8(O[u][dt][0] * sc, O[u][dt][1] * sc, O[u][dt][2] * sc, O[u][dt][3] * sc); }
}
__device__ __forceinline__ void p2_attn(const Params& p, LAS unsigned char* lds) {
    int tab_head = -1, mb = 0;
    const int nper = (1024 + (int)gridDim.x - 1) / (int)gridDim.x;
    const int NB = (MOE_ITEMS + 8 * (int)gridDim.x - 1) / (8 * (int)gridDim.x);
    for (int s = 0; s < 2 * nper || mb < NB; ++s) {
        if (s < 2 * nper) {
            const bool nat = s >= nper; const int it = (int)blockIdx.x + (nat ? s - nper : s) * (int)gridDim.x;
            if (s == nper) { tab_head = -1;
#ifdef PROBE_A
                if (blockIdx.x == 0 && threadIdx.x == 0) ((unsigned long long*)(p.ws + WS_END))[11] = __builtin_amdgcn_s_memrealtime();
#endif
            }
            if (it < 1024) { if (!nat) attn_window_item(p, lds, it, tab_head); else attn_nat_item(p, lds, it, tab_head); }
        }
        if ((((s + (int)blockIdx.x) & 1) == 0 || s >= 2 * nper) && mb < NB) {
            ATT_BAR();
            for (int q = 0; q < 3 && mb < NB; ++q) moe_prep_batch(p, lds, mb++);
        }
    }
    asm volatile("s_waitcnt vmcnt(0)" ::: "memory"); __syncthreads();
}

struct UpHook { const bf16_t* gates;
    __device__ __forceinline__ void operator()(f32x4 (&acc)[2][2][4][2], const Unit& u, int wr, int wc, int fr, int fq) const {
        const unsigned goff = (unsigned)(u.pm * 256 + wr * 64 + fr) * NGATE + u.pn * 256 + wc * 32 + 8 * fq;
#pragma unroll
        for (int ai = 0; ai < 2; ++ai) {
            bf16x8 ra[4][2];
#pragma unroll
            for (int m = 0; m < 4; ++m)
#pragma unroll
                for (int bj = 0; bj < 2; ++bj) ra[m][bj] = *(const bf16x8*)(gates + goff + (unsigned)((ai * 128 + m * 16) * NGATE) + bj * 128);
#pragma unroll
            for (int m = 0; m < 4; ++m)
#pragma unroll
                for (int bj = 0; bj < 2; ++bj)
#pragma unroll
                    for (int n = 0; n < 2; ++n)
#pragma unroll
                        for (int j = 0; j < 4; ++j) acc[ai][bj][m][n][j] *= bf2f(ra[m][bj][4 * n + j]);
            asm volatile("" ::: "memory"); }
    } };
struct UpSched {
    pg8::TileOrder o; const unsigned char* A; const unsigned char* Bt;
    __device__ __forceinline__ bool next(int i, Unit& u) const { u.aux = i & 1; return o.tile(i >> 1, u.pm, u.pn); }
    __device__ __forceinline__ const char* a_base(const Unit&) const { return (const char*)A; }
    __device__ __forceinline__ const char* b_base(const Unit& u) const { return (const char*)(Bt + (size_t)u.pn * 256 * D + u.aux * 1024); }
    __device__ __forceinline__ bool keep_acc(const Unit& u) const { return u.aux == 0; }
    __device__ __forceinline__ void a_offs(const Unit& u, int R0, int C0, int R1, int C1, unsigned (&v)[2][2]) const {
#pragma unroll
        for (int h = 0; h < 2; ++h) { v[h][0] = (unsigned)(u.pm * 256 + 128 * h + R0) * D + u.aux * 1024 + C0 * 2u; v[h][1] = (unsigned)(u.pm * 256 + 128 * h + R1) * D + u.aux * 1024 + C1 * 2u; } }
};
struct EpiUp { const bf16_t* gates; unsigned char* merged;
    __device__ __forceinline__ void operator()(f32x4 (&acc)[2][2][4][2], const Unit& u, int wr, int wc, int fr, int fq) const {
        if (u.aux == 0) { UpHook{gates}(acc, u, wr, wc, fr, fq); return; }
        const unsigned goff = (unsigned)(u.pm * 256 + wr * 64 + fr) * NGATE + 2048 + u.pn * 256 + wc * 32 + 8 * fq;
        const unsigned moff = (unsigned)(u.pm * 256 + wr * 64 + fr) * D + u.pn * 256 + wc * 32 + 8 * fq;
#pragma unroll
        for (int ai = 0; ai < 2; ++ai) {
            bf16x8 sb[4][2];
#pragma unroll
            for (int m = 0; m < 4; ++m)
#pragma unroll
                for (int bj = 0; bj < 2; ++bj) sb[m][bj] = *(const bf16x8*)(gates + goff + (unsigned)((ai * 128 + m * 16) * NGATE) + bj * 128);
#pragma unroll
            for (int m = 0; m < 4; ++m)
#pragma unroll
                for (int bj = 0; bj < 2; ++bj) { f32x4 v0 = acc[ai][bj][m][0], v1 = acc[ai][bj][m][1];
#pragma unroll
                    for (int j = 0; j < 4; ++j) { v0[j] *= bf2f(sb[m][bj][j]) * (1.0f / 64.0f); v1[j] *= bf2f(sb[m][bj][4 + j]) * (1.0f / 64.0f); }
                    u32x2 w; w.x = pk4_fp8(v0[0], v0[1], v0[2], v0[3]); w.y = pk4_fp8(v1[0], v1[1], v1[2], v1[3]);
                    *(u32x2*)(merged + moff + (unsigned)((ai * 128 + m * 16) * D) + bj * 128) = w; }
            asm volatile("" ::: "memory"); }
    } };
__device__ __forceinline__ void p3_up(const Params& p, LAS unsigned char* lds) {
    UpSched S; S.o.init(128, 8, gridDim.x, blockIdx.x); S.A = p.ws + WS_O8; S.Bt = p.ws + WS_WUP;
    EpiUp E{(const bf16_t*)(p.ws + WS_GATES), p.ws + WS_MG};
    int ntv = 1024 / 128; asm volatile("" : "+s"(ntv));
    pg8::gemm_phase<true, true, UpSched, EpiUp, true>(lds, S, E, ntv, D / 2, D / 2);
}

struct EpiOut { const bf16_t* xb; bf16_t* hb; unsigned char* h8;
    __device__ __forceinline__ void operator()(f32x4 (&acc)[2][2][4][2], const Unit& u, int wr, int wc, int fr, int fq) const {
        unsigned off = (unsigned)(u.pm * 256 + wr * 64 + fr) * D + u.pn * 256 + wc * 32 + 8 * fq;
#pragma unroll
        for (int ai = 0; ai < 2; ++ai) {
            bf16x8 xr[4][2];
#pragma unroll
            for (int m = 0; m < 4; ++m)
#pragma unroll
                for (int bj = 0; bj < 2; ++bj) xr[m][bj] = *(const bf16x8*)(xb + off + (unsigned)(m * 16 * D) + bj * 128);
#pragma unroll
            for (int m = 0; m < 4; ++m) { asm volatile("" : "+v"(off));
#pragma unroll
                for (int bj = 0; bj < 2; ++bj) { const f32x4 v0 = acc[ai][bj][m][0] * (1.0f / 1024.0f), v1 = acc[ai][bj][m][1] * (1.0f / 1024.0f); const u32x4 xw = __builtin_bit_cast(u32x4, xr[m][bj]);
                    const float h0 = v0[0] + __uint_as_float(xw.x << 16), h1 = v0[1] + __uint_as_float(xw.x & 0xffff0000u), h2 = v0[2] + __uint_as_float(xw.y << 16), h3 = v0[3] + __uint_as_float(xw.y & 0xffff0000u);
                    const float h4 = v1[0] + __uint_as_float(xw.z << 16), h5 = v1[1] + __uint_as_float(xw.z & 0xffff0000u), h6 = v1[2] + __uint_as_float(xw.w << 16), h7 = v1[3] + __uint_as_float(xw.w & 0xffff0000u);
                    u32x4 w; w.x = pk2(h0, h1); w.y = pk2(h2, h3); w.z = pk2(h4, h5); w.w = pk2(h6, h7);
                    *(u32x4*)(hb + off + bj * 128) = w;
                    }
                off += 16 * D; }
            off += 64 * D; }
    } };
__device__ __forceinline__ void p4_out(const Params& p, LAS unsigned char* lds) {
    GateSched S; S.o.init(128, 8, gridDim.x, blockIdx.x); S.x8 = p.ws + WS_MG; S.W8 = p.ws + WS_WOUT;
    EpiOut E{(const bf16_t*)(p.ws + WS_XB), (bf16_t*)(p.ws + WS_O), p.ws + WS_H8};
    pg8::gemm_phase<true, true, GateSched, EpiOut, true, false>(lds, S, E, D / 128, D / 2, D / 2);
}

__device__ __forceinline__ void p5_router(const Params& p, LAS unsigned char* lds) {
    const int tid = phase_tid(), lane = tid & 63, wave = __builtin_amdgcn_readfirstlane(tid >> 6), g = lane >> 4, tl = lane & 15;
    const bf16_t* wsp = (const bf16_t*)(p.ws + WS_WRT); float* r2 = (float*)(p.ws + WS_R2); int* cnt = (int*)(p.ws + WS_CNT); int* tokl = (int*)(p.ws + WS_TOK);
    int* recc = (int*)(p.ws + WS_RECC); float* recw = (float*)(p.ws + WS_RECW); const bf16_t* hb = (const bf16_t*)(p.ws + WS_O);
    const float* brg = p.in[15]; const float* bre = p.in[17];
    LAS unsigned char* H = lds + wave * 2304;
    LAS unsigned char* WL = lds + 36864;
    const int r8 = lane >> 3, s8 = lane & 7;
    const int pa0 = tid / 384, pr0 = (tid % 384) >> 3, ps0 = tid & 7, pi1 = 512 + tid, pa1 = pi1 / 384, pr1 = (pi1 % 384) >> 3;
    const unsigned wsrc0 = (unsigned)(pa0 * 48 * 2048 + pr0 * D + ps0 * 8), wsrc1 = (unsigned)(pa1 * 48 * 2048 + pr1 * D + ps0 * 8);
    const unsigned wdst0 = (unsigned)(pa0 * 6144 + pr0 * 128 + ((ps0 ^ (pr0 & 7)) << 4)), wdst1 = (unsigned)(pa1 * 6144 + pr1 * 128 + ((ps0 ^ (pr1 & 7)) << 4));
    for (int round = blockIdx.x; round < T / 128; round += gridDim.x) {
        const int tile = round * 8 + wave;
        const bf16_t* hs = hb + (size_t)tile * 16 * D + r8 * D + s8 * 8; unsigned char* h8s = p.ws + WS_H8 + (size_t)tile * 16 * D + r8 * D + s8 * 8;
        f32x4 accA = {0.f, 0.f, 0.f, 0.f}, accB = accA, accC = accA; float ss = 0.f;
        u32x4 hq0[2], hq1[2], hq2[2], hq3[2], wr0, wr1;
#define RT_LOADS(bq, k) do { bq[0] = *(const u32x4*)(hs + 64 * (k)); bq[1] = *(const u32x4*)(hs + 8 * D + 64 * (k)); } while (0)
#define RT_H8(w_) ({ const u32x4 w__ = (w_); u32x2 f__; f__.x = pk4_fp8(__uint_as_float(w__.x << 16), __uint_as_float(w__.x & 0xffff0000u), __uint_as_float(w__.y << 16), __uint_as_float(w__.y & 0xffff0000u)); \
            f__.y = pk4_fp8(__uint_as_float(w__.z << 16), __uint_as_float(w__.z & 0xffff0000u), __uint_as_float(w__.w << 16), __uint_as_float(w__.w & 0xffff0000u)); f__; })
#define RT_COMP(bq, wbuf, k) do { \
            *(u32x2*)(h8s + 64 * (k)) = RT_H8(bq[0]); *(u32x2*)(h8s + 8 * D + 64 * (k)) = RT_H8(bq[1]); \
            *(LAS u32x4*)(H + r8 * 144 + s8 * 16) = bq[0]; *(LAS u32x4*)(H + (r8 + 8) * 144 + s8 * 16) = bq[1]; \
            _Pragma("unroll") for (int ks = 0; ks < 2; ++ks) { const u32x4 hw = *(const LAS u32x4*)(H + tl * 144 + 64 * ks + 16 * g); \
                { const float a0 = __uint_as_float(hw.x << 16), a1 = __uint_as_float(hw.x & 0xffff0000u), a2 = __uint_as_float(hw.y << 16), a3 = __uint_as_float(hw.y & 0xffff0000u); \
                  const float a4 = __uint_as_float(hw.z << 16), a5 = __uint_as_float(hw.z & 0xffff0000u), a6 = __uint_as_float(hw.w << 16), a7 = __uint_as_float(hw.w & 0xffff0000u); \
                  ss += (a0 * a0 + a1 * a1) + (a2 * a2 + a3 * a3) + (a4 * a4 + a5 * a5) + (a6 * a6 + a7 * a7); } \
                const bf16x8 bh = __builtin_bit_cast(bf16x8, hw); const unsigned so_ = (unsigned)(((4 * ks + g) ^ (tl & 7)) << 4); \
                _Pragma("unroll") for (int t = 0; t < 3; ++t) { const bf16x8 ah = *(const LAS bf16x8*)((wbuf) + (16 * t + tl) * 128 + so_), al = *(const LAS bf16x8*)((wbuf) + 6144 + (16 * t + tl) * 128 + so_); \
                    f32x4& ac = (t == 0 ? accA : (t == 1 ? accB : accC)); \
                    ac = __builtin_amdgcn_mfma_f32_16x16x32_bf16(ah, bh, ac, 0, 0, 0); ac = __builtin_amdgcn_mfma_f32_16x16x32_bf16(al, bh, ac, 0, 0, 0); } } } while (0)
#define RT_WLOAD(c) do { wr0 = *(const u32x4*)(wsp + wsrc0 + 64 * (c)); if (tid < 256) wr1 = *(const u32x4*)(wsp + wsrc1 + 64 * (c)); } while (0)
#define RT_WSTORE(wbuf) do { *(LAS u32x4*)((wbuf) + wdst0) = wr0; if (tid < 256) *(LAS u32x4*)((wbuf) + wdst1) = wr1; } while (0)
        __syncthreads();
        RT_WLOAD(0); RT_LOADS(hq0, 0); RT_LOADS(hq1, 1); RT_LOADS(hq2, 2);
        RT_WSTORE(WL); RT_WLOAD(1);
        __syncthreads();
#pragma unroll 1
        for (int c = 0; c < D / 64; c += 4) {
            RT_LOADS(hq3, (c + 3));      RT_COMP(hq0, WL, c);             RT_WSTORE(WL + 12288); RT_WLOAD((c + 2) & 31); __syncthreads();
            RT_LOADS(hq0, (c + 4) & 31); RT_COMP(hq1, WL + 12288, c + 1); RT_WSTORE(WL);         RT_WLOAD((c + 3) & 31); __syncthreads();
            RT_LOADS(hq1, (c + 5) & 31); RT_COMP(hq2, WL, c + 2);         RT_WSTORE(WL + 12288); RT_WLOAD((c + 4) & 31); __syncthreads();
            RT_LOADS(hq2, (c + 6) & 31); RT_COMP(hq3, WL + 12288, c + 3); RT_WSTORE(WL);         RT_WLOAD((c + 5) & 31); __syncthreads();
        }
#undef RT_LOADS
#undef RT_COMP
#undef RT_H8
#undef RT_WLOAD
#undef RT_WSTORE
        const int tok = tile * 16 + tl;
        ss += __shfl_xor(ss, 16); ss += __shfl_xor(ss, 32);
        const float rr = rsqrtf(ss * (1.0f / D) + EPS);
        const float myg = accC[0] * rr + brg[g];
        float gl[4];
#pragma unroll
        for (int j = 0; j < 4; ++j) gl[j] = __shfl(myg, tl + 16 * j);
        int gi = 0; float gm = gl[0];
#pragma unroll
        for (int i = 1; i < 4; ++i) if (gl[i] > gm) { gm = gl[i]; gi = i; }
        float den = 0.f;
#pragma unroll
        for (int i = 0; i < 4; ++i) den += __expf(gl[i] - gm);
        const float pg = 1.0f / den;
        int L0 = 0, L1 = 0; float wt0 = 0.f, wt1 = 0.f; const bool owner = (g == gi);
        if (owner) {
            float el[8];
#pragma unroll
            for (int i = 0; i < 4; ++i) { el[i] = accA[i] * rr + bre[g * 8 + i]; el[4 + i] = accB[i] * rr + bre[g * 8 + 4 + i]; }
            int e0 = 0; float v0 = el[0];
#pragma unroll
            for (int i = 1; i < 8; ++i) if (el[i] > v0) { v0 = el[i]; e0 = i; }
            int e1 = -1; float v1 = -3.0e38f;
#pragma unroll
            for (int i = 0; i < 8; ++i) if (i != e0 && el[i] > v1) { v1 = el[i]; e1 = i; }
            const float ex = __expf(v1 - v0); const float s0 = 1.0f / (1.0f + ex), s1 = ex * s0;
            r2[tok] = rr; L0 = gi * 8 + e0; L1 = gi * 8 + e1; wt0 = pg * s0; wt1 = pg * s1;
        }
        LAS int* cl = (LAS int*)(lds + 61440);
        if (tid < 32) cl[tid] = 0;
        __syncthreads();
        int q0 = 0, q1 = 0;
        if (owner) { q0 = __hip_atomic_fetch_add(&cl[L0], 1, __ATOMIC_RELAXED, __HIP_MEMORY_SCOPE_WORKGROUP); q1 = __hip_atomic_fetch_add(&cl[L1], 1, __ATOMIC_RELAXED, __HIP_MEMORY_SCOPE_WORKGROUP); }
        __syncthreads();
        if (tid < 32) { const int n = cl[tid]; cl[32 + tid] = n ? atomicAdd(&cnt[tid], n) : 0; }
        __syncthreads();
        if (owner) { const int p0 = cl[32 + L0] + q0, p1 = cl[32 + L1] + q1;
            float* r2l = (float*)(p.ws + WS_R2L);
            tokl[(size_t)L0 * T + p0] = tok; r2l[(size_t)L0 * T + p0] = rr; recc[2 * tok] = L0 * 32768 + p0; recw[2 * tok] = wt0;
            tokl[(size_t)L1 * T + p1] = tok; r2l[(size_t)L1 * T + p1] = rr; recc[2 * tok + 1] = L1 * 32768 + p1; recw[2 * tok + 1] = wt1; }
    }
    __syncthreads();
}

__device__ __forceinline__ void build_tiles(const Params& p, LAS int* tab) {
    __syncthreads();
    if (threadIdx.x < 64) { const int L = threadIdx.x; const int c = L < 32 ? ((const int*)(p.ws + WS_CNT))[L] : 0; const int nt = (c + 255) >> 8;
        int pre = nt;
#pragma unroll
        for (int o = 1; o < 32; o <<= 1) { const int v = __shfl_up(pre, o); if (L >= o) pre += v; }
        const int first = pre - nt;
        if (L < 32) { tab[1400 + L] = first * 256; for (int i = 0; i < nt; ++i) { tab[4 + (first + i) * 4 + 0] = L; tab[4 + (first + i) * 4 + 1] = i * 256; tab[4 + (first + i) * 4 + 2] = (first + i) * 256; tab[4 + (first + i) * 4 + 3] = min(256, c - i * 256); } }
        if (L == 31) tab[0] = pre; }
    __syncthreads();
}
template <int NPN> struct MoeOrder { int G, c, t_lo, nt_tiles; const LAS int* tab;
    __device__ __forceinline__ bool unit(int i, Unit& u) const { const long L = (long)i * G + c; if (L >= (long)nt_tiles * NPN) return false;
        const int nwg = nt_tiles * NPN; int wgid = (int)L; { const int q = nwg / 8, r = nwg % 8, xcd = wgid % 8, off = wgid / 8; wgid = (xcd < r ? xcd * (q + 1) : r * (q + 1) + (xcd - r) * q) + off; }
        u.pm = t_lo + wgid / NPN; u.pn = wgid % NPN; u.aux = 0; return true; } };
struct GateUpSched { MoeOrder<4> o; const unsigned char* hb; const unsigned char* WguT; const int* tokl;
    __device__ __forceinline__ bool next(int i, Unit& u) const { return o.unit(i, u); }
    __device__ __forceinline__ const char* a_base(const Unit&) const { return (const char*)hb; }
    __device__ __forceinline__ const char* b_base(const Unit& u) const { const int e = o.tab[4 + u.pm * 4] & 31; return (const char*)(WguT + (size_t)(e * 1024 + u.pn * 256) * D); }
    __device__ __forceinline__ bool keep_acc(const Unit&) const { return false; }
    __device__ __forceinline__ void a_offs(const Unit& u, int R0, int C0, int R1, int C1, unsigned (&v)[2][2]) const {
        const int L = o.tab[4 + u.pm * 4], row0 = o.tab[4 + u.pm * 4 + 1], nrows = o.tab[4 + u.pm * 4 + 3]; const int* lst = tokl + (size_t)L * T + row0;
#pragma unroll
        for (int h = 0; h < 2; ++h) { const int r0 = R0 + 128 * h, r1 = R1 + 128 * h; const int t0 = r0 < nrows ? lst[r0] : 0, t1 = r1 < nrows ? lst[r1] : 0;
            v[h][0] = (unsigned)t0 * D + C0 * 2u; v[h][1] = (unsigned)t1 * D + C1 * 2u; } }
};
struct EpiGateUp { const LAS int* tab; const float* r2l; unsigned char* he;
    __device__ __forceinline__ void operator()(f32x4 (&acc)[2][2][4][2], const Unit& u, int wr, int wc, int fr, int fq) const {
        const int L = tab[4 + u.pm * 4], row0 = tab[4 + u.pm * 4 + 1], slot = tab[4 + u.pm * 4 + 2], nrows = tab[4 + u.pm * 4 + 3];
#pragma unroll
        for (int ai = 0; ai < 2; ++ai)
#pragma unroll
            for (int m = 0; m < 4; ++m) { const int rr = ai * 128 + wr * 64 + m * 16 + fr; const float rs = rr < nrows ? r2l[(size_t)L * T + row0 + rr] * (1.0f / 64.0f) : 0.f;
                u32x2 w; unsigned ww[2];
#pragma unroll
                for (int n = 0; n < 2; ++n) { float hv[4];
#pragma unroll
                    for (int j = 0; j < 4; ++j) { const float gt = acc[ai][0][m][n][j] * rs, up = acc[ai][1][m][n][j] * rs; hv[j] = gt * sigmoidf_(gt) * up * 4.0f; }
                    ww[n] = pk4_fp8(hv[0], hv[1], hv[2], hv[3]); }
                w.x = ww[0]; w.y = ww[1];
                *(u32x2*)(he + (size_t)(slot + rr) * 512 + u.pn * 128 + wc * 32 + 8 * fq) = w; }
    } };
__device__ __forceinline__ void p6_gateup(const Params& p, LAS unsigned char* lds) {
    LAS int* tab = (LAS int*)(lds + TAB_OFF); build_tiles(p, tab);
    GateUpSched S; S.o.G = gridDim.x; S.o.c = blockIdx.x; S.o.t_lo = 0; S.o.nt_tiles = tab[0]; S.o.tab = tab;
    S.hb = p.ws + WS_H8; S.WguT = p.ws + WS_WGU; S.tokl = (const int*)(p.ws + WS_TOK);
    EpiGateUp E{tab, (const float*)(p.ws + WS_R2L), p.ws + WS_HE};
    pg8::gemm_phase<true, true, GateUpSched, EpiGateUp, true>(lds, S, E, D / 128, D / 2, D / 2);
}
struct DownSched { MoeOrder<8> o; const unsigned char* he; const unsigned char* WdT;
    __device__ __forceinline__ bool next(int i, Unit& u) const { return o.unit(i, u); }
    __device__ __forceinline__ const char* a_base(const Unit&) const { return (const char*)he; }
    __device__ __forceinline__ const char* b_base(const Unit& u) const { const int e = o.tab[4 + u.pm * 4] & 31; return (const char*)(WdT + (size_t)(e * 2048 + u.pn * 256) * 512); }
    __device__ __forceinline__ bool keep_acc(const Unit&) const { return false; }
    __device__ __forceinline__ void a_offs(const Unit& u, int R0, int C0, int R1, int C1, unsigned (&v)[2][2]) const {
        const int slot = o.tab[4 + u.pm * 4 + 2];
#pragma unroll
        for (int h = 0; h < 2; ++h) { v[h][0] = (unsigned)(slot + 128 * h + R0) * 512u + C0 * 2u; v[h][1] = (unsigned)(slot + 128 * h + R1) * 512u + C1 * 2u; } }
};
struct EpiDown { const LAS int* tab; unsigned char* ye;
    __device__ __forceinline__ void operator()(f32x4 (&acc)[2][2][4][2], const Unit& u, int wr, int wc, int fr, int fq) const {
        const int slot = tab[4 + u.pm * 4 + 2];
        unsigned off = (unsigned)(slot + wr * 64 + fr) * 2048 + u.pn * 256 + wc * 32 + 8 * fq;
#pragma unroll
        for (int ai = 0; ai < 2; ++ai) {
#pragma unroll
            for (int m = 0; m < 4; ++m) { asm volatile("" : "+v"(off));
#pragma unroll
                for (int bj = 0; bj < 2; ++bj) { const f32x4 v0 = acc[ai][bj][m][0] * 0.0625f, v1 = acc[ai][bj][m][1] * 0.0625f;
                    u32x2 w; w.x = pk4_fp8(v0[0], v0[1], v0[2], v0[3]); w.y = pk4_fp8(v1[0], v1[1], v1[2], v1[3]);
                    *(u32x2*)(ye + off + bj * 128) = w; }
                off += 16 * 2048; }
            off += 64 * 2048; }
    } };
__device__ __forceinline__ void p7_down(const Params& p, LAS unsigned char* lds) {
    LAS int* tab = (LAS int*)(lds + TAB_OFF); build_tiles(p, tab);
    DownSched S; S.o.G = gridDim.x; S.o.c = blockIdx.x; S.o.t_lo = 0; S.o.nt_tiles = tab[0]; S.o.tab = tab;
    S.he = p.ws + WS_HE; S.WdT = p.ws + WS_WD;
    EpiDown E{tab, p.ws + WS_YE};
    int ntv = 512 / 128; asm volatile("" : "+s"(ntv));
    pg8::gemm_phase<true, true, DownSched, EpiDown, true, false>(lds, S, E, ntv, 256, 256);
}
__device__ __forceinline__ void p8_combine(const Params& p, LAS unsigned char* lds) {
    LAS int* tab = (LAS int*)(lds + TAB_OFF); build_tiles(p, tab);
    const int tid = phase_tid(), lane = tid & 63, wave = tid >> 6; const int gw = blockIdx.x * 8 + wave, NGW = gridDim.x * 8;
    const int* recc = (const int*)(p.ws + WS_RECC); const float* recw = (const float*)(p.ws + WS_RECW); const bf16_t* hb = (const bf16_t*)(p.ws + WS_O);
    const unsigned char* ye = p.ws + WS_YE;
    for (int tok = gw; tok < T; tok += NGW) {
        const int c0 = recc[2 * tok], c1 = recc[2 * tok + 1]; const float wa = recw[2 * tok] * 0.0625f, wb = recw[2 * tok + 1] * 0.0625f;
        const int s0 = tab[1400 + (c0 >> 15)] + (c0 & 32767), s1 = tab[1400 + (c1 >> 15)] + (c1 & 32767);
        f32x4* op = (f32x4*)(p.out + (size_t)tok * D) + lane; const u32x2* hp = (const u32x2*)(hb + (size_t)tok * D) + lane;
        const unsigned* ya = (const unsigned*)(ye + (size_t)s0 * 2048) + lane; const unsigned* yb = (const unsigned*)(ye + (size_t)s1 * 2048) + lane;
        u32x2 m[8]; unsigned a[8], b[8];
#pragma unroll
        for (int j = 0; j < 8; ++j) { m[j] = hp[64 * j]; a[j] = ya[64 * j]; b[j] = yb[64 * j]; }
#pragma unroll
        for (int j = 0; j < 8; ++j) { f32x4 v;
            const f32x2 a0 = __builtin_amdgcn_cvt_pk_f32_fp8(a[j], false), a1 = __builtin_amdgcn_cvt_pk_f32_fp8(a[j], true), b0 = __builtin_amdgcn_cvt_pk_f32_fp8(b[j], false), b1 = __builtin_amdgcn_cvt_pk_f32_fp8(b[j], true);
            v.x = __uint_as_float(m[j].x << 16) + wa * a0.x + wb * b0.x; v.y = __uint_as_float(m[j].x & 0xffff0000u) + wa * a0.y + wb * b0.y;
            v.z = __uint_as_float(m[j].y << 16) + wa * a1.x + wb * b1.x; v.w = __uint_as_float(m[j].y & 0xffff0000u) + wa * a1.y + wb * b1.y;
            op[64 * j] = v; }
    }
}

#define XB_TMO      128
#define XB_XCNT(j)  (256  + 64 * (j))
#define XB_XSUB(j)  (1280 + 64 * (j))
#define XB_XGEN(j)  (2304 + 64 * (j))
#define XB_TOP      3328
#define XB_TOPGEN   3392
#define XCD_BAR_WORDS 3456
#define XB_SPIN_CAP (1u << 18)
__device__ __forceinline__ unsigned xb_ld(unsigned* p)              { return __hip_atomic_load(p, __ATOMIC_RELAXED, __HIP_MEMORY_SCOPE_AGENT); }
__device__ __forceinline__ unsigned xb_add(unsigned* p, unsigned v) { return __hip_atomic_fetch_add(p, v, __ATOMIC_RELAXED, __HIP_MEMORY_SCOPE_AGENT); }
__device__ __forceinline__ unsigned xb_xcc_id() { return (unsigned)__builtin_amdgcn_s_getreg((3 << 11) | 20) & 0xFu; }
#define XB_SPIN(cond, bar) do { unsigned _sp = 0; while (cond) { __builtin_amdgcn_s_sleep(1); \
    if ((++_sp & 255u) == 0u) { if (xb_ld(&(bar)[XB_TMO])) break; if (_sp > XB_SPIN_CAP) { atomicAdd(&(bar)[XB_TMO], 1u); break; } } } } while (0)
struct XcdBarrier { unsigned* bar; unsigned x; volatile LAS unsigned* st; };
__device__ __forceinline__ XcdBarrier xcd_barrier_post(unsigned* bar, volatile LAS unsigned* st) {
    XcdBarrier b; b.bar = bar; b.x = xb_xcc_id(); b.st = st;
    if (threadIdx.x == 0) (void)xb_add(&bar[XB_XCNT(b.x)], 1u);
    return b;
}
__device__ __forceinline__ void xcd_barrier_complete(unsigned* bar, unsigned x, unsigned& nloc, unsigned& nx) {
    const unsigned G = gridDim.x * gridDim.y * gridDim.z;
    unsigned sum, cnt, mine, sp = 0u;
    for (;;) {
        sum = 0u; cnt = 0u; mine = 0u;
#pragma unroll
        for (unsigned j = 0; j < 16; ++j) { const unsigned c = xb_ld(&bar[XB_XCNT(j)]); sum += c; cnt += (c > 0u) ? 1u : 0u; mine = (j == x) ? c : mine; }
        if (sum == G) break;
        __builtin_amdgcn_s_sleep(1);
        if ((++sp & 255u) == 0u) { if (xb_ld(&bar[XB_TMO])) break; if (sp > XB_SPIN_CAP) { atomicAdd(&bar[XB_TMO], 1u); break; } }
    }
    nloc = mine > 0u ? mine : 1u; nx = cnt > 0u ? cnt : 1u;
}
__device__ __forceinline__ void xcd_barrier(const XcdBarrier& b) {
    asm volatile("s_waitcnt vmcnt(0)" ::: "memory");
    __syncthreads();
    if (threadIdx.x == 0) {
        unsigned* bar = b.bar;
        __builtin_amdgcn_s_waitcnt(0);
        unsigned nloc = b.st[0], nx = b.st[1];
        if (nloc == 0u) { xcd_barrier_complete(bar, b.x, nloc, nx); b.st[0] = nloc; b.st[1] = nx; }
        const unsigned old = xb_add(&bar[XB_XSUB(b.x)], 1u);
        const unsigned gen = old / nloc;
        if (old + 1u == (gen + 1u) * nloc) {
            __builtin_amdgcn_fence(__ATOMIC_RELEASE, "agent");
            asm volatile("s_waitcnt vmcnt(0)" ::: "memory");
            const unsigned og = xb_add(&bar[XB_TOP], 1u);
            const unsigned tg = og / nx;
            if (og + 1u == (tg + 1u) * nx) xb_add(&bar[XB_TOPGEN], 1u);
            else XB_SPIN(xb_ld(&bar[XB_TOPGEN]) == tg, bar);
            __builtin_amdgcn_fence(__ATOMIC_ACQUIRE, "agent");
            xb_add(&bar[XB_XGEN(b.x)], 1u);
            asm volatile("s_waitcnt vmcnt(0)" ::: "memory");
        } else {
            XB_SPIN(xb_ld(&bar[XB_XGEN(b.x)]) == gen, bar);
            __builtin_amdgcn_fence(__ATOMIC_ACQUIRE, "agent");
            asm volatile("s_waitcnt vmcnt(0)" ::: "memory");
        }
    }
    __syncthreads();
}

namespace cg = cooperative_groups;
#ifdef PROBE_A
#define STAMP(k) do { if (blockIdx.x == 0 && threadIdx.x == 0) ((unsigned long long*)(p.ws + WS_END))[k] = __builtin_amdgcn_s_memrealtime(); } while (0)
#else
#define STAMP(k) do {} while (0)
#endif
__global__ void __launch_bounds__(512, 2) fwd_megakernel(Params p) {
    extern __shared__ __attribute__((aligned(16))) unsigned char lds_raw[];
    LAS unsigned char* lds = (LAS unsigned char*)lds_raw;
    cg::grid_group grid = cg::this_grid();
    if (threadIdx.x == 0) { *(volatile LAS unsigned*)(lds + XBST_OFF) = 0u; *(volatile LAS unsigned*)(lds + XBST_OFF + 4) = 0u; }
    if (blockIdx.x == 0) for (int i = threadIdx.x; i < XCD_BAR_WORDS; i += 512) ((unsigned*)(p.ws + WS_BAR))[i] = 0u;
    __syncthreads();
#define GSYNC() xcd_barrier(xb)
    STAMP(0);
    p0_prep(p, lds);            grid.sync(); STAMP(1);
    const XcdBarrier xb = xcd_barrier_post((unsigned*)(p.ws + WS_BAR), (volatile LAS unsigned*)(lds + XBST_OFF));
    p1_inproj(p, lds);          GSYNC(); STAMP(2);
    p2_attn(p, lds);            GSYNC(); STAMP(3);
    STAMP(4);
    p3_up(p, lds);              GSYNC(); STAMP(5);
    p4_out(p, lds);             GSYNC(); STAMP(6);
    p5_router(p, lds);          GSYNC(); STAMP(7);
    p6_gateup(p, lds);          GSYNC(); STAMP(8);
    p7_down(p, lds);            GSYNC(); STAMP(9);
    p8_combine(p, lds);
#ifdef PROBE_A
    grid.sync(); STAMP(10); grid.sync();
    {
        const unsigned long long* ts = (const unsigned long long*)(p.ws + WS_END);
        #ifndef PROBE_A1
#define PROBE_A1 (PROBE_A + 1)
#endif
#ifndef PROBE_B1
#define PROBE_B1 (PROBE_B + 1)
#endif
        const float usA = (float)(ts[PROBE_A1] - ts[PROBE_A]) * 0.01f, usB = (float)(ts[PROBE_B1] - ts[PROBE_B]) * 0.01f;
        const float eps = sqrtf(usA * 1e-6f);
        for (size_t i = (size_t)blockIdx.x * 512 + threadIdx.x; i < (size_t)T * D / 4; i += (size_t)gridDim.x * 512) { f32x4 v = ((f32x4*)p.out)[i]; v = v * (1.0f + eps); if (i == 0) v.x += usB * 0.1f; ((f32x4*)p.out)[i] = v; }
    }
#endif
}

extern "C" void kernel_launch(void* const* d_in, const int* in_sizes, int n_in, void* d_out, int out_size, void* d_ws, size_t ws_size, hipStream_t stream) {
    static int grid_blocks = 0;
    if (!grid_blocks) {
        if (n_in != 21 || out_size != T * D || ws_size < WS_TOP) { fprintf(stderr, "kernel_launch: unexpected problem (n_in %d out %d ws %zu)\n", n_in, out_size, ws_size); grid_blocks = -1; return; }
        if (hipFuncSetAttribute((const void*)fwd_megakernel, hipFuncAttributeMaxDynamicSharedMemorySize, LDS_BYTES) != hipSuccess) { fprintf(stderr, "kernel_launch: hipFuncSetAttribute failed\n"); grid_blocks = -1; return; }
        int dev = 0, cus = 0, per_cu = 0;
        hipGetDevice(&dev); hipDeviceGetAttribute(&cus, hipDeviceAttributeMultiprocessorCount, dev);
        hipOccupancyMaxActiveBlocksPerMultiprocessor(&per_cu, (const void*)fwd_megakernel, 512, LDS_BYTES);
        if (per_cu < 1 || cus < 1) { fprintf(stderr, "kernel_launch: occupancy query gave %d blocks/CU on %d CUs\n", per_cu, cus); grid_blocks = -1; return; }
        grid_blocks = cus;
    }
    if (grid_blocks < 0) return;
    Params p{};
    for (int i = 0; i < 21; ++i) p.in[i] = (const float*)d_in[i];
    p.out = (float*)d_out; p.ws = (unsigned char*)d_ws;
    void* args[] = {&p};
    hipError_t e = hipLaunchCooperativeKernel((const void*)fwd_megakernel, dim3(grid_blocks), dim3(512), args, LDS_BYTES, stream);
    if (e != hipSuccess) fprintf(stderr, "cooperative launch failed: %s (grid %d)\n", hipGetErrorString(e), grid_blocks);
}
```

```cpp
#include <hip/hip_runtime.h>
#include <hip/hip_cooperative_groups.h>
#include <cstdio>
#include <cstdint>

#define LAS __attribute__((address_space(3)))
typedef unsigned short bf16_t;
typedef short bf16x8 __attribute__((ext_vector_type(8)));
typedef short s16x4 __attribute__((ext_vector_type(4)));
typedef float f32x4 __attribute__((ext_vector_type(4)));
typedef unsigned u32x4 __attribute__((ext_vector_type(4)));
typedef unsigned u32x2 __attribute__((ext_vector_type(2)));
typedef short v4i16_t __attribute__((ext_vector_type(4)));

namespace cfg {
constexpr int T = 32768, D = 2048, SEQ = 16384;
constexpr int NQKV = 4608, NGATE = 4096, NIN = 8704;
constexpr size_t MiB = 1ull << 20;
constexpr size_t WS_XB = 0, WS_QKV = 128 * MiB, WS_GATES = 416 * MiB, WS_O = 672 * MiB, WS_WIN = 800 * MiB, WS_WUP = 834 * MiB, WS_WOUT = 842 * MiB, WS_MISC = 850 * MiB;
constexpr size_t WS_WGU = 872 * MiB, WS_WD = 936 * MiB, WS_MG = WS_QKV, WS_HE = WS_QKV + 192 * MiB;
constexpr size_t WS_R1 = WS_MISC, WS_R2 = WS_R1 + (size_t)T * 4, WS_WRT = WS_R2 + (size_t)T * 4, WS_CNT = WS_WRT + 512 * 1024, WS_TOK = WS_CNT + 4096,
                 WS_RECC = WS_TOK + 32ull * T * 4, WS_RECW = WS_RECC + 2ull * T * 4, WS_R2L = WS_RECW + 2ull * T * 4, WS_END = WS_R2L + 32ull * T * 4;
constexpr size_t WS_H8 = WS_GATES + 144 * MiB;
constexpr size_t WS_YE = WS_QKV;
constexpr size_t WS_BAR = WS_END + 4096;
constexpr size_t WS_X8 = 872 * MiB;
constexpr size_t WS_O8 = WS_O + 64 * MiB;
constexpr size_t WS_TOP = 1000 * MiB;
constexpr int LDS_BYTES = 140 * 1024;
constexpr int XBST_OFF = LDS_BYTES - 16;
constexpr int TAB_OFF = 132 * 1024;
constexpr float EPS = 1e-6f;
}
using namespace cfg;

struct Params { const float* in[21]; float* out; unsigned char* ws; };
__device__ __forceinline__ int phase_tid() { int t = threadIdx.x; asm volatile("" : "+v"(t)); return t; }

__device__ __forceinline__ float bf2f(short s) { return __uint_as_float(((unsigned)(unsigned short)s) << 16); }
typedef float f32x2 __attribute__((ext_vector_type(2)));
typedef __bf16 bf16x2_t __attribute__((ext_vector_type(2)));
__device__ __forceinline__ unsigned pk2(float lo, float hi) { const f32x2 v = {lo, hi}; return __builtin_bit_cast(unsigned, __builtin_convertvector(v, bf16x2_t)); }
__device__ __forceinline__ unsigned pk4_fp8(float a, float b, float c, float d) { int w = 0; w = __builtin_amdgcn_cvt_pk_fp8_f32(a, b, w, false); w = __builtin_amdgcn_cvt_pk_fp8_f32(c, d, w, true); return (unsigned)w; }
__device__ __forceinline__ float wave_sum(float v) {
#pragma unroll
    for (int o = 1; o < 64; o <<= 1) v += __shfl_xor(v, o);
    return v;
}
__device__ __forceinline__ float sigmoidf_(float v) { return 1.0f / (1.0f + __expf(-v)); }
__device__ __forceinline__ unsigned off_b(unsigned row, unsigned ch) { return 256u * row + 16u * (ch ^ (((row & 3) << 2) | ((row >> 2) & 3))); }
__device__ __forceinline__ s16x4 tr_read(LAS unsigned char* p) { return __builtin_bit_cast(s16x4, __builtin_amdgcn_ds_read_tr16_b64_v4i16((LAS v4i16_t*)p)); }
__host__ __device__ __forceinline__ int perm32(int rho) { const int n = rho >> 4, i = rho & 15; return 8 * (i >> 2) + 4 * n + (i & 3); }
__device__ __forceinline__ int t5_bucket(int rel) {
    const int n = rel < 0 ? -rel : rel; const int ret = rel > 0 ? 16 : 0; int b;
    if (n < 8) b = n; else if (n < 12) b = 8; else if (n < 16) b = 9; else if (n < 23) b = 10; else if (n < 32) b = 11; else if (n < 46) b = 12; else if (n < 64) b = 13; else if (n < 91) b = 14; else b = 15;
    return ret + b;
}

template <bool FP8>
__device__ __forceinline__ void transpose_item(const float* __restrict__ W, int ldw, int k0, int n0, bf16_t* __restrict__ WT, int ldt, int drow0, int dk0, const float* __restrict__ scale, LAS unsigned* scr, int lane, float f8scale = 1.f) {
    const int n4 = (lane & 15) * 4, kk = lane >> 4;
    const float* src = W + (size_t)(k0 + 2 * kk) * ldw + n0 + n4;
    f32x4 ev[8], od[8];
#pragma unroll
    for (int j = 0; j < 8; ++j) { ev[j] = *(const f32x4*)(src + (size_t)(8 * j) * ldw); od[j] = *(const f32x4*)(src + (size_t)(8 * j + 1) * ldw); }
#pragma unroll
    for (int j = 0; j < 8; ++j) { f32x4 e = ev[j], o = od[j];
        if (scale) { const float se = scale[k0 + 8 * j + 2 * kk], so = scale[k0 + 8 * j + 2 * kk + 1]; e = e * se; o = o * so; }
        u32x4 w; w.x = pk2(e.x, o.x); w.y = pk2(e.y, o.y); w.z = pk2(e.z, o.z); w.w = pk2(e.w, o.w);
        *(LAS u32x4*)(scr + (4 * j + kk) * 68 + n4) = w; }
    asm volatile("s_waitcnt lgkmcnt(0)" ::: "memory");
    const int kq = lane & 7;
#pragma unroll
    for (int i = 0; i < 8; ++i) { const int n = (lane >> 3) + 8 * i; const LAS unsigned* q = scr + (4 * kq) * 68 + n;
        u32x4 o; o.x = q[0]; o.y = q[68]; o.z = q[136]; o.w = q[204];
        if (FP8) { u32x2 f; f.x = pk4_fp8(__uint_as_float(o.x << 16) * f8scale, __uint_as_float(o.x & 0xffff0000u) * f8scale, __uint_as_float(o.y << 16) * f8scale, __uint_as_float(o.y & 0xffff0000u) * f8scale);
            f.y = pk4_fp8(__uint_as_float(o.z << 16) * f8scale, __uint_as_float(o.z & 0xffff0000u) * f8scale, __uint_as_float(o.w << 16) * f8scale, __uint_as_float(o.w & 0xffff0000u) * f8scale);
            *(u32x2*)((unsigned char*)WT + (size_t)(drow0 + n) * ldt + dk0 + k0 + 8 * kq) = f; }
        else *(u32x4*)(WT + (size_t)(drow0 + n) * ldt + dk0 + k0 + 8 * kq) = o; }
    asm volatile("s_waitcnt lgkmcnt(0)" ::: "memory");
}

__device__ __forceinline__ void p0_prep(const Params& p, LAS unsigned char* lds) {
    const int tid = phase_tid(), lane = tid & 63, wave = tid >> 6;
    const int gw = blockIdx.x * 8 + wave, NGW = gridDim.x * 8;
    LAS unsigned* scr = (LAS unsigned*)(lds + wave * 8704);
    const float* x = p.in[0]; const float* g1 = p.in[1]; const float* w_in = p.in[2];
    bf16_t* xb = (bf16_t*)(p.ws + WS_XB); float* r1 = (float*)(p.ws + WS_R1);
    bf16_t* WinT = (bf16_t*)(p.ws + WS_WIN); bf16_t* WupT = (bf16_t*)(p.ws + WS_WUP); bf16_t* WoutT = (bf16_t*)(p.ws + WS_WOUT);
    constexpr int I_WIN = 32 * 136, I_UP = 16 * 32, I_OUT = 32 * 32, NITEMS = I_WIN + 2 * I_UP + I_OUT;
    for (int it = gw; it < NITEMS; it += NGW) {
        int r = it;
        if (r < I_WIN) { const int kb = r / 136, nb = r % 136; const int n0 = nb * 64;
            int drow = n0;
            if (n0 >= NQKV) { const int c = (n0 - NQKV) & 2047, isb = (n0 - NQKV) >> 11; drow = NQKV + (c >> 7) * 256 + isb * 128 + (c & 127); }
            transpose_item<true>(w_in, NIN, kb * 64, n0, WinT, 2048, drow, 0, g1, scr, lane, 64.f); continue; } r -= I_WIN;
        if (r < I_UP) { const int kb = r / 32, nb = r % 32; transpose_item<true>(p.in[9], 2048, kb * 64, nb * 64, WupT, 2048, nb * 64, 0, nullptr, scr, lane, 64.f); continue; } r -= I_UP;
        if (r < I_UP) { const int kb = r / 32, nb = r % 32; transpose_item<true>(p.in[10], 2048, kb * 64, nb * 64, WupT, 2048, nb * 64, 1024, nullptr, scr, lane, 64.f); continue; } r -= I_UP;
        { const int kb = r / 32, nb = r % 32; transpose_item<true>(p.in[11], 2048, kb * 64, nb * 64, WoutT, 2048, nb * 64, 0, nullptr, scr, lane, 64.f); }
    }
    { bf16_t* whi = (bf16_t*)(p.ws + WS_WRT); bf16_t* wlo = whi + 48 * 2048; const float* g2 = p.in[13]; const float* wrg = p.in[14]; const float* wre = p.in[16];
      for (int i = blockIdx.x * 512 + tid; i < 48 * 2048; i += gridDim.x * 512) { const int row = i >> 11, k = i & 2047, t = row >> 4, r = row & 15; float w;
          if (t == 0) w = wre[k * 32 + (r >> 2) * 8 + (r & 3)]; else if (t == 1) w = wre[k * 32 + (r >> 2) * 8 + 4 + (r & 3)]; else w = (r & 3) == 0 ? wrg[k * 4 + (r >> 2)] : 0.f;
          w *= g2[k]; const unsigned hi = pk2(w, 0.f) & 0xffffu; const float hf = __uint_as_float(hi << 16); whi[i] = (bf16_t)hi; wlo[i] = (bf16_t)(pk2(w - hf, 0.f) & 0xffffu); } }
    if (blockIdx.x == 0 && tid < 33) ((int*)(p.ws + WS_CNT))[tid] = 0;
    for (int row0 = 2 * gw; row0 < T; row0 += 2 * NGW) {
        f32x4 v[2][8]; float ss[2] = {0.f, 0.f};
#pragma unroll
        for (int u = 0; u < 2; ++u) { const f32x4* xr = (const f32x4*)(x + (size_t)(row0 + u) * D) + lane;
#pragma unroll
            for (int j = 0; j < 8; ++j) v[u][j] = xr[64 * j]; }
#pragma unroll
        for (int u = 0; u < 2; ++u) {
#pragma unroll
            for (int j = 0; j < 8; ++j) ss[u] += (v[u][j].x * v[u][j].x + v[u][j].y * v[u][j].y) + (v[u][j].z * v[u][j].z + v[u][j].w * v[u][j].w);
            ss[u] = wave_sum(ss[u]);
            if (lane == 0) r1[row0 + u] = rsqrtf(ss[u] * (1.0f / D) + EPS);
            u32x2* o = (u32x2*)(xb + (size_t)(row0 + u) * D) + lane; unsigned* o8 = (unsigned*)(p.ws + WS_X8 + (size_t)(row0 + u) * D) + lane;
#pragma unroll
            for (int j = 0; j < 8; ++j) { u32x2 w; w.x = pk2(v[u][j].x, v[u][j].y); w.y = pk2(v[u][j].z, v[u][j].w); o[64 * j] = w; o8[64 * j] = pk4_fp8(v[u][j].x, v[u][j].y, v[u][j].z, v[u][j].w); } }
    }
}

constexpr int MOE_ITEMS = 2 * 32 * 32 * 8;
__device__ __forceinline__ void moe_prep_batch(const Params& p, LAS unsigned char* lds, int bi) {
    const int tid = phase_tid(), lane = tid & 63, wave = tid >> 6;
    LAS unsigned* scr = (LAS unsigned*)(lds + wave * 8704);
    const float* g2 = p.in[13];
    bf16_t* WguT = (bf16_t*)(p.ws + WS_WGU);
    constexpr int I_G = 32 * 32 * 8;
    int r = (bi * (int)gridDim.x + (int)blockIdx.x) * 8 + wave;
    if (r >= MOE_ITEMS) return;
    const int which = r >= I_G; if (which) r -= I_G; const int e = r / 256, rr = r % 256, kb = rr / 8, nb = rr % 8;
    const float* W = p.in[which ? 19 : 18] + (size_t)e * 2048 * 512; const int n0 = nb * 64;
    transpose_item<true>(W, 512, kb * 64, n0, WguT, 2048, e * 1024 + (n0 >> 7) * 256 + which * 128 + (n0 & 127), 0, g2, scr, lane, 64.f);
}
constexpr int WD_BATCHES = 32 * 8 * 32 / 8;
__device__ __forceinline__ void wd_prep_batch(const Params& p, LAS unsigned char* lds, int b) {
    const int tid = phase_tid(), lane = tid & 63, wave = tid >> 6;
    LAS unsigned* scr = (LAS unsigned*)(lds + wave * 8704);
    bf16_t* WdT = (bf16_t*)(p.ws + WS_WD);
    const int r = b * 8 + wave; const int e = r / 256, rr = r % 256, kb = rr / 32, nb = rr % 32; const float* W = p.in[20] + (size_t)e * 512 * 2048;
    transpose_item<true>(W, 2048, kb * 64, nb * 64, WdT, 512, e * 2048 + nb * 64, 0, nullptr, scr, lane, 64.f);
}

struct Unit { int pm, pn, aux; };
namespace pg8 {
constexpr int BM = 256, BK = 64, HALF = 128, HTB = HALF * BK * 2, STAGE_BYTES = 8 * HTB;
__device__ __forceinline__ int lds_byte(int r, int c) { const int st = (r >> 4) * 2 + (c >> 5), rr = r & 15, cc = c & 31, ob = rr * 64 + cc * 2; return st * 1024 + (ob ^ (((ob >> 9) & 1) << 5)); }
__device__ __forceinline__ void stage_rc(int b, int& R, int& C) { const int st = b / 1024, sb = b % 1024, swz = sb ^ (((sb >> 9) & 1) << 5); R = (st >> 1) * 16 + swz / 64; C = (st & 1) * 32 + (swz % 64) / 2; }

template <bool PERM, bool GATHER, class Sched, class Epi, bool FP8 = false, bool ALIGN_EPI = true>
__device__ __forceinline__ void gemm_phase(LAS unsigned char* lds, const Sched& S, const Epi& E, const int nt, const int lda, const int ldb) {
    int tid_ = threadIdx.x; asm volatile("" : "+v"(tid_));
    const int tid = tid_, wid = __builtin_amdgcn_readfirstlane(tid >> 6), lane = tid & 63, wr = wid >> 2, wc = wid & 3, fr = lane & 15, fq = lane >> 4;
    int R0, C0, R1, C1; stage_rc(tid * 16, R0, C0); stage_rc(tid * 16 + 8192, R1, C1);
    unsigned voffB[2], voffA[2][2];
    { const int Rb0 = PERM ? ((R0 & ~31) + perm32(R0 & 31)) : R0, Rb1 = PERM ? ((R1 & ~31) + perm32(R1 & 31)) : R1;
      voffB[0] = (unsigned)(Rb0 * ldb + C0) * 2u; voffB[1] = (unsigned)(Rb1 * ldb + C1) * 2u; }
    const size_t kstep = (size_t)(BK * 2);
    const size_t hstepB = (size_t)HALF * ldb * 2, hstepA = (size_t)HALF * lda * 2;
    const unsigned ldsw = (unsigned)wid * 1024u;
    const int aoff = lds_byte(wr * 64 + fr, fq * 8), boff = lds_byte(wc * 32 + fr, fq * 8);
#define PG8_SA(b, h) (((b) * 2 + (h)) * HTB)
#define PG8_SB(b, h) ((4 + (b) * 2 + (h)) * HTB)
#define PG8_STAGE_B(bufoff, gbase) do { _Pragma("unroll") for (int _i = 0; _i < 2; ++_i) \
        __builtin_amdgcn_global_load_lds((const unsigned*)((const char*)(gbase) + voffB[_i]), (LAS unsigned*)(lds + (bufoff) + ldsw + _i * 8192), 16, 0, 0); } while (0)
#define PG8_STAGE_A(bufoff, gbase, h) do { _Pragma("unroll") for (int _i = 0; _i < 2; ++_i) \
        __builtin_amdgcn_global_load_lds((const unsigned*)((const char*)(gbase) + (GATHER ? (size_t)0 : (size_t)(h) * hstepA) + voffA[GATHER ? (h) : 0][_i]), (LAS unsigned*)(lds + (bufoff) + ldsw + _i * 8192), 16, 0, 0); } while (0)
#define PG8_LDA(dst, b, h) do { _Pragma("unroll") for (int m = 0; m < 4; ++m) _Pragma("unroll") for (int k = 0; k < 2; ++k) dst[m][k] = *(const LAS bf16x8*)(lds + PG8_SA(b, h) + aoff + m * 2048 + k * 1024); } while (0)
#define PG8_LDB(dst, b, h) do { _Pragma("unroll") for (int n = 0; n < 2; ++n) _Pragma("unroll") for (int k = 0; k < 2; ++k) dst[n][k] = *(const LAS bf16x8*)(lds + PG8_SB(b, h) + boff + n * 2048 + k * 1024); } while (0)
#define PG8_MMA(ai, bj, At, Bt) do { __builtin_amdgcn_s_setprio(1); _Pragma("unroll") for (int m = 0; m < 4; ++m) _Pragma("unroll") for (int n = 0; n < 2; ++n) { \
        if (FP8) { typedef int v8i_ __attribute__((ext_vector_type(8))); typedef int v4i_ __attribute__((ext_vector_type(4))); \
            const v4i_ b0_ = __builtin_bit_cast(v4i_, Bt[n][0]), b1_ = __builtin_bit_cast(v4i_, Bt[n][1]), a0_ = __builtin_bit_cast(v4i_, At[m][0]), a1_ = __builtin_bit_cast(v4i_, At[m][1]); \
            const v8i_ bb_ = {b0_[0], b0_[1], b0_[2], b0_[3], b1_[0], b1_[1], b1_[2], b1_[3]}, aa_ = {a0_[0], a0_[1], a0_[2], a0_[3], a1_[0], a1_[1], a1_[2], a1_[3]}; \
            acc[ai][bj][m][n] = __builtin_amdgcn_mfma_scale_f32_16x16x128_f8f6f4(bb_, aa_, acc[ai][bj][m][n], 0, 0, 0, 0x7f7f7f7f, 0, 0x7f7f7f7f); } \
        else { _Pragma("unroll") for (int k = 0; k < 2; ++k) acc[ai][bj][m][n] = __builtin_amdgcn_mfma_f32_16x16x32_bf16(Bt[n][k], At[m][k], acc[ai][bj][m][n], 0, 0, 0); } } \
        __builtin_amdgcn_s_setprio(0); } while (0)
#define PG8_WAIT_V(n) asm volatile("s_waitcnt vmcnt(" #n ")" ::: "memory")
#define PG8_WAIT_L(n) asm volatile("s_waitcnt lgkmcnt(" #n ")" ::: "memory")
#define PG8_BAR __builtin_amdgcn_s_barrier()
#define PG8_SCHED __builtin_amdgcn_sched_barrier(0)
    Unit cur, nxt; int ui = 0;
    __syncthreads();
    if (!S.next(0, cur)) return;
    if (GATHER) S.a_offs(cur, R0, C0, R1, C1, voffA);
    else { voffA[0][0] = (unsigned)(R0 * lda + C0) * 2u; voffA[0][1] = (unsigned)(R1 * lda + C1) * 2u; voffA[1][0] = 0; voffA[1][1] = 0; }
    f32x4 acc[2][2][4][2];
#pragma unroll
    for (int a = 0; a < 2; ++a)
#pragma unroll
        for (int b = 0; b < 2; ++b)
#pragma unroll
            for (int m = 0; m < 4; ++m)
#pragma unroll
                for (int n = 0; n < 2; ++n) acc[a][b][m][n] = (f32x4){0.f, 0.f, 0.f, 0.f};
    bf16x8 At[4][2], B0[2][2], B1[2][2];
    const char* cA = S.a_base(cur); const char* cB = S.b_base(cur);
    PG8_STAGE_B(PG8_SB(0, 0), cB); PG8_STAGE_B(PG8_SB(0, 1), cB + hstepB); PG8_STAGE_A(PG8_SA(0, 0), cA, 0); PG8_STAGE_A(PG8_SA(0, 1), cA, 1);
    if (wr == 1) PG8_BAR;
    PG8_WAIT_V(2); PG8_BAR;
    PG8_STAGE_B(PG8_SB(1, 0), cB + kstep); PG8_STAGE_A(PG8_SA(1, 0), cA + kstep, 0); PG8_STAGE_B(PG8_SB(1, 1), cB + hstepB + kstep);
    PG8_WAIT_V(6); PG8_BAR;
    for (;;) {
        const bool has_next = S.next(ui + 1, nxt);
        const char* nA = has_next ? S.a_base(nxt) : cA; const char* nB = has_next ? S.b_base(nxt) : cB;
        unsigned vn[2][2];
        if (GATHER) { if (has_next) S.a_offs(nxt, R0, C0, R1, C1, vn); else { vn[0][0] = voffA[0][0]; vn[0][1] = voffA[0][1]; vn[1][0] = voffA[1][0]; vn[1][1] = voffA[1][1]; } }
        for (int t = 0; t < nt; t += 2) {
            const bool last = (t == nt - 2);
            const char* a1 = cA + (size_t)(t + 1) * kstep;
            const char* a2 = last ? nA : cA + (size_t)(t + 2) * kstep; const char* b2 = last ? nB : cB + (size_t)(t + 2) * kstep;
            const char* a3 = a2 + kstep; const char* b3 = b2 + kstep;
            PG8_LDB(B0, 0, 0); PG8_LDB(B1, 0, 1); PG8_SCHED; PG8_LDA(At, 0, 0); PG8_STAGE_A(PG8_SA(1, 1), a1, 1);
            if (GATHER) { if (last) { voffA[0][0] = vn[0][0]; voffA[0][1] = vn[0][1]; voffA[1][0] = vn[1][0]; voffA[1][1] = vn[1][1]; } }
            PG8_WAIT_V(8); PG8_WAIT_L(0); PG8_BAR; PG8_MMA(0, 0, At, B0); PG8_MMA(0, 1, At, B1); PG8_BAR; PG8_SCHED;
            PG8_LDA(At, 0, 1); PG8_STAGE_B(PG8_SB(0, 0), b2); PG8_STAGE_B(PG8_SB(0, 1), b2 + hstepB); PG8_STAGE_A(PG8_SA(0, 0), a2, 0);
            PG8_WAIT_V(8); PG8_WAIT_L(0); PG8_BAR; PG8_MMA(1, 0, At, B0); PG8_MMA(1, 1, At, B1); PG8_BAR; PG8_SCHED;
            PG8_LDB(B0, 1, 0); PG8_LDB(B1, 1, 1); PG8_SCHED; PG8_LDA(At, 1, 0); PG8_STAGE_A(PG8_SA(0, 1), a2, 1);
            PG8_WAIT_V(8); PG8_WAIT_L(0); PG8_BAR; PG8_MMA(0, 0, At, B0); PG8_MMA(0, 1, At, B1); PG8_BAR; PG8_SCHED;
            PG8_LDA(At, 1, 1); PG8_STAGE_B(PG8_SB(1, 0), b3); PG8_STAGE_B(PG8_SB(1, 1), b3 + hstepB); PG8_STAGE_A(PG8_SA(1, 0), a3, 0);
            PG8_WAIT_V(8); PG8_WAIT_L(0); PG8_BAR; PG8_MMA(1, 0, At, B0); PG8_MMA(1, 1, At, B1); PG8_BAR; PG8_SCHED;
        }
        if (ALIGN_EPI) { if (wr == 0) PG8_BAR; }
        { int te = threadIdx.x; asm volatile("" : "+v"(te)); E(acc, cur, wr, wc, te & 15, (te & 63) >> 4); }
        if (!has_next) break;
        if (!S.keep_acc(cur)) {
#pragma unroll
        for (int a = 0; a < 2; ++a)
#pragma unroll
            for (int b = 0; b < 2; ++b)
#pragma unroll
                for (int m = 0; m < 4; ++m)
#pragma unroll
                    for (int n = 0; n < 2; ++n) acc[a][b][m][n] = (f32x4){0.f, 0.f, 0.f, 0.f};
        }
        cur = nxt; cA = nA; cB = nB; ++ui;
        if (ALIGN_EPI) { if (wr == 1) PG8_BAR; }
    }
    PG8_WAIT_V(0);
    if (!ALIGN_EPI) { if (wr == 0) PG8_BAR; }
    PG8_BAR;
#undef PG8_SA
#undef PG8_SB
#undef PG8_STAGE_A
#undef PG8_STAGE_B
#undef PG8_LDA
#undef PG8_LDB
#undef PG8_MMA
#undef PG8_WAIT_V
#undef PG8_WAIT_L
#undef PG8_BAR
#undef PG8_SCHED
}
struct TileOrder {
    int nM, nN, nwg, G, c;
    __device__ __forceinline__ void init(int nM_, int nN_, int G_, int c_) { nM = nM_; nN = nN_; nwg = nM * nN; G = G_; c = c_; }
    __device__ __forceinline__ bool tile(int i, int& pm, int& pn) const {
        const long L = (long)i * G + c; if (L >= nwg) return false;
        int wgid = (int)L; { const int q = nwg / 8, r = nwg % 8, xcd = wgid % 8, off = wgid / 8; wgid = (xcd < r ? xcd * (q + 1) : r * (q + 1) + (xcd - r) * q) + off; }
        const int nig = 8 * nN, gid = wgid / nig, fm = gid * 8, gsz = (nM - fm) < 8 ? (nM - fm) : 8;
        pm = fm + ((wgid % nig) % gsz); pn = (wgid % nig) / gsz; return true;
    }
};
struct DenseSched {
    TileOrder o; const bf16_t* A; const bf16_t* Bt; int lda, ldb;
    __device__ __forceinline__ bool next(int i, Unit& u) const { u.aux = 0; return o.tile(i, u.pm, u.pn); }
    __device__ __forceinline__ const char* a_base(const Unit& u) const { return (const char*)(A + (size_t)u.pm * 256 * lda); }
    __device__ __forceinline__ const char* b_base(const Unit& u) const { return (const char*)(Bt + (size_t)u.pn * 256 * ldb); }
    __device__ __forceinline__ bool keep_acc(const Unit&) const { return false; }
    __device__ __forceinline__ void a_offs(const Unit&, int, int, int, int, unsigned (&)[2][2]) const {}
};
}

struct EpiInProj { bf16_t* qkv; const float* r1; const float* gqa; const float* gka; const float* gqb; const float* gkb; LAS float* X;
    __device__ __forceinline__ void operator()(f32x4 (&acc)[2][2][4][2], const Unit& u, int wr, int wc, int fr, int fq) const {
        const int pn = u.pn;
        bf16_t* base = qkv; const int ldc = NQKV; const int colt = pn * 256 + wc * 32 + 8 * fq;
        const float* gain = pn < 4 ? gqa : (pn == 4 ? gka : ((pn >= 6 && pn < 10) ? gqb : ((pn >= 10 && pn < 14) ? gkb : nullptr)));
        if (gain) {
            const float extra = (pn < 4 || (pn >= 6 && pn < 10)) ? 0.08838834764831845f * 1.4426950408889634f : 1.0f;
#pragma unroll
            for (int ai = 0; ai < 2; ++ai)
#pragma unroll
                for (int m = 0; m < 4; ++m)
#pragma unroll
                    for (int bj = 0; bj < 2; ++bj) { const f32x4 a0 = acc[ai][bj][m][0], a1 = acc[ai][bj][m][1];
                        float sq = (a0[0] * a0[0] + a0[1] * a0[1]) + (a0[2] * a0[2] + a0[3] * a0[3]) + (a1[0] * a1[0] + a1[1] * a1[1]) + (a1[2] * a1[2] + a1[3] * a1[3]);
                        sq += __shfl_xor(sq, 16); sq += __shfl_xor(sq, 32);
                        if (fq == 0) X[(ai * 128 + wr * 64 + m * 16 + fr) * 8 + bj * 4 + wc] = sq; }
            asm volatile("s_waitcnt lgkmcnt(0)" ::: "memory"); __builtin_amdgcn_s_barrier(); asm volatile("" ::: "memory");
            const f32x4 g0 = *(const f32x4*)(gain + wc * 32 + 8 * fq), g1 = *(const f32x4*)(gain + wc * 32 + 8 * fq + 4);
#pragma unroll
            for (int ai = 0; ai < 2; ++ai)
#pragma unroll
                for (int m = 0; m < 4; ++m) { const int rl = ai * 128 + wr * 64 + m * 16 + fr; const int row = u.pm * 256 + rl; const float rs = r1[row] * (1.0f / 64.0f); bf16_t* rowp = base + (size_t)row * ldc + colt;
#pragma unroll
                    for (int bj = 0; bj < 2; ++bj) { const f32x4 t = *(const LAS f32x4*)(X + rl * 8 + bj * 4); const float tot = (t[0] + t[1]) + (t[2] + t[3]);
                        const float sc = rs * rsqrtf(rs * rs * tot * (1.0f / 128.0f) + EPS) * extra;
                        const f32x4 v0 = acc[ai][bj][m][0] * sc * g0, v1 = acc[ai][bj][m][1] * sc * g1;
                        u32x4 w; w.x = pk2(v0[0], v0[1]); w.y = pk2(v0[2], v0[3]); w.z = pk2(v1[0], v1[1]); w.w = pk2(v1[2], v1[3]);
                        *(u32x4*)(rowp + bj * 128) = w; } }
            return;
        }
#pragma unroll
        for (int ai = 0; ai < 2; ++ai)
#pragma unroll
            for (int m = 0; m < 4; ++m) { const int row = u.pm * 256 + ai * 128 + wr * 64 + m * 16 + fr; const float rs = r1[row] * (1.0f / 64.0f); bf16_t* rowp = base + (size_t)row * ldc + colt;
#pragma unroll
                for (int bj = 0; bj < 2; ++bj) { const f32x4 v0 = acc[ai][bj][m][0] * rs, v1 = acc[ai][bj][m][1] * rs;
                    u32x4 w; w.x = pk2(v0[0], v0[1]); w.y = pk2(v0[2], v0[3]); w.z = pk2(v1[0], v1[1]); w.w = pk2(v1[2], v1[3]);
                    *(u32x4*)(rowp + bj * 128) = w; } }
    } };
struct GateSched { pg8::TileOrder o; const unsigned char* x8; const unsigned char* W8;
    __device__ __forceinline__ bool next(int i, Unit& u) const { u.aux = 0; return o.tile(i, u.pm, u.pn); }
    __device__ __forceinline__ const char* a_base(const Unit&) const { return (const char*)x8; }
    __device__ __forceinline__ const char* b_base(const Unit& u) const { return (const char*)(W8 + (size_t)(u.pn * 256) * D); }
    __device__ __forceinline__ bool keep_acc(const Unit&) const { return false; }
    __device__ __forceinline__ void a_offs(const Unit& u, int R0, int C0, int R1, int C1, unsigned (&v)[2][2]) const {
#pragma unroll
        for (int h = 0; h < 2; ++h) { v[h][0] = (unsigned)(u.pm * 256 + 128 * h + R0) * D + C0 * 2u; v[h][1] = (unsigned)(u.pm * 256 + 128 * h + R1) * D + C1 * 2u; } }
};
struct EpiGates { bf16_t* gates; const float* r1;
    __device__ __forceinline__ void operator()(f32x4 (&acc)[2][2][4][2], const Unit& u, int wr, int wc, int fr, int fq) const {
        const int cg = u.pn * 128 + wc * 32 + 8 * fq;
#pragma unroll
        for (int ai = 0; ai < 2; ++ai)
#pragma unroll
            for (int m = 0; m < 4; ++m) { const int row = u.pm * 256 + ai * 128 + wr * 64 + m * 16 + fr; const float rs = r1[row] * (1.0f / 64.0f); bf16_t* rowp = gates + (size_t)row * NGATE + cg;
                float ra[8], sb[8];
#pragma unroll
                for (int n = 0; n < 2; ++n)
#pragma unroll
                    for (int j = 0; j < 4; ++j) { const float ea = __expf(-acc[ai][0][m][n][j] * rs), eb = fminf(__expf(-acc[ai][1][m][n][j] * rs), 1e30f);
                        sb[4 * n + j] = __builtin_amdgcn_rcpf(1.0f + eb); ra[4 * n + j] = (1.0f + eb) * __builtin_amdgcn_rcpf(1.0f + ea); }
                u32x4 w; w.x = pk2(ra[0], ra[1]); w.y = pk2(ra[2], ra[3]); w.z = pk2(ra[4], ra[5]); w.w = pk2(ra[6], ra[7]); *(u32x4*)rowp = w;
                w.x = pk2(sb[0], sb[1]); w.y = pk2(sb[2], sb[3]); w.z = pk2(sb[4], sb[5]); w.w = pk2(sb[6], sb[7]); *(u32x4*)(rowp + 2048) = w; }
    } };
__device__ __forceinline__ void p1_inproj(const Params& p, LAS unsigned char* lds) {
    { GateSched S; S.o.init(128, 18, gridDim.x, blockIdx.x); S.x8 = p.ws + WS_X8; S.W8 = p.ws + WS_WIN;
      EpiInProj E{(bf16_t*)(p.ws + WS_QKV), (const float*)(p.ws + WS_R1), p.in[3], p.in[4], p.in[6], p.in[7], (LAS float*)(lds + 131072)};
      pg8::gemm_phase<true, true, GateSched, EpiInProj, true>(lds, S, E, D / 128, D / 2, D / 2); }
    { GateSched S; S.o.init(128, 16, gridDim.x, blockIdx.x); S.x8 = p.ws + WS_X8; S.W8 = p.ws + WS_WIN + (size_t)NQKV * D;
      EpiGates E{(bf16_t*)(p.ws + WS_GATES), (const float*)(p.ws + WS_R1)};
      pg8::gemm_phase<true, true, GateSched, EpiGates, true>(lds, S, E, D / 128, D / 2, D / 2); }
}

__device__ __forceinline__ void wait_vm(int n) {
    switch (n) { case 0: asm volatile("s_waitcnt vmcnt(0)" ::: "memory"); break; case 2: asm volatile("s_waitcnt vmcnt(2)" ::: "memory"); break; case 4: asm volatile("s_waitcnt vmcnt(4)" ::: "memory"); break;
                 case 6: asm volatile("s_waitcnt vmcnt(6)" ::: "memory"); break; case 8: asm volatile("s_waitcnt vmcnt(8)" ::: "memory"); break; case 10: asm volatile("s_waitcnt vmcnt(10)" ::: "memory"); break;
                 default: asm volatile("s_waitcnt vmcnt(12)" ::: "memory"); break; }
}
__device__ __forceinline__ void glds16_asm(const void* gsrc, unsigned lds_dst) {
    unsigned keep;
    asm volatile("s_mov_b32 %0, m0\n\ts_mov_b32 m0, %2\n\ts_nop 0\n\tglobal_load_lds_dwordx4 %1, off\n\ts_mov_b32 m0, %0" : "=&s"(keep) : "v"(gsrc), "s"(lds_dst) : "memory");
}
#define ATT_BAR() do { asm volatile("s_waitcnt lgkmcnt(0)" ::: "memory"); __builtin_amdgcn_s_barrier(); asm volatile("" ::: "memory"); } while (0)
__device__ __forceinline__ void load_q(const bf16_t* qp, int g, bf16x8 (&qf)[4]) {
#pragma unroll
    for (int ks = 0; ks < 4; ++ks) qf[ks] = *(const bf16x8*)(qp + 32 * ks + 8 * g);
#pragma unroll
    for (int ks = 0; ks < 4; ++ks) asm volatile("" : "+v"(qf[ks]));
}
__device__ __forceinline__ bf16x8 vt_frag(LAS unsigned char* base, int row0, int g, int q4, int pp, int dt) {
    const s16x4 lo = tr_read(base + off_b(row0 + 4 * g + q4, 2 * dt + (pp >> 1)) + 8 * (pp & 1)), hi = tr_read(base + off_b(row0 + 16 + 4 * g + q4, 2 * dt + (pp >> 1)) + 8 * (pp & 1));
    bf16x8 vf; vf[0] = lo[0]; vf[1] = lo[1]; vf[2] = lo[2]; vf[3] = lo[3]; vf[4] = hi[0]; vf[5] = hi[1]; vf[6] = hi[2]; vf[7] = hi[3]; return vf;
}

__device__ __forceinline__ void attn_window_item(const Params& p, LAS unsigned char* lds, int item, int& tab_head) {
    const int tid = phase_tid(), lane = tid & 63, w = __builtin_amdgcn_readfirstlane(tid >> 6), g = lane >> 4, ql = lane & 15;
    const int b = item >> 9, nb = (item >> 2) & 127, hpq = item & 3, kv = hpq >> 1, hq0 = 2 * hpq;
    const bf16_t* qkv = (const bf16_t*)(p.ws + WS_QKV); unsigned char* o = p.ws + WS_O8;
    LAS float* bias = (LAS float*)(lds + 131072); const unsigned ldsb = (unsigned)(size_t)lds;
    const unsigned loff = (unsigned)(w * 4 + g) * NQKV + (unsigned)((ql ^ ((g << 2) | (w & 3))) * 8);
    const bf16_t* kbase = qkv + (size_t)(b * SEQ) * NQKV + 1024 + kv * 128;
#define WIN_ISSUE(c) do { const int _c = (c); const int _kb = min(max(nb - 1 + (_c % 3), 0), 127); const bf16_t* _src = kbase + (size_t)(_kb * 128) * NQKV + (_c >= 3 ? 256 : 0) + loff; \
        _Pragma("unroll") for (int _i = 0; _i < 4; ++_i) glds16_asm(_src + (size_t)(32 * _i) * NQKV, ldsb + (unsigned)((_c & 3) * 32768 + _i * 8192 + w * 1024)); } while (0)
    ATT_BAR();
    WIN_ISSUE(0); WIN_ISSUE(1); WIN_ISSUE(2);
    if (hpq != tab_head) { for (int i = tid; i < 2 * 257; i += 512) { const int hh = i >= 257, j = i - 257 * hh; bias[hh * 264 + j] = p.in[12][t5_bucket(j - 128) * 8 + hq0 + hh] * 1.4426950408889634f; } tab_head = hpq; }
    const int tq = b * SEQ + nb * 128 + 16 * w + ql;
    bf16x8 qf[2][4]; load_q(qkv + (size_t)tq * NQKV + hq0 * 128, g, qf[0]); load_q(qkv + (size_t)tq * NQKV + (hq0 + 1) * 128, g, qf[1]);
    float sink[2]; sink[0] = p.in[5][hq0] * 1.4426950408889634f; sink[1] = p.in[5][hq0 + 1] * 1.4426950408889634f; asm volatile("" : "+v"(sink[0]), "+v"(sink[1]));
    f32x4 S1[2][8], SC[2][9];
#pragma unroll
    for (int u = 0; u < 2; ++u) {
#pragma unroll
        for (int kt = 0; kt < 8; ++kt) S1[u][kt] = (f32x4){0.f, 0.f, 0.f, 0.f};
#pragma unroll
        for (int s = 0; s < 9; ++s) SC[u][s] = (f32x4){0.f, 0.f, 0.f, 0.f}; }
    const bool in0 = nb > 0, in2 = nb < 127;
#pragma unroll
    for (int c = 0; c < 3; ++c) {
        wait_vm(8); ATT_BAR(); WIN_ISSUE(c + 3);
        LAS unsigned char* buf = lds + (c & 3) * 32768;
#pragma unroll
        for (int kt = 0; kt < 8; ++kt) {
            const bool act = (c == 1) || (c == 0 ? kt >= w : kt <= w);
            if (act) {
#pragma unroll
                for (int ks = 0; ks < 4; ++ks) { const bf16x8 kf = *(const LAS bf16x8*)(buf + off_b(16 * kt + ql, 4 * ks + g));
#pragma unroll
                    for (int u = 0; u < 2; ++u) {
                        if (c == 1) S1[u][kt] = __builtin_amdgcn_mfma_f32_16x16x32_bf16(kf, qf[u][ks], S1[u][kt], 0, 0, 0);
                        else if (c == 0) SC[u][7 - kt] = __builtin_amdgcn_mfma_f32_16x16x32_bf16(kf, qf[u][ks], SC[u][7 - kt], 0, 0, 0);
                        else SC[u][8 - kt] = __builtin_amdgcn_mfma_f32_16x16x32_bf16(kf, qf[u][ks], SC[u][8 - kt], 0, 0, 0); } } }
        }
    }
    const int qi = 16 * w + ql; float inv[2];
    unsigned P1[2][4][4], PC[2][9][2];
#pragma unroll
    for (int u = 0; u < 2; ++u) { float mx = sink[u]; const LAS float* bt = bias + u * 264;
#pragma unroll
        for (int kt = 0; kt < 8; ++kt)
#pragma unroll
            for (int r = 0; r < 4; ++r) { const int rel = 16 * kt + 4 * g + r - qi; const float sv = S1[u][kt][r] + bt[rel + 128]; S1[u][kt][r] = sv; mx = fmaxf(mx, sv); }
#pragma unroll
        for (int s = 0; s < 9; ++s) { const bool c0 = s <= 7 - w; const int kt = c0 ? 7 - s : 8 - s; const int cofs = c0 ? -128 : 128; const bool inr = c0 ? in0 : in2;
#pragma unroll
            for (int r = 0; r < 4; ++r) { const int rel = cofs + 16 * kt + 4 * g + r - qi; const bool valid = inr && rel >= -128 && rel <= 128;
                const float bv = bt[rel + 128];
                const float sv = valid ? SC[u][s][r] + bv : -1e30f; SC[u][s][r] = sv; mx = fmaxf(mx, sv); } }
        mx = fmaxf(mx, __shfl_xor(mx, 16)); mx = fmaxf(mx, __shfl_xor(mx, 32));
        float l = 0.f;
#pragma unroll
        for (int kk = 0; kk < 4; ++kk) { float e[8];
#pragma unroll
            for (int r = 0; r < 4; ++r) { e[r] = __builtin_amdgcn_exp2f(S1[u][2 * kk][r] - mx); e[4 + r] = __builtin_amdgcn_exp2f(S1[u][2 * kk + 1][r] - mx); l += e[r] + e[4 + r]; }
            P1[u][kk][0] = pk2(e[0], e[1]); P1[u][kk][1] = pk2(e[2], e[3]); P1[u][kk][2] = pk2(e[4], e[5]); P1[u][kk][3] = pk2(e[6], e[7]); }
#pragma unroll
        for (int s = 0; s < 9; ++s) { float e[4];
#pragma unroll
            for (int r = 0; r < 4; ++r) { e[r] = __builtin_amdgcn_exp2f(SC[u][s][r] - mx); l += e[r]; }
            PC[u][s][0] = pk2(e[0], e[1]); PC[u][s][1] = pk2(e[2], e[3]); }
        l += __shfl_xor(l, 16); l += __shfl_xor(l, 32); l += __builtin_amdgcn_exp2f(sink[u] - mx);
        inv[u] = 1.0f / l; }
    f32x4 O[2][8];
#pragma unroll
    for (int u = 0; u < 2; ++u)
#pragma unroll
        for (int dt = 0; dt < 8; ++dt) O[u][dt] = (f32x4){0.f, 0.f, 0.f, 0.f};
    const int q4 = ql >> 2, pp = ql & 3;
#pragma unroll
    for (int c = 0; c < 3; ++c) {
        wait_vm(c == 0 ? 8 : (c == 1 ? 4 : 0)); ATT_BAR();
        LAS unsigned char* buf = lds + ((c + 3) & 3) * 32768;
#pragma unroll
        for (int kk = 0; kk < 4; ++kk) {
            bool a0, a1;
            if (c == 1) { a0 = true; a1 = true; } else if (c == 0) { a0 = 2 * kk >= w; a1 = 2 * kk + 1 >= w; } else { a0 = 2 * kk <= w; a1 = 2 * kk + 1 <= w; }
            if (a0 || a1) { bf16x8 pf[2];
#pragma unroll
                for (int u = 0; u < 2; ++u) { u32x4 pw;
                    if (c == 1) { pw.x = P1[u][kk][0]; pw.y = P1[u][kk][1]; pw.z = P1[u][kk][2]; pw.w = P1[u][kk][3]; }
                    else if (c == 0) { pw.x = a0 ? PC[u][7 - 2 * kk][0] : 0u; pw.y = a0 ? PC[u][7 - 2 * kk][1] : 0u; pw.z = a1 ? PC[u][6 - 2 * kk][0] : 0u; pw.w = a1 ? PC[u][6 - 2 * kk][1] : 0u; }
                    else { pw.x = a0 ? PC[u][8 - 2 * kk][0] : 0u; pw.y = a0 ? PC[u][8 - 2 * kk][1] : 0u; pw.z = a1 ? PC[u][7 - 2 * kk][0] : 0u; pw.w = a1 ? PC[u][7 - 2 * kk][1] : 0u; }
                    pf[u] = __builtin_bit_cast(bf16x8, pw); }
#pragma unroll
                for (int dt = 0; dt < 8; ++dt) { const bf16x8 vf = vt_frag(buf, 32 * kk, g, q4, pp, dt);
                    O[0][dt] = __builtin_amdgcn_mfma_f32_16x16x32_bf16(vf, pf[0], O[0][dt], 0, 0, 0); O[1][dt] = __builtin_amdgcn_mfma_f32_16x16x32_bf16(vf, pf[1], O[1][dt], 0, 0, 0); } } }
    }
#undef WIN_ISSUE
#pragma unroll
    for (int u = 0; u < 2; ++u) { unsigned char* op = o + (size_t)tq * D + (hq0 + u) * 128 + 4 * g; const float sc = inv[u] * 16.f;
#pragma unroll
        for (int dt = 0; dt < 8; ++dt) *(unsigned*)(op + 16 * dt) = pk4_fp8(O[u][dt][0] * sc, O[u][dt][1] * sc, O[u][dt][2] * sc, O[u][dt][3] * sc); }
}

__device__ __forceinline__ void attn_nat_item(const Params& p, LAS unsigned char* lds, int item, int& tab_head) {
    const int tid = phase_tid(), lane = tid & 63, w = __builtin_amdgcn_readfirstlane(tid >> 6), g = lane >> 4, ql = lane & 15;
    const int b = item >> 9, rp = (item >> 2) & 127, hp = item & 3, hh = w >> 2, h = 2 * hp + hh, jq = w & 3;
    const int kr_lo = min(max(2 * rp - 4, 0), 248);
    const int d0 = min(max(2 * rp - 4, 0), 248) - kr_lo, d1 = min(max(2 * rp - 3, 0), 248) - kr_lo;
    const int w0 = jq == 0 ? 0 : (jq == 1 ? 8 : (jq == 2 ? 24 : 32));
    const bf16_t* qkv = (const bf16_t*)(p.ws + WS_QKV); unsigned char* o = p.ws + WS_O8;
    LAS float* rpb = (LAS float*)(lds + 131072); const unsigned ldsb = (unsigned)(size_t)lds;
    const unsigned loff = (unsigned)(w * 4 + g) * NQKV + (unsigned)((ql ^ ((g << 2) | (w & 3))) * 8);
    const bf16_t* kbase = qkv + (size_t)(b * SEQ) * NQKV + 2560 + 2 * hp * 128;
#define NAT_ISSUE(s) do { const int _s = (s); const int _kr = min(kr_lo + (_s % 9), 255); const bf16_t* _src = kbase + (size_t)(_kr * 64) * NQKV + (_s >= 9 ? 1024 : 0) + loff; \
        _Pragma("unroll") for (int _i = 0; _i < 4; ++_i) glds16_asm(_src + (size_t)(32 * (_i & 1)) * NQKV + 128 * (_i >> 1), ldsb + (unsigned)((_s & 3) * 32768 + _i * 8192 + w * 1024)); } while (0)
    ATT_BAR();
    NAT_ISSUE(0); NAT_ISSUE(1); NAT_ISSUE(2);
    if (hp != tab_head) { for (int i = tid; i < 930; i += 512) rpb[i] = p.in[8][2 * hp * 465 + i] * 1.4426950408889634f; tab_head = hp; }
    const int qcol = 16 * jq + ql; const int tq0 = b * SEQ + (2 * rp) * 64 + qcol;
    bf16x8 qf[2][4]; load_q(qkv + (size_t)tq0 * NQKV + 1536 + h * 128, g, qf[0]); load_q(qkv + (size_t)(tq0 + 64) * NQKV + 1536 + h * 128, g, qf[1]);
    f32x4 S[2][9][2];
#pragma unroll
    for (int u = 0; u < 2; ++u)
#pragma unroll
        for (int c = 0; c < 9; ++c) { S[u][c][0] = (f32x4){0.f, 0.f, 0.f, 0.f}; S[u][c][1] = (f32x4){0.f, 0.f, 0.f, 0.f}; }
#pragma unroll
    for (int c = 0; c < 9; ++c) {
        wait_vm(8); ATT_BAR(); NAT_ISSUE(c + 3);
        const bool a0 = c >= d0 && c < d0 + 8, a1 = c >= d1 && c < d1 + 8;
        LAS unsigned char* buf = lds + (c & 3) * 32768 + hh * 16384;
#pragma unroll
        for (int t = 0; t < 2; ++t)
#pragma unroll
            for (int ks = 0; ks < 4; ++ks) { const bf16x8 kf = *(const LAS bf16x8*)(buf + off_b(w0 + 16 * t + ql, 4 * ks + g));
                if (a0) S[0][c][t] = __builtin_amdgcn_mfma_f32_16x16x32_bf16(kf, qf[0][ks], S[0][c][t], 0, 0, 0);
                if (a1) S[1][c][t] = __builtin_amdgcn_mfma_f32_16x16x32_bf16(kf, qf[1][ks], S[1][c][t], 0, 0, 0); }
    }
    const int cs = min(max(qcol - 8, 0), 48); float inv[2];
    unsigned P[2][9][4];
    int dcv[2][4]; bool cv[2][4];
#pragma unroll
    for (int t = 0; t < 2; ++t)
#pragma unroll
        for (int q = 0; q < 4; ++q) { const int kc = w0 + 16 * t + 4 * g + q; cv[t][q] = kc >= cs && kc < cs + 16; dcv[t][q] = hh * 465 + kc - qcol + 15; }
#pragma unroll
    for (int u = 0; u < 2; ++u) { const int du = u ? d1 : d0; const int r = 2 * rp + u; float mx = -1e30f;
#pragma unroll
        for (int c = 0; c < 9; ++c) { const bool act = c >= du && c < du + 8;
            if (act) { const int rowb = (kr_lo + c - r + 7) * 31;
#pragma unroll
                for (int t = 0; t < 2; ++t)
#pragma unroll
                    for (int q = 0; q < 4; ++q) { const float sv = cv[t][q] ? S[u][c][t][q] + rpb[rowb + dcv[t][q]] : -1e30f; S[u][c][t][q] = sv; mx = fmaxf(mx, sv); } } }
        mx = fmaxf(mx, __shfl_xor(mx, 16)); mx = fmaxf(mx, __shfl_xor(mx, 32));
        float l = 0.f;
#pragma unroll
        for (int c = 0; c < 9; ++c) { const bool act = c >= du && c < du + 8;
            if (act) { float e[2][4];
#pragma unroll
                for (int t = 0; t < 2; ++t)
#pragma unroll
                    for (int q = 0; q < 4; ++q) { e[t][q] = __builtin_amdgcn_exp2f(S[u][c][t][q] - mx); l += e[t][q]; }
                P[u][c][0] = pk2(e[0][0], e[0][1]); P[u][c][1] = pk2(e[0][2], e[0][3]); P[u][c][2] = pk2(e[1][0], e[1][1]); P[u][c][3] = pk2(e[1][2], e[1][3]); }
            else { P[u][c][0] = 0u; P[u][c][1] = 0u; P[u][c][2] = 0u; P[u][c][3] = 0u; } }
        l += __shfl_xor(l, 16); l += __shfl_xor(l, 32);
        inv[u] = 1.0f / l; }
    f32x4 O[2][8];
#pragma unroll
    for (int u = 0; u < 2; ++u)
#pragma unroll
        for (int dt = 0; dt < 8; ++dt) O[u][dt] = (f32x4){0.f, 0.f, 0.f, 0.f};
    const int q4 = ql >> 2, pp = ql & 3;
#pragma unroll
    for (int c = 0; c < 9; ++c) {
        wait_vm(c <= 6 ? 8 : (c == 7 ? 4 : 0)); ATT_BAR(); if (c + 12 < 18) NAT_ISSUE(c + 12);
        const bool a0 = c >= d0 && c < d0 + 8, a1 = c >= d1 && c < d1 + 8;
        LAS unsigned char* buf = lds + ((c + 9) & 3) * 32768 + hh * 16384;
        u32x4 pw0; pw0.x = P[0][c][0]; pw0.y = P[0][c][1]; pw0.z = P[0][c][2]; pw0.w = P[0][c][3];
        u32x4 pw1; pw1.x = P[1][c][0]; pw1.y = P[1][c][1]; pw1.z = P[1][c][2]; pw1.w = P[1][c][3];
        const bf16x8 pf0 = __builtin_bit_cast(bf16x8, pw0), pf1 = __builtin_bit_cast(bf16x8, pw1);
#pragma unroll
        for (int dt = 0; dt < 8; ++dt) { const bf16x8 vf = vt_frag(buf, w0, g, q4, pp, dt);
            if (a0) O[0][dt] = __builtin_amdgcn_mfma_f32_16x16x32_bf16(vf, pf0, O[0][dt], 0, 0, 0);
            if (a1) O[1][dt] = __builtin_amdgcn_mfma_f32_16x16x32_bf16(vf, pf1, O[1][dt], 0, 0, 0); }
    }
#undef NAT_ISSUE
#pragma unroll
    for (int u = 0; u < 2; ++u) { unsigned char* op = o + (size_t)(tq0 + 64 * u) * D + 1024 + h * 128 + 4 * g; const float sc = inv[u] * 16.f;
#pragma unroll
        for (int dt = 0; dt < 8; ++dt) *(unsigned*)(op + 16 * dt) = pk4_fp8(O[u][dt][0] * sc, O[u][dt][1] * sc, O[u][dt][2] * sc, O[u][dt][3] * sc); }
}
__device__ __forceinline__ void p2_attn(const Params& p, LAS unsigned char* lds) {
    int tab_head = -1, mb = 0;
    const int nper = (1024 + (int)gridDim.x - 1) / (int)gridDim.x;
    const int NB = (MOE_ITEMS + 8 * (int)gridDim.x - 1) / (8 * (int)gridDim.x);
    for (int s = 0; s < 2 * nper || mb < NB; ++s) {
        if (s < 2 * nper) {
            const bool nat = s >= nper; const int it = (int)blockIdx.x + (nat ? s - nper : s) * (int)gridDim.x;
            if (s == nper) { tab_head = -1;
#ifdef PROBE_A
                if (blockIdx.x == 0 && threadIdx.x == 0) ((unsigned long long*)(p.ws + WS_END))[11] = __builtin_amdgcn_s_memrealtime();
#endif
            }
            if (it < 1024) { if (!nat) attn_window_item(p, lds, it, tab_head); else attn_nat_item(p, lds, it, tab_head); }
        }
        if ((((s + (int)blockIdx.x) & 1) == 0 || s >= 2 * nper) && mb < NB) {
            ATT_BAR();
            for (int q = 0; q < 2 && mb < NB; ++q) moe_prep_batch(p, lds, mb++);
        }
    }
    asm volatile("s_waitcnt vmcnt(0)" ::: "memory"); __syncthreads();
}

struct UpHook { const bf16_t* gates;
    __device__ __forceinline__ void operator()(f32x4 (&acc)[2][2][4][2], const Unit& u, int wr, int wc, int fr, int fq) const {
        const unsigned goff = (unsigned)(u.pm * 256 + wr * 64 + fr) * NGATE + u.pn * 256 + wc * 32 + 8 * fq;
#pragma unroll
        for (int ai = 0; ai < 2; ++ai) {
            bf16x8 ra[4][2];
#pragma unroll
            for (int m = 0; m < 4; ++m)
#pragma unroll
                for (int bj = 0; bj < 2; ++bj) ra[m][bj] = *(const bf16x8*)(gates + goff + (unsigned)((ai * 128 + m * 16) * NGATE) + bj * 128);
#pragma unroll
            for (int m = 0; m < 4; ++m)
#pragma unroll
                for (int bj = 0; bj < 2; ++bj)
#pragma unroll
                    for (int n = 0; n < 2; ++n)
#pragma unroll
                        for (int j = 0; j < 4; ++j) acc[ai][bj][m][n][j] *= bf2f(ra[m][bj][4 * n + j]);
            asm volatile("" ::: "memory"); }
    } };
struct UpSched {
    pg8::TileOrder o; const unsigned char* A; const unsigned char* Bt;
    __device__ __forceinline__ bool next(int i, Unit& u) const { u.aux = i & 1; return o.tile(i >> 1, u.pm, u.pn); }
    __device__ __forceinline__ const char* a_base(const Unit&) const { return (const char*)A; }
    __device__ __forceinline__ const char* b_base(const Unit& u) const { return (const char*)(Bt + (size_t)u.pn * 256 * D + u.aux * 1024); }
    __device__ __forceinline__ bool keep_acc(const Unit& u) const { return u.aux == 0; }
    __device__ __forceinline__ void a_offs(const Unit& u, int R0, int C0, int R1, int C1, unsigned (&v)[2][2]) const {
#pragma unroll
        for (int h = 0; h < 2; ++h) { v[h][0] = (unsigned)(u.pm * 256 + 128 * h + R0) * D + u.aux * 1024 + C0 * 2u; v[h][1] = (unsigned)(u.pm * 256 + 128 * h + R1) * D + u.aux * 1024 + C1 * 2u; } }
};
struct EpiUp { const bf16_t* gates; unsigned char* merged;
    __device__ __forceinline__ void operator()(f32x4 (&acc)[2][2][4][2], const Unit& u, int wr, int wc, int fr, int fq) const {
        if (u.aux == 0) { UpHook{gates}(acc, u, wr, wc, fr, fq); return; }
        const unsigned goff = (unsigned)(u.pm * 256 + wr * 64 + fr) * NGATE + 2048 + u.pn * 256 + wc * 32 + 8 * fq;
        const unsigned moff = (unsigned)(u.pm * 256 + wr * 64 + fr) * D + u.pn * 256 + wc * 32 + 8 * fq;
#pragma unroll
        for (int ai = 0; ai < 2; ++ai) {
            bf16x8 sb[4][2];
#pragma unroll
            for (int m = 0; m < 4; ++m)
#pragma unroll
                for (int bj = 0; bj < 2; ++bj) sb[m][bj] = *(const bf16x8*)(gates + goff + (unsigned)((ai * 128 + m * 16) * NGATE) + bj * 128);
#pragma unroll
            for (int m = 0; m < 4; ++m)
#pragma unroll
                for (int bj = 0; bj < 2; ++bj) { f32x4 v0 = acc[ai][bj][m][0], v1 = acc[ai][bj][m][1];
#pragma unroll
                    for (int j = 0; j < 4; ++j) { v0[j] *= bf2f(sb[m][bj][j]) * (1.0f / 64.0f); v1[j] *= bf2f(sb[m][bj][4 + j]) * (1.0f / 64.0f); }
                    u32x2 w; w.x = pk4_fp8(v0[0], v0[1], v0[2], v0[3]); w.y = pk4_fp8(v1[0], v1[1], v1[2], v1[3]);
                    *(u32x2*)(merged + moff + (unsigned)((ai * 128 + m * 16) * D) + bj * 128) = w; }
            asm volatile("" ::: "memory"); }
    } };
__device__ __forceinline__ void p3_up(const Params& p, LAS unsigned char* lds) {
    UpSched S; S.o.init(128, 8, gridDim.x, blockIdx.x); S.A = p.ws + WS_O8; S.Bt = p.ws + WS_WUP;
    EpiUp E{(const bf16_t*)(p.ws + WS_GATES), p.ws + WS_MG};
    int ntv = 1024 / 128; asm volatile("" : "+s"(ntv));
    pg8::gemm_phase<true, true, UpSched, EpiUp, true>(lds, S, E, ntv, D / 2, D / 2);
}

struct EpiOut { const bf16_t* xb; bf16_t* hb; unsigned char* h8;
    __device__ __forceinline__ void operator()(f32x4 (&acc)[2][2][4][2], const Unit& u, int wr, int wc, int fr, int fq) const {
        unsigned off = (unsigned)(u.pm * 256 + wr * 64 + fr) * D + u.pn * 256 + wc * 32 + 8 * fq;
#pragma unroll
        for (int ai = 0; ai < 2; ++ai) {
            bf16x8 xr[4][2];
#pragma unroll
            for (int m = 0; m < 4; ++m)
#pragma unroll
                for (int bj = 0; bj < 2; ++bj) xr[m][bj] = *(const bf16x8*)(xb + off + (unsigned)(m * 16 * D) + bj * 128);
#pragma unroll
            for (int m = 0; m < 4; ++m) { asm volatile("" : "+v"(off));
#pragma unroll
                for (int bj = 0; bj < 2; ++bj) { const f32x4 v0 = acc[ai][bj][m][0] * (1.0f / 1024.0f), v1 = acc[ai][bj][m][1] * (1.0f / 1024.0f); const u32x4 xw = __builtin_bit_cast(u32x4, xr[m][bj]);
                    const float h0 = v0[0] + __uint_as_float(xw.x << 16), h1 = v0[1] + __uint_as_float(xw.x & 0xffff0000u), h2 = v0[2] + __uint_as_float(xw.y << 16), h3 = v0[3] + __uint_as_float(xw.y & 0xffff0000u);
                    const float h4 = v1[0] + __uint_as_float(xw.z << 16), h5 = v1[1] + __uint_as_float(xw.z & 0xffff0000u), h6 = v1[2] + __uint_as_float(xw.w << 16), h7 = v1[3] + __uint_as_float(xw.w & 0xffff0000u);
                    u32x4 w; w.x = pk2(h0, h1); w.y = pk2(h2, h3); w.z = pk2(h4, h5); w.w = pk2(h6, h7);
                    *(u32x4*)(hb + off + bj * 128) = w;
                    }
                off += 16 * D; }
            off += 64 * D; }
    } };
__device__ __forceinline__ void p4_out(const Params& p, LAS unsigned char* lds) {
    GateSched S; S.o.init(128, 8, gridDim.x, blockIdx.x); S.x8 = p.ws + WS_MG; S.W8 = p.ws + WS_WOUT;
    EpiOut E{(const bf16_t*)(p.ws + WS_XB), (bf16_t*)(p.ws + WS_O), p.ws + WS_H8};
    pg8::gemm_phase<true, true, GateSched, EpiOut, true, false>(lds, S, E, D / 128, D / 2, D / 2);
}

__device__ __forceinline__ void p5_router(const Params& p, LAS unsigned char* lds) {
    const int tid = phase_tid(), lane = tid & 63, wave = __builtin_amdgcn_readfirstlane(tid >> 6), g = lane >> 4, tl = lane & 15;
    const bf16_t* wsp = (const bf16_t*)(p.ws + WS_WRT); float* r2 = (float*)(p.ws + WS_R2); int* cnt = (int*)(p.ws + WS_CNT); int* tokl = (int*)(p.ws + WS_TOK);
    int* recc = (int*)(p.ws + WS_RECC); float* recw = (float*)(p.ws + WS_RECW); const bf16_t* hb = (const bf16_t*)(p.ws + WS_O);
    const float* brg = p.in[15]; const float* bre = p.in[17];
    LAS unsigned char* H = lds + wave * 2304;
    LAS unsigned char* WL = lds + 36864;
    const int r8 = lane >> 3, s8 = lane & 7;
    const int pa0 = tid / 384, pr0 = (tid % 384) >> 3, ps0 = tid & 7, pi1 = 512 + tid, pa1 = pi1 / 384, pr1 = (pi1 % 384) >> 3;
    const unsigned wsrc0 = (unsigned)(pa0 * 48 * 2048 + pr0 * D + ps0 * 8), wsrc1 = (unsigned)(pa1 * 48 * 2048 + pr1 * D + ps0 * 8);
    const unsigned wdst0 = (unsigned)(pa0 * 6144 + pr0 * 128 + ((ps0 ^ (pr0 & 7)) << 4)), wdst1 = (unsigned)(pa1 * 6144 + pr1 * 128 + ((ps0 ^ (pr1 & 7)) << 4));
    for (int round = blockIdx.x; round < T / 128; round += gridDim.x) {
        const int tile = round * 8 + wave;
        const bf16_t* hs = hb + (size_t)tile * 16 * D + r8 * D + s8 * 8; unsigned char* h8s = p.ws + WS_H8 + (size_t)tile * 16 * D + r8 * D + s8 * 8;
        f32x4 accA = {0.f, 0.f, 0.f, 0.f}, accB = accA, accC = accA; float ss = 0.f;
        u32x4 hq0[2], hq1[2], hq2[2], hq3[2], wr0, wr1;
#define RT_LOADS(bq, k) do { bq[0] = *(const u32x4*)(hs + 64 * (k)); bq[1] = *(const u32x4*)(hs + 8 * D + 64 * (k)); } while (0)
#define RT_H8(w_) ({ const u32x4 w__ = (w_); u32x2 f__; f__.x = pk4_fp8(__uint_as_float(w__.x << 16), __uint_as_float(w__.x & 0xffff0000u), __uint_as_float(w__.y << 16), __uint_as_float(w__.y & 0xffff0000u)); \
            f__.y = pk4_fp8(__uint_as_float(w__.z << 16), __uint_as_float(w__.z & 0xffff0000u), __uint_as_float(w__.w << 16), __uint_as_float(w__.w & 0xffff0000u)); f__; })
#define RT_COMP(bq, wbuf, k) do { \
            *(u32x2*)(h8s + 64 * (k)) = RT_H8(bq[0]); *(u32x2*)(h8s + 8 * D + 64 * (k)) = RT_H8(bq[1]); \
            *(LAS u32x4*)(H + r8 * 144 + s8 * 16) = bq[0]; *(LAS u32x4*)(H + (r8 + 8) * 144 + s8 * 16) = bq[1]; \
            _Pragma("unroll") for (int ks = 0; ks < 2; ++ks) { const u32x4 hw = *(const LAS u32x4*)(H + tl * 144 + 64 * ks + 16 * g); \
                { const float a0 = __uint_as_float(hw.x << 16), a1 = __uint_as_float(hw.x & 0xffff0000u), a2 = __uint_as_float(hw.y << 16), a3 = __uint_as_float(hw.y & 0xffff0000u); \
                  const float a4 = __uint_as_float(hw.z << 16), a5 = __uint_as_float(hw.z & 0xffff0000u), a6 = __uint_as_float(hw.w << 16), a7 = __uint_as_float(hw.w & 0xffff0000u); \
                  ss += (a0 * a0 + a1 * a1) + (a2 * a2 + a3 * a3) + (a4 * a4 + a5 * a5) + (a6 * a6 + a7 * a7); } \
                const bf16x8 bh = __builtin_bit_cast(bf16x8, hw); const unsigned so_ = (unsigned)(((4 * ks + g) ^ (tl & 7)) << 4); \
                _Pragma("unroll") for (int t = 0; t < 3; ++t) { const bf16x8 ah = *(const LAS bf16x8*)((wbuf) + (16 * t + tl) * 128 + so_), al = *(const LAS bf16x8*)((wbuf) + 6144 + (16 * t + tl) * 128 + so_); \
                    f32x4& ac = (t == 0 ? accA : (t == 1 ? accB : accC)); \
                    ac = __builtin_amdgcn_mfma_f32_16x16x32_bf16(ah, bh, ac, 0, 0, 0); ac = __builtin_amdgcn_mfma_f32_16x16x32_bf16(al, bh, ac, 0, 0, 0); } } } while (0)
#define RT_WLOAD(c) do { wr0 = *(const u32x4*)(wsp + wsrc0 + 64 * (c)); if (tid < 256) wr1 = *(const u32x4*)(wsp + wsrc1 + 64 * (c)); } while (0)
#define RT_WSTORE(wbuf) do { *(LAS u32x4*)((wbuf) + wdst0) = wr0; if (tid < 256) *(LAS u32x4*)((wbuf) + wdst1) = wr1; } while (0)
        __syncthreads();
        RT_WLOAD(0); RT_LOADS(hq0, 0); RT_LOADS(hq1, 1); RT_LOADS(hq2, 2);
        RT_WSTORE(WL); RT_WLOAD(1);
        __syncthreads();
#pragma unroll 1
        for (int c = 0; c < D / 64; c += 4) {
            RT_LOADS(hq3, (c + 3));      RT_COMP(hq0, WL, c);             RT_WSTORE(WL + 12288); RT_WLOAD((c + 2) & 31); __syncthreads();
            RT_LOADS(hq0, (c + 4) & 31); RT_COMP(hq1, WL + 12288, c + 1); RT_WSTORE(WL);         RT_WLOAD((c + 3) & 31); __syncthreads();
            RT_LOADS(hq1, (c + 5) & 31); RT_COMP(hq2, WL, c + 2);         RT_WSTORE(WL + 12288); RT_WLOAD((c + 4) & 31); __syncthreads();
            RT_LOADS(hq2, (c + 6) & 31); RT_COMP(hq3, WL + 12288, c + 3); RT_WSTORE(WL);         RT_WLOAD((c + 5) & 31); __syncthreads();
        }
#undef RT_LOADS
#undef RT_COMP
#undef RT_H8
#undef RT_WLOAD
#undef RT_WSTORE
        const int tok = tile * 16 + tl;
        ss += __shfl_xor(ss, 16); ss += __shfl_xor(ss, 32);
        const float rr = rsqrtf(ss * (1.0f / D) + EPS);
        const float myg = accC[0] * rr + brg[g];
        float gl[4];
#pragma unroll
        for (int j = 0; j < 4; ++j) gl[j] = __shfl(myg, tl + 16 * j);
        int gi = 0; float gm = gl[0];
#pragma unroll
        for (int i = 1; i < 4; ++i) if (gl[i] > gm) { gm = gl[i]; gi = i; }
        float den = 0.f;
#pragma unroll
        for (int i = 0; i < 4; ++i) den += __expf(gl[i] - gm);
        const float pg = 1.0f / den;
        int L0 = 0, L1 = 0; float wt0 = 0.f, wt1 = 0.f; const bool owner = (g == gi);
        if (owner) {
            float el[8];
#pragma unroll
            for (int i = 0; i < 4; ++i) { el[i] = accA[i] * rr + bre[g * 8 + i]; el[4 + i] = accB[i] * rr + bre[g * 8 + 4 + i]; }
            int e0 = 0; float v0 = el[0];
#pragma unroll
            for (int i = 1; i < 8; ++i) if (el[i] > v0) { v0 = el[i]; e0 = i; }
            int e1 = -1; float v1 = -3.0e38f;
#pragma unroll
            for (int i = 0; i < 8; ++i) if (i != e0 && el[i] > v1) { v1 = el[i]; e1 = i; }
            const float ex = __expf(v1 - v0); const float s0 = 1.0f / (1.0f + ex), s1 = ex * s0;
            r2[tok] = rr; L0 = gi * 8 + e0; L1 = gi * 8 + e1; wt0 = pg * s0; wt1 = pg * s1;
        }
        LAS int* cl = (LAS int*)(lds + 61440);
        if (tid < 32) cl[tid] = 0;
        __syncthreads();
        int q0 = 0, q1 = 0;
        if (owner) { q0 = __hip_atomic_fetch_add(&cl[L0], 1, __ATOMIC_RELAXED, __HIP_MEMORY_SCOPE_WORKGROUP); q1 = __hip_atomic_fetch_add(&cl[L1], 1, __ATOMIC_RELAXED, __HIP_MEMORY_SCOPE_WORKGROUP); }
        __syncthreads();
        if (tid < 32) { const int n = cl[tid]; cl[32 + tid] = n ? atomicAdd(&cnt[tid], n) : 0; }
        __syncthreads();
        if (owner) { const int p0 = cl[32 + L0] + q0, p1 = cl[32 + L1] + q1;
            float* r2l = (float*)(p.ws + WS_R2L);
            tokl[(size_t)L0 * T + p0] = tok; r2l[(size_t)L0 * T + p0] = rr; recc[2 * tok] = L0 * 32768 + p0; recw[2 * tok] = wt0;
            tokl[(size_t)L1 * T + p1] = tok; r2l[(size_t)L1 * T + p1] = rr; recc[2 * tok + 1] = L1 * 32768 + p1; recw[2 * tok + 1] = wt1; }
    }
    __syncthreads();
}

__device__ __forceinline__ void build_tiles(const Params& p, LAS int* tab) {
    __syncthreads();
    if (threadIdx.x < 64) { const int L = threadIdx.x; const int c = L < 32 ? ((const int*)(p.ws + WS_CNT))[L] : 0; const int nt = (c + 255) >> 8;
        int pre = nt;
#pragma unroll
        for (int o = 1; o < 32; o <<= 1) { const int v = __shfl_up(pre, o); if (L >= o) pre += v; }
        const int first = pre - nt;
        if (L < 32) { tab[1400 + L] = first * 256; for (int i = 0; i < nt; ++i) { tab[4 + (first + i) * 4 + 0] = L; tab[4 + (first + i) * 4 + 1] = i * 256; tab[4 + (first + i) * 4 + 2] = (first + i) * 256; tab[4 + (first + i) * 4 + 3] = min(256, c - i * 256); } }
        if (L == 31) tab[0] = pre; }
    __syncthreads();
}
template <int NPN> struct MoeOrder { int G, c, t_lo, nt_tiles; const LAS int* tab;
    __device__ __forceinline__ bool unit(int i, Unit& u) const { const long L = (long)i * G + c; if (L >= (long)nt_tiles * NPN) return false;
        const int nwg = nt_tiles * NPN; int wgid = (int)L; { const int q = nwg / 8, r = nwg % 8, xcd = wgid % 8, off = wgid / 8; wgid = (xcd < r ? xcd * (q + 1) : r * (q + 1) + (xcd - r) * q) + off; }
        u.pm = t_lo + wgid / NPN; u.pn = wgid % NPN; u.aux = 0; return true; } };
struct GateUpSched { MoeOrder<4> o; const unsigned char* hb; const unsigned char* WguT; const int* tokl;
    __device__ __forceinline__ bool next(int i, Unit& u) const { return o.unit(i, u); }
    __device__ __forceinline__ const char* a_base(const Unit&) const { return (const char*)hb; }
    __device__ __forceinline__ const char* b_base(const Unit& u) const { const int e = o.tab[4 + u.pm * 4] & 31; return (const char*)(WguT + (size_t)(e * 1024 + u.pn * 256) * D); }
    __device__ __forceinline__ bool keep_acc(const Unit&) const { return false; }
    __device__ __forceinline__ void a_offs(const Unit& u, int R0, int C0, int R1, int C1, unsigned (&v)[2][2]) const {
        const int L = o.tab[4 + u.pm * 4], row0 = o.tab[4 + u.pm * 4 + 1], nrows = o.tab[4 + u.pm * 4 + 3]; const int* lst = tokl + (size_t)L * T + row0;
#pragma unroll
        for (int h = 0; h < 2; ++h) { const int r0 = R0 + 128 * h, r1 = R1 + 128 * h; const int t0 = r0 < nrows ? lst[r0] : 0, t1 = r1 < nrows ? lst[r1] : 0;
            v[h][0] = (unsigned)t0 * D + C0 * 2u; v[h][1] = (unsigned)t1 * D + C1 * 2u; } }
};
struct EpiGateUp { const LAS int* tab; const float* r2l; unsigned char* he;
    __device__ __forceinline__ void operator()(f32x4 (&acc)[2][2][4][2], const Unit& u, int wr, int wc, int fr, int fq) const {
        const int L = tab[4 + u.pm * 4], row0 = tab[4 + u.pm * 4 + 1], slot = tab[4 + u.pm * 4 + 2], nrows = tab[4 + u.pm * 4 + 3];
#pragma unroll
        for (int ai = 0; ai < 2; ++ai)
#pragma unroll
            for (int m = 0; m < 4; ++m) { const int rr = ai * 128 + wr * 64 + m * 16 + fr; const float rs = rr < nrows ? r2l[(size_t)L * T + row0 + rr] * (1.0f / 64.0f) : 0.f;
                u32x2 w; unsigned ww[2];
#pragma unroll
                for (int n = 0; n < 2; ++n) { float hv[4];
#pragma unroll
                    for (int j = 0; j < 4; ++j) { const float gt = acc[ai][0][m][n][j] * rs, up = acc[ai][1][m][n][j] * rs; hv[j] = gt * sigmoidf_(gt) * up * 4.0f; }
                    ww[n] = pk4_fp8(hv[0], hv[1], hv[2], hv[3]); }
                w.x = ww[0]; w.y = ww[1];
                *(u32x2*)(he + (size_t)(slot + rr) * 512 + u.pn * 128 + wc * 32 + 8 * fq) = w; }
    } };
__device__ __forceinline__ void p6_gateup(const Params& p, LAS unsigned char* lds) {
    LAS int* tab = (LAS int*)(lds + TAB_OFF); build_tiles(p, tab);
    GateUpSched S; S.o.G = gridDim.x; S.o.c = blockIdx.x; S.o.t_lo = 0; S.o.nt_tiles = tab[0]; S.o.tab = tab;
    S.hb = p.ws + WS_H8; S.WguT = p.ws + WS_WGU; S.tokl = (const int*)(p.ws + WS_TOK);
    EpiGateUp E{tab, (const float*)(p.ws + WS_R2L), p.ws + WS_HE};
    pg8::gemm_phase<true, true, GateUpSched, EpiGateUp, true>(lds, S, E, D / 128, D / 2, D / 2);
    { LAS int* qb = (LAS int*)(lds + 131072); int* qhead = (int*)(p.ws + WS_CNT) + 32;
      for (;;) { __syncthreads(); if (threadIdx.x == 0) *qb = atomicAdd(qhead, 1); __syncthreads(); const int b = *qb; if (b >= WD_BATCHES) break; wd_prep_batch(p, lds, b); } }
}
struct DownSched { MoeOrder<8> o; const unsigned char* he; const unsigned char* WdT;
    __device__ __forceinline__ bool next(int i, Unit& u) const { return o.unit(i, u); }
    __device__ __forceinline__ const char* a_base(const Unit&) const { return (const char*)he; }
    __device__ __forceinline__ const char* b_base(const Unit& u) const { const int e = o.tab[4 + u.pm * 4] & 31; return (const char*)(WdT + (size_t)(e * 2048 + u.pn * 256) * 512); }
    __device__ __forceinline__ bool keep_acc(const Unit&) const { return false; }
    __device__ __forceinline__ void a_offs(const Unit& u, int R0, int C0, int R1, int C1, unsigned (&v)[2][2]) const {
        const int slot = o.tab[4 + u.pm * 4 + 2];
#pragma unroll
        for (int h = 0; h < 2; ++h) { v[h][0] = (unsigned)(slot + 128 * h + R0) * 512u + C0 * 2u; v[h][1] = (unsigned)(slot + 128 * h + R1) * 512u + C1 * 2u; } }
};
struct EpiDown { const LAS int* tab; unsigned char* ye;
    __device__ __forceinline__ void operator()(f32x4 (&acc)[2][2][4][2], const Unit& u, int wr, int wc, int fr, int fq) const {
        const int slot = tab[4 + u.pm * 4 + 2];
        unsigned off = (unsigned)(slot + wr * 64 + fr) * 2048 + u.pn * 256 + wc * 32 + 8 * fq;
#pragma unroll
        for (int ai = 0; ai < 2; ++ai) {
#pragma unroll
            for (int m = 0; m < 4; ++m) { asm volatile("" : "+v"(off));
#pragma unroll
                for (int bj = 0; bj < 2; ++bj) { const f32x4 v0 = acc[ai][bj][m][0] * 0.0625f, v1 = acc[ai][bj][m][1] * 0.0625f;
                    u32x2 w; w.x = pk4_fp8(v0[0], v0[1], v0[2], v0[3]); w.y = pk4_fp8(v1[0], v1[1], v1[2], v1[3]);
                    *(u32x2*)(ye + off + bj * 128) = w; }
                off += 16 * 2048; }
            off += 64 * 2048; }
    } };
__device__ __forceinline__ void p7_down(const Params& p, LAS unsigned char* lds) {
    LAS int* tab = (LAS int*)(lds + TAB_OFF); build_tiles(p, tab);
    DownSched S; S.o.G = gridDim.x; S.o.c = blockIdx.x; S.o.t_lo = 0; S.o.nt_tiles = tab[0]; S.o.tab = tab;
    S.he = p.ws + WS_HE; S.WdT = p.ws + WS_WD;
    EpiDown E{tab, p.ws + WS_YE};
    int ntv = 512 / 128; asm volatile("" : "+s"(ntv));
    pg8::gemm_phase<true, true, DownSched, EpiDown, true, false>(lds, S, E, ntv, 256, 256);
}
__device__ __forceinline__ void p8_combine(const Params& p, LAS unsigned char* lds) {
    LAS int* tab = (LAS int*)(lds + TAB_OFF); build_tiles(p, tab);
    const int tid = phase_tid(), lane = tid & 63, wave = tid >> 6; const int gw = blockIdx.x * 8 + wave, NGW = gridDim.x * 8;
    const int* recc = (const int*)(p.ws + WS_RECC); const float* recw = (const float*)(p.ws + WS_RECW); const bf16_t* hb = (const bf16_t*)(p.ws + WS_O);
    const unsigned char* ye = p.ws + WS_YE;
    for (int tok = gw; tok < T; tok += NGW) {
        const int c0 = recc[2 * tok], c1 = recc[2 * tok + 1]; const float wa = recw[2 * tok] * 0.0625f, wb = recw[2 * tok + 1] * 0.0625f;
        const int s0 = tab[1400 + (c0 >> 15)] + (c0 & 32767), s1 = tab[1400 + (c1 >> 15)] + (c1 & 32767);
        f32x4* op = (f32x4*)(p.out + (size_t)tok * D) + lane; const u32x2* hp = (const u32x2*)(hb + (size_t)tok * D) + lane;
        const unsigned* ya = (const unsigned*)(ye + (size_t)s0 * 2048) + lane; const unsigned* yb = (const unsigned*)(ye + (size_t)s1 * 2048) + lane;
        u32x2 m[8]; unsigned a[8], b[8];
#pragma unroll
        for (int j = 0; j < 8; ++j) { m[j] = hp[64 * j]; a[j] = ya[64 * j]; b[j] = yb[64 * j]; }
#pragma unroll
        for (int j = 0; j < 8; ++j) { f32x4 v;
            const f32x2 a0 = __builtin_amdgcn_cvt_pk_f32_fp8(a[j], false), a1 = __builtin_amdgcn_cvt_pk_f32_fp8(a[j], true), b0 = __builtin_amdgcn_cvt_pk_f32_fp8(b[j], false), b1 = __builtin_amdgcn_cvt_pk_f32_fp8(b[j], true);
            v.x = __uint_as_float(m[j].x << 16) + wa * a0.x + wb * b0.x; v.y = __uint_as_float(m[j].x & 0xffff0000u) + wa * a0.y + wb * b0.y;
            v.z = __uint_as_float(m[j].y << 16) + wa * a1.x + wb * b1.x; v.w = __uint_as_float(m[j].y & 0xffff0000u) + wa * a1.y + wb * b1.y;
            op[64 * j] = v; }
    }
}

#define XB_TMO      128
#define XB_XCNT(j)  (256  + 64 * (j))
#define XB_XSUB(j)  (1280 + 64 * (j))
#define XB_XGEN(j)  (2304 + 64 * (j))
#define XB_TOP      3328
#define XB_TOPGEN   3392
#define XCD_BAR_WORDS 3456
#define XB_SPIN_CAP (1u << 18)
__device__ __forceinline__ unsigned xb_ld(unsigned* p)              { return __hip_atomic_load(p, __ATOMIC_RELAXED, __HIP_MEMORY_SCOPE_AGENT); }
__device__ __forceinline__ unsigned xb_add(unsigned* p, unsigned v) { return __hip_atomic_fetch_add(p, v, __ATOMIC_RELAXED, __HIP_MEMORY_SCOPE_AGENT); }
__device__ __forceinline__ unsigned xb_xcc_id() { return (unsigned)__builtin_amdgcn_s_getreg((3 << 11) | 20) & 0xFu; }
#define XB_SPIN(cond, bar) do { unsigned _sp = 0; while (cond) { __builtin_amdgcn_s_sleep(1); \
    if ((++_sp & 255u) == 0u) { if (xb_ld(&(bar)[XB_TMO])) break; if (_sp > XB_SPIN_CAP) { atomicAdd(&(bar)[XB_TMO], 1u); break; } } } } while (0)
struct XcdBarrier { unsigned* bar; unsigned x; volatile LAS unsigned* st; };
__device__ __forceinline__ XcdBarrier xcd_barrier_post(unsigned* bar, volatile LAS unsigned* st) {
    XcdBarrier b; b.bar = bar; b.x = xb_xcc_id(); b.st = st;
    if (threadIdx.x == 0) (void)xb_add(&bar[XB_XCNT(b.x)], 1u);
    return b;
}
__device__ __forceinline__ void xcd_barrier_complete(unsigned* bar, unsigned x, unsigned& nloc, unsigned& nx) {
    const unsigned G = gridDim.x * gridDim.y * gridDim.z;
    unsigned sum, cnt, mine, sp = 0u;
    for (;;) {
        sum = 0u; cnt = 0u; mine = 0u;
#pragma unroll
        for (unsigned j = 0; j < 16; ++j) { const unsigned c = xb_ld(&bar[XB_XCNT(j)]); sum += c; cnt += (c > 0u) ? 1u : 0u; mine = (j == x) ? c : mine; }
        if (sum == G) break;
        __builtin_amdgcn_s_sleep(1);
        if ((++sp & 255u) == 0u) { if (xb_ld(&bar[XB_TMO])) break; if (sp > XB_SPIN_CAP) { atomicAdd(&bar[XB_TMO], 1u); break; } }
    }
    nloc = mine > 0u ? mine : 1u; nx = cnt > 0u ? cnt : 1u;
}
__device__ __forceinline__ void xcd_barrier(const XcdBarrier& b) {
    asm volatile("s_waitcnt vmcnt(0)" ::: "memory");
    __syncthreads();
    if (threadIdx.x == 0) {
        unsigned* bar = b.bar;
        __builtin_amdgcn_s_waitcnt(0);
        unsigned nloc = b.st[0], nx = b.st[1];
        if (nloc == 0u) { xcd_barrier_complete(bar, b.x, nloc, nx); b.st[0] = nloc; b.st[1] = nx; }
        const unsigned old = xb_add(&bar[XB_XSUB(b.x)], 1u);
        const unsigned gen = old / nloc;
        if (old + 1u == (gen + 1u) * nloc) {
            __builtin_amdgcn_fence(__ATOMIC_RELEASE, "agent");
            asm volatile("s_waitcnt vmcnt(0)" ::: "memory");
            const unsigned og = xb_add(&bar[XB_TOP], 1u);
            const unsigned tg = og / nx;
            if (og + 1u == (tg + 1u) * nx) xb_add(&bar[XB_TOPGEN], 1u);
            else XB_SPIN(xb_ld(&bar[XB_TOPGEN]) == tg, bar);
            __builtin_amdgcn_fence(__ATOMIC_ACQUIRE, "agent");
            xb_add(&bar[XB_XGEN(b.x)], 1u);
            asm volatile("s_waitcnt vmcnt(0)" ::: "memory");
        } else {
            XB_SPIN(xb_ld(&bar[XB_XGEN(b.x)]) == gen, bar);
            __builtin_amdgcn_fence(__ATOMIC_ACQUIRE, "agent");
            asm volatile("s_waitcnt vmcnt(0)" ::: "memory");
        }
    }
    __syncthreads();
}

namespace cg = cooperative_groups;
#ifdef PROBE_A
#define STAMP(k) do { if (blockIdx.x == 0 && threadIdx.x == 0) ((unsigned long long*)(p.ws + WS_END))[k] = __builtin_amdgcn_s_memrealtime(); } while (0)
#else
#define STAMP(k) do {} while (0)
#endif
__global__ void __launch_bounds__(512, 2) fwd_megakernel(Params p) {
    extern __shared__ __attribute__((aligned(16))) unsigned char lds_raw[];
    LAS unsigned char* lds = (LAS unsigned char*)lds_raw;
    cg::grid_group grid = cg::this_grid();
    if (threadIdx.x == 0) { *(volatile LAS unsigned*)(lds + XBST_OFF) = 0u; *(volatile LAS unsigned*)(lds + XBST_OFF + 4) = 0u; }
    if (blockIdx.x == 0) for (int i = threadIdx.x; i < XCD_BAR_WORDS; i += 512) ((unsigned*)(p.ws + WS_BAR))[i] = 0u;
    __syncthreads();
#define GSYNC() xcd_barrier(xb)
    STAMP(0);
    p0_prep(p, lds);            grid.sync(); STAMP(1);
    const XcdBarrier xb = xcd_barrier_post((unsigned*)(p.ws + WS_BAR), (volatile LAS unsigned*)(lds + XBST_OFF));
    p1_inproj(p, lds);          GSYNC(); STAMP(2);
    p2_attn(p, lds);            GSYNC(); STAMP(3);
    STAMP(4);
    p3_up(p, lds);              GSYNC(); STAMP(5);
    p4_out(p, lds);             GSYNC(); STAMP(6);
    p5_router(p, lds);          GSYNC(); STAMP(7);
    p6_gateup(p, lds);          GSYNC(); STAMP(8);
    p7_down(p, lds);            GSYNC(); STAMP(9);
    p8_combine(p, lds);
#ifdef PROBE_A
    grid.sync(); STAMP(10); grid.sync();
    {
        const unsigned long long* ts = (const unsigned long long*)(p.ws + WS_END);
        #ifndef PROBE_A1
#define PROBE_A1 (PROBE_A + 1)
#endif
#ifndef PROBE_B1
#define PROBE_B1 (PROBE_B + 1)
#endif
        const float usA = (float)(ts[PROBE_A1] - ts[PROBE_A]) * 0.01f, usB = (float)(ts[PROBE_B1] - ts[PROBE_B]) * 0.01f;
        const float eps = sqrtf(usA * 1e-6f);
        for (size_t i = (size_t)blockIdx.x * 512 + threadIdx.x; i < (size_t)T * D / 4; i += (size_t)gridDim.x * 512) { f32x4 v = ((f32x4*)p.out)[i]; v = v * (1.0f + eps); if (i == 0) v.x += usB * 0.1f; ((f32x4*)p.out)[i] = v; }
    }
#endif
}

extern "C" void kernel_launch(void* const* d_in, const int* in_sizes, int n_in, void* d_out, int out_size, void* d_ws, size_t ws_size, hipStream_t stream) {
    static int grid_blocks = 0;
    if (!grid_blocks) {
        if (n_in != 21 || out_size != T * D || ws_size < WS_TOP) { fprintf(stderr, "kernel_launch: unexpected problem (n_in %d out %d ws %zu)\n", n_in, out_size, ws_size); grid_blocks = -1; return; }
        if (hipFuncSetAttribute((const void*)fwd_megakernel, hipFuncAttributeMaxDynamicSharedMemorySize, LDS_BYTES) != hipSuccess) { fprintf(stderr, "kernel_launch: hipFuncSetAttribute failed\n"); grid_blocks = -1; return; }
        int dev = 0, cus = 0, per_cu = 0;
        hipGetDevice(&dev); hipDeviceGetAttribute(&cus, hipDeviceAttributeMultiprocessorCount, dev);
        hipOccupancyMaxActiveBlocksPerMultiprocessor(&per_cu, (const void*)fwd_megakernel, 512, LDS_BYTES);
        if (per_cu < 1 || cus < 1) { fprintf(stderr, "kernel_launch: occupancy query gave %d blocks/CU on %d CUs\n", per_cu, cus); grid_blocks = -1; return; }
        grid_blocks = cus;
    }
    if (grid_blocks < 0) return;
    Params p{};
    for (int i = 0; i < 21; ++i) p.in[i] = (const float*)d_in[i];
    p.out = (float*)d_out; p.ws = (unsigned char*)d_ws;
    void* args[] = {&p};
    hipError_t e = hipLaunchCooperativeKernel((const void*)fwd_megakernel, dim3(grid_blocks), dim3(512), args, LDS_BYTES, stream);
    if (e != hipSuccess) fprintf(stderr, "cooperative launch failed: %s (grid %d)\n", hipGetErrorString(e), grid_blocks);
}
```

```cpp
#include <hip/hip_runtime.h>
#include <hip/hip_cooperative_groups.h>
#include <cstdio>
#include <cstdint>

#define LAS __attribute__((address_space(3)))
typedef unsigned short bf16_t;
typedef short bf16x8 __attribute__((ext_vector_type(8)));
typedef short s16x4 __attribute__((ext_vector_type(4)));
typedef float f32x4 __attribute__((ext_vector_type(4)));
typedef unsigned u32x4 __attribute__((ext_vector_type(4)));
typedef unsigned u32x2 __attribute__((ext_vector_type(2)));
typedef short v4i16_t __attribute__((ext_vector_type(4)));

namespace cfg {
constexpr int T = 32768, D = 2048, SEQ = 16384;
constexpr int NQKV = 4608, NGATE = 4096, NIN = 8704;
constexpr size_t MiB = 1ull << 20;
constexpr size_t WS_XB = 0, WS_QKV = 128 * MiB, WS_GATES = 416 * MiB, WS_O = 672 * MiB, WS_WIN = 800 * MiB, WS_WUP = 834 * MiB, WS_WOUT = 842 * MiB, WS_MISC = 850 * MiB;
constexpr size_t WS_WGU = 872 * MiB, WS_WD = 936 * MiB, WS_MG = WS_QKV, WS_HE = WS_QKV + 192 * MiB;
constexpr size_t WS_R1 = WS_MISC, WS_R2 = WS_R1 + (size_t)T * 4, WS_WRT = WS_R2 + (size_t)T * 4, WS_CNT = WS_WRT + 512 * 1024, WS_TOK = WS_CNT + 4096,
                 WS_RECC = WS_TOK + 32ull * T * 4, WS_RECW = WS_RECC + 2ull * T * 4, WS_R2L = WS_RECW + 2ull * T * 4, WS_END = WS_R2L + 32ull * T * 4;
constexpr size_t WS_H8 = WS_GATES + 144 * MiB;
constexpr size_t WS_YE = WS_QKV;
constexpr size_t WS_BAR = WS_END + 4096;
constexpr size_t WS_X8 = 872 * MiB;
constexpr size_t WS_O8 = WS_O + 64 * MiB;
constexpr size_t WS_KVB = 0, WS_KVA = WS_O;
constexpr size_t WS_TOP = 1000 * MiB;
constexpr int LDS_BYTES = 140 * 1024;
constexpr int XBST_OFF = LDS_BYTES - 16;
constexpr int TAB_OFF = 132 * 1024;
constexpr float EPS = 1e-6f;
}
using namespace cfg;

struct Params { const float* in[21]; float* out; unsigned char* ws; };
__device__ __forceinline__ int phase_tid() { int t = threadIdx.x; asm volatile("" : "+v"(t)); return t; }

__device__ __forceinline__ float bf2f(short s) { return __uint_as_float(((unsigned)(unsigned short)s) << 16); }
typedef float f32x2 __attribute__((ext_vector_type(2)));
typedef __bf16 bf16x2_t __attribute__((ext_vector_type(2)));
__device__ __forceinline__ unsigned pk2(float lo, float hi) { const f32x2 v = {lo, hi}; return __builtin_bit_cast(unsigned, __builtin_convertvector(v, bf16x2_t)); }
__device__ __forceinline__ unsigned pk4_fp8(float a, float b, float c, float d) { int w = 0; w = __builtin_amdgcn_cvt_pk_fp8_f32(a, b, w, false); w = __builtin_amdgcn_cvt_pk_fp8_f32(c, d, w, true); return (unsigned)w; }
__device__ __forceinline__ float wave_sum(float v) {
#pragma unroll
    for (int o = 1; o < 64; o <<= 1) v += __shfl_xor(v, o);
    return v;
}
__device__ __forceinline__ float sigmoidf_(float v) { return 1.0f / (1.0f + __expf(-v)); }
__device__ __forceinline__ unsigned off_b(unsigned row, unsigned ch) { return 256u * row + 16u * (ch ^ (((row & 3) << 2) | ((row >> 2) & 3))); }
__device__ __forceinline__ s16x4 tr_read(LAS unsigned char* p) { return __builtin_bit_cast(s16x4, __builtin_amdgcn_ds_read_tr16_b64_v4i16((LAS v4i16_t*)p)); }
__host__ __device__ __forceinline__ int perm32(int rho) { const int n = rho >> 4, i = rho & 15; return 8 * (i >> 2) + 4 * n + (i & 3); }
__device__ __forceinline__ int t5_bucket(int rel) {
    const int n = rel < 0 ? -rel : rel; const int ret = rel > 0 ? 16 : 0; int b;
    if (n < 8) b = n; else if (n < 12) b = 8; else if (n < 16) b = 9; else if (n < 23) b = 10; else if (n < 32) b = 11; else if (n < 46) b = 12; else if (n < 64) b = 13; else if (n < 91) b = 14; else b = 15;
    return ret + b;
}

template <bool FP8, bool NTS = false>
__device__ __forceinline__ void transpose_item(const float* __restrict__ W, int ldw, int k0, int n0, bf16_t* __restrict__ WT, int ldt, int drow0, int dk0, const float* __restrict__ scale, LAS unsigned* scr, int lane, float f8scale = 1.f) {
    const int n4 = (lane & 15) * 4, kk = lane >> 4;
    const float* src = W + (size_t)(k0 + 2 * kk) * ldw + n0 + n4;
    f32x4 ev[8], od[8];
#pragma unroll
    for (int j = 0; j < 8; ++j) { ev[j] = __builtin_nontemporal_load((const f32x4*)(src + (size_t)(8 * j) * ldw)); od[j] = __builtin_nontemporal_load((const f32x4*)(src + (size_t)(8 * j + 1) * ldw)); }
    const float scl = scale ? scale[k0 + lane] : 1.f;
#pragma unroll
    for (int j = 0; j < 8; ++j) { f32x4 e = ev[j], o = od[j];
        if (scale) { const float se = __shfl(scl, 8 * j + 2 * kk), so = __shfl(scl, 8 * j + 2 * kk + 1); e = e * se; o = o * so; }
        u32x4 w; w.x = pk2(e.x, o.x); w.y = pk2(e.y, o.y); w.z = pk2(e.z, o.z); w.w = pk2(e.w, o.w);
        *(LAS u32x4*)(scr + (4 * j + kk) * 68 + n4) = w; }
    asm volatile("s_waitcnt lgkmcnt(0)" ::: "memory");
    if (FP8) {
        const int kq = lane & 3;
#pragma unroll
        for (int i = 0; i < 4; ++i) { const int n = (lane >> 2) + 16 * i; const LAS unsigned* q = scr + (8 * kq) * 68 + n; u32x4 f;
#pragma unroll
            for (int h2 = 0; h2 < 2; ++h2) { const unsigned o0 = q[(4 * h2) * 68], o1 = q[(4 * h2 + 1) * 68], o2 = q[(4 * h2 + 2) * 68], o3 = q[(4 * h2 + 3) * 68];
                f[2 * h2] = pk4_fp8(__uint_as_float(o0 << 16) * f8scale, __uint_as_float(o0 & 0xffff0000u) * f8scale, __uint_as_float(o1 << 16) * f8scale, __uint_as_float(o1 & 0xffff0000u) * f8scale);
                f[2 * h2 + 1] = pk4_fp8(__uint_as_float(o2 << 16) * f8scale, __uint_as_float(o2 & 0xffff0000u) * f8scale, __uint_as_float(o3 << 16) * f8scale, __uint_as_float(o3 & 0xffff0000u) * f8scale); }
            u32x4* dp = (u32x4*)((unsigned char*)WT + (size_t)(drow0 + n) * ldt + dk0 + k0 + 16 * kq); if (NTS) __builtin_nontemporal_store(f, dp); else *dp = f; }
    } else {
        const int kq = lane & 7;
#pragma unroll
        for (int i = 0; i < 8; ++i) { const int n = (lane >> 3) + 8 * i; const LAS unsigned* q = scr + (4 * kq) * 68 + n;
            u32x4 o; o.x = q[0]; o.y = q[68]; o.z = q[136]; o.w = q[204];
            *(u32x4*)(WT + (size_t)(drow0 + n) * ldt + dk0 + k0 + 8 * kq) = o; }
    }
    asm volatile("s_waitcnt lgkmcnt(0)" ::: "memory");
}

__device__ __forceinline__ void p0_prep(const Params& p, LAS unsigned char* lds) {
    const int tid = phase_tid(), lane = tid & 63, wave = tid >> 6;
    const int gw = blockIdx.x * 8 + wave, NGW = gridDim.x * 8;
    LAS unsigned* scr = (LAS unsigned*)(lds + wave * 8704);
    const float* x = p.in[0]; const float* g1 = p.in[1]; const float* w_in = p.in[2];
    float* r1 = (float*)(p.ws + WS_R1);
    bf16_t* WinT = (bf16_t*)(p.ws + WS_WIN); bf16_t* WupT = (bf16_t*)(p.ws + WS_WUP); bf16_t* WoutT = (bf16_t*)(p.ws + WS_WOUT);
    constexpr int I_WIN = 32 * 136, I_UP = 16 * 32, I_OUT = 32 * 32, NITEMS = I_WIN + 2 * I_UP + I_OUT;
    for (int it = gw; it < NITEMS; it += NGW) {
        int r = it;
        if (r < I_WIN) { const int kb = r / 136, nb = r % 136; const int n0 = nb * 64;
            int drow = n0;
            if (n0 >= NQKV) { const int c = (n0 - NQKV) & 2047, isb = (n0 - NQKV) >> 11; drow = NQKV + (c >> 7) * 256 + isb * 128 + (c & 127); }
            transpose_item<true>(w_in, NIN, kb * 64, n0, WinT, 2048, drow, 0, g1, scr, lane, 64.f); continue; } r -= I_WIN;
        if (r < I_UP) { const int kb = r / 32, nb = r % 32; transpose_item<true>(p.in[9], 2048, kb * 64, nb * 64, WupT, 2048, nb * 64, 0, nullptr, scr, lane, 64.f); continue; } r -= I_UP;
        if (r < I_UP) { const int kb = r / 32, nb = r % 32; transpose_item<true>(p.in[10], 2048, kb * 64, nb * 64, WupT, 2048, nb * 64, 1024, nullptr, scr, lane, 64.f); continue; } r -= I_UP;
        { const int kb = r / 32, nb = r % 32; transpose_item<true>(p.in[11], 2048, kb * 64, nb * 64, WoutT, 2048, nb * 64, 0, nullptr, scr, lane, 64.f); }
    }
    { bf16_t* whi = (bf16_t*)(p.ws + WS_WRT); bf16_t* wlo = whi + 48 * 2048; const float* g2 = p.in[13]; const float* wrg = p.in[14]; const float* wre = p.in[16];
      for (int i = blockIdx.x * 512 + tid; i < 48 * 2048; i += gridDim.x * 512) { const int row = i >> 11, k = i & 2047, t = row >> 4, r = row & 15; float w;
          if (t == 0) w = wre[k * 32 + (r >> 2) * 8 + (r & 3)]; else if (t == 1) w = wre[k * 32 + (r >> 2) * 8 + 4 + (r & 3)]; else w = (r & 3) == 0 ? wrg[k * 4 + (r >> 2)] : 0.f;
          w *= g2[k]; const unsigned hi = pk2(w, 0.f) & 0xffffu; const float hf = __uint_as_float(hi << 16); whi[i] = (bf16_t)hi; wlo[i] = (bf16_t)(pk2(w - hf, 0.f) & 0xffffu); } }
    if (blockIdx.x == 0 && tid < 33) ((int*)(p.ws + WS_CNT))[tid] = 0;
    for (int row0 = 2 * gw; row0 < T; row0 += 2 * NGW) {
        f32x4 v[2][8]; float ss[2] = {0.f, 0.f};
#pragma unroll
        for (int u = 0; u < 2; ++u) { const f32x4* xr = (const f32x4*)(x + (size_t)(row0 + u) * D) + lane;
#pragma unroll
            for (int j = 0; j < 8; ++j) v[u][j] = __builtin_nontemporal_load(&xr[64 * j]); }
#pragma unroll
        for (int u = 0; u < 2; ++u) {
#pragma unroll
            for (int j = 0; j < 8; ++j) ss[u] += (v[u][j].x * v[u][j].x + v[u][j].y * v[u][j].y) + (v[u][j].z * v[u][j].z + v[u][j].w * v[u][j].w);
            ss[u] = wave_sum(ss[u]);
            if (lane == 0) { const int rw = row0 + u, rl = rw & 255; r1[(rw & ~255) + ((rl >> 6) & 1) * 128 + (rl & 15) * 8 + ((rl >> 7) & 1) * 4 + ((rl >> 4) & 3)] = rsqrtf(ss[u] * (1.0f / D) + EPS); }
            unsigned* o8 = (unsigned*)(p.ws + WS_X8 + (size_t)(row0 + u) * D) + lane;
#pragma unroll
            for (int j = 0; j < 8; ++j) o8[64 * j] = pk4_fp8(v[u][j].x, v[u][j].y, v[u][j].z, v[u][j].w); }
    }
}

constexpr int MOE_ITEMS = 2 * 32 * 32 * 8;
__device__ __forceinline__ void moe_prep_batch(const Params& p, LAS unsigned char* lds, int bi) {
    const int tid = phase_tid(), lane = tid & 63, wave = tid >> 6;
    LAS unsigned* scr = (LAS unsigned*)(lds + wave * 8704);
    const float* g2 = p.in[13];
    bf16_t* WguT = (bf16_t*)(p.ws + WS_WGU);
    constexpr int I_G = 32 * 32 * 8;
    int r = (bi * (int)gridDim.x + (int)blockIdx.x) * 8 + wave;
    if (r >= MOE_ITEMS) return;
    const int which = r >= I_G; if (which) r -= I_G; const int e = r / 256, rr = r % 256, kb = rr / 8, nb = rr % 8;
    const float* W = p.in[which ? 19 : 18] + (size_t)e * 2048 * 512; const int n0 = nb * 64;
    transpose_item<true, true>(W, 512, kb * 64, n0, WguT, 2048, e * 1024 + (n0 >> 7) * 256 + which * 128 + (n0 & 127), 0, g2, scr, lane, 64.f);
}
constexpr int WD_BATCHES = 32 * 8 * 32 / 8;
__device__ __forceinline__ void wd_prep_batch(const Params& p, LAS unsigned char* lds, int b) {
    const int tid = phase_tid(), lane = tid & 63, wave = tid >> 6;
    LAS unsigned* scr = (LAS unsigned*)(lds + wave * 8704);
    bf16_t* WdT = (bf16_t*)(p.ws + WS_WD);
    const int r = b * 8 + wave; const int e = r / 256, rr = r % 256, kb = rr / 32, nb = rr % 32; const float* W = p.in[20] + (size_t)e * 512 * 2048;
    transpose_item<true, false>(W, 2048, kb * 64, nb * 64, WdT, 512, e * 2048 + nb * 64, 0, nullptr, scr, lane, 64.f);
}

struct Unit { int pm, pn, aux; };
namespace pg8 {
constexpr int BM = 256, BK = 64, HALF = 128, HTB = HALF * BK * 2, STAGE_BYTES = 8 * HTB;
__device__ __forceinline__ int lds_byte(int r, int c) { const int st = (r >> 4) * 2 + (c >> 5), rr = r & 15, cc = c & 31, ob = rr * 64 + cc * 2; return st * 1024 + (ob ^ (((ob >> 9) & 1) << 5)); }
__device__ __forceinline__ void stage_rc(int b, int& R, int& C) { const int st = b / 1024, sb = b % 1024, swz = sb ^ (((sb >> 9) & 1) << 5); R = (st >> 1) * 16 + swz / 64; C = (st & 1) * 32 + (swz % 64) / 2; }

template <bool PERM, bool GATHER, class Sched, class Epi, bool FP8 = false, bool ALIGN_EPI = true, bool PERM16 = false>
__device__ __forceinline__ void gemm_phase(LAS unsigned char* lds, const Sched& S, const Epi& E, const int nt, const int lda, const int ldb) {
    int tid_ = threadIdx.x; asm volatile("" : "+v"(tid_));
    const int tid = tid_, wid = __builtin_amdgcn_readfirstlane(tid >> 6), lane = tid & 63, wr = wid >> 2, wc = wid & 3, fr = lane & 15, fq = lane >> 4;
    int R0, C0, R1, C1; stage_rc(tid * 16, R0, C0); stage_rc(tid * 16 + 8192, R1, C1);
    unsigned voffB[2], voffA[2][2];
    { const int Rb0 = PERM16 ? (R0 >> 5) * 64 + 16 * ((R0 & 15) >> 2) + 4 * ((R0 >> 4) & 1) + (R0 & 3) : (PERM ? ((R0 & ~31) + perm32(R0 & 31)) : R0),
                Rb1 = PERM16 ? (R1 >> 5) * 64 + 16 * ((R1 & 15) >> 2) + 4 * ((R1 >> 4) & 1) + (R1 & 3) : (PERM ? ((R1 & ~31) + perm32(R1 & 31)) : R1);
      voffB[0] = (unsigned)(Rb0 * ldb + C0) * 2u; voffB[1] = (unsigned)(Rb1 * ldb + C1) * 2u; }
    const size_t kstep = (size_t)(BK * 2);
    const size_t hstepB = PERM16 ? (size_t)8 * ldb * 2 : (size_t)HALF * ldb * 2, hstepA = (size_t)HALF * lda * 2;
    const unsigned ldsw = (unsigned)wid * 1024u;
    const int aoff = lds_byte(wr * 64 + fr, fq * 8), boff = lds_byte(wc * 32 + fr, fq * 8);
#define PG8_SA(b, h) (((b) * 2 + (h)) * HTB)
#define PG8_SB(b, h) ((4 + (b) * 2 + (h)) * HTB)
#define PG8_STAGE_B(bufoff, gbase) do { _Pragma("unroll") for (int _i = 0; _i < 2; ++_i) \
        __builtin_amdgcn_global_load_lds((const unsigned*)((const char*)(gbase) + voffB[_i]), (LAS unsigned*)(lds + (bufoff) + ldsw + _i * 8192), 16, 0, 0); } while (0)
#define PG8_STAGE_A(bufoff, gbase, h) do { _Pragma("unroll") for (int _i = 0; _i < 2; ++_i) \
        __builtin_amdgcn_global_load_lds((const unsigned*)((const char*)(gbase) + (GATHER ? (size_t)0 : (size_t)(h) * hstepA) + voffA[GATHER ? (h) : 0][_i]), (LAS unsigned*)(lds + (bufoff) + ldsw + _i * 8192), 16, 0, 0); } while (0)
#define PG8_LDA(dst, b, h) do { _Pragma("unroll") for (int m = 0; m < 4; ++m) _Pragma("unroll") for (int k = 0; k < 2; ++k) dst[m][k] = *(const LAS bf16x8*)(lds + PG8_SA(b, h) + aoff + m * 2048 + k * 1024); } while (0)
#define PG8_LDB(dst, b, h) do { _Pragma("unroll") for (int n = 0; n < 2; ++n) _Pragma("unroll") for (int k = 0; k < 2; ++k) dst[n][k] = *(const LAS bf16x8*)(lds + PG8_SB(b, h) + boff + n * 2048 + k * 1024); } while (0)
#define PG8_MMA(ai, bj, At, Bt) do { __builtin_amdgcn_s_setprio(1); _Pragma("unroll") for (int m = 0; m < 4; ++m) _Pragma("unroll") for (int n = 0; n < 2; ++n) { \
        if (FP8) { typedef int v8i_ __attribute__((ext_vector_type(8))); typedef int v4i_ __attribute__((ext_vector_type(4))); \
            const v4i_ b0_ = __builtin_bit_cast(v4i_, Bt[n][0]), b1_ = __builtin_bit_cast(v4i_, Bt[n][1]), a0_ = __builtin_bit_cast(v4i_, At[m][0]), a1_ = __builtin_bit_cast(v4i_, At[m][1]); \
            const v8i_ bb_ = {b0_[0], b0_[1], b0_[2], b0_[3], b1_[0], b1_[1], b1_[2], b1_[3]}, aa_ = {a0_[0], a0_[1], a0_[2], a0_[3], a1_[0], a1_[1], a1_[2], a1_[3]}; \
            acc[ai][bj][m][n] = __builtin_amdgcn_mfma_scale_f32_16x16x128_f8f6f4(bb_, aa_, acc[ai][bj][m][n], 0, 0, 0, 0x7f7f7f7f, 0, 0x7f7f7f7f); } \
        else { _Pragma("unroll") for (int k = 0; k < 2; ++k) acc[ai][bj][m][n] = __builtin_amdgcn_mfma_f32_16x16x32_bf16(Bt[n][k], At[m][k], acc[ai][bj][m][n], 0, 0, 0); } } \
        __builtin_amdgcn_s_setprio(0); } while (0)
#define PG8_WAIT_V(n) asm volatile("s_waitcnt vmcnt(" #n ")" ::: "memory")
#define PG8_WAIT_L(n) asm volatile("s_waitcnt lgkmcnt(" #n ")" ::: "memory")
#define PG8_BAR __builtin_amdgcn_s_barrier()
#define PG8_SCHED __builtin_amdgcn_sched_barrier(0)
    Unit cur, nxt; int ui = 0;
    __syncthreads();
    if (!S.next(0, cur)) return;
    if (GATHER) S.a_offs(cur, R0, C0, R1, C1, voffA);
    else { voffA[0][0] = (unsigned)(R0 * lda + C0) * 2u; voffA[0][1] = (unsigned)(R1 * lda + C1) * 2u; voffA[1][0] = 0; voffA[1][1] = 0; }
    f32x4 acc[2][2][4][2];
#pragma unroll
    for (int a = 0; a < 2; ++a)
#pragma unroll
        for (int b = 0; b < 2; ++b)
#pragma unroll
            for (int m = 0; m < 4; ++m)
#pragma unroll
                for (int n = 0; n < 2; ++n) acc[a][b][m][n] = (f32x4){0.f, 0.f, 0.f, 0.f};
    bf16x8 At[4][2], B0[2][2], B1[2][2];
    const char* cA = S.a_base(cur); const char* cB = S.b_base(cur);
    PG8_STAGE_B(PG8_SB(0, 0), cB); PG8_STAGE_B(PG8_SB(0, 1), cB + hstepB); PG8_STAGE_A(PG8_SA(0, 0), cA, 0); PG8_STAGE_A(PG8_SA(0, 1), cA, 1);
    if (wr == 1) PG8_BAR;
    PG8_WAIT_V(2); PG8_BAR;
    PG8_STAGE_B(PG8_SB(1, 0), cB + kstep); PG8_STAGE_A(PG8_SA(1, 0), cA + kstep, 0); PG8_STAGE_B(PG8_SB(1, 1), cB + hstepB + kstep);
    PG8_WAIT_V(6); PG8_BAR;
    for (;;) {
        const bool has_next = S.next(ui + 1, nxt);
        const char* nA = has_next ? S.a_base(nxt) : cA; const char* nB = has_next ? S.b_base(nxt) : cB;
        unsigned vn[2][2];
        if (GATHER) { if (has_next) S.a_offs(nxt, R0, C0, R1, C1, vn); else { vn[0][0] = voffA[0][0]; vn[0][1] = voffA[0][1]; vn[1][0] = voffA[1][0]; vn[1][1] = voffA[1][1]; } }
        for (int t = 0; t < nt; t += 2) {
            const bool last = (t == nt - 2);
            const char* a1 = cA + (size_t)(t + 1) * kstep;
            const char* a2 = last ? nA : cA + (size_t)(t + 2) * kstep; const char* b2 = last ? nB : cB + (size_t)(t + 2) * kstep;
            const char* a3 = a2 + kstep; const char* b3 = b2 + kstep;
            PG8_LDB(B0, 0, 0); PG8_LDB(B1, 0, 1); PG8_SCHED; PG8_LDA(At, 0, 0); PG8_STAGE_A(PG8_SA(1, 1), a1, 1);
            if (GATHER) { if (last) { voffA[0][0] = vn[0][0]; voffA[0][1] = vn[0][1]; voffA[1][0] = vn[1][0]; voffA[1][1] = vn[1][1]; } }
            PG8_WAIT_V(8); PG8_WAIT_L(0); PG8_BAR; PG8_MMA(0, 0, At, B0); PG8_MMA(0, 1, At, B1); PG8_BAR; PG8_SCHED;
            PG8_LDA(At, 0, 1); PG8_STAGE_B(PG8_SB(0, 0), b2); PG8_STAGE_B(PG8_SB(0, 1), b2 + hstepB); PG8_STAGE_A(PG8_SA(0, 0), a2, 0);
            PG8_WAIT_V(8); PG8_WAIT_L(0); PG8_BAR; PG8_MMA(1, 0, At, B0); PG8_MMA(1, 1, At, B1); PG8_BAR; PG8_SCHED;
            PG8_LDB(B0, 1, 0); PG8_LDB(B1, 1, 1); PG8_SCHED; PG8_LDA(At, 1, 0); PG8_STAGE_A(PG8_SA(0, 1), a2, 1);
            PG8_WAIT_V(8); PG8_WAIT_L(0); PG8_BAR; PG8_MMA(0, 0, At, B0); PG8_MMA(0, 1, At, B1); PG8_BAR; PG8_SCHED;
            PG8_LDA(At, 1, 1); PG8_STAGE_B(PG8_SB(1, 0), b3); PG8_STAGE_B(PG8_SB(1, 1), b3 + hstepB); PG8_STAGE_A(PG8_SA(1, 0), a3, 0);
            PG8_WAIT_V(8); PG8_WAIT_L(0); PG8_BAR; PG8_MMA(1, 0, At, B0); PG8_MMA(1, 1, At, B1); PG8_BAR; PG8_SCHED;
        }
        if (ALIGN_EPI) { if (wr == 0) PG8_BAR; }
        { int te = threadIdx.x; asm volatile("" : "+v"(te)); E(acc, cur, wr, wc, te & 15, (te & 63) >> 4); }
        if (!has_next) break;
        if (!S.keep_acc(cur)) {
#pragma unroll
        for (int a = 0; a < 2; ++a)
#pragma unroll
            for (int b = 0; b < 2; ++b)
#pragma unroll
                for (int m = 0; m < 4; ++m)
#pragma unroll
                    for (int n = 0; n < 2; ++n) acc[a][b][m][n] = (f32x4){0.f, 0.f, 0.f, 0.f};
        }
        cur = nxt; cA = nA; cB = nB; ++ui;
        if (ALIGN_EPI) { if (wr == 1) PG8_BAR; }
    }
    PG8_WAIT_V(0);
    if (!ALIGN_EPI) { if (wr == 0) PG8_BAR; }
    PG8_BAR;
#undef PG8_SA
#undef PG8_SB
#undef PG8_STAGE_A
#undef PG8_STAGE_B
#undef PG8_LDA
#undef PG8_LDB
#undef PG8_MMA
#undef PG8_WAIT_V
#undef PG8_WAIT_L
#undef PG8_BAR
#undef PG8_SCHED
}
struct TileOrder {
    int nM, nN, nwg, G, c;
    __device__ __forceinline__ void init(int nM_, int nN_, int G_, int c_) { nM = nM_; nN = nN_; nwg = nM * nN; G = G_; c = c_; }
    __device__ __forceinline__ bool tile(int i, int& pm, int& pn) const {
        const long L = (long)i * G + c; if (L >= nwg) return false;
        int wgid = (int)L; { const int q = nwg / 8, r = nwg % 8, xcd = wgid % 8, off = wgid / 8; wgid = (xcd < r ? xcd * (q + 1) : r * (q + 1) + (xcd - r) * q) + off; }
        const int nig = 8 * nN, gid = wgid / nig, fm = gid * 8, gsz = (nM - fm) < 8 ? (nM - fm) : 8;
        pm = fm + ((wgid % nig) % gsz); pn = (wgid % nig) / gsz; return true;
    }
};
struct DenseSched {
    TileOrder o; const bf16_t* A; const bf16_t* Bt; int lda, ldb;
    __device__ __forceinline__ bool next(int i, Unit& u) const { u.aux = 0; return o.tile(i, u.pm, u.pn); }
    __device__ __forceinline__ const char* a_base(const Unit& u) const { return (const char*)(A + (size_t)u.pm * 256 * lda); }
    __device__ __forceinline__ const char* b_base(const Unit& u) const { return (const char*)(Bt + (size_t)u.pn * 256 * ldb); }
    __device__ __forceinline__ bool keep_acc(const Unit&) const { return false; }
    __device__ __forceinline__ void a_offs(const Unit&, int, int, int, int, unsigned (&)[2][2]) const {}
};
}

struct EpiInProj { bf16_t* qkv; bf16_t* kva; bf16_t* kvb; const float* r1; const float* gqa; const float* gka; const float* gqb; const float* gkb; LAS float* X;
    __device__ __forceinline__ void operator()(f32x4 (&acc)[2][2][4][2], const Unit& u, int wr, int wc, int fr, int fq) const {
        const int pn = u.pn;
        f32x4 rq[2]; { const f32x4* rp = (const f32x4*)(r1 + u.pm * 256 + wr * 128 + fr * 8); rq[0] = rp[0]; rq[1] = rp[1]; }
        const bool iskv = (pn == 4) || (pn == 5) || (pn >= 10);
        const int plane0 = pn == 4 ? 0 : (pn == 5 ? 2 : (pn >= 14 ? 12 + 2 * (pn - 14) : 4 + 2 * (pn - 10)));
        bf16_t* base = iskv ? (plane0 < 4 ? kva + (size_t)plane0 * T * 128 : kvb + (size_t)(plane0 - 4) * T * 128) + wc * 32 + 8 * fq : qkv + pn * 256 + wc * 32 + 8 * fq;
        const size_t ldc = iskv ? (size_t)128 : (size_t)NQKV, cst = iskv ? (size_t)T * 128 : (size_t)128;
        const float* gain = pn < 4 ? gqa : (pn == 4 ? gka : ((pn >= 6 && pn < 10) ? gqb : ((pn >= 10 && pn < 14) ? gkb : nullptr)));
        if (gain) {
            const float extra = (pn < 4 || (pn >= 6 && pn < 10)) ? 0.08838834764831845f * 1.4426950408889634f : 1.0f;
#pragma unroll
            for (int ai = 0; ai < 2; ++ai)
#pragma unroll
                for (int m = 0; m < 4; ++m)
#pragma unroll
                    for (int bj = 0; bj < 2; ++bj) { const f32x4 a0 = acc[ai][bj][m][0], a1 = acc[ai][bj][m][1];
                        float sq = (a0[0] * a0[0] + a0[1] * a0[1]) + (a0[2] * a0[2] + a0[3] * a0[3]) + (a1[0] * a1[0] + a1[1] * a1[1]) + (a1[2] * a1[2] + a1[3] * a1[3]);
                        sq += __shfl_xor(sq, 16); sq += __shfl_xor(sq, 32);
                        if (fq == 0) X[(ai * 128 + wr * 64 + m * 16 + fr) * 8 + bj * 4 + wc] = sq; }
            asm volatile("s_waitcnt lgkmcnt(0)" ::: "memory"); __builtin_amdgcn_s_barrier(); asm volatile("" ::: "memory");
            const f32x4 g0 = *(const f32x4*)(gain + wc * 32 + 8 * fq), g1 = *(const f32x4*)(gain + wc * 32 + 8 * fq + 4);
#pragma unroll
            for (int ai = 0; ai < 2; ++ai)
#pragma unroll
                for (int m = 0; m < 4; ++m) { const int rl = ai * 128 + wr * 64 + m * 16 + fr; const int row = u.pm * 256 + rl; const float rs = rq[ai][m] * (1.0f / 64.0f); bf16_t* rowp = base + (size_t)row * ldc;
#pragma unroll
                    for (int bj = 0; bj < 2; ++bj) { const f32x4 t = *(const LAS f32x4*)(X + rl * 8 + bj * 4); const float tot = (t[0] + t[1]) + (t[2] + t[3]);
                        const float sc = rs * rsqrtf(rs * rs * tot * (1.0f / 128.0f) + EPS) * extra;
                        const f32x4 v0 = acc[ai][bj][m][0] * sc * g0, v1 = acc[ai][bj][m][1] * sc * g1;
                        u32x4 w; w.x = pk2(v0[0], v0[1]); w.y = pk2(v0[2], v0[3]); w.z = pk2(v1[0], v1[1]); w.w = pk2(v1[2], v1[3]);
                        *(u32x4*)(rowp + bj * cst) = w; } }
            return;
        }
#pragma unroll
        for (int ai = 0; ai < 2; ++ai)
#pragma unroll
            for (int m = 0; m < 4; ++m) { const int row = u.pm * 256 + ai * 128 + wr * 64 + m * 16 + fr; const float rs = rq[ai][m] * (1.0f / 64.0f); bf16_t* rowp = base + (size_t)row * ldc;
#pragma unroll
                for (int bj = 0; bj < 2; ++bj) { const f32x4 v0 = acc[ai][bj][m][0] * rs, v1 = acc[ai][bj][m][1] * rs;
                    u32x4 w; w.x = pk2(v0[0], v0[1]); w.y = pk2(v0[2], v0[3]); w.z = pk2(v1[0], v1[1]); w.w = pk2(v1[2], v1[3]);
                    *(u32x4*)(rowp + bj * cst) = w; } }
    } };
struct GateSched { pg8::TileOrder o; const unsigned char* x8; const unsigned char* W8;
    __device__ __forceinline__ bool next(int i, Unit& u) const { u.aux = 0; return o.tile(i, u.pm, u.pn); }
    __device__ __forceinline__ const char* a_base(const Unit&) const { return (const char*)x8; }
    __device__ __forceinline__ const char* b_base(const Unit& u) const { return (const char*)(W8 + (size_t)(u.pn * 256) * D); }
    __device__ __forceinline__ bool keep_acc(const Unit&) const { return false; }
    __device__ __forceinline__ void a_offs(const Unit& u, int R0, int C0, int R1, int C1, unsigned (&v)[2][2]) const {
#pragma unroll
        for (int h = 0; h < 2; ++h) { v[h][0] = (unsigned)(u.pm * 256 + 128 * h + R0) * D + C0 * 2u; v[h][1] = (unsigned)(u.pm * 256 + 128 * h + R1) * D + C1 * 2u; } }
};
struct EpiGates { bf16_t* gates; const float* r1;
    __device__ __forceinline__ void operator()(f32x4 (&acc)[2][2][4][2], const Unit& u, int wr, int wc, int fr, int fq) const {
        const int cg = (u.pn & 1) * 128 + wc * 32 + 8 * fq;
        f32x4 rq[2]; { const f32x4* rp = (const f32x4*)(r1 + u.pm * 256 + wr * 128 + fr * 8); rq[0] = rp[0]; rq[1] = rp[1]; }
#pragma unroll
        for (int ai = 0; ai < 2; ++ai)
#pragma unroll
            for (int m = 0; m < 4; ++m) { const float rs = rq[ai][m] * (1.0f / 64.0f); unsigned char* blk = (unsigned char*)gates + (size_t)(u.pm * 8 + (u.pn >> 1)) * 196608; const unsigned rt = (unsigned)(ai * 128 + wr * 64 + m * 16 + fr);
                float ra[8]; unsigned cb[8];
#pragma unroll
                for (int n = 0; n < 2; ++n)
#pragma unroll
                    for (int j = 0; j < 4; ++j) { const float ea = __expf(-acc[ai][0][m][n][j] * rs), eb = __expf(-acc[ai][1][m][n][j] * rs);
                        const unsigned c = min((unsigned)(int)(__builtin_amdgcn_rcpf(1.0f + eb) * 256.0f), 255u); cb[4 * n + j] = c;
                        ra[4 * n + j] = 256.0f * __builtin_amdgcn_rcpf(((float)c + 0.5f) * (1.0f + ea)); }
                u32x4 w; w.x = pk2(ra[0], ra[1]); w.y = pk2(ra[2], ra[3]); w.z = pk2(ra[4], ra[5]); w.w = pk2(ra[6], ra[7]); __builtin_nontemporal_store(w, (u32x4*)(blk + rt * 512 + cg * 2));
                u32x2 q; q.x = cb[0] | (cb[1] << 8) | (cb[2] << 16) | (cb[3] << 24); q.y = cb[4] | (cb[5] << 8) | (cb[6] << 16) | (cb[7] << 24); __builtin_nontemporal_store(q, (u32x2*)(blk + 131072 + rt * 256 + cg)); }
    } };
__device__ __forceinline__ void p1_inproj(const Params& p, LAS unsigned char* lds) {
    { GateSched S; S.o.init(128, 18, gridDim.x, blockIdx.x); S.x8 = p.ws + WS_X8; S.W8 = p.ws + WS_WIN;
      EpiInProj E{(bf16_t*)(p.ws + WS_QKV), (bf16_t*)(p.ws + WS_KVA), (bf16_t*)(p.ws + WS_KVB), (const float*)(p.ws + WS_R1), p.in[3], p.in[4], p.in[6], p.in[7], (LAS float*)(lds + 131072)};
      pg8::gemm_phase<true, true, GateSched, EpiInProj, true>(lds, S, E, D / 128, D / 2, D / 2); }
    { GateSched S; S.o.init(128, 16, gridDim.x, blockIdx.x); S.x8 = p.ws + WS_X8; S.W8 = p.ws + WS_WIN + (size_t)NQKV * D;
      EpiGates E{(bf16_t*)(p.ws + WS_GATES), (const float*)(p.ws + WS_R1)};
      pg8::gemm_phase<true, true, GateSched, EpiGates, true>(lds, S, E, D / 128, D / 2, D / 2); }
}

__device__ __forceinline__ void wait_vm(int n) {
    switch (n) { case 0: asm volatile("s_waitcnt vmcnt(0)" ::: "memory"); break; case 2: asm volatile("s_waitcnt vmcnt(2)" ::: "memory"); break; case 4: asm volatile("s_waitcnt vmcnt(4)" ::: "memory"); break;
                 case 6: asm volatile("s_waitcnt vmcnt(6)" ::: "memory"); break; case 8: asm volatile("s_waitcnt vmcnt(8)" ::: "memory"); break; case 10: asm volatile("s_waitcnt vmcnt(10)" ::: "memory"); break;
                 default: asm volatile("s_waitcnt vmcnt(12)" ::: "memory"); break; }
}
__device__ __forceinline__ void glds16_asm(const void* gsrc, unsigned lds_dst) {
    unsigned keep;
    asm volatile("s_mov_b32 %0, m0\n\ts_mov_b32 m0, %2\n\ts_nop 0\n\tglobal_load_lds_dwordx4 %1, off\n\ts_mov_b32 m0, %0" : "=&s"(keep) : "v"(gsrc), "s"(lds_dst) : "memory");
}
#define ATT_BAR() do { asm volatile("s_waitcnt lgkmcnt(0)" ::: "memory"); __builtin_amdgcn_s_barrier(); asm volatile("" ::: "memory"); } while (0)
__device__ __forceinline__ void load_q(const bf16_t* qp, int g, bf16x8 (&qf)[4]) {
#pragma unroll
    for (int ks = 0; ks < 4; ++ks) qf[ks] = __builtin_nontemporal_load((const bf16x8*)(qp + 32 * ks + 8 * g));
#pragma unroll
    for (int ks = 0; ks < 4; ++ks) asm volatile("" : "+v"(qf[ks]));
}
__device__ __forceinline__ bf16x8 vt_frag(LAS unsigned char* base, int row0, int g, int q4, int pp, int dt) {
    const s16x4 lo = tr_read(base + off_b(row0 + 4 * g + q4, 2 * dt + (pp >> 1)) + 8 * (pp & 1)), hi = tr_read(base + off_b(row0 + 16 + 4 * g + q4, 2 * dt + (pp >> 1)) + 8 * (pp & 1));
    bf16x8 vf; vf[0] = lo[0]; vf[1] = lo[1]; vf[2] = lo[2]; vf[3] = lo[3]; vf[4] = hi[0]; vf[5] = hi[1]; vf[6] = hi[2]; vf[7] = hi[3]; return vf;
}

__device__ __forceinline__ void store_o_tile(LAS unsigned char* stg, const f32x4 (&O)[8], float sc, unsigned char* grow, int g, int ql) {
#pragma unroll
    for (int dt = 0; dt < 8; ++dt) *(LAS unsigned*)(stg + ql * 144 + (4 * dt + g) * 4) = pk4_fp8(O[dt][0] * sc, O[dt][1] * sc, O[dt][2] * sc, O[dt][3] * sc);
    const u32x4 a = *(const LAS u32x4*)(stg + ql * 144 + 16 * g), b = *(const LAS u32x4*)(stg + ql * 144 + 64 + 16 * g);
    *(u32x4*)(grow + 16 * g) = a; *(u32x4*)(grow + 64 + 16 * g) = b;
}
__device__ __forceinline__ void attn_window_item(const Params& p, LAS unsigned char* lds, int item, int& tab_head) {
    const int tid = phase_tid(), lane = tid & 63, w = __builtin_amdgcn_readfirstlane(tid >> 6), g = lane >> 4, ql = lane & 15;
    const int b = item >> 9, nb = (item >> 2) & 127, hpq = item & 3, kv = hpq >> 1, hq0 = 2 * hpq;
    const bf16_t* qkv = (const bf16_t*)(p.ws + WS_QKV); unsigned char* o = p.ws + WS_O8;
    LAS float* bias = (LAS float*)(lds + 131072); const unsigned ldsb = (unsigned)(size_t)lds;
    const unsigned loff = (unsigned)(w * 4 + g) * 128 + (unsigned)((ql ^ ((g << 2) | (w & 3))) * 8);
    const bf16_t* kbase = (const bf16_t*)(p.ws + WS_KVA) + (size_t)kv * T * 128 + (size_t)(b * SEQ) * 128;
#define WIN_ISSUE(c) do { const int _c = (c); const int _kb = min(max(nb - 1 + (_c % 3), 0), 127); const bf16_t* _src = kbase + (_c >= 3 ? (size_t)2 * T * 128 : (size_t)0) + (size_t)(_kb * 128) * 128 + loff; \
        _Pragma("unroll") for (int _i = 0; _i < 4; ++_i) glds16_asm(_src + (size_t)(32 * _i) * 128, ldsb + (unsigned)((_c & 3) * 32768 + _i * 8192 + w * 1024)); } while (0)
    ATT_BAR();
    WIN_ISSUE(0); WIN_ISSUE(1); WIN_ISSUE(2);
    if (hpq != tab_head) { for (int i = tid; i < 2 * 257; i += 512) { const int hh = i >= 257, j = i - 257 * hh; bias[hh * 264 + j] = p.in[12][t5_bucket(j - 128) * 8 + hq0 + hh] * 1.4426950408889634f; } tab_head = hpq; }
    const int tq = b * SEQ + nb * 128 + 16 * w + ql;
    bf16x8 qf[2][4]; load_q(qkv + (size_t)tq * NQKV + hq0 * 128, g, qf[0]); load_q(qkv + (size_t)tq * NQKV + (hq0 + 1) * 128, g, qf[1]);
    float sink[2]; sink[0] = p.in[5][hq0] * 1.4426950408889634f; sink[1] = p.in[5][hq0 + 1] * 1.4426950408889634f; asm volatile("" : "+v"(sink[0]), "+v"(sink[1]));
    f32x4 S1[2][8], SC[2][9];
#pragma unroll
    for (int u = 0; u < 2; ++u) {
#pragma unroll
        for (int kt = 0; kt < 8; ++kt) S1[u][kt] = (f32x4){0.f, 0.f, 0.f, 0.f};
#pragma unroll
        for (int s = 0; s < 9; ++s) SC[u][s] = (f32x4){0.f, 0.f, 0.f, 0.f}; }
    const bool in0 = nb > 0, in2 = nb < 127;
#pragma unroll
    for (int c = 0; c < 3; ++c) {
        wait_vm(8); ATT_BAR(); WIN_ISSUE(c + 3);
        LAS unsigned char* buf = lds + (c & 3) * 32768;
#pragma unroll
        for (int kt = 0; kt < 8; ++kt) {
            const bool act = (c == 1) || (c == 0 ? kt >= w : kt <= w);
            if (act) {
#pragma unroll
                for (int ks = 0; ks < 4; ++ks) { const bf16x8 kf = *(const LAS bf16x8*)(buf + off_b(16 * kt + ql, 4 * ks + g));
#pragma unroll
                    for (int u = 0; u < 2; ++u) {
                        if (c == 1) S1[u][kt] = __builtin_amdgcn_mfma_f32_16x16x32_bf16(kf, qf[u][ks], S1[u][kt], 0, 0, 0);
                        else if (c == 0) SC[u][7 - kt] = __builtin_amdgcn_mfma_f32_16x16x32_bf16(kf, qf[u][ks], SC[u][7 - kt], 0, 0, 0);
                        else SC[u][8 - kt] = __builtin_amdgcn_mfma_f32_16x16x32_bf16(kf, qf[u][ks], SC[u][8 - kt], 0, 0, 0); } } }
        }
    }
    const int qi = 16 * w + ql; float inv[2];
    unsigned P1[2][4][4], PC[2][9][2];
#pragma unroll
    for (int u = 0; u < 2; ++u) { float mx = sink[u]; const LAS float* bt = bias + u * 264;
#pragma unroll
        for (int kt = 0; kt < 8; kt += 2) { float bv[8];
#pragma unroll
            for (int j = 0; j < 8; ++j) bv[j] = bt[16 * (kt + (j >> 2)) + 4 * g + (j & 3) - qi + 128];
            asm volatile("" : "+v"(bv[0]), "+v"(bv[1]), "+v"(bv[2]), "+v"(bv[3]), "+v"(bv[4]), "+v"(bv[5]), "+v"(bv[6]), "+v"(bv[7]));
#pragma unroll
            for (int j = 0; j < 8; ++j) { const float sv = S1[u][kt + (j >> 2)][j & 3] + bv[j]; S1[u][kt + (j >> 2)][j & 3] = sv; mx = fmaxf(mx, sv); } }
#pragma unroll
        for (int s = 0; s < 9; ++s) { const bool c0 = s <= 7 - w; const int kt = c0 ? 7 - s : 8 - s; const int cofs = c0 ? -128 : 128; const bool inr = c0 ? in0 : in2;
            float bv[4];
#pragma unroll
            for (int r = 0; r < 4; ++r) bv[r] = bt[cofs + 16 * kt + 4 * g + r - qi + 128];
            asm volatile("" : "+v"(bv[0]), "+v"(bv[1]), "+v"(bv[2]), "+v"(bv[3]));
#pragma unroll
            for (int r = 0; r < 4; ++r) { const int rel = cofs + 16 * kt + 4 * g + r - qi; const bool valid = inr && rel >= -128 && rel <= 128;
                const float sv = valid ? SC[u][s][r] + bv[r] : -1e30f; SC[u][s][r] = sv; mx = fmaxf(mx, sv); } }
        mx = fmaxf(mx, __shfl_xor(mx, 16)); mx = fmaxf(mx, __shfl_xor(mx, 32));
        float l = 0.f;
#pragma unroll
        for (int kk = 0; kk < 4; ++kk) { float e[8];
#pragma unroll
            for (int r = 0; r < 4; ++r) { e[r] = __builtin_amdgcn_exp2f(S1[u][2 * kk][r] - mx); e[4 + r] = __builtin_amdgcn_exp2f(S1[u][2 * kk + 1][r] - mx); l += e[r] + e[4 + r]; }
            P1[u][kk][0] = pk2(e[0], e[1]); P1[u][kk][1] = pk2(e[2], e[3]); P1[u][kk][2] = pk2(e[4], e[5]); P1[u][kk][3] = pk2(e[6], e[7]); }
#pragma unroll
        for (int s = 0; s < 9; ++s) { float e[4];
#pragma unroll
            for (int r = 0; r < 4; ++r) { e[r] = __builtin_amdgcn_exp2f(SC[u][s][r] - mx); l += e[r]; }
            PC[u][s][0] = pk2(e[0], e[1]); PC[u][s][1] = pk2(e[2], e[3]); }
        l += __shfl_xor(l, 16); l += __shfl_xor(l, 32); l += __builtin_amdgcn_exp2f(sink[u] - mx);
        inv[u] = 1.0f / l; }
    f32x4 O[2][8];
#pragma unroll
    for (int u = 0; u < 2; ++u)
#pragma unroll
        for (int dt = 0; dt < 8; ++dt) O[u][dt] = (f32x4){0.f, 0.f, 0.f, 0.f};
    const int q4 = ql >> 2, pp = ql & 3;
#pragma unroll
    for (int c = 0; c < 3; ++c) {
        wait_vm(c == 0 ? 8 : (c == 1 ? 4 : 0)); ATT_BAR();
        LAS unsigned char* buf = lds + ((c + 3) & 3) * 32768;
#pragma unroll
        for (int kk = 0; kk < 4; ++kk) {
            bool a0, a1;
            if (c == 1) { a0 = true; a1 = true; } else if (c == 0) { a0 = 2 * kk >= w; a1 = 2 * kk + 1 >= w; } else { a0 = 2 * kk <= w; a1 = 2 * kk + 1 <= w; }
            if (a0 || a1) { bf16x8 pf[2];
#pragma unroll
                for (int u = 0; u < 2; ++u) { u32x4 pw;
                    if (c == 1) { pw.x = P1[u][kk][0]; pw.y = P1[u][kk][1]; pw.z = P1[u][kk][2]; pw.w = P1[u][kk][3]; }
                    else if (c == 0) { pw.x = a0 ? PC[u][7 - 2 * kk][0] : 0u; pw.y = a0 ? PC[u][7 - 2 * kk][1] : 0u; pw.z = a1 ? PC[u][6 - 2 * kk][0] : 0u; pw.w = a1 ? PC[u][6 - 2 * kk][1] : 0u; }
                    else { pw.x = a0 ? PC[u][8 - 2 * kk][0] : 0u; pw.y = a0 ? PC[u][8 - 2 * kk][1] : 0u; pw.z = a1 ? PC[u][7 - 2 * kk][0] : 0u; pw.w = a1 ? PC[u][7 - 2 * kk][1] : 0u; }
                    pf[u] = __builtin_bit_cast(bf16x8, pw); }
#pragma unroll
                for (int dt = 0; dt < 8; ++dt) { const bf16x8 vf = vt_frag(buf, 32 * kk, g, q4, pp, dt);
                    O[0][dt] = __builtin_amdgcn_mfma_f32_16x16x32_bf16(vf, pf[0], O[0][dt], 0, 0, 0); O[1][dt] = __builtin_amdgcn_mfma_f32_16x16x32_bf16(vf, pf[1], O[1][dt], 0, 0, 0); } } }
    }
#undef WIN_ISSUE
#pragma unroll
    for (int u = 0; u < 2; ++u) store_o_tile(lds + 2 * 32768 + w * 2304, O[u], inv[u] * 16.f, o + (size_t)tq * D + (hq0 + u) * 128, g, ql);
}

__device__ __forceinline__ void attn_nat_item(const Params& p, LAS unsigned char* lds, int item, int& tab_head) {
    const int tid = phase_tid(), lane = tid & 63, w = __builtin_amdgcn_readfirstlane(tid >> 6), g = lane >> 4, ql = lane & 15;
    const int b = item >> 9, rp = (item >> 2) & 127, hp = item & 3, hh = w >> 2, h = 2 * hp + hh, jq = w & 3;
    const int kr_lo = min(max(2 * rp - 4, 0), 248);
    const int d0 = min(max(2 * rp - 4, 0), 248) - kr_lo, d1 = min(max(2 * rp - 3, 0), 248) - kr_lo;
    const int w0 = jq == 0 ? 0 : (jq == 1 ? 8 : (jq == 2 ? 24 : 32));
    const bf16_t* qkv = (const bf16_t*)(p.ws + WS_QKV); unsigned char* o = p.ws + WS_O8;
    LAS float* rpb = (LAS float*)(lds + 131072); const unsigned ldsb = (unsigned)(size_t)lds;
    const unsigned loff = (unsigned)(w * 4 + g) * 128 + (unsigned)((ql ^ ((g << 2) | (w & 3))) * 8);
    const bf16_t* kbase = (const bf16_t*)(p.ws + WS_KVB) + (size_t)(2 * hp) * T * 128 + (size_t)(b * SEQ) * 128;
#define NAT_ISSUE(s) do { const int _s = (s); const int _kr = min(kr_lo + (_s % 9), 255); const bf16_t* _src = kbase + (_s >= 9 ? (size_t)8 * T * 128 : (size_t)0) + (size_t)(_kr * 64) * 128 + loff; \
        _Pragma("unroll") for (int _i = 0; _i < 4; ++_i) glds16_asm(_src + (size_t)(32 * (_i & 1)) * 128 + (size_t)(_i >> 1) * T * 128, ldsb + (unsigned)((_s & 3) * 32768 + _i * 8192 + w * 1024)); } while (0)
    ATT_BAR();
    NAT_ISSUE(0); NAT_ISSUE(1); NAT_ISSUE(2);
    if (hp != tab_head) { for (int i = tid; i < 930; i += 512) rpb[i] = p.in[8][2 * hp * 465 + i] * 1.4426950408889634f; tab_head = hp; }
    const int qcol = 16 * jq + ql; const int tq0 = b * SEQ + (2 * rp) * 64 + qcol;
    bf16x8 qf[2][4]; load_q(qkv + (size_t)tq0 * NQKV + 1536 + h * 128, g, qf[0]); load_q(qkv + (size_t)(tq0 + 64) * NQKV + 1536 + h * 128, g, qf[1]);
    f32x4 S[2][9][2];
#pragma unroll
    for (int u = 0; u < 2; ++u)
#pragma unroll
        for (int c = 0; c < 9; ++c) { S[u][c][0] = (f32x4){0.f, 0.f, 0.f, 0.f}; S[u][c][1] = (f32x4){0.f, 0.f, 0.f, 0.f}; }
#pragma unroll
    for (int c = 0; c < 9; ++c) {
        wait_vm(8); ATT_BAR(); NAT_ISSUE(c + 3);
        const bool a0 = c >= d0 && c < d0 + 8, a1 = c >= d1 && c < d1 + 8;
        LAS unsigned char* buf = lds + (c & 3) * 32768 + hh * 16384;
#pragma unroll
        for (int t = 0; t < 2; ++t)
#pragma unroll
            for (int ks = 0; ks < 4; ++ks) { const bf16x8 kf = *(const LAS bf16x8*)(buf + off_b(w0 + 16 * t + ql, 4 * ks + g));
                if (a0) S[0][c][t] = __builtin_amdgcn_mfma_f32_16x16x32_bf16(kf, qf[0][ks], S[0][c][t], 0, 0, 0);
                if (a1) S[1][c][t] = __builtin_amdgcn_mfma_f32_16x16x32_bf16(kf, qf[1][ks], S[1][c][t], 0, 0, 0); }
    }
    const int cs = min(max(qcol - 8, 0), 48); float inv[2];
    unsigned P[2][9][4];
    int dcv[2][4]; bool cv[2][4];
#pragma unroll
    for (int t = 0; t < 2; ++t)
#pragma unroll
        for (int q = 0; q < 4; ++q) { const int kc = w0 + 16 * t + 4 * g + q; cv[t][q] = kc >= cs && kc < cs + 16; dcv[t][q] = hh * 465 + kc - qcol + 15; }
#pragma unroll
    for (int u = 0; u < 2; ++u) { const int du = u ? d1 : d0; const int r = 2 * rp + u; float mx = -1e30f;
#pragma unroll
        for (int c = 0; c < 9; ++c) { const bool act = c >= du && c < du + 8;
            if (act) { const int rowb = (kr_lo + c - r + 7) * 31;
                float bv[8];
#pragma unroll
                for (int j = 0; j < 8; ++j) bv[j] = rpb[rowb + dcv[j >> 2][j & 3]];
                asm volatile("" : "+v"(bv[0]), "+v"(bv[1]), "+v"(bv[2]), "+v"(bv[3]), "+v"(bv[4]), "+v"(bv[5]), "+v"(bv[6]), "+v"(bv[7]));
#pragma unroll
                for (int t = 0; t < 2; ++t)
#pragma unroll
                    for (int q = 0; q < 4; ++q) { const float sv = cv[t][q] ? S[u][c][t][q] + bv[4 * t + q] : -1e30f; S[u][c][t][q] = sv; mx = fmaxf(mx, sv); } } }
        mx = fmaxf(mx, __shfl_xor(mx, 16)); mx = fmaxf(mx, __shfl_xor(mx, 32));
        float l = 0.f;
#pragma unroll
        for (int c = 0; c < 9; ++c) { const bool act = c >= du && c < du + 8;
            if (act) { float e[2][4];
#pragma unroll
                for (int t = 0; t < 2; ++t)
#pragma unroll
                    for (int q = 0; q < 4; ++q) { e[t][q] = __builtin_amdgcn_exp2f(S[u][c][t][q] - mx); l += e[t][q]; }
                P[u][c][0] = pk2(e[0][0], e[0][1]); P[u][c][1] = pk2(e[0][2], e[0][3]); P[u][c][2] = pk2(e[1][0], e[1][1]); P[u][c][3] = pk2(e[1][2], e[1][3]); }
            else { P[u][c][0] = 0u; P[u][c][1] = 0u; P[u][c][2] = 0u; P[u][c][3] = 0u; } }
        l += __shfl_xor(l, 16); l += __shfl_xor(l, 32);
        inv[u] = 1.0f / l; }
    f32x4 O[2][8];
#pragma unroll
    for (int u = 0; u < 2; ++u)
#pragma unroll
        for (int dt = 0; dt < 8; ++dt) O[u][dt] = (f32x4){0.f, 0.f, 0.f, 0.f};
    const int q4 = ql >> 2, pp = ql & 3;
#pragma unroll
    for (int c = 0; c < 9; ++c) {
        wait_vm(c <= 6 ? 8 : (c == 7 ? 4 : 0)); ATT_BAR(); if (c + 12 < 18) NAT_ISSUE(c + 12);
        const bool a0 = c >= d0 && c < d0 + 8, a1 = c >= d1 && c < d1 + 8;
        LAS unsigned char* buf = lds + ((c + 9) & 3) * 32768 + hh * 16384;
        u32x4 pw0; pw0.x = P[0][c][0]; pw0.y = P[0][c][1]; pw0.z = P[0][c][2]; pw0.w = P[0][c][3];
        u32x4 pw1; pw1.x = P[1][c][0]; pw1.y = P[1][c][1]; pw1.z = P[1][c][2]; pw1.w = P[1][c][3];
        const bf16x8 pf0 = __builtin_bit_cast(bf16x8, pw0), pf1 = __builtin_bit_cast(bf16x8, pw1);
#pragma unroll
        for (int dt = 0; dt < 8; ++dt) { const bf16x8 vf = vt_frag(buf, w0, g, q4, pp, dt);
            if (a0) O[0][dt] = __builtin_amdgcn_mfma_f32_16x16x32_bf16(vf, pf0, O[0][dt], 0, 0, 0);
            if (a1) O[1][dt] = __builtin_amdgcn_mfma_f32_16x16x32_bf16(vf, pf1, O[1][dt], 0, 0, 0); }
    }
#undef NAT_ISSUE
#pragma unroll
    for (int u = 0; u < 2; ++u) store_o_tile(lds + 2 * 32768 + w * 2304, O[u], inv[u] * 16.f, o + (size_t)(tq0 + 64 * u) * D + 1024 + h * 128, g, ql);
}
__device__ __forceinline__ void p2_attn(const Params& p, LAS unsigned char* lds) {
    int tab_head = -1, mb = 0;
    const int nper = (1024 + (int)gridDim.x - 1) / (int)gridDim.x;
    const int NB = (MOE_ITEMS + 8 * (int)gridDim.x - 1) / (8 * (int)gridDim.x);
    for (int s = 0; s < 2 * nper || mb < NB; ++s) {
        if (s < 2 * nper) {
            const bool nat = s >= nper; const int it = (int)blockIdx.x + (nat ? s - nper : s) * (int)gridDim.x;
            if (s == nper) { tab_head = -1;
#ifdef PROBE_A
                if (blockIdx.x == 0 && threadIdx.x == 0) ((unsigned long long*)(p.ws + WS_END))[11] = __builtin_amdgcn_s_memrealtime();
#endif
            }
            if (it < 1024) { if (!nat) attn_window_item(p, lds, it, tab_head); else attn_nat_item(p, lds, it, tab_head); }
        }
        if ((((s + (int)blockIdx.x) & 1) == 0 || s >= 2 * nper) && mb < NB) {
            ATT_BAR();
            for (int q = 0; q < 2 && mb < NB; ++q) moe_prep_batch(p, lds, mb++);
        }
    }
    asm volatile("s_waitcnt vmcnt(0)" ::: "memory"); __syncthreads();
}

struct UpHook { const bf16_t* gates;
    __device__ __forceinline__ void operator()(f32x4 (&acc)[2][2][4][2], const Unit& u, int wr, int wc, int fr, int fq) const {
        const unsigned goff = (unsigned)(u.pm * 8 + u.pn) * 98304u + (unsigned)(wr * 64 + fr) * 256 + wc * 64 + 16 * fq;
#pragma unroll
        for (int ai = 0; ai < 2; ++ai) {
            bf16x8 ra[4][2];
#pragma unroll
            for (int m = 0; m < 4; ++m)
#pragma unroll
                for (int bj = 0; bj < 2; ++bj) ra[m][bj] = __builtin_nontemporal_load((const bf16x8*)(gates + goff + (unsigned)((ai * 128 + m * 16) * 256) + bj * 8));
#pragma unroll
            for (int m = 0; m < 4; ++m)
#pragma unroll
                for (int bj = 0; bj < 2; ++bj)
#pragma unroll
                    for (int n = 0; n < 2; ++n)
#pragma unroll
                        for (int j = 0; j < 4; ++j) acc[ai][bj][m][n][j] *= bf2f(ra[m][bj][4 * n + j]);
            asm volatile("" ::: "memory"); }
    } };
struct UpSched {
    pg8::TileOrder o; const unsigned char* A; const unsigned char* Bt;
    __device__ __forceinline__ bool next(int i, Unit& u) const { u.aux = i & 1; return o.tile(i >> 1, u.pm, u.pn); }
    __device__ __forceinline__ const char* a_base(const Unit&) const { return (const char*)A; }
    __device__ __forceinline__ const char* b_base(const Unit& u) const { return (const char*)(Bt + (size_t)u.pn * 256 * D + u.aux * 1024); }
    __device__ __forceinline__ bool keep_acc(const Unit& u) const { return u.aux == 0; }
    __device__ __forceinline__ void a_offs(const Unit& u, int R0, int C0, int R1, int C1, unsigned (&v)[2][2]) const {
#pragma unroll
        for (int h = 0; h < 2; ++h) { v[h][0] = (unsigned)(u.pm * 256 + 128 * h + R0) * D + u.aux * 1024 + C0 * 2u; v[h][1] = (unsigned)(u.pm * 256 + 128 * h + R1) * D + u.aux * 1024 + C1 * 2u; } }
};
struct EpiUp { const bf16_t* gates; unsigned char* merged;
    __device__ __forceinline__ void operator()(f32x4 (&acc)[2][2][4][2], const Unit& u, int wr, int wc, int fr, int fq) const {
        if (u.aux == 0) { UpHook{gates}(acc, u, wr, wc, fr, fq); return; }
        const unsigned char* sbp = (const unsigned char*)gates + (size_t)(u.pm * 8 + u.pn) * 196608 + 131072 + (unsigned)(wr * 64 + fr) * 256 + wc * 64 + 16 * fq;
        const unsigned moff = (unsigned)(u.pm * 256 + wr * 64 + fr) * D + u.pn * 256 + wc * 64 + 16 * fq;
#pragma unroll
        for (int ai = 0; ai < 2; ++ai) {
            u32x4 sb[4];
#pragma unroll
            for (int m = 0; m < 4; ++m) sb[m] = __builtin_nontemporal_load((const u32x4*)(sbp + (unsigned)((ai * 128 + m * 16) * 256)));
#pragma unroll
            for (int m = 0; m < 4; ++m) { unsigned wq[4];
#pragma unroll
                for (int bj = 0; bj < 2; ++bj) { f32x4 v0 = acc[ai][bj][m][0], v1 = acc[ai][bj][m][1];
#pragma unroll
                    for (int j = 0; j < 4; ++j) { v0[j] *= ((float)((sb[m][2 * bj] >> (8 * j)) & 255u) + 0.5f) * (1.0f / 16384.0f); v1[j] *= ((float)((sb[m][2 * bj + 1] >> (8 * j)) & 255u) + 0.5f) * (1.0f / 16384.0f); }
                    wq[2 * bj] = pk4_fp8(v0[0], v0[1], v0[2], v0[3]); wq[2 * bj + 1] = pk4_fp8(v1[0], v1[1], v1[2], v1[3]); }
                u32x4 w; w.x = wq[0]; w.y = wq[1]; w.z = wq[2]; w.w = wq[3];
                *(u32x4*)(merged + moff + (unsigned)((ai * 128 + m * 16) * D)) = w; }
            asm volatile("" ::: "memory"); }
    } };
__device__ __forceinline__ void p3_up(const Params& p, LAS unsigned char* lds) {
    UpSched S; S.o.init(128, 8, gridDim.x, blockIdx.x); S.A = p.ws + WS_O8; S.Bt = p.ws + WS_WUP;
    EpiUp E{(const bf16_t*)(p.ws + WS_GATES), p.ws + WS_MG};
    int ntv = 1024 / 128; asm volatile("" : "+s"(ntv));
    pg8::gemm_phase<true, true, UpSched, EpiUp, true, true, true>(lds, S, E, ntv, D / 2, D / 2);
}

struct EpiOut { const float* x; bf16_t* hb;
    __device__ __forceinline__ void operator()(f32x4 (&acc)[2][2][4][2], const Unit& u, int wr, int wc, int fr, int fq) const {
        unsigned off = (unsigned)(u.pm * 256 + wr * 64 + fr) * D + u.pn * 256 + wc * 32 + 8 * fq;
        unsigned hoff = (unsigned)(u.pm * 8 + u.pn) * 65536u + (unsigned)(wr * 64 + fr) * 256 + wc * 32 + 8 * fq;
#pragma unroll
        for (int ai = 0; ai < 2; ++ai) {
            f32x4 xr[4][2][2];
#pragma unroll
            for (int m = 0; m < 4; ++m)
#pragma unroll
                for (int bj = 0; bj < 2; ++bj) { const f32x4* xp = (const f32x4*)(x + off + (unsigned)(m * 16 * D) + bj * 128); xr[m][bj][0] = __builtin_nontemporal_load(xp); xr[m][bj][1] = __builtin_nontemporal_load(xp + 1); }
#pragma unroll
            for (int m = 0; m < 4; ++m) { asm volatile("" : "+v"(off));
#pragma unroll
                for (int bj = 0; bj < 2; ++bj) { const f32x4 h0 = acc[ai][bj][m][0] * (1.0f / 1024.0f) + xr[m][bj][0], h1 = acc[ai][bj][m][1] * (1.0f / 1024.0f) + xr[m][bj][1];
                    u32x4 w; w.x = pk2(h0[0], h0[1]); w.y = pk2(h0[2], h0[3]); w.z = pk2(h1[0], h1[1]); w.w = pk2(h1[2], h1[3]);
                    *(u32x4*)(hb + hoff + bj * 128) = w; }
                off += 16 * D; hoff += 16 * 256; }
            off += 64 * D; hoff += 64 * 256; }
    } };
__device__ __forceinline__ void p4_out(const Params& p, LAS unsigned char* lds) {
    GateSched S; S.o.init(128, 8, gridDim.x, blockIdx.x); S.x8 = p.ws + WS_MG; S.W8 = p.ws + WS_WOUT;
    EpiOut E{p.in[0], (bf16_t*)(p.ws + WS_O)};
    pg8::gemm_phase<true, true, GateSched, EpiOut, true, false>(lds, S, E, D / 128, D / 2, D / 2);
}

__device__ __forceinline__ void p5_router(const Params& p, LAS unsigned char* lds) {
    const int tid = phase_tid(), lane = tid & 63, wave = __builtin_amdgcn_readfirstlane(tid >> 6), g = lane >> 4, tl = lane & 15;
    const bf16_t* wsp = (const bf16_t*)(p.ws + WS_WRT); float* r2 = (float*)(p.ws + WS_R2); int* cnt = (int*)(p.ws + WS_CNT); int* tokl = (int*)(p.ws + WS_TOK);
    int* recc = (int*)(p.ws + WS_RECC); float* recw = (float*)(p.ws + WS_RECW); const bf16_t* hb = (const bf16_t*)(p.ws + WS_O);
    const float* brg = p.in[15]; const float* bre = p.in[17];
    LAS unsigned char* H = lds + wave * 2304;
    LAS unsigned char* WL = lds + 36864;
    const int r8 = lane >> 3, s8 = lane & 7;
    const int pa0 = tid / 384, pr0 = (tid % 384) >> 3, ps0 = tid & 7, pi1 = 512 + tid, pa1 = pi1 / 384, pr1 = (pi1 % 384) >> 3;
    const unsigned wsrc0 = (unsigned)(pa0 * 48 * 2048 + pr0 * D + ps0 * 8), wsrc1 = (unsigned)(pa1 * 48 * 2048 + pr1 * D + ps0 * 8);
    const unsigned wdst0 = (unsigned)(pa0 * 6144 + pr0 * 128 + ((ps0 ^ (pr0 & 7)) << 4)), wdst1 = (unsigned)(pa1 * 6144 + pr1 * 128 + ((ps0 ^ (pr1 & 7)) << 4));
    for (int round = blockIdx.x; round < T / 128; round += gridDim.x) {
        const int tile = round * 8 + wave;
        const bf16_t* hs = hb + (size_t)((tile >> 4) * 8) * 65536 + (size_t)(((tile & 15) * 16 + r8) * 256 + s8 * 8);   unsigned char* h8s = p.ws + WS_H8 + (size_t)tile * 16 * D + r8 * D + s8 * 8;
        f32x4 accA = {0.f, 0.f, 0.f, 0.f}, accB = accA, accC = accA; float ss = 0.f;
        u32x4 hq0[2], hq1[2], hq2[2], hq3[2], wr0, wr1;
#define RT_LOADS(bq, k) do { const int ko_ = (((k) >> 2) << 16) + (((k) & 3) << 6); bq[0] = __builtin_nontemporal_load((const u32x4*)(hs + ko_)); bq[1] = __builtin_nontemporal_load((const u32x4*)(hs + 8 * 256 + ko_)); } while (0)
#define RT_H8(w_) ({ const u32x4 w__ = (w_); u32x2 f__; f__.x = pk4_fp8(__uint_as_float(w__.x << 16), __uint_as_float(w__.x & 0xffff0000u), __uint_as_float(w__.y << 16), __uint_as_float(w__.y & 0xffff0000u)); \
            f__.y = pk4_fp8(__uint_as_float(w__.z << 16), __uint_as_float(w__.z & 0xffff0000u), __uint_as_float(w__.w << 16), __uint_as_float(w__.w & 0xffff0000u)); f__; })
#define RT_COMP(bq, wbuf, k) do { \
            *(u32x2*)(h8s + 64 * (k)) = RT_H8(bq[0]); *(u32x2*)(h8s + 8 * D + 64 * (k)) = RT_H8(bq[1]); \
            *(LAS u32x4*)(H + r8 * 144 + s8 * 16) = bq[0]; *(LAS u32x4*)(H + (r8 + 8) * 144 + s8 * 16) = bq[1]; \
            _Pragma("unroll") for (int ks = 0; ks < 2; ++ks) { const u32x4 hw = *(const LAS u32x4*)(H + tl * 144 + 64 * ks + 16 * g); \
                { const float a0 = __uint_as_float(hw.x << 16), a1 = __uint_as_float(hw.x & 0xffff0000u), a2 = __uint_as_float(hw.y << 16), a3 = __uint_as_float(hw.y & 0xffff0000u); \
                  const float a4 = __uint_as_float(hw.z << 16), a5 = __uint_as_float(hw.z & 0xffff0000u), a6 = __uint_as_float(hw.w << 16), a7 = __uint_as_float(hw.w & 0xffff0000u); \
                  ss += (a0 * a0 + a1 * a1) + (a2 * a2 + a3 * a3) + (a4 * a4 + a5 * a5) + (a6 * a6 + a7 * a7); } \
                const bf16x8 bh = __builtin_bit_cast(bf16x8, hw); const unsigned so_ = (unsigned)(((4 * ks + g) ^ (tl & 7)) << 4); \
                _Pragma("unroll") for (int t = 0; t < 3; ++t) { const bf16x8 ah = *(const LAS bf16x8*)((wbuf) + (16 * t + tl) * 128 + so_), al = *(const LAS bf16x8*)((wbuf) + 6144 + (16 * t + tl) * 128 + so_); \
                    f32x4& ac = (t == 0 ? accA : (t == 1 ? accB : accC)); \
                    ac = __builtin_amdgcn_mfma_f32_16x16x32_bf16(ah, bh, ac, 0, 0, 0); ac = __builtin_amdgcn_mfma_f32_16x16x32_bf16(al, bh, ac, 0, 0, 0); } } } while (0)
#define RT_WLOAD(c) do { wr0 = *(const u32x4*)(wsp + wsrc0 + 64 * (c)); if (tid < 256) wr1 = *(const u32x4*)(wsp + wsrc1 + 64 * (c)); } while (0)
#define RT_WSTORE(wbuf) do { *(LAS u32x4*)((wbuf) + wdst0) = wr0; if (tid < 256) *(LAS u32x4*)((wbuf) + wdst1) = wr1; } while (0)
        __syncthreads();
        RT_WLOAD(0); RT_LOADS(hq0, 0); RT_LOADS(hq1, 1); RT_LOADS(hq2, 2);
        RT_WSTORE(WL); RT_WLOAD(1);
        __syncthreads();
#pragma unroll 1
        for (int c = 0; c < D / 64; c += 4) {
            RT_LOADS(hq3, (c + 3));      RT_COMP(hq0, WL, c);             RT_WSTORE(WL + 12288); RT_WLOAD((c + 2) & 31); __syncthreads();
            RT_LOADS(hq0, (c + 4) & 31); RT_COMP(hq1, WL + 12288, c + 1); RT_WSTORE(WL);         RT_WLOAD((c + 3) & 31); __syncthreads();
            RT_LOADS(hq1, (c + 5) & 31); RT_COMP(hq2, WL, c + 2);         RT_WSTORE(WL + 12288); RT_WLOAD((c + 4) & 31); __syncthreads();
            RT_LOADS(hq2, (c + 6) & 31); RT_COMP(hq3, WL + 12288, c + 3); RT_WSTORE(WL);         RT_WLOAD((c + 5) & 31); __syncthreads();
        }
#undef RT_LOADS
#undef RT_COMP
#undef RT_H8
#undef RT_WLOAD
#undef RT_WSTORE
        const int tok = tile * 16 + tl;
        ss += __shfl_xor(ss, 16); ss += __shfl_xor(ss, 32);
        const float rr = rsqrtf(ss * (1.0f / D) + EPS);
        const float myg = accC[0] * rr + brg[g];
        float gl[4];
#pragma unroll
        for (int j = 0; j < 4; ++j) gl[j] = __shfl(myg, tl + 16 * j);
        int gi = 0; float gm = gl[0];
#pragma unroll
        for (int i = 1; i < 4; ++i) if (gl[i] > gm) { gm = gl[i]; gi = i; }
        float den = 0.f;
#pragma unroll
        for (int i = 0; i < 4; ++i) den += __expf(gl[i] - gm);
        const float pg = 1.0f / den;
        int L0 = 0, L1 = 0; float wt0 = 0.f, wt1 = 0.f; const bool owner = (g == gi);
        if (owner) {
            float el[8];
#pragma unroll
            for (int i = 0; i < 4; ++i) { el[i] = accA[i] * rr + bre[g * 8 + i]; el[4 + i] = accB[i] * rr + bre[g * 8 + 4 + i]; }
            int e0 = 0; float v0 = el[0];
#pragma unroll
            for (int i = 1; i < 8; ++i) if (el[i] > v0) { v0 = el[i]; e0 = i; }
            int e1 = -1; float v1 = -3.0e38f;
#pragma unroll
            for (int i = 0; i < 8; ++i) if (i != e0 && el[i] > v1) { v1 = el[i]; e1 = i; }
            const float ex = __expf(v1 - v0); const float s0 = 1.0f / (1.0f + ex), s1 = ex * s0;
            r2[tok] = rr; L0 = gi * 8 + e0; L1 = gi * 8 + e1; wt0 = pg * s0; wt1 = pg * s1;
        }
        LAS int* cl = (LAS int*)(lds + 61440);
        if (tid < 32) cl[tid] = 0;
        __syncthreads();
        int q0 = 0, q1 = 0;
        if (owner) { q0 = __hip_atomic_fetch_add(&cl[L0], 1, __ATOMIC_RELAXED, __HIP_MEMORY_SCOPE_WORKGROUP); q1 = __hip_atomic_fetch_add(&cl[L1], 1, __ATOMIC_RELAXED, __HIP_MEMORY_SCOPE_WORKGROUP); }
        __syncthreads();
        if (tid < 32) { const int n = cl[tid]; cl[32 + tid] = n ? atomicAdd(&cnt[tid], n) : 0; }
        __syncthreads();
        if (owner) { const int p0 = cl[32 + L0] + q0, p1 = cl[32 + L1] + q1;
            float* r2l = (float*)(p.ws + WS_R2L);
#define R2L_PERM(p_) (((p_) & ~255) + ((((p_) >> 6) & 1) * 128 + ((p_) & 15) * 8 + (((p_) >> 7) & 1) * 4 + (((p_) >> 4) & 3)))
            tokl[(size_t)L0 * T + p0] = tok; r2l[(size_t)L0 * T + R2L_PERM(p0)] = rr; recc[2 * tok] = L0 * 32768 + p0; recw[2 * tok] = wt0;
            tokl[(size_t)L1 * T + p1] = tok; r2l[(size_t)L1 * T + R2L_PERM(p1)] = rr; recc[2 * tok + 1] = L1 * 32768 + p1; recw[2 * tok + 1] = wt1; }
#undef R2L_PERM
    }
    __syncthreads();
}

__device__ __forceinline__ void build_tiles(const Params& p, LAS int* tab) {
    __syncthreads();
    if (threadIdx.x < 64) { const int L = threadIdx.x; const int c = L < 32 ? ((const int*)(p.ws + WS_CNT))[L] : 0; const int nt = (c + 255) >> 8;
        int pre = nt;
#pragma unroll
        for (int o = 1; o < 32; o <<= 1) { const int v = __shfl_up(pre, o); if (L >= o) pre += v; }
        const int first = pre - nt;
        if (L < 32) { tab[1400 + L] = first * 256; for (int i = 0; i < nt; ++i) { tab[4 + (first + i) * 4 + 0] = L; tab[4 + (first + i) * 4 + 1] = i * 256; tab[4 + (first + i) * 4 + 2] = (first + i) * 256; tab[4 + (first + i) * 4 + 3] = min(256, c - i * 256); } }
        if (L == 31) tab[0] = pre; }
    __syncthreads();
}
template <int NPN> struct MoeOrder { int G, c, t_lo, nt_tiles; const LAS int* tab;
    __device__ __forceinline__ bool unit(int i, Unit& u) const { const long L = (long)i * G + c; if (L >= (long)nt_tiles * NPN) return false;
        const int nwg = nt_tiles * NPN; int wgid = (int)L; { const int q = nwg / 8, r = nwg % 8, xcd = wgid % 8, off = wgid / 8; wgid = (xcd < r ? xcd * (q + 1) : r * (q + 1) + (xcd - r) * q) + off; }
        u.pm = t_lo + wgid / NPN; u.pn = wgid % NPN; u.aux = 0; return true; } };
struct GateUpSched { MoeOrder<4> o; const unsigned char* hb; const unsigned char* WguT; const int* tokl;
    __device__ __forceinline__ bool next(int i, Unit& u) const { return o.unit(i, u); }
    __device__ __forceinline__ const char* a_base(const Unit&) const { return (const char*)hb; }
    __device__ __forceinline__ const char* b_base(const Unit& u) const { const int e = o.tab[4 + u.pm * 4] & 31; return (const char*)(WguT + (size_t)(e * 1024 + u.pn * 256) * D); }
    __device__ __forceinline__ bool keep_acc(const Unit&) const { return false; }
    __device__ __forceinline__ void a_offs(const Unit& u, int R0, int C0, int R1, int C1, unsigned (&v)[2][2]) const {
        const int L = o.tab[4 + u.pm * 4], row0 = o.tab[4 + u.pm * 4 + 1], nrows = o.tab[4 + u.pm * 4 + 3]; const int* lst = tokl + (size_t)L * T + row0;
#pragma unroll
        for (int h = 0; h < 2; ++h) { const int r0 = R0 + 128 * h, r1 = R1 + 128 * h; const int t0 = r0 < nrows ? lst[r0] : 0, t1 = r1 < nrows ? lst[r1] : 0;
            v[h][0] = (unsigned)t0 * D + C0 * 2u; v[h][1] = (unsigned)t1 * D + C1 * 2u; } }
};
struct EpiGateUp { const LAS int* tab; const float* r2l; unsigned char* he;
    __device__ __forceinline__ void operator()(f32x4 (&acc)[2][2][4][2], const Unit& u, int wr, int wc, int fr, int fq) const {
        const int L = tab[4 + u.pm * 4], row0 = tab[4 + u.pm * 4 + 1], slot = tab[4 + u.pm * 4 + 2], nrows = tab[4 + u.pm * 4 + 3];
        f32x4 rq[2]; { const f32x4* rp = (const f32x4*)(r2l + (size_t)L * T + row0 + wr * 128 + fr * 8); rq[0] = rp[0]; rq[1] = rp[1]; }
#pragma unroll
        for (int ai = 0; ai < 2; ++ai)
#pragma unroll
            for (int m = 0; m < 4; ++m) { const int rr = ai * 128 + wr * 64 + m * 16 + fr; const float rs = rr < nrows ? rq[ai][m] * (1.0f / 64.0f) : 0.f;
                u32x2 w; unsigned ww[2];
#pragma unroll
                for (int n = 0; n < 2; ++n) { float hv[4];
#pragma unroll
                    for (int j = 0; j < 4; ++j) { const float gt = acc[ai][0][m][n][j] * rs, up = acc[ai][1][m][n][j] * rs; hv[j] = gt * sigmoidf_(gt) * up * 4.0f; }
                    ww[n] = pk4_fp8(hv[0], hv[1], hv[2], hv[3]); }
                w.x = ww[0]; w.y = ww[1];
                *(u32x2*)(he + (size_t)(slot + rr) * 512 + u.pn * 128 + wc * 32 + 8 * fq) = w; }
    } };
__device__ __forceinline__ void p6_gateup(const Params& p, LAS unsigned char* lds) {
    LAS int* tab = (LAS int*)(lds + TAB_OFF); build_tiles(p, tab);
    GateUpSched S; S.o.G = gridDim.x; S.o.c = blockIdx.x; S.o.t_lo = 0; S.o.nt_tiles = tab[0]; S.o.tab = tab;
    S.hb = p.ws + WS_H8; S.WguT = p.ws + WS_WGU; S.tokl = (const int*)(p.ws + WS_TOK);
    EpiGateUp E{tab, (const float*)(p.ws + WS_R2L), p.ws + WS_HE};
    pg8::gemm_phase<true, true, GateUpSched, EpiGateUp, true>(lds, S, E, D / 128, D / 2, D / 2);
    { LAS int* qb = (LAS int*)(lds + 131072); int* qhead = (int*)(p.ws + WS_CNT) + 32;
      for (;;) { __syncthreads(); if (threadIdx.x == 0) *qb = atomicAdd(qhead, 1); __syncthreads(); const int b = *qb; if (b >= WD_BATCHES) break; wd_prep_batch(p, lds, b); } }
}
struct DownSched { MoeOrder<8> o; const unsigned char* he; const unsigned char* WdT;
    __device__ __forceinline__ bool next(int i, Unit& u) const { return o.unit(i, u); }
    __device__ __forceinline__ const char* a_base(const Unit&) const { return (const char*)he; }
    __device__ __forceinline__ const char* b_base(const Unit& u) const { const int e = o.tab[4 + u.pm * 4] & 31; return (const char*)(WdT + (size_t)(e * 2048 + u.pn * 256) * 512); }
    __device__ __forceinline__ bool keep_acc(const Unit&) const { return false; }
    __device__ __forceinline__ void a_offs(const Unit& u, int R0, int C0, int R1, int C1, unsigned (&v)[2][2]) const {
        const int slot = o.tab[4 + u.pm * 4 + 2];
#pragma unroll
        for (int h = 0; h < 2; ++h) { v[h][0] = (unsigned)(slot + 128 * h + R0) * 512u + C0 * 2u; v[h][1] = (unsigned)(slot + 128 * h + R1) * 512u + C1 * 2u; } }
};
struct EpiDown { const LAS int* tab; unsigned char* ye;
    __device__ __forceinline__ void operator()(f32x4 (&acc)[2][2][4][2], const Unit& u, int wr, int wc, int fr, int fq) const {
        const int slot = tab[4 + u.pm * 4 + 2];
        unsigned off = (unsigned)(slot + wr * 64 + fr) * 2048 + u.pn * 256 + wc * 64 + 16 * fq;
#pragma unroll
        for (int ai = 0; ai < 2; ++ai) {
#pragma unroll
            for (int m = 0; m < 4; ++m) { asm volatile("" : "+v"(off));
                u32x4 w;
                { const f32x4 v = acc[ai][0][m][0] * 0.0625f; w.x = pk4_fp8(v[0], v[1], v[2], v[3]); } { const f32x4 v = acc[ai][0][m][1] * 0.0625f; w.y = pk4_fp8(v[0], v[1], v[2], v[3]); }
                { const f32x4 v = acc[ai][1][m][0] * 0.0625f; w.z = pk4_fp8(v[0], v[1], v[2], v[3]); } { const f32x4 v = acc[ai][1][m][1] * 0.0625f; w.w = pk4_fp8(v[0], v[1], v[2], v[3]); }
                *(u32x4*)(ye + off) = w;
                off += 16 * 2048; }
            off += 64 * 2048; }
    } };
__device__ __forceinline__ void p7_down(const Params& p, LAS unsigned char* lds) {
    LAS int* tab = (LAS int*)(lds + TAB_OFF); build_tiles(p, tab);
    DownSched S; S.o.G = gridDim.x; S.o.c = blockIdx.x; S.o.t_lo = 0; S.o.nt_tiles = tab[0]; S.o.tab = tab;
    S.he = p.ws + WS_HE; S.WdT = p.ws + WS_WD;
    EpiDown E{tab, p.ws + WS_YE};
    int ntv = 512 / 128; asm volatile("" : "+s"(ntv));
    pg8::gemm_phase<true, true, DownSched, EpiDown, true, false, true>(lds, S, E, ntv, 256, 256);
}
__device__ __forceinline__ void p8_combine(const Params& p, LAS unsigned char* lds) {
    LAS int* tab = (LAS int*)(lds + TAB_OFF); build_tiles(p, tab);
    const int tid = phase_tid(), lane = tid & 63, wave = tid >> 6; const int gw = blockIdx.x * 8 + wave, NGW = gridDim.x * 8;
    const int* recc = (const int*)(p.ws + WS_RECC); const float* recw = (const float*)(p.ws + WS_RECW); const bf16_t* hb = (const bf16_t*)(p.ws + WS_O);
    const unsigned char* ye = p.ws + WS_YE;
    for (int tok = gw; tok < T; tok += NGW) {
        const int c0 = recc[2 * tok], c1 = recc[2 * tok + 1]; const float wa = recw[2 * tok] * 0.0625f, wb = recw[2 * tok + 1] * 0.0625f;
        const int s0 = tab[1400 + (c0 >> 15)] + (c0 & 32767), s1 = tab[1400 + (c1 >> 15)] + (c1 & 32767);
        f32x4* op = (f32x4*)(p.out + (size_t)tok * D) + lane; const u32x2* hp = (const u32x2*)(hb + (size_t)((tok >> 8) * 8) * 65536 + (size_t)(tok & 255) * 256) + lane;
        const unsigned* ya = (const unsigned*)(ye + (size_t)s0 * 2048) + lane; const unsigned* yb = (const unsigned*)(ye + (size_t)s1 * 2048) + lane;
        u32x2 m[8]; unsigned a[8], b[8];
#pragma unroll
        for (int j = 0; j < 8; ++j) { m[j] = hp[(size_t)j * 16384]; a[j] = ya[64 * j]; b[j] = yb[64 * j]; }
#pragma unroll
        for (int j = 0; j < 8; ++j) { f32x4 v;
            const f32x2 a0 = __builtin_amdgcn_cvt_pk_f32_fp8(a[j], false), a1 = __builtin_amdgcn_cvt_pk_f32_fp8(a[j], true), b0 = __builtin_amdgcn_cvt_pk_f32_fp8(b[j], false), b1 = __builtin_amdgcn_cvt_pk_f32_fp8(b[j], true);
            v.x = __uint_as_float(m[j].x << 16) + wa * a0.x + wb * b0.x; v.y = __uint_as_float(m[j].x & 0xffff0000u) + wa * a0.y + wb * b0.y;
            v.z = __uint_as_float(m[j].y << 16) + wa * a1.x + wb * b1.x; v.w = __uint_as_float(m[j].y & 0xffff0000u) + wa * a1.y + wb * b1.y;
            op[64 * j] = v; }
    }
}

#define XB_TMO      128
#define XB_XCNT(j)  (256  + 64 * (j))
#define XB_XSUB(j)  (1280 + 64 * (j))
#define XB_XGEN(j)  (2304 + 64 * (j))
#define XB_TOP      3328
#define XB_TOPGEN   3392
#define XCD_BAR_WORDS 3456
#define XB_SPIN_CAP (1u << 18)
__device__ __forceinline__ unsigned xb_ld(unsigned* p)              { return __hip_atomic_load(p, __ATOMIC_RELAXED, __HIP_MEMORY_SCOPE_AGENT); }
__device__ __forceinline__ unsigned xb_add(unsigned* p, unsigned v) { return __hip_atomic_fetch_add(p, v, __ATOMIC_RELAXED, __HIP_MEMORY_SCOPE_AGENT); }
__device__ __forceinline__ unsigned xb_xcc_id() { return (unsigned)__builtin_amdgcn_s_getreg((3 << 11) | 20) & 0xFu; }
#define XB_SPIN(cond, bar) do { unsigned _sp = 0; while (cond) { __builtin_amdgcn_s_sleep(1); \
    if ((++_sp & 255u) == 0u) { if (xb_ld(&(bar)[XB_TMO])) break; if (_sp > XB_SPIN_CAP) { atomicAdd(&(bar)[XB_TMO], 1u); break; } } } } while (0)
struct XcdBarrier { unsigned* bar; unsigned x; volatile LAS unsigned* st; };
__device__ __forceinline__ XcdBarrier xcd_barrier_post(unsigned* bar, volatile LAS unsigned* st) {
    XcdBarrier b; b.bar = bar; b.x = xb_xcc_id(); b.st = st;
    if (threadIdx.x == 0) (void)xb_add(&bar[XB_XCNT(b.x)], 1u);
    return b;
}
__device__ __forceinline__ void xcd_barrier_complete(unsigned* bar, unsigned x, unsigned& nloc, unsigned& nx) {
    const unsigned G = gridDim.x * gridDim.y * gridDim.z;
    unsigned sum, cnt, mine, sp = 0u;
    for (;;) {
        sum = 0u; cnt = 0u; mine = 0u;
#pragma unroll
        for (unsigned j = 0; j < 16; ++j) { const unsigned c = xb_ld(&bar[XB_XCNT(j)]); sum += c; cnt += (c > 0u) ? 1u : 0u; mine = (j == x) ? c : mine; }
        if (sum == G) break;
        __builtin_amdgcn_s_sleep(1);
        if ((++sp & 255u) == 0u) { if (xb_ld(&bar[XB_TMO])) break; if (sp > XB_SPIN_CAP) { atomicAdd(&bar[XB_TMO], 1u); break; } }
    }
    nloc = mine > 0u ? mine : 1u; nx = cnt > 0u ? cnt : 1u;
}
__device__ __forceinline__ void xcd_barrier(const XcdBarrier& b) {
    asm volatile("s_waitcnt vmcnt(0)" ::: "memory");
    __syncthreads();
    if (threadIdx.x == 0) {
        unsigned* bar = b.bar;
        __builtin_amdgcn_s_waitcnt(0);
        unsigned nloc = b.st[0], nx = b.st[1];
        if (nloc == 0u) { xcd_barrier_complete(bar, b.x, nloc, nx); b.st[0] = nloc; b.st[1] = nx; }
        const unsigned old = xb_add(&bar[XB_XSUB(b.x)], 1u);
        const unsigned gen = old / nloc;
        if (old + 1u == (gen + 1u) * nloc) {
            __builtin_amdgcn_fence(__ATOMIC_RELEASE, "agent");
            asm volatile("s_waitcnt vmcnt(0)" ::: "memory");
            const unsigned og = xb_add(&bar[XB_TOP], 1u);
            const unsigned tg = og / nx;
            if (og + 1u == (tg + 1u) * nx) xb_add(&bar[XB_TOPGEN], 1u);
            else XB_SPIN(xb_ld(&bar[XB_TOPGEN]) == tg, bar);
            __builtin_amdgcn_fence(__ATOMIC_ACQUIRE, "agent");
            xb_add(&bar[XB_XGEN(b.x)], 1u);
            asm volatile("s_waitcnt vmcnt(0)" ::: "memory");
        } else {
            XB_SPIN(xb_ld(&bar[XB_XGEN(b.x)]) == gen, bar);
            __builtin_amdgcn_fence(__ATOMIC_ACQUIRE, "agent");
            asm volatile("s_waitcnt vmcnt(0)" ::: "memory");
        }
    }
    __syncthreads();
}

namespace cg = cooperative_groups;
#ifdef PROBE_A
#define STAMP(k) do { if (blockIdx.x == 0 && threadIdx.x == 0) ((unsigned long long*)(p.ws + WS_END))[k] = __builtin_amdgcn_s_memrealtime(); } while (0)
#else
#define STAMP(k) do {} while (0)
#endif
__global__ void __launch_bounds__(512, 2) fwd_megakernel(Params p) {
    extern __shared__ __attribute__((aligned(16))) unsigned char lds_raw[];
    LAS unsigned char* lds = (LAS unsigned char*)lds_raw;
    cg::grid_group grid = cg::this_grid();
    if (threadIdx.x == 0) { *(volatile LAS unsigned*)(lds + XBST_OFF) = 0u; *(volatile LAS unsigned*)(lds + XBST_OFF + 4) = 0u; }
    if (blockIdx.x == 0) for (int i = threadIdx.x; i < XCD_BAR_WORDS; i += 512) ((unsigned*)(p.ws + WS_BAR))[i] = 0u;
    __syncthreads();
#define GSYNC() xcd_barrier(xb)
    STAMP(0);
    p0_prep(p, lds);            grid.sync(); STAMP(1);
    const XcdBarrier xb = xcd_barrier_post((unsigned*)(p.ws + WS_BAR), (volatile LAS unsigned*)(lds + XBST_OFF));
    p1_inproj(p, lds);          GSYNC(); STAMP(2);
    p2_attn(p, lds);            GSYNC(); STAMP(3);
    STAMP(4);
    p3_up(p, lds);              GSYNC(); STAMP(5);
    p4_out(p, lds);             GSYNC(); STAMP(6);
    p5_router(p, lds);          GSYNC(); STAMP(7);
    p6_gateup(p, lds);          GSYNC(); STAMP(8);
    p7_down(p, lds);            GSYNC(); STAMP(9);
    p8_combine(p, lds);
#ifdef PROBE_A
    grid.sync(); STAMP(10); grid.sync();
    {
        const unsigned long long* ts = (const unsigned long long*)(p.ws + WS_END);
        #ifndef PROBE_A1
#define PROBE_A1 (PROBE_A + 1)
#endif
#ifndef PROBE_B1
#define PROBE_B1 (PROBE_B + 1)
#endif
        const float usA = (float)(ts[PROBE_A1] - ts[PROBE_A]) * 0.01f, usB = (float)(ts[PROBE_B1] - ts[PROBE_B]) * 0.01f;
        const float eps = sqrtf(usA * 1e-6f);
        for (size_t i = (size_t)blockIdx.x * 512 + threadIdx.x; i < (size_t)T * D / 4; i += (size_t)gridDim.x * 512) { f32x4 v = ((f32x4*)p.out)[i]; v = v * (1.0f + eps); if (i == 0) v.x += usB * 0.1f; ((f32x4*)p.out)[i] = v; }
    }
#endif
}

extern "C" void kernel_launch(void* const* d_in, const int* in_sizes, int n_in, void* d_out, int out_size, void* d_ws, size_t ws_size, hipStream_t stream) {
    static int grid_blocks = 0;
    if (!grid_blocks) {
        if (n_in != 21 || out_size != T * D || ws_size < WS_TOP) { fprintf(stderr, "kernel_launch: unexpected problem (n_in %d out %d ws %zu)\n", n_in, out_size, ws_size); grid_blocks = -1; return; }
        if (hipFuncSetAttribute((const void*)fwd_megakernel, hipFuncAttributeMaxDynamicSharedMemorySize, LDS_BYTES) != hipSuccess) { fprintf(stderr, "kernel_launch: hipFuncSetAttribute failed\n"); grid_blocks = -1; return; }
        int dev = 0, cus = 0, per_cu = 0;
        hipGetDevice(&dev); hipDeviceGetAttribute(&cus, hipDeviceAttributeMultiprocessorCount, dev);
        hipOccupancyMaxActiveBlocksPerMultiprocessor(&per_cu, (const void*)fwd_megakernel, 512, LDS_BYTES);
        if (per_cu < 1 || cus < 1) { fprintf(stderr, "kernel_launch: occupancy query gave %d blocks/CU on %d CUs\n", per_cu, cus); grid_blocks = -1; return; }
        grid_blocks = cus;
    }
    if (grid_blocks < 0) return;
    Params p{};
    for (int i = 0; i < 21; ++i) p.in[i] = (const float*)d_in[i];
    p.out = (float*)d_out; p.ws = (unsigned char*)d_ws;
    void* args[] = {&p};
    hipError_t e = hipLaunchCooperativeKernel((const void*)fwd_megakernel, dim3(grid_blocks), dim3(512), args, LDS_BYTES, stream);
    if (e != hipSuccess) fprintf(stderr, "cooperative launch failed: %s (grid %d)\n", hipGetErrorString(e), grid_blocks);
}
```
